# Optimizing an MI355X kernel written in HIP

```python
import jax, jax.numpy as jnp
from jax import lax
import numpy as np

D_MODEL = 1024
BATCH = 2
SEQ = 16384
DEPTH = 4

ATTN_HEAD_DIM = 64
ATTN_HEADS = D_MODEL // 128
ATTN_KV_HEADS = ATTN_HEADS // 4
ROPE_DIM = ATTN_HEAD_DIM // 4
ROPE_THETA = 500000.0
WINDOW = 128
ATTN_BLOCK = 128
MLSTM_HEAD_DIM = 128
MLSTM_HEADS = D_MODEL // 256
MLSTM_CHUNK = 64
CONV_WIDTH = 4
N_EXPERTS = 16
N_GROUPS = 4
EXPERTS_PER_GROUP = N_EXPERTS // N_GROUPS
TOP_K = 2
D_FF_EXPERT = D_MODEL // 2
MOE_BLOCK = 256
EPS = 1e-6

ATTN_Q_W = ATTN_HEADS * ATTN_HEAD_DIM
ATTN_KV_W = ATTN_KV_HEADS * ATTN_HEAD_DIM
MLSTM_W = MLSTM_HEADS * MLSTM_HEAD_DIM
IN_WIDTHS = (ATTN_Q_W, ATTN_KV_W, ATTN_KV_W, 2 * MLSTM_W, MLSTM_W, MLSTM_HEADS, MLSTM_HEADS, MLSTM_W, D_MODEL, D_MODEL)
D_IN = ATTN_Q_W + 2 * ATTN_KV_W + 4 * MLSTM_W + 2 * MLSTM_HEADS + 2 * D_MODEL

kernel_name = "hybrid_swa_mlstm_grouped_moe_trunk"


def rms_norm(x, w):
    xf = x.astype(jnp.float32)
    y = xf * lax.rsqrt(jnp.mean(xf * xf, axis=-1, keepdims=True) + EPS)
    return (y * w.astype(jnp.float32)).astype(x.dtype)


def split_cols(p):
    outs = []
    start = 0
    for w in IN_WIDTHS:
        outs.append(p[..., start:start + w])
        start += w
    return outs


def partial_rope(t, cos, sin):
    half = ROPE_DIM // 2
    tf = t.astype(jnp.float32)
    t1 = tf[..., :half]
    t2 = tf[..., half:ROPE_DIM]
    out = jnp.concatenate([t1 * cos - t2 * sin, t2 * cos + t1 * sin, tf[..., ROPE_DIM:]], axis=-1)
    return out.astype(t.dtype)


def sliding_window_attention(q, k, v, sinks):
    B, S, Hq, hd = q.shape
    Hkv = k.shape[2]
    G = Hq // Hkv
    nb = S // ATTN_BLOCK
    f32 = jnp.float32
    qb = q.astype(f32).reshape(B, nb, ATTN_BLOCK, Hkv, G, hd)

    def band(t):
        tb = t.astype(f32).reshape(B, nb, ATTN_BLOCK, Hkv, hd)
        prev = jnp.concatenate([jnp.zeros_like(tb[:, :1]), tb[:, :-1]], axis=1)
        return jnp.concatenate([prev, tb], axis=2)

    kb, vb = band(k), band(v)
    s = jnp.einsum('bnqhgd,bnkhd->bhgnqk', qb, kb) * (hd ** -0.5)
    qi = jnp.arange(ATTN_BLOCK)[:, None]
    kj = jnp.arange(2 * ATTN_BLOCK)[None, :]
    dist = qi + ATTN_BLOCK - kj
    in_window = (dist >= 0) & (dist < WINDOW)
    has_prev = (jnp.arange(nb)[:, None, None] > 0) | (kj >= ATTN_BLOCK)[None]
    mask = in_window[None] & has_prev
    s = jnp.where(mask, s, -jnp.inf)
    sink = sinks.astype(f32).reshape(1, Hkv, G, 1, 1)
    m = jnp.maximum(jnp.max(s, axis=-1), sink)
    p = jnp.exp(s - m[..., None])
    den = jnp.sum(p, axis=-1) + jnp.exp(sink - m)
    o = jnp.einsum('bhgnqk,bnkhd->bnqhgd', p / den[..., None], vb)
    return o.reshape(B, S, Hq * hd).astype(q.dtype)


def causal_depthwise_conv(u, w, b):
    S = u.shape[1]
    K = w.shape[0]
    up = jnp.pad(u, ((0, 0), (K - 1, 0), (0, 0)))
    out = b
    for j in range(K):
        out = out + up[:, j:j + S] * w[j]
    return out


def mlstm_chunkwise(q, k, v, i_pre, f_pre):
    B, S, H, Dh = q.shape
    Dv = v.shape[-1]
    L = MLSTM_CHUNK
    nc = S // L
    f32 = jnp.float32

    def to_chunks(t):
        return t.astype(f32).reshape(B, nc, L, H, -1).transpose(0, 3, 1, 2, 4)

    qc, kc, vc = to_chunks(q), to_chunks(k), to_chunks(v)
    log_i = i_pre.astype(f32).reshape(B, nc, L, H).transpose(0, 3, 1, 2)
    log_f = jax.nn.log_sigmoid(f_pre.astype(f32)).reshape(B, nc, L, H).transpose(0, 3, 1, 2)
    b = jnp.cumsum(log_f, axis=-1)
    b_last = b[..., -1]

    w_state = b_last[..., None] - b + log_i
    m_loc = jnp.max(w_state, axis=-1)
    e_state = jnp.exp(w_state - m_loc[..., None])
    kv_chunk = jnp.einsum('bhcld,bhcle->bhcde', kc * e_state[..., None], vc)
    n_chunk = jnp.einsum('bhcl,bhcld->bhcd', e_state, kc)

    def step(carry, inp):
        C, n, m = carry
        kv_c, n_c, m_c, bl = inp
        m_new = jnp.maximum(bl + m, m_c)
        a = jnp.exp(bl + m - m_new)
        s = jnp.exp(m_c - m_new)
        C_new = a[..., None, None] * C + s[..., None, None] * kv_c
        n_new = a[..., None] * n + s[..., None] * n_c
        return (C_new, n_new, m_new), (C, n, m)

    init = (jnp.zeros((B, H, Dh, Dv), f32), jnp.zeros((B, H, Dh), f32), jnp.zeros((B, H), f32))
    xs = (jnp.moveaxis(kv_chunk, 2, 0), jnp.moveaxis(n_chunk, 2, 0),
          jnp.moveaxis(m_loc, 2, 0), jnp.moveaxis(b_last, 2, 0))
    _, (C_prev, n_prev, m_prev) = lax.scan(step, init, xs)
    C_prev = jnp.moveaxis(C_prev, 0, 2)
    n_prev = jnp.moveaxis(n_prev, 0, 2)
    m_prev = jnp.moveaxis(m_prev, 0, 2)

    causal = jnp.tril(jnp.ones((L, L), dtype=bool))
    d_mat = b[..., :, None] - b[..., None, :] + log_i[..., None, :]
    d_mat = jnp.where(causal, d_mat, -jnp.inf)
    g = b + m_prev[..., None]
    m_t = jnp.maximum(jnp.max(d_mat, axis=-1), g)
    p = jnp.exp(d_mat - m_t[..., None])
    qk = jnp.einsum('bhctd,bhcsd->bhcts', qc, kc) * p
    inter = jnp.exp(g - m_t)
    num = jnp.einsum('bhcts,bhcse->bhcte', qk, vc) + inter[..., None] * jnp.einsum('bhctd,bhcde->bhcte', qc, C_prev)
    den = jnp.sum(qk, axis=-1) + inter * jnp.einsum('bhctd,bhcd->bhct', qc, n_prev)
    den = jnp.maximum(jnp.abs(den), jnp.exp(-m_t))
    h = num / den[..., None]
    return h.transpose(0, 2, 3, 1, 4).reshape(B, S, H, Dv).astype(q.dtype)


def grouped_moe(h, router_w, router_bias, w_gate, w_up, w_down):
    B, S, D = h.shape
    T = B * S
    E = N_EXPERTS
    f32 = jnp.float32
    xt = h.reshape(T, D)
    scores = jax.nn.sigmoid(xt.astype(f32) @ router_w.astype(f32))
    sel = scores + router_bias.astype(f32)
    grp = sel.reshape(T, N_GROUPS, EXPERTS_PER_GROUP)
    grp_score = jnp.sum(lax.top_k(grp, TOP_K)[0], axis=-1)
    g_idx = jnp.argmax(grp_score, axis=-1)
    in_grp = jnp.take_along_axis(grp, g_idx[:, None, None], axis=1)[:, 0]
    _, local = lax.top_k(in_grp, TOP_K)
    expert_idx = (g_idx[:, None] * EXPERTS_PER_GROUP + local).astype(jnp.int32)
    gate = jnp.take_along_axis(scores, expert_idx, axis=1)
    gate = gate / jnp.sum(gate, axis=-1, keepdims=True)

    n_assign = T * TOP_K
    flat_e = expert_idx.reshape(-1)
    flat_tok = jnp.arange(n_assign, dtype=jnp.int32) // TOP_K
    order = jnp.argsort(flat_e)
    e_sorted = flat_e[order]
    tok_sorted = flat_tok[order]
    gate_sorted = gate.reshape(-1)[order]
    counts = jnp.zeros((E,), jnp.int32).at[flat_e].add(1)
    starts = jnp.cumsum(counts) - counts
    padded = (counts + MOE_BLOCK - 1) // MOE_BLOCK * MOE_BLOCK
    pad_ends = jnp.cumsum(padded)
    pad_starts = pad_ends - padded
    dest = pad_starts[e_sorted] + jnp.arange(n_assign, dtype=jnp.int32) - starts[e_sorted]
    n_blocks = (n_assign + E * (MOE_BLOCK - 1) + MOE_BLOCK - 1) // MOE_BLOCK
    x_pad = jnp.zeros((n_blocks * MOE_BLOCK, D), xt.dtype).at[dest].set(xt[tok_sorted])
    blk_start = jnp.arange(n_blocks, dtype=jnp.int32) * MOE_BLOCK
    blk_e = jnp.minimum(jnp.searchsorted(pad_ends, blk_start, side='right'), E - 1)

    def expert_block(args):
        xb, e = args
        return (jax.nn.silu(xb @ w_gate[e]) * (xb @ w_up[e])) @ w_down[e]

    y_pad = lax.map(expert_block, (x_pad.reshape(n_blocks, MOE_BLOCK, D), blk_e)).reshape(-1, D)
    y = jax.ops.segment_sum(y_pad[dest] * gate_sorted[:, None].astype(y_pad.dtype), tok_sorted, num_segments=T)
    return y.reshape(B, S, D)


def setup_inputs(seed: int = 0) -> dict:
    key = jax.random.key(seed)
    ks = jax.random.split(key, 26)
    nrm = jax.random.normal
    D = D_MODEL
    E = N_EXPERTS
    F = D_FF_EXPERT
    x = nrm(ks[0], (BATCH, SEQ, D), jnp.float32)
    c = nrm(ks[1], (BATCH, D), jnp.float32)
    offs = jax.random.randint(ks[2], (BATCH, 1), 0, 4096, dtype=jnp.int32)
    positions = (jnp.arange(SEQ, dtype=jnp.int32)[None, :] + offs).astype(jnp.int32)
    ada_w = nrm(ks[3], (DEPTH, D, 6 * D)) * (0.5 * D ** -0.5)
    ada_b = 0.02 * nrm(ks[4], (DEPTH, 6 * D))
    norm_mix_w = 1.0 + 0.05 * nrm(ks[5], (DEPTH, D))
    norm_ffn_w = 1.0 + 0.05 * nrm(ks[6], (DEPTH, D))
    w_in = nrm(ks[7], (DEPTH, D, D_IN)) * D ** -0.5
    b_igate = 0.1 * nrm(ks[8], (DEPTH, MLSTM_HEADS))
    b_fgate = jnp.linspace(3.0, 6.0, MLSTM_HEADS)[None, :] + 0.1 * nrm(ks[9], (DEPTH, MLSTM_HEADS))
    q_norm_w = 1.0 + 0.05 * nrm(ks[10], (DEPTH, ATTN_HEAD_DIM))
    k_norm_w = 1.0 + 0.05 * nrm(ks[11], (DEPTH, ATTN_HEAD_DIM))
    sinks = 0.5 * nrm(ks[12], (DEPTH, ATTN_HEADS))
    conv_w = nrm(ks[13], (DEPTH, CONV_WIDTH, 2 * MLSTM_W)) * CONV_WIDTH ** -0.5
    conv_b = 0.02 * nrm(ks[14], (DEPTH, 2 * MLSTM_W))
    mlstm_norm_w = 1.0 + 0.05 * nrm(ks[15], (DEPTH, MLSTM_W))
    w_attn_up = nrm(ks[16], (DEPTH, ATTN_Q_W, D)) * ATTN_Q_W ** -0.5
    w_mlstm_up = nrm(ks[17], (DEPTH, MLSTM_W, D)) * MLSTM_W ** -0.5
    w_out = nrm(ks[18], (DEPTH, D, D)) * D ** -0.5
    router_w = nrm(ks[19], (D, E)) * D ** -0.5
    router_bias = 0.01 * nrm(ks[20], (E,))
    w_gate = nrm(ks[21], (DEPTH, E, D, F)) * D ** -0.5
    w_up = nrm(ks[22], (DEPTH, E, D, F)) * D ** -0.5
    w_down = nrm(ks[23], (DEPTH, E, F, D)) * F ** -0.5
    return {"x": x, "c": c, "positions": positions, "ada_w": ada_w, "ada_b": ada_b,
            "norm_mix_w": norm_mix_w, "norm_ffn_w": norm_ffn_w, "w_in": w_in,
            "b_igate": b_igate, "b_fgate": b_fgate, "q_norm_w": q_norm_w, "k_norm_w": k_norm_w,
            "sinks": sinks, "conv_w": conv_w, "conv_b": conv_b, "mlstm_norm_w": mlstm_norm_w,
            "w_attn_up": w_attn_up, "w_mlstm_up": w_mlstm_up, "w_out": w_out,
            "router_w": router_w, "router_bias": router_bias,
            "w_gate": w_gate, "w_up": w_up, "w_down": w_down}


def reference(x, c, positions, ada_w, ada_b, norm_mix_w, norm_ffn_w, w_in, b_igate, b_fgate,
              q_norm_w, k_norm_w, sinks, conv_w, conv_b, mlstm_norm_w, w_attn_up, w_mlstm_up,
              w_out, router_w, router_bias, w_gate, w_up, w_down):
    B, S, D = x.shape
    inv_freq = ROPE_THETA ** (-(jnp.arange(0, ROPE_DIM, 2, dtype=jnp.float32) / ROPE_DIM))
    ang = positions.astype(jnp.float32)[..., None] * inv_freq
    cos = jnp.cos(ang)[:, :, None, :]
    sin = jnp.sin(ang)[:, :, None, :]
    c_act = jax.nn.silu(c)

    for l in range(DEPTH):
        mod = c_act @ ada_w[l] + ada_b[l]
        sh1, sc1, g1, sh2, sc2, g2 = [t[:, None, :] for t in jnp.split(mod, 6, axis=-1)]

        h = rms_norm(x, norm_mix_w[l]) * (1.0 + sc1) + sh1
        proj = h @ w_in[l]
        aq, ak, av, mqk, mv, mi, mf, mo, ga, gb = split_cols(proj)

        aq = rms_norm(aq.reshape(B, S, ATTN_HEADS, ATTN_HEAD_DIM), q_norm_w[l])
        ak = rms_norm(ak.reshape(B, S, ATTN_KV_HEADS, ATTN_HEAD_DIM), k_norm_w[l])
        aq = partial_rope(aq, cos, sin)
        ak = partial_rope(ak, cos, sin)
        av = av.reshape(B, S, ATTN_KV_HEADS, ATTN_HEAD_DIM)
        ya = sliding_window_attention(aq, ak, av, sinks[l]) @ w_attn_up[l]

        mqk = jax.nn.silu(causal_depthwise_conv(mqk, conv_w[l], conv_b[l]))
        mq = mqk[..., :MLSTM_W].reshape(B, S, MLSTM_HEADS, MLSTM_HEAD_DIM)
        mk = mqk[..., MLSTM_W:].reshape(B, S, MLSTM_HEADS, MLSTM_HEAD_DIM) * (MLSTM_HEAD_DIM ** -0.5)
        mv = mv.reshape(B, S, MLSTM_HEADS, MLSTM_HEAD_DIM)
        hm = mlstm_chunkwise(mq, mk, mv, mi + b_igate[l], mf + b_fgate[l])
        hm = rms_norm(hm, mlstm_norm_w[l].reshape(MLSTM_HEADS, MLSTM_HEAD_DIM)).reshape(B, S, MLSTM_W)
        yb = (jax.nn.sigmoid(mo) * hm) @ w_mlstm_up[l]

        merged = jax.nn.sigmoid(ga) * ya + jax.nn.sigmoid(gb) * yb
        x = x + g1 * (merged @ w_out[l])

        h2 = rms_norm(x, norm_ffn_w[l]) * (1.0 + sc2) + sh2
        x = x + g2 * grouped_moe(h2, router_w, router_bias, w_gate[l], w_up[l], w_down[l])
    return x
```

```cpp
#include <hip/hip_runtime.h>
#include <cstdio>
#include <cstdint>

#ifndef MK_MULTI
#define MK_MULTI 1
#endif

#define GAS __attribute__((address_space(1)))
#define LAS __attribute__((address_space(3)))
typedef unsigned short bf16;
typedef unsigned v4u __attribute__((ext_vector_type(4)));
typedef unsigned v2u __attribute__((ext_vector_type(2)));
typedef float f32x4 __attribute__((ext_vector_type(4)));
typedef float f32x2 __attribute__((ext_vector_type(2)));
typedef short bf16x8 __attribute__((ext_vector_type(8)));
typedef short bf16x4 __attribute__((ext_vector_type(4)));
#define DI __device__ __forceinline__
#define RLX_AGENT __ATOMIC_RELAXED, __HIP_MEMORY_SCOPE_AGENT
#define LDS_WAIT() asm volatile("s_waitcnt lgkmcnt(0)" ::: "memory")
#define VM_WAIT() asm volatile("s_waitcnt vmcnt(0)" ::: "memory")

constexpr int NB = 2, SEQ = 16384, T = NB * SEQ, D = 1024, NL = 4;
constexpr int DIN_SRC = 4872;
constexpr int NPROJ = 4864;
constexpr int C_AQ = 0, C_AK = 512, C_AV = 640, C_MQ = 768, C_MK = 1280, C_MV = 1792, C_MO = 2304, C_GA = 2816, C_GB = 3840;
constexpr int NE = 16, FF = 512;
constexpr int NCLS = 24, CLS_CAP = 32768;
constexpr float EPS = 1e-6f;
constexpr int NPH = 10;
constexpr int NGP = 1 + NL * NPH;

constexpr size_t MiB = 1u << 20;
constexpr size_t WS_CTL = 0, CTL_ZERO_BYTES = 1 * MiB;
constexpr size_t WS_MOD = 1 * MiB;
constexpr size_t WS_ROPE = 2 * MiB;
constexpr size_t WS_GATES = 4 * MiB;
constexpr size_t WS_TGATE = 5 * MiB;
constexpr size_t WS_TOKL = 6 * MiB;
constexpr size_t WS_MLB = 9 * MiB;
constexpr size_t WS_MLC = 10 * MiB;
constexpr size_t WS_WIN = 28 * MiB;
constexpr size_t WS_WAU = 66 * MiB;
constexpr size_t WS_WMU = 70 * MiB;
constexpr size_t WS_WOUT = 74 * MiB;
constexpr size_t WS_WGU = 82 * MiB;
constexpr size_t WS_WD = 210 * MiB;
constexpr size_t WS_H = 274 * MiB;
constexpr size_t WS_PROJ = 338 * MiB;
constexpr size_t WS_END = 642 * MiB;

constexpr int CW_TMO = 0;
constexpr int CW_BAR = 4096;
constexpr int CW_CNT = 8192;

constexpr int RING_BYTES = 131072;
constexpr int MISC_OFF = RING_BYTES;
constexpr int TAB_OFF = RING_BYTES + 256;
constexpr int TOKOFF_OFF = RING_BYTES + 2048;
constexpr int LDS_BYTES = 147456;

DI unsigned f2bf(float f) { unsigned u = __builtin_bit_cast(unsigned, f); return (u + 0x7fffu + ((u >> 16) & 1u)) >> 16; }
DI unsigned pk2(float lo, float hi) { return f2bf(lo) | (f2bf(hi) << 16); }
DI float bf2f(unsigned short b) { return __builtin_bit_cast(float, ((unsigned)b) << 16); }
DI float bflo(unsigned w) { return __builtin_bit_cast(float, w << 16); }
DI float bfhi(unsigned w) { return __builtin_bit_cast(float, w & 0xffff0000u); }
DI float wave_sum(float v) {
#pragma unroll
    for (int o = 1; o < 64; o <<= 1) v += __shfl_xor(v, o);
    return v;
}
DI float sigmoidf_(float x) { return 1.0f / (1.0f + __expf(-x)); }

#define XB_TMO      128
#define XB_XCNT(j)  (256  + 64 * (j))
#define XB_XSUB(j)  (1280 + 64 * (j))
#define XB_XGEN(j)  (2304 + 64 * (j))
#define XB_TOP      3328
#define XB_TOPGEN   3392
#define XCD_BAR_WORDS 3456
#define XB_SPIN_CAP (1u << 18)
__device__ __forceinline__ unsigned xb_ld(unsigned* p)              { return __hip_atomic_load(p, __ATOMIC_RELAXED, __HIP_MEMORY_SCOPE_AGENT); }
__device__ __forceinline__ unsigned xb_add(unsigned* p, unsigned v) { return __hip_atomic_fetch_add(p, v, __ATOMIC_RELAXED, __HIP_MEMORY_SCOPE_AGENT); }
__device__ __forceinline__ unsigned xb_xcc_id() { return (unsigned)__builtin_amdgcn_s_getreg((3 << 11) | 20) & 0xFu; }
#define XB_SPIN(cond, bar) do { unsigned _sp = 0; while (cond) { __builtin_amdgcn_s_sleep(1); \
    if ((++_sp & 255u) == 0u) { if (xb_ld(&(bar)[XB_TMO])) break; if (_sp > XB_SPIN_CAP) { atomicAdd(&(bar)[XB_TMO], 1u); break; } } } } while (0)
struct XcdBarrier { unsigned* bar; unsigned x; volatile LAS unsigned* st; };
__device__ __forceinline__ XcdBarrier xcd_barrier_post(unsigned* bar, volatile LAS unsigned* st) {
    XcdBarrier b; b.bar = bar; b.x = xb_xcc_id(); b.st = st;
    if (threadIdx.x == 0) (void)xb_add(&bar[XB_XCNT(b.x)], 1u);
    return b;
}
__device__ __forceinline__ void xcd_barrier_complete(unsigned* bar, unsigned x, unsigned& nloc, unsigned& nx) {
    const unsigned G = gridDim.x * gridDim.y * gridDim.z;
    unsigned sum, cnt, mine, sp = 0u;
    for (;;) {
        sum = 0u; cnt = 0u; mine = 0u;
#pragma unroll
        for (unsigned j = 0; j < 16; ++j) { const unsigned c = xb_ld(&bar[XB_XCNT(j)]); sum += c; cnt += (c > 0u) ? 1u : 0u; mine = (j == x) ? c : mine; }
        if (sum == G) break;
        __builtin_amdgcn_s_sleep(1);
        if ((++sp & 255u) == 0u) { if (xb_ld(&bar[XB_TMO])) break; if (sp > XB_SPIN_CAP) { atomicAdd(&bar[XB_TMO], 1u); break; } }
    }
    nloc = mine > 0u ? mine : 1u; nx = cnt > 0u ? cnt : 1u;
}
__device__ __forceinline__ void xcd_barrier(const XcdBarrier& b) {
    asm volatile("s_waitcnt vmcnt(0)" ::: "memory");
    __syncthreads();
    if (threadIdx.x == 0) {
        unsigned* bar = b.bar;
        __builtin_amdgcn_s_waitcnt(0);
        unsigned nloc = b.st[0], nx = b.st[1];
        if (nloc == 0u) { xcd_barrier_complete(bar, b.x, nloc, nx); b.st[0] = nloc; b.st[1] = nx; }
        const unsigned old = xb_add(&bar[XB_XSUB(b.x)], 1u);
        const unsigned gen = old / nloc;
        if (old + 1u == (gen + 1u) * nloc) {
            __builtin_amdgcn_fence(__ATOMIC_RELEASE, "agent");
            asm volatile("s_waitcnt vmcnt(0)" ::: "memory");
            const unsigned og = xb_add(&bar[XB_TOP], 1u);
            const unsigned tg = og / nx;
            if (og + 1u == (tg + 1u) * nx) xb_add(&bar[XB_TOPGEN], 1u);
            else XB_SPIN(xb_ld(&bar[XB_TOPGEN]) == tg, bar);
            __builtin_amdgcn_fence(__ATOMIC_ACQUIRE, "agent");
            xb_add(&bar[XB_XGEN(b.x)], 1u);
            asm volatile("s_waitcnt vmcnt(0)" ::: "memory");
        } else {
            XB_SPIN(xb_ld(&bar[XB_XGEN(b.x)]) == gen, bar);
            __builtin_amdgcn_fence(__ATOMIC_ACQUIRE, "agent");
            asm volatile("s_waitcnt vmcnt(0)" ::: "memory");
        }
    }
    __syncthreads();
}

namespace pg8 {
constexpr int BM = 256, BK = 64, HALF = 128, HTB = HALF * BK * 2, STAGE_BYTES = 8 * HTB, NXCD = 8, WGM = 8;
__host__ __device__ __forceinline__ int lds_byte(int r, int c) { const int st = (r >> 4) * 2 + (c >> 5), rr = r & 15, cc = c & 31, ob = rr * 64 + cc * 2; return st * 1024 + (ob ^ (((ob >> 9) & 1) << 5)); }
__host__ __device__ __forceinline__ void stage_rc(int b, int& R, int& C) { const int st = b / 1024, sb = b % 1024, swz = sb ^ (((sb >> 9) & 1) << 5); R = (st >> 1) * 16 + swz / 64; C = (st & 1) * 32 + (swz % 64) / 2; }
__host__ __device__ __forceinline__ int perm32(int rho) { const int n = rho >> 4, i = rho & 15; return 8 * (i >> 2) + 4 * n + (i & 3); }

struct Unit { int pm, pn, x0, x1; };

struct TileOrder {
    int nM, nN, nwg, G, c;
    __device__ void init(int nM_, int nN_, int G_, int c_) { nM = nM_; nN = nN_; nwg = nM * nN; G = G_; c = c_; }
    __device__ bool get(int i, int& pm, int& pn) const {
        const long L = (long)i * G + c; if (L >= nwg) return false;
        int wgid = (int)L; { const int q = nwg / NXCD, r = nwg % NXCD, xcd = wgid % NXCD, off = wgid / NXCD; wgid = (xcd < r ? xcd * (q + 1) : r * (q + 1) + (xcd - r) * q) + off; }
        const int nig = WGM * nN, gid = wgid / nig, fm = gid * WGM, gsz = (nM - fm) < WGM ? (nM - fm) : WGM;
        pm = fm + ((wgid % nig) % gsz); pn = (wgid % nig) / gsz; return true;
    }
};

template <class Epi, class Sched>
__device__ __forceinline__ void gemm_phase(LAS unsigned char* lds, const int K, const Sched& S, const Epi& E) {
    int tid = threadIdx.x; asm volatile("" : "+v"(tid));
    const int wid = __builtin_amdgcn_readfirstlane(tid >> 6), lane = tid & 63, wr = wid >> 2, wc = wid & 3, fr = lane & 15, fq = lane >> 4;
    const int nt = K / BK;
    constexpr bool GA = Sched::GATHER; constexpr int KS = Sched::KSPLIT;
    unsigned voffA[2], voffB[2]; int Rst[2], Cst[2];
#pragma unroll
    for (int i = 0; i < 2; ++i) { int R, C; stage_rc(tid * 16 + i * 8192, R, C); const int Rb = Epi::PERM ? ((R & ~31) + perm32(R & 31)) : R;
        voffA[i] = (unsigned)(R * S.lda + C) * 2u; voffB[i] = (unsigned)(Rb * S.ldb + C) * 2u; Rst[i] = R; Cst[i] = C; }
    const size_t kstep = (size_t)(BK * 2);
    const size_t hstepA = (size_t)HALF * S.lda * 2, hstepB = (size_t)HALF * S.ldb * 2;
    const unsigned ldsw = (unsigned)wid * 1024u; const unsigned gmul = (unsigned)S.lda * 2u;
    const int aoff = lds_byte(wr * 64 + fr, fq * 8), boff = lds_byte(wc * 32 + fr, fq * 8);
    unsigned vAc[2], vAn[2];
#define PG8_SA(b, h) (((b) * 2 + (h)) * HTB)
#define PG8_SB(b, h) ((4 + (b) * 2 + (h)) * HTB)
#define PG8_STAGE2(bufoff, gbase, v0, v1) do { \
        __builtin_amdgcn_global_load_lds((const unsigned*)((const char*)(gbase) + (v0)), (LAS unsigned*)(lds + (bufoff) + ldsw), 16, 0, 0); \
        __builtin_amdgcn_global_load_lds((const unsigned*)((const char*)(gbase) + (v1)), (LAS unsigned*)(lds + (bufoff) + ldsw + 8192), 16, 0, 0); } while (0)
#define PG8_STAGE_B(bufoff, ptr, h) PG8_STAGE2(bufoff, (ptr) + (h) * hstepB, voffB[0], voffB[1])
#define PG8_STAGE_A(bufoff, ptr, h, nx) do { if constexpr (GA) { const unsigned _p = (nx) ? vAn[h] : vAc[h]; PG8_STAGE2(bufoff, ptr, (_p & 0xffffu) * gmul + (unsigned)Cst[0] * 2u, (_p >> 16) * gmul + (unsigned)Cst[0] * 2u); } \
        else { PG8_STAGE2(bufoff, (ptr) + (h) * hstepA, voffA[0], voffA[1]); } } while (0)
#define PG8_LDA(dst, b, h) do { _Pragma("unroll") for (int m = 0; m < 4; ++m) _Pragma("unroll") for (int k = 0; k < 2; ++k) dst[m][k] = *(const LAS bf16x8*)(lds + PG8_SA(b, h) + aoff + m * 2048 + k * 1024); } while (0)
#define PG8_LDB(dst, b, h) do { _Pragma("unroll") for (int n = 0; n < 2; ++n) _Pragma("unroll") for (int k = 0; k < 2; ++k) dst[n][k] = *(const LAS bf16x8*)(lds + PG8_SB(b, h) + boff + n * 2048 + k * 1024); } while (0)
#define PG8_MMA(ai, bj, At, Bt) do { __builtin_amdgcn_s_setprio(1); _Pragma("unroll") for (int m = 0; m < 4; ++m) _Pragma("unroll") for (int n = 0; n < 2; ++n) _Pragma("unroll") for (int k = 0; k < 2; ++k) \
        acc[ai][bj][m][n] = __builtin_amdgcn_mfma_f32_16x16x32_bf16(Bt[n][k], At[m][k], acc[ai][bj][m][n], 0, 0, 0); __builtin_amdgcn_s_setprio(0); } while (0)
#define PG8_WAIT_V(n) asm volatile("s_waitcnt vmcnt(" #n ")" ::: "memory")
#define PG8_WAIT_L(n) asm volatile("s_waitcnt lgkmcnt(" #n ")" ::: "memory")
#define PG8_BAR __builtin_amdgcn_s_barrier()
#define PG8_SCHED __builtin_amdgcn_sched_barrier(0)
#define PG8_GOFF(dst, u) do { if constexpr (GA) { _Pragma("unroll") for (int h = 0; h < 2; ++h) dst[h] = S.a_rowoff(u, Rst[0] + HALF * h) | (S.a_rowoff(u, Rst[0] + 64 + HALF * h) << 16); } } while (0)
    Unit cur, nxt; int ui = 0;
    if (!S.next(0, cur)) return;
    f32x4 acc[2][2][4][2];
#pragma unroll
    for (int a = 0; a < 2; ++a)
#pragma unroll
        for (int b = 0; b < 2; ++b)
#pragma unroll
            for (int m = 0; m < 4; ++m)
#pragma unroll
                for (int n = 0; n < 2; ++n) acc[a][b][m][n] = (f32x4){0.f, 0.f, 0.f, 0.f};
    bf16x8 At[4][2], B0[2][2], B1[2][2];
    const char* cA = S.a_base(cur); const char* cB0 = S.b_base(cur, 0); const char* cB1 = KS ? S.b_base(cur, 1) : cB0;
    PG8_GOFF(vAc, cur);
    vAn[0] = vAc[0]; vAn[1] = vAc[1];
    PG8_STAGE_B(PG8_SB(0, 0), cB0, 0); PG8_STAGE_B(PG8_SB(0, 1), cB0, 1); PG8_STAGE_A(PG8_SA(0, 0), cA, 0, false); PG8_STAGE_A(PG8_SA(0, 1), cA, 1, false);
    if (wr == 1) PG8_BAR;
    PG8_WAIT_V(2); PG8_BAR;
    PG8_STAGE_B(PG8_SB(1, 0), cB0 + kstep, 0); PG8_STAGE_A(PG8_SA(1, 0), cA + kstep, 0, false); PG8_STAGE_B(PG8_SB(1, 1), cB0 + kstep, 1);
    PG8_WAIT_V(6); PG8_BAR;
    for (;;) {
        const bool has_next = S.next(ui + 1, nxt);
        const char* nA = has_next ? S.a_base(nxt) : cA; const char* nB0 = has_next ? S.b_base(nxt, 0) : cB0; const char* nB1 = (KS && has_next) ? S.b_base(nxt, 1) : (KS ? cB1 : nB0);
        if constexpr (GA) { if (has_next) { PG8_GOFF(vAn, nxt); } }
        for (int t = 0; t < nt; t += 2) {
            const bool last = (t == nt - 2);
            const char* a1 = cA + (size_t)(t + 1) * kstep;
            const char* a2 = last ? nA : cA + (size_t)(t + 2) * kstep;
            const char* b2 = last ? nB0 : ((KS && (t + 2) >= KS) ? cB1 + (size_t)(t + 2 - KS) * kstep : cB0 + (size_t)(t + 2) * kstep);
            const char* a3 = a2 + kstep; const char* b3 = b2 + kstep;
            PG8_LDB(B0, 0, 0); PG8_LDB(B1, 0, 1); PG8_SCHED; PG8_LDA(At, 0, 0); PG8_STAGE_A(PG8_SA(1, 1), a1, 1, false);
            PG8_WAIT_V(8); PG8_WAIT_L(0); PG8_BAR; PG8_MMA(0, 0, At, B0); PG8_MMA(0, 1, At, B1); PG8_BAR; PG8_SCHED;
            PG8_LDA(At, 0, 1); PG8_STAGE_B(PG8_SB(0, 0), b2, 0); PG8_STAGE_B(PG8_SB(0, 1), b2, 1); PG8_STAGE_A(PG8_SA(0, 0), a2, 0, last);
            PG8_WAIT_V(8); PG8_WAIT_L(0); PG8_BAR; PG8_MMA(1, 0, At, B0); PG8_MMA(1, 1, At, B1); PG8_BAR; PG8_SCHED;
            PG8_LDB(B0, 1, 0); PG8_LDB(B1, 1, 1); PG8_SCHED; PG8_LDA(At, 1, 0); PG8_STAGE_A(PG8_SA(0, 1), a2, 1, last);
            PG8_WAIT_V(8); PG8_WAIT_L(0); PG8_BAR; PG8_MMA(0, 0, At, B0); PG8_MMA(0, 1, At, B1); PG8_BAR; PG8_SCHED;
            PG8_LDA(At, 1, 1); PG8_STAGE_B(PG8_SB(1, 0), b3, 0); PG8_STAGE_B(PG8_SB(1, 1), b3, 1); PG8_STAGE_A(PG8_SA(1, 0), a3, 0, last);
            PG8_WAIT_V(8); PG8_WAIT_L(0); PG8_BAR; PG8_MMA(1, 0, At, B0); PG8_MMA(1, 1, At, B1); PG8_BAR; PG8_SCHED;
        }
        if (wr == 0) PG8_BAR;
        E(acc, cur, wr, wc, fr, fq);
        if (!has_next) break;
#pragma unroll
        for (int a = 0; a < 2; ++a)
#pragma unroll
            for (int b = 0; b < 2; ++b)
#pragma unroll
                for (int m = 0; m < 4; ++m)
#pragma unroll
                    for (int n = 0; n < 2; ++n) acc[a][b][m][n] = (f32x4){0.f, 0.f, 0.f, 0.f};
        cur = nxt; cA = nA; cB0 = nB0; cB1 = nB1; ++ui;
        vAc[0] = vAn[0]; vAc[1] = vAn[1];
        if (wr == 1) PG8_BAR;
    }
    PG8_WAIT_V(0);
    PG8_BAR;
#undef PG8_SA
#undef PG8_SB
#undef PG8_STAGE2
#undef PG8_STAGE_A
#undef PG8_STAGE_B
#undef PG8_LDA
#undef PG8_LDB
#undef PG8_MMA
#undef PG8_WAIT_V
#undef PG8_WAIT_L
#undef PG8_BAR
#undef PG8_SCHED
#undef PG8_GOFF
}
}
using pg8::Unit;

DI unsigned cvt_pk_bf16(float lo, float hi) { unsigned r; asm volatile("v_cvt_pk_bf16_f32 %0, %1, %2" : "=v"(r) : "v"(lo), "v"(hi)); return r; }

struct Args {
    const float* x; const float* c; const int* pos; const float* ada_w; const float* ada_b; const float* nmw; const float* nfw; const float* w_in;
    const float* b_ig; const float* b_fg; const float* qnw; const float* knw; const float* sinks; const float* conv_w; const float* conv_b; const float* mnw;
    const float* w_au; const float* w_mu; const float* w_out; const float* router_w; const float* router_b; const float* w_gate; const float* w_up; const float* w_down;
    float* out; unsigned char* ws; int ph_lo, ph_hi;
};

__constant__ float c_invf[8] = {1.0f, 0.1939227432012558f, 0.03760603070259094f, 0.007292664609849453f, 0.0014142135623842478f, 0.00027424818836152554f, 5.3182957344688475e-05f, 1.0313385246263351e-05f};

struct DenseSched {
    static constexpr bool GATHER = false; static constexpr int KSPLIT = 0;
    const char* A; const char* Bt; int lda, ldb; pg8::TileOrder ord;
    DI bool next(int i, Unit& u) const { int pm, pn; if (!ord.get(i, pm, pn)) return false; u.pm = pm; u.pn = pn; u.x0 = 0; u.x1 = 0; return true; }
    DI const char* a_base(const Unit& u) const { return A + (size_t)u.pm * 256 * lda * 2; }
    DI const char* b_base(const Unit& u, int) const { return Bt + (size_t)u.pn * 256 * ldb * 2; }
    DI unsigned a_rowoff(const Unit&, int) const { return 0u; }
};
struct EpiProj {
    static constexpr bool PERM = true;
    bf16* O;
    DI void operator()(const f32x4 (&acc)[2][2][4][2], const Unit& u, int wr, int wc, int fr, int fq) const {
        const int row0 = u.pm * 256 + wr * 64 + fr, col0 = u.pn * 256 + wc * 32 + 8 * fq; const bool sg = u.pn >= 9;
#pragma unroll
        for (int ai = 0; ai < 2; ++ai)
#pragma unroll
            for (int m = 0; m < 4; ++m) { bf16* rowp = O + (size_t)(row0 + ai * 128 + m * 16) * NPROJ + col0;
#pragma unroll
                for (int bj = 0; bj < 2; ++bj) { f32x4 v0 = acc[ai][bj][m][0], v1 = acc[ai][bj][m][1];
                    if (sg) {
#pragma unroll
                        for (int j = 0; j < 4; ++j) { v0[j] = sigmoidf_(v0[j]); v1[j] = sigmoidf_(v1[j]); } }
                    v4u w; w.x = cvt_pk_bf16(v0[0], v0[1]); w.y = cvt_pk_bf16(v0[2], v0[3]); w.z = cvt_pk_bf16(v1[0], v1[1]); w.w = cvt_pk_bf16(v1[2], v1[3]);
                    *(v4u*)(rowp + bj * 128) = w; } }
    }
};
template <bool ADD> struct EpiGate {
    static constexpr bool PERM = true;
    bf16* P; int gcol;
    DI void operator()(const f32x4 (&acc)[2][2][4][2], const Unit& u, int wr, int wc, int fr, int fq) const {
        const int row0 = u.pm * 256 + wr * 64 + fr, col0 = u.pn * 256 + wc * 32 + 8 * fq;
#pragma unroll
        for (int ai = 0; ai < 2; ++ai)
#pragma unroll
            for (int m = 0; m < 4; ++m) { bf16* rowp = P + (size_t)(row0 + ai * 128 + m * 16) * NPROJ + col0;
#pragma unroll
                for (int bj = 0; bj < 2; ++bj) { const f32x4 v0 = acc[ai][bj][m][0], v1 = acc[ai][bj][m][1];
                    const v4u g = *(const v4u*)(rowp + gcol + bj * 128);
                    float o[8] = {bflo(g.x) * v0[0], bfhi(g.x) * v0[1], bflo(g.y) * v0[2], bfhi(g.y) * v0[3], bflo(g.z) * v1[0], bfhi(g.z) * v1[1], bflo(g.w) * v1[2], bfhi(g.w) * v1[3]};
                    if (ADD) { const v4u p = *(const v4u*)(rowp + C_MQ + bj * 128);
                        o[0] += bflo(p.x); o[1] += bfhi(p.x); o[2] += bflo(p.y); o[3] += bfhi(p.y); o[4] += bflo(p.z); o[5] += bfhi(p.z); o[6] += bflo(p.w); o[7] += bfhi(p.w); }
                    v4u w; w.x = cvt_pk_bf16(o[0], o[1]); w.y = cvt_pk_bf16(o[2], o[3]); w.z = cvt_pk_bf16(o[4], o[5]); w.w = cvt_pk_bf16(o[6], o[7]);
                    *(v4u*)(rowp + C_MQ + bj * 128) = w; } }
    }
};
struct EpiRes {
    static constexpr bool PERM = false;
    const float* xin; float* out; const float* g;
    DI void operator()(const f32x4 (&acc)[2][2][4][2], const Unit& u, int wr, int wc, int fr, int fq) const {
        const int row0 = u.pm * 256 + wr * 64 + fr, col0 = u.pn * 256 + wc * 32 + 4 * fq; const int b = (u.pm * 256) >> 14;
        f32x4 gv[2][2];
#pragma unroll
        for (int bj = 0; bj < 2; ++bj)
#pragma unroll
            for (int n = 0; n < 2; ++n) gv[bj][n] = *(const f32x4*)(g + b * 6144 + col0 + bj * 128 + n * 16);
#pragma unroll
        for (int ai = 0; ai < 2; ++ai)
#pragma unroll
            for (int m = 0; m < 4; ++m) { const size_t off = (size_t)(row0 + ai * 128 + m * 16) * D + col0;
#pragma unroll
                for (int bj = 0; bj < 2; ++bj)
#pragma unroll
                    for (int n = 0; n < 2; ++n) { const f32x4 xv = *(const f32x4*)(xin + off + bj * 128 + n * 16);
                        *(f32x4*)(out + off + bj * 128 + n * 16) = xv + gv[bj][n] * acc[ai][bj][m][n]; } }
    }
};

struct MoeTab { const LAS int* tcls; const LAS int* tpos; const LAS int* cnt; int Rtot; };
DI void cls_experts(int cls, int& ea, int& eb) { const int g = cls / 6, p = cls - 6 * g; const int a = (p < 3) ? 0 : ((p < 5) ? 1 : 2); const int b = (p < 3) ? (p + 1) : ((p < 5) ? (p - 1) : 3); ea = 4 * g + a; eb = 4 * g + b; }
struct MoeUpSched {
    static constexpr bool GATHER = true; static constexpr int KSPLIT = 0;
    const char* A; const char* W; int lda, ldb; MoeTab tb; int G, c; const LAS unsigned* tokoff;
    DI bool next(int i, Unit& u) const { const int L = i * G + c; if (L >= tb.Rtot * 8) return false; u.pm = L >> 3; u.pn = L & 7; u.x0 = i; u.x1 = __builtin_amdgcn_readfirstlane(tb.tcls[u.pm]); return true; }
    DI const char* a_base(const Unit&) const { return A; }
    DI const char* b_base(const Unit& u, int) const { int ea, eb; cls_experts(u.x1, ea, eb); const int e = (u.pn < 4) ? ea : eb; return W + ((size_t)e * 1024 + (size_t)(u.pn & 3) * 256) * 1024 * 2; }
    DI unsigned a_rowoff(const Unit& u, int r) const { return tokoff[u.x0 * 256 + r]; }
};
struct EpiSwiglu {
    static constexpr bool PERM = true;
    bf16* H; const float* tgate; const LAS unsigned* tokoff;
    DI void operator()(const f32x4 (&acc)[2][2][4][2], const Unit& u, int wr, int wc, int fr, int fq) const {
        const int r0 = wr * 64 + fr; const int hc = (u.pn >> 2) * 512 + (u.pn & 3) * 128 + wc * 32 + 8 * fq; const int gsel = u.pn >> 2;
#pragma unroll
        for (int ai = 0; ai < 2; ++ai)
#pragma unroll
            for (int m = 0; m < 4; ++m) { const int r = r0 + ai * 128 + m * 16; const unsigned tok = tokoff[u.x0 * 256 + r]; const float rg = tgate[tok * 2 + gsel];
                const f32x4 g0 = acc[ai][0][m][0], g1 = acc[ai][0][m][1], u0 = acc[ai][1][m][0], u1 = acc[ai][1][m][1];
                float o[8];
#pragma unroll
                for (int j = 0; j < 4; ++j) { o[j] = g0[j] * sigmoidf_(g0[j]) * u0[j] * rg; o[4 + j] = g1[j] * sigmoidf_(g1[j]) * u1[j] * rg; }
                v4u w; w.x = cvt_pk_bf16(o[0], o[1]); w.y = cvt_pk_bf16(o[2], o[3]); w.z = cvt_pk_bf16(o[4], o[5]); w.w = cvt_pk_bf16(o[6], o[7]);
                *(v4u*)(H + ((size_t)u.pm * 256 + r) * 1024 + hc) = w; }
    }
};
struct MoeDownSched {
    static constexpr bool GATHER = false; static constexpr int KSPLIT = 8;
    const char* A; const char* W; int lda, ldb; MoeTab tb; int G, c;
    DI bool next(int i, Unit& u) const { const int L = i * G + c; if (L >= tb.Rtot * 4) return false; u.pm = L >> 2; u.pn = L & 3; u.x0 = __builtin_amdgcn_readfirstlane(tb.tpos[u.pm]); u.x1 = __builtin_amdgcn_readfirstlane(tb.tcls[u.pm]); return true; }
    DI const char* a_base(const Unit& u) const { return A + (size_t)u.pm * 256 * lda * 2; }
    DI const char* b_base(const Unit& u, int half) const { int ea, eb; cls_experts(u.x1, ea, eb); const int e = half ? eb : ea; return W + ((size_t)e * 1024 + (size_t)u.pn * 256) * 512 * 2; }
    DI unsigned a_rowoff(const Unit&, int) const { return 0u; }
};
struct EpiMoeOut {
    static constexpr bool PERM = false;
    float* out; const float* g; const int* tokl; MoeTab tb;
    DI void operator()(const f32x4 (&acc)[2][2][4][2], const Unit& u, int wr, int wc, int fr, int fq) const {
        const int r0 = wr * 64 + fr, col0 = u.pn * 256 + wc * 32 + 4 * fq; const int cn = tb.cnt[u.x1];
#pragma unroll
        for (int ai = 0; ai < 2; ++ai)
#pragma unroll
            for (int m = 0; m < 4; ++m) { const int pos = u.x0 + r0 + ai * 128 + m * 16;
                if (pos < cn) { const int tok = tokl[u.x1 * CLS_CAP + pos]; const int b = tok >> 14; float* op = out + (size_t)tok * D + col0; const float* gp = g + b * 6144 + col0;
#pragma unroll
                    for (int bj = 0; bj < 2; ++bj)
#pragma unroll
                        for (int n = 0; n < 2; ++n) { const f32x4 xv = *(const f32x4*)(op + bj * 128 + n * 16); const f32x4 gv = *(const f32x4*)(gp + bj * 128 + n * 16);
                            *(f32x4*)(op + bj * 128 + n * 16) = xv + gv * acc[ai][bj][m][n]; } } }
    }
};

struct Ctx { LAS unsigned char* lds; int tid, lane, wave, G, bid; };
DI Ctx fresh(const Ctx& X) { Ctx P = X; int t = X.tid; asm volatile("" : "+v"(t)); P.tid = t; P.lane = t & 63; P.wave = __builtin_amdgcn_readfirstlane(t >> 6); return P; }

DI void tr_item(const float* W, int ldw, int K, bf16* WT, int k0, LAS float* scr, int lane) {
#pragma unroll 8
    for (int i = 0; i < 32; ++i) { const int kk = 2 * i + (lane >> 5); scr[kk * 33 + (lane & 31)] = W[(size_t)(k0 + kk) * ldw + (lane & 31)]; }
    LDS_WAIT(); asm volatile("" ::: "memory");
    const int c = lane & 7;
#pragma unroll
    for (int j = 0; j < 4; ++j) { const int n = (lane >> 3) + 8 * j; const LAS float* s = scr + (8 * c) * 33 + n;
        v4u o; o.x = pk2(s[0 * 33], s[1 * 33]); o.y = pk2(s[2 * 33], s[3 * 33]); o.z = pk2(s[4 * 33], s[5 * 33]); o.w = pk2(s[6 * 33], s[7 * 33]);
        *(v4u*)(WT + (size_t)n * K + k0 + 8 * c) = o; }
    LDS_WAIT(); asm volatile("" ::: "memory");
}
DI void p0_prologue(const Args& a, const Ctx& X) {
    unsigned char* ws = a.ws;
    LAS float* scr = (LAS float*)(X.lds + X.wave * 16384);
    const int gw = X.bid * 8 + X.wave, NGW = X.G * 8;
    constexpr int IT_WIN = 16 * 152, IT_AU = 8 * 32, IT_OUT = 16 * 32, IT_GU = 16 * 16 * 32, IT_DN = 16 * 8 * 32;
    constexpr int IT_L = IT_WIN + 2 * IT_AU + IT_OUT + IT_GU + IT_DN;
    for (int it = gw; it < NL * IT_L; it += NGW) {
        const int l = it / IT_L; int r = it - l * IT_L;
        if (r < IT_WIN) { const int kb = r / 152, nb = r - kb * 152, d0 = 32 * nb, s0 = d0 + (d0 >= 2304 ? 8 : 0);
            tr_item(a.w_in + (size_t)l * D * DIN_SRC + s0, DIN_SRC, D, (bf16*)(ws + WS_WIN) + ((size_t)l * NPROJ + d0) * D, 64 * kb, scr, X.lane); continue; }
        r -= IT_WIN;
        if (r < IT_AU) { const int kb = r >> 5, nb = r & 31;
            tr_item(a.w_au + (size_t)l * 512 * D + 32 * nb, D, 512, (bf16*)(ws + WS_WAU) + ((size_t)l * D + 32 * nb) * 512, 64 * kb, scr, X.lane); continue; }
        r -= IT_AU;
        if (r < IT_AU) { const int kb = r >> 5, nb = r & 31;
            tr_item(a.w_mu + (size_t)l * 512 * D + 32 * nb, D, 512, (bf16*)(ws + WS_WMU) + ((size_t)l * D + 32 * nb) * 512, 64 * kb, scr, X.lane); continue; }
        r -= IT_AU;
        if (r < IT_OUT) { const int kb = r >> 5, nb = r & 31;
            tr_item(a.w_out + (size_t)l * D * D + 32 * nb, D, D, (bf16*)(ws + WS_WOUT) + ((size_t)l * D + 32 * nb) * D, 64 * kb, scr, X.lane); continue; }
        r -= IT_OUT;
        if (r < IT_GU) { const int e = r >> 9, q = r & 511, kb = q >> 5, nb = q & 31, tq = nb >> 3, rb = nb & 7;
            const float* src = ((rb < 4) ? a.w_gate : a.w_up) + ((size_t)(l * NE + e) * D) * FF + 128 * tq + 32 * (rb & 3);
            tr_item(src, FF, D, (bf16*)(ws + WS_WGU) + ((size_t)(l * NE + e) * 1024 + 32 * nb) * D, 64 * kb, scr, X.lane); continue; }
        r -= IT_GU;
        { const int e = r >> 8, q = r & 255, kb = q >> 5, nb = q & 31;
            tr_item(a.w_down + ((size_t)(l * NE + e) * FF) * D + 32 * nb, D, FF, (bf16*)(ws + WS_WD) + ((size_t)(l * NE + e) * 1024 + 32 * nb) * FF, 64 * kb, scr, X.lane); }
    }
    { float* cs = (float*)(ws + WS_ROPE); float* sn = cs + (size_t)T * 8;
      for (int i = X.bid * 512 + X.tid; i < T * 8; i += X.G * 512) { const int tok = i >> 3, f = i & 7; const float angf = (float)a.pos[tok] * c_invf[f];
          double rev = (double)angf * 0.15915494309189535; rev -= rint(rev); const float rf = (float)rev;
          cs[i] = __builtin_amdgcn_cosf(rf); sn[i] = __builtin_amdgcn_sinf(rf); } }
    __syncthreads();
    LAS float* cact = (LAS float*)X.lds; LAS float* red = (LAS float*)(X.lds + 8192);
    for (int i = X.tid; i < 2048; i += 512) { const float cv = a.c[i]; cact[i] = cv / (1.0f + __expf(-cv)); }
    __syncthreads();
    float* mod = (float*)(ws + WS_MOD);
    for (int it = X.bid; it < NL * 96; it += X.G) { const int l = it / 96, cg = it - l * 96; const int col = cg * 64 + X.lane;
        const float* w = a.ada_w + (size_t)l * D * 6144 + col; float s0 = 0.f, s1 = 0.f;
#pragma unroll 8
        for (int kk = 0; kk < 128; ++kk) { const int k = X.wave * 128 + kk; const float wv = w[(size_t)k * 6144]; s0 += cact[k] * wv; s1 += cact[1024 + k] * wv; }
        red[(X.wave * 2 + 0) * 64 + X.lane] = s0; red[(X.wave * 2 + 1) * 64 + X.lane] = s1;
        __syncthreads();
        if (X.tid < 128) { const int b = X.tid >> 6, ln = X.tid & 63; float s = 0.f;
#pragma unroll
            for (int w8 = 0; w8 < 8; ++w8) s += red[(w8 * 2 + b) * 64 + ln];
            mod[(size_t)(l * 2 + b) * 6144 + cg * 64 + ln] = s + a.ada_b[l * 6144 + cg * 64 + ln]; }
        __syncthreads();
    }
}

DI void p1_norm_gates(const Args& a, const Ctx& X, int l, const float* xin) {
    unsigned char* ws = a.ws;
    LAS float* gwl = (LAS float*)X.lds;
    for (int idx = X.tid; idx < 8192; idx += 512) { const int k = idx >> 3, g = idx & 7; gwl[g * 1024 + k] = a.w_in[(size_t)l * D * DIN_SRC + (size_t)k * DIN_SRC + 2304 + g]; }
    __syncthreads();
    const float* mod = (const float*)(ws + WS_MOD); bf16* hb = (bf16*)(ws + WS_H); float* gates = (float*)(ws + WS_GATES);
    const int gw = X.bid * 8 + X.wave, NGW = X.G * 8;
    for (int rg = gw; rg < T / 16; rg += NGW) {
        const int row0 = rg * 16, b = row0 >> 14;
        const float* mb = mod + (size_t)(l * 2 + b) * 6144;
        f32x4 aw[4], sh[4];
#pragma unroll
        for (int j = 0; j < 4; ++j) { const int k = 256 * j + 4 * X.lane; const f32x4 nw = *(const f32x4*)(a.nmw + l * D + k); const f32x4 sc = *(const f32x4*)(mb + 1024 + k); aw[j] = nw * (sc + 1.0f); sh[j] = *(const f32x4*)(mb + k); }
#pragma unroll 1
        for (int r = 0; r < 16; ++r) { const int row = row0 + r;
            const f32x4* xr = (const f32x4*)(xin + (size_t)row * D) + X.lane; f32x4 v[4]; float ss = 0.f;
#pragma unroll
            for (int j = 0; j < 4; ++j) { v[j] = xr[64 * j]; ss += (v[j].x * v[j].x + v[j].y * v[j].y) + (v[j].z * v[j].z + v[j].w * v[j].w); }
            ss = wave_sum(ss); const float rstd = 1.0f / sqrtf(ss * (1.0f / D) + EPS);
            unsigned long long* o8 = (unsigned long long*)(hb + (size_t)row * D) + X.lane;
#pragma unroll
            for (int j = 0; j < 4; ++j) { v[j] = v[j] * rstd * aw[j] + sh[j]; o8[64 * j] = (unsigned long long)pk2(v[j].x, v[j].y) | ((unsigned long long)pk2(v[j].z, v[j].w) << 32); }
            float gp[8];
#pragma unroll
            for (int g = 0; g < 8; ++g) { float p = 0.f;
#pragma unroll
                for (int j = 0; j < 4; ++j) { const f32x4 w = *(const LAS f32x4*)(gwl + g * 1024 + 256 * j + 4 * X.lane); p += (v[j].x * w.x + v[j].y * w.y) + (v[j].z * w.z + v[j].w * w.w); }
                gp[g] = wave_sum(p); }
            if (X.lane == 0) {
#pragma unroll
                for (int g = 0; g < 4; ++g) { gates[(size_t)row * 8 + g] = gp[g] + a.b_ig[l * 4 + g];
                    const float z = gp[4 + g] + a.b_fg[l * 4 + g]; gates[(size_t)row * 8 + 4 + g] = fminf(z, 0.f) - log1pf(__expf(-fabsf(z))); } }
        }
    }
}

DI void attn_unit(const Args& a, const Ctx& X, int l, int unit) {
    unsigned char* ws = a.ws; const bf16* proj = (const bf16*)(ws + WS_PROJ); bf16* ao = (bf16*)(ws + WS_H);
    const float* cs = (const float*)(ws + WS_ROPE); const float* sn = cs + (size_t)T * 8;
    const int b = unit >> 8, rem = unit & 255, nb = rem >> 1, kvh = rem & 1; const int tok0 = b * SEQ + nb * 128;
    LAS bf16* Kl = (LAS bf16*)X.lds;
    LAS bf16* VT = (LAS bf16*)(X.lds + 36864);
    int lane = X.lane; asm volatile("" : "+v"(lane));
    const int c16 = lane & 15, quad = lane >> 4;
    {
        const int row = X.tid >> 1, half = X.tid & 1; const int tokk = tok0 - 128 + row; const bool valid = (nb > 0) || (row >= 128);
        float y[32]; float vv[32];
        if (valid) {
            const v4u* kp = (const v4u*)(proj + (size_t)tokk * NPROJ + C_AK + kvh * 64 + half * 32); const v4u* vp = (const v4u*)(proj + (size_t)tokk * NPROJ + C_AV + kvh * 64 + half * 32);
#pragma unroll
            for (int q = 0; q < 4; ++q) { const v4u kw = kp[q], vw = vp[q];
                y[8 * q + 0] = bflo(kw.x); y[8 * q + 1] = bfhi(kw.x); y[8 * q + 2] = bflo(kw.y); y[8 * q + 3] = bfhi(kw.y); y[8 * q + 4] = bflo(kw.z); y[8 * q + 5] = bfhi(kw.z); y[8 * q + 6] = bflo(kw.w); y[8 * q + 7] = bfhi(kw.w);
                vv[8 * q + 0] = bflo(vw.x); vv[8 * q + 1] = bfhi(vw.x); vv[8 * q + 2] = bflo(vw.y); vv[8 * q + 3] = bfhi(vw.y); vv[8 * q + 4] = bflo(vw.z); vv[8 * q + 5] = bfhi(vw.z); vv[8 * q + 6] = bflo(vw.w); vv[8 * q + 7] = bfhi(vw.w); }
        } else {
#pragma unroll
            for (int i = 0; i < 32; ++i) { y[i] = 0.f; vv[i] = 0.f; } }
        float ss = 0.f;
#pragma unroll
        for (int i = 0; i < 32; ++i) ss += y[i] * y[i];
        ss += __shfl_xor(ss, 1); const float rstd = 1.0f / sqrtf(ss * (1.0f / 64.0f) + EPS);
#pragma unroll
        for (int i = 0; i < 32; ++i) y[i] = y[i] * rstd * a.knw[l * 64 + half * 32 + i];
        if (half == 0 && valid) {
#pragma unroll
            for (int d = 0; d < 8; ++d) { const float c = cs[(size_t)tokk * 8 + d], s = sn[(size_t)tokk * 8 + d]; const float t1 = y[d], t2 = y[d + 8]; y[d] = t1 * c - t2 * s; y[d + 8] = t2 * c + t1 * s; } }
#pragma unroll
        for (int q = 0; q < 4; ++q) { v4u w; w.x = pk2(y[8 * q], y[8 * q + 1]); w.y = pk2(y[8 * q + 2], y[8 * q + 3]); w.z = pk2(y[8 * q + 4], y[8 * q + 5]); w.w = pk2(y[8 * q + 6], y[8 * q + 7]);
            *(LAS v4u*)(Kl + row * 72 + half * 32 + 8 * q) = w; }
#pragma unroll
        for (int i = 0; i < 32; ++i) VT[(half * 32 + i) * 280 + row] = (bf16)f2bf(vv[i]);
        if (X.tid < 64) {
#pragma unroll
            for (int cc = 256; cc < 280; ++cc) VT[X.tid * 280 + cc] = 0; }
    }
    __syncthreads();
#pragma unroll 1
    for (int task = X.wave; task < 32; task += 8) {
        const int g = task >> 3, rg = task & 7, r0 = 16 * rg, head = kvh * 4 + g; const int tokq = tok0 + r0 + c16;
        const float sink = a.sinks[l * 8 + head];
        float qv[16];
        { const bf16* qp = proj + (size_t)tokq * NPROJ + C_AQ + head * 64; const v4u w0 = *(const v4u*)(qp + 8 * quad), w1 = *(const v4u*)(qp + 32 + 8 * quad);
          qv[0] = bflo(w0.x); qv[1] = bfhi(w0.x); qv[2] = bflo(w0.y); qv[3] = bfhi(w0.y); qv[4] = bflo(w0.z); qv[5] = bfhi(w0.z); qv[6] = bflo(w0.w); qv[7] = bfhi(w0.w);
          qv[8] = bflo(w1.x); qv[9] = bfhi(w1.x); qv[10] = bflo(w1.y); qv[11] = bfhi(w1.y); qv[12] = bflo(w1.z); qv[13] = bfhi(w1.z); qv[14] = bflo(w1.w); qv[15] = bfhi(w1.w); }
        float ss = 0.f;
#pragma unroll
        for (int i = 0; i < 16; ++i) ss += qv[i] * qv[i];
        ss += __shfl_xor(ss, 16); ss += __shfl_xor(ss, 32); const float rstd = 1.0f / sqrtf(ss * (1.0f / 64.0f) + EPS);
#pragma unroll
        for (int i = 0; i < 8; ++i) { qv[i] = qv[i] * rstd * a.qnw[l * 64 + 8 * quad + i]; qv[8 + i] = qv[8 + i] * rstd * a.qnw[l * 64 + 32 + 8 * quad + i]; }
#pragma unroll
        for (int d = 0; d < 8; ++d) { const float other = __shfl_xor(qv[d], 16); const float c = cs[(size_t)tokq * 8 + d], s = sn[(size_t)tokq * 8 + d];
            if (quad == 0) qv[d] = qv[d] * c - other * s; else if (quad == 1) qv[d] = qv[d] * c + other * s; }
        bf16x8 qf[2];
        { v4u w; w.x = pk2(qv[0], qv[1]); w.y = pk2(qv[2], qv[3]); w.z = pk2(qv[4], qv[5]); w.w = pk2(qv[6], qv[7]); qf[0] = __builtin_bit_cast(bf16x8, w);
          w.x = pk2(qv[8], qv[9]); w.y = pk2(qv[10], qv[11]); w.z = pk2(qv[12], qv[13]); w.w = pk2(qv[14], qv[15]); qf[1] = __builtin_bit_cast(bf16x8, w); }
        f32x4 sacc[9];
#pragma unroll
        for (int i = 0; i < 9; ++i) { const LAS bf16* kr = Kl + (16 * (rg + i) + c16) * 72 + 8 * quad;
            const bf16x8 k0 = *(const LAS bf16x8*)kr, k1 = *(const LAS bf16x8*)(kr + 32);
            f32x4 z = {0.f, 0.f, 0.f, 0.f}; z = __builtin_amdgcn_mfma_f32_16x16x32_bf16(k0, qf[0], z, 0, 0, 0); sacc[i] = __builtin_amdgcn_mfma_f32_16x16x32_bf16(k1, qf[1], z, 0, 0, 0); }
        int dbase = 4 * quad - c16; asm volatile("" : "+v"(dbase)); int kbase = 16 * rg + 4 * quad; asm volatile("" : "+v"(kbase)); float mx = sink;
#pragma unroll
        for (int i = 0; i < 9; ++i)
#pragma unroll
            for (int j = 0; j < 4; ++j) { const int dlt = dbase + 16 * i + j; const int kj = kbase + 16 * i + j; const bool ok = (dlt > 0) && (dlt <= 128) && ((nb > 0) || (kj >= 128));
                const float s = ok ? sacc[i][j] * 0.125f : -3.0e38f; sacc[i][j] = s; mx = fmaxf(mx, s); }
        mx = fmaxf(mx, __shfl_xor(mx, 16)); mx = fmaxf(mx, __shfl_xor(mx, 32));
        float sum = 0.f;
#pragma unroll
        for (int i = 0; i < 9; ++i)
#pragma unroll
            for (int j = 0; j < 4; ++j) { const float p = (sacc[i][j] > -1.0e38f) ? __expf(sacc[i][j] - mx) : 0.f; sacc[i][j] = p; sum += p; }
        sum += __shfl_xor(sum, 16); sum += __shfl_xor(sum, 32);
        const float inv = 1.0f / (sum + __expf(sink - mx));
        f32x4 oacc[4];
#pragma unroll
        for (int et = 0; et < 4; ++et) oacc[et] = (f32x4){0.f, 0.f, 0.f, 0.f};
#pragma unroll
        for (int kk = 0; kk < 5; ++kk) {
            v4u pw; pw.x = pk2(sacc[2 * kk][0], sacc[2 * kk][1]); pw.y = pk2(sacc[2 * kk][2], sacc[2 * kk][3]);
            if (2 * kk + 1 < 9) { pw.z = pk2(sacc[(2 * kk + 1 < 9) ? 2 * kk + 1 : 0][0], sacc[(2 * kk + 1 < 9) ? 2 * kk + 1 : 0][1]); pw.w = pk2(sacc[(2 * kk + 1 < 9) ? 2 * kk + 1 : 0][2], sacc[(2 * kk + 1 < 9) ? 2 * kk + 1 : 0][3]); } else { pw.z = 0u; pw.w = 0u; }
            const bf16x8 pf = __builtin_bit_cast(bf16x8, pw);
#pragma unroll
            for (int et = 0; et < 4; ++et) { const LAS bf16* vr = VT + (16 * et + c16) * 280 + 16 * rg + 32 * kk + 4 * quad;
                const v2u lo = *(const LAS v2u*)vr, hi = *(const LAS v2u*)(vr + 16); v4u vw; vw.x = lo.x; vw.y = lo.y; vw.z = hi.x; vw.w = hi.y;
                oacc[et] = __builtin_amdgcn_mfma_f32_16x16x32_bf16(__builtin_bit_cast(bf16x8, vw), pf, oacc[et], 0, 0, 0); }
        }
#pragma unroll
        for (int et = 0; et < 4; ++et) { v2u w; w.x = pk2(oacc[et][0] * inv, oacc[et][1] * inv); w.y = pk2(oacc[et][2] * inv, oacc[et][3] * inv);
            *(v2u*)(ao + (size_t)tokq * 512 + head * 64 + 16 * et + 4 * quad) = w; }
    }
    __syncthreads();
}

constexpr int ML_Q = 0, ML_K = 17408, ML_KET = 34816, ML_VT = 53248, ML_CT = 73984, ML_CW = 113152, ML_CB = 118272, ML_RED = 118784, ML_NW = 119296;
template <bool L3> DI void mlstm_unit(const Args& a, const Ctx& X, int l, int unit) {
    unsigned char* ws = a.ws; const bf16* proj = (const bf16*)(ws + WS_PROJ); bf16* hm = (bf16*)(ws + WS_H) + (size_t)T * 512;
    const float* gates = (const float*)(ws + WS_GATES); float* mlc = (float*)(ws + WS_MLC) + (size_t)unit * 18432; float* mlb = (float*)(ws + WS_MLB);
    const int seq = unit >> 5, sj = unit & 31, b = seq >> 2, hh = seq & 3; const int tokbase = b * SEQ + sj * 512;
    LAS bf16* Qs = (LAS bf16*)(X.lds + ML_Q); LAS bf16* Ks = (LAS bf16*)(X.lds + ML_K); LAS bf16* KET = (LAS bf16*)(X.lds + ML_KET);
    LAS bf16* VT = (LAS bf16*)(X.lds + ML_VT); LAS bf16* CT = (LAS bf16*)(X.lds + ML_CT); LAS float* CW = (LAS float*)(X.lds + ML_CW);
    LAS float* CB = (LAS float*)(X.lds + ML_CB); LAS float* RED = (LAS float*)(X.lds + ML_RED); LAS float* NW = (LAS float*)(X.lds + ML_NW);
    int lane = X.lane; asm volatile("" : "+v"(lane));
    const int c16 = lane & 15, quad = lane >> 4, w = X.wave;
    for (int idx = X.tid; idx < 1280; idx += 512) { const int tap = idx >> 8, ch = idx & 255; const int gch = (ch < 128) ? (hh * 128 + ch) : (512 + hh * 128 + (ch - 128));
        CW[idx] = (tap < 4) ? a.conv_w[(size_t)(l * 4 + tap) * 1024 + gch] : a.conv_b[l * 1024 + gch]; }
    for (int idx = X.tid; idx < 16 * 72; idx += 512) VT[128 * 72 + idx] = (idx < 72) ? (bf16)0x3F80 : (bf16)0;
    if (X.tid < 128) NW[X.tid] = a.mnw[l * 512 + hh * 128 + X.tid];
    f32x4 cacc[9];
#pragma unroll
    for (int et = 0; et < 9; ++et) {
        if (L3) {
#pragma unroll
            for (int j = 0; j < 4; ++j) { const float v = mlc[(16 * et + 4 * quad + j) * 128 + 16 * w + c16]; cacc[et][j] = v; CT[(16 * et + 4 * quad + j) * 136 + 16 * w + c16] = (bf16)f2bf(v); }
        } else cacc[et] = (f32x4){0.f, 0.f, 0.f, 0.f};
    }
    float bsum = 0.f;
    __syncthreads();
#pragma unroll 1
    for (int c = 0; c < 8; ++c) {
        const int tok0 = tokbase + c * 64;
        float bsc = gates[(size_t)(tok0 + lane) * 8 + 4 + hh]; const float li = gates[(size_t)(tok0 + lane) * 8 + hh];
#pragma unroll
        for (int o = 1; o < 64; o <<= 1) { const float v = __shfl_up(bsc, o); if (lane >= o) bsc += v; }
        const float bl = __shfl(bsc, 63); const float csv = li - bsc;
        if (w == 0) { CB[lane] = bsc; CB[64 + lane] = csv; }
        bsum += bl;
        { const int t = X.tid >> 3, dc = X.tid & 7; const float fac = __expf(bl + __shfl(csv, t));
          const int tokt = tok0 + t;
#pragma unroll
          for (int qk = (L3 ? 0 : 1); qk < 2; ++qk) {
              float accv[16];
#pragma unroll
              for (int i = 0; i < 16; ++i) accv[i] = CW[4 * 256 + qk * 128 + 16 * dc + i];
#pragma unroll
              for (int j = 0; j < 4; ++j) { const int tt = tokt - 3 + j;
                  if (tt >= b * SEQ) { const v4u* p = (const v4u*)(proj + (size_t)tt * NPROJ + (qk ? C_MK : C_MQ) + hh * 128 + 16 * dc); const v4u w0 = p[0], w1 = p[1];
                      const float xv[16] = {bflo(w0.x), bfhi(w0.x), bflo(w0.y), bfhi(w0.y), bflo(w0.z), bfhi(w0.z), bflo(w0.w), bfhi(w0.w), bflo(w1.x), bfhi(w1.x), bflo(w1.y), bfhi(w1.y), bflo(w1.z), bfhi(w1.z), bflo(w1.w), bfhi(w1.w)};
#pragma unroll
                      for (int i = 0; i < 16; ++i) accv[i] += CW[j * 256 + qk * 128 + 16 * dc + i] * xv[i]; } }
#pragma unroll
              for (int i = 0; i < 16; ++i) { const float z = accv[i]; accv[i] = z / (1.0f + __expf(-z)) * (qk ? 0.08838834764831845f : 1.0f); }
              if (L3) { LAS bf16* dst = (qk ? Ks : Qs) + t * 136 + 16 * dc;
                  v4u o0, o1; o0.x = pk2(accv[0], accv[1]); o0.y = pk2(accv[2], accv[3]); o0.z = pk2(accv[4], accv[5]); o0.w = pk2(accv[6], accv[7]);
                  o1.x = pk2(accv[8], accv[9]); o1.y = pk2(accv[10], accv[11]); o1.z = pk2(accv[12], accv[13]); o1.w = pk2(accv[14], accv[15]);
                  *(LAS v4u*)dst = o0; *(LAS v4u*)(dst + 8) = o1; }
              if (qk) {
#pragma unroll
                  for (int i = 0; i < 16; ++i) KET[(16 * dc + i) * 72 + t] = (bf16)f2bf(accv[i] * fac); }
          }
          { const v4u* p = (const v4u*)(proj + (size_t)tokt * NPROJ + C_MV + hh * 128 + 16 * dc); const v4u w0 = p[0], w1 = p[1];
            const unsigned ww[8] = {w0.x, w0.y, w0.z, w0.w, w1.x, w1.y, w1.z, w1.w};
#pragma unroll
            for (int i = 0; i < 8; ++i) { VT[(16 * dc + 2 * i) * 72 + t] = (bf16)(ww[i] & 0xffffu); VT[(16 * dc + 2 * i + 1) * 72 + t] = (bf16)(ww[i] >> 16); } }
        }
        __syncthreads();
        float hval[4][4]; int tt_ = w & 3, eh = w >> 2; const int tq = 16 * tt_ + c16;
        if (L3) {
            bf16x8 qf[4];
#pragma unroll
            for (int ks = 0; ks < 4; ++ks) qf[ks] = *(const LAS bf16x8*)(Qs + tq * 136 + 32 * ks + 8 * quad);
            f32x4 sacc[4];
#pragma unroll
            for (int st = 0; st < 4; ++st) { f32x4 z = {0.f, 0.f, 0.f, 0.f};
#pragma unroll
                for (int ks = 0; ks < 4; ++ks) z = __builtin_amdgcn_mfma_f32_16x16x32_bf16(*(const LAS bf16x8*)(Ks + (16 * st + c16) * 136 + 32 * ks + 8 * quad), qf[ks], z, 0, 0, 0);
                sacc[st] = z; }
            const float cbt = CB[tq];
#pragma unroll
            for (int st = 0; st < 4; ++st)
#pragma unroll
                for (int j = 0; j < 4; ++j) { const int s = 16 * st + 4 * quad + j; const float d = (s <= tq) ? __expf(cbt + CB[64 + s]) : 0.f; sacc[st][j] *= d; }
            bf16x8 pf[2];
#pragma unroll
            for (int kk = 0; kk < 2; ++kk) { v4u pw; pw.x = pk2(sacc[2 * kk][0], sacc[2 * kk][1]); pw.y = pk2(sacc[2 * kk][2], sacc[2 * kk][3]); pw.z = pk2(sacc[2 * kk + 1][0], sacc[2 * kk + 1][1]); pw.w = pk2(sacc[2 * kk + 1][2], sacc[2 * kk + 1][3]); pf[kk] = __builtin_bit_cast(bf16x8, pw); }
            const float ebt = __expf(cbt);
            f32x4 nn[5];
#pragma unroll
            for (int x = 0; x < 5; ++x) { const int et = (x < 4) ? (4 * eh + x) : 8; f32x4 na = {0.f, 0.f, 0.f, 0.f}, ia = {0.f, 0.f, 0.f, 0.f};
#pragma unroll
                for (int kk = 0; kk < 2; ++kk) { const LAS bf16* vr = VT + (16 * et + c16) * 72 + 32 * kk + 4 * quad; const v2u lo = *(const LAS v2u*)vr, hi = *(const LAS v2u*)(vr + 16); v4u vw; vw.x = lo.x; vw.y = lo.y; vw.z = hi.x; vw.w = hi.y;
                    na = __builtin_amdgcn_mfma_f32_16x16x32_bf16(__builtin_bit_cast(bf16x8, vw), pf[kk], na, 0, 0, 0); }
#pragma unroll
                for (int ks = 0; ks < 4; ++ks) ia = __builtin_amdgcn_mfma_f32_16x16x32_bf16(*(const LAS bf16x8*)(CT + (16 * et + c16) * 136 + 32 * ks + 8 * quad), qf[ks], ia, 0, 0, 0);
                nn[x] = na + ia * ebt; }
            const float den = __shfl(nn[4][0], c16); const float inv = 1.0f / fmaxf(fabsf(den), 1.0f);
            float ss = 0.f;
#pragma unroll
            for (int x = 0; x < 4; ++x)
#pragma unroll
                for (int j = 0; j < 4; ++j) { hval[x][j] = nn[x][j] * inv; ss += hval[x][j] * hval[x][j]; }
            ss += __shfl_xor(ss, 16); ss += __shfl_xor(ss, 32);
            if (quad == 0) RED[eh * 64 + tq] = ss;
            __syncthreads();
            const float rstd = 1.0f / sqrtf((RED[tq] + RED[64 + tq]) * (1.0f / 128.0f) + EPS);
#pragma unroll
            for (int x = 0; x < 4; ++x) { const int e = 16 * (4 * eh + x) + 4 * quad; const v2u og = *(const v2u*)(proj + (size_t)(tok0 + tq) * NPROJ + C_MO + hh * 128 + e);
                const float y0 = hval[x][0] * rstd * NW[e] * bflo(og.x), y1 = hval[x][1] * rstd * NW[e + 1] * bfhi(og.x), y2 = hval[x][2] * rstd * NW[e + 2] * bflo(og.y), y3 = hval[x][3] * rstd * NW[e + 3] * bfhi(og.y);
                v2u o; o.x = pk2(y0, y1); o.y = pk2(y2, y3); *(v2u*)(hm + (size_t)(tok0 + tq) * 512 + hh * 128 + e) = o; }
        }
        { const float ebl = __expf(bl);
          bf16x8 kf[2];
#pragma unroll
          for (int kk = 0; kk < 2; ++kk) kf[kk] = *(const LAS bf16x8*)(KET + (16 * w + c16) * 72 + 32 * kk + 8 * quad);
#pragma unroll
          for (int et = 0; et < 9; ++et) { f32x4 z = cacc[et] * ebl;
#pragma unroll
              for (int kk = 0; kk < 2; ++kk) z = __builtin_amdgcn_mfma_f32_16x16x32_bf16(*(const LAS bf16x8*)(VT + (16 * et + c16) * 72 + 32 * kk + 8 * quad), kf[kk], z, 0, 0, 0);
              cacc[et] = z;
              if (L3) {
#pragma unroll
                  for (int j = 0; j < 4; ++j) CT[(16 * et + 4 * quad + j) * 136 + 16 * w + c16] = (bf16)f2bf(z[j]); } } }
        __syncthreads();
    }
    if (!L3) {
#pragma unroll
        for (int et = 0; et < 9; ++et)
#pragma unroll
            for (int j = 0; j < 4; ++j) mlc[(16 * et + 4 * quad + j) * 128 + 16 * w + c16] = cacc[et][j];
        if (X.tid == 0) mlb[unit] = bsum;
    }
}
DI void mlstm_scan(const Args& a, const Ctx& X) {
    float* mlc = (float*)(a.ws + WS_MLC); const float* mlb = (const float*)(a.ws + WS_MLB);
    for (int idx = X.bid * 512 + X.tid; idx < 8 * 18432; idx += X.G * 512) { const int seq = idx / 18432, el = idx - seq * 18432; float carry = 0.f;
        for (int j = 0; j < 32; ++j) { const int u = seq * 32 + j; float* p = mlc + (size_t)u * 18432 + el; const float tmp = *p; *p = carry; carry = __expf(mlb[u]) * carry + tmp; } }
}

DI void p6_norm_route(const Args& a, const Ctx& X, int l, const float* xin) {
    unsigned char* ws = a.ws;
    LAS float* wr = (LAS float*)X.lds;
    for (int idx = X.tid; idx < 16384; idx += 512) { const int k = idx >> 4, e = idx & 15; wr[e * 1024 + k] = a.router_w[idx]; }
    __syncthreads();
    const float* mod = (const float*)(ws + WS_MOD); bf16* hb = (bf16*)(ws + WS_H); float* tgate = (float*)(ws + WS_TGATE); int* tokl = (int*)(ws + WS_TOKL);
    unsigned* cnt = (unsigned*)(ws + WS_CTL) + CW_CNT + l * 32;
    const int gw = X.bid * 8 + X.wave, NGW = X.G * 8;
    for (int rg = gw; rg < T / 16; rg += NGW) {
        const int row0 = rg * 16, b = row0 >> 14;
        const float* mb = mod + (size_t)(l * 2 + b) * 6144;
        f32x4 aw[4], sh[4];
#pragma unroll
        for (int j = 0; j < 4; ++j) { const int k = 256 * j + 4 * X.lane; const f32x4 nw = *(const f32x4*)(a.nfw + l * D + k); const f32x4 sc = *(const f32x4*)(mb + 4 * 1024 + k); aw[j] = nw * (sc + 1.0f); sh[j] = *(const f32x4*)(mb + 3 * 1024 + k); }
        int my_cls = 0; float my_ga = 0.f, my_gb = 0.f;
#pragma unroll 1
        for (int r = 0; r < 16; ++r) { const int row = row0 + r;
            const f32x4* xr = (const f32x4*)(xin + (size_t)row * D) + X.lane; f32x4 v[4]; float ss = 0.f;
#pragma unroll
            for (int j = 0; j < 4; ++j) { v[j] = xr[64 * j]; ss += (v[j].x * v[j].x + v[j].y * v[j].y) + (v[j].z * v[j].z + v[j].w * v[j].w); }
            ss = wave_sum(ss); const float rstd = 1.0f / sqrtf(ss * (1.0f / D) + EPS);
            unsigned long long* o8 = (unsigned long long*)(hb + (size_t)row * D) + X.lane;
#pragma unroll
            for (int j = 0; j < 4; ++j) { v[j] = v[j] * rstd * aw[j] + sh[j]; o8[64 * j] = (unsigned long long)pk2(v[j].x, v[j].y) | ((unsigned long long)pk2(v[j].z, v[j].w) << 32); }
            float sc[16], sel[16];
#pragma unroll
            for (int e = 0; e < 16; ++e) { float p = 0.f;
#pragma unroll
                for (int j = 0; j < 4; ++j) { const f32x4 wv = *(const LAS f32x4*)(wr + e * 1024 + 256 * j + 4 * X.lane); p += (v[j].x * wv.x + v[j].y * wv.y) + (v[j].z * wv.z + v[j].w * wv.w); }
                p = wave_sum(p); sc[e] = 1.0f / (1.0f + __expf(-p)); sel[e] = sc[e] + a.router_b[e]; __builtin_amdgcn_sched_barrier(0); }
            int gi = 0; float gbest = -1.0e30f;
#pragma unroll
            for (int g = 0; g < 4; ++g) { const float p0 = sel[4 * g], p1 = sel[4 * g + 1], p2 = sel[4 * g + 2], p3 = sel[4 * g + 3];
                const float gs = fmaxf(fmaxf(fmaxf(p0 + p1, p0 + p2), fmaxf(p0 + p3, p1 + p2)), fmaxf(p1 + p3, p2 + p3));
                if (gs > gbest) { gbest = gs; gi = g; } }
            float q[4], s4[4];
#pragma unroll
            for (int i = 0; i < 4; ++i) { q[i] = 0.f; s4[i] = 0.f; }
#pragma unroll
            for (int g = 0; g < 4; ++g) if (g == gi) {
#pragma unroll
                for (int i = 0; i < 4; ++i) { q[i] = sel[4 * g + i]; s4[i] = sc[4 * g + i]; } }
            int i1 = 0; float b1 = q[0];
#pragma unroll
            for (int i = 1; i < 4; ++i) if (q[i] > b1) { b1 = q[i]; i1 = i; }
            int i2 = -1; float b2 = -1.0e30f;
#pragma unroll
            for (int i = 0; i < 4; ++i) if (i != i1 && q[i] > b2) { b2 = q[i]; i2 = i; }
            const int ia = (i1 < i2) ? i1 : i2, ib = (i1 < i2) ? i2 : i1;
            float sa = 0.f, sb = 0.f;
#pragma unroll
            for (int i = 0; i < 4; ++i) { if (i == ia) sa = s4[i]; if (i == ib) sb = s4[i]; }
            const int pidx = (ia == 0) ? (ib - 1) : ((ia == 1) ? (ib + 1) : 5);
            const float inv = 1.0f / (sa + sb);
            if (X.lane == r) { my_cls = gi * 6 + pidx; my_ga = sa * inv; my_gb = sb * inv; }
        }
        if (X.lane < 16) { const int tok = row0 + X.lane; const unsigned pos = __hip_atomic_fetch_add(cnt + my_cls, 1u, RLX_AGENT);
            tokl[my_cls * CLS_CAP + (int)pos] = tok; tgate[tok * 2] = my_ga; tgate[tok * 2 + 1] = my_gb; }
    }
}
DI MoeTab moe_tables(const Args& a, const Ctx& X, int l) {
    LAS int* tab = (LAS int*)(X.lds + TAB_OFF); LAS int* tcls = tab; LAS int* tpos = tab + 160; LAS int* cn = tab + 320; LAS int* rt_ = tab + 344;
    unsigned* cnt = (unsigned*)(a.ws + WS_CTL) + CW_CNT + l * 32;
    if (X.tid < NCLS) cn[X.tid] = (int)__hip_atomic_load(cnt + X.tid, RLX_AGENT);
    __syncthreads();
    if (X.tid == 0) { int r = 0;
#pragma unroll 1
        for (int c = 0; c < NCLS; ++c) { const int n = (cn[c] + 255) >> 8;
#pragma unroll 1
            for (int i = 0; i < n; ++i) { tcls[r] = c; tpos[r] = i * 256; ++r; } }
        rt_[0] = r; }
    __syncthreads();
    MoeTab tb; tb.tcls = tcls; tb.tpos = tpos; tb.cnt = cn; tb.Rtot = __builtin_amdgcn_readfirstlane(rt_[0]); return tb;
}

__global__ void __launch_bounds__(512, 2) fwd(Args a) {
    extern __shared__ __attribute__((aligned(16))) unsigned char lds_raw[];
    Ctx X; X.lds = (LAS unsigned char*)lds_raw; X.tid = threadIdx.x; X.lane = X.tid & 63; X.wave = __builtin_amdgcn_readfirstlane(X.tid >> 6); X.G = gridDim.x; X.bid = blockIdx.x;
    volatile LAS unsigned* MISC = (volatile LAS unsigned*)(X.lds + MISC_OFF);
    if (X.tid < 64) MISC[X.tid] = 0u;
    __syncthreads();
    unsigned char* ws = a.ws;
    unsigned* ctl = (unsigned*)(ws + WS_CTL);
    const int lo = a.ph_lo, hi = a.ph_hi;
    XcdBarrier bar; bar.bar = ctl + CW_BAR; bar.x = 0; bar.st = MISC + 8;
    if (hi - lo > 1) bar = xcd_barrier_post(ctl + CW_BAR, MISC + 8);
#ifndef PH_MASK
#define PH_MASK 0xFFFFF
#endif
#define PON(p) ((PH_MASK >> (p)) & 1)
#define IN(k) (lo <= (k) && (k) < hi)
#define SEAM(k) do { if (IN(k) && IN((k) + 1)) xcd_barrier(bar); } while (0)
    if (PON(10) && IN(0)) p0_prologue(a, X);
    SEAM(0);
    const float* mod = (const float*)(ws + WS_MOD);
    bf16* proj = (bf16*)(ws + WS_PROJ);
    for (int l = 0; l < NL; ++l) {
        const int g0 = 1 + l * NPH;
        const float* xin = (l == 0) ? a.x : a.out;
        if (PON(0) && IN(g0 + 0)) { const Ctx P = fresh(X); p1_norm_gates(a, P, l, xin); }
        SEAM(g0 + 0);
        if (PON(1) && IN(g0 + 1)) { const Ctx P = fresh(X);
            DenseSched S; S.A = (const char*)(ws + WS_H); S.Bt = (const char*)(ws + WS_WIN) + (size_t)l * NPROJ * D * 2; S.lda = D; S.ldb = D; S.ord.init(T / 256, NPROJ / 256, P.G, P.bid);
            EpiProj E; E.O = proj;
            pg8::gemm_phase<EpiProj, DenseSched>(P.lds, D, S, E);
        }
        SEAM(g0 + 1);
        if (PON(2) && IN(g0 + 2)) { const Ctx P = fresh(X);
            if (PON(11)) {
#pragma unroll 1
                for (int u = P.bid; u < 512; u += P.G) attn_unit(a, P, l, u); }
            if (PON(12)) {
#pragma unroll 1
                for (int u = P.bid; u < 256; u += P.G) mlstm_unit<false>(a, P, l, u); }
        }
        SEAM(g0 + 2);
        if (PON(3) && IN(g0 + 3)) { const Ctx P = fresh(X); mlstm_scan(a, P); }
        SEAM(g0 + 3);
        if (PON(4) && IN(g0 + 4)) { const Ctx P = fresh(X);
#pragma unroll 1
            for (int u = P.bid; u < 256; u += P.G) mlstm_unit<true>(a, P, l, u); }
        SEAM(g0 + 4);
        if (PON(5) && IN(g0 + 5)) { const Ctx P = fresh(X);
            { DenseSched S; S.A = (const char*)(ws + WS_H); S.Bt = (const char*)(ws + WS_WAU) + (size_t)l * D * 512 * 2; S.lda = 512; S.ldb = 512; S.ord.init(T / 256, D / 256, P.G, P.bid);
              EpiGate<false> E; E.P = proj; E.gcol = C_GA; pg8::gemm_phase<EpiGate<false>, DenseSched>(P.lds, 512, S, E); }
            { DenseSched S; S.A = (const char*)(ws + WS_H) + (size_t)T * 512 * 2; S.Bt = (const char*)(ws + WS_WMU) + (size_t)l * D * 512 * 2; S.lda = 512; S.ldb = 512; S.ord.init(T / 256, D / 256, P.G, P.bid);
              EpiGate<true> E; E.P = proj; E.gcol = C_GB; pg8::gemm_phase<EpiGate<true>, DenseSched>(P.lds, 512, S, E); }
        }
        SEAM(g0 + 5);
        if (PON(6) && IN(g0 + 6)) { const Ctx P = fresh(X);
            DenseSched S; S.A = (const char*)(proj + C_MQ); S.Bt = (const char*)(ws + WS_WOUT) + (size_t)l * D * D * 2; S.lda = NPROJ; S.ldb = D; S.ord.init(T / 256, D / 256, P.G, P.bid);
            EpiRes E; E.xin = xin; E.out = a.out; E.g = mod + (size_t)(l * 2) * 6144 + 2 * 1024;
            pg8::gemm_phase<EpiRes, DenseSched>(P.lds, D, S, E);
        }
        SEAM(g0 + 6);
        if (PON(7) && IN(g0 + 7)) { const Ctx P = fresh(X); p6_norm_route(a, P, l, a.out); }
        SEAM(g0 + 7);
        if (PON(8) && IN(g0 + 8)) { const Ctx P = fresh(X);
            const MoeTab tb = moe_tables(a, P, l);
            LAS unsigned* tokoff = (LAS unsigned*)(P.lds + TOKOFF_OFF); const int* tokl = (const int*)(ws + WS_TOKL);
#pragma unroll 1
            for (int s = 0; s < 8; ++s) { const int L = s * P.G + P.bid;
                if (L < tb.Rtot * 8 && P.tid < 256) { const int rt = L >> 3, cls = tb.tcls[rt], pos = tb.tpos[rt] + P.tid, cn = tb.cnt[cls]; const int tok = tokl[cls * CLS_CAP + (pos < cn ? pos : 0)]; tokoff[s * 256 + P.tid] = (unsigned)tok; } }
            __syncthreads();
            MoeUpSched S; S.A = (const char*)(ws + WS_H); S.W = (const char*)(ws + WS_WGU) + (size_t)l * NE * 1024 * D * 2; S.lda = D; S.ldb = D; S.tb = tb; S.G = P.G; S.c = P.bid; S.tokoff = tokoff;
            EpiSwiglu E; E.H = proj; E.tgate = (const float*)(ws + WS_TGATE); E.tokoff = tokoff;
            pg8::gemm_phase<EpiSwiglu, MoeUpSched>(P.lds, D, S, E);
        }
        SEAM(g0 + 8);
        if (PON(9) && IN(g0 + 9)) { const Ctx P = fresh(X);
            const MoeTab tb = moe_tables(a, P, l);
            MoeDownSched S; S.A = (const char*)proj; S.W = (const char*)(ws + WS_WD) + (size_t)l * NE * 1024 * FF * 2; S.lda = D; S.ldb = FF; S.tb = tb; S.G = P.G; S.c = P.bid;
            EpiMoeOut E; E.out = a.out; E.g = mod + (size_t)(l * 2) * 6144 + 5 * 1024; E.tokl = (const int*)(ws + WS_TOKL); E.tb = tb;
            pg8::gemm_phase<EpiMoeOut, MoeDownSched>(P.lds, D, S, E);
        }
        SEAM(g0 + 9);
    }
#undef IN
#undef SEAM
}

extern "C" void kernel_launch(void* const* d_in, const int* in_sizes, int n_in, void* d_out, int out_size, void* d_ws, size_t ws_size, hipStream_t stream) {
    static int grid = 0;
    if (grid == 0) {
        if (n_in != 24 || in_sizes[0] != T * D || out_size != T * D || ws_size < WS_END) { fprintf(stderr, "kernel_launch: unexpected shapes / workspace (n_in %d, ws %zu, need %zu)\n", n_in, ws_size, (size_t)WS_END); grid = -1; return; }
        int dev = 0, cus = 0;
        if (hipGetDevice(&dev) != hipSuccess || hipDeviceGetAttribute(&cus, hipDeviceAttributeMultiprocessorCount, dev) != hipSuccess) { grid = -1; return; }
        if (hipFuncSetAttribute((const void*)fwd, hipFuncAttributeMaxDynamicSharedMemorySize, LDS_BYTES) != hipSuccess) { fprintf(stderr, "kernel_launch: hipFuncSetAttribute failed\n"); grid = -1; return; }
        int per_cu = 0;
        if (hipOccupancyMaxActiveBlocksPerMultiprocessor(&per_cu, (const void*)fwd, 512, LDS_BYTES) != hipSuccess || per_cu < 1) fprintf(stderr, "kernel_launch: occupancy query reports %d\n", per_cu);
        (void)hipGetLastError();
        grid = cus < 256 ? cus : 256;
    }
    if (grid < 0) return;
    (void)hipMemsetAsync((char*)d_ws + WS_CTL, 0, CTL_ZERO_BYTES, stream);
    Args a{};
    a.x = (const float*)d_in[0]; a.c = (const float*)d_in[1]; a.pos = (const int*)d_in[2]; a.ada_w = (const float*)d_in[3]; a.ada_b = (const float*)d_in[4];
    a.nmw = (const float*)d_in[5]; a.nfw = (const float*)d_in[6]; a.w_in = (const float*)d_in[7]; a.b_ig = (const float*)d_in[8]; a.b_fg = (const float*)d_in[9];
    a.qnw = (const float*)d_in[10]; a.knw = (const float*)d_in[11]; a.sinks = (const float*)d_in[12]; a.conv_w = (const float*)d_in[13]; a.conv_b = (const float*)d_in[14];
    a.mnw = (const float*)d_in[15]; a.w_au = (const float*)d_in[16]; a.w_mu = (const float*)d_in[17]; a.w_out = (const float*)d_in[18]; a.router_w = (const float*)d_in[19];
    a.router_b = (const float*)d_in[20]; a.w_gate = (const float*)d_in[21]; a.w_up = (const float*)d_in[22]; a.w_down = (const float*)d_in[23];
    a.out = (float*)d_out; a.ws = (unsigned char*)d_ws;
#if MK_MULTI
    for (int gp = 0; gp < NGP; ++gp) { a.ph_lo = gp; a.ph_hi = gp + 1; hipLaunchKernelGGL(fwd, dim3(grid), dim3(512), LDS_BYTES, stream, a); }
#else
    a.ph_lo = 0; a.ph_hi = NGP; hipLaunchKernelGGL(fwd, dim3(grid), dim3(512), LDS_BYTES, stream, a);
#endif
}
```

```cpp
#include <hip/hip_runtime.h>
#include <cstdio>
#include <cstdint>

#ifndef MK_MULTI
#define MK_MULTI 0
#endif

#define GAS __attribute__((address_space(1)))
#define LAS __attribute__((address_space(3)))
typedef unsigned short bf16;
typedef unsigned v4u __attribute__((ext_vector_type(4)));
typedef unsigned v2u __attribute__((ext_vector_type(2)));
typedef float f32x4 __attribute__((ext_vector_type(4)));
typedef float f32x2 __attribute__((ext_vector_type(2)));
typedef short bf16x8 __attribute__((ext_vector_type(8)));
typedef short bf16x4 __attribute__((ext_vector_type(4)));
#define DI __device__ __forceinline__
#define RLX_AGENT __ATOMIC_RELAXED, __HIP_MEMORY_SCOPE_AGENT
#define LDS_WAIT() asm volatile("s_waitcnt lgkmcnt(0)" ::: "memory")
#define VM_WAIT() asm volatile("s_waitcnt vmcnt(0)" ::: "memory")

constexpr int NB = 2, SEQ = 16384, T = NB * SEQ, D = 1024, NL = 4;
constexpr int DIN_SRC = 4872;
constexpr int NPROJ = 4864;
constexpr int C_AQ = 0, C_AK = 512, C_AV = 640, C_MQ = 768, C_MK = 1280, C_MV = 1792, C_MO = 2304, C_GA = 2816, C_GB = 3840;
constexpr int NE = 16, FF = 512;
constexpr int NCLS = 24, CLS_CAP = 32768;
constexpr float EPS = 1e-6f;
constexpr int NPH = 10;
constexpr int NGP = 1 + NL * NPH;

constexpr size_t MiB = 1u << 20;
constexpr size_t WS_CTL = 0, CTL_ZERO_BYTES = 1 * MiB;
constexpr size_t WS_MOD = 1 * MiB;
constexpr size_t WS_ROPE = 2 * MiB;
constexpr size_t WS_GATES = 4 * MiB;
constexpr size_t WS_TGATE = 5 * MiB;
constexpr size_t WS_TOKL = 6 * MiB;
constexpr size_t WS_MLB = 9 * MiB;
constexpr size_t WS_MLC = 10 * MiB;
constexpr size_t WS_WIN = 28 * MiB;
constexpr size_t WS_WAU = 66 * MiB;
constexpr size_t WS_WMU = 70 * MiB;
constexpr size_t WS_WOUT = 74 * MiB;
constexpr size_t WS_WGU = 82 * MiB;
constexpr size_t WS_WD = 210 * MiB;
constexpr size_t WS_H = 274 * MiB;
constexpr size_t WS_PROJ = 338 * MiB;
constexpr size_t WS_END = 642 * MiB;

constexpr int CW_TMO = 0;
constexpr int CW_BAR = 4096;
constexpr int CW_CNT = 8192;

constexpr int RING_BYTES = 131072;
constexpr int MISC_OFF = RING_BYTES;
constexpr int TAB_OFF = RING_BYTES + 256;
constexpr int TOKOFF_OFF = RING_BYTES + 2048;
constexpr int LDS_BYTES = 147456;

DI unsigned f2bf(float f) { unsigned u = __builtin_bit_cast(unsigned, f); return (u + 0x7fffu + ((u >> 16) & 1u)) >> 16; }
DI unsigned pk2(float lo, float hi) { return f2bf(lo) | (f2bf(hi) << 16); }
DI float bf2f(unsigned short b) { return __builtin_bit_cast(float, ((unsigned)b) << 16); }
DI float bflo(unsigned w) { return __builtin_bit_cast(float, w << 16); }
DI float bfhi(unsigned w) { return __builtin_bit_cast(float, w & 0xffff0000u); }
DI float wave_sum(float v) {
#pragma unroll
    for (int o = 1; o < 64; o <<= 1) v += __shfl_xor(v, o);
    return v;
}
DI float sigmoidf_(float x) { return 1.0f / (1.0f + __expf(-x)); }

#define XB_TMO      128
#define XB_XCNT(j)  (256  + 64 * (j))
#define XB_XSUB(j)  (1280 + 64 * (j))
#define XB_XGEN(j)  (2304 + 64 * (j))
#define XB_TOP      3328
#define XB_TOPGEN   3392
#define XCD_BAR_WORDS 3456
#define XB_SPIN_CAP (1u << 18)
__device__ __forceinline__ unsigned xb_ld(unsigned* p)              { return __hip_atomic_load(p, __ATOMIC_RELAXED, __HIP_MEMORY_SCOPE_AGENT); }
__device__ __forceinline__ unsigned xb_add(unsigned* p, unsigned v) { return __hip_atomic_fetch_add(p, v, __ATOMIC_RELAXED, __HIP_MEMORY_SCOPE_AGENT); }
__device__ __forceinline__ unsigned xb_xcc_id() { return (unsigned)__builtin_amdgcn_s_getreg((3 << 11) | 20) & 0xFu; }
#define XB_SPIN(cond, bar) do { unsigned _sp = 0; while (cond) { __builtin_amdgcn_s_sleep(1); \
    if ((++_sp & 255u) == 0u) { if (xb_ld(&(bar)[XB_TMO])) break; if (_sp > XB_SPIN_CAP) { atomicAdd(&(bar)[XB_TMO], 1u); break; } } } } while (0)
struct XcdBarrier { unsigned* bar; unsigned x; volatile LAS unsigned* st; };
__device__ __forceinline__ XcdBarrier xcd_barrier_post(unsigned* bar, volatile LAS unsigned* st) {
    XcdBarrier b; b.bar = bar; b.x = xb_xcc_id(); b.st = st;
    if (threadIdx.x == 0) (void)xb_add(&bar[XB_XCNT(b.x)], 1u);
    return b;
}
__device__ __forceinline__ void xcd_barrier_complete(unsigned* bar, unsigned x, unsigned& nloc, unsigned& nx) {
    const unsigned G = gridDim.x * gridDim.y * gridDim.z;
    unsigned sum, cnt, mine, sp = 0u;
    for (;;) {
        sum = 0u; cnt = 0u; mine = 0u;
#pragma unroll
        for (unsigned j = 0; j < 16; ++j) { const unsigned c = xb_ld(&bar[XB_XCNT(j)]); sum += c; cnt += (c > 0u) ? 1u : 0u; mine = (j == x) ? c : mine; }
        if (sum == G) break;
        __builtin_amdgcn_s_sleep(1);
        if ((++sp & 255u) == 0u) { if (xb_ld(&bar[XB_TMO])) break; if (sp > XB_SPIN_CAP) { atomicAdd(&bar[XB_TMO], 1u); break; } }
    }
    nloc = mine > 0u ? mine : 1u; nx = cnt > 0u ? cnt : 1u;
}
__device__ __forceinline__ void xcd_barrier(const XcdBarrier& b) {
    asm volatile("s_waitcnt vmcnt(0)" ::: "memory");
    __syncthreads();
    if (threadIdx.x == 0) {
        unsigned* bar = b.bar;
        __builtin_amdgcn_s_waitcnt(0);
        unsigned nloc = b.st[0], nx = b.st[1];
        if (nloc == 0u) { xcd_barrier_complete(bar, b.x, nloc, nx); b.st[0] = nloc; b.st[1] = nx; }
        const unsigned old = xb_add(&bar[XB_XSUB(b.x)], 1u);
        const unsigned gen = old / nloc;
        if (old + 1u == (gen + 1u) * nloc) {
            __builtin_amdgcn_fence(__ATOMIC_RELEASE, "agent");
            asm volatile("s_waitcnt vmcnt(0)" ::: "memory");
            const unsigned og = xb_add(&bar[XB_TOP], 1u);
            const unsigned tg = og / nx;
            if (og + 1u == (tg + 1u) * nx) xb_add(&bar[XB_TOPGEN], 1u);
            else XB_SPIN(xb_ld(&bar[XB_TOPGEN]) == tg, bar);
            __builtin_amdgcn_fence(__ATOMIC_ACQUIRE, "agent");
            xb_add(&bar[XB_XGEN(b.x)], 1u);
            asm volatile("s_waitcnt vmcnt(0)" ::: "memory");
        } else {
            XB_SPIN(xb_ld(&bar[XB_XGEN(b.x)]) == gen, bar);
            __builtin_amdgcn_fence(__ATOMIC_ACQUIRE, "agent");
            asm volatile("s_waitcnt vmcnt(0)" ::: "memory");
        }
    }
    __syncthreads();
}

namespace pg8 {
constexpr int BM = 256, BK = 64, HALF = 128, HTB = HALF * BK * 2, STAGE_BYTES = 8 * HTB, NXCD = 8, WGM = 8;
__host__ __device__ __forceinline__ int lds_byte(int r, int c) { const int st = (r >> 4) * 2 + (c >> 5), rr = r & 15, cc = c & 31, ob = rr * 64 + cc * 2; return st * 1024 + (ob ^ (((ob >> 9) & 1) << 5)); }
__host__ __device__ __forceinline__ void stage_rc(int b, int& R, int& C) { const int st = b / 1024, sb = b % 1024, swz = sb ^ (((sb >> 9) & 1) << 5); R = (st >> 1) * 16 + swz / 64; C = (st & 1) * 32 + (swz % 64) / 2; }
__host__ __device__ __forceinline__ int perm32(int rho) { const int n = rho >> 4, i = rho & 15; return 8 * (i >> 2) + 4 * n + (i & 3); }

struct Unit { int pm, pn, x0, x1; };

struct TileOrder {
    int nM, nN, nwg, G, c;
    __device__ void init(int nM_, int nN_, int G_, int c_) { nM = nM_; nN = nN_; nwg = nM * nN; G = G_; c = c_; }
    __device__ bool get(int i, int& pm, int& pn) const {
        const long L = (long)i * G + c; if (L >= nwg) return false;
        int wgid = (int)L; { const int q = nwg / NXCD, r = nwg % NXCD, xcd = wgid % NXCD, off = wgid / NXCD; wgid = (xcd < r ? xcd * (q + 1) : r * (q + 1) + (xcd - r) * q) + off; }
        const int nig = WGM * nN, gid = wgid / nig, fm = gid * WGM, gsz = (nM - fm) < WGM ? (nM - fm) : WGM;
        pm = fm + ((wgid % nig) % gsz); pn = (wgid % nig) / gsz; return true;
    }
};

template <class Epi, class Sched>
__device__ __forceinline__ void gemm_phase(LAS unsigned char* lds, const int K, const Sched& S, const Epi& E) {
    int tid = threadIdx.x; asm volatile("" : "+v"(tid));
    const int wid = __builtin_amdgcn_readfirstlane(tid >> 6), lane = tid & 63, wr = wid >> 2, wc = wid & 3, fr = lane & 15, fq = lane >> 4;
    const int nt = K / BK;
    constexpr bool GA = Sched::GATHER; constexpr int KS = Sched::KSPLIT;
    unsigned voffA[2], voffB[2]; int Rst[2], Cst[2];
#pragma unroll
    for (int i = 0; i < 2; ++i) { int R, C; stage_rc(tid * 16 + i * 8192, R, C); const int Rb = Epi::PERM ? ((R & ~31) + perm32(R & 31)) : R;
        voffA[i] = (unsigned)(R * S.lda + C) * 2u; voffB[i] = (unsigned)(Rb * S.ldb + C) * 2u; Rst[i] = R; Cst[i] = C; }
    const size_t kstep = (size_t)(BK * 2);
    const size_t hstepA = (size_t)HALF * S.lda * 2, hstepB = (size_t)HALF * S.ldb * 2;
    const unsigned ldsw = (unsigned)wid * 1024u; const unsigned gmul = (unsigned)S.lda * 2u;
    const int aoff = lds_byte(wr * 64 + fr, fq * 8), boff = lds_byte(wc * 32 + fr, fq * 8);
    unsigned vAc[2], vAn[2];
#define PG8_SA(b, h) (((b) * 2 + (h)) * HTB)
#define PG8_SB(b, h) ((4 + (b) * 2 + (h)) * HTB)
#define PG8_STAGE2(bufoff, gbase, v0, v1) do { \
        __builtin_amdgcn_global_load_lds((const unsigned*)((const char*)(gbase) + (v0)), (LAS unsigned*)(lds + (bufoff) + ldsw), 16, 0, 0); \
        __builtin_amdgcn_global_load_lds((const unsigned*)((const char*)(gbase) + (v1)), (LAS unsigned*)(lds + (bufoff) + ldsw + 8192), 16, 0, 0); } while (0)
#define PG8_STAGE_B(bufoff, ptr, h) PG8_STAGE2(bufoff, (ptr) + (h) * hstepB, voffB[0], voffB[1])
#define PG8_STAGE_A(bufoff, ptr, h, nx) do { if constexpr (GA) { const unsigned _p = (nx) ? vAn[h] : vAc[h]; PG8_STAGE2(bufoff, ptr, (_p & 0xffffu) * gmul + (unsigned)Cst[0] * 2u, (_p >> 16) * gmul + (unsigned)Cst[0] * 2u); } \
        else { PG8_STAGE2(bufoff, (ptr) + (h) * hstepA, voffA[0], voffA[1]); } } while (0)
#define PG8_LDA(dst, b, h) do { _Pragma("unroll") for (int m = 0; m < 4; ++m) _Pragma("unroll") for (int k = 0; k < 2; ++k) dst[m][k] = *(const LAS bf16x8*)(lds + PG8_SA(b, h) + aoff + m * 2048 + k * 1024); } while (0)
#define PG8_LDB(dst, b, h) do { _Pragma("unroll") for (int n = 0; n < 2; ++n) _Pragma("unroll") for (int k = 0; k < 2; ++k) dst[n][k] = *(const LAS bf16x8*)(lds + PG8_SB(b, h) + boff + n * 2048 + k * 1024); } while (0)
#define PG8_MMA(ai, bj, At, Bt) do { __builtin_amdgcn_s_setprio(1); _Pragma("unroll") for (int m = 0; m < 4; ++m) _Pragma("unroll") for (int n = 0; n < 2; ++n) _Pragma("unroll") for (int k = 0; k < 2; ++k) \
        acc[ai][bj][m][n] = __builtin_amdgcn_mfma_f32_16x16x32_bf16(Bt[n][k], At[m][k], acc[ai][bj][m][n], 0, 0, 0); __builtin_amdgcn_s_setprio(0); } while (0)
#define PG8_WAIT_V(n) asm volatile("s_waitcnt vmcnt(" #n ")" ::: "memory")
#define PG8_WAIT_L(n) asm volatile("s_waitcnt lgkmcnt(" #n ")" ::: "memory")
#define PG8_BAR __builtin_amdgcn_s_barrier()
#define PG8_SCHED __builtin_amdgcn_sched_barrier(0)
#define PG8_GOFF(dst, u) do { if constexpr (GA) { _Pragma("unroll") for (int h = 0; h < 2; ++h) dst[h] = S.a_rowoff(u, Rst[0] + HALF * h) | (S.a_rowoff(u, Rst[0] + 64 + HALF * h) << 16); } } while (0)
    Unit cur, nxt; int ui = 0;
    if (!S.next(0, cur)) return;
    f32x4 acc[2][2][4][2];
#pragma unroll
    for (int a = 0; a < 2; ++a)
#pragma unroll
        for (int b = 0; b < 2; ++b)
#pragma unroll
            for (int m = 0; m < 4; ++m)
#pragma unroll
                for (int n = 0; n < 2; ++n) acc[a][b][m][n] = (f32x4){0.f, 0.f, 0.f, 0.f};
    bf16x8 At[4][2], B0[2][2], B1[2][2];
    const char* cA = S.a_base(cur); const char* cB0 = S.b_base(cur, 0); const char* cB1 = KS ? S.b_base(cur, 1) : cB0;
    PG8_GOFF(vAc, cur);
    vAn[0] = vAc[0]; vAn[1] = vAc[1];
    PG8_STAGE_B(PG8_SB(0, 0), cB0, 0); PG8_STAGE_B(PG8_SB(0, 1), cB0, 1); PG8_STAGE_A(PG8_SA(0, 0), cA, 0, false); PG8_STAGE_A(PG8_SA(0, 1), cA, 1, false);
    if (wr == 1) PG8_BAR;
    PG8_WAIT_V(2); PG8_BAR;
    PG8_STAGE_B(PG8_SB(1, 0), cB0 + kstep, 0); PG8_STAGE_A(PG8_SA(1, 0), cA + kstep, 0, false); PG8_STAGE_B(PG8_SB(1, 1), cB0 + kstep, 1);
    PG8_WAIT_V(6); PG8_BAR;
    for (;;) {
        const bool has_next = S.next(ui + 1, nxt);
        const char* nA = has_next ? S.a_base(nxt) : cA; const char* nB0 = has_next ? S.b_base(nxt, 0) : cB0; const char* nB1 = (KS && has_next) ? S.b_base(nxt, 1) : (KS ? cB1 : nB0);
        if constexpr (GA) { if (has_next) { PG8_GOFF(vAn, nxt); } }
        for (int t = 0; t < nt; t += 2) {
            const bool last = (t == nt - 2);
            const char* a1 = cA + (size_t)(t + 1) * kstep;
            const char* a2 = last ? nA : cA + (size_t)(t + 2) * kstep;
            const char* b2 = last ? nB0 : ((KS && (t + 2) >= KS) ? cB1 + (size_t)(t + 2 - KS) * kstep : cB0 + (size_t)(t + 2) * kstep);
            const char* a3 = a2 + kstep; const char* b3 = b2 + kstep;
            PG8_LDB(B0, 0, 0); PG8_LDB(B1, 0, 1); PG8_SCHED; PG8_LDA(At, 0, 0); PG8_STAGE_A(PG8_SA(1, 1), a1, 1, false);
            PG8_WAIT_V(8); PG8_WAIT_L(0); PG8_BAR; PG8_MMA(0, 0, At, B0); PG8_MMA(0, 1, At, B1); PG8_BAR; PG8_SCHED;
            PG8_LDA(At, 0, 1); PG8_STAGE_B(PG8_SB(0, 0), b2, 0); PG8_STAGE_B(PG8_SB(0, 1), b2, 1); PG8_STAGE_A(PG8_SA(0, 0), a2, 0, last);
            PG8_WAIT_V(8); PG8_WAIT_L(0); PG8_BAR; PG8_MMA(1, 0, At, B0); PG8_MMA(1, 1, At, B1); PG8_BAR; PG8_SCHED;
            PG8_LDB(B0, 1, 0); PG8_LDB(B1, 1, 1); PG8_SCHED; PG8_LDA(At, 1, 0); PG8_STAGE_A(PG8_SA(0, 1), a2, 1, last);
            PG8_WAIT_V(8); PG8_WAIT_L(0); PG8_BAR; PG8_MMA(0, 0, At, B0); PG8_MMA(0, 1, At, B1); PG8_BAR; PG8_SCHED;
            PG8_LDA(At, 1, 1); PG8_STAGE_B(PG8_SB(1, 0), b3, 0); PG8_STAGE_B(PG8_SB(1, 1), b3, 1); PG8_STAGE_A(PG8_SA(1, 0), a3, 0, last);
            PG8_WAIT_V(8); PG8_WAIT_L(0); PG8_BAR; PG8_MMA(1, 0, At, B0); PG8_MMA(1, 1, At, B1); PG8_BAR; PG8_SCHED;
        }
        if (wr == 0) PG8_BAR;
        E(acc, cur, wr, wc, fr, fq);
        if (!has_next) break;
#pragma unroll
        for (int a = 0; a < 2; ++a)
#pragma unroll
            for (int b = 0; b < 2; ++b)
#pragma unroll
                for (int m = 0; m < 4; ++m)
#pragma unroll
                    for (int n = 0; n < 2; ++n) acc[a][b][m][n] = (f32x4){0.f, 0.f, 0.f, 0.f};
        cur = nxt; cA = nA; cB0 = nB0; cB1 = nB1; ++ui;
        vAc[0] = vAn[0]; vAc[1] = vAn[1];
        if (wr == 1) PG8_BAR;
    }
    PG8_WAIT_V(0);
    PG8_BAR;
#undef PG8_SA
#undef PG8_SB
#undef PG8_STAGE2
#undef PG8_STAGE_A
#undef PG8_STAGE_B
#undef PG8_LDA
#undef PG8_LDB
#undef PG8_MMA
#undef PG8_WAIT_V
#undef PG8_WAIT_L
#undef PG8_BAR
#undef PG8_SCHED
#undef PG8_GOFF
}
}
using pg8::Unit;

DI unsigned cvt_pk_bf16(float lo, float hi) { unsigned r; asm volatile("v_cvt_pk_bf16_f32 %0, %1, %2" : "=v"(r) : "v"(lo), "v"(hi)); return r; }

struct Args {
    const float* x; const float* c; const int* pos; const float* ada_w; const float* ada_b; const float* nmw; const float* nfw; const float* w_in;
    const float* b_ig; const float* b_fg; const float* qnw; const float* knw; const float* sinks; const float* conv_w; const float* conv_b; const float* mnw;
    const float* w_au; const float* w_mu; const float* w_out; const float* router_w; const float* router_b; const float* w_gate; const float* w_up; const float* w_down;
    float* out; unsigned char* ws; int ph_lo, ph_hi;
};

__constant__ float c_invf[8] = {1.0f, 0.1939227432012558f, 0.03760603070259094f, 0.007292664609849453f, 0.0014142135623842478f, 0.00027424818836152554f, 5.3182957344688475e-05f, 1.0313385246263351e-05f};

struct DenseSched {
    static constexpr bool GATHER = false; static constexpr int KSPLIT = 0;
    const char* A; const char* Bt; int lda, ldb; pg8::TileOrder ord;
    DI bool next(int i, Unit& u) const { int pm, pn; if (!ord.get(i, pm, pn)) return false; u.pm = pm; u.pn = pn; u.x0 = 0; u.x1 = 0; return true; }
    DI const char* a_base(const Unit& u) const { return A + (size_t)u.pm * 256 * lda * 2; }
    DI const char* b_base(const Unit& u, int) const { return Bt + (size_t)u.pn * 256 * ldb * 2; }
    DI unsigned a_rowoff(const Unit&, int) const { return 0u; }
};
struct EpiProj {
    static constexpr bool PERM = true;
    bf16* O;
    DI void operator()(const f32x4 (&acc)[2][2][4][2], const Unit& u, int wr, int wc, int fr, int fq) const {
        const int row0 = u.pm * 256 + wr * 64 + fr, col0 = u.pn * 256 + wc * 32 + 8 * fq; const bool sg = u.pn >= 9;
#pragma unroll
        for (int ai = 0; ai < 2; ++ai)
#pragma unroll
            for (int m = 0; m < 4; ++m) { bf16* rowp = O + (size_t)(row0 + ai * 128 + m * 16) * NPROJ + col0;
#pragma unroll
                for (int bj = 0; bj < 2; ++bj) { f32x4 v0 = acc[ai][bj][m][0], v1 = acc[ai][bj][m][1];
                    if (sg) {
#pragma unroll
                        for (int j = 0; j < 4; ++j) { v0[j] = sigmoidf_(v0[j]); v1[j] = sigmoidf_(v1[j]); } }
                    v4u w; w.x = cvt_pk_bf16(v0[0], v0[1]); w.y = cvt_pk_bf16(v0[2], v0[3]); w.z = cvt_pk_bf16(v1[0], v1[1]); w.w = cvt_pk_bf16(v1[2], v1[3]);
                    *(v4u*)(rowp + bj * 128) = w; } }
    }
};
template <bool ADD> struct EpiGate {
    static constexpr bool PERM = true;
    bf16* P; int gcol;
    DI void operator()(const f32x4 (&acc)[2][2][4][2], const Unit& u, int wr, int wc, int fr, int fq) const {
        const int row0 = u.pm * 256 + wr * 64 + fr, col0 = u.pn * 256 + wc * 32 + 8 * fq;
#pragma unroll
        for (int ai = 0; ai < 2; ++ai)
#pragma unroll
            for (int m = 0; m < 4; ++m) { bf16* rowp = P + (size_t)(row0 + ai * 128 + m * 16) * NPROJ + col0;
#pragma unroll
                for (int bj = 0; bj < 2; ++bj) { const f32x4 v0 = acc[ai][bj][m][0], v1 = acc[ai][bj][m][1];
                    const v4u g = *(const v4u*)(rowp + gcol + bj * 128);
                    float o[8] = {bflo(g.x) * v0[0], bfhi(g.x) * v0[1], bflo(g.y) * v0[2], bfhi(g.y) * v0[3], bflo(g.z) * v1[0], bfhi(g.z) * v1[1], bflo(g.w) * v1[2], bfhi(g.w) * v1[3]};
                    if (ADD) { const v4u p = *(const v4u*)(rowp + C_MQ + bj * 128);
                        o[0] += bflo(p.x); o[1] += bfhi(p.x); o[2] += bflo(p.y); o[3] += bfhi(p.y); o[4] += bflo(p.z); o[5] += bfhi(p.z); o[6] += bflo(p.w); o[7] += bfhi(p.w); }
                    v4u w; w.x = cvt_pk_bf16(o[0], o[1]); w.y = cvt_pk_bf16(o[2], o[3]); w.z = cvt_pk_bf16(o[4], o[5]); w.w = cvt_pk_bf16(o[6], o[7]);
                    *(v4u*)(rowp + C_MQ + bj * 128) = w; } }
    }
};
struct EpiRes {
    static constexpr bool PERM = false;
    const float* xin; float* out; const float* g;
    DI void operator()(const f32x4 (&acc)[2][2][4][2], const Unit& u, int wr, int wc, int fr, int fq) const {
        const int row0 = u.pm * 256 + wr * 64 + fr, col0 = u.pn * 256 + wc * 32 + 4 * fq; const int b = (u.pm * 256) >> 14;
        f32x4 gv[2][2];
#pragma unroll
        for (int bj = 0; bj < 2; ++bj)
#pragma unroll
            for (int n = 0; n < 2; ++n) gv[bj][n] = *(const f32x4*)(g + b * 6144 + col0 + bj * 128 + n * 16);
#pragma unroll
        for (int ai = 0; ai < 2; ++ai)
#pragma unroll
            for (int m = 0; m < 4; ++m) { const size_t off = (size_t)(row0 + ai * 128 + m * 16) * D + col0;
#pragma unroll
                for (int bj = 0; bj < 2; ++bj)
#pragma unroll
                    for (int n = 0; n < 2; ++n) { const f32x4 xv = *(const f32x4*)(xin + off + bj * 128 + n * 16);
                        *(f32x4*)(out + off + bj * 128 + n * 16) = xv + gv[bj][n] * acc[ai][bj][m][n]; } }
    }
};

struct MoeTab { const LAS int* tcls; const LAS int* tpos; const LAS int* cnt; int Rtot; };
DI void cls_experts(int cls, int& ea, int& eb) { const int g = cls / 6, p = cls - 6 * g; const int a = (p < 3) ? 0 : ((p < 5) ? 1 : 2); const int b = (p < 3) ? (p + 1) : ((p < 5) ? (p - 1) : 3); ea = 4 * g + a; eb = 4 * g + b; }
struct MoeUpSched {
    static constexpr bool GATHER = true; static constexpr int KSPLIT = 0;
    const char* A; const char* W; int lda, ldb; MoeTab tb; int G, c; const LAS unsigned* tokoff;
    DI bool next(int i, Unit& u) const { const int L = i * G + c; if (L >= tb.Rtot * 8) return false; u.pm = L >> 3; u.pn = L & 7; u.x0 = i; u.x1 = __builtin_amdgcn_readfirstlane(tb.tcls[u.pm]); return true; }
    DI const char* a_base(const Unit&) const { return A; }
    DI const char* b_base(const Unit& u, int) const { int ea, eb; cls_experts(u.x1, ea, eb); const int e = (u.pn < 4) ? ea : eb; return W + ((size_t)e * 1024 + (size_t)(u.pn & 3) * 256) * 1024 * 2; }
    DI unsigned a_rowoff(const Unit& u, int r) const { return tokoff[u.x0 * 256 + r]; }
};
struct EpiSwiglu {
    static constexpr bool PERM = true;
    bf16* H; const float* tgate; const LAS unsigned* tokoff;
    DI void operator()(const f32x4 (&acc)[2][2][4][2], const Unit& u, int wr, int wc, int fr, int fq) const {
        const int r0 = wr * 64 + fr; const int hc = (u.pn >> 2) * 512 + (u.pn & 3) * 128 + wc * 32 + 8 * fq; const int gsel = u.pn >> 2;
#pragma unroll
        for (int ai = 0; ai < 2; ++ai)
#pragma unroll
            for (int m = 0; m < 4; ++m) { const int r = r0 + ai * 128 + m * 16; const unsigned tok = tokoff[u.x0 * 256 + r]; const float rg = tgate[tok * 2 + gsel];
                const f32x4 g0 = acc[ai][0][m][0], g1 = acc[ai][0][m][1], u0 = acc[ai][1][m][0], u1 = acc[ai][1][m][1];
                float o[8];
#pragma unroll
                for (int j = 0; j < 4; ++j) { o[j] = g0[j] * sigmoidf_(g0[j]) * u0[j] * rg; o[4 + j] = g1[j] * sigmoidf_(g1[j]) * u1[j] * rg; }
                v4u w; w.x = cvt_pk_bf16(o[0], o[1]); w.y = cvt_pk_bf16(o[2], o[3]); w.z = cvt_pk_bf16(o[4], o[5]); w.w = cvt_pk_bf16(o[6], o[7]);
                *(v4u*)(H + ((size_t)u.pm * 256 + r) * 1024 + hc) = w; }
    }
};
struct MoeDownSched {
    static constexpr bool GATHER = false; static constexpr int KSPLIT = 8;
    const char* A; const char* W; int lda, ldb; MoeTab tb; int G, c;
    DI bool next(int i, Unit& u) const { const int L = i * G + c; if (L >= tb.Rtot * 4) return false; u.pm = L >> 2; u.pn = L & 3; u.x0 = __builtin_amdgcn_readfirstlane(tb.tpos[u.pm]); u.x1 = __builtin_amdgcn_readfirstlane(tb.tcls[u.pm]); return true; }
    DI const char* a_base(const Unit& u) const { return A + (size_t)u.pm * 256 * lda * 2; }
    DI const char* b_base(const Unit& u, int half) const { int ea, eb; cls_experts(u.x1, ea, eb); const int e = half ? eb : ea; return W + ((size_t)e * 1024 + (size_t)u.pn * 256) * 512 * 2; }
    DI unsigned a_rowoff(const Unit&, int) const { return 0u; }
};
struct EpiMoeOut {
    static constexpr bool PERM = false;
    float* out; const float* g; const int* tokl; MoeTab tb;
    DI void operator()(const f32x4 (&acc)[2][2][4][2], const Unit& u, int wr, int wc, int fr, int fq) const {
        const int r0 = wr * 64 + fr, col0 = u.pn * 256 + wc * 32 + 4 * fq; const int cn = tb.cnt[u.x1];
#pragma unroll
        for (int ai = 0; ai < 2; ++ai)
#pragma unroll
            for (int m = 0; m < 4; ++m) { const int pos = u.x0 + r0 + ai * 128 + m * 16;
                if (pos < cn) { const int tok = tokl[u.x1 * CLS_CAP + pos]; const int b = tok >> 14; float* op = out + (size_t)tok * D + col0; const float* gp = g + b * 6144 + col0;
#pragma unroll
                    for (int bj = 0; bj < 2; ++bj)
#pragma unroll
                        for (int n = 0; n < 2; ++n) { const f32x4 xv = *(const f32x4*)(op + bj * 128 + n * 16); const f32x4 gv = *(const f32x4*)(gp + bj * 128 + n * 16);
                            *(f32x4*)(op + bj * 128 + n * 16) = xv + gv * acc[ai][bj][m][n]; } } }
    }
};

struct Ctx { LAS unsigned char* lds; int tid, lane, wave, G, bid; };
DI Ctx fresh(const Ctx& X) { Ctx P = X; int t = X.tid; asm volatile("" : "+v"(t)); P.tid = t; P.lane = t & 63; P.wave = __builtin_amdgcn_readfirstlane(t >> 6); return P; }

DI void tr_item(const float* W, int ldw, int K, bf16* WT, int k0, LAS float* scr, int lane) {
#pragma unroll 8
    for (int i = 0; i < 32; ++i) { const int kk = 2 * i + (lane >> 5); scr[kk * 33 + (lane & 31)] = W[(size_t)(k0 + kk) * ldw + (lane & 31)]; }
    LDS_WAIT(); asm volatile("" ::: "memory");
    const int c = lane & 7;
#pragma unroll
    for (int j = 0; j < 4; ++j) { const int n = (lane >> 3) + 8 * j; const LAS float* s = scr + (8 * c) * 33 + n;
        v4u o; o.x = pk2(s[0 * 33], s[1 * 33]); o.y = pk2(s[2 * 33], s[3 * 33]); o.z = pk2(s[4 * 33], s[5 * 33]); o.w = pk2(s[6 * 33], s[7 * 33]);
        *(v4u*)(WT + (size_t)n * K + k0 + 8 * c) = o; }
    LDS_WAIT(); asm volatile("" ::: "memory");
}
DI void p0_prologue(const Args& a, const Ctx& X) {
    unsigned char* ws = a.ws;
    LAS float* scr = (LAS float*)(X.lds + X.wave * 16384);
    const int gw = X.bid * 8 + X.wave, NGW = X.G * 8;
    constexpr int IT_WIN = 16 * 152, IT_AU = 8 * 32, IT_OUT = 16 * 32, IT_GU = 16 * 16 * 32, IT_DN = 16 * 8 * 32;
    constexpr int IT_L = IT_WIN + 2 * IT_AU + IT_OUT + IT_GU + IT_DN;
    for (int it = gw; it < NL * IT_L; it += NGW) {
        const int l = it / IT_L; int r = it - l * IT_L;
        if (r < IT_WIN) { const int kb = r / 152, nb = r - kb * 152, d0 = 32 * nb, s0 = d0 + (d0 >= 2304 ? 8 : 0);
            tr_item(a.w_in + (size_t)l * D * DIN_SRC + s0, DIN_SRC, D, (bf16*)(ws + WS_WIN) + ((size_t)l * NPROJ + d0) * D, 64 * kb, scr, X.lane); continue; }
        r -= IT_WIN;
        if (r < IT_AU) { const int kb = r >> 5, nb = r & 31;
            tr_item(a.w_au + (size_t)l * 512 * D + 32 * nb, D, 512, (bf16*)(ws + WS_WAU) + ((size_t)l * D + 32 * nb) * 512, 64 * kb, scr, X.lane); continue; }
        r -= IT_AU;
        if (r < IT_AU) { const int kb = r >> 5, nb = r & 31;
            tr_item(a.w_mu + (size_t)l * 512 * D + 32 * nb, D, 512, (bf16*)(ws + WS_WMU) + ((size_t)l * D + 32 * nb) * 512, 64 * kb, scr, X.lane); continue; }
        r -= IT_AU;
        if (r < IT_OUT) { const int kb = r >> 5, nb = r & 31;
            tr_item(a.w_out + (size_t)l * D * D + 32 * nb, D, D, (bf16*)(ws + WS_WOUT) + ((size_t)l * D + 32 * nb) * D, 64 * kb, scr, X.lane); continue; }
        r -= IT_OUT;
        if (r < IT_GU) { const int e = r >> 9, q = r & 511, kb = q >> 5, nb = q & 31, tq = nb >> 3, rb = nb & 7;
            const float* src = ((rb < 4) ? a.w_gate : a.w_up) + ((size_t)(l * NE + e) * D) * FF + 128 * tq + 32 * (rb & 3);
            tr_item(src, FF, D, (bf16*)(ws + WS_WGU) + ((size_t)(l * NE + e) * 1024 + 32 * nb) * D, 64 * kb, scr, X.lane); continue; }
        r -= IT_GU;
        { const int e = r >> 8, q = r & 255, kb = q >> 5, nb = q & 31;
            tr_item(a.w_down + ((size_t)(l * NE + e) * FF) * D + 32 * nb, D, FF, (bf16*)(ws + WS_WD) + ((size_t)(l * NE + e) * 1024 + 32 * nb) * FF, 64 * kb, scr, X.lane); }
    }
    { float* cs = (float*)(ws + WS_ROPE); float* sn = cs + (size_t)T * 8;
      for (int i = X.bid * 512 + X.tid; i < T * 8; i += X.G * 512) { const int tok = i >> 3, f = i & 7; const float angf = (float)a.pos[tok] * c_invf[f];
          double rev = (double)angf * 0.15915494309189535; rev -= rint(rev); const float rf = (float)rev;
          cs[i] = __builtin_amdgcn_cosf(rf); sn[i] = __builtin_amdgcn_sinf(rf); } }
    __syncthreads();
    LAS float* cact = (LAS float*)X.lds; LAS float* red = (LAS float*)(X.lds + 8192);
    for (int i = X.tid; i < 2048; i += 512) { const float cv = a.c[i]; cact[i] = cv / (1.0f + __expf(-cv)); }
    __syncthreads();
    float* mod = (float*)(ws + WS_MOD);
    for (int it = X.bid; it < NL * 96; it += X.G) { const int l = it / 96, cg = it - l * 96; const int col = cg * 64 + X.lane;
        const float* w = a.ada_w + (size_t)l * D * 6144 + col; float s0 = 0.f, s1 = 0.f;
#pragma unroll 8
        for (int kk = 0; kk < 128; ++kk) { const int k = X.wave * 128 + kk; const float wv = w[(size_t)k * 6144]; s0 += cact[k] * wv; s1 += cact[1024 + k] * wv; }
        red[(X.wave * 2 + 0) * 64 + X.lane] = s0; red[(X.wave * 2 + 1) * 64 + X.lane] = s1;
        __syncthreads();
        if (X.tid < 128) { const int b = X.tid >> 6, ln = X.tid & 63; float s = 0.f;
#pragma unroll
            for (int w8 = 0; w8 < 8; ++w8) s += red[(w8 * 2 + b) * 64 + ln];
            mod[(size_t)(l * 2 + b) * 6144 + cg * 64 + ln] = s + a.ada_b[l * 6144 + cg * 64 + ln]; }
        __syncthreads();
    }
}

DI void p1_norm_gates(const Args& a, const Ctx& X, int l, const float* xin) {
    unsigned char* ws = a.ws;
    LAS float* gwl = (LAS float*)X.lds;
    for (int idx = X.tid; idx < 8192; idx += 512) { const int k = idx >> 3, g = idx & 7; gwl[g * 1024 + k] = a.w_in[(size_t)l * D * DIN_SRC + (size_t)k * DIN_SRC + 2304 + g]; }
    __syncthreads();
    const float* mod = (const float*)(ws + WS_MOD); bf16* hb = (bf16*)(ws + WS_H); float* gates = (float*)(ws + WS_GATES);
    const int gw = X.bid * 8 + X.wave, NGW = X.G * 8;
    for (int rg = gw; rg < T / 16; rg += NGW) {
        const int row0 = rg * 16, b = row0 >> 14;
        const float* mb = mod + (size_t)(l * 2 + b) * 6144;
        f32x4 aw[4], sh[4];
#pragma unroll
        for (int j = 0; j < 4; ++j) { const int k = 256 * j + 4 * X.lane; const f32x4 nw = *(const f32x4*)(a.nmw + l * D + k); const f32x4 sc = *(const f32x4*)(mb + 1024 + k); aw[j] = nw * (sc + 1.0f); sh[j] = *(const f32x4*)(mb + k); }
#pragma unroll 1
        for (int r = 0; r < 16; ++r) { const int row = row0 + r;
            const f32x4* xr = (const f32x4*)(xin + (size_t)row * D) + X.lane; f32x4 v[4]; float ss = 0.f;
#pragma unroll
            for (int j = 0; j < 4; ++j) { v[j] = xr[64 * j]; ss += (v[j].x * v[j].x + v[j].y * v[j].y) + (v[j].z * v[j].z + v[j].w * v[j].w); }
            ss = wave_sum(ss); const float rstd = 1.0f / sqrtf(ss * (1.0f / D) + EPS);
            unsigned long long* o8 = (unsigned long long*)(hb + (size_t)row * D) + X.lane;
#pragma unroll
            for (int j = 0; j < 4; ++j) { v[j] = v[j] * rstd * aw[j] + sh[j]; o8[64 * j] = (unsigned long long)pk2(v[j].x, v[j].y) | ((unsigned long long)pk2(v[j].z, v[j].w) << 32); }
            float gp[8];
#pragma unroll
            for (int g = 0; g < 8; ++g) { float p = 0.f;
#pragma unroll
                for (int j = 0; j < 4; ++j) { const f32x4 w = *(const LAS f32x4*)(gwl + g * 1024 + 256 * j + 4 * X.lane); p += (v[j].x * w.x + v[j].y * w.y) + (v[j].z * w.z + v[j].w * w.w); }
                gp[g] = wave_sum(p); }
            if (X.lane == 0) {
#pragma unroll
                for (int g = 0; g < 4; ++g) { gates[(size_t)row * 8 + g] = gp[g] + a.b_ig[l * 4 + g];
                    const float z = gp[4 + g] + a.b_fg[l * 4 + g]; gates[(size_t)row * 8 + 4 + g] = fminf(z, 0.f) - log1pf(__expf(-fabsf(z))); } }
        }
    }
}

DI void attn_unit(const Args& a, const Ctx& X, int l, int unit) {
    unsigned char* ws = a.ws; const bf16* proj = (const bf16*)(ws + WS_PROJ); bf16* ao = (bf16*)(ws + WS_H);
    const float* cs = (const float*)(ws + WS_ROPE); const float* sn = cs + (size_t)T * 8;
    const int b = unit >> 8, rem = unit & 255, nb = rem >> 1, kvh = rem & 1; const int tok0 = b * SEQ + nb * 128;
    LAS bf16* Kl = (LAS bf16*)X.lds;
    LAS bf16* VT = (LAS bf16*)(X.lds + 36864);
    int lane = X.lane; asm volatile("" : "+v"(lane));
    const int c16 = lane & 15, quad = lane >> 4;
    {
        const int row = X.tid >> 1, half = X.tid & 1; const int tokk = tok0 - 128 + row; const bool valid = (nb > 0) || (row >= 128);
        float y[32]; float vv[32];
        if (valid) {
            const v4u* kp = (const v4u*)(proj + (size_t)tokk * NPROJ + C_AK + kvh * 64 + half * 32); const v4u* vp = (const v4u*)(proj + (size_t)tokk * NPROJ + C_AV + kvh * 64 + half * 32);
#pragma unroll
            for (int q = 0; q < 4; ++q) { const v4u kw = kp[q], vw = vp[q];
                y[8 * q + 0] = bflo(kw.x); y[8 * q + 1] = bfhi(kw.x); y[8 * q + 2] = bflo(kw.y); y[8 * q + 3] = bfhi(kw.y); y[8 * q + 4] = bflo(kw.z); y[8 * q + 5] = bfhi(kw.z); y[8 * q + 6] = bflo(kw.w); y[8 * q + 7] = bfhi(kw.w);
                vv[8 * q + 0] = bflo(vw.x); vv[8 * q + 1] = bfhi(vw.x); vv[8 * q + 2] = bflo(vw.y); vv[8 * q + 3] = bfhi(vw.y); vv[8 * q + 4] = bflo(vw.z); vv[8 * q + 5] = bfhi(vw.z); vv[8 * q + 6] = bflo(vw.w); vv[8 * q + 7] = bfhi(vw.w); }
        } else {
#pragma unroll
            for (int i = 0; i < 32; ++i) { y[i] = 0.f; vv[i] = 0.f; } }
        float ss = 0.f;
#pragma unroll
        for (int i = 0; i < 32; ++i) ss += y[i] * y[i];
        ss += __shfl_xor(ss, 1); const float rstd = 1.0f / sqrtf(ss * (1.0f / 64.0f) + EPS);
#pragma unroll
        for (int i = 0; i < 32; ++i) y[i] = y[i] * rstd * a.knw[l * 64 + half * 32 + i];
        if (half == 0 && valid) {
#pragma unroll
            for (int d = 0; d < 8; ++d) { const float c = cs[(size_t)tokk * 8 + d], s = sn[(size_t)tokk * 8 + d]; const float t1 = y[d], t2 = y[d + 8]; y[d] = t1 * c - t2 * s; y[d + 8] = t2 * c + t1 * s; } }
#pragma unroll
        for (int q = 0; q < 4; ++q) { v4u w; w.x = pk2(y[8 * q], y[8 * q + 1]); w.y = pk2(y[8 * q + 2], y[8 * q + 3]); w.z = pk2(y[8 * q + 4], y[8 * q + 5]); w.w = pk2(y[8 * q + 6], y[8 * q + 7]);
            *(LAS v4u*)(Kl + row * 72 + half * 32 + 8 * q) = w; }
#pragma unroll
        for (int i = 0; i < 32; ++i) VT[(half * 32 + i) * 280 + row] = (bf16)f2bf(vv[i]);
        if (X.tid < 64) {
#pragma unroll
            for (int cc = 256; cc < 280; ++cc) VT[X.tid * 280 + cc] = 0; }
    }
    __syncthreads();
#pragma unroll 1
    for (int task = X.wave; task < 32; task += 8) {
        const int g = task >> 3, rg = task & 7, r0 = 16 * rg, head = kvh * 4 + g; const int tokq = tok0 + r0 + c16;
        const float sink = a.sinks[l * 8 + head];
        float qv[16];
        { const bf16* qp = proj + (size_t)tokq * NPROJ + C_AQ + head * 64; const v4u w0 = *(const v4u*)(qp + 8 * quad), w1 = *(const v4u*)(qp + 32 + 8 * quad);
          qv[0] = bflo(w0.x); qv[1] = bfhi(w0.x); qv[2] = bflo(w0.y); qv[3] = bfhi(w0.y); qv[4] = bflo(w0.z); qv[5] = bfhi(w0.z); qv[6] = bflo(w0.w); qv[7] = bfhi(w0.w);
          qv[8] = bflo(w1.x); qv[9] = bfhi(w1.x); qv[10] = bflo(w1.y); qv[11] = bfhi(w1.y); qv[12] = bflo(w1.z); qv[13] = bfhi(w1.z); qv[14] = bflo(w1.w); qv[15] = bfhi(w1.w); }
        float ss = 0.f;
#pragma unroll
        for (int i = 0; i < 16; ++i) ss += qv[i] * qv[i];
        ss += __shfl_xor(ss, 16); ss += __shfl_xor(ss, 32); const float rstd = 1.0f / sqrtf(ss * (1.0f / 64.0f) + EPS);
#pragma unroll
        for (int i = 0; i < 8; ++i) { qv[i] = qv[i] * rstd * a.qnw[l * 64 + 8 * quad + i]; qv[8 + i] = qv[8 + i] * rstd * a.qnw[l * 64 + 32 + 8 * quad + i]; }
#pragma unroll
        for (int d = 0; d < 8; ++d) { const float other = __shfl_xor(qv[d], 16); const float c = cs[(size_t)tokq * 8 + d], s = sn[(size_t)tokq * 8 + d];
            if (quad == 0) qv[d] = qv[d] * c - other * s; else if (quad == 1) qv[d] = qv[d] * c + other * s; }
        bf16x8 qf[2];
        { v4u w; w.x = pk2(qv[0], qv[1]); w.y = pk2(qv[2], qv[3]); w.z = pk2(qv[4], qv[5]); w.w = pk2(qv[6], qv[7]); qf[0] = __builtin_bit_cast(bf16x8, w);
          w.x = pk2(qv[8], qv[9]); w.y = pk2(qv[10], qv[11]); w.z = pk2(qv[12], qv[13]); w.w = pk2(qv[14], qv[15]); qf[1] = __builtin_bit_cast(bf16x8, w); }
        f32x4 sacc[9];
#pragma unroll
        for (int i = 0; i < 9; ++i) { const LAS bf16* kr = Kl + (16 * (rg + i) + c16) * 72 + 8 * quad;
            const bf16x8 k0 = *(const LAS bf16x8*)kr, k1 = *(const LAS bf16x8*)(kr + 32);
            f32x4 z = {0.f, 0.f, 0.f, 0.f}; z = __builtin_amdgcn_mfma_f32_16x16x32_bf16(k0, qf[0], z, 0, 0, 0); sacc[i] = __builtin_amdgcn_mfma_f32_16x16x32_bf16(k1, qf[1], z, 0, 0, 0); }
        int dbase = 4 * quad - c16; asm volatile("" : "+v"(dbase)); int kbase = 16 * rg + 4 * quad; asm volatile("" : "+v"(kbase)); float mx = sink;
#pragma unroll
        for (int i = 0; i < 9; ++i)
#pragma unroll
            for (int j = 0; j < 4; ++j) { const int dlt = dbase + 16 * i + j; const int kj = kbase + 16 * i + j; const bool ok = (dlt > 0) && (dlt <= 128) && ((nb > 0) || (kj >= 128));
                const float s = ok ? sacc[i][j] * 0.125f : -3.0e38f; sacc[i][j] = s; mx = fmaxf(mx, s); }
        mx = fmaxf(mx, __shfl_xor(mx, 16)); mx = fmaxf(mx, __shfl_xor(mx, 32));
        float sum = 0.f;
#pragma unroll
        for (int i = 0; i < 9; ++i)
#pragma unroll
            for (int j = 0; j < 4; ++j) { const float p = (sacc[i][j] > -1.0e38f) ? __expf(sacc[i][j] - mx) : 0.f; sacc[i][j] = p; sum += p; }
        sum += __shfl_xor(sum, 16); sum += __shfl_xor(sum, 32);
        const float inv = 1.0f / (sum + __expf(sink - mx));
        f32x4 oacc[4];
#pragma unroll
        for (int et = 0; et < 4; ++et) oacc[et] = (f32x4){0.f, 0.f, 0.f, 0.f};
#pragma unroll
        for (int kk = 0; kk < 5; ++kk) {
            v4u pw; pw.x = pk2(sacc[2 * kk][0], sacc[2 * kk][1]); pw.y = pk2(sacc[2 * kk][2], sacc[2 * kk][3]);
            if (2 * kk + 1 < 9) { pw.z = pk2(sacc[(2 * kk + 1 < 9) ? 2 * kk + 1 : 0][0], sacc[(2 * kk + 1 < 9) ? 2 * kk + 1 : 0][1]); pw.w = pk2(sacc[(2 * kk + 1 < 9) ? 2 * kk + 1 : 0][2], sacc[(2 * kk + 1 < 9) ? 2 * kk + 1 : 0][3]); } else { pw.z = 0u; pw.w = 0u; }
            const bf16x8 pf = __builtin_bit_cast(bf16x8, pw);
#pragma unroll
            for (int et = 0; et < 4; ++et) { const LAS bf16* vr = VT + (16 * et + c16) * 280 + 16 * rg + 32 * kk + 4 * quad;
                const v2u lo = *(const LAS v2u*)vr, hi = *(const LAS v2u*)(vr + 16); v4u vw; vw.x = lo.x; vw.y = lo.y; vw.z = hi.x; vw.w = hi.y;
                oacc[et] = __builtin_amdgcn_mfma_f32_16x16x32_bf16(__builtin_bit_cast(bf16x8, vw), pf, oacc[et], 0, 0, 0); }
        }
#pragma unroll
        for (int et = 0; et < 4; ++et) { v2u w; w.x = pk2(oacc[et][0] * inv, oacc[et][1] * inv); w.y = pk2(oacc[et][2] * inv, oacc[et][3] * inv);
            *(v2u*)(ao + (size_t)tokq * 512 + head * 64 + 16 * et + 4 * quad) = w; }
    }
    __syncthreads();
}

constexpr int ML_Q = 0, ML_K = 17408, ML_KET = 34816, ML_VT = 53248, ML_CT = 73984, ML_CW = 113152, ML_CB = 118272, ML_RED = 118784, ML_NW = 119296;
template <bool L3> DI void mlstm_unit(const Args& a, const Ctx& X, int l, int unit) {
    unsigned char* ws = a.ws; const bf16* proj = (const bf16*)(ws + WS_PROJ); bf16* hm = (bf16*)(ws + WS_H) + (size_t)T * 512;
    const float* gates = (const float*)(ws + WS_GATES); float* mlc = (float*)(ws + WS_MLC) + (size_t)unit * 18432; float* mlb = (float*)(ws + WS_MLB);
    const int seq = unit >> 5, sj = unit & 31, b = seq >> 2, hh = seq & 3; const int tokbase = b * SEQ + sj * 512;
    LAS bf16* Qs = (LAS bf16*)(X.lds + ML_Q); LAS bf16* Ks = (LAS bf16*)(X.lds + ML_K); LAS bf16* KET = (LAS bf16*)(X.lds + ML_KET);
    LAS bf16* VT = (LAS bf16*)(X.lds + ML_VT); LAS bf16* CT = (LAS bf16*)(X.lds + ML_CT); LAS float* CW = (LAS float*)(X.lds + ML_CW);
    LAS float* CB = (LAS float*)(X.lds + ML_CB); LAS float* RED = (LAS float*)(X.lds + ML_RED); LAS float* NW = (LAS float*)(X.lds + ML_NW);
    int lane = X.lane; asm volatile("" : "+v"(lane));
    const int c16 = lane & 15, quad = lane >> 4, w = X.wave;
    for (int idx = X.tid; idx < 1280; idx += 512) { const int tap = idx >> 8, ch = idx & 255; const int gch = (ch < 128) ? (hh * 128 + ch) : (512 + hh * 128 + (ch - 128));
        CW[idx] = (tap < 4) ? a.conv_w[(size_t)(l * 4 + tap) * 1024 + gch] : a.conv_b[l * 1024 + gch]; }
    for (int idx = X.tid; idx < 16 * 72; idx += 512) VT[128 * 72 + idx] = (idx < 72) ? (bf16)0x3F80 : (bf16)0;
    if (X.tid < 128) NW[X.tid] = a.mnw[l * 512 + hh * 128 + X.tid];
    f32x4 cacc[9];
#pragma unroll
    for (int et = 0; et < 9; ++et) {
        if (L3) {
#pragma unroll
            for (int j = 0; j < 4; ++j) { const float v = mlc[(16 * et + 4 * quad + j) * 128 + 16 * w + c16]; cacc[et][j] = v; CT[(16 * et + 4 * quad + j) * 136 + 16 * w + c16] = (bf16)f2bf(v); }
        } else cacc[et] = (f32x4){0.f, 0.f, 0.f, 0.f};
    }
    float bsum = 0.f;
    __syncthreads();
#pragma unroll 1
    for (int c = 0; c < 8; ++c) {
        const int tok0 = tokbase + c * 64;
        float bsc = gates[(size_t)(tok0 + lane) * 8 + 4 + hh]; const float li = gates[(size_t)(tok0 + lane) * 8 + hh];
#pragma unroll
        for (int o = 1; o < 64; o <<= 1) { const float v = __shfl_up(bsc, o); if (lane >= o) bsc += v; }
        const float bl = __shfl(bsc, 63); const float csv = li - bsc;
        if (w == 0) { CB[lane] = bsc; CB[64 + lane] = csv; }
        bsum += bl;
        { const int t = X.tid >> 3, dc = X.tid & 7; const float fac = __expf(bl + __shfl(csv, t));
          const int tokt = tok0 + t;
#pragma unroll
          for (int qk = (L3 ? 0 : 1); qk < 2; ++qk) {
              float accv[16];
#pragma unroll
              for (int i = 0; i < 16; ++i) accv[i] = CW[4 * 256 + qk * 128 + 16 * dc + i];
#pragma unroll
              for (int j = 0; j < 4; ++j) { const int tt = tokt - 3 + j;
                  if (tt >= b * SEQ) { const v4u* p = (const v4u*)(proj + (size_t)tt * NPROJ + (qk ? C_MK : C_MQ) + hh * 128 + 16 * dc); const v4u w0 = p[0], w1 = p[1];
                      const float xv[16] = {bflo(w0.x), bfhi(w0.x), bflo(w0.y), bfhi(w0.y), bflo(w0.z), bfhi(w0.z), bflo(w0.w), bfhi(w0.w), bflo(w1.x), bfhi(w1.x), bflo(w1.y), bfhi(w1.y), bflo(w1.z), bfhi(w1.z), bflo(w1.w), bfhi(w1.w)};
#pragma unroll
                      for (int i = 0; i < 16; ++i) accv[i] += CW[j * 256 + qk * 128 + 16 * dc + i] * xv[i]; } }
#pragma unroll
              for (int i = 0; i < 16; ++i) { const float z = accv[i]; accv[i] = z / (1.0f + __expf(-z)) * (qk ? 0.08838834764831845f : 1.0f); }
              if (L3) { LAS bf16* dst = (qk ? Ks : Qs) + t * 136 + 16 * dc;
                  v4u o0, o1; o0.x = pk2(accv[0], accv[1]); o0.y = pk2(accv[2], accv[3]); o0.z = pk2(accv[4], accv[5]); o0.w = pk2(accv[6], accv[7]);
                  o1.x = pk2(accv[8], accv[9]); o1.y = pk2(accv[10], accv[11]); o1.z = pk2(accv[12], accv[13]); o1.w = pk2(accv[14], accv[15]);
                  *(LAS v4u*)dst = o0; *(LAS v4u*)(dst + 8) = o1; }
              if (qk) {
#pragma unroll
                  for (int i = 0; i < 16; ++i) KET[(16 * dc + i) * 72 + t] = (bf16)f2bf(accv[i] * fac); }
          }
          { const v4u* p = (const v4u*)(proj + (size_t)tokt * NPROJ + C_MV + hh * 128 + 16 * dc); const v4u w0 = p[0], w1 = p[1];
            const unsigned ww[8] = {w0.x, w0.y, w0.z, w0.w, w1.x, w1.y, w1.z, w1.w};
#pragma unroll
            for (int i = 0; i < 8; ++i) { VT[(16 * dc + 2 * i) * 72 + t] = (bf16)(ww[i] & 0xffffu); VT[(16 * dc + 2 * i + 1) * 72 + t] = (bf16)(ww[i] >> 16); } }
        }
        __syncthreads();
        float hval[4][4]; int tt_ = w & 3, eh = w >> 2; const int tq = 16 * tt_ + c16;
        if (L3) {
            bf16x8 qf[4];
#pragma unroll
            for (int ks = 0; ks < 4; ++ks) qf[ks] = *(const LAS bf16x8*)(Qs + tq * 136 + 32 * ks + 8 * quad);
            f32x4 sacc[4];
#pragma unroll
            for (int st = 0; st < 4; ++st) { f32x4 z = {0.f, 0.f, 0.f, 0.f};
#pragma unroll
                for (int ks = 0; ks < 4; ++ks) z = __builtin_amdgcn_mfma_f32_16x16x32_bf16(*(const LAS bf16x8*)(Ks + (16 * st + c16) * 136 + 32 * ks + 8 * quad), qf[ks], z, 0, 0, 0);
                sacc[st] = z; }
            const float cbt = CB[tq];
#pragma unroll
            for (int st = 0; st < 4; ++st)
#pragma unroll
                for (int j = 0; j < 4; ++j) { const int s = 16 * st + 4 * quad + j; const float d = (s <= tq) ? __expf(cbt + CB[64 + s]) : 0.f; sacc[st][j] *= d; }
            bf16x8 pf[2];
#pragma unroll
            for (int kk = 0; kk < 2; ++kk) { v4u pw; pw.x = pk2(sacc[2 * kk][0], sacc[2 * kk][1]); pw.y = pk2(sacc[2 * kk][2], sacc[2 * kk][3]); pw.z = pk2(sacc[2 * kk + 1][0], sacc[2 * kk + 1][1]); pw.w = pk2(sacc[2 * kk + 1][2], sacc[2 * kk + 1][3]); pf[kk] = __builtin_bit_cast(bf16x8, pw); }
            const float ebt = __expf(cbt);
            f32x4 nn[5];
#pragma unroll
            for (int x = 0; x < 5; ++x) { const int et = (x < 4) ? (4 * eh + x) : 8; f32x4 na = {0.f, 0.f, 0.f, 0.f}, ia = {0.f, 0.f, 0.f, 0.f};
#pragma unroll
                for (int kk = 0; kk < 2; ++kk) { const LAS bf16* vr = VT + (16 * et + c16) * 72 + 32 * kk + 4 * quad; const v2u lo = *(const LAS v2u*)vr, hi = *(const LAS v2u*)(vr + 16); v4u vw; vw.x = lo.x; vw.y = lo.y; vw.z = hi.x; vw.w = hi.y;
                    na = __builtin_amdgcn_mfma_f32_16x16x32_bf16(__builtin_bit_cast(bf16x8, vw), pf[kk], na, 0, 0, 0); }
#pragma unroll
                for (int ks = 0; ks < 4; ++ks) ia = __builtin_amdgcn_mfma_f32_16x16x32_bf16(*(const LAS bf16x8*)(CT + (16 * et + c16) * 136 + 32 * ks + 8 * quad), qf[ks], ia, 0, 0, 0);
                nn[x] = na + ia * ebt; }
            const float den = __shfl(nn[4][0], c16); const float inv = 1.0f / fmaxf(fabsf(den), 1.0f);
            float ss = 0.f;
#pragma unroll
            for (int x = 0; x < 4; ++x)
#pragma unroll
                for (int j = 0; j < 4; ++j) { hval[x][j] = nn[x][j] * inv; ss += hval[x][j] * hval[x][j]; }
            ss += __shfl_xor(ss, 16); ss += __shfl_xor(ss, 32);
            if (quad == 0) RED[eh * 64 + tq] = ss;
            __syncthreads();
            const float rstd = 1.0f / sqrtf((RED[tq] + RED[64 + tq]) * (1.0f / 128.0f) + EPS);
#pragma unroll
            for (int x = 0; x < 4; ++x) { const int e = 16 * (4 * eh + x) + 4 * quad; const v2u og = *(const v2u*)(proj + (size_t)(tok0 + tq) * NPROJ + C_MO + hh * 128 + e);
                const float y0 = hval[x][0] * rstd * NW[e] * bflo(og.x), y1 = hval[x][1] * rstd * NW[e + 1] * bfhi(og.x), y2 = hval[x][2] * rstd * NW[e + 2] * bflo(og.y), y3 = hval[x][3] * rstd * NW[e + 3] * bfhi(og.y);
                v2u o; o.x = pk2(y0, y1); o.y = pk2(y2, y3); *(v2u*)(hm + (size_t)(tok0 + tq) * 512 + hh * 128 + e) = o; }
        }
        { const float ebl = __expf(bl);
          bf16x8 kf[2];
#pragma unroll
          for (int kk = 0; kk < 2; ++kk) kf[kk] = *(const LAS bf16x8*)(KET + (16 * w + c16) * 72 + 32 * kk + 8 * quad);
#pragma unroll
          for (int et = 0; et < 9; ++et) { f32x4 z = cacc[et] * ebl;
#pragma unroll
              for (int kk = 0; kk < 2; ++kk) z = __builtin_amdgcn_mfma_f32_16x16x32_bf16(*(const LAS bf16x8*)(VT + (16 * et + c16) * 72 + 32 * kk + 8 * quad), kf[kk], z, 0, 0, 0);
              cacc[et] = z;
              if (L3) {
#pragma unroll
                  for (int j = 0; j < 4; ++j) CT[(16 * et + 4 * quad + j) * 136 + 16 * w + c16] = (bf16)f2bf(z[j]); } } }
        __syncthreads();
    }
    if (!L3) {
#pragma unroll
        for (int et = 0; et < 9; ++et)
#pragma unroll
            for (int j = 0; j < 4; ++j) mlc[(16 * et + 4 * quad + j) * 128 + 16 * w + c16] = cacc[et][j];
        if (X.tid == 0) mlb[unit] = bsum;
    }
}
DI void mlstm_scan(const Args& a, const Ctx& X) {
    float* mlc = (float*)(a.ws + WS_MLC); const float* mlb = (const float*)(a.ws + WS_MLB);
    for (int idx = X.bid * 512 + X.tid; idx < 8 * 18432; idx += X.G * 512) { const int seq = idx / 18432, el = idx - seq * 18432; float carry = 0.f;
        for (int j = 0; j < 32; ++j) { const int u = seq * 32 + j; float* p = mlc + (size_t)u * 18432 + el; const float tmp = *p; *p = carry; carry = __expf(mlb[u]) * carry + tmp; } }
}

DI void p6_norm_route(const Args& a, const Ctx& X, int l, const float* xin) {
    unsigned char* ws = a.ws;
    LAS float* wr = (LAS float*)X.lds;
    for (int idx = X.tid; idx < 16384; idx += 512) { const int k = idx >> 4, e = idx & 15; wr[e * 1024 + k] = a.router_w[idx]; }
    __syncthreads();
    const float* mod = (const float*)(ws + WS_MOD); bf16* hb = (bf16*)(ws + WS_H); float* tgate = (float*)(ws + WS_TGATE); int* tokl = (int*)(ws + WS_TOKL);
    unsigned* cnt = (unsigned*)(ws + WS_CTL) + CW_CNT + l * 32;
    const int gw = X.bid * 8 + X.wave, NGW = X.G * 8;
    for (int rg = gw; rg < T / 16; rg += NGW) {
        const int row0 = rg * 16, b = row0 >> 14;
        const float* mb = mod + (size_t)(l * 2 + b) * 6144;
        f32x4 aw[4], sh[4];
#pragma unroll
        for (int j = 0; j < 4; ++j) { const int k = 256 * j + 4 * X.lane; const f32x4 nw = *(const f32x4*)(a.nfw + l * D + k); const f32x4 sc = *(const f32x4*)(mb + 4 * 1024 + k); aw[j] = nw * (sc + 1.0f); sh[j] = *(const f32x4*)(mb + 3 * 1024 + k); }
        int my_cls = 0; float my_ga = 0.f, my_gb = 0.f;
#pragma unroll 1
        for (int r = 0; r < 16; ++r) { const int row = row0 + r;
            const f32x4* xr = (const f32x4*)(xin + (size_t)row * D) + X.lane; f32x4 v[4]; float ss = 0.f;
#pragma unroll
            for (int j = 0; j < 4; ++j) { v[j] = xr[64 * j]; ss += (v[j].x * v[j].x + v[j].y * v[j].y) + (v[j].z * v[j].z + v[j].w * v[j].w); }
            ss = wave_sum(ss); const float rstd = 1.0f / sqrtf(ss * (1.0f / D) + EPS);
            unsigned long long* o8 = (unsigned long long*)(hb + (size_t)row * D) + X.lane;
#pragma unroll
            for (int j = 0; j < 4; ++j) { v[j] = v[j] * rstd * aw[j] + sh[j]; o8[64 * j] = (unsigned long long)pk2(v[j].x, v[j].y) | ((unsigned long long)pk2(v[j].z, v[j].w) << 32); }
            float sc[16], sel[16];
#pragma unroll
            for (int e = 0; e < 16; ++e) { float p = 0.f;
#pragma unroll
                for (int j = 0; j < 4; ++j) { const f32x4 wv = *(const LAS f32x4*)(wr + e * 1024 + 256 * j + 4 * X.lane); p += (v[j].x * wv.x + v[j].y * wv.y) + (v[j].z * wv.z + v[j].w * wv.w); }
                p = wave_sum(p); sc[e] = 1.0f / (1.0f + __expf(-p)); sel[e] = sc[e] + a.router_b[e]; __builtin_amdgcn_sched_barrier(0); }
            int gi = 0; float gbest = -1.0e30f;
#pragma unroll
            for (int g = 0; g < 4; ++g) { const float p0 = sel[4 * g], p1 = sel[4 * g + 1], p2 = sel[4 * g + 2], p3 = sel[4 * g + 3];
                const float gs = fmaxf(fmaxf(fmaxf(p0 + p1, p0 + p2), fmaxf(p0 + p3, p1 + p2)), fmaxf(p1 + p3, p2 + p3));
                if (gs > gbest) { gbest = gs; gi = g; } }
            float q[4], s4[4];
#pragma unroll
            for (int i = 0; i < 4; ++i) { q[i] = 0.f; s4[i] = 0.f; }
#pragma unroll
            for (int g = 0; g < 4; ++g) if (g == gi) {
#pragma unroll
                for (int i = 0; i < 4; ++i) { q[i] = sel[4 * g + i]; s4[i] = sc[4 * g + i]; } }
            int i1 = 0; float b1 = q[0];
#pragma unroll
            for (int i = 1; i < 4; ++i) if (q[i] > b1) { b1 = q[i]; i1 = i; }
            int i2 = -1; float b2 = -1.0e30f;
#pragma unroll
            for (int i = 0; i < 4; ++i) if (i != i1 && q[i] > b2) { b2 = q[i]; i2 = i; }
            const int ia = (i1 < i2) ? i1 : i2, ib = (i1 < i2) ? i2 : i1;
            float sa = 0.f, sb = 0.f;
#pragma unroll
            for (int i = 0; i < 4; ++i) { if (i == ia) sa = s4[i]; if (i == ib) sb = s4[i]; }
            const int pidx = (ia == 0) ? (ib - 1) : ((ia == 1) ? (ib + 1) : 5);
            const float inv = 1.0f / (sa + sb);
            if (X.lane == r) { my_cls = gi * 6 + pidx; my_ga = sa * inv; my_gb = sb * inv; }
        }
        if (X.lane < 16) { const int tok = row0 + X.lane; const unsigned pos = __hip_atomic_fetch_add(cnt + my_cls, 1u, RLX_AGENT);
            tokl[my_cls * CLS_CAP + (int)pos] = tok; tgate[tok * 2] = my_ga; tgate[tok * 2 + 1] = my_gb; }
    }
}
DI MoeTab moe_tables(const Args& a, const Ctx& X, int l) {
    LAS int* tab = (LAS int*)(X.lds + TAB_OFF); LAS int* tcls = tab; LAS int* tpos = tab + 160; LAS int* cn = tab + 320; LAS int* rt_ = tab + 344;
    unsigned* cnt = (unsigned*)(a.ws + WS_CTL) + CW_CNT + l * 32;
    if (X.tid < NCLS) cn[X.tid] = (int)__hip_atomic_load(cnt + X.tid, RLX_AGENT);
    __syncthreads();
    if (X.tid == 0) { int r = 0;
#pragma unroll 1
        for (int c = 0; c < NCLS; ++c) { const int n = (cn[c] + 255) >> 8;
#pragma unroll 1
            for (int i = 0; i < n; ++i) { tcls[r] = c; tpos[r] = i * 256; ++r; } }
        rt_[0] = r; }
    __syncthreads();
    MoeTab tb; tb.tcls = tcls; tb.tpos = tpos; tb.cnt = cn; tb.Rtot = __builtin_amdgcn_readfirstlane(rt_[0]); return tb;
}

__global__ void __launch_bounds__(512, 2) fwd(Args a) {
    extern __shared__ __attribute__((aligned(16))) unsigned char lds_raw[];
    Ctx X; X.lds = (LAS unsigned char*)lds_raw; X.tid = threadIdx.x; X.lane = X.tid & 63; X.wave = __builtin_amdgcn_readfirstlane(X.tid >> 6); X.G = gridDim.x; X.bid = blockIdx.x;
    volatile LAS unsigned* MISC = (volatile LAS unsigned*)(X.lds + MISC_OFF);
    if (X.tid < 64) MISC[X.tid] = 0u;
    __syncthreads();
    unsigned char* ws = a.ws;
    unsigned* ctl = (unsigned*)(ws + WS_CTL);
    const int lo = a.ph_lo, hi = a.ph_hi;
    XcdBarrier bar; bar.bar = ctl + CW_BAR; bar.x = 0; bar.st = MISC + 8;
    if (hi - lo > 1) bar = xcd_barrier_post(ctl + CW_BAR, MISC + 8);
#ifndef PH_MASK
#define PH_MASK 0xFFFFF
#endif
#define PON(p) ((PH_MASK >> (p)) & 1)
#define IN(k) (lo <= (k) && (k) < hi)
#define SEAM(k) do { if (IN(k) && IN((k) + 1)) xcd_barrier(bar); } while (0)
    if (PON(10) && IN(0)) p0_prologue(a, X);
    SEAM(0);
    const float* mod = (const float*)(ws + WS_MOD);
    bf16* proj = (bf16*)(ws + WS_PROJ);
    for (int l = 0; l < NL; ++l) {
        const int g0 = 1 + l * NPH;
        const float* xin = (l == 0) ? a.x : a.out;
        if (PON(0) && IN(g0 + 0)) { const Ctx P = fresh(X); p1_norm_gates(a, P, l, xin); }
        SEAM(g0 + 0);
        if (PON(1) && IN(g0 + 1)) { const Ctx P = fresh(X);
            DenseSched S; S.A = (const char*)(ws + WS_H); S.Bt = (const char*)(ws + WS_WIN) + (size_t)l * NPROJ * D * 2; S.lda = D; S.ldb = D; S.ord.init(T / 256, NPROJ / 256, P.G, P.bid);
            EpiProj E; E.O = proj;
            pg8::gemm_phase<EpiProj, DenseSched>(P.lds, D, S, E);
        }
        SEAM(g0 + 1);
        if (PON(2) && IN(g0 + 2)) { const Ctx P = fresh(X);
            if (PON(11)) {
#pragma unroll 1
                for (int u = P.bid; u < 512; u += P.G) attn_unit(a, P, l, u); }
            if (PON(12)) {
#pragma unroll 1
                for (int u = P.bid; u < 256; u += P.G) mlstm_unit<false>(a, P, l, u); }
        }
        SEAM(g0 + 2);
        if (PON(3) && IN(g0 + 3)) { const Ctx P = fresh(X); mlstm_scan(a, P); }
        SEAM(g0 + 3);
        if (PON(4) && IN(g0 + 4)) { const Ctx P = fresh(X);
#pragma unroll 1
            for (int u = P.bid; u < 256; u += P.G) mlstm_unit<true>(a, P, l, u); }
        SEAM(g0 + 4);
        if (PON(5) && IN(g0 + 5)) { const Ctx P = fresh(X);
            { DenseSched S; S.A = (const char*)(ws + WS_H); S.Bt = (const char*)(ws + WS_WAU) + (size_t)l * D * 512 * 2; S.lda = 512; S.ldb = 512; S.ord.init(T / 256, D / 256, P.G, P.bid);
              EpiGate<false> E; E.P = proj; E.gcol = C_GA; pg8::gemm_phase<EpiGate<false>, DenseSched>(P.lds, 512, S, E); }
            { DenseSched S; S.A = (const char*)(ws + WS_H) + (size_t)T * 512 * 2; S.Bt = (const char*)(ws + WS_WMU) + (size_t)l * D * 512 * 2; S.lda = 512; S.ldb = 512; S.ord.init(T / 256, D / 256, P.G, P.bid);
              EpiGate<true> E; E.P = proj; E.gcol = C_GB; pg8::gemm_phase<EpiGate<true>, DenseSched>(P.lds, 512, S, E); }
        }
        SEAM(g0 + 5);
        if (PON(6) && IN(g0 + 6)) { const Ctx P = fresh(X);
            DenseSched S; S.A = (const char*)(proj + C_MQ); S.Bt = (const char*)(ws + WS_WOUT) + (size_t)l * D * D * 2; S.lda = NPROJ; S.ldb = D; S.ord.init(T / 256, D / 256, P.G, P.bid);
            EpiRes E; E.xin = xin; E.out = a.out; E.g = mod + (size_t)(l * 2) * 6144 + 2 * 1024;
            pg8::gemm_phase<EpiRes, DenseSched>(P.lds, D, S, E);
        }
        SEAM(g0 + 6);
        if (PON(7) && IN(g0 + 7)) { const Ctx P = fresh(X); p6_norm_route(a, P, l, a.out); }
        SEAM(g0 + 7);
        if (PON(8) && IN(g0 + 8)) { const Ctx P = fresh(X);
            const MoeTab tb = moe_tables(a, P, l);
            LAS unsigned* tokoff = (LAS unsigned*)(P.lds + TOKOFF_OFF); const int* tokl = (const int*)(ws + WS_TOKL);
#pragma unroll 1
            for (int s = 0; s < 8; ++s) { const int L = s * P.G + P.bid;
                if (L < tb.Rtot * 8 && P.tid < 256) { const int rt = L >> 3, cls = tb.tcls[rt], pos = tb.tpos[rt] + P.tid, cn = tb.cnt[cls]; const int tok = tokl[cls * CLS_CAP + (pos < cn ? pos : 0)]; tokoff[s * 256 + P.tid] = (unsigned)tok; } }
            __syncthreads();
            MoeUpSched S; S.A = (const char*)(ws + WS_H); S.W = (const char*)(ws + WS_WGU) + (size_t)l * NE * 1024 * D * 2; S.lda = D; S.ldb = D; S.tb = tb; S.G = P.G; S.c = P.bid; S.tokoff = tokoff;
            EpiSwiglu E; E.H = proj; E.tgate = (const float*)(ws + WS_TGATE); E.tokoff = tokoff;
            pg8::gemm_phase<EpiSwiglu, MoeUpSched>(P.lds, D, S, E);
        }
        SEAM(g0 + 8);
        if (PON(9) && IN(g0 + 9)) { const Ctx P = fresh(X);
            const MoeTab tb = moe_tables(a, P, l);
            MoeDownSched S; S.A = (const char*)proj; S.W = (const char*)(ws + WS_WD) + (size_t)l * NE * 1024 * FF * 2; S.lda = D; S.ldb = FF; S.tb = tb; S.G = P.G; S.c = P.bid;
            EpiMoeOut E; E.out = a.out; E.g = mod + (size_t)(l * 2) * 6144 + 5 * 1024; E.tokl = (const int*)(ws + WS_TOKL); E.tb = tb;
            pg8::gemm_phase<EpiMoeOut, MoeDownSched>(P.lds, D, S, E);
        }
        SEAM(g0 + 9);
    }
#undef IN
#undef SEAM
}

extern "C" void kernel_launch(void* const* d_in, const int* in_sizes, int n_in, void* d_out, int out_size, void* d_ws, size_t ws_size, hipStream_t stream) {
    static int grid = 0;
    if (grid == 0) {
        if (n_in != 24 || in_sizes[0] != T * D || out_size != T * D || ws_size < WS_END) { fprintf(stderr, "kernel_launch: unexpected shapes / workspace (n_in %d, ws %zu, need %zu)\n", n_in, ws_size, (size_t)WS_END); grid = -1; return; }
        int dev = 0, cus = 0;
        if (hipGetDevice(&dev) != hipSuccess || hipDeviceGetAttribute(&cus, hipDeviceAttributeMultiprocessorCount, dev) != hipSuccess) { grid = -1; return; }
        if (hipFuncSetAttribute((const void*)fwd, hipFuncAttributeMaxDynamicSharedMemorySize, LDS_BYTES) != hipSuccess) { fprintf(stderr, "kernel_launch: hipFuncSetAttribute failed\n"); grid = -1; return; }
        int per_cu = 0;
        if (hipOccupancyMaxActiveBlocksPerMultiprocessor(&per_cu, (const void*)fwd, 512, LDS_BYTES) != hipSuccess || per_cu < 1) fprintf(stderr, "kernel_launch: occupancy query reports %d\n", per_cu);
        (void)hipGetLastError();
        grid = cus < 256 ? cus : 256;
    }
    if (grid < 0) return;
    (void)hipMemsetAsync((char*)d_ws + WS_CTL, 0, CTL_ZERO_BYTES, stream);
    Args a{};
    a.x = (const float*)d_in[0]; a.c = (const float*)d_in[1]; a.pos = (const int*)d_in[2]; a.ada_w = (const float*)d_in[3]; a.ada_b = (const float*)d_in[4];
    a.nmw = (const float*)d_in[5]; a.nfw = (const float*)d_in[6]; a.w_in = (const float*)d_in[7]; a.b_ig = (const float*)d_in[8]; a.b_fg = (const float*)d_in[9];
    a.qnw = (const float*)d_in[10]; a.knw = (const float*)d_in[11]; a.sinks = (const float*)d_in[12]; a.conv_w = (const float*)d_in[13]; a.conv_b = (const float*)d_in[14];
    a.mnw = (const float*)d_in[15]; a.w_au = (const float*)d_in[16]; a.w_mu = (const float*)d_in[17]; a.w_out = (const float*)d_in[18]; a.router_w = (const float*)d_in[19];
    a.router_b = (const float*)d_in[20]; a.w_gate = (const float*)d_in[21]; a.w_up = (const float*)d_in[22]; a.w_down = (const float*)d_in[23];
    a.out = (float*)d_out; a.ws = (unsigned char*)d_ws;
#if MK_MULTI
    for (int gp = 0; gp < NGP; ++gp) { a.ph_lo = gp; a.ph_hi = gp + 1; hipLaunchKernelGGL(fwd, dim3(grid), dim3(512), LDS_BYTES, stream, a); }
#else
    a.ph_lo = 0; a.ph_hi = NGP; hipLaunchKernelGGL(fwd, dim3(grid), dim3(512), LDS_BYTES, stream, a);
#endif
}
```

```cpp
#include <hip/hip_runtime.h>
#include <cstdio>
#include <cstdint>

#ifndef MK_MULTI
#define MK_MULTI 0
#endif

#define GAS __attribute__((address_space(1)))
#define LAS __attribute__((address_space(3)))
typedef unsigned short bf16;
typedef unsigned v4u __attribute__((ext_vector_type(4)));
typedef unsigned v2u __attribute__((ext_vector_type(2)));
typedef float f32x4 __attribute__((ext_vector_type(4)));
typedef float f32x2 __attribute__((ext_vector_type(2)));
typedef short bf16x8 __attribute__((ext_vector_type(8)));
typedef short bf16x4 __attribute__((ext_vector_type(4)));
#define DI __device__ __forceinline__
#define RLX_AGENT __ATOMIC_RELAXED, __HIP_MEMORY_SCOPE_AGENT
#define LDS_WAIT() asm volatile("s_waitcnt lgkmcnt(0)" ::: "memory")
#define VM_WAIT() asm volatile("s_waitcnt vmcnt(0)" ::: "memory")

constexpr int NB = 2, SEQ = 16384, T = NB * SEQ, D = 1024, NL = 4;
constexpr int DIN_SRC = 4872;
constexpr int NPROJ = 4864;
constexpr int C_AQ = 0, C_AK = 512, C_AV = 640, C_MQ = 768, C_MK = 1280, C_MV = 1792, C_MO = 2304, C_GA = 2816, C_GB = 3840;
constexpr int NE = 16, FF = 512;
constexpr int NCLS = 24, CLS_CAP = 32768;
constexpr float EPS = 1e-6f;
constexpr int NPH = 10;
constexpr int NGP = 1 + NL * NPH;

constexpr size_t MiB = 1u << 20;
constexpr size_t WS_CTL = 0, CTL_ZERO_BYTES = 1 * MiB;
constexpr size_t WS_MOD = 1 * MiB;
constexpr size_t WS_ROPE = 2 * MiB;
constexpr size_t WS_GATES = 4 * MiB;
constexpr size_t WS_TGATE = 5 * MiB;
constexpr size_t WS_TOKL = 6 * MiB;
constexpr size_t WS_MLB = 9 * MiB;
constexpr size_t WS_MLC = 10 * MiB;
constexpr size_t WS_WIN = 28 * MiB;
constexpr size_t WS_WAU = 66 * MiB;
constexpr size_t WS_WMU = 70 * MiB;
constexpr size_t WS_WOUT = 74 * MiB;
constexpr size_t WS_WGU = 82 * MiB;
constexpr size_t WS_WD = 210 * MiB;
constexpr size_t WS_H = 274 * MiB;
constexpr size_t WS_PROJ = 338 * MiB;
constexpr size_t WS_END = 642 * MiB;

constexpr int CW_TMO = 0;
constexpr int CW_BAR = 4096;
constexpr int CW_CNT = 8192;

constexpr int RING_BYTES = 131072;
constexpr int MISC_OFF = RING_BYTES;
constexpr int TAB_OFF = RING_BYTES + 256;
constexpr int TOKOFF_OFF = RING_BYTES + 2048;
constexpr int LDS_BYTES = 147456;

DI unsigned f2bf(float f) { unsigned u = __builtin_bit_cast(unsigned, f); return (u + 0x7fffu + ((u >> 16) & 1u)) >> 16; }
DI unsigned pk2(float lo, float hi) { return f2bf(lo) | (f2bf(hi) << 16); }
DI float bf2f(unsigned short b) { return __builtin_bit_cast(float, ((unsigned)b) << 16); }
DI float bflo(unsigned w) { return __builtin_bit_cast(float, w << 16); }
DI float bfhi(unsigned w) { return __builtin_bit_cast(float, w & 0xffff0000u); }
DI float wave_sum(float v) {
#pragma unroll
    for (int o = 1; o < 64; o <<= 1) v += __shfl_xor(v, o);
    return v;
}
DI float sigmoidf_(float x) { return 1.0f / (1.0f + __expf(-x)); }

#define XB_TMO      128
#define XB_XCNT(j)  (256  + 64 * (j))
#define XB_XSUB(j)  (1280 + 64 * (j))
#define XB_XGEN(j)  (2304 + 64 * (j))
#define XB_TOP      3328
#define XB_TOPGEN   3392
#define XCD_BAR_WORDS 3456
#define XB_SPIN_CAP (1u << 18)
__device__ __forceinline__ unsigned xb_ld(unsigned* p)              { return __hip_atomic_load(p, __ATOMIC_RELAXED, __HIP_MEMORY_SCOPE_AGENT); }
__device__ __forceinline__ unsigned xb_add(unsigned* p, unsigned v) { return __hip_atomic_fetch_add(p, v, __ATOMIC_RELAXED, __HIP_MEMORY_SCOPE_AGENT); }
__device__ __forceinline__ unsigned xb_xcc_id() { return (unsigned)__builtin_amdgcn_s_getreg((3 << 11) | 20) & 0xFu; }
#define XB_SPIN(cond, bar) do { unsigned _sp = 0; while (cond) { __builtin_amdgcn_s_sleep(1); \
    if ((++_sp & 255u) == 0u) { if (xb_ld(&(bar)[XB_TMO])) break; if (_sp > XB_SPIN_CAP) { atomicAdd(&(bar)[XB_TMO], 1u); break; } } } } while (0)
struct XcdBarrier { unsigned* bar; unsigned x; volatile LAS unsigned* st; };
__device__ __forceinline__ XcdBarrier xcd_barrier_post(unsigned* bar, volatile LAS unsigned* st) {
    XcdBarrier b; b.bar = bar; b.x = xb_xcc_id(); b.st = st;
    if (threadIdx.x == 0) (void)xb_add(&bar[XB_XCNT(b.x)], 1u);
    return b;
}
__device__ __forceinline__ void xcd_barrier_complete(unsigned* bar, unsigned x, unsigned& nloc, unsigned& nx) {
    const unsigned G = gridDim.x * gridDim.y * gridDim.z;
    unsigned sum, cnt, mine, sp = 0u;
    for (;;) {
        sum = 0u; cnt = 0u; mine = 0u;
#pragma unroll
        for (unsigned j = 0; j < 16; ++j) { const unsigned c = xb_ld(&bar[XB_XCNT(j)]); sum += c; cnt += (c > 0u) ? 1u : 0u; mine = (j == x) ? c : mine; }
        if (sum == G) break;
        __builtin_amdgcn_s_sleep(1);
        if ((++sp & 255u) == 0u) { if (xb_ld(&bar[XB_TMO])) break; if (sp > XB_SPIN_CAP) { atomicAdd(&bar[XB_TMO], 1u); break; } }
    }
    nloc = mine > 0u ? mine : 1u; nx = cnt > 0u ? cnt : 1u;
}
__device__ __forceinline__ void xcd_barrier(const XcdBarrier& b) {
    asm volatile("s_waitcnt vmcnt(0)" ::: "memory");
    __syncthreads();
    if (threadIdx.x == 0) {
        unsigned* bar = b.bar;
        __builtin_amdgcn_s_waitcnt(0);
        unsigned nloc = b.st[0], nx = b.st[1];
        if (nloc == 0u) { xcd_barrier_complete(bar, b.x, nloc, nx); b.st[0] = nloc; b.st[1] = nx; }
        const unsigned old = xb_add(&bar[XB_XSUB(b.x)], 1u);
        const unsigned gen = old / nloc;
        if (old + 1u == (gen + 1u) * nloc) {
            __builtin_amdgcn_fence(__ATOMIC_RELEASE, "agent");
            asm volatile("s_waitcnt vmcnt(0)" ::: "memory");
            const unsigned og = xb_add(&bar[XB_TOP], 1u);
            const unsigned tg = og / nx;
            if (og + 1u == (tg + 1u) * nx) xb_add(&bar[XB_TOPGEN], 1u);
            else XB_SPIN(xb_ld(&bar[XB_TOPGEN]) == tg, bar);
            __builtin_amdgcn_fence(__ATOMIC_ACQUIRE, "agent");
            xb_add(&bar[XB_XGEN(b.x)], 1u);
            asm volatile("s_waitcnt vmcnt(0)" ::: "memory");
        } else {
            XB_SPIN(xb_ld(&bar[XB_XGEN(b.x)]) == gen, bar);
            __builtin_amdgcn_fence(__ATOMIC_ACQUIRE, "agent");
            asm volatile("s_waitcnt vmcnt(0)" ::: "memory");
        }
    }
    __syncthreads();
}

namespace pg8 {
constexpr int BM = 256, BK = 64, HALF = 128, HTB = HALF * BK * 2, STAGE_BYTES = 8 * HTB, NXCD = 8, WGM = 8;
__host__ __device__ __forceinline__ int lds_byte(int r, int c) { const int st = (r >> 4) * 2 + (c >> 5), rr = r & 15, cc = c & 31, ob = rr * 64 + cc * 2; return st * 1024 + (ob ^ (((ob >> 9) & 1) << 5)); }
__host__ __device__ __forceinline__ void stage_rc(int b, int& R, int& C) { const int st = b / 1024, sb = b % 1024, swz = sb ^ (((sb >> 9) & 1) << 5); R = (st >> 1) * 16 + swz / 64; C = (st & 1) * 32 + (swz % 64) / 2; }
__host__ __device__ __forceinline__ int perm32(int rho) { const int n = rho >> 4, i = rho & 15; return 8 * (i >> 2) + 4 * n + (i & 3); }

struct Unit { int pm, pn, x0, x1; };

struct TileOrder {
    int nM, nN, nwg, G, c;
    __device__ void init(int nM_, int nN_, int G_, int c_) { nM = nM_; nN = nN_; nwg = nM * nN; G = G_; c = c_; }
    __device__ bool get(int i, int& pm, int& pn) const {
        const long L = (long)i * G + c; if (L >= nwg) return false;
        int wgid = (int)L; { const int q = nwg / NXCD, r = nwg % NXCD, xcd = wgid % NXCD, off = wgid / NXCD; wgid = (xcd < r ? xcd * (q + 1) : r * (q + 1) + (xcd - r) * q) + off; }
        const int nig = WGM * nN, gid = wgid / nig, fm = gid * WGM, gsz = (nM - fm) < WGM ? (nM - fm) : WGM;
        pm = fm + ((wgid % nig) % gsz); pn = (wgid % nig) / gsz; return true;
    }
};

template <class Epi, class Sched>
__device__ __forceinline__ void gemm_phase(LAS unsigned char* lds, const int K, const Sched& S, const Epi& E) {
    int tid = threadIdx.x; asm volatile("" : "+v"(tid));
    const int wid = __builtin_amdgcn_readfirstlane(tid >> 6), lane = tid & 63, wr = wid >> 2, wc = wid & 3, fr = lane & 15, fq = lane >> 4;
    const int nt = K / BK;
    constexpr bool GA = Sched::GATHER; constexpr int KS = Sched::KSPLIT;
    unsigned voffA[2], voffB[2]; int Rst[2], Cst[2];
#pragma unroll
    for (int i = 0; i < 2; ++i) { int R, C; stage_rc(tid * 16 + i * 8192, R, C); const int Rb = Epi::PERM ? ((R & ~31) + perm32(R & 31)) : R;
        voffA[i] = (unsigned)(R * S.lda + C) * 2u; voffB[i] = (unsigned)(Rb * S.ldb + C) * 2u; Rst[i] = R; Cst[i] = C; }
    const size_t kstep = (size_t)(BK * 2);
    const size_t hstepA = (size_t)HALF * S.lda * 2, hstepB = (size_t)HALF * S.ldb * 2;
    const unsigned ldsw = (unsigned)wid * 1024u; const unsigned gmul = (unsigned)S.lda * 2u;
    const int aoff = lds_byte(wr * 64 + fr, fq * 8), boff = lds_byte(wc * 32 + fr, fq * 8);
    unsigned vAc[2], vAn[2];
#define PG8_SA(b, h) (((b) * 2 + (h)) * HTB)
#define PG8_SB(b, h) ((4 + (b) * 2 + (h)) * HTB)
#define PG8_STAGE2(bufoff, gbase, v0, v1) do { \
        __builtin_amdgcn_global_load_lds((const unsigned*)((const char*)(gbase) + (v0)), (LAS unsigned*)(lds + (bufoff) + ldsw), 16, 0, 0); \
        __builtin_amdgcn_global_load_lds((const unsigned*)((const char*)(gbase) + (v1)), (LAS unsigned*)(lds + (bufoff) + ldsw + 8192), 16, 0, 0); } while (0)
#define PG8_STAGE_B(bufoff, ptr, h) PG8_STAGE2(bufoff, (ptr) + (h) * hstepB, voffB[0], voffB[1])
#define PG8_STAGE_A(bufoff, ptr, h, nx) do { if constexpr (GA) { const unsigned _p = (nx) ? vAn[h] : vAc[h]; PG8_STAGE2(bufoff, ptr, (_p & 0xffffu) * gmul + (unsigned)Cst[0] * 2u, (_p >> 16) * gmul + (unsigned)Cst[0] * 2u); } \
        else { PG8_STAGE2(bufoff, (ptr) + (h) * hstepA, voffA[0], voffA[1]); } } while (0)
#define PG8_LDA(dst, b, h) do { _Pragma("unroll") for (int m = 0; m < 4; ++m) _Pragma("unroll") for (int k = 0; k < 2; ++k) dst[m][k] = *(const LAS bf16x8*)(lds + PG8_SA(b, h) + aoff + m * 2048 + k * 1024); } while (0)
#define PG8_LDB(dst, b, h) do { _Pragma("unroll") for (int n = 0; n < 2; ++n) _Pragma("unroll") for (int k = 0; k < 2; ++k) dst[n][k] = *(const LAS bf16x8*)(lds + PG8_SB(b, h) + boff + n * 2048 + k * 1024); } while (0)
#define PG8_MMA(ai, bj, At, Bt) do { __builtin_amdgcn_s_setprio(1); _Pragma("unroll") for (int m = 0; m < 4; ++m) _Pragma("unroll") for (int n = 0; n < 2; ++n) _Pragma("unroll") for (int k = 0; k < 2; ++k) \
        acc[ai][bj][m][n] = __builtin_amdgcn_mfma_f32_16x16x32_bf16(Bt[n][k], At[m][k], acc[ai][bj][m][n], 0, 0, 0); __builtin_amdgcn_s_setprio(0); } while (0)
#define PG8_WAIT_V(n) asm volatile("s_waitcnt vmcnt(" #n ")" ::: "memory")
#define PG8_WAIT_L(n) asm volatile("s_waitcnt lgkmcnt(" #n ")" ::: "memory")
#define PG8_BAR __builtin_amdgcn_s_barrier()
#define PG8_SCHED __builtin_amdgcn_sched_barrier(0)
#define PG8_GOFF(dst, u) do { if constexpr (GA) { _Pragma("unroll") for (int h = 0; h < 2; ++h) dst[h] = S.a_rowoff(u, Rst[0] + HALF * h) | (S.a_rowoff(u, Rst[0] + 64 + HALF * h) << 16); } } while (0)
    Unit cur, nxt; int ui = 0;
    if (!S.next(0, cur)) return;
    f32x4 acc[2][2][4][2];
#pragma unroll
    for (int a = 0; a < 2; ++a)
#pragma unroll
        for (int b = 0; b < 2; ++b)
#pragma unroll
            for (int m = 0; m < 4; ++m)
#pragma unroll
                for (int n = 0; n < 2; ++n) acc[a][b][m][n] = (f32x4){0.f, 0.f, 0.f, 0.f};
    bf16x8 At[4][2], B0[2][2], B1[2][2];
    const char* cA = S.a_base(cur); const char* cB0 = S.b_base(cur, 0); const char* cB1 = KS ? S.b_base(cur, 1) : cB0;
    PG8_GOFF(vAc, cur);
    vAn[0] = vAc[0]; vAn[1] = vAc[1];
    PG8_STAGE_B(PG8_SB(0, 0), cB0, 0); PG8_STAGE_B(PG8_SB(0, 1), cB0, 1); PG8_STAGE_A(PG8_SA(0, 0), cA, 0, false); PG8_STAGE_A(PG8_SA(0, 1), cA, 1, false);
    if (wr == 1) PG8_BAR;
    PG8_WAIT_V(2); PG8_BAR;
    PG8_STAGE_B(PG8_SB(1, 0), cB0 + kstep, 0); PG8_STAGE_A(PG8_SA(1, 0), cA + kstep, 0, false); PG8_STAGE_B(PG8_SB(1, 1), cB0 + kstep, 1);
    PG8_WAIT_V(6); PG8_BAR;
    for (;;) {
        const bool has_next = S.next(ui + 1, nxt);
        const char* nA = has_next ? S.a_base(nxt) : cA; const char* nB0 = has_next ? S.b_base(nxt, 0) : cB0; const char* nB1 = (KS && has_next) ? S.b_base(nxt, 1) : (KS ? cB1 : nB0);
        if constexpr (GA) { if (has_next) { PG8_GOFF(vAn, nxt); } }
        for (int t = 0; t < nt; t += 2) {
            const bool last = (t == nt - 2);
            const char* a1 = cA + (size_t)(t + 1) * kstep;
            const char* a2 = last ? nA : cA + (size_t)(t + 2) * kstep;
            const char* b2 = last ? nB0 : ((KS && (t + 2) >= KS) ? cB1 + (size_t)(t + 2 - KS) * kstep : cB0 + (size_t)(t + 2) * kstep);
            const char* a3 = a2 + kstep; const char* b3 = b2 + kstep;
            PG8_LDB(B0, 0, 0); PG8_LDB(B1, 0, 1); PG8_SCHED; PG8_LDA(At, 0, 0); PG8_STAGE_A(PG8_SA(1, 1), a1, 1, false);
            PG8_WAIT_V(8); PG8_WAIT_L(0); PG8_BAR; PG8_MMA(0, 0, At, B0); PG8_MMA(0, 1, At, B1); PG8_BAR; PG8_SCHED;
            PG8_LDA(At, 0, 1); PG8_STAGE_B(PG8_SB(0, 0), b2, 0); PG8_STAGE_B(PG8_SB(0, 1), b2, 1); PG8_STAGE_A(PG8_SA(0, 0), a2, 0, last);
            PG8_WAIT_V(8); PG8_WAIT_L(0); PG8_BAR; PG8_MMA(1, 0, At, B0); PG8_MMA(1, 1, At, B1); PG8_BAR; PG8_SCHED;
            PG8_LDB(B0, 1, 0); PG8_LDB(B1, 1, 1); PG8_SCHED; PG8_LDA(At, 1, 0); PG8_STAGE_A(PG8_SA(0, 1), a2, 1, last);
            PG8_WAIT_V(8); PG8_WAIT_L(0); PG8_BAR; PG8_MMA(0, 0, At, B0); PG8_MMA(0, 1, At, B1); PG8_BAR; PG8_SCHED;
            PG8_LDA(At, 1, 1); PG8_STAGE_B(PG8_SB(1, 0), b3, 0); PG8_STAGE_B(PG8_SB(1, 1), b3, 1); PG8_STAGE_A(PG8_SA(1, 0), a3, 0, last);
            PG8_WAIT_V(8); PG8_WAIT_L(0); PG8_BAR; PG8_MMA(1, 0, At, B0); PG8_MMA(1, 1, At, B1); PG8_BAR; PG8_SCHED;
        }
        if (wr == 0) PG8_BAR;
        { int fr_ = fr, fq_ = fq; asm volatile("" : "+v"(fr_), "+v"(fq_));
          E(acc, cur, wr, wc, fr_, fq_); }
        if (!has_next) break;
#pragma unroll
        for (int a = 0; a < 2; ++a)
#pragma unroll
            for (int b = 0; b < 2; ++b)
#pragma unroll
                for (int m = 0; m < 4; ++m)
#pragma unroll
                    for (int n = 0; n < 2; ++n) acc[a][b][m][n] = (f32x4){0.f, 0.f, 0.f, 0.f};
        cur = nxt; cA = nA; cB0 = nB0; cB1 = nB1; ++ui;
        vAc[0] = vAn[0]; vAc[1] = vAn[1];
        if (wr == 1) PG8_BAR;
    }
    PG8_WAIT_V(0);
    PG8_BAR;
#undef PG8_SA
#undef PG8_SB
#undef PG8_STAGE2
#undef PG8_STAGE_A
#undef PG8_STAGE_B
#undef PG8_LDA
#undef PG8_LDB
#undef PG8_MMA
#undef PG8_WAIT_V
#undef PG8_WAIT_L
#undef PG8_BAR
#undef PG8_SCHED
#undef PG8_GOFF
}
}
using pg8::Unit;

DI unsigned cvt_pk_bf16(float lo, float hi) { unsigned r; asm volatile("v_cvt_pk_bf16_f32 %0, %1, %2" : "=v"(r) : "v"(lo), "v"(hi)); return r; }

struct Args {
    const float* x; const float* c; const int* pos; const float* ada_w; const float* ada_b; const float* nmw; const float* nfw; const float* w_in;
    const float* b_ig; const float* b_fg; const float* qnw; const float* knw; const float* sinks; const float* conv_w; const float* conv_b; const float* mnw;
    const float* w_au; const float* w_mu; const float* w_out; const float* router_w; const float* router_b; const float* w_gate; const float* w_up; const float* w_down;
    float* out; unsigned char* ws; int ph_lo, ph_hi;
};

__constant__ float c_invf[8] = {1.0f, 0.1939227432012558f, 0.03760603070259094f, 0.007292664609849453f, 0.0014142135623842478f, 0.00027424818836152554f, 5.3182957344688475e-05f, 1.0313385246263351e-05f};

struct DenseSched {
    static constexpr bool GATHER = false; static constexpr int KSPLIT = 0;
    const char* A; const char* Bt; int lda, ldb; pg8::TileOrder ord;
    DI bool next(int i, Unit& u) const { int pm, pn; if (!ord.get(i, pm, pn)) return false; u.pm = pm; u.pn = pn; u.x0 = 0; u.x1 = 0; return true; }
    DI const char* a_base(const Unit& u) const { return A + (size_t)u.pm * 256 * lda * 2; }
    DI const char* b_base(const Unit& u, int) const { return Bt + (size_t)u.pn * 256 * ldb * 2; }
    DI unsigned a_rowoff(const Unit&, int) const { return 0u; }
};
struct EpiProj {
    static constexpr bool PERM = true;
    bf16* O;
    DI void operator()(const f32x4 (&acc)[2][2][4][2], const Unit& u, int wr, int wc, int fr, int fq) const {
        const int row0 = u.pm * 256 + wr * 64 + fr, col0 = u.pn * 256 + wc * 32 + 8 * fq; const bool sg = u.pn >= 9;
#pragma unroll
        for (int ai = 0; ai < 2; ++ai)
#pragma unroll
            for (int m = 0; m < 4; ++m) { bf16* rowp = O + (size_t)(row0 + ai * 128 + m * 16) * NPROJ + col0;
#pragma unroll
                for (int bj = 0; bj < 2; ++bj) { f32x4 v0 = acc[ai][bj][m][0], v1 = acc[ai][bj][m][1];
                    if (sg) {
#pragma unroll
                        for (int j = 0; j < 4; ++j) { v0[j] = sigmoidf_(v0[j]); v1[j] = sigmoidf_(v1[j]); } }
                    v4u w; w.x = cvt_pk_bf16(v0[0], v0[1]); w.y = cvt_pk_bf16(v0[2], v0[3]); w.z = cvt_pk_bf16(v1[0], v1[1]); w.w = cvt_pk_bf16(v1[2], v1[3]);
                    *(v4u*)(rowp + bj * 128) = w; } }
    }
};
template <bool ADD> struct EpiGate {
    static constexpr bool PERM = true;
    bf16* P; int gcol;
    DI void operator()(const f32x4 (&acc)[2][2][4][2], const Unit& u, int wr, int wc, int fr, int fq) const {
        const int row0 = u.pm * 256 + wr * 64 + fr, col0 = u.pn * 256 + wc * 32 + 8 * fq;
#pragma unroll
        for (int ai = 0; ai < 2; ++ai)
#pragma unroll
            for (int m = 0; m < 4; ++m) { bf16* rowp = P + (size_t)(row0 + ai * 128 + m * 16) * NPROJ + col0;
#pragma unroll
                for (int bj = 0; bj < 2; ++bj) { const f32x4 v0 = acc[ai][bj][m][0], v1 = acc[ai][bj][m][1];
                    const v4u g = *(const v4u*)(rowp + gcol + bj * 128);
                    float o[8] = {bflo(g.x) * v0[0], bfhi(g.x) * v0[1], bflo(g.y) * v0[2], bfhi(g.y) * v0[3], bflo(g.z) * v1[0], bfhi(g.z) * v1[1], bflo(g.w) * v1[2], bfhi(g.w) * v1[3]};
                    if (ADD) { const v4u p = *(const v4u*)(rowp + C_MQ + bj * 128);
                        o[0] += bflo(p.x); o[1] += bfhi(p.x); o[2] += bflo(p.y); o[3] += bfhi(p.y); o[4] += bflo(p.z); o[5] += bfhi(p.z); o[6] += bflo(p.w); o[7] += bfhi(p.w); }
                    v4u w; w.x = cvt_pk_bf16(o[0], o[1]); w.y = cvt_pk_bf16(o[2], o[3]); w.z = cvt_pk_bf16(o[4], o[5]); w.w = cvt_pk_bf16(o[6], o[7]);
                    *(v4u*)(rowp + C_MQ + bj * 128) = w; } }
    }
};
struct EpiRes {
    static constexpr bool PERM = false;
    const float* xin; float* out; const float* g; int rmask;
    DI void operator()(const f32x4 (&acc)[2][2][4][2], const Unit& u, int wr, int wc, int fr, int fq) const {
        const int row0 = u.pm * 256 + wr * 64 + fr, col0 = u.pn * 256 + wc * 32 + 4 * fq; const int b = (u.pm * 256) >> 14;
        f32x4 gv[2][2];
#pragma unroll
        for (int bj = 0; bj < 2; ++bj)
#pragma unroll
            for (int n = 0; n < 2; ++n) gv[bj][n] = *(const f32x4*)(g + b * 6144 + col0 + bj * 128 + n * 16);
#pragma unroll
        for (int ai = 0; ai < 2; ++ai)
#pragma unroll
            for (int m = 0; m < 4; ++m) { const size_t off = (size_t)(row0 + ai * 128 + m * 16) * D + col0; const size_t offo = (size_t)((row0 + ai * 128 + m * 16) & rmask) * D + col0;
#pragma unroll
                for (int bj = 0; bj < 2; ++bj)
#pragma unroll
                    for (int n = 0; n < 2; ++n) { const f32x4 xv = *(const f32x4*)(xin + off + bj * 128 + n * 16);
                        *(f32x4*)(out + offo + bj * 128 + n * 16) = xv + gv[bj][n] * acc[ai][bj][m][n]; } }
    }
};

struct MoeTab { const LAS int* tcls; const LAS int* tpos; const LAS int* cnt; int Rtot; };
DI void cls_experts(int cls, int& ea, int& eb) { const int g = cls / 6, p = cls - 6 * g; const int a = (p < 3) ? 0 : ((p < 5) ? 1 : 2); const int b = (p < 3) ? (p + 1) : ((p < 5) ? (p - 1) : 3); ea = 4 * g + a; eb = 4 * g + b; }
struct MoeUpSched {
    static constexpr bool GATHER = true; static constexpr int KSPLIT = 0;
    const char* A; const char* W; int lda, ldb; MoeTab tb; int G, c; const LAS unsigned* tokoff;
    DI bool next(int i, Unit& u) const { const int L = i * G + c; if (L >= tb.Rtot * 8) return false; u.pm = L >> 3; u.pn = L & 7; u.x0 = i; u.x1 = __builtin_amdgcn_readfirstlane(tb.tcls[u.pm]); return true; }
    DI const char* a_base(const Unit&) const { return A; }
    DI const char* b_base(const Unit& u, int) const { int ea, eb; cls_experts(u.x1, ea, eb); const int e = (u.pn < 4) ? ea : eb; return W + ((size_t)e * 1024 + (size_t)(u.pn & 3) * 256) * 1024 * 2; }
    DI unsigned a_rowoff(const Unit& u, int r) const { return tokoff[u.x0 * 256 + r]; }
};
struct EpiSwiglu {
    static constexpr bool PERM = true;
    bf16* H; const float* tgate; const LAS unsigned* tokoff;
    DI void operator()(const f32x4 (&acc)[2][2][4][2], const Unit& u, int wr, int wc, int fr, int fq) const {
        const int r0 = wr * 64 + fr; const int hc = (u.pn >> 2) * 512 + (u.pn & 3) * 128 + wc * 32 + 8 * fq; const int gsel = u.pn >> 2;
#pragma unroll
        for (int ai = 0; ai < 2; ++ai)
#pragma unroll
            for (int m = 0; m < 4; ++m) { const int r = r0 + ai * 128 + m * 16; const unsigned tok = tokoff[u.x0 * 256 + r]; const float rg = tgate[tok * 2 + gsel];
                const f32x4 g0 = acc[ai][0][m][0], g1 = acc[ai][0][m][1], u0 = acc[ai][1][m][0], u1 = acc[ai][1][m][1];
                float o[8];
#pragma unroll
                for (int j = 0; j < 4; ++j) { o[j] = g0[j] * sigmoidf_(g0[j]) * u0[j] * rg; o[4 + j] = g1[j] * sigmoidf_(g1[j]) * u1[j] * rg; }
                v4u w; w.x = cvt_pk_bf16(o[0], o[1]); w.y = cvt_pk_bf16(o[2], o[3]); w.z = cvt_pk_bf16(o[4], o[5]); w.w = cvt_pk_bf16(o[6], o[7]);
                *(v4u*)(H + ((size_t)u.pm * 256 + r) * 1024 + hc) = w; }
    }
};
struct MoeDownSched {
    static constexpr bool GATHER = false; static constexpr int KSPLIT = 8;
    const char* A; const char* W; int lda, ldb; MoeTab tb; int G, c;
    DI bool next(int i, Unit& u) const { const int L = i * G + c; if (L >= tb.Rtot * 4) return false; u.pm = L >> 2; u.pn = L & 3; u.x0 = __builtin_amdgcn_readfirstlane(tb.tpos[u.pm]); u.x1 = __builtin_amdgcn_readfirstlane(tb.tcls[u.pm]); return true; }
    DI const char* a_base(const Unit& u) const { return A + (size_t)u.pm * 256 * lda * 2; }
    DI const char* b_base(const Unit& u, int half) const { int ea, eb; cls_experts(u.x1, ea, eb); const int e = half ? eb : ea; return W + ((size_t)e * 1024 + (size_t)u.pn * 256) * 512 * 2; }
    DI unsigned a_rowoff(const Unit&, int) const { return 0u; }
};
struct EpiMoeOut {
    static constexpr bool PERM = false;
    const float* xin; float* out; const float* g; const int* tokl; MoeTab tb; int rmask;
    DI void operator()(const f32x4 (&acc)[2][2][4][2], const Unit& u, int wr, int wc, int fr, int fq) const {
        const int r0 = wr * 64 + fr, col0 = u.pn * 256 + wc * 32 + 4 * fq; const int cn = tb.cnt[u.x1];
#pragma unroll
        for (int ai = 0; ai < 2; ++ai)
#pragma unroll
            for (int m = 0; m < 4; ++m) { const int pos = u.x0 + r0 + ai * 128 + m * 16;
                if (pos < cn) { const int tok = tokl[u.x1 * CLS_CAP + pos]; const int b = tok >> 14; const float* ip = xin + (size_t)tok * D + col0; float* op = out + (size_t)(tok & rmask) * D + col0; const float* gp = g + b * 6144 + col0;
#pragma unroll
                    for (int bj = 0; bj < 2; ++bj)
#pragma unroll
                        for (int n = 0; n < 2; ++n) { const f32x4 xv = *(const f32x4*)(ip + bj * 128 + n * 16); const f32x4 gv = *(const f32x4*)(gp + bj * 128 + n * 16);
                            *(f32x4*)(op + bj * 128 + n * 16) = xv + gv * acc[ai][bj][m][n]; } } }
    }
};

struct Ctx { LAS unsigned char* lds; int tid, lane, wave, G, bid; };
DI Ctx fresh(const Ctx& X) { Ctx P = X; int t = X.tid; asm volatile("" : "+v"(t)); P.tid = t; P.lane = t & 63; P.wave = __builtin_amdgcn_readfirstlane(t >> 6); return P; }

DI void tr_item(const float* W, int ldw, int K, bf16* WT, int k0, LAS float* scr, int lane) {
#pragma unroll 8
    for (int i = 0; i < 32; ++i) { const int kk = 2 * i + (lane >> 5); scr[kk * 33 + (lane & 31)] = W[(size_t)(k0 + kk) * ldw + (lane & 31)]; }
    LDS_WAIT(); asm volatile("" ::: "memory");
    const int c = lane & 7;
#pragma unroll
    for (int j = 0; j < 4; ++j) { const int n = (lane >> 3) + 8 * j; const LAS float* s = scr + (8 * c) * 33 + n;
        v4u o; o.x = pk2(s[0 * 33], s[1 * 33]); o.y = pk2(s[2 * 33], s[3 * 33]); o.z = pk2(s[4 * 33], s[5 * 33]); o.w = pk2(s[6 * 33], s[7 * 33]);
        *(v4u*)(WT + (size_t)n * K + k0 + 8 * c) = o; }
    LDS_WAIT(); asm volatile("" ::: "memory");
}
DI void p0_prologue(const Args& a, const Ctx& X) {
    unsigned char* ws = a.ws;
    LAS float* scr = (LAS float*)(X.lds + X.wave * 16384);
    const int gw = X.bid * 8 + X.wave, NGW = X.G * 8;
    constexpr int IT_WIN = 16 * 152, IT_AU = 8 * 32, IT_OUT = 16 * 32, IT_GU = 16 * 16 * 32, IT_DN = 16 * 8 * 32;
    constexpr int IT_L = IT_WIN + 2 * IT_AU + IT_OUT + IT_GU + IT_DN;
    for (int it = gw; it < NL * IT_L; it += NGW) {
        const int l = it / IT_L; int r = it - l * IT_L;
        if (r < IT_WIN) { const int kb = r / 152, nb = r - kb * 152, d0 = 32 * nb, s0 = d0 + (d0 >= 2304 ? 8 : 0);
            tr_item(a.w_in + (size_t)l * D * DIN_SRC + s0, DIN_SRC, D, (bf16*)(ws + WS_WIN) + ((size_t)l * NPROJ + d0) * D, 64 * kb, scr, X.lane); continue; }
        r -= IT_WIN;
        if (r < IT_AU) { const int kb = r >> 5, nb = r & 31;
            tr_item(a.w_au + (size_t)l * 512 * D + 32 * nb, D, 512, (bf16*)(ws + WS_WAU) + ((size_t)l * D + 32 * nb) * 512, 64 * kb, scr, X.lane); continue; }
        r -= IT_AU;
        if (r < IT_AU) { const int kb = r >> 5, nb = r & 31;
            tr_item(a.w_mu + (size_t)l * 512 * D + 32 * nb, D, 512, (bf16*)(ws + WS_WMU) + ((size_t)l * D + 32 * nb) * 512, 64 * kb, scr, X.lane); continue; }
        r -= IT_AU;
        if (r < IT_OUT) { const int kb = r >> 5, nb = r & 31;
            tr_item(a.w_out + (size_t)l * D * D + 32 * nb, D, D, (bf16*)(ws + WS_WOUT) + ((size_t)l * D + 32 * nb) * D, 64 * kb, scr, X.lane); continue; }
        r -= IT_OUT;
        if (r < IT_GU) { const int e = r >> 9, q = r & 511, kb = q >> 5, nb = q & 31, tq = nb >> 3, rb = nb & 7;
            const float* src = ((rb < 4) ? a.w_gate : a.w_up) + ((size_t)(l * NE + e) * D) * FF + 128 * tq + 32 * (rb & 3);
            tr_item(src, FF, D, (bf16*)(ws + WS_WGU) + ((size_t)(l * NE + e) * 1024 + 32 * nb) * D, 64 * kb, scr, X.lane); continue; }
        r -= IT_GU;
        { const int e = r >> 8, q = r & 255, kb = q >> 5, nb = q & 31;
            tr_item(a.w_down + ((size_t)(l * NE + e) * FF) * D + 32 * nb, D, FF, (bf16*)(ws + WS_WD) + ((size_t)(l * NE + e) * 1024 + 32 * nb) * FF, 64 * kb, scr, X.lane); }
    }
    { float* cs = (float*)(ws + WS_ROPE); float* sn = cs + (size_t)T * 8;
      for (int i = X.bid * 512 + X.tid; i < T * 8; i += X.G * 512) { const int tok = i >> 3, f = i & 7; const float angf = (float)a.pos[tok] * c_invf[f];
          double rev = (double)angf * 0.15915494309189535; rev -= rint(rev); const float rf = (float)rev;
          cs[i] = __builtin_amdgcn_cosf(rf); sn[i] = __builtin_amdgcn_sinf(rf); } }
    __syncthreads();
    LAS float* cact = (LAS float*)X.lds; LAS float* red = (LAS float*)(X.lds + 8192);
    for (int i = X.tid; i < 2048; i += 512) { const float cv = a.c[i]; cact[i] = cv / (1.0f + __expf(-cv)); }
    __syncthreads();
    float* mod = (float*)(ws + WS_MOD);
    for (int it = X.bid; it < NL * 96; it += X.G) { const int l = it / 96, cg = it - l * 96; const int col = cg * 64 + X.lane;
        const float* w = a.ada_w + (size_t)l * D * 6144 + col; float s0 = 0.f, s1 = 0.f;
#pragma unroll 8
        for (int kk = 0; kk < 128; ++kk) { const int k = X.wave * 128 + kk; const float wv = w[(size_t)k * 6144]; s0 += cact[k] * wv; s1 += cact[1024 + k] * wv; }
        red[(X.wave * 2 + 0) * 64 + X.lane] = s0; red[(X.wave * 2 + 1) * 64 + X.lane] = s1;
        __syncthreads();
        if (X.tid < 128) { const int b = X.tid >> 6, ln = X.tid & 63; float s = 0.f;
#pragma unroll
            for (int w8 = 0; w8 < 8; ++w8) s += red[(w8 * 2 + b) * 64 + ln];
            mod[(size_t)(l * 2 + b) * 6144 + cg * 64 + ln] = s + a.ada_b[l * 6144 + cg * 64 + ln]; }
        __syncthreads();
    }
}

DI void p1_norm_gates(const Args& a, const Ctx& X, int l, const float* xin) {
    unsigned char* ws = a.ws;
    LAS float* gwl = (LAS float*)X.lds;
    for (int idx = X.tid; idx < 8192; idx += 512) { const int k = idx >> 3, g = idx & 7; gwl[g * 1024 + k] = a.w_in[(size_t)l * D * DIN_SRC + (size_t)k * DIN_SRC + 2304 + g]; }
    __syncthreads();
    const float* mod = (const float*)(ws + WS_MOD); bf16* hb = (bf16*)(ws + WS_H); float* gates = (float*)(ws + WS_GATES);
    const int gw = X.bid * 8 + X.wave, NGW = X.G * 8;
    for (int rg = gw; rg < T / 16; rg += NGW) {
        const int row0 = rg * 16, b = row0 >> 14;
        const float* mb = mod + (size_t)(l * 2 + b) * 6144;
        f32x4 aw[4], sh[4];
#pragma unroll
        for (int j = 0; j < 4; ++j) { const int k = 256 * j + 4 * X.lane; const f32x4 nw = *(const f32x4*)(a.nmw + l * D + k); const f32x4 sc = *(const f32x4*)(mb + 1024 + k); aw[j] = nw * (sc + 1.0f); sh[j] = *(const f32x4*)(mb + k); }
#pragma unroll 1
        for (int r = 0; r < 16; ++r) { const int row = row0 + r;
            const f32x4* xr = (const f32x4*)(xin + (size_t)row * D) + X.lane; f32x4 v[4]; float ss = 0.f;
#pragma unroll
            for (int j = 0; j < 4; ++j) { v[j] = xr[64 * j]; ss += (v[j].x * v[j].x + v[j].y * v[j].y) + (v[j].z * v[j].z + v[j].w * v[j].w); }
            ss = wave_sum(ss); const float rstd = 1.0f / sqrtf(ss * (1.0f / D) + EPS);
            unsigned long long* o8 = (unsigned long long*)(hb + (size_t)row * D) + X.lane;
#pragma unroll
            for (int j = 0; j < 4; ++j) { v[j] = v[j] * rstd * aw[j] + sh[j]; o8[64 * j] = (unsigned long long)pk2(v[j].x, v[j].y) | ((unsigned long long)pk2(v[j].z, v[j].w) << 32); }
            float gp[8];
#pragma unroll
            for (int g = 0; g < 8; ++g) { float p = 0.f;
#pragma unroll
                for (int j = 0; j < 4; ++j) { const f32x4 w = *(const LAS f32x4*)(gwl + g * 1024 + 256 * j + 4 * X.lane); p += (v[j].x * w.x + v[j].y * w.y) + (v[j].z * w.z + v[j].w * w.w); }
                gp[g] = wave_sum(p); }
            if (X.lane == 0) {
#pragma unroll
                for (int g = 0; g < 4; ++g) { gates[(size_t)row * 8 + g] = gp[g] + a.b_ig[l * 4 + g];
                    const float z = gp[4 + g] + a.b_fg[l * 4 + g]; gates[(size_t)row * 8 + 4 + g] = fminf(z, 0.f) - log1pf(__expf(-fabsf(z))); } }
        }
    }
}

DI void attn_unit(const Args& a, const Ctx& X, int l, int unit) {
    unsigned char* ws = a.ws; const bf16* proj = (const bf16*)(ws + WS_PROJ); bf16* ao = (bf16*)(ws + WS_H);
    const float* cs = (const float*)(ws + WS_ROPE); const float* sn = cs + (size_t)T * 8;
    const int b = unit >> 8, rem = unit & 255, nb = rem >> 1, kvh = rem & 1; const int tok0 = b * SEQ + nb * 128;
    LAS bf16* Kl = (LAS bf16*)X.lds;
    LAS bf16* VT = (LAS bf16*)(X.lds + 36864);
    int lane = X.lane; asm volatile("" : "+v"(lane));
    const int c16 = lane & 15, quad = lane >> 4;
    {
        const int row = X.tid >> 1, half = X.tid & 1; const int tokk = tok0 - 128 + row; const bool valid = (nb > 0) || (row >= 128);
        float y[32]; float vv[32];
        if (valid) {
            const v4u* kp = (const v4u*)(proj + (size_t)tokk * NPROJ + C_AK + kvh * 64 + half * 32); const v4u* vp = (const v4u*)(proj + (size_t)tokk * NPROJ + C_AV + kvh * 64 + half * 32);
#pragma unroll
            for (int q = 0; q < 4; ++q) { const v4u kw = kp[q], vw = vp[q];
                y[8 * q + 0] = bflo(kw.x); y[8 * q + 1] = bfhi(kw.x); y[8 * q + 2] = bflo(kw.y); y[8 * q + 3] = bfhi(kw.y); y[8 * q + 4] = bflo(kw.z); y[8 * q + 5] = bfhi(kw.z); y[8 * q + 6] = bflo(kw.w); y[8 * q + 7] = bfhi(kw.w);
                vv[8 * q + 0] = bflo(vw.x); vv[8 * q + 1] = bfhi(vw.x); vv[8 * q + 2] = bflo(vw.y); vv[8 * q + 3] = bfhi(vw.y); vv[8 * q + 4] = bflo(vw.z); vv[8 * q + 5] = bfhi(vw.z); vv[8 * q + 6] = bflo(vw.w); vv[8 * q + 7] = bfhi(vw.w); }
        } else {
#pragma unroll
            for (int i = 0; i < 32; ++i) { y[i] = 0.f; vv[i] = 0.f; } }
        float ss = 0.f;
#pragma unroll
        for (int i = 0; i < 32; ++i) ss += y[i] * y[i];
        ss += __shfl_xor(ss, 1); const float rstd = 1.0f / sqrtf(ss * (1.0f / 64.0f) + EPS);
#pragma unroll
        for (int i = 0; i < 32; ++i) y[i] = y[i] * rstd * a.knw[l * 64 + half * 32 + i];
        if (half == 0 && valid) {
#pragma unroll
            for (int d = 0; d < 8; ++d) { const float c = cs[(size_t)tokk * 8 + d], s = sn[(size_t)tokk * 8 + d]; const float t1 = y[d], t2 = y[d + 8]; y[d] = t1 * c - t2 * s; y[d + 8] = t2 * c + t1 * s; } }
#pragma unroll
        for (int q = 0; q < 4; ++q) { v4u w; w.x = pk2(y[8 * q], y[8 * q + 1]); w.y = pk2(y[8 * q + 2], y[8 * q + 3]); w.z = pk2(y[8 * q + 4], y[8 * q + 5]); w.w = pk2(y[8 * q + 6], y[8 * q + 7]);
            *(LAS v4u*)(Kl + row * 72 + half * 32 + 8 * q) = w; }
#pragma unroll
        for (int i = 0; i < 32; ++i) VT[(half * 32 + i) * 280 + row] = (bf16)f2bf(vv[i]);
        if (X.tid < 64) {
#pragma unroll
            for (int cc = 256; cc < 280; ++cc) VT[X.tid * 280 + cc] = 0; }
    }
    __syncthreads();
#pragma unroll 1
    for (int task = X.wave; task < 32; task += 8) {
        const int g = task >> 3, rg = task & 7, r0 = 16 * rg, head = kvh * 4 + g; const int tokq = tok0 + r0 + c16;
        const float sink = a.sinks[l * 8 + head];
        float qv[16];
        { const bf16* qp = proj + (size_t)tokq * NPROJ + C_AQ + head * 64; const v4u w0 = *(const v4u*)(qp + 8 * quad), w1 = *(const v4u*)(qp + 32 + 8 * quad);
          qv[0] = bflo(w0.x); qv[1] = bfhi(w0.x); qv[2] = bflo(w0.y); qv[3] = bfhi(w0.y); qv[4] = bflo(w0.z); qv[5] = bfhi(w0.z); qv[6] = bflo(w0.w); qv[7] = bfhi(w0.w);
          qv[8] = bflo(w1.x); qv[9] = bfhi(w1.x); qv[10] = bflo(w1.y); qv[11] = bfhi(w1.y); qv[12] = bflo(w1.z); qv[13] = bfhi(w1.z); qv[14] = bflo(w1.w); qv[15] = bfhi(w1.w); }
        float ss = 0.f;
#pragma unroll
        for (int i = 0; i < 16; ++i) ss += qv[i] * qv[i];
        ss += __shfl_xor(ss, 16); ss += __shfl_xor(ss, 32); const float rstd = 1.0f / sqrtf(ss * (1.0f / 64.0f) + EPS);
#pragma unroll
        for (int i = 0; i < 8; ++i) { qv[i] = qv[i] * rstd * a.qnw[l * 64 + 8 * quad + i]; qv[8 + i] = qv[8 + i] * rstd * a.qnw[l * 64 + 32 + 8 * quad + i]; }
#pragma unroll
        for (int d = 0; d < 8; ++d) { const float other = __shfl_xor(qv[d], 16); const float c = cs[(size_t)tokq * 8 + d], s = sn[(size_t)tokq * 8 + d];
            if (quad == 0) qv[d] = qv[d] * c - other * s; else if (quad == 1) qv[d] = qv[d] * c + other * s; }
        bf16x8 qf[2];
        { v4u w; w.x = pk2(qv[0], qv[1]); w.y = pk2(qv[2], qv[3]); w.z = pk2(qv[4], qv[5]); w.w = pk2(qv[6], qv[7]); qf[0] = __builtin_bit_cast(bf16x8, w);
          w.x = pk2(qv[8], qv[9]); w.y = pk2(qv[10], qv[11]); w.z = pk2(qv[12], qv[13]); w.w = pk2(qv[14], qv[15]); qf[1] = __builtin_bit_cast(bf16x8, w); }
        f32x4 sacc[9];
#pragma unroll
        for (int i = 0; i < 9; ++i) { const LAS bf16* kr = Kl + (16 * (rg + i) + c16) * 72 + 8 * quad;
            const bf16x8 k0 = *(const LAS bf16x8*)kr, k1 = *(const LAS bf16x8*)(kr + 32);
            f32x4 z = {0.f, 0.f, 0.f, 0.f}; z = __builtin_amdgcn_mfma_f32_16x16x32_bf16(k0, qf[0], z, 0, 0, 0); sacc[i] = __builtin_amdgcn_mfma_f32_16x16x32_bf16(k1, qf[1], z, 0, 0, 0); }
        int dbase = 4 * quad - c16; asm volatile("" : "+v"(dbase)); int kbase = 16 * rg + 4 * quad; asm volatile("" : "+v"(kbase)); float mx = sink;
#pragma unroll
        for (int i = 0; i < 9; ++i)
#pragma unroll
            for (int j = 0; j < 4; ++j) { const int dlt = dbase + 16 * i + j; const int kj = kbase + 16 * i + j; const bool ok = (dlt > 0) && (dlt <= 128) && ((nb > 0) || (kj >= 128));
                const float s = ok ? sacc[i][j] * 0.125f : -3.0e38f; sacc[i][j] = s; mx = fmaxf(mx, s); }
        mx = fmaxf(mx, __shfl_xor(mx, 16)); mx = fmaxf(mx, __shfl_xor(mx, 32));
        float sum = 0.f;
#pragma unroll
        for (int i = 0; i < 9; ++i)
#pragma unroll
            for (int j = 0; j < 4; ++j) { const float p = (sacc[i][j] > -1.0e38f) ? __expf(sacc[i][j] - mx) : 0.f; sacc[i][j] = p; sum += p; }
        sum += __shfl_xor(sum, 16); sum += __shfl_xor(sum, 32);
        const float inv = 1.0f / (sum + __expf(sink - mx));
        f32x4 oacc[4];
#pragma unroll
        for (int et = 0; et < 4; ++et) oacc[et] = (f32x4){0.f, 0.f, 0.f, 0.f};
#pragma unroll
        for (int kk = 0; kk < 5; ++kk) {
            v4u pw; pw.x = pk2(sacc[2 * kk][0], sacc[2 * kk][1]); pw.y = pk2(sacc[2 * kk][2], sacc[2 * kk][3]);
            if (2 * kk + 1 < 9) { pw.z = pk2(sacc[(2 * kk + 1 < 9) ? 2 * kk + 1 : 0][0], sacc[(2 * kk + 1 < 9) ? 2 * kk + 1 : 0][1]); pw.w = pk2(sacc[(2 * kk + 1 < 9) ? 2 * kk + 1 : 0][2], sacc[(2 * kk + 1 < 9) ? 2 * kk + 1 : 0][3]); } else { pw.z = 0u; pw.w = 0u; }
            const bf16x8 pf = __builtin_bit_cast(bf16x8, pw);
#pragma unroll
            for (int et = 0; et < 4; ++et) { const LAS bf16* vr = VT + (16 * et + c16) * 280 + 16 * rg + 32 * kk + 4 * quad;
                const v2u lo = *(const LAS v2u*)vr, hi = *(const LAS v2u*)(vr + 16); v4u vw; vw.x = lo.x; vw.y = lo.y; vw.z = hi.x; vw.w = hi.y;
                oacc[et] = __builtin_amdgcn_mfma_f32_16x16x32_bf16(__builtin_bit_cast(bf16x8, vw), pf, oacc[et], 0, 0, 0); }
        }
#pragma unroll
        for (int et = 0; et < 4; ++et) { v2u w; w.x = pk2(oacc[et][0] * inv, oacc[et][1] * inv); w.y = pk2(oacc[et][2] * inv, oacc[et][3] * inv);
            *(v2u*)(ao + (size_t)tokq * 512 + head * 64 + 16 * et + 4 * quad) = w; }
    }
    __syncthreads();
}

constexpr int ML_Q = 0, ML_K = 17408, ML_KET = 34816, ML_VT = 53248, ML_CT = 73984, ML_CW = 113152, ML_CB = 118272, ML_RED = 118784, ML_NW = 119296;
template <bool L3> DI void mlstm_unit(const Args& a, const Ctx& X, int l, int unit) {
    unsigned char* ws = a.ws; const bf16* proj = (const bf16*)(ws + WS_PROJ); bf16* hm = (bf16*)(ws + WS_H) + (size_t)T * 512;
    const float* gates = (const float*)(ws + WS_GATES); float* mlc = (float*)(ws + WS_MLC) + (size_t)unit * 18432; float* mlb = (float*)(ws + WS_MLB);
    const int seq = unit >> 5, sj = unit & 31, b = seq >> 2, hh = seq & 3; const int tokbase = b * SEQ + sj * 512;
    LAS bf16* Qs = (LAS bf16*)(X.lds + ML_Q); LAS bf16* Ks = (LAS bf16*)(X.lds + ML_K); LAS bf16* KET = (LAS bf16*)(X.lds + ML_KET);
    LAS bf16* VT = (LAS bf16*)(X.lds + ML_VT); LAS bf16* CT = (LAS bf16*)(X.lds + ML_CT); LAS float* CW = (LAS float*)(X.lds + ML_CW);
    LAS float* CB = (LAS float*)(X.lds + ML_CB); LAS float* RED = (LAS float*)(X.lds + ML_RED); LAS float* NW = (LAS float*)(X.lds + ML_NW);
    int lane = X.lane; asm volatile("" : "+v"(lane));
    const int c16 = lane & 15, quad = lane >> 4, w = X.wave;
    for (int idx = X.tid; idx < 1280; idx += 512) { const int tap = idx >> 8, ch = idx & 255; const int gch = (ch < 128) ? (hh * 128 + ch) : (512 + hh * 128 + (ch - 128));
        CW[idx] = (tap < 4) ? a.conv_w[(size_t)(l * 4 + tap) * 1024 + gch] : a.conv_b[l * 1024 + gch]; }
    for (int idx = X.tid; idx < 16 * 72; idx += 512) VT[128 * 72 + idx] = (idx < 72) ? (bf16)0x3F80 : (bf16)0;
    if (X.tid < 128) NW[X.tid] = a.mnw[l * 512 + hh * 128 + X.tid];
    f32x4 cacc[9];
#pragma unroll
    for (int et = 0; et < 9; ++et) {
        if (L3) {
#pragma unroll
            for (int j = 0; j < 4; ++j) { const float v = mlc[(16 * et + 4 * quad + j) * 128 + 16 * w + c16]; cacc[et][j] = v; CT[(16 * et + 4 * quad + j) * 136 + 16 * w + c16] = (bf16)f2bf(v); }
        } else cacc[et] = (f32x4){0.f, 0.f, 0.f, 0.f};
    }
    float bsum = 0.f;
    __syncthreads();
#pragma unroll 1
    for (int c = 0; c < 8; ++c) {
        const int tok0 = tokbase + c * 64;
        float bsc = gates[(size_t)(tok0 + lane) * 8 + 4 + hh]; const float li = gates[(size_t)(tok0 + lane) * 8 + hh];
#pragma unroll
        for (int o = 1; o < 64; o <<= 1) { const float v = __shfl_up(bsc, o); if (lane >= o) bsc += v; }
        const float bl = __shfl(bsc, 63); const float csv = li - bsc;
        if (w == 0) { CB[lane] = bsc; CB[64 + lane] = csv; }
        bsum += bl;
        { const int t = X.tid >> 3, dc = X.tid & 7; const float fac = __expf(bl + __shfl(csv, t));
          const int tokt = tok0 + t;
#pragma unroll
          for (int qk = (L3 ? 0 : 1); qk < 2; ++qk) {
              float accv[16];
#pragma unroll
              for (int i = 0; i < 16; ++i) accv[i] = CW[4 * 256 + qk * 128 + 16 * dc + i];
#pragma unroll
              for (int j = 0; j < 4; ++j) { const int tt = tokt - 3 + j;
                  if (tt >= b * SEQ) { const v4u* p = (const v4u*)(proj + (size_t)tt * NPROJ + (qk ? C_MK : C_MQ) + hh * 128 + 16 * dc); const v4u w0 = p[0], w1 = p[1];
                      const float xv[16] = {bflo(w0.x), bfhi(w0.x), bflo(w0.y), bfhi(w0.y), bflo(w0.z), bfhi(w0.z), bflo(w0.w), bfhi(w0.w), bflo(w1.x), bfhi(w1.x), bflo(w1.y), bfhi(w1.y), bflo(w1.z), bfhi(w1.z), bflo(w1.w), bfhi(w1.w)};
#pragma unroll
                      for (int i = 0; i < 16; ++i) accv[i] += CW[j * 256 + qk * 128 + 16 * dc + i] * xv[i]; } }
#pragma unroll
              for (int i = 0; i < 16; ++i) { const float z = accv[i]; accv[i] = z / (1.0f + __expf(-z)) * (qk ? 0.08838834764831845f : 1.0f); }
              if (L3) { LAS bf16* dst = (qk ? Ks : Qs) + t * 136 + 16 * dc;
                  v4u o0, o1; o0.x = pk2(accv[0], accv[1]); o0.y = pk2(accv[2], accv[3]); o0.z = pk2(accv[4], accv[5]); o0.w = pk2(accv[6], accv[7]);
                  o1.x = pk2(accv[8], accv[9]); o1.y = pk2(accv[10], accv[11]); o1.z = pk2(accv[12], accv[13]); o1.w = pk2(accv[14], accv[15]);
                  *(LAS v4u*)dst = o0; *(LAS v4u*)(dst + 8) = o1; }
              if (qk) {
#pragma unroll
                  for (int i = 0; i < 16; ++i) KET[(16 * dc + i) * 72 + t] = (bf16)f2bf(accv[i] * fac); }
          }
          { const v4u* p = (const v4u*)(proj + (size_t)tokt * NPROJ + C_MV + hh * 128 + 16 * dc); const v4u w0 = p[0], w1 = p[1];
            const unsigned ww[8] = {w0.x, w0.y, w0.z, w0.w, w1.x, w1.y, w1.z, w1.w};
#pragma unroll
            for (int i = 0; i < 8; ++i) { VT[(16 * dc + 2 * i) * 72 + t] = (bf16)(ww[i] & 0xffffu); VT[(16 * dc + 2 * i + 1) * 72 + t] = (bf16)(ww[i] >> 16); } }
        }
        __syncthreads();
        float hval[4][4]; int tt_ = w & 3, eh = w >> 2; const int tq = 16 * tt_ + c16;
        if (L3) {
            bf16x8 qf[4];
#pragma unroll
            for (int ks = 0; ks < 4; ++ks) qf[ks] = *(const LAS bf16x8*)(Qs + tq * 136 + 32 * ks + 8 * quad);
            f32x4 sacc[4];
#pragma unroll
            for (int st = 0; st < 4; ++st) { f32x4 z = {0.f, 0.f, 0.f, 0.f};
#pragma unroll
                for (int ks = 0; ks < 4; ++ks) z = __builtin_amdgcn_mfma_f32_16x16x32_bf16(*(const LAS bf16x8*)(Ks + (16 * st + c16) * 136 + 32 * ks + 8 * quad), qf[ks], z, 0, 0, 0);
                sacc[st] = z; }
            const float cbt = CB[tq];
#pragma unroll
            for (int st = 0; st < 4; ++st)
#pragma unroll
                for (int j = 0; j < 4; ++j) { const int s = 16 * st + 4 * quad + j; const float d = (s <= tq) ? __expf(cbt + CB[64 + s]) : 0.f; sacc[st][j] *= d; }
            bf16x8 pf[2];
#pragma unroll
            for (int kk = 0; kk < 2; ++kk) { v4u pw; pw.x = pk2(sacc[2 * kk][0], sacc[2 * kk][1]); pw.y = pk2(sacc[2 * kk][2], sacc[2 * kk][3]); pw.z = pk2(sacc[2 * kk + 1][0], sacc[2 * kk + 1][1]); pw.w = pk2(sacc[2 * kk + 1][2], sacc[2 * kk + 1][3]); pf[kk] = __builtin_bit_cast(bf16x8, pw); }
            const float ebt = __expf(cbt);
            f32x4 nn[5];
#pragma unroll
            for (int x = 0; x < 5; ++x) { const int et = (x < 4) ? (4 * eh + x) : 8; f32x4 na = {0.f, 0.f, 0.f, 0.f}, ia = {0.f, 0.f, 0.f, 0.f};
#pragma unroll
                for (int kk = 0; kk < 2; ++kk) { const LAS bf16* vr = VT + (16 * et + c16) * 72 + 32 * kk + 4 * quad; const v2u lo = *(const LAS v2u*)vr, hi = *(const LAS v2u*)(vr + 16); v4u vw; vw.x = lo.x; vw.y = lo.y; vw.z = hi.x; vw.w = hi.y;
                    na = __builtin_amdgcn_mfma_f32_16x16x32_bf16(__builtin_bit_cast(bf16x8, vw), pf[kk], na, 0, 0, 0); }
#pragma unroll
                for (int ks = 0; ks < 4; ++ks) ia = __builtin_amdgcn_mfma_f32_16x16x32_bf16(*(const LAS bf16x8*)(CT + (16 * et + c16) * 136 + 32 * ks + 8 * quad), qf[ks], ia, 0, 0, 0);
                nn[x] = na + ia * ebt; }
            const float den = __shfl(nn[4][0], c16); const float inv = 1.0f / fmaxf(fabsf(den), 1.0f);
            float ss = 0.f;
#pragma unroll
            for (int x = 0; x < 4; ++x)
#pragma unroll
                for (int j = 0; j < 4; ++j) { hval[x][j] = nn[x][j] * inv; ss += hval[x][j] * hval[x][j]; }
            ss += __shfl_xor(ss, 16); ss += __shfl_xor(ss, 32);
            if (quad == 0) RED[eh * 64 + tq] = ss;
            __syncthreads();
            const float rstd = 1.0f / sqrtf((RED[tq] + RED[64 + tq]) * (1.0f / 128.0f) + EPS);
#pragma unroll
            for (int x = 0; x < 4; ++x) { const int e = 16 * (4 * eh + x) + 4 * quad; const v2u og = *(const v2u*)(proj + (size_t)(tok0 + tq) * NPROJ + C_MO + hh * 128 + e);
                const float y0 = hval[x][0] * rstd * NW[e] * bflo(og.x), y1 = hval[x][1] * rstd * NW[e + 1] * bfhi(og.x), y2 = hval[x][2] * rstd * NW[e + 2] * bflo(og.y), y3 = hval[x][3] * rstd * NW[e + 3] * bfhi(og.y);
                v2u o; o.x = pk2(y0, y1); o.y = pk2(y2, y3); *(v2u*)(hm + (size_t)(tok0 + tq) * 512 + hh * 128 + e) = o; }
        }
        { const float ebl = __expf(bl);
          bf16x8 kf[2];
#pragma unroll
          for (int kk = 0; kk < 2; ++kk) kf[kk] = *(const LAS bf16x8*)(KET + (16 * w + c16) * 72 + 32 * kk + 8 * quad);
#pragma unroll
          for (int et = 0; et < 9; ++et) { f32x4 z = cacc[et] * ebl;
#pragma unroll
              for (int kk = 0; kk < 2; ++kk) z = __builtin_amdgcn_mfma_f32_16x16x32_bf16(*(const LAS bf16x8*)(VT + (16 * et + c16) * 72 + 32 * kk + 8 * quad), kf[kk], z, 0, 0, 0);
              cacc[et] = z;
              if (L3) {
#pragma unroll
                  for (int j = 0; j < 4; ++j) CT[(16 * et + 4 * quad + j) * 136 + 16 * w + c16] = (bf16)f2bf(z[j]); } } }
        __syncthreads();
    }
    if (!L3) {
#pragma unroll
        for (int et = 0; et < 9; ++et)
#pragma unroll
            for (int j = 0; j < 4; ++j) mlc[(16 * et + 4 * quad + j) * 128 + 16 * w + c16] = cacc[et][j];
        if (X.tid == 0) mlb[unit] = bsum;
    }
}
DI void mlstm_scan(const Args& a, const Ctx& X) {
    float* mlc = (float*)(a.ws + WS_MLC); const float* mlb = (const float*)(a.ws + WS_MLB);
    for (int idx = X.bid * 512 + X.tid; idx < 8 * 18432; idx += X.G * 512) { const int seq = idx / 18432, el = idx - seq * 18432; float carry = 0.f;
        for (int j = 0; j < 32; ++j) { const int u = seq * 32 + j; float* p = mlc + (size_t)u * 18432 + el; const float tmp = *p; *p = carry; carry = __expf(mlb[u]) * carry + tmp; } }
}

DI void p6_norm_route(const Args& a, const Ctx& X, int l, const float* xin) {
    unsigned char* ws = a.ws;
    LAS float* wr = (LAS float*)X.lds;
    for (int idx = X.tid; idx < 16384; idx += 512) { const int k = idx >> 4, e = idx & 15; wr[e * 1024 + k] = a.router_w[idx]; }
    __syncthreads();
    const float* mod = (const float*)(ws + WS_MOD); bf16* hb = (bf16*)(ws + WS_H); float* tgate = (float*)(ws + WS_TGATE); int* tokl = (int*)(ws + WS_TOKL);
    unsigned* cnt = (unsigned*)(ws + WS_CTL) + CW_CNT + l * 32;
    const int gw = X.bid * 8 + X.wave, NGW = X.G * 8;
    for (int rg = gw; rg < T / 16; rg += NGW) {
        const int row0 = rg * 16, b = row0 >> 14;
        const float* mb = mod + (size_t)(l * 2 + b) * 6144;
        f32x4 aw[4], sh[4];
#pragma unroll
        for (int j = 0; j < 4; ++j) { const int k = 256 * j + 4 * X.lane; const f32x4 nw = *(const f32x4*)(a.nfw + l * D + k); const f32x4 sc = *(const f32x4*)(mb + 4 * 1024 + k); aw[j] = nw * (sc + 1.0f); sh[j] = *(const f32x4*)(mb + 3 * 1024 + k); }
        int my_cls = 0; float my_ga = 0.f, my_gb = 0.f;
#pragma unroll 1
        for (int r = 0; r < 16; ++r) { const int row = row0 + r;
            const f32x4* xr = (const f32x4*)(xin + (size_t)row * D) + X.lane; f32x4 v[4]; float ss = 0.f;
#pragma unroll
            for (int j = 0; j < 4; ++j) { v[j] = xr[64 * j]; ss += (v[j].x * v[j].x + v[j].y * v[j].y) + (v[j].z * v[j].z + v[j].w * v[j].w); }
            ss = wave_sum(ss); const float rstd = 1.0f / sqrtf(ss * (1.0f / D) + EPS);
            unsigned long long* o8 = (unsigned long long*)(hb + (size_t)row * D) + X.lane;
#pragma unroll
            for (int j = 0; j < 4; ++j) { v[j] = v[j] * rstd * aw[j] + sh[j]; o8[64 * j] = (unsigned long long)pk2(v[j].x, v[j].y) | ((unsigned long long)pk2(v[j].z, v[j].w) << 32); }
            float sc[16], sel[16];
#pragma unroll
            for (int e = 0; e < 16; ++e) { float p = 0.f;
#pragma unroll
                for (int j = 0; j < 4; ++j) { const f32x4 wv = *(const LAS f32x4*)(wr + e * 1024 + 256 * j + 4 * X.lane); p += (v[j].x * wv.x + v[j].y * wv.y) + (v[j].z * wv.z + v[j].w * wv.w); }
                p = wave_sum(p); sc[e] = 1.0f / (1.0f + __expf(-p)); sel[e] = sc[e] + a.router_b[e]; __builtin_amdgcn_sched_barrier(0); }
            int gi = 0; float gbest = -1.0e30f;
#pragma unroll
            for (int g = 0; g < 4; ++g) { const float p0 = sel[4 * g], p1 = sel[4 * g + 1], p2 = sel[4 * g + 2], p3 = sel[4 * g + 3];
                const float gs = fmaxf(fmaxf(fmaxf(p0 + p1, p0 + p2), fmaxf(p0 + p3, p1 + p2)), fmaxf(p1 + p3, p2 + p3));
                if (gs > gbest) { gbest = gs; gi = g; } }
            float q[4], s4[4];
#pragma unroll
            for (int i = 0; i < 4; ++i) { q[i] = 0.f; s4[i] = 0.f; }
#pragma unroll
            for (int g = 0; g < 4; ++g) if (g == gi) {
#pragma unroll
                for (int i = 0; i < 4; ++i) { q[i] = sel[4 * g + i]; s4[i] = sc[4 * g + i]; } }
            int i1 = 0; float b1 = q[0];
#pragma unroll
            for (int i = 1; i < 4; ++i) if (q[i] > b1) { b1 = q[i]; i1 = i; }
            int i2 = -1; float b2 = -1.0e30f;
#pragma unroll
            for (int i = 0; i < 4; ++i) if (i != i1 && q[i] > b2) { b2 = q[i]; i2 = i; }
            const int ia = (i1 < i2) ? i1 : i2, ib = (i1 < i2) ? i2 : i1;
            float sa = 0.f, sb = 0.f;
#pragma unroll
            for (int i = 0; i < 4; ++i) { if (i == ia) sa = s4[i]; if (i == ib) sb = s4[i]; }
            const int pidx = (ia == 0) ? (ib - 1) : ((ia == 1) ? (ib + 1) : 5);
            const float inv = 1.0f / (sa + sb);
            if (X.lane == r) { my_cls = gi * 6 + pidx; my_ga = sa * inv; my_gb = sb * inv; }
        }
        if (X.lane < 16) { const int tok = row0 + X.lane; const unsigned pos = __hip_atomic_fetch_add(cnt + my_cls, 1u, RLX_AGENT);
            tokl[my_cls * CLS_CAP + (int)pos] = tok; tgate[tok * 2] = my_ga; tgate[tok * 2 + 1] = my_gb; }
    }
}
DI MoeTab moe_tables(const Args& a, const Ctx& X, int l) {
    LAS int* tab = (LAS int*)(X.lds + TAB_OFF); LAS int* tcls = tab; LAS int* tpos = tab + 160; LAS int* cn = tab + 320; LAS int* rt_ = tab + 344;
    unsigned* cnt = (unsigned*)(a.ws + WS_CTL) + CW_CNT + l * 32;
    if (X.tid < NCLS) cn[X.tid] = (int)__hip_atomic_load(cnt + X.tid, RLX_AGENT);
    __syncthreads();
    if (X.tid == 0) { int r = 0;
#pragma unroll 1
        for (int c = 0; c < NCLS; ++c) { const int n = (cn[c] + 255) >> 8;
#pragma unroll 1
            for (int i = 0; i < n; ++i) { tcls[r] = c; tpos[r] = i * 256; ++r; } }
        rt_[0] = r; }
    __syncthreads();
    MoeTab tb; tb.tcls = tcls; tb.tpos = tpos; tb.cnt = cn; tb.Rtot = __builtin_amdgcn_readfirstlane(rt_[0]); return tb;
}

#if defined(__HIP_DEVICE_COMPILE__)
DI Args load_args() { auto p = __builtin_amdgcn_kernarg_segment_ptr(); asm volatile("" : "+s"(p)); return *(const __attribute__((address_space(4))) Args*)p; }
#else
DI Args load_args() { return Args{}; }
#endif
__global__ void __launch_bounds__(512, 2) fwd(Args a_unused) {
    extern __shared__ __attribute__((aligned(16))) unsigned char lds_raw[];
    Ctx X; X.lds = (LAS unsigned char*)lds_raw; X.tid = threadIdx.x; X.lane = X.tid & 63; X.wave = __builtin_amdgcn_readfirstlane(X.tid >> 6); X.G = gridDim.x; X.bid = blockIdx.x;
    volatile LAS unsigned* MISC = (volatile LAS unsigned*)(X.lds + MISC_OFF);
    if (X.tid < 64) MISC[X.tid] = 0u;
    __syncthreads();
    int lo, hi; unsigned* ctl;
    { const Args a = load_args(); lo = a.ph_lo; hi = a.ph_hi; ctl = (unsigned*)(a.ws + WS_CTL); }
    XcdBarrier bar; bar.bar = ctl + CW_BAR; bar.x = 0; bar.st = MISC + 8;
    if (hi - lo > 1) bar = xcd_barrier_post(ctl + CW_BAR, MISC + 8);
#ifndef PH_MASK
#define PH_MASK 0xFFFFF
#endif
#define PON(p) ((PH_MASK >> (p)) & 1)
#ifndef DUP_MASK
#define DUP_MASK 0
#endif
#define NREP(p) (((DUP_MASK >> (p)) & 1) ? 2 : 1)
#define IN(k) (lo <= (k) && (k) < hi)
#define SEAM(k) do { if (IN(k) && IN((k) + 1)) xcd_barrier(bar); } while (0)
    if (PON(10) && IN(0)) { for (int rep = 0; rep < NREP(10); ++rep) { const Args a = load_args(); p0_prologue(a, X); } }
    SEAM(0);
    for (int l = 0; l < NL; ++l) {
        const int g0 = 1 + l * NPH;
        if (PON(0) && IN(g0 + 0)) { for (int rep = 0; rep < NREP(0); ++rep) { const Args a = load_args(); unsigned char* ws = a.ws; const float* mod = (const float*)(ws + WS_MOD); bf16* proj = (bf16*)(ws + WS_PROJ); const float* xin = (l == 0) ? a.x : a.out; (void)mod; (void)proj; (void)xin; const Ctx P = fresh(X); p1_norm_gates(a, P, l, xin); } }
        SEAM(g0 + 0);
        if (PON(1) && IN(g0 + 1)) for (int rep = 0; rep < NREP(1); ++rep) { const Args a = load_args(); unsigned char* ws = a.ws; const float* mod = (const float*)(ws + WS_MOD); bf16* proj = (bf16*)(ws + WS_PROJ); const float* xin = (l == 0) ? a.x : a.out; (void)mod; (void)proj; (void)xin; const Ctx P = fresh(X);
            DenseSched S; S.A = (const char*)(ws + WS_H); S.Bt = (const char*)(ws + WS_WIN) + (size_t)l * NPROJ * D * 2; S.lda = D; S.ldb = D; S.ord.init(T / 256, NPROJ / 256, P.G, P.bid);
            EpiProj E; E.O = proj;
            pg8::gemm_phase<EpiProj, DenseSched>(P.lds, D, S, E);
        }
        SEAM(g0 + 1);
        if (PON(2) && IN(g0 + 2)) { const Args a = load_args(); unsigned char* ws = a.ws; const float* mod = (const float*)(ws + WS_MOD); bf16* proj = (bf16*)(ws + WS_PROJ); const float* xin = (l == 0) ? a.x : a.out; (void)mod; (void)proj; (void)xin; const Ctx P = fresh(X);
            if (PON(11)) for (int rep = 0; rep < NREP(11); ++rep) {
#pragma unroll 1
                for (int u = P.bid; u < 512; u += P.G) attn_unit(a, P, l, u); }
            if (PON(12)) for (int rep = 0; rep < NREP(12); ++rep) {
#pragma unroll 1
                for (int u = P.bid; u < 256; u += P.G) mlstm_unit<false>(a, P, l, u); }
        }
        SEAM(g0 + 2);
        if (PON(3) && IN(g0 + 3)) { const Args a = load_args(); unsigned char* ws = a.ws; const float* mod = (const float*)(ws + WS_MOD); bf16* proj = (bf16*)(ws + WS_PROJ); const float* xin = (l == 0) ? a.x : a.out; (void)mod; (void)proj; (void)xin; const Ctx P = fresh(X); mlstm_scan(a, P); }
        SEAM(g0 + 3);
        if (PON(4) && IN(g0 + 4)) for (int rep = 0; rep < NREP(4); ++rep) { const Args a = load_args(); unsigned char* ws = a.ws; const float* mod = (const float*)(ws + WS_MOD); bf16* proj = (bf16*)(ws + WS_PROJ); const float* xin = (l == 0) ? a.x : a.out; (void)mod; (void)proj; (void)xin; const Ctx P = fresh(X);
#pragma unroll 1
            for (int u = P.bid; u < 256; u += P.G) mlstm_unit<true>(a, P, l, u); }
        SEAM(g0 + 4);
        if (PON(5) && IN(g0 + 5)) for (int rep = 0; rep < NREP(5); ++rep) { const Args a = load_args(); unsigned char* ws = a.ws; const float* mod = (const float*)(ws + WS_MOD); bf16* proj = (bf16*)(ws + WS_PROJ); const float* xin = (l == 0) ? a.x : a.out; (void)mod; (void)proj; (void)xin; const Ctx P = fresh(X);
            { DenseSched S; S.A = (const char*)(ws + WS_H); S.Bt = (const char*)(ws + WS_WAU) + (size_t)l * D * 512 * 2; S.lda = 512; S.ldb = 512; S.ord.init(T / 256, D / 256, P.G, P.bid);
              EpiGate<false> E; E.P = proj; E.gcol = C_GA; pg8::gemm_phase<EpiGate<false>, DenseSched>(P.lds, 512, S, E); }
            { DenseSched S; S.A = (const char*)(ws + WS_H) + (size_t)T * 512 * 2; S.Bt = (const char*)(ws + WS_WMU) + (size_t)l * D * 512 * 2; S.lda = 512; S.ldb = 512; S.ord.init(T / 256, D / 256, P.G, P.bid);
              EpiGate<true> E; E.P = proj; E.gcol = C_GB; pg8::gemm_phase<EpiGate<true>, DenseSched>(P.lds, 512, S, E); }
        }
        SEAM(g0 + 5);
        if (PON(6) && IN(g0 + 6)) for (int rep = 0; rep < NREP(6); ++rep) { const Args a = load_args(); unsigned char* ws = a.ws; const float* mod = (const float*)(ws + WS_MOD); bf16* proj = (bf16*)(ws + WS_PROJ); const float* xin = (l == 0) ? a.x : a.out; (void)mod; (void)proj; (void)xin; const Ctx P = fresh(X);
            DenseSched S; S.A = (const char*)(proj + C_MQ); S.Bt = (const char*)(ws + WS_WOUT) + (size_t)l * D * D * 2; S.lda = NPROJ; S.ldb = D; S.ord.init(T / 256, D / 256, P.G, P.bid);
            EpiRes E; E.xin = xin; E.out = a.out; E.g = mod + (size_t)(l * 2) * 6144 + 2 * 1024; E.rmask = T - 1;
            if (rep) { E.out = (float*)(ws + WS_H); E.rmask = T / 2 - 1; }
            pg8::gemm_phase<EpiRes, DenseSched>(P.lds, D, S, E);
        }
        SEAM(g0 + 6);
        if (PON(7) && IN(g0 + 7)) { const Args a = load_args(); unsigned char* ws = a.ws; const float* mod = (const float*)(ws + WS_MOD); bf16* proj = (bf16*)(ws + WS_PROJ); const float* xin = (l == 0) ? a.x : a.out; (void)mod; (void)proj; (void)xin; const Ctx P = fresh(X); p6_norm_route(a, P, l, a.out); }
        SEAM(g0 + 7);
        if (PON(8) && IN(g0 + 8)) for (int rep = 0; rep < NREP(8); ++rep) { const Args a = load_args(); unsigned char* ws = a.ws; const float* mod = (const float*)(ws + WS_MOD); bf16* proj = (bf16*)(ws + WS_PROJ); const float* xin = (l == 0) ? a.x : a.out; (void)mod; (void)proj; (void)xin; const Ctx P = fresh(X);
            const MoeTab tb = moe_tables(a, P, l);
            LAS unsigned* tokoff = (LAS unsigned*)(P.lds + TOKOFF_OFF); const int* tokl = (const int*)(ws + WS_TOKL);
#pragma unroll 1
            for (int s = 0; s < 8; ++s) { const int L = s * P.G + P.bid;
                if (L < tb.Rtot * 8 && P.tid < 256) { const int rt = L >> 3, cls = tb.tcls[rt], pos = tb.tpos[rt] + P.tid, cn = tb.cnt[cls]; const int tok = tokl[cls * CLS_CAP + (pos < cn ? pos : 0)]; tokoff[s * 256 + P.tid] = (unsigned)tok; } }
            __syncthreads();
            MoeUpSched S; S.A = (const char*)(ws + WS_H); S.W = (const char*)(ws + WS_WGU) + (size_t)l * NE * 1024 * D * 2; S.lda = D; S.ldb = D; S.tb = tb; S.G = P.G; S.c = P.bid; S.tokoff = tokoff;
            EpiSwiglu E; E.H = proj; E.tgate = (const float*)(ws + WS_TGATE); E.tokoff = tokoff;
            pg8::gemm_phase<EpiSwiglu, MoeUpSched>(P.lds, D, S, E);
        }
        SEAM(g0 + 8);
        if (PON(9) && IN(g0 + 9)) for (int rep = 0; rep < NREP(9); ++rep) { const Args a = load_args(); unsigned char* ws = a.ws; const float* mod = (const float*)(ws + WS_MOD); bf16* proj = (bf16*)(ws + WS_PROJ); const float* xin = (l == 0) ? a.x : a.out; (void)mod; (void)proj; (void)xin; const Ctx P = fresh(X);
            const MoeTab tb = moe_tables(a, P, l);
            MoeDownSched S; S.A = (const char*)proj; S.W = (const char*)(ws + WS_WD) + (size_t)l * NE * 1024 * FF * 2; S.lda = D; S.ldb = FF; S.tb = tb; S.G = P.G; S.c = P.bid;
            EpiMoeOut E; E.xin = a.out; E.out = a.out; E.g = mod + (size_t)(l * 2) * 6144 + 5 * 1024; E.tokl = (const int*)(ws + WS_TOKL); E.tb = tb; E.rmask = T - 1;
            if (rep) { E.out = (float*)(ws + WS_H); E.rmask = T / 2 - 1; }
            pg8::gemm_phase<EpiMoeOut, MoeDownSched>(P.lds, D, S, E);
        }
        SEAM(g0 + 9);
    }
#undef IN
#undef SEAM
}

extern "C" void kernel_launch(void* const* d_in, const int* in_sizes, int n_in, void* d_out, int out_size, void* d_ws, size_t ws_size, hipStream_t stream) {
    static int grid = 0;
    if (grid == 0) {
        if (n_in != 24 || in_sizes[0] != T * D || out_size != T * D || ws_size < WS_END) { fprintf(stderr, "kernel_launch: unexpected shapes / workspace (n_in %d, ws %zu, need %zu)\n", n_in, ws_size, (size_t)WS_END); grid = -1; return; }
        int dev = 0, cus = 0;
        if (hipGetDevice(&dev) != hipSuccess || hipDeviceGetAttribute(&cus, hipDeviceAttributeMultiprocessorCount, dev) != hipSuccess) { grid = -1; return; }
        if (hipFuncSetAttribute((const void*)fwd, hipFuncAttributeMaxDynamicSharedMemorySize, LDS_BYTES) != hipSuccess) { fprintf(stderr, "kernel_launch: hipFuncSetAttribute failed\n"); grid = -1; return; }
        int per_cu = 0;
        if (hipOccupancyMaxActiveBlocksPerMultiprocessor(&per_cu, (const void*)fwd, 512, LDS_BYTES) != hipSuccess || per_cu < 1) fprintf(stderr, "kernel_launch: occupancy query reports %d\n", per_cu);
        (void)hipGetLastError();
        grid = cus < 256 ? cus : 256;
    }
    if (grid < 0) return;
    (void)hipMemsetAsync((char*)d_ws + WS_CTL, 0, CTL_ZERO_BYTES, stream);
    Args a{};
    a.x = (const float*)d_in[0]; a.c = (const float*)d_in[1]; a.pos = (const int*)d_in[2]; a.ada_w = (const float*)d_in[3]; a.ada_b = (const float*)d_in[4];
    a.nmw = (const float*)d_in[5]; a.nfw = (const float*)d_in[6]; a.w_in = (const float*)d_in[7]; a.b_ig = (const float*)d_in[8]; a.b_fg = (const float*)d_in[9];
    a.qnw = (const float*)d_in[10]; a.knw = (const float*)d_in[11]; a.sinks = (const float*)d_in[12]; a.conv_w = (const float*)d_in[13]; a.conv_b = (const float*)d_in[14];
    a.mnw = (const float*)d_in[15]; a.w_au = (const float*)d_in[16]; a.w_mu = (const float*)d_in[17]; a.w_out = (const float*)d_in[18]; a.router_w = (const float*)d_in[19];
    a.router_b = (const float*)d_in[20]; a.w_gate = (const float*)d_in[21]; a.w_up = (const float*)d_in[22]; a.w_down = (const float*)d_in[23];
    a.out = (float*)d_out; a.ws = (unsigned char*)d_ws;
#if MK_MULTI
    for (int gp = 0; gp < NGP; ++gp) { a.ph_lo = gp; a.ph_hi = gp + 1; hipLaunchKernelGGL(fwd, dim3(grid), dim3(512), LDS_BYTES, stream, a); }
#else
    a.ph_lo = 0; a.ph_hi = NGP; hipLaunchKernelGGL(fwd, dim3(grid), dim3(512), LDS_BYTES, stream, a);
#endif
}
```

```cpp
#include <hip/hip_runtime.h>
#include <cstdio>
#include <cstdint>

#ifndef MK_MULTI
#define MK_MULTI 0
#endif

#define GAS __attribute__((address_space(1)))
#define LAS __attribute__((address_space(3)))
typedef unsigned short bf16;
typedef unsigned v4u __attribute__((ext_vector_type(4)));
typedef unsigned v2u __attribute__((ext_vector_type(2)));
typedef float f32x4 __attribute__((ext_vector_type(4)));
typedef float f32x2 __attribute__((ext_vector_type(2)));
typedef short bf16x8 __attribute__((ext_vector_type(8)));
typedef short bf16x4 __attribute__((ext_vector_type(4)));
#define DI __device__ __forceinline__
#define RLX_AGENT __ATOMIC_RELAXED, __HIP_MEMORY_SCOPE_AGENT
#define LDS_WAIT() asm volatile("s_waitcnt lgkmcnt(0)" ::: "memory")
#define VM_WAIT() asm volatile("s_waitcnt vmcnt(0)" ::: "memory")

constexpr int NB = 2, SEQ = 16384, T = NB * SEQ, D = 1024, NL = 4;
constexpr int DIN_SRC = 4872;
constexpr int NPROJ = 4864;
constexpr int C_AQ = 0, C_AK = 512, C_AV = 640, C_MQ = 768, C_MK = 1280, C_MV = 1792, C_MO = 2304, C_GA = 2816, C_GB = 3840;
constexpr int NE = 16, FF = 512;
constexpr int NCLS = 24, CLS_CAP = 32768;
constexpr float EPS = 1e-6f;
constexpr int NPH = 10;
constexpr int NGP = 1 + NL * NPH;

constexpr size_t MiB = 1u << 20;
constexpr size_t WS_CTL = 0, CTL_ZERO_BYTES = 1 * MiB;
constexpr size_t WS_MOD = 1 * MiB;
constexpr size_t WS_ROPE = 2 * MiB;
constexpr size_t WS_GATES = 4 * MiB;
constexpr size_t WS_TGATE = 5 * MiB;
constexpr size_t WS_TOKL = 6 * MiB;
constexpr size_t WS_MLB = 9 * MiB;
constexpr size_t WS_MLC = 10 * MiB;
constexpr size_t WS_WIN = 28 * MiB;
constexpr size_t WS_WAU = 66 * MiB;
constexpr size_t WS_WMU = 70 * MiB;
constexpr size_t WS_WOUT = 74 * MiB;
constexpr size_t WS_WGU = 82 * MiB;
constexpr size_t WS_WD = 210 * MiB;
constexpr size_t WS_H = 274 * MiB;
constexpr size_t WS_PROJ = 338 * MiB;
constexpr size_t WS_END = 642 * MiB;

constexpr int CW_TMO = 0;
constexpr int CW_BAR = 4096;
constexpr int CW_CNT = 8192;

constexpr int RING_BYTES = 131072;
constexpr int MISC_OFF = RING_BYTES;
constexpr int TAB_OFF = RING_BYTES + 256;
constexpr int TOKOFF_OFF = RING_BYTES + 2048;
constexpr int LDS_BYTES = 147456;

DI unsigned f2bf(float f) { unsigned u = __builtin_bit_cast(unsigned, f); return (u + 0x7fffu + ((u >> 16) & 1u)) >> 16; }
DI unsigned pk2(float lo, float hi) { return f2bf(lo) | (f2bf(hi) << 16); }
DI float bf2f(unsigned short b) { return __builtin_bit_cast(float, ((unsigned)b) << 16); }
DI float bflo(unsigned w) { return __builtin_bit_cast(float, w << 16); }
DI float bfhi(unsigned w) { return __builtin_bit_cast(float, w & 0xffff0000u); }
DI float wave_sum(float v) {
#pragma unroll
    for (int o = 1; o < 64; o <<= 1) v += __shfl_xor(v, o);
    return v;
}
DI float sigmoidf_(float x) { return __builtin_amdgcn_rcpf(1.0f + __expf(-x)); }

#define XB_TMO      128
#define XB_XCNT(j)  (256  + 64 * (j))
#define XB_XSUB(j)  (1280 + 64 * (j))
#define XB_XGEN(j)  (2304 + 64 * (j))
#define XB_TOP      3328
#define XB_TOPGEN   3392
#define XCD_BAR_WORDS 3456
#define XB_SPIN_CAP (1u << 18)
__device__ __forceinline__ unsigned xb_ld(unsigned* p)              { return __hip_atomic_load(p, __ATOMIC_RELAXED, __HIP_MEMORY_SCOPE_AGENT); }
__device__ __forceinline__ unsigned xb_add(unsigned* p, unsigned v) { return __hip_atomic_fetch_add(p, v, __ATOMIC_RELAXED, __HIP_MEMORY_SCOPE_AGENT); }
__device__ __forceinline__ unsigned xb_xcc_id() { return (unsigned)__builtin_amdgcn_s_getreg((3 << 11) | 20) & 0xFu; }
#define XB_SPIN(cond, bar) do { unsigned _sp = 0; while (cond) { __builtin_amdgcn_s_sleep(1); \
    if ((++_sp & 255u) == 0u) { if (xb_ld(&(bar)[XB_TMO])) break; if (_sp > XB_SPIN_CAP) { atomicAdd(&(bar)[XB_TMO], 1u); break; } } } } while (0)
struct XcdBarrier { unsigned* bar; unsigned x; volatile LAS unsigned* st; };
__device__ __forceinline__ XcdBarrier xcd_barrier_post(unsigned* bar, volatile LAS unsigned* st) {
    XcdBarrier b; b.bar = bar; b.x = xb_xcc_id(); b.st = st;
    if (threadIdx.x == 0) (void)xb_add(&bar[XB_XCNT(b.x)], 1u);
    return b;
}
__device__ __forceinline__ void xcd_barrier_complete(unsigned* bar, unsigned x, unsigned& nloc, unsigned& nx) {
    const unsigned G = gridDim.x * gridDim.y * gridDim.z;
    unsigned sum, cnt, mine, sp = 0u;
    for (;;) {
        sum = 0u; cnt = 0u; mine = 0u;
#pragma unroll
        for (unsigned j = 0; j < 16; ++j) { const unsigned c = xb_ld(&bar[XB_XCNT(j)]); sum += c; cnt += (c > 0u) ? 1u : 0u; mine = (j == x) ? c : mine; }
        if (sum == G) break;
        __builtin_amdgcn_s_sleep(1);
        if ((++sp & 255u) == 0u) { if (xb_ld(&bar[XB_TMO])) break; if (sp > XB_SPIN_CAP) { atomicAdd(&bar[XB_TMO], 1u); break; } }
    }
    nloc = mine > 0u ? mine : 1u; nx = cnt > 0u ? cnt : 1u;
}
__device__ __forceinline__ void xcd_barrier(const XcdBarrier& b) {
    asm volatile("s_waitcnt vmcnt(0)" ::: "memory");
    __syncthreads();
    if (threadIdx.x == 0) {
        unsigned* bar = b.bar;
        __builtin_amdgcn_s_waitcnt(0);
        unsigned nloc = b.st[0], nx = b.st[1];
        if (nloc == 0u) { xcd_barrier_complete(bar, b.x, nloc, nx); b.st[0] = nloc; b.st[1] = nx; }
        const unsigned old = xb_add(&bar[XB_XSUB(b.x)], 1u);
        const unsigned gen = old / nloc;
        if (old + 1u == (gen + 1u) * nloc) {
            __builtin_amdgcn_fence(__ATOMIC_RELEASE, "agent");
            asm volatile("s_waitcnt vmcnt(0)" ::: "memory");
            const unsigned og = xb_add(&bar[XB_TOP], 1u);
            const unsigned tg = og / nx;
            if (og + 1u == (tg + 1u) * nx) xb_add(&bar[XB_TOPGEN], 1u);
            else XB_SPIN(xb_ld(&bar[XB_TOPGEN]) == tg, bar);
            __builtin_amdgcn_fence(__ATOMIC_ACQUIRE, "agent");
            xb_add(&bar[XB_XGEN(b.x)], 1u);
            asm volatile("s_waitcnt vmcnt(0)" ::: "memory");
        } else {
            XB_SPIN(xb_ld(&bar[XB_XGEN(b.x)]) == gen, bar);
            __builtin_amdgcn_fence(__ATOMIC_ACQUIRE, "agent");
            asm volatile("s_waitcnt vmcnt(0)" ::: "memory");
        }
    }
    __syncthreads();
}

namespace pg8 {
constexpr int BM = 256, BK = 64, HALF = 128, HTB = HALF * BK * 2, STAGE_BYTES = 8 * HTB, NXCD = 8, WGM = 8;
__host__ __device__ __forceinline__ int lds_byte(int r, int c) { const int st = (r >> 4) * 2 + (c >> 5), rr = r & 15, cc = c & 31, ob = rr * 64 + cc * 2; return st * 1024 + (ob ^ (((ob >> 9) & 1) << 5)); }
__host__ __device__ __forceinline__ void stage_rc(int b, int& R, int& C) { const int st = b / 1024, sb = b % 1024, swz = sb ^ (((sb >> 9) & 1) << 5); R = (st >> 1) * 16 + swz / 64; C = (st & 1) * 32 + (swz % 64) / 2; }
__host__ __device__ __forceinline__ int perm32(int rho) { const int n = rho >> 4, i = rho & 15; return 8 * (i >> 2) + 4 * n + (i & 3); }

struct Unit { int pm, pn, x0, x1; };

struct TileOrder {
    int nM, nN, nwg, G, c;
    __device__ void init(int nM_, int nN_, int G_, int c_) { nM = nM_; nN = nN_; nwg = nM * nN; G = G_; c = c_; }
    __device__ bool get(int i, int& pm, int& pn) const {
        const long L = (long)i * G + c; if (L >= nwg) return false;
        int wgid = (int)L; { const int q = nwg / NXCD, r = nwg % NXCD, xcd = wgid % NXCD, off = wgid / NXCD; wgid = (xcd < r ? xcd * (q + 1) : r * (q + 1) + (xcd - r) * q) + off; }
        const int nig = WGM * nN, gid = wgid / nig, fm = gid * WGM, gsz = (nM - fm) < WGM ? (nM - fm) : WGM;
        pm = fm + ((wgid % nig) % gsz); pn = (wgid % nig) / gsz; return true;
    }
};

template <class Epi, class Sched>
__device__ __forceinline__ void gemm_phase(LAS unsigned char* lds, const int K, const Sched& S, const Epi& E) {
    int tid = threadIdx.x; asm volatile("" : "+v"(tid));
    const int wid = __builtin_amdgcn_readfirstlane(tid >> 6), lane = tid & 63, wr = wid >> 2, wc = wid & 3, fr = lane & 15, fq = lane >> 4;
    const int nt = K / BK;
    constexpr bool GA = Sched::GATHER; constexpr int KS = Sched::KSPLIT;
    unsigned voffA[2], voffB[2]; int Rst[2], Cst[2];
#pragma unroll
    for (int i = 0; i < 2; ++i) { int R, C; stage_rc(tid * 16 + i * 8192, R, C); const int Rb = Epi::PERM ? ((R & ~31) + perm32(R & 31)) : R;
        voffA[i] = (unsigned)(R * S.lda + C) * 2u; voffB[i] = (unsigned)(Rb * S.ldb + C) * 2u; Rst[i] = R; Cst[i] = C; }
    const size_t kstep = (size_t)(BK * 2);
    const size_t hstepA = (size_t)HALF * S.lda * 2, hstepB = (size_t)HALF * S.ldb * 2;
    const unsigned ldsw = (unsigned)wid * 1024u; const unsigned gmul = (unsigned)S.lda * 2u;
    const int aoff = lds_byte(wr * 64 + fr, fq * 8), boff = lds_byte(wc * 32 + fr, fq * 8);
    unsigned vAc[2], vAn[2];
#define PG8_SA(b, h) (((b) * 2 + (h)) * HTB)
#define PG8_SB(b, h) ((4 + (b) * 2 + (h)) * HTB)
#define PG8_STAGE2(bufoff, gbase, v0, v1) do { \
        __builtin_amdgcn_global_load_lds((const unsigned*)((const char*)(gbase) + (v0)), (LAS unsigned*)(lds + (bufoff) + ldsw), 16, 0, 0); \
        __builtin_amdgcn_global_load_lds((const unsigned*)((const char*)(gbase) + (v1)), (LAS unsigned*)(lds + (bufoff) + ldsw + 8192), 16, 0, 0); } while (0)
#define PG8_STAGE_B(bufoff, ptr, h) PG8_STAGE2(bufoff, (ptr) + (h) * hstepB, voffB[0], voffB[1])
#define PG8_STAGE_A(bufoff, ptr, h, nx) do { if constexpr (GA) { const unsigned _p = (nx) ? vAn[h] : vAc[h]; PG8_STAGE2(bufoff, ptr, (_p & 0xffffu) * gmul + (unsigned)Cst[0] * 2u, (_p >> 16) * gmul + (unsigned)Cst[0] * 2u); } \
        else { PG8_STAGE2(bufoff, (ptr) + (h) * hstepA, voffA[0], voffA[1]); } } while (0)
#define PG8_LDA(dst, b, h) do { _Pragma("unroll") for (int m = 0; m < 4; ++m) _Pragma("unroll") for (int k = 0; k < 2; ++k) dst[m][k] = *(const LAS bf16x8*)(lds + PG8_SA(b, h) + aoff + m * 2048 + k * 1024); } while (0)
#define PG8_LDB(dst, b, h) do { _Pragma("unroll") for (int n = 0; n < 2; ++n) _Pragma("unroll") for (int k = 0; k < 2; ++k) dst[n][k] = *(const LAS bf16x8*)(lds + PG8_SB(b, h) + boff + n * 2048 + k * 1024); } while (0)
#define PG8_MMA(ai, bj, At, Bt) do { __builtin_amdgcn_s_setprio(1); _Pragma("unroll") for (int m = 0; m < 4; ++m) _Pragma("unroll") for (int n = 0; n < 2; ++n) _Pragma("unroll") for (int k = 0; k < 2; ++k) \
        acc[ai][bj][m][n] = __builtin_amdgcn_mfma_f32_16x16x32_bf16(Bt[n][k], At[m][k], acc[ai][bj][m][n], 0, 0, 0); __builtin_amdgcn_s_setprio(0); } while (0)
#define PG8_WAIT_V(n) asm volatile("s_waitcnt vmcnt(" #n ")" ::: "memory")
#define PG8_WAIT_L(n) asm volatile("s_waitcnt lgkmcnt(" #n ")" ::: "memory")
#define PG8_BAR __builtin_amdgcn_s_barrier()
#define PG8_SCHED __builtin_amdgcn_sched_barrier(0)
#define PG8_GOFF(dst, u) do { if constexpr (GA) { _Pragma("unroll") for (int h = 0; h < 2; ++h) dst[h] = S.a_rowoff(u, Rst[0] + HALF * h) | (S.a_rowoff(u, Rst[0] + 64 + HALF * h) << 16); } } while (0)
    Unit cur, nxt; int ui = 0;
    if (!S.next(0, cur)) return;
    f32x4 acc[2][2][4][2];
#pragma unroll
    for (int a = 0; a < 2; ++a)
#pragma unroll
        for (int b = 0; b < 2; ++b)
#pragma unroll
            for (int m = 0; m < 4; ++m)
#pragma unroll
                for (int n = 0; n < 2; ++n) acc[a][b][m][n] = (f32x4){0.f, 0.f, 0.f, 0.f};
    bf16x8 At[4][2], B0[2][2], B1[2][2];
    const char* cA = S.a_base(cur); const char* cB0 = S.b_base(cur, 0); const char* cB1 = KS ? S.b_base(cur, 1) : cB0;
    PG8_GOFF(vAc, cur);
    vAn[0] = vAc[0]; vAn[1] = vAc[1];
    PG8_STAGE_B(PG8_SB(0, 0), cB0, 0); PG8_STAGE_B(PG8_SB(0, 1), cB0, 1); PG8_STAGE_A(PG8_SA(0, 0), cA, 0, false); PG8_STAGE_A(PG8_SA(0, 1), cA, 1, false);
    if (wr == 1) PG8_BAR;
    PG8_WAIT_V(2); PG8_BAR;
    PG8_STAGE_B(PG8_SB(1, 0), cB0 + kstep, 0); PG8_STAGE_A(PG8_SA(1, 0), cA + kstep, 0, false); PG8_STAGE_B(PG8_SB(1, 1), cB0 + kstep, 1);
    PG8_WAIT_V(6); PG8_BAR;
    for (;;) {
        const bool has_next = S.next(ui + 1, nxt);
        const char* nA = has_next ? S.a_base(nxt) : cA; const char* nB0 = has_next ? S.b_base(nxt, 0) : cB0; const char* nB1 = (KS && has_next) ? S.b_base(nxt, 1) : (KS ? cB1 : nB0);
        if constexpr (GA) { if (has_next) { PG8_GOFF(vAn, nxt); } }
        for (int t = 0; t < nt; t += 2) {
            const bool last = (t == nt - 2);
            const char* a1 = cA + (size_t)(t + 1) * kstep;
            const char* a2 = last ? nA : cA + (size_t)(t + 2) * kstep;
            const char* b2 = last ? nB0 : ((KS && (t + 2) >= KS) ? cB1 + (size_t)(t + 2 - KS) * kstep : cB0 + (size_t)(t + 2) * kstep);
            const char* a3 = a2 + kstep; const char* b3 = b2 + kstep;
            PG8_LDB(B0, 0, 0); PG8_LDB(B1, 0, 1); PG8_SCHED; PG8_LDA(At, 0, 0); PG8_STAGE_A(PG8_SA(1, 1), a1, 1, false);
            PG8_WAIT_V(8); PG8_WAIT_L(0); PG8_BAR; PG8_MMA(0, 0, At, B0); PG8_MMA(0, 1, At, B1); PG8_BAR; PG8_SCHED;
            PG8_LDA(At, 0, 1); PG8_STAGE_B(PG8_SB(0, 0), b2, 0); PG8_STAGE_B(PG8_SB(0, 1), b2, 1); PG8_STAGE_A(PG8_SA(0, 0), a2, 0, last);
            PG8_WAIT_V(8); PG8_WAIT_L(0); PG8_BAR; PG8_MMA(1, 0, At, B0); PG8_MMA(1, 1, At, B1); PG8_BAR; PG8_SCHED;
            PG8_LDB(B0, 1, 0); PG8_LDB(B1, 1, 1); PG8_SCHED; PG8_LDA(At, 1, 0); PG8_STAGE_A(PG8_SA(0, 1), a2, 1, last);
            PG8_WAIT_V(8); PG8_WAIT_L(0); PG8_BAR; PG8_MMA(0, 0, At, B0); PG8_MMA(0, 1, At, B1); PG8_BAR; PG8_SCHED;
            PG8_LDA(At, 1, 1); PG8_STAGE_B(PG8_SB(1, 0), b3, 0); PG8_STAGE_B(PG8_SB(1, 1), b3, 1); PG8_STAGE_A(PG8_SA(1, 0), a3, 0, last);
            PG8_WAIT_V(8); PG8_WAIT_L(0); PG8_BAR; PG8_MMA(1, 0, At, B0); PG8_MMA(1, 1, At, B1); PG8_BAR; PG8_SCHED;
        }
        if (wr == 0) PG8_BAR;
        { int fr_ = fr, fq_ = fq; asm volatile("" : "+v"(fr_), "+v"(fq_));
          E(acc, cur, wr, wc, fr_, fq_); }
        if (!has_next) break;
#pragma unroll
        for (int a = 0; a < 2; ++a)
#pragma unroll
            for (int b = 0; b < 2; ++b)
#pragma unroll
                for (int m = 0; m < 4; ++m)
#pragma unroll
                    for (int n = 0; n < 2; ++n) acc[a][b][m][n] = (f32x4){0.f, 0.f, 0.f, 0.f};
        cur = nxt; cA = nA; cB0 = nB0; cB1 = nB1; ++ui;
        vAc[0] = vAn[0]; vAc[1] = vAn[1];
        if (wr == 1) PG8_BAR;
    }
    PG8_WAIT_V(0);
    PG8_BAR;
#undef PG8_SA
#undef PG8_SB
#undef PG8_STAGE2
#undef PG8_STAGE_A
#undef PG8_STAGE_B
#undef PG8_LDA
#undef PG8_LDB
#undef PG8_MMA
#undef PG8_WAIT_V
#undef PG8_WAIT_L
#undef PG8_BAR
#undef PG8_SCHED
#undef PG8_GOFF
}
}
using pg8::Unit;

DI unsigned cvt_pk_bf16(float lo, float hi) { unsigned r; asm volatile("v_cvt_pk_bf16_f32 %0, %1, %2" : "=v"(r) : "v"(lo), "v"(hi)); return r; }

struct Args {
    const float* x; const float* c; const int* pos; const float* ada_w; const float* ada_b; const float* nmw; const float* nfw; const float* w_in;
    const float* b_ig; const float* b_fg; const float* qnw; const float* knw; const float* sinks; const float* conv_w; const float* conv_b; const float* mnw;
    const float* w_au; const float* w_mu; const float* w_out; const float* router_w; const float* router_b; const float* w_gate; const float* w_up; const float* w_down;
    float* out; unsigned char* ws; int ph_lo, ph_hi;
};

__constant__ float c_invf[8] = {1.0f, 0.1939227432012558f, 0.03760603070259094f, 0.007292664609849453f, 0.0014142135623842478f, 0.00027424818836152554f, 5.3182957344688475e-05f, 1.0313385246263351e-05f};

struct DenseSched {
    static constexpr bool GATHER = false; static constexpr int KSPLIT = 0;
    const char* A; const char* Bt; int lda, ldb; pg8::TileOrder ord;
    DI bool next(int i, Unit& u) const { int pm, pn; if (!ord.get(i, pm, pn)) return false; u.pm = pm; u.pn = pn; u.x0 = 0; u.x1 = 0; return true; }
    DI const char* a_base(const Unit& u) const { return A + (size_t)u.pm * 256 * lda * 2; }
    DI const char* b_base(const Unit& u, int) const { return Bt + (size_t)u.pn * 256 * ldb * 2; }
    DI unsigned a_rowoff(const Unit&, int) const { return 0u; }
};
struct EpiProj {
    static constexpr bool PERM = true;
    bf16* O;
    DI void operator()(const f32x4 (&acc)[2][2][4][2], const Unit& u, int wr, int wc, int fr, int fq) const {
        const int row0 = u.pm * 256 + wr * 64 + fr, col0 = u.pn * 256 + wc * 32 + 8 * fq; const bool sg = u.pn >= 9;
#pragma unroll
        for (int ai = 0; ai < 2; ++ai)
#pragma unroll
            for (int m = 0; m < 4; ++m) { bf16* rowp = O + (size_t)(row0 + ai * 128 + m * 16) * NPROJ + col0;
#pragma unroll
                for (int bj = 0; bj < 2; ++bj) { f32x4 v0 = acc[ai][bj][m][0], v1 = acc[ai][bj][m][1];
                    if (sg) {
#pragma unroll
                        for (int j = 0; j < 4; ++j) { v0[j] = sigmoidf_(v0[j]); v1[j] = sigmoidf_(v1[j]); } }
                    v4u w; w.x = cvt_pk_bf16(v0[0], v0[1]); w.y = cvt_pk_bf16(v0[2], v0[3]); w.z = cvt_pk_bf16(v1[0], v1[1]); w.w = cvt_pk_bf16(v1[2], v1[3]);
                    *(v4u*)(rowp + bj * 128) = w; } }
    }
};
template <bool ADD> struct EpiGate {
    static constexpr bool PERM = true;
    bf16* P; int gcol;
    DI void operator()(const f32x4 (&acc)[2][2][4][2], const Unit& u, int wr, int wc, int fr, int fq) const {
        const int row0 = u.pm * 256 + wr * 64 + fr, col0 = u.pn * 256 + wc * 32 + 8 * fq;
#pragma unroll
        for (int ai = 0; ai < 2; ++ai)
#pragma unroll
            for (int m = 0; m < 4; ++m) { bf16* rowp = P + (size_t)(row0 + ai * 128 + m * 16) * NPROJ + col0;
#pragma unroll
                for (int bj = 0; bj < 2; ++bj) { const f32x4 v0 = acc[ai][bj][m][0], v1 = acc[ai][bj][m][1];
                    const v4u g = *(const v4u*)(rowp + gcol + bj * 128);
                    float o[8] = {bflo(g.x) * v0[0], bfhi(g.x) * v0[1], bflo(g.y) * v0[2], bfhi(g.y) * v0[3], bflo(g.z) * v1[0], bfhi(g.z) * v1[1], bflo(g.w) * v1[2], bfhi(g.w) * v1[3]};
                    if (ADD) { const v4u p = *(const v4u*)(rowp + C_MQ + bj * 128);
                        o[0] += bflo(p.x); o[1] += bfhi(p.x); o[2] += bflo(p.y); o[3] += bfhi(p.y); o[4] += bflo(p.z); o[5] += bfhi(p.z); o[6] += bflo(p.w); o[7] += bfhi(p.w); }
                    v4u w; w.x = cvt_pk_bf16(o[0], o[1]); w.y = cvt_pk_bf16(o[2], o[3]); w.z = cvt_pk_bf16(o[4], o[5]); w.w = cvt_pk_bf16(o[6], o[7]);
                    *(v4u*)(rowp + C_MQ + bj * 128) = w; } }
    }
};
struct EpiRes {
    static constexpr bool PERM = false;
    const float* xin; float* out; const float* g; int rmask;
    DI void operator()(const f32x4 (&acc)[2][2][4][2], const Unit& u, int wr, int wc, int fr, int fq) const {
        const int row0 = u.pm * 256 + wr * 64 + fr, col0 = u.pn * 256 + wc * 32 + 4 * fq; const int b = (u.pm * 256) >> 14;
        f32x4 gv[2][2];
#pragma unroll
        for (int bj = 0; bj < 2; ++bj)
#pragma unroll
            for (int n = 0; n < 2; ++n) gv[bj][n] = *(const f32x4*)(g + b * 6144 + col0 + bj * 128 + n * 16);
#pragma unroll
        for (int ai = 0; ai < 2; ++ai)
#pragma unroll
            for (int m = 0; m < 4; ++m) { const size_t off = (size_t)(row0 + ai * 128 + m * 16) * D + col0; const size_t offo = (size_t)((row0 + ai * 128 + m * 16) & rmask) * D + col0;
#pragma unroll
                for (int bj = 0; bj < 2; ++bj)
#pragma unroll
                    for (int n = 0; n < 2; ++n) { const f32x4 xv = *(const f32x4*)(xin + off + bj * 128 + n * 16);
                        *(f32x4*)(out + offo + bj * 128 + n * 16) = xv + gv[bj][n] * acc[ai][bj][m][n]; } }
    }
};

struct MoeTab { const LAS int* tcls; const LAS int* tpos; const LAS int* cnt; int Rtot; };
DI void cls_experts(int cls, int& ea, int& eb) { const int g = cls / 6, p = cls - 6 * g; const int a = (p < 3) ? 0 : ((p < 5) ? 1 : 2); const int b = (p < 3) ? (p + 1) : ((p < 5) ? (p - 1) : 3); ea = 4 * g + a; eb = 4 * g + b; }
struct MoeUpSched {
    static constexpr bool GATHER = true; static constexpr int KSPLIT = 0;
    const char* A; const char* W; int lda, ldb; MoeTab tb; int G, c; const LAS unsigned* tokoff;
    DI bool next(int i, Unit& u) const { const int L = i * G + c; if (L >= tb.Rtot * 8) return false; u.pm = L >> 3; u.pn = L & 7; u.x0 = i; u.x1 = __builtin_amdgcn_readfirstlane(tb.tcls[u.pm]); return true; }
    DI const char* a_base(const Unit&) const { return A; }
    DI const char* b_base(const Unit& u, int) const { int ea, eb; cls_experts(u.x1, ea, eb); const int e = (u.pn < 4) ? ea : eb; return W + ((size_t)e * 1024 + (size_t)(u.pn & 3) * 256) * 1024 * 2; }
    DI unsigned a_rowoff(const Unit& u, int r) const { return tokoff[u.x0 * 256 + r]; }
};
struct EpiSwiglu {
    static constexpr bool PERM = true;
    bf16* H; const float* tgate; const LAS unsigned* tokoff;
    DI void operator()(const f32x4 (&acc)[2][2][4][2], const Unit& u, int wr, int wc, int fr, int fq) const {
        const int r0 = wr * 64 + fr; const int hc = (u.pn >> 2) * 512 + (u.pn & 3) * 128 + wc * 32 + 8 * fq; const int gsel = u.pn >> 2;
#pragma unroll
        for (int ai = 0; ai < 2; ++ai)
#pragma unroll
            for (int m = 0; m < 4; ++m) { const int r = r0 + ai * 128 + m * 16; const unsigned tok = tokoff[u.x0 * 256 + r]; const float rg = tgate[tok * 2 + gsel];
                const f32x4 g0 = acc[ai][0][m][0], g1 = acc[ai][0][m][1], u0 = acc[ai][1][m][0], u1 = acc[ai][1][m][1];
                float o[8];
#pragma unroll
                for (int j = 0; j < 4; ++j) { o[j] = g0[j] * sigmoidf_(g0[j]) * u0[j] * rg; o[4 + j] = g1[j] * sigmoidf_(g1[j]) * u1[j] * rg; }
                v4u w; w.x = cvt_pk_bf16(o[0], o[1]); w.y = cvt_pk_bf16(o[2], o[3]); w.z = cvt_pk_bf16(o[4], o[5]); w.w = cvt_pk_bf16(o[6], o[7]);
                *(v4u*)(H + ((size_t)u.pm * 256 + r) * 1024 + hc) = w; }
    }
};
struct MoeDownSched {
    static constexpr bool GATHER = false; static constexpr int KSPLIT = 8;
    const char* A; const char* W; int lda, ldb; MoeTab tb; int G, c;
    DI bool next(int i, Unit& u) const { const int L = i * G + c; if (L >= tb.Rtot * 4) return false; u.pm = L >> 2; u.pn = L & 3; u.x0 = __builtin_amdgcn_readfirstlane(tb.tpos[u.pm]); u.x1 = __builtin_amdgcn_readfirstlane(tb.tcls[u.pm]); return true; }
    DI const char* a_base(const Unit& u) const { return A + (size_t)u.pm * 256 * lda * 2; }
    DI const char* b_base(const Unit& u, int half) const { int ea, eb; cls_experts(u.x1, ea, eb); const int e = half ? eb : ea; return W + ((size_t)e * 1024 + (size_t)u.pn * 256) * 512 * 2; }
    DI unsigned a_rowoff(const Unit&, int) const { return 0u; }
};
struct EpiMoeOut {
    static constexpr bool PERM = false;
    const float* xin; float* out; const float* g; const int* tokl; MoeTab tb; int rmask;
    DI void operator()(const f32x4 (&acc)[2][2][4][2], const Unit& u, int wr, int wc, int fr, int fq) const {
        const int r0 = wr * 64 + fr, col0 = u.pn * 256 + wc * 32 + 4 * fq; const int cn = tb.cnt[u.x1];
#pragma unroll
        for (int ai = 0; ai < 2; ++ai)
#pragma unroll
            for (int m = 0; m < 4; ++m) { const int pos = u.x0 + r0 + ai * 128 + m * 16;
                if (pos < cn) { const int tok = tokl[u.x1 * CLS_CAP + pos]; const int b = tok >> 14; const float* ip = xin + (size_t)tok * D + col0; float* op = out + (size_t)(tok & rmask) * D + col0; const float* gp = g + b * 6144 + col0;
#pragma unroll
                    for (int bj = 0; bj < 2; ++bj)
#pragma unroll
                        for (int n = 0; n < 2; ++n) { const f32x4 xv = *(const f32x4*)(ip + bj * 128 + n * 16); const f32x4 gv = *(const f32x4*)(gp + bj * 128 + n * 16);
                            *(f32x4*)(op + bj * 128 + n * 16) = xv + gv * acc[ai][bj][m][n]; } } }
    }
};

struct Ctx { LAS unsigned char* lds; int tid, lane, wave, G, bid; };
DI Ctx fresh(const Ctx& X) { Ctx P = X; int t = X.tid; asm volatile("" : "+v"(t)); P.tid = t; P.lane = t & 63; P.wave = __builtin_amdgcn_readfirstlane(t >> 6); return P; }

DI void tr_item(const float* W, int ldw, int K, bf16* WT, int k0, LAS float* scr, int lane) {
#pragma unroll 8
    for (int i = 0; i < 32; ++i) { const int kk = 2 * i + (lane >> 5); scr[kk * 33 + (lane & 31)] = W[(size_t)(k0 + kk) * ldw + (lane & 31)]; }
    LDS_WAIT(); asm volatile("" ::: "memory");
    const int c = lane & 7;
#pragma unroll
    for (int j = 0; j < 4; ++j) { const int n = (lane >> 3) + 8 * j; const LAS float* s = scr + (8 * c) * 33 + n;
        v4u o; o.x = pk2(s[0 * 33], s[1 * 33]); o.y = pk2(s[2 * 33], s[3 * 33]); o.z = pk2(s[4 * 33], s[5 * 33]); o.w = pk2(s[6 * 33], s[7 * 33]);
        *(v4u*)(WT + (size_t)n * K + k0 + 8 * c) = o; }
    LDS_WAIT(); asm volatile("" ::: "memory");
}
DI void p0_prologue(const Args& a, const Ctx& X) {
    unsigned char* ws = a.ws;
    LAS float* scr = (LAS float*)(X.lds + X.wave * 16384);
    const int gw = X.bid * 8 + X.wave, NGW = X.G * 8;
    constexpr int IT_WIN = 16 * 152, IT_AU = 8 * 32, IT_OUT = 16 * 32, IT_GU = 16 * 16 * 32, IT_DN = 16 * 8 * 32;
    constexpr int IT_L = IT_WIN + 2 * IT_AU + IT_OUT + IT_GU + IT_DN;
    for (int it = gw; it < NL * IT_L; it += NGW) {
        const int l = it / IT_L; int r = it - l * IT_L;
        if (r < IT_WIN) { const int kb = r / 152, nb = r - kb * 152, d0 = 32 * nb, s0 = d0 + (d0 >= 2304 ? 8 : 0);
            tr_item(a.w_in + (size_t)l * D * DIN_SRC + s0, DIN_SRC, D, (bf16*)(ws + WS_WIN) + ((size_t)l * NPROJ + d0) * D, 64 * kb, scr, X.lane); continue; }
        r -= IT_WIN;
        if (r < IT_AU) { const int kb = r >> 5, nb = r & 31;
            tr_item(a.w_au + (size_t)l * 512 * D + 32 * nb, D, 512, (bf16*)(ws + WS_WAU) + ((size_t)l * D + 32 * nb) * 512, 64 * kb, scr, X.lane); continue; }
        r -= IT_AU;
        if (r < IT_AU) { const int kb = r >> 5, nb = r & 31;
            tr_item(a.w_mu + (size_t)l * 512 * D + 32 * nb, D, 512, (bf16*)(ws + WS_WMU) + ((size_t)l * D + 32 * nb) * 512, 64 * kb, scr, X.lane); continue; }
        r -= IT_AU;
        if (r < IT_OUT) { const int kb = r >> 5, nb = r & 31;
            tr_item(a.w_out + (size_t)l * D * D + 32 * nb, D, D, (bf16*)(ws + WS_WOUT) + ((size_t)l * D + 32 * nb) * D, 64 * kb, scr, X.lane); continue; }
        r -= IT_OUT;
        if (r < IT_GU) { const int e = r >> 9, q = r & 511, kb = q >> 5, nb = q & 31, tq = nb >> 3, rb = nb & 7;
            const float* src = ((rb < 4) ? a.w_gate : a.w_up) + ((size_t)(l * NE + e) * D) * FF + 128 * tq + 32 * (rb & 3);
            tr_item(src, FF, D, (bf16*)(ws + WS_WGU) + ((size_t)(l * NE + e) * 1024 + 32 * nb) * D, 64 * kb, scr, X.lane); continue; }
        r -= IT_GU;
        { const int e = r >> 8, q = r & 255, kb = q >> 5, nb = q & 31;
            tr_item(a.w_down + ((size_t)(l * NE + e) * FF) * D + 32 * nb, D, FF, (bf16*)(ws + WS_WD) + ((size_t)(l * NE + e) * 1024 + 32 * nb) * FF, 64 * kb, scr, X.lane); }
    }
    { float* cs = (float*)(ws + WS_ROPE); float* sn = cs + (size_t)T * 8;
      for (int i = X.bid * 512 + X.tid; i < T * 8; i += X.G * 512) { const int tok = i >> 3, f = i & 7; const float angf = (float)a.pos[tok] * c_invf[f];
          double rev = (double)angf * 0.15915494309189535; rev -= rint(rev); const float rf = (float)rev;
          cs[i] = __builtin_amdgcn_cosf(rf); sn[i] = __builtin_amdgcn_sinf(rf); } }
    __syncthreads();
    LAS float* cact = (LAS float*)X.lds; LAS float* red = (LAS float*)(X.lds + 8192);
    for (int i = X.tid; i < 2048; i += 512) { const float cv = a.c[i]; cact[i] = cv / (1.0f + __expf(-cv)); }
    __syncthreads();
    float* mod = (float*)(ws + WS_MOD);
    for (int it = X.bid; it < NL * 96; it += X.G) { const int l = it / 96, cg = it - l * 96; const int col = cg * 64 + X.lane;
        const float* w = a.ada_w + (size_t)l * D * 6144 + col; float s0 = 0.f, s1 = 0.f;
#pragma unroll 8
        for (int kk = 0; kk < 128; ++kk) { const int k = X.wave * 128 + kk; const float wv = w[(size_t)k * 6144]; s0 += cact[k] * wv; s1 += cact[1024 + k] * wv; }
        red[(X.wave * 2 + 0) * 64 + X.lane] = s0; red[(X.wave * 2 + 1) * 64 + X.lane] = s1;
        __syncthreads();
        if (X.tid < 128) { const int b = X.tid >> 6, ln = X.tid & 63; float s = 0.f;
#pragma unroll
            for (int w8 = 0; w8 < 8; ++w8) s += red[(w8 * 2 + b) * 64 + ln];
            mod[(size_t)(l * 2 + b) * 6144 + cg * 64 + ln] = s + a.ada_b[l * 6144 + cg * 64 + ln]; }
        __syncthreads();
    }
}

DI void p1_norm_gates(const Args& a, const Ctx& X, int l, const float* xin) {
    unsigned char* ws = a.ws;
    LAS float* gwl = (LAS float*)X.lds;
    for (int idx = X.tid; idx < 8192; idx += 512) { const int k = idx >> 3, g = idx & 7; gwl[g * 1024 + k] = a.w_in[(size_t)l * D * DIN_SRC + (size_t)k * DIN_SRC + 2304 + g]; }
    __syncthreads();
    const float* mod = (const float*)(ws + WS_MOD); bf16* hb = (bf16*)(ws + WS_H); float* gates = (float*)(ws + WS_GATES);
    const int gw = X.bid * 8 + X.wave, NGW = X.G * 8;
    for (int rg = gw; rg < T / 16; rg += NGW) {
        const int row0 = rg * 16, b = row0 >> 14;
        const float* mb = mod + (size_t)(l * 2 + b) * 6144;
        f32x4 aw[4], sh[4];
#pragma unroll
        for (int j = 0; j < 4; ++j) { const int k = 256 * j + 4 * X.lane; const f32x4 nw = *(const f32x4*)(a.nmw + l * D + k); const f32x4 sc = *(const f32x4*)(mb + 1024 + k); aw[j] = nw * (sc + 1.0f); sh[j] = *(const f32x4*)(mb + k); }
#pragma unroll 1
        for (int r = 0; r < 16; ++r) { const int row = row0 + r;
            const f32x4* xr = (const f32x4*)(xin + (size_t)row * D) + X.lane; f32x4 v[4]; float ss = 0.f;
#pragma unroll
            for (int j = 0; j < 4; ++j) { v[j] = xr[64 * j]; ss += (v[j].x * v[j].x + v[j].y * v[j].y) + (v[j].z * v[j].z + v[j].w * v[j].w); }
            ss = wave_sum(ss); const float rstd = 1.0f / sqrtf(ss * (1.0f / D) + EPS);
            unsigned long long* o8 = (unsigned long long*)(hb + (size_t)row * D) + X.lane;
#pragma unroll
            for (int j = 0; j < 4; ++j) { v[j] = v[j] * rstd * aw[j] + sh[j]; o8[64 * j] = (unsigned long long)pk2(v[j].x, v[j].y) | ((unsigned long long)pk2(v[j].z, v[j].w) << 32); }
            float gp[8];
#pragma unroll
            for (int g = 0; g < 8; ++g) { float p = 0.f;
#pragma unroll
                for (int j = 0; j < 4; ++j) { const f32x4 w = *(const LAS f32x4*)(gwl + g * 1024 + 256 * j + 4 * X.lane); p += (v[j].x * w.x + v[j].y * w.y) + (v[j].z * w.z + v[j].w * w.w); }
                gp[g] = wave_sum(p); }
            if (X.lane == 0) {
#pragma unroll
                for (int g = 0; g < 4; ++g) { gates[(size_t)row * 8 + g] = gp[g] + a.b_ig[l * 4 + g];
                    const float z = gp[4 + g] + a.b_fg[l * 4 + g]; gates[(size_t)row * 8 + 4 + g] = fminf(z, 0.f) - log1pf(__expf(-fabsf(z))); } }
        }
    }
}

DI void attn_unit(const Args& a, const Ctx& X, int l, int unit) {
    unsigned char* ws = a.ws; const bf16* proj = (const bf16*)(ws + WS_PROJ); bf16* ao = (bf16*)(ws + WS_H);
    const float* cs = (const float*)(ws + WS_ROPE); const float* sn = cs + (size_t)T * 8;
    const int b = unit >> 8, rem = unit & 255, nb = rem >> 1, kvh = rem & 1; const int tok0 = b * SEQ + nb * 128;
    LAS bf16* Kl = (LAS bf16*)X.lds;
    LAS bf16* VT = (LAS bf16*)(X.lds + 36864);
    int lane = X.lane; asm volatile("" : "+v"(lane));
    const int c16 = lane & 15, quad = lane >> 4;
    {
        const int row = X.tid >> 1, half = X.tid & 1; const int tokk = tok0 - 128 + row; const bool valid = (nb > 0) || (row >= 128);
        float y[32]; float vv[32];
        if (valid) {
            const v4u* kp = (const v4u*)(proj + (size_t)tokk * NPROJ + C_AK + kvh * 64 + half * 32); const v4u* vp = (const v4u*)(proj + (size_t)tokk * NPROJ + C_AV + kvh * 64 + half * 32);
#pragma unroll
            for (int q = 0; q < 4; ++q) { const v4u kw = kp[q], vw = vp[q];
                y[8 * q + 0] = bflo(kw.x); y[8 * q + 1] = bfhi(kw.x); y[8 * q + 2] = bflo(kw.y); y[8 * q + 3] = bfhi(kw.y); y[8 * q + 4] = bflo(kw.z); y[8 * q + 5] = bfhi(kw.z); y[8 * q + 6] = bflo(kw.w); y[8 * q + 7] = bfhi(kw.w);
                vv[8 * q + 0] = bflo(vw.x); vv[8 * q + 1] = bfhi(vw.x); vv[8 * q + 2] = bflo(vw.y); vv[8 * q + 3] = bfhi(vw.y); vv[8 * q + 4] = bflo(vw.z); vv[8 * q + 5] = bfhi(vw.z); vv[8 * q + 6] = bflo(vw.w); vv[8 * q + 7] = bfhi(vw.w); }
        } else {
#pragma unroll
            for (int i = 0; i < 32; ++i) { y[i] = 0.f; vv[i] = 0.f; } }
        float ss = 0.f;
#pragma unroll
        for (int i = 0; i < 32; ++i) ss += y[i] * y[i];
        ss += __shfl_xor(ss, 1); const float rstd = 1.0f / sqrtf(ss * (1.0f / 64.0f) + EPS);
#pragma unroll
        for (int i = 0; i < 32; ++i) y[i] = y[i] * rstd * a.knw[l * 64 + half * 32 + i];
        if (half == 0 && valid) {
#pragma unroll
            for (int d = 0; d < 8; ++d) { const float c = cs[(size_t)tokk * 8 + d], s = sn[(size_t)tokk * 8 + d]; const float t1 = y[d], t2 = y[d + 8]; y[d] = t1 * c - t2 * s; y[d + 8] = t2 * c + t1 * s; } }
#pragma unroll
        for (int q = 0; q < 4; ++q) { v4u w; w.x = pk2(y[8 * q], y[8 * q + 1]); w.y = pk2(y[8 * q + 2], y[8 * q + 3]); w.z = pk2(y[8 * q + 4], y[8 * q + 5]); w.w = pk2(y[8 * q + 6], y[8 * q + 7]);
            *(LAS v4u*)(Kl + row * 72 + half * 32 + 8 * q) = w; }
#pragma unroll
        for (int i = 0; i < 32; ++i) VT[(half * 32 + i) * 280 + row] = (bf16)f2bf(vv[i]);
        if (X.tid < 64) {
#pragma unroll
            for (int cc = 256; cc < 280; ++cc) VT[X.tid * 280 + cc] = 0; }
    }
    __syncthreads();
#pragma unroll 1
    for (int task = X.wave; task < 32; task += 8) {
        const int g = task >> 3, rg = task & 7, r0 = 16 * rg, head = kvh * 4 + g; const int tokq = tok0 + r0 + c16;
        const float sink = a.sinks[l * 8 + head];
        float qv[16];
        { const bf16* qp = proj + (size_t)tokq * NPROJ + C_AQ + head * 64; const v4u w0 = *(const v4u*)(qp + 8 * quad), w1 = *(const v4u*)(qp + 32 + 8 * quad);
          qv[0] = bflo(w0.x); qv[1] = bfhi(w0.x); qv[2] = bflo(w0.y); qv[3] = bfhi(w0.y); qv[4] = bflo(w0.z); qv[5] = bfhi(w0.z); qv[6] = bflo(w0.w); qv[7] = bfhi(w0.w);
          qv[8] = bflo(w1.x); qv[9] = bfhi(w1.x); qv[10] = bflo(w1.y); qv[11] = bfhi(w1.y); qv[12] = bflo(w1.z); qv[13] = bfhi(w1.z); qv[14] = bflo(w1.w); qv[15] = bfhi(w1.w); }
        float ss = 0.f;
#pragma unroll
        for (int i = 0; i < 16; ++i) ss += qv[i] * qv[i];
        ss += __shfl_xor(ss, 16); ss += __shfl_xor(ss, 32); const float rstd = 1.0f / sqrtf(ss * (1.0f / 64.0f) + EPS);
#pragma unroll
        for (int i = 0; i < 8; ++i) { qv[i] = qv[i] * rstd * a.qnw[l * 64 + 8 * quad + i]; qv[8 + i] = qv[8 + i] * rstd * a.qnw[l * 64 + 32 + 8 * quad + i]; }
#pragma unroll
        for (int d = 0; d < 8; ++d) { const float other = __shfl_xor(qv[d], 16); const float c = cs[(size_t)tokq * 8 + d], s = sn[(size_t)tokq * 8 + d];
            if (quad == 0) qv[d] = qv[d] * c - other * s; else if (quad == 1) qv[d] = qv[d] * c + other * s; }
        bf16x8 qf[2];
        { v4u w; w.x = pk2(qv[0], qv[1]); w.y = pk2(qv[2], qv[3]); w.z = pk2(qv[4], qv[5]); w.w = pk2(qv[6], qv[7]); qf[0] = __builtin_bit_cast(bf16x8, w);
          w.x = pk2(qv[8], qv[9]); w.y = pk2(qv[10], qv[11]); w.z = pk2(qv[12], qv[13]); w.w = pk2(qv[14], qv[15]); qf[1] = __builtin_bit_cast(bf16x8, w); }
        f32x4 sacc[9];
#pragma unroll
        for (int i = 0; i < 9; ++i) { const LAS bf16* kr = Kl + (16 * (rg + i) + c16) * 72 + 8 * quad;
            const bf16x8 k0 = *(const LAS bf16x8*)kr, k1 = *(const LAS bf16x8*)(kr + 32);
            f32x4 z = {0.f, 0.f, 0.f, 0.f}; z = __builtin_amdgcn_mfma_f32_16x16x32_bf16(k0, qf[0], z, 0, 0, 0); sacc[i] = __builtin_amdgcn_mfma_f32_16x16x32_bf16(k1, qf[1], z, 0, 0, 0); }
        int dbase = 4 * quad - c16; asm volatile("" : "+v"(dbase)); int kbase = 16 * rg + 4 * quad; asm volatile("" : "+v"(kbase)); float mx = sink;
#pragma unroll
        for (int i = 0; i < 9; ++i)
#pragma unroll
            for (int j = 0; j < 4; ++j) { const int dlt = dbase + 16 * i + j; const int kj = kbase + 16 * i + j; const bool ok = (dlt > 0) && (dlt <= 128) && ((nb > 0) || (kj >= 128));
                const float s = ok ? sacc[i][j] * 0.125f : -3.0e38f; sacc[i][j] = s; mx = fmaxf(mx, s); }
        mx = fmaxf(mx, __shfl_xor(mx, 16)); mx = fmaxf(mx, __shfl_xor(mx, 32));
        float sum = 0.f;
#pragma unroll
        for (int i = 0; i < 9; ++i)
#pragma unroll
            for (int j = 0; j < 4; ++j) { const float p = (sacc[i][j] > -1.0e38f) ? __expf(sacc[i][j] - mx) : 0.f; sacc[i][j] = p; sum += p; }
        sum += __shfl_xor(sum, 16); sum += __shfl_xor(sum, 32);
        const float inv = 1.0f / (sum + __expf(sink - mx));
        f32x4 oacc[4];
#pragma unroll
        for (int et = 0; et < 4; ++et) oacc[et] = (f32x4){0.f, 0.f, 0.f, 0.f};
#pragma unroll
        for (int kk = 0; kk < 5; ++kk) {
            v4u pw; pw.x = pk2(sacc[2 * kk][0], sacc[2 * kk][1]); pw.y = pk2(sacc[2 * kk][2], sacc[2 * kk][3]);
            if (2 * kk + 1 < 9) { pw.z = pk2(sacc[(2 * kk + 1 < 9) ? 2 * kk + 1 : 0][0], sacc[(2 * kk + 1 < 9) ? 2 * kk + 1 : 0][1]); pw.w = pk2(sacc[(2 * kk + 1 < 9) ? 2 * kk + 1 : 0][2], sacc[(2 * kk + 1 < 9) ? 2 * kk + 1 : 0][3]); } else { pw.z = 0u; pw.w = 0u; }
            const bf16x8 pf = __builtin_bit_cast(bf16x8, pw);
#pragma unroll
            for (int et = 0; et < 4; ++et) { const LAS bf16* vr = VT + (16 * et + c16) * 280 + 16 * rg + 32 * kk + 4 * quad;
                const v2u lo = *(const LAS v2u*)vr, hi = *(const LAS v2u*)(vr + 16); v4u vw; vw.x = lo.x; vw.y = lo.y; vw.z = hi.x; vw.w = hi.y;
                oacc[et] = __builtin_amdgcn_mfma_f32_16x16x32_bf16(__builtin_bit_cast(bf16x8, vw), pf, oacc[et], 0, 0, 0); }
        }
#pragma unroll
        for (int et = 0; et < 4; ++et) { v2u w; w.x = pk2(oacc[et][0] * inv, oacc[et][1] * inv); w.y = pk2(oacc[et][2] * inv, oacc[et][3] * inv);
            *(v2u*)(ao + (size_t)tokq * 512 + head * 64 + 16 * et + 4 * quad) = w; }
    }
    __syncthreads();
}

constexpr int ML_Q = 0, ML_K = 17408, ML_KET = 34816, ML_VT = 53248, ML_CT = 73984, ML_CW = 113152, ML_CB = 118272, ML_RED = 118784, ML_NW = 119296;
template <bool L3> DI void mlstm_unit(const Args& a, const Ctx& X, int l, int unit) {
    unsigned char* ws = a.ws; const bf16* proj = (const bf16*)(ws + WS_PROJ); bf16* hm = (bf16*)(ws + WS_H) + (size_t)T * 512;
    const float* gates = (const float*)(ws + WS_GATES); float* mlc = (float*)(ws + WS_MLC) + (size_t)unit * 18432; float* mlb = (float*)(ws + WS_MLB);
    const int seq = unit >> 5, sj = unit & 31, b = seq >> 2, hh = seq & 3; const int tokbase = b * SEQ + sj * 512;
    LAS bf16* Qs = (LAS bf16*)(X.lds + ML_Q); LAS bf16* Ks = (LAS bf16*)(X.lds + ML_K); LAS bf16* KET = (LAS bf16*)(X.lds + ML_KET);
    LAS bf16* VT = (LAS bf16*)(X.lds + ML_VT); LAS bf16* CT = (LAS bf16*)(X.lds + ML_CT); LAS float* CW = (LAS float*)(X.lds + ML_CW);
    LAS float* CB = (LAS float*)(X.lds + ML_CB); LAS float* RED = (LAS float*)(X.lds + ML_RED); LAS float* NW = (LAS float*)(X.lds + ML_NW);
    int lane = X.lane; asm volatile("" : "+v"(lane));
    const int c16 = lane & 15, quad = lane >> 4, w = X.wave;
    for (int idx = X.tid; idx < 1280; idx += 512) { const int tap = idx >> 8, ch = idx & 255; const int gch = (ch < 128) ? (hh * 128 + ch) : (512 + hh * 128 + (ch - 128));
        CW[idx] = (tap < 4) ? a.conv_w[(size_t)(l * 4 + tap) * 1024 + gch] : a.conv_b[l * 1024 + gch]; }
    for (int idx = X.tid; idx < 16 * 72; idx += 512) VT[128 * 72 + idx] = (idx < 72) ? (bf16)0x3F80 : (bf16)0;
    if (X.tid < 128) NW[X.tid] = a.mnw[l * 512 + hh * 128 + X.tid];
    f32x4 cacc[9];
#pragma unroll
    for (int et = 0; et < 9; ++et) {
        if (L3) {
#pragma unroll
            for (int j = 0; j < 4; ++j) { const float v = mlc[(16 * et + 4 * quad + j) * 128 + 16 * w + c16]; cacc[et][j] = v; CT[(16 * et + 4 * quad + j) * 136 + 16 * w + c16] = (bf16)f2bf(v); }
        } else cacc[et] = (f32x4){0.f, 0.f, 0.f, 0.f};
    }
    float bsum = 0.f;
    __syncthreads();
#pragma unroll 1
    for (int c = 0; c < 8; ++c) {
        const int tok0 = tokbase + c * 64;
        float bsc = gates[(size_t)(tok0 + lane) * 8 + 4 + hh]; const float li = gates[(size_t)(tok0 + lane) * 8 + hh];
#pragma unroll
        for (int o = 1; o < 64; o <<= 1) { const float v = __shfl_up(bsc, o); if (lane >= o) bsc += v; }
        const float bl = __shfl(bsc, 63); const float csv = li - bsc;
        if (w == 0) { CB[lane] = bsc; CB[64 + lane] = csv; }
        bsum += bl;
        { const int t = X.tid >> 3, dc = X.tid & 7; const float fac = __expf(bl + __shfl(csv, t));
          const int tokt = tok0 + t;
#pragma unroll
          for (int qk = (L3 ? 0 : 1); qk < 2; ++qk) {
              float accv[16];
#pragma unroll
              for (int i = 0; i < 16; ++i) accv[i] = CW[4 * 256 + qk * 128 + 16 * dc + i];
#pragma unroll
              for (int j = 0; j < 4; ++j) { const int tt = tokt - 3 + j;
                  if (tt >= b * SEQ) { const v4u* p = (const v4u*)(proj + (size_t)tt * NPROJ + (qk ? C_MK : C_MQ) + hh * 128 + 16 * dc); const v4u w0 = p[0], w1 = p[1];
                      const float xv[16] = {bflo(w0.x), bfhi(w0.x), bflo(w0.y), bfhi(w0.y), bflo(w0.z), bfhi(w0.z), bflo(w0.w), bfhi(w0.w), bflo(w1.x), bfhi(w1.x), bflo(w1.y), bfhi(w1.y), bflo(w1.z), bfhi(w1.z), bflo(w1.w), bfhi(w1.w)};
#pragma unroll
                      for (int i = 0; i < 16; ++i) accv[i] += CW[j * 256 + qk * 128 + 16 * dc + i] * xv[i]; } }
#pragma unroll
              for (int i = 0; i < 16; ++i) { const float z = accv[i]; accv[i] = z / (1.0f + __expf(-z)) * (qk ? 0.08838834764831845f : 1.0f); }
              if (L3) { LAS bf16* dst = (qk ? Ks : Qs) + t * 136 + 16 * dc;
                  v4u o0, o1; o0.x = pk2(accv[0], accv[1]); o0.y = pk2(accv[2], accv[3]); o0.z = pk2(accv[4], accv[5]); o0.w = pk2(accv[6], accv[7]);
                  o1.x = pk2(accv[8], accv[9]); o1.y = pk2(accv[10], accv[11]); o1.z = pk2(accv[12], accv[13]); o1.w = pk2(accv[14], accv[15]);
                  *(LAS v4u*)dst = o0; *(LAS v4u*)(dst + 8) = o1; }
              if (qk) {
#pragma unroll
                  for (int i = 0; i < 16; ++i) KET[(16 * dc + i) * 72 + t] = (bf16)f2bf(accv[i] * fac); }
          }
          { const v4u* p = (const v4u*)(proj + (size_t)tokt * NPROJ + C_MV + hh * 128 + 16 * dc); const v4u w0 = p[0], w1 = p[1];
            const unsigned ww[8] = {w0.x, w0.y, w0.z, w0.w, w1.x, w1.y, w1.z, w1.w};
#pragma unroll
            for (int i = 0; i < 8; ++i) { VT[(16 * dc + 2 * i) * 72 + t] = (bf16)(ww[i] & 0xffffu); VT[(16 * dc + 2 * i + 1) * 72 + t] = (bf16)(ww[i] >> 16); } }
        }
        __syncthreads();
        float hval[4][4]; int tt_ = w & 3, eh = w >> 2; const int tq = 16 * tt_ + c16;
        if (L3) {
            bf16x8 qf[4];
#pragma unroll
            for (int ks = 0; ks < 4; ++ks) qf[ks] = *(const LAS bf16x8*)(Qs + tq * 136 + 32 * ks + 8 * quad);
            f32x4 sacc[4];
#pragma unroll
            for (int st = 0; st < 4; ++st) { f32x4 z = {0.f, 0.f, 0.f, 0.f};
#pragma unroll
                for (int ks = 0; ks < 4; ++ks) z = __builtin_amdgcn_mfma_f32_16x16x32_bf16(*(const LAS bf16x8*)(Ks + (16 * st + c16) * 136 + 32 * ks + 8 * quad), qf[ks], z, 0, 0, 0);
                sacc[st] = z; }
            const float cbt = CB[tq];
#pragma unroll
            for (int st = 0; st < 4; ++st)
#pragma unroll
                for (int j = 0; j < 4; ++j) { const int s = 16 * st + 4 * quad + j; const float d = (s <= tq) ? __expf(cbt + CB[64 + s]) : 0.f; sacc[st][j] *= d; }
            bf16x8 pf[2];
#pragma unroll
            for (int kk = 0; kk < 2; ++kk) { v4u pw; pw.x = pk2(sacc[2 * kk][0], sacc[2 * kk][1]); pw.y = pk2(sacc[2 * kk][2], sacc[2 * kk][3]); pw.z = pk2(sacc[2 * kk + 1][0], sacc[2 * kk + 1][1]); pw.w = pk2(sacc[2 * kk + 1][2], sacc[2 * kk + 1][3]); pf[kk] = __builtin_bit_cast(bf16x8, pw); }
            const float ebt = __expf(cbt);
            f32x4 nn[5];
#pragma unroll
            for (int x = 0; x < 5; ++x) { const int et = (x < 4) ? (4 * eh + x) : 8; f32x4 na = {0.f, 0.f, 0.f, 0.f}, ia = {0.f, 0.f, 0.f, 0.f};
#pragma unroll
                for (int kk = 0; kk < 2; ++kk) { const LAS bf16* vr = VT + (16 * et + c16) * 72 + 32 * kk + 4 * quad; const v2u lo = *(const LAS v2u*)vr, hi = *(const LAS v2u*)(vr + 16); v4u vw; vw.x = lo.x; vw.y = lo.y; vw.z = hi.x; vw.w = hi.y;
                    na = __builtin_amdgcn_mfma_f32_16x16x32_bf16(__builtin_bit_cast(bf16x8, vw), pf[kk], na, 0, 0, 0); }
#pragma unroll
                for (int ks = 0; ks < 4; ++ks) ia = __builtin_amdgcn_mfma_f32_16x16x32_bf16(*(const LAS bf16x8*)(CT + (16 * et + c16) * 136 + 32 * ks + 8 * quad), qf[ks], ia, 0, 0, 0);
                nn[x] = na + ia * ebt; }
            const float den = __shfl(nn[4][0], c16); const float inv = 1.0f / fmaxf(fabsf(den), 1.0f);
            float ss = 0.f;
#pragma unroll
            for (int x = 0; x < 4; ++x)
#pragma unroll
                for (int j = 0; j < 4; ++j) { hval[x][j] = nn[x][j] * inv; ss += hval[x][j] * hval[x][j]; }
            ss += __shfl_xor(ss, 16); ss += __shfl_xor(ss, 32);
            if (quad == 0) RED[eh * 64 + tq] = ss;
            __syncthreads();
            const float rstd = 1.0f / sqrtf((RED[tq] + RED[64 + tq]) * (1.0f / 128.0f) + EPS);
#pragma unroll
            for (int x = 0; x < 4; ++x) { const int e = 16 * (4 * eh + x) + 4 * quad; const v2u og = *(const v2u*)(proj + (size_t)(tok0 + tq) * NPROJ + C_MO + hh * 128 + e);
                const float y0 = hval[x][0] * rstd * NW[e] * bflo(og.x), y1 = hval[x][1] * rstd * NW[e + 1] * bfhi(og.x), y2 = hval[x][2] * rstd * NW[e + 2] * bflo(og.y), y3 = hval[x][3] * rstd * NW[e + 3] * bfhi(og.y);
                v2u o; o.x = pk2(y0, y1); o.y = pk2(y2, y3); *(v2u*)(hm + (size_t)(tok0 + tq) * 512 + hh * 128 + e) = o; }
        }
        { const float ebl = __expf(bl);
          bf16x8 kf[2];
#pragma unroll
          for (int kk = 0; kk < 2; ++kk) kf[kk] = *(const LAS bf16x8*)(KET + (16 * w + c16) * 72 + 32 * kk + 8 * quad);
#pragma unroll
          for (int et = 0; et < 9; ++et) { f32x4 z = cacc[et] * ebl;
#pragma unroll
              for (int kk = 0; kk < 2; ++kk) z = __builtin_amdgcn_mfma_f32_16x16x32_bf16(*(const LAS bf16x8*)(VT + (16 * et + c16) * 72 + 32 * kk + 8 * quad), kf[kk], z, 0, 0, 0);
              cacc[et] = z;
              if (L3) {
#pragma unroll
                  for (int j = 0; j < 4; ++j) CT[(16 * et + 4 * quad + j) * 136 + 16 * w + c16] = (bf16)f2bf(z[j]); } } }
        __syncthreads();
    }
    if (!L3) {
#pragma unroll
        for (int et = 0; et < 9; ++et)
#pragma unroll
            for (int j = 0; j < 4; ++j) mlc[(16 * et + 4 * quad + j) * 128 + 16 * w + c16] = cacc[et][j];
        if (X.tid == 0) mlb[unit] = bsum;
    }
}
DI void mlstm_scan(const Args& a, const Ctx& X) {
    float* mlc = (float*)(a.ws + WS_MLC); const float* mlb = (const float*)(a.ws + WS_MLB);
    for (int idx = X.bid * 512 + X.tid; idx < 8 * 18432; idx += X.G * 512) { const int seq = idx / 18432, el = idx - seq * 18432; float carry = 0.f;
        float* p0 = mlc + (size_t)seq * 32 * 18432 + el; float v[32], dcy[32];
#pragma unroll
        for (int j = 0; j < 32; ++j) { v[j] = p0[(size_t)j * 18432]; dcy[j] = mlb[seq * 32 + j]; }
#pragma unroll
        for (int j = 0; j < 32; ++j) { p0[(size_t)j * 18432] = carry; carry = __expf(dcy[j]) * carry + v[j]; } }
}

DI void p6_norm_route(const Args& a, const Ctx& X, int l, const float* xin) {
    unsigned char* ws = a.ws;
    LAS float* wr = (LAS float*)X.lds;
    for (int idx = X.tid; idx < 16384; idx += 512) { const int k = idx >> 4, e = idx & 15; wr[e * 1024 + k] = a.router_w[idx]; }
    __syncthreads();
    const float* mod = (const float*)(ws + WS_MOD); bf16* hb = (bf16*)(ws + WS_H); float* tgate = (float*)(ws + WS_TGATE); int* tokl = (int*)(ws + WS_TOKL);
    unsigned* cnt = (unsigned*)(ws + WS_CTL) + CW_CNT + l * 32;
    const int gw = X.bid * 8 + X.wave, NGW = X.G * 8;
    for (int rg = gw; rg < T / 16; rg += NGW) {
        const int row0 = rg * 16, b = row0 >> 14;
        const float* mb = mod + (size_t)(l * 2 + b) * 6144;
        f32x4 aw[4], sh[4];
#pragma unroll
        for (int j = 0; j < 4; ++j) { const int k = 256 * j + 4 * X.lane; const f32x4 nw = *(const f32x4*)(a.nfw + l * D + k); const f32x4 sc = *(const f32x4*)(mb + 4 * 1024 + k); aw[j] = nw * (sc + 1.0f); sh[j] = *(const f32x4*)(mb + 3 * 1024 + k); }
        int my_cls = 0; float my_ga = 0.f, my_gb = 0.f;
#pragma unroll 1
        for (int r = 0; r < 16; ++r) { const int row = row0 + r;
            const f32x4* xr = (const f32x4*)(xin + (size_t)row * D) + X.lane; f32x4 v[4]; float ss = 0.f;
#pragma unroll
            for (int j = 0; j < 4; ++j) { v[j] = xr[64 * j]; ss += (v[j].x * v[j].x + v[j].y * v[j].y) + (v[j].z * v[j].z + v[j].w * v[j].w); }
            ss = wave_sum(ss); const float rstd = 1.0f / sqrtf(ss * (1.0f / D) + EPS);
            unsigned long long* o8 = (unsigned long long*)(hb + (size_t)row * D) + X.lane;
#pragma unroll
            for (int j = 0; j < 4; ++j) { v[j] = v[j] * rstd * aw[j] + sh[j]; o8[64 * j] = (unsigned long long)pk2(v[j].x, v[j].y) | ((unsigned long long)pk2(v[j].z, v[j].w) << 32); }
            float sc[16], sel[16];
#pragma unroll
            for (int e = 0; e < 16; ++e) { float p = 0.f;
#pragma unroll
                for (int j = 0; j < 4; ++j) { const f32x4 wv = *(const LAS f32x4*)(wr + e * 1024 + 256 * j + 4 * X.lane); p += (v[j].x * wv.x + v[j].y * wv.y) + (v[j].z * wv.z + v[j].w * wv.w); }
                p = wave_sum(p); sc[e] = 1.0f / (1.0f + __expf(-p)); sel[e] = sc[e] + a.router_b[e]; __builtin_amdgcn_sched_barrier(0); }
            int gi = 0; float gbest = -1.0e30f;
#pragma unroll
            for (int g = 0; g < 4; ++g) { const float p0 = sel[4 * g], p1 = sel[4 * g + 1], p2 = sel[4 * g + 2], p3 = sel[4 * g + 3];
                const float gs = fmaxf(fmaxf(fmaxf(p0 + p1, p0 + p2), fmaxf(p0 + p3, p1 + p2)), fmaxf(p1 + p3, p2 + p3));
                if (gs > gbest) { gbest = gs; gi = g; } }
            float q[4], s4[4];
#pragma unroll
            for (int i = 0; i < 4; ++i) { q[i] = 0.f; s4[i] = 0.f; }
#pragma unroll
            for (int g = 0; g < 4; ++g) if (g == gi) {
#pragma unroll
                for (int i = 0; i < 4; ++i) { q[i] = sel[4 * g + i]; s4[i] = sc[4 * g + i]; } }
            int i1 = 0; float b1 = q[0];
#pragma unroll
            for (int i = 1; i < 4; ++i) if (q[i] > b1) { b1 = q[i]; i1 = i; }
            int i2 = -1; float b2 = -1.0e30f;
#pragma unroll
            for (int i = 0; i < 4; ++i) if (i != i1 && q[i] > b2) { b2 = q[i]; i2 = i; }
            const int ia = (i1 < i2) ? i1 : i2, ib = (i1 < i2) ? i2 : i1;
            float sa = 0.f, sb = 0.f;
#pragma unroll
            for (int i = 0; i < 4; ++i) { if (i == ia) sa = s4[i]; if (i == ib) sb = s4[i]; }
            const int pidx = (ia == 0) ? (ib - 1) : ((ia == 1) ? (ib + 1) : 5);
            const float inv = 1.0f / (sa + sb);
            if (X.lane == r) { my_cls = gi * 6 + pidx; my_ga = sa * inv; my_gb = sb * inv; }
        }
        if (X.lane < 16) { const int tok = row0 + X.lane; const unsigned pos = __hip_atomic_fetch_add(cnt + my_cls, 1u, RLX_AGENT);
            tokl[my_cls * CLS_CAP + (int)pos] = tok; tgate[tok * 2] = my_ga; tgate[tok * 2 + 1] = my_gb; }
    }
}
DI MoeTab moe_tables(const Args& a, const Ctx& X, int l) {
    LAS int* tab = (LAS int*)(X.lds + TAB_OFF); LAS int* tcls = tab; LAS int* tpos = tab + 160; LAS int* cn = tab + 320; LAS int* rt_ = tab + 344;
    unsigned* cnt = (unsigned*)(a.ws + WS_CTL) + CW_CNT + l * 32;
    if (X.tid < NCLS) cn[X.tid] = (int)__hip_atomic_load(cnt + X.tid, RLX_AGENT);
    __syncthreads();
    if (X.tid == 0) { int r = 0;
#pragma unroll 1
        for (int c = 0; c < NCLS; ++c) { const int n = (cn[c] + 255) >> 8;
#pragma unroll 1
            for (int i = 0; i < n; ++i) { tcls[r] = c; tpos[r] = i * 256; ++r; } }
        rt_[0] = r; }
    __syncthreads();
    MoeTab tb; tb.tcls = tcls; tb.tpos = tpos; tb.cnt = cn; tb.Rtot = __builtin_amdgcn_readfirstlane(rt_[0]); return tb;
}

#if defined(__HIP_DEVICE_COMPILE__)
DI Args load_args() { auto p = __builtin_amdgcn_kernarg_segment_ptr(); asm volatile("" : "+s"(p)); return *(const __attribute__((address_space(4))) Args*)p; }
#else
DI Args load_args() { return Args{}; }
#endif
__global__ void __launch_bounds__(512, 2) fwd(Args a_unused) {
    extern __shared__ __attribute__((aligned(16))) unsigned char lds_raw[];
    Ctx X; X.lds = (LAS unsigned char*)lds_raw; X.tid = threadIdx.x; X.lane = X.tid & 63; X.wave = __builtin_amdgcn_readfirstlane(X.tid >> 6); X.G = gridDim.x; X.bid = blockIdx.x;
    volatile LAS unsigned* MISC = (volatile LAS unsigned*)(X.lds + MISC_OFF);
    if (X.tid < 64) MISC[X.tid] = 0u;
    __syncthreads();
    int lo, hi; unsigned* ctl;
    { const Args a = load_args(); lo = a.ph_lo; hi = a.ph_hi; ctl = (unsigned*)(a.ws + WS_CTL); }
    XcdBarrier bar; bar.bar = ctl + CW_BAR; bar.x = 0; bar.st = MISC + 8;
    if (hi - lo > 1) bar = xcd_barrier_post(ctl + CW_BAR, MISC + 8);
#ifndef PH_MASK
#define PH_MASK 0xFFFFF
#endif
#define PON(p) ((PH_MASK >> (p)) & 1)
#ifndef DUP_MASK
#define DUP_MASK 0
#endif
#define NREP(p) (((DUP_MASK >> (p)) & 1) ? 2 : 1)
#define IN(k) (lo <= (k) && (k) < hi)
#define SEAM(k) do { if (IN(k) && IN((k) + 1)) xcd_barrier(bar); } while (0)
    if (PON(10) && IN(0)) { for (int rep = 0; rep < NREP(10); ++rep) { const Args a = load_args(); p0_prologue(a, X); } }
    SEAM(0);
    for (int l = 0; l < NL; ++l) {
        const int g0 = 1 + l * NPH;
        if (PON(0) && IN(g0 + 0)) { for (int rep = 0; rep < NREP(0); ++rep) { const Args a = load_args(); unsigned char* ws = a.ws; const float* mod = (const float*)(ws + WS_MOD); bf16* proj = (bf16*)(ws + WS_PROJ); const float* xin = (l == 0) ? a.x : a.out; (void)mod; (void)proj; (void)xin; const Ctx P = fresh(X); p1_norm_gates(a, P, l, xin); } }
        SEAM(g0 + 0);
        if (PON(1) && IN(g0 + 1)) for (int rep = 0; rep < NREP(1); ++rep) { const Args a = load_args(); unsigned char* ws = a.ws; const float* mod = (const float*)(ws + WS_MOD); bf16* proj = (bf16*)(ws + WS_PROJ); const float* xin = (l == 0) ? a.x : a.out; (void)mod; (void)proj; (void)xin; const Ctx P = fresh(X);
            DenseSched S; S.A = (const char*)(ws + WS_H); S.Bt = (const char*)(ws + WS_WIN) + (size_t)l * NPROJ * D * 2; S.lda = D; S.ldb = D; S.ord.init(T / 256, NPROJ / 256, P.G, P.bid);
            EpiProj E; E.O = proj;
            pg8::gemm_phase<EpiProj, DenseSched>(P.lds, D, S, E);
        }
        SEAM(g0 + 1);
        if (PON(2) && IN(g0 + 2)) { const Args a = load_args(); unsigned char* ws = a.ws; const float* mod = (const float*)(ws + WS_MOD); bf16* proj = (bf16*)(ws + WS_PROJ); const float* xin = (l == 0) ? a.x : a.out; (void)mod; (void)proj; (void)xin; const Ctx P = fresh(X);
            if (PON(11)) for (int rep = 0; rep < NREP(11); ++rep) {
#pragma unroll 1
                for (int u = P.bid; u < 512; u += P.G) attn_unit(a, P, l, u); }
            if (PON(12)) for (int rep = 0; rep < NREP(12); ++rep) {
#pragma unroll 1
                for (int u = P.bid; u < 256; u += P.G) mlstm_unit<false>(a, P, l, u); }
        }
        SEAM(g0 + 2);
        if (PON(3) && IN(g0 + 3)) { const Args a = load_args(); unsigned char* ws = a.ws; const float* mod = (const float*)(ws + WS_MOD); bf16* proj = (bf16*)(ws + WS_PROJ); const float* xin = (l == 0) ? a.x : a.out; (void)mod; (void)proj; (void)xin; const Ctx P = fresh(X); mlstm_scan(a, P); }
        SEAM(g0 + 3);
        if (PON(4) && IN(g0 + 4)) for (int rep = 0; rep < NREP(4); ++rep) { const Args a = load_args(); unsigned char* ws = a.ws; const float* mod = (const float*)(ws + WS_MOD); bf16* proj = (bf16*)(ws + WS_PROJ); const float* xin = (l == 0) ? a.x : a.out; (void)mod; (void)proj; (void)xin; const Ctx P = fresh(X);
#pragma unroll 1
            for (int u = P.bid; u < 256; u += P.G) mlstm_unit<true>(a, P, l, u); }
        SEAM(g0 + 4);
        if (PON(5) && IN(g0 + 5)) for (int rep = 0; rep < NREP(5); ++rep) { const Args a = load_args(); unsigned char* ws = a.ws; const float* mod = (const float*)(ws + WS_MOD); bf16* proj = (bf16*)(ws + WS_PROJ); const float* xin = (l == 0) ? a.x : a.out; (void)mod; (void)proj; (void)xin; const Ctx P = fresh(X);
            { DenseSched S; S.A = (const char*)(ws + WS_H); S.Bt = (const char*)(ws + WS_WAU) + (size_t)l * D * 512 * 2; S.lda = 512; S.ldb = 512; S.ord.init(T / 256, D / 256, P.G, P.bid);
              EpiGate<false> E; E.P = proj; E.gcol = C_GA; pg8::gemm_phase<EpiGate<false>, DenseSched>(P.lds, 512, S, E); }
            { DenseSched S; S.A = (const char*)(ws + WS_H) + (size_t)T * 512 * 2; S.Bt = (const char*)(ws + WS_WMU) + (size_t)l * D * 512 * 2; S.lda = 512; S.ldb = 512; S.ord.init(T / 256, D / 256, P.G, P.bid);
              EpiGate<true> E; E.P = proj; E.gcol = C_GB; pg8::gemm_phase<EpiGate<true>, DenseSched>(P.lds, 512, S, E); }
        }
        SEAM(g0 + 5);
        if (PON(6) && IN(g0 + 6)) for (int rep = 0; rep < NREP(6); ++rep) { const Args a = load_args(); unsigned char* ws = a.ws; const float* mod = (const float*)(ws + WS_MOD); bf16* proj = (bf16*)(ws + WS_PROJ); const float* xin = (l == 0) ? a.x : a.out; (void)mod; (void)proj; (void)xin; const Ctx P = fresh(X);
            DenseSched S; S.A = (const char*)(proj + C_MQ); S.Bt = (const char*)(ws + WS_WOUT) + (size_t)l * D * D * 2; S.lda = NPROJ; S.ldb = D; S.ord.init(T / 256, D / 256, P.G, P.bid);
            EpiRes E; E.xin = xin; E.out = a.out; E.g = mod + (size_t)(l * 2) * 6144 + 2 * 1024; E.rmask = T - 1;
            if (rep) { E.out = (float*)(ws + WS_H); E.rmask = T / 2 - 1; }
            pg8::gemm_phase<EpiRes, DenseSched>(P.lds, D, S, E);
        }
        SEAM(g0 + 6);
        if (PON(7) && IN(g0 + 7)) { const Args a = load_args(); unsigned char* ws = a.ws; const float* mod = (const float*)(ws + WS_MOD); bf16* proj = (bf16*)(ws + WS_PROJ); const float* xin = (l == 0) ? a.x : a.out; (void)mod; (void)proj; (void)xin; const Ctx P = fresh(X); p6_norm_route(a, P, l, a.out); }
        SEAM(g0 + 7);
        if (PON(8) && IN(g0 + 8)) for (int rep = 0; rep < NREP(8); ++rep) { const Args a = load_args(); unsigned char* ws = a.ws; const float* mod = (const float*)(ws + WS_MOD); bf16* proj = (bf16*)(ws + WS_PROJ); const float* xin = (l == 0) ? a.x : a.out; (void)mod; (void)proj; (void)xin; const Ctx P = fresh(X);
            const MoeTab tb = moe_tables(a, P, l);
            LAS unsigned* tokoff = (LAS unsigned*)(P.lds + TOKOFF_OFF); const int* tokl = (const int*)(ws + WS_TOKL);
#pragma unroll 1
            for (int s = 0; s < 8; ++s) { const int L = s * P.G + P.bid;
                if (L < tb.Rtot * 8 && P.tid < 256) { const int rt = L >> 3, cls = tb.tcls[rt], pos = tb.tpos[rt] + P.tid, cn = tb.cnt[cls]; const int tok = tokl[cls * CLS_CAP + (pos < cn ? pos : 0)]; tokoff[s * 256 + P.tid] = (unsigned)tok; } }
            __syncthreads();
            MoeUpSched S; S.A = (const char*)(ws + WS_H); S.W = (const char*)(ws + WS_WGU) + (size_t)l * NE * 1024 * D * 2; S.lda = D; S.ldb = D; S.tb = tb; S.G = P.G; S.c = P.bid; S.tokoff = tokoff;
            EpiSwiglu E; E.H = proj; E.tgate = (const float*)(ws + WS_TGATE); E.tokoff = tokoff;
            pg8::gemm_phase<EpiSwiglu, MoeUpSched>(P.lds, D, S, E);
        }
        SEAM(g0 + 8);
        if (PON(9) && IN(g0 + 9)) for (int rep = 0; rep < NREP(9); ++rep) { const Args a = load_args(); unsigned char* ws = a.ws; const float* mod = (const float*)(ws + WS_MOD); bf16* proj = (bf16*)(ws + WS_PROJ); const float* xin = (l == 0) ? a.x : a.out; (void)mod; (void)proj; (void)xin; const Ctx P = fresh(X);
            const MoeTab tb = moe_tables(a, P, l);
            MoeDownSched S; S.A = (const char*)proj; S.W = (const char*)(ws + WS_WD) + (size_t)l * NE * 1024 * FF * 2; S.lda = D; S.ldb = FF; S.tb = tb; S.G = P.G; S.c = P.bid;
            EpiMoeOut E; E.xin = a.out; E.out = a.out; E.g = mod + (size_t)(l * 2) * 6144 + 5 * 1024; E.tokl = (const int*)(ws + WS_TOKL); E.tb = tb; E.rmask = T - 1;
            if (rep) { E.out = (float*)(ws + WS_H); E.rmask = T / 2 - 1; }
            pg8::gemm_phase<EpiMoeOut, MoeDownSched>(P.lds, D, S, E);
        }
        SEAM(g0 + 9);
    }
#undef IN
#undef SEAM
}

extern "C" void kernel_launch(void* const* d_in, const int* in_sizes, int n_in, void* d_out, int out_size, void* d_ws, size_t ws_size, hipStream_t stream) {
    static int grid = 0;
    if (grid == 0) {
        if (n_in != 24 || in_sizes[0] != T * D || out_size != T * D || ws_size < WS_END) { fprintf(stderr, "kernel_launch: unexpected shapes / workspace (n_in %d, ws %zu, need %zu)\n", n_in, ws_size, (size_t)WS_END); grid = -1; return; }
        int dev = 0, cus = 0;
        if (hipGetDevice(&dev) != hipSuccess || hipDeviceGetAttribute(&cus, hipDeviceAttributeMultiprocessorCount, dev) != hipSuccess) { grid = -1; return; }
        if (hipFuncSetAttribute((const void*)fwd, hipFuncAttributeMaxDynamicSharedMemorySize, LDS_BYTES) != hipSuccess) { fprintf(stderr, "kernel_launch: hipFuncSetAttribute failed\n"); grid = -1; return; }
        int per_cu = 0;
        if (hipOccupancyMaxActiveBlocksPerMultiprocessor(&per_cu, (const void*)fwd, 512, LDS_BYTES) != hipSuccess || per_cu < 1) fprintf(stderr, "kernel_launch: occupancy query reports %d\n", per_cu);
        (void)hipGetLastError();
        grid = cus < 256 ? cus : 256;
    }
    if (grid < 0) return;
    (void)hipMemsetAsync((char*)d_ws + WS_CTL, 0, CTL_ZERO_BYTES, stream);
    Args a{};
    a.x = (const float*)d_in[0]; a.c = (const float*)d_in[1]; a.pos = (const int*)d_in[2]; a.ada_w = (const float*)d_in[3]; a.ada_b = (const float*)d_in[4];
    a.nmw = (const float*)d_in[5]; a.nfw = (const float*)d_in[6]; a.w_in = (const float*)d_in[7]; a.b_ig = (const float*)d_in[8]; a.b_fg = (const float*)d_in[9];
    a.qnw = (const float*)d_in[10]; a.knw = (const float*)d_in[11]; a.sinks = (const float*)d_in[12]; a.conv_w = (const float*)d_in[13]; a.conv_b = (const float*)d_in[14];
    a.mnw = (const float*)d_in[15]; a.w_au = (const float*)d_in[16]; a.w_mu = (const float*)d_in[17]; a.w_out = (const float*)d_in[18]; a.router_w = (const float*)d_in[19];
    a.router_b = (const float*)d_in[20]; a.w_gate = (const float*)d_in[21]; a.w_up = (const float*)d_in[22]; a.w_down = (const float*)d_in[23];
    a.out = (float*)d_out; a.ws = (unsigned char*)d_ws;
#if MK_MULTI
    for (int gp = 0; gp < NGP; ++gp) { a.ph_lo = gp; a.ph_hi = gp + 1; hipLaunchKernelGGL(fwd, dim3(grid), dim3(512), LDS_BYTES, stream, a); }
#else
    a.ph_lo = 0; a.ph_hi = NGP; hipLaunchKernelGGL(fwd, dim3(grid), dim3(512), LDS_BYTES, stream, a);
#endif
}
```

```cpp
#include <hip/hip_runtime.h>
#include <cstdio>
#include <cstdint>

#ifndef MK_MULTI
#define MK_MULTI 0
#endif

#define GAS __attribute__((address_space(1)))
#define LAS __attribute__((address_space(3)))
typedef unsigned short bf16;
typedef unsigned v4u __attribute__((ext_vector_type(4)));
typedef unsigned v2u __attribute__((ext_vector_type(2)));
typedef float f32x4 __attribute__((ext_vector_type(4)));
typedef float f32x2 __attribute__((ext_vector_type(2)));
typedef short bf16x8 __attribute__((ext_vector_type(8)));
typedef short bf16x4 __attribute__((ext_vector_type(4)));
#define DI __device__ __forceinline__
#define RLX_AGENT __ATOMIC_RELAXED, __HIP_MEMORY_SCOPE_AGENT
#define LDS_WAIT() asm volatile("s_waitcnt lgkmcnt(0)" ::: "memory")
#define VM_WAIT() asm volatile("s_waitcnt vmcnt(0)" ::: "memory")

constexpr int NB = 2, SEQ = 16384, T = NB * SEQ, D = 1024, NL = 4;
constexpr int DIN_SRC = 4872;
constexpr int NPROJ = 4864;
constexpr int C_AQ = 0, C_AK = 512, C_AV = 640, C_MQ = 768, C_MK = 1280, C_MV = 1792, C_MO = 2304, C_GA = 2816, C_GB = 3840;
constexpr int NE = 16, FF = 512;
constexpr int NCLS = 24, CLS_CAP = 32768;
constexpr float EPS = 1e-6f;
constexpr int NPH = 10;
constexpr int NGP = 1 + NL * NPH;

constexpr size_t MiB = 1u << 20;
constexpr size_t WS_CTL = 0, CTL_ZERO_BYTES = 1 * MiB;
constexpr size_t WS_MOD = 1 * MiB;
constexpr size_t WS_ROPE = 2 * MiB;
constexpr size_t WS_GATES = 4 * MiB;
constexpr size_t WS_TGATE = 5 * MiB;
constexpr size_t WS_TOKL = 6 * MiB;
constexpr size_t WS_MLB = 9 * MiB;
constexpr size_t WS_MLC = 10 * MiB;
constexpr size_t WS_WIN = 28 * MiB;
constexpr size_t WS_WAU = 66 * MiB;
constexpr size_t WS_WMU = 70 * MiB;
constexpr size_t WS_WOUT = 74 * MiB;
constexpr size_t WS_WGU = 82 * MiB;
constexpr size_t WS_WD = 210 * MiB;
constexpr size_t WS_H = 274 * MiB;
constexpr size_t WS_PROJ = 338 * MiB;
constexpr size_t WS_END = 642 * MiB;

constexpr int CW_TMO = 0;
constexpr int CW_BAR = 4096;
constexpr int CW_CNT = 8192;

constexpr int RING_BYTES = 131072;
constexpr int MISC_OFF = RING_BYTES;
constexpr int TAB_OFF = RING_BYTES + 256;
constexpr int TOKOFF_OFF = RING_BYTES + 2048;
constexpr int LDS_BYTES = 147456;

DI unsigned f2bf(float f) { unsigned u = __builtin_bit_cast(unsigned, f); return (u + 0x7fffu + ((u >> 16) & 1u)) >> 16; }
DI unsigned pk2(float lo, float hi) { return f2bf(lo) | (f2bf(hi) << 16); }
DI float bf2f(unsigned short b) { return __builtin_bit_cast(float, ((unsigned)b) << 16); }
DI float bflo(unsigned w) { return __builtin_bit_cast(float, w << 16); }
DI float bfhi(unsigned w) { return __builtin_bit_cast(float, w & 0xffff0000u); }
DI float wave_sum(float v) {
#pragma unroll
    for (int o = 1; o < 64; o <<= 1) v += __shfl_xor(v, o);
    return v;
}
DI float sigmoidf_(float x) { return __builtin_amdgcn_rcpf(1.0f + __expf(-x)); }

#define XB_TMO      128
#define XB_XCNT(j)  (256  + 64 * (j))
#define XB_XSUB(j)  (1280 + 64 * (j))
#define XB_XGEN(j)  (2304 + 64 * (j))
#define XB_TOP      3328
#define XB_TOPGEN   3392
#define XCD_BAR_WORDS 3456
#define XB_SPIN_CAP (1u << 18)
__device__ __forceinline__ unsigned xb_ld(unsigned* p)              { return __hip_atomic_load(p, __ATOMIC_RELAXED, __HIP_MEMORY_SCOPE_AGENT); }
__device__ __forceinline__ unsigned xb_add(unsigned* p, unsigned v) { return __hip_atomic_fetch_add(p, v, __ATOMIC_RELAXED, __HIP_MEMORY_SCOPE_AGENT); }
__device__ __forceinline__ unsigned xb_xcc_id() { return (unsigned)__builtin_amdgcn_s_getreg((3 << 11) | 20) & 0xFu; }
#define XB_SPIN(cond, bar) do { unsigned _sp = 0; while (cond) { __builtin_amdgcn_s_sleep(1); \
    if ((++_sp & 255u) == 0u) { if (xb_ld(&(bar)[XB_TMO])) break; if (_sp > XB_SPIN_CAP) { atomicAdd(&(bar)[XB_TMO], 1u); break; } } } } while (0)
struct XcdBarrier { unsigned* bar; unsigned x; volatile LAS unsigned* st; };
__device__ __forceinline__ XcdBarrier xcd_barrier_post(unsigned* bar, volatile LAS unsigned* st) {
    XcdBarrier b; b.bar = bar; b.x = xb_xcc_id(); b.st = st;
    if (threadIdx.x == 0) (void)xb_add(&bar[XB_XCNT(b.x)], 1u);
    return b;
}
__device__ __forceinline__ void xcd_barrier_complete(unsigned* bar, unsigned x, unsigned& nloc, unsigned& nx) {
    const unsigned G = gridDim.x * gridDim.y * gridDim.z;
    unsigned sum, cnt, mine, sp = 0u;
    for (;;) {
        sum = 0u; cnt = 0u; mine = 0u;
#pragma unroll
        for (unsigned j = 0; j < 16; ++j) { const unsigned c = xb_ld(&bar[XB_XCNT(j)]); sum += c; cnt += (c > 0u) ? 1u : 0u; mine = (j == x) ? c : mine; }
        if (sum == G) break;
        __builtin_amdgcn_s_sleep(1);
        if ((++sp & 255u) == 0u) { if (xb_ld(&bar[XB_TMO])) break; if (sp > XB_SPIN_CAP) { atomicAdd(&bar[XB_TMO], 1u); break; } }
    }
    nloc = mine > 0u ? mine : 1u; nx = cnt > 0u ? cnt : 1u;
}
__device__ __forceinline__ void xcd_barrier(const XcdBarrier& b) {
    asm volatile("s_waitcnt vmcnt(0)" ::: "memory");
    __syncthreads();
    if (threadIdx.x == 0) {
        unsigned* bar = b.bar;
        __builtin_amdgcn_s_waitcnt(0);
        unsigned nloc = b.st[0], nx = b.st[1];
        if (nloc == 0u) { xcd_barrier_complete(bar, b.x, nloc, nx); b.st[0] = nloc; b.st[1] = nx; }
        const unsigned old = xb_add(&bar[XB_XSUB(b.x)], 1u);
        const unsigned gen = old / nloc;
        if (old + 1u == (gen + 1u) * nloc) {
            __builtin_amdgcn_fence(__ATOMIC_RELEASE, "agent");
            asm volatile("s_waitcnt vmcnt(0)" ::: "memory");
            const unsigned og = xb_add(&bar[XB_TOP], 1u);
            const unsigned tg = og / nx;
            if (og + 1u == (tg + 1u) * nx) xb_add(&bar[XB_TOPGEN], 1u);
            else XB_SPIN(xb_ld(&bar[XB_TOPGEN]) == tg, bar);
            __builtin_amdgcn_fence(__ATOMIC_ACQUIRE, "agent");
            xb_add(&bar[XB_XGEN(b.x)], 1u);
            asm volatile("s_waitcnt vmcnt(0)" ::: "memory");
        } else {
            XB_SPIN(xb_ld(&bar[XB_XGEN(b.x)]) == gen, bar);
            __builtin_amdgcn_fence(__ATOMIC_ACQUIRE, "agent");
            asm volatile("s_waitcnt vmcnt(0)" ::: "memory");
        }
    }
    __syncthreads();
}

namespace pg8 {
constexpr int BM = 256, BK = 64, HALF = 128, HTB = HALF * BK * 2, STAGE_BYTES = 8 * HTB, NXCD = 8, WGM = 8;
__host__ __device__ __forceinline__ int lds_byte(int r, int c) { const int st = (r >> 4) * 2 + (c >> 5), rr = r & 15, cc = c & 31, ob = rr * 64 + cc * 2; return st * 1024 + (ob ^ (((ob >> 9) & 1) << 5)); }
__host__ __device__ __forceinline__ void stage_rc(int b, int& R, int& C) { const int st = b / 1024, sb = b % 1024, swz = sb ^ (((sb >> 9) & 1) << 5); R = (st >> 1) * 16 + swz / 64; C = (st & 1) * 32 + (swz % 64) / 2; }
__host__ __device__ __forceinline__ int perm32(int rho) { const int n = rho >> 4, i = rho & 15; return 8 * (i >> 2) + 4 * n + (i & 3); }

struct Unit { int pm, pn, x0, x1; };

struct TileOrder {
    int nM, nN, nwg, G, c;
    __device__ void init(int nM_, int nN_, int G_, int c_) { nM = nM_; nN = nN_; nwg = nM * nN; G = G_; c = c_; }
    __device__ bool get(int i, int& pm, int& pn) const {
        const long L = (long)i * G + c; if (L >= nwg) return false;
        int wgid = (int)L; { const int q = nwg / NXCD, r = nwg % NXCD, xcd = wgid % NXCD, off = wgid / NXCD; wgid = (xcd < r ? xcd * (q + 1) : r * (q + 1) + (xcd - r) * q) + off; }
        const int nig = WGM * nN, gid = wgid / nig, fm = gid * WGM, gsz = (nM - fm) < WGM ? (nM - fm) : WGM;
        pm = fm + ((wgid % nig) % gsz); pn = (wgid % nig) / gsz; return true;
    }
};

template <class Epi, class Sched>
__device__ __forceinline__ void gemm_phase(LAS unsigned char* lds, const int K, const Sched& S, const Epi& E) {
    int tid = threadIdx.x; asm volatile("" : "+v"(tid));
    const int wid = __builtin_amdgcn_readfirstlane(tid >> 6), lane = tid & 63, wr = wid >> 2, wc = wid & 3, fr = lane & 15, fq = lane >> 4;
    const int nt = K / BK;
    constexpr bool GA = Sched::GATHER; constexpr int KS = Sched::KSPLIT;
    unsigned voffA[2], voffB[2]; int Rst[2], Cst[2];
#pragma unroll
    for (int i = 0; i < 2; ++i) { int R, C; stage_rc(tid * 16 + i * 8192, R, C); const int Rb = Epi::PERM ? ((R & ~31) + perm32(R & 31)) : R;
        voffA[i] = (unsigned)(R * S.lda + C) * 2u; voffB[i] = (unsigned)(Rb * S.ldb + C) * 2u; Rst[i] = R; Cst[i] = C; }
    const size_t kstep = (size_t)(BK * 2);
    const size_t hstepA = (size_t)HALF * S.lda * 2, hstepB = (size_t)HALF * S.ldb * 2;
    const unsigned ldsw = (unsigned)wid * 1024u; const unsigned gmul = (unsigned)S.lda * 2u;
    const int aoff = lds_byte(wr * 64 + fr, fq * 8), boff = lds_byte(wc * 32 + fr, fq * 8);
    unsigned vAc[2], vAn[2];
#define PG8_SA(b, h) (((b) * 2 + (h)) * HTB)
#define PG8_SB(b, h) ((4 + (b) * 2 + (h)) * HTB)
#define PG8_STAGE2(bufoff, gbase, v0, v1) do { \
        __builtin_amdgcn_global_load_lds((const unsigned*)((const char*)(gbase) + (v0)), (LAS unsigned*)(lds + (bufoff) + ldsw), 16, 0, 0); \
        __builtin_amdgcn_global_load_lds((const unsigned*)((const char*)(gbase) + (v1)), (LAS unsigned*)(lds + (bufoff) + ldsw + 8192), 16, 0, 0); } while (0)
#define PG8_STAGE_B(bufoff, ptr, h) PG8_STAGE2(bufoff, (ptr) + (h) * hstepB, voffB[0], voffB[1])
#define PG8_STAGE_A(bufoff, ptr, h, nx) do { if constexpr (GA) { const unsigned _p = (nx) ? vAn[h] : vAc[h]; PG8_STAGE2(bufoff, ptr, (_p & 0xffffu) * gmul + (unsigned)Cst[0] * 2u, (_p >> 16) * gmul + (unsigned)Cst[0] * 2u); } \
        else { PG8_STAGE2(bufoff, (ptr) + (h) * hstepA, voffA[0], voffA[1]); } } while (0)
#define PG8_LDA(dst, b, h) do { _Pragma("unroll") for (int m = 0; m < 4; ++m) _Pragma("unroll") for (int k = 0; k < 2; ++k) dst[m][k] = *(const LAS bf16x8*)(lds + PG8_SA(b, h) + aoff + m * 2048 + k * 1024); } while (0)
#define PG8_LDB(dst, b, h) do { _Pragma("unroll") for (int n = 0; n < 2; ++n) _Pragma("unroll") for (int k = 0; k < 2; ++k) dst[n][k] = *(const LAS bf16x8*)(lds + PG8_SB(b, h) + boff + n * 2048 + k * 1024); } while (0)
#define PG8_MMA(ai, bj, At, Bt) do { __builtin_amdgcn_s_setprio(1); _Pragma("unroll") for (int m = 0; m < 4; ++m) _Pragma("unroll") for (int n = 0; n < 2; ++n) _Pragma("unroll") for (int k = 0; k < 2; ++k) \
        acc[ai][bj][m][n] = __builtin_amdgcn_mfma_f32_16x16x32_bf16(Bt[n][k], At[m][k], acc[ai][bj][m][n], 0, 0, 0); __builtin_amdgcn_s_setprio(0); } while (0)
#define PG8_WAIT_V(n) asm volatile("s_waitcnt vmcnt(" #n ")" ::: "memory")
#define PG8_WAIT_L(n) asm volatile("s_waitcnt lgkmcnt(" #n ")" ::: "memory")
#define PG8_BAR __builtin_amdgcn_s_barrier()
#define PG8_SCHED __builtin_amdgcn_sched_barrier(0)
#define PG8_GOFF(dst, u) do { if constexpr (GA) { _Pragma("unroll") for (int h = 0; h < 2; ++h) dst[h] = S.a_rowoff(u, Rst[0] + HALF * h) | (S.a_rowoff(u, Rst[0] + 64 + HALF * h) << 16); } } while (0)
    Unit cur, nxt; int ui = 0;
    if (!S.next(0, cur)) return;
    f32x4 acc[2][2][4][2];
#pragma unroll
    for (int a = 0; a < 2; ++a)
#pragma unroll
        for (int b = 0; b < 2; ++b)
#pragma unroll
            for (int m = 0; m < 4; ++m)
#pragma unroll
                for (int n = 0; n < 2; ++n) acc[a][b][m][n] = (f32x4){0.f, 0.f, 0.f, 0.f};
    bf16x8 At[4][2], B0[2][2], B1[2][2];
    const char* cA = S.a_base(cur); const char* cB0 = S.b_base(cur, 0); const char* cB1 = KS ? S.b_base(cur, 1) : cB0;
    PG8_GOFF(vAc, cur);
    vAn[0] = vAc[0]; vAn[1] = vAc[1];
    PG8_STAGE_B(PG8_SB(0, 0), cB0, 0); PG8_STAGE_B(PG8_SB(0, 1), cB0, 1); PG8_STAGE_A(PG8_SA(0, 0), cA, 0, false); PG8_STAGE_A(PG8_SA(0, 1), cA, 1, false);
    if (wr == 1) PG8_BAR;
    PG8_WAIT_V(2); PG8_BAR;
    PG8_STAGE_B(PG8_SB(1, 0), cB0 + kstep, 0); PG8_STAGE_A(PG8_SA(1, 0), cA + kstep, 0, false); PG8_STAGE_B(PG8_SB(1, 1), cB0 + kstep, 1);
    PG8_WAIT_V(6); PG8_BAR;
    for (;;) {
        const bool has_next = S.next(ui + 1, nxt);
        const char* nA = has_next ? S.a_base(nxt) : cA; const char* nB0 = has_next ? S.b_base(nxt, 0) : cB0; const char* nB1 = (KS && has_next) ? S.b_base(nxt, 1) : (KS ? cB1 : nB0);
        if constexpr (GA) { if (has_next) { PG8_GOFF(vAn, nxt); } }
        for (int t = 0; t < nt; t += 2) {
            const bool last = (t == nt - 2);
            const char* a1 = cA + (size_t)(t + 1) * kstep;
            const char* a2 = last ? nA : cA + (size_t)(t + 2) * kstep;
            const char* b2 = last ? nB0 : ((KS && (t + 2) >= KS) ? cB1 + (size_t)(t + 2 - KS) * kstep : cB0 + (size_t)(t + 2) * kstep);
            const char* a3 = a2 + kstep; const char* b3 = b2 + kstep;
            PG8_LDB(B0, 0, 0); PG8_LDB(B1, 0, 1); PG8_SCHED; PG8_LDA(At, 0, 0); PG8_STAGE_A(PG8_SA(1, 1), a1, 1, false);
            PG8_WAIT_V(8); PG8_WAIT_L(0); PG8_BAR; PG8_MMA(0, 0, At, B0); PG8_MMA(0, 1, At, B1); PG8_BAR; PG8_SCHED;
            PG8_LDA(At, 0, 1); PG8_STAGE_B(PG8_SB(0, 0), b2, 0); PG8_STAGE_B(PG8_SB(0, 1), b2, 1); PG8_STAGE_A(PG8_SA(0, 0), a2, 0, last);
            PG8_WAIT_V(8); PG8_WAIT_L(0); PG8_BAR; PG8_MMA(1, 0, At, B0); PG8_MMA(1, 1, At, B1); PG8_BAR; PG8_SCHED;
            PG8_LDB(B0, 1, 0); PG8_LDB(B1, 1, 1); PG8_SCHED; PG8_LDA(At, 1, 0); PG8_STAGE_A(PG8_SA(0, 1), a2, 1, last);
            PG8_WAIT_V(8); PG8_WAIT_L(0); PG8_BAR; PG8_MMA(0, 0, At, B0); PG8_MMA(0, 1, At, B1); PG8_BAR; PG8_SCHED;
            PG8_LDA(At, 1, 1); PG8_STAGE_B(PG8_SB(1, 0), b3, 0); PG8_STAGE_B(PG8_SB(1, 1), b3, 1); PG8_STAGE_A(PG8_SA(1, 0), a3, 0, last);
            PG8_WAIT_V(8); PG8_WAIT_L(0); PG8_BAR; PG8_MMA(1, 0, At, B0); PG8_MMA(1, 1, At, B1); PG8_BAR; PG8_SCHED;
        }
        if (wr == 0) PG8_BAR;
        { int fr_ = fr, fq_ = fq; asm volatile("" : "+v"(fr_), "+v"(fq_));
          E(acc, cur, wr, wc, fr_, fq_); }
        if (!has_next) break;
#pragma unroll
        for (int a = 0; a < 2; ++a)
#pragma unroll
            for (int b = 0; b < 2; ++b)
#pragma unroll
                for (int m = 0; m < 4; ++m)
#pragma unroll
                    for (int n = 0; n < 2; ++n) acc[a][b][m][n] = (f32x4){0.f, 0.f, 0.f, 0.f};
        cur = nxt; cA = nA; cB0 = nB0; cB1 = nB1; ++ui;
        vAc[0] = vAn[0]; vAc[1] = vAn[1];
        if (wr == 1) PG8_BAR;
    }
    PG8_WAIT_V(0);
    PG8_BAR;
#undef PG8_SA
#undef PG8_SB
#undef PG8_STAGE2
#undef PG8_STAGE_A
#undef PG8_STAGE_B
#undef PG8_LDA
#undef PG8_LDB
#undef PG8_MMA
#undef PG8_WAIT_V
#undef PG8_WAIT_L
#undef PG8_BAR
#undef PG8_SCHED
#undef PG8_GOFF
}
}
using pg8::Unit;

DI unsigned cvt_pk_bf16(float lo, float hi) { unsigned r; asm volatile("v_cvt_pk_bf16_f32 %0, %1, %2" : "=v"(r) : "v"(lo), "v"(hi)); return r; }

struct Args {
    const float* x; const float* c; const int* pos; const float* ada_w; const float* ada_b; const float* nmw; const float* nfw; const float* w_in;
    const float* b_ig; const float* b_fg; const float* qnw; const float* knw; const float* sinks; const float* conv_w; const float* conv_b; const float* mnw;
    const float* w_au; const float* w_mu; const float* w_out; const float* router_w; const float* router_b; const float* w_gate; const float* w_up; const float* w_down;
    float* out; unsigned char* ws; int ph_lo, ph_hi;
};

__constant__ float c_invf[8] = {1.0f, 0.1939227432012558f, 0.03760603070259094f, 0.007292664609849453f, 0.0014142135623842478f, 0.00027424818836152554f, 5.3182957344688475e-05f, 1.0313385246263351e-05f};

struct DenseSched {
    static constexpr bool GATHER = false; static constexpr int KSPLIT = 0;
    const char* A; const char* Bt; int lda, ldb; pg8::TileOrder ord;
    DI bool next(int i, Unit& u) const { int pm, pn; if (!ord.get(i, pm, pn)) return false; u.pm = pm; u.pn = pn; u.x0 = 0; u.x1 = 0; return true; }
    DI const char* a_base(const Unit& u) const { return A + (size_t)u.pm * 256 * lda * 2; }
    DI const char* b_base(const Unit& u, int) const { return Bt + (size_t)u.pn * 256 * ldb * 2; }
    DI unsigned a_rowoff(const Unit&, int) const { return 0u; }
};
struct EpiProj {
    static constexpr bool PERM = true;
    bf16* O;
    DI void operator()(const f32x4 (&acc)[2][2][4][2], const Unit& u, int wr, int wc, int fr, int fq) const {
        const int row0 = u.pm * 256 + wr * 64 + fr, col0 = u.pn * 256 + wc * 32 + 8 * fq; const bool sg = u.pn >= 9;
#pragma unroll
        for (int ai = 0; ai < 2; ++ai)
#pragma unroll
            for (int m = 0; m < 4; ++m) { bf16* rowp = O + (size_t)(row0 + ai * 128 + m * 16) * NPROJ + col0;
#pragma unroll
                for (int bj = 0; bj < 2; ++bj) { f32x4 v0 = acc[ai][bj][m][0], v1 = acc[ai][bj][m][1];
                    if (sg) {
#pragma unroll
                        for (int j = 0; j < 4; ++j) { v0[j] = sigmoidf_(v0[j]); v1[j] = sigmoidf_(v1[j]); } }
                    v4u w; w.x = cvt_pk_bf16(v0[0], v0[1]); w.y = cvt_pk_bf16(v0[2], v0[3]); w.z = cvt_pk_bf16(v1[0], v1[1]); w.w = cvt_pk_bf16(v1[2], v1[3]);
                    *(v4u*)(rowp + bj * 128) = w; } }
    }
};
template <bool ADD> struct EpiGate {
    static constexpr bool PERM = true;
    bf16* P; int gcol;
    DI void operator()(const f32x4 (&acc)[2][2][4][2], const Unit& u, int wr, int wc, int fr, int fq) const {
        const int row0 = u.pm * 256 + wr * 64 + fr, col0 = u.pn * 256 + wc * 32 + 8 * fq;
#pragma unroll
        for (int ai = 0; ai < 2; ++ai)
#pragma unroll
            for (int m = 0; m < 4; ++m) { bf16* rowp = P + (size_t)(row0 + ai * 128 + m * 16) * NPROJ + col0;
#pragma unroll
                for (int bj = 0; bj < 2; ++bj) { const f32x4 v0 = acc[ai][bj][m][0], v1 = acc[ai][bj][m][1];
                    const v4u g = *(const v4u*)(rowp + gcol + bj * 128);
                    float o[8] = {bflo(g.x) * v0[0], bfhi(g.x) * v0[1], bflo(g.y) * v0[2], bfhi(g.y) * v0[3], bflo(g.z) * v1[0], bfhi(g.z) * v1[1], bflo(g.w) * v1[2], bfhi(g.w) * v1[3]};
                    if (ADD) { const v4u p = *(const v4u*)(rowp + C_MQ + bj * 128);
                        o[0] += bflo(p.x); o[1] += bfhi(p.x); o[2] += bflo(p.y); o[3] += bfhi(p.y); o[4] += bflo(p.z); o[5] += bfhi(p.z); o[6] += bflo(p.w); o[7] += bfhi(p.w); }
                    v4u w; w.x = cvt_pk_bf16(o[0], o[1]); w.y = cvt_pk_bf16(o[2], o[3]); w.z = cvt_pk_bf16(o[4], o[5]); w.w = cvt_pk_bf16(o[6], o[7]);
                    *(v4u*)(rowp + C_MQ + bj * 128) = w; } }
    }
};
struct EpiRes {
    static constexpr bool PERM = false;
    const float* xin; float* out; const float* g; int rmask;
    DI void operator()(const f32x4 (&acc)[2][2][4][2], const Unit& u, int wr, int wc, int fr, int fq) const {
        const int row0 = u.pm * 256 + wr * 64 + fr, col0 = u.pn * 256 + wc * 32 + 4 * fq; const int b = (u.pm * 256) >> 14;
        f32x4 gv[2][2];
#pragma unroll
        for (int bj = 0; bj < 2; ++bj)
#pragma unroll
            for (int n = 0; n < 2; ++n) gv[bj][n] = *(const f32x4*)(g + b * 6144 + col0 + bj * 128 + n * 16);
#pragma unroll
        for (int ai = 0; ai < 2; ++ai)
#pragma unroll
            for (int m = 0; m < 4; ++m) { const size_t off = (size_t)(row0 + ai * 128 + m * 16) * D + col0; const size_t offo = (size_t)((row0 + ai * 128 + m * 16) & rmask) * D + col0;
#pragma unroll
                for (int bj = 0; bj < 2; ++bj)
#pragma unroll
                    for (int n = 0; n < 2; ++n) { const f32x4 xv = *(const f32x4*)(xin + off + bj * 128 + n * 16);
                        *(f32x4*)(out + offo + bj * 128 + n * 16) = xv + gv[bj][n] * acc[ai][bj][m][n]; } }
    }
};

struct MoeTab { const LAS int* tcls; const LAS int* tpos; const LAS int* cnt; int Rtot; };
DI void cls_experts(int cls, int& ea, int& eb) { const int g = cls / 6, p = cls - 6 * g; const int a = (p < 3) ? 0 : ((p < 5) ? 1 : 2); const int b = (p < 3) ? (p + 1) : ((p < 5) ? (p - 1) : 3); ea = 4 * g + a; eb = 4 * g + b; }
struct MoeUpSched {
    static constexpr bool GATHER = true; static constexpr int KSPLIT = 0;
    const char* A; const char* W; int lda, ldb; MoeTab tb; int G, c; const LAS unsigned* tokoff;
    DI bool next(int i, Unit& u) const { const int L = i * G + c; if (L >= tb.Rtot * 8) return false; u.pm = L >> 3; u.pn = L & 7; u.x0 = i; u.x1 = __builtin_amdgcn_readfirstlane(tb.tcls[u.pm]); return true; }
    DI const char* a_base(const Unit&) const { return A; }
    DI const char* b_base(const Unit& u, int) const { int ea, eb; cls_experts(u.x1, ea, eb); const int e = (u.pn < 4) ? ea : eb; return W + ((size_t)e * 1024 + (size_t)(u.pn & 3) * 256) * 1024 * 2; }
    DI unsigned a_rowoff(const Unit& u, int r) const { return tokoff[u.x0 * 256 + r]; }
};
struct EpiSwiglu {
    static constexpr bool PERM = true;
    bf16* H; const float* tgate; const LAS unsigned* tokoff;
    DI void operator()(const f32x4 (&acc)[2][2][4][2], const Unit& u, int wr, int wc, int fr, int fq) const {
        const int r0 = wr * 64 + fr; const int hc = (u.pn >> 2) * 512 + (u.pn & 3) * 128 + wc * 32 + 8 * fq; const int gsel = u.pn >> 2;
#pragma unroll
        for (int ai = 0; ai < 2; ++ai)
#pragma unroll
            for (int m = 0; m < 4; ++m) { const int r = r0 + ai * 128 + m * 16; const unsigned tok = tokoff[u.x0 * 256 + r]; const float rg = tgate[tok * 2 + gsel];
                const f32x4 g0 = acc[ai][0][m][0], g1 = acc[ai][0][m][1], u0 = acc[ai][1][m][0], u1 = acc[ai][1][m][1];
                float o[8];
#pragma unroll
                for (int j = 0; j < 4; ++j) { o[j] = g0[j] * sigmoidf_(g0[j]) * u0[j] * rg; o[4 + j] = g1[j] * sigmoidf_(g1[j]) * u1[j] * rg; }
                v4u w; w.x = cvt_pk_bf16(o[0], o[1]); w.y = cvt_pk_bf16(o[2], o[3]); w.z = cvt_pk_bf16(o[4], o[5]); w.w = cvt_pk_bf16(o[6], o[7]);
                *(v4u*)(H + ((size_t)u.pm * 256 + r) * 1024 + hc) = w; }
    }
};
struct MoeDownSched {
    static constexpr bool GATHER = false; static constexpr int KSPLIT = 8;
    const char* A; const char* W; int lda, ldb; MoeTab tb; int G, c;
    DI bool next(int i, Unit& u) const { const int L = i * G + c; if (L >= tb.Rtot * 4) return false; u.pm = L >> 2; u.pn = L & 3; u.x0 = __builtin_amdgcn_readfirstlane(tb.tpos[u.pm]); u.x1 = __builtin_amdgcn_readfirstlane(tb.tcls[u.pm]); return true; }
    DI const char* a_base(const Unit& u) const { return A + (size_t)u.pm * 256 * lda * 2; }
    DI const char* b_base(const Unit& u, int half) const { int ea, eb; cls_experts(u.x1, ea, eb); const int e = half ? eb : ea; return W + ((size_t)e * 1024 + (size_t)u.pn * 256) * 512 * 2; }
    DI unsigned a_rowoff(const Unit&, int) const { return 0u; }
};
struct EpiMoeOut {
    static constexpr bool PERM = false;
    const float* xin; float* out; const float* g; const int* tokl; MoeTab tb; int rmask;
    DI void operator()(const f32x4 (&acc)[2][2][4][2], const Unit& u, int wr, int wc, int fr, int fq) const {
        const int r0 = wr * 64 + fr, col0 = u.pn * 256 + wc * 32 + 4 * fq; const int cn = tb.cnt[u.x1];
#pragma unroll
        for (int ai = 0; ai < 2; ++ai)
#pragma unroll
            for (int m = 0; m < 4; ++m) { const int pos = u.x0 + r0 + ai * 128 + m * 16;
                if (pos < cn) { const int tok = tokl[u.x1 * CLS_CAP + pos]; const int b = tok >> 14; const float* ip = xin + (size_t)tok * D + col0; float* op = out + (size_t)(tok & rmask) * D + col0; const float* gp = g + b * 6144 + col0;
#pragma unroll
                    for (int bj = 0; bj < 2; ++bj)
#pragma unroll
                        for (int n = 0; n < 2; ++n) { const f32x4 xv = *(const f32x4*)(ip + bj * 128 + n * 16); const f32x4 gv = *(const f32x4*)(gp + bj * 128 + n * 16);
                            *(f32x4*)(op + bj * 128 + n * 16) = xv + gv * acc[ai][bj][m][n]; } } }
    }
};

struct Ctx { LAS unsigned char* lds; int tid, lane, wave, G, bid; };
DI Ctx fresh(const Ctx& X) { Ctx P = X; int t = X.tid; asm volatile("" : "+v"(t)); P.tid = t; P.lane = t & 63; P.wave = __builtin_amdgcn_readfirstlane(t >> 6); return P; }

DI void tr_item(const float* W, int ldw, int K, bf16* WT, int k0, LAS float* scr, int lane) {
#pragma unroll 8
    for (int i = 0; i < 32; ++i) { const int kk = 2 * i + (lane >> 5); scr[kk * 33 + (lane & 31)] = W[(size_t)(k0 + kk) * ldw + (lane & 31)]; }
    LDS_WAIT(); asm volatile("" ::: "memory");
    const int c = lane & 7;
#pragma unroll
    for (int j = 0; j < 4; ++j) { const int n = (lane >> 3) + 8 * j; const LAS float* s = scr + (8 * c) * 33 + n;
        v4u o; o.x = pk2(s[0 * 33], s[1 * 33]); o.y = pk2(s[2 * 33], s[3 * 33]); o.z = pk2(s[4 * 33], s[5 * 33]); o.w = pk2(s[6 * 33], s[7 * 33]);
        *(v4u*)(WT + (size_t)n * K + k0 + 8 * c) = o; }
    LDS_WAIT(); asm volatile("" ::: "memory");
}
DI void p0_prologue(const Args& a, const Ctx& X) {
    unsigned char* ws = a.ws;
    LAS float* scr = (LAS float*)(X.lds + X.wave * 16384);
    const int gw = X.bid * 8 + X.wave, NGW = X.G * 8;
    constexpr int IT_WIN = 16 * 152, IT_AU = 8 * 32, IT_OUT = 16 * 32, IT_GU = 16 * 16 * 32, IT_DN = 16 * 8 * 32;
    constexpr int IT_L = IT_WIN + 2 * IT_AU + IT_OUT + IT_GU + IT_DN;
    for (int it = gw; it < NL * IT_L; it += NGW) {
        const int l = it / IT_L; int r = it - l * IT_L;
        if (r < IT_WIN) { const int kb = r / 152, nb = r - kb * 152, d0 = 32 * nb, s0 = d0 + (d0 >= 2304 ? 8 : 0);
            tr_item(a.w_in + (size_t)l * D * DIN_SRC + s0, DIN_SRC, D, (bf16*)(ws + WS_WIN) + ((size_t)l * NPROJ + d0) * D, 64 * kb, scr, X.lane); continue; }
        r -= IT_WIN;
        if (r < IT_AU) { const int kb = r >> 5, nb = r & 31;
            tr_item(a.w_au + (size_t)l * 512 * D + 32 * nb, D, 512, (bf16*)(ws + WS_WAU) + ((size_t)l * D + 32 * nb) * 512, 64 * kb, scr, X.lane); continue; }
        r -= IT_AU;
        if (r < IT_AU) { const int kb = r >> 5, nb = r & 31;
            tr_item(a.w_mu + (size_t)l * 512 * D + 32 * nb, D, 512, (bf16*)(ws + WS_WMU) + ((size_t)l * D + 32 * nb) * 512, 64 * kb, scr, X.lane); continue; }
        r -= IT_AU;
        if (r < IT_OUT) { const int kb = r >> 5, nb = r & 31;
            tr_item(a.w_out + (size_t)l * D * D + 32 * nb, D, D, (bf16*)(ws + WS_WOUT) + ((size_t)l * D + 32 * nb) * D, 64 * kb, scr, X.lane); continue; }
        r -= IT_OUT;
        if (r < IT_GU) { const int e = r >> 9, q = r & 511, kb = q >> 5, nb = q & 31, tq = nb >> 3, rb = nb & 7;
            const float* src = ((rb < 4) ? a.w_gate : a.w_up) + ((size_t)(l * NE + e) * D) * FF + 128 * tq + 32 * (rb & 3);
            tr_item(src, FF, D, (bf16*)(ws + WS_WGU) + ((size_t)(l * NE + e) * 1024 + 32 * nb) * D, 64 * kb, scr, X.lane); continue; }
        r -= IT_GU;
        { const int e = r >> 8, q = r & 255, kb = q >> 5, nb = q & 31;
            tr_item(a.w_down + ((size_t)(l * NE + e) * FF) * D + 32 * nb, D, FF, (bf16*)(ws + WS_WD) + ((size_t)(l * NE + e) * 1024 + 32 * nb) * FF, 64 * kb, scr, X.lane); }
    }
    { float* cs = (float*)(ws + WS_ROPE); float* sn = cs + (size_t)T * 8;
      for (int i = X.bid * 512 + X.tid; i < T * 8; i += X.G * 512) { const int tok = i >> 3, f = i & 7; const float angf = (float)a.pos[tok] * c_invf[f];
          double rev = (double)angf * 0.15915494309189535; rev -= rint(rev); const float rf = (float)rev;
          cs[i] = __builtin_amdgcn_cosf(rf); sn[i] = __builtin_amdgcn_sinf(rf); } }
    __syncthreads();
    LAS float* cact = (LAS float*)X.lds; LAS float* red = (LAS float*)(X.lds + 8192);
    for (int i = X.tid; i < 2048; i += 512) { const float cv = a.c[i]; cact[i] = cv / (1.0f + __expf(-cv)); }
    __syncthreads();
    float* mod = (float*)(ws + WS_MOD);
    for (int it = X.bid; it < NL * 96; it += X.G) { const int l = it / 96, cg = it - l * 96; const int col = cg * 64 + X.lane;
        const float* w = a.ada_w + (size_t)l * D * 6144 + col; float s0 = 0.f, s1 = 0.f;
#pragma unroll 8
        for (int kk = 0; kk < 128; ++kk) { const int k = X.wave * 128 + kk; const float wv = w[(size_t)k * 6144]; s0 += cact[k] * wv; s1 += cact[1024 + k] * wv; }
        red[(X.wave * 2 + 0) * 64 + X.lane] = s0; red[(X.wave * 2 + 1) * 64 + X.lane] = s1;
        __syncthreads();
        if (X.tid < 128) { const int b = X.tid >> 6, ln = X.tid & 63; float s = 0.f;
#pragma unroll
            for (int w8 = 0; w8 < 8; ++w8) s += red[(w8 * 2 + b) * 64 + ln];
            mod[(size_t)(l * 2 + b) * 6144 + cg * 64 + ln] = s + a.ada_b[l * 6144 + cg * 64 + ln]; }
        __syncthreads();
    }
}

DI void p1_norm_gates(const Args& a, const Ctx& X, int l, const float* xin) {
    unsigned char* ws = a.ws;
    LAS float* gwl = (LAS float*)X.lds;
    for (int idx = X.tid; idx < 8192; idx += 512) { const int k = idx >> 3, g = idx & 7; gwl[g * 1024 + k] = a.w_in[(size_t)l * D * DIN_SRC + (size_t)k * DIN_SRC + 2304 + g]; }
    __syncthreads();
    const float* mod = (const float*)(ws + WS_MOD); bf16* hb = (bf16*)(ws + WS_H); float* gates = (float*)(ws + WS_GATES);
    const int gw = X.bid * 8 + X.wave, NGW = X.G * 8;
    for (int rg = gw; rg < T / 16; rg += NGW) {
        const int row0 = rg * 16, b = row0 >> 14;
        const float* mb = mod + (size_t)(l * 2 + b) * 6144;
        f32x4 aw[4], sh[4];
#pragma unroll
        for (int j = 0; j < 4; ++j) { const int k = 256 * j + 4 * X.lane; const f32x4 nw = *(const f32x4*)(a.nmw + l * D + k); const f32x4 sc = *(const f32x4*)(mb + 1024 + k); aw[j] = nw * (sc + 1.0f); sh[j] = *(const f32x4*)(mb + k); }
        f32x4 pre[4][4];
#pragma unroll
        for (int q = 0; q < 4; ++q) { const f32x4* xp = (const f32x4*)(xin + (size_t)(row0 + q) * D) + X.lane;
#pragma unroll
            for (int j = 0; j < 4; ++j) pre[q][j] = xp[64 * j]; }
#pragma unroll 1
        for (int rb = 0; rb < 16; rb += 4) {
#pragma unroll
          for (int q = 0; q < 4; ++q) { const int r = rb + q; const int row = row0 + r;
            f32x4 v[4]; float ss = 0.f;
#pragma unroll
            for (int j = 0; j < 4; ++j) v[j] = pre[q][j];
            if (rb + 4 < 16) { const f32x4* xp = (const f32x4*)(xin + (size_t)(row + 4) * D) + X.lane;
#pragma unroll
                for (int j = 0; j < 4; ++j) pre[q][j] = xp[64 * j]; }
#pragma unroll
            for (int j = 0; j < 4; ++j) ss += (v[j].x * v[j].x + v[j].y * v[j].y) + (v[j].z * v[j].z + v[j].w * v[j].w);
            ss = wave_sum(ss); const float rstd = 1.0f / sqrtf(ss * (1.0f / D) + EPS);
            unsigned long long* o8 = (unsigned long long*)(hb + (size_t)row * D) + X.lane;
#pragma unroll
            for (int j = 0; j < 4; ++j) { v[j] = v[j] * rstd * aw[j] + sh[j]; o8[64 * j] = (unsigned long long)pk2(v[j].x, v[j].y) | ((unsigned long long)pk2(v[j].z, v[j].w) << 32); }
            float gp[8];
#pragma unroll
            for (int g = 0; g < 8; ++g) { float p = 0.f;
#pragma unroll
                for (int j = 0; j < 4; ++j) { const f32x4 w = *(const LAS f32x4*)(gwl + g * 1024 + 256 * j + 4 * X.lane); p += (v[j].x * w.x + v[j].y * w.y) + (v[j].z * w.z + v[j].w * w.w); }
                gp[g] = wave_sum(p); __builtin_amdgcn_sched_barrier(0); }
            if (X.lane == 0) {
#pragma unroll
                for (int g = 0; g < 4; ++g) { gates[(size_t)row * 8 + g] = gp[g] + a.b_ig[l * 4 + g];
                    const float z = gp[4 + g] + a.b_fg[l * 4 + g]; gates[(size_t)row * 8 + 4 + g] = fminf(z, 0.f) - log1pf(__expf(-fabsf(z))); } }
            __builtin_amdgcn_sched_barrier(0);
          }
        }
    }
}

DI void attn_unit(const Args& a, const Ctx& X, int l, int unit) {
    unsigned char* ws = a.ws; const bf16* proj = (const bf16*)(ws + WS_PROJ); bf16* ao = (bf16*)(ws + WS_H);
    const float* cs = (const float*)(ws + WS_ROPE); const float* sn = cs + (size_t)T * 8;
    const int b = unit >> 8, rem = unit & 255, nb = rem >> 1, kvh = rem & 1; const int tok0 = b * SEQ + nb * 128;
    LAS bf16* Kl = (LAS bf16*)X.lds;
    LAS bf16* VT = (LAS bf16*)(X.lds + 36864);
    int lane = X.lane; asm volatile("" : "+v"(lane));
    const int c16 = lane & 15, quad = lane >> 4;
    {
        const int row = X.tid >> 1, half = X.tid & 1; const int tokk = tok0 - 128 + row; const bool valid = (nb > 0) || (row >= 128);
        float y[32]; float vv[32];
        if (valid) {
            const v4u* kp = (const v4u*)(proj + (size_t)tokk * NPROJ + C_AK + kvh * 64 + half * 32); const v4u* vp = (const v4u*)(proj + (size_t)tokk * NPROJ + C_AV + kvh * 64 + half * 32);
#pragma unroll
            for (int q = 0; q < 4; ++q) { const v4u kw = kp[q], vw = vp[q];
                y[8 * q + 0] = bflo(kw.x); y[8 * q + 1] = bfhi(kw.x); y[8 * q + 2] = bflo(kw.y); y[8 * q + 3] = bfhi(kw.y); y[8 * q + 4] = bflo(kw.z); y[8 * q + 5] = bfhi(kw.z); y[8 * q + 6] = bflo(kw.w); y[8 * q + 7] = bfhi(kw.w);
                vv[8 * q + 0] = bflo(vw.x); vv[8 * q + 1] = bfhi(vw.x); vv[8 * q + 2] = bflo(vw.y); vv[8 * q + 3] = bfhi(vw.y); vv[8 * q + 4] = bflo(vw.z); vv[8 * q + 5] = bfhi(vw.z); vv[8 * q + 6] = bflo(vw.w); vv[8 * q + 7] = bfhi(vw.w); }
        } else {
#pragma unroll
            for (int i = 0; i < 32; ++i) { y[i] = 0.f; vv[i] = 0.f; } }
        float ss = 0.f;
#pragma unroll
        for (int i = 0; i < 32; ++i) ss += y[i] * y[i];
        ss += __shfl_xor(ss, 1); const float rstd = 1.0f / sqrtf(ss * (1.0f / 64.0f) + EPS);
#pragma unroll
        for (int i = 0; i < 32; ++i) y[i] = y[i] * rstd * a.knw[l * 64 + half * 32 + i];
        if (half == 0 && valid) {
#pragma unroll
            for (int d = 0; d < 8; ++d) { const float c = cs[(size_t)tokk * 8 + d], s = sn[(size_t)tokk * 8 + d]; const float t1 = y[d], t2 = y[d + 8]; y[d] = t1 * c - t2 * s; y[d + 8] = t2 * c + t1 * s; } }
#pragma unroll
        for (int q = 0; q < 4; ++q) { v4u w; w.x = pk2(y[8 * q], y[8 * q + 1]); w.y = pk2(y[8 * q + 2], y[8 * q + 3]); w.z = pk2(y[8 * q + 4], y[8 * q + 5]); w.w = pk2(y[8 * q + 6], y[8 * q + 7]);
            *(LAS v4u*)(Kl + row * 72 + half * 32 + 8 * q) = w; }
#pragma unroll
        for (int i = 0; i < 32; ++i) VT[(half * 32 + i) * 280 + row] = (bf16)f2bf(vv[i]);
        if (X.tid < 64) {
#pragma unroll
            for (int cc = 256; cc < 280; ++cc) VT[X.tid * 280 + cc] = 0; }
    }
    __syncthreads();
#pragma unroll 1
    for (int task = X.wave; task < 32; task += 8) {
        const int g = task >> 3, rg = task & 7, r0 = 16 * rg, head = kvh * 4 + g; const int tokq = tok0 + r0 + c16;
        const float sink = a.sinks[l * 8 + head];
        float qv[16];
        { const bf16* qp = proj + (size_t)tokq * NPROJ + C_AQ + head * 64; const v4u w0 = *(const v4u*)(qp + 8 * quad), w1 = *(const v4u*)(qp + 32 + 8 * quad);
          qv[0] = bflo(w0.x); qv[1] = bfhi(w0.x); qv[2] = bflo(w0.y); qv[3] = bfhi(w0.y); qv[4] = bflo(w0.z); qv[5] = bfhi(w0.z); qv[6] = bflo(w0.w); qv[7] = bfhi(w0.w);
          qv[8] = bflo(w1.x); qv[9] = bfhi(w1.x); qv[10] = bflo(w1.y); qv[11] = bfhi(w1.y); qv[12] = bflo(w1.z); qv[13] = bfhi(w1.z); qv[14] = bflo(w1.w); qv[15] = bfhi(w1.w); }
        float ss = 0.f;
#pragma unroll
        for (int i = 0; i < 16; ++i) ss += qv[i] * qv[i];
        ss += __shfl_xor(ss, 16); ss += __shfl_xor(ss, 32); const float rstd = 1.0f / sqrtf(ss * (1.0f / 64.0f) + EPS);
#pragma unroll
        for (int i = 0; i < 8; ++i) { qv[i] = qv[i] * rstd * a.qnw[l * 64 + 8 * quad + i]; qv[8 + i] = qv[8 + i] * rstd * a.qnw[l * 64 + 32 + 8 * quad + i]; }
#pragma unroll
        for (int d = 0; d < 8; ++d) { const float other = __shfl_xor(qv[d], 16); const float c = cs[(size_t)tokq * 8 + d], s = sn[(size_t)tokq * 8 + d];
            if (quad == 0) qv[d] = qv[d] * c - other * s; else if (quad == 1) qv[d] = qv[d] * c + other * s; }
        bf16x8 qf[2];
        { v4u w; w.x = pk2(qv[0], qv[1]); w.y = pk2(qv[2], qv[3]); w.z = pk2(qv[4], qv[5]); w.w = pk2(qv[6], qv[7]); qf[0] = __builtin_bit_cast(bf16x8, w);
          w.x = pk2(qv[8], qv[9]); w.y = pk2(qv[10], qv[11]); w.z = pk2(qv[12], qv[13]); w.w = pk2(qv[14], qv[15]); qf[1] = __builtin_bit_cast(bf16x8, w); }
        f32x4 sacc[9];
#pragma unroll
        for (int i = 0; i < 9; ++i) { const LAS bf16* kr = Kl + (16 * (rg + i) + c16) * 72 + 8 * quad;
            const bf16x8 k0 = *(const LAS bf16x8*)kr, k1 = *(const LAS bf16x8*)(kr + 32);
            f32x4 z = {0.f, 0.f, 0.f, 0.f}; z = __builtin_amdgcn_mfma_f32_16x16x32_bf16(k0, qf[0], z, 0, 0, 0); sacc[i] = __builtin_amdgcn_mfma_f32_16x16x32_bf16(k1, qf[1], z, 0, 0, 0); }
        int dbase = 4 * quad - c16; asm volatile("" : "+v"(dbase)); int kbase = 16 * rg + 4 * quad; asm volatile("" : "+v"(kbase)); float mx = sink;
#pragma unroll
        for (int i = 0; i < 9; ++i)
#pragma unroll
            for (int j = 0; j < 4; ++j) { const int dlt = dbase + 16 * i + j; const int kj = kbase + 16 * i + j; const bool ok = (dlt > 0) && (dlt <= 128) && ((nb > 0) || (kj >= 128));
                const float s = ok ? sacc[i][j] * 0.125f : -3.0e38f; sacc[i][j] = s; mx = fmaxf(mx, s); }
        mx = fmaxf(mx, __shfl_xor(mx, 16)); mx = fmaxf(mx, __shfl_xor(mx, 32));
        float sum = 0.f;
#pragma unroll
        for (int i = 0; i < 9; ++i)
#pragma unroll
            for (int j = 0; j < 4; ++j) { const float p = (sacc[i][j] > -1.0e38f) ? __expf(sacc[i][j] - mx) : 0.f; sacc[i][j] = p; sum += p; }
        sum += __shfl_xor(sum, 16); sum += __shfl_xor(sum, 32);
        const float inv = 1.0f / (sum + __expf(sink - mx));
        f32x4 oacc[4];
#pragma unroll
        for (int et = 0; et < 4; ++et) oacc[et] = (f32x4){0.f, 0.f, 0.f, 0.f};
#pragma unroll
        for (int kk = 0; kk < 5; ++kk) {
            v4u pw; pw.x = pk2(sacc[2 * kk][0], sacc[2 * kk][1]); pw.y = pk2(sacc[2 * kk][2], sacc[2 * kk][3]);
            if (2 * kk + 1 < 9) { pw.z = pk2(sacc[(2 * kk + 1 < 9) ? 2 * kk + 1 : 0][0], sacc[(2 * kk + 1 < 9) ? 2 * kk + 1 : 0][1]); pw.w = pk2(sacc[(2 * kk + 1 < 9) ? 2 * kk + 1 : 0][2], sacc[(2 * kk + 1 < 9) ? 2 * kk + 1 : 0][3]); } else { pw.z = 0u; pw.w = 0u; }
            const bf16x8 pf = __builtin_bit_cast(bf16x8, pw);
#pragma unroll
            for (int et = 0; et < 4; ++et) { const LAS bf16* vr = VT + (16 * et + c16) * 280 + 16 * rg + 32 * kk + 4 * quad;
                const v2u lo = *(const LAS v2u*)vr, hi = *(const LAS v2u*)(vr + 16); v4u vw; vw.x = lo.x; vw.y = lo.y; vw.z = hi.x; vw.w = hi.y;
                oacc[et] = __builtin_amdgcn_mfma_f32_16x16x32_bf16(__builtin_bit_cast(bf16x8, vw), pf, oacc[et], 0, 0, 0); }
        }
#pragma unroll
        for (int et = 0; et < 4; ++et) { v2u w; w.x = pk2(oacc[et][0] * inv, oacc[et][1] * inv); w.y = pk2(oacc[et][2] * inv, oacc[et][3] * inv);
            *(v2u*)(ao + (size_t)tokq * 512 + head * 64 + 16 * et + 4 * quad) = w; }
    }
    __syncthreads();
}

constexpr int ML_Q = 0, ML_K = 17408, ML_KET = 34816, ML_VT = 53248, ML_CT = 73984, ML_CW = 113152, ML_CB = 118272, ML_RED = 118784, ML_NW = 119296;
template <bool L3> DI void mlstm_unit(const Args& a, const Ctx& X, int l, int unit) {
    unsigned char* ws = a.ws; const bf16* proj = (const bf16*)(ws + WS_PROJ); bf16* hm = (bf16*)(ws + WS_H) + (size_t)T * 512;
    const float* gates = (const float*)(ws + WS_GATES); float* mlc = (float*)(ws + WS_MLC) + (size_t)unit * 18432; float* mlb = (float*)(ws + WS_MLB);
    const int seq = unit >> 5, sj = unit & 31, b = seq >> 2, hh = seq & 3; const int tokbase = b * SEQ + sj * 512;
    LAS bf16* Qs = (LAS bf16*)(X.lds + ML_Q); LAS bf16* Ks = (LAS bf16*)(X.lds + ML_K); LAS bf16* KET = (LAS bf16*)(X.lds + ML_KET);
    LAS bf16* VT = (LAS bf16*)(X.lds + ML_VT); LAS bf16* CT = (LAS bf16*)(X.lds + ML_CT); LAS float* CW = (LAS float*)(X.lds + ML_CW);
    LAS float* CB = (LAS float*)(X.lds + ML_CB); LAS float* RED = (LAS float*)(X.lds + ML_RED); LAS float* NW = (LAS float*)(X.lds + ML_NW);
    int lane = X.lane; asm volatile("" : "+v"(lane));
    const int c16 = lane & 15, quad = lane >> 4, w = X.wave;
    for (int idx = X.tid; idx < 1280; idx += 512) { const int tap = idx >> 8, ch = idx & 255; const int gch = (ch < 128) ? (hh * 128 + ch) : (512 + hh * 128 + (ch - 128));
        CW[idx] = (tap < 4) ? a.conv_w[(size_t)(l * 4 + tap) * 1024 + gch] : a.conv_b[l * 1024 + gch]; }
    for (int idx = X.tid; idx < 16 * 72; idx += 512) VT[128 * 72 + idx] = (idx < 72) ? (bf16)0x3F80 : (bf16)0;
    if (X.tid < 128) NW[X.tid] = a.mnw[l * 512 + hh * 128 + X.tid];
    f32x4 cacc[9];
#pragma unroll
    for (int et = 0; et < 9; ++et) {
        if (L3) {
#pragma unroll
            for (int j = 0; j < 4; ++j) { const float v = mlc[(16 * et + 4 * quad + j) * 128 + 16 * w + c16]; cacc[et][j] = v; CT[(16 * et + 4 * quad + j) * 136 + 16 * w + c16] = (bf16)f2bf(v); }
        } else cacc[et] = (f32x4){0.f, 0.f, 0.f, 0.f};
    }
    float bsum = 0.f;
    __syncthreads();
#pragma unroll 1
    for (int c = 0; c < 8; ++c) {
        const int tok0 = tokbase + c * 64;
        float bsc = gates[(size_t)(tok0 + lane) * 8 + 4 + hh]; const float li = gates[(size_t)(tok0 + lane) * 8 + hh];
#pragma unroll
        for (int o = 1; o < 64; o <<= 1) { const float v = __shfl_up(bsc, o); if (lane >= o) bsc += v; }
        const float bl = __shfl(bsc, 63); const float csv = li - bsc;
        if (w == 0) { CB[lane] = bsc; CB[64 + lane] = csv; }
        bsum += bl;
        { const int t = X.tid >> 3, dc = X.tid & 7; const float fac = __expf(bl + __shfl(csv, t));
          const int tokt = tok0 + t;
#pragma unroll
          for (int qk = (L3 ? 0 : 1); qk < 2; ++qk) {
              float accv[16];
#pragma unroll
              for (int i = 0; i < 16; ++i) accv[i] = CW[4 * 256 + qk * 128 + 16 * dc + i];
#pragma unroll
              for (int j = 0; j < 4; ++j) { const int tt = tokt - 3 + j;
                  if (tt >= b * SEQ) { const v4u* p = (const v4u*)(proj + (size_t)tt * NPROJ + (qk ? C_MK : C_MQ) + hh * 128 + 16 * dc); const v4u w0 = p[0], w1 = p[1];
                      const float xv[16] = {bflo(w0.x), bfhi(w0.x), bflo(w0.y), bfhi(w0.y), bflo(w0.z), bfhi(w0.z), bflo(w0.w), bfhi(w0.w), bflo(w1.x), bfhi(w1.x), bflo(w1.y), bfhi(w1.y), bflo(w1.z), bfhi(w1.z), bflo(w1.w), bfhi(w1.w)};
#pragma unroll
                      for (int i = 0; i < 16; ++i) accv[i] += CW[j * 256 + qk * 128 + 16 * dc + i] * xv[i]; } }
#pragma unroll
              for (int i = 0; i < 16; ++i) { const float z = accv[i]; accv[i] = z / (1.0f + __expf(-z)) * (qk ? 0.08838834764831845f : 1.0f); }
              if (L3) { LAS bf16* dst = (qk ? Ks : Qs) + t * 136 + 16 * dc;
                  v4u o0, o1; o0.x = pk2(accv[0], accv[1]); o0.y = pk2(accv[2], accv[3]); o0.z = pk2(accv[4], accv[5]); o0.w = pk2(accv[6], accv[7]);
                  o1.x = pk2(accv[8], accv[9]); o1.y = pk2(accv[10], accv[11]); o1.z = pk2(accv[12], accv[13]); o1.w = pk2(accv[14], accv[15]);
                  *(LAS v4u*)dst = o0; *(LAS v4u*)(dst + 8) = o1; }
              if (qk) {
#pragma unroll
                  for (int i = 0; i < 16; ++i) KET[(16 * dc + i) * 72 + t] = (bf16)f2bf(accv[i] * fac); }
          }
          { const v4u* p = (const v4u*)(proj + (size_t)tokt * NPROJ + C_MV + hh * 128 + 16 * dc); const v4u w0 = p[0], w1 = p[1];
            const unsigned ww[8] = {w0.x, w0.y, w0.z, w0.w, w1.x, w1.y, w1.z, w1.w};
#pragma unroll
            for (int i = 0; i < 8; ++i) { VT[(16 * dc + 2 * i) * 72 + t] = (bf16)(ww[i] & 0xffffu); VT[(16 * dc + 2 * i + 1) * 72 + t] = (bf16)(ww[i] >> 16); } }
        }
        __syncthreads();
        float hval[4][4]; int tt_ = w & 3, eh = w >> 2; const int tq = 16 * tt_ + c16;
        if (L3) {
            bf16x8 qf[4];
#pragma unroll
            for (int ks = 0; ks < 4; ++ks) qf[ks] = *(const LAS bf16x8*)(Qs + tq * 136 + 32 * ks + 8 * quad);
            f32x4 sacc[4];
#pragma unroll
            for (int st = 0; st < 4; ++st) { f32x4 z = {0.f, 0.f, 0.f, 0.f};
#pragma unroll
                for (int ks = 0; ks < 4; ++ks) z = __builtin_amdgcn_mfma_f32_16x16x32_bf16(*(const LAS bf16x8*)(Ks + (16 * st + c16) * 136 + 32 * ks + 8 * quad), qf[ks], z, 0, 0, 0);
                sacc[st] = z; }
            const float cbt = CB[tq];
#pragma unroll
            for (int st = 0; st < 4; ++st)
#pragma unroll
                for (int j = 0; j < 4; ++j) { const int s = 16 * st + 4 * quad + j; const float d = (s <= tq) ? __expf(cbt + CB[64 + s]) : 0.f; sacc[st][j] *= d; }
            bf16x8 pf[2];
#pragma unroll
            for (int kk = 0; kk < 2; ++kk) { v4u pw; pw.x = pk2(sacc[2 * kk][0], sacc[2 * kk][1]); pw.y = pk2(sacc[2 * kk][2], sacc[2 * kk][3]); pw.z = pk2(sacc[2 * kk + 1][0], sacc[2 * kk + 1][1]); pw.w = pk2(sacc[2 * kk + 1][2], sacc[2 * kk + 1][3]); pf[kk] = __builtin_bit_cast(bf16x8, pw); }
            const float ebt = __expf(cbt);
            f32x4 nn[5];
#pragma unroll
            for (int x = 0; x < 5; ++x) { const int et = (x < 4) ? (4 * eh + x) : 8; f32x4 na = {0.f, 0.f, 0.f, 0.f}, ia = {0.f, 0.f, 0.f, 0.f};
#pragma unroll
                for (int kk = 0; kk < 2; ++kk) { const LAS bf16* vr = VT + (16 * et + c16) * 72 + 32 * kk + 4 * quad; const v2u lo = *(const LAS v2u*)vr, hi = *(const LAS v2u*)(vr + 16); v4u vw; vw.x = lo.x; vw.y = lo.y; vw.z = hi.x; vw.w = hi.y;
                    na = __builtin_amdgcn_mfma_f32_16x16x32_bf16(__builtin_bit_cast(bf16x8, vw), pf[kk], na, 0, 0, 0); }
#pragma unroll
                for (int ks = 0; ks < 4; ++ks) ia = __builtin_amdgcn_mfma_f32_16x16x32_bf16(*(const LAS bf16x8*)(CT + (16 * et + c16) * 136 + 32 * ks + 8 * quad), qf[ks], ia, 0, 0, 0);
                nn[x] = na + ia * ebt; }
            const float den = __shfl(nn[4][0], c16); const float inv = 1.0f / fmaxf(fabsf(den), 1.0f);
            float ss = 0.f;
#pragma unroll
            for (int x = 0; x < 4; ++x)
#pragma unroll
                for (int j = 0; j < 4; ++j) { hval[x][j] = nn[x][j] * inv; ss += hval[x][j] * hval[x][j]; }
            ss += __shfl_xor(ss, 16); ss += __shfl_xor(ss, 32);
            if (quad == 0) RED[eh * 64 + tq] = ss;
            __syncthreads();
            const float rstd = 1.0f / sqrtf((RED[tq] + RED[64 + tq]) * (1.0f / 128.0f) + EPS);
#pragma unroll
            for (int x = 0; x < 4; ++x) { const int e = 16 * (4 * eh + x) + 4 * quad; const v2u og = *(const v2u*)(proj + (size_t)(tok0 + tq) * NPROJ + C_MO + hh * 128 + e);
                const float y0 = hval[x][0] * rstd * NW[e] * bflo(og.x), y1 = hval[x][1] * rstd * NW[e + 1] * bfhi(og.x), y2 = hval[x][2] * rstd * NW[e + 2] * bflo(og.y), y3 = hval[x][3] * rstd * NW[e + 3] * bfhi(og.y);
                v2u o; o.x = pk2(y0, y1); o.y = pk2(y2, y3); *(v2u*)(hm + (size_t)(tok0 + tq) * 512 + hh * 128 + e) = o; }
        }
        { const float ebl = __expf(bl);
          bf16x8 kf[2];
#pragma unroll
          for (int kk = 0; kk < 2; ++kk) kf[kk] = *(const LAS bf16x8*)(KET + (16 * w + c16) * 72 + 32 * kk + 8 * quad);
#pragma unroll
          for (int et = 0; et < 9; ++et) { f32x4 z = cacc[et] * ebl;
#pragma unroll
              for (int kk = 0; kk < 2; ++kk) z = __builtin_amdgcn_mfma_f32_16x16x32_bf16(*(const LAS bf16x8*)(VT + (16 * et + c16) * 72 + 32 * kk + 8 * quad), kf[kk], z, 0, 0, 0);
              cacc[et] = z;
              if (L3) {
#pragma unroll
                  for (int j = 0; j < 4; ++j) CT[(16 * et + 4 * quad + j) * 136 + 16 * w + c16] = (bf16)f2bf(z[j]); } } }
        __syncthreads();
    }
    if (!L3) {
#pragma unroll
        for (int et = 0; et < 9; ++et)
#pragma unroll
            for (int j = 0; j < 4; ++j) mlc[(16 * et + 4 * quad + j) * 128 + 16 * w + c16] = cacc[et][j];
        if (X.tid == 0) mlb[unit] = bsum;
    }
}
DI void mlstm_scan(const Args& a, const Ctx& X) {
    float* mlc = (float*)(a.ws + WS_MLC); const float* mlb = (const float*)(a.ws + WS_MLB);
    for (int idx = X.bid * 512 + X.tid; idx < 8 * 18432; idx += X.G * 512) { const int seq = idx / 18432, el = idx - seq * 18432; float carry = 0.f;
        float* p0 = mlc + (size_t)seq * 32 * 18432 + el; float v[32], dcy[32];
#pragma unroll
        for (int j = 0; j < 32; ++j) { v[j] = p0[(size_t)j * 18432]; dcy[j] = mlb[seq * 32 + j]; }
#pragma unroll
        for (int j = 0; j < 32; ++j) { p0[(size_t)j * 18432] = carry; carry = __expf(dcy[j]) * carry + v[j]; } }
}

DI void p6_norm_route(const Args& a, const Ctx& X, int l, const float* xin) {
    unsigned char* ws = a.ws;
    LAS float* wr = (LAS float*)X.lds;
    for (int idx = X.tid; idx < 16384; idx += 512) { const int k = idx >> 4, e = idx & 15; wr[e * 1024 + k] = a.router_w[idx]; }
    __syncthreads();
    const float* mod = (const float*)(ws + WS_MOD); bf16* hb = (bf16*)(ws + WS_H); float* tgate = (float*)(ws + WS_TGATE); int* tokl = (int*)(ws + WS_TOKL);
    unsigned* cnt = (unsigned*)(ws + WS_CTL) + CW_CNT + l * 2048;
    LAS int* hist = (LAS int*)(X.lds + 65536); LAS int* cbase = hist + 32;
    const int gw = X.bid * 8 + X.wave, NGW = X.G * 8;
    for (int it = 0; it * NGW < T / 16; ++it) {
        const int rg = it * NGW + gw; const bool act = rg < T / 16;
        if (X.tid < 32) hist[X.tid] = 0;
        __syncthreads();
        const int row0 = (act ? rg : 0) * 16, b = row0 >> 14;
        const float* mb = mod + (size_t)(l * 2 + b) * 6144;
        f32x4 aw[4], sh[4];
#pragma unroll
        for (int j = 0; j < 4; ++j) { const int k = 256 * j + 4 * X.lane; const f32x4 nw = *(const f32x4*)(a.nfw + l * D + k); const f32x4 sc = *(const f32x4*)(mb + 4 * 1024 + k); aw[j] = nw * (sc + 1.0f); sh[j] = *(const f32x4*)(mb + 3 * 1024 + k); }
        int my_cls = 0; float my_ga = 0.f, my_gb = 0.f;
        f32x4 pre[4][4];
#pragma unroll
        for (int q = 0; q < 4; ++q) { const f32x4* xp = (const f32x4*)(xin + (size_t)(row0 + q) * D) + X.lane;
#pragma unroll
            for (int j = 0; j < 4; ++j) pre[q][j] = xp[64 * j]; }
#pragma unroll 1
        for (int rb = 0; rb < 16; rb += 4) {
#pragma unroll
          for (int q = 0; q < 4; ++q) { const int r = rb + q; const int row = row0 + r;
            f32x4 v[4]; float ss = 0.f;
#pragma unroll
            for (int j = 0; j < 4; ++j) v[j] = pre[q][j];
            if (rb + 4 < 16) { const f32x4* xp = (const f32x4*)(xin + (size_t)(row + 4) * D) + X.lane;
#pragma unroll
                for (int j = 0; j < 4; ++j) pre[q][j] = xp[64 * j]; }
#pragma unroll
            for (int j = 0; j < 4; ++j) ss += (v[j].x * v[j].x + v[j].y * v[j].y) + (v[j].z * v[j].z + v[j].w * v[j].w);
            ss = wave_sum(ss); const float rstd = 1.0f / sqrtf(ss * (1.0f / D) + EPS);
            unsigned long long* o8 = (unsigned long long*)(hb + (size_t)row * D) + X.lane;
#pragma unroll
            for (int j = 0; j < 4; ++j) { v[j] = v[j] * rstd * aw[j] + sh[j]; o8[64 * j] = (unsigned long long)pk2(v[j].x, v[j].y) | ((unsigned long long)pk2(v[j].z, v[j].w) << 32); }
            float sc[16], sel[16];
#pragma unroll
            for (int e = 0; e < 16; ++e) { float p = 0.f;
#pragma unroll
                for (int j = 0; j < 4; ++j) { const f32x4 wv = *(const LAS f32x4*)(wr + e * 1024 + 256 * j + 4 * X.lane); p += (v[j].x * wv.x + v[j].y * wv.y) + (v[j].z * wv.z + v[j].w * wv.w); }
                p = wave_sum(p); sc[e] = 1.0f / (1.0f + __expf(-p)); sel[e] = sc[e] + a.router_b[e]; __builtin_amdgcn_sched_barrier(0); }
            int gi = 0; float gbest = -1.0e30f;
#pragma unroll
            for (int g = 0; g < 4; ++g) { const float p0 = sel[4 * g], p1 = sel[4 * g + 1], p2 = sel[4 * g + 2], p3 = sel[4 * g + 3];
                const float gs = fmaxf(fmaxf(fmaxf(p0 + p1, p0 + p2), fmaxf(p0 + p3, p1 + p2)), fmaxf(p1 + p3, p2 + p3));
                if (gs > gbest) { gbest = gs; gi = g; } }
            float qs[4], s4[4];
#pragma unroll
            for (int i = 0; i < 4; ++i) { qs[i] = 0.f; s4[i] = 0.f; }
#pragma unroll
            for (int g = 0; g < 4; ++g) if (g == gi) {
#pragma unroll
                for (int i = 0; i < 4; ++i) { qs[i] = sel[4 * g + i]; s4[i] = sc[4 * g + i]; } }
            int i1 = 0; float b1 = qs[0];
#pragma unroll
            for (int i = 1; i < 4; ++i) if (qs[i] > b1) { b1 = qs[i]; i1 = i; }
            int i2 = -1; float b2 = -1.0e30f;
#pragma unroll
            for (int i = 0; i < 4; ++i) if (i != i1 && qs[i] > b2) { b2 = qs[i]; i2 = i; }
            const int ia = (i1 < i2) ? i1 : i2, ib = (i1 < i2) ? i2 : i1;
            float sa = 0.f, sb = 0.f;
#pragma unroll
            for (int i = 0; i < 4; ++i) { if (i == ia) sa = s4[i]; if (i == ib) sb = s4[i]; }
            const int pidx = (ia == 0) ? (ib - 1) : ((ia == 1) ? (ib + 1) : 5);
            const float inv = 1.0f / (sa + sb);
            if (X.lane == r) { my_cls = gi * 6 + pidx; my_ga = sa * inv; my_gb = sb * inv; }
          }
        }
        int rank = 0;
        if (act && X.lane < 16) rank = __hip_atomic_fetch_add(hist + my_cls, 1, __ATOMIC_RELAXED, __HIP_MEMORY_SCOPE_WORKGROUP);
        __syncthreads();
        if (X.tid < NCLS) { const int n = hist[X.tid]; cbase[X.tid] = n ? (int)__hip_atomic_fetch_add(cnt + 64 * X.tid, (unsigned)n, RLX_AGENT) : 0; }
        __syncthreads();
        if (act && X.lane < 16) { const int tok = row0 + X.lane; const int pos = cbase[my_cls] + rank;
            tokl[my_cls * CLS_CAP + pos] = tok; tgate[tok * 2] = my_ga; tgate[tok * 2 + 1] = my_gb; }
        __syncthreads();
    }
}
DI MoeTab moe_tables(const Args& a, const Ctx& X, int l) {
    LAS int* tab = (LAS int*)(X.lds + TAB_OFF); LAS int* tcls = tab; LAS int* tpos = tab + 160; LAS int* cn = tab + 320; LAS int* rt_ = tab + 344;
    unsigned* cnt = (unsigned*)(a.ws + WS_CTL) + CW_CNT + l * 2048;
    if (X.tid < NCLS) cn[X.tid] = (int)__hip_atomic_load(cnt + 64 * X.tid, RLX_AGENT);
    __syncthreads();
    if (X.tid == 0) { int r = 0;
#pragma unroll 1
        for (int c = 0; c < NCLS; ++c) { const int n = (cn[c] + 255) >> 8;
#pragma unroll 1
            for (int i = 0; i < n; ++i) { tcls[r] = c; tpos[r] = i * 256; ++r; } }
        rt_[0] = r; }
    __syncthreads();
    MoeTab tb; tb.tcls = tcls; tb.tpos = tpos; tb.cnt = cn; tb.Rtot = __builtin_amdgcn_readfirstlane(rt_[0]); return tb;
}

#if defined(__HIP_DEVICE_COMPILE__)
DI Args load_args() { auto p = __builtin_amdgcn_kernarg_segment_ptr(); asm volatile("" : "+s"(p)); return *(const __attribute__((address_space(4))) Args*)p; }
#else
DI Args load_args() { return Args{}; }
#endif
__global__ void __launch_bounds__(512, 2) fwd(Args a_unused) {
    extern __shared__ __attribute__((aligned(16))) unsigned char lds_raw[];
    Ctx X; X.lds = (LAS unsigned char*)lds_raw; X.tid = threadIdx.x; X.lane = X.tid & 63; X.wave = __builtin_amdgcn_readfirstlane(X.tid >> 6); X.G = gridDim.x; X.bid = blockIdx.x;
    volatile LAS unsigned* MISC = (volatile LAS unsigned*)(X.lds + MISC_OFF);
    if (X.tid < 64) MISC[X.tid] = 0u;
    __syncthreads();
    int lo, hi; unsigned* ctl;
    { const Args a = load_args(); lo = a.ph_lo; hi = a.ph_hi; ctl = (unsigned*)(a.ws + WS_CTL); }
    XcdBarrier bar; bar.bar = ctl + CW_BAR; bar.x = 0; bar.st = MISC + 8;
    if (hi - lo > 1) bar = xcd_barrier_post(ctl + CW_BAR, MISC + 8);
#ifndef PH_MASK
#define PH_MASK 0xFFFFF
#endif
#define PON(p) ((PH_MASK >> (p)) & 1)
#ifndef DUP_MASK
#define DUP_MASK 0
#endif
#define NREP(p) (((DUP_MASK >> (p)) & 1) ? 2 : 1)
#ifndef TSEL_MASK
#define TSEL_MASK 0
#endif
#define TSCALE 4
#define TSEL(p) ((TSEL_MASK >> (p)) & 1)
#define IN(k) (lo <= (k) && (k) < hi)
#define SEAM(k) do { if (IN(k) && IN((k) + 1)) xcd_barrier(bar); } while (0)
    unsigned long long tacc = 0ull, tph = 0ull;
#define TBEG() do { if (TSEL_MASK) tph = __builtin_amdgcn_s_memrealtime(); } while (0)
#define TEND(p) do { if (TSEL(p)) tacc += __builtin_amdgcn_s_memrealtime() - tph; } while (0)
    TBEG();
    if (PON(10) && IN(0)) { for (int rep = 0; rep < NREP(10); ++rep) { const Args a = load_args(); p0_prologue(a, X); } }
    SEAM(0); TEND(10);
    TBEG();
    for (int l = 0; l < NL; ++l) {
        const int g0 = 1 + l * NPH;
        if (PON(0) && IN(g0 + 0)) { for (int rep = 0; rep < NREP(0); ++rep) { const Args a = load_args(); unsigned char* ws = a.ws; const float* mod = (const float*)(ws + WS_MOD); bf16* proj = (bf16*)(ws + WS_PROJ); const float* xin = (l == 0) ? a.x : a.out; (void)mod; (void)proj; (void)xin; const Ctx P = fresh(X); p1_norm_gates(a, P, l, xin); } }
        SEAM(g0 + 0); TEND(0); TBEG();
        if (PON(1) && IN(g0 + 1)) for (int rep = 0; rep < NREP(1); ++rep) { const Args a = load_args(); unsigned char* ws = a.ws; const float* mod = (const float*)(ws + WS_MOD); bf16* proj = (bf16*)(ws + WS_PROJ); const float* xin = (l == 0) ? a.x : a.out; (void)mod; (void)proj; (void)xin; const Ctx P = fresh(X);
            DenseSched S; S.A = (const char*)(ws + WS_H); S.Bt = (const char*)(ws + WS_WIN) + (size_t)l * NPROJ * D * 2; S.lda = D; S.ldb = D; S.ord.init(T / 256, NPROJ / 256, P.G, P.bid);
            EpiProj E; E.O = proj;
            pg8::gemm_phase<EpiProj, DenseSched>(P.lds, D, S, E);
        }
        SEAM(g0 + 1); TEND(1); TBEG();
        if (PON(2) && IN(g0 + 2)) { const Args a = load_args(); unsigned char* ws = a.ws; const float* mod = (const float*)(ws + WS_MOD); bf16* proj = (bf16*)(ws + WS_PROJ); const float* xin = (l == 0) ? a.x : a.out; (void)mod; (void)proj; (void)xin; const Ctx P = fresh(X);
            if (PON(11)) for (int rep = 0; rep < NREP(11); ++rep) {
#pragma unroll 1
                for (int u = P.bid; u < 512; u += P.G) attn_unit(a, P, l, u); }
            if (PON(12)) for (int rep = 0; rep < NREP(12); ++rep) {
#pragma unroll 1
                for (int u = P.bid; u < 256; u += P.G) mlstm_unit<false>(a, P, l, u); }
        }
        SEAM(g0 + 2); TEND(2); TBEG();
        if (PON(3) && IN(g0 + 3)) { const Args a = load_args(); unsigned char* ws = a.ws; const float* mod = (const float*)(ws + WS_MOD); bf16* proj = (bf16*)(ws + WS_PROJ); const float* xin = (l == 0) ? a.x : a.out; (void)mod; (void)proj; (void)xin; const Ctx P = fresh(X); mlstm_scan(a, P); }
        SEAM(g0 + 3); TEND(3); TBEG();
        if (PON(4) && IN(g0 + 4)) for (int rep = 0; rep < NREP(4); ++rep) { const Args a = load_args(); unsigned char* ws = a.ws; const float* mod = (const float*)(ws + WS_MOD); bf16* proj = (bf16*)(ws + WS_PROJ); const float* xin = (l == 0) ? a.x : a.out; (void)mod; (void)proj; (void)xin; const Ctx P = fresh(X);
#pragma unroll 1
            for (int u = P.bid; u < 256; u += P.G) mlstm_unit<true>(a, P, l, u); }
        SEAM(g0 + 4); TEND(4); TBEG();
        if (PON(5) && IN(g0 + 5)) for (int rep = 0; rep < NREP(5); ++rep) { const Args a = load_args(); unsigned char* ws = a.ws; const float* mod = (const float*)(ws + WS_MOD); bf16* proj = (bf16*)(ws + WS_PROJ); const float* xin = (l == 0) ? a.x : a.out; (void)mod; (void)proj; (void)xin; const Ctx P = fresh(X);
            { DenseSched S; S.A = (const char*)(ws + WS_H); S.Bt = (const char*)(ws + WS_WAU) + (size_t)l * D * 512 * 2; S.lda = 512; S.ldb = 512; S.ord.init(T / 256, D / 256, P.G, P.bid);
              EpiGate<false> E; E.P = proj; E.gcol = C_GA; pg8::gemm_phase<EpiGate<false>, DenseSched>(P.lds, 512, S, E); }
            { DenseSched S; S.A = (const char*)(ws + WS_H) + (size_t)T * 512 * 2; S.Bt = (const char*)(ws + WS_WMU) + (size_t)l * D * 512 * 2; S.lda = 512; S.ldb = 512; S.ord.init(T / 256, D / 256, P.G, P.bid);
              EpiGate<true> E; E.P = proj; E.gcol = C_GB; pg8::gemm_phase<EpiGate<true>, DenseSched>(P.lds, 512, S, E); }
        }
        SEAM(g0 + 5); TEND(5); TBEG();
        if (PON(6) && IN(g0 + 6)) for (int rep = 0; rep < NREP(6); ++rep) { const Args a = load_args(); unsigned char* ws = a.ws; const float* mod = (const float*)(ws + WS_MOD); bf16* proj = (bf16*)(ws + WS_PROJ); const float* xin = (l == 0) ? a.x : a.out; (void)mod; (void)proj; (void)xin; const Ctx P = fresh(X);
            DenseSched S; S.A = (const char*)(proj + C_MQ); S.Bt = (const char*)(ws + WS_WOUT) + (size_t)l * D * D * 2; S.lda = NPROJ; S.ldb = D; S.ord.init(T / 256, D / 256, P.G, P.bid);
            EpiRes E; E.xin = xin; E.out = a.out; E.g = mod + (size_t)(l * 2) * 6144 + 2 * 1024; E.rmask = T - 1;
            if (rep) { E.out = (float*)(ws + WS_H); E.rmask = T / 2 - 1; }
            pg8::gemm_phase<EpiRes, DenseSched>(P.lds, D, S, E);
        }
        SEAM(g0 + 6); TEND(6); TBEG();
        if (PON(7) && IN(g0 + 7)) { const Args a = load_args(); unsigned char* ws = a.ws; const float* mod = (const float*)(ws + WS_MOD); bf16* proj = (bf16*)(ws + WS_PROJ); const float* xin = (l == 0) ? a.x : a.out; (void)mod; (void)proj; (void)xin; const Ctx P = fresh(X); p6_norm_route(a, P, l, a.out); }
        SEAM(g0 + 7); TEND(7); TBEG();
        if (PON(8) && IN(g0 + 8)) for (int rep = 0; rep < NREP(8); ++rep) { const Args a = load_args(); unsigned char* ws = a.ws; const float* mod = (const float*)(ws + WS_MOD); bf16* proj = (bf16*)(ws + WS_PROJ); const float* xin = (l == 0) ? a.x : a.out; (void)mod; (void)proj; (void)xin; const Ctx P = fresh(X);
            const MoeTab tb = moe_tables(a, P, l);
            LAS unsigned* tokoff = (LAS unsigned*)(P.lds + TOKOFF_OFF); const int* tokl = (const int*)(ws + WS_TOKL);
#pragma unroll 1
            for (int s = 0; s < 8; ++s) { const int L = s * P.G + P.bid;
                if (L < tb.Rtot * 8 && P.tid < 256) { const int rt = L >> 3, cls = tb.tcls[rt], pos = tb.tpos[rt] + P.tid, cn = tb.cnt[cls]; const int tok = tokl[cls * CLS_CAP + (pos < cn ? pos : 0)]; tokoff[s * 256 + P.tid] = (unsigned)tok; } }
            __syncthreads();
            MoeUpSched S; S.A = (const char*)(ws + WS_H); S.W = (const char*)(ws + WS_WGU) + (size_t)l * NE * 1024 * D * 2; S.lda = D; S.ldb = D; S.tb = tb; S.G = P.G; S.c = P.bid; S.tokoff = tokoff;
            EpiSwiglu E; E.H = proj; E.tgate = (const float*)(ws + WS_TGATE); E.tokoff = tokoff;
            pg8::gemm_phase<EpiSwiglu, MoeUpSched>(P.lds, D, S, E);
        }
        SEAM(g0 + 8); TEND(8); TBEG();
        if (PON(9) && IN(g0 + 9)) for (int rep = 0; rep < NREP(9); ++rep) { const Args a = load_args(); unsigned char* ws = a.ws; const float* mod = (const float*)(ws + WS_MOD); bf16* proj = (bf16*)(ws + WS_PROJ); const float* xin = (l == 0) ? a.x : a.out; (void)mod; (void)proj; (void)xin; const Ctx P = fresh(X);
            const MoeTab tb = moe_tables(a, P, l);
            MoeDownSched S; S.A = (const char*)proj; S.W = (const char*)(ws + WS_WD) + (size_t)l * NE * 1024 * FF * 2; S.lda = D; S.ldb = FF; S.tb = tb; S.G = P.G; S.c = P.bid;
            EpiMoeOut E; E.xin = a.out; E.out = a.out; E.g = mod + (size_t)(l * 2) * 6144 + 5 * 1024; E.tokl = (const int*)(ws + WS_TOKL); E.tb = tb; E.rmask = T - 1;
            if (rep) { E.out = (float*)(ws + WS_H); E.rmask = T / 2 - 1; }
            pg8::gemm_phase<EpiMoeOut, MoeDownSched>(P.lds, D, S, E);
        }
        SEAM(g0 + 9); TEND(9); TBEG();
    }
    if (TSEL_MASK && X.bid == 0) { const unsigned long long t1 = __builtin_amdgcn_s_memrealtime(); while (__builtin_amdgcn_s_memrealtime() - t1 < TSCALE * tacc) __builtin_amdgcn_s_sleep(8); }
#undef IN
#undef SEAM
}

extern "C" void kernel_launch(void* const* d_in, const int* in_sizes, int n_in, void* d_out, int out_size, void* d_ws, size_t ws_size, hipStream_t stream) {
    static int grid = 0;
    if (grid == 0) {
        if (n_in != 24 || in_sizes[0] != T * D || out_size != T * D || ws_size < WS_END) { fprintf(stderr, "kernel_launch: unexpected shapes / workspace (n_in %d, ws %zu, need %zu)\n", n_in, ws_size, (size_t)WS_END); grid = -1; return; }
        int dev = 0, cus = 0;
        if (hipGetDevice(&dev) != hipSuccess || hipDeviceGetAttribute(&cus, hipDeviceAttributeMultiprocessorCount, dev) != hipSuccess) { grid = -1; return; }
        if (hipFuncSetAttribute((const void*)fwd, hipFuncAttributeMaxDynamicSharedMemorySize, LDS_BYTES) != hipSuccess) { fprintf(stderr, "kernel_launch: hipFuncSetAttribute failed\n"); grid = -1; return; }
        int per_cu = 0;
        if (hipOccupancyMaxActiveBlocksPerMultiprocessor(&per_cu, (const void*)fwd, 512, LDS_BYTES) != hipSuccess || per_cu < 1) fprintf(stderr, "kernel_launch: occupancy query reports %d\n", per_cu);
        (void)hipGetLastError();
        grid = cus < 256 ? cus : 256;
    }
    if (grid < 0) return;
    (void)hipMemsetAsync((char*)d_ws + WS_CTL, 0, CTL_ZERO_BYTES, stream);
    Args a{};
    a.x = (const float*)d_in[0]; a.c = (const float*)d_in[1]; a.pos = (const int*)d_in[2]; a.ada_w = (const float*)d_in[3]; a.ada_b = (const float*)d_in[4];
    a.nmw = (const float*)d_in[5]; a.nfw = (const float*)d_in[6]; a.w_in = (const float*)d_in[7]; a.b_ig = (const float*)d_in[8]; a.b_fg = (const float*)d_in[9];
    a.qnw = (const float*)d_in[10]; a.knw = (const float*)d_in[11]; a.sinks = (const float*)d_in[12]; a.conv_w = (const float*)d_in[13]; a.conv_b = (const float*)d_in[14];
    a.mnw = (const float*)d_in[15]; a.w_au = (const float*)d_in[16]; a.w_mu = (const float*)d_in[17]; a.w_out = (const float*)d_in[18]; a.router_w = (const float*)d_in[19];
    a.router_b = (const float*)d_in[20]; a.w_gate = (const float*)d_in[21]; a.w_up = (const float*)d_in[22]; a.w_down = (const float*)d_in[23];
    a.out = (float*)d_out; a.ws = (unsigned char*)d_ws;
#if MK_MULTI
    for (int gp = 0; gp < NGP; ++gp) { a.ph_lo = gp; a.ph_hi = gp + 1; hipLaunchKernelGGL(fwd, dim3(grid), dim3(512), LDS_BYTES, stream, a); }
#else
    a.ph_lo = 0; a.ph_hi = NGP; hipLaunchKernelGGL(fwd, dim3(grid), dim3(512), LDS_BYTES, stream, a);
#endif
}
```

```cpp
#include <hip/hip_runtime.h>
#include <cstdio>
#include <cstdint>

#ifndef MK_MULTI
#define MK_MULTI 0
#endif

#define GAS __attribute__((address_space(1)))
#define LAS __attribute__((address_space(3)))
typedef unsigned short bf16;
typedef unsigned v4u __attribute__((ext_vector_type(4)));
typedef unsigned v2u __attribute__((ext_vector_type(2)));
typedef float f32x4 __attribute__((ext_vector_type(4)));
typedef float f32x2 __attribute__((ext_vector_type(2)));
typedef short bf16x8 __attribute__((ext_vector_type(8)));
typedef short bf16x4 __attribute__((ext_vector_type(4)));
#define DI __device__ __forceinline__
#define RLX_AGENT __ATOMIC_RELAXED, __HIP_MEMORY_SCOPE_AGENT
#define LDS_WAIT() asm volatile("s_waitcnt lgkmcnt(0)" ::: "memory")
#define VM_WAIT() asm volatile("s_waitcnt vmcnt(0)" ::: "memory")

constexpr int NB = 2, SEQ = 16384, T = NB * SEQ, D = 1024, NL = 4;
constexpr int DIN_SRC = 4872;
constexpr int NPROJ = 4864;
constexpr int C_AQ = 0, C_AK = 512, C_AV = 640, C_MQ = 768, C_MK = 1280, C_MV = 1792, C_MO = 2304, C_GA = 2816, C_GB = 3840;
constexpr int NE = 16, FF = 512;
constexpr int NCLS = 24, CLS_CAP = 32768;
constexpr float EPS = 1e-6f;
constexpr int NPH = 10;
constexpr int NGP = 1 + NL * NPH;

constexpr size_t MiB = 1u << 20;
constexpr size_t WS_CTL = 0, CTL_ZERO_BYTES = 1 * MiB;
constexpr size_t WS_MOD = 1 * MiB;
constexpr size_t WS_ROPE = 2 * MiB;
constexpr size_t WS_GATES = 4 * MiB;
constexpr size_t WS_TGATE = 5 * MiB;
constexpr size_t WS_TOKL = 6 * MiB;
constexpr size_t WS_MLB = 9 * MiB;
constexpr size_t WS_MLC = 10 * MiB;
constexpr size_t WS_WIN = 28 * MiB;
constexpr size_t WS_WAU = 66 * MiB;
constexpr size_t WS_WMU = 70 * MiB;
constexpr size_t WS_WOUT = 74 * MiB;
constexpr size_t WS_WGU = 82 * MiB;
constexpr size_t WS_WD = 210 * MiB;
constexpr size_t WS_H = 274 * MiB;
constexpr size_t WS_PROJ = 338 * MiB;
constexpr size_t WS_END = 642 * MiB;

constexpr int CW_TMO = 0;
constexpr int CW_BAR = 4096;
constexpr int CW_CNT = 8192;

constexpr int RING_BYTES = 131072;
constexpr int MISC_OFF = RING_BYTES;
constexpr int TAB_OFF = RING_BYTES + 256;
constexpr int TOKOFF_OFF = RING_BYTES + 2048;
constexpr int LDS_BYTES = 147456;

DI unsigned f2bf(float f) { unsigned u = __builtin_bit_cast(unsigned, f); return (u + 0x7fffu + ((u >> 16) & 1u)) >> 16; }
DI unsigned pk2(float lo, float hi) { return f2bf(lo) | (f2bf(hi) << 16); }
DI float bf2f(unsigned short b) { return __builtin_bit_cast(float, ((unsigned)b) << 16); }
DI float bflo(unsigned w) { return __builtin_bit_cast(float, w << 16); }
DI float bfhi(unsigned w) { return __builtin_bit_cast(float, w & 0xffff0000u); }
DI float wave_sum(float v) {
#pragma unroll
    for (int o = 1; o < 64; o <<= 1) v += __shfl_xor(v, o);
    return v;
}
DI float sigmoidf_(float x) { return __builtin_amdgcn_rcpf(1.0f + __expf(-x)); }

#define XB_TMO      128
#define XB_XCNT(j)  (256  + 64 * (j))
#define XB_XSUB(j)  (1280 + 64 * (j))
#define XB_XGEN(j)  (2304 + 64 * (j))
#define XB_TOP      3328
#define XB_TOPGEN   3392
#define XCD_BAR_WORDS 3456
#define XB_SPIN_CAP (1u << 18)
__device__ __forceinline__ unsigned xb_ld(unsigned* p)              { return __hip_atomic_load(p, __ATOMIC_RELAXED, __HIP_MEMORY_SCOPE_AGENT); }
__device__ __forceinline__ unsigned xb_add(unsigned* p, unsigned v) { return __hip_atomic_fetch_add(p, v, __ATOMIC_RELAXED, __HIP_MEMORY_SCOPE_AGENT); }
__device__ __forceinline__ unsigned xb_xcc_id() { return (unsigned)__builtin_amdgcn_s_getreg((3 << 11) | 20) & 0xFu; }
#define XB_SPIN(cond, bar) do { unsigned _sp = 0; while (cond) { __builtin_amdgcn_s_sleep(1); \
    if ((++_sp & 255u) == 0u) { if (xb_ld(&(bar)[XB_TMO])) break; if (_sp > XB_SPIN_CAP) { atomicAdd(&(bar)[XB_TMO], 1u); break; } } } } while (0)
struct XcdBarrier { unsigned* bar; unsigned x; volatile LAS unsigned* st; };
__device__ __forceinline__ XcdBarrier xcd_barrier_post(unsigned* bar, volatile LAS unsigned* st) {
    XcdBarrier b; b.bar = bar; b.x = xb_xcc_id(); b.st = st;
    if (threadIdx.x == 0) (void)xb_add(&bar[XB_XCNT(b.x)], 1u);
    return b;
}
__device__ __forceinline__ void xcd_barrier_complete(unsigned* bar, unsigned x, unsigned& nloc, unsigned& nx) {
    const unsigned G = gridDim.x * gridDim.y * gridDim.z;
    unsigned sum, cnt, mine, sp = 0u;
    for (;;) {
        sum = 0u; cnt = 0u; mine = 0u;
#pragma unroll
        for (unsigned j = 0; j < 16; ++j) { const unsigned c = xb_ld(&bar[XB_XCNT(j)]); sum += c; cnt += (c > 0u) ? 1u : 0u; mine = (j == x) ? c : mine; }
        if (sum == G) break;
        __builtin_amdgcn_s_sleep(1);
        if ((++sp & 255u) == 0u) { if (xb_ld(&bar[XB_TMO])) break; if (sp > XB_SPIN_CAP) { atomicAdd(&bar[XB_TMO], 1u); break; } }
    }
    nloc = mine > 0u ? mine : 1u; nx = cnt > 0u ? cnt : 1u;
}
__device__ __forceinline__ void xcd_barrier(const XcdBarrier& b) {
    asm volatile("s_waitcnt vmcnt(0)" ::: "memory");
    __syncthreads();
    if (threadIdx.x == 0) {
        unsigned* bar = b.bar;
        __builtin_amdgcn_s_waitcnt(0);
        unsigned nloc = b.st[0], nx = b.st[1];
        if (nloc == 0u) { xcd_barrier_complete(bar, b.x, nloc, nx); b.st[0] = nloc; b.st[1] = nx; }
        const unsigned old = xb_add(&bar[XB_XSUB(b.x)], 1u);
        const unsigned gen = old / nloc;
        if (old + 1u == (gen + 1u) * nloc) {
            __builtin_amdgcn_fence(__ATOMIC_RELEASE, "agent");
            asm volatile("s_waitcnt vmcnt(0)" ::: "memory");
            const unsigned og = xb_add(&bar[XB_TOP], 1u);
            const unsigned tg = og / nx;
            if (og + 1u == (tg + 1u) * nx) xb_add(&bar[XB_TOPGEN], 1u);
            else XB_SPIN(xb_ld(&bar[XB_TOPGEN]) == tg, bar);
            __builtin_amdgcn_fence(__ATOMIC_ACQUIRE, "agent");
            xb_add(&bar[XB_XGEN(b.x)], 1u);
            asm volatile("s_waitcnt vmcnt(0)" ::: "memory");
        } else {
            XB_SPIN(xb_ld(&bar[XB_XGEN(b.x)]) == gen, bar);
            __builtin_amdgcn_fence(__ATOMIC_ACQUIRE, "agent");
            asm volatile("s_waitcnt vmcnt(0)" ::: "memory");
        }
    }
    __syncthreads();
}

namespace pg8 {
constexpr int BM = 256, BK = 64, HALF = 128, HTB = HALF * BK * 2, STAGE_BYTES = 8 * HTB, NXCD = 8, WGM = 8;
__host__ __device__ __forceinline__ int lds_byte(int r, int c) { const int st = (r >> 4) * 2 + (c >> 5), rr = r & 15, cc = c & 31, ob = rr * 64 + cc * 2; return st * 1024 + (ob ^ (((ob >> 9) & 1) << 5)); }
__host__ __device__ __forceinline__ void stage_rc(int b, int& R, int& C) { const int st = b / 1024, sb = b % 1024, swz = sb ^ (((sb >> 9) & 1) << 5); R = (st >> 1) * 16 + swz / 64; C = (st & 1) * 32 + (swz % 64) / 2; }
__host__ __device__ __forceinline__ int perm32(int rho) { const int n = rho >> 4, i = rho & 15; return 8 * (i >> 2) + 4 * n + (i & 3); }

struct Unit { int pm, pn, x0, x1; };

struct TileOrder {
    int nM, nN, nwg, G, c;
    __device__ void init(int nM_, int nN_, int G_, int c_) { nM = nM_; nN = nN_; nwg = nM * nN; G = G_; c = c_; }
    __device__ bool get(int i, int& pm, int& pn) const {
        const long L = (long)i * G + c; if (L >= nwg) return false;
        int wgid = (int)L; { const int q = nwg / NXCD, r = nwg % NXCD, xcd = wgid % NXCD, off = wgid / NXCD; wgid = (xcd < r ? xcd * (q + 1) : r * (q + 1) + (xcd - r) * q) + off; }
        const int nig = WGM * nN, gid = wgid / nig, fm = gid * WGM, gsz = (nM - fm) < WGM ? (nM - fm) : WGM;
        pm = fm + ((wgid % nig) % gsz); pn = (wgid % nig) / gsz; return true;
    }
};

template <class Epi, class Sched>
__device__ __forceinline__ void gemm_phase(LAS unsigned char* lds, const int K, const Sched& S, const Epi& E) {
    int tid = threadIdx.x; asm volatile("" : "+v"(tid));
    const int wid = __builtin_amdgcn_readfirstlane(tid >> 6), lane = tid & 63, wr = wid >> 2, wc = wid & 3, fr = lane & 15, fq = lane >> 4;
    const int nt = K / BK;
    constexpr bool GA = Sched::GATHER; constexpr int KS = Sched::KSPLIT;
    unsigned voffA[2], voffB[2]; int Rst[2], Cst[2];
#pragma unroll
    for (int i = 0; i < 2; ++i) { int R, C; stage_rc(tid * 16 + i * 8192, R, C); const int Rb = Epi::PERM ? ((R & ~31) + perm32(R & 31)) : R;
        voffA[i] = (unsigned)(R * S.lda + C) * 2u; voffB[i] = (unsigned)(Rb * S.ldb + C) * 2u; Rst[i] = R; Cst[i] = C; }
    const size_t kstep = (size_t)(BK * 2);
    const size_t hstepA = (size_t)HALF * S.lda * 2, hstepB = (size_t)HALF * S.ldb * 2;
    const unsigned ldsw = (unsigned)wid * 1024u; const unsigned gmul = (unsigned)S.lda * 2u;
    const int aoff = lds_byte(wr * 64 + fr, fq * 8), boff = lds_byte(wc * 32 + fr, fq * 8);
    unsigned vAc[2], vAn[2];
#define PG8_SA(b, h) (((b) * 2 + (h)) * HTB)
#define PG8_SB(b, h) ((4 + (b) * 2 + (h)) * HTB)
#define PG8_STAGE2(bufoff, gbase, v0, v1) do { \
        __builtin_amdgcn_global_load_lds((const unsigned*)((const char*)(gbase) + (v0)), (LAS unsigned*)(lds + (bufoff) + ldsw), 16, 0, 0); \
        __builtin_amdgcn_global_load_lds((const unsigned*)((const char*)(gbase) + (v1)), (LAS unsigned*)(lds + (bufoff) + ldsw + 8192), 16, 0, 0); } while (0)
#define PG8_STAGE_B(bufoff, ptr, h) PG8_STAGE2(bufoff, (ptr) + (h) * hstepB, voffB[0], voffB[1])
#define PG8_STAGE_A(bufoff, ptr, h, nx) do { if constexpr (GA) { const unsigned _p = (nx) ? vAn[h] : vAc[h]; PG8_STAGE2(bufoff, ptr, (_p & 0xffffu) * gmul + (unsigned)Cst[0] * 2u, (_p >> 16) * gmul + (unsigned)Cst[0] * 2u); } \
        else { PG8_STAGE2(bufoff, (ptr) + (h) * hstepA, voffA[0], voffA[1]); } } while (0)
#define PG8_LDA(dst, b, h) do { _Pragma("unroll") for (int m = 0; m < 4; ++m) _Pragma("unroll") for (int k = 0; k < 2; ++k) dst[m][k] = *(const LAS bf16x8*)(lds + PG8_SA(b, h) + aoff + m * 2048 + k * 1024); } while (0)
#define PG8_LDB(dst, b, h) do { _Pragma("unroll") for (int n = 0; n < 2; ++n) _Pragma("unroll") for (int k = 0; k < 2; ++k) dst[n][k] = *(const LAS bf16x8*)(lds + PG8_SB(b, h) + boff + n * 2048 + k * 1024); } while (0)
#define PG8_MMA(ai, bj, At, Bt) do { __builtin_amdgcn_s_setprio(1); _Pragma("unroll") for (int m = 0; m < 4; ++m) _Pragma("unroll") for (int n = 0; n < 2; ++n) _Pragma("unroll") for (int k = 0; k < 2; ++k) \
        acc[ai][bj][m][n] = __builtin_amdgcn_mfma_f32_16x16x32_bf16(Bt[n][k], At[m][k], acc[ai][bj][m][n], 0, 0, 0); __builtin_amdgcn_s_setprio(0); } while (0)
#define PG8_WAIT_V(n) asm volatile("s_waitcnt vmcnt(" #n ")" ::: "memory")
#define PG8_WAIT_L(n) asm volatile("s_waitcnt lgkmcnt(" #n ")" ::: "memory")
#define PG8_BAR __builtin_amdgcn_s_barrier()
#define PG8_SCHED __builtin_amdgcn_sched_barrier(0)
#define PG8_GOFF(dst, u) do { if constexpr (GA) { _Pragma("unroll") for (int h = 0; h < 2; ++h) dst[h] = S.a_rowoff(u, Rst[0] + HALF * h) | (S.a_rowoff(u, Rst[0] + 64 + HALF * h) << 16); } } while (0)
    Unit cur, nxt; int ui = 0;
    if (!S.next(0, cur)) return;
    f32x4 acc[2][2][4][2];
#pragma unroll
    for (int a = 0; a < 2; ++a)
#pragma unroll
        for (int b = 0; b < 2; ++b)
#pragma unroll
            for (int m = 0; m < 4; ++m)
#pragma unroll
                for (int n = 0; n < 2; ++n) acc[a][b][m][n] = (f32x4){0.f, 0.f, 0.f, 0.f};
    bf16x8 At[4][2], B0[2][2], B1[2][2];
    const char* cA = S.a_base(cur); const char* cB0 = S.b_base(cur, 0); const char* cB1 = KS ? S.b_base(cur, 1) : cB0;
    PG8_GOFF(vAc, cur);
    vAn[0] = vAc[0]; vAn[1] = vAc[1];
    PG8_STAGE_B(PG8_SB(0, 0), cB0, 0); PG8_STAGE_B(PG8_SB(0, 1), cB0, 1); PG8_STAGE_A(PG8_SA(0, 0), cA, 0, false); PG8_STAGE_A(PG8_SA(0, 1), cA, 1, false);
    if (wr == 1) PG8_BAR;
    PG8_WAIT_V(2); PG8_BAR;
    PG8_STAGE_B(PG8_SB(1, 0), cB0 + kstep, 0); PG8_STAGE_A(PG8_SA(1, 0), cA + kstep, 0, false); PG8_STAGE_B(PG8_SB(1, 1), cB0 + kstep, 1);
    PG8_WAIT_V(6); PG8_BAR;
    for (;;) {
        const bool has_next = S.next(ui + 1, nxt);
        const char* nA = has_next ? S.a_base(nxt) : cA; const char* nB0 = has_next ? S.b_base(nxt, 0) : cB0; const char* nB1 = (KS && has_next) ? S.b_base(nxt, 1) : (KS ? cB1 : nB0);
        if constexpr (GA) { if (has_next) { PG8_GOFF(vAn, nxt); } }
        for (int t = 0; t < nt; t += 2) {
            const bool last = (t == nt - 2);
            const char* a1 = cA + (size_t)(t + 1) * kstep;
            const char* a2 = last ? nA : cA + (size_t)(t + 2) * kstep;
            const char* b2 = last ? nB0 : ((KS && (t + 2) >= KS) ? cB1 + (size_t)(t + 2 - KS) * kstep : cB0 + (size_t)(t + 2) * kstep);
            const char* a3 = a2 + kstep; const char* b3 = b2 + kstep;
            PG8_LDB(B0, 0, 0); PG8_LDB(B1, 0, 1); PG8_SCHED; PG8_LDA(At, 0, 0); PG8_STAGE_A(PG8_SA(1, 1), a1, 1, false);
            PG8_WAIT_V(8); PG8_WAIT_L(0); PG8_BAR; PG8_MMA(0, 0, At, B0); PG8_MMA(0, 1, At, B1); PG8_BAR; PG8_SCHED;
            PG8_LDA(At, 0, 1); PG8_STAGE_B(PG8_SB(0, 0), b2, 0); PG8_STAGE_B(PG8_SB(0, 1), b2, 1); PG8_STAGE_A(PG8_SA(0, 0), a2, 0, last);
            PG8_WAIT_V(8); PG8_WAIT_L(0); PG8_BAR; PG8_MMA(1, 0, At, B0); PG8_MMA(1, 1, At, B1); PG8_BAR; PG8_SCHED;
            PG8_LDB(B0, 1, 0); PG8_LDB(B1, 1, 1); PG8_SCHED; PG8_LDA(At, 1, 0); PG8_STAGE_A(PG8_SA(0, 1), a2, 1, last);
            PG8_WAIT_V(8); PG8_WAIT_L(0); PG8_BAR; PG8_MMA(0, 0, At, B0); PG8_MMA(0, 1, At, B1); PG8_BAR; PG8_SCHED;
            PG8_LDA(At, 1, 1); PG8_STAGE_B(PG8_SB(1, 0), b3, 0); PG8_STAGE_B(PG8_SB(1, 1), b3, 1); PG8_STAGE_A(PG8_SA(1, 0), a3, 0, last);
            PG8_WAIT_V(8); PG8_WAIT_L(0); PG8_BAR; PG8_MMA(1, 0, At, B0); PG8_MMA(1, 1, At, B1); PG8_BAR; PG8_SCHED;
        }
        if (wr == 0) PG8_BAR;
        { int fr_ = fr, fq_ = fq; asm volatile("" : "+v"(fr_), "+v"(fq_));
          E(acc, cur, wr, wc, fr_, fq_); }
        if (!has_next) break;
#pragma unroll
        for (int a = 0; a < 2; ++a)
#pragma unroll
            for (int b = 0; b < 2; ++b)
#pragma unroll
                for (int m = 0; m < 4; ++m)
#pragma unroll
                    for (int n = 0; n < 2; ++n) acc[a][b][m][n] = (f32x4){0.f, 0.f, 0.f, 0.f};
        cur = nxt; cA = nA; cB0 = nB0; cB1 = nB1; ++ui;
        vAc[0] = vAn[0]; vAc[1] = vAn[1];
        if (wr == 1) PG8_BAR;
    }
    PG8_WAIT_V(0);
    PG8_BAR;
#undef PG8_SA
#undef PG8_SB
#undef PG8_STAGE2
#undef PG8_STAGE_A
#undef PG8_STAGE_B
#undef PG8_LDA
#undef PG8_LDB
#undef PG8_MMA
#undef PG8_WAIT_V
#undef PG8_WAIT_L
#undef PG8_BAR
#undef PG8_SCHED
#undef PG8_GOFF
}
}
using pg8::Unit;

DI unsigned cvt_pk_bf16(float lo, float hi) { unsigned r; asm volatile("v_cvt_pk_bf16_f32 %0, %1, %2" : "=v"(r) : "v"(lo), "v"(hi)); return r; }

struct Args {
    const float* x; const float* c; const int* pos; const float* ada_w; const float* ada_b; const float* nmw; const float* nfw; const float* w_in;
    const float* b_ig; const float* b_fg; const float* qnw; const float* knw; const float* sinks; const float* conv_w; const float* conv_b; const float* mnw;
    const float* w_au; const float* w_mu; const float* w_out; const float* router_w; const float* router_b; const float* w_gate; const float* w_up; const float* w_down;
    float* out; unsigned char* ws; int ph_lo, ph_hi;
};

__constant__ float c_invf[8] = {1.0f, 0.1939227432012558f, 0.03760603070259094f, 0.007292664609849453f, 0.0014142135623842478f, 0.00027424818836152554f, 5.3182957344688475e-05f, 1.0313385246263351e-05f};

struct DenseSched {
    static constexpr bool GATHER = false; static constexpr int KSPLIT = 0;
    const char* A; const char* Bt; int lda, ldb; pg8::TileOrder ord;
    DI bool next(int i, Unit& u) const { int pm, pn; if (!ord.get(i, pm, pn)) return false; u.pm = pm; u.pn = pn; u.x0 = 0; u.x1 = 0; return true; }
    DI const char* a_base(const Unit& u) const { return A + (size_t)u.pm * 256 * lda * 2; }
    DI const char* b_base(const Unit& u, int) const { return Bt + (size_t)u.pn * 256 * ldb * 2; }
    DI unsigned a_rowoff(const Unit&, int) const { return 0u; }
};
struct EpiProj {
    static constexpr bool PERM = true;
    bf16* O;
    DI void operator()(const f32x4 (&acc)[2][2][4][2], const Unit& u, int wr, int wc, int fr, int fq) const {
        const int row0 = u.pm * 256 + wr * 64 + fr, col0 = u.pn * 256 + wc * 32 + 8 * fq; const bool sg = u.pn >= 9;
#pragma unroll
        for (int ai = 0; ai < 2; ++ai)
#pragma unroll
            for (int m = 0; m < 4; ++m) { bf16* rowp = O + (size_t)(row0 + ai * 128 + m * 16) * NPROJ + col0;
#pragma unroll
                for (int bj = 0; bj < 2; ++bj) { f32x4 v0 = acc[ai][bj][m][0], v1 = acc[ai][bj][m][1];
                    if (sg) {
#pragma unroll
                        for (int j = 0; j < 4; ++j) { v0[j] = sigmoidf_(v0[j]); v1[j] = sigmoidf_(v1[j]); } }
                    v4u w; w.x = cvt_pk_bf16(v0[0], v0[1]); w.y = cvt_pk_bf16(v0[2], v0[3]); w.z = cvt_pk_bf16(v1[0], v1[1]); w.w = cvt_pk_bf16(v1[2], v1[3]);
                    *(v4u*)(rowp + bj * 128) = w; } }
    }
};
template <bool ADD> struct EpiGate {
    static constexpr bool PERM = true;
    bf16* P; int gcol;
    DI void operator()(const f32x4 (&acc)[2][2][4][2], const Unit& u, int wr, int wc, int fr, int fq) const {
        const int row0 = u.pm * 256 + wr * 64 + fr, col0 = u.pn * 256 + wc * 32 + 8 * fq;
#pragma unroll
        for (int ai = 0; ai < 2; ++ai)
#pragma unroll
            for (int m = 0; m < 4; ++m) { bf16* rowp = P + (size_t)(row0 + ai * 128 + m * 16) * NPROJ + col0;
#pragma unroll
                for (int bj = 0; bj < 2; ++bj) { const f32x4 v0 = acc[ai][bj][m][0], v1 = acc[ai][bj][m][1];
                    const v4u g = *(const v4u*)(rowp + gcol + bj * 128);
                    float o[8] = {bflo(g.x) * v0[0], bfhi(g.x) * v0[1], bflo(g.y) * v0[2], bfhi(g.y) * v0[3], bflo(g.z) * v1[0], bfhi(g.z) * v1[1], bflo(g.w) * v1[2], bfhi(g.w) * v1[3]};
                    if (ADD) { const v4u p = *(const v4u*)(rowp + C_MQ + bj * 128);
                        o[0] += bflo(p.x); o[1] += bfhi(p.x); o[2] += bflo(p.y); o[3] += bfhi(p.y); o[4] += bflo(p.z); o[5] += bfhi(p.z); o[6] += bflo(p.w); o[7] += bfhi(p.w); }
                    v4u w; w.x = cvt_pk_bf16(o[0], o[1]); w.y = cvt_pk_bf16(o[2], o[3]); w.z = cvt_pk_bf16(o[4], o[5]); w.w = cvt_pk_bf16(o[6], o[7]);
                    *(v4u*)(rowp + C_MQ + bj * 128) = w; } }
    }
};
struct EpiRes {
    static constexpr bool PERM = false;
    const float* xin; float* out; const float* g; int rmask;
    DI void operator()(const f32x4 (&acc)[2][2][4][2], const Unit& u, int wr, int wc, int fr, int fq) const {
        const int row0 = u.pm * 256 + wr * 64 + fr, col0 = u.pn * 256 + wc * 32 + 4 * fq; const int b = (u.pm * 256) >> 14;
        f32x4 gv[2][2];
#pragma unroll
        for (int bj = 0; bj < 2; ++bj)
#pragma unroll
            for (int n = 0; n < 2; ++n) gv[bj][n] = *(const f32x4*)(g + b * 6144 + col0 + bj * 128 + n * 16);
#pragma unroll
        for (int ai = 0; ai < 2; ++ai)
#pragma unroll
            for (int m = 0; m < 4; ++m) { const size_t off = (size_t)(row0 + ai * 128 + m * 16) * D + col0; const size_t offo = (size_t)((row0 + ai * 128 + m * 16) & rmask) * D + col0;
#pragma unroll
                for (int bj = 0; bj < 2; ++bj)
#pragma unroll
                    for (int n = 0; n < 2; ++n) { const f32x4 xv = *(const f32x4*)(xin + off + bj * 128 + n * 16);
                        *(f32x4*)(out + offo + bj * 128 + n * 16) = xv + gv[bj][n] * acc[ai][bj][m][n]; } }
    }
};

struct MoeTab { const LAS int* tcls; const LAS int* tpos; const LAS int* cnt; int Rtot; };
DI int xcd_remap(int L, int nwg) { const int q = nwg >> 3, r = nwg & 7, xcd = L & 7, off = L >> 3; return (xcd < r ? xcd * (q + 1) : r * (q + 1) + (xcd - r) * q) + off; }
DI void cls_experts(int cls, int& ea, int& eb) { const int g = cls / 6, p = cls - 6 * g; const int a = (p < 3) ? 0 : ((p < 5) ? 1 : 2); const int b = (p < 3) ? (p + 1) : ((p < 5) ? (p - 1) : 3); ea = 4 * g + a; eb = 4 * g + b; }
struct MoeUpSched {
    static constexpr bool GATHER = true; static constexpr int KSPLIT = 0;
    const char* A; const char* W; int lda, ldb; MoeTab tb; int G, c; const LAS unsigned* tokoff;
    DI bool next(int i, Unit& u) const { const int L0 = i * G + c; if (L0 >= tb.Rtot * 8) return false; const int L = xcd_remap(L0, tb.Rtot * 8); u.pm = L >> 3; u.pn = L & 7; u.x0 = i; u.x1 = __builtin_amdgcn_readfirstlane(tb.tcls[u.pm]); return true; }
    DI const char* a_base(const Unit&) const { return A; }
    DI const char* b_base(const Unit& u, int) const { int ea, eb; cls_experts(u.x1, ea, eb); const int e = (u.pn < 4) ? ea : eb; return W + ((size_t)e * 1024 + (size_t)(u.pn & 3) * 256) * 1024 * 2; }
    DI unsigned a_rowoff(const Unit& u, int r) const { return tokoff[u.x0 * 256 + r]; }
};
struct EpiSwiglu {
    static constexpr bool PERM = true;
    bf16* H; const float* tgate; const LAS unsigned* tokoff;
    DI void operator()(const f32x4 (&acc)[2][2][4][2], const Unit& u, int wr, int wc, int fr, int fq) const {
        const int r0 = wr * 64 + fr; const int hc = (u.pn >> 2) * 512 + (u.pn & 3) * 128 + wc * 32 + 8 * fq; const int gsel = u.pn >> 2;
#pragma unroll
        for (int ai = 0; ai < 2; ++ai)
#pragma unroll
            for (int m = 0; m < 4; ++m) { const int r = r0 + ai * 128 + m * 16; const unsigned tok = tokoff[u.x0 * 256 + r]; const float rg = tgate[tok * 2 + gsel];
                const f32x4 g0 = acc[ai][0][m][0], g1 = acc[ai][0][m][1], u0 = acc[ai][1][m][0], u1 = acc[ai][1][m][1];
                float o[8];
#pragma unroll
                for (int j = 0; j < 4; ++j) { o[j] = g0[j] * sigmoidf_(g0[j]) * u0[j] * rg; o[4 + j] = g1[j] * sigmoidf_(g1[j]) * u1[j] * rg; }
                v4u w; w.x = cvt_pk_bf16(o[0], o[1]); w.y = cvt_pk_bf16(o[2], o[3]); w.z = cvt_pk_bf16(o[4], o[5]); w.w = cvt_pk_bf16(o[6], o[7]);
                *(v4u*)(H + ((size_t)u.pm * 256 + r) * 1024 + hc) = w; }
    }
};
struct MoeDownSched {
    static constexpr bool GATHER = false; static constexpr int KSPLIT = 8;
    const char* A; const char* W; int lda, ldb; MoeTab tb; int G, c;
    DI bool next(int i, Unit& u) const { const int L0 = i * G + c; if (L0 >= tb.Rtot * 4) return false; const int L = xcd_remap(L0, tb.Rtot * 4); u.pm = L >> 2; u.pn = L & 3; u.x0 = __builtin_amdgcn_readfirstlane(tb.tpos[u.pm]); u.x1 = __builtin_amdgcn_readfirstlane(tb.tcls[u.pm]); return true; }
    DI const char* a_base(const Unit& u) const { return A + (size_t)u.pm * 256 * lda * 2; }
    DI const char* b_base(const Unit& u, int half) const { int ea, eb; cls_experts(u.x1, ea, eb); const int e = half ? eb : ea; return W + ((size_t)e * 1024 + (size_t)u.pn * 256) * 512 * 2; }
    DI unsigned a_rowoff(const Unit&, int) const { return 0u; }
};
struct EpiMoeOut {
    static constexpr bool PERM = false;
    const float* xin; float* out; const float* g; const int* tokl; MoeTab tb; int rmask;
    DI void operator()(const f32x4 (&acc)[2][2][4][2], const Unit& u, int wr, int wc, int fr, int fq) const {
        const int r0 = wr * 64 + fr, col0 = u.pn * 256 + wc * 32 + 4 * fq; const int cn = tb.cnt[u.x1];
#pragma unroll
        for (int ai = 0; ai < 2; ++ai)
#pragma unroll
            for (int m = 0; m < 4; ++m) { const int pos = u.x0 + r0 + ai * 128 + m * 16;
                if (pos < cn) { const int tok = tokl[u.x1 * CLS_CAP + pos]; const int b = tok >> 14; const float* ip = xin + (size_t)tok * D + col0; float* op = out + (size_t)(tok & rmask) * D + col0; const float* gp = g + b * 6144 + col0;
#pragma unroll
                    for (int bj = 0; bj < 2; ++bj)
#pragma unroll
                        for (int n = 0; n < 2; ++n) { const f32x4 xv = *(const f32x4*)(ip + bj * 128 + n * 16); const f32x4 gv = *(const f32x4*)(gp + bj * 128 + n * 16);
                            *(f32x4*)(op + bj * 128 + n * 16) = xv + gv * acc[ai][bj][m][n]; } } }
    }
};

struct Ctx { LAS unsigned char* lds; int tid, lane, wave, G, bid; };
DI Ctx fresh(const Ctx& X) { Ctx P = X; int t = X.tid; asm volatile("" : "+v"(t)); P.tid = t; P.lane = t & 63; P.wave = __builtin_amdgcn_readfirstlane(t >> 6); return P; }

DI void tr_item(const float* W, int ldw, int K, bf16* WT, int k0, LAS float* scr, int lane) {
#pragma unroll 8
    for (int i = 0; i < 32; ++i) { const int kk = 2 * i + (lane >> 5); scr[kk * 33 + (lane & 31)] = W[(size_t)(k0 + kk) * ldw + (lane & 31)]; }
    LDS_WAIT(); asm volatile("" ::: "memory");
    const int c = lane & 7;
#pragma unroll
    for (int j = 0; j < 4; ++j) { const int n = (lane >> 3) + 8 * j; const LAS float* s = scr + (8 * c) * 33 + n;
        v4u o; o.x = pk2(s[0 * 33], s[1 * 33]); o.y = pk2(s[2 * 33], s[3 * 33]); o.z = pk2(s[4 * 33], s[5 * 33]); o.w = pk2(s[6 * 33], s[7 * 33]);
        *(v4u*)(WT + (size_t)n * K + k0 + 8 * c) = o; }
    LDS_WAIT(); asm volatile("" ::: "memory");
}
DI void p0_prologue(const Args& a, const Ctx& X) {
    unsigned char* ws = a.ws;
    LAS float* scr = (LAS float*)(X.lds + X.wave * 16384);
    const int gw = X.bid * 8 + X.wave, NGW = X.G * 8;
    constexpr int IT_WIN = 16 * 152, IT_AU = 8 * 32, IT_OUT = 16 * 32, IT_GU = 16 * 16 * 32, IT_DN = 16 * 8 * 32;
    constexpr int IT_L = IT_WIN + 2 * IT_AU + IT_OUT + IT_GU + IT_DN;
    for (int it = gw; it < NL * IT_L; it += NGW) {
        const int l = it / IT_L; int r = it - l * IT_L;
        if (r < IT_WIN) { const int kb = r / 152, nb = r - kb * 152, d0 = 32 * nb, s0 = d0 + (d0 >= 2304 ? 8 : 0);
            tr_item(a.w_in + (size_t)l * D * DIN_SRC + s0, DIN_SRC, D, (bf16*)(ws + WS_WIN) + ((size_t)l * NPROJ + d0) * D, 64 * kb, scr, X.lane); continue; }
        r -= IT_WIN;
        if (r < IT_AU) { const int kb = r >> 5, nb = r & 31;
            tr_item(a.w_au + (size_t)l * 512 * D + 32 * nb, D, 512, (bf16*)(ws + WS_WAU) + ((size_t)l * D + 32 * nb) * 512, 64 * kb, scr, X.lane); continue; }
        r -= IT_AU;
        if (r < IT_AU) { const int kb = r >> 5, nb = r & 31;
            tr_item(a.w_mu + (size_t)l * 512 * D + 32 * nb, D, 512, (bf16*)(ws + WS_WMU) + ((size_t)l * D + 32 * nb) * 512, 64 * kb, scr, X.lane); continue; }
        r -= IT_AU;
        if (r < IT_OUT) { const int kb = r >> 5, nb = r & 31;
            tr_item(a.w_out + (size_t)l * D * D + 32 * nb, D, D, (bf16*)(ws + WS_WOUT) + ((size_t)l * D + 32 * nb) * D, 64 * kb, scr, X.lane); continue; }
        r -= IT_OUT;
        if (r < IT_GU) { const int e = r >> 9, q = r & 511, kb = q >> 5, nb = q & 31, tq = nb >> 3, rb = nb & 7;
            const float* src = ((rb < 4) ? a.w_gate : a.w_up) + ((size_t)(l * NE + e) * D) * FF + 128 * tq + 32 * (rb & 3);
            tr_item(src, FF, D, (bf16*)(ws + WS_WGU) + ((size_t)(l * NE + e) * 1024 + 32 * nb) * D, 64 * kb, scr, X.lane); continue; }
        r -= IT_GU;
        { const int e = r >> 8, q = r & 255, kb = q >> 5, nb = q & 31;
            tr_item(a.w_down + ((size_t)(l * NE + e) * FF) * D + 32 * nb, D, FF, (bf16*)(ws + WS_WD) + ((size_t)(l * NE + e) * 1024 + 32 * nb) * FF, 64 * kb, scr, X.lane); }
    }
    { float* cs = (float*)(ws + WS_ROPE); float* sn = cs + (size_t)T * 8;
      for (int i = X.bid * 512 + X.tid; i < T * 8; i += X.G * 512) { const int tok = i >> 3, f = i & 7; const float angf = (float)a.pos[tok] * c_invf[f];
          double rev = (double)angf * 0.15915494309189535; rev -= rint(rev); const float rf = (float)rev;
          cs[i] = __builtin_amdgcn_cosf(rf); sn[i] = __builtin_amdgcn_sinf(rf); } }
    __syncthreads();
    LAS float* cact = (LAS float*)X.lds; LAS float* red = (LAS float*)(X.lds + 8192);
    for (int i = X.tid; i < 2048; i += 512) { const float cv = a.c[i]; cact[i] = cv / (1.0f + __expf(-cv)); }
    __syncthreads();
    float* mod = (float*)(ws + WS_MOD);
    for (int it = X.bid; it < NL * 96; it += X.G) { const int l = it / 96, cg = it - l * 96; const int col = cg * 64 + X.lane;
        const float* w = a.ada_w + (size_t)l * D * 6144 + col; float s0 = 0.f, s1 = 0.f;
#pragma unroll 8
        for (int kk = 0; kk < 128; ++kk) { const int k = X.wave * 128 + kk; const float wv = w[(size_t)k * 6144]; s0 += cact[k] * wv; s1 += cact[1024 + k] * wv; }
        red[(X.wave * 2 + 0) * 64 + X.lane] = s0; red[(X.wave * 2 + 1) * 64 + X.lane] = s1;
        __syncthreads();
        if (X.tid < 128) { const int b = X.tid >> 6, ln = X.tid & 63; float s = 0.f;
#pragma unroll
            for (int w8 = 0; w8 < 8; ++w8) s += red[(w8 * 2 + b) * 64 + ln];
            mod[(size_t)(l * 2 + b) * 6144 + cg * 64 + ln] = s + a.ada_b[l * 6144 + cg * 64 + ln]; }
        __syncthreads();
    }
}

DI void p1_norm_gates(const Args& a, const Ctx& X, int l, const float* xin) {
    unsigned char* ws = a.ws;
    LAS float* gwl = (LAS float*)X.lds;
    for (int idx = X.tid; idx < 8192; idx += 512) { const int k = idx >> 3, g = idx & 7; gwl[g * 1024 + k] = a.w_in[(size_t)l * D * DIN_SRC + (size_t)k * DIN_SRC + 2304 + g]; }
    __syncthreads();
    const float* mod = (const float*)(ws + WS_MOD); bf16* hb = (bf16*)(ws + WS_H); float* gates = (float*)(ws + WS_GATES);
    const int gw = X.bid * 8 + X.wave, NGW = X.G * 8;
    for (int rg = gw; rg < T / 16; rg += NGW) {
        const int row0 = rg * 16, b = row0 >> 14;
        const float* mb = mod + (size_t)(l * 2 + b) * 6144;
        f32x4 aw[4], sh[4];
#pragma unroll
        for (int j = 0; j < 4; ++j) { const int k = 256 * j + 4 * X.lane; const f32x4 nw = *(const f32x4*)(a.nmw + l * D + k); const f32x4 sc = *(const f32x4*)(mb + 1024 + k); aw[j] = nw * (sc + 1.0f); sh[j] = *(const f32x4*)(mb + k); }
        f32x4 pre[4][4];
#pragma unroll
        for (int q = 0; q < 4; ++q) { const f32x4* xp = (const f32x4*)(xin + (size_t)(row0 + q) * D) + X.lane;
#pragma unroll
            for (int j = 0; j < 4; ++j) pre[q][j] = xp[64 * j]; }
#pragma unroll 1
        for (int rb = 0; rb < 16; rb += 4) {
#pragma unroll
          for (int q = 0; q < 4; ++q) { const int r = rb + q; const int row = row0 + r;
            f32x4 v[4]; float ss = 0.f;
#pragma unroll
            for (int j = 0; j < 4; ++j) v[j] = pre[q][j];
            if (rb + 4 < 16) { const f32x4* xp = (const f32x4*)(xin + (size_t)(row + 4) * D) + X.lane;
#pragma unroll
                for (int j = 0; j < 4; ++j) pre[q][j] = xp[64 * j]; }
#pragma unroll
            for (int j = 0; j < 4; ++j) ss += (v[j].x * v[j].x + v[j].y * v[j].y) + (v[j].z * v[j].z + v[j].w * v[j].w);
            ss = wave_sum(ss); const float rstd = 1.0f / sqrtf(ss * (1.0f / D) + EPS);
            unsigned long long* o8 = (unsigned long long*)(hb + (size_t)row * D) + X.lane;
#pragma unroll
            for (int j = 0; j < 4; ++j) { v[j] = v[j] * rstd * aw[j] + sh[j]; o8[64 * j] = (unsigned long long)pk2(v[j].x, v[j].y) | ((unsigned long long)pk2(v[j].z, v[j].w) << 32); }
            float gp[8];
#pragma unroll
            for (int g = 0; g < 8; ++g) { float p = 0.f;
#pragma unroll
                for (int j = 0; j < 4; ++j) { const f32x4 w = *(const LAS f32x4*)(gwl + g * 1024 + 256 * j + 4 * X.lane); p += (v[j].x * w.x + v[j].y * w.y) + (v[j].z * w.z + v[j].w * w.w); }
                gp[g] = wave_sum(p); __builtin_amdgcn_sched_barrier(0); }
            if (X.lane == 0) {
#pragma unroll
                for (int g = 0; g < 4; ++g) { gates[(size_t)row * 8 + g] = gp[g] + a.b_ig[l * 4 + g];
                    const float z = gp[4 + g] + a.b_fg[l * 4 + g]; gates[(size_t)row * 8 + 4 + g] = fminf(z, 0.f) - log1pf(__expf(-fabsf(z))); } }
            __builtin_amdgcn_sched_barrier(0);
          }
        }
    }
}

DI void attn_unit(const Args& a, const Ctx& X, int l, int unit) {
    unsigned char* ws = a.ws; const bf16* proj = (const bf16*)(ws + WS_PROJ); bf16* ao = (bf16*)(ws + WS_H);
    const float* cs = (const float*)(ws + WS_ROPE); const float* sn = cs + (size_t)T * 8;
    const int b = unit >> 8, rem = unit & 255, nb = rem >> 1, kvh = rem & 1; const int tok0 = b * SEQ + nb * 128;
    LAS bf16* Kl = (LAS bf16*)X.lds;
    LAS bf16* VT = (LAS bf16*)(X.lds + 36864);
    int lane = X.lane; asm volatile("" : "+v"(lane));
    const int c16 = lane & 15, quad = lane >> 4;
    {
        const int row = X.tid >> 1, half = X.tid & 1; const int tokk = tok0 - 128 + row; const bool valid = (nb > 0) || (row >= 128);
        float y[32]; float vv[32];
        if (valid) {
            const v4u* kp = (const v4u*)(proj + (size_t)tokk * NPROJ + C_AK + kvh * 64 + half * 32); const v4u* vp = (const v4u*)(proj + (size_t)tokk * NPROJ + C_AV + kvh * 64 + half * 32);
#pragma unroll
            for (int q = 0; q < 4; ++q) { const v4u kw = kp[q], vw = vp[q];
                y[8 * q + 0] = bflo(kw.x); y[8 * q + 1] = bfhi(kw.x); y[8 * q + 2] = bflo(kw.y); y[8 * q + 3] = bfhi(kw.y); y[8 * q + 4] = bflo(kw.z); y[8 * q + 5] = bfhi(kw.z); y[8 * q + 6] = bflo(kw.w); y[8 * q + 7] = bfhi(kw.w);
                vv[8 * q + 0] = bflo(vw.x); vv[8 * q + 1] = bfhi(vw.x); vv[8 * q + 2] = bflo(vw.y); vv[8 * q + 3] = bfhi(vw.y); vv[8 * q + 4] = bflo(vw.z); vv[8 * q + 5] = bfhi(vw.z); vv[8 * q + 6] = bflo(vw.w); vv[8 * q + 7] = bfhi(vw.w); }
        } else {
#pragma unroll
            for (int i = 0; i < 32; ++i) { y[i] = 0.f; vv[i] = 0.f; } }
        float ss = 0.f;
#pragma unroll
        for (int i = 0; i < 32; ++i) ss += y[i] * y[i];
        ss += __shfl_xor(ss, 1); const float rstd = 1.0f / sqrtf(ss * (1.0f / 64.0f) + EPS);
#pragma unroll
        for (int i = 0; i < 32; ++i) y[i] = y[i] * rstd * a.knw[l * 64 + half * 32 + i];
        if (half == 0 && valid) {
#pragma unroll
            for (int d = 0; d < 8; ++d) { const float c = cs[(size_t)tokk * 8 + d], s = sn[(size_t)tokk * 8 + d]; const float t1 = y[d], t2 = y[d + 8]; y[d] = t1 * c - t2 * s; y[d + 8] = t2 * c + t1 * s; } }
#pragma unroll
        for (int q = 0; q < 4; ++q) { v4u w; w.x = pk2(y[8 * q], y[8 * q + 1]); w.y = pk2(y[8 * q + 2], y[8 * q + 3]); w.z = pk2(y[8 * q + 4], y[8 * q + 5]); w.w = pk2(y[8 * q + 6], y[8 * q + 7]);
            *(LAS v4u*)(Kl + row * 72 + half * 32 + 8 * q) = w; }
#pragma unroll
        for (int i = 0; i < 32; ++i) VT[(half * 32 + i) * 280 + row] = (bf16)f2bf(vv[i]);
        if (X.tid < 64) {
#pragma unroll
            for (int cc = 256; cc < 280; ++cc) VT[X.tid * 280 + cc] = 0; }
    }
    __syncthreads();
#pragma unroll 1
    for (int task = X.wave; task < 32; task += 8) {
        const int g = task >> 3, rg = task & 7, r0 = 16 * rg, head = kvh * 4 + g; const int tokq = tok0 + r0 + c16;
        const float sink = a.sinks[l * 8 + head];
        float qv[16];
        { const bf16* qp = proj + (size_t)tokq * NPROJ + C_AQ + head * 64; const v4u w0 = *(const v4u*)(qp + 8 * quad), w1 = *(const v4u*)(qp + 32 + 8 * quad);
          qv[0] = bflo(w0.x); qv[1] = bfhi(w0.x); qv[2] = bflo(w0.y); qv[3] = bfhi(w0.y); qv[4] = bflo(w0.z); qv[5] = bfhi(w0.z); qv[6] = bflo(w0.w); qv[7] = bfhi(w0.w);
          qv[8] = bflo(w1.x); qv[9] = bfhi(w1.x); qv[10] = bflo(w1.y); qv[11] = bfhi(w1.y); qv[12] = bflo(w1.z); qv[13] = bfhi(w1.z); qv[14] = bflo(w1.w); qv[15] = bfhi(w1.w); }
        float ss = 0.f;
#pragma unroll
        for (int i = 0; i < 16; ++i) ss += qv[i] * qv[i];
        ss += __shfl_xor(ss, 16); ss += __shfl_xor(ss, 32); const float rstd = 1.0f / sqrtf(ss * (1.0f / 64.0f) + EPS);
#pragma unroll
        for (int i = 0; i < 8; ++i) { qv[i] = qv[i] * rstd * a.qnw[l * 64 + 8 * quad + i]; qv[8 + i] = qv[8 + i] * rstd * a.qnw[l * 64 + 32 + 8 * quad + i]; }
#pragma unroll
        for (int d = 0; d < 8; ++d) { const float other = __shfl_xor(qv[d], 16); const float c = cs[(size_t)tokq * 8 + d], s = sn[(size_t)tokq * 8 + d];
            if (quad == 0) qv[d] = qv[d] * c - other * s; else if (quad == 1) qv[d] = qv[d] * c + other * s; }
        bf16x8 qf[2];
        { v4u w; w.x = pk2(qv[0], qv[1]); w.y = pk2(qv[2], qv[3]); w.z = pk2(qv[4], qv[5]); w.w = pk2(qv[6], qv[7]); qf[0] = __builtin_bit_cast(bf16x8, w);
          w.x = pk2(qv[8], qv[9]); w.y = pk2(qv[10], qv[11]); w.z = pk2(qv[12], qv[13]); w.w = pk2(qv[14], qv[15]); qf[1] = __builtin_bit_cast(bf16x8, w); }
        f32x4 sacc[9];
#pragma unroll
        for (int i = 0; i < 9; ++i) { const LAS bf16* kr = Kl + (16 * (rg + i) + c16) * 72 + 8 * quad;
            const bf16x8 k0 = *(const LAS bf16x8*)kr, k1 = *(const LAS bf16x8*)(kr + 32);
            f32x4 z = {0.f, 0.f, 0.f, 0.f}; z = __builtin_amdgcn_mfma_f32_16x16x32_bf16(k0, qf[0], z, 0, 0, 0); sacc[i] = __builtin_amdgcn_mfma_f32_16x16x32_bf16(k1, qf[1], z, 0, 0, 0); }
        int dbase = 4 * quad - c16; asm volatile("" : "+v"(dbase)); int kbase = 16 * rg + 4 * quad; asm volatile("" : "+v"(kbase)); float mx = sink;
#pragma unroll
        for (int i = 0; i < 9; ++i)
#pragma unroll
            for (int j = 0; j < 4; ++j) { const int dlt = dbase + 16 * i + j; const int kj = kbase + 16 * i + j; const bool ok = (dlt > 0) && (dlt <= 128) && ((nb > 0) || (kj >= 128));
                const float s = ok ? sacc[i][j] * 0.125f : -3.0e38f; sacc[i][j] = s; mx = fmaxf(mx, s); }
        mx = fmaxf(mx, __shfl_xor(mx, 16)); mx = fmaxf(mx, __shfl_xor(mx, 32));
        float sum = 0.f;
#pragma unroll
        for (int i = 0; i < 9; ++i)
#pragma unroll
            for (int j = 0; j < 4; ++j) { const float p = (sacc[i][j] > -1.0e38f) ? __expf(sacc[i][j] - mx) : 0.f; sacc[i][j] = p; sum += p; }
        sum += __shfl_xor(sum, 16); sum += __shfl_xor(sum, 32);
        const float inv = 1.0f / (sum + __expf(sink - mx));
        f32x4 oacc[4];
#pragma unroll
        for (int et = 0; et < 4; ++et) oacc[et] = (f32x4){0.f, 0.f, 0.f, 0.f};
#pragma unroll
        for (int kk = 0; kk < 5; ++kk) {
            v4u pw; pw.x = pk2(sacc[2 * kk][0], sacc[2 * kk][1]); pw.y = pk2(sacc[2 * kk][2], sacc[2 * kk][3]);
            if (2 * kk + 1 < 9) { pw.z = pk2(sacc[(2 * kk + 1 < 9) ? 2 * kk + 1 : 0][0], sacc[(2 * kk + 1 < 9) ? 2 * kk + 1 : 0][1]); pw.w = pk2(sacc[(2 * kk + 1 < 9) ? 2 * kk + 1 : 0][2], sacc[(2 * kk + 1 < 9) ? 2 * kk + 1 : 0][3]); } else { pw.z = 0u; pw.w = 0u; }
            const bf16x8 pf = __builtin_bit_cast(bf16x8, pw);
#pragma unroll
            for (int et = 0; et < 4; ++et) { const LAS bf16* vr = VT + (16 * et + c16) * 280 + 16 * rg + 32 * kk + 4 * quad;
                const v2u lo = *(const LAS v2u*)vr, hi = *(const LAS v2u*)(vr + 16); v4u vw; vw.x = lo.x; vw.y = lo.y; vw.z = hi.x; vw.w = hi.y;
                oacc[et] = __builtin_amdgcn_mfma_f32_16x16x32_bf16(__builtin_bit_cast(bf16x8, vw), pf, oacc[et], 0, 0, 0); }
        }
#pragma unroll
        for (int et = 0; et < 4; ++et) { v2u w; w.x = pk2(oacc[et][0] * inv, oacc[et][1] * inv); w.y = pk2(oacc[et][2] * inv, oacc[et][3] * inv);
            *(v2u*)(ao + (size_t)tokq * 512 + head * 64 + 16 * et + 4 * quad) = w; }
    }
    __syncthreads();
}

constexpr int ML_Q = 0, ML_K = 17408, ML_KET = 34816, ML_VT = 53248, ML_CT = 73984, ML_CW = 113152, ML_CB = 118272, ML_RED = 118784, ML_NW = 119296;
template <bool L3> DI void mlstm_unit(const Args& a, const Ctx& X, int l, int unit) {
    unsigned char* ws = a.ws; const bf16* proj = (const bf16*)(ws + WS_PROJ); bf16* hm = (bf16*)(ws + WS_H) + (size_t)T * 512;
    const float* gates = (const float*)(ws + WS_GATES); float* mlc = (float*)(ws + WS_MLC) + (size_t)unit * 18432; float* mlb = (float*)(ws + WS_MLB);
    const int seq = unit >> 5, sj = unit & 31, b = seq >> 2, hh = seq & 3; const int tokbase = b * SEQ + sj * 512;
    LAS bf16* Qs = (LAS bf16*)(X.lds + ML_Q); LAS bf16* Ks = (LAS bf16*)(X.lds + ML_K); LAS bf16* KET = (LAS bf16*)(X.lds + ML_KET);
    LAS bf16* VT = (LAS bf16*)(X.lds + ML_VT); LAS bf16* CT = (LAS bf16*)(X.lds + ML_CT); LAS float* CW = (LAS float*)(X.lds + ML_CW);
    LAS float* CB = (LAS float*)(X.lds + ML_CB); LAS float* RED = (LAS float*)(X.lds + ML_RED); LAS float* NW = (LAS float*)(X.lds + ML_NW);
    int lane = X.lane; asm volatile("" : "+v"(lane));
    const int c16 = lane & 15, quad = lane >> 4, w = X.wave;
    for (int idx = X.tid; idx < 1280; idx += 512) { const int tap = idx >> 8, ch = idx & 255; const int gch = (ch < 128) ? (hh * 128 + ch) : (512 + hh * 128 + (ch - 128));
        CW[idx] = (tap < 4) ? a.conv_w[(size_t)(l * 4 + tap) * 1024 + gch] : a.conv_b[l * 1024 + gch]; }
    for (int idx = X.tid; idx < 16 * 72; idx += 512) VT[128 * 72 + idx] = (idx < 72) ? (bf16)0x3F80 : (bf16)0;
    if (X.tid < 128) NW[X.tid] = a.mnw[l * 512 + hh * 128 + X.tid];
    f32x4 cacc[9];
#pragma unroll
    for (int et = 0; et < 9; ++et) {
        if (L3) {
#pragma unroll
            for (int j = 0; j < 4; ++j) { const float v = mlc[(16 * et + 4 * quad + j) * 128 + 16 * w + c16]; cacc[et][j] = v; CT[(16 * et + 4 * quad + j) * 136 + 16 * w + c16] = (bf16)f2bf(v); }
        } else cacc[et] = (f32x4){0.f, 0.f, 0.f, 0.f};
    }
    float bsum = 0.f;
    __syncthreads();
#pragma unroll 1
    for (int c = 0; c < 8; ++c) {
        const int tok0 = tokbase + c * 64;
        float bsc = gates[(size_t)(tok0 + lane) * 8 + 4 + hh]; const float li = gates[(size_t)(tok0 + lane) * 8 + hh];
#pragma unroll
        for (int o = 1; o < 64; o <<= 1) { const float v = __shfl_up(bsc, o); if (lane >= o) bsc += v; }
        const float bl = __shfl(bsc, 63); const float csv = li - bsc;
        if (w == 0) { CB[lane] = bsc; CB[64 + lane] = csv; }
        bsum += bl;
        { const int t = X.tid >> 3, dc = X.tid & 7; const float fac = __expf(bl + __shfl(csv, t));
          const int tokt = tok0 + t;
#pragma unroll
          for (int qk = (L3 ? 0 : 1); qk < 2; ++qk) {
              float accv[16];
#pragma unroll
              for (int i = 0; i < 16; ++i) accv[i] = CW[4 * 256 + qk * 128 + 16 * dc + i];
#pragma unroll
              for (int j = 0; j < 4; ++j) { const int tt = tokt - 3 + j;
                  if (tt >= b * SEQ) { const v4u* p = (const v4u*)(proj + (size_t)tt * NPROJ + (qk ? C_MK : C_MQ) + hh * 128 + 16 * dc); const v4u w0 = p[0], w1 = p[1];
                      const float xv[16] = {bflo(w0.x), bfhi(w0.x), bflo(w0.y), bfhi(w0.y), bflo(w0.z), bfhi(w0.z), bflo(w0.w), bfhi(w0.w), bflo(w1.x), bfhi(w1.x), bflo(w1.y), bfhi(w1.y), bflo(w1.z), bfhi(w1.z), bflo(w1.w), bfhi(w1.w)};
#pragma unroll
                      for (int i = 0; i < 16; ++i) accv[i] += CW[j * 256 + qk * 128 + 16 * dc + i] * xv[i]; } }
#pragma unroll
              for (int i = 0; i < 16; ++i) { const float z = accv[i]; accv[i] = z / (1.0f + __expf(-z)) * (qk ? 0.08838834764831845f : 1.0f); }
              if (L3) { LAS bf16* dst = (qk ? Ks : Qs) + t * 136 + 16 * dc;
                  v4u o0, o1; o0.x = pk2(accv[0], accv[1]); o0.y = pk2(accv[2], accv[3]); o0.z = pk2(accv[4], accv[5]); o0.w = pk2(accv[6], accv[7]);
                  o1.x = pk2(accv[8], accv[9]); o1.y = pk2(accv[10], accv[11]); o1.z = pk2(accv[12], accv[13]); o1.w = pk2(accv[14], accv[15]);
                  *(LAS v4u*)dst = o0; *(LAS v4u*)(dst + 8) = o1; }
              if (qk) {
#pragma unroll
                  for (int i = 0; i < 16; ++i) KET[(16 * dc + i) * 72 + t] = (bf16)f2bf(accv[i] * fac); }
          }
          { const v4u* p = (const v4u*)(proj + (size_t)tokt * NPROJ + C_MV + hh * 128 + 16 * dc); const v4u w0 = p[0], w1 = p[1];
            const unsigned ww[8] = {w0.x, w0.y, w0.z, w0.w, w1.x, w1.y, w1.z, w1.w};
#pragma unroll
            for (int i = 0; i < 8; ++i) { VT[(16 * dc + 2 * i) * 72 + t] = (bf16)(ww[i] & 0xffffu); VT[(16 * dc + 2 * i + 1) * 72 + t] = (bf16)(ww[i] >> 16); } }
        }
        __syncthreads();
        float hval[4][4]; int tt_ = w & 3, eh = w >> 2; const int tq = 16 * tt_ + c16;
        if (L3) {
            bf16x8 qf[4];
#pragma unroll
            for (int ks = 0; ks < 4; ++ks) qf[ks] = *(const LAS bf16x8*)(Qs + tq * 136 + 32 * ks + 8 * quad);
            f32x4 sacc[4];
#pragma unroll
            for (int st = 0; st < 4; ++st) { f32x4 z = {0.f, 0.f, 0.f, 0.f};
#pragma unroll
                for (int ks = 0; ks < 4; ++ks) z = __builtin_amdgcn_mfma_f32_16x16x32_bf16(*(const LAS bf16x8*)(Ks + (16 * st + c16) * 136 + 32 * ks + 8 * quad), qf[ks], z, 0, 0, 0);
                sacc[st] = z; }
            const float cbt = CB[tq];
#pragma unroll
            for (int st = 0; st < 4; ++st)
#pragma unroll
                for (int j = 0; j < 4; ++j) { const int s = 16 * st + 4 * quad + j; const float d = (s <= tq) ? __expf(cbt + CB[64 + s]) : 0.f; sacc[st][j] *= d; }
            bf16x8 pf[2];
#pragma unroll
            for (int kk = 0; kk < 2; ++kk) { v4u pw; pw.x = pk2(sacc[2 * kk][0], sacc[2 * kk][1]); pw.y = pk2(sacc[2 * kk][2], sacc[2 * kk][3]); pw.z = pk2(sacc[2 * kk + 1][0], sacc[2 * kk + 1][1]); pw.w = pk2(sacc[2 * kk + 1][2], sacc[2 * kk + 1][3]); pf[kk] = __builtin_bit_cast(bf16x8, pw); }
            const float ebt = __expf(cbt);
            f32x4 nn[5];
#pragma unroll
            for (int x = 0; x < 5; ++x) { const int et = (x < 4) ? (4 * eh + x) : 8; f32x4 na = {0.f, 0.f, 0.f, 0.f}, ia = {0.f, 0.f, 0.f, 0.f};
#pragma unroll
                for (int kk = 0; kk < 2; ++kk) { const LAS bf16* vr = VT + (16 * et + c16) * 72 + 32 * kk + 4 * quad; const v2u lo = *(const LAS v2u*)vr, hi = *(const LAS v2u*)(vr + 16); v4u vw; vw.x = lo.x; vw.y = lo.y; vw.z = hi.x; vw.w = hi.y;
                    na = __builtin_amdgcn_mfma_f32_16x16x32_bf16(__builtin_bit_cast(bf16x8, vw), pf[kk], na, 0, 0, 0); }
#pragma unroll
                for (int ks = 0; ks < 4; ++ks) ia = __builtin_amdgcn_mfma_f32_16x16x32_bf16(*(const LAS bf16x8*)(CT + (16 * et + c16) * 136 + 32 * ks + 8 * quad), qf[ks], ia, 0, 0, 0);
                nn[x] = na + ia * ebt; }
            const float den = __shfl(nn[4][0], c16); const float inv = 1.0f / fmaxf(fabsf(den), 1.0f);
            float ss = 0.f;
#pragma unroll
            for (int x = 0; x < 4; ++x)
#pragma unroll
                for (int j = 0; j < 4; ++j) { hval[x][j] = nn[x][j] * inv; ss += hval[x][j] * hval[x][j]; }
            ss += __shfl_xor(ss, 16); ss += __shfl_xor(ss, 32);
            if (quad == 0) RED[eh * 64 + tq] = ss;
            __syncthreads();
            const float rstd = 1.0f / sqrtf((RED[tq] + RED[64 + tq]) * (1.0f / 128.0f) + EPS);
#pragma unroll
            for (int x = 0; x < 4; ++x) { const int e = 16 * (4 * eh + x) + 4 * quad; const v2u og = *(const v2u*)(proj + (size_t)(tok0 + tq) * NPROJ + C_MO + hh * 128 + e);
                const float y0 = hval[x][0] * rstd * NW[e] * bflo(og.x), y1 = hval[x][1] * rstd * NW[e + 1] * bfhi(og.x), y2 = hval[x][2] * rstd * NW[e + 2] * bflo(og.y), y3 = hval[x][3] * rstd * NW[e + 3] * bfhi(og.y);
                v2u o; o.x = pk2(y0, y1); o.y = pk2(y2, y3); *(v2u*)(hm + (size_t)(tok0 + tq) * 512 + hh * 128 + e) = o; }
        }
        { const float ebl = __expf(bl);
          bf16x8 kf[2];
#pragma unroll
          for (int kk = 0; kk < 2; ++kk) kf[kk] = *(const LAS bf16x8*)(KET + (16 * w + c16) * 72 + 32 * kk + 8 * quad);
#pragma unroll
          for (int et = 0; et < 9; ++et) { f32x4 z = cacc[et] * ebl;
#pragma unroll
              for (int kk = 0; kk < 2; ++kk) z = __builtin_amdgcn_mfma_f32_16x16x32_bf16(*(const LAS bf16x8*)(VT + (16 * et + c16) * 72 + 32 * kk + 8 * quad), kf[kk], z, 0, 0, 0);
              cacc[et] = z;
              if (L3) {
#pragma unroll
                  for (int j = 0; j < 4; ++j) CT[(16 * et + 4 * quad + j) * 136 + 16 * w + c16] = (bf16)f2bf(z[j]); } } }
        __syncthreads();
    }
    if (!L3) {
#pragma unroll
        for (int et = 0; et < 9; ++et)
#pragma unroll
            for (int j = 0; j < 4; ++j) mlc[(16 * et + 4 * quad + j) * 128 + 16 * w + c16] = cacc[et][j];
        if (X.tid == 0) mlb[unit] = bsum;
    }
}
DI void mlstm_scan(const Args& a, const Ctx& X) {
    float* mlc = (float*)(a.ws + WS_MLC); const float* mlb = (const float*)(a.ws + WS_MLB);
    for (int idx = X.bid * 512 + X.tid; idx < 8 * 18432; idx += X.G * 512) { const int seq = idx / 18432, el = idx - seq * 18432; float carry = 0.f;
        float* p0 = mlc + (size_t)seq * 32 * 18432 + el; float v[32], dcy[32];
#pragma unroll
        for (int j = 0; j < 32; ++j) { v[j] = p0[(size_t)j * 18432]; dcy[j] = mlb[seq * 32 + j]; }
#pragma unroll
        for (int j = 0; j < 32; ++j) { p0[(size_t)j * 18432] = carry; carry = __expf(dcy[j]) * carry + v[j]; } }
}

DI void p6_norm_route(const Args& a, const Ctx& X, int l, const float* xin) {
    unsigned char* ws = a.ws;
    LAS float* wr = (LAS float*)X.lds;
    for (int idx = X.tid; idx < 16384; idx += 512) { const int k = idx >> 4, e = idx & 15; wr[e * 1024 + k] = a.router_w[idx]; }
    __syncthreads();
    const float* mod = (const float*)(ws + WS_MOD); bf16* hb = (bf16*)(ws + WS_H); float* tgate = (float*)(ws + WS_TGATE); int* tokl = (int*)(ws + WS_TOKL);
    unsigned* cnt = (unsigned*)(ws + WS_CTL) + CW_CNT + l * 2048;
    LAS int* hist = (LAS int*)(X.lds + 65536); LAS int* cbase = hist + 32;
    const int gw = X.bid * 8 + X.wave, NGW = X.G * 8;
    for (int it = 0; it * NGW < T / 16; ++it) {
        const int rg = it * NGW + gw; const bool act = rg < T / 16;
        if (X.tid < 32) hist[X.tid] = 0;
        __syncthreads();
        const int row0 = (act ? rg : 0) * 16, b = row0 >> 14;
        const float* mb = mod + (size_t)(l * 2 + b) * 6144;
        f32x4 aw[4], sh[4];
#pragma unroll
        for (int j = 0; j < 4; ++j) { const int k = 256 * j + 4 * X.lane; const f32x4 nw = *(const f32x4*)(a.nfw + l * D + k); const f32x4 sc = *(const f32x4*)(mb + 4 * 1024 + k); aw[j] = nw * (sc + 1.0f); sh[j] = *(const f32x4*)(mb + 3 * 1024 + k); }
        int my_cls = 0; float my_ga = 0.f, my_gb = 0.f;
        f32x4 pre[4][4];
#pragma unroll
        for (int q = 0; q < 4; ++q) { const f32x4* xp = (const f32x4*)(xin + (size_t)(row0 + q) * D) + X.lane;
#pragma unroll
            for (int j = 0; j < 4; ++j) pre[q][j] = xp[64 * j]; }
#pragma unroll 1
        for (int rb = 0; rb < 16; rb += 4) {
#pragma unroll
          for (int q = 0; q < 4; ++q) { const int r = rb + q; const int row = row0 + r;
            f32x4 v[4]; float ss = 0.f;
#pragma unroll
            for (int j = 0; j < 4; ++j) v[j] = pre[q][j];
            if (rb + 4 < 16) { const f32x4* xp = (const f32x4*)(xin + (size_t)(row + 4) * D) + X.lane;
#pragma unroll
                for (int j = 0; j < 4; ++j) pre[q][j] = xp[64 * j]; }
#pragma unroll
            for (int j = 0; j < 4; ++j) ss += (v[j].x * v[j].x + v[j].y * v[j].y) + (v[j].z * v[j].z + v[j].w * v[j].w);
            ss = wave_sum(ss); const float rstd = 1.0f / sqrtf(ss * (1.0f / D) + EPS);
            unsigned long long* o8 = (unsigned long long*)(hb + (size_t)row * D) + X.lane;
#pragma unroll
            for (int j = 0; j < 4; ++j) { v[j] = v[j] * rstd * aw[j] + sh[j]; o8[64 * j] = (unsigned long long)pk2(v[j].x, v[j].y) | ((unsigned long long)pk2(v[j].z, v[j].w) << 32); }
            float sc[16], sel[16];
#pragma unroll
            for (int e = 0; e < 16; ++e) { float p = 0.f;
#pragma unroll
                for (int j = 0; j < 4; ++j) { const f32x4 wv = *(const LAS f32x4*)(wr + e * 1024 + 256 * j + 4 * X.lane); p += (v[j].x * wv.x + v[j].y * wv.y) + (v[j].z * wv.z + v[j].w * wv.w); }
                p = wave_sum(p); sc[e] = 1.0f / (1.0f + __expf(-p)); sel[e] = sc[e] + a.router_b[e]; __builtin_amdgcn_sched_barrier(0); }
            int gi = 0; float gbest = -1.0e30f;
#pragma unroll
            for (int g = 0; g < 4; ++g) { const float p0 = sel[4 * g], p1 = sel[4 * g + 1], p2 = sel[4 * g + 2], p3 = sel[4 * g + 3];
                const float gs = fmaxf(fmaxf(fmaxf(p0 + p1, p0 + p2), fmaxf(p0 + p3, p1 + p2)), fmaxf(p1 + p3, p2 + p3));
                if (gs > gbest) { gbest = gs; gi = g; } }
            float qs[4], s4[4];
#pragma unroll
            for (int i = 0; i < 4; ++i) { qs[i] = 0.f; s4[i] = 0.f; }
#pragma unroll
            for (int g = 0; g < 4; ++g) if (g == gi) {
#pragma unroll
                for (int i = 0; i < 4; ++i) { qs[i] = sel[4 * g + i]; s4[i] = sc[4 * g + i]; } }
            int i1 = 0; float b1 = qs[0];
#pragma unroll
            for (int i = 1; i < 4; ++i) if (qs[i] > b1) { b1 = qs[i]; i1 = i; }
            int i2 = -1; float b2 = -1.0e30f;
#pragma unroll
            for (int i = 0; i < 4; ++i) if (i != i1 && qs[i] > b2) { b2 = qs[i]; i2 = i; }
            const int ia = (i1 < i2) ? i1 : i2, ib = (i1 < i2) ? i2 : i1;
            float sa = 0.f, sb = 0.f;
#pragma unroll
            for (int i = 0; i < 4; ++i) { if (i == ia) sa = s4[i]; if (i == ib) sb = s4[i]; }
            const int pidx = (ia == 0) ? (ib - 1) : ((ia == 1) ? (ib + 1) : 5);
            const float inv = 1.0f / (sa + sb);
            if (X.lane == r) { my_cls = gi * 6 + pidx; my_ga = sa * inv; my_gb = sb * inv; }
          }
        }
        int rank = 0;
        if (act && X.lane < 16) rank = __hip_atomic_fetch_add(hist + my_cls, 1, __ATOMIC_RELAXED, __HIP_MEMORY_SCOPE_WORKGROUP);
        __syncthreads();
        if (X.tid < NCLS) { const int n = hist[X.tid]; cbase[X.tid] = n ? (int)__hip_atomic_fetch_add(cnt + 64 * X.tid, (unsigned)n, RLX_AGENT) : 0; }
        __syncthreads();
        if (act && X.lane < 16) { const int tok = row0 + X.lane; const int pos = cbase[my_cls] + rank;
            tokl[my_cls * CLS_CAP + pos] = tok; tgate[tok * 2] = my_ga; tgate[tok * 2 + 1] = my_gb; }
        __syncthreads();
    }
}
DI MoeTab moe_tables(const Args& a, const Ctx& X, int l) {
    LAS int* tab = (LAS int*)(X.lds + TAB_OFF); LAS int* tcls = tab; LAS int* tpos = tab + 160; LAS int* cn = tab + 320; LAS int* rt_ = tab + 344;
    unsigned* cnt = (unsigned*)(a.ws + WS_CTL) + CW_CNT + l * 2048;
    if (X.tid < NCLS) cn[X.tid] = (int)__hip_atomic_load(cnt + 64 * X.tid, RLX_AGENT);
    __syncthreads();
    if (X.tid == 0) { int r = 0;
#pragma unroll 1
        for (int c = 0; c < NCLS; ++c) { const int n = (cn[c] + 255) >> 8;
#pragma unroll 1
            for (int i = 0; i < n; ++i) { tcls[r] = c; tpos[r] = i * 256; ++r; } }
        rt_[0] = r; }
    __syncthreads();
    MoeTab tb; tb.tcls = tcls; tb.tpos = tpos; tb.cnt = cn; tb.Rtot = __builtin_amdgcn_readfirstlane(rt_[0]); return tb;
}

#if defined(__HIP_DEVICE_COMPILE__)
DI Args load_args() { auto p = __builtin_amdgcn_kernarg_segment_ptr(); asm volatile("" : "+s"(p)); return *(const __attribute__((address_space(4))) Args*)p; }
#else
DI Args load_args() { return Args{}; }
#endif
__global__ void __launch_bounds__(512, 2) fwd(Args a_unused) {
    extern __shared__ __attribute__((aligned(16))) unsigned char lds_raw[];
    Ctx X; X.lds = (LAS unsigned char*)lds_raw; X.tid = threadIdx.x; X.lane = X.tid & 63; X.wave = __builtin_amdgcn_readfirstlane(X.tid >> 6); X.G = gridDim.x; X.bid = blockIdx.x;
    volatile LAS unsigned* MISC = (volatile LAS unsigned*)(X.lds + MISC_OFF);
    if (X.tid < 64) MISC[X.tid] = 0u;
    __syncthreads();
    int lo, hi; unsigned* ctl;
    { const Args a = load_args(); lo = a.ph_lo; hi = a.ph_hi; ctl = (unsigned*)(a.ws + WS_CTL); }
    XcdBarrier bar; bar.bar = ctl + CW_BAR; bar.x = 0; bar.st = MISC + 8;
    if (hi - lo > 1) bar = xcd_barrier_post(ctl + CW_BAR, MISC + 8);
#ifndef PH_MASK
#define PH_MASK 0xFFFFF
#endif
#define PON(p) ((PH_MASK >> (p)) & 1)
#ifndef DUP_MASK
#define DUP_MASK 0
#endif
#define NREP(p) (((DUP_MASK >> (p)) & 1) ? 2 : 1)
#ifndef TSEL_MASK
#define TSEL_MASK 0
#endif
#define TSCALE 4
#define TSEL(p) ((TSEL_MASK >> (p)) & 1)
#define IN(k) (lo <= (k) && (k) < hi)
#define SEAM(k) do { if (IN(k) && IN((k) + 1)) xcd_barrier(bar); } while (0)
    unsigned long long tacc = 0ull, tph = 0ull;
#define TBEG() do { if (TSEL_MASK) tph = __builtin_amdgcn_s_memrealtime(); } while (0)
#define TEND(p) do { if (TSEL(p)) tacc += __builtin_amdgcn_s_memrealtime() - tph; } while (0)
    TBEG();
    if (PON(10) && IN(0)) { for (int rep = 0; rep < NREP(10); ++rep) { const Args a = load_args(); p0_prologue(a, X); } }
    SEAM(0); TEND(10);
    TBEG();
    for (int l = 0; l < NL; ++l) {
        const int g0 = 1 + l * NPH;
        if (PON(0) && IN(g0 + 0)) { for (int rep = 0; rep < NREP(0); ++rep) { const Args a = load_args(); unsigned char* ws = a.ws; const float* mod = (const float*)(ws + WS_MOD); bf16* proj = (bf16*)(ws + WS_PROJ); const float* xin = (l == 0) ? a.x : a.out; (void)mod; (void)proj; (void)xin; const Ctx P = fresh(X); p1_norm_gates(a, P, l, xin); } }
        SEAM(g0 + 0); TEND(0); TBEG();
        if (PON(1) && IN(g0 + 1)) for (int rep = 0; rep < NREP(1); ++rep) { const Args a = load_args(); unsigned char* ws = a.ws; const float* mod = (const float*)(ws + WS_MOD); bf16* proj = (bf16*)(ws + WS_PROJ); const float* xin = (l == 0) ? a.x : a.out; (void)mod; (void)proj; (void)xin; const Ctx P = fresh(X);
            DenseSched S; S.A = (const char*)(ws + WS_H); S.Bt = (const char*)(ws + WS_WIN) + (size_t)l * NPROJ * D * 2; S.lda = D; S.ldb = D; S.ord.init(T / 256, NPROJ / 256, P.G, P.bid);
            EpiProj E; E.O = proj;
            pg8::gemm_phase<EpiProj, DenseSched>(P.lds, D, S, E);
        }
        SEAM(g0 + 1); TEND(1); TBEG();
        if (PON(2) && IN(g0 + 2)) { const Args a = load_args(); unsigned char* ws = a.ws; const float* mod = (const float*)(ws + WS_MOD); bf16* proj = (bf16*)(ws + WS_PROJ); const float* xin = (l == 0) ? a.x : a.out; (void)mod; (void)proj; (void)xin; const Ctx P = fresh(X);
            if (PON(11)) for (int rep = 0; rep < NREP(11); ++rep) {
#pragma unroll 1
                for (int u = P.bid; u < 512; u += P.G) attn_unit(a, P, l, u); }
            if (PON(12)) for (int rep = 0; rep < NREP(12); ++rep) {
#pragma unroll 1
                for (int u = P.bid; u < 256; u += P.G) mlstm_unit<false>(a, P, l, u); }
        }
        SEAM(g0 + 2); TEND(2); TBEG();
        if (PON(3) && IN(g0 + 3)) { const Args a = load_args(); unsigned char* ws = a.ws; const float* mod = (const float*)(ws + WS_MOD); bf16* proj = (bf16*)(ws + WS_PROJ); const float* xin = (l == 0) ? a.x : a.out; (void)mod; (void)proj; (void)xin; const Ctx P = fresh(X); mlstm_scan(a, P); }
        SEAM(g0 + 3); TEND(3); TBEG();
        if (PON(4) && IN(g0 + 4)) for (int rep = 0; rep < NREP(4); ++rep) { const Args a = load_args(); unsigned char* ws = a.ws; const float* mod = (const float*)(ws + WS_MOD); bf16* proj = (bf16*)(ws + WS_PROJ); const float* xin = (l == 0) ? a.x : a.out; (void)mod; (void)proj; (void)xin; const Ctx P = fresh(X);
#pragma unroll 1
            for (int u = P.bid; u < 256; u += P.G) mlstm_unit<true>(a, P, l, u); }
        SEAM(g0 + 4); TEND(4); TBEG();
        if (PON(5) && IN(g0 + 5)) for (int rep = 0; rep < NREP(5); ++rep) { const Args a = load_args(); unsigned char* ws = a.ws; const float* mod = (const float*)(ws + WS_MOD); bf16* proj = (bf16*)(ws + WS_PROJ); const float* xin = (l == 0) ? a.x : a.out; (void)mod; (void)proj; (void)xin; const Ctx P = fresh(X);
            { DenseSched S; S.A = (const char*)(ws + WS_H); S.Bt = (const char*)(ws + WS_WAU) + (size_t)l * D * 512 * 2; S.lda = 512; S.ldb = 512; S.ord.init(T / 256, D / 256, P.G, P.bid);
              EpiGate<false> E; E.P = proj; E.gcol = C_GA; pg8::gemm_phase<EpiGate<false>, DenseSched>(P.lds, 512, S, E); }
            { DenseSched S; S.A = (const char*)(ws + WS_H) + (size_t)T * 512 * 2; S.Bt = (const char*)(ws + WS_WMU) + (size_t)l * D * 512 * 2; S.lda = 512; S.ldb = 512; S.ord.init(T / 256, D / 256, P.G, P.bid);
              EpiGate<true> E; E.P = proj; E.gcol = C_GB; pg8::gemm_phase<EpiGate<true>, DenseSched>(P.lds, 512, S, E); }
        }
        SEAM(g0 + 5); TEND(5); TBEG();
        if (PON(6) && IN(g0 + 6)) for (int rep = 0; rep < NREP(6); ++rep) { const Args a = load_args(); unsigned char* ws = a.ws; const float* mod = (const float*)(ws + WS_MOD); bf16* proj = (bf16*)(ws + WS_PROJ); const float* xin = (l == 0) ? a.x : a.out; (void)mod; (void)proj; (void)xin; const Ctx P = fresh(X);
            DenseSched S; S.A = (const char*)(proj + C_MQ); S.Bt = (const char*)(ws + WS_WOUT) + (size_t)l * D * D * 2; S.lda = NPROJ; S.ldb = D; S.ord.init(T / 256, D / 256, P.G, P.bid);
            EpiRes E; E.xin = xin; E.out = a.out; E.g = mod + (size_t)(l * 2) * 6144 + 2 * 1024; E.rmask = T - 1;
            if (rep) { E.out = (float*)(ws + WS_H); E.rmask = T / 2 - 1; }
            pg8::gemm_phase<EpiRes, DenseSched>(P.lds, D, S, E);
        }
        SEAM(g0 + 6); TEND(6); TBEG();
        if (PON(7) && IN(g0 + 7)) { const Args a = load_args(); unsigned char* ws = a.ws; const float* mod = (const float*)(ws + WS_MOD); bf16* proj = (bf16*)(ws + WS_PROJ); const float* xin = (l == 0) ? a.x : a.out; (void)mod; (void)proj; (void)xin; const Ctx P = fresh(X); p6_norm_route(a, P, l, a.out); }
        SEAM(g0 + 7); TEND(7); TBEG();
        if (PON(8) && IN(g0 + 8)) for (int rep = 0; rep < NREP(8); ++rep) { const Args a = load_args(); unsigned char* ws = a.ws; const float* mod = (const float*)(ws + WS_MOD); bf16* proj = (bf16*)(ws + WS_PROJ); const float* xin = (l == 0) ? a.x : a.out; (void)mod; (void)proj; (void)xin; const Ctx P = fresh(X);
            const MoeTab tb = moe_tables(a, P, l);
            LAS unsigned* tokoff = (LAS unsigned*)(P.lds + TOKOFF_OFF); const int* tokl = (const int*)(ws + WS_TOKL);
#pragma unroll 1
            for (int s = 0; s < 8; ++s) { const int L0 = s * P.G + P.bid;
                if (L0 < tb.Rtot * 8 && P.tid < 256) { const int L = xcd_remap(L0, tb.Rtot * 8); const int rt = L >> 3, cls = tb.tcls[rt], pos = tb.tpos[rt] + P.tid, cn = tb.cnt[cls]; const int tok = tokl[cls * CLS_CAP + (pos < cn ? pos : 0)]; tokoff[s * 256 + P.tid] = (unsigned)tok; } }
            __syncthreads();
            MoeUpSched S; S.A = (const char*)(ws + WS_H); S.W = (const char*)(ws + WS_WGU) + (size_t)l * NE * 1024 * D * 2; S.lda = D; S.ldb = D; S.tb = tb; S.G = P.G; S.c = P.bid; S.tokoff = tokoff;
            EpiSwiglu E; E.H = proj; E.tgate = (const float*)(ws + WS_TGATE); E.tokoff = tokoff;
            pg8::gemm_phase<EpiSwiglu, MoeUpSched>(P.lds, D, S, E);
        }
        SEAM(g0 + 8); TEND(8); TBEG();
        if (PON(9) && IN(g0 + 9)) for (int rep = 0; rep < NREP(9); ++rep) { const Args a = load_args(); unsigned char* ws = a.ws; const float* mod = (const float*)(ws + WS_MOD); bf16* proj = (bf16*)(ws + WS_PROJ); const float* xin = (l == 0) ? a.x : a.out; (void)mod; (void)proj; (void)xin; const Ctx P = fresh(X);
            const MoeTab tb = moe_tables(a, P, l);
            MoeDownSched S; S.A = (const char*)proj; S.W = (const char*)(ws + WS_WD) + (size_t)l * NE * 1024 * FF * 2; S.lda = D; S.ldb = FF; S.tb = tb; S.G = P.G; S.c = P.bid;
            EpiMoeOut E; E.xin = a.out; E.out = a.out; E.g = mod + (size_t)(l * 2) * 6144 + 5 * 1024; E.tokl = (const int*)(ws + WS_TOKL); E.tb = tb; E.rmask = T - 1;
            if (rep) { E.out = (float*)(ws + WS_H); E.rmask = T / 2 - 1; }
            pg8::gemm_phase<EpiMoeOut, MoeDownSched>(P.lds, D, S, E);
        }
        SEAM(g0 + 9); TEND(9); TBEG();
    }
    if (TSEL_MASK && X.bid == 0) { const unsigned long long t1 = __builtin_amdgcn_s_memrealtime(); while (__builtin_amdgcn_s_memrealtime() - t1 < TSCALE * tacc) __builtin_amdgcn_s_sleep(8); }
#undef IN
#undef SEAM
}

extern "C" void kernel_launch(void* const* d_in, const int* in_sizes, int n_in, void* d_out, int out_size, void* d_ws, size_t ws_size, hipStream_t stream) {
    static int grid = 0;
    if (grid == 0) {
        if (n_in != 24 || in_sizes[0] != T * D || out_size != T * D || ws_size < WS_END) { fprintf(stderr, "kernel_launch: unexpected shapes / workspace (n_in %d, ws %zu, need %zu)\n", n_in, ws_size, (size_t)WS_END); grid = -1; return; }
        int dev = 0, cus = 0;
        if (hipGetDevice(&dev) != hipSuccess || hipDeviceGetAttribute(&cus, hipDeviceAttributeMultiprocessorCount, dev) != hipSuccess) { grid = -1; return; }
        if (hipFuncSetAttribute((const void*)fwd, hipFuncAttributeMaxDynamicSharedMemorySize, LDS_BYTES) != hipSuccess) { fprintf(stderr, "kernel_launch: hipFuncSetAttribute failed\n"); grid = -1; return; }
        int per_cu = 0;
        if (hipOccupancyMaxActiveBlocksPerMultiprocessor(&per_cu, (const void*)fwd, 512, LDS_BYTES) != hipSuccess || per_cu < 1) fprintf(stderr, "kernel_launch: occupancy query reports %d\n", per_cu);
        (void)hipGetLastError();
        grid = cus < 256 ? cus : 256;
    }
    if (grid < 0) return;
    (void)hipMemsetAsync((char*)d_ws + WS_CTL, 0, CTL_ZERO_BYTES, stream);
    Args a{};
    a.x = (const float*)d_in[0]; a.c = (const float*)d_in[1]; a.pos = (const int*)d_in[2]; a.ada_w = (const float*)d_in[3]; a.ada_b = (const float*)d_in[4];
    a.nmw = (const float*)d_in[5]; a.nfw = (const float*)d_in[6]; a.w_in = (const float*)d_in[7]; a.b_ig = (const float*)d_in[8]; a.b_fg = (const float*)d_in[9];
    a.qnw = (const float*)d_in[10]; a.knw = (const float*)d_in[11]; a.sinks = (const float*)d_in[12]; a.conv_w = (const float*)d_in[13]; a.conv_b = (const float*)d_in[14];
    a.mnw = (const float*)d_in[15]; a.w_au = (const float*)d_in[16]; a.w_mu = (const float*)d_in[17]; a.w_out = (const float*)d_in[18]; a.router_w = (const float*)d_in[19];
    a.router_b = (const float*)d_in[20]; a.w_gate = (const float*)d_in[21]; a.w_up = (const float*)d_in[22]; a.w_down = (const float*)d_in[23];
    a.out = (float*)d_out; a.ws = (unsigned char*)d_ws;
#if MK_MULTI
    for (int gp = 0; gp < NGP; ++gp) { a.ph_lo = gp; a.ph_hi = gp + 1; hipLaunchKernelGGL(fwd, dim3(grid), dim3(512), LDS_BYTES, stream, a); }
#else
    a.ph_lo = 0; a.ph_hi = NGP; hipLaunchKernelGGL(fwd, dim3(grid), dim3(512), LDS_BYTES, stream, a);
#endif
}
```

```cpp
#include <hip/hip_runtime.h>
#include <cstdio>
#include <cstdint>

#ifndef MK_MULTI
#define MK_MULTI 0
#endif

#define GAS __attribute__((address_space(1)))
#define LAS __attribute__((address_space(3)))
typedef unsigned short bf16;
typedef unsigned v4u __attribute__((ext_vector_type(4)));
typedef unsigned v2u __attribute__((ext_vector_type(2)));
typedef float f32x4 __attribute__((ext_vector_type(4)));
typedef float f32x2 __attribute__((ext_vector_type(2)));
typedef short bf16x8 __attribute__((ext_vector_type(8)));
typedef short bf16x4 __attribute__((ext_vector_type(4)));
#define DI __device__ __forceinline__
#define RLX_AGENT __ATOMIC_RELAXED, __HIP_MEMORY_SCOPE_AGENT
#define LDS_WAIT() asm volatile("s_waitcnt lgkmcnt(0)" ::: "memory")
#define VM_WAIT() asm volatile("s_waitcnt vmcnt(0)" ::: "memory")

constexpr int NB = 2, SEQ = 16384, T = NB * SEQ, D = 1024, NL = 4;
constexpr int DIN_SRC = 4872;
constexpr int NPROJ = 4864;
constexpr int C_AQ = 0, C_AK = 512, C_AV = 640, C_MQ = 768, C_MK = 1280, C_MV = 1792, C_MO = 2304, C_GA = 2816, C_GB = 3840;
constexpr int NE = 16, FF = 512;
constexpr int NCLS = 24, CLS_CAP = 32768;
constexpr float EPS = 1e-6f;
constexpr int NPH = 10;
constexpr int NGP = 1 + NL * NPH;

constexpr size_t MiB = 1u << 20;
constexpr size_t WS_CTL = 0, CTL_ZERO_BYTES = 1 * MiB;
constexpr size_t WS_MOD = 1 * MiB;
constexpr size_t WS_ROPE = 2 * MiB;
constexpr size_t WS_GATES = 4 * MiB;
constexpr size_t WS_TGATE = 5 * MiB;
constexpr size_t WS_TOKL = 6 * MiB;
constexpr size_t WS_MLB = 9 * MiB;
constexpr size_t WS_MLC = 10 * MiB;
constexpr int NPROJW = 5120;
constexpr size_t WS_WIN = 28 * MiB;
constexpr size_t WS_WAU = 68 * MiB;
constexpr size_t WS_WMU = 72 * MiB;
constexpr size_t WS_WOUT = 76 * MiB;
constexpr size_t WS_WGU = 84 * MiB;
constexpr size_t WS_WD = 212 * MiB;
constexpr size_t WS_H = 276 * MiB;
constexpr size_t WS_PROJ = 340 * MiB;
constexpr size_t WS_END = 644 * MiB;

constexpr int CW_TMO = 0;
constexpr int CW_BAR = 4096;
constexpr int CW_CNT = 8192;

constexpr int RING_BYTES = 131072;
constexpr int MISC_OFF = RING_BYTES;
constexpr int TAB_OFF = RING_BYTES + 256;
constexpr int TOKOFF_OFF = RING_BYTES + 2048;
constexpr int LDS_BYTES = 147456;

DI unsigned f2bf(float f) { unsigned u = __builtin_bit_cast(unsigned, f); return (u + 0x7fffu + ((u >> 16) & 1u)) >> 16; }
DI unsigned pk2(float lo, float hi) { return f2bf(lo) | (f2bf(hi) << 16); }
DI float bf2f(unsigned short b) { return __builtin_bit_cast(float, ((unsigned)b) << 16); }
DI float bflo(unsigned w) { return __builtin_bit_cast(float, w << 16); }
DI float bfhi(unsigned w) { return __builtin_bit_cast(float, w & 0xffff0000u); }
DI float wave_sum(float v) {
#pragma unroll
    for (int o = 1; o < 64; o <<= 1) v += __shfl_xor(v, o);
    return v;
}
DI float sigmoidf_(float x) { return __builtin_amdgcn_rcpf(1.0f + __expf(-x)); }

#define XB_TMO      128
#define XB_XCNT(j)  (256  + 64 * (j))
#define XB_XSUB(j)  (1280 + 64 * (j))
#define XB_XGEN(j)  (2304 + 64 * (j))
#define XB_TOP      3328
#define XB_TOPGEN   3392
#define XCD_BAR_WORDS 3456
#define XB_SPIN_CAP (1u << 18)
__device__ __forceinline__ unsigned xb_ld(unsigned* p)              { return __hip_atomic_load(p, __ATOMIC_RELAXED, __HIP_MEMORY_SCOPE_AGENT); }
__device__ __forceinline__ unsigned xb_add(unsigned* p, unsigned v) { return __hip_atomic_fetch_add(p, v, __ATOMIC_RELAXED, __HIP_MEMORY_SCOPE_AGENT); }
__device__ __forceinline__ unsigned xb_xcc_id() { return (unsigned)__builtin_amdgcn_s_getreg((3 << 11) | 20) & 0xFu; }
#define XB_SPIN(cond, bar) do { unsigned _sp = 0; while (cond) { __builtin_amdgcn_s_sleep(1); \
    if ((++_sp & 255u) == 0u) { if (xb_ld(&(bar)[XB_TMO])) break; if (_sp > XB_SPIN_CAP) { atomicAdd(&(bar)[XB_TMO], 1u); break; } } } } while (0)
struct XcdBarrier { unsigned* bar; unsigned x; volatile LAS unsigned* st; };
__device__ __forceinline__ XcdBarrier xcd_barrier_post(unsigned* bar, volatile LAS unsigned* st) {
    XcdBarrier b; b.bar = bar; b.x = xb_xcc_id(); b.st = st;
    if (threadIdx.x == 0) (void)xb_add(&bar[XB_XCNT(b.x)], 1u);
    return b;
}
__device__ __forceinline__ void xcd_barrier_complete(unsigned* bar, unsigned x, unsigned& nloc, unsigned& nx) {
    const unsigned G = gridDim.x * gridDim.y * gridDim.z;
    unsigned sum, cnt, mine, sp = 0u;
    for (;;) {
        sum = 0u; cnt = 0u; mine = 0u;
#pragma unroll
        for (unsigned j = 0; j < 16; ++j) { const unsigned c = xb_ld(&bar[XB_XCNT(j)]); sum += c; cnt += (c > 0u) ? 1u : 0u; mine = (j == x) ? c : mine; }
        if (sum == G) break;
        __builtin_amdgcn_s_sleep(1);
        if ((++sp & 255u) == 0u) { if (xb_ld(&bar[XB_TMO])) break; if (sp > XB_SPIN_CAP) { atomicAdd(&bar[XB_TMO], 1u); break; } }
    }
    nloc = mine > 0u ? mine : 1u; nx = cnt > 0u ? cnt : 1u;
}
__device__ __forceinline__ void xcd_barrier(const XcdBarrier& b) {
    asm volatile("s_waitcnt vmcnt(0)" ::: "memory");
    __syncthreads();
    if (threadIdx.x == 0) {
        unsigned* bar = b.bar;
        __builtin_amdgcn_s_waitcnt(0);
        unsigned nloc = b.st[0], nx = b.st[1];
        if (nloc == 0u) { xcd_barrier_complete(bar, b.x, nloc, nx); b.st[0] = nloc; b.st[1] = nx; }
        const unsigned old = xb_add(&bar[XB_XSUB(b.x)], 1u);
        const unsigned gen = old / nloc;
        if (old + 1u == (gen + 1u) * nloc) {
            __builtin_amdgcn_fence(__ATOMIC_RELEASE, "agent");
            asm volatile("s_waitcnt vmcnt(0)" ::: "memory");
            const unsigned og = xb_add(&bar[XB_TOP], 1u);
            const unsigned tg = og / nx;
            if (og + 1u == (tg + 1u) * nx) xb_add(&bar[XB_TOPGEN], 1u);
            else XB_SPIN(xb_ld(&bar[XB_TOPGEN]) == tg, bar);
            __builtin_amdgcn_fence(__ATOMIC_ACQUIRE, "agent");
            xb_add(&bar[XB_XGEN(b.x)], 1u);
            asm volatile("s_waitcnt vmcnt(0)" ::: "memory");
        } else {
            XB_SPIN(xb_ld(&bar[XB_XGEN(b.x)]) == gen, bar);
            __builtin_amdgcn_fence(__ATOMIC_ACQUIRE, "agent");
            asm volatile("s_waitcnt vmcnt(0)" ::: "memory");
        }
    }
    __syncthreads();
}

namespace pg8 {
constexpr int BM = 256, BK = 64, HALF = 128, HTB = HALF * BK * 2, STAGE_BYTES = 8 * HTB, NXCD = 8, WGM = 8;
__host__ __device__ __forceinline__ int lds_byte(int r, int c) { const int st = (r >> 4) * 2 + (c >> 5), rr = r & 15, cc = c & 31, ob = rr * 64 + cc * 2; return st * 1024 + (ob ^ (((ob >> 9) & 1) << 5)); }
__host__ __device__ __forceinline__ void stage_rc(int b, int& R, int& C) { const int st = b / 1024, sb = b % 1024, swz = sb ^ (((sb >> 9) & 1) << 5); R = (st >> 1) * 16 + swz / 64; C = (st & 1) * 32 + (swz % 64) / 2; }
__host__ __device__ __forceinline__ int perm32(int rho) { const int n = rho >> 4, i = rho & 15; return 8 * (i >> 2) + 4 * n + (i & 3); }

struct Unit { int pm, pn, x0, x1; };

struct TileOrder {
    int nM, nN, nwg, G, c;
    __device__ void init(int nM_, int nN_, int G_, int c_) { nM = nM_; nN = nN_; nwg = nM * nN; G = G_; c = c_; }
    __device__ bool get(int i, int& pm, int& pn) const {
        const long L = (long)i * G + c; if (L >= nwg) return false;
        int wgid = (int)L; { const int q = nwg / NXCD, r = nwg % NXCD, xcd = wgid % NXCD, off = wgid / NXCD; wgid = (xcd < r ? xcd * (q + 1) : r * (q + 1) + (xcd - r) * q) + off; }
        const int nig = WGM * nN, gid = wgid / nig, fm = gid * WGM, gsz = (nM - fm) < WGM ? (nM - fm) : WGM;
        pm = fm + ((wgid % nig) % gsz); pn = (wgid % nig) / gsz; return true;
    }
};

template <class Epi, class Sched>
__device__ __forceinline__ void gemm_phase(LAS unsigned char* lds, const int K, const Sched& S, const Epi& E) {
    int tid = threadIdx.x; asm volatile("" : "+v"(tid));
    const int wid = __builtin_amdgcn_readfirstlane(tid >> 6), lane = tid & 63, wr = wid >> 2, wc = wid & 3, fr = lane & 15, fq = lane >> 4;
    const int nt = K / BK;
    constexpr bool GA = Sched::GATHER; constexpr int KS = Sched::KSPLIT;
    unsigned voffA[2], voffB[2]; int Rst[2], Cst[2];
#pragma unroll
    for (int i = 0; i < 2; ++i) { int R, C; stage_rc(tid * 16 + i * 8192, R, C); const int Rb = Epi::PERM ? ((R & ~31) + perm32(R & 31)) : R;
        voffA[i] = (unsigned)(R * S.lda + C) * 2u; voffB[i] = (unsigned)(Rb * S.ldb + C) * 2u; Rst[i] = R; Cst[i] = C; }
    const size_t kstep = (size_t)(BK * 2);
    const size_t hstepA = (size_t)HALF * S.lda * 2, hstepB = (size_t)HALF * S.ldb * 2;
    const unsigned ldsw = (unsigned)wid * 1024u; const unsigned gmul = (unsigned)S.lda * 2u;
    const int aoff = lds_byte(wr * 64 + fr, fq * 8), boff = lds_byte(wc * 32 + fr, fq * 8);
    unsigned vAc[2], vAn[2];
#define PG8_SA(b, h) (((b) * 2 + (h)) * HTB)
#define PG8_SB(b, h) ((4 + (b) * 2 + (h)) * HTB)
#define PG8_STAGE2(bufoff, gbase, v0, v1) do { \
        __builtin_amdgcn_global_load_lds((const unsigned*)((const char*)(gbase) + (v0)), (LAS unsigned*)(lds + (bufoff) + ldsw), 16, 0, 0); \
        __builtin_amdgcn_global_load_lds((const unsigned*)((const char*)(gbase) + (v1)), (LAS unsigned*)(lds + (bufoff) + ldsw + 8192), 16, 0, 0); } while (0)
#define PG8_STAGE_B(bufoff, ptr, h) PG8_STAGE2(bufoff, (ptr) + (h) * hstepB, voffB[0], voffB[1])
#define PG8_STAGE_A(bufoff, ptr, h, nx) do { if constexpr (GA) { const unsigned _p = (nx) ? vAn[h] : vAc[h]; PG8_STAGE2(bufoff, ptr, (_p & 0xffffu) * gmul + (unsigned)Cst[0] * 2u, (_p >> 16) * gmul + (unsigned)Cst[0] * 2u); } \
        else { PG8_STAGE2(bufoff, (ptr) + (h) * hstepA, voffA[0], voffA[1]); } } while (0)
#define PG8_LDA(dst, b, h) do { _Pragma("unroll") for (int m = 0; m < 4; ++m) _Pragma("unroll") for (int k = 0; k < 2; ++k) dst[m][k] = *(const LAS bf16x8*)(lds + PG8_SA(b, h) + aoff + m * 2048 + k * 1024); } while (0)
#define PG8_LDB(dst, b, h) do { _Pragma("unroll") for (int n = 0; n < 2; ++n) _Pragma("unroll") for (int k = 0; k < 2; ++k) dst[n][k] = *(const LAS bf16x8*)(lds + PG8_SB(b, h) + boff + n * 2048 + k * 1024); } while (0)
#define PG8_MMA(ai, bj, At, Bt) do { __builtin_amdgcn_s_setprio(1); _Pragma("unroll") for (int m = 0; m < 4; ++m) _Pragma("unroll") for (int n = 0; n < 2; ++n) _Pragma("unroll") for (int k = 0; k < 2; ++k) \
        acc[ai][bj][m][n] = __builtin_amdgcn_mfma_f32_16x16x32_bf16(Bt[n][k], At[m][k], acc[ai][bj][m][n], 0, 0, 0); __builtin_amdgcn_s_setprio(0); } while (0)
#define PG8_WAIT_V(n) asm volatile("s_waitcnt vmcnt(" #n ")" ::: "memory")
#define PG8_WAIT_L(n) asm volatile("s_waitcnt lgkmcnt(" #n ")" ::: "memory")
#define PG8_BAR __builtin_amdgcn_s_barrier()
#define PG8_SCHED __builtin_amdgcn_sched_barrier(0)
#define PG8_GOFF(dst, u) do { if constexpr (GA) { _Pragma("unroll") for (int h = 0; h < 2; ++h) dst[h] = S.a_rowoff(u, Rst[0] + HALF * h) | (S.a_rowoff(u, Rst[0] + 64 + HALF * h) << 16); } } while (0)
    Unit cur, nxt; int ui = 0;
    if (!S.next(0, cur)) return;
    f32x4 acc[2][2][4][2];
#pragma unroll
    for (int a = 0; a < 2; ++a)
#pragma unroll
        for (int b = 0; b < 2; ++b)
#pragma unroll
            for (int m = 0; m < 4; ++m)
#pragma unroll
                for (int n = 0; n < 2; ++n) acc[a][b][m][n] = (f32x4){0.f, 0.f, 0.f, 0.f};
    bf16x8 At[4][2], B0[2][2], B1[2][2];
    const char* cA = S.a_base(cur); const char* cB0 = S.b_base(cur, 0); const char* cB1 = KS ? S.b_base(cur, 1) : cB0;
    PG8_GOFF(vAc, cur);
    vAn[0] = vAc[0]; vAn[1] = vAc[1];
    PG8_STAGE_B(PG8_SB(0, 0), cB0, 0); PG8_STAGE_B(PG8_SB(0, 1), cB0, 1); PG8_STAGE_A(PG8_SA(0, 0), cA, 0, false); PG8_STAGE_A(PG8_SA(0, 1), cA, 1, false);
    if (wr == 1) PG8_BAR;
    PG8_WAIT_V(2); PG8_BAR;
    PG8_STAGE_B(PG8_SB(1, 0), cB0 + kstep, 0); PG8_STAGE_A(PG8_SA(1, 0), cA + kstep, 0, false); PG8_STAGE_B(PG8_SB(1, 1), cB0 + kstep, 1);
    PG8_WAIT_V(6); PG8_BAR;
    for (;;) {
        const bool has_next = S.next(ui + 1, nxt);
        const char* nA = has_next ? S.a_base(nxt) : cA; const char* nB0 = has_next ? S.b_base(nxt, 0) : cB0; const char* nB1 = (KS && has_next) ? S.b_base(nxt, 1) : (KS ? cB1 : nB0);
        if constexpr (GA) { if (has_next) { PG8_GOFF(vAn, nxt); } }
        for (int t = 0; t < nt; t += 2) {
            const bool last = (t == nt - 2);
            const char* a1 = cA + (size_t)(t + 1) * kstep;
            const char* a2 = last ? nA : cA + (size_t)(t + 2) * kstep;
            const char* b2 = last ? nB0 : ((KS && (t + 2) >= KS) ? cB1 + (size_t)(t + 2 - KS) * kstep : cB0 + (size_t)(t + 2) * kstep);
            const char* a3 = a2 + kstep; const char* b3 = b2 + kstep;
            PG8_LDB(B0, 0, 0); PG8_LDB(B1, 0, 1); PG8_SCHED; PG8_LDA(At, 0, 0); PG8_STAGE_A(PG8_SA(1, 1), a1, 1, false);
            PG8_WAIT_V(8); PG8_WAIT_L(0); PG8_BAR; PG8_MMA(0, 0, At, B0); PG8_MMA(0, 1, At, B1); PG8_BAR; PG8_SCHED;
            PG8_LDA(At, 0, 1); PG8_STAGE_B(PG8_SB(0, 0), b2, 0); PG8_STAGE_B(PG8_SB(0, 1), b2, 1); PG8_STAGE_A(PG8_SA(0, 0), a2, 0, last);
            PG8_WAIT_V(8); PG8_WAIT_L(0); PG8_BAR; PG8_MMA(1, 0, At, B0); PG8_MMA(1, 1, At, B1); PG8_BAR; PG8_SCHED;
            PG8_LDB(B0, 1, 0); PG8_LDB(B1, 1, 1); PG8_SCHED; PG8_LDA(At, 1, 0); PG8_STAGE_A(PG8_SA(0, 1), a2, 1, last);
            PG8_WAIT_V(8); PG8_WAIT_L(0); PG8_BAR; PG8_MMA(0, 0, At, B0); PG8_MMA(0, 1, At, B1); PG8_BAR; PG8_SCHED;
            PG8_LDA(At, 1, 1); PG8_STAGE_B(PG8_SB(1, 0), b3, 0); PG8_STAGE_B(PG8_SB(1, 1), b3, 1); PG8_STAGE_A(PG8_SA(1, 0), a3, 0, last);
            PG8_WAIT_V(8); PG8_WAIT_L(0); PG8_BAR; PG8_MMA(1, 0, At, B0); PG8_MMA(1, 1, At, B1); PG8_BAR; PG8_SCHED;
        }
        if (wr == 0) PG8_BAR;
        { int fr_ = fr, fq_ = fq; asm volatile("" : "+v"(fr_), "+v"(fq_));
          E(acc, cur, wr, wc, fr_, fq_); }
        if (!has_next) break;
#pragma unroll
        for (int a = 0; a < 2; ++a)
#pragma unroll
            for (int b = 0; b < 2; ++b)
#pragma unroll
                for (int m = 0; m < 4; ++m)
#pragma unroll
                    for (int n = 0; n < 2; ++n) acc[a][b][m][n] = (f32x4){0.f, 0.f, 0.f, 0.f};
        cur = nxt; cA = nA; cB0 = nB0; cB1 = nB1; ++ui;
        vAc[0] = vAn[0]; vAc[1] = vAn[1];
        if (wr == 1) PG8_BAR;
    }
    PG8_WAIT_V(0);
    PG8_BAR;
#undef PG8_SA
#undef PG8_SB
#undef PG8_STAGE2
#undef PG8_STAGE_A
#undef PG8_STAGE_B
#undef PG8_LDA
#undef PG8_LDB
#undef PG8_MMA
#undef PG8_WAIT_V
#undef PG8_WAIT_L
#undef PG8_BAR
#undef PG8_SCHED
#undef PG8_GOFF
}
}
using pg8::Unit;

DI unsigned cvt_pk_bf16(float lo, float hi) { unsigned r; asm volatile("v_cvt_pk_bf16_f32 %0, %1, %2" : "=v"(r) : "v"(lo), "v"(hi)); return r; }

struct Args {
    const float* x; const float* c; const int* pos; const float* ada_w; const float* ada_b; const float* nmw; const float* nfw; const float* w_in;
    const float* b_ig; const float* b_fg; const float* qnw; const float* knw; const float* sinks; const float* conv_w; const float* conv_b; const float* mnw;
    const float* w_au; const float* w_mu; const float* w_out; const float* router_w; const float* router_b; const float* w_gate; const float* w_up; const float* w_down;
    float* out; unsigned char* ws; int ph_lo, ph_hi;
};

__constant__ float c_invf[8] = {1.0f, 0.1939227432012558f, 0.03760603070259094f, 0.007292664609849453f, 0.0014142135623842478f, 0.00027424818836152554f, 5.3182957344688475e-05f, 1.0313385246263351e-05f};

struct DenseSched {
    static constexpr bool GATHER = false; static constexpr int KSPLIT = 0;
    const char* A; const char* Bt; int lda, ldb; pg8::TileOrder ord;
    DI bool next(int i, Unit& u) const { int pm, pn; if (!ord.get(i, pm, pn)) return false; u.pm = pm; u.pn = pn; u.x0 = 0; u.x1 = 0; return true; }
    DI const char* a_base(const Unit& u) const { return A + (size_t)u.pm * 256 * lda * 2; }
    DI const char* b_base(const Unit& u, int) const { return Bt + (size_t)u.pn * 256 * ldb * 2; }
    DI unsigned a_rowoff(const Unit&, int) const { return 0u; }
};
struct EpiProj {
    static constexpr bool PERM = true;
    bf16* O; float* gates; const float* big; const float* bfg;
    DI void operator()(const f32x4 (&acc)[2][2][4][2], const Unit& u, int wr, int wc, int fr, int fq) const {
        const int row0 = u.pm * 256 + wr * 64 + fr, col0 = u.pn * 256 + wc * 32 + 8 * fq; const bool sg = u.pn >= 9;
        if (u.pn == 19) {
            if (wc == 0 && fq == 0) {
#pragma unroll
                for (int ai = 0; ai < 2; ++ai)
#pragma unroll
                    for (int m = 0; m < 4; ++m) { const int row = row0 + ai * 128 + m * 16; const f32x4 vi = acc[ai][0][m][0], vf = acc[ai][0][m][1]; f32x4 oi, of;
#pragma unroll
                        for (int j = 0; j < 4; ++j) { oi[j] = vi[j] + big[j]; const float z = vf[j] + bfg[j]; of[j] = fminf(z, 0.f) - log1pf(__expf(-fabsf(z))); }
                        *(f32x4*)(gates + (size_t)row * 8) = oi; *(f32x4*)(gates + (size_t)row * 8 + 4) = of; } }
            return; }
#pragma unroll
        for (int ai = 0; ai < 2; ++ai)
#pragma unroll
            for (int m = 0; m < 4; ++m) { bf16* rowp = O + (size_t)(row0 + ai * 128 + m * 16) * NPROJ + col0;
#pragma unroll
                for (int bj = 0; bj < 2; ++bj) { f32x4 v0 = acc[ai][bj][m][0], v1 = acc[ai][bj][m][1];
                    if (sg) {
#pragma unroll
                        for (int j = 0; j < 4; ++j) { v0[j] = sigmoidf_(v0[j]); v1[j] = sigmoidf_(v1[j]); } }
                    v4u w; w.x = cvt_pk_bf16(v0[0], v0[1]); w.y = cvt_pk_bf16(v0[2], v0[3]); w.z = cvt_pk_bf16(v1[0], v1[1]); w.w = cvt_pk_bf16(v1[2], v1[3]);
                    *(v4u*)(rowp + bj * 128) = w; } }
    }
};
template <bool ADD> struct EpiGate {
    static constexpr bool PERM = true;
    bf16* P; int gcol;
    DI void operator()(const f32x4 (&acc)[2][2][4][2], const Unit& u, int wr, int wc, int fr, int fq) const {
        const int row0 = u.pm * 256 + wr * 64 + fr, col0 = u.pn * 256 + wc * 32 + 8 * fq;
#pragma unroll
        for (int ai = 0; ai < 2; ++ai)
#pragma unroll
            for (int m = 0; m < 4; ++m) { bf16* rowp = P + (size_t)(row0 + ai * 128 + m * 16) * NPROJ + col0;
#pragma unroll
                for (int bj = 0; bj < 2; ++bj) { const f32x4 v0 = acc[ai][bj][m][0], v1 = acc[ai][bj][m][1];
                    const v4u g = *(const v4u*)(rowp + gcol + bj * 128);
                    float o[8] = {bflo(g.x) * v0[0], bfhi(g.x) * v0[1], bflo(g.y) * v0[2], bfhi(g.y) * v0[3], bflo(g.z) * v1[0], bfhi(g.z) * v1[1], bflo(g.w) * v1[2], bfhi(g.w) * v1[3]};
                    if (ADD) { const v4u p = *(const v4u*)(rowp + C_MQ + bj * 128);
                        o[0] += bflo(p.x); o[1] += bfhi(p.x); o[2] += bflo(p.y); o[3] += bfhi(p.y); o[4] += bflo(p.z); o[5] += bfhi(p.z); o[6] += bflo(p.w); o[7] += bfhi(p.w); }
                    v4u w; w.x = cvt_pk_bf16(o[0], o[1]); w.y = cvt_pk_bf16(o[2], o[3]); w.z = cvt_pk_bf16(o[4], o[5]); w.w = cvt_pk_bf16(o[6], o[7]);
                    *(v4u*)(rowp + C_MQ + bj * 128) = w; } }
    }
};
struct EpiRes {
    static constexpr bool PERM = false;
    const float* xin; float* out; const float* g; int rmask;
    DI void operator()(const f32x4 (&acc)[2][2][4][2], const Unit& u, int wr, int wc, int fr, int fq) const {
        const int row0 = u.pm * 256 + wr * 64 + fr, col0 = u.pn * 256 + wc * 32 + 4 * fq; const int b = (u.pm * 256) >> 14;
        f32x4 gv[2][2];
#pragma unroll
        for (int bj = 0; bj < 2; ++bj)
#pragma unroll
            for (int n = 0; n < 2; ++n) gv[bj][n] = *(const f32x4*)(g + b * 6144 + col0 + bj * 128 + n * 16);
#pragma unroll
        for (int ai = 0; ai < 2; ++ai)
#pragma unroll
            for (int m = 0; m < 4; ++m) { const size_t off = (size_t)(row0 + ai * 128 + m * 16) * D + col0; const size_t offo = (size_t)((row0 + ai * 128 + m * 16) & rmask) * D + col0;
#pragma unroll
                for (int bj = 0; bj < 2; ++bj)
#pragma unroll
                    for (int n = 0; n < 2; ++n) { const f32x4 xv = *(const f32x4*)(xin + off + bj * 128 + n * 16);
                        *(f32x4*)(out + offo + bj * 128 + n * 16) = xv + gv[bj][n] * acc[ai][bj][m][n]; } }
    }
};

struct MoeTab { const LAS int* tcls; const LAS int* tpos; const LAS int* cnt; int Rtot; };
DI int xcd_remap(int L, int nwg) { const int q = nwg >> 3, r = nwg & 7, xcd = L & 7, off = L >> 3; return (xcd < r ? xcd * (q + 1) : r * (q + 1) + (xcd - r) * q) + off; }
DI void cls_experts(int cls, int& ea, int& eb) { const int g = cls / 6, p = cls - 6 * g; const int a = (p < 3) ? 0 : ((p < 5) ? 1 : 2); const int b = (p < 3) ? (p + 1) : ((p < 5) ? (p - 1) : 3); ea = 4 * g + a; eb = 4 * g + b; }
struct MoeUpSched {
    static constexpr bool GATHER = true; static constexpr int KSPLIT = 0;
    const char* A; const char* W; int lda, ldb; MoeTab tb; int G, c; const LAS unsigned* tokoff;
    DI bool next(int i, Unit& u) const { const int L0 = i * G + c; if (L0 >= tb.Rtot * 8) return false; const int L = xcd_remap(L0, tb.Rtot * 8); u.pm = L >> 3; u.pn = L & 7; u.x0 = i; u.x1 = __builtin_amdgcn_readfirstlane(tb.tcls[u.pm]); return true; }
    DI const char* a_base(const Unit&) const { return A; }
    DI const char* b_base(const Unit& u, int) const { int ea, eb; cls_experts(u.x1, ea, eb); const int e = (u.pn < 4) ? ea : eb; return W + ((size_t)e * 1024 + (size_t)(u.pn & 3) * 256) * 1024 * 2; }
    DI unsigned a_rowoff(const Unit& u, int r) const { return tokoff[u.x0 * 256 + r]; }
};
struct EpiSwiglu {
    static constexpr bool PERM = true;
    bf16* H; const float* tgate; const LAS unsigned* tokoff;
    DI void operator()(const f32x4 (&acc)[2][2][4][2], const Unit& u, int wr, int wc, int fr, int fq) const {
        const int r0 = wr * 64 + fr; const int hc = (u.pn >> 2) * 512 + (u.pn & 3) * 128 + wc * 32 + 8 * fq; const int gsel = u.pn >> 2;
#pragma unroll
        for (int ai = 0; ai < 2; ++ai)
#pragma unroll
            for (int m = 0; m < 4; ++m) { const int r = r0 + ai * 128 + m * 16; const unsigned tok = tokoff[u.x0 * 256 + r]; const float rg = tgate[tok * 2 + gsel];
                const f32x4 g0 = acc[ai][0][m][0], g1 = acc[ai][0][m][1], u0 = acc[ai][1][m][0], u1 = acc[ai][1][m][1];
                float o[8];
#pragma unroll
                for (int j = 0; j < 4; ++j) { o[j] = g0[j] * sigmoidf_(g0[j]) * u0[j] * rg; o[4 + j] = g1[j] * sigmoidf_(g1[j]) * u1[j] * rg; }
                v4u w; w.x = cvt_pk_bf16(o[0], o[1]); w.y = cvt_pk_bf16(o[2], o[3]); w.z = cvt_pk_bf16(o[4], o[5]); w.w = cvt_pk_bf16(o[6], o[7]);
                *(v4u*)(H + ((size_t)u.pm * 256 + r) * 1024 + hc) = w; }
    }
};
struct MoeDownSched {
    static constexpr bool GATHER = false; static constexpr int KSPLIT = 8;
    const char* A; const char* W; int lda, ldb; MoeTab tb; int G, c;
    DI bool next(int i, Unit& u) const { const int L0 = i * G + c; if (L0 >= tb.Rtot * 4) return false; const int L = xcd_remap(L0, tb.Rtot * 4); u.pm = L >> 2; u.pn = L & 3; u.x0 = __builtin_amdgcn_readfirstlane(tb.tpos[u.pm]); u.x1 = __builtin_amdgcn_readfirstlane(tb.tcls[u.pm]); return true; }
    DI const char* a_base(const Unit& u) const { return A + (size_t)u.pm * 256 * lda * 2; }
    DI const char* b_base(const Unit& u, int half) const { int ea, eb; cls_experts(u.x1, ea, eb); const int e = half ? eb : ea; return W + ((size_t)e * 1024 + (size_t)u.pn * 256) * 512 * 2; }
    DI unsigned a_rowoff(const Unit&, int) const { return 0u; }
};
struct EpiMoeOut {
    static constexpr bool PERM = false;
    const float* xin; float* out; const float* g; const int* tokl; MoeTab tb; int rmask;
    DI void operator()(const f32x4 (&acc)[2][2][4][2], const Unit& u, int wr, int wc, int fr, int fq) const {
        const int r0 = wr * 64 + fr, col0 = u.pn * 256 + wc * 32 + 4 * fq; const int cn = tb.cnt[u.x1];
#pragma unroll
        for (int ai = 0; ai < 2; ++ai)
#pragma unroll
            for (int m = 0; m < 4; ++m) { const int pos = u.x0 + r0 + ai * 128 + m * 16;
                if (pos < cn) { const int tok = tokl[u.x1 * CLS_CAP + pos]; const int b = tok >> 14; const float* ip = xin + (size_t)tok * D + col0; float* op = out + (size_t)(tok & rmask) * D + col0; const float* gp = g + b * 6144 + col0;
#pragma unroll
                    for (int bj = 0; bj < 2; ++bj)
#pragma unroll
                        for (int n = 0; n < 2; ++n) { const f32x4 xv = *(const f32x4*)(ip + bj * 128 + n * 16); const f32x4 gv = *(const f32x4*)(gp + bj * 128 + n * 16);
                            *(f32x4*)(op + bj * 128 + n * 16) = xv + gv * acc[ai][bj][m][n]; } } }
    }
};

struct Ctx { LAS unsigned char* lds; int tid, lane, wave, G, bid; };
DI Ctx fresh(const Ctx& X) { Ctx P = X; int t = X.tid; asm volatile("" : "+v"(t)); P.tid = t; P.lane = t & 63; P.wave = __builtin_amdgcn_readfirstlane(t >> 6); return P; }

DI void tr_item(const float* W, int ldw, int K, bf16* WT, int k0, LAS float* scr, int lane) {
#pragma unroll 8
    for (int i = 0; i < 32; ++i) { const int kk = 2 * i + (lane >> 5); scr[kk * 33 + (lane & 31)] = W[(size_t)(k0 + kk) * ldw + (lane & 31)]; }
    LDS_WAIT(); asm volatile("" ::: "memory");
    const int c = lane & 7;
#pragma unroll
    for (int j = 0; j < 4; ++j) { const int n = (lane >> 3) + 8 * j; const LAS float* s = scr + (8 * c) * 33 + n;
        v4u o; o.x = pk2(s[0 * 33], s[1 * 33]); o.y = pk2(s[2 * 33], s[3 * 33]); o.z = pk2(s[4 * 33], s[5 * 33]); o.w = pk2(s[6 * 33], s[7 * 33]);
        *(v4u*)(WT + (size_t)n * K + k0 + 8 * c) = o; }
    LDS_WAIT(); asm volatile("" ::: "memory");
}
DI void p0_prologue(const Args& a, const Ctx& X) {
    unsigned char* ws = a.ws;
    LAS float* scr = (LAS float*)(X.lds + X.wave * 16384);
    const int gw = X.bid * 8 + X.wave, NGW = X.G * 8;
    constexpr int IT_WIN = 16 * 153, IT_AU = 8 * 32, IT_OUT = 16 * 32, IT_GU = 16 * 16 * 32, IT_DN = 16 * 8 * 32;
    constexpr int IT_L = IT_WIN + 2 * IT_AU + IT_OUT + IT_GU + IT_DN;
    for (int it = gw; it < NL * IT_L; it += NGW) {
        const int l = it / IT_L; int r = it - l * IT_L;
        if (r < IT_WIN) { const int kb = r / 153, nb = r - kb * 153, d0 = 32 * nb, s0 = (nb == 152) ? 2304 : (d0 + (d0 >= 2304 ? 8 : 0));
            tr_item(a.w_in + (size_t)l * D * DIN_SRC + s0, DIN_SRC, D, (bf16*)(ws + WS_WIN) + ((size_t)l * NPROJW + d0) * D, 64 * kb, scr, X.lane); continue; }
        r -= IT_WIN;
        if (r < IT_AU) { const int kb = r >> 5, nb = r & 31;
            tr_item(a.w_au + (size_t)l * 512 * D + 32 * nb, D, 512, (bf16*)(ws + WS_WAU) + ((size_t)l * D + 32 * nb) * 512, 64 * kb, scr, X.lane); continue; }
        r -= IT_AU;
        if (r < IT_AU) { const int kb = r >> 5, nb = r & 31;
            tr_item(a.w_mu + (size_t)l * 512 * D + 32 * nb, D, 512, (bf16*)(ws + WS_WMU) + ((size_t)l * D + 32 * nb) * 512, 64 * kb, scr, X.lane); continue; }
        r -= IT_AU;
        if (r < IT_OUT) { const int kb = r >> 5, nb = r & 31;
            tr_item(a.w_out + (size_t)l * D * D + 32 * nb, D, D, (bf16*)(ws + WS_WOUT) + ((size_t)l * D + 32 * nb) * D, 64 * kb, scr, X.lane); continue; }
        r -= IT_OUT;
        if (r < IT_GU) { const int e = r >> 9, q = r & 511, kb = q >> 5, nb = q & 31, tq = nb >> 3, rb = nb & 7;
            const float* src = ((rb < 4) ? a.w_gate : a.w_up) + ((size_t)(l * NE + e) * D) * FF + 128 * tq + 32 * (rb & 3);
            tr_item(src, FF, D, (bf16*)(ws + WS_WGU) + ((size_t)(l * NE + e) * 1024 + 32 * nb) * D, 64 * kb, scr, X.lane); continue; }
        r -= IT_GU;
        { const int e = r >> 8, q = r & 255, kb = q >> 5, nb = q & 31;
            tr_item(a.w_down + ((size_t)(l * NE + e) * FF) * D + 32 * nb, D, FF, (bf16*)(ws + WS_WD) + ((size_t)(l * NE + e) * 1024 + 32 * nb) * FF, 64 * kb, scr, X.lane); }
    }
    { float* cs = (float*)(ws + WS_ROPE); float* sn = cs + (size_t)T * 8;
      for (int i = X.bid * 512 + X.tid; i < T * 8; i += X.G * 512) { const int tok = i >> 3, f = i & 7; const float angf = (float)a.pos[tok] * c_invf[f];
          double rev = (double)angf * 0.15915494309189535; rev -= rint(rev); const float rf = (float)rev;
          cs[i] = __builtin_amdgcn_cosf(rf); sn[i] = __builtin_amdgcn_sinf(rf); } }
    __syncthreads();
    LAS float* cact = (LAS float*)X.lds; LAS float* red = (LAS float*)(X.lds + 8192);
    for (int i = X.tid; i < 2048; i += 512) { const float cv = a.c[i]; cact[i] = cv / (1.0f + __expf(-cv)); }
    __syncthreads();
    float* mod = (float*)(ws + WS_MOD);
    for (int it = X.bid; it < NL * 96; it += X.G) { const int l = it / 96, cg = it - l * 96; const int col = cg * 64 + X.lane;
        const float* w = a.ada_w + (size_t)l * D * 6144 + col; float s0 = 0.f, s1 = 0.f;
#pragma unroll 8
        for (int kk = 0; kk < 128; ++kk) { const int k = X.wave * 128 + kk; const float wv = w[(size_t)k * 6144]; s0 += cact[k] * wv; s1 += cact[1024 + k] * wv; }
        red[(X.wave * 2 + 0) * 64 + X.lane] = s0; red[(X.wave * 2 + 1) * 64 + X.lane] = s1;
        __syncthreads();
        if (X.tid < 128) { const int b = X.tid >> 6, ln = X.tid & 63; float s = 0.f;
#pragma unroll
            for (int w8 = 0; w8 < 8; ++w8) s += red[(w8 * 2 + b) * 64 + ln];
            mod[(size_t)(l * 2 + b) * 6144 + cg * 64 + ln] = s + a.ada_b[l * 6144 + cg * 64 + ln]; }
        __syncthreads();
    }
}

DI void p1_norm_gates(const Args& a, const Ctx& X, int l, const float* xin) {
    unsigned char* ws = a.ws;
    const float* mod = (const float*)(ws + WS_MOD); bf16* hb = (bf16*)(ws + WS_H);
    const int gw = X.bid * 8 + X.wave, NGW = X.G * 8;
    for (int rg = gw; rg < T / 16; rg += NGW) {
        const int row0 = rg * 16, b = row0 >> 14;
        const float* mb = mod + (size_t)(l * 2 + b) * 6144;
        f32x4 aw[4], sh[4];
#pragma unroll
        for (int j = 0; j < 4; ++j) { const int k = 256 * j + 4 * X.lane; const f32x4 nw = *(const f32x4*)(a.nmw + l * D + k); const f32x4 sc = *(const f32x4*)(mb + 1024 + k); aw[j] = nw * (sc + 1.0f); sh[j] = *(const f32x4*)(mb + k); }
        f32x4 pre[4][4];
#pragma unroll
        for (int q = 0; q < 4; ++q) { const f32x4* xp = (const f32x4*)(xin + (size_t)(row0 + q) * D) + X.lane;
#pragma unroll
            for (int j = 0; j < 4; ++j) pre[q][j] = xp[64 * j]; }
#pragma unroll 1
        for (int rb = 0; rb < 16; rb += 4) {
#pragma unroll
          for (int q = 0; q < 4; ++q) { const int row = row0 + rb + q;
            f32x4 v[4]; float ss = 0.f;
#pragma unroll
            for (int j = 0; j < 4; ++j) v[j] = pre[q][j];
            if (rb + 4 < 16) { const f32x4* xp = (const f32x4*)(xin + (size_t)(row + 4) * D) + X.lane;
#pragma unroll
                for (int j = 0; j < 4; ++j) pre[q][j] = xp[64 * j]; }
#pragma unroll
            for (int j = 0; j < 4; ++j) ss += (v[j].x * v[j].x + v[j].y * v[j].y) + (v[j].z * v[j].z + v[j].w * v[j].w);
            ss = wave_sum(ss); const float rstd = __builtin_amdgcn_rsqf(ss * (1.0f / D) + EPS);
            v2u* o8 = (v2u*)(hb + (size_t)row * D) + X.lane;
#pragma unroll
            for (int j = 0; j < 4; ++j) { v[j] = v[j] * rstd * aw[j] + sh[j]; v2u o; o.x = cvt_pk_bf16(v[j].x, v[j].y); o.y = cvt_pk_bf16(v[j].z, v[j].w); o8[64 * j] = o; }
          }
        }
    }
}

DI void attn_unit(const Args& a, const Ctx& X, int l, int unit) {
    unsigned char* ws = a.ws; const bf16* proj = (const bf16*)(ws + WS_PROJ); bf16* ao = (bf16*)(ws + WS_H);
    const float* cs = (const float*)(ws + WS_ROPE); const float* sn = cs + (size_t)T * 8;
    const int b = unit >> 8, rem = unit & 255, nb = rem >> 1, kvh = rem & 1; const int tok0 = b * SEQ + nb * 128;
    LAS bf16* Kl = (LAS bf16*)X.lds;
    LAS bf16* VT = (LAS bf16*)(X.lds + 36864);
    int lane = X.lane; asm volatile("" : "+v"(lane));
    const int c16 = lane & 15, quad = lane >> 4;
    {
        const int row = X.tid >> 1, half = X.tid & 1; const int tokk = tok0 - 128 + row; const bool valid = (nb > 0) || (row >= 128);
        float y[32]; float vv[32];
        if (valid) {
            const v4u* kp = (const v4u*)(proj + (size_t)tokk * NPROJ + C_AK + kvh * 64 + half * 32); const v4u* vp = (const v4u*)(proj + (size_t)tokk * NPROJ + C_AV + kvh * 64 + half * 32);
#pragma unroll
            for (int q = 0; q < 4; ++q) { const v4u kw = kp[q], vw = vp[q];
                y[8 * q + 0] = bflo(kw.x); y[8 * q + 1] = bfhi(kw.x); y[8 * q + 2] = bflo(kw.y); y[8 * q + 3] = bfhi(kw.y); y[8 * q + 4] = bflo(kw.z); y[8 * q + 5] = bfhi(kw.z); y[8 * q + 6] = bflo(kw.w); y[8 * q + 7] = bfhi(kw.w);
                vv[8 * q + 0] = bflo(vw.x); vv[8 * q + 1] = bfhi(vw.x); vv[8 * q + 2] = bflo(vw.y); vv[8 * q + 3] = bfhi(vw.y); vv[8 * q + 4] = bflo(vw.z); vv[8 * q + 5] = bfhi(vw.z); vv[8 * q + 6] = bflo(vw.w); vv[8 * q + 7] = bfhi(vw.w); }
        } else {
#pragma unroll
            for (int i = 0; i < 32; ++i) { y[i] = 0.f; vv[i] = 0.f; } }
        float ss = 0.f;
#pragma unroll
        for (int i = 0; i < 32; ++i) ss += y[i] * y[i];
        ss += __shfl_xor(ss, 1); const float rstd = 1.0f / sqrtf(ss * (1.0f / 64.0f) + EPS);
#pragma unroll
        for (int i = 0; i < 32; ++i) y[i] = y[i] * rstd * a.knw[l * 64 + half * 32 + i];
        if (half == 0 && valid) {
#pragma unroll
            for (int d = 0; d < 8; ++d) { const float c = cs[(size_t)tokk * 8 + d], s = sn[(size_t)tokk * 8 + d]; const float t1 = y[d], t2 = y[d + 8]; y[d] = t1 * c - t2 * s; y[d + 8] = t2 * c + t1 * s; } }
#pragma unroll
        for (int q = 0; q < 4; ++q) { v4u w; w.x = pk2(y[8 * q], y[8 * q + 1]); w.y = pk2(y[8 * q + 2], y[8 * q + 3]); w.z = pk2(y[8 * q + 4], y[8 * q + 5]); w.w = pk2(y[8 * q + 6], y[8 * q + 7]);
            *(LAS v4u*)(Kl + row * 72 + half * 32 + 8 * q) = w; }
#pragma unroll
        for (int i = 0; i < 32; ++i) VT[(half * 32 + i) * 280 + row] = (bf16)f2bf(vv[i]);
        if (X.tid < 64) {
#pragma unroll
            for (int cc = 256; cc < 280; ++cc) VT[X.tid * 280 + cc] = 0; }
    }
    __syncthreads();
#pragma unroll 1
    for (int task = X.wave; task < 32; task += 8) {
        const int g = task >> 3, rg = task & 7, r0 = 16 * rg, head = kvh * 4 + g; const int tokq = tok0 + r0 + c16;
        const float sink = a.sinks[l * 8 + head];
        float qv[16];
        { const bf16* qp = proj + (size_t)tokq * NPROJ + C_AQ + head * 64; const v4u w0 = *(const v4u*)(qp + 8 * quad), w1 = *(const v4u*)(qp + 32 + 8 * quad);
          qv[0] = bflo(w0.x); qv[1] = bfhi(w0.x); qv[2] = bflo(w0.y); qv[3] = bfhi(w0.y); qv[4] = bflo(w0.z); qv[5] = bfhi(w0.z); qv[6] = bflo(w0.w); qv[7] = bfhi(w0.w);
          qv[8] = bflo(w1.x); qv[9] = bfhi(w1.x); qv[10] = bflo(w1.y); qv[11] = bfhi(w1.y); qv[12] = bflo(w1.z); qv[13] = bfhi(w1.z); qv[14] = bflo(w1.w); qv[15] = bfhi(w1.w); }
        float ss = 0.f;
#pragma unroll
        for (int i = 0; i < 16; ++i) ss += qv[i] * qv[i];
        ss += __shfl_xor(ss, 16); ss += __shfl_xor(ss, 32); const float rstd = 1.0f / sqrtf(ss * (1.0f / 64.0f) + EPS);
#pragma unroll
        for (int i = 0; i < 8; ++i) { qv[i] = qv[i] * rstd * a.qnw[l * 64 + 8 * quad + i]; qv[8 + i] = qv[8 + i] * rstd * a.qnw[l * 64 + 32 + 8 * quad + i]; }
#pragma unroll
        for (int d = 0; d < 8; ++d) { const float other = __shfl_xor(qv[d], 16); const float c = cs[(size_t)tokq * 8 + d], s = sn[(size_t)tokq * 8 + d];
            if (quad == 0) qv[d] = qv[d] * c - other * s; else if (quad == 1) qv[d] = qv[d] * c + other * s; }
        bf16x8 qf[2];
        { v4u w; w.x = pk2(qv[0], qv[1]); w.y = pk2(qv[2], qv[3]); w.z = pk2(qv[4], qv[5]); w.w = pk2(qv[6], qv[7]); qf[0] = __builtin_bit_cast(bf16x8, w);
          w.x = pk2(qv[8], qv[9]); w.y = pk2(qv[10], qv[11]); w.z = pk2(qv[12], qv[13]); w.w = pk2(qv[14], qv[15]); qf[1] = __builtin_bit_cast(bf16x8, w); }
        f32x4 sacc[9];
#pragma unroll
        for (int i = 0; i < 9; ++i) { const LAS bf16* kr = Kl + (16 * (rg + i) + c16) * 72 + 8 * quad;
            const bf16x8 k0 = *(const LAS bf16x8*)kr, k1 = *(const LAS bf16x8*)(kr + 32);
            f32x4 z = {0.f, 0.f, 0.f, 0.f}; z = __builtin_amdgcn_mfma_f32_16x16x32_bf16(k0, qf[0], z, 0, 0, 0); sacc[i] = __builtin_amdgcn_mfma_f32_16x16x32_bf16(k1, qf[1], z, 0, 0, 0); }
        int dbase = 4 * quad - c16; asm volatile("" : "+v"(dbase)); int kbase = 16 * rg + 4 * quad; asm volatile("" : "+v"(kbase)); float mx = sink;
#pragma unroll
        for (int i = 0; i < 9; ++i)
#pragma unroll
            for (int j = 0; j < 4; ++j) { const int dlt = dbase + 16 * i + j; const int kj = kbase + 16 * i + j; const bool ok = (dlt > 0) && (dlt <= 128) && ((nb > 0) || (kj >= 128));
                const float s = ok ? sacc[i][j] * 0.125f : -3.0e38f; sacc[i][j] = s; mx = fmaxf(mx, s); }
        mx = fmaxf(mx, __shfl_xor(mx, 16)); mx = fmaxf(mx, __shfl_xor(mx, 32));
        float sum = 0.f;
#pragma unroll
        for (int i = 0; i < 9; ++i)
#pragma unroll
            for (int j = 0; j < 4; ++j) { const float p = (sacc[i][j] > -1.0e38f) ? __expf(sacc[i][j] - mx) : 0.f; sacc[i][j] = p; sum += p; }
        sum += __shfl_xor(sum, 16); sum += __shfl_xor(sum, 32);
        const float inv = 1.0f / (sum + __expf(sink - mx));
        f32x4 oacc[4];
#pragma unroll
        for (int et = 0; et < 4; ++et) oacc[et] = (f32x4){0.f, 0.f, 0.f, 0.f};
#pragma unroll
        for (int kk = 0; kk < 5; ++kk) {
            v4u pw; pw.x = pk2(sacc[2 * kk][0], sacc[2 * kk][1]); pw.y = pk2(sacc[2 * kk][2], sacc[2 * kk][3]);
            if (2 * kk + 1 < 9) { pw.z = pk2(sacc[(2 * kk + 1 < 9) ? 2 * kk + 1 : 0][0], sacc[(2 * kk + 1 < 9) ? 2 * kk + 1 : 0][1]); pw.w = pk2(sacc[(2 * kk + 1 < 9) ? 2 * kk + 1 : 0][2], sacc[(2 * kk + 1 < 9) ? 2 * kk + 1 : 0][3]); } else { pw.z = 0u; pw.w = 0u; }
            const bf16x8 pf = __builtin_bit_cast(bf16x8, pw);
#pragma unroll
            for (int et = 0; et < 4; ++et) { const LAS bf16* vr = VT + (16 * et + c16) * 280 + 16 * rg + 32 * kk + 4 * quad;
                const v2u lo = *(const LAS v2u*)vr, hi = *(const LAS v2u*)(vr + 16); v4u vw; vw.x = lo.x; vw.y = lo.y; vw.z = hi.x; vw.w = hi.y;
                oacc[et] = __builtin_amdgcn_mfma_f32_16x16x32_bf16(__builtin_bit_cast(bf16x8, vw), pf, oacc[et], 0, 0, 0); }
        }
#pragma unroll
        for (int et = 0; et < 4; ++et) { v2u w; w.x = pk2(oacc[et][0] * inv, oacc[et][1] * inv); w.y = pk2(oacc[et][2] * inv, oacc[et][3] * inv);
            *(v2u*)(ao + (size_t)tokq * 512 + head * 64 + 16 * et + 4 * quad) = w; }
    }
    __syncthreads();
}

constexpr int ML_Q = 0, ML_K = 17408, ML_KET = 34816, ML_VT = 53248, ML_CT = 73984, ML_CW = 113152, ML_CB = 118272, ML_RED = 118784, ML_NW = 119296;
template <bool L3> DI void mlstm_unit(const Args& a, const Ctx& X, int l, int unit) {
    unsigned char* ws = a.ws; const bf16* proj = (const bf16*)(ws + WS_PROJ); bf16* hm = (bf16*)(ws + WS_H) + (size_t)T * 512;
    const float* gates = (const float*)(ws + WS_GATES); float* mlc = (float*)(ws + WS_MLC) + (size_t)unit * 18432; float* mlb = (float*)(ws + WS_MLB);
    const int seq = unit >> 5, sj = unit & 31, b = seq >> 2, hh = seq & 3; const int tokbase = b * SEQ + sj * 512;
    LAS bf16* Qs = (LAS bf16*)(X.lds + ML_Q); LAS bf16* Ks = (LAS bf16*)(X.lds + ML_K); LAS bf16* KET = (LAS bf16*)(X.lds + ML_KET);
    LAS bf16* VT = (LAS bf16*)(X.lds + ML_VT); LAS bf16* CT = (LAS bf16*)(X.lds + ML_CT); LAS float* CW = (LAS float*)(X.lds + ML_CW);
    LAS float* CB = (LAS float*)(X.lds + ML_CB); LAS float* RED = (LAS float*)(X.lds + ML_RED); LAS float* NW = (LAS float*)(X.lds + ML_NW);
    int lane = X.lane; asm volatile("" : "+v"(lane));
    const int c16 = lane & 15, quad = lane >> 4, w = X.wave;
    for (int idx = X.tid; idx < 1280; idx += 512) { const int tap = idx >> 8, ch = idx & 255; const int gch = (ch < 128) ? (hh * 128 + ch) : (512 + hh * 128 + (ch - 128));
        CW[idx] = (tap < 4) ? a.conv_w[(size_t)(l * 4 + tap) * 1024 + gch] : a.conv_b[l * 1024 + gch]; }
    for (int idx = X.tid; idx < 16 * 72; idx += 512) VT[128 * 72 + idx] = (idx < 72) ? (bf16)0x3F80 : (bf16)0;
    if (X.tid < 128) NW[X.tid] = a.mnw[l * 512 + hh * 128 + X.tid];
    f32x4 cacc[9];
#pragma unroll
    for (int et = 0; et < 9; ++et) {
        if (L3) {
#pragma unroll
            for (int j = 0; j < 4; ++j) { const float v = mlc[(16 * et + 4 * quad + j) * 128 + 16 * w + c16]; cacc[et][j] = v; CT[(16 * et + 4 * quad + j) * 136 + 16 * w + c16] = (bf16)f2bf(v); }
        } else cacc[et] = (f32x4){0.f, 0.f, 0.f, 0.f};
    }
    float bsum = 0.f;
    __syncthreads();
#pragma unroll 1
    for (int c = 0; c < 8; ++c) {
        const int tok0 = tokbase + c * 64;
        float bsc = gates[(size_t)(tok0 + lane) * 8 + 4 + hh]; const float li = gates[(size_t)(tok0 + lane) * 8 + hh];
#pragma unroll
        for (int o = 1; o < 64; o <<= 1) { const float v = __shfl_up(bsc, o); if (lane >= o) bsc += v; }
        const float bl = __shfl(bsc, 63); const float csv = li - bsc;
        if (w == 0) { CB[lane] = bsc; CB[64 + lane] = csv; }
        bsum += bl;
        { const int t = X.tid >> 3, dc = X.tid & 7; const float fac = __expf(bl + __shfl(csv, t));
          const int tokt = tok0 + t;
#pragma unroll
          for (int qk = (L3 ? 0 : 1); qk < 2; ++qk) {
              float accv[16];
#pragma unroll
              for (int i = 0; i < 16; ++i) accv[i] = CW[4 * 256 + qk * 128 + 16 * dc + i];
#pragma unroll
              for (int j = 0; j < 4; ++j) { const int tt = tokt - 3 + j;
                  if (tt >= b * SEQ) { const v4u* p = (const v4u*)(proj + (size_t)tt * NPROJ + (qk ? C_MK : C_MQ) + hh * 128 + 16 * dc); const v4u w0 = p[0], w1 = p[1];
                      const float xv[16] = {bflo(w0.x), bfhi(w0.x), bflo(w0.y), bfhi(w0.y), bflo(w0.z), bfhi(w0.z), bflo(w0.w), bfhi(w0.w), bflo(w1.x), bfhi(w1.x), bflo(w1.y), bfhi(w1.y), bflo(w1.z), bfhi(w1.z), bflo(w1.w), bfhi(w1.w)};
#pragma unroll
                      for (int i = 0; i < 16; ++i) accv[i] += CW[j * 256 + qk * 128 + 16 * dc + i] * xv[i]; } }
#pragma unroll
              for (int i = 0; i < 16; ++i) { const float z = accv[i]; accv[i] = z / (1.0f + __expf(-z)) * (qk ? 0.08838834764831845f : 1.0f); }
              if (L3) { LAS bf16* dst = (qk ? Ks : Qs) + t * 136 + 16 * dc;
                  v4u o0, o1; o0.x = pk2(accv[0], accv[1]); o0.y = pk2(accv[2], accv[3]); o0.z = pk2(accv[4], accv[5]); o0.w = pk2(accv[6], accv[7]);
                  o1.x = pk2(accv[8], accv[9]); o1.y = pk2(accv[10], accv[11]); o1.z = pk2(accv[12], accv[13]); o1.w = pk2(accv[14], accv[15]);
                  *(LAS v4u*)dst = o0; *(LAS v4u*)(dst + 8) = o1; }
              if (qk) {
#pragma unroll
                  for (int i = 0; i < 16; ++i) KET[(16 * dc + i) * 72 + t] = (bf16)f2bf(accv[i] * fac); }
          }
          { const v4u* p = (const v4u*)(proj + (size_t)tokt * NPROJ + C_MV + hh * 128 + 16 * dc); const v4u w0 = p[0], w1 = p[1];
            const unsigned ww[8] = {w0.x, w0.y, w0.z, w0.w, w1.x, w1.y, w1.z, w1.w};
#pragma unroll
            for (int i = 0; i < 8; ++i) { VT[(16 * dc + 2 * i) * 72 + t] = (bf16)(ww[i] & 0xffffu); VT[(16 * dc + 2 * i + 1) * 72 + t] = (bf16)(ww[i] >> 16); } }
        }
        __syncthreads();
        float hval[4][4]; int tt_ = w & 3, eh = w >> 2; const int tq = 16 * tt_ + c16;
        if (L3) {
            bf16x8 qf[4];
#pragma unroll
            for (int ks = 0; ks < 4; ++ks) qf[ks] = *(const LAS bf16x8*)(Qs + tq * 136 + 32 * ks + 8 * quad);
            f32x4 sacc[4];
#pragma unroll
            for (int st = 0; st < 4; ++st) { f32x4 z = {0.f, 0.f, 0.f, 0.f};
#pragma unroll
                for (int ks = 0; ks < 4; ++ks) z = __builtin_amdgcn_mfma_f32_16x16x32_bf16(*(const LAS bf16x8*)(Ks + (16 * st + c16) * 136 + 32 * ks + 8 * quad), qf[ks], z, 0, 0, 0);
                sacc[st] = z; }
            const float cbt = CB[tq];
#pragma unroll
            for (int st = 0; st < 4; ++st)
#pragma unroll
                for (int j = 0; j < 4; ++j) { const int s = 16 * st + 4 * quad + j; const float d = (s <= tq) ? __expf(cbt + CB[64 + s]) : 0.f; sacc[st][j] *= d; }
            bf16x8 pf[2];
#pragma unroll
            for (int kk = 0; kk < 2; ++kk) { v4u pw; pw.x = pk2(sacc[2 * kk][0], sacc[2 * kk][1]); pw.y = pk2(sacc[2 * kk][2], sacc[2 * kk][3]); pw.z = pk2(sacc[2 * kk + 1][0], sacc[2 * kk + 1][1]); pw.w = pk2(sacc[2 * kk + 1][2], sacc[2 * kk + 1][3]); pf[kk] = __builtin_bit_cast(bf16x8, pw); }
            const float ebt = __expf(cbt);
            f32x4 nn[5];
#pragma unroll
            for (int x = 0; x < 5; ++x) { const int et = (x < 4) ? (4 * eh + x) : 8; f32x4 na = {0.f, 0.f, 0.f, 0.f}, ia = {0.f, 0.f, 0.f, 0.f};
#pragma unroll
                for (int kk = 0; kk < 2; ++kk) { const LAS bf16* vr = VT + (16 * et + c16) * 72 + 32 * kk + 4 * quad; const v2u lo = *(const LAS v2u*)vr, hi = *(const LAS v2u*)(vr + 16); v4u vw; vw.x = lo.x; vw.y = lo.y; vw.z = hi.x; vw.w = hi.y;
                    na = __builtin_amdgcn_mfma_f32_16x16x32_bf16(__builtin_bit_cast(bf16x8, vw), pf[kk], na, 0, 0, 0); }
#pragma unroll
                for (int ks = 0; ks < 4; ++ks) ia = __builtin_amdgcn_mfma_f32_16x16x32_bf16(*(const LAS bf16x8*)(CT + (16 * et + c16) * 136 + 32 * ks + 8 * quad), qf[ks], ia, 0, 0, 0);
                nn[x] = na + ia * ebt; }
            const float den = __shfl(nn[4][0], c16); const float inv = 1.0f / fmaxf(fabsf(den), 1.0f);
            float ss = 0.f;
#pragma unroll
            for (int x = 0; x < 4; ++x)
#pragma unroll
                for (int j = 0; j < 4; ++j) { hval[x][j] = nn[x][j] * inv; ss += hval[x][j] * hval[x][j]; }
            ss += __shfl_xor(ss, 16); ss += __shfl_xor(ss, 32);
            if (quad == 0) RED[eh * 64 + tq] = ss;
            __syncthreads();
            const float rstd = 1.0f / sqrtf((RED[tq] + RED[64 + tq]) * (1.0f / 128.0f) + EPS);
#pragma unroll
            for (int x = 0; x < 4; ++x) { const int e = 16 * (4 * eh + x) + 4 * quad; const v2u og = *(const v2u*)(proj + (size_t)(tok0 + tq) * NPROJ + C_MO + hh * 128 + e);
                const float y0 = hval[x][0] * rstd * NW[e] * bflo(og.x), y1 = hval[x][1] * rstd * NW[e + 1] * bfhi(og.x), y2 = hval[x][2] * rstd * NW[e + 2] * bflo(og.y), y3 = hval[x][3] * rstd * NW[e + 3] * bfhi(og.y);
                v2u o; o.x = pk2(y0, y1); o.y = pk2(y2, y3); *(v2u*)(hm + (size_t)(tok0 + tq) * 512 + hh * 128 + e) = o; }
        }
        { const float ebl = __expf(bl);
          bf16x8 kf[2];
#pragma unroll
          for (int kk = 0; kk < 2; ++kk) kf[kk] = *(const LAS bf16x8*)(KET + (16 * w + c16) * 72 + 32 * kk + 8 * quad);
#pragma unroll
          for (int et = 0; et < 9; ++et) { f32x4 z = cacc[et] * ebl;
#pragma unroll
              for (int kk = 0; kk < 2; ++kk) z = __builtin_amdgcn_mfma_f32_16x16x32_bf16(*(const LAS bf16x8*)(VT + (16 * et + c16) * 72 + 32 * kk + 8 * quad), kf[kk], z, 0, 0, 0);
              cacc[et] = z;
              if (L3) {
#pragma unroll
                  for (int j = 0; j < 4; ++j) CT[(16 * et + 4 * quad + j) * 136 + 16 * w + c16] = (bf16)f2bf(z[j]); } } }
        __syncthreads();
    }
    if (!L3) {
#pragma unroll
        for (int et = 0; et < 9; ++et)
#pragma unroll
            for (int j = 0; j < 4; ++j) mlc[(16 * et + 4 * quad + j) * 128 + 16 * w + c16] = cacc[et][j];
        if (X.tid == 0) mlb[unit] = bsum;
    }
}
DI void mlstm_scan(const Args& a, const Ctx& X) {
    float* mlc = (float*)(a.ws + WS_MLC); const float* mlb = (const float*)(a.ws + WS_MLB);
    for (int idx = X.bid * 512 + X.tid; idx < 8 * 18432; idx += X.G * 512) { const int seq = idx / 18432, el = idx - seq * 18432; float carry = 0.f;
        float* p0 = mlc + (size_t)seq * 32 * 18432 + el; float v[32], dcy[32];
#pragma unroll
        for (int j = 0; j < 32; ++j) { v[j] = p0[(size_t)j * 18432]; dcy[j] = mlb[seq * 32 + j]; }
#pragma unroll
        for (int j = 0; j < 32; ++j) { p0[(size_t)j * 18432] = carry; carry = __expf(dcy[j]) * carry + v[j]; } }
}

DI void p6_norm_route(const Args& a, const Ctx& X, int l, const float* xin) {
    unsigned char* ws = a.ws;
    LAS float* wr = (LAS float*)X.lds;
    for (int idx = X.tid; idx < 16384; idx += 512) { const int k = idx >> 4, e = idx & 15; wr[e * 1024 + k] = a.router_w[idx]; }
    __syncthreads();
    const float* mod = (const float*)(ws + WS_MOD); bf16* hb = (bf16*)(ws + WS_H); float* tgate = (float*)(ws + WS_TGATE); int* tokl = (int*)(ws + WS_TOKL);
    unsigned* cnt = (unsigned*)(ws + WS_CTL) + CW_CNT + l * 2048;
    LAS int* hist = (LAS int*)(X.lds + 65536); LAS int* cbase = hist + 32;
    const int gw = X.bid * 8 + X.wave, NGW = X.G * 8;
    for (int it = 0; it * NGW < T / 16; ++it) {
        const int rg = it * NGW + gw; const bool act = rg < T / 16;
        if (X.tid < 32) hist[X.tid] = 0;
        __syncthreads();
        const int row0 = (act ? rg : 0) * 16, b = row0 >> 14;
        const float* mb = mod + (size_t)(l * 2 + b) * 6144;
        f32x4 aw[4], sh[4];
#pragma unroll
        for (int j = 0; j < 4; ++j) { const int k = 256 * j + 4 * X.lane; const f32x4 nw = *(const f32x4*)(a.nfw + l * D + k); const f32x4 sc = *(const f32x4*)(mb + 4 * 1024 + k); aw[j] = nw * (sc + 1.0f); sh[j] = *(const f32x4*)(mb + 3 * 1024 + k); }
        int my_cls = 0; float my_ga = 0.f, my_gb = 0.f;
        f32x4 pre[4][4];
#pragma unroll
        for (int q = 0; q < 4; ++q) { const f32x4* xp = (const f32x4*)(xin + (size_t)(row0 + q) * D) + X.lane;
#pragma unroll
            for (int j = 0; j < 4; ++j) pre[q][j] = xp[64 * j]; }
#pragma unroll 1
        for (int rb = 0; rb < 16; rb += 4) {
#pragma unroll
          for (int q = 0; q < 4; ++q) { const int r = rb + q; const int row = row0 + r;
            f32x4 v[4]; float ss = 0.f;
#pragma unroll
            for (int j = 0; j < 4; ++j) v[j] = pre[q][j];
            if (rb + 4 < 16) { const f32x4* xp = (const f32x4*)(xin + (size_t)(row + 4) * D) + X.lane;
#pragma unroll
                for (int j = 0; j < 4; ++j) pre[q][j] = xp[64 * j]; }
#pragma unroll
            for (int j = 0; j < 4; ++j) ss += (v[j].x * v[j].x + v[j].y * v[j].y) + (v[j].z * v[j].z + v[j].w * v[j].w);
            ss = wave_sum(ss); const float rstd = 1.0f / sqrtf(ss * (1.0f / D) + EPS);
            unsigned long long* o8 = (unsigned long long*)(hb + (size_t)row * D) + X.lane;
#pragma unroll
            for (int j = 0; j < 4; ++j) { v[j] = v[j] * rstd * aw[j] + sh[j]; o8[64 * j] = (unsigned long long)pk2(v[j].x, v[j].y) | ((unsigned long long)pk2(v[j].z, v[j].w) << 32); }
            float sc[16], sel[16];
#pragma unroll
            for (int e = 0; e < 16; ++e) { float p = 0.f;
#pragma unroll
                for (int j = 0; j < 4; ++j) { const f32x4 wv = *(const LAS f32x4*)(wr + e * 1024 + 256 * j + 4 * X.lane); p += (v[j].x * wv.x + v[j].y * wv.y) + (v[j].z * wv.z + v[j].w * wv.w); }
                p = wave_sum(p); sc[e] = 1.0f / (1.0f + __expf(-p)); sel[e] = sc[e] + a.router_b[e]; __builtin_amdgcn_sched_barrier(0); }
            int gi = 0; float gbest = -1.0e30f;
#pragma unroll
            for (int g = 0; g < 4; ++g) { const float p0 = sel[4 * g], p1 = sel[4 * g + 1], p2 = sel[4 * g + 2], p3 = sel[4 * g + 3];
                const float gs = fmaxf(fmaxf(fmaxf(p0 + p1, p0 + p2), fmaxf(p0 + p3, p1 + p2)), fmaxf(p1 + p3, p2 + p3));
                if (gs > gbest) { gbest = gs; gi = g; } }
            float qs[4], s4[4];
#pragma unroll
            for (int i = 0; i < 4; ++i) { qs[i] = 0.f; s4[i] = 0.f; }
#pragma unroll
            for (int g = 0; g < 4; ++g) if (g == gi) {
#pragma unroll
                for (int i = 0; i < 4; ++i) { qs[i] = sel[4 * g + i]; s4[i] = sc[4 * g + i]; } }
            int i1 = 0; float b1 = qs[0];
#pragma unroll
            for (int i = 1; i < 4; ++i) if (qs[i] > b1) { b1 = qs[i]; i1 = i; }
            int i2 = -1; float b2 = -1.0e30f;
#pragma unroll
            for (int i = 0; i < 4; ++i) if (i != i1 && qs[i] > b2) { b2 = qs[i]; i2 = i; }
            const int ia = (i1 < i2) ? i1 : i2, ib = (i1 < i2) ? i2 : i1;
            float sa = 0.f, sb = 0.f;
#pragma unroll
            for (int i = 0; i < 4; ++i) { if (i == ia) sa = s4[i]; if (i == ib) sb = s4[i]; }
            const int pidx = (ia == 0) ? (ib - 1) : ((ia == 1) ? (ib + 1) : 5);
            const float inv = 1.0f / (sa + sb);
            if (X.lane == r) { my_cls = gi * 6 + pidx; my_ga = sa * inv; my_gb = sb * inv; }
          }
        }
        int rank = 0;
        if (act && X.lane < 16) rank = __hip_atomic_fetch_add(hist + my_cls, 1, __ATOMIC_RELAXED, __HIP_MEMORY_SCOPE_WORKGROUP);
        __syncthreads();
        if (X.tid < NCLS) { const int n = hist[X.tid]; cbase[X.tid] = n ? (int)__hip_atomic_fetch_add(cnt + 64 * X.tid, (unsigned)n, RLX_AGENT) : 0; }
        __syncthreads();
        if (act && X.lane < 16) { const int tok = row0 + X.lane; const int pos = cbase[my_cls] + rank;
            tokl[my_cls * CLS_CAP + pos] = tok; tgate[tok * 2] = my_ga; tgate[tok * 2 + 1] = my_gb; }
        __syncthreads();
    }
}
DI MoeTab moe_tables(const Args& a, const Ctx& X, int l) {
    LAS int* tab = (LAS int*)(X.lds + TAB_OFF); LAS int* tcls = tab; LAS int* tpos = tab + 160; LAS int* cn = tab + 320; LAS int* rt_ = tab + 344;
    unsigned* cnt = (unsigned*)(a.ws + WS_CTL) + CW_CNT + l * 2048;
    if (X.tid < NCLS) cn[X.tid] = (int)__hip_atomic_load(cnt + 64 * X.tid, RLX_AGENT);
    __syncthreads();
    if (X.tid == 0) { int r = 0;
#pragma unroll 1
        for (int c = 0; c < NCLS; ++c) { const int n = (cn[c] + 255) >> 8;
#pragma unroll 1
            for (int i = 0; i < n; ++i) { tcls[r] = c; tpos[r] = i * 256; ++r; } }
        rt_[0] = r; }
    __syncthreads();
    MoeTab tb; tb.tcls = tcls; tb.tpos = tpos; tb.cnt = cn; tb.Rtot = __builtin_amdgcn_readfirstlane(rt_[0]); return tb;
}

#if defined(__HIP_DEVICE_COMPILE__)
DI Args load_args() { auto p = __builtin_amdgcn_kernarg_segment_ptr(); asm volatile("" : "+s"(p)); return *(const __attribute__((address_space(4))) Args*)p; }
#else
DI Args load_args() { return Args{}; }
#endif
__global__ void __launch_bounds__(512, 2) fwd(Args a_unused) {
    extern __shared__ __attribute__((aligned(16))) unsigned char lds_raw[];
    Ctx X; X.lds = (LAS unsigned char*)lds_raw; X.tid = threadIdx.x; X.lane = X.tid & 63; X.wave = __builtin_amdgcn_readfirstlane(X.tid >> 6); X.G = gridDim.x; X.bid = blockIdx.x;
    volatile LAS unsigned* MISC = (volatile LAS unsigned*)(X.lds + MISC_OFF);
    if (X.tid < 64) MISC[X.tid] = 0u;
    __syncthreads();
    int lo, hi; unsigned* ctl;
    { const Args a = load_args(); lo = a.ph_lo; hi = a.ph_hi; ctl = (unsigned*)(a.ws + WS_CTL); }
    XcdBarrier bar; bar.bar = ctl + CW_BAR; bar.x = 0; bar.st = MISC + 8;
    if (hi - lo > 1) bar = xcd_barrier_post(ctl + CW_BAR, MISC + 8);
#ifndef PH_MASK
#define PH_MASK 0xFFFFF
#endif
#define PON(p) ((PH_MASK >> (p)) & 1)
#ifndef DUP_MASK
#define DUP_MASK 0
#endif
#define NREP(p) (((DUP_MASK >> (p)) & 1) ? 2 : 1)
#ifndef TSEL_MASK
#define TSEL_MASK 0
#endif
#define TSCALE 4
#define TSEL(p) ((TSEL_MASK >> (p)) & 1)
#define IN(k) (lo <= (k) && (k) < hi)
#define SEAM(k) do { if (IN(k) && IN((k) + 1)) xcd_barrier(bar); } while (0)
    unsigned long long tacc = 0ull, tph = 0ull;
#define TBEG() do { if (TSEL_MASK) tph = __builtin_amdgcn_s_memrealtime(); } while (0)
#define TEND(p) do { if (TSEL(p)) tacc += __builtin_amdgcn_s_memrealtime() - tph; } while (0)
    TBEG();
    if (PON(10) && IN(0)) { for (int rep = 0; rep < NREP(10); ++rep) { const Args a = load_args(); p0_prologue(a, X); } }
    SEAM(0); TEND(10);
    TBEG();
    for (int l = 0; l < NL; ++l) {
        const int g0 = 1 + l * NPH;
        if (PON(0) && IN(g0 + 0)) { for (int rep = 0; rep < NREP(0); ++rep) { const Args a = load_args(); unsigned char* ws = a.ws; const float* mod = (const float*)(ws + WS_MOD); bf16* proj = (bf16*)(ws + WS_PROJ); const float* xin = (l == 0) ? a.x : a.out; (void)mod; (void)proj; (void)xin; const Ctx P = fresh(X); p1_norm_gates(a, P, l, xin); } }
        SEAM(g0 + 0); TEND(0); TBEG();
        if (PON(1) && IN(g0 + 1)) for (int rep = 0; rep < NREP(1); ++rep) { const Args a = load_args(); unsigned char* ws = a.ws; const float* mod = (const float*)(ws + WS_MOD); bf16* proj = (bf16*)(ws + WS_PROJ); const float* xin = (l == 0) ? a.x : a.out; (void)mod; (void)proj; (void)xin; const Ctx P = fresh(X);
            DenseSched S; S.A = (const char*)(ws + WS_H); S.Bt = (const char*)(ws + WS_WIN) + (size_t)l * NPROJW * D * 2; S.lda = D; S.ldb = D; S.ord.init(T / 256, NPROJW / 256, P.G, P.bid);
            EpiProj E; E.O = proj; E.gates = (float*)(ws + WS_GATES); E.big = a.b_ig + l * 4; E.bfg = a.b_fg + l * 4;
            pg8::gemm_phase<EpiProj, DenseSched>(P.lds, D, S, E);
        }
        SEAM(g0 + 1); TEND(1); TBEG();
        if (PON(2) && IN(g0 + 2)) { const Args a = load_args(); unsigned char* ws = a.ws; const float* mod = (const float*)(ws + WS_MOD); bf16* proj = (bf16*)(ws + WS_PROJ); const float* xin = (l == 0) ? a.x : a.out; (void)mod; (void)proj; (void)xin; const Ctx P = fresh(X);
            if (PON(11)) for (int rep = 0; rep < NREP(11); ++rep) {
#pragma unroll 1
                for (int u = P.bid; u < 512; u += P.G) attn_unit(a, P, l, u); }
            if (PON(12)) for (int rep = 0; rep < NREP(12); ++rep) {
#pragma unroll 1
                for (int u = P.bid; u < 256; u += P.G) mlstm_unit<false>(a, P, l, u); }
        }
        SEAM(g0 + 2); TEND(2); TBEG();
        if (PON(3) && IN(g0 + 3)) { const Args a = load_args(); unsigned char* ws = a.ws; const float* mod = (const float*)(ws + WS_MOD); bf16* proj = (bf16*)(ws + WS_PROJ); const float* xin = (l == 0) ? a.x : a.out; (void)mod; (void)proj; (void)xin; const Ctx P = fresh(X); mlstm_scan(a, P); }
        SEAM(g0 + 3); TEND(3); TBEG();
        if (PON(4) && IN(g0 + 4)) for (int rep = 0; rep < NREP(4); ++rep) { const Args a = load_args(); unsigned char* ws = a.ws; const float* mod = (const float*)(ws + WS_MOD); bf16* proj = (bf16*)(ws + WS_PROJ); const float* xin = (l == 0) ? a.x : a.out; (void)mod; (void)proj; (void)xin; const Ctx P = fresh(X);
#pragma unroll 1
            for (int u = P.bid; u < 256; u += P.G) mlstm_unit<true>(a, P, l, u); }
        SEAM(g0 + 4); TEND(4); TBEG();
        if (PON(5) && IN(g0 + 5)) for (int rep = 0; rep < NREP(5); ++rep) { const Args a = load_args(); unsigned char* ws = a.ws; const float* mod = (const float*)(ws + WS_MOD); bf16* proj = (bf16*)(ws + WS_PROJ); const float* xin = (l == 0) ? a.x : a.out; (void)mod; (void)proj; (void)xin; const Ctx P = fresh(X);
            { DenseSched S; S.A = (const char*)(ws + WS_H); S.Bt = (const char*)(ws + WS_WAU) + (size_t)l * D * 512 * 2; S.lda = 512; S.ldb = 512; S.ord.init(T / 256, D / 256, P.G, P.bid);
              EpiGate<false> E; E.P = proj; E.gcol = C_GA; pg8::gemm_phase<EpiGate<false>, DenseSched>(P.lds, 512, S, E); }
            { DenseSched S; S.A = (const char*)(ws + WS_H) + (size_t)T * 512 * 2; S.Bt = (const char*)(ws + WS_WMU) + (size_t)l * D * 512 * 2; S.lda = 512; S.ldb = 512; S.ord.init(T / 256, D / 256, P.G, P.bid);
              EpiGate<true> E; E.P = proj; E.gcol = C_GB; pg8::gemm_phase<EpiGate<true>, DenseSched>(P.lds, 512, S, E); }
        }
        SEAM(g0 + 5); TEND(5); TBEG();
        if (PON(6) && IN(g0 + 6)) for (int rep = 0; rep < NREP(6); ++rep) { const Args a = load_args(); unsigned char* ws = a.ws; const float* mod = (const float*)(ws + WS_MOD); bf16* proj = (bf16*)(ws + WS_PROJ); const float* xin = (l == 0) ? a.x : a.out; (void)mod; (void)proj; (void)xin; const Ctx P = fresh(X);
            DenseSched S; S.A = (const char*)(proj + C_MQ); S.Bt = (const char*)(ws + WS_WOUT) + (size_t)l * D * D * 2; S.lda = NPROJ; S.ldb = D; S.ord.init(T / 256, D / 256, P.G, P.bid);
            EpiRes E; E.xin = xin; E.out = a.out; E.g = mod + (size_t)(l * 2) * 6144 + 2 * 1024; E.rmask = T - 1;
            if (rep) { E.out = (float*)(ws + WS_H); E.rmask = T / 2 - 1; }
            pg8::gemm_phase<EpiRes, DenseSched>(P.lds, D, S, E);
        }
        SEAM(g0 + 6); TEND(6); TBEG();
        if (PON(7) && IN(g0 + 7)) { const Args a = load_args(); unsigned char* ws = a.ws; const float* mod = (const float*)(ws + WS_MOD); bf16* proj = (bf16*)(ws + WS_PROJ); const float* xin = (l == 0) ? a.x : a.out; (void)mod; (void)proj; (void)xin; const Ctx P = fresh(X); p6_norm_route(a, P, l, a.out); }
        SEAM(g0 + 7); TEND(7); TBEG();
        if (PON(8) && IN(g0 + 8)) for (int rep = 0; rep < NREP(8); ++rep) { const Args a = load_args(); unsigned char* ws = a.ws; const float* mod = (const float*)(ws + WS_MOD); bf16* proj = (bf16*)(ws + WS_PROJ); const float* xin = (l == 0) ? a.x : a.out; (void)mod; (void)proj; (void)xin; const Ctx P = fresh(X);
            const MoeTab tb = moe_tables(a, P, l);
            LAS unsigned* tokoff = (LAS unsigned*)(P.lds + TOKOFF_OFF); const int* tokl = (const int*)(ws + WS_TOKL);
#pragma unroll 1
            for (int s = 0; s < 8; ++s) { const int L0 = s * P.G + P.bid;
                if (L0 < tb.Rtot * 8 && P.tid < 256) { const int L = xcd_remap(L0, tb.Rtot * 8); const int rt = L >> 3, cls = tb.tcls[rt], pos = tb.tpos[rt] + P.tid, cn = tb.cnt[cls]; const int tok = tokl[cls * CLS_CAP + (pos < cn ? pos : 0)]; tokoff[s * 256 + P.tid] = (unsigned)tok; } }
            __syncthreads();
            MoeUpSched S; S.A = (const char*)(ws + WS_H); S.W = (const char*)(ws + WS_WGU) + (size_t)l * NE * 1024 * D * 2; S.lda = D; S.ldb = D; S.tb = tb; S.G = P.G; S.c = P.bid; S.tokoff = tokoff;
            EpiSwiglu E; E.H = proj; E.tgate = (const float*)(ws + WS_TGATE); E.tokoff = tokoff;
            pg8::gemm_phase<EpiSwiglu, MoeUpSched>(P.lds, D, S, E);
        }
        SEAM(g0 + 8); TEND(8); TBEG();
        if (PON(9) && IN(g0 + 9)) for (int rep = 0; rep < NREP(9); ++rep) { const Args a = load_args(); unsigned char* ws = a.ws; const float* mod = (const float*)(ws + WS_MOD); bf16* proj = (bf16*)(ws + WS_PROJ); const float* xin = (l == 0) ? a.x : a.out; (void)mod; (void)proj; (void)xin; const Ctx P = fresh(X);
            const MoeTab tb = moe_tables(a, P, l);
            MoeDownSched S; S.A = (const char*)proj; S.W = (const char*)(ws + WS_WD) + (size_t)l * NE * 1024 * FF * 2; S.lda = D; S.ldb = FF; S.tb = tb; S.G = P.G; S.c = P.bid;
            EpiMoeOut E; E.xin = a.out; E.out = a.out; E.g = mod + (size_t)(l * 2) * 6144 + 5 * 1024; E.tokl = (const int*)(ws + WS_TOKL); E.tb = tb; E.rmask = T - 1;
            if (rep) { E.out = (float*)(ws + WS_H); E.rmask = T / 2 - 1; }
            pg8::gemm_phase<EpiMoeOut, MoeDownSched>(P.lds, D, S, E);
        }
        SEAM(g0 + 9); TEND(9); TBEG();
    }
    if (TSEL_MASK && X.bid == 0) { const unsigned long long t1 = __builtin_amdgcn_s_memrealtime(); while (__builtin_amdgcn_s_memrealtime() - t1 < TSCALE * tacc) __builtin_amdgcn_s_sleep(8); }
#undef IN
#undef SEAM
}

extern "C" void kernel_launch(void* const* d_in, const int* in_sizes, int n_in, void* d_out, int out_size, void* d_ws, size_t ws_size, hipStream_t stream) {
    static int grid = 0;
    if (grid == 0) {
        if (n_in != 24 || in_sizes[0] != T * D || out_size != T * D || ws_size < WS_END) { fprintf(stderr, "kernel_launch: unexpected shapes / workspace (n_in %d, ws %zu, need %zu)\n", n_in, ws_size, (size_t)WS_END); grid = -1; return; }
        int dev = 0, cus = 0;
        if (hipGetDevice(&dev) != hipSuccess || hipDeviceGetAttribute(&cus, hipDeviceAttributeMultiprocessorCount, dev) != hipSuccess) { grid = -1; return; }
        if (hipFuncSetAttribute((const void*)fwd, hipFuncAttributeMaxDynamicSharedMemorySize, LDS_BYTES) != hipSuccess) { fprintf(stderr, "kernel_launch: hipFuncSetAttribute failed\n"); grid = -1; return; }
        int per_cu = 0;
        if (hipOccupancyMaxActiveBlocksPerMultiprocessor(&per_cu, (const void*)fwd, 512, LDS_BYTES) != hipSuccess || per_cu < 1) fprintf(stderr, "kernel_launch: occupancy query reports %d\n", per_cu);
        (void)hipGetLastError();
        grid = cus < 256 ? cus : 256;
    }
    if (grid < 0) return;
    (void)hipMemsetAsync((char*)d_ws + WS_CTL, 0, CTL_ZERO_BYTES, stream);
    Args a{};
    a.x = (const float*)d_in[0]; a.c = (const float*)d_in[1]; a.pos = (const int*)d_in[2]; a.ada_w = (const float*)d_in[3]; a.ada_b = (const float*)d_in[4];
    a.nmw = (const float*)d_in[5]; a.nfw = (const float*)d_in[6]; a.w_in = (const float*)d_in[7]; a.b_ig = (const float*)d_in[8]; a.b_fg = (const float*)d_in[9];
    a.qnw = (const float*)d_in[10]; a.knw = (const float*)d_in[11]; a.sinks = (const float*)d_in[12]; a.conv_w = (const float*)d_in[13]; a.conv_b = (const float*)d_in[14];
    a.mnw = (const float*)d_in[15]; a.w_au = (const float*)d_in[16]; a.w_mu = (const float*)d_in[17]; a.w_out = (const float*)d_in[18]; a.router_w = (const float*)d_in[19];
    a.router_b = (const float*)d_in[20]; a.w_gate = (const float*)d_in[21]; a.w_up = (const float*)d_in[22]; a.w_down = (const float*)d_in[23];
    a.out = (float*)d_out; a.ws = (unsigned char*)d_ws;
#if MK_MULTI
    for (int gp = 0; gp < NGP; ++gp) { a.ph_lo = gp; a.ph_hi = gp + 1; hipLaunchKernelGGL(fwd, dim3(grid), dim3(512), LDS_BYTES, stream, a); }
#else
    a.ph_lo = 0; a.ph_hi = NGP; hipLaunchKernelGGL(fwd, dim3(grid), dim3(512), LDS_BYTES, stream, a);
#endif
}
```

```cpp
#include <hip/hip_runtime.h>
#include <cstdio>
#include <cstdint>

#ifndef MK_MULTI
#define MK_MULTI 0
#endif

#define GAS __attribute__((address_space(1)))
#define LAS __attribute__((address_space(3)))
typedef unsigned short bf16;
typedef unsigned v4u __attribute__((ext_vector_type(4)));
typedef unsigned v2u __attribute__((ext_vector_type(2)));
typedef float f32x4 __attribute__((ext_vector_type(4)));
typedef float f32x2 __attribute__((ext_vector_type(2)));
typedef short bf16x8 __attribute__((ext_vector_type(8)));
typedef short bf16x4 __attribute__((ext_vector_type(4)));
#define DI __device__ __forceinline__
#define RLX_AGENT __ATOMIC_RELAXED, __HIP_MEMORY_SCOPE_AGENT
#define LDS_WAIT() asm volatile("s_waitcnt lgkmcnt(0)" ::: "memory")
#define VM_WAIT() asm volatile("s_waitcnt vmcnt(0)" ::: "memory")

constexpr int NB = 2, SEQ = 16384, T = NB * SEQ, D = 1024, NL = 4;
constexpr int DIN_SRC = 4872;
constexpr int NPROJ = 4864;
constexpr int C_AQ = 0, C_AK = 512, C_AV = 640, C_MQ = 768, C_MK = 1280, C_MV = 1792, C_MO = 2304, C_GA = 2816, C_GB = 3840;
constexpr int NE = 16, FF = 512;
constexpr int NCLS = 24, CLS_CAP = 32768;
constexpr float EPS = 1e-6f;
constexpr int NPH = 10;
constexpr int NGP = 1 + NL * NPH;

constexpr size_t MiB = 1u << 20;
constexpr size_t WS_CTL = 0, CTL_ZERO_BYTES = 1 * MiB;
constexpr size_t WS_MOD = 1 * MiB;
constexpr size_t WS_ROPE = 2 * MiB;
constexpr size_t WS_GATES = 4 * MiB;
constexpr size_t WS_TGATE = 5 * MiB;
constexpr size_t WS_TOKL = 6 * MiB;
constexpr size_t WS_MLB = 9 * MiB;
constexpr size_t WS_MLC = 10 * MiB;
constexpr int NPROJW = 5120;
constexpr size_t WS_WIN = 28 * MiB;
constexpr size_t WS_WAU = 68 * MiB;
constexpr size_t WS_WMU = 72 * MiB;
constexpr size_t WS_WOUT = 76 * MiB;
constexpr size_t WS_WGU = 84 * MiB;
constexpr size_t WS_WD = 212 * MiB;
constexpr size_t WS_H = 276 * MiB;
constexpr size_t WS_PROJ = 340 * MiB;
constexpr size_t WS_SSQ = 644 * MiB;
constexpr size_t WS_END = 646 * MiB;

constexpr int CW_TMO = 0;
constexpr int CW_BAR = 4096;
constexpr int CW_CNT = 8192;

constexpr int RING_BYTES = 131072;
constexpr int MISC_OFF = RING_BYTES;
constexpr int TAB_OFF = RING_BYTES + 256;
constexpr int TOKOFF_OFF = RING_BYTES + 2048;
constexpr int LDS_BYTES = 147456;

DI unsigned f2bf(float f) { unsigned u = __builtin_bit_cast(unsigned, f); return (u + 0x7fffu + ((u >> 16) & 1u)) >> 16; }
DI unsigned pk2(float lo, float hi) { return f2bf(lo) | (f2bf(hi) << 16); }
DI float bf2f(unsigned short b) { return __builtin_bit_cast(float, ((unsigned)b) << 16); }
DI float bflo(unsigned w) { return __builtin_bit_cast(float, w << 16); }
DI float bfhi(unsigned w) { return __builtin_bit_cast(float, w & 0xffff0000u); }
DI float wave_sum(float v) {
#pragma unroll
    for (int o = 1; o < 64; o <<= 1) v += __shfl_xor(v, o);
    return v;
}
DI float sigmoidf_(float x) { return __builtin_amdgcn_rcpf(1.0f + __expf(-x)); }

#define XB_TMO      128
#define XB_XCNT(j)  (256  + 64 * (j))
#define XB_XSUB(j)  (1280 + 64 * (j))
#define XB_XGEN(j)  (2304 + 64 * (j))
#define XB_TOP      3328
#define XB_TOPGEN   3392
#define XCD_BAR_WORDS 3456
#define XB_SPIN_CAP (1u << 18)
__device__ __forceinline__ unsigned xb_ld(unsigned* p)              { return __hip_atomic_load(p, __ATOMIC_RELAXED, __HIP_MEMORY_SCOPE_AGENT); }
__device__ __forceinline__ unsigned xb_add(unsigned* p, unsigned v) { return __hip_atomic_fetch_add(p, v, __ATOMIC_RELAXED, __HIP_MEMORY_SCOPE_AGENT); }
__device__ __forceinline__ unsigned xb_xcc_id() { return (unsigned)__builtin_amdgcn_s_getreg((3 << 11) | 20) & 0xFu; }
#define XB_SPIN(cond, bar) do { unsigned _sp = 0; while (cond) { __builtin_amdgcn_s_sleep(1); \
    if ((++_sp & 255u) == 0u) { if (xb_ld(&(bar)[XB_TMO])) break; if (_sp > XB_SPIN_CAP) { atomicAdd(&(bar)[XB_TMO], 1u); break; } } } } while (0)
struct XcdBarrier { unsigned* bar; unsigned x; volatile LAS unsigned* st; };
__device__ __forceinline__ XcdBarrier xcd_barrier_post(unsigned* bar, volatile LAS unsigned* st) {
    XcdBarrier b; b.bar = bar; b.x = xb_xcc_id(); b.st = st;
    if (threadIdx.x == 0) (void)xb_add(&bar[XB_XCNT(b.x)], 1u);
    return b;
}
__device__ __forceinline__ void xcd_barrier_complete(unsigned* bar, unsigned x, unsigned& nloc, unsigned& nx) {
    const unsigned G = gridDim.x * gridDim.y * gridDim.z;
    unsigned sum, cnt, mine, sp = 0u;
    for (;;) {
        sum = 0u; cnt = 0u; mine = 0u;
#pragma unroll
        for (unsigned j = 0; j < 16; ++j) { const unsigned c = xb_ld(&bar[XB_XCNT(j)]); sum += c; cnt += (c > 0u) ? 1u : 0u; mine = (j == x) ? c : mine; }
        if (sum == G) break;
        __builtin_amdgcn_s_sleep(1);
        if ((++sp & 255u) == 0u) { if (xb_ld(&bar[XB_TMO])) break; if (sp > XB_SPIN_CAP) { atomicAdd(&bar[XB_TMO], 1u); break; } }
    }
    nloc = mine > 0u ? mine : 1u; nx = cnt > 0u ? cnt : 1u;
}
__device__ __forceinline__ void xcd_barrier(const XcdBarrier& b) {
    asm volatile("s_waitcnt vmcnt(0)" ::: "memory");
    __syncthreads();
    if (threadIdx.x == 0) {
        unsigned* bar = b.bar;
        __builtin_amdgcn_s_waitcnt(0);
        unsigned nloc = b.st[0], nx = b.st[1];
        if (nloc == 0u) { xcd_barrier_complete(bar, b.x, nloc, nx); b.st[0] = nloc; b.st[1] = nx; }
        const unsigned old = xb_add(&bar[XB_XSUB(b.x)], 1u);
        const unsigned gen = old / nloc;
        if (old + 1u == (gen + 1u) * nloc) {
            __builtin_amdgcn_fence(__ATOMIC_RELEASE, "agent");
            asm volatile("s_waitcnt vmcnt(0)" ::: "memory");
            const unsigned og = xb_add(&bar[XB_TOP], 1u);
            const unsigned tg = og / nx;
            if (og + 1u == (tg + 1u) * nx) xb_add(&bar[XB_TOPGEN], 1u);
            else XB_SPIN(xb_ld(&bar[XB_TOPGEN]) == tg, bar);
            __builtin_amdgcn_fence(__ATOMIC_ACQUIRE, "agent");
            xb_add(&bar[XB_XGEN(b.x)], 1u);
            asm volatile("s_waitcnt vmcnt(0)" ::: "memory");
        } else {
            XB_SPIN(xb_ld(&bar[XB_XGEN(b.x)]) == gen, bar);
            __builtin_amdgcn_fence(__ATOMIC_ACQUIRE, "agent");
            asm volatile("s_waitcnt vmcnt(0)" ::: "memory");
        }
    }
    __syncthreads();
}

namespace pg8 {
constexpr int BM = 256, BK = 64, HALF = 128, HTB = HALF * BK * 2, STAGE_BYTES = 8 * HTB, NXCD = 8, WGM = 8;
__host__ __device__ __forceinline__ int lds_byte(int r, int c) { const int st = (r >> 4) * 2 + (c >> 5), rr = r & 15, cc = c & 31, ob = rr * 64 + cc * 2; return st * 1024 + (ob ^ (((ob >> 9) & 1) << 5)); }
__host__ __device__ __forceinline__ void stage_rc(int b, int& R, int& C) { const int st = b / 1024, sb = b % 1024, swz = sb ^ (((sb >> 9) & 1) << 5); R = (st >> 1) * 16 + swz / 64; C = (st & 1) * 32 + (swz % 64) / 2; }
__host__ __device__ __forceinline__ int perm32(int rho) { const int n = rho >> 4, i = rho & 15; return 8 * (i >> 2) + 4 * n + (i & 3); }

struct Unit { int pm, pn, x0, x1; };

struct TileOrder {
    int nM, nN, nwg, G, c;
    __device__ void init(int nM_, int nN_, int G_, int c_) { nM = nM_; nN = nN_; nwg = nM * nN; G = G_; c = c_; }
    __device__ bool get(int i, int& pm, int& pn) const {
        const long L = (long)i * G + c; if (L >= nwg) return false;
        int wgid = (int)L; { const int q = nwg / NXCD, r = nwg % NXCD, xcd = wgid % NXCD, off = wgid / NXCD; wgid = (xcd < r ? xcd * (q + 1) : r * (q + 1) + (xcd - r) * q) + off; }
        const int nig = WGM * nN, gid = wgid / nig, fm = gid * WGM, gsz = (nM - fm) < WGM ? (nM - fm) : WGM;
        pm = fm + ((wgid % nig) % gsz); pn = (wgid % nig) / gsz; return true;
    }
};

template <class Epi, class Sched>
__device__ __forceinline__ void gemm_phase(LAS unsigned char* lds, const int K, const Sched& S, const Epi& E) {
    int tid = threadIdx.x; asm volatile("" : "+v"(tid));
    const int wid = __builtin_amdgcn_readfirstlane(tid >> 6), lane = tid & 63, wr = wid >> 2, wc = wid & 3, fr = lane & 15, fq = lane >> 4;
    const int nt = K / BK;
    constexpr bool GA = Sched::GATHER; constexpr int KS = Sched::KSPLIT;
    unsigned voffA[2], voffB[2]; int Rst[2], Cst[2];
#pragma unroll
    for (int i = 0; i < 2; ++i) { int R, C; stage_rc(tid * 16 + i * 8192, R, C); const int Rb = Epi::PERM ? ((R & ~31) + perm32(R & 31)) : R;
        voffA[i] = (unsigned)(R * S.lda + C) * 2u; voffB[i] = (unsigned)(Rb * S.ldb + C) * 2u; Rst[i] = R; Cst[i] = C; }
    const size_t kstep = (size_t)(BK * 2);
    const size_t hstepA = (size_t)HALF * S.lda * 2, hstepB = (size_t)HALF * S.ldb * 2;
    const unsigned ldsw = (unsigned)wid * 1024u; const unsigned gmul = (unsigned)S.lda * 2u;
    const int aoff = lds_byte(wr * 64 + fr, fq * 8), boff = lds_byte(wc * 32 + fr, fq * 8);
    unsigned vAc[2], vAn[2];
#define PG8_SA(b, h) (((b) * 2 + (h)) * HTB)
#define PG8_SB(b, h) ((4 + (b) * 2 + (h)) * HTB)
#define PG8_STAGE2(bufoff, gbase, v0, v1) do { \
        __builtin_amdgcn_global_load_lds((const unsigned*)((const char*)(gbase) + (v0)), (LAS unsigned*)(lds + (bufoff) + ldsw), 16, 0, 0); \
        __builtin_amdgcn_global_load_lds((const unsigned*)((const char*)(gbase) + (v1)), (LAS unsigned*)(lds + (bufoff) + ldsw + 8192), 16, 0, 0); } while (0)
#define PG8_STAGE_B(bufoff, ptr, h) PG8_STAGE2(bufoff, (ptr) + (h) * hstepB, voffB[0], voffB[1])
#define PG8_STAGE_A(bufoff, ptr, h, nx) do { if constexpr (GA) { const unsigned _p = (nx) ? vAn[h] : vAc[h]; PG8_STAGE2(bufoff, ptr, (_p & 0xffffu) * gmul + (unsigned)Cst[0] * 2u, (_p >> 16) * gmul + (unsigned)Cst[0] * 2u); } \
        else { PG8_STAGE2(bufoff, (ptr) + (h) * hstepA, voffA[0], voffA[1]); } } while (0)
#define PG8_LDA(dst, b, h) do { _Pragma("unroll") for (int m = 0; m < 4; ++m) _Pragma("unroll") for (int k = 0; k < 2; ++k) dst[m][k] = *(const LAS bf16x8*)(lds + PG8_SA(b, h) + aoff + m * 2048 + k * 1024); } while (0)
#define PG8_LDB(dst, b, h) do { _Pragma("unroll") for (int n = 0; n < 2; ++n) _Pragma("unroll") for (int k = 0; k < 2; ++k) dst[n][k] = *(const LAS bf16x8*)(lds + PG8_SB(b, h) + boff + n * 2048 + k * 1024); } while (0)
#define PG8_MMA(ai, bj, At, Bt) do { __builtin_amdgcn_s_setprio(1); _Pragma("unroll") for (int m = 0; m < 4; ++m) _Pragma("unroll") for (int n = 0; n < 2; ++n) _Pragma("unroll") for (int k = 0; k < 2; ++k) \
        acc[ai][bj][m][n] = __builtin_amdgcn_mfma_f32_16x16x32_bf16(Bt[n][k], At[m][k], acc[ai][bj][m][n], 0, 0, 0); __builtin_amdgcn_s_setprio(0); } while (0)
#define PG8_WAIT_V(n) asm volatile("s_waitcnt vmcnt(" #n ")" ::: "memory")
#define PG8_WAIT_L(n) asm volatile("s_waitcnt lgkmcnt(" #n ")" ::: "memory")
#define PG8_BAR __builtin_amdgcn_s_barrier()
#define PG8_SCHED __builtin_amdgcn_sched_barrier(0)
#define PG8_GOFF(dst, u) do { if constexpr (GA) { _Pragma("unroll") for (int h = 0; h < 2; ++h) dst[h] = S.a_rowoff(u, Rst[0] + HALF * h) | (S.a_rowoff(u, Rst[0] + 64 + HALF * h) << 16); } } while (0)
    Unit cur, nxt; int ui = 0;
    if (!S.next(0, cur)) return;
    f32x4 acc[2][2][4][2];
#pragma unroll
    for (int a = 0; a < 2; ++a)
#pragma unroll
        for (int b = 0; b < 2; ++b)
#pragma unroll
            for (int m = 0; m < 4; ++m)
#pragma unroll
                for (int n = 0; n < 2; ++n) acc[a][b][m][n] = (f32x4){0.f, 0.f, 0.f, 0.f};
    bf16x8 At[4][2], B0[2][2], B1[2][2];
    const char* cA = S.a_base(cur); const char* cB0 = S.b_base(cur, 0); const char* cB1 = KS ? S.b_base(cur, 1) : cB0;
    PG8_GOFF(vAc, cur);
    vAn[0] = vAc[0]; vAn[1] = vAc[1];
    PG8_STAGE_B(PG8_SB(0, 0), cB0, 0); PG8_STAGE_B(PG8_SB(0, 1), cB0, 1); PG8_STAGE_A(PG8_SA(0, 0), cA, 0, false); PG8_STAGE_A(PG8_SA(0, 1), cA, 1, false);
    if (wr == 1) PG8_BAR;
    PG8_WAIT_V(2); PG8_BAR;
    PG8_STAGE_B(PG8_SB(1, 0), cB0 + kstep, 0); PG8_STAGE_A(PG8_SA(1, 0), cA + kstep, 0, false); PG8_STAGE_B(PG8_SB(1, 1), cB0 + kstep, 1);
    PG8_WAIT_V(6); PG8_BAR;
    for (;;) {
        const bool has_next = S.next(ui + 1, nxt);
        const char* nA = has_next ? S.a_base(nxt) : cA; const char* nB0 = has_next ? S.b_base(nxt, 0) : cB0; const char* nB1 = (KS && has_next) ? S.b_base(nxt, 1) : (KS ? cB1 : nB0);
        if constexpr (GA) { if (has_next) { PG8_GOFF(vAn, nxt); } }
        for (int t = 0; t < nt; t += 2) {
            const bool last = (t == nt - 2);
            const char* a1 = cA + (size_t)(t + 1) * kstep;
            const char* a2 = last ? nA : cA + (size_t)(t + 2) * kstep;
            const char* b2 = last ? nB0 : ((KS && (t + 2) >= KS) ? cB1 + (size_t)(t + 2 - KS) * kstep : cB0 + (size_t)(t + 2) * kstep);
            const char* a3 = a2 + kstep; const char* b3 = b2 + kstep;
            PG8_LDB(B0, 0, 0); PG8_LDB(B1, 0, 1); PG8_SCHED; PG8_LDA(At, 0, 0); PG8_STAGE_A(PG8_SA(1, 1), a1, 1, false);
            PG8_WAIT_V(8); PG8_WAIT_L(0); PG8_BAR; PG8_MMA(0, 0, At, B0); PG8_MMA(0, 1, At, B1); PG8_BAR; PG8_SCHED;
            PG8_LDA(At, 0, 1); PG8_STAGE_B(PG8_SB(0, 0), b2, 0); PG8_STAGE_B(PG8_SB(0, 1), b2, 1); PG8_STAGE_A(PG8_SA(0, 0), a2, 0, last);
            PG8_WAIT_V(8); PG8_WAIT_L(0); PG8_BAR; PG8_MMA(1, 0, At, B0); PG8_MMA(1, 1, At, B1); PG8_BAR; PG8_SCHED;
            PG8_LDB(B0, 1, 0); PG8_LDB(B1, 1, 1); PG8_SCHED; PG8_LDA(At, 1, 0); PG8_STAGE_A(PG8_SA(0, 1), a2, 1, last);
            PG8_WAIT_V(8); PG8_WAIT_L(0); PG8_BAR; PG8_MMA(0, 0, At, B0); PG8_MMA(0, 1, At, B1); PG8_BAR; PG8_SCHED;
            PG8_LDA(At, 1, 1); PG8_STAGE_B(PG8_SB(1, 0), b3, 0); PG8_STAGE_B(PG8_SB(1, 1), b3, 1); PG8_STAGE_A(PG8_SA(1, 0), a3, 0, last);
            PG8_WAIT_V(8); PG8_WAIT_L(0); PG8_BAR; PG8_MMA(1, 0, At, B0); PG8_MMA(1, 1, At, B1); PG8_BAR; PG8_SCHED;
        }
        if (wr == 0) PG8_BAR;
        { int fr_ = fr, fq_ = fq; asm volatile("" : "+v"(fr_), "+v"(fq_));
          E(acc, cur, wr, wc, fr_, fq_); }
        if (!has_next) break;
#pragma unroll
        for (int a = 0; a < 2; ++a)
#pragma unroll
            for (int b = 0; b < 2; ++b)
#pragma unroll
                for (int m = 0; m < 4; ++m)
#pragma unroll
                    for (int n = 0; n < 2; ++n) acc[a][b][m][n] = (f32x4){0.f, 0.f, 0.f, 0.f};
        cur = nxt; cA = nA; cB0 = nB0; cB1 = nB1; ++ui;
        vAc[0] = vAn[0]; vAc[1] = vAn[1];
        if (wr == 1) PG8_BAR;
    }
    PG8_WAIT_V(0);
    PG8_BAR;
#undef PG8_SA
#undef PG8_SB
#undef PG8_STAGE2
#undef PG8_STAGE_A
#undef PG8_STAGE_B
#undef PG8_LDA
#undef PG8_LDB
#undef PG8_MMA
#undef PG8_WAIT_V
#undef PG8_WAIT_L
#undef PG8_BAR
#undef PG8_SCHED
#undef PG8_GOFF
}
}
using pg8::Unit;

DI unsigned cvt_pk_bf16(float lo, float hi) { unsigned r; asm volatile("v_cvt_pk_bf16_f32 %0, %1, %2" : "=v"(r) : "v"(lo), "v"(hi)); return r; }

struct Args {
    const float* x; const float* c; const int* pos; const float* ada_w; const float* ada_b; const float* nmw; const float* nfw; const float* w_in;
    const float* b_ig; const float* b_fg; const float* qnw; const float* knw; const float* sinks; const float* conv_w; const float* conv_b; const float* mnw;
    const float* w_au; const float* w_mu; const float* w_out; const float* router_w; const float* router_b; const float* w_gate; const float* w_up; const float* w_down;
    float* out; unsigned char* ws; int ph_lo, ph_hi;
};

__constant__ float c_invf[8] = {1.0f, 0.1939227432012558f, 0.03760603070259094f, 0.007292664609849453f, 0.0014142135623842478f, 0.00027424818836152554f, 5.3182957344688475e-05f, 1.0313385246263351e-05f};

struct DenseSched {
    static constexpr bool GATHER = false; static constexpr int KSPLIT = 0;
    const char* A; const char* Bt; int lda, ldb; pg8::TileOrder ord;
    DI bool next(int i, Unit& u) const { int pm, pn; if (!ord.get(i, pm, pn)) return false; u.pm = pm; u.pn = pn; u.x0 = 0; u.x1 = 0; return true; }
    DI const char* a_base(const Unit& u) const { return A + (size_t)u.pm * 256 * lda * 2; }
    DI const char* b_base(const Unit& u, int) const { return Bt + (size_t)u.pn * 256 * ldb * 2; }
    DI unsigned a_rowoff(const Unit&, int) const { return 0u; }
};
struct EpiProj {
    static constexpr bool PERM = true;
    bf16* O; float* gates; const float* big; const float* bfg;
    DI void operator()(const f32x4 (&acc)[2][2][4][2], const Unit& u, int wr, int wc, int fr, int fq) const {
        const int row0 = u.pm * 256 + wr * 64 + fr, col0 = u.pn * 256 + wc * 32 + 8 * fq; const bool sg = u.pn >= 9;
        if (u.pn == 19) {
            if (wc == 0 && fq == 0) {
#pragma unroll
                for (int ai = 0; ai < 2; ++ai)
#pragma unroll
                    for (int m = 0; m < 4; ++m) { const int row = row0 + ai * 128 + m * 16; const f32x4 vi = acc[ai][0][m][0], vf = acc[ai][0][m][1]; f32x4 oi, of;
#pragma unroll
                        for (int j = 0; j < 4; ++j) { oi[j] = vi[j] + big[j]; const float z = vf[j] + bfg[j]; of[j] = fminf(z, 0.f) - log1pf(__expf(-fabsf(z))); }
                        *(f32x4*)(gates + (size_t)row * 8) = oi; *(f32x4*)(gates + (size_t)row * 8 + 4) = of; } }
            return; }
#pragma unroll
        for (int ai = 0; ai < 2; ++ai)
#pragma unroll
            for (int m = 0; m < 4; ++m) { bf16* rowp = O + (size_t)(row0 + ai * 128 + m * 16) * NPROJ + col0;
#pragma unroll
                for (int bj = 0; bj < 2; ++bj) { f32x4 v0 = acc[ai][bj][m][0], v1 = acc[ai][bj][m][1];
                    if (sg) {
#pragma unroll
                        for (int j = 0; j < 4; ++j) { v0[j] = sigmoidf_(v0[j]); v1[j] = sigmoidf_(v1[j]); } }
                    v4u w; w.x = cvt_pk_bf16(v0[0], v0[1]); w.y = cvt_pk_bf16(v0[2], v0[3]); w.z = cvt_pk_bf16(v1[0], v1[1]); w.w = cvt_pk_bf16(v1[2], v1[3]);
                    *(v4u*)(rowp + bj * 128) = w; } }
    }
};
template <bool ADD> struct EpiGate {
    static constexpr bool PERM = true;
    bf16* P; int gcol;
    DI void operator()(const f32x4 (&acc)[2][2][4][2], const Unit& u, int wr, int wc, int fr, int fq) const {
        const int row0 = u.pm * 256 + wr * 64 + fr, col0 = u.pn * 256 + wc * 32 + 8 * fq;
#pragma unroll
        for (int ai = 0; ai < 2; ++ai)
#pragma unroll
            for (int m = 0; m < 4; ++m) { bf16* rowp = P + (size_t)(row0 + ai * 128 + m * 16) * NPROJ + col0;
#pragma unroll
                for (int bj = 0; bj < 2; ++bj) { const f32x4 v0 = acc[ai][bj][m][0], v1 = acc[ai][bj][m][1];
                    const v4u g = *(const v4u*)(rowp + gcol + bj * 128);
                    float o[8] = {bflo(g.x) * v0[0], bfhi(g.x) * v0[1], bflo(g.y) * v0[2], bfhi(g.y) * v0[3], bflo(g.z) * v1[0], bfhi(g.z) * v1[1], bflo(g.w) * v1[2], bfhi(g.w) * v1[3]};
                    if (ADD) { const v4u p = *(const v4u*)(rowp + C_MQ + bj * 128);
                        o[0] += bflo(p.x); o[1] += bfhi(p.x); o[2] += bflo(p.y); o[3] += bfhi(p.y); o[4] += bflo(p.z); o[5] += bfhi(p.z); o[6] += bflo(p.w); o[7] += bfhi(p.w); }
                    v4u w; w.x = cvt_pk_bf16(o[0], o[1]); w.y = cvt_pk_bf16(o[2], o[3]); w.z = cvt_pk_bf16(o[4], o[5]); w.w = cvt_pk_bf16(o[6], o[7]);
                    *(v4u*)(rowp + C_MQ + bj * 128) = w; } }
    }
};
struct EpiRes {
    static constexpr bool PERM = false;
    const float* xin; float* out; const float* g; float* ssq; int rmask;
    DI void operator()(const f32x4 (&acc)[2][2][4][2], const Unit& u, int wr, int wc, int fr, int fq) const {
        const int row0 = u.pm * 256 + wr * 64 + fr, col0 = u.pn * 256 + wc * 32 + 4 * fq; const int b = (u.pm * 256) >> 14;
        f32x4 gv[2][2];
#pragma unroll
        for (int bj = 0; bj < 2; ++bj)
#pragma unroll
            for (int n = 0; n < 2; ++n) gv[bj][n] = *(const f32x4*)(g + b * 6144 + col0 + bj * 128 + n * 16);
#pragma unroll
        for (int ai = 0; ai < 2; ++ai)
#pragma unroll
            for (int m = 0; m < 4; ++m) { const size_t off = (size_t)(row0 + ai * 128 + m * 16) * D + col0; const size_t offo = (size_t)((row0 + ai * 128 + m * 16) & rmask) * D + col0; float sq = 0.f;
#pragma unroll
                for (int bj = 0; bj < 2; ++bj)
#pragma unroll
                    for (int n = 0; n < 2; ++n) { const f32x4 xv = *(const f32x4*)(xin + off + bj * 128 + n * 16); const f32x4 o = xv + gv[bj][n] * acc[ai][bj][m][n];
                        sq += (o.x * o.x + o.y * o.y) + (o.z * o.z + o.w * o.w);
                        *(f32x4*)(out + offo + bj * 128 + n * 16) = o; }
                sq += __shfl_xor(sq, 16); sq += __shfl_xor(sq, 32);
                if (fq == 0) ssq[(size_t)(row0 + ai * 128 + m * 16) * 16 + u.pn * 4 + wc] = sq; }
    }
};

struct MoeTab { const LAS int* tcls; const LAS int* tpos; const LAS int* cnt; int Rtot; };
DI int xcd_remap(int L, int nwg) { const int q = nwg >> 3, r = nwg & 7, xcd = L & 7, off = L >> 3; return (xcd < r ? xcd * (q + 1) : r * (q + 1) + (xcd - r) * q) + off; }
DI void cls_experts(int cls, int& ea, int& eb) { const int g = cls / 6, p = cls - 6 * g; const int a = (p < 3) ? 0 : ((p < 5) ? 1 : 2); const int b = (p < 3) ? (p + 1) : ((p < 5) ? (p - 1) : 3); ea = 4 * g + a; eb = 4 * g + b; }
struct MoeUpSched {
    static constexpr bool GATHER = true; static constexpr int KSPLIT = 0;
    const char* A; const char* W; int lda, ldb; MoeTab tb; int G, c; const LAS unsigned* tokoff;
    DI bool next(int i, Unit& u) const { const int L0 = i * G + c; if (L0 >= tb.Rtot * 8) return false; const int L = xcd_remap(L0, tb.Rtot * 8); u.pm = L >> 3; u.pn = L & 7; u.x0 = i; u.x1 = __builtin_amdgcn_readfirstlane(tb.tcls[u.pm]); return true; }
    DI const char* a_base(const Unit&) const { return A; }
    DI const char* b_base(const Unit& u, int) const { int ea, eb; cls_experts(u.x1, ea, eb); const int e = (u.pn < 4) ? ea : eb; return W + ((size_t)e * 1024 + (size_t)(u.pn & 3) * 256) * 1024 * 2; }
    DI unsigned a_rowoff(const Unit& u, int r) const { return tokoff[u.x0 * 256 + r]; }
};
struct EpiSwiglu {
    static constexpr bool PERM = true;
    bf16* H; const float* tgate; const LAS unsigned* tokoff;
    DI void operator()(const f32x4 (&acc)[2][2][4][2], const Unit& u, int wr, int wc, int fr, int fq) const {
        const int r0 = wr * 64 + fr; const int hc = (u.pn >> 2) * 512 + (u.pn & 3) * 128 + wc * 32 + 8 * fq; const int gsel = u.pn >> 2;
#pragma unroll
        for (int ai = 0; ai < 2; ++ai)
#pragma unroll
            for (int m = 0; m < 4; ++m) { const int r = r0 + ai * 128 + m * 16; const unsigned tok = tokoff[u.x0 * 256 + r]; const float rg = tgate[tok * 2 + gsel];
                const f32x4 g0 = acc[ai][0][m][0], g1 = acc[ai][0][m][1], u0 = acc[ai][1][m][0], u1 = acc[ai][1][m][1];
                float o[8];
#pragma unroll
                for (int j = 0; j < 4; ++j) { o[j] = g0[j] * sigmoidf_(g0[j]) * u0[j] * rg; o[4 + j] = g1[j] * sigmoidf_(g1[j]) * u1[j] * rg; }
                v4u w; w.x = cvt_pk_bf16(o[0], o[1]); w.y = cvt_pk_bf16(o[2], o[3]); w.z = cvt_pk_bf16(o[4], o[5]); w.w = cvt_pk_bf16(o[6], o[7]);
                *(v4u*)(H + ((size_t)u.pm * 256 + r) * 1024 + hc) = w; }
    }
};
struct MoeDownSched {
    static constexpr bool GATHER = false; static constexpr int KSPLIT = 8;
    const char* A; const char* W; int lda, ldb; MoeTab tb; int G, c;
    DI bool next(int i, Unit& u) const { const int L0 = i * G + c; if (L0 >= tb.Rtot * 4) return false; const int L = xcd_remap(L0, tb.Rtot * 4); u.pm = L >> 2; u.pn = L & 3; u.x0 = __builtin_amdgcn_readfirstlane(tb.tpos[u.pm]); u.x1 = __builtin_amdgcn_readfirstlane(tb.tcls[u.pm]); return true; }
    DI const char* a_base(const Unit& u) const { return A + (size_t)u.pm * 256 * lda * 2; }
    DI const char* b_base(const Unit& u, int half) const { int ea, eb; cls_experts(u.x1, ea, eb); const int e = half ? eb : ea; return W + ((size_t)e * 1024 + (size_t)u.pn * 256) * 512 * 2; }
    DI unsigned a_rowoff(const Unit&, int) const { return 0u; }
};
struct EpiMoeOut {
    static constexpr bool PERM = false;
    const float* xin; float* out; const float* g; const int* tokl; MoeTab tb; int rmask;
    DI void operator()(const f32x4 (&acc)[2][2][4][2], const Unit& u, int wr, int wc, int fr, int fq) const {
        const int r0 = wr * 64 + fr, col0 = u.pn * 256 + wc * 32 + 4 * fq; const int cn = tb.cnt[u.x1];
#pragma unroll
        for (int ai = 0; ai < 2; ++ai)
#pragma unroll
            for (int m = 0; m < 4; ++m) { const int pos = u.x0 + r0 + ai * 128 + m * 16;
                if (pos < cn) { const int tok = tokl[u.x1 * CLS_CAP + pos]; const int b = tok >> 14; const float* ip = xin + (size_t)tok * D + col0; float* op = out + (size_t)(tok & rmask) * D + col0; const float* gp = g + b * 6144 + col0;
#pragma unroll
                    for (int bj = 0; bj < 2; ++bj)
#pragma unroll
                        for (int n = 0; n < 2; ++n) { const f32x4 xv = *(const f32x4*)(ip + bj * 128 + n * 16); const f32x4 gv = *(const f32x4*)(gp + bj * 128 + n * 16);
                            *(f32x4*)(op + bj * 128 + n * 16) = xv + gv * acc[ai][bj][m][n]; } } }
    }
};

struct Ctx { LAS unsigned char* lds; int tid, lane, wave, G, bid; };
DI Ctx fresh(const Ctx& X) { Ctx P = X; int t = X.tid; asm volatile("" : "+v"(t)); P.tid = t; P.lane = t & 63; P.wave = __builtin_amdgcn_readfirstlane(t >> 6); return P; }

DI void tr_item(const float* W, int ldw, int K, bf16* WT, int k0, LAS float* scr, int lane) {
#pragma unroll 8
    for (int i = 0; i < 32; ++i) { const int kk = 2 * i + (lane >> 5); scr[kk * 33 + (lane & 31)] = W[(size_t)(k0 + kk) * ldw + (lane & 31)]; }
    LDS_WAIT(); asm volatile("" ::: "memory");
    const int c = lane & 7;
#pragma unroll
    for (int j = 0; j < 4; ++j) { const int n = (lane >> 3) + 8 * j; const LAS float* s = scr + (8 * c) * 33 + n;
        v4u o; o.x = pk2(s[0 * 33], s[1 * 33]); o.y = pk2(s[2 * 33], s[3 * 33]); o.z = pk2(s[4 * 33], s[5 * 33]); o.w = pk2(s[6 * 33], s[7 * 33]);
        *(v4u*)(WT + (size_t)n * K + k0 + 8 * c) = o; }
    LDS_WAIT(); asm volatile("" ::: "memory");
}
DI void p0_prologue(const Args& a, const Ctx& X) {
    unsigned char* ws = a.ws;
    LAS float* scr = (LAS float*)(X.lds + X.wave * 16384);
    const int gw = X.bid * 8 + X.wave, NGW = X.G * 8;
    constexpr int IT_WIN = 16 * 153, IT_AU = 8 * 32, IT_OUT = 16 * 32, IT_GU = 16 * 16 * 32, IT_DN = 16 * 8 * 32;
    constexpr int IT_L = IT_WIN + 2 * IT_AU + IT_OUT + IT_GU + IT_DN;
    for (int it = gw; it < NL * IT_L; it += NGW) {
        const int l = it / IT_L; int r = it - l * IT_L;
        if (r < IT_WIN) { const int kb = r / 153, nb = r - kb * 153, d0 = 32 * nb, s0 = (nb == 152) ? 2304 : (d0 + (d0 >= 2304 ? 8 : 0));
            tr_item(a.w_in + (size_t)l * D * DIN_SRC + s0, DIN_SRC, D, (bf16*)(ws + WS_WIN) + ((size_t)l * NPROJW + d0) * D, 64 * kb, scr, X.lane); continue; }
        r -= IT_WIN;
        if (r < IT_AU) { const int kb = r >> 5, nb = r & 31;
            tr_item(a.w_au + (size_t)l * 512 * D + 32 * nb, D, 512, (bf16*)(ws + WS_WAU) + ((size_t)l * D + 32 * nb) * 512, 64 * kb, scr, X.lane); continue; }
        r -= IT_AU;
        if (r < IT_AU) { const int kb = r >> 5, nb = r & 31;
            tr_item(a.w_mu + (size_t)l * 512 * D + 32 * nb, D, 512, (bf16*)(ws + WS_WMU) + ((size_t)l * D + 32 * nb) * 512, 64 * kb, scr, X.lane); continue; }
        r -= IT_AU;
        if (r < IT_OUT) { const int kb = r >> 5, nb = r & 31;
            tr_item(a.w_out + (size_t)l * D * D + 32 * nb, D, D, (bf16*)(ws + WS_WOUT) + ((size_t)l * D + 32 * nb) * D, 64 * kb, scr, X.lane); continue; }
        r -= IT_OUT;
        if (r < IT_GU) { const int e = r >> 9, q = r & 511, kb = q >> 5, nb = q & 31, tq = nb >> 3, rb = nb & 7;
            const float* src = ((rb < 4) ? a.w_gate : a.w_up) + ((size_t)(l * NE + e) * D) * FF + 128 * tq + 32 * (rb & 3);
            tr_item(src, FF, D, (bf16*)(ws + WS_WGU) + ((size_t)(l * NE + e) * 1024 + 32 * nb) * D, 64 * kb, scr, X.lane); continue; }
        r -= IT_GU;
        { const int e = r >> 8, q = r & 255, kb = q >> 5, nb = q & 31;
            tr_item(a.w_down + ((size_t)(l * NE + e) * FF) * D + 32 * nb, D, FF, (bf16*)(ws + WS_WD) + ((size_t)(l * NE + e) * 1024 + 32 * nb) * FF, 64 * kb, scr, X.lane); }
    }
    { float* cs = (float*)(ws + WS_ROPE); float* sn = cs + (size_t)T * 8;
      for (int i = X.bid * 512 + X.tid; i < T * 8; i += X.G * 512) { const int tok = i >> 3, f = i & 7; const float angf = (float)a.pos[tok] * c_invf[f];
          double rev = (double)angf * 0.15915494309189535; rev -= rint(rev); const float rf = (float)rev;
          cs[i] = __builtin_amdgcn_cosf(rf); sn[i] = __builtin_amdgcn_sinf(rf); } }
    __syncthreads();
    LAS float* cact = (LAS float*)X.lds; LAS float* red = (LAS float*)(X.lds + 8192);
    for (int i = X.tid; i < 2048; i += 512) { const float cv = a.c[i]; cact[i] = cv / (1.0f + __expf(-cv)); }
    __syncthreads();
    float* mod = (float*)(ws + WS_MOD);
    for (int it = X.bid; it < NL * 96; it += X.G) { const int l = it / 96, cg = it - l * 96; const int col = cg * 64 + X.lane;
        const float* w = a.ada_w + (size_t)l * D * 6144 + col; float s0 = 0.f, s1 = 0.f;
#pragma unroll 8
        for (int kk = 0; kk < 128; ++kk) { const int k = X.wave * 128 + kk; const float wv = w[(size_t)k * 6144]; s0 += cact[k] * wv; s1 += cact[1024 + k] * wv; }
        red[(X.wave * 2 + 0) * 64 + X.lane] = s0; red[(X.wave * 2 + 1) * 64 + X.lane] = s1;
        __syncthreads();
        if (X.tid < 128) { const int b = X.tid >> 6, ln = X.tid & 63; float s = 0.f;
#pragma unroll
            for (int w8 = 0; w8 < 8; ++w8) s += red[(w8 * 2 + b) * 64 + ln];
            mod[(size_t)(l * 2 + b) * 6144 + cg * 64 + ln] = s + a.ada_b[l * 6144 + cg * 64 + ln]; }
        __syncthreads();
    }
}

DI void p1_norm_gates(const Args& a, const Ctx& X, int l, const float* xin) {
    unsigned char* ws = a.ws;
    const float* mod = (const float*)(ws + WS_MOD); bf16* hb = (bf16*)(ws + WS_H);
    const int gw = X.bid * 8 + X.wave, NGW = X.G * 8;
    for (int rg = gw; rg < T / 16; rg += NGW) {
        const int row0 = rg * 16, b = row0 >> 14;
        const float* mb = mod + (size_t)(l * 2 + b) * 6144;
        f32x4 aw[4], sh[4];
#pragma unroll
        for (int j = 0; j < 4; ++j) { const int k = 256 * j + 4 * X.lane; const f32x4 nw = *(const f32x4*)(a.nmw + l * D + k); const f32x4 sc = *(const f32x4*)(mb + 1024 + k); aw[j] = nw * (sc + 1.0f); sh[j] = *(const f32x4*)(mb + k); }
        f32x4 pre[4][4];
#pragma unroll
        for (int q = 0; q < 4; ++q) { const f32x4* xp = (const f32x4*)(xin + (size_t)(row0 + q) * D) + X.lane;
#pragma unroll
            for (int j = 0; j < 4; ++j) pre[q][j] = xp[64 * j]; }
#pragma unroll 1
        for (int rb = 0; rb < 16; rb += 4) {
#pragma unroll
          for (int q = 0; q < 4; ++q) { const int row = row0 + rb + q;
            f32x4 v[4]; float ss = 0.f;
#pragma unroll
            for (int j = 0; j < 4; ++j) v[j] = pre[q][j];
            if (rb + 4 < 16) { const f32x4* xp = (const f32x4*)(xin + (size_t)(row + 4) * D) + X.lane;
#pragma unroll
                for (int j = 0; j < 4; ++j) pre[q][j] = xp[64 * j]; }
#pragma unroll
            for (int j = 0; j < 4; ++j) ss += (v[j].x * v[j].x + v[j].y * v[j].y) + (v[j].z * v[j].z + v[j].w * v[j].w);
            ss = wave_sum(ss); const float rstd = __builtin_amdgcn_rsqf(ss * (1.0f / D) + EPS);
            v2u* o8 = (v2u*)(hb + (size_t)row * D) + X.lane;
#pragma unroll
            for (int j = 0; j < 4; ++j) { v[j] = v[j] * rstd * aw[j] + sh[j]; v2u o; o.x = cvt_pk_bf16(v[j].x, v[j].y); o.y = cvt_pk_bf16(v[j].z, v[j].w); o8[64 * j] = o; }
          }
        }
    }
}

DI void attn_unit(const Args& a, const Ctx& X, int l, int unit) {
    unsigned char* ws = a.ws; const bf16* proj = (const bf16*)(ws + WS_PROJ); bf16* ao = (bf16*)(ws + WS_H);
    const float* cs = (const float*)(ws + WS_ROPE); const float* sn = cs + (size_t)T * 8;
    const int b = unit >> 8, rem = unit & 255, nb = rem >> 1, kvh = rem & 1; const int tok0 = b * SEQ + nb * 128;
    LAS bf16* Kl = (LAS bf16*)X.lds;
    LAS bf16* VT = (LAS bf16*)(X.lds + 36864);
    int lane = X.lane; asm volatile("" : "+v"(lane));
    const int c16 = lane & 15, quad = lane >> 4;
    {
        const int row = X.tid >> 1, half = X.tid & 1; const int tokk = tok0 - 128 + row; const bool valid = (nb > 0) || (row >= 128);
        float y[32]; float vv[32];
        if (valid) {
            const v4u* kp = (const v4u*)(proj + (size_t)tokk * NPROJ + C_AK + kvh * 64 + half * 32); const v4u* vp = (const v4u*)(proj + (size_t)tokk * NPROJ + C_AV + kvh * 64 + half * 32);
#pragma unroll
            for (int q = 0; q < 4; ++q) { const v4u kw = kp[q], vw = vp[q];
                y[8 * q + 0] = bflo(kw.x); y[8 * q + 1] = bfhi(kw.x); y[8 * q + 2] = bflo(kw.y); y[8 * q + 3] = bfhi(kw.y); y[8 * q + 4] = bflo(kw.z); y[8 * q + 5] = bfhi(kw.z); y[8 * q + 6] = bflo(kw.w); y[8 * q + 7] = bfhi(kw.w);
                vv[8 * q + 0] = bflo(vw.x); vv[8 * q + 1] = bfhi(vw.x); vv[8 * q + 2] = bflo(vw.y); vv[8 * q + 3] = bfhi(vw.y); vv[8 * q + 4] = bflo(vw.z); vv[8 * q + 5] = bfhi(vw.z); vv[8 * q + 6] = bflo(vw.w); vv[8 * q + 7] = bfhi(vw.w); }
        } else {
#pragma unroll
            for (int i = 0; i < 32; ++i) { y[i] = 0.f; vv[i] = 0.f; } }
        float ss = 0.f;
#pragma unroll
        for (int i = 0; i < 32; ++i) ss += y[i] * y[i];
        ss += __shfl_xor(ss, 1); const float rstd = 1.0f / sqrtf(ss * (1.0f / 64.0f) + EPS);
#pragma unroll
        for (int i = 0; i < 32; ++i) y[i] = y[i] * rstd * a.knw[l * 64 + half * 32 + i];
        if (half == 0 && valid) {
#pragma unroll
            for (int d = 0; d < 8; ++d) { const float c = cs[(size_t)tokk * 8 + d], s = sn[(size_t)tokk * 8 + d]; const float t1 = y[d], t2 = y[d + 8]; y[d] = t1 * c - t2 * s; y[d + 8] = t2 * c + t1 * s; } }
#pragma unroll
        for (int q = 0; q < 4; ++q) { v4u w; w.x = pk2(y[8 * q], y[8 * q + 1]); w.y = pk2(y[8 * q + 2], y[8 * q + 3]); w.z = pk2(y[8 * q + 4], y[8 * q + 5]); w.w = pk2(y[8 * q + 6], y[8 * q + 7]);
            *(LAS v4u*)(Kl + row * 72 + half * 32 + 8 * q) = w; }
#pragma unroll
        for (int i = 0; i < 32; ++i) VT[(half * 32 + i) * 280 + row] = (bf16)f2bf(vv[i]);
        if (X.tid < 64) {
#pragma unroll
            for (int cc = 256; cc < 280; ++cc) VT[X.tid * 280 + cc] = 0; }
    }
    __syncthreads();
#pragma unroll 1
    for (int task = X.wave; task < 32; task += 8) {
        const int g = task >> 3, rg = task & 7, r0 = 16 * rg, head = kvh * 4 + g; const int tokq = tok0 + r0 + c16;
        const float sink = a.sinks[l * 8 + head];
        float qv[16];
        { const bf16* qp = proj + (size_t)tokq * NPROJ + C_AQ + head * 64; const v4u w0 = *(const v4u*)(qp + 8 * quad), w1 = *(const v4u*)(qp + 32 + 8 * quad);
          qv[0] = bflo(w0.x); qv[1] = bfhi(w0.x); qv[2] = bflo(w0.y); qv[3] = bfhi(w0.y); qv[4] = bflo(w0.z); qv[5] = bfhi(w0.z); qv[6] = bflo(w0.w); qv[7] = bfhi(w0.w);
          qv[8] = bflo(w1.x); qv[9] = bfhi(w1.x); qv[10] = bflo(w1.y); qv[11] = bfhi(w1.y); qv[12] = bflo(w1.z); qv[13] = bfhi(w1.z); qv[14] = bflo(w1.w); qv[15] = bfhi(w1.w); }
        float ss = 0.f;
#pragma unroll
        for (int i = 0; i < 16; ++i) ss += qv[i] * qv[i];
        ss += __shfl_xor(ss, 16); ss += __shfl_xor(ss, 32); const float rstd = 1.0f / sqrtf(ss * (1.0f / 64.0f) + EPS);
#pragma unroll
        for (int i = 0; i < 8; ++i) { qv[i] = qv[i] * rstd * a.qnw[l * 64 + 8 * quad + i]; qv[8 + i] = qv[8 + i] * rstd * a.qnw[l * 64 + 32 + 8 * quad + i]; }
#pragma unroll
        for (int d = 0; d < 8; ++d) { const float other = __shfl_xor(qv[d], 16); const float c = cs[(size_t)tokq * 8 + d], s = sn[(size_t)tokq * 8 + d];
            if (quad == 0) qv[d] = qv[d] * c - other * s; else if (quad == 1) qv[d] = qv[d] * c + other * s; }
        bf16x8 qf[2];
        { v4u w; w.x = pk2(qv[0], qv[1]); w.y = pk2(qv[2], qv[3]); w.z = pk2(qv[4], qv[5]); w.w = pk2(qv[6], qv[7]); qf[0] = __builtin_bit_cast(bf16x8, w);
          w.x = pk2(qv[8], qv[9]); w.y = pk2(qv[10], qv[11]); w.z = pk2(qv[12], qv[13]); w.w = pk2(qv[14], qv[15]); qf[1] = __builtin_bit_cast(bf16x8, w); }
        f32x4 sacc[9];
#pragma unroll
        for (int i = 0; i < 9; ++i) { const LAS bf16* kr = Kl + (16 * (rg + i) + c16) * 72 + 8 * quad;
            const bf16x8 k0 = *(const LAS bf16x8*)kr, k1 = *(const LAS bf16x8*)(kr + 32);
            f32x4 z = {0.f, 0.f, 0.f, 0.f}; z = __builtin_amdgcn_mfma_f32_16x16x32_bf16(k0, qf[0], z, 0, 0, 0); sacc[i] = __builtin_amdgcn_mfma_f32_16x16x32_bf16(k1, qf[1], z, 0, 0, 0); }
        int dbase = 4 * quad - c16; asm volatile("" : "+v"(dbase)); int kbase = 16 * rg + 4 * quad; asm volatile("" : "+v"(kbase)); float mx = sink;
#pragma unroll
        for (int i = 0; i < 9; ++i)
#pragma unroll
            for (int j = 0; j < 4; ++j) { const int dlt = dbase + 16 * i + j; const int kj = kbase + 16 * i + j; const bool ok = (dlt > 0) && (dlt <= 128) && ((nb > 0) || (kj >= 128));
                const float s = ok ? sacc[i][j] * 0.125f : -3.0e38f; sacc[i][j] = s; mx = fmaxf(mx, s); }
        mx = fmaxf(mx, __shfl_xor(mx, 16)); mx = fmaxf(mx, __shfl_xor(mx, 32));
        float sum = 0.f;
#pragma unroll
        for (int i = 0; i < 9; ++i)
#pragma unroll
            for (int j = 0; j < 4; ++j) { const float p = (sacc[i][j] > -1.0e38f) ? __expf(sacc[i][j] - mx) : 0.f; sacc[i][j] = p; sum += p; }
        sum += __shfl_xor(sum, 16); sum += __shfl_xor(sum, 32);
        const float inv = 1.0f / (sum + __expf(sink - mx));
        f32x4 oacc[4];
#pragma unroll
        for (int et = 0; et < 4; ++et) oacc[et] = (f32x4){0.f, 0.f, 0.f, 0.f};
#pragma unroll
        for (int kk = 0; kk < 5; ++kk) {
            v4u pw; pw.x = pk2(sacc[2 * kk][0], sacc[2 * kk][1]); pw.y = pk2(sacc[2 * kk][2], sacc[2 * kk][3]);
            if (2 * kk + 1 < 9) { pw.z = pk2(sacc[(2 * kk + 1 < 9) ? 2 * kk + 1 : 0][0], sacc[(2 * kk + 1 < 9) ? 2 * kk + 1 : 0][1]); pw.w = pk2(sacc[(2 * kk + 1 < 9) ? 2 * kk + 1 : 0][2], sacc[(2 * kk + 1 < 9) ? 2 * kk + 1 : 0][3]); } else { pw.z = 0u; pw.w = 0u; }
            const bf16x8 pf = __builtin_bit_cast(bf16x8, pw);
#pragma unroll
            for (int et = 0; et < 4; ++et) { const LAS bf16* vr = VT + (16 * et + c16) * 280 + 16 * rg + 32 * kk + 4 * quad;
                const v2u lo = *(const LAS v2u*)vr, hi = *(const LAS v2u*)(vr + 16); v4u vw; vw.x = lo.x; vw.y = lo.y; vw.z = hi.x; vw.w = hi.y;
                oacc[et] = __builtin_amdgcn_mfma_f32_16x16x32_bf16(__builtin_bit_cast(bf16x8, vw), pf, oacc[et], 0, 0, 0); }
        }
#pragma unroll
        for (int et = 0; et < 4; ++et) { v2u w; w.x = pk2(oacc[et][0] * inv, oacc[et][1] * inv); w.y = pk2(oacc[et][2] * inv, oacc[et][3] * inv);
            *(v2u*)(ao + (size_t)tokq * 512 + head * 64 + 16 * et + 4 * quad) = w; }
    }
    __syncthreads();
}

constexpr int ML_Q = 0, ML_K = 17408, ML_KET = 34816, ML_VT = 53248, ML_CT = 73984, ML_CW = 113152, ML_CB = 118272, ML_RED = 118784, ML_NW = 119296;
template <bool L3> DI void mlstm_unit(const Args& a, const Ctx& X, int l, int unit) {
    unsigned char* ws = a.ws; const bf16* proj = (const bf16*)(ws + WS_PROJ); bf16* hm = (bf16*)(ws + WS_H) + (size_t)T * 512;
    const float* gates = (const float*)(ws + WS_GATES); float* mlc = (float*)(ws + WS_MLC) + (size_t)unit * 18432; float* mlb = (float*)(ws + WS_MLB);
    const int seq = unit >> 5, sj = unit & 31, b = seq >> 2, hh = seq & 3; const int tokbase = b * SEQ + sj * 512;
    LAS bf16* Qs = (LAS bf16*)(X.lds + ML_Q); LAS bf16* Ks = (LAS bf16*)(X.lds + ML_K); LAS bf16* KET = (LAS bf16*)(X.lds + ML_KET);
    LAS bf16* VT = (LAS bf16*)(X.lds + ML_VT); LAS bf16* CT = (LAS bf16*)(X.lds + ML_CT); LAS float* CW = (LAS float*)(X.lds + ML_CW);
    LAS float* CB = (LAS float*)(X.lds + ML_CB); LAS float* RED = (LAS float*)(X.lds + ML_RED); LAS float* NW = (LAS float*)(X.lds + ML_NW);
    int lane = X.lane; asm volatile("" : "+v"(lane));
    const int c16 = lane & 15, quad = lane >> 4, w = X.wave;
    for (int idx = X.tid; idx < 1280; idx += 512) { const int tap = idx >> 8, ch = idx & 255; const int gch = (ch < 128) ? (hh * 128 + ch) : (512 + hh * 128 + (ch - 128));
        CW[idx] = (tap < 4) ? a.conv_w[(size_t)(l * 4 + tap) * 1024 + gch] : a.conv_b[l * 1024 + gch]; }
    for (int idx = X.tid; idx < 16 * 72; idx += 512) VT[128 * 72 + idx] = (idx < 72) ? (bf16)0x3F80 : (bf16)0;
    if (X.tid < 128) NW[X.tid] = a.mnw[l * 512 + hh * 128 + X.tid];
    f32x4 cacc[9];
#pragma unroll
    for (int et = 0; et < 9; ++et) {
        if (L3) {
#pragma unroll
            for (int j = 0; j < 4; ++j) { const float v = mlc[(16 * et + 4 * quad + j) * 128 + 16 * w + c16]; cacc[et][j] = v; CT[(16 * et + 4 * quad + j) * 136 + 16 * w + c16] = (bf16)f2bf(v); }
        } else cacc[et] = (f32x4){0.f, 0.f, 0.f, 0.f};
    }
    float bsum = 0.f;
    __syncthreads();
#pragma unroll 1
    for (int c = 0; c < 8; ++c) {
        const int tok0 = tokbase + c * 64;
        float bsc = gates[(size_t)(tok0 + lane) * 8 + 4 + hh]; const float li = gates[(size_t)(tok0 + lane) * 8 + hh];
#pragma unroll
        for (int o = 1; o < 64; o <<= 1) { const float v = __shfl_up(bsc, o); if (lane >= o) bsc += v; }
        const float bl = __shfl(bsc, 63); const float csv = li - bsc;
        if (w == 0) { CB[lane] = bsc; CB[64 + lane] = csv; }
        bsum += bl;
        { const int t = X.tid >> 3, dc = X.tid & 7; const float fac = __expf(bl + __shfl(csv, t));
          const int tokt = tok0 + t;
#pragma unroll
          for (int qk = (L3 ? 0 : 1); qk < 2; ++qk) {
              float accv[16];
#pragma unroll
              for (int i = 0; i < 16; ++i) accv[i] = CW[4 * 256 + qk * 128 + 16 * dc + i];
#pragma unroll
              for (int j = 0; j < 4; ++j) { const int tt = tokt - 3 + j;
                  if (tt >= b * SEQ) { const v4u* p = (const v4u*)(proj + (size_t)tt * NPROJ + (qk ? C_MK : C_MQ) + hh * 128 + 16 * dc); const v4u w0 = p[0], w1 = p[1];
                      const float xv[16] = {bflo(w0.x), bfhi(w0.x), bflo(w0.y), bfhi(w0.y), bflo(w0.z), bfhi(w0.z), bflo(w0.w), bfhi(w0.w), bflo(w1.x), bfhi(w1.x), bflo(w1.y), bfhi(w1.y), bflo(w1.z), bfhi(w1.z), bflo(w1.w), bfhi(w1.w)};
#pragma unroll
                      for (int i = 0; i < 16; ++i) accv[i] += CW[j * 256 + qk * 128 + 16 * dc + i] * xv[i]; } }
#pragma unroll
              for (int i = 0; i < 16; ++i) { const float z = accv[i]; accv[i] = z / (1.0f + __expf(-z)) * (qk ? 0.08838834764831845f : 1.0f); }
              if (L3) { LAS bf16* dst = (qk ? Ks : Qs) + t * 136 + 16 * dc;
                  v4u o0, o1; o0.x = pk2(accv[0], accv[1]); o0.y = pk2(accv[2], accv[3]); o0.z = pk2(accv[4], accv[5]); o0.w = pk2(accv[6], accv[7]);
                  o1.x = pk2(accv[8], accv[9]); o1.y = pk2(accv[10], accv[11]); o1.z = pk2(accv[12], accv[13]); o1.w = pk2(accv[14], accv[15]);
                  *(LAS v4u*)dst = o0; *(LAS v4u*)(dst + 8) = o1; }
              if (qk) {
#pragma unroll
                  for (int i = 0; i < 16; ++i) KET[(16 * dc + i) * 72 + t] = (bf16)f2bf(accv[i] * fac); }
          }
          { const v4u* p = (const v4u*)(proj + (size_t)tokt * NPROJ + C_MV + hh * 128 + 16 * dc); const v4u w0 = p[0], w1 = p[1];
            const unsigned ww[8] = {w0.x, w0.y, w0.z, w0.w, w1.x, w1.y, w1.z, w1.w};
#pragma unroll
            for (int i = 0; i < 8; ++i) { VT[(16 * dc + 2 * i) * 72 + t] = (bf16)(ww[i] & 0xffffu); VT[(16 * dc + 2 * i + 1) * 72 + t] = (bf16)(ww[i] >> 16); } }
        }
        __syncthreads();
        float hval[4][4]; int tt_ = w & 3, eh = w >> 2; const int tq = 16 * tt_ + c16;
        if (L3) {
            bf16x8 qf[4];
#pragma unroll
            for (int ks = 0; ks < 4; ++ks) qf[ks] = *(const LAS bf16x8*)(Qs + tq * 136 + 32 * ks + 8 * quad);
            f32x4 sacc[4];
#pragma unroll
            for (int st = 0; st < 4; ++st) { f32x4 z = {0.f, 0.f, 0.f, 0.f};
#pragma unroll
                for (int ks = 0; ks < 4; ++ks) z = __builtin_amdgcn_mfma_f32_16x16x32_bf16(*(const LAS bf16x8*)(Ks + (16 * st + c16) * 136 + 32 * ks + 8 * quad), qf[ks], z, 0, 0, 0);
                sacc[st] = z; }
            const float cbt = CB[tq];
#pragma unroll
            for (int st = 0; st < 4; ++st)
#pragma unroll
                for (int j = 0; j < 4; ++j) { const int s = 16 * st + 4 * quad + j; const float d = (s <= tq) ? __expf(cbt + CB[64 + s]) : 0.f; sacc[st][j] *= d; }
            bf16x8 pf[2];
#pragma unroll
            for (int kk = 0; kk < 2; ++kk) { v4u pw; pw.x = pk2(sacc[2 * kk][0], sacc[2 * kk][1]); pw.y = pk2(sacc[2 * kk][2], sacc[2 * kk][3]); pw.z = pk2(sacc[2 * kk + 1][0], sacc[2 * kk + 1][1]); pw.w = pk2(sacc[2 * kk + 1][2], sacc[2 * kk + 1][3]); pf[kk] = __builtin_bit_cast(bf16x8, pw); }
            const float ebt = __expf(cbt);
            f32x4 nn[5];
#pragma unroll
            for (int x = 0; x < 5; ++x) { const int et = (x < 4) ? (4 * eh + x) : 8; f32x4 na = {0.f, 0.f, 0.f, 0.f}, ia = {0.f, 0.f, 0.f, 0.f};
#pragma unroll
                for (int kk = 0; kk < 2; ++kk) { const LAS bf16* vr = VT + (16 * et + c16) * 72 + 32 * kk + 4 * quad; const v2u lo = *(const LAS v2u*)vr, hi = *(const LAS v2u*)(vr + 16); v4u vw; vw.x = lo.x; vw.y = lo.y; vw.z = hi.x; vw.w = hi.y;
                    na = __builtin_amdgcn_mfma_f32_16x16x32_bf16(__builtin_bit_cast(bf16x8, vw), pf[kk], na, 0, 0, 0); }
#pragma unroll
                for (int ks = 0; ks < 4; ++ks) ia = __builtin_amdgcn_mfma_f32_16x16x32_bf16(*(const LAS bf16x8*)(CT + (16 * et + c16) * 136 + 32 * ks + 8 * quad), qf[ks], ia, 0, 0, 0);
                nn[x] = na + ia * ebt; }
            const float den = __shfl(nn[4][0], c16); const float inv = 1.0f / fmaxf(fabsf(den), 1.0f);
            float ss = 0.f;
#pragma unroll
            for (int x = 0; x < 4; ++x)
#pragma unroll
                for (int j = 0; j < 4; ++j) { hval[x][j] = nn[x][j] * inv; ss += hval[x][j] * hval[x][j]; }
            ss += __shfl_xor(ss, 16); ss += __shfl_xor(ss, 32);
            if (quad == 0) RED[eh * 64 + tq] = ss;
            __syncthreads();
            const float rstd = 1.0f / sqrtf((RED[tq] + RED[64 + tq]) * (1.0f / 128.0f) + EPS);
#pragma unroll
            for (int x = 0; x < 4; ++x) { const int e = 16 * (4 * eh + x) + 4 * quad; const v2u og = *(const v2u*)(proj + (size_t)(tok0 + tq) * NPROJ + C_MO + hh * 128 + e);
                const float y0 = hval[x][0] * rstd * NW[e] * bflo(og.x), y1 = hval[x][1] * rstd * NW[e + 1] * bfhi(og.x), y2 = hval[x][2] * rstd * NW[e + 2] * bflo(og.y), y3 = hval[x][3] * rstd * NW[e + 3] * bfhi(og.y);
                v2u o; o.x = pk2(y0, y1); o.y = pk2(y2, y3); *(v2u*)(hm + (size_t)(tok0 + tq) * 512 + hh * 128 + e) = o; }
        }
        { const float ebl = __expf(bl);
          bf16x8 kf[2];
#pragma unroll
          for (int kk = 0; kk < 2; ++kk) kf[kk] = *(const LAS bf16x8*)(KET + (16 * w + c16) * 72 + 32 * kk + 8 * quad);
#pragma unroll
          for (int et = 0; et < 9; ++et) { f32x4 z = cacc[et] * ebl;
#pragma unroll
              for (int kk = 0; kk < 2; ++kk) z = __builtin_amdgcn_mfma_f32_16x16x32_bf16(*(const LAS bf16x8*)(VT + (16 * et + c16) * 72 + 32 * kk + 8 * quad), kf[kk], z, 0, 0, 0);
              cacc[et] = z;
              if (L3) {
#pragma unroll
                  for (int j = 0; j < 4; ++j) CT[(16 * et + 4 * quad + j) * 136 + 16 * w + c16] = (bf16)f2bf(z[j]); } } }
        __syncthreads();
    }
    if (!L3) {
#pragma unroll
        for (int et = 0; et < 9; ++et)
#pragma unroll
            for (int j = 0; j < 4; ++j) mlc[(16 * et + 4 * quad + j) * 128 + 16 * w + c16] = cacc[et][j];
        if (X.tid == 0) mlb[unit] = bsum;
    }
}
DI void mlstm_scan(const Args& a, const Ctx& X) {
    float* mlc = (float*)(a.ws + WS_MLC); const float* mlb = (const float*)(a.ws + WS_MLB);
    for (int idx = X.bid * 512 + X.tid; idx < 8 * 18432; idx += X.G * 512) { const int seq = idx / 18432, el = idx - seq * 18432; float carry = 0.f;
        float* p0 = mlc + (size_t)seq * 32 * 18432 + el; float v[32], dcy[32];
#pragma unroll
        for (int j = 0; j < 32; ++j) { v[j] = p0[(size_t)j * 18432]; dcy[j] = mlb[seq * 32 + j]; }
#pragma unroll
        for (int j = 0; j < 32; ++j) { p0[(size_t)j * 18432] = carry; carry = __expf(dcy[j]) * carry + v[j]; } }
}

constexpr int P6_WR = 0, P6_AT = 33024, P6_SH = 37120, P6_LG = 41216, P6_HIST = 65536;
DI void p6_norm_route(const Args& a, const Ctx& X, int l, const float* xin) {
    unsigned char* ws = a.ws;
    LAS bf16* wrb = (LAS bf16*)(X.lds + P6_WR);
    LAS float* at = (LAS float*)(X.lds + P6_AT); LAS float* sht = (LAS float*)(X.lds + P6_SH);
    LAS float* lg = (LAS float*)(X.lds + P6_LG) + X.wave * 272;
    for (int idx = X.tid; idx < 16384; idx += 512) { const int k = idx >> 4, e = idx & 15; wrb[e * 1032 + k] = (bf16)f2bf(a.router_w[idx]); }
    const float* mod = (const float*)(ws + WS_MOD); bf16* hb = (bf16*)(ws + WS_H); float* tgate = (float*)(ws + WS_TGATE); int* tokl = (int*)(ws + WS_TOKL);
    const float* ssq = (const float*)(ws + WS_SSQ);
    unsigned* cnt = (unsigned*)(ws + WS_CTL) + CW_CNT + l * 2048;
    LAS int* hist = (LAS int*)(X.lds + P6_HIST); LAS int* cbase = hist + 32;
    int lane = X.lane; asm volatile("" : "+v"(lane));
    const int r = lane & 15, q = lane >> 4;
    const int gw = X.bid * 8 + X.wave, NGW = X.G * 8;
    for (int it = 0; it * NGW < T / 16; ++it) {
        const int rg = it * NGW + gw; const bool act = rg < T / 16;
        const int row0 = (act ? rg : 0) * 16; const int bb = ((it * NGW + X.bid * 8) * 16) >> 14;
        __syncthreads();
        if (X.tid < 32) hist[X.tid] = 0;
        { const float* mb = mod + (size_t)(l * 2 + (bb < 2 ? bb : 1)) * 6144;
          for (int k = X.tid; k < 1024; k += 512) { at[k] = a.nfw[l * D + k] * (1.0f + mb[4 * 1024 + k]); sht[k] = mb[3 * 1024 + k]; } }
        __syncthreads();
        const int row = row0 + r;
        float rstd;
        { const f32x4 pp = *(const f32x4*)(ssq + (size_t)row * 16 + 4 * q); float ss = (pp.x + pp.y) + (pp.z + pp.w); ss += __shfl_xor(ss, 16); ss += __shfl_xor(ss, 32); rstd = __builtin_amdgcn_rsqf(ss * (1.0f / D) + EPS); }
        const float* xr = xin + (size_t)row * D + 8 * q; bf16* hr = hb + (size_t)row * D + 8 * q;
        f32x4 acc = {0.f, 0.f, 0.f, 0.f};
#pragma unroll 8
        for (int s = 0; s < 32; ++s) {
            const f32x4 x0 = *(const f32x4*)(xr + 32 * s), x1 = *(const f32x4*)(xr + 32 * s + 4);
            const f32x4 a0 = *(const LAS f32x4*)(at + 32 * s + 8 * q), a1 = *(const LAS f32x4*)(at + 32 * s + 8 * q + 4);
            const f32x4 s0 = *(const LAS f32x4*)(sht + 32 * s + 8 * q), s1 = *(const LAS f32x4*)(sht + 32 * s + 8 * q + 4);
            const f32x4 h0 = x0 * rstd * a0 + s0, h1 = x1 * rstd * a1 + s1;
            v4u w; w.x = cvt_pk_bf16(h0.x, h0.y); w.y = cvt_pk_bf16(h0.z, h0.w); w.z = cvt_pk_bf16(h1.x, h1.y); w.w = cvt_pk_bf16(h1.z, h1.w);
            *(v4u*)(hr + 32 * s) = w;
            const bf16x8 bfr = *(const LAS bf16x8*)(wrb + r * 1032 + 32 * s + 8 * q);
            acc = __builtin_amdgcn_mfma_f32_16x16x32_bf16(__builtin_bit_cast(bf16x8, w), bfr, acc, 0, 0, 0);
        }
#pragma unroll
        for (int j = 0; j < 4; ++j) lg[(4 * q + j) * 17 + r] = acc[j];
        LDS_WAIT(); asm volatile("" ::: "memory");
        int my_cls = 0; float my_ga = 0.f, my_gb = 0.f;
        if (lane < 16) {
            float sc[16], sel[16];
#pragma unroll
            for (int e = 0; e < 16; ++e) { const float p = lg[lane * 17 + e]; sc[e] = 1.0f / (1.0f + __expf(-p)); sel[e] = sc[e] + a.router_b[e]; }
            int gi = 0; float gbest = -1.0e30f;
#pragma unroll
            for (int g = 0; g < 4; ++g) { const float p0 = sel[4 * g], p1 = sel[4 * g + 1], p2 = sel[4 * g + 2], p3 = sel[4 * g + 3];
                const float gs = fmaxf(fmaxf(fmaxf(p0 + p1, p0 + p2), fmaxf(p0 + p3, p1 + p2)), fmaxf(p1 + p3, p2 + p3));
                if (gs > gbest) { gbest = gs; gi = g; } }
            float qs[4], s4[4];
#pragma unroll
            for (int i = 0; i < 4; ++i) { qs[i] = 0.f; s4[i] = 0.f; }
#pragma unroll
            for (int g = 0; g < 4; ++g) if (g == gi) {
#pragma unroll
                for (int i = 0; i < 4; ++i) { qs[i] = sel[4 * g + i]; s4[i] = sc[4 * g + i]; } }
            int i1 = 0; float b1 = qs[0];
#pragma unroll
            for (int i = 1; i < 4; ++i) if (qs[i] > b1) { b1 = qs[i]; i1 = i; }
            int i2 = -1; float b2 = -1.0e30f;
#pragma unroll
            for (int i = 0; i < 4; ++i) if (i != i1 && qs[i] > b2) { b2 = qs[i]; i2 = i; }
            const int ia = (i1 < i2) ? i1 : i2, ib = (i1 < i2) ? i2 : i1;
            float sa = 0.f, sb = 0.f;
#pragma unroll
            for (int i = 0; i < 4; ++i) { if (i == ia) sa = s4[i]; if (i == ib) sb = s4[i]; }
            const int pidx = (ia == 0) ? (ib - 1) : ((ia == 1) ? (ib + 1) : 5);
            const float inv = 1.0f / (sa + sb);
            my_cls = gi * 6 + pidx; my_ga = sa * inv; my_gb = sb * inv;
        }
        int rank = 0;
        if (act && lane < 16) rank = __hip_atomic_fetch_add(hist + my_cls, 1, __ATOMIC_RELAXED, __HIP_MEMORY_SCOPE_WORKGROUP);
        __syncthreads();
        if (X.tid < NCLS) { const int n = hist[X.tid]; cbase[X.tid] = n ? (int)__hip_atomic_fetch_add(cnt + 64 * X.tid, (unsigned)n, RLX_AGENT) : 0; }
        __syncthreads();
        if (act && lane < 16) { const int tok = row0 + lane; const int pos = cbase[my_cls] + rank;
            tokl[my_cls * CLS_CAP + pos] = tok; tgate[tok * 2] = my_ga; tgate[tok * 2 + 1] = my_gb; }
    }
}
DI MoeTab moe_tables(const Args& a, const Ctx& X, int l) {
    LAS int* tab = (LAS int*)(X.lds + TAB_OFF); LAS int* tcls = tab; LAS int* tpos = tab + 160; LAS int* cn = tab + 320; LAS int* rt_ = tab + 344;
    unsigned* cnt = (unsigned*)(a.ws + WS_CTL) + CW_CNT + l * 2048;
    if (X.tid < NCLS) cn[X.tid] = (int)__hip_atomic_load(cnt + 64 * X.tid, RLX_AGENT);
    __syncthreads();
    if (X.tid == 0) { int r = 0;
#pragma unroll 1
        for (int c = 0; c < NCLS; ++c) { const int n = (cn[c] + 255) >> 8;
#pragma unroll 1
            for (int i = 0; i < n; ++i) { tcls[r] = c; tpos[r] = i * 256; ++r; } }
        rt_[0] = r; }
    __syncthreads();
    MoeTab tb; tb.tcls = tcls; tb.tpos = tpos; tb.cnt = cn; tb.Rtot = __builtin_amdgcn_readfirstlane(rt_[0]); return tb;
}

#if defined(__HIP_DEVICE_COMPILE__)
DI Args load_args() { auto p = __builtin_amdgcn_kernarg_segment_ptr(); asm volatile("" : "+s"(p)); return *(const __attribute__((address_space(4))) Args*)p; }
#else
DI Args load_args() { return Args{}; }
#endif
__global__ void __launch_bounds__(512, 2) fwd(Args a_unused) {
    extern __shared__ __attribute__((aligned(16))) unsigned char lds_raw[];
    Ctx X; X.lds = (LAS unsigned char*)lds_raw; X.tid = threadIdx.x; X.lane = X.tid & 63; X.wave = __builtin_amdgcn_readfirstlane(X.tid >> 6); X.G = gridDim.x; X.bid = blockIdx.x;
    volatile LAS unsigned* MISC = (volatile LAS unsigned*)(X.lds + MISC_OFF);
    if (X.tid < 64) MISC[X.tid] = 0u;
    __syncthreads();
    int lo, hi; unsigned* ctl;
    { const Args a = load_args(); lo = a.ph_lo; hi = a.ph_hi; ctl = (unsigned*)(a.ws + WS_CTL); }
    XcdBarrier bar; bar.bar = ctl + CW_BAR; bar.x = 0; bar.st = MISC + 8;
    if (hi - lo > 1) bar = xcd_barrier_post(ctl + CW_BAR, MISC + 8);
#ifndef PH_MASK
#define PH_MASK 0xFFFFF
#endif
#define PON(p) ((PH_MASK >> (p)) & 1)
#ifndef DUP_MASK
#define DUP_MASK 0
#endif
#define NREP(p) (((DUP_MASK >> (p)) & 1) ? 2 : 1)
#ifndef TSEL_MASK
#define TSEL_MASK 0
#endif
#define TSCALE 4
#define TSEL(p) ((TSEL_MASK >> (p)) & 1)
#define IN(k) (lo <= (k) && (k) < hi)
#define SEAM(k) do { if (IN(k) && IN((k) + 1)) xcd_barrier(bar); } while (0)
    unsigned long long tacc = 0ull, tph = 0ull;
#define TBEG() do { if (TSEL_MASK) tph = __builtin_amdgcn_s_memrealtime(); } while (0)
#define TEND(p) do { if (TSEL(p)) tacc += __builtin_amdgcn_s_memrealtime() - tph; } while (0)
    TBEG();
    if (PON(10) && IN(0)) { for (int rep = 0; rep < NREP(10); ++rep) { const Args a = load_args(); p0_prologue(a, X); } }
    SEAM(0); TEND(10);
    TBEG();
    for (int l = 0; l < NL; ++l) {
        const int g0 = 1 + l * NPH;
        if (PON(0) && IN(g0 + 0)) { for (int rep = 0; rep < NREP(0); ++rep) { const Args a = load_args(); unsigned char* ws = a.ws; const float* mod = (const float*)(ws + WS_MOD); bf16* proj = (bf16*)(ws + WS_PROJ); const float* xin = (l == 0) ? a.x : a.out; (void)mod; (void)proj; (void)xin; const Ctx P = fresh(X); p1_norm_gates(a, P, l, xin); } }
        SEAM(g0 + 0); TEND(0); TBEG();
        if (PON(1) && IN(g0 + 1)) for (int rep = 0; rep < NREP(1); ++rep) { const Args a = load_args(); unsigned char* ws = a.ws; const float* mod = (const float*)(ws + WS_MOD); bf16* proj = (bf16*)(ws + WS_PROJ); const float* xin = (l == 0) ? a.x : a.out; (void)mod; (void)proj; (void)xin; const Ctx P = fresh(X);
            DenseSched S; S.A = (const char*)(ws + WS_H); S.Bt = (const char*)(ws + WS_WIN) + (size_t)l * NPROJW * D * 2; S.lda = D; S.ldb = D; S.ord.init(T / 256, NPROJW / 256, P.G, P.bid);
            EpiProj E; E.O = proj; E.gates = (float*)(ws + WS_GATES); E.big = a.b_ig + l * 4; E.bfg = a.b_fg + l * 4;
            pg8::gemm_phase<EpiProj, DenseSched>(P.lds, D, S, E);
        }
        SEAM(g0 + 1); TEND(1); TBEG();
        if (PON(2) && IN(g0 + 2)) { const Args a = load_args(); unsigned char* ws = a.ws; const float* mod = (const float*)(ws + WS_MOD); bf16* proj = (bf16*)(ws + WS_PROJ); const float* xin = (l == 0) ? a.x : a.out; (void)mod; (void)proj; (void)xin; const Ctx P = fresh(X);
            if (PON(11)) for (int rep = 0; rep < NREP(11); ++rep) {
#pragma unroll 1
                for (int u = P.bid; u < 512; u += P.G) attn_unit(a, P, l, u); }
            if (PON(12)) for (int rep = 0; rep < NREP(12); ++rep) {
#pragma unroll 1
                for (int u = P.bid; u < 256; u += P.G) mlstm_unit<false>(a, P, l, u); }
        }
        SEAM(g0 + 2); TEND(2); TBEG();
        if (PON(3) && IN(g0 + 3)) { const Args a = load_args(); unsigned char* ws = a.ws; const float* mod = (const float*)(ws + WS_MOD); bf16* proj = (bf16*)(ws + WS_PROJ); const float* xin = (l == 0) ? a.x : a.out; (void)mod; (void)proj; (void)xin; const Ctx P = fresh(X); mlstm_scan(a, P); }
        SEAM(g0 + 3); TEND(3); TBEG();
        if (PON(4) && IN(g0 + 4)) for (int rep = 0; rep < NREP(4); ++rep) { const Args a = load_args(); unsigned char* ws = a.ws; const float* mod = (const float*)(ws + WS_MOD); bf16* proj = (bf16*)(ws + WS_PROJ); const float* xin = (l == 0) ? a.x : a.out; (void)mod; (void)proj; (void)xin; const Ctx P = fresh(X);
#pragma unroll 1
            for (int u = P.bid; u < 256; u += P.G) mlstm_unit<true>(a, P, l, u); }
        SEAM(g0 + 4); TEND(4); TBEG();
        if (PON(5) && IN(g0 + 5)) for (int rep = 0; rep < NREP(5); ++rep) { const Args a = load_args(); unsigned char* ws = a.ws; const float* mod = (const float*)(ws + WS_MOD); bf16* proj = (bf16*)(ws + WS_PROJ); const float* xin = (l == 0) ? a.x : a.out; (void)mod; (void)proj; (void)xin; const Ctx P = fresh(X);
            { DenseSched S; S.A = (const char*)(ws + WS_H); S.Bt = (const char*)(ws + WS_WAU) + (size_t)l * D * 512 * 2; S.lda = 512; S.ldb = 512; S.ord.init(T / 256, D / 256, P.G, P.bid);
              EpiGate<false> E; E.P = proj; E.gcol = C_GA; pg8::gemm_phase<EpiGate<false>, DenseSched>(P.lds, 512, S, E); }
            { DenseSched S; S.A = (const char*)(ws + WS_H) + (size_t)T * 512 * 2; S.Bt = (const char*)(ws + WS_WMU) + (size_t)l * D * 512 * 2; S.lda = 512; S.ldb = 512; S.ord.init(T / 256, D / 256, P.G, P.bid);
              EpiGate<true> E; E.P = proj; E.gcol = C_GB; pg8::gemm_phase<EpiGate<true>, DenseSched>(P.lds, 512, S, E); }
        }
        SEAM(g0 + 5); TEND(5); TBEG();
        if (PON(6) && IN(g0 + 6)) for (int rep = 0; rep < NREP(6); ++rep) { const Args a = load_args(); unsigned char* ws = a.ws; const float* mod = (const float*)(ws + WS_MOD); bf16* proj = (bf16*)(ws + WS_PROJ); const float* xin = (l == 0) ? a.x : a.out; (void)mod; (void)proj; (void)xin; const Ctx P = fresh(X);
            DenseSched S; S.A = (const char*)(proj + C_MQ); S.Bt = (const char*)(ws + WS_WOUT) + (size_t)l * D * D * 2; S.lda = NPROJ; S.ldb = D; S.ord.init(T / 256, D / 256, P.G, P.bid);
            EpiRes E; E.xin = xin; E.out = a.out; E.g = mod + (size_t)(l * 2) * 6144 + 2 * 1024; E.ssq = (float*)(ws + WS_SSQ); E.rmask = T - 1;
            if (rep) { E.out = (float*)(ws + WS_H); E.rmask = T / 2 - 1; }
            pg8::gemm_phase<EpiRes, DenseSched>(P.lds, D, S, E);
        }
        SEAM(g0 + 6); TEND(6); TBEG();
        if (PON(7) && IN(g0 + 7)) { const Args a = load_args(); unsigned char* ws = a.ws; const float* mod = (const float*)(ws + WS_MOD); bf16* proj = (bf16*)(ws + WS_PROJ); const float* xin = (l == 0) ? a.x : a.out; (void)mod; (void)proj; (void)xin; const Ctx P = fresh(X); p6_norm_route(a, P, l, a.out); }
        SEAM(g0 + 7); TEND(7); TBEG();
        if (PON(8) && IN(g0 + 8)) for (int rep = 0; rep < NREP(8); ++rep) { const Args a = load_args(); unsigned char* ws = a.ws; const float* mod = (const float*)(ws + WS_MOD); bf16* proj = (bf16*)(ws + WS_PROJ); const float* xin = (l == 0) ? a.x : a.out; (void)mod; (void)proj; (void)xin; const Ctx P = fresh(X);
            const MoeTab tb = moe_tables(a, P, l);
            LAS unsigned* tokoff = (LAS unsigned*)(P.lds + TOKOFF_OFF); const int* tokl = (const int*)(ws + WS_TOKL);
#pragma unroll 1
            for (int s = 0; s < 8; ++s) { const int L0 = s * P.G + P.bid;
                if (L0 < tb.Rtot * 8 && P.tid < 256) { const int L = xcd_remap(L0, tb.Rtot * 8); const int rt = L >> 3, cls = tb.tcls[rt], pos = tb.tpos[rt] + P.tid, cn = tb.cnt[cls]; const int tok = tokl[cls * CLS_CAP + (pos < cn ? pos : 0)]; tokoff[s * 256 + P.tid] = (unsigned)tok; } }
            __syncthreads();
            MoeUpSched S; S.A = (const char*)(ws + WS_H); S.W = (const char*)(ws + WS_WGU) + (size_t)l * NE * 1024 * D * 2; S.lda = D; S.ldb = D; S.tb = tb; S.G = P.G; S.c = P.bid; S.tokoff = tokoff;
            EpiSwiglu E; E.H = proj; E.tgate = (const float*)(ws + WS_TGATE); E.tokoff = tokoff;
            pg8::gemm_phase<EpiSwiglu, MoeUpSched>(P.lds, D, S, E);
        }
        SEAM(g0 + 8); TEND(8); TBEG();
        if (PON(9) && IN(g0 + 9)) for (int rep = 0; rep < NREP(9); ++rep) { const Args a = load_args(); unsigned char* ws = a.ws; const float* mod = (const float*)(ws + WS_MOD); bf16* proj = (bf16*)(ws + WS_PROJ); const float* xin = (l == 0) ? a.x : a.out; (void)mod; (void)proj; (void)xin; const Ctx P = fresh(X);
            const MoeTab tb = moe_tables(a, P, l);
            MoeDownSched S; S.A = (const char*)proj; S.W = (const char*)(ws + WS_WD) + (size_t)l * NE * 1024 * FF * 2; S.lda = D; S.ldb = FF; S.tb = tb; S.G = P.G; S.c = P.bid;
            EpiMoeOut E; E.xin = a.out; E.out = a.out; E.g = mod + (size_t)(l * 2) * 6144 + 5 * 1024; E.tokl = (const int*)(ws + WS_TOKL); E.tb = tb; E.rmask = T - 1;
            if (rep) { E.out = (float*)(ws + WS_H); E.rmask = T / 2 - 1; }
            pg8::gemm_phase<EpiMoeOut, MoeDownSched>(P.lds, D, S, E);
        }
        SEAM(g0 + 9); TEND(9); TBEG();
    }
    if (TSEL_MASK && X.bid == 0) { const unsigned long long t1 = __builtin_amdgcn_s_memrealtime(); while (__builtin_amdgcn_s_memrealtime() - t1 < TSCALE * tacc) __builtin_amdgcn_s_sleep(8); }
#undef IN
#undef SEAM
}

extern "C" void kernel_launch(void* const* d_in, const int* in_sizes, int n_in, void* d_out, int out_size, void* d_ws, size_t ws_size, hipStream_t stream) {
    static int grid = 0;
    if (grid == 0) {
        if (n_in != 24 || in_sizes[0] != T * D || out_size != T * D || ws_size < WS_END) { fprintf(stderr, "kernel_launch: unexpected shapes / workspace (n_in %d, ws %zu, need %zu)\n", n_in, ws_size, (size_t)WS_END); grid = -1; return; }
        int dev = 0, cus = 0;
        if (hipGetDevice(&dev) != hipSuccess || hipDeviceGetAttribute(&cus, hipDeviceAttributeMultiprocessorCount, dev) != hipSuccess) { grid = -1; return; }
        if (hipFuncSetAttribute((const void*)fwd, hipFuncAttributeMaxDynamicSharedMemorySize, LDS_BYTES) != hipSuccess) { fprintf(stderr, "kernel_launch: hipFuncSetAttribute failed\n"); grid = -1; return; }
        int per_cu = 0;
        if (hipOccupancyMaxActiveBlocksPerMultiprocessor(&per_cu, (const void*)fwd, 512, LDS_BYTES) != hipSuccess || per_cu < 1) fprintf(stderr, "kernel_launch: occupancy query reports %d\n", per_cu);
        (void)hipGetLastError();
        grid = cus < 256 ? cus : 256;
    }
    if (grid < 0) return;
    (void)hipMemsetAsync((char*)d_ws + WS_CTL, 0, CTL_ZERO_BYTES, stream);
    Args a{};
    a.x = (const float*)d_in[0]; a.c = (const float*)d_in[1]; a.pos = (const int*)d_in[2]; a.ada_w = (const float*)d_in[3]; a.ada_b = (const float*)d_in[4];
    a.nmw = (const float*)d_in[5]; a.nfw = (const float*)d_in[6]; a.w_in = (const float*)d_in[7]; a.b_ig = (const float*)d_in[8]; a.b_fg = (const float*)d_in[9];
    a.qnw = (const float*)d_in[10]; a.knw = (const float*)d_in[11]; a.sinks = (const float*)d_in[12]; a.conv_w = (const float*)d_in[13]; a.conv_b = (const float*)d_in[14];
    a.mnw = (const float*)d_in[15]; a.w_au = (const float*)d_in[16]; a.w_mu = (const float*)d_in[17]; a.w_out = (const float*)d_in[18]; a.router_w = (const float*)d_in[19];
    a.router_b = (const float*)d_in[20]; a.w_gate = (const float*)d_in[21]; a.w_up = (const float*)d_in[22]; a.w_down = (const float*)d_in[23];
    a.out = (float*)d_out; a.ws = (unsigned char*)d_ws;
#if MK_MULTI
    for (int gp = 0; gp < NGP; ++gp) { a.ph_lo = gp; a.ph_hi = gp + 1; hipLaunchKernelGGL(fwd, dim3(grid), dim3(512), LDS_BYTES, stream, a); }
#else
    a.ph_lo = 0; a.ph_hi = NGP; hipLaunchKernelGGL(fwd, dim3(grid), dim3(512), LDS_BYTES, stream, a);
#endif
}
```

```cpp
#include <hip/hip_runtime.h>
#include <cstdio>
#include <cstdint>

#ifndef MK_MULTI
#define MK_MULTI 0
#endif

#define GAS __attribute__((address_space(1)))
#define LAS __attribute__((address_space(3)))
typedef unsigned short bf16;
typedef unsigned v4u __attribute__((ext_vector_type(4)));
typedef unsigned v2u __attribute__((ext_vector_type(2)));
typedef float f32x4 __attribute__((ext_vector_type(4)));
typedef float f32x2 __attribute__((ext_vector_type(2)));
typedef short bf16x8 __attribute__((ext_vector_type(8)));
typedef short bf16x4 __attribute__((ext_vector_type(4)));
#define DI __device__ __forceinline__
#define RLX_AGENT __ATOMIC_RELAXED, __HIP_MEMORY_SCOPE_AGENT
#define LDS_WAIT() asm volatile("s_waitcnt lgkmcnt(0)" ::: "memory")
#define VM_WAIT() asm volatile("s_waitcnt vmcnt(0)" ::: "memory")

constexpr int NB = 2, SEQ = 16384, T = NB * SEQ, D = 1024, NL = 4;
constexpr int DIN_SRC = 4872;
constexpr int NPROJ = 4864;
constexpr int C_AQ = 0, C_AK = 512, C_AV = 640, C_MQ = 768, C_MK = 1280, C_MV = 1792, C_MO = 2304, C_GA = 2816, C_GB = 3840;
constexpr int NE = 16, FF = 512;
constexpr int NCLS = 24, CLS_CAP = 32768;
constexpr float EPS = 1e-6f;
constexpr int NPH = 10;
constexpr int NGP = 1 + NL * NPH;

constexpr size_t MiB = 1u << 20;
constexpr size_t WS_CTL = 0, CTL_ZERO_BYTES = 1 * MiB;
constexpr size_t WS_MOD = 1 * MiB;
constexpr size_t WS_ROPE = 2 * MiB;
constexpr size_t WS_GATES = 4 * MiB;
constexpr size_t WS_TGATE = 5 * MiB;
constexpr size_t WS_TOKL = 6 * MiB;
constexpr size_t WS_MLB = 9 * MiB;
constexpr size_t WS_MLC = 10 * MiB;
constexpr int NPROJW = 5120;
constexpr size_t WS_WIN = 28 * MiB;
constexpr size_t WS_WAU = 68 * MiB;
constexpr size_t WS_WMU = 72 * MiB;
constexpr size_t WS_WOUT = 76 * MiB;
constexpr size_t WS_WGU = 84 * MiB;
constexpr size_t WS_WD = 212 * MiB;
constexpr size_t WS_H = 276 * MiB;
constexpr size_t WS_PROJ = 340 * MiB;
constexpr size_t WS_SSQ = 644 * MiB;
constexpr size_t WS_END = 646 * MiB;

constexpr int CW_TMO = 0;
constexpr int CW_BAR = 4096;
constexpr int CW_CNT = 8192;

constexpr int RING_BYTES = 131072;
constexpr int MISC_OFF = RING_BYTES;
constexpr int TAB_OFF = RING_BYTES + 256;
constexpr int TOKOFF_OFF = RING_BYTES + 2048;
constexpr int LDS_BYTES = 147456;

DI unsigned f2bf(float f) { unsigned u = __builtin_bit_cast(unsigned, f); return (u + 0x7fffu + ((u >> 16) & 1u)) >> 16; }
DI unsigned pk2(float lo, float hi) { return f2bf(lo) | (f2bf(hi) << 16); }
DI float bf2f(unsigned short b) { return __builtin_bit_cast(float, ((unsigned)b) << 16); }
DI float bflo(unsigned w) { return __builtin_bit_cast(float, w << 16); }
DI float bfhi(unsigned w) { return __builtin_bit_cast(float, w & 0xffff0000u); }
DI float wave_sum(float v) {
#pragma unroll
    for (int o = 1; o < 64; o <<= 1) v += __shfl_xor(v, o);
    return v;
}
DI float sigmoidf_(float x) { return __builtin_amdgcn_rcpf(1.0f + __expf(-x)); }

#define XB_TMO      128
#define XB_XCNT(j)  (256  + 64 * (j))
#define XB_XSUB(j)  (1280 + 64 * (j))
#define XB_XGEN(j)  (2304 + 64 * (j))
#define XB_TOP      3328
#define XB_TOPGEN   3392
#define XCD_BAR_WORDS 3456
#define XB_SPIN_CAP (1u << 18)
__device__ __forceinline__ unsigned xb_ld(unsigned* p)              { return __hip_atomic_load(p, __ATOMIC_RELAXED, __HIP_MEMORY_SCOPE_AGENT); }
__device__ __forceinline__ unsigned xb_add(unsigned* p, unsigned v) { return __hip_atomic_fetch_add(p, v, __ATOMIC_RELAXED, __HIP_MEMORY_SCOPE_AGENT); }
__device__ __forceinline__ unsigned xb_xcc_id() { return (unsigned)__builtin_amdgcn_s_getreg((3 << 11) | 20) & 0xFu; }
#define XB_SPIN(cond, bar) do { unsigned _sp = 0; while (cond) { __builtin_amdgcn_s_sleep(1); \
    if ((++_sp & 255u) == 0u) { if (xb_ld(&(bar)[XB_TMO])) break; if (_sp > XB_SPIN_CAP) { atomicAdd(&(bar)[XB_TMO], 1u); break; } } } } while (0)
struct XcdBarrier { unsigned* bar; unsigned x; volatile LAS unsigned* st; };
__device__ __forceinline__ XcdBarrier xcd_barrier_post(unsigned* bar, volatile LAS unsigned* st) {
    XcdBarrier b; b.bar = bar; b.x = xb_xcc_id(); b.st = st;
    if (threadIdx.x == 0) (void)xb_add(&bar[XB_XCNT(b.x)], 1u);
    return b;
}
__device__ __forceinline__ void xcd_barrier_complete(unsigned* bar, unsigned x, unsigned& nloc, unsigned& nx) {
    const unsigned G = gridDim.x * gridDim.y * gridDim.z;
    unsigned sum, cnt, mine, sp = 0u;
    for (;;) {
        sum = 0u; cnt = 0u; mine = 0u;
#pragma unroll
        for (unsigned j = 0; j < 16; ++j) { const unsigned c = xb_ld(&bar[XB_XCNT(j)]); sum += c; cnt += (c > 0u) ? 1u : 0u; mine = (j == x) ? c : mine; }
        if (sum == G) break;
        __builtin_amdgcn_s_sleep(1);
        if ((++sp & 255u) == 0u) { if (xb_ld(&bar[XB_TMO])) break; if (sp > XB_SPIN_CAP) { atomicAdd(&bar[XB_TMO], 1u); break; } }
    }
    nloc = mine > 0u ? mine : 1u; nx = cnt > 0u ? cnt : 1u;
}
__device__ __forceinline__ void xcd_barrier(const XcdBarrier& b) {
    asm volatile("s_waitcnt vmcnt(0)" ::: "memory");
    __syncthreads();
    if (threadIdx.x == 0) {
        unsigned* bar = b.bar;
        __builtin_amdgcn_s_waitcnt(0);
        unsigned nloc = b.st[0], nx = b.st[1];
        if (nloc == 0u) { xcd_barrier_complete(bar, b.x, nloc, nx); b.st[0] = nloc; b.st[1] = nx; }
        const unsigned old = xb_add(&bar[XB_XSUB(b.x)], 1u);
        const unsigned gen = old / nloc;
        if (old + 1u == (gen + 1u) * nloc) {
            __builtin_amdgcn_fence(__ATOMIC_RELEASE, "agent");
            asm volatile("s_waitcnt vmcnt(0)" ::: "memory");
            const unsigned og = xb_add(&bar[XB_TOP], 1u);
            const unsigned tg = og / nx;
            if (og + 1u == (tg + 1u) * nx) xb_add(&bar[XB_TOPGEN], 1u);
            else XB_SPIN(xb_ld(&bar[XB_TOPGEN]) == tg, bar);
            __builtin_amdgcn_fence(__ATOMIC_ACQUIRE, "agent");
            xb_add(&bar[XB_XGEN(b.x)], 1u);
            asm volatile("s_waitcnt vmcnt(0)" ::: "memory");
        } else {
            XB_SPIN(xb_ld(&bar[XB_XGEN(b.x)]) == gen, bar);
            __builtin_amdgcn_fence(__ATOMIC_ACQUIRE, "agent");
            asm volatile("s_waitcnt vmcnt(0)" ::: "memory");
        }
    }
    __syncthreads();
}

namespace pg8 {
constexpr int BM = 256, BK = 64, HALF = 128, HTB = HALF * BK * 2, STAGE_BYTES = 8 * HTB, NXCD = 8, WGM = 8;
__host__ __device__ __forceinline__ int lds_byte(int r, int c) { const int st = (r >> 4) * 2 + (c >> 5), rr = r & 15, cc = c & 31, ob = rr * 64 + cc * 2; return st * 1024 + (ob ^ (((ob >> 9) & 1) << 5)); }
__host__ __device__ __forceinline__ void stage_rc(int b, int& R, int& C) { const int st = b / 1024, sb = b % 1024, swz = sb ^ (((sb >> 9) & 1) << 5); R = (st >> 1) * 16 + swz / 64; C = (st & 1) * 32 + (swz % 64) / 2; }
__host__ __device__ __forceinline__ int perm32(int rho) { const int n = rho >> 4, i = rho & 15; return 8 * (i >> 2) + 4 * n + (i & 3); }

struct Unit { int pm, pn, x0, x1; };

struct TileOrder {
    int nM, nN, nwg, G, c;
    __device__ void init(int nM_, int nN_, int G_, int c_) { nM = nM_; nN = nN_; nwg = nM * nN; G = G_; c = c_; }
    __device__ bool get(int i, int& pm, int& pn) const {
        const long L = (long)i * G + c; if (L >= nwg) return false;
        int wgid = (int)L; { const int q = nwg / NXCD, r = nwg % NXCD, xcd = wgid % NXCD, off = wgid / NXCD; wgid = (xcd < r ? xcd * (q + 1) : r * (q + 1) + (xcd - r) * q) + off; }
        const int nig = WGM * nN, gid = wgid / nig, fm = gid * WGM, gsz = (nM - fm) < WGM ? (nM - fm) : WGM;
        pm = fm + ((wgid % nig) % gsz); pn = (wgid % nig) / gsz; return true;
    }
};

typedef int v8i __attribute__((ext_vector_type(8)));
template <class Epi, class Sched, bool F8 = false>
__device__ __forceinline__ void gemm_phase(LAS unsigned char* lds, const int Kb, const Sched& S, const Epi& E) {
    int tid = threadIdx.x; asm volatile("" : "+v"(tid));
    const int wid = __builtin_amdgcn_readfirstlane(tid >> 6), lane = tid & 63, wr = wid >> 2, wc = wid & 3, fr = lane & 15, fq = lane >> 4;
    const int nt = Kb / 128;
    constexpr bool GA = Sched::GATHER; constexpr int KS = Sched::KSPLIT;
    unsigned voffA[2], voffB[2]; int Rst[2], Cst[2];
#pragma unroll
    for (int i = 0; i < 2; ++i) { int R, C; stage_rc(tid * 16 + i * 8192, R, C); const int Rb = Epi::PERM ? ((R & ~31) + perm32(R & 31)) : R;
        voffA[i] = (unsigned)(R * S.lda + C * 2); voffB[i] = (unsigned)(Rb * S.ldb + C * 2); Rst[i] = R; Cst[i] = C; }
    const size_t kstep = (size_t)(BK * 2);
    const size_t hstepA = (size_t)HALF * S.lda, hstepB = (size_t)HALF * S.ldb;
    const unsigned ldsw = (unsigned)wid * 1024u; const unsigned gmul = (unsigned)S.lda;
    const int aoff = F8 ? (lds_byte(wr * 64 + fr, (fq & 1) * 16) + (fq >> 1) * 1024) : lds_byte(wr * 64 + fr, fq * 8);
    const int boff = F8 ? (lds_byte(wc * 32 + fr, (fq & 1) * 16) + (fq >> 1) * 1024) : lds_byte(wc * 32 + fr, fq * 8);
    unsigned vAc[2], vAn[2];
#define PG8_SA(b, h) (((b) * 2 + (h)) * HTB)
#define PG8_SB(b, h) ((4 + (b) * 2 + (h)) * HTB)
#define PG8_STAGE2(bufoff, gbase, v0, v1) do { \
        __builtin_amdgcn_global_load_lds((const unsigned*)((const char*)(gbase) + (v0)), (LAS unsigned*)(lds + (bufoff) + ldsw), 16, 0, 0); \
        __builtin_amdgcn_global_load_lds((const unsigned*)((const char*)(gbase) + (v1)), (LAS unsigned*)(lds + (bufoff) + ldsw + 8192), 16, 0, 0); } while (0)
#define PG8_STAGE_B(bufoff, ptr, h) PG8_STAGE2(bufoff, (ptr) + (h) * hstepB, voffB[0], voffB[1])
#define PG8_STAGE_A(bufoff, ptr, h, nx) do { if constexpr (GA) { const unsigned _p = (nx) ? vAn[h] : vAc[h]; PG8_STAGE2(bufoff, ptr, (_p & 0xffffu) * gmul + (unsigned)Cst[0] * 2u, (_p >> 16) * gmul + (unsigned)Cst[0] * 2u); } \
        else { PG8_STAGE2(bufoff, (ptr) + (h) * hstepA, voffA[0], voffA[1]); } } while (0)
    typedef int v4i_ __attribute__((ext_vector_type(4)));
#define PG8_LDA(dst, b, h) do { _Pragma("unroll") for (int m = 0; m < 4; ++m) { if constexpr (F8) { dst##8[m].lo = *(const LAS v4i_*)(lds + PG8_SA(b, h) + aoff + m * 2048); dst##8[m].hi = *(const LAS v4i_*)(lds + PG8_SA(b, h) + aoff + m * 2048 + 16); } \
        else { _Pragma("unroll") for (int k = 0; k < 2; ++k) dst[m][k] = *(const LAS bf16x8*)(lds + PG8_SA(b, h) + aoff + m * 2048 + k * 1024); } } } while (0)
#define PG8_LDB(dst, b, h) do { _Pragma("unroll") for (int n = 0; n < 2; ++n) { if constexpr (F8) { dst##8[n].lo = *(const LAS v4i_*)(lds + PG8_SB(b, h) + boff + n * 2048); dst##8[n].hi = *(const LAS v4i_*)(lds + PG8_SB(b, h) + boff + n * 2048 + 16); } \
        else { _Pragma("unroll") for (int k = 0; k < 2; ++k) dst[n][k] = *(const LAS bf16x8*)(lds + PG8_SB(b, h) + boff + n * 2048 + k * 1024); } } } while (0)
#define PG8_MMA(ai, bj, At, Bt) do { __builtin_amdgcn_s_setprio(1); _Pragma("unroll") for (int m = 0; m < 4; ++m) _Pragma("unroll") for (int n = 0; n < 2; ++n) { \
        if constexpr (F8) { asm volatile("v_mfma_scale_f32_16x16x128_f8f6f4 %0, %1, %2, %0, %3, %3 op_sel_hi:[0,0,0]" : "+v"(acc[ai][bj][m][n]) : "v"(Bt##8[n]), "v"(At##8[m]), "v"(f8scale)); } \
        else { _Pragma("unroll") for (int k = 0; k < 2; ++k) acc[ai][bj][m][n] = __builtin_amdgcn_mfma_f32_16x16x32_bf16(Bt[n][k], At[m][k], acc[ai][bj][m][n], 0, 0, 0); } } \
        __builtin_amdgcn_s_setprio(0); } while (0)
#define PG8_WAIT_V(n) asm volatile("s_waitcnt vmcnt(" #n ")" ::: "memory")
#define PG8_WAIT_L(n) asm volatile("s_waitcnt lgkmcnt(" #n ")" ::: "memory")
#define PG8_BAR __builtin_amdgcn_s_barrier()
#define PG8_SCHED __builtin_amdgcn_sched_barrier(0)
#define PG8_GOFF(dst, u) do { if constexpr (GA) { _Pragma("unroll") for (int h = 0; h < 2; ++h) dst[h] = S.a_rowoff(u, Rst[0] + HALF * h) | (S.a_rowoff(u, Rst[0] + 64 + HALF * h) << 16); } } while (0)
    Unit cur, nxt; int ui = 0;
    if (!S.next(0, cur)) return;
    f32x4 acc[2][2][4][2];
#pragma unroll
    for (int a = 0; a < 2; ++a)
#pragma unroll
        for (int b = 0; b < 2; ++b)
#pragma unroll
            for (int m = 0; m < 4; ++m)
#pragma unroll
                for (int n = 0; n < 2; ++n) acc[a][b][m][n] = (f32x4){0.f, 0.f, 0.f, 0.f};
    int f8scale = 0x7F7F7F7F; asm volatile("" : "+v"(f8scale));
    bf16x8 At[4][2], B0[2][2], B1[2][2]; v8i At8[4], B08[2], B18[2];
    const char* cA = S.a_base(cur); const char* cB0 = S.b_base(cur, 0); const char* cB1 = KS ? S.b_base(cur, 1) : cB0;
    PG8_GOFF(vAc, cur);
    vAn[0] = vAc[0]; vAn[1] = vAc[1];
    PG8_STAGE_B(PG8_SB(0, 0), cB0, 0); PG8_STAGE_B(PG8_SB(0, 1), cB0, 1); PG8_STAGE_A(PG8_SA(0, 0), cA, 0, false); PG8_STAGE_A(PG8_SA(0, 1), cA, 1, false);
    if (wr == 1) PG8_BAR;
    PG8_WAIT_V(2); PG8_BAR;
    PG8_STAGE_B(PG8_SB(1, 0), cB0 + kstep, 0); PG8_STAGE_A(PG8_SA(1, 0), cA + kstep, 0, false); PG8_STAGE_B(PG8_SB(1, 1), cB0 + kstep, 1);
    PG8_WAIT_V(6); PG8_BAR;
    for (;;) {
        const bool has_next = S.next(ui + 1, nxt);
        const char* nA = has_next ? S.a_base(nxt) : cA; const char* nB0 = has_next ? S.b_base(nxt, 0) : cB0; const char* nB1 = (KS && has_next) ? S.b_base(nxt, 1) : (KS ? cB1 : nB0);
        if constexpr (GA) { if (has_next) { PG8_GOFF(vAn, nxt); } }
#pragma unroll 1
        for (int t = 0; t < nt; t += 2) {
            const bool last = (t == nt - 2);
            const char* a1 = cA + (size_t)(t + 1) * kstep;
            const char* a2 = last ? nA : cA + (size_t)(t + 2) * kstep;
            const char* b2 = last ? nB0 : ((KS && (t + 2) >= KS) ? cB1 + (size_t)(t + 2 - KS) * kstep : cB0 + (size_t)(t + 2) * kstep);
            const char* a3 = a2 + kstep; const char* b3 = b2 + kstep;
            PG8_LDB(B0, 0, 0); PG8_LDB(B1, 0, 1); PG8_SCHED; PG8_LDA(At, 0, 0); PG8_STAGE_A(PG8_SA(1, 1), a1, 1, false);
            PG8_WAIT_V(8); PG8_WAIT_L(0); PG8_BAR; PG8_MMA(0, 0, At, B0); PG8_MMA(0, 1, At, B1); PG8_BAR; PG8_SCHED;
            PG8_LDA(At, 0, 1); PG8_STAGE_B(PG8_SB(0, 0), b2, 0); PG8_STAGE_B(PG8_SB(0, 1), b2, 1); PG8_STAGE_A(PG8_SA(0, 0), a2, 0, last);
            PG8_WAIT_V(8); PG8_WAIT_L(0); PG8_BAR; PG8_MMA(1, 0, At, B0); PG8_MMA(1, 1, At, B1); PG8_BAR; PG8_SCHED;
            PG8_LDB(B0, 1, 0); PG8_LDB(B1, 1, 1); PG8_SCHED; PG8_LDA(At, 1, 0); PG8_STAGE_A(PG8_SA(0, 1), a2, 1, last);
            PG8_WAIT_V(8); PG8_WAIT_L(0); PG8_BAR; PG8_MMA(0, 0, At, B0); PG8_MMA(0, 1, At, B1); PG8_BAR; PG8_SCHED;
            PG8_LDA(At, 1, 1); PG8_STAGE_B(PG8_SB(1, 0), b3, 0); PG8_STAGE_B(PG8_SB(1, 1), b3, 1); PG8_STAGE_A(PG8_SA(1, 0), a3, 0, last);
            PG8_WAIT_V(8); PG8_WAIT_L(0); PG8_BAR; PG8_MMA(1, 0, At, B0); PG8_MMA(1, 1, At, B1); PG8_BAR; PG8_SCHED;
        }
        if (wr == 0) PG8_BAR;
        if constexpr (F8) { asm volatile("s_nop 15\n\ts_nop 15" ::: "memory"); }
        { int fr_ = fr, fq_ = fq; asm volatile("" : "+v"(fr_), "+v"(fq_));
          E(acc, cur, wr, wc, fr_, fq_); }
        if (!has_next) break;
#pragma unroll
        for (int a = 0; a < 2; ++a)
#pragma unroll
            for (int b = 0; b < 2; ++b)
#pragma unroll
                for (int m = 0; m < 4; ++m)
#pragma unroll
                    for (int n = 0; n < 2; ++n) acc[a][b][m][n] = (f32x4){0.f, 0.f, 0.f, 0.f};
        cur = nxt; cA = nA; cB0 = nB0; cB1 = nB1; ++ui;
        vAc[0] = vAn[0]; vAc[1] = vAn[1];
        if (wr == 1) PG8_BAR;
    }
    PG8_WAIT_V(0);
    PG8_BAR;
#undef PG8_SA
#undef PG8_SB
#undef PG8_STAGE2
#undef PG8_STAGE_A
#undef PG8_STAGE_B
#undef PG8_LDA
#undef PG8_LDB
#undef PG8_MMA
#undef PG8_WAIT_V
#undef PG8_WAIT_L
#undef PG8_BAR
#undef PG8_SCHED
#undef PG8_GOFF
}
}
using pg8::Unit;

DI unsigned cvt_pk_bf16(float lo, float hi) { unsigned r; asm volatile("v_cvt_pk_bf16_f32 %0, %1, %2" : "=v"(r) : "v"(lo), "v"(hi)); return r; }

struct Args {
    const float* x; const float* c; const int* pos; const float* ada_w; const float* ada_b; const float* nmw; const float* nfw; const float* w_in;
    const float* b_ig; const float* b_fg; const float* qnw; const float* knw; const float* sinks; const float* conv_w; const float* conv_b; const float* mnw;
    const float* w_au; const float* w_mu; const float* w_out; const float* router_w; const float* router_b; const float* w_gate; const float* w_up; const float* w_down;
    float* out; unsigned char* ws; int ph_lo, ph_hi;
};

__constant__ float c_invf[8] = {1.0f, 0.1939227432012558f, 0.03760603070259094f, 0.007292664609849453f, 0.0014142135623842478f, 0.00027424818836152554f, 5.3182957344688475e-05f, 1.0313385246263351e-05f};

struct DenseSched {
    static constexpr bool GATHER = false; static constexpr int KSPLIT = 0;
    const char* A; const char* Bt; int lda, ldb; pg8::TileOrder ord;
    DI bool next(int i, Unit& u) const { int pm, pn; if (!ord.get(i, pm, pn)) return false; u.pm = pm; u.pn = pn; u.x0 = 0; u.x1 = 0; return true; }
    DI const char* a_base(const Unit& u) const { return A + (size_t)u.pm * 256 * lda; }
    DI const char* b_base(const Unit& u, int) const { return Bt + (size_t)u.pn * 256 * ldb; }
    DI unsigned a_rowoff(const Unit&, int) const { return 0u; }
};
struct EpiProj {
    static constexpr bool PERM = true;
    bf16* O; float* gates; const float* big; const float* bfg;
    DI void operator()(const f32x4 (&acc)[2][2][4][2], const Unit& u, int wr, int wc, int fr, int fq) const {
        const int row0 = u.pm * 256 + wr * 64 + fr, col0 = u.pn * 256 + wc * 32 + 8 * fq; const bool sg = u.pn >= 9; constexpr float WSC = 1.0f / 64.0f;
        if (u.pn == 19) {
            if (wc == 0 && fq == 0) {
#pragma unroll
                for (int ai = 0; ai < 2; ++ai)
#pragma unroll
                    for (int m = 0; m < 4; ++m) { const int row = row0 + ai * 128 + m * 16; const f32x4 vi = acc[ai][0][m][0], vf = acc[ai][0][m][1]; f32x4 oi, of;
#pragma unroll
                        for (int j = 0; j < 4; ++j) { oi[j] = vi[j] * WSC + big[j]; const float z = vf[j] * WSC + bfg[j]; of[j] = fminf(z, 0.f) - log1pf(__expf(-fabsf(z))); }
                        *(f32x4*)(gates + (size_t)row * 8) = oi; *(f32x4*)(gates + (size_t)row * 8 + 4) = of; } }
            return; }
#pragma unroll
        for (int ai = 0; ai < 2; ++ai)
#pragma unroll
            for (int m = 0; m < 4; ++m) { bf16* rowp = O + (size_t)(row0 + ai * 128 + m * 16) * NPROJ + col0;
#pragma unroll
                for (int bj = 0; bj < 2; ++bj) { f32x4 v0 = acc[ai][bj][m][0] * WSC, v1 = acc[ai][bj][m][1] * WSC;
                    if (sg) {
#pragma unroll
                        for (int j = 0; j < 4; ++j) { v0[j] = sigmoidf_(v0[j]); v1[j] = sigmoidf_(v1[j]); } }
                    v4u w; w.x = cvt_pk_bf16(v0[0], v0[1]); w.y = cvt_pk_bf16(v0[2], v0[3]); w.z = cvt_pk_bf16(v1[0], v1[1]); w.w = cvt_pk_bf16(v1[2], v1[3]);
                    *(v4u*)(rowp + bj * 128) = w; } }
    }
};
template <bool ADD> struct EpiGate {
    static constexpr bool PERM = true;
    bf16* P; int gcol;
    DI void operator()(const f32x4 (&acc)[2][2][4][2], const Unit& u, int wr, int wc, int fr, int fq) const {
        const int row0 = u.pm * 256 + wr * 64 + fr, col0 = u.pn * 256 + wc * 32 + 8 * fq;
#pragma unroll
        for (int ai = 0; ai < 2; ++ai)
#pragma unroll
            for (int m = 0; m < 4; ++m) { bf16* rowp = P + (size_t)(row0 + ai * 128 + m * 16) * NPROJ + col0;
#pragma unroll
                for (int bj = 0; bj < 2; ++bj) { const f32x4 v0 = acc[ai][bj][m][0], v1 = acc[ai][bj][m][1];
                    const v4u g = *(const v4u*)(rowp + gcol + bj * 128);
                    float o[8] = {bflo(g.x) * v0[0], bfhi(g.x) * v0[1], bflo(g.y) * v0[2], bfhi(g.y) * v0[3], bflo(g.z) * v1[0], bfhi(g.z) * v1[1], bflo(g.w) * v1[2], bfhi(g.w) * v1[3]};
                    if (ADD) { const v4u p = *(const v4u*)(rowp + C_MQ + bj * 128);
                        o[0] += bflo(p.x); o[1] += bfhi(p.x); o[2] += bflo(p.y); o[3] += bfhi(p.y); o[4] += bflo(p.z); o[5] += bfhi(p.z); o[6] += bflo(p.w); o[7] += bfhi(p.w); }
                    v4u w; w.x = cvt_pk_bf16(o[0], o[1]); w.y = cvt_pk_bf16(o[2], o[3]); w.z = cvt_pk_bf16(o[4], o[5]); w.w = cvt_pk_bf16(o[6], o[7]);
                    *(v4u*)(rowp + C_MQ + bj * 128) = w; } }
    }
};
struct EpiRes {
    static constexpr bool PERM = false;
    const float* xin; float* out; const float* g; float* ssq; int rmask;
    DI void operator()(const f32x4 (&acc)[2][2][4][2], const Unit& u, int wr, int wc, int fr, int fq) const {
        const int row0 = u.pm * 256 + wr * 64 + fr, col0 = u.pn * 256 + wc * 32 + 4 * fq; const int b = (u.pm * 256) >> 14;
        f32x4 gv[2][2];
#pragma unroll
        for (int bj = 0; bj < 2; ++bj)
#pragma unroll
            for (int n = 0; n < 2; ++n) gv[bj][n] = *(const f32x4*)(g + b * 6144 + col0 + bj * 128 + n * 16);
#pragma unroll
        for (int ai = 0; ai < 2; ++ai)
#pragma unroll
            for (int m = 0; m < 4; ++m) { const size_t off = (size_t)(row0 + ai * 128 + m * 16) * D + col0; const size_t offo = (size_t)((row0 + ai * 128 + m * 16) & rmask) * D + col0; float sq = 0.f;
#pragma unroll
                for (int bj = 0; bj < 2; ++bj)
#pragma unroll
                    for (int n = 0; n < 2; ++n) { const f32x4 xv = *(const f32x4*)(xin + off + bj * 128 + n * 16); const f32x4 o = xv + gv[bj][n] * acc[ai][bj][m][n];
                        sq += (o.x * o.x + o.y * o.y) + (o.z * o.z + o.w * o.w);
                        *(f32x4*)(out + offo + bj * 128 + n * 16) = o; }
                sq += __shfl_xor(sq, 16); sq += __shfl_xor(sq, 32);
                if (fq == 0) ssq[(size_t)(row0 + ai * 128 + m * 16) * 16 + u.pn * 4 + wc] = sq; }
    }
};

struct MoeTab { const LAS int* tcls; const LAS int* tpos; const LAS int* cnt; int Rtot; };
DI int xcd_remap(int L, int nwg) { const int q = nwg >> 3, r = nwg & 7, xcd = L & 7, off = L >> 3; return (xcd < r ? xcd * (q + 1) : r * (q + 1) + (xcd - r) * q) + off; }
DI void cls_experts(int cls, int& ea, int& eb) { const int g = cls / 6, p = cls - 6 * g; const int a = (p < 3) ? 0 : ((p < 5) ? 1 : 2); const int b = (p < 3) ? (p + 1) : ((p < 5) ? (p - 1) : 3); ea = 4 * g + a; eb = 4 * g + b; }
struct MoeUpSched {
    static constexpr bool GATHER = true; static constexpr int KSPLIT = 0;
    const char* A; const char* W; int lda, ldb; MoeTab tb; int G, c; const LAS unsigned* tokoff;
    DI bool next(int i, Unit& u) const { const int L0 = i * G + c; if (L0 >= tb.Rtot * 8) return false; const int L = xcd_remap(L0, tb.Rtot * 8); u.pm = L >> 3; u.pn = L & 7; u.x0 = i; u.x1 = __builtin_amdgcn_readfirstlane(tb.tcls[u.pm]); return true; }
    DI const char* a_base(const Unit&) const { return A; }
    DI const char* b_base(const Unit& u, int) const { int ea, eb; cls_experts(u.x1, ea, eb); const int e = (u.pn < 4) ? ea : eb; return W + ((size_t)e * 1024 + (size_t)(u.pn & 3) * 256) * ldb; }
    DI unsigned a_rowoff(const Unit& u, int r) const { return tokoff[u.x0 * 256 + r]; }
};
struct EpiSwiglu {
    static constexpr bool PERM = true;
    bf16* H; const float* tgate; const LAS unsigned* tokoff;
    DI void operator()(const f32x4 (&acc)[2][2][4][2], const Unit& u, int wr, int wc, int fr, int fq) const {
        const int r0 = wr * 64 + fr; const int hc = (u.pn >> 2) * 512 + (u.pn & 3) * 128 + wc * 32 + 8 * fq; const int gsel = u.pn >> 2;
#pragma unroll
        for (int ai = 0; ai < 2; ++ai)
#pragma unroll
            for (int m = 0; m < 4; ++m) { const int r = r0 + ai * 128 + m * 16; const unsigned tok = tokoff[u.x0 * 256 + r]; const float rg = tgate[tok * 2 + gsel];
                const f32x4 g0 = acc[ai][0][m][0], g1 = acc[ai][0][m][1], u0 = acc[ai][1][m][0], u1 = acc[ai][1][m][1];
                float o[8];
#pragma unroll
                for (int j = 0; j < 4; ++j) { o[j] = g0[j] * sigmoidf_(g0[j]) * u0[j] * rg; o[4 + j] = g1[j] * sigmoidf_(g1[j]) * u1[j] * rg; }
                v4u w; w.x = cvt_pk_bf16(o[0], o[1]); w.y = cvt_pk_bf16(o[2], o[3]); w.z = cvt_pk_bf16(o[4], o[5]); w.w = cvt_pk_bf16(o[6], o[7]);
                *(v4u*)(H + ((size_t)u.pm * 256 + r) * 1024 + hc) = w; }
    }
};
struct MoeDownSched {
    static constexpr bool GATHER = false; static constexpr int KSPLIT = 8;
    const char* A; const char* W; int lda, ldb; MoeTab tb; int G, c;
    DI bool next(int i, Unit& u) const { const int L0 = i * G + c; if (L0 >= tb.Rtot * 4) return false; const int L = xcd_remap(L0, tb.Rtot * 4); u.pm = L >> 2; u.pn = L & 3; u.x0 = __builtin_amdgcn_readfirstlane(tb.tpos[u.pm]); u.x1 = __builtin_amdgcn_readfirstlane(tb.tcls[u.pm]); return true; }
    DI const char* a_base(const Unit& u) const { return A + (size_t)u.pm * 256 * lda; }
    DI const char* b_base(const Unit& u, int half) const { int ea, eb; cls_experts(u.x1, ea, eb); const int e = half ? eb : ea; return W + ((size_t)e * 1024 + (size_t)u.pn * 256) * ldb; }
    DI unsigned a_rowoff(const Unit&, int) const { return 0u; }
};
struct EpiMoeOut {
    static constexpr bool PERM = false;
    const float* xin; float* out; const float* g; const int* tokl; MoeTab tb; int rmask;
    DI void operator()(const f32x4 (&acc)[2][2][4][2], const Unit& u, int wr, int wc, int fr, int fq) const {
        const int r0 = wr * 64 + fr, col0 = u.pn * 256 + wc * 32 + 4 * fq; const int cn = tb.cnt[u.x1];
#pragma unroll
        for (int ai = 0; ai < 2; ++ai)
#pragma unroll
            for (int m = 0; m < 4; ++m) { const int pos = u.x0 + r0 + ai * 128 + m * 16;
                if (pos < cn) { const int tok = tokl[u.x1 * CLS_CAP + pos]; const int b = tok >> 14; const float* ip = xin + (size_t)tok * D + col0; float* op = out + (size_t)(tok & rmask) * D + col0; const float* gp = g + b * 6144 + col0;
#pragma unroll
                    for (int bj = 0; bj < 2; ++bj)
#pragma unroll
                        for (int n = 0; n < 2; ++n) { const f32x4 xv = *(const f32x4*)(ip + bj * 128 + n * 16); const f32x4 gv = *(const f32x4*)(gp + bj * 128 + n * 16);
                            *(f32x4*)(op + bj * 128 + n * 16) = xv + gv * acc[ai][bj][m][n]; } } }
    }
};

struct Ctx { LAS unsigned char* lds; int tid, lane, wave, G, bid; };
DI Ctx fresh(const Ctx& X) { Ctx P = X; int t = X.tid; asm volatile("" : "+v"(t)); P.tid = t; P.lane = t & 63; P.wave = __builtin_amdgcn_readfirstlane(t >> 6); return P; }

DI void tr_item(const float* W, int ldw, int K, bf16* WT, int k0, LAS float* scr, int lane) {
#pragma unroll 8
    for (int i = 0; i < 32; ++i) { const int kk = 2 * i + (lane >> 5); scr[kk * 33 + (lane & 31)] = W[(size_t)(k0 + kk) * ldw + (lane & 31)]; }
    LDS_WAIT(); asm volatile("" ::: "memory");
    const int c = lane & 7;
#pragma unroll
    for (int j = 0; j < 4; ++j) { const int n = (lane >> 3) + 8 * j; const LAS float* s = scr + (8 * c) * 33 + n;
        v4u o; o.x = pk2(s[0 * 33], s[1 * 33]); o.y = pk2(s[2 * 33], s[3 * 33]); o.z = pk2(s[4 * 33], s[5 * 33]); o.w = pk2(s[6 * 33], s[7 * 33]);
        *(v4u*)(WT + (size_t)n * K + k0 + 8 * c) = o; }
    LDS_WAIT(); asm volatile("" ::: "memory");
}
DI unsigned pk4_fp8(float a0, float a1, float a2, float a3) { int p = __builtin_amdgcn_cvt_pk_fp8_f32(a0, a1, 0, false); p = __builtin_amdgcn_cvt_pk_fp8_f32(a2, a3, p, true); return (unsigned)p; }
DI void tr_item8(const float* W, int ldw, int K, unsigned char* WT, int k0, float scale, LAS float* scr, int lane) {
#pragma unroll 8
    for (int i = 0; i < 32; ++i) { const int kk = 2 * i + (lane >> 5); scr[kk * 33 + (lane & 31)] = W[(size_t)(k0 + kk) * ldw + (lane & 31)]; }
    LDS_WAIT(); asm volatile("" ::: "memory");
    const int c = lane & 7;
#pragma unroll
    for (int j = 0; j < 4; ++j) { const int n = (lane >> 3) + 8 * j; const LAS float* s = scr + (8 * c) * 33 + n;
        v2u o; o.x = pk4_fp8(s[0 * 33] * scale, s[1 * 33] * scale, s[2 * 33] * scale, s[3 * 33] * scale); o.y = pk4_fp8(s[4 * 33] * scale, s[5 * 33] * scale, s[6 * 33] * scale, s[7 * 33] * scale);
        *(v2u*)(WT + (size_t)n * K + k0 + 8 * c) = o; }
    LDS_WAIT(); asm volatile("" ::: "memory");
}
DI void p0_prologue(const Args& a, const Ctx& X) {
    unsigned char* ws = a.ws;
    LAS float* scr = (LAS float*)(X.lds + X.wave * 16384);
    const int gw = X.bid * 8 + X.wave, NGW = X.G * 8;
    constexpr int IT_WIN = 16 * 153, IT_AU = 8 * 32, IT_OUT = 16 * 32, IT_GU = 16 * 16 * 32, IT_DN = 16 * 8 * 32;
    constexpr int IT_L = IT_WIN + 2 * IT_AU + IT_OUT + IT_GU + IT_DN;
    for (int it = gw; it < NL * IT_L; it += NGW) {
        const int l = it / IT_L; int r = it - l * IT_L;
        if (r < IT_WIN) { const int kb = r / 153, nb = r - kb * 153, d0 = 32 * nb, s0 = (nb == 152) ? 2304 : (d0 + (d0 >= 2304 ? 8 : 0));
            tr_item8(a.w_in + (size_t)l * D * DIN_SRC + s0, DIN_SRC, D, (unsigned char*)(ws + WS_WIN) + ((size_t)l * NPROJW + d0) * D, 64 * kb, 64.0f, scr, X.lane); continue; }
        r -= IT_WIN;
        if (r < IT_AU) { const int kb = r >> 5, nb = r & 31;
            tr_item(a.w_au + (size_t)l * 512 * D + 32 * nb, D, 512, (bf16*)(ws + WS_WAU) + ((size_t)l * D + 32 * nb) * 512, 64 * kb, scr, X.lane); continue; }
        r -= IT_AU;
        if (r < IT_AU) { const int kb = r >> 5, nb = r & 31;
            tr_item(a.w_mu + (size_t)l * 512 * D + 32 * nb, D, 512, (bf16*)(ws + WS_WMU) + ((size_t)l * D + 32 * nb) * 512, 64 * kb, scr, X.lane); continue; }
        r -= IT_AU;
        if (r < IT_OUT) { const int kb = r >> 5, nb = r & 31;
            tr_item(a.w_out + (size_t)l * D * D + 32 * nb, D, D, (bf16*)(ws + WS_WOUT) + ((size_t)l * D + 32 * nb) * D, 64 * kb, scr, X.lane); continue; }
        r -= IT_OUT;
        if (r < IT_GU) { const int e = r >> 9, q = r & 511, kb = q >> 5, nb = q & 31, tq = nb >> 3, rb = nb & 7;
            const float* src = ((rb < 4) ? a.w_gate : a.w_up) + ((size_t)(l * NE + e) * D) * FF + 128 * tq + 32 * (rb & 3);
            tr_item(src, FF, D, (bf16*)(ws + WS_WGU) + ((size_t)(l * NE + e) * 1024 + 32 * nb) * D, 64 * kb, scr, X.lane); continue; }
        r -= IT_GU;
        { const int e = r >> 8, q = r & 255, kb = q >> 5, nb = q & 31;
            tr_item(a.w_down + ((size_t)(l * NE + e) * FF) * D + 32 * nb, D, FF, (bf16*)(ws + WS_WD) + ((size_t)(l * NE + e) * 1024 + 32 * nb) * FF, 64 * kb, scr, X.lane); }
    }
    { float* cs = (float*)(ws + WS_ROPE); float* sn = cs + (size_t)T * 8;
      for (int i = X.bid * 512 + X.tid; i < T * 8; i += X.G * 512) { const int tok = i >> 3, f = i & 7; const float angf = (float)a.pos[tok] * c_invf[f];
          double rev = (double)angf * 0.15915494309189535; rev -= rint(rev); const float rf = (float)rev;
          cs[i] = __builtin_amdgcn_cosf(rf); sn[i] = __builtin_amdgcn_sinf(rf); } }
    __syncthreads();
    LAS float* cact = (LAS float*)X.lds; LAS float* red = (LAS float*)(X.lds + 8192);
    for (int i = X.tid; i < 2048; i += 512) { const float cv = a.c[i]; cact[i] = cv / (1.0f + __expf(-cv)); }
    __syncthreads();
    float* mod = (float*)(ws + WS_MOD);
    for (int it = X.bid; it < NL * 96; it += X.G) { const int l = it / 96, cg = it - l * 96; const int col = cg * 64 + X.lane;
        const float* w = a.ada_w + (size_t)l * D * 6144 + col; float s0 = 0.f, s1 = 0.f;
#pragma unroll 8
        for (int kk = 0; kk < 128; ++kk) { const int k = X.wave * 128 + kk; const float wv = w[(size_t)k * 6144]; s0 += cact[k] * wv; s1 += cact[1024 + k] * wv; }
        red[(X.wave * 2 + 0) * 64 + X.lane] = s0; red[(X.wave * 2 + 1) * 64 + X.lane] = s1;
        __syncthreads();
        if (X.tid < 128) { const int b = X.tid >> 6, ln = X.tid & 63; float s = 0.f;
#pragma unroll
            for (int w8 = 0; w8 < 8; ++w8) s += red[(w8 * 2 + b) * 64 + ln];
            mod[(size_t)(l * 2 + b) * 6144 + cg * 64 + ln] = s + a.ada_b[l * 6144 + cg * 64 + ln]; }
        __syncthreads();
    }
}

DI void p1_norm_gates(const Args& a, const Ctx& X, int l, const float* xin) {
    unsigned char* ws = a.ws;
    const float* mod = (const float*)(ws + WS_MOD); unsigned char* hb = (unsigned char*)(ws + WS_H);
    const int gw = X.bid * 8 + X.wave, NGW = X.G * 8;
    for (int rg = gw; rg < T / 16; rg += NGW) {
        const int row0 = rg * 16, b = row0 >> 14;
        const float* mb = mod + (size_t)(l * 2 + b) * 6144;
        f32x4 aw[4], sh[4];
#pragma unroll
        for (int j = 0; j < 4; ++j) { const int k = 256 * j + 4 * X.lane; const f32x4 nw = *(const f32x4*)(a.nmw + l * D + k); const f32x4 sc = *(const f32x4*)(mb + 1024 + k); aw[j] = nw * (sc + 1.0f); sh[j] = *(const f32x4*)(mb + k); }
        f32x4 pre[4][4];
#pragma unroll
        for (int q = 0; q < 4; ++q) { const f32x4* xp = (const f32x4*)(xin + (size_t)(row0 + q) * D) + X.lane;
#pragma unroll
            for (int j = 0; j < 4; ++j) pre[q][j] = xp[64 * j]; }
#pragma unroll 1
        for (int rb = 0; rb < 16; rb += 4) {
#pragma unroll
          for (int q = 0; q < 4; ++q) { const int row = row0 + rb + q;
            f32x4 v[4]; float ss = 0.f;
#pragma unroll
            for (int j = 0; j < 4; ++j) v[j] = pre[q][j];
            if (rb + 4 < 16) { const f32x4* xp = (const f32x4*)(xin + (size_t)(row + 4) * D) + X.lane;
#pragma unroll
                for (int j = 0; j < 4; ++j) pre[q][j] = xp[64 * j]; }
#pragma unroll
            for (int j = 0; j < 4; ++j) ss += (v[j].x * v[j].x + v[j].y * v[j].y) + (v[j].z * v[j].z + v[j].w * v[j].w);
            ss = wave_sum(ss); const float rstd = __builtin_amdgcn_rsqf(ss * (1.0f / D) + EPS);
            unsigned* o4 = (unsigned*)(hb + (size_t)row * D) + X.lane;
#pragma unroll
            for (int j = 0; j < 4; ++j) { v[j] = v[j] * rstd * aw[j] + sh[j]; o4[64 * j] = pk4_fp8(v[j].x, v[j].y, v[j].z, v[j].w); }
          }
        }
    }
}

DI void attn_unit(const Args& a, const Ctx& X, int l, int unit) {
    unsigned char* ws = a.ws; const bf16* proj = (const bf16*)(ws + WS_PROJ); bf16* ao = (bf16*)(ws + WS_H);
    const float* cs = (const float*)(ws + WS_ROPE); const float* sn = cs + (size_t)T * 8;
    const int b = unit >> 8, rem = unit & 255, nb = rem >> 1, kvh = rem & 1; const int tok0 = b * SEQ + nb * 128;
    LAS bf16* Kl = (LAS bf16*)X.lds;
    LAS bf16* VT = (LAS bf16*)(X.lds + 36864);
    int lane = X.lane; asm volatile("" : "+v"(lane));
    const int c16 = lane & 15, quad = lane >> 4;
    {
        const int row = X.tid >> 1, half = X.tid & 1; const int tokk = tok0 - 128 + row; const bool valid = (nb > 0) || (row >= 128);
        float y[32]; float vv[32];
        if (valid) {
            const v4u* kp = (const v4u*)(proj + (size_t)tokk * NPROJ + C_AK + kvh * 64 + half * 32); const v4u* vp = (const v4u*)(proj + (size_t)tokk * NPROJ + C_AV + kvh * 64 + half * 32);
#pragma unroll
            for (int q = 0; q < 4; ++q) { const v4u kw = kp[q], vw = vp[q];
                y[8 * q + 0] = bflo(kw.x); y[8 * q + 1] = bfhi(kw.x); y[8 * q + 2] = bflo(kw.y); y[8 * q + 3] = bfhi(kw.y); y[8 * q + 4] = bflo(kw.z); y[8 * q + 5] = bfhi(kw.z); y[8 * q + 6] = bflo(kw.w); y[8 * q + 7] = bfhi(kw.w);
                vv[8 * q + 0] = bflo(vw.x); vv[8 * q + 1] = bfhi(vw.x); vv[8 * q + 2] = bflo(vw.y); vv[8 * q + 3] = bfhi(vw.y); vv[8 * q + 4] = bflo(vw.z); vv[8 * q + 5] = bfhi(vw.z); vv[8 * q + 6] = bflo(vw.w); vv[8 * q + 7] = bfhi(vw.w); }
        } else {
#pragma unroll
            for (int i = 0; i < 32; ++i) { y[i] = 0.f; vv[i] = 0.f; } }
        float ss = 0.f;
#pragma unroll
        for (int i = 0; i < 32; ++i) ss += y[i] * y[i];
        ss += __shfl_xor(ss, 1); const float rstd = 1.0f / sqrtf(ss * (1.0f / 64.0f) + EPS);
#pragma unroll
        for (int i = 0; i < 32; ++i) y[i] = y[i] * rstd * a.knw[l * 64 + half * 32 + i];
        if (half == 0 && valid) {
#pragma unroll
            for (int d = 0; d < 8; ++d) { const float c = cs[(size_t)tokk * 8 + d], s = sn[(size_t)tokk * 8 + d]; const float t1 = y[d], t2 = y[d + 8]; y[d] = t1 * c - t2 * s; y[d + 8] = t2 * c + t1 * s; } }
#pragma unroll
        for (int q = 0; q < 4; ++q) { v4u w; w.x = pk2(y[8 * q], y[8 * q + 1]); w.y = pk2(y[8 * q + 2], y[8 * q + 3]); w.z = pk2(y[8 * q + 4], y[8 * q + 5]); w.w = pk2(y[8 * q + 6], y[8 * q + 7]);
            *(LAS v4u*)(Kl + row * 72 + half * 32 + 8 * q) = w; }
#pragma unroll
        for (int i = 0; i < 32; ++i) VT[(half * 32 + i) * 280 + row] = (bf16)f2bf(vv[i]);
        if (X.tid < 64) {
#pragma unroll
            for (int cc = 256; cc < 280; ++cc) VT[X.tid * 280 + cc] = 0; }
    }
    __syncthreads();
#pragma unroll 1
    for (int task = X.wave; task < 32; task += 8) {
        const int g = task >> 3, rg = task & 7, r0 = 16 * rg, head = kvh * 4 + g; const int tokq = tok0 + r0 + c16;
        const float sink = a.sinks[l * 8 + head];
        float qv[16];
        { const bf16* qp = proj + (size_t)tokq * NPROJ + C_AQ + head * 64; const v4u w0 = *(const v4u*)(qp + 8 * quad), w1 = *(const v4u*)(qp + 32 + 8 * quad);
          qv[0] = bflo(w0.x); qv[1] = bfhi(w0.x); qv[2] = bflo(w0.y); qv[3] = bfhi(w0.y); qv[4] = bflo(w0.z); qv[5] = bfhi(w0.z); qv[6] = bflo(w0.w); qv[7] = bfhi(w0.w);
          qv[8] = bflo(w1.x); qv[9] = bfhi(w1.x); qv[10] = bflo(w1.y); qv[11] = bfhi(w1.y); qv[12] = bflo(w1.z); qv[13] = bfhi(w1.z); qv[14] = bflo(w1.w); qv[15] = bfhi(w1.w); }
        float ss = 0.f;
#pragma unroll
        for (int i = 0; i < 16; ++i) ss += qv[i] * qv[i];
        ss += __shfl_xor(ss, 16); ss += __shfl_xor(ss, 32); const float rstd = 1.0f / sqrtf(ss * (1.0f / 64.0f) + EPS);
#pragma unroll
        for (int i = 0; i < 8; ++i) { qv[i] = qv[i] * rstd * a.qnw[l * 64 + 8 * quad + i]; qv[8 + i] = qv[8 + i] * rstd * a.qnw[l * 64 + 32 + 8 * quad + i]; }
#pragma unroll
        for (int d = 0; d < 8; ++d) { const float other = __shfl_xor(qv[d], 16); const float c = cs[(size_t)tokq * 8 + d], s = sn[(size_t)tokq * 8 + d];
            if (quad == 0) qv[d] = qv[d] * c - other * s; else if (quad == 1) qv[d] = qv[d] * c + other * s; }
        bf16x8 qf[2];
        { v4u w; w.x = pk2(qv[0], qv[1]); w.y = pk2(qv[2], qv[3]); w.z = pk2(qv[4], qv[5]); w.w = pk2(qv[6], qv[7]); qf[0] = __builtin_bit_cast(bf16x8, w);
          w.x = pk2(qv[8], qv[9]); w.y = pk2(qv[10], qv[11]); w.z = pk2(qv[12], qv[13]); w.w = pk2(qv[14], qv[15]); qf[1] = __builtin_bit_cast(bf16x8, w); }
        f32x4 sacc[9];
#pragma unroll
        for (int i = 0; i < 9; ++i) { const LAS bf16* kr = Kl + (16 * (rg + i) + c16) * 72 + 8 * quad;
            const bf16x8 k0 = *(const LAS bf16x8*)kr, k1 = *(const LAS bf16x8*)(kr + 32);
            f32x4 z = {0.f, 0.f, 0.f, 0.f}; z = __builtin_amdgcn_mfma_f32_16x16x32_bf16(k0, qf[0], z, 0, 0, 0); sacc[i] = __builtin_amdgcn_mfma_f32_16x16x32_bf16(k1, qf[1], z, 0, 0, 0); }
        int dbase = 4 * quad - c16; asm volatile("" : "+v"(dbase)); int kbase = 16 * rg + 4 * quad; asm volatile("" : "+v"(kbase)); float mx = sink;
#pragma unroll
        for (int i = 0; i < 9; ++i)
#pragma unroll
            for (int j = 0; j < 4; ++j) { const int dlt = dbase + 16 * i + j; const int kj = kbase + 16 * i + j; const bool ok = (dlt > 0) && (dlt <= 128) && ((nb > 0) || (kj >= 128));
                const float s = ok ? sacc[i][j] * 0.125f : -3.0e38f; sacc[i][j] = s; mx = fmaxf(mx, s); }
        mx = fmaxf(mx, __shfl_xor(mx, 16)); mx = fmaxf(mx, __shfl_xor(mx, 32));
        float sum = 0.f;
#pragma unroll
        for (int i = 0; i < 9; ++i)
#pragma unroll
            for (int j = 0; j < 4; ++j) { const float p = (sacc[i][j] > -1.0e38f) ? __expf(sacc[i][j] - mx) : 0.f; sacc[i][j] = p; sum += p; }
        sum += __shfl_xor(sum, 16); sum += __shfl_xor(sum, 32);
        const float inv = 1.0f / (sum + __expf(sink - mx));
        f32x4 oacc[4];
#pragma unroll
        for (int et = 0; et < 4; ++et) oacc[et] = (f32x4){0.f, 0.f, 0.f, 0.f};
#pragma unroll
        for (int kk = 0; kk < 5; ++kk) {
            v4u pw; pw.x = pk2(sacc[2 * kk][0], sacc[2 * kk][1]); pw.y = pk2(sacc[2 * kk][2], sacc[2 * kk][3]);
            if (2 * kk + 1 < 9) { pw.z = pk2(sacc[(2 * kk + 1 < 9) ? 2 * kk + 1 : 0][0], sacc[(2 * kk + 1 < 9) ? 2 * kk + 1 : 0][1]); pw.w = pk2(sacc[(2 * kk + 1 < 9) ? 2 * kk + 1 : 0][2], sacc[(2 * kk + 1 < 9) ? 2 * kk + 1 : 0][3]); } else { pw.z = 0u; pw.w = 0u; }
            const bf16x8 pf = __builtin_bit_cast(bf16x8, pw);
#pragma unroll
            for (int et = 0; et < 4; ++et) { const LAS bf16* vr = VT + (16 * et + c16) * 280 + 16 * rg + 32 * kk + 4 * quad;
                const v2u lo = *(const LAS v2u*)vr, hi = *(const LAS v2u*)(vr + 16); v4u vw; vw.x = lo.x; vw.y = lo.y; vw.z = hi.x; vw.w = hi.y;
                oacc[et] = __builtin_amdgcn_mfma_f32_16x16x32_bf16(__builtin_bit_cast(bf16x8, vw), pf, oacc[et], 0, 0, 0); }
        }
#pragma unroll
        for (int et = 0; et < 4; ++et) { v2u w; w.x = pk2(oacc[et][0] * inv, oacc[et][1] * inv); w.y = pk2(oacc[et][2] * inv, oacc[et][3] * inv);
            *(v2u*)(ao + (size_t)tokq * 512 + head * 64 + 16 * et + 4 * quad) = w; }
    }
    __syncthreads();
}

constexpr int ML_Q = 0, ML_K = 17408, ML_KET = 34816, ML_VT = 53248, ML_CT = 73984, ML_CW = 113152, ML_CB = 118272, ML_RED = 118784, ML_NW = 119296;
template <bool L3> DI void mlstm_unit(const Args& a, const Ctx& X, int l, int unit) {
    unsigned char* ws = a.ws; const bf16* proj = (const bf16*)(ws + WS_PROJ); bf16* hm = (bf16*)(ws + WS_H) + (size_t)T * 512;
    const float* gates = (const float*)(ws + WS_GATES); float* mlc = (float*)(ws + WS_MLC) + (size_t)unit * 18432; float* mlb = (float*)(ws + WS_MLB);
    const int seq = unit >> 5, sj = unit & 31, b = seq >> 2, hh = seq & 3; const int tokbase = b * SEQ + sj * 512;
    LAS bf16* Qs = (LAS bf16*)(X.lds + ML_Q); LAS bf16* Ks = (LAS bf16*)(X.lds + ML_K); LAS bf16* KET = (LAS bf16*)(X.lds + ML_KET);
    LAS bf16* VT = (LAS bf16*)(X.lds + ML_VT); LAS bf16* CT = (LAS bf16*)(X.lds + ML_CT); LAS float* CW = (LAS float*)(X.lds + ML_CW);
    LAS float* CB = (LAS float*)(X.lds + ML_CB); LAS float* RED = (LAS float*)(X.lds + ML_RED); LAS float* NW = (LAS float*)(X.lds + ML_NW);
    int lane = X.lane; asm volatile("" : "+v"(lane));
    const int c16 = lane & 15, quad = lane >> 4, w = X.wave;
    for (int idx = X.tid; idx < 1280; idx += 512) { const int tap = idx >> 8, ch = idx & 255; const int gch = (ch < 128) ? (hh * 128 + ch) : (512 + hh * 128 + (ch - 128));
        CW[idx] = (tap < 4) ? a.conv_w[(size_t)(l * 4 + tap) * 1024 + gch] : a.conv_b[l * 1024 + gch]; }
    for (int idx = X.tid; idx < 16 * 72; idx += 512) VT[128 * 72 + idx] = (idx < 72) ? (bf16)0x3F80 : (bf16)0;
    if (X.tid < 128) NW[X.tid] = a.mnw[l * 512 + hh * 128 + X.tid];
    f32x4 cacc[9];
#pragma unroll
    for (int et = 0; et < 9; ++et) {
        if (L3) {
#pragma unroll
            for (int j = 0; j < 4; ++j) { const float v = mlc[(16 * et + 4 * quad + j) * 128 + 16 * w + c16]; cacc[et][j] = v; CT[(16 * et + 4 * quad + j) * 136 + 16 * w + c16] = (bf16)f2bf(v); }
        } else cacc[et] = (f32x4){0.f, 0.f, 0.f, 0.f};
    }
    float bsum = 0.f;
    __syncthreads();
#pragma unroll 1
    for (int c = 0; c < 8; ++c) {
        const int tok0 = tokbase + c * 64;
        float bsc = gates[(size_t)(tok0 + lane) * 8 + 4 + hh]; const float li = gates[(size_t)(tok0 + lane) * 8 + hh];
#pragma unroll
        for (int o = 1; o < 64; o <<= 1) { const float v = __shfl_up(bsc, o); if (lane >= o) bsc += v; }
        const float bl = __shfl(bsc, 63); const float csv = li - bsc;
        if (w == 0) { CB[lane] = bsc; CB[64 + lane] = csv; }
        bsum += bl;
        { const int t = X.tid >> 3, dc = X.tid & 7; const float fac = __expf(bl + __shfl(csv, t));
          const int tokt = tok0 + t;
#pragma unroll
          for (int qk = (L3 ? 0 : 1); qk < 2; ++qk) {
              float accv[16];
#pragma unroll
              for (int i = 0; i < 16; ++i) accv[i] = CW[4 * 256 + qk * 128 + 16 * dc + i];
#pragma unroll
              for (int j = 0; j < 4; ++j) { const int tt = tokt - 3 + j;
                  if (tt >= b * SEQ) { const v4u* p = (const v4u*)(proj + (size_t)tt * NPROJ + (qk ? C_MK : C_MQ) + hh * 128 + 16 * dc); const v4u w0 = p[0], w1 = p[1];
                      const float xv[16] = {bflo(w0.x), bfhi(w0.x), bflo(w0.y), bfhi(w0.y), bflo(w0.z), bfhi(w0.z), bflo(w0.w), bfhi(w0.w), bflo(w1.x), bfhi(w1.x), bflo(w1.y), bfhi(w1.y), bflo(w1.z), bfhi(w1.z), bflo(w1.w), bfhi(w1.w)};
#pragma unroll
                      for (int i = 0; i < 16; ++i) accv[i] += CW[j * 256 + qk * 128 + 16 * dc + i] * xv[i]; } }
#pragma unroll
              for (int i = 0; i < 16; ++i) { const float z = accv[i]; accv[i] = z / (1.0f + __expf(-z)) * (qk ? 0.08838834764831845f : 1.0f); }
              if (L3) { LAS bf16* dst = (qk ? Ks : Qs) + t * 136 + 16 * dc;
                  v4u o0, o1; o0.x = pk2(accv[0], accv[1]); o0.y = pk2(accv[2], accv[3]); o0.z = pk2(accv[4], accv[5]); o0.w = pk2(accv[6], accv[7]);
                  o1.x = pk2(accv[8], accv[9]); o1.y = pk2(accv[10], accv[11]); o1.z = pk2(accv[12], accv[13]); o1.w = pk2(accv[14], accv[15]);
                  *(LAS v4u*)dst = o0; *(LAS v4u*)(dst + 8) = o1; }
              if (qk) {
#pragma unroll
                  for (int i = 0; i < 16; ++i) KET[(16 * dc + i) * 72 + t] = (bf16)f2bf(accv[i] * fac); }
          }
          { const v4u* p = (const v4u*)(proj + (size_t)tokt * NPROJ + C_MV + hh * 128 + 16 * dc); const v4u w0 = p[0], w1 = p[1];
            const unsigned ww[8] = {w0.x, w0.y, w0.z, w0.w, w1.x, w1.y, w1.z, w1.w};
#pragma unroll
            for (int i = 0; i < 8; ++i) { VT[(16 * dc + 2 * i) * 72 + t] = (bf16)(ww[i] & 0xffffu); VT[(16 * dc + 2 * i + 1) * 72 + t] = (bf16)(ww[i] >> 16); } }
        }
        __syncthreads();
        float hval[4][4]; int tt_ = w & 3, eh = w >> 2; const int tq = 16 * tt_ + c16;
        if (L3) {
            bf16x8 qf[4];
#pragma unroll
            for (int ks = 0; ks < 4; ++ks) qf[ks] = *(const LAS bf16x8*)(Qs + tq * 136 + 32 * ks + 8 * quad);
            f32x4 sacc[4];
#pragma unroll
            for (int st = 0; st < 4; ++st) { f32x4 z = {0.f, 0.f, 0.f, 0.f};
#pragma unroll
                for (int ks = 0; ks < 4; ++ks) z = __builtin_amdgcn_mfma_f32_16x16x32_bf16(*(const LAS bf16x8*)(Ks + (16 * st + c16) * 136 + 32 * ks + 8 * quad), qf[ks], z, 0, 0, 0);
                sacc[st] = z; }
            const float cbt = CB[tq];
#pragma unroll
            for (int st = 0; st < 4; ++st)
#pragma unroll
                for (int j = 0; j < 4; ++j) { const int s = 16 * st + 4 * quad + j; const float d = (s <= tq) ? __expf(cbt + CB[64 + s]) : 0.f; sacc[st][j] *= d; }
            bf16x8 pf[2];
#pragma unroll
            for (int kk = 0; kk < 2; ++kk) { v4u pw; pw.x = pk2(sacc[2 * kk][0], sacc[2 * kk][1]); pw.y = pk2(sacc[2 * kk][2], sacc[2 * kk][3]); pw.z = pk2(sacc[2 * kk + 1][0], sacc[2 * kk + 1][1]); pw.w = pk2(sacc[2 * kk + 1][2], sacc[2 * kk + 1][3]); pf[kk] = __builtin_bit_cast(bf16x8, pw); }
            const float ebt = __expf(cbt);
            f32x4 nn[5];
#pragma unroll
            for (int x = 0; x < 5; ++x) { const int et = (x < 4) ? (4 * eh + x) : 8; f32x4 na = {0.f, 0.f, 0.f, 0.f}, ia = {0.f, 0.f, 0.f, 0.f};
#pragma unroll
                for (int kk = 0; kk < 2; ++kk) { const LAS bf16* vr = VT + (16 * et + c16) * 72 + 32 * kk + 4 * quad; const v2u lo = *(const LAS v2u*)vr, hi = *(const LAS v2u*)(vr + 16); v4u vw; vw.x = lo.x; vw.y = lo.y; vw.z = hi.x; vw.w = hi.y;
                    na = __builtin_amdgcn_mfma_f32_16x16x32_bf16(__builtin_bit_cast(bf16x8, vw), pf[kk], na, 0, 0, 0); }
#pragma unroll
                for (int ks = 0; ks < 4; ++ks) ia = __builtin_amdgcn_mfma_f32_16x16x32_bf16(*(const LAS bf16x8*)(CT + (16 * et + c16) * 136 + 32 * ks + 8 * quad), qf[ks], ia, 0, 0, 0);
                nn[x] = na + ia * ebt; }
            const float den = __shfl(nn[4][0], c16); const float inv = 1.0f / fmaxf(fabsf(den), 1.0f);
            float ss = 0.f;
#pragma unroll
            for (int x = 0; x < 4; ++x)
#pragma unroll
                for (int j = 0; j < 4; ++j) { hval[x][j] = nn[x][j] * inv; ss += hval[x][j] * hval[x][j]; }
            ss += __shfl_xor(ss, 16); ss += __shfl_xor(ss, 32);
            if (quad == 0) RED[eh * 64 + tq] = ss;
            __syncthreads();
            const float rstd = 1.0f / sqrtf((RED[tq] + RED[64 + tq]) * (1.0f / 128.0f) + EPS);
#pragma unroll
            for (int x = 0; x < 4; ++x) { const int e = 16 * (4 * eh + x) + 4 * quad; const v2u og = *(const v2u*)(proj + (size_t)(tok0 + tq) * NPROJ + C_MO + hh * 128 + e);
                const float y0 = hval[x][0] * rstd * NW[e] * bflo(og.x), y1 = hval[x][1] * rstd * NW[e + 1] * bfhi(og.x), y2 = hval[x][2] * rstd * NW[e + 2] * bflo(og.y), y3 = hval[x][3] * rstd * NW[e + 3] * bfhi(og.y);
                v2u o; o.x = pk2(y0, y1); o.y = pk2(y2, y3); *(v2u*)(hm + (size_t)(tok0 + tq) * 512 + hh * 128 + e) = o; }
        }
        { const float ebl = __expf(bl);
          bf16x8 kf[2];
#pragma unroll
          for (int kk = 0; kk < 2; ++kk) kf[kk] = *(const LAS bf16x8*)(KET + (16 * w + c16) * 72 + 32 * kk + 8 * quad);
#pragma unroll
          for (int et = 0; et < 9; ++et) { f32x4 z = cacc[et] * ebl;
#pragma unroll
              for (int kk = 0; kk < 2; ++kk) z = __builtin_amdgcn_mfma_f32_16x16x32_bf16(*(const LAS bf16x8*)(VT + (16 * et + c16) * 72 + 32 * kk + 8 * quad), kf[kk], z, 0, 0, 0);
              cacc[et] = z;
              if (L3) {
#pragma unroll
                  for (int j = 0; j < 4; ++j) CT[(16 * et + 4 * quad + j) * 136 + 16 * w + c16] = (bf16)f2bf(z[j]); } } }
        __syncthreads();
    }
    if (!L3) {
#pragma unroll
        for (int et = 0; et < 9; ++et)
#pragma unroll
            for (int j = 0; j < 4; ++j) mlc[(16 * et + 4 * quad + j) * 128 + 16 * w + c16] = cacc[et][j];
        if (X.tid == 0) mlb[unit] = bsum;
    }
}
DI void mlstm_scan(const Args& a, const Ctx& X) {
    float* mlc = (float*)(a.ws + WS_MLC); const float* mlb = (const float*)(a.ws + WS_MLB);
    for (int idx = X.bid * 512 + X.tid; idx < 8 * 18432; idx += X.G * 512) { const int seq = idx / 18432, el = idx - seq * 18432; float carry = 0.f;
        float* p0 = mlc + (size_t)seq * 32 * 18432 + el; float v[32], dcy[32];
#pragma unroll
        for (int j = 0; j < 32; ++j) { v[j] = p0[(size_t)j * 18432]; dcy[j] = mlb[seq * 32 + j]; }
#pragma unroll
        for (int j = 0; j < 32; ++j) { p0[(size_t)j * 18432] = carry; carry = __expf(dcy[j]) * carry + v[j]; } }
}

constexpr int P6_WR = 0, P6_AT = 33024, P6_SH = 37120, P6_LG = 41216, P6_HIST = 65536;
DI void p6_norm_route(const Args& a, const Ctx& X, int l, const float* xin) {
    unsigned char* ws = a.ws;
    LAS bf16* wrb = (LAS bf16*)(X.lds + P6_WR);
    LAS float* at = (LAS float*)(X.lds + P6_AT); LAS float* sht = (LAS float*)(X.lds + P6_SH);
    LAS float* lg = (LAS float*)(X.lds + P6_LG) + X.wave * 272;
    for (int idx = X.tid; idx < 16384; idx += 512) { const int k = idx >> 4, e = idx & 15; wrb[e * 1032 + k] = (bf16)f2bf(a.router_w[idx]); }
    const float* mod = (const float*)(ws + WS_MOD); bf16* hb = (bf16*)(ws + WS_H); float* tgate = (float*)(ws + WS_TGATE); int* tokl = (int*)(ws + WS_TOKL);
    const float* ssq = (const float*)(ws + WS_SSQ);
    unsigned* cnt = (unsigned*)(ws + WS_CTL) + CW_CNT + l * 2048;
    LAS int* hist = (LAS int*)(X.lds + P6_HIST); LAS int* cbase = hist + 32;
    int lane = X.lane; asm volatile("" : "+v"(lane));
    const int r = lane & 15, q = lane >> 4;
    const int gw = X.bid * 8 + X.wave, NGW = X.G * 8;
    for (int it = 0; it * NGW < T / 16; ++it) {
        const int rg = it * NGW + gw; const bool act = rg < T / 16;
        const int row0 = (act ? rg : 0) * 16; const int bb = ((it * NGW + X.bid * 8) * 16) >> 14;
        __syncthreads();
        if (X.tid < 32) hist[X.tid] = 0;
        { const float* mb = mod + (size_t)(l * 2 + (bb < 2 ? bb : 1)) * 6144;
          for (int k = X.tid; k < 1024; k += 512) { at[k] = a.nfw[l * D + k] * (1.0f + mb[4 * 1024 + k]); sht[k] = mb[3 * 1024 + k]; } }
        __syncthreads();
        const int row = row0 + r;
        float rstd;
        { const f32x4 pp = *(const f32x4*)(ssq + (size_t)row * 16 + 4 * q); float ss = (pp.x + pp.y) + (pp.z + pp.w); ss += __shfl_xor(ss, 16); ss += __shfl_xor(ss, 32); rstd = __builtin_amdgcn_rsqf(ss * (1.0f / D) + EPS); }
        const float* xr = xin + (size_t)row * D + 8 * q; bf16* hr = hb + (size_t)row * D + 8 * q;
        f32x4 acc = {0.f, 0.f, 0.f, 0.f};
#pragma unroll 8
        for (int s = 0; s < 32; ++s) {
            const f32x4 x0 = *(const f32x4*)(xr + 32 * s), x1 = *(const f32x4*)(xr + 32 * s + 4);
            const f32x4 a0 = *(const LAS f32x4*)(at + 32 * s + 8 * q), a1 = *(const LAS f32x4*)(at + 32 * s + 8 * q + 4);
            const f32x4 s0 = *(const LAS f32x4*)(sht + 32 * s + 8 * q), s1 = *(const LAS f32x4*)(sht + 32 * s + 8 * q + 4);
            const f32x4 h0 = x0 * rstd * a0 + s0, h1 = x1 * rstd * a1 + s1;
            v4u w; w.x = cvt_pk_bf16(h0.x, h0.y); w.y = cvt_pk_bf16(h0.z, h0.w); w.z = cvt_pk_bf16(h1.x, h1.y); w.w = cvt_pk_bf16(h1.z, h1.w);
            *(v4u*)(hr + 32 * s) = w;
            const bf16x8 bfr = *(const LAS bf16x8*)(wrb + r * 1032 + 32 * s + 8 * q);
            acc = __builtin_amdgcn_mfma_f32_16x16x32_bf16(__builtin_bit_cast(bf16x8, w), bfr, acc, 0, 0, 0);
        }
#pragma unroll
        for (int j = 0; j < 4; ++j) lg[(4 * q + j) * 17 + r] = acc[j];
        LDS_WAIT(); asm volatile("" ::: "memory");
        int my_cls = 0; float my_ga = 0.f, my_gb = 0.f;
        if (lane < 16) {
            float sc[16], sel[16];
#pragma unroll
            for (int e = 0; e < 16; ++e) { const float p = lg[lane * 17 + e]; sc[e] = 1.0f / (1.0f + __expf(-p)); sel[e] = sc[e] + a.router_b[e]; }
            int gi = 0; float gbest = -1.0e30f;
#pragma unroll
            for (int g = 0; g < 4; ++g) { const float p0 = sel[4 * g], p1 = sel[4 * g + 1], p2 = sel[4 * g + 2], p3 = sel[4 * g + 3];
                const float gs = fmaxf(fmaxf(fmaxf(p0 + p1, p0 + p2), fmaxf(p0 + p3, p1 + p2)), fmaxf(p1 + p3, p2 + p3));
                if (gs > gbest) { gbest = gs; gi = g; } }
            float qs[4], s4[4];
#pragma unroll
            for (int i = 0; i < 4; ++i) { qs[i] = 0.f; s4[i] = 0.f; }
#pragma unroll
            for (int g = 0; g < 4; ++g) if (g == gi) {
#pragma unroll
                for (int i = 0; i < 4; ++i) { qs[i] = sel[4 * g + i]; s4[i] = sc[4 * g + i]; } }
            int i1 = 0; float b1 = qs[0];
#pragma unroll
            for (int i = 1; i < 4; ++i) if (qs[i] > b1) { b1 = qs[i]; i1 = i; }
            int i2 = -1; float b2 = -1.0e30f;
#pragma unroll
            for (int i = 0; i < 4; ++i) if (i != i1 && qs[i] > b2) { b2 = qs[i]; i2 = i; }
            const int ia = (i1 < i2) ? i1 : i2, ib = (i1 < i2) ? i2 : i1;
            float sa = 0.f, sb = 0.f;
#pragma unroll
            for (int i = 0; i < 4; ++i) { if (i == ia) sa = s4[i]; if (i == ib) sb = s4[i]; }
            const int pidx = (ia == 0) ? (ib - 1) : ((ia == 1) ? (ib + 1) : 5);
            const float inv = 1.0f / (sa + sb);
            my_cls = gi * 6 + pidx; my_ga = sa * inv; my_gb = sb * inv;
        }
        int rank = 0;
        if (act && lane < 16) rank = __hip_atomic_fetch_add(hist + my_cls, 1, __ATOMIC_RELAXED, __HIP_MEMORY_SCOPE_WORKGROUP);
        __syncthreads();
        if (X.tid < NCLS) { const int n = hist[X.tid]; cbase[X.tid] = n ? (int)__hip_atomic_fetch_add(cnt + 64 * X.tid, (unsigned)n, RLX_AGENT) : 0; }
        __syncthreads();
        if (act && lane < 16) { const int tok = row0 + lane; const int pos = cbase[my_cls] + rank;
            tokl[my_cls * CLS_CAP + pos] = tok; tgate[tok * 2] = my_ga; tgate[tok * 2 + 1] = my_gb; }
    }
}
DI MoeTab moe_tables(const Args& a, const Ctx& X, int l) {
    LAS int* tab = (LAS int*)(X.lds + TAB_OFF); LAS int* tcls = tab; LAS int* tpos = tab + 160; LAS int* cn = tab + 320; LAS int* rt_ = tab + 344;
    unsigned* cnt = (unsigned*)(a.ws + WS_CTL) + CW_CNT + l * 2048;
    if (X.tid < NCLS) cn[X.tid] = (int)__hip_atomic_load(cnt + 64 * X.tid, RLX_AGENT);
    __syncthreads();
    if (X.tid == 0) { int r = 0;
#pragma unroll 1
        for (int c = 0; c < NCLS; ++c) { const int n = (cn[c] + 255) >> 8;
#pragma unroll 1
            for (int i = 0; i < n; ++i) { tcls[r] = c; tpos[r] = i * 256; ++r; } }
        rt_[0] = r; }
    __syncthreads();
    MoeTab tb; tb.tcls = tcls; tb.tpos = tpos; tb.cnt = cn; tb.Rtot = __builtin_amdgcn_readfirstlane(rt_[0]); return tb;
}

#if defined(__HIP_DEVICE_COMPILE__)
DI Args load_args() { auto p = __builtin_amdgcn_kernarg_segment_ptr(); asm volatile("" : "+s"(p)); return *(const __attribute__((address_space(4))) Args*)p; }
#else
DI Args load_args() { return Args{}; }
#endif
__global__ void __launch_bounds__(512, 2) fwd(Args a_unused) {
    extern __shared__ __attribute__((aligned(16))) unsigned char lds_raw[];
    Ctx X; X.lds = (LAS unsigned char*)lds_raw; X.tid = threadIdx.x; X.lane = X.tid & 63; X.wave = __builtin_amdgcn_readfirstlane(X.tid >> 6); X.G = gridDim.x; X.bid = blockIdx.x;
    volatile LAS unsigned* MISC = (volatile LAS unsigned*)(X.lds + MISC_OFF);
    if (X.tid < 64) MISC[X.tid] = 0u;
    __syncthreads();
    int lo, hi; unsigned* ctl;
    { const Args a = load_args(); lo = a.ph_lo; hi = a.ph_hi; ctl = (unsigned*)(a.ws + WS_CTL); }
    XcdBarrier bar; bar.bar = ctl + CW_BAR; bar.x = 0; bar.st = MISC + 8;
    if (hi - lo > 1) bar = xcd_barrier_post(ctl + CW_BAR, MISC + 8);
#ifndef PH_MASK
#define PH_MASK 0xFFFFF
#endif
#define PON(p) ((PH_MASK >> (p)) & 1)
#ifndef DUP_MASK
#define DUP_MASK 0
#endif
#define NREP(p) (((DUP_MASK >> (p)) & 1) ? 2 : 1)
#ifndef TSEL_MASK
#define TSEL_MASK 0
#endif
#define TSCALE 4
#define TSEL(p) ((TSEL_MASK >> (p)) & 1)
#define IN(k) (lo <= (k) && (k) < hi)
#define SEAM(k) do { if (IN(k) && IN((k) + 1)) xcd_barrier(bar); } while (0)
    unsigned long long tacc = 0ull, tph = 0ull;
#define TBEG() do { if (TSEL_MASK) tph = __builtin_amdgcn_s_memrealtime(); } while (0)
#define TEND(p) do { if (TSEL(p)) tacc += __builtin_amdgcn_s_memrealtime() - tph; } while (0)
    TBEG();
    if (PON(10) && IN(0)) { for (int rep = 0; rep < NREP(10); ++rep) { const Args a = load_args(); p0_prologue(a, X); } }
    SEAM(0); TEND(10);
    TBEG();
    for (int l = 0; l < NL; ++l) {
        const int g0 = 1 + l * NPH;
        if (PON(0) && IN(g0 + 0)) { for (int rep = 0; rep < NREP(0); ++rep) { const Args a = load_args(); unsigned char* ws = a.ws; const float* mod = (const float*)(ws + WS_MOD); bf16* proj = (bf16*)(ws + WS_PROJ); const float* xin = (l == 0) ? a.x : a.out; (void)mod; (void)proj; (void)xin; const Ctx P = fresh(X); p1_norm_gates(a, P, l, xin); } }
        SEAM(g0 + 0); TEND(0); TBEG();
        if (PON(1) && IN(g0 + 1)) for (int rep = 0; rep < NREP(1); ++rep) { const Args a = load_args(); unsigned char* ws = a.ws; const float* mod = (const float*)(ws + WS_MOD); bf16* proj = (bf16*)(ws + WS_PROJ); const float* xin = (l == 0) ? a.x : a.out; (void)mod; (void)proj; (void)xin; const Ctx P = fresh(X);
            DenseSched S; S.A = (const char*)(ws + WS_H); S.Bt = (const char*)(ws + WS_WIN) + (size_t)l * NPROJW * D; S.lda = D; S.ldb = D; S.ord.init(T / 256, NPROJW / 256, P.G, P.bid);
            EpiProj E; E.O = proj; E.gates = (float*)(ws + WS_GATES); E.big = a.b_ig + l * 4; E.bfg = a.b_fg + l * 4;
            pg8::gemm_phase<EpiProj, DenseSched, true>(P.lds, D, S, E);
        }
        SEAM(g0 + 1); TEND(1); TBEG();
        if (PON(2) && IN(g0 + 2)) { const Args a = load_args(); unsigned char* ws = a.ws; const float* mod = (const float*)(ws + WS_MOD); bf16* proj = (bf16*)(ws + WS_PROJ); const float* xin = (l == 0) ? a.x : a.out; (void)mod; (void)proj; (void)xin; const Ctx P = fresh(X);
            if (PON(11)) for (int rep = 0; rep < NREP(11); ++rep) {
#pragma unroll 1
                for (int u = P.bid; u < 512; u += P.G) attn_unit(a, P, l, u); }
            if (PON(12)) for (int rep = 0; rep < NREP(12); ++rep) {
#pragma unroll 1
                for (int u = P.bid; u < 256; u += P.G) mlstm_unit<false>(a, P, l, u); }
        }
        SEAM(g0 + 2); TEND(2); TBEG();
        if (PON(3) && IN(g0 + 3)) { const Args a = load_args(); unsigned char* ws = a.ws; const float* mod = (const float*)(ws + WS_MOD); bf16* proj = (bf16*)(ws + WS_PROJ); const float* xin = (l == 0) ? a.x : a.out; (void)mod; (void)proj; (void)xin; const Ctx P = fresh(X); mlstm_scan(a, P); }
        SEAM(g0 + 3); TEND(3); TBEG();
        if (PON(4) && IN(g0 + 4)) for (int rep = 0; rep < NREP(4); ++rep) { const Args a = load_args(); unsigned char* ws = a.ws; const float* mod = (const float*)(ws + WS_MOD); bf16* proj = (bf16*)(ws + WS_PROJ); const float* xin = (l == 0) ? a.x : a.out; (void)mod; (void)proj; (void)xin; const Ctx P = fresh(X);
#pragma unroll 1
            for (int u = P.bid; u < 256; u += P.G) mlstm_unit<true>(a, P, l, u); }
        SEAM(g0 + 4); TEND(4); TBEG();
        if (PON(5) && IN(g0 + 5)) for (int rep = 0; rep < NREP(5); ++rep) { const Args a = load_args(); unsigned char* ws = a.ws; const float* mod = (const float*)(ws + WS_MOD); bf16* proj = (bf16*)(ws + WS_PROJ); const float* xin = (l == 0) ? a.x : a.out; (void)mod; (void)proj; (void)xin; const Ctx P = fresh(X);
            { DenseSched S; S.A = (const char*)(ws + WS_H); S.Bt = (const char*)(ws + WS_WAU) + (size_t)l * D * 512 * 2; S.lda = 1024; S.ldb = 1024; S.ord.init(T / 256, D / 256, P.G, P.bid);
              EpiGate<false> E; E.P = proj; E.gcol = C_GA; pg8::gemm_phase<EpiGate<false>, DenseSched>(P.lds, 1024, S, E); }
            { DenseSched S; S.A = (const char*)(ws + WS_H) + (size_t)T * 512 * 2; S.Bt = (const char*)(ws + WS_WMU) + (size_t)l * D * 512 * 2; S.lda = 1024; S.ldb = 1024; S.ord.init(T / 256, D / 256, P.G, P.bid);
              EpiGate<true> E; E.P = proj; E.gcol = C_GB; pg8::gemm_phase<EpiGate<true>, DenseSched>(P.lds, 1024, S, E); }
        }
        SEAM(g0 + 5); TEND(5); TBEG();
        if (PON(6) && IN(g0 + 6)) for (int rep = 0; rep < NREP(6); ++rep) { const Args a = load_args(); unsigned char* ws = a.ws; const float* mod = (const float*)(ws + WS_MOD); bf16* proj = (bf16*)(ws + WS_PROJ); const float* xin = (l == 0) ? a.x : a.out; (void)mod; (void)proj; (void)xin; const Ctx P = fresh(X);
            DenseSched S; S.A = (const char*)(proj + C_MQ); S.Bt = (const char*)(ws + WS_WOUT) + (size_t)l * D * D * 2; S.lda = NPROJ * 2; S.ldb = D * 2; S.ord.init(T / 256, D / 256, P.G, P.bid);
            EpiRes E; E.xin = xin; E.out = a.out; E.g = mod + (size_t)(l * 2) * 6144 + 2 * 1024; E.ssq = (float*)(ws + WS_SSQ); E.rmask = T - 1;
            if (rep) { E.out = (float*)(ws + WS_H); E.rmask = T / 2 - 1; }
            pg8::gemm_phase<EpiRes, DenseSched>(P.lds, D * 2, S, E);
        }
        SEAM(g0 + 6); TEND(6); TBEG();
        if (PON(7) && IN(g0 + 7)) { const Args a = load_args(); unsigned char* ws = a.ws; const float* mod = (const float*)(ws + WS_MOD); bf16* proj = (bf16*)(ws + WS_PROJ); const float* xin = (l == 0) ? a.x : a.out; (void)mod; (void)proj; (void)xin; const Ctx P = fresh(X); p6_norm_route(a, P, l, a.out); }
        SEAM(g0 + 7); TEND(7); TBEG();
        if (PON(8) && IN(g0 + 8)) for (int rep = 0; rep < NREP(8); ++rep) { const Args a = load_args(); unsigned char* ws = a.ws; const float* mod = (const float*)(ws + WS_MOD); bf16* proj = (bf16*)(ws + WS_PROJ); const float* xin = (l == 0) ? a.x : a.out; (void)mod; (void)proj; (void)xin; const Ctx P = fresh(X);
            const MoeTab tb = moe_tables(a, P, l);
            LAS unsigned* tokoff = (LAS unsigned*)(P.lds + TOKOFF_OFF); const int* tokl = (const int*)(ws + WS_TOKL);
#pragma unroll 1
            for (int s = 0; s < 8; ++s) { const int L0 = s * P.G + P.bid;
                if (L0 < tb.Rtot * 8 && P.tid < 256) { const int L = xcd_remap(L0, tb.Rtot * 8); const int rt = L >> 3, cls = tb.tcls[rt], pos = tb.tpos[rt] + P.tid, cn = tb.cnt[cls]; const int tok = tokl[cls * CLS_CAP + (pos < cn ? pos : 0)]; tokoff[s * 256 + P.tid] = (unsigned)tok; } }
            __syncthreads();
            MoeUpSched S; S.A = (const char*)(ws + WS_H); S.W = (const char*)(ws + WS_WGU) + (size_t)l * NE * 1024 * D * 2; S.lda = D * 2; S.ldb = D * 2; S.tb = tb; S.G = P.G; S.c = P.bid; S.tokoff = tokoff;
            EpiSwiglu E; E.H = proj; E.tgate = (const float*)(ws + WS_TGATE); E.tokoff = tokoff;
            pg8::gemm_phase<EpiSwiglu, MoeUpSched>(P.lds, D * 2, S, E);
        }
        SEAM(g0 + 8); TEND(8); TBEG();
        if (PON(9) && IN(g0 + 9)) for (int rep = 0; rep < NREP(9); ++rep) { const Args a = load_args(); unsigned char* ws = a.ws; const float* mod = (const float*)(ws + WS_MOD); bf16* proj = (bf16*)(ws + WS_PROJ); const float* xin = (l == 0) ? a.x : a.out; (void)mod; (void)proj; (void)xin; const Ctx P = fresh(X);
            const MoeTab tb = moe_tables(a, P, l);
            MoeDownSched S; S.A = (const char*)proj; S.W = (const char*)(ws + WS_WD) + (size_t)l * NE * 1024 * FF * 2; S.lda = D * 2; S.ldb = FF * 2; S.tb = tb; S.G = P.G; S.c = P.bid;
            EpiMoeOut E; E.xin = a.out; E.out = a.out; E.g = mod + (size_t)(l * 2) * 6144 + 5 * 1024; E.tokl = (const int*)(ws + WS_TOKL); E.tb = tb; E.rmask = T - 1;
            if (rep) { E.out = (float*)(ws + WS_H); E.rmask = T / 2 - 1; }
            pg8::gemm_phase<EpiMoeOut, MoeDownSched>(P.lds, D * 2, S, E);
        }
        SEAM(g0 + 9); TEND(9); TBEG();
    }
    if (TSEL_MASK && X.bid == 0) { const unsigned long long t1 = __builtin_amdgcn_s_memrealtime(); while (__builtin_amdgcn_s_memrealtime() - t1 < TSCALE * tacc) __builtin_amdgcn_s_sleep(8); }
#undef IN
#undef SEAM
}

extern "C" void kernel_launch(void* const* d_in, const int* in_sizes, int n_in, void* d_out, int out_size, void* d_ws, size_t ws_size, hipStream_t stream) {
    static int grid = 0;
    if (grid == 0) {
        if (n_in != 24 || in_sizes[0] != T * D || out_size != T * D || ws_size < WS_END) { fprintf(stderr, "kernel_launch: unexpected shapes / workspace (n_in %d, ws %zu, need %zu)\n", n_in, ws_size, (size_t)WS_END); grid = -1; return; }
        int dev = 0, cus = 0;
        if (hipGetDevice(&dev) != hipSuccess || hipDeviceGetAttribute(&cus, hipDeviceAttributeMultiprocessorCount, dev) != hipSuccess) { grid = -1; return; }
        if (hipFuncSetAttribute((const void*)fwd, hipFuncAttributeMaxDynamicSharedMemorySize, LDS_BYTES) != hipSuccess) { fprintf(stderr, "kernel_launch: hipFuncSetAttribute failed\n"); grid = -1; return; }
        int per_cu = 0;
        if (hipOccupancyMaxActiveBlocksPerMultiprocessor(&per_cu, (const void*)fwd, 512, LDS_BYTES) != hipSuccess || per_cu < 1) fprintf(stderr, "kernel_launch: occupancy query reports %d\n", per_cu);
        (void)hipGetLastError();
        grid = cus < 256 ? cus : 256;
    }
    if (grid < 0) return;
    (void)hipMemsetAsync((char*)d_ws + WS_CTL, 0, CTL_ZERO_BYTES, stream);
    Args a{};
    a.x = (const float*)d_in[0]; a.c = (const float*)d_in[1]; a.pos = (const int*)d_in[2]; a.ada_w = (const float*)d_in[3]; a.ada_b = (const float*)d_in[4];
    a.nmw = (const float*)d_in[5]; a.nfw = (const float*)d_in[6]; a.w_in = (const float*)d_in[7]; a.b_ig = (const float*)d_in[8]; a.b_fg = (const float*)d_in[9];
    a.qnw = (const float*)d_in[10]; a.knw = (const float*)d_in[11]; a.sinks = (const float*)d_in[12]; a.conv_w = (const float*)d_in[13]; a.conv_b = (const float*)d_in[14];
    a.mnw = (const float*)d_in[15]; a.w_au = (const float*)d_in[16]; a.w_mu = (const float*)d_in[17]; a.w_out = (const float*)d_in[18]; a.router_w = (const float*)d_in[19];
    a.router_b = (const float*)d_in[20]; a.w_gate = (const float*)d_in[21]; a.w_up = (const float*)d_in[22]; a.w_down = (const float*)d_in[23];
    a.out = (float*)d_out; a.ws = (unsigned char*)d_ws;
#if MK_MULTI
    for (int gp = 0; gp < NGP; ++gp) { a.ph_lo = gp; a.ph_hi = gp + 1; hipLaunchKernelGGL(fwd, dim3(grid), dim3(512), LDS_BYTES, stream, a); }
#else
    a.ph_lo = 0; a.ph_hi = NGP; hipLaunchKernelGGL(fwd, dim3(grid), dim3(512), LDS_BYTES, stream, a);
#endif
}
```

```cpp
#include <hip/hip_runtime.h>
#include <cstdio>
#include <cstdint>

#ifndef MK_MULTI
#define MK_MULTI 0
#endif

#define GAS __attribute__((address_space(1)))
#define LAS __attribute__((address_space(3)))
typedef unsigned short bf16;
typedef unsigned v4u __attribute__((ext_vector_type(4)));
typedef unsigned v2u __attribute__((ext_vector_type(2)));
typedef float f32x4 __attribute__((ext_vector_type(4)));
typedef float f32x2 __attribute__((ext_vector_type(2)));
typedef short bf16x8 __attribute__((ext_vector_type(8)));
typedef short bf16x4 __attribute__((ext_vector_type(4)));
#define DI __device__ __forceinline__
#define RLX_AGENT __ATOMIC_RELAXED, __HIP_MEMORY_SCOPE_AGENT
#define LDS_WAIT() asm volatile("s_waitcnt lgkmcnt(0)" ::: "memory")
#define VM_WAIT() asm volatile("s_waitcnt vmcnt(0)" ::: "memory")

constexpr int NB = 2, SEQ = 16384, T = NB * SEQ, D = 1024, NL = 4;
constexpr int DIN_SRC = 4872;
constexpr int NPROJ = 4864;
constexpr int C_AQ = 0, C_AK = 512, C_AV = 640, C_MQ = 768, C_MK = 1280, C_MV = 1792, C_MO = 2304, C_GA = 2816, C_GB = 3840;
constexpr int NE = 16, FF = 512;
constexpr int NCLS = 24, CLS_CAP = 32768;
constexpr float EPS = 1e-6f;
constexpr int NPH = 10;
constexpr int NGP = 1 + NL * NPH;

constexpr size_t MiB = 1u << 20;
constexpr size_t WS_CTL = 0, CTL_ZERO_BYTES = 1 * MiB;
constexpr size_t WS_MOD = 1 * MiB;
constexpr size_t WS_ROPE = 2 * MiB;
constexpr size_t WS_GATES = 4 * MiB;
constexpr size_t WS_TGATE = 5 * MiB;
constexpr size_t WS_TOKL = 6 * MiB;
constexpr size_t WS_MLB = 9 * MiB;
constexpr size_t WS_MLC = 10 * MiB;
constexpr int NPROJW = 5120;
constexpr size_t WS_WIN = 28 * MiB;
constexpr size_t WS_WAU = 68 * MiB;
constexpr size_t WS_WMU = 72 * MiB;
constexpr size_t WS_WOUT = 76 * MiB;
constexpr size_t WS_WGU = 84 * MiB;
constexpr size_t WS_WD = 212 * MiB;
constexpr size_t WS_H = 276 * MiB;
constexpr size_t WS_PROJ = 340 * MiB;
constexpr size_t WS_SSQ = 644 * MiB;
constexpr size_t WS_END = 646 * MiB;

constexpr int CW_TMO = 0;
constexpr int CW_BAR = 4096;
constexpr int CW_CNT = 8192;

constexpr int RING_BYTES = 131072;
constexpr int MISC_OFF = RING_BYTES;
constexpr int TAB_OFF = RING_BYTES + 256;
constexpr int TOKOFF_OFF = RING_BYTES + 2048;
constexpr int LDS_BYTES = 147456;

DI unsigned f2bf(float f) { unsigned u = __builtin_bit_cast(unsigned, f); return (u + 0x7fffu + ((u >> 16) & 1u)) >> 16; }
DI unsigned pk2(float lo, float hi) { return f2bf(lo) | (f2bf(hi) << 16); }
DI float bf2f(unsigned short b) { return __builtin_bit_cast(float, ((unsigned)b) << 16); }
DI float bflo(unsigned w) { return __builtin_bit_cast(float, w << 16); }
DI float bfhi(unsigned w) { return __builtin_bit_cast(float, w & 0xffff0000u); }
DI float wave_sum(float v) {
#pragma unroll
    for (int o = 1; o < 64; o <<= 1) v += __shfl_xor(v, o);
    return v;
}
DI float sigmoidf_(float x) { return __builtin_amdgcn_rcpf(1.0f + __expf(-x)); }

#define XB_TMO      128
#define XB_XCNT(j)  (256  + 64 * (j))
#define XB_XSUB(j)  (1280 + 64 * (j))
#define XB_XGEN(j)  (2304 + 64 * (j))
#define XB_TOP      3328
#define XB_TOPGEN   3392
#define XCD_BAR_WORDS 3456
#define XB_SPIN_CAP (1u << 18)
__device__ __forceinline__ unsigned xb_ld(unsigned* p)              { return __hip_atomic_load(p, __ATOMIC_RELAXED, __HIP_MEMORY_SCOPE_AGENT); }
__device__ __forceinline__ unsigned xb_add(unsigned* p, unsigned v) { return __hip_atomic_fetch_add(p, v, __ATOMIC_RELAXED, __HIP_MEMORY_SCOPE_AGENT); }
__device__ __forceinline__ unsigned xb_xcc_id() { return (unsigned)__builtin_amdgcn_s_getreg((3 << 11) | 20) & 0xFu; }
#define XB_SPIN(cond, bar) do { unsigned _sp = 0; while (cond) { __builtin_amdgcn_s_sleep(1); \
    if ((++_sp & 255u) == 0u) { if (xb_ld(&(bar)[XB_TMO])) break; if (_sp > XB_SPIN_CAP) { atomicAdd(&(bar)[XB_TMO], 1u); break; } } } } while (0)
struct XcdBarrier { unsigned* bar; unsigned x; volatile LAS unsigned* st; };
__device__ __forceinline__ XcdBarrier xcd_barrier_post(unsigned* bar, volatile LAS unsigned* st) {
    XcdBarrier b; b.bar = bar; b.x = xb_xcc_id(); b.st = st;
    if (threadIdx.x == 0) (void)xb_add(&bar[XB_XCNT(b.x)], 1u);
    return b;
}
__device__ __forceinline__ void xcd_barrier_complete(unsigned* bar, unsigned x, unsigned& nloc, unsigned& nx) {
    const unsigned G = gridDim.x * gridDim.y * gridDim.z;
    unsigned sum, cnt, mine, sp = 0u;
    for (;;) {
        sum = 0u; cnt = 0u; mine = 0u;
#pragma unroll
        for (unsigned j = 0; j < 16; ++j) { const unsigned c = xb_ld(&bar[XB_XCNT(j)]); sum += c; cnt += (c > 0u) ? 1u : 0u; mine = (j == x) ? c : mine; }
        if (sum == G) break;
        __builtin_amdgcn_s_sleep(1);
        if ((++sp & 255u) == 0u) { if (xb_ld(&bar[XB_TMO])) break; if (sp > XB_SPIN_CAP) { atomicAdd(&bar[XB_TMO], 1u); break; } }
    }
    nloc = mine > 0u ? mine : 1u; nx = cnt > 0u ? cnt : 1u;
}
__device__ __forceinline__ void xcd_barrier(const XcdBarrier& b) {
    asm volatile("s_waitcnt vmcnt(0)" ::: "memory");
    __syncthreads();
    if (threadIdx.x == 0) {
        unsigned* bar = b.bar;
        __builtin_amdgcn_s_waitcnt(0);
        unsigned nloc = b.st[0], nx = b.st[1];
        if (nloc == 0u) { xcd_barrier_complete(bar, b.x, nloc, nx); b.st[0] = nloc; b.st[1] = nx; }
        const unsigned old = xb_add(&bar[XB_XSUB(b.x)], 1u);
        const unsigned gen = old / nloc;
        if (old + 1u == (gen + 1u) * nloc) {
            __builtin_amdgcn_fence(__ATOMIC_RELEASE, "agent");
            asm volatile("s_waitcnt vmcnt(0)" ::: "memory");
            const unsigned og = xb_add(&bar[XB_TOP], 1u);
            const unsigned tg = og / nx;
            if (og + 1u == (tg + 1u) * nx) xb_add(&bar[XB_TOPGEN], 1u);
            else XB_SPIN(xb_ld(&bar[XB_TOPGEN]) == tg, bar);
            __builtin_amdgcn_fence(__ATOMIC_ACQUIRE, "agent");
            xb_add(&bar[XB_XGEN(b.x)], 1u);
            asm volatile("s_waitcnt vmcnt(0)" ::: "memory");
        } else {
            XB_SPIN(xb_ld(&bar[XB_XGEN(b.x)]) == gen, bar);
            __builtin_amdgcn_fence(__ATOMIC_ACQUIRE, "agent");
            asm volatile("s_waitcnt vmcnt(0)" ::: "memory");
        }
    }
    __syncthreads();
}

namespace pg8 {
constexpr int BM = 256, BK = 64, HALF = 128, HTB = HALF * BK * 2, STAGE_BYTES = 8 * HTB, NXCD = 8, WGM = 8;
__host__ __device__ __forceinline__ int lds_byte(int r, int c) { const int st = (r >> 4) * 2 + (c >> 5), rr = r & 15, cc = c & 31, ob = rr * 64 + cc * 2; return st * 1024 + (ob ^ (((ob >> 9) & 1) << 5)); }
__host__ __device__ __forceinline__ void stage_rc(int b, int& R, int& C) { const int st = b / 1024, sb = b % 1024, swz = sb ^ (((sb >> 9) & 1) << 5); R = (st >> 1) * 16 + swz / 64; C = (st & 1) * 32 + (swz % 64) / 2; }
__host__ __device__ __forceinline__ int perm32(int rho) { const int n = rho >> 4, i = rho & 15; return 8 * (i >> 2) + 4 * n + (i & 3); }

struct Unit { int pm, pn, x0, x1; };

struct TileOrder {
    int nM, nN, nwg, G, c;
    __device__ void init(int nM_, int nN_, int G_, int c_) { nM = nM_; nN = nN_; nwg = nM * nN; G = G_; c = c_; }
    __device__ bool get(int i, int& pm, int& pn) const {
        const long L = (long)i * G + c; if (L >= nwg) return false;
        int wgid = (int)L; { const int q = nwg / NXCD, r = nwg % NXCD, xcd = wgid % NXCD, off = wgid / NXCD; wgid = (xcd < r ? xcd * (q + 1) : r * (q + 1) + (xcd - r) * q) + off; }
        const int nig = WGM * nN, gid = wgid / nig, fm = gid * WGM, gsz = (nM - fm) < WGM ? (nM - fm) : WGM;
        pm = fm + ((wgid % nig) % gsz); pn = (wgid % nig) / gsz; return true;
    }
};

typedef int v8i __attribute__((ext_vector_type(8)));
template <class Epi, class Sched, bool F8 = false>
__device__ __forceinline__ void gemm_phase(LAS unsigned char* lds, const int Kb, const Sched& S, const Epi& E) {
    int tid = threadIdx.x; asm volatile("" : "+v"(tid));
    const int wid = __builtin_amdgcn_readfirstlane(tid >> 6), lane = tid & 63, wr = wid >> 2, wc = wid & 3, fr = lane & 15, fq = lane >> 4;
    const int nt = Kb / 128;
    constexpr bool GA = Sched::GATHER; constexpr int KS = Sched::KSPLIT;
    unsigned voffA[2], voffB[2]; int Rst[2], Cst[2];
#pragma unroll
    for (int i = 0; i < 2; ++i) { int R, C; stage_rc(tid * 16 + i * 8192, R, C); const int Rb = Epi::PERM ? ((R & ~31) + perm32(R & 31)) : R;
        voffA[i] = (unsigned)(R * S.lda + C * 2); voffB[i] = (unsigned)(Rb * S.ldb + C * 2); Rst[i] = R; Cst[i] = C; }
    const size_t kstep = (size_t)(BK * 2);
    const size_t hstepA = (size_t)HALF * S.lda, hstepB = (size_t)HALF * S.ldb;
    const unsigned ldsw = (unsigned)wid * 1024u; const unsigned gmul = (unsigned)S.lda;
    const int aoff = F8 ? (lds_byte(wr * 64 + fr, (fq & 1) * 16) + (fq >> 1) * 1024) : lds_byte(wr * 64 + fr, fq * 8);
    const int boff = F8 ? (lds_byte(wc * 32 + fr, (fq & 1) * 16) + (fq >> 1) * 1024) : lds_byte(wc * 32 + fr, fq * 8);
    unsigned vAc[2], vAn[2];
#define PG8_SA(b, h) (((b) * 2 + (h)) * HTB)
#define PG8_SB(b, h) ((4 + (b) * 2 + (h)) * HTB)
#define PG8_STAGE2(bufoff, gbase, v0, v1) do { \
        __builtin_amdgcn_global_load_lds((const unsigned*)((const char*)(gbase) + (v0)), (LAS unsigned*)(lds + (bufoff) + ldsw), 16, 0, 0); \
        __builtin_amdgcn_global_load_lds((const unsigned*)((const char*)(gbase) + (v1)), (LAS unsigned*)(lds + (bufoff) + ldsw + 8192), 16, 0, 0); } while (0)
#define PG8_STAGE_B(bufoff, ptr, h) PG8_STAGE2(bufoff, (ptr) + (h) * hstepB, voffB[0], voffB[1])
#define PG8_STAGE_A(bufoff, ptr, h, nx) do { if constexpr (GA) { const unsigned _p = (nx) ? vAn[h] : vAc[h]; PG8_STAGE2(bufoff, ptr, (_p & 0xffffu) * gmul + (unsigned)Cst[0] * 2u, (_p >> 16) * gmul + (unsigned)Cst[0] * 2u); } \
        else { PG8_STAGE2(bufoff, (ptr) + (h) * hstepA, voffA[0], voffA[1]); } } while (0)
    typedef int v4i_ __attribute__((ext_vector_type(4)));
#define PG8_LDA(dst, b, h) do { _Pragma("unroll") for (int m = 0; m < 4; ++m) { if constexpr (F8) { dst##8[m].lo = *(const LAS v4i_*)(lds + PG8_SA(b, h) + aoff + m * 2048); dst##8[m].hi = *(const LAS v4i_*)(lds + PG8_SA(b, h) + aoff + m * 2048 + 16); } \
        else { _Pragma("unroll") for (int k = 0; k < 2; ++k) dst[m][k] = *(const LAS bf16x8*)(lds + PG8_SA(b, h) + aoff + m * 2048 + k * 1024); } } } while (0)
#define PG8_LDB(dst, b, h) do { _Pragma("unroll") for (int n = 0; n < 2; ++n) { if constexpr (F8) { dst##8[n].lo = *(const LAS v4i_*)(lds + PG8_SB(b, h) + boff + n * 2048); dst##8[n].hi = *(const LAS v4i_*)(lds + PG8_SB(b, h) + boff + n * 2048 + 16); } \
        else { _Pragma("unroll") for (int k = 0; k < 2; ++k) dst[n][k] = *(const LAS bf16x8*)(lds + PG8_SB(b, h) + boff + n * 2048 + k * 1024); } } } while (0)
#define PG8_MMA(ai, bj, At, Bt) do { __builtin_amdgcn_s_setprio(1); _Pragma("unroll") for (int m = 0; m < 4; ++m) _Pragma("unroll") for (int n = 0; n < 2; ++n) { \
        if constexpr (F8) { asm volatile("v_mfma_scale_f32_16x16x128_f8f6f4 %0, %1, %2, %0, %3, %3 op_sel_hi:[0,0,0]" : "+v"(acc[ai][bj][m][n]) : "v"(Bt##8[n]), "v"(At##8[m]), "v"(f8scale)); } \
        else { _Pragma("unroll") for (int k = 0; k < 2; ++k) acc[ai][bj][m][n] = __builtin_amdgcn_mfma_f32_16x16x32_bf16(Bt[n][k], At[m][k], acc[ai][bj][m][n], 0, 0, 0); } } \
        __builtin_amdgcn_s_setprio(0); } while (0)
#define PG8_WAIT_V(n) asm volatile("s_waitcnt vmcnt(" #n ")" ::: "memory")
#define PG8_WAIT_L(n) asm volatile("s_waitcnt lgkmcnt(" #n ")" ::: "memory")
#define PG8_BAR __builtin_amdgcn_s_barrier()
#define PG8_SCHED __builtin_amdgcn_sched_barrier(0)
#define PG8_GOFF(dst, u) do { if constexpr (GA) { _Pragma("unroll") for (int h = 0; h < 2; ++h) dst[h] = S.a_rowoff(u, Rst[0] + HALF * h) | (S.a_rowoff(u, Rst[0] + 64 + HALF * h) << 16); } } while (0)
    Unit cur, nxt; int ui = 0;
    if (!S.next(0, cur)) return;
    f32x4 acc[2][2][4][2];
#pragma unroll
    for (int a = 0; a < 2; ++a)
#pragma unroll
        for (int b = 0; b < 2; ++b)
#pragma unroll
            for (int m = 0; m < 4; ++m)
#pragma unroll
                for (int n = 0; n < 2; ++n) acc[a][b][m][n] = (f32x4){0.f, 0.f, 0.f, 0.f};
    int f8scale = 0x7F7F7F7F; asm volatile("" : "+v"(f8scale));
    bf16x8 At[4][2], B0[2][2], B1[2][2]; v8i At8[4], B08[2], B18[2];
    const char* cA = S.a_base(cur); const char* cB0 = S.b_base(cur, 0); const char* cB1 = KS ? S.b_base(cur, 1) : cB0;
    PG8_GOFF(vAc, cur);
    vAn[0] = vAc[0]; vAn[1] = vAc[1];
    PG8_STAGE_B(PG8_SB(0, 0), cB0, 0); PG8_STAGE_B(PG8_SB(0, 1), cB0, 1); PG8_STAGE_A(PG8_SA(0, 0), cA, 0, false); PG8_STAGE_A(PG8_SA(0, 1), cA, 1, false);
    if (wr == 1) PG8_BAR;
    PG8_WAIT_V(2); PG8_BAR;
    PG8_STAGE_B(PG8_SB(1, 0), cB0 + kstep, 0); PG8_STAGE_A(PG8_SA(1, 0), cA + kstep, 0, false); PG8_STAGE_B(PG8_SB(1, 1), cB0 + kstep, 1);
    PG8_WAIT_V(6); PG8_BAR;
    for (;;) {
        const bool has_next = S.next(ui + 1, nxt);
        const char* nA = has_next ? S.a_base(nxt) : cA; const char* nB0 = has_next ? S.b_base(nxt, 0) : cB0; const char* nB1 = (KS && has_next) ? S.b_base(nxt, 1) : (KS ? cB1 : nB0);
        if constexpr (GA) { if (has_next) { PG8_GOFF(vAn, nxt); } }
#pragma unroll 1
        for (int t = 0; t < nt; t += 2) {
            const bool last = (t == nt - 2);
            const char* a1 = cA + (size_t)(t + 1) * kstep;
            const char* a2 = last ? nA : cA + (size_t)(t + 2) * kstep;
            const char* b2 = last ? nB0 : ((KS && (t + 2) >= KS) ? cB1 + (size_t)(t + 2 - KS) * kstep : cB0 + (size_t)(t + 2) * kstep);
            const char* a3 = a2 + kstep; const char* b3 = b2 + kstep;
            PG8_LDB(B0, 0, 0); PG8_LDB(B1, 0, 1); PG8_SCHED; PG8_LDA(At, 0, 0); PG8_STAGE_A(PG8_SA(1, 1), a1, 1, false);
            PG8_WAIT_V(8); PG8_WAIT_L(0); PG8_BAR; PG8_MMA(0, 0, At, B0); PG8_MMA(0, 1, At, B1); PG8_BAR; PG8_SCHED;
            PG8_LDA(At, 0, 1); PG8_STAGE_B(PG8_SB(0, 0), b2, 0); PG8_STAGE_B(PG8_SB(0, 1), b2, 1); PG8_STAGE_A(PG8_SA(0, 0), a2, 0, last);
            PG8_WAIT_V(8); PG8_WAIT_L(0); PG8_BAR; PG8_MMA(1, 0, At, B0); PG8_MMA(1, 1, At, B1); PG8_BAR; PG8_SCHED;
            PG8_LDB(B0, 1, 0); PG8_LDB(B1, 1, 1); PG8_SCHED; PG8_LDA(At, 1, 0); PG8_STAGE_A(PG8_SA(0, 1), a2, 1, last);
            PG8_WAIT_V(8); PG8_WAIT_L(0); PG8_BAR; PG8_MMA(0, 0, At, B0); PG8_MMA(0, 1, At, B1); PG8_BAR; PG8_SCHED;
            PG8_LDA(At, 1, 1); PG8_STAGE_B(PG8_SB(1, 0), b3, 0); PG8_STAGE_B(PG8_SB(1, 1), b3, 1); PG8_STAGE_A(PG8_SA(1, 0), a3, 0, last);
            PG8_WAIT_V(8); PG8_WAIT_L(0); PG8_BAR; PG8_MMA(1, 0, At, B0); PG8_MMA(1, 1, At, B1); PG8_BAR; PG8_SCHED;
        }
        if (wr == 0) PG8_BAR;
        if constexpr (F8) { asm volatile("s_nop 15\n\ts_nop 15" ::: "memory"); }
        { int fr_ = fr, fq_ = fq; asm volatile("" : "+v"(fr_), "+v"(fq_));
          E(acc, cur, wr, wc, fr_, fq_); }
        if (!has_next) break;
#pragma unroll
        for (int a = 0; a < 2; ++a)
#pragma unroll
            for (int b = 0; b < 2; ++b)
#pragma unroll
                for (int m = 0; m < 4; ++m)
#pragma unroll
                    for (int n = 0; n < 2; ++n) acc[a][b][m][n] = (f32x4){0.f, 0.f, 0.f, 0.f};
        cur = nxt; cA = nA; cB0 = nB0; cB1 = nB1; ++ui;
        vAc[0] = vAn[0]; vAc[1] = vAn[1];
        if (wr == 1) PG8_BAR;
    }
    PG8_WAIT_V(0);
    PG8_BAR;
#undef PG8_SA
#undef PG8_SB
#undef PG8_STAGE2
#undef PG8_STAGE_A
#undef PG8_STAGE_B
#undef PG8_LDA
#undef PG8_LDB
#undef PG8_MMA
#undef PG8_WAIT_V
#undef PG8_WAIT_L
#undef PG8_BAR
#undef PG8_SCHED
#undef PG8_GOFF
}
}
using pg8::Unit;

DI unsigned cvt_pk_bf16(float lo, float hi) { unsigned r; asm volatile("v_cvt_pk_bf16_f32 %0, %1, %2" : "=v"(r) : "v"(lo), "v"(hi)); return r; }

struct Args {
    const float* x; const float* c; const int* pos; const float* ada_w; const float* ada_b; const float* nmw; const float* nfw; const float* w_in;
    const float* b_ig; const float* b_fg; const float* qnw; const float* knw; const float* sinks; const float* conv_w; const float* conv_b; const float* mnw;
    const float* w_au; const float* w_mu; const float* w_out; const float* router_w; const float* router_b; const float* w_gate; const float* w_up; const float* w_down;
    float* out; unsigned char* ws; int ph_lo, ph_hi;
};

__constant__ float c_invf[8] = {1.0f, 0.1939227432012558f, 0.03760603070259094f, 0.007292664609849453f, 0.0014142135623842478f, 0.00027424818836152554f, 5.3182957344688475e-05f, 1.0313385246263351e-05f};

struct DenseSched {
    static constexpr bool GATHER = false; static constexpr int KSPLIT = 0;
    const char* A; const char* Bt; int lda, ldb; pg8::TileOrder ord;
    DI bool next(int i, Unit& u) const { int pm, pn; if (!ord.get(i, pm, pn)) return false; u.pm = pm; u.pn = pn; u.x0 = 0; u.x1 = 0; return true; }
    DI const char* a_base(const Unit& u) const { return A + (size_t)u.pm * 256 * lda; }
    DI const char* b_base(const Unit& u, int) const { return Bt + (size_t)u.pn * 256 * ldb; }
    DI unsigned a_rowoff(const Unit&, int) const { return 0u; }
};
struct EpiProj {
    static constexpr bool PERM = true;
    bf16* O; float* gates; const float* big; const float* bfg;
    DI void operator()(const f32x4 (&acc)[2][2][4][2], const Unit& u, int wr, int wc, int fr, int fq) const {
        const int row0 = u.pm * 256 + wr * 64 + fr, col0 = u.pn * 256 + wc * 32 + 8 * fq; const bool sg = u.pn >= 9; constexpr float WSC = 1.0f / 64.0f;
        if (u.pn == 19) {
            if (wc == 0 && fq == 0) {
#pragma unroll
                for (int ai = 0; ai < 2; ++ai)
#pragma unroll
                    for (int m = 0; m < 4; ++m) { const int row = row0 + ai * 128 + m * 16; const f32x4 vi = acc[ai][0][m][0], vf = acc[ai][0][m][1]; f32x4 oi, of;
#pragma unroll
                        for (int j = 0; j < 4; ++j) { oi[j] = vi[j] * WSC + big[j]; const float z = vf[j] * WSC + bfg[j]; of[j] = fminf(z, 0.f) - log1pf(__expf(-fabsf(z))); }
                        *(f32x4*)(gates + (size_t)row * 8) = oi; *(f32x4*)(gates + (size_t)row * 8 + 4) = of; } }
            return; }
#pragma unroll
        for (int ai = 0; ai < 2; ++ai)
#pragma unroll
            for (int m = 0; m < 4; ++m) { bf16* rowp = O + (size_t)(row0 + ai * 128 + m * 16) * NPROJ + col0;
#pragma unroll
                for (int bj = 0; bj < 2; ++bj) { f32x4 v0 = acc[ai][bj][m][0] * WSC, v1 = acc[ai][bj][m][1] * WSC;
                    if (sg) {
#pragma unroll
                        for (int j = 0; j < 4; ++j) { v0[j] = sigmoidf_(v0[j]); v1[j] = sigmoidf_(v1[j]); } }
                    v4u w; w.x = cvt_pk_bf16(v0[0], v0[1]); w.y = cvt_pk_bf16(v0[2], v0[3]); w.z = cvt_pk_bf16(v1[0], v1[1]); w.w = cvt_pk_bf16(v1[2], v1[3]);
                    *(v4u*)(rowp + bj * 128) = w; } }
    }
};
template <bool ADD> struct EpiGate {
    static constexpr bool PERM = true;
    bf16* P; int gcol;
    DI void operator()(const f32x4 (&acc)[2][2][4][2], const Unit& u, int wr, int wc, int fr, int fq) const {
        const int row0 = u.pm * 256 + wr * 64 + fr, col0 = u.pn * 256 + wc * 32 + 8 * fq;
#pragma unroll
        for (int ai = 0; ai < 2; ++ai)
#pragma unroll
            for (int m = 0; m < 4; ++m) { bf16* rowp = P + (size_t)(row0 + ai * 128 + m * 16) * NPROJ + col0;
#pragma unroll
                for (int bj = 0; bj < 2; ++bj) { const f32x4 v0 = acc[ai][bj][m][0], v1 = acc[ai][bj][m][1];
                    const v4u g = *(const v4u*)(rowp + gcol + bj * 128);
                    float o[8] = {bflo(g.x) * v0[0], bfhi(g.x) * v0[1], bflo(g.y) * v0[2], bfhi(g.y) * v0[3], bflo(g.z) * v1[0], bfhi(g.z) * v1[1], bflo(g.w) * v1[2], bfhi(g.w) * v1[3]};
                    if (ADD) { const v4u p = *(const v4u*)(rowp + C_MQ + bj * 128);
                        o[0] += bflo(p.x); o[1] += bfhi(p.x); o[2] += bflo(p.y); o[3] += bfhi(p.y); o[4] += bflo(p.z); o[5] += bfhi(p.z); o[6] += bflo(p.w); o[7] += bfhi(p.w); }
                    v4u w; w.x = cvt_pk_bf16(o[0], o[1]); w.y = cvt_pk_bf16(o[2], o[3]); w.z = cvt_pk_bf16(o[4], o[5]); w.w = cvt_pk_bf16(o[6], o[7]);
                    *(v4u*)(rowp + C_MQ + bj * 128) = w; } }
    }
};
struct EpiRes {
    static constexpr bool PERM = false;
    const float* xin; float* out; const float* g; float* ssq; int rmask;
    DI void operator()(const f32x4 (&acc)[2][2][4][2], const Unit& u, int wr, int wc, int fr, int fq) const {
        const int row0 = u.pm * 256 + wr * 64 + fr, col0 = u.pn * 256 + wc * 32 + 4 * fq; const int b = (u.pm * 256) >> 14;
        f32x4 gv[2][2];
#pragma unroll
        for (int bj = 0; bj < 2; ++bj)
#pragma unroll
            for (int n = 0; n < 2; ++n) gv[bj][n] = *(const f32x4*)(g + b * 6144 + col0 + bj * 128 + n * 16);
#pragma unroll
        for (int ai = 0; ai < 2; ++ai)
#pragma unroll
            for (int m = 0; m < 4; ++m) { const size_t off = (size_t)(row0 + ai * 128 + m * 16) * D + col0; const size_t offo = (size_t)((row0 + ai * 128 + m * 16) & rmask) * D + col0; float sq = 0.f;
#pragma unroll
                for (int bj = 0; bj < 2; ++bj)
#pragma unroll
                    for (int n = 0; n < 2; ++n) { const f32x4 xv = *(const f32x4*)(xin + off + bj * 128 + n * 16); const f32x4 o = xv + gv[bj][n] * acc[ai][bj][m][n];
                        sq += (o.x * o.x + o.y * o.y) + (o.z * o.z + o.w * o.w);
                        *(f32x4*)(out + offo + bj * 128 + n * 16) = o; }
                sq += __shfl_xor(sq, 16); sq += __shfl_xor(sq, 32);
                if (fq == 0) ssq[(size_t)(row0 + ai * 128 + m * 16) * 16 + u.pn * 4 + wc] = sq; }
    }
};

struct MoeTab { const LAS int* tcls; const LAS int* tpos; const LAS int* cnt; int Rtot; };
DI int xcd_remap(int L, int nwg) { const int q = nwg >> 3, r = nwg & 7, xcd = L & 7, off = L >> 3; return (xcd < r ? xcd * (q + 1) : r * (q + 1) + (xcd - r) * q) + off; }
DI void cls_experts(int cls, int& ea, int& eb) { const int g = cls / 6, p = cls - 6 * g; const int a = (p < 3) ? 0 : ((p < 5) ? 1 : 2); const int b = (p < 3) ? (p + 1) : ((p < 5) ? (p - 1) : 3); ea = 4 * g + a; eb = 4 * g + b; }
struct MoeUpSched {
    static constexpr bool GATHER = true; static constexpr int KSPLIT = 0;
    const char* A; const char* W; int lda, ldb; MoeTab tb; int G, c; const LAS unsigned* tokoff;
    DI bool next(int i, Unit& u) const { const int L0 = i * G + c; if (L0 >= tb.Rtot * 8) return false; const int L = xcd_remap(L0, tb.Rtot * 8); u.pm = L >> 3; u.pn = L & 7; u.x0 = i; u.x1 = __builtin_amdgcn_readfirstlane(tb.tcls[u.pm]); return true; }
    DI const char* a_base(const Unit&) const { return A; }
    DI const char* b_base(const Unit& u, int) const { int ea, eb; cls_experts(u.x1, ea, eb); const int e = (u.pn < 4) ? ea : eb; return W + ((size_t)e * 1024 + (size_t)(u.pn & 3) * 256) * ldb; }
    DI unsigned a_rowoff(const Unit& u, int r) const { return tokoff[u.x0 * 256 + r]; }
};
struct EpiSwiglu {
    static constexpr bool PERM = true;
    bf16* H; const float* tgate; const LAS unsigned* tokoff;
    DI void operator()(const f32x4 (&acc)[2][2][4][2], const Unit& u, int wr, int wc, int fr, int fq) const {
        const int r0 = wr * 64 + fr; const int hc = (u.pn >> 2) * 512 + (u.pn & 3) * 128 + wc * 32 + 8 * fq; const int gsel = u.pn >> 2;
#pragma unroll
        for (int ai = 0; ai < 2; ++ai)
#pragma unroll
            for (int m = 0; m < 4; ++m) { const int r = r0 + ai * 128 + m * 16; const unsigned tok = tokoff[u.x0 * 256 + r]; const float rg = tgate[tok * 2 + gsel];
                const f32x4 g0 = acc[ai][0][m][0] * (1.0f / 64.0f), g1 = acc[ai][0][m][1] * (1.0f / 64.0f), u0 = acc[ai][1][m][0] * (1.0f / 64.0f), u1 = acc[ai][1][m][1] * (1.0f / 64.0f);
                float o[8];
#pragma unroll
                for (int j = 0; j < 4; ++j) { o[j] = g0[j] * sigmoidf_(g0[j]) * u0[j] * rg; o[4 + j] = g1[j] * sigmoidf_(g1[j]) * u1[j] * rg; }
                v4u w; w.x = cvt_pk_bf16(o[0], o[1]); w.y = cvt_pk_bf16(o[2], o[3]); w.z = cvt_pk_bf16(o[4], o[5]); w.w = cvt_pk_bf16(o[6], o[7]);
                *(v4u*)(H + ((size_t)u.pm * 256 + r) * 1024 + hc) = w; }
    }
};
struct MoeDownSched {
    static constexpr bool GATHER = false; static constexpr int KSPLIT = 8;
    const char* A; const char* W; int lda, ldb; MoeTab tb; int G, c;
    DI bool next(int i, Unit& u) const { const int L0 = i * G + c; if (L0 >= tb.Rtot * 4) return false; const int L = xcd_remap(L0, tb.Rtot * 4); u.pm = L >> 2; u.pn = L & 3; u.x0 = __builtin_amdgcn_readfirstlane(tb.tpos[u.pm]); u.x1 = __builtin_amdgcn_readfirstlane(tb.tcls[u.pm]); return true; }
    DI const char* a_base(const Unit& u) const { return A + (size_t)u.pm * 256 * lda; }
    DI const char* b_base(const Unit& u, int half) const { int ea, eb; cls_experts(u.x1, ea, eb); const int e = half ? eb : ea; return W + ((size_t)e * 1024 + (size_t)u.pn * 256) * ldb; }
    DI unsigned a_rowoff(const Unit&, int) const { return 0u; }
};
struct EpiMoeOut {
    static constexpr bool PERM = false;
    const float* xin; float* out; const float* g; const int* tokl; MoeTab tb; int rmask;
    DI void operator()(const f32x4 (&acc)[2][2][4][2], const Unit& u, int wr, int wc, int fr, int fq) const {
        const int r0 = wr * 64 + fr, col0 = u.pn * 256 + wc * 32 + 4 * fq; const int cn = tb.cnt[u.x1];
#pragma unroll
        for (int ai = 0; ai < 2; ++ai)
#pragma unroll
            for (int m = 0; m < 4; ++m) { const int pos = u.x0 + r0 + ai * 128 + m * 16;
                if (pos < cn) { const int tok = tokl[u.x1 * CLS_CAP + pos]; const int b = tok >> 14; const float* ip = xin + (size_t)tok * D + col0; float* op = out + (size_t)(tok & rmask) * D + col0; const float* gp = g + b * 6144 + col0;
#pragma unroll
                    for (int bj = 0; bj < 2; ++bj)
#pragma unroll
                        for (int n = 0; n < 2; ++n) { const f32x4 xv = *(const f32x4*)(ip + bj * 128 + n * 16); const f32x4 gv = *(const f32x4*)(gp + bj * 128 + n * 16);
                            *(f32x4*)(op + bj * 128 + n * 16) = xv + gv * acc[ai][bj][m][n]; } } }
    }
};

struct Ctx { LAS unsigned char* lds; int tid, lane, wave, G, bid; };
DI Ctx fresh(const Ctx& X) { Ctx P = X; int t = X.tid; asm volatile("" : "+v"(t)); P.tid = t; P.lane = t & 63; P.wave = __builtin_amdgcn_readfirstlane(t >> 6); return P; }

DI void tr_item(const float* W, int ldw, int K, bf16* WT, int k0, LAS float* scr, int lane) {
#pragma unroll 8
    for (int i = 0; i < 32; ++i) { const int kk = 2 * i + (lane >> 5); scr[kk * 33 + (lane & 31)] = W[(size_t)(k0 + kk) * ldw + (lane & 31)]; }
    LDS_WAIT(); asm volatile("" ::: "memory");
    const int c = lane & 7;
#pragma unroll
    for (int j = 0; j < 4; ++j) { const int n = (lane >> 3) + 8 * j; const LAS float* s = scr + (8 * c) * 33 + n;
        v4u o; o.x = pk2(s[0 * 33], s[1 * 33]); o.y = pk2(s[2 * 33], s[3 * 33]); o.z = pk2(s[4 * 33], s[5 * 33]); o.w = pk2(s[6 * 33], s[7 * 33]);
        *(v4u*)(WT + (size_t)n * K + k0 + 8 * c) = o; }
    LDS_WAIT(); asm volatile("" ::: "memory");
}
DI unsigned pk4_fp8(float a0, float a1, float a2, float a3) { int p = __builtin_amdgcn_cvt_pk_fp8_f32(a0, a1, 0, false); p = __builtin_amdgcn_cvt_pk_fp8_f32(a2, a3, p, true); return (unsigned)p; }
DI void tr_item8(const float* W, int ldw, int K, unsigned char* WT, int k0, float scale, LAS float* scr, int lane) {
#pragma unroll 8
    for (int i = 0; i < 32; ++i) { const int kk = 2 * i + (lane >> 5); scr[kk * 33 + (lane & 31)] = W[(size_t)(k0 + kk) * ldw + (lane & 31)]; }
    LDS_WAIT(); asm volatile("" ::: "memory");
    const int c = lane & 7;
#pragma unroll
    for (int j = 0; j < 4; ++j) { const int n = (lane >> 3) + 8 * j; const LAS float* s = scr + (8 * c) * 33 + n;
        v2u o; o.x = pk4_fp8(s[0 * 33] * scale, s[1 * 33] * scale, s[2 * 33] * scale, s[3 * 33] * scale); o.y = pk4_fp8(s[4 * 33] * scale, s[5 * 33] * scale, s[6 * 33] * scale, s[7 * 33] * scale);
        *(v2u*)(WT + (size_t)n * K + k0 + 8 * c) = o; }
    LDS_WAIT(); asm volatile("" ::: "memory");
}
DI void p0_prologue(const Args& a, const Ctx& X) {
    unsigned char* ws = a.ws;
    LAS float* scr = (LAS float*)(X.lds + X.wave * 16384);
    const int gw = X.bid * 8 + X.wave, NGW = X.G * 8;
    constexpr int IT_WIN = 16 * 153, IT_AU = 8 * 32, IT_OUT = 16 * 32, IT_GU = 16 * 16 * 32, IT_DN = 16 * 8 * 32;
    constexpr int IT_L = IT_WIN + 2 * IT_AU + IT_OUT + IT_GU + IT_DN;
    for (int it = gw; it < NL * IT_L; it += NGW) {
        const int l = it / IT_L; int r = it - l * IT_L;
        if (r < IT_WIN) { const int kb = r / 153, nb = r - kb * 153, d0 = 32 * nb, s0 = (nb == 152) ? 2304 : (d0 + (d0 >= 2304 ? 8 : 0));
            tr_item8(a.w_in + (size_t)l * D * DIN_SRC + s0, DIN_SRC, D, (unsigned char*)(ws + WS_WIN) + ((size_t)l * NPROJW + d0) * D, 64 * kb, 64.0f, scr, X.lane); continue; }
        r -= IT_WIN;
        if (r < IT_AU) { const int kb = r >> 5, nb = r & 31;
            tr_item(a.w_au + (size_t)l * 512 * D + 32 * nb, D, 512, (bf16*)(ws + WS_WAU) + ((size_t)l * D + 32 * nb) * 512, 64 * kb, scr, X.lane); continue; }
        r -= IT_AU;
        if (r < IT_AU) { const int kb = r >> 5, nb = r & 31;
            tr_item(a.w_mu + (size_t)l * 512 * D + 32 * nb, D, 512, (bf16*)(ws + WS_WMU) + ((size_t)l * D + 32 * nb) * 512, 64 * kb, scr, X.lane); continue; }
        r -= IT_AU;
        if (r < IT_OUT) { const int kb = r >> 5, nb = r & 31;
            tr_item(a.w_out + (size_t)l * D * D + 32 * nb, D, D, (bf16*)(ws + WS_WOUT) + ((size_t)l * D + 32 * nb) * D, 64 * kb, scr, X.lane); continue; }
        r -= IT_OUT;
        if (r < IT_GU) { const int e = r >> 9, q = r & 511, kb = q >> 5, nb = q & 31, tq = nb >> 3, rb = nb & 7;
            const float* src = ((rb < 4) ? a.w_gate : a.w_up) + ((size_t)(l * NE + e) * D) * FF + 128 * tq + 32 * (rb & 3);
            tr_item8(src, FF, D, (unsigned char*)(ws + WS_WGU) + ((size_t)(l * NE + e) * 1024 + 32 * nb) * D, 64 * kb, 64.0f, scr, X.lane); continue; }
        r -= IT_GU;
        { const int e = r >> 8, q = r & 255, kb = q >> 5, nb = q & 31;
            tr_item(a.w_down + ((size_t)(l * NE + e) * FF) * D + 32 * nb, D, FF, (bf16*)(ws + WS_WD) + ((size_t)(l * NE + e) * 1024 + 32 * nb) * FF, 64 * kb, scr, X.lane); }
    }
    { float* cs = (float*)(ws + WS_ROPE); float* sn = cs + (size_t)T * 8;
      for (int i = X.bid * 512 + X.tid; i < T * 8; i += X.G * 512) { const int tok = i >> 3, f = i & 7; const float angf = (float)a.pos[tok] * c_invf[f];
          double rev = (double)angf * 0.15915494309189535; rev -= rint(rev); const float rf = (float)rev;
          cs[i] = __builtin_amdgcn_cosf(rf); sn[i] = __builtin_amdgcn_sinf(rf); } }
    __syncthreads();
    LAS float* cact = (LAS float*)X.lds; LAS float* red = (LAS float*)(X.lds + 8192);
    for (int i = X.tid; i < 2048; i += 512) { const float cv = a.c[i]; cact[i] = cv / (1.0f + __expf(-cv)); }
    __syncthreads();
    float* mod = (float*)(ws + WS_MOD);
    for (int it = X.bid; it < NL * 96; it += X.G) { const int l = it / 96, cg = it - l * 96; const int col = cg * 64 + X.lane;
        const float* w = a.ada_w + (size_t)l * D * 6144 + col; float s0 = 0.f, s1 = 0.f;
#pragma unroll 8
        for (int kk = 0; kk < 128; ++kk) { const int k = X.wave * 128 + kk; const float wv = w[(size_t)k * 6144]; s0 += cact[k] * wv; s1 += cact[1024 + k] * wv; }
        red[(X.wave * 2 + 0) * 64 + X.lane] = s0; red[(X.wave * 2 + 1) * 64 + X.lane] = s1;
        __syncthreads();
        if (X.tid < 128) { const int b = X.tid >> 6, ln = X.tid & 63; float s = 0.f;
#pragma unroll
            for (int w8 = 0; w8 < 8; ++w8) s += red[(w8 * 2 + b) * 64 + ln];
            mod[(size_t)(l * 2 + b) * 6144 + cg * 64 + ln] = s + a.ada_b[l * 6144 + cg * 64 + ln]; }
        __syncthreads();
    }
}

DI void p1_norm_gates(const Args& a, const Ctx& X, int l, const float* xin) {
    unsigned char* ws = a.ws;
    const float* mod = (const float*)(ws + WS_MOD); unsigned char* hb = (unsigned char*)(ws + WS_H);
    const int gw = X.bid * 8 + X.wave, NGW = X.G * 8;
    for (int rg = gw; rg < T / 16; rg += NGW) {
        const int row0 = rg * 16, b = row0 >> 14;
        const float* mb = mod + (size_t)(l * 2 + b) * 6144;
        f32x4 aw[4], sh[4];
#pragma unroll
        for (int j = 0; j < 4; ++j) { const int k = 256 * j + 4 * X.lane; const f32x4 nw = *(const f32x4*)(a.nmw + l * D + k); const f32x4 sc = *(const f32x4*)(mb + 1024 + k); aw[j] = nw * (sc + 1.0f); sh[j] = *(const f32x4*)(mb + k); }
        f32x4 pre[4][4];
#pragma unroll
        for (int q = 0; q < 4; ++q) { const f32x4* xp = (const f32x4*)(xin + (size_t)(row0 + q) * D) + X.lane;
#pragma unroll
            for (int j = 0; j < 4; ++j) pre[q][j] = xp[64 * j]; }
#pragma unroll 1
        for (int rb = 0; rb < 16; rb += 4) {
#pragma unroll
          for (int q = 0; q < 4; ++q) { const int row = row0 + rb + q;
            f32x4 v[4]; float ss = 0.f;
#pragma unroll
            for (int j = 0; j < 4; ++j) v[j] = pre[q][j];
            if (rb + 4 < 16) { const f32x4* xp = (const f32x4*)(xin + (size_t)(row + 4) * D) + X.lane;
#pragma unroll
                for (int j = 0; j < 4; ++j) pre[q][j] = xp[64 * j]; }
#pragma unroll
            for (int j = 0; j < 4; ++j) ss += (v[j].x * v[j].x + v[j].y * v[j].y) + (v[j].z * v[j].z + v[j].w * v[j].w);
            ss = wave_sum(ss); const float rstd = __builtin_amdgcn_rsqf(ss * (1.0f / D) + EPS);
            unsigned* o4 = (unsigned*)(hb + (size_t)row * D) + X.lane;
#pragma unroll
            for (int j = 0; j < 4; ++j) { v[j] = v[j] * rstd * aw[j] + sh[j]; o4[64 * j] = pk4_fp8(v[j].x, v[j].y, v[j].z, v[j].w); }
          }
        }
    }
}

DI void attn_unit(const Args& a, const Ctx& X, int l, int unit) {
    unsigned char* ws = a.ws; const bf16* proj = (const bf16*)(ws + WS_PROJ); bf16* ao = (bf16*)(ws + WS_H);
    const float* cs = (const float*)(ws + WS_ROPE); const float* sn = cs + (size_t)T * 8;
    const int b = unit >> 8, rem = unit & 255, nb = rem >> 1, kvh = rem & 1; const int tok0 = b * SEQ + nb * 128;
    LAS bf16* Kl = (LAS bf16*)X.lds;
    LAS bf16* VT = (LAS bf16*)(X.lds + 36864);
    int lane = X.lane; asm volatile("" : "+v"(lane));
    const int c16 = lane & 15, quad = lane >> 4;
    {
        const int row = X.tid >> 1, half = X.tid & 1; const int tokk = tok0 - 128 + row; const bool valid = (nb > 0) || (row >= 128);
        float y[32]; float vv[32];
        if (valid) {
            const v4u* kp = (const v4u*)(proj + (size_t)tokk * NPROJ + C_AK + kvh * 64 + half * 32); const v4u* vp = (const v4u*)(proj + (size_t)tokk * NPROJ + C_AV + kvh * 64 + half * 32);
#pragma unroll
            for (int q = 0; q < 4; ++q) { const v4u kw = kp[q], vw = vp[q];
                y[8 * q + 0] = bflo(kw.x); y[8 * q + 1] = bfhi(kw.x); y[8 * q + 2] = bflo(kw.y); y[8 * q + 3] = bfhi(kw.y); y[8 * q + 4] = bflo(kw.z); y[8 * q + 5] = bfhi(kw.z); y[8 * q + 6] = bflo(kw.w); y[8 * q + 7] = bfhi(kw.w);
                vv[8 * q + 0] = bflo(vw.x); vv[8 * q + 1] = bfhi(vw.x); vv[8 * q + 2] = bflo(vw.y); vv[8 * q + 3] = bfhi(vw.y); vv[8 * q + 4] = bflo(vw.z); vv[8 * q + 5] = bfhi(vw.z); vv[8 * q + 6] = bflo(vw.w); vv[8 * q + 7] = bfhi(vw.w); }
        } else {
#pragma unroll
            for (int i = 0; i < 32; ++i) { y[i] = 0.f; vv[i] = 0.f; } }
        float ss = 0.f;
#pragma unroll
        for (int i = 0; i < 32; ++i) ss += y[i] * y[i];
        ss += __shfl_xor(ss, 1); const float rstd = 1.0f / sqrtf(ss * (1.0f / 64.0f) + EPS);
#pragma unroll
        for (int i = 0; i < 32; ++i) y[i] = y[i] * rstd * a.knw[l * 64 + half * 32 + i];
        if (half == 0 && valid) {
#pragma unroll
            for (int d = 0; d < 8; ++d) { const float c = cs[(size_t)tokk * 8 + d], s = sn[(size_t)tokk * 8 + d]; const float t1 = y[d], t2 = y[d + 8]; y[d] = t1 * c - t2 * s; y[d + 8] = t2 * c + t1 * s; } }
#pragma unroll
        for (int q = 0; q < 4; ++q) { v4u w; w.x = pk2(y[8 * q], y[8 * q + 1]); w.y = pk2(y[8 * q + 2], y[8 * q + 3]); w.z = pk2(y[8 * q + 4], y[8 * q + 5]); w.w = pk2(y[8 * q + 6], y[8 * q + 7]);
            *(LAS v4u*)(Kl + row * 72 + half * 32 + 8 * q) = w; }
#pragma unroll
        for (int i = 0; i < 32; ++i) VT[(half * 32 + i) * 280 + row] = (bf16)f2bf(vv[i]);
        if (X.tid < 64) {
#pragma unroll
            for (int cc = 256; cc < 280; ++cc) VT[X.tid * 280 + cc] = 0; }
    }
    __syncthreads();
#pragma unroll 1
    for (int task = X.wave; task < 32; task += 8) {
        const int g = task >> 3, rg = task & 7, r0 = 16 * rg, head = kvh * 4 + g; const int tokq = tok0 + r0 + c16;
        const float sink = a.sinks[l * 8 + head];
        float qv[16];
        { const bf16* qp = proj + (size_t)tokq * NPROJ + C_AQ + head * 64; const v4u w0 = *(const v4u*)(qp + 8 * quad), w1 = *(const v4u*)(qp + 32 + 8 * quad);
          qv[0] = bflo(w0.x); qv[1] = bfhi(w0.x); qv[2] = bflo(w0.y); qv[3] = bfhi(w0.y); qv[4] = bflo(w0.z); qv[5] = bfhi(w0.z); qv[6] = bflo(w0.w); qv[7] = bfhi(w0.w);
          qv[8] = bflo(w1.x); qv[9] = bfhi(w1.x); qv[10] = bflo(w1.y); qv[11] = bfhi(w1.y); qv[12] = bflo(w1.z); qv[13] = bfhi(w1.z); qv[14] = bflo(w1.w); qv[15] = bfhi(w1.w); }
        float ss = 0.f;
#pragma unroll
        for (int i = 0; i < 16; ++i) ss += qv[i] * qv[i];
        ss += __shfl_xor(ss, 16); ss += __shfl_xor(ss, 32); const float rstd = 1.0f / sqrtf(ss * (1.0f / 64.0f) + EPS);
#pragma unroll
        for (int i = 0; i < 8; ++i) { qv[i] = qv[i] * rstd * a.qnw[l * 64 + 8 * quad + i]; qv[8 + i] = qv[8 + i] * rstd * a.qnw[l * 64 + 32 + 8 * quad + i]; }
#pragma unroll
        for (int d = 0; d < 8; ++d) { const float other = __shfl_xor(qv[d], 16); const float c = cs[(size_t)tokq * 8 + d], s = sn[(size_t)tokq * 8 + d];
            if (quad == 0) qv[d] = qv[d] * c - other * s; else if (quad == 1) qv[d] = qv[d] * c + other * s; }
        bf16x8 qf[2];
        { v4u w; w.x = pk2(qv[0], qv[1]); w.y = pk2(qv[2], qv[3]); w.z = pk2(qv[4], qv[5]); w.w = pk2(qv[6], qv[7]); qf[0] = __builtin_bit_cast(bf16x8, w);
          w.x = pk2(qv[8], qv[9]); w.y = pk2(qv[10], qv[11]); w.z = pk2(qv[12], qv[13]); w.w = pk2(qv[14], qv[15]); qf[1] = __builtin_bit_cast(bf16x8, w); }
        f32x4 sacc[9];
#pragma unroll
        for (int i = 0; i < 9; ++i) { const LAS bf16* kr = Kl + (16 * (rg + i) + c16) * 72 + 8 * quad;
            const bf16x8 k0 = *(const LAS bf16x8*)kr, k1 = *(const LAS bf16x8*)(kr + 32);
            f32x4 z = {0.f, 0.f, 0.f, 0.f}; z = __builtin_amdgcn_mfma_f32_16x16x32_bf16(k0, qf[0], z, 0, 0, 0); sacc[i] = __builtin_amdgcn_mfma_f32_16x16x32_bf16(k1, qf[1], z, 0, 0, 0); }
        int dbase = 4 * quad - c16; asm volatile("" : "+v"(dbase)); int kbase = 16 * rg + 4 * quad; asm volatile("" : "+v"(kbase)); float mx = sink;
#pragma unroll
        for (int i = 0; i < 9; ++i)
#pragma unroll
            for (int j = 0; j < 4; ++j) { const int dlt = dbase + 16 * i + j; const int kj = kbase + 16 * i + j; const bool ok = (dlt > 0) && (dlt <= 128) && ((nb > 0) || (kj >= 128));
                const float s = ok ? sacc[i][j] * 0.125f : -3.0e38f; sacc[i][j] = s; mx = fmaxf(mx, s); }
        mx = fmaxf(mx, __shfl_xor(mx, 16)); mx = fmaxf(mx, __shfl_xor(mx, 32));
        float sum = 0.f;
#pragma unroll
        for (int i = 0; i < 9; ++i)
#pragma unroll
            for (int j = 0; j < 4; ++j) { const float p = (sacc[i][j] > -1.0e38f) ? __expf(sacc[i][j] - mx) : 0.f; sacc[i][j] = p; sum += p; }
        sum += __shfl_xor(sum, 16); sum += __shfl_xor(sum, 32);
        const float inv = 1.0f / (sum + __expf(sink - mx));
        f32x4 oacc[4];
#pragma unroll
        for (int et = 0; et < 4; ++et) oacc[et] = (f32x4){0.f, 0.f, 0.f, 0.f};
#pragma unroll
        for (int kk = 0; kk < 5; ++kk) {
            v4u pw; pw.x = pk2(sacc[2 * kk][0], sacc[2 * kk][1]); pw.y = pk2(sacc[2 * kk][2], sacc[2 * kk][3]);
            if (2 * kk + 1 < 9) { pw.z = pk2(sacc[(2 * kk + 1 < 9) ? 2 * kk + 1 : 0][0], sacc[(2 * kk + 1 < 9) ? 2 * kk + 1 : 0][1]); pw.w = pk2(sacc[(2 * kk + 1 < 9) ? 2 * kk + 1 : 0][2], sacc[(2 * kk + 1 < 9) ? 2 * kk + 1 : 0][3]); } else { pw.z = 0u; pw.w = 0u; }
            const bf16x8 pf = __builtin_bit_cast(bf16x8, pw);
#pragma unroll
            for (int et = 0; et < 4; ++et) { const LAS bf16* vr = VT + (16 * et + c16) * 280 + 16 * rg + 32 * kk + 4 * quad;
                const v2u lo = *(const LAS v2u*)vr, hi = *(const LAS v2u*)(vr + 16); v4u vw; vw.x = lo.x; vw.y = lo.y; vw.z = hi.x; vw.w = hi.y;
                oacc[et] = __builtin_amdgcn_mfma_f32_16x16x32_bf16(__builtin_bit_cast(bf16x8, vw), pf, oacc[et], 0, 0, 0); }
        }
#pragma unroll
        for (int et = 0; et < 4; ++et) { v2u w; w.x = pk2(oacc[et][0] * inv, oacc[et][1] * inv); w.y = pk2(oacc[et][2] * inv, oacc[et][3] * inv);
            *(v2u*)(ao + (size_t)tokq * 512 + head * 64 + 16 * et + 4 * quad) = w; }
    }
    __syncthreads();
}

constexpr int ML_Q = 0, ML_K = 17408, ML_KET = 34816, ML_VT = 53248, ML_CT = 73984, ML_CW = 113152, ML_CB = 118272, ML_RED = 118784, ML_NW = 119296;
template <bool L3> DI void mlstm_unit(const Args& a, const Ctx& X, int l, int unit) {
    unsigned char* ws = a.ws; const bf16* proj = (const bf16*)(ws + WS_PROJ); bf16* hm = (bf16*)(ws + WS_H) + (size_t)T * 512;
    const float* gates = (const float*)(ws + WS_GATES); float* mlc = (float*)(ws + WS_MLC) + (size_t)unit * 18432; float* mlb = (float*)(ws + WS_MLB);
    const int seq = unit >> 5, sj = unit & 31, b = seq >> 2, hh = seq & 3; const int tokbase = b * SEQ + sj * 512;
    LAS bf16* Qs = (LAS bf16*)(X.lds + ML_Q); LAS bf16* Ks = (LAS bf16*)(X.lds + ML_K); LAS bf16* KET = (LAS bf16*)(X.lds + ML_KET);
    LAS bf16* VT = (LAS bf16*)(X.lds + ML_VT); LAS bf16* CT = (LAS bf16*)(X.lds + ML_CT); LAS float* CW = (LAS float*)(X.lds + ML_CW);
    LAS float* CB = (LAS float*)(X.lds + ML_CB); LAS float* RED = (LAS float*)(X.lds + ML_RED); LAS float* NW = (LAS float*)(X.lds + ML_NW);
    int lane = X.lane; asm volatile("" : "+v"(lane));
    const int c16 = lane & 15, quad = lane >> 4, w = X.wave;
    for (int idx = X.tid; idx < 1280; idx += 512) { const int tap = idx >> 8, ch = idx & 255; const int gch = (ch < 128) ? (hh * 128 + ch) : (512 + hh * 128 + (ch - 128));
        CW[idx] = (tap < 4) ? a.conv_w[(size_t)(l * 4 + tap) * 1024 + gch] : a.conv_b[l * 1024 + gch]; }
    for (int idx = X.tid; idx < 16 * 72; idx += 512) VT[128 * 72 + idx] = (idx < 72) ? (bf16)0x3F80 : (bf16)0;
    if (X.tid < 128) NW[X.tid] = a.mnw[l * 512 + hh * 128 + X.tid];
    f32x4 cacc[9];
#pragma unroll
    for (int et = 0; et < 9; ++et) {
        if (L3) {
#pragma unroll
            for (int j = 0; j < 4; ++j) { const float v = mlc[(16 * et + 4 * quad + j) * 128 + 16 * w + c16]; cacc[et][j] = v; CT[(16 * et + 4 * quad + j) * 136 + 16 * w + c16] = (bf16)f2bf(v); }
        } else cacc[et] = (f32x4){0.f, 0.f, 0.f, 0.f};
    }
    float bsum = 0.f;
    __syncthreads();
#pragma unroll 1
    for (int c = 0; c < 8; ++c) {
        const int tok0 = tokbase + c * 64;
        float bsc = gates[(size_t)(tok0 + lane) * 8 + 4 + hh]; const float li = gates[(size_t)(tok0 + lane) * 8 + hh];
#pragma unroll
        for (int o = 1; o < 64; o <<= 1) { const float v = __shfl_up(bsc, o); if (lane >= o) bsc += v; }
        const float bl = __shfl(bsc, 63); const float csv = li - bsc;
        if (w == 0) { CB[lane] = bsc; CB[64 + lane] = csv; }
        bsum += bl;
        { const int t = X.tid >> 3, dc = X.tid & 7; const float fac = __expf(bl + __shfl(csv, t));
          const int tokt = tok0 + t;
#pragma unroll
          for (int qk = (L3 ? 0 : 1); qk < 2; ++qk) {
              float accv[16];
#pragma unroll
              for (int i = 0; i < 16; ++i) accv[i] = CW[4 * 256 + qk * 128 + 16 * dc + i];
#pragma unroll
              for (int j = 0; j < 4; ++j) { const int tt = tokt - 3 + j;
                  if (tt >= b * SEQ) { const v4u* p = (const v4u*)(proj + (size_t)tt * NPROJ + (qk ? C_MK : C_MQ) + hh * 128 + 16 * dc); const v4u w0 = p[0], w1 = p[1];
                      const float xv[16] = {bflo(w0.x), bfhi(w0.x), bflo(w0.y), bfhi(w0.y), bflo(w0.z), bfhi(w0.z), bflo(w0.w), bfhi(w0.w), bflo(w1.x), bfhi(w1.x), bflo(w1.y), bfhi(w1.y), bflo(w1.z), bfhi(w1.z), bflo(w1.w), bfhi(w1.w)};
#pragma unroll
                      for (int i = 0; i < 16; ++i) accv[i] += CW[j * 256 + qk * 128 + 16 * dc + i] * xv[i]; } }
#pragma unroll
              for (int i = 0; i < 16; ++i) { const float z = accv[i]; accv[i] = z / (1.0f + __expf(-z)) * (qk ? 0.08838834764831845f : 1.0f); }
              if (L3) { LAS bf16* dst = (qk ? Ks : Qs) + t * 136 + 16 * dc;
                  v4u o0, o1; o0.x = pk2(accv[0], accv[1]); o0.y = pk2(accv[2], accv[3]); o0.z = pk2(accv[4], accv[5]); o0.w = pk2(accv[6], accv[7]);
                  o1.x = pk2(accv[8], accv[9]); o1.y = pk2(accv[10], accv[11]); o1.z = pk2(accv[12], accv[13]); o1.w = pk2(accv[14], accv[15]);
                  *(LAS v4u*)dst = o0; *(LAS v4u*)(dst + 8) = o1; }
              if (qk) {
#pragma unroll
                  for (int i = 0; i < 16; ++i) KET[(16 * dc + i) * 72 + t] = (bf16)f2bf(accv[i] * fac); }
          }
          { const v4u* p = (const v4u*)(proj + (size_t)tokt * NPROJ + C_MV + hh * 128 + 16 * dc); const v4u w0 = p[0], w1 = p[1];
            const unsigned ww[8] = {w0.x, w0.y, w0.z, w0.w, w1.x, w1.y, w1.z, w1.w};
#pragma unroll
            for (int i = 0; i < 8; ++i) { VT[(16 * dc + 2 * i) * 72 + t] = (bf16)(ww[i] & 0xffffu); VT[(16 * dc + 2 * i + 1) * 72 + t] = (bf16)(ww[i] >> 16); } }
        }
        __syncthreads();
        float hval[4][4]; int tt_ = w & 3, eh = w >> 2; const int tq = 16 * tt_ + c16;
        if (L3) {
            bf16x8 qf[4];
#pragma unroll
            for (int ks = 0; ks < 4; ++ks) qf[ks] = *(const LAS bf16x8*)(Qs + tq * 136 + 32 * ks + 8 * quad);
            f32x4 sacc[4];
#pragma unroll
            for (int st = 0; st < 4; ++st) { f32x4 z = {0.f, 0.f, 0.f, 0.f};
#pragma unroll
                for (int ks = 0; ks < 4; ++ks) z = __builtin_amdgcn_mfma_f32_16x16x32_bf16(*(const LAS bf16x8*)(Ks + (16 * st + c16) * 136 + 32 * ks + 8 * quad), qf[ks], z, 0, 0, 0);
                sacc[st] = z; }
            const float cbt = CB[tq];
#pragma unroll
            for (int st = 0; st < 4; ++st)
#pragma unroll
                for (int j = 0; j < 4; ++j) { const int s = 16 * st + 4 * quad + j; const float d = (s <= tq) ? __expf(cbt + CB[64 + s]) : 0.f; sacc[st][j] *= d; }
            bf16x8 pf[2];
#pragma unroll
            for (int kk = 0; kk < 2; ++kk) { v4u pw; pw.x = pk2(sacc[2 * kk][0], sacc[2 * kk][1]); pw.y = pk2(sacc[2 * kk][2], sacc[2 * kk][3]); pw.z = pk2(sacc[2 * kk + 1][0], sacc[2 * kk + 1][1]); pw.w = pk2(sacc[2 * kk + 1][2], sacc[2 * kk + 1][3]); pf[kk] = __builtin_bit_cast(bf16x8, pw); }
            const float ebt = __expf(cbt);
            f32x4 nn[5];
#pragma unroll
            for (int x = 0; x < 5; ++x) { const int et = (x < 4) ? (4 * eh + x) : 8; f32x4 na = {0.f, 0.f, 0.f, 0.f}, ia = {0.f, 0.f, 0.f, 0.f};
#pragma unroll
                for (int kk = 0; kk < 2; ++kk) { const LAS bf16* vr = VT + (16 * et + c16) * 72 + 32 * kk + 4 * quad; const v2u lo = *(const LAS v2u*)vr, hi = *(const LAS v2u*)(vr + 16); v4u vw; vw.x = lo.x; vw.y = lo.y; vw.z = hi.x; vw.w = hi.y;
                    na = __builtin_amdgcn_mfma_f32_16x16x32_bf16(__builtin_bit_cast(bf16x8, vw), pf[kk], na, 0, 0, 0); }
#pragma unroll
                for (int ks = 0; ks < 4; ++ks) ia = __builtin_amdgcn_mfma_f32_16x16x32_bf16(*(const LAS bf16x8*)(CT + (16 * et + c16) * 136 + 32 * ks + 8 * quad), qf[ks], ia, 0, 0, 0);
                nn[x] = na + ia * ebt; }
            const float den = __shfl(nn[4][0], c16); const float inv = 1.0f / fmaxf(fabsf(den), 1.0f);
            float ss = 0.f;
#pragma unroll
            for (int x = 0; x < 4; ++x)
#pragma unroll
                for (int j = 0; j < 4; ++j) { hval[x][j] = nn[x][j] * inv; ss += hval[x][j] * hval[x][j]; }
            ss += __shfl_xor(ss, 16); ss += __shfl_xor(ss, 32);
            if (quad == 0) RED[eh * 64 + tq] = ss;
            __syncthreads();
            const float rstd = 1.0f / sqrtf((RED[tq] + RED[64 + tq]) * (1.0f / 128.0f) + EPS);
#pragma unroll
            for (int x = 0; x < 4; ++x) { const int e = 16 * (4 * eh + x) + 4 * quad; const v2u og = *(const v2u*)(proj + (size_t)(tok0 + tq) * NPROJ + C_MO + hh * 128 + e);
                const float y0 = hval[x][0] * rstd * NW[e] * bflo(og.x), y1 = hval[x][1] * rstd * NW[e + 1] * bfhi(og.x), y2 = hval[x][2] * rstd * NW[e + 2] * bflo(og.y), y3 = hval[x][3] * rstd * NW[e + 3] * bfhi(og.y);
                v2u o; o.x = pk2(y0, y1); o.y = pk2(y2, y3); *(v2u*)(hm + (size_t)(tok0 + tq) * 512 + hh * 128 + e) = o; }
        }
        { const float ebl = __expf(bl);
          bf16x8 kf[2];
#pragma unroll
          for (int kk = 0; kk < 2; ++kk) kf[kk] = *(const LAS bf16x8*)(KET + (16 * w + c16) * 72 + 32 * kk + 8 * quad);
#pragma unroll
          for (int et = 0; et < 9; ++et) { f32x4 z = cacc[et] * ebl;
#pragma unroll
              for (int kk = 0; kk < 2; ++kk) z = __builtin_amdgcn_mfma_f32_16x16x32_bf16(*(const LAS bf16x8*)(VT + (16 * et + c16) * 72 + 32 * kk + 8 * quad), kf[kk], z, 0, 0, 0);
              cacc[et] = z;
              if (L3) {
#pragma unroll
                  for (int j = 0; j < 4; ++j) CT[(16 * et + 4 * quad + j) * 136 + 16 * w + c16] = (bf16)f2bf(z[j]); } } }
        __syncthreads();
    }
    if (!L3) {
#pragma unroll
        for (int et = 0; et < 9; ++et)
#pragma unroll
            for (int j = 0; j < 4; ++j) mlc[(16 * et + 4 * quad + j) * 128 + 16 * w + c16] = cacc[et][j];
        if (X.tid == 0) mlb[unit] = bsum;
    }
}
DI void mlstm_scan(const Args& a, const Ctx& X) {
    float* mlc = (float*)(a.ws + WS_MLC); const float* mlb = (const float*)(a.ws + WS_MLB);
    for (int idx = X.bid * 512 + X.tid; idx < 8 * 18432; idx += X.G * 512) { const int seq = idx / 18432, el = idx - seq * 18432; float carry = 0.f;
        float* p0 = mlc + (size_t)seq * 32 * 18432 + el; float v[32], dcy[32];
#pragma unroll
        for (int j = 0; j < 32; ++j) { v[j] = p0[(size_t)j * 18432]; dcy[j] = mlb[seq * 32 + j]; }
#pragma unroll
        for (int j = 0; j < 32; ++j) { p0[(size_t)j * 18432] = carry; carry = __expf(dcy[j]) * carry + v[j]; } }
}

constexpr int P6_WR = 0, P6_AT = 33024, P6_SH = 37120, P6_LG = 41216, P6_HIST = 65536;
DI void p6_norm_route(const Args& a, const Ctx& X, int l, const float* xin) {
    unsigned char* ws = a.ws;
    LAS bf16* wrb = (LAS bf16*)(X.lds + P6_WR);
    LAS float* at = (LAS float*)(X.lds + P6_AT); LAS float* sht = (LAS float*)(X.lds + P6_SH);
    LAS float* lg = (LAS float*)(X.lds + P6_LG) + X.wave * 272;
    for (int idx = X.tid; idx < 16384; idx += 512) { const int k = idx >> 4, e = idx & 15; wrb[e * 1032 + k] = (bf16)f2bf(a.router_w[idx]); }
    const float* mod = (const float*)(ws + WS_MOD); unsigned char* hb = (unsigned char*)(ws + WS_H); float* tgate = (float*)(ws + WS_TGATE); int* tokl = (int*)(ws + WS_TOKL);
    const float* ssq = (const float*)(ws + WS_SSQ);
    unsigned* cnt = (unsigned*)(ws + WS_CTL) + CW_CNT + l * 2048;
    LAS int* hist = (LAS int*)(X.lds + P6_HIST); LAS int* cbase = hist + 32;
    int lane = X.lane; asm volatile("" : "+v"(lane));
    const int r = lane & 15, q = lane >> 4;
    const int gw = X.bid * 8 + X.wave, NGW = X.G * 8;
    for (int it = 0; it * NGW < T / 16; ++it) {
        const int rg = it * NGW + gw; const bool act = rg < T / 16;
        const int row0 = (act ? rg : 0) * 16; const int bb = ((it * NGW + X.bid * 8) * 16) >> 14;
        __syncthreads();
        if (X.tid < 32) hist[X.tid] = 0;
        { const float* mb = mod + (size_t)(l * 2 + (bb < 2 ? bb : 1)) * 6144;
          for (int k = X.tid; k < 1024; k += 512) { at[k] = a.nfw[l * D + k] * (1.0f + mb[4 * 1024 + k]); sht[k] = mb[3 * 1024 + k]; } }
        __syncthreads();
        const int row = row0 + r;
        float rstd;
        { const f32x4 pp = *(const f32x4*)(ssq + (size_t)row * 16 + 4 * q); float ss = (pp.x + pp.y) + (pp.z + pp.w); ss += __shfl_xor(ss, 16); ss += __shfl_xor(ss, 32); rstd = __builtin_amdgcn_rsqf(ss * (1.0f / D) + EPS); }
        const float* xr = xin + (size_t)row * D + 8 * q; unsigned char* hr = hb + (size_t)row * D + 8 * q;
        f32x4 acc = {0.f, 0.f, 0.f, 0.f};
#pragma unroll 8
        for (int s = 0; s < 32; ++s) {
            const f32x4 x0 = *(const f32x4*)(xr + 32 * s), x1 = *(const f32x4*)(xr + 32 * s + 4);
            const f32x4 a0 = *(const LAS f32x4*)(at + 32 * s + 8 * q), a1 = *(const LAS f32x4*)(at + 32 * s + 8 * q + 4);
            const f32x4 s0 = *(const LAS f32x4*)(sht + 32 * s + 8 * q), s1 = *(const LAS f32x4*)(sht + 32 * s + 8 * q + 4);
            const f32x4 h0 = x0 * rstd * a0 + s0, h1 = x1 * rstd * a1 + s1;
            v4u w; w.x = cvt_pk_bf16(h0.x, h0.y); w.y = cvt_pk_bf16(h0.z, h0.w); w.z = cvt_pk_bf16(h1.x, h1.y); w.w = cvt_pk_bf16(h1.z, h1.w);
            { v2u w8; w8.x = pk4_fp8(h0.x, h0.y, h0.z, h0.w); w8.y = pk4_fp8(h1.x, h1.y, h1.z, h1.w); *(v2u*)(hr + 32 * s) = w8; }
            const bf16x8 bfr = *(const LAS bf16x8*)(wrb + r * 1032 + 32 * s + 8 * q);
            acc = __builtin_amdgcn_mfma_f32_16x16x32_bf16(__builtin_bit_cast(bf16x8, w), bfr, acc, 0, 0, 0);
        }
#pragma unroll
        for (int j = 0; j < 4; ++j) lg[(4 * q + j) * 17 + r] = acc[j];
        LDS_WAIT(); asm volatile("" ::: "memory");
        int my_cls = 0; float my_ga = 0.f, my_gb = 0.f;
        if (lane < 16) {
            float sc[16], sel[16];
#pragma unroll
            for (int e = 0; e < 16; ++e) { const float p = lg[lane * 17 + e]; sc[e] = 1.0f / (1.0f + __expf(-p)); sel[e] = sc[e] + a.router_b[e]; }
            int gi = 0; float gbest = -1.0e30f;
#pragma unroll
            for (int g = 0; g < 4; ++g) { const float p0 = sel[4 * g], p1 = sel[4 * g + 1], p2 = sel[4 * g + 2], p3 = sel[4 * g + 3];
                const float gs = fmaxf(fmaxf(fmaxf(p0 + p1, p0 + p2), fmaxf(p0 + p3, p1 + p2)), fmaxf(p1 + p3, p2 + p3));
                if (gs > gbest) { gbest = gs; gi = g; } }
            float qs[4], s4[4];
#pragma unroll
            for (int i = 0; i < 4; ++i) { qs[i] = 0.f; s4[i] = 0.f; }
#pragma unroll
            for (int g = 0; g < 4; ++g) if (g == gi) {
#pragma unroll
                for (int i = 0; i < 4; ++i) { qs[i] = sel[4 * g + i]; s4[i] = sc[4 * g + i]; } }
            int i1 = 0; float b1 = qs[0];
#pragma unroll
            for (int i = 1; i < 4; ++i) if (qs[i] > b1) { b1 = qs[i]; i1 = i; }
            int i2 = -1; float b2 = -1.0e30f;
#pragma unroll
            for (int i = 0; i < 4; ++i) if (i != i1 && qs[i] > b2) { b2 = qs[i]; i2 = i; }
            const int ia = (i1 < i2) ? i1 : i2, ib = (i1 < i2) ? i2 : i1;
            float sa = 0.f, sb = 0.f;
#pragma unroll
            for (int i = 0; i < 4; ++i) { if (i == ia) sa = s4[i]; if (i == ib) sb = s4[i]; }
            const int pidx = (ia == 0) ? (ib - 1) : ((ia == 1) ? (ib + 1) : 5);
            const float inv = 1.0f / (sa + sb);
            my_cls = gi * 6 + pidx; my_ga = sa * inv; my_gb = sb * inv;
        }
        int rank = 0;
        if (act && lane < 16) rank = __hip_atomic_fetch_add(hist + my_cls, 1, __ATOMIC_RELAXED, __HIP_MEMORY_SCOPE_WORKGROUP);
        __syncthreads();
        if (X.tid < NCLS) { const int n = hist[X.tid]; cbase[X.tid] = n ? (int)__hip_atomic_fetch_add(cnt + 64 * X.tid, (unsigned)n, RLX_AGENT) : 0; }
        __syncthreads();
        if (act && lane < 16) { const int tok = row0 + lane; const int pos = cbase[my_cls] + rank;
            tokl[my_cls * CLS_CAP + pos] = tok; tgate[tok * 2] = my_ga; tgate[tok * 2 + 1] = my_gb; }
    }
}
DI MoeTab moe_tables(const Args& a, const Ctx& X, int l) {
    LAS int* tab = (LAS int*)(X.lds + TAB_OFF); LAS int* tcls = tab; LAS int* tpos = tab + 160; LAS int* cn = tab + 320; LAS int* rt_ = tab + 344;
    unsigned* cnt = (unsigned*)(a.ws + WS_CTL) + CW_CNT + l * 2048;
    if (X.tid < NCLS) cn[X.tid] = (int)__hip_atomic_load(cnt + 64 * X.tid, RLX_AGENT);
    __syncthreads();
    if (X.tid == 0) { int r = 0;
#pragma unroll 1
        for (int c = 0; c < NCLS; ++c) { const int n = (cn[c] + 255) >> 8;
#pragma unroll 1
            for (int i = 0; i < n; ++i) { tcls[r] = c; tpos[r] = i * 256; ++r; } }
        rt_[0] = r; }
    __syncthreads();
    MoeTab tb; tb.tcls = tcls; tb.tpos = tpos; tb.cnt = cn; tb.Rtot = __builtin_amdgcn_readfirstlane(rt_[0]); return tb;
}

#if defined(__HIP_DEVICE_COMPILE__)
DI Args load_args() { auto p = __builtin_amdgcn_kernarg_segment_ptr(); asm volatile("" : "+s"(p)); return *(const __attribute__((address_space(4))) Args*)p; }
#else
DI Args load_args() { return Args{}; }
#endif
__global__ void __launch_bounds__(512, 2) fwd(Args a_unused) {
    extern __shared__ __attribute__((aligned(16))) unsigned char lds_raw[];
    Ctx X; X.lds = (LAS unsigned char*)lds_raw; X.tid = threadIdx.x; X.lane = X.tid & 63; X.wave = __builtin_amdgcn_readfirstlane(X.tid >> 6); X.G = gridDim.x; X.bid = blockIdx.x;
    volatile LAS unsigned* MISC = (volatile LAS unsigned*)(X.lds + MISC_OFF);
    if (X.tid < 64) MISC[X.tid] = 0u;
    __syncthreads();
    int lo, hi; unsigned* ctl;
    { const Args a = load_args(); lo = a.ph_lo; hi = a.ph_hi; ctl = (unsigned*)(a.ws + WS_CTL); }
    XcdBarrier bar; bar.bar = ctl + CW_BAR; bar.x = 0; bar.st = MISC + 8;
    if (hi - lo > 1) bar = xcd_barrier_post(ctl + CW_BAR, MISC + 8);
#ifndef PH_MASK
#define PH_MASK 0xFFFFF
#endif
#define PON(p) ((PH_MASK >> (p)) & 1)
#ifndef DUP_MASK
#define DUP_MASK 0
#endif
#define NREP(p) (((DUP_MASK >> (p)) & 1) ? 2 : 1)
#ifndef TSEL_MASK
#define TSEL_MASK 0
#endif
#define TSCALE 4
#define TSEL(p) ((TSEL_MASK >> (p)) & 1)
#define IN(k) (lo <= (k) && (k) < hi)
#define SEAM(k) do { if (IN(k) && IN((k) + 1)) xcd_barrier(bar); } while (0)
    unsigned long long tacc = 0ull, tph = 0ull;
#define TBEG() do { if (TSEL_MASK) tph = __builtin_amdgcn_s_memrealtime(); } while (0)
#define TEND(p) do { if (TSEL(p)) tacc += __builtin_amdgcn_s_memrealtime() - tph; } while (0)
    TBEG();
    if (PON(10) && IN(0)) { for (int rep = 0; rep < NREP(10); ++rep) { const Args a = load_args(); p0_prologue(a, X); } }
    SEAM(0); TEND(10);
    TBEG();
    for (int l = 0; l < NL; ++l) {
        const int g0 = 1 + l * NPH;
        if (PON(0) && IN(g0 + 0)) { for (int rep = 0; rep < NREP(0); ++rep) { const Args a = load_args(); unsigned char* ws = a.ws; const float* mod = (const float*)(ws + WS_MOD); bf16* proj = (bf16*)(ws + WS_PROJ); const float* xin = (l == 0) ? a.x : a.out; (void)mod; (void)proj; (void)xin; const Ctx P = fresh(X); p1_norm_gates(a, P, l, xin); } }
        SEAM(g0 + 0); TEND(0); TBEG();
        if (PON(1) && IN(g0 + 1)) for (int rep = 0; rep < NREP(1); ++rep) { const Args a = load_args(); unsigned char* ws = a.ws; const float* mod = (const float*)(ws + WS_MOD); bf16* proj = (bf16*)(ws + WS_PROJ); const float* xin = (l == 0) ? a.x : a.out; (void)mod; (void)proj; (void)xin; const Ctx P = fresh(X);
            DenseSched S; S.A = (const char*)(ws + WS_H); S.Bt = (const char*)(ws + WS_WIN) + (size_t)l * NPROJW * D; S.lda = D; S.ldb = D; S.ord.init(T / 256, NPROJW / 256, P.G, P.bid);
            EpiProj E; E.O = proj; E.gates = (float*)(ws + WS_GATES); E.big = a.b_ig + l * 4; E.bfg = a.b_fg + l * 4;
            pg8::gemm_phase<EpiProj, DenseSched, true>(P.lds, D, S, E);
        }
        SEAM(g0 + 1); TEND(1); TBEG();
        if (PON(2) && IN(g0 + 2)) { const Args a = load_args(); unsigned char* ws = a.ws; const float* mod = (const float*)(ws + WS_MOD); bf16* proj = (bf16*)(ws + WS_PROJ); const float* xin = (l == 0) ? a.x : a.out; (void)mod; (void)proj; (void)xin; const Ctx P = fresh(X);
            if (PON(11)) for (int rep = 0; rep < NREP(11); ++rep) {
#pragma unroll 1
                for (int u = P.bid; u < 512; u += P.G) attn_unit(a, P, l, u); }
            if (PON(12)) for (int rep = 0; rep < NREP(12); ++rep) {
#pragma unroll 1
                for (int u = P.bid; u < 256; u += P.G) mlstm_unit<false>(a, P, l, u); }
        }
        SEAM(g0 + 2); TEND(2); TBEG();
        if (PON(3) && IN(g0 + 3)) { const Args a = load_args(); unsigned char* ws = a.ws; const float* mod = (const float*)(ws + WS_MOD); bf16* proj = (bf16*)(ws + WS_PROJ); const float* xin = (l == 0) ? a.x : a.out; (void)mod; (void)proj; (void)xin; const Ctx P = fresh(X); mlstm_scan(a, P); }
        SEAM(g0 + 3); TEND(3); TBEG();
        if (PON(4) && IN(g0 + 4)) for (int rep = 0; rep < NREP(4); ++rep) { const Args a = load_args(); unsigned char* ws = a.ws; const float* mod = (const float*)(ws + WS_MOD); bf16* proj = (bf16*)(ws + WS_PROJ); const float* xin = (l == 0) ? a.x : a.out; (void)mod; (void)proj; (void)xin; const Ctx P = fresh(X);
#pragma unroll 1
            for (int u = P.bid; u < 256; u += P.G) mlstm_unit<true>(a, P, l, u); }
        SEAM(g0 + 4); TEND(4); TBEG();
        if (PON(5) && IN(g0 + 5)) for (int rep = 0; rep < NREP(5); ++rep) { const Args a = load_args(); unsigned char* ws = a.ws; const float* mod = (const float*)(ws + WS_MOD); bf16* proj = (bf16*)(ws + WS_PROJ); const float* xin = (l == 0) ? a.x : a.out; (void)mod; (void)proj; (void)xin; const Ctx P = fresh(X);
            { DenseSched S; S.A = (const char*)(ws + WS_H); S.Bt = (const char*)(ws + WS_WAU) + (size_t)l * D * 512 * 2; S.lda = 1024; S.ldb = 1024; S.ord.init(T / 256, D / 256, P.G, P.bid);
              EpiGate<false> E; E.P = proj; E.gcol = C_GA; pg8::gemm_phase<EpiGate<false>, DenseSched>(P.lds, 1024, S, E); }
            { DenseSched S; S.A = (const char*)(ws + WS_H) + (size_t)T * 512 * 2; S.Bt = (const char*)(ws + WS_WMU) + (size_t)l * D * 512 * 2; S.lda = 1024; S.ldb = 1024; S.ord.init(T / 256, D / 256, P.G, P.bid);
              EpiGate<true> E; E.P = proj; E.gcol = C_GB; pg8::gemm_phase<EpiGate<true>, DenseSched>(P.lds, 1024, S, E); }
        }
        SEAM(g0 + 5); TEND(5); TBEG();
        if (PON(6) && IN(g0 + 6)) for (int rep = 0; rep < NREP(6); ++rep) { const Args a = load_args(); unsigned char* ws = a.ws; const float* mod = (const float*)(ws + WS_MOD); bf16* proj = (bf16*)(ws + WS_PROJ); const float* xin = (l == 0) ? a.x : a.out; (void)mod; (void)proj; (void)xin; const Ctx P = fresh(X);
            DenseSched S; S.A = (const char*)(proj + C_MQ); S.Bt = (const char*)(ws + WS_WOUT) + (size_t)l * D * D * 2; S.lda = NPROJ * 2; S.ldb = D * 2; S.ord.init(T / 256, D / 256, P.G, P.bid);
            EpiRes E; E.xin = xin; E.out = a.out; E.g = mod + (size_t)(l * 2) * 6144 + 2 * 1024; E.ssq = (float*)(ws + WS_SSQ); E.rmask = T - 1;
            if (rep) { E.out = (float*)(ws + WS_H); E.rmask = T / 2 - 1; }
            pg8::gemm_phase<EpiRes, DenseSched>(P.lds, D * 2, S, E);
        }
        SEAM(g0 + 6); TEND(6); TBEG();
        if (PON(7) && IN(g0 + 7)) { const Args a = load_args(); unsigned char* ws = a.ws; const float* mod = (const float*)(ws + WS_MOD); bf16* proj = (bf16*)(ws + WS_PROJ); const float* xin = (l == 0) ? a.x : a.out; (void)mod; (void)proj; (void)xin; const Ctx P = fresh(X); p6_norm_route(a, P, l, a.out); }
        SEAM(g0 + 7); TEND(7); TBEG();
        if (PON(8) && IN(g0 + 8)) for (int rep = 0; rep < NREP(8); ++rep) { const Args a = load_args(); unsigned char* ws = a.ws; const float* mod = (const float*)(ws + WS_MOD); bf16* proj = (bf16*)(ws + WS_PROJ); const float* xin = (l == 0) ? a.x : a.out; (void)mod; (void)proj; (void)xin; const Ctx P = fresh(X);
            const MoeTab tb = moe_tables(a, P, l);
            LAS unsigned* tokoff = (LAS unsigned*)(P.lds + TOKOFF_OFF); const int* tokl = (const int*)(ws + WS_TOKL);
#pragma unroll 1
            for (int s = 0; s < 8; ++s) { const int L0 = s * P.G + P.bid;
                if (L0 < tb.Rtot * 8 && P.tid < 256) { const int L = xcd_remap(L0, tb.Rtot * 8); const int rt = L >> 3, cls = tb.tcls[rt], pos = tb.tpos[rt] + P.tid, cn = tb.cnt[cls]; const int tok = tokl[cls * CLS_CAP + (pos < cn ? pos : 0)]; tokoff[s * 256 + P.tid] = (unsigned)tok; } }
            __syncthreads();
            MoeUpSched S; S.A = (const char*)(ws + WS_H); S.W = (const char*)(ws + WS_WGU) + (size_t)l * NE * 1024 * D; S.lda = D; S.ldb = D; S.tb = tb; S.G = P.G; S.c = P.bid; S.tokoff = tokoff;
            EpiSwiglu E; E.H = proj; E.tgate = (const float*)(ws + WS_TGATE); E.tokoff = tokoff;
            pg8::gemm_phase<EpiSwiglu, MoeUpSched, true>(P.lds, D, S, E);
        }
        SEAM(g0 + 8); TEND(8); TBEG();
        if (PON(9) && IN(g0 + 9)) for (int rep = 0; rep < NREP(9); ++rep) { const Args a = load_args(); unsigned char* ws = a.ws; const float* mod = (const float*)(ws + WS_MOD); bf16* proj = (bf16*)(ws + WS_PROJ); const float* xin = (l == 0) ? a.x : a.out; (void)mod; (void)proj; (void)xin; const Ctx P = fresh(X);
            const MoeTab tb = moe_tables(a, P, l);
            MoeDownSched S; S.A = (const char*)proj; S.W = (const char*)(ws + WS_WD) + (size_t)l * NE * 1024 * FF * 2; S.lda = D * 2; S.ldb = FF * 2; S.tb = tb; S.G = P.G; S.c = P.bid;
            EpiMoeOut E; E.xin = a.out; E.out = a.out; E.g = mod + (size_t)(l * 2) * 6144 + 5 * 1024; E.tokl = (const int*)(ws + WS_TOKL); E.tb = tb; E.rmask = T - 1;
            if (rep) { E.out = (float*)(ws + WS_H); E.rmask = T / 2 - 1; }
            pg8::gemm_phase<EpiMoeOut, MoeDownSched>(P.lds, D * 2, S, E);
        }
        SEAM(g0 + 9); TEND(9); TBEG();
    }
    if (TSEL_MASK && X.bid == 0) { const unsigned long long t1 = __builtin_amdgcn_s_memrealtime(); while (__builtin_amdgcn_s_memrealtime() - t1 < TSCALE * tacc) __builtin_amdgcn_s_sleep(8); }
#undef IN
#undef SEAM
}

extern "C" void kernel_launch(void* const* d_in, const int* in_sizes, int n_in, void* d_out, int out_size, void* d_ws, size_t ws_size, hipStream_t stream) {
    static int grid = 0;
    if (grid == 0) {
        if (n_in != 24 || in_sizes[0] != T * D || out_size != T * D || ws_size < WS_END) { fprintf(stderr, "kernel_launch: unexpected shapes / workspace (n_in %d, ws %zu, need %zu)\n", n_in, ws_size, (size_t)WS_END); grid = -1; return; }
        int dev = 0, cus = 0;
        if (hipGetDevice(&dev) != hipSuccess || hipDeviceGetAttribute(&cus, hipDeviceAttributeMultiprocessorCount, dev) != hipSuccess) { grid = -1; return; }
        if (hipFuncSetAttribute((const void*)fwd, hipFuncAttributeMaxDynamicSharedMemorySize, LDS_BYTES) != hipSuccess) { fprintf(stderr, "kernel_launch: hipFuncSetAttribute failed\n"); grid = -1; return; }
        int per_cu = 0;
        if (hipOccupancyMaxActiveBlocksPerMultiprocessor(&per_cu, (const void*)fwd, 512, LDS_BYTES) != hipSuccess || per_cu < 1) fprintf(stderr, "kernel_launch: occupancy query reports %d\n", per_cu);
        (void)hipGetLastError();
        grid = cus < 256 ? cus : 256;
    }
    if (grid < 0) return;
    (void)hipMemsetAsync((char*)d_ws + WS_CTL, 0, CTL_ZERO_BYTES, stream);
    Args a{};
    a.x = (const float*)d_in[0]; a.c = (const float*)d_in[1]; a.pos = (const int*)d_in[2]; a.ada_w = (const float*)d_in[3]; a.ada_b = (const float*)d_in[4];
    a.nmw = (const float*)d_in[5]; a.nfw = (const float*)d_in[6]; a.w_in = (const float*)d_in[7]; a.b_ig = (const float*)d_in[8]; a.b_fg = (const float*)d_in[9];
    a.qnw = (const float*)d_in[10]; a.knw = (const float*)d_in[11]; a.sinks = (const float*)d_in[12]; a.conv_w = (const float*)d_in[13]; a.conv_b = (const float*)d_in[14];
    a.mnw = (const float*)d_in[15]; a.w_au = (const float*)d_in[16]; a.w_mu = (const float*)d_in[17]; a.w_out = (const float*)d_in[18]; a.router_w = (const float*)d_in[19];
    a.router_b = (const float*)d_in[20]; a.w_gate = (const float*)d_in[21]; a.w_up = (const float*)d_in[22]; a.w_down = (const float*)d_in[23];
    a.out = (float*)d_out; a.ws = (unsigned char*)d_ws;
#if MK_MULTI
    for (int gp = 0; gp < NGP; ++gp) { a.ph_lo = gp; a.ph_hi = gp + 1; hipLaunchKernelGGL(fwd, dim3(grid), dim3(512), LDS_BYTES, stream, a); }
#else
    a.ph_lo = 0; a.ph_hi = NGP; hipLaunchKernelGGL(fwd, dim3(grid), dim3(512), LDS_BYTES, stream, a);
#endif
}
```

```cpp
#include <hip/hip_runtime.h>
#include <cstdio>
#include <cstdint>

#ifndef MK_MULTI
#define MK_MULTI 0
#endif

#define GAS __attribute__((address_space(1)))
#define LAS __attribute__((address_space(3)))
typedef unsigned short bf16;
typedef unsigned v4u __attribute__((ext_vector_type(4)));
typedef unsigned v2u __attribute__((ext_vector_type(2)));
typedef float f32x4 __attribute__((ext_vector_type(4)));
typedef float f32x2 __attribute__((ext_vector_type(2)));
typedef short bf16x8 __attribute__((ext_vector_type(8)));
typedef short bf16x4 __attribute__((ext_vector_type(4)));
#define DI __device__ __forceinline__
#define RLX_AGENT __ATOMIC_RELAXED, __HIP_MEMORY_SCOPE_AGENT
#define LDS_WAIT() asm volatile("s_waitcnt lgkmcnt(0)" ::: "memory")
#define VM_WAIT() asm volatile("s_waitcnt vmcnt(0)" ::: "memory")

constexpr int NB = 2, SEQ = 16384, T = NB * SEQ, D = 1024, NL = 4;
constexpr int DIN_SRC = 4872;
constexpr int NPROJ = 4864;
constexpr int C_AQ = 0, C_AK = 512, C_AV = 640, C_MQ = 768, C_MK = 1280, C_MV = 1792, C_MO = 2304, C_GA = 2816, C_GB = 3840;
constexpr int NE = 16, FF = 512;
constexpr int NCLS = 24, CLS_CAP = 32768;
constexpr float EPS = 1e-6f;
constexpr int NPH = 10;
constexpr int NGP = 1 + NL * NPH;

constexpr size_t MiB = 1u << 20;
constexpr size_t WS_CTL = 0, CTL_ZERO_BYTES = 1 * MiB;
constexpr size_t WS_MOD = 1 * MiB;
constexpr size_t WS_ROPE = 2 * MiB;
constexpr size_t WS_GATES = 4 * MiB;
constexpr size_t WS_TGATE = 5 * MiB;
constexpr size_t WS_TOKL = 6 * MiB;
constexpr size_t WS_MLB = 9 * MiB;
constexpr size_t WS_MLC = 10 * MiB;
constexpr int NPROJW = 5120;
constexpr size_t WS_WIN = 28 * MiB;
constexpr size_t WS_WAU = 68 * MiB;
constexpr size_t WS_WMU = 72 * MiB;
constexpr size_t WS_WOUT = 76 * MiB;
constexpr size_t WS_WGU = 84 * MiB;
constexpr size_t WS_WD = 212 * MiB;
constexpr size_t WS_H = 276 * MiB;
constexpr size_t WS_PROJ = 340 * MiB;
constexpr size_t WS_SSQ = 644 * MiB;
constexpr size_t WS_END = 646 * MiB;

constexpr int CW_TMO = 0;
constexpr int CW_BAR = 4096;
constexpr int CW_CNT = 8192;

constexpr int RING_BYTES = 131072;
constexpr int MISC_OFF = RING_BYTES;
constexpr int TAB_OFF = RING_BYTES + 256;
constexpr int TOKOFF_OFF = RING_BYTES + 2048;
constexpr int LDS_BYTES = 147456;

DI unsigned f2bf(float f) { unsigned u = __builtin_bit_cast(unsigned, f); return (u + 0x7fffu + ((u >> 16) & 1u)) >> 16; }
DI unsigned pk2(float lo, float hi) { return f2bf(lo) | (f2bf(hi) << 16); }
DI float bf2f(unsigned short b) { return __builtin_bit_cast(float, ((unsigned)b) << 16); }
DI float bflo(unsigned w) { return __builtin_bit_cast(float, w << 16); }
DI float bfhi(unsigned w) { return __builtin_bit_cast(float, w & 0xffff0000u); }
DI float wave_sum(float v) {
#pragma unroll
    for (int o = 1; o < 64; o <<= 1) v += __shfl_xor(v, o);
    return v;
}
DI float sigmoidf_(float x) { return __builtin_amdgcn_rcpf(1.0f + __expf(-x)); }

#define XB_TMO      128
#define XB_XCNT(j)  (256  + 64 * (j))
#define XB_XSUB(j)  (1280 + 64 * (j))
#define XB_XGEN(j)  (2304 + 64 * (j))
#define XB_TOP      3328
#define XB_TOPGEN   3392
#define XCD_BAR_WORDS 3456
#define XB_SPIN_CAP (1u << 18)
__device__ __forceinline__ unsigned xb_ld(unsigned* p)              { return __hip_atomic_load(p, __ATOMIC_RELAXED, __HIP_MEMORY_SCOPE_AGENT); }
__device__ __forceinline__ unsigned xb_add(unsigned* p, unsigned v) { return __hip_atomic_fetch_add(p, v, __ATOMIC_RELAXED, __HIP_MEMORY_SCOPE_AGENT); }
__device__ __forceinline__ unsigned xb_xcc_id() { return (unsigned)__builtin_amdgcn_s_getreg((3 << 11) | 20) & 0xFu; }
#define XB_SPIN(cond, bar) do { unsigned _sp = 0; while (cond) { __builtin_amdgcn_s_sleep(1); \
    if ((++_sp & 255u) == 0u) { if (xb_ld(&(bar)[XB_TMO])) break; if (_sp > XB_SPIN_CAP) { atomicAdd(&(bar)[XB_TMO], 1u); break; } } } } while (0)
struct XcdBarrier { unsigned* bar; unsigned x; volatile LAS unsigned* st; };
__device__ __forceinline__ XcdBarrier xcd_barrier_post(unsigned* bar, volatile LAS unsigned* st) {
    XcdBarrier b; b.bar = bar; b.x = xb_xcc_id(); b.st = st;
    if (threadIdx.x == 0) (void)xb_add(&bar[XB_XCNT(b.x)], 1u);
    return b;
}
__device__ __forceinline__ void xcd_barrier_complete(unsigned* bar, unsigned x, unsigned& nloc, unsigned& nx) {
    const unsigned G = gridDim.x * gridDim.y * gridDim.z;
    unsigned sum, cnt, mine, sp = 0u;
    for (;;) {
        sum = 0u; cnt = 0u; mine = 0u;
#pragma unroll
        for (unsigned j = 0; j < 16; ++j) { const unsigned c = xb_ld(&bar[XB_XCNT(j)]); sum += c; cnt += (c > 0u) ? 1u : 0u; mine = (j == x) ? c : mine; }
        if (sum == G) break;
        __builtin_amdgcn_s_sleep(1);
        if ((++sp & 255u) == 0u) { if (xb_ld(&bar[XB_TMO])) break; if (sp > XB_SPIN_CAP) { atomicAdd(&bar[XB_TMO], 1u); break; } }
    }
    nloc = mine > 0u ? mine : 1u; nx = cnt > 0u ? cnt : 1u;
}
__device__ __forceinline__ void xcd_barrier(const XcdBarrier& b) {
    asm volatile("s_waitcnt vmcnt(0)" ::: "memory");
    __syncthreads();
    if (threadIdx.x == 0) {
        unsigned* bar = b.bar;
        __builtin_amdgcn_s_waitcnt(0);
        unsigned nloc = b.st[0], nx = b.st[1];
        if (nloc == 0u) { xcd_barrier_complete(bar, b.x, nloc, nx); b.st[0] = nloc; b.st[1] = nx; }
        const unsigned old = xb_add(&bar[XB_XSUB(b.x)], 1u);
        const unsigned gen = old / nloc;
        if (old + 1u == (gen + 1u) * nloc) {
            __builtin_amdgcn_fence(__ATOMIC_RELEASE, "agent");
            asm volatile("s_waitcnt vmcnt(0)" ::: "memory");
            const unsigned og = xb_add(&bar[XB_TOP], 1u);
            const unsigned tg = og / nx;
            if (og + 1u == (tg + 1u) * nx) xb_add(&bar[XB_TOPGEN], 1u);
            else XB_SPIN(xb_ld(&bar[XB_TOPGEN]) == tg, bar);
            __builtin_amdgcn_fence(__ATOMIC_ACQUIRE, "agent");
            xb_add(&bar[XB_XGEN(b.x)], 1u);
            asm volatile("s_waitcnt vmcnt(0)" ::: "memory");
        } else {
            XB_SPIN(xb_ld(&bar[XB_XGEN(b.x)]) == gen, bar);
            __builtin_amdgcn_fence(__ATOMIC_ACQUIRE, "agent");
            asm volatile("s_waitcnt vmcnt(0)" ::: "memory");
        }
    }
    __syncthreads();
}

namespace pg8 {
constexpr int BM = 256, BK = 64, HALF = 128, HTB = HALF * BK * 2, STAGE_BYTES = 8 * HTB, NXCD = 8, WGM = 8;
__host__ __device__ __forceinline__ int lds_byte(int r, int c) { const int st = (r >> 4) * 2 + (c >> 5), rr = r & 15, cc = c & 31, ob = rr * 64 + cc * 2; return st * 1024 + (ob ^ (((ob >> 9) & 1) << 5)); }
__host__ __device__ __forceinline__ void stage_rc(int b, int& R, int& C) { const int st = b / 1024, sb = b % 1024, swz = sb ^ (((sb >> 9) & 1) << 5); R = (st >> 1) * 16 + swz / 64; C = (st & 1) * 32 + (swz % 64) / 2; }
__host__ __device__ __forceinline__ int perm32(int rho) { const int n = rho >> 4, i = rho & 15; return 8 * (i >> 2) + 4 * n + (i & 3); }

struct Unit { int pm, pn, x0, x1; };

struct TileOrder {
    int nM, nN, nwg, G, c;
    __device__ void init(int nM_, int nN_, int G_, int c_) { nM = nM_; nN = nN_; nwg = nM * nN; G = G_; c = c_; }
    __device__ bool get(int i, int& pm, int& pn) const {
        const long L = (long)i * G + c; if (L >= nwg) return false;
        int wgid = (int)L; { const int q = nwg / NXCD, r = nwg % NXCD, xcd = wgid % NXCD, off = wgid / NXCD; wgid = (xcd < r ? xcd * (q + 1) : r * (q + 1) + (xcd - r) * q) + off; }
        const int nig = WGM * nN, gid = wgid / nig, fm = gid * WGM, gsz = (nM - fm) < WGM ? (nM - fm) : WGM;
        pm = fm + ((wgid % nig) % gsz); pn = (wgid % nig) / gsz; return true;
    }
};

typedef int v8i __attribute__((ext_vector_type(8)));
template <class Epi, class Sched, bool F8 = false>
__device__ __forceinline__ void gemm_phase(LAS unsigned char* lds, const int Kb, const Sched& S, const Epi& E) {
    int tid = threadIdx.x; asm volatile("" : "+v"(tid));
    const int wid = __builtin_amdgcn_readfirstlane(tid >> 6), lane = tid & 63, wr = wid >> 2, wc = wid & 3, fr = lane & 15, fq = lane >> 4;
    const int nt = Kb / 128;
    constexpr bool GA = Sched::GATHER; constexpr int KS = Sched::KSPLIT;
    unsigned voffA[2], voffB[2]; int Rst[2], Cst[2];
#pragma unroll
    for (int i = 0; i < 2; ++i) { int R, C; stage_rc(tid * 16 + i * 8192, R, C); const int Rb = Epi::PERM ? ((R & ~31) + perm32(R & 31)) : R;
        voffA[i] = (unsigned)(R * S.lda + C * 2); voffB[i] = (unsigned)(Rb * S.ldb + C * 2); Rst[i] = R; Cst[i] = C; }
    const size_t kstep = (size_t)(BK * 2);
    const size_t hstepA = (size_t)HALF * S.lda, hstepB = (size_t)HALF * S.ldb;
    const unsigned ldsw = (unsigned)wid * 1024u; const unsigned gmul = (unsigned)S.lda;
    const int aoff = F8 ? (lds_byte(wr * 64 + fr, (fq & 1) * 16) + (fq >> 1) * 1024) : lds_byte(wr * 64 + fr, fq * 8);
    const int boff = F8 ? (lds_byte(wc * 32 + fr, (fq & 1) * 16) + (fq >> 1) * 1024) : lds_byte(wc * 32 + fr, fq * 8);
    unsigned vAc[2], vAn[2];
#define PG8_SA(b, h) (((b) * 2 + (h)) * HTB)
#define PG8_SB(b, h) ((4 + (b) * 2 + (h)) * HTB)
#define PG8_STAGE2(bufoff, gbase, v0, v1) do { \
        __builtin_amdgcn_global_load_lds((const unsigned*)((const char*)(gbase) + (v0)), (LAS unsigned*)(lds + (bufoff) + ldsw), 16, 0, 0); \
        __builtin_amdgcn_global_load_lds((const unsigned*)((const char*)(gbase) + (v1)), (LAS unsigned*)(lds + (bufoff) + ldsw + 8192), 16, 0, 0); } while (0)
#define PG8_STAGE_B(bufoff, ptr, h) PG8_STAGE2(bufoff, (ptr) + (h) * hstepB, voffB[0], voffB[1])
#define PG8_STAGE_A(bufoff, ptr, h, nx) do { if constexpr (GA) { const unsigned _p = (nx) ? vAn[h] : vAc[h]; PG8_STAGE2(bufoff, ptr, (_p & 0xffffu) * gmul + (unsigned)Cst[0] * 2u, (_p >> 16) * gmul + (unsigned)Cst[0] * 2u); } \
        else { PG8_STAGE2(bufoff, (ptr) + (h) * hstepA, voffA[0], voffA[1]); } } while (0)
    typedef int v4i_ __attribute__((ext_vector_type(4)));
#define PG8_LDA(dst, b, h) do { _Pragma("unroll") for (int m = 0; m < 4; ++m) { if constexpr (F8) { dst##8[m].lo = *(const LAS v4i_*)(lds + PG8_SA(b, h) + aoff + m * 2048); dst##8[m].hi = *(const LAS v4i_*)(lds + PG8_SA(b, h) + aoff + m * 2048 + 16); } \
        else { _Pragma("unroll") for (int k = 0; k < 2; ++k) dst[m][k] = *(const LAS bf16x8*)(lds + PG8_SA(b, h) + aoff + m * 2048 + k * 1024); } } } while (0)
#define PG8_LDB(dst, b, h) do { _Pragma("unroll") for (int n = 0; n < 2; ++n) { if constexpr (F8) { dst##8[n].lo = *(const LAS v4i_*)(lds + PG8_SB(b, h) + boff + n * 2048); dst##8[n].hi = *(const LAS v4i_*)(lds + PG8_SB(b, h) + boff + n * 2048 + 16); } \
        else { _Pragma("unroll") for (int k = 0; k < 2; ++k) dst[n][k] = *(const LAS bf16x8*)(lds + PG8_SB(b, h) + boff + n * 2048 + k * 1024); } } } while (0)
#define PG8_MMA(ai, bj, At, Bt) do { __builtin_amdgcn_s_setprio(1); _Pragma("unroll") for (int m = 0; m < 4; ++m) _Pragma("unroll") for (int n = 0; n < 2; ++n) { \
        if constexpr (F8) { asm volatile("v_mfma_scale_f32_16x16x128_f8f6f4 %0, %1, %2, %0, %3, %3 op_sel_hi:[0,0,0]" : "+v"(acc[ai][bj][m][n]) : "v"(Bt##8[n]), "v"(At##8[m]), "v"(f8scale)); } \
        else { _Pragma("unroll") for (int k = 0; k < 2; ++k) acc[ai][bj][m][n] = __builtin_amdgcn_mfma_f32_16x16x32_bf16(Bt[n][k], At[m][k], acc[ai][bj][m][n], 0, 0, 0); } } \
        __builtin_amdgcn_s_setprio(0); } while (0)
#define PG8_WAIT_V(n) asm volatile("s_waitcnt vmcnt(" #n ")" ::: "memory")
#define PG8_WAIT_L(n) asm volatile("s_waitcnt lgkmcnt(" #n ")" ::: "memory")
#define PG8_BAR __builtin_amdgcn_s_barrier()
#define PG8_SCHED __builtin_amdgcn_sched_barrier(0)
#define PG8_GOFF(dst, u) do { if constexpr (GA) { _Pragma("unroll") for (int h = 0; h < 2; ++h) dst[h] = S.a_rowoff(u, Rst[0] + HALF * h) | (S.a_rowoff(u, Rst[0] + 64 + HALF * h) << 16); } } while (0)
    Unit cur, nxt; int ui = 0;
    if (!S.next(0, cur)) return;
    f32x4 acc[2][2][4][2];
#pragma unroll
    for (int a = 0; a < 2; ++a)
#pragma unroll
        for (int b = 0; b < 2; ++b)
#pragma unroll
            for (int m = 0; m < 4; ++m)
#pragma unroll
                for (int n = 0; n < 2; ++n) acc[a][b][m][n] = (f32x4){0.f, 0.f, 0.f, 0.f};
    int f8scale = 0x7F7F7F7F; asm volatile("" : "+v"(f8scale));
    bf16x8 At[4][2], B0[2][2], B1[2][2]; v8i At8[4], B08[2], B18[2];
    const char* cA = S.a_base(cur); const char* cB0 = S.b_base(cur, 0); const char* cB1 = KS ? S.b_base(cur, 1) : cB0;
    PG8_GOFF(vAc, cur);
    vAn[0] = vAc[0]; vAn[1] = vAc[1];
    PG8_STAGE_B(PG8_SB(0, 0), cB0, 0); PG8_STAGE_B(PG8_SB(0, 1), cB0, 1); PG8_STAGE_A(PG8_SA(0, 0), cA, 0, false); PG8_STAGE_A(PG8_SA(0, 1), cA, 1, false);
    if (wr == 1) PG8_BAR;
    PG8_WAIT_V(2); PG8_BAR;
    PG8_STAGE_B(PG8_SB(1, 0), cB0 + kstep, 0); PG8_STAGE_A(PG8_SA(1, 0), cA + kstep, 0, false); PG8_STAGE_B(PG8_SB(1, 1), cB0 + kstep, 1);
    PG8_WAIT_V(6); PG8_BAR;
    for (;;) {
        const bool has_next = S.next(ui + 1, nxt);
        const char* nA = has_next ? S.a_base(nxt) : cA; const char* nB0 = has_next ? S.b_base(nxt, 0) : cB0; const char* nB1 = (KS && has_next) ? S.b_base(nxt, 1) : (KS ? cB1 : nB0);
        if constexpr (GA) { if (has_next) { PG8_GOFF(vAn, nxt); } }
#pragma unroll 1
        for (int t = 0; t < nt; t += 2) {
            const bool last = (t == nt - 2);
            const char* a1 = cA + (size_t)(t + 1) * kstep;
            const char* a2 = last ? nA : cA + (size_t)(t + 2) * kstep;
            const char* b2 = last ? nB0 : ((KS && (t + 2) >= KS) ? cB1 + (size_t)(t + 2 - KS) * kstep : cB0 + (size_t)(t + 2) * kstep);
            const char* a3 = a2 + kstep; const char* b3 = b2 + kstep;
            PG8_LDB(B0, 0, 0); PG8_LDB(B1, 0, 1); PG8_SCHED; PG8_LDA(At, 0, 0); PG8_STAGE_A(PG8_SA(1, 1), a1, 1, false);
            PG8_WAIT_V(8); PG8_WAIT_L(0); PG8_BAR; PG8_MMA(0, 0, At, B0); PG8_MMA(0, 1, At, B1); PG8_BAR; PG8_SCHED;
            PG8_LDA(At, 0, 1); PG8_STAGE_B(PG8_SB(0, 0), b2, 0); PG8_STAGE_B(PG8_SB(0, 1), b2, 1); PG8_STAGE_A(PG8_SA(0, 0), a2, 0, last);
            PG8_WAIT_V(8); PG8_WAIT_L(0); PG8_BAR; PG8_MMA(1, 0, At, B0); PG8_MMA(1, 1, At, B1); PG8_BAR; PG8_SCHED;
            PG8_LDB(B0, 1, 0); PG8_LDB(B1, 1, 1); PG8_SCHED; PG8_LDA(At, 1, 0); PG8_STAGE_A(PG8_SA(0, 1), a2, 1, last);
            PG8_WAIT_V(8); PG8_WAIT_L(0); PG8_BAR; PG8_MMA(0, 0, At, B0); PG8_MMA(0, 1, At, B1); PG8_BAR; PG8_SCHED;
            PG8_LDA(At, 1, 1); PG8_STAGE_B(PG8_SB(1, 0), b3, 0); PG8_STAGE_B(PG8_SB(1, 1), b3, 1); PG8_STAGE_A(PG8_SA(1, 0), a3, 0, last);
            PG8_WAIT_V(8); PG8_WAIT_L(0); PG8_BAR; PG8_MMA(1, 0, At, B0); PG8_MMA(1, 1, At, B1); PG8_BAR; PG8_SCHED;
        }
        if (wr == 0) PG8_BAR;
        if constexpr (F8) { asm volatile("s_nop 15\n\ts_nop 15" ::: "memory"); }
        { int fr_ = fr, fq_ = fq; asm volatile("" : "+v"(fr_), "+v"(fq_));
          E(acc, cur, wr, wc, fr_, fq_); }
        if (!has_next) break;
#pragma unroll
        for (int a = 0; a < 2; ++a)
#pragma unroll
            for (int b = 0; b < 2; ++b)
#pragma unroll
                for (int m = 0; m < 4; ++m)
#pragma unroll
                    for (int n = 0; n < 2; ++n) acc[a][b][m][n] = (f32x4){0.f, 0.f, 0.f, 0.f};
        cur = nxt; cA = nA; cB0 = nB0; cB1 = nB1; ++ui;
        vAc[0] = vAn[0]; vAc[1] = vAn[1];
        if (wr == 1) PG8_BAR;
    }
    PG8_WAIT_V(0);
    PG8_BAR;
#undef PG8_SA
#undef PG8_SB
#undef PG8_STAGE2
#undef PG8_STAGE_A
#undef PG8_STAGE_B
#undef PG8_LDA
#undef PG8_LDB
#undef PG8_MMA
#undef PG8_WAIT_V
#undef PG8_WAIT_L
#undef PG8_BAR
#undef PG8_SCHED
#undef PG8_GOFF
}
}
using pg8::Unit;

DI unsigned cvt_pk_bf16(float lo, float hi) { unsigned r; asm volatile("v_cvt_pk_bf16_f32 %0, %1, %2" : "=v"(r) : "v"(lo), "v"(hi)); return r; }

struct Args {
    const float* x; const float* c; const int* pos; const float* ada_w; const float* ada_b; const float* nmw; const float* nfw; const float* w_in;
    const float* b_ig; const float* b_fg; const float* qnw; const float* knw; const float* sinks; const float* conv_w; const float* conv_b; const float* mnw;
    const float* w_au; const float* w_mu; const float* w_out; const float* router_w; const float* router_b; const float* w_gate; const float* w_up; const float* w_down;
    float* out; unsigned char* ws; int ph_lo, ph_hi;
};

__constant__ float c_invf[8] = {1.0f, 0.1939227432012558f, 0.03760603070259094f, 0.007292664609849453f, 0.0014142135623842478f, 0.00027424818836152554f, 5.3182957344688475e-05f, 1.0313385246263351e-05f};

struct DenseSched {
    static constexpr bool GATHER = false; static constexpr int KSPLIT = 0;
    const char* A; const char* Bt; int lda, ldb; pg8::TileOrder ord;
    DI bool next(int i, Unit& u) const { int pm, pn; if (!ord.get(i, pm, pn)) return false; u.pm = pm; u.pn = pn; u.x0 = 0; u.x1 = 0; return true; }
    DI const char* a_base(const Unit& u) const { return A + (size_t)u.pm * 256 * lda; }
    DI const char* b_base(const Unit& u, int) const { return Bt + (size_t)u.pn * 256 * ldb; }
    DI unsigned a_rowoff(const Unit&, int) const { return 0u; }
};
struct EpiProj {
    static constexpr bool PERM = true;
    bf16* O; float* gates; const float* big; const float* bfg;
    DI void operator()(const f32x4 (&acc)[2][2][4][2], const Unit& u, int wr, int wc, int fr, int fq) const {
        const int row0 = u.pm * 256 + wr * 64 + fr, col0 = u.pn * 256 + wc * 32 + 8 * fq; const bool sg = u.pn >= 9; constexpr float WSC = 1.0f / 64.0f;
        if (u.pn == 19) {
            if (wc == 0 && fq == 0) {
#pragma unroll
                for (int ai = 0; ai < 2; ++ai)
#pragma unroll
                    for (int m = 0; m < 4; ++m) { const int row = row0 + ai * 128 + m * 16; const f32x4 vi = acc[ai][0][m][0], vf = acc[ai][0][m][1]; f32x4 oi, of;
#pragma unroll
                        for (int j = 0; j < 4; ++j) { oi[j] = vi[j] * WSC + big[j]; const float z = vf[j] * WSC + bfg[j]; of[j] = fminf(z, 0.f) - log1pf(__expf(-fabsf(z))); }
                        *(f32x4*)(gates + (size_t)row * 8) = oi; *(f32x4*)(gates + (size_t)row * 8 + 4) = of; } }
            return; }
#pragma unroll
        for (int ai = 0; ai < 2; ++ai)
#pragma unroll
            for (int m = 0; m < 4; ++m) { bf16* rowp = O + (size_t)(row0 + ai * 128 + m * 16) * NPROJ + col0;
#pragma unroll
                for (int bj = 0; bj < 2; ++bj) { f32x4 v0 = acc[ai][bj][m][0] * WSC, v1 = acc[ai][bj][m][1] * WSC;
                    if (sg) {
#pragma unroll
                        for (int j = 0; j < 4; ++j) { v0[j] = sigmoidf_(v0[j]); v1[j] = sigmoidf_(v1[j]); } }
                    v4u w; w.x = cvt_pk_bf16(v0[0], v0[1]); w.y = cvt_pk_bf16(v0[2], v0[3]); w.z = cvt_pk_bf16(v1[0], v1[1]); w.w = cvt_pk_bf16(v1[2], v1[3]);
                    *(v4u*)(rowp + bj * 128) = w; } }
    }
};
template <bool ADD> struct EpiGate {
    static constexpr bool PERM = true;
    bf16* P; int gcol;
    DI void operator()(const f32x4 (&acc)[2][2][4][2], const Unit& u, int wr, int wc, int fr, int fq) const {
        const int row0 = u.pm * 256 + wr * 64 + fr, col0 = u.pn * 256 + wc * 32 + 8 * fq;
#pragma unroll
        for (int ai = 0; ai < 2; ++ai)
#pragma unroll
            for (int m = 0; m < 4; ++m) { bf16* rowp = P + (size_t)(row0 + ai * 128 + m * 16) * NPROJ + col0;
#pragma unroll
                for (int bj = 0; bj < 2; ++bj) { const f32x4 v0 = acc[ai][bj][m][0], v1 = acc[ai][bj][m][1];
                    const v4u g = *(const v4u*)(rowp + gcol + bj * 128);
                    float o[8] = {bflo(g.x) * v0[0], bfhi(g.x) * v0[1], bflo(g.y) * v0[2], bfhi(g.y) * v0[3], bflo(g.z) * v1[0], bfhi(g.z) * v1[1], bflo(g.w) * v1[2], bfhi(g.w) * v1[3]};
                    if (ADD) { const v4u p = *(const v4u*)(rowp + C_MQ + bj * 128);
                        o[0] += bflo(p.x); o[1] += bfhi(p.x); o[2] += bflo(p.y); o[3] += bfhi(p.y); o[4] += bflo(p.z); o[5] += bfhi(p.z); o[6] += bflo(p.w); o[7] += bfhi(p.w); }
                    v4u w; w.x = cvt_pk_bf16(o[0], o[1]); w.y = cvt_pk_bf16(o[2], o[3]); w.z = cvt_pk_bf16(o[4], o[5]); w.w = cvt_pk_bf16(o[6], o[7]);
                    *(v4u*)(rowp + C_MQ + bj * 128) = w; } }
    }
};
struct EpiRes {
    static constexpr bool PERM = false;
    const float* xin; float* out; const float* g; float* ssq; int rmask;
    DI void operator()(const f32x4 (&acc)[2][2][4][2], const Unit& u, int wr, int wc, int fr, int fq) const {
        const int row0 = u.pm * 256 + wr * 64 + fr, col0 = u.pn * 256 + wc * 32 + 4 * fq; const int b = (u.pm * 256) >> 14;
        f32x4 gv[2][2];
#pragma unroll
        for (int bj = 0; bj < 2; ++bj)
#pragma unroll
            for (int n = 0; n < 2; ++n) gv[bj][n] = *(const f32x4*)(g + b * 6144 + col0 + bj * 128 + n * 16);
#pragma unroll
        for (int ai = 0; ai < 2; ++ai)
#pragma unroll
            for (int m = 0; m < 4; ++m) { const size_t off = (size_t)(row0 + ai * 128 + m * 16) * D + col0; const size_t offo = (size_t)((row0 + ai * 128 + m * 16) & rmask) * D + col0; float sq = 0.f;
#pragma unroll
                for (int bj = 0; bj < 2; ++bj)
#pragma unroll
                    for (int n = 0; n < 2; ++n) { const f32x4 xv = *(const f32x4*)(xin + off + bj * 128 + n * 16); const f32x4 o = xv + gv[bj][n] * acc[ai][bj][m][n];
                        sq += (o.x * o.x + o.y * o.y) + (o.z * o.z + o.w * o.w);
                        *(f32x4*)(out + offo + bj * 128 + n * 16) = o; }
                sq += __shfl_xor(sq, 16); sq += __shfl_xor(sq, 32);
                if (fq == 0) ssq[(size_t)(row0 + ai * 128 + m * 16) * 16 + u.pn * 4 + wc] = sq; }
    }
};

struct MoeTab { const LAS int* tcls; const LAS int* tpos; const LAS int* cnt; int Rtot; };
DI int xcd_remap(int L, int nwg) { const int q = nwg >> 3, r = nwg & 7, xcd = L & 7, off = L >> 3; return (xcd < r ? xcd * (q + 1) : r * (q + 1) + (xcd - r) * q) + off; }
DI void cls_experts(int cls, int& ea, int& eb) { const int g = cls / 6, p = cls - 6 * g; const int a = (p < 3) ? 0 : ((p < 5) ? 1 : 2); const int b = (p < 3) ? (p + 1) : ((p < 5) ? (p - 1) : 3); ea = 4 * g + a; eb = 4 * g + b; }
struct MoeUpSched {
    static constexpr bool GATHER = true; static constexpr int KSPLIT = 0;
    const char* A; const char* W; int lda, ldb; MoeTab tb; int G, c; const LAS unsigned* tokoff;
    DI bool next(int i, Unit& u) const { const int L0 = i * G + c; if (L0 >= tb.Rtot * 8) return false; const int L = xcd_remap(L0, tb.Rtot * 8); u.pm = L >> 3; u.pn = L & 7; u.x0 = i; u.x1 = __builtin_amdgcn_readfirstlane(tb.tcls[u.pm]); return true; }
    DI const char* a_base(const Unit&) const { return A; }
    DI const char* b_base(const Unit& u, int) const { int ea, eb; cls_experts(u.x1, ea, eb); const int e = (u.pn < 4) ? ea : eb; return W + ((size_t)e * 1024 + (size_t)(u.pn & 3) * 256) * ldb; }
    DI unsigned a_rowoff(const Unit& u, int r) const { return tokoff[u.x0 * 256 + r]; }
};
struct EpiSwiglu {
    static constexpr bool PERM = true;
    bf16* H; const float* tgate; const LAS unsigned* tokoff;
    DI void operator()(const f32x4 (&acc)[2][2][4][2], const Unit& u, int wr, int wc, int fr, int fq) const {
        const int r0 = wr * 64 + fr; const int hc = (u.pn >> 2) * 512 + (u.pn & 3) * 128 + wc * 32 + 8 * fq; const int gsel = u.pn >> 2;
#pragma unroll
        for (int ai = 0; ai < 2; ++ai)
#pragma unroll
            for (int m = 0; m < 4; ++m) { const int r = r0 + ai * 128 + m * 16; const unsigned tok = tokoff[u.x0 * 256 + r]; const float rg = tgate[tok * 2 + gsel];
                const f32x4 g0 = acc[ai][0][m][0] * (1.0f / 64.0f), g1 = acc[ai][0][m][1] * (1.0f / 64.0f), u0 = acc[ai][1][m][0] * (1.0f / 64.0f), u1 = acc[ai][1][m][1] * (1.0f / 64.0f);
                float o[8];
#pragma unroll
                for (int j = 0; j < 4; ++j) { o[j] = g0[j] * sigmoidf_(g0[j]) * u0[j] * rg; o[4 + j] = g1[j] * sigmoidf_(g1[j]) * u1[j] * rg; }
                v4u w; w.x = cvt_pk_bf16(o[0], o[1]); w.y = cvt_pk_bf16(o[2], o[3]); w.z = cvt_pk_bf16(o[4], o[5]); w.w = cvt_pk_bf16(o[6], o[7]);
                *(v4u*)(H + ((size_t)u.pm * 256 + r) * 1024 + hc) = w; }
    }
};
struct MoeDownSched {
    static constexpr bool GATHER = false; static constexpr int KSPLIT = 8;
    const char* A; const char* W; int lda, ldb; MoeTab tb; int G, c;
    DI bool next(int i, Unit& u) const { const int L0 = i * G + c; if (L0 >= tb.Rtot * 4) return false; const int L = xcd_remap(L0, tb.Rtot * 4); u.pm = L >> 2; u.pn = L & 3; u.x0 = __builtin_amdgcn_readfirstlane(tb.tpos[u.pm]); u.x1 = __builtin_amdgcn_readfirstlane(tb.tcls[u.pm]); return true; }
    DI const char* a_base(const Unit& u) const { return A + (size_t)u.pm * 256 * lda; }
    DI const char* b_base(const Unit& u, int half) const { int ea, eb; cls_experts(u.x1, ea, eb); const int e = half ? eb : ea; return W + ((size_t)e * 1024 + (size_t)u.pn * 256) * ldb; }
    DI unsigned a_rowoff(const Unit&, int) const { return 0u; }
};
struct EpiMoeOut {
    static constexpr bool PERM = false;
    const float* xin; float* out; const float* g; const int* tokl; MoeTab tb; int rmask;
    DI void operator()(const f32x4 (&acc)[2][2][4][2], const Unit& u, int wr, int wc, int fr, int fq) const {
        const int r0 = wr * 64 + fr, col0 = u.pn * 256 + wc * 32 + 4 * fq; const int cn = tb.cnt[u.x1];
#pragma unroll
        for (int ai = 0; ai < 2; ++ai)
#pragma unroll
            for (int m = 0; m < 4; ++m) { const int pos = u.x0 + r0 + ai * 128 + m * 16;
                if (pos < cn) { const int tok = tokl[u.x1 * CLS_CAP + pos]; const int b = tok >> 14; const float* ip = xin + (size_t)tok * D + col0; float* op = out + (size_t)(tok & rmask) * D + col0; const float* gp = g + b * 6144 + col0;
#pragma unroll
                    for (int bj = 0; bj < 2; ++bj)
#pragma unroll
                        for (int n = 0; n < 2; ++n) { const f32x4 xv = *(const f32x4*)(ip + bj * 128 + n * 16); const f32x4 gv = *(const f32x4*)(gp + bj * 128 + n * 16);
                            *(f32x4*)(op + bj * 128 + n * 16) = xv + gv * acc[ai][bj][m][n]; } } }
    }
};

struct Ctx { LAS unsigned char* lds; int tid, lane, wave, G, bid; };
DI Ctx fresh(const Ctx& X) { Ctx P = X; int t = X.tid; asm volatile("" : "+v"(t)); P.tid = t; P.lane = t & 63; P.wave = __builtin_amdgcn_readfirstlane(t >> 6); return P; }

DI void tr_item(const float* W, int ldw, int K, bf16* WT, int k0, LAS float* scr, int lane) {
#pragma unroll 8
    for (int i = 0; i < 32; ++i) { const int kk = 2 * i + (lane >> 5); scr[kk * 33 + (lane & 31)] = W[(size_t)(k0 + kk) * ldw + (lane & 31)]; }
    LDS_WAIT(); asm volatile("" ::: "memory");
    const int c = lane & 7;
#pragma unroll
    for (int j = 0; j < 4; ++j) { const int n = (lane >> 3) + 8 * j; const LAS float* s = scr + (8 * c) * 33 + n;
        v4u o; o.x = pk2(s[0 * 33], s[1 * 33]); o.y = pk2(s[2 * 33], s[3 * 33]); o.z = pk2(s[4 * 33], s[5 * 33]); o.w = pk2(s[6 * 33], s[7 * 33]);
        *(v4u*)(WT + (size_t)n * K + k0 + 8 * c) = o; }
    LDS_WAIT(); asm volatile("" ::: "memory");
}
DI unsigned pk4_fp8(float a0, float a1, float a2, float a3) { int p = __builtin_amdgcn_cvt_pk_fp8_f32(a0, a1, 0, false); p = __builtin_amdgcn_cvt_pk_fp8_f32(a2, a3, p, true); return (unsigned)p; }
DI void tr_item8(const float* W, int ldw, int K, unsigned char* WT, int k0, float scale, LAS float* scr, int lane) {
#pragma unroll 8
    for (int i = 0; i < 32; ++i) { const int kk = 2 * i + (lane >> 5); scr[kk * 33 + (lane & 31)] = W[(size_t)(k0 + kk) * ldw + (lane & 31)]; }
    LDS_WAIT(); asm volatile("" ::: "memory");
    const int c = lane & 7;
#pragma unroll
    for (int j = 0; j < 4; ++j) { const int n = (lane >> 3) + 8 * j; const LAS float* s = scr + (8 * c) * 33 + n;
        v2u o; o.x = pk4_fp8(s[0 * 33] * scale, s[1 * 33] * scale, s[2 * 33] * scale, s[3 * 33] * scale); o.y = pk4_fp8(s[4 * 33] * scale, s[5 * 33] * scale, s[6 * 33] * scale, s[7 * 33] * scale);
        *(v2u*)(WT + (size_t)n * K + k0 + 8 * c) = o; }
    LDS_WAIT(); asm volatile("" ::: "memory");
}
DI void p0_prologue(const Args& a, const Ctx& X) {
    unsigned char* ws = a.ws;
    LAS float* scr = (LAS float*)(X.lds + X.wave * 16384);
    const int gw = X.bid * 8 + X.wave, NGW = X.G * 8;
    constexpr int IT_WIN = 16 * 153, IT_AU = 8 * 32, IT_OUT = 16 * 32, IT_GU = 16 * 16 * 32, IT_DN = 16 * 8 * 32;
    constexpr int IT_L = IT_WIN + 2 * IT_AU + IT_OUT + IT_GU + IT_DN;
    for (int it = gw; it < NL * IT_L; it += NGW) {
        const int l = it / IT_L; int r = it - l * IT_L;
        if (r < IT_WIN) { const int kb = r / 153, nb = r - kb * 153, d0 = 32 * nb, s0 = (nb == 152) ? 2304 : (d0 + (d0 >= 2304 ? 8 : 0));
            tr_item8(a.w_in + (size_t)l * D * DIN_SRC + s0, DIN_SRC, D, (unsigned char*)(ws + WS_WIN) + ((size_t)l * NPROJW + d0) * D, 64 * kb, 64.0f, scr, X.lane); continue; }
        r -= IT_WIN;
        if (r < IT_AU) { const int kb = r >> 5, nb = r & 31;
            tr_item(a.w_au + (size_t)l * 512 * D + 32 * nb, D, 512, (bf16*)(ws + WS_WAU) + ((size_t)l * D + 32 * nb) * 512, 64 * kb, scr, X.lane); continue; }
        r -= IT_AU;
        if (r < IT_AU) { const int kb = r >> 5, nb = r & 31;
            tr_item(a.w_mu + (size_t)l * 512 * D + 32 * nb, D, 512, (bf16*)(ws + WS_WMU) + ((size_t)l * D + 32 * nb) * 512, 64 * kb, scr, X.lane); continue; }
        r -= IT_AU;
        if (r < IT_OUT) { const int kb = r >> 5, nb = r & 31;
            tr_item(a.w_out + (size_t)l * D * D + 32 * nb, D, D, (bf16*)(ws + WS_WOUT) + ((size_t)l * D + 32 * nb) * D, 64 * kb, scr, X.lane); continue; }
        r -= IT_OUT;
        if (r < IT_GU) { const int e = r >> 9, q = r & 511, kb = q >> 5, nb = q & 31, tq = nb >> 3, rb = nb & 7;
            const float* src = ((rb < 4) ? a.w_gate : a.w_up) + ((size_t)(l * NE + e) * D) * FF + 128 * tq + 32 * (rb & 3);
            tr_item8(src, FF, D, (unsigned char*)(ws + WS_WGU) + ((size_t)(l * NE + e) * 1024 + 32 * nb) * D, 64 * kb, 64.0f, scr, X.lane); continue; }
        r -= IT_GU;
        { const int e = r >> 8, q = r & 255, kb = q >> 5, nb = q & 31;
            tr_item(a.w_down + ((size_t)(l * NE + e) * FF) * D + 32 * nb, D, FF, (bf16*)(ws + WS_WD) + ((size_t)(l * NE + e) * 1024 + 32 * nb) * FF, 64 * kb, scr, X.lane); }
    }
    { float* cs = (float*)(ws + WS_ROPE); float* sn = cs + (size_t)T * 8;
      for (int i = X.bid * 512 + X.tid; i < T * 8; i += X.G * 512) { const int tok = i >> 3, f = i & 7; const float angf = (float)a.pos[tok] * c_invf[f];
          double rev = (double)angf * 0.15915494309189535; rev -= rint(rev); const float rf = (float)rev;
          cs[i] = __builtin_amdgcn_cosf(rf); sn[i] = __builtin_amdgcn_sinf(rf); } }
    __syncthreads();
    LAS float* cact = (LAS float*)X.lds; LAS float* red = (LAS float*)(X.lds + 8192);
    for (int i = X.tid; i < 2048; i += 512) { const float cv = a.c[i]; cact[i] = cv / (1.0f + __expf(-cv)); }
    __syncthreads();
    float* mod = (float*)(ws + WS_MOD);
    for (int it = X.bid; it < NL * 96; it += X.G) { const int l = it / 96, cg = it - l * 96; const int col = cg * 64 + X.lane;
        const float* w = a.ada_w + (size_t)l * D * 6144 + col; float s0 = 0.f, s1 = 0.f;
#pragma unroll 8
        for (int kk = 0; kk < 128; ++kk) { const int k = X.wave * 128 + kk; const float wv = w[(size_t)k * 6144]; s0 += cact[k] * wv; s1 += cact[1024 + k] * wv; }
        red[(X.wave * 2 + 0) * 64 + X.lane] = s0; red[(X.wave * 2 + 1) * 64 + X.lane] = s1;
        __syncthreads();
        if (X.tid < 128) { const int b = X.tid >> 6, ln = X.tid & 63; float s = 0.f;
#pragma unroll
            for (int w8 = 0; w8 < 8; ++w8) s += red[(w8 * 2 + b) * 64 + ln];
            mod[(size_t)(l * 2 + b) * 6144 + cg * 64 + ln] = s + a.ada_b[l * 6144 + cg * 64 + ln]; }
        __syncthreads();
    }
}

DI void p1_norm_gates(const Args& a, const Ctx& X, int l, const float* xin) {
    unsigned char* ws = a.ws;
    const float* mod = (const float*)(ws + WS_MOD); unsigned char* hb = (unsigned char*)(ws + WS_H);
    const int gw = X.bid * 8 + X.wave, NGW = X.G * 8;
    for (int rg = gw; rg < T / 16; rg += NGW) {
        const int row0 = rg * 16, b = row0 >> 14;
        const float* mb = mod + (size_t)(l * 2 + b) * 6144;
        f32x4 aw[4], sh[4];
#pragma unroll
        for (int j = 0; j < 4; ++j) { const int k = 256 * j + 4 * X.lane; const f32x4 nw = *(const f32x4*)(a.nmw + l * D + k); const f32x4 sc = *(const f32x4*)(mb + 1024 + k); aw[j] = nw * (sc + 1.0f); sh[j] = *(const f32x4*)(mb + k); }
        f32x4 pre[4][4];
#pragma unroll
        for (int q = 0; q < 4; ++q) { const f32x4* xp = (const f32x4*)(xin + (size_t)(row0 + q) * D) + X.lane;
#pragma unroll
            for (int j = 0; j < 4; ++j) pre[q][j] = xp[64 * j]; }
#pragma unroll 1
        for (int rb = 0; rb < 16; rb += 4) {
#pragma unroll
          for (int q = 0; q < 4; ++q) { const int row = row0 + rb + q;
            f32x4 v[4]; float ss = 0.f;
#pragma unroll
            for (int j = 0; j < 4; ++j) v[j] = pre[q][j];
            if (rb + 4 < 16) { const f32x4* xp = (const f32x4*)(xin + (size_t)(row + 4) * D) + X.lane;
#pragma unroll
                for (int j = 0; j < 4; ++j) pre[q][j] = xp[64 * j]; }
#pragma unroll
            for (int j = 0; j < 4; ++j) ss += (v[j].x * v[j].x + v[j].y * v[j].y) + (v[j].z * v[j].z + v[j].w * v[j].w);
            ss = wave_sum(ss); const float rstd = __builtin_amdgcn_rsqf(ss * (1.0f / D) + EPS);
            unsigned* o4 = (unsigned*)(hb + (size_t)row * D) + X.lane;
#pragma unroll
            for (int j = 0; j < 4; ++j) { v[j] = v[j] * rstd * aw[j] + sh[j]; o4[64 * j] = pk4_fp8(v[j].x, v[j].y, v[j].z, v[j].w); }
          }
        }
    }
}

DI void attn_unit(const Args& a, const Ctx& X, int l, int unit) {
    unsigned char* ws = a.ws; const bf16* proj = (const bf16*)(ws + WS_PROJ); bf16* ao = (bf16*)(ws + WS_H);
    const float* cs = (const float*)(ws + WS_ROPE); const float* sn = cs + (size_t)T * 8;
    const int b = unit >> 8, rem = unit & 255, nb = rem >> 1, kvh = rem & 1; const int tok0 = b * SEQ + nb * 128;
    LAS bf16* Kl = (LAS bf16*)X.lds;
    LAS bf16* VT = (LAS bf16*)(X.lds + 36864);
    int lane = X.lane; asm volatile("" : "+v"(lane));
    const int c16 = lane & 15, quad = lane >> 4;
    {
        const int row = X.tid >> 1, half = X.tid & 1; const int tokk = tok0 - 128 + row; const bool valid = (nb > 0) || (row >= 128);
        float y[32]; float vv[32];
        if (valid) {
            const v4u* kp = (const v4u*)(proj + (size_t)tokk * NPROJ + C_AK + kvh * 64 + half * 32); const v4u* vp = (const v4u*)(proj + (size_t)tokk * NPROJ + C_AV + kvh * 64 + half * 32);
#pragma unroll
            for (int q = 0; q < 4; ++q) { const v4u kw = kp[q], vw = vp[q];
                y[8 * q + 0] = bflo(kw.x); y[8 * q + 1] = bfhi(kw.x); y[8 * q + 2] = bflo(kw.y); y[8 * q + 3] = bfhi(kw.y); y[8 * q + 4] = bflo(kw.z); y[8 * q + 5] = bfhi(kw.z); y[8 * q + 6] = bflo(kw.w); y[8 * q + 7] = bfhi(kw.w);
                vv[8 * q + 0] = bflo(vw.x); vv[8 * q + 1] = bfhi(vw.x); vv[8 * q + 2] = bflo(vw.y); vv[8 * q + 3] = bfhi(vw.y); vv[8 * q + 4] = bflo(vw.z); vv[8 * q + 5] = bfhi(vw.z); vv[8 * q + 6] = bflo(vw.w); vv[8 * q + 7] = bfhi(vw.w); }
        } else {
#pragma unroll
            for (int i = 0; i < 32; ++i) { y[i] = 0.f; vv[i] = 0.f; } }
        float ss = 0.f;
#pragma unroll
        for (int i = 0; i < 32; ++i) ss += y[i] * y[i];
        ss += __shfl_xor(ss, 1); const float rstd = 1.0f / sqrtf(ss * (1.0f / 64.0f) + EPS);
#pragma unroll
        for (int i = 0; i < 32; ++i) y[i] = y[i] * rstd * a.knw[l * 64 + half * 32 + i];
        if (half == 0 && valid) {
#pragma unroll
            for (int d = 0; d < 8; ++d) { const float c = cs[(size_t)tokk * 8 + d], s = sn[(size_t)tokk * 8 + d]; const float t1 = y[d], t2 = y[d + 8]; y[d] = t1 * c - t2 * s; y[d + 8] = t2 * c + t1 * s; } }
#pragma unroll
        for (int q = 0; q < 4; ++q) { v4u w; w.x = pk2(y[8 * q], y[8 * q + 1]); w.y = pk2(y[8 * q + 2], y[8 * q + 3]); w.z = pk2(y[8 * q + 4], y[8 * q + 5]); w.w = pk2(y[8 * q + 6], y[8 * q + 7]);
            *(LAS v4u*)(Kl + row * 72 + half * 32 + 8 * q) = w; }
#pragma unroll
        for (int i = 0; i < 32; ++i) VT[(half * 32 + i) * 280 + row] = (bf16)f2bf(vv[i]);
        if (X.tid < 64) {
#pragma unroll
            for (int cc = 256; cc < 280; ++cc) VT[X.tid * 280 + cc] = 0; }
    }
    __syncthreads();
#pragma unroll 1
    for (int task = X.wave; task < 32; task += 8) {
        const int g = task >> 3, rg = task & 7, r0 = 16 * rg, head = kvh * 4 + g; const int tokq = tok0 + r0 + c16;
        const float sink = a.sinks[l * 8 + head];
        float qv[16];
        { const bf16* qp = proj + (size_t)tokq * NPROJ + C_AQ + head * 64; const v4u w0 = *(const v4u*)(qp + 8 * quad), w1 = *(const v4u*)(qp + 32 + 8 * quad);
          qv[0] = bflo(w0.x); qv[1] = bfhi(w0.x); qv[2] = bflo(w0.y); qv[3] = bfhi(w0.y); qv[4] = bflo(w0.z); qv[5] = bfhi(w0.z); qv[6] = bflo(w0.w); qv[7] = bfhi(w0.w);
          qv[8] = bflo(w1.x); qv[9] = bfhi(w1.x); qv[10] = bflo(w1.y); qv[11] = bfhi(w1.y); qv[12] = bflo(w1.z); qv[13] = bfhi(w1.z); qv[14] = bflo(w1.w); qv[15] = bfhi(w1.w); }
        float ss = 0.f;
#pragma unroll
        for (int i = 0; i < 16; ++i) ss += qv[i] * qv[i];
        ss += __shfl_xor(ss, 16); ss += __shfl_xor(ss, 32); const float rstd = 1.0f / sqrtf(ss * (1.0f / 64.0f) + EPS);
#pragma unroll
        for (int i = 0; i < 8; ++i) { qv[i] = qv[i] * rstd * a.qnw[l * 64 + 8 * quad + i]; qv[8 + i] = qv[8 + i] * rstd * a.qnw[l * 64 + 32 + 8 * quad + i]; }
#pragma unroll
        for (int d = 0; d < 8; ++d) { const float other = __shfl_xor(qv[d], 16); const float c = cs[(size_t)tokq * 8 + d], s = sn[(size_t)tokq * 8 + d];
            if (quad == 0) qv[d] = qv[d] * c - other * s; else if (quad == 1) qv[d] = qv[d] * c + other * s; }
        bf16x8 qf[2];
        { v4u w; w.x = pk2(qv[0], qv[1]); w.y = pk2(qv[2], qv[3]); w.z = pk2(qv[4], qv[5]); w.w = pk2(qv[6], qv[7]); qf[0] = __builtin_bit_cast(bf16x8, w);
          w.x = pk2(qv[8], qv[9]); w.y = pk2(qv[10], qv[11]); w.z = pk2(qv[12], qv[13]); w.w = pk2(qv[14], qv[15]); qf[1] = __builtin_bit_cast(bf16x8, w); }
        f32x4 sacc[9];
#pragma unroll
        for (int i = 0; i < 9; ++i) { const LAS bf16* kr = Kl + (16 * (rg + i) + c16) * 72 + 8 * quad;
            const bf16x8 k0 = *(const LAS bf16x8*)kr, k1 = *(const LAS bf16x8*)(kr + 32);
            f32x4 z = {0.f, 0.f, 0.f, 0.f}; z = __builtin_amdgcn_mfma_f32_16x16x32_bf16(k0, qf[0], z, 0, 0, 0); sacc[i] = __builtin_amdgcn_mfma_f32_16x16x32_bf16(k1, qf[1], z, 0, 0, 0); }
        int dbase = 4 * quad - c16; asm volatile("" : "+v"(dbase)); int kbase = 16 * rg + 4 * quad; asm volatile("" : "+v"(kbase)); float mx = sink;
#pragma unroll
        for (int i = 0; i < 9; ++i)
#pragma unroll
            for (int j = 0; j < 4; ++j) { const int dlt = dbase + 16 * i + j; const int kj = kbase + 16 * i + j; const bool ok = (dlt > 0) && (dlt <= 128) && ((nb > 0) || (kj >= 128));
                const float s = ok ? sacc[i][j] * 0.125f : -3.0e38f; sacc[i][j] = s; mx = fmaxf(mx, s); }
        mx = fmaxf(mx, __shfl_xor(mx, 16)); mx = fmaxf(mx, __shfl_xor(mx, 32));
        float sum = 0.f;
#pragma unroll
        for (int i = 0; i < 9; ++i)
#pragma unroll
            for (int j = 0; j < 4; ++j) { const float p = (sacc[i][j] > -1.0e38f) ? __expf(sacc[i][j] - mx) : 0.f; sacc[i][j] = p; sum += p; }
        sum += __shfl_xor(sum, 16); sum += __shfl_xor(sum, 32);
        const float inv = 1.0f / (sum + __expf(sink - mx));
        f32x4 oacc[4];
#pragma unroll
        for (int et = 0; et < 4; ++et) oacc[et] = (f32x4){0.f, 0.f, 0.f, 0.f};
#pragma unroll
        for (int kk = 0; kk < 5; ++kk) {
            v4u pw; pw.x = pk2(sacc[2 * kk][0], sacc[2 * kk][1]); pw.y = pk2(sacc[2 * kk][2], sacc[2 * kk][3]);
            if (2 * kk + 1 < 9) { pw.z = pk2(sacc[(2 * kk + 1 < 9) ? 2 * kk + 1 : 0][0], sacc[(2 * kk + 1 < 9) ? 2 * kk + 1 : 0][1]); pw.w = pk2(sacc[(2 * kk + 1 < 9) ? 2 * kk + 1 : 0][2], sacc[(2 * kk + 1 < 9) ? 2 * kk + 1 : 0][3]); } else { pw.z = 0u; pw.w = 0u; }
            const bf16x8 pf = __builtin_bit_cast(bf16x8, pw);
#pragma unroll
            for (int et = 0; et < 4; ++et) { const LAS bf16* vr = VT + (16 * et + c16) * 280 + 16 * rg + 32 * kk + 4 * quad;
                const v2u lo = *(const LAS v2u*)vr, hi = *(const LAS v2u*)(vr + 16); v4u vw; vw.x = lo.x; vw.y = lo.y; vw.z = hi.x; vw.w = hi.y;
                oacc[et] = __builtin_amdgcn_mfma_f32_16x16x32_bf16(__builtin_bit_cast(bf16x8, vw), pf, oacc[et], 0, 0, 0); }
        }
#pragma unroll
        for (int et = 0; et < 4; ++et) { v2u w; w.x = pk2(oacc[et][0] * inv, oacc[et][1] * inv); w.y = pk2(oacc[et][2] * inv, oacc[et][3] * inv);
            *(v2u*)(ao + (size_t)tokq * 512 + head * 64 + 16 * et + 4 * quad) = w; }
    }
    __syncthreads();
}

constexpr int ML_Q = 0, ML_K = 17408, ML_KET = 34816, ML_VT = 53248, ML_CT = 73984, ML_CW = 113152, ML_CB = 118272, ML_RED = 118784, ML_NW = 119296, ML_GT = 119808;
DI float bfw(unsigned w, int hi) { return hi ? bfhi(w) : bflo(w); }
template <bool L3> DI void mlstm_unit(const Args& a, const Ctx& X, int l, int unit) {
    unsigned char* ws = a.ws; const bf16* proj = (const bf16*)(ws + WS_PROJ); bf16* hm = (bf16*)(ws + WS_H) + (size_t)T * 512;
    const float* gates = (const float*)(ws + WS_GATES); float* mlc = (float*)(ws + WS_MLC) + (size_t)unit * 18432; float* mlb = (float*)(ws + WS_MLB);
    const int seq = unit >> 5, sj = unit & 31, b = seq >> 2, hh = seq & 3; const int tokbase = b * SEQ + sj * 512;
    LAS bf16* Qs = (LAS bf16*)(X.lds + ML_Q); LAS bf16* Ks = (LAS bf16*)(X.lds + ML_K); LAS bf16* KET = (LAS bf16*)(X.lds + ML_KET);
    LAS bf16* VT = (LAS bf16*)(X.lds + ML_VT); LAS bf16* CT = (LAS bf16*)(X.lds + ML_CT); LAS float* CW = (LAS float*)(X.lds + ML_CW);
    LAS float* CB = (LAS float*)(X.lds + ML_CB); LAS float* RED = (LAS float*)(X.lds + ML_RED); LAS float* NW = (LAS float*)(X.lds + ML_NW);
    LAS float* GT = (LAS float*)(X.lds + ML_GT);
    int lane = X.lane; asm volatile("" : "+v"(lane));
    const int c16 = lane & 15, quad = lane >> 4, w = X.wave;
    int tidl = X.tid; asm volatile("" : "+v"(tidl));
    const int tg = tidl >> 5, cg = tidl & 31, t0 = 4 * tg, c0 = 4 * cg;
    v2u rq[7], rk[7], rv[4];
#define ML_LOADRAW(tokc) do { _Pragma("unroll") for (int j = 0; j < 7; ++j) { const int tt = (tokc) + t0 - 3 + j; const bool ok = tt >= b * SEQ; const bf16* rp = proj + (size_t)(ok ? tt : (tokc)) * NPROJ + hh * 128 + c0; \
        if (L3) { rq[j] = *(const v2u*)(rp + C_MQ); if (!ok) { rq[j].x = 0u; rq[j].y = 0u; } } rk[j] = *(const v2u*)(rp + C_MK); if (!ok) { rk[j].x = 0u; rk[j].y = 0u; } } \
        _Pragma("unroll") for (int i = 0; i < 4; ++i) rv[i] = *(const v2u*)(proj + (size_t)((tokc) + t0 + i) * NPROJ + C_MV + hh * 128 + c0); } while (0)
    ML_LOADRAW(tokbase);
    for (int idx = X.tid; idx < 1280; idx += 512) { const int tap = idx >> 8, ch = idx & 255; const int gch = (ch < 128) ? (hh * 128 + ch) : (512 + hh * 128 + (ch - 128));
        CW[idx] = (tap < 4) ? a.conv_w[(size_t)(l * 4 + tap) * 1024 + gch] : a.conv_b[l * 1024 + gch]; }
    for (int idx = X.tid; idx < 16 * 72; idx += 512) VT[128 * 72 + idx] = (idx < 72) ? (bf16)0x3F80 : (bf16)0;
    if (X.tid < 128) NW[X.tid] = a.mnw[l * 512 + hh * 128 + X.tid];
    { const float* gp = gates + (size_t)(tokbase + X.tid) * 8; GT[2 * X.tid] = gp[hh]; GT[2 * X.tid + 1] = gp[4 + hh]; }
    f32x4 cacc[9];
#pragma unroll
    for (int et = 0; et < 9; ++et) {
        if (L3) {
#pragma unroll
            for (int j = 0; j < 4; ++j) { const float v = mlc[(16 * et + 4 * quad + j) * 128 + 16 * w + c16]; cacc[et][j] = v; CT[(16 * et + 4 * quad + j) * 136 + 16 * w + c16] = (bf16)f2bf(v); }
        } else cacc[et] = (f32x4){0.f, 0.f, 0.f, 0.f};
    }
    float bsum = 0.f;
    __syncthreads();
#pragma unroll 1
    for (int c = 0; c < 8; ++c) {
        const int tok0 = tokbase + c * 64;
        const f32x2 gl = *(const LAS f32x2*)(GT + 2 * (c * 64 + lane)); float bsc = gl.y; const float li = gl.x;
#pragma unroll
        for (int o = 1; o < 64; o <<= 1) { const float v = __shfl_up(bsc, o); if (lane >= o) bsc += v; }
        const float bl = __shfl(bsc, 63); const float csv = li - bsc;
        if (w == 0) { CB[lane] = bsc; CB[64 + lane] = csv; }
        bsum += bl;
        const int tt_ = w & 3, eh = w >> 2; const int tq = 16 * tt_ + c16;
        v2u ogv[4];
        if (L3) {
#pragma unroll
            for (int x = 0; x < 4; ++x) ogv[x] = *(const v2u*)(proj + (size_t)(tok0 + tq) * NPROJ + C_MO + hh * 128 + 16 * (4 * eh + x) + 4 * quad); }
        { float fac[4];
#pragma unroll
          for (int i = 0; i < 4; ++i) fac[i] = __expf(bl + __shfl(csv, t0 + i));
#pragma unroll
          for (int qk = (L3 ? 0 : 1); qk < 2; ++qk) {
              float o[4][4];
              const f32x4 bias = *(const LAS f32x4*)(CW + 4 * 256 + qk * 128 + c0);
#pragma unroll
              for (int i = 0; i < 4; ++i) { o[i][0] = bias.x; o[i][1] = bias.y; o[i][2] = bias.z; o[i][3] = bias.w; }
#pragma unroll
              for (int j = 0; j < 4; ++j) { const f32x4 wj = *(const LAS f32x4*)(CW + j * 256 + qk * 128 + c0);
#pragma unroll
                  for (int i = 0; i < 4; ++i) { const v2u rr = qk ? rk[i + j] : rq[i + j];
                      o[i][0] += wj.x * bflo(rr.x); o[i][1] += wj.y * bfhi(rr.x); o[i][2] += wj.z * bflo(rr.y); o[i][3] += wj.w * bfhi(rr.y); } }
#pragma unroll
              for (int i = 0; i < 4; ++i)
#pragma unroll
                  for (int ch = 0; ch < 4; ++ch) { const float z = o[i][ch]; o[i][ch] = z * __builtin_amdgcn_rcpf(1.0f + __expf(-z)) * (qk ? 0.08838834764831845f : 1.0f); }
              if (L3) { LAS bf16* dst = (qk ? Ks : Qs) + t0 * 136 + c0;
#pragma unroll
                  for (int i = 0; i < 4; ++i) { v2u pw; pw.x = pk2(o[i][0], o[i][1]); pw.y = pk2(o[i][2], o[i][3]); *(LAS v2u*)(dst + i * 136) = pw; } }
              if (qk) {
#pragma unroll
                  for (int ch = 0; ch < 4; ++ch) { v2u pw; pw.x = pk2(o[0][ch] * fac[0], o[1][ch] * fac[1]); pw.y = pk2(o[2][ch] * fac[2], o[3][ch] * fac[3]); *(LAS v2u*)(KET + (c0 + ch) * 72 + t0) = pw; } }
          }
          { v2u p0, p1, p2, p3;
            p0.x = (rv[0].x & 0xffffu) | (rv[1].x << 16); p0.y = (rv[2].x & 0xffffu) | (rv[3].x << 16);
            p1.x = (rv[0].x >> 16) | (rv[1].x & 0xffff0000u); p1.y = (rv[2].x >> 16) | (rv[3].x & 0xffff0000u);
            p2.x = (rv[0].y & 0xffffu) | (rv[1].y << 16); p2.y = (rv[2].y & 0xffffu) | (rv[3].y << 16);
            p3.x = (rv[0].y >> 16) | (rv[1].y & 0xffff0000u); p3.y = (rv[2].y >> 16) | (rv[3].y & 0xffff0000u);
            *(LAS v2u*)(VT + (c0 + 0) * 72 + t0) = p0; *(LAS v2u*)(VT + (c0 + 1) * 72 + t0) = p1; *(LAS v2u*)(VT + (c0 + 2) * 72 + t0) = p2; *(LAS v2u*)(VT + (c0 + 3) * 72 + t0) = p3; }
        }
        __syncthreads();
        if (c < 7) { ML_LOADRAW(tok0 + 64); }
        float hval[4][4];
        if (L3) {
            bf16x8 qf[4];
#pragma unroll
            for (int ks = 0; ks < 4; ++ks) qf[ks] = *(const LAS bf16x8*)(Qs + tq * 136 + 32 * ks + 8 * quad);
            f32x4 sacc[4];
#pragma unroll
            for (int st = 0; st < 4; ++st) { f32x4 z = {0.f, 0.f, 0.f, 0.f};
#pragma unroll
                for (int ks = 0; ks < 4; ++ks) z = __builtin_amdgcn_mfma_f32_16x16x32_bf16(*(const LAS bf16x8*)(Ks + (16 * st + c16) * 136 + 32 * ks + 8 * quad), qf[ks], z, 0, 0, 0);
                sacc[st] = z; }
            const float cbt = CB[tq];
#pragma unroll
            for (int st = 0; st < 4; ++st)
#pragma unroll
                for (int j = 0; j < 4; ++j) { const int s = 16 * st + 4 * quad + j; const float d = (s <= tq) ? __expf(cbt + CB[64 + s]) : 0.f; sacc[st][j] *= d; }
            bf16x8 pf[2];
#pragma unroll
            for (int kk = 0; kk < 2; ++kk) { v4u pw; pw.x = pk2(sacc[2 * kk][0], sacc[2 * kk][1]); pw.y = pk2(sacc[2 * kk][2], sacc[2 * kk][3]); pw.z = pk2(sacc[2 * kk + 1][0], sacc[2 * kk + 1][1]); pw.w = pk2(sacc[2 * kk + 1][2], sacc[2 * kk + 1][3]); pf[kk] = __builtin_bit_cast(bf16x8, pw); }
            const float ebt = __expf(cbt);
            f32x4 nn[5];
#pragma unroll
            for (int x = 0; x < 5; ++x) { const int et = (x < 4) ? (4 * eh + x) : 8; f32x4 na = {0.f, 0.f, 0.f, 0.f}, ia = {0.f, 0.f, 0.f, 0.f};
#pragma unroll
                for (int kk = 0; kk < 2; ++kk) { const LAS bf16* vr = VT + (16 * et + c16) * 72 + 32 * kk + 4 * quad; const v2u lo = *(const LAS v2u*)vr, hi = *(const LAS v2u*)(vr + 16); v4u vw; vw.x = lo.x; vw.y = lo.y; vw.z = hi.x; vw.w = hi.y;
                    na = __builtin_amdgcn_mfma_f32_16x16x32_bf16(__builtin_bit_cast(bf16x8, vw), pf[kk], na, 0, 0, 0); }
#pragma unroll
                for (int ks = 0; ks < 4; ++ks) ia = __builtin_amdgcn_mfma_f32_16x16x32_bf16(*(const LAS bf16x8*)(CT + (16 * et + c16) * 136 + 32 * ks + 8 * quad), qf[ks], ia, 0, 0, 0);
                nn[x] = na + ia * ebt; }
            const float den = __shfl(nn[4][0], c16); const float inv = 1.0f / fmaxf(fabsf(den), 1.0f);
            float ss = 0.f;
#pragma unroll
            for (int x = 0; x < 4; ++x)
#pragma unroll
                for (int j = 0; j < 4; ++j) { hval[x][j] = nn[x][j] * inv; ss += hval[x][j] * hval[x][j]; }
            ss += __shfl_xor(ss, 16); ss += __shfl_xor(ss, 32);
            if (quad == 0) RED[eh * 64 + tq] = ss;
            __syncthreads();
            const float rstd = __builtin_amdgcn_rsqf((RED[tq] + RED[64 + tq]) * (1.0f / 128.0f) + EPS);
#pragma unroll
            for (int x = 0; x < 4; ++x) { const int e = 16 * (4 * eh + x) + 4 * quad; const v2u og = ogv[x];
                const float y0 = hval[x][0] * rstd * NW[e] * bflo(og.x), y1 = hval[x][1] * rstd * NW[e + 1] * bfhi(og.x), y2 = hval[x][2] * rstd * NW[e + 2] * bflo(og.y), y3 = hval[x][3] * rstd * NW[e + 3] * bfhi(og.y);
                v2u o; o.x = pk2(y0, y1); o.y = pk2(y2, y3); *(v2u*)(hm + (size_t)(tok0 + tq) * 512 + hh * 128 + e) = o; }
        }
        { const float ebl = __expf(bl);
          bf16x8 kf[2];
#pragma unroll
          for (int kk = 0; kk < 2; ++kk) kf[kk] = *(const LAS bf16x8*)(KET + (16 * w + c16) * 72 + 32 * kk + 8 * quad);
#pragma unroll
          for (int et = 0; et < 9; ++et) { f32x4 z = cacc[et] * ebl;
#pragma unroll
              for (int kk = 0; kk < 2; ++kk) z = __builtin_amdgcn_mfma_f32_16x16x32_bf16(*(const LAS bf16x8*)(VT + (16 * et + c16) * 72 + 32 * kk + 8 * quad), kf[kk], z, 0, 0, 0);
              cacc[et] = z;
              if (L3) {
#pragma unroll
                  for (int j = 0; j < 4; ++j) CT[(16 * et + 4 * quad + j) * 136 + 16 * w + c16] = (bf16)f2bf(z[j]); } } }
        __syncthreads();
    }
#undef ML_LOADRAW
    if (!L3) {
#pragma unroll
        for (int et = 0; et < 9; ++et)
#pragma unroll
            for (int j = 0; j < 4; ++j) mlc[(16 * et + 4 * quad + j) * 128 + 16 * w + c16] = cacc[et][j];
        if (X.tid == 0) mlb[unit] = bsum;
    }
}
DI void mlstm_scan(const Args& a, const Ctx& X) {
    float* mlc = (float*)(a.ws + WS_MLC); const float* mlb = (const float*)(a.ws + WS_MLB);
    for (int idx = X.bid * 512 + X.tid; idx < 8 * 18432; idx += X.G * 512) { const int seq = idx / 18432, el = idx - seq * 18432; float carry = 0.f;
        float* p0 = mlc + (size_t)seq * 32 * 18432 + el; float v[32], dcy[32];
#pragma unroll
        for (int j = 0; j < 32; ++j) { v[j] = p0[(size_t)j * 18432]; dcy[j] = mlb[seq * 32 + j]; }
#pragma unroll
        for (int j = 0; j < 32; ++j) { p0[(size_t)j * 18432] = carry; carry = __expf(dcy[j]) * carry + v[j]; } }
}

constexpr int P6_WR = 0, P6_AT = 33024, P6_SH = 37120, P6_LG = 41216, P6_HIST = 65536;
DI void p6_norm_route(const Args& a, const Ctx& X, int l, const float* xin) {
    unsigned char* ws = a.ws;
    LAS bf16* wrb = (LAS bf16*)(X.lds + P6_WR);
    LAS float* at = (LAS float*)(X.lds + P6_AT); LAS float* sht = (LAS float*)(X.lds + P6_SH);
    LAS float* lg = (LAS float*)(X.lds + P6_LG) + X.wave * 272;
    for (int idx = X.tid; idx < 16384; idx += 512) { const int k = idx >> 4, e = idx & 15; wrb[e * 1032 + k] = (bf16)f2bf(a.router_w[idx]); }
    const float* mod = (const float*)(ws + WS_MOD); unsigned char* hb = (unsigned char*)(ws + WS_H); float* tgate = (float*)(ws + WS_TGATE); int* tokl = (int*)(ws + WS_TOKL);
    const float* ssq = (const float*)(ws + WS_SSQ);
    unsigned* cnt = (unsigned*)(ws + WS_CTL) + CW_CNT + l * 2048;
    LAS int* hist = (LAS int*)(X.lds + P6_HIST); LAS int* cbase = hist + 32;
    int lane = X.lane; asm volatile("" : "+v"(lane));
    const int r = lane & 15, q = lane >> 4;
    const int gw = X.bid * 8 + X.wave, NGW = X.G * 8;
    for (int it = 0; it * NGW < T / 16; ++it) {
        const int rg = it * NGW + gw; const bool act = rg < T / 16;
        const int row0 = (act ? rg : 0) * 16; const int bb = ((it * NGW + X.bid * 8) * 16) >> 14;
        __syncthreads();
        if (X.tid < 32) hist[X.tid] = 0;
        { const float* mb = mod + (size_t)(l * 2 + (bb < 2 ? bb : 1)) * 6144;
          for (int k = X.tid; k < 1024; k += 512) { at[k] = a.nfw[l * D + k] * (1.0f + mb[4 * 1024 + k]); sht[k] = mb[3 * 1024 + k]; } }
        __syncthreads();
        const int row = row0 + r;
        float rstd;
        { const f32x4 pp = *(const f32x4*)(ssq + (size_t)row * 16 + 4 * q); float ss = (pp.x + pp.y) + (pp.z + pp.w); ss += __shfl_xor(ss, 16); ss += __shfl_xor(ss, 32); rstd = __builtin_amdgcn_rsqf(ss * (1.0f / D) + EPS); }
        const float* xr = xin + (size_t)row * D + 8 * q; unsigned char* hr = hb + (size_t)row * D + 8 * q;
        f32x4 acc = {0.f, 0.f, 0.f, 0.f};
#pragma unroll 8
        for (int s = 0; s < 32; ++s) {
            const f32x4 x0 = *(const f32x4*)(xr + 32 * s), x1 = *(const f32x4*)(xr + 32 * s + 4);
            const f32x4 a0 = *(const LAS f32x4*)(at + 32 * s + 8 * q), a1 = *(const LAS f32x4*)(at + 32 * s + 8 * q + 4);
            const f32x4 s0 = *(const LAS f32x4*)(sht + 32 * s + 8 * q), s1 = *(const LAS f32x4*)(sht + 32 * s + 8 * q + 4);
            const f32x4 h0 = x0 * rstd * a0 + s0, h1 = x1 * rstd * a1 + s1;
            v4u w; w.x = cvt_pk_bf16(h0.x, h0.y); w.y = cvt_pk_bf16(h0.z, h0.w); w.z = cvt_pk_bf16(h1.x, h1.y); w.w = cvt_pk_bf16(h1.z, h1.w);
            { v2u w8; w8.x = pk4_fp8(h0.x, h0.y, h0.z, h0.w); w8.y = pk4_fp8(h1.x, h1.y, h1.z, h1.w); *(v2u*)(hr + 32 * s) = w8; }
            const bf16x8 bfr = *(const LAS bf16x8*)(wrb + r * 1032 + 32 * s + 8 * q);
            acc = __builtin_amdgcn_mfma_f32_16x16x32_bf16(__builtin_bit_cast(bf16x8, w), bfr, acc, 0, 0, 0);
        }
#pragma unroll
        for (int j = 0; j < 4; ++j) lg[(4 * q + j) * 17 + r] = acc[j];
        LDS_WAIT(); asm volatile("" ::: "memory");
        int my_cls = 0; float my_ga = 0.f, my_gb = 0.f;
        if (lane < 16) {
            float sc[16], sel[16];
#pragma unroll
            for (int e = 0; e < 16; ++e) { const float p = lg[lane * 17 + e]; sc[e] = 1.0f / (1.0f + __expf(-p)); sel[e] = sc[e] + a.router_b[e]; }
            int gi = 0; float gbest = -1.0e30f;
#pragma unroll
            for (int g = 0; g < 4; ++g) { const float p0 = sel[4 * g], p1 = sel[4 * g + 1], p2 = sel[4 * g + 2], p3 = sel[4 * g + 3];
                const float gs = fmaxf(fmaxf(fmaxf(p0 + p1, p0 + p2), fmaxf(p0 + p3, p1 + p2)), fmaxf(p1 + p3, p2 + p3));
                if (gs > gbest) { gbest = gs; gi = g; } }
            float qs[4], s4[4];
#pragma unroll
            for (int i = 0; i < 4; ++i) { qs[i] = 0.f; s4[i] = 0.f; }
#pragma unroll
            for (int g = 0; g < 4; ++g) if (g == gi) {
#pragma unroll
                for (int i = 0; i < 4; ++i) { qs[i] = sel[4 * g + i]; s4[i] = sc[4 * g + i]; } }
            int i1 = 0; float b1 = qs[0];
#pragma unroll
            for (int i = 1; i < 4; ++i) if (qs[i] > b1) { b1 = qs[i]; i1 = i; }
            int i2 = -1; float b2 = -1.0e30f;
#pragma unroll
            for (int i = 0; i < 4; ++i) if (i != i1 && qs[i] > b2) { b2 = qs[i]; i2 = i; }
            const int ia = (i1 < i2) ? i1 : i2, ib = (i1 < i2) ? i2 : i1;
            float sa = 0.f, sb = 0.f;
#pragma unroll
            for (int i = 0; i < 4; ++i) { if (i == ia) sa = s4[i]; if (i == ib) sb = s4[i]; }
            const int pidx = (ia == 0) ? (ib - 1) : ((ia == 1) ? (ib + 1) : 5);
            const float inv = 1.0f / (sa + sb);
            my_cls = gi * 6 + pidx; my_ga = sa * inv; my_gb = sb * inv;
        }
        int rank = 0;
        if (act && lane < 16) rank = __hip_atomic_fetch_add(hist + my_cls, 1, __ATOMIC_RELAXED, __HIP_MEMORY_SCOPE_WORKGROUP);
        __syncthreads();
        if (X.tid < NCLS) { const int n = hist[X.tid]; cbase[X.tid] = n ? (int)__hip_atomic_fetch_add(cnt + 64 * X.tid, (unsigned)n, RLX_AGENT) : 0; }
        __syncthreads();
        if (act && lane < 16) { const int tok = row0 + lane; const int pos = cbase[my_cls] + rank;
            tokl[my_cls * CLS_CAP + pos] = tok; tgate[tok * 2] = my_ga; tgate[tok * 2 + 1] = my_gb; }
    }
}
DI MoeTab moe_tables(const Args& a, const Ctx& X, int l) {
    LAS int* tab = (LAS int*)(X.lds + TAB_OFF); LAS int* tcls = tab; LAS int* tpos = tab + 160; LAS int* cn = tab + 320; LAS int* rt_ = tab + 344;
    unsigned* cnt = (unsigned*)(a.ws + WS_CTL) + CW_CNT + l * 2048;
    if (X.tid < NCLS) cn[X.tid] = (int)__hip_atomic_load(cnt + 64 * X.tid, RLX_AGENT);
    __syncthreads();
    if (X.tid == 0) { int r = 0;
#pragma unroll 1
        for (int c = 0; c < NCLS; ++c) { const int n = (cn[c] + 255) >> 8;
#pragma unroll 1
            for (int i = 0; i < n; ++i) { tcls[r] = c; tpos[r] = i * 256; ++r; } }
        rt_[0] = r; }
    __syncthreads();
    MoeTab tb; tb.tcls = tcls; tb.tpos = tpos; tb.cnt = cn; tb.Rtot = __builtin_amdgcn_readfirstlane(rt_[0]); return tb;
}

#if defined(__HIP_DEVICE_COMPILE__)
DI Args load_args() { auto p = __builtin_amdgcn_kernarg_segment_ptr(); asm volatile("" : "+s"(p)); return *(const __attribute__((address_space(4))) Args*)p; }
#else
DI Args load_args() { return Args{}; }
#endif
__global__ void __launch_bounds__(512, 2) fwd(Args a_unused) {
    extern __shared__ __attribute__((aligned(16))) unsigned char lds_raw[];
    Ctx X; X.lds = (LAS unsigned char*)lds_raw; X.tid = threadIdx.x; X.lane = X.tid & 63; X.wave = __builtin_amdgcn_readfirstlane(X.tid >> 6); X.G = gridDim.x; X.bid = blockIdx.x;
    volatile LAS unsigned* MISC = (volatile LAS unsigned*)(X.lds + MISC_OFF);
    if (X.tid < 64) MISC[X.tid] = 0u;
    __syncthreads();
    int lo, hi; unsigned* ctl;
    { const Args a = load_args(); lo = a.ph_lo; hi = a.ph_hi; ctl = (unsigned*)(a.ws + WS_CTL); }
    XcdBarrier bar; bar.bar = ctl + CW_BAR; bar.x = 0; bar.st = MISC + 8;
    if (hi - lo > 1) bar = xcd_barrier_post(ctl + CW_BAR, MISC + 8);
#ifndef PH_MASK
#define PH_MASK 0xFFFFF
#endif
#define PON(p) ((PH_MASK >> (p)) & 1)
#ifndef DUP_MASK
#define DUP_MASK 0
#endif
#define NREP(p) (((DUP_MASK >> (p)) & 1) ? 2 : 1)
#ifndef TSEL_MASK
#define TSEL_MASK 0
#endif
#define TSCALE 4
#define TSEL(p) ((TSEL_MASK >> (p)) & 1)
#define IN(k) (lo <= (k) && (k) < hi)
#define SEAM(k) do { if (IN(k) && IN((k) + 1)) xcd_barrier(bar); } while (0)
    unsigned long long tacc = 0ull, tph = 0ull;
#define TBEG() do { if (TSEL_MASK) tph = __builtin_amdgcn_s_memrealtime(); } while (0)
#define TEND(p) do { if (TSEL(p)) tacc += __builtin_amdgcn_s_memrealtime() - tph; } while (0)
    TBEG();
    if (PON(10) && IN(0)) { for (int rep = 0; rep < NREP(10); ++rep) { const Args a = load_args(); p0_prologue(a, X); } }
    SEAM(0); TEND(10);
    TBEG();
    for (int l = 0; l < NL; ++l) {
        const int g0 = 1 + l * NPH;
        if (PON(0) && IN(g0 + 0)) { for (int rep = 0; rep < NREP(0); ++rep) { const Args a = load_args(); unsigned char* ws = a.ws; const float* mod = (const float*)(ws + WS_MOD); bf16* proj = (bf16*)(ws + WS_PROJ); const float* xin = (l == 0) ? a.x : a.out; (void)mod; (void)proj; (void)xin; const Ctx P = fresh(X); p1_norm_gates(a, P, l, xin); } }
        SEAM(g0 + 0); TEND(0); TBEG();
        if (PON(1) && IN(g0 + 1)) for (int rep = 0; rep < NREP(1); ++rep) { const Args a = load_args(); unsigned char* ws = a.ws; const float* mod = (const float*)(ws + WS_MOD); bf16* proj = (bf16*)(ws + WS_PROJ); const float* xin = (l == 0) ? a.x : a.out; (void)mod; (void)proj; (void)xin; const Ctx P = fresh(X);
            DenseSched S; S.A = (const char*)(ws + WS_H); S.Bt = (const char*)(ws + WS_WIN) + (size_t)l * NPROJW * D; S.lda = D; S.ldb = D; S.ord.init(T / 256, NPROJW / 256, P.G, P.bid);
            EpiProj E; E.O = proj; E.gates = (float*)(ws + WS_GATES); E.big = a.b_ig + l * 4; E.bfg = a.b_fg + l * 4;
            pg8::gemm_phase<EpiProj, DenseSched, true>(P.lds, D, S, E);
        }
        SEAM(g0 + 1); TEND(1); TBEG();
        if (PON(2) && IN(g0 + 2)) { const Args a = load_args(); unsigned char* ws = a.ws; const float* mod = (const float*)(ws + WS_MOD); bf16* proj = (bf16*)(ws + WS_PROJ); const float* xin = (l == 0) ? a.x : a.out; (void)mod; (void)proj; (void)xin; const Ctx P = fresh(X);
            if (PON(11)) for (int rep = 0; rep < NREP(11); ++rep) {
#pragma unroll 1
                for (int u = P.bid; u < 512; u += P.G) attn_unit(a, P, l, u); }
            if (PON(12)) for (int rep = 0; rep < NREP(12); ++rep) {
#pragma unroll 1
                for (int u = P.bid; u < 256; u += P.G) mlstm_unit<false>(a, P, l, u); }
        }
        SEAM(g0 + 2); TEND(2); TBEG();
        if (PON(3) && IN(g0 + 3)) { const Args a = load_args(); unsigned char* ws = a.ws; const float* mod = (const float*)(ws + WS_MOD); bf16* proj = (bf16*)(ws + WS_PROJ); const float* xin = (l == 0) ? a.x : a.out; (void)mod; (void)proj; (void)xin; const Ctx P = fresh(X); mlstm_scan(a, P); }
        SEAM(g0 + 3); TEND(3); TBEG();
        if (PON(4) && IN(g0 + 4)) for (int rep = 0; rep < NREP(4); ++rep) { const Args a = load_args(); unsigned char* ws = a.ws; const float* mod = (const float*)(ws + WS_MOD); bf16* proj = (bf16*)(ws + WS_PROJ); const float* xin = (l == 0) ? a.x : a.out; (void)mod; (void)proj; (void)xin; const Ctx P = fresh(X);
#pragma unroll 1
            for (int u = P.bid; u < 256; u += P.G) mlstm_unit<true>(a, P, l, u); }
        SEAM(g0 + 4); TEND(4); TBEG();
        if (PON(5) && IN(g0 + 5)) for (int rep = 0; rep < NREP(5); ++rep) { const Args a = load_args(); unsigned char* ws = a.ws; const float* mod = (const float*)(ws + WS_MOD); bf16* proj = (bf16*)(ws + WS_PROJ); const float* xin = (l == 0) ? a.x : a.out; (void)mod; (void)proj; (void)xin; const Ctx P = fresh(X);
            { DenseSched S; S.A = (const char*)(ws + WS_H); S.Bt = (const char*)(ws + WS_WAU) + (size_t)l * D * 512 * 2; S.lda = 1024; S.ldb = 1024; S.ord.init(T / 256, D / 256, P.G, P.bid);
              EpiGate<false> E; E.P = proj; E.gcol = C_GA; pg8::gemm_phase<EpiGate<false>, DenseSched>(P.lds, 1024, S, E); }
            { DenseSched S; S.A = (const char*)(ws + WS_H) + (size_t)T * 512 * 2; S.Bt = (const char*)(ws + WS_WMU) + (size_t)l * D * 512 * 2; S.lda = 1024; S.ldb = 1024; S.ord.init(T / 256, D / 256, P.G, P.bid);
              EpiGate<true> E; E.P = proj; E.gcol = C_GB; pg8::gemm_phase<EpiGate<true>, DenseSched>(P.lds, 1024, S, E); }
        }
        SEAM(g0 + 5); TEND(5); TBEG();
        if (PON(6) && IN(g0 + 6)) for (int rep = 0; rep < NREP(6); ++rep) { const Args a = load_args(); unsigned char* ws = a.ws; const float* mod = (const float*)(ws + WS_MOD); bf16* proj = (bf16*)(ws + WS_PROJ); const float* xin = (l == 0) ? a.x : a.out; (void)mod; (void)proj; (void)xin; const Ctx P = fresh(X);
            DenseSched S; S.A = (const char*)(proj + C_MQ); S.Bt = (const char*)(ws + WS_WOUT) + (size_t)l * D * D * 2; S.lda = NPROJ * 2; S.ldb = D * 2; S.ord.init(T / 256, D / 256, P.G, P.bid);
            EpiRes E; E.xin = xin; E.out = a.out; E.g = mod + (size_t)(l * 2) * 6144 + 2 * 1024; E.ssq = (float*)(ws + WS_SSQ); E.rmask = T - 1;
            if (rep) { E.out = (float*)(ws + WS_H); E.rmask = T / 2 - 1; }
            pg8::gemm_phase<EpiRes, DenseSched>(P.lds, D * 2, S, E);
        }
        SEAM(g0 + 6); TEND(6); TBEG();
        if (PON(7) && IN(g0 + 7)) { const Args a = load_args(); unsigned char* ws = a.ws; const float* mod = (const float*)(ws + WS_MOD); bf16* proj = (bf16*)(ws + WS_PROJ); const float* xin = (l == 0) ? a.x : a.out; (void)mod; (void)proj; (void)xin; const Ctx P = fresh(X); p6_norm_route(a, P, l, a.out); }
        SEAM(g0 + 7); TEND(7); TBEG();
        if (PON(8) && IN(g0 + 8)) for (int rep = 0; rep < NREP(8); ++rep) { const Args a = load_args(); unsigned char* ws = a.ws; const float* mod = (const float*)(ws + WS_MOD); bf16* proj = (bf16*)(ws + WS_PROJ); const float* xin = (l == 0) ? a.x : a.out; (void)mod; (void)proj; (void)xin; const Ctx P = fresh(X);
            const MoeTab tb = moe_tables(a, P, l);
            LAS unsigned* tokoff = (LAS unsigned*)(P.lds + TOKOFF_OFF); const int* tokl = (const int*)(ws + WS_TOKL);
#pragma unroll 1
            for (int s = 0; s < 8; ++s) { const int L0 = s * P.G + P.bid;
                if (L0 < tb.Rtot * 8 && P.tid < 256) { const int L = xcd_remap(L0, tb.Rtot * 8); const int rt = L >> 3, cls = tb.tcls[rt], pos = tb.tpos[rt] + P.tid, cn = tb.cnt[cls]; const int tok = tokl[cls * CLS_CAP + (pos < cn ? pos : 0)]; tokoff[s * 256 + P.tid] = (unsigned)tok; } }
            __syncthreads();
            MoeUpSched S; S.A = (const char*)(ws + WS_H); S.W = (const char*)(ws + WS_WGU) + (size_t)l * NE * 1024 * D; S.lda = D; S.ldb = D; S.tb = tb; S.G = P.G; S.c = P.bid; S.tokoff = tokoff;
            EpiSwiglu E; E.H = proj; E.tgate = (const float*)(ws + WS_TGATE); E.tokoff = tokoff;
            pg8::gemm_phase<EpiSwiglu, MoeUpSched, true>(P.lds, D, S, E);
        }
        SEAM(g0 + 8); TEND(8); TBEG();
        if (PON(9) && IN(g0 + 9)) for (int rep = 0; rep < NREP(9); ++rep) { const Args a = load_args(); unsigned char* ws = a.ws; const float* mod = (const float*)(ws + WS_MOD); bf16* proj = (bf16*)(ws + WS_PROJ); const float* xin = (l == 0) ? a.x : a.out; (void)mod; (void)proj; (void)xin; const Ctx P = fresh(X);
            const MoeTab tb = moe_tables(a, P, l);
            MoeDownSched S; S.A = (const char*)proj; S.W = (const char*)(ws + WS_WD) + (size_t)l * NE * 1024 * FF * 2; S.lda = D * 2; S.ldb = FF * 2; S.tb = tb; S.G = P.G; S.c = P.bid;
            EpiMoeOut E; E.xin = a.out; E.out = a.out; E.g = mod + (size_t)(l * 2) * 6144 + 5 * 1024; E.tokl = (const int*)(ws + WS_TOKL); E.tb = tb; E.rmask = T - 1;
            if (rep) { E.out = (float*)(ws + WS_H); E.rmask = T / 2 - 1; }
            pg8::gemm_phase<EpiMoeOut, MoeDownSched>(P.lds, D * 2, S, E);
        }
        SEAM(g0 + 9); TEND(9); TBEG();
    }
    if (TSEL_MASK && X.bid == 0) { const unsigned long long t1 = __builtin_amdgcn_s_memrealtime(); while (__builtin_amdgcn_s_memrealtime() - t1 < TSCALE * tacc) __builtin_amdgcn_s_sleep(8); }
#undef IN
#undef SEAM
}

extern "C" void kernel_launch(void* const* d_in, const int* in_sizes, int n_in, void* d_out, int out_size, void* d_ws, size_t ws_size, hipStream_t stream) {
    static int grid = 0;
    if (grid == 0) {
        if (n_in != 24 || in_sizes[0] != T * D || out_size != T * D || ws_size < WS_END) { fprintf(stderr, "kernel_launch: unexpected shapes / workspace (n_in %d, ws %zu, need %zu)\n", n_in, ws_size, (size_t)WS_END); grid = -1; return; }
        int dev = 0, cus = 0;
        if (hipGetDevice(&dev) != hipSuccess || hipDeviceGetAttribute(&cus, hipDeviceAttributeMultiprocessorCount, dev) != hipSuccess) { grid = -1; return; }
        if (hipFuncSetAttribute((const void*)fwd, hipFuncAttributeMaxDynamicSharedMemorySize, LDS_BYTES) != hipSuccess) { fprintf(stderr, "kernel_launch: hipFuncSetAttribute failed\n"); grid = -1; return; }
        int per_cu = 0;
        if (hipOccupancyMaxActiveBlocksPerMultiprocessor(&per_cu, (const void*)fwd, 512, LDS_BYTES) != hipSuccess || per_cu < 1) fprintf(stderr, "kernel_launch: occupancy query reports %d\n", per_cu);
        (void)hipGetLastError();
        grid = cus < 256 ? cus : 256;
    }
    if (grid < 0) return;
    (void)hipMemsetAsync((char*)d_ws + WS_CTL, 0, CTL_ZERO_BYTES, stream);
    Args a{};
    a.x = (const float*)d_in[0]; a.c = (const float*)d_in[1]; a.pos = (const int*)d_in[2]; a.ada_w = (const float*)d_in[3]; a.ada_b = (const float*)d_in[4];
    a.nmw = (const float*)d_in[5]; a.nfw = (const float*)d_in[6]; a.w_in = (const float*)d_in[7]; a.b_ig = (const float*)d_in[8]; a.b_fg = (const float*)d_in[9];
    a.qnw = (const float*)d_in[10]; a.knw = (const float*)d_in[11]; a.sinks = (const float*)d_in[12]; a.conv_w = (const float*)d_in[13]; a.conv_b = (const float*)d_in[14];
    a.mnw = (const float*)d_in[15]; a.w_au = (const float*)d_in[16]; a.w_mu = (const float*)d_in[17]; a.w_out = (const float*)d_in[18]; a.router_w = (const float*)d_in[19];
    a.router_b = (const float*)d_in[20]; a.w_gate = (const float*)d_in[21]; a.w_up = (const float*)d_in[22]; a.w_down = (const float*)d_in[23];
    a.out = (float*)d_out; a.ws = (unsigned char*)d_ws;
#if MK_MULTI
    for (int gp = 0; gp < NGP; ++gp) { a.ph_lo = gp; a.ph_hi = gp + 1; hipLaunchKernelGGL(fwd, dim3(grid), dim3(512), LDS_BYTES, stream, a); }
#else
    a.ph_lo = 0; a.ph_hi = NGP; hipLaunchKernelGGL(fwd, dim3(grid), dim3(512), LDS_BYTES, stream, a);
#endif
}
```

```cpp
#include <hip/hip_runtime.h>
#include <cstdio>
#include <cstdint>

#ifndef MK_MULTI
#define MK_MULTI 0
#endif

#define GAS __attribute__((address_space(1)))
#define LAS __attribute__((address_space(3)))
typedef unsigned short bf16;
typedef unsigned v4u __attribute__((ext_vector_type(4)));
typedef unsigned v2u __attribute__((ext_vector_type(2)));
typedef float f32x4 __attribute__((ext_vector_type(4)));
typedef float f32x2 __attribute__((ext_vector_type(2)));
typedef short bf16x8 __attribute__((ext_vector_type(8)));
typedef short bf16x4 __attribute__((ext_vector_type(4)));
#define DI __device__ __forceinline__
#define RLX_AGENT __ATOMIC_RELAXED, __HIP_MEMORY_SCOPE_AGENT
#define LDS_WAIT() asm volatile("s_waitcnt lgkmcnt(0)" ::: "memory")
#define VM_WAIT() asm volatile("s_waitcnt vmcnt(0)" ::: "memory")

constexpr int NB = 2, SEQ = 16384, T = NB * SEQ, D = 1024, NL = 4;
constexpr int DIN_SRC = 4872;
constexpr int NPROJ = 4864;
constexpr int C_AQ = 0, C_AK = 512, C_AV = 640, C_MQ = 768, C_MK = 1280, C_MV = 1792, C_MO = 2304, C_GA = 2816, C_GB = 3840;
constexpr int NE = 16, FF = 512;
constexpr int NCLS = 24, CLS_CAP = 32768;
constexpr float EPS = 1e-6f;
constexpr int NPH = 10;
constexpr int NGP = 1 + NL * NPH;

constexpr size_t MiB = 1u << 20;
constexpr size_t WS_CTL = 0, CTL_ZERO_BYTES = 1 * MiB;
constexpr size_t WS_MOD = 1 * MiB;
constexpr size_t WS_ROPE = 2 * MiB;
constexpr size_t WS_GATES = 4 * MiB;
constexpr size_t WS_TGATE = 5 * MiB;
constexpr size_t WS_TOKL = 6 * MiB;
constexpr size_t WS_MLB = 9 * MiB;
constexpr size_t WS_MLC = 10 * MiB;
constexpr int NPROJW = 5120;
constexpr size_t WS_WIN = 28 * MiB;
constexpr size_t WS_WAU = 68 * MiB;
constexpr size_t WS_WMU = 72 * MiB;
constexpr size_t WS_WOUT = 76 * MiB;
constexpr size_t WS_WGU = 84 * MiB;
constexpr size_t WS_WD = 212 * MiB;
constexpr size_t WS_H = 276 * MiB;
constexpr size_t WS_PROJ = 340 * MiB;
constexpr size_t WS_SSQ = 644 * MiB;
constexpr size_t WS_KC = 646 * MiB;
constexpr size_t WS_END = 678 * MiB;

constexpr int CW_TMO = 0;
constexpr int CW_BAR = 4096;
constexpr int CW_CNT = 8192;

constexpr int RING_BYTES = 131072;
constexpr int MISC_OFF = RING_BYTES;
constexpr int TAB_OFF = RING_BYTES + 256;
constexpr int TOKOFF_OFF = RING_BYTES + 2048;
constexpr int LDS_BYTES = 147456;

DI unsigned f2bf(float f) { unsigned u = __builtin_bit_cast(unsigned, f); return (u + 0x7fffu + ((u >> 16) & 1u)) >> 16; }
DI unsigned pk2(float lo, float hi) { return f2bf(lo) | (f2bf(hi) << 16); }
DI float bf2f(unsigned short b) { return __builtin_bit_cast(float, ((unsigned)b) << 16); }
DI float bflo(unsigned w) { return __builtin_bit_cast(float, w << 16); }
DI float bfhi(unsigned w) { return __builtin_bit_cast(float, w & 0xffff0000u); }
DI float wave_sum(float v) {
#pragma unroll
    for (int o = 1; o < 64; o <<= 1) v += __shfl_xor(v, o);
    return v;
}
DI float sigmoidf_(float x) { return __builtin_amdgcn_rcpf(1.0f + __expf(-x)); }

#define XB_TMO      128
#define XB_XCNT(j)  (256  + 64 * (j))
#define XB_XSUB(j)  (1280 + 64 * (j))
#define XB_XGEN(j)  (2304 + 64 * (j))
#define XB_TOP      3328
#define XB_TOPGEN   3392
#define XCD_BAR_WORDS 3456
#define XB_SPIN_CAP (1u << 18)
__device__ __forceinline__ unsigned xb_ld(unsigned* p)              { return __hip_atomic_load(p, __ATOMIC_RELAXED, __HIP_MEMORY_SCOPE_AGENT); }
__device__ __forceinline__ unsigned xb_add(unsigned* p, unsigned v) { return __hip_atomic_fetch_add(p, v, __ATOMIC_RELAXED, __HIP_MEMORY_SCOPE_AGENT); }
__device__ __forceinline__ unsigned xb_xcc_id() { return (unsigned)__builtin_amdgcn_s_getreg((3 << 11) | 20) & 0xFu; }
#define XB_SPIN(cond, bar) do { unsigned _sp = 0; while (cond) { __builtin_amdgcn_s_sleep(1); \
    if ((++_sp & 255u) == 0u) { if (xb_ld(&(bar)[XB_TMO])) break; if (_sp > XB_SPIN_CAP) { atomicAdd(&(bar)[XB_TMO], 1u); break; } } } } while (0)
struct XcdBarrier { unsigned* bar; unsigned x; volatile LAS unsigned* st; };
__device__ __forceinline__ XcdBarrier xcd_barrier_post(unsigned* bar, volatile LAS unsigned* st) {
    XcdBarrier b; b.bar = bar; b.x = xb_xcc_id(); b.st = st;
    if (threadIdx.x == 0) (void)xb_add(&bar[XB_XCNT(b.x)], 1u);
    return b;
}
__device__ __forceinline__ void xcd_barrier_complete(unsigned* bar, unsigned x, unsigned& nloc, unsigned& nx) {
    const unsigned G = gridDim.x * gridDim.y * gridDim.z;
    unsigned sum, cnt, mine, sp = 0u;
    for (;;) {
        sum = 0u; cnt = 0u; mine = 0u;
#pragma unroll
        for (unsigned j = 0; j < 16; ++j) { const unsigned c = xb_ld(&bar[XB_XCNT(j)]); sum += c; cnt += (c > 0u) ? 1u : 0u; mine = (j == x) ? c : mine; }
        if (sum == G) break;
        __builtin_amdgcn_s_sleep(1);
        if ((++sp & 255u) == 0u) { if (xb_ld(&bar[XB_TMO])) break; if (sp > XB_SPIN_CAP) { atomicAdd(&bar[XB_TMO], 1u); break; } }
    }
    nloc = mine > 0u ? mine : 1u; nx = cnt > 0u ? cnt : 1u;
}
__device__ __forceinline__ void xcd_barrier(const XcdBarrier& b) {
    asm volatile("s_waitcnt vmcnt(0)" ::: "memory");
    __syncthreads();
    if (threadIdx.x == 0) {
        unsigned* bar = b.bar;
        __builtin_amdgcn_s_waitcnt(0);
        unsigned nloc = b.st[0], nx = b.st[1];
        if (nloc == 0u) { xcd_barrier_complete(bar, b.x, nloc, nx); b.st[0] = nloc; b.st[1] = nx; }
        const unsigned old = xb_add(&bar[XB_XSUB(b.x)], 1u);
        const unsigned gen = old / nloc;
        if (old + 1u == (gen + 1u) * nloc) {
            __builtin_amdgcn_fence(__ATOMIC_RELEASE, "agent");
            asm volatile("s_waitcnt vmcnt(0)" ::: "memory");
            const unsigned og = xb_add(&bar[XB_TOP], 1u);
            const unsigned tg = og / nx;
            if (og + 1u == (tg + 1u) * nx) xb_add(&bar[XB_TOPGEN], 1u);
            else XB_SPIN(xb_ld(&bar[XB_TOPGEN]) == tg, bar);
            __builtin_amdgcn_fence(__ATOMIC_ACQUIRE, "agent");
            xb_add(&bar[XB_XGEN(b.x)], 1u);
            asm volatile("s_waitcnt vmcnt(0)" ::: "memory");
        } else {
            XB_SPIN(xb_ld(&bar[XB_XGEN(b.x)]) == gen, bar);
            __builtin_amdgcn_fence(__ATOMIC_ACQUIRE, "agent");
            asm volatile("s_waitcnt vmcnt(0)" ::: "memory");
        }
    }
    __syncthreads();
}

namespace pg8 {
constexpr int BM = 256, BK = 64, HALF = 128, HTB = HALF * BK * 2, STAGE_BYTES = 8 * HTB, NXCD = 8, WGM = 8;
__host__ __device__ __forceinline__ int lds_byte(int r, int c) { const int st = (r >> 4) * 2 + (c >> 5), rr = r & 15, cc = c & 31, ob = rr * 64 + cc * 2; return st * 1024 + (ob ^ (((ob >> 9) & 1) << 5)); }
__host__ __device__ __forceinline__ void stage_rc(int b, int& R, int& C) { const int st = b / 1024, sb = b % 1024, swz = sb ^ (((sb >> 9) & 1) << 5); R = (st >> 1) * 16 + swz / 64; C = (st & 1) * 32 + (swz % 64) / 2; }
__host__ __device__ __forceinline__ int perm32(int rho) { const int n = rho >> 4, i = rho & 15; return 8 * (i >> 2) + 4 * n + (i & 3); }

struct Unit { int pm, pn, x0, x1; };

struct TileOrder {
    int nM, nN, nwg, G, c;
    __device__ void init(int nM_, int nN_, int G_, int c_) { nM = nM_; nN = nN_; nwg = nM * nN; G = G_; c = c_; }
    __device__ bool get(int i, int& pm, int& pn) const {
        const long L = (long)i * G + c; if (L >= nwg) return false;
        int wgid = (int)L; { const int q = nwg / NXCD, r = nwg % NXCD, xcd = wgid % NXCD, off = wgid / NXCD; wgid = (xcd < r ? xcd * (q + 1) : r * (q + 1) + (xcd - r) * q) + off; }
        const int nig = WGM * nN, gid = wgid / nig, fm = gid * WGM, gsz = (nM - fm) < WGM ? (nM - fm) : WGM;
        pm = fm + ((wgid % nig) % gsz); pn = (wgid % nig) / gsz; return true;
    }
};

typedef int v8i __attribute__((ext_vector_type(8)));
template <class Epi, class Sched, bool F8 = false>
__device__ __forceinline__ void gemm_phase(LAS unsigned char* lds, const int Kb, const Sched& S, const Epi& E) {
    int tid = threadIdx.x; asm volatile("" : "+v"(tid));
    const int wid = __builtin_amdgcn_readfirstlane(tid >> 6), lane = tid & 63, wr = wid >> 2, wc = wid & 3, fr = lane & 15, fq = lane >> 4;
    const int nt = Kb / 128;
    constexpr bool GA = Sched::GATHER; constexpr int KS = Sched::KSPLIT;
    unsigned voffA[2], voffB[2]; int Rst[2], Cst[2];
#pragma unroll
    for (int i = 0; i < 2; ++i) { int R, C; stage_rc(tid * 16 + i * 8192, R, C); const int Rb = Epi::PERM ? ((R & ~31) + perm32(R & 31)) : R;
        voffA[i] = (unsigned)(R * S.lda + C * 2); voffB[i] = (unsigned)(Rb * S.ldb + C * 2); Rst[i] = R; Cst[i] = C; }
    const size_t kstep = (size_t)(BK * 2);
    const size_t hstepA = (size_t)HALF * S.lda, hstepB = (size_t)HALF * S.ldb;
    const unsigned ldsw = (unsigned)wid * 1024u; const unsigned gmul = (unsigned)S.lda;
    const int aoff = F8 ? (lds_byte(wr * 64 + fr, (fq & 1) * 16) + (fq >> 1) * 1024) : lds_byte(wr * 64 + fr, fq * 8);
    const int boff = F8 ? (lds_byte(wc * 32 + fr, (fq & 1) * 16) + (fq >> 1) * 1024) : lds_byte(wc * 32 + fr, fq * 8);
    unsigned vAc[2], vAn[2];
#define PG8_SA(b, h) (((b) * 2 + (h)) * HTB)
#define PG8_SB(b, h) ((4 + (b) * 2 + (h)) * HTB)
#define PG8_STAGE2(bufoff, gbase, v0, v1) do { \
        __builtin_amdgcn_global_load_lds((const unsigned*)((const char*)(gbase) + (v0)), (LAS unsigned*)(lds + (bufoff) + ldsw), 16, 0, 0); \
        __builtin_amdgcn_global_load_lds((const unsigned*)((const char*)(gbase) + (v1)), (LAS unsigned*)(lds + (bufoff) + ldsw + 8192), 16, 0, 0); } while (0)
#define PG8_STAGE_B(bufoff, ptr, h) PG8_STAGE2(bufoff, (ptr) + (h) * hstepB, voffB[0], voffB[1])
#define PG8_STAGE_A(bufoff, ptr, h, nx) do { if constexpr (GA) { const unsigned _p = (nx) ? vAn[h] : vAc[h]; PG8_STAGE2(bufoff, ptr, (_p & 0xffffu) * gmul + (unsigned)Cst[0] * 2u, (_p >> 16) * gmul + (unsigned)Cst[0] * 2u); } \
        else { PG8_STAGE2(bufoff, (ptr) + (h) * hstepA, voffA[0], voffA[1]); } } while (0)
    typedef int v4i_ __attribute__((ext_vector_type(4)));
#define PG8_LDA(dst, b, h) do { _Pragma("unroll") for (int m = 0; m < 4; ++m) { if constexpr (F8) { dst##8[m].lo = *(const LAS v4i_*)(lds + PG8_SA(b, h) + aoff + m * 2048); dst##8[m].hi = *(const LAS v4i_*)(lds + PG8_SA(b, h) + aoff + m * 2048 + 16); } \
        else { _Pragma("unroll") for (int k = 0; k < 2; ++k) dst[m][k] = *(const LAS bf16x8*)(lds + PG8_SA(b, h) + aoff + m * 2048 + k * 1024); } } } while (0)
#define PG8_LDB(dst, b, h) do { _Pragma("unroll") for (int n = 0; n < 2; ++n) { if constexpr (F8) { dst##8[n].lo = *(const LAS v4i_*)(lds + PG8_SB(b, h) + boff + n * 2048); dst##8[n].hi = *(const LAS v4i_*)(lds + PG8_SB(b, h) + boff + n * 2048 + 16); } \
        else { _Pragma("unroll") for (int k = 0; k < 2; ++k) dst[n][k] = *(const LAS bf16x8*)(lds + PG8_SB(b, h) + boff + n * 2048 + k * 1024); } } } while (0)
#define PG8_MMA(ai, bj, At, Bt) do { __builtin_amdgcn_s_setprio(1); _Pragma("unroll") for (int m = 0; m < 4; ++m) _Pragma("unroll") for (int n = 0; n < 2; ++n) { \
        if constexpr (F8) { asm volatile("v_mfma_scale_f32_16x16x128_f8f6f4 %0, %1, %2, %0, %3, %3 op_sel_hi:[0,0,0]" : "+v"(acc[ai][bj][m][n]) : "v"(Bt##8[n]), "v"(At##8[m]), "v"(f8scale)); } \
        else { _Pragma("unroll") for (int k = 0; k < 2; ++k) acc[ai][bj][m][n] = __builtin_amdgcn_mfma_f32_16x16x32_bf16(Bt[n][k], At[m][k], acc[ai][bj][m][n], 0, 0, 0); } } \
        __builtin_amdgcn_s_setprio(0); } while (0)
#define PG8_WAIT_V(n) asm volatile("s_waitcnt vmcnt(" #n ")" ::: "memory")
#define PG8_WAIT_L(n) asm volatile("s_waitcnt lgkmcnt(" #n ")" ::: "memory")
#define PG8_BAR __builtin_amdgcn_s_barrier()
#define PG8_SCHED __builtin_amdgcn_sched_barrier(0)
#define PG8_GOFF(dst, u) do { if constexpr (GA) { _Pragma("unroll") for (int h = 0; h < 2; ++h) dst[h] = S.a_rowoff(u, Rst[0] + HALF * h) | (S.a_rowoff(u, Rst[0] + 64 + HALF * h) << 16); } } while (0)
    Unit cur, nxt; int ui = 0;
    if (!S.next(0, cur)) return;
    f32x4 acc[2][2][4][2];
#pragma unroll
    for (int a = 0; a < 2; ++a)
#pragma unroll
        for (int b = 0; b < 2; ++b)
#pragma unroll
            for (int m = 0; m < 4; ++m)
#pragma unroll
                for (int n = 0; n < 2; ++n) acc[a][b][m][n] = (f32x4){0.f, 0.f, 0.f, 0.f};
    int f8scale = 0x7F7F7F7F; asm volatile("" : "+v"(f8scale));
    bf16x8 At[4][2], B0[2][2], B1[2][2]; v8i At8[4], B08[2], B18[2];
    const char* cA = S.a_base(cur); const char* cB0 = S.b_base(cur, 0); const char* cB1 = KS ? S.b_base(cur, 1) : cB0;
    PG8_GOFF(vAc, cur);
    vAn[0] = vAc[0]; vAn[1] = vAc[1];
    PG8_STAGE_B(PG8_SB(0, 0), cB0, 0); PG8_STAGE_B(PG8_SB(0, 1), cB0, 1); PG8_STAGE_A(PG8_SA(0, 0), cA, 0, false); PG8_STAGE_A(PG8_SA(0, 1), cA, 1, false);
    if (wr == 1) PG8_BAR;
    PG8_WAIT_V(2); PG8_BAR;
    PG8_STAGE_B(PG8_SB(1, 0), cB0 + kstep, 0); PG8_STAGE_A(PG8_SA(1, 0), cA + kstep, 0, false); PG8_STAGE_B(PG8_SB(1, 1), cB0 + kstep, 1);
    PG8_WAIT_V(6); PG8_BAR;
    for (;;) {
        const bool has_next = S.next(ui + 1, nxt);
        const char* nA = has_next ? S.a_base(nxt) : cA; const char* nB0 = has_next ? S.b_base(nxt, 0) : cB0; const char* nB1 = (KS && has_next) ? S.b_base(nxt, 1) : (KS ? cB1 : nB0);
        if constexpr (GA) { if (has_next) { PG8_GOFF(vAn, nxt); } }
#pragma unroll 1
        for (int t = 0; t < nt; t += 2) {
            const bool last = (t == nt - 2);
            const char* a1 = cA + (size_t)(t + 1) * kstep;
            const char* a2 = last ? nA : cA + (size_t)(t + 2) * kstep;
            const char* b2 = last ? nB0 : ((KS && (t + 2) >= KS) ? cB1 + (size_t)(t + 2 - KS) * kstep : cB0 + (size_t)(t + 2) * kstep);
            const char* a3 = a2 + kstep; const char* b3 = b2 + kstep;
            PG8_LDB(B0, 0, 0); PG8_LDB(B1, 0, 1); PG8_SCHED; PG8_LDA(At, 0, 0); PG8_STAGE_A(PG8_SA(1, 1), a1, 1, false);
            PG8_WAIT_V(8); PG8_WAIT_L(0); PG8_BAR; PG8_MMA(0, 0, At, B0); PG8_MMA(0, 1, At, B1); PG8_BAR; PG8_SCHED;
            PG8_LDA(At, 0, 1); PG8_STAGE_B(PG8_SB(0, 0), b2, 0); PG8_STAGE_B(PG8_SB(0, 1), b2, 1); PG8_STAGE_A(PG8_SA(0, 0), a2, 0, last);
            PG8_WAIT_V(8); PG8_WAIT_L(0); PG8_BAR; PG8_MMA(1, 0, At, B0); PG8_MMA(1, 1, At, B1); PG8_BAR; PG8_SCHED;
            PG8_LDB(B0, 1, 0); PG8_LDB(B1, 1, 1); PG8_SCHED; PG8_LDA(At, 1, 0); PG8_STAGE_A(PG8_SA(0, 1), a2, 1, last);
            PG8_WAIT_V(8); PG8_WAIT_L(0); PG8_BAR; PG8_MMA(0, 0, At, B0); PG8_MMA(0, 1, At, B1); PG8_BAR; PG8_SCHED;
            PG8_LDA(At, 1, 1); PG8_STAGE_B(PG8_SB(1, 0), b3, 0); PG8_STAGE_B(PG8_SB(1, 1), b3, 1); PG8_STAGE_A(PG8_SA(1, 0), a3, 0, last);
            PG8_WAIT_V(8); PG8_WAIT_L(0); PG8_BAR; PG8_MMA(1, 0, At, B0); PG8_MMA(1, 1, At, B1); PG8_BAR; PG8_SCHED;
        }
        if (wr == 0) PG8_BAR;
        if constexpr (F8) { asm volatile("s_nop 15\n\ts_nop 15" ::: "memory"); }
        { int fr_ = fr, fq_ = fq; asm volatile("" : "+v"(fr_), "+v"(fq_));
          E(acc, cur, wr, wc, fr_, fq_); }
        if (!has_next) break;
#pragma unroll
        for (int a = 0; a < 2; ++a)
#pragma unroll
            for (int b = 0; b < 2; ++b)
#pragma unroll
                for (int m = 0; m < 4; ++m)
#pragma unroll
                    for (int n = 0; n < 2; ++n) acc[a][b][m][n] = (f32x4){0.f, 0.f, 0.f, 0.f};
        cur = nxt; cA = nA; cB0 = nB0; cB1 = nB1; ++ui;
        vAc[0] = vAn[0]; vAc[1] = vAn[1];
        if (wr == 1) PG8_BAR;
    }
    PG8_WAIT_V(0);
    PG8_BAR;
#undef PG8_SA
#undef PG8_SB
#undef PG8_STAGE2
#undef PG8_STAGE_A
#undef PG8_STAGE_B
#undef PG8_LDA
#undef PG8_LDB
#undef PG8_MMA
#undef PG8_WAIT_V
#undef PG8_WAIT_L
#undef PG8_BAR
#undef PG8_SCHED
#undef PG8_GOFF
}
}
using pg8::Unit;

DI unsigned cvt_pk_bf16(float lo, float hi) { unsigned r; asm volatile("v_cvt_pk_bf16_f32 %0, %1, %2" : "=v"(r) : "v"(lo), "v"(hi)); return r; }

struct Args {
    const float* x; const float* c; const int* pos; const float* ada_w; const float* ada_b; const float* nmw; const float* nfw; const float* w_in;
    const float* b_ig; const float* b_fg; const float* qnw; const float* knw; const float* sinks; const float* conv_w; const float* conv_b; const float* mnw;
    const float* w_au; const float* w_mu; const float* w_out; const float* router_w; const float* router_b; const float* w_gate; const float* w_up; const float* w_down;
    float* out; unsigned char* ws; int ph_lo, ph_hi;
};

__constant__ float c_invf[8] = {1.0f, 0.1939227432012558f, 0.03760603070259094f, 0.007292664609849453f, 0.0014142135623842478f, 0.00027424818836152554f, 5.3182957344688475e-05f, 1.0313385246263351e-05f};

struct DenseSched {
    static constexpr bool GATHER = false; static constexpr int KSPLIT = 0;
    const char* A; const char* Bt; int lda, ldb; pg8::TileOrder ord;
    DI bool next(int i, Unit& u) const { int pm, pn; if (!ord.get(i, pm, pn)) return false; u.pm = pm; u.pn = pn; u.x0 = 0; u.x1 = 0; return true; }
    DI const char* a_base(const Unit& u) const { return A + (size_t)u.pm * 256 * lda; }
    DI const char* b_base(const Unit& u, int) const { return Bt + (size_t)u.pn * 256 * ldb; }
    DI unsigned a_rowoff(const Unit&, int) const { return 0u; }
};
struct EpiProj {
    static constexpr bool PERM = true;
    bf16* O; float* gates; const float* big; const float* bfg;
    DI void operator()(const f32x4 (&acc)[2][2][4][2], const Unit& u, int wr, int wc, int fr, int fq) const {
        const int row0 = u.pm * 256 + wr * 64 + fr, col0 = u.pn * 256 + wc * 32 + 8 * fq; const bool sg = u.pn >= 9; constexpr float WSC = 1.0f / 64.0f;
        if (u.pn == 19) {
            if (wc == 0 && fq == 0) {
#pragma unroll
                for (int ai = 0; ai < 2; ++ai)
#pragma unroll
                    for (int m = 0; m < 4; ++m) { const int row = row0 + ai * 128 + m * 16; const f32x4 vi = acc[ai][0][m][0], vf = acc[ai][0][m][1]; f32x4 oi, of;
#pragma unroll
                        for (int j = 0; j < 4; ++j) { oi[j] = vi[j] * WSC + big[j]; const float z = vf[j] * WSC + bfg[j]; of[j] = fminf(z, 0.f) - log1pf(__expf(-fabsf(z))); }
                        *(f32x4*)(gates + (size_t)row * 8) = oi; *(f32x4*)(gates + (size_t)row * 8 + 4) = of; } }
            return; }
#pragma unroll
        for (int ai = 0; ai < 2; ++ai)
#pragma unroll
            for (int m = 0; m < 4; ++m) { bf16* rowp = O + (size_t)(row0 + ai * 128 + m * 16) * NPROJ + col0;
#pragma unroll
                for (int bj = 0; bj < 2; ++bj) { f32x4 v0 = acc[ai][bj][m][0] * WSC, v1 = acc[ai][bj][m][1] * WSC;
                    if (sg) {
#pragma unroll
                        for (int j = 0; j < 4; ++j) { v0[j] = sigmoidf_(v0[j]); v1[j] = sigmoidf_(v1[j]); } }
                    v4u w; w.x = cvt_pk_bf16(v0[0], v0[1]); w.y = cvt_pk_bf16(v0[2], v0[3]); w.z = cvt_pk_bf16(v1[0], v1[1]); w.w = cvt_pk_bf16(v1[2], v1[3]);
                    *(v4u*)(rowp + bj * 128) = w; } }
    }
};
template <bool ADD> struct EpiGate {
    static constexpr bool PERM = true;
    bf16* P; int gcol;
    DI void operator()(const f32x4 (&acc)[2][2][4][2], const Unit& u, int wr, int wc, int fr, int fq) const {
        const int row0 = u.pm * 256 + wr * 64 + fr, col0 = u.pn * 256 + wc * 32 + 8 * fq;
#pragma unroll
        for (int ai = 0; ai < 2; ++ai)
#pragma unroll
            for (int m = 0; m < 4; ++m) { bf16* rowp = P + (size_t)(row0 + ai * 128 + m * 16) * NPROJ + col0;
#pragma unroll
                for (int bj = 0; bj < 2; ++bj) { const f32x4 v0 = acc[ai][bj][m][0], v1 = acc[ai][bj][m][1];
                    const v4u g = *(const v4u*)(rowp + gcol + bj * 128);
                    float o[8] = {bflo(g.x) * v0[0], bfhi(g.x) * v0[1], bflo(g.y) * v0[2], bfhi(g.y) * v0[3], bflo(g.z) * v1[0], bfhi(g.z) * v1[1], bflo(g.w) * v1[2], bfhi(g.w) * v1[3]};
                    if (ADD) { const v4u p = *(const v4u*)(rowp + C_MQ + bj * 128);
                        o[0] += bflo(p.x); o[1] += bfhi(p.x); o[2] += bflo(p.y); o[3] += bfhi(p.y); o[4] += bflo(p.z); o[5] += bfhi(p.z); o[6] += bflo(p.w); o[7] += bfhi(p.w); }
                    v4u w; w.x = cvt_pk_bf16(o[0], o[1]); w.y = cvt_pk_bf16(o[2], o[3]); w.z = cvt_pk_bf16(o[4], o[5]); w.w = cvt_pk_bf16(o[6], o[7]);
                    *(v4u*)(rowp + C_MQ + bj * 128) = w; } }
    }
};
struct EpiRes {
    static constexpr bool PERM = false;
    const float* xin; float* out; const float* g; float* ssq; int rmask;
    DI void operator()(const f32x4 (&acc)[2][2][4][2], const Unit& u, int wr, int wc, int fr, int fq) const {
        const int row0 = u.pm * 256 + wr * 64 + fr, col0 = u.pn * 256 + wc * 32 + 4 * fq; const int b = (u.pm * 256) >> 14;
        f32x4 gv[2][2];
#pragma unroll
        for (int bj = 0; bj < 2; ++bj)
#pragma unroll
            for (int n = 0; n < 2; ++n) gv[bj][n] = *(const f32x4*)(g + b * 6144 + col0 + bj * 128 + n * 16);
#pragma unroll
        for (int ai = 0; ai < 2; ++ai)
#pragma unroll
            for (int m = 0; m < 4; ++m) { const size_t off = (size_t)(row0 + ai * 128 + m * 16) * D + col0; const size_t offo = (size_t)((row0 + ai * 128 + m * 16) & rmask) * D + col0; float sq = 0.f;
#pragma unroll
                for (int bj = 0; bj < 2; ++bj)
#pragma unroll
                    for (int n = 0; n < 2; ++n) { const f32x4 xv = *(const f32x4*)(xin + off + bj * 128 + n * 16); const f32x4 o = xv + gv[bj][n] * acc[ai][bj][m][n];
                        sq += (o.x * o.x + o.y * o.y) + (o.z * o.z + o.w * o.w);
                        *(f32x4*)(out + offo + bj * 128 + n * 16) = o; }
                sq += __shfl_xor(sq, 16); sq += __shfl_xor(sq, 32);
                if (fq == 0) ssq[(size_t)(row0 + ai * 128 + m * 16) * 16 + u.pn * 4 + wc] = sq; }
    }
};

struct MoeTab { const LAS int* tcls; const LAS int* tpos; const LAS int* cnt; int Rtot; };
DI int xcd_remap(int L, int nwg) { const int q = nwg >> 3, r = nwg & 7, xcd = L & 7, off = L >> 3; return (xcd < r ? xcd * (q + 1) : r * (q + 1) + (xcd - r) * q) + off; }
DI void cls_experts(int cls, int& ea, int& eb) { const int g = cls / 6, p = cls - 6 * g; const int a = (p < 3) ? 0 : ((p < 5) ? 1 : 2); const int b = (p < 3) ? (p + 1) : ((p < 5) ? (p - 1) : 3); ea = 4 * g + a; eb = 4 * g + b; }
struct MoeUpSched {
    static constexpr bool GATHER = true; static constexpr int KSPLIT = 0;
    const char* A; const char* W; int lda, ldb; MoeTab tb; int G, c; const LAS unsigned* tokoff;
    DI bool next(int i, Unit& u) const { const int L0 = i * G + c; if (L0 >= tb.Rtot * 8) return false; const int L = xcd_remap(L0, tb.Rtot * 8); u.pm = L >> 3; u.pn = L & 7; u.x0 = i; u.x1 = __builtin_amdgcn_readfirstlane(tb.tcls[u.pm]); return true; }
    DI const char* a_base(const Unit&) const { return A; }
    DI const char* b_base(const Unit& u, int) const { int ea, eb; cls_experts(u.x1, ea, eb); const int e = (u.pn < 4) ? ea : eb; return W + ((size_t)e * 1024 + (size_t)(u.pn & 3) * 256) * ldb; }
    DI unsigned a_rowoff(const Unit& u, int r) const { return tokoff[u.x0 * 256 + r]; }
};
struct EpiSwiglu {
    static constexpr bool PERM = true;
    bf16* H; const float* tgate; const LAS unsigned* tokoff;
    DI void operator()(const f32x4 (&acc)[2][2][4][2], const Unit& u, int wr, int wc, int fr, int fq) const {
        const int r0 = wr * 64 + fr; const int hc = (u.pn >> 2) * 512 + (u.pn & 3) * 128 + wc * 32 + 8 * fq; const int gsel = u.pn >> 2;
#pragma unroll
        for (int ai = 0; ai < 2; ++ai)
#pragma unroll
            for (int m = 0; m < 4; ++m) { const int r = r0 + ai * 128 + m * 16; const unsigned tok = tokoff[u.x0 * 256 + r]; const float rg = tgate[tok * 2 + gsel];
                const f32x4 g0 = acc[ai][0][m][0] * (1.0f / 64.0f), g1 = acc[ai][0][m][1] * (1.0f / 64.0f), u0 = acc[ai][1][m][0] * (1.0f / 64.0f), u1 = acc[ai][1][m][1] * (1.0f / 64.0f);
                float o[8];
#pragma unroll
                for (int j = 0; j < 4; ++j) { o[j] = g0[j] * sigmoidf_(g0[j]) * u0[j] * rg; o[4 + j] = g1[j] * sigmoidf_(g1[j]) * u1[j] * rg; }
                v4u w; w.x = cvt_pk_bf16(o[0], o[1]); w.y = cvt_pk_bf16(o[2], o[3]); w.z = cvt_pk_bf16(o[4], o[5]); w.w = cvt_pk_bf16(o[6], o[7]);
                *(v4u*)(H + ((size_t)u.pm * 256 + r) * 1024 + hc) = w; }
    }
};
struct MoeDownSched {
    static constexpr bool GATHER = false; static constexpr int KSPLIT = 8;
    const char* A; const char* W; int lda, ldb; MoeTab tb; int G, c;
    DI bool next(int i, Unit& u) const { const int L0 = i * G + c; if (L0 >= tb.Rtot * 4) return false; const int L = xcd_remap(L0, tb.Rtot * 4); u.pm = L >> 2; u.pn = L & 3; u.x0 = __builtin_amdgcn_readfirstlane(tb.tpos[u.pm]); u.x1 = __builtin_amdgcn_readfirstlane(tb.tcls[u.pm]); return true; }
    DI const char* a_base(const Unit& u) const { return A + (size_t)u.pm * 256 * lda; }
    DI const char* b_base(const Unit& u, int half) const { int ea, eb; cls_experts(u.x1, ea, eb); const int e = half ? eb : ea; return W + ((size_t)e * 1024 + (size_t)u.pn * 256) * ldb; }
    DI unsigned a_rowoff(const Unit&, int) const { return 0u; }
};
struct EpiMoeOut {
    static constexpr bool PERM = false;
    const float* xin; float* out; const float* g; const int* tokl; MoeTab tb; int rmask;
    DI void operator()(const f32x4 (&acc)[2][2][4][2], const Unit& u, int wr, int wc, int fr, int fq) const {
        const int r0 = wr * 64 + fr, col0 = u.pn * 256 + wc * 32 + 4 * fq; const int cn = tb.cnt[u.x1];
#pragma unroll
        for (int ai = 0; ai < 2; ++ai)
#pragma unroll
            for (int m = 0; m < 4; ++m) { const int pos = u.x0 + r0 + ai * 128 + m * 16;
                if (pos < cn) { const int tok = tokl[u.x1 * CLS_CAP + pos]; const int b = tok >> 14; const float* ip = xin + (size_t)tok * D + col0; float* op = out + (size_t)(tok & rmask) * D + col0; const float* gp = g + b * 6144 + col0;
#pragma unroll
                    for (int bj = 0; bj < 2; ++bj)
#pragma unroll
                        for (int n = 0; n < 2; ++n) { const f32x4 xv = *(const f32x4*)(ip + bj * 128 + n * 16); const f32x4 gv = *(const f32x4*)(gp + bj * 128 + n * 16);
                            *(f32x4*)(op + bj * 128 + n * 16) = xv + gv * acc[ai][bj][m][n]; } } }
    }
};

struct Ctx { LAS unsigned char* lds; int tid, lane, wave, G, bid; };
DI Ctx fresh(const Ctx& X) { Ctx P = X; int t = X.tid; asm volatile("" : "+v"(t)); P.tid = t; P.lane = t & 63; P.wave = __builtin_amdgcn_readfirstlane(t >> 6); return P; }

DI void tr_item(const float* W, int ldw, int K, bf16* WT, int k0, LAS float* scr, int lane) {
#pragma unroll 8
    for (int i = 0; i < 32; ++i) { const int kk = 2 * i + (lane >> 5); scr[kk * 33 + (lane & 31)] = W[(size_t)(k0 + kk) * ldw + (lane & 31)]; }
    LDS_WAIT(); asm volatile("" ::: "memory");
    const int c = lane & 7;
#pragma unroll
    for (int j = 0; j < 4; ++j) { const int n = (lane >> 3) + 8 * j; const LAS float* s = scr + (8 * c) * 33 + n;
        v4u o; o.x = pk2(s[0 * 33], s[1 * 33]); o.y = pk2(s[2 * 33], s[3 * 33]); o.z = pk2(s[4 * 33], s[5 * 33]); o.w = pk2(s[6 * 33], s[7 * 33]);
        *(v4u*)(WT + (size_t)n * K + k0 + 8 * c) = o; }
    LDS_WAIT(); asm volatile("" ::: "memory");
}
DI unsigned pk4_fp8(float a0, float a1, float a2, float a3) { int p = __builtin_amdgcn_cvt_pk_fp8_f32(a0, a1, 0, false); p = __builtin_amdgcn_cvt_pk_fp8_f32(a2, a3, p, true); return (unsigned)p; }
DI void tr_item8(const float* W, int ldw, int K, unsigned char* WT, int k0, float scale, LAS float* scr, int lane) {
#pragma unroll 8
    for (int i = 0; i < 32; ++i) { const int kk = 2 * i + (lane >> 5); scr[kk * 33 + (lane & 31)] = W[(size_t)(k0 + kk) * ldw + (lane & 31)]; }
    LDS_WAIT(); asm volatile("" ::: "memory");
    const int c = lane & 7;
#pragma unroll
    for (int j = 0; j < 4; ++j) { const int n = (lane >> 3) + 8 * j; const LAS float* s = scr + (8 * c) * 33 + n;
        v2u o; o.x = pk4_fp8(s[0 * 33] * scale, s[1 * 33] * scale, s[2 * 33] * scale, s[3 * 33] * scale); o.y = pk4_fp8(s[4 * 33] * scale, s[5 * 33] * scale, s[6 * 33] * scale, s[7 * 33] * scale);
        *(v2u*)(WT + (size_t)n * K + k0 + 8 * c) = o; }
    LDS_WAIT(); asm volatile("" ::: "memory");
}
DI void p0_prologue(const Args& a, const Ctx& X) {
    unsigned char* ws = a.ws;
    LAS float* scr = (LAS float*)(X.lds + X.wave * 16384);
    const int gw = X.bid * 8 + X.wave, NGW = X.G * 8;
    constexpr int IT_WIN = 16 * 153, IT_AU = 8 * 32, IT_OUT = 16 * 32, IT_GU = 16 * 16 * 32, IT_DN = 16 * 8 * 32;
    constexpr int IT_L = IT_WIN + 2 * IT_AU + IT_OUT + IT_GU + IT_DN;
    for (int it = gw; it < NL * IT_L; it += NGW) {
        const int l = it / IT_L; int r = it - l * IT_L;
        if (r < IT_WIN) { const int kb = r / 153, nb = r - kb * 153, d0 = 32 * nb, s0 = (nb == 152) ? 2304 : (d0 + (d0 >= 2304 ? 8 : 0));
            tr_item8(a.w_in + (size_t)l * D * DIN_SRC + s0, DIN_SRC, D, (unsigned char*)(ws + WS_WIN) + ((size_t)l * NPROJW + d0) * D, 64 * kb, 64.0f, scr, X.lane); continue; }
        r -= IT_WIN;
        if (r < IT_AU) { const int kb = r >> 5, nb = r & 31;
            tr_item(a.w_au + (size_t)l * 512 * D + 32 * nb, D, 512, (bf16*)(ws + WS_WAU) + ((size_t)l * D + 32 * nb) * 512, 64 * kb, scr, X.lane); continue; }
        r -= IT_AU;
        if (r < IT_AU) { const int kb = r >> 5, nb = r & 31;
            tr_item(a.w_mu + (size_t)l * 512 * D + 32 * nb, D, 512, (bf16*)(ws + WS_WMU) + ((size_t)l * D + 32 * nb) * 512, 64 * kb, scr, X.lane); continue; }
        r -= IT_AU;
        if (r < IT_OUT) { const int kb = r >> 5, nb = r & 31;
            tr_item(a.w_out + (size_t)l * D * D + 32 * nb, D, D, (bf16*)(ws + WS_WOUT) + ((size_t)l * D + 32 * nb) * D, 64 * kb, scr, X.lane); continue; }
        r -= IT_OUT;
        if (r < IT_GU) { const int e = r >> 9, q = r & 511, kb = q >> 5, nb = q & 31, tq = nb >> 3, rb = nb & 7;
            const float* src = ((rb < 4) ? a.w_gate : a.w_up) + ((size_t)(l * NE + e) * D) * FF + 128 * tq + 32 * (rb & 3);
            tr_item8(src, FF, D, (unsigned char*)(ws + WS_WGU) + ((size_t)(l * NE + e) * 1024 + 32 * nb) * D, 64 * kb, 64.0f, scr, X.lane); continue; }
        r -= IT_GU;
        { const int e = r >> 8, q = r & 255, kb = q >> 5, nb = q & 31;
            tr_item(a.w_down + ((size_t)(l * NE + e) * FF) * D + 32 * nb, D, FF, (bf16*)(ws + WS_WD) + ((size_t)(l * NE + e) * 1024 + 32 * nb) * FF, 64 * kb, scr, X.lane); }
    }
    { float* cs = (float*)(ws + WS_ROPE); float* sn = cs + (size_t)T * 8;
      for (int i = X.bid * 512 + X.tid; i < T * 8; i += X.G * 512) { const int tok = i >> 3, f = i & 7; const float angf = (float)a.pos[tok] * c_invf[f];
          double rev = (double)angf * 0.15915494309189535; rev -= rint(rev); const float rf = (float)rev;
          cs[i] = __builtin_amdgcn_cosf(rf); sn[i] = __builtin_amdgcn_sinf(rf); } }
    __syncthreads();
    LAS float* cact = (LAS float*)X.lds; LAS float* red = (LAS float*)(X.lds + 8192);
    for (int i = X.tid; i < 2048; i += 512) { const float cv = a.c[i]; cact[i] = cv / (1.0f + __expf(-cv)); }
    __syncthreads();
    float* mod = (float*)(ws + WS_MOD);
    for (int it = X.bid; it < NL * 96; it += X.G) { const int l = it / 96, cg = it - l * 96; const int col = cg * 64 + X.lane;
        const float* w = a.ada_w + (size_t)l * D * 6144 + col; float s0 = 0.f, s1 = 0.f;
#pragma unroll 8
        for (int kk = 0; kk < 128; ++kk) { const int k = X.wave * 128 + kk; const float wv = w[(size_t)k * 6144]; s0 += cact[k] * wv; s1 += cact[1024 + k] * wv; }
        red[(X.wave * 2 + 0) * 64 + X.lane] = s0; red[(X.wave * 2 + 1) * 64 + X.lane] = s1;
        __syncthreads();
        if (X.tid < 128) { const int b = X.tid >> 6, ln = X.tid & 63; float s = 0.f;
#pragma unroll
            for (int w8 = 0; w8 < 8; ++w8) s += red[(w8 * 2 + b) * 64 + ln];
            mod[(size_t)(l * 2 + b) * 6144 + cg * 64 + ln] = s + a.ada_b[l * 6144 + cg * 64 + ln]; }
        __syncthreads();
    }
}

DI void p1_norm_gates(const Args& a, const Ctx& X, int l, const float* xin) {
    unsigned char* ws = a.ws;
    const float* mod = (const float*)(ws + WS_MOD); unsigned char* hb = (unsigned char*)(ws + WS_H);
    const int gw = X.bid * 8 + X.wave, NGW = X.G * 8;
    for (int rg = gw; rg < T / 16; rg += NGW) {
        const int row0 = rg * 16, b = row0 >> 14;
        const float* mb = mod + (size_t)(l * 2 + b) * 6144;
        f32x4 aw[4], sh[4];
#pragma unroll
        for (int j = 0; j < 4; ++j) { const int k = 256 * j + 4 * X.lane; const f32x4 nw = *(const f32x4*)(a.nmw + l * D + k); const f32x4 sc = *(const f32x4*)(mb + 1024 + k); aw[j] = nw * (sc + 1.0f); sh[j] = *(const f32x4*)(mb + k); }
        f32x4 pre[4][4];
#pragma unroll
        for (int q = 0; q < 4; ++q) { const f32x4* xp = (const f32x4*)(xin + (size_t)(row0 + q) * D) + X.lane;
#pragma unroll
            for (int j = 0; j < 4; ++j) pre[q][j] = xp[64 * j]; }
#pragma unroll 1
        for (int rb = 0; rb < 16; rb += 4) {
#pragma unroll
          for (int q = 0; q < 4; ++q) { const int row = row0 + rb + q;
            f32x4 v[4]; float ss = 0.f;
#pragma unroll
            for (int j = 0; j < 4; ++j) v[j] = pre[q][j];
            if (rb + 4 < 16) { const f32x4* xp = (const f32x4*)(xin + (size_t)(row + 4) * D) + X.lane;
#pragma unroll
                for (int j = 0; j < 4; ++j) pre[q][j] = xp[64 * j]; }
#pragma unroll
            for (int j = 0; j < 4; ++j) ss += (v[j].x * v[j].x + v[j].y * v[j].y) + (v[j].z * v[j].z + v[j].w * v[j].w);
            ss = wave_sum(ss); const float rstd = __builtin_amdgcn_rsqf(ss * (1.0f / D) + EPS);
            unsigned* o4 = (unsigned*)(hb + (size_t)row * D) + X.lane;
#pragma unroll
            for (int j = 0; j < 4; ++j) { v[j] = v[j] * rstd * aw[j] + sh[j]; o4[64 * j] = pk4_fp8(v[j].x, v[j].y, v[j].z, v[j].w); }
          }
        }
    }
}

DI void attn_unit(const Args& a, const Ctx& X, int l, int unit) {
    unsigned char* ws = a.ws; const bf16* proj = (const bf16*)(ws + WS_PROJ); bf16* ao = (bf16*)(ws + WS_H);
    const float* cs = (const float*)(ws + WS_ROPE); const float* sn = cs + (size_t)T * 8;
    const int b = unit >> 8, rem = unit & 255, nb = rem >> 1, kvh = rem & 1; const int tok0 = b * SEQ + nb * 128;
    LAS bf16* Kl = (LAS bf16*)X.lds;
    LAS bf16* VT = (LAS bf16*)(X.lds + 36864);
    int lane = X.lane; asm volatile("" : "+v"(lane));
    const int c16 = lane & 15, quad = lane >> 4;
    {
        const int row = X.tid >> 1, half = X.tid & 1; const int tokk = tok0 - 128 + row; const bool valid = (nb > 0) || (row >= 128);
        float y[32]; float vv[32];
        if (valid) {
            const v4u* kp = (const v4u*)(proj + (size_t)tokk * NPROJ + C_AK + kvh * 64 + half * 32); const v4u* vp = (const v4u*)(proj + (size_t)tokk * NPROJ + C_AV + kvh * 64 + half * 32);
#pragma unroll
            for (int q = 0; q < 4; ++q) { const v4u kw = kp[q], vw = vp[q];
                y[8 * q + 0] = bflo(kw.x); y[8 * q + 1] = bfhi(kw.x); y[8 * q + 2] = bflo(kw.y); y[8 * q + 3] = bfhi(kw.y); y[8 * q + 4] = bflo(kw.z); y[8 * q + 5] = bfhi(kw.z); y[8 * q + 6] = bflo(kw.w); y[8 * q + 7] = bfhi(kw.w);
                vv[8 * q + 0] = bflo(vw.x); vv[8 * q + 1] = bfhi(vw.x); vv[8 * q + 2] = bflo(vw.y); vv[8 * q + 3] = bfhi(vw.y); vv[8 * q + 4] = bflo(vw.z); vv[8 * q + 5] = bfhi(vw.z); vv[8 * q + 6] = bflo(vw.w); vv[8 * q + 7] = bfhi(vw.w); }
        } else {
#pragma unroll
            for (int i = 0; i < 32; ++i) { y[i] = 0.f; vv[i] = 0.f; } }
        float ss = 0.f;
#pragma unroll
        for (int i = 0; i < 32; ++i) ss += y[i] * y[i];
        ss += __shfl_xor(ss, 1); const float rstd = 1.0f / sqrtf(ss * (1.0f / 64.0f) + EPS);
#pragma unroll
        for (int i = 0; i < 32; ++i) y[i] = y[i] * rstd * a.knw[l * 64 + half * 32 + i];
        if (half == 0 && valid) {
#pragma unroll
            for (int d = 0; d < 8; ++d) { const float c = cs[(size_t)tokk * 8 + d], s = sn[(size_t)tokk * 8 + d]; const float t1 = y[d], t2 = y[d + 8]; y[d] = t1 * c - t2 * s; y[d + 8] = t2 * c + t1 * s; } }
#pragma unroll
        for (int q = 0; q < 4; ++q) { v4u w; w.x = pk2(y[8 * q], y[8 * q + 1]); w.y = pk2(y[8 * q + 2], y[8 * q + 3]); w.z = pk2(y[8 * q + 4], y[8 * q + 5]); w.w = pk2(y[8 * q + 6], y[8 * q + 7]);
            *(LAS v4u*)(Kl + row * 72 + half * 32 + 8 * q) = w; }
#pragma unroll
        for (int i = 0; i < 32; ++i) VT[(half * 32 + i) * 280 + row] = (bf16)f2bf(vv[i]);
        if (X.tid < 64) {
#pragma unroll
            for (int cc = 256; cc < 280; ++cc) VT[X.tid * 280 + cc] = 0; }
    }
    __syncthreads();
#pragma unroll 1
    for (int task = X.wave; task < 32; task += 8) {
        const int g = task >> 3, rg = task & 7, r0 = 16 * rg, head = kvh * 4 + g; const int tokq = tok0 + r0 + c16;
        const float sink = a.sinks[l * 8 + head];
        float qv[16];
        { const bf16* qp = proj + (size_t)tokq * NPROJ + C_AQ + head * 64; const v4u w0 = *(const v4u*)(qp + 8 * quad), w1 = *(const v4u*)(qp + 32 + 8 * quad);
          qv[0] = bflo(w0.x); qv[1] = bfhi(w0.x); qv[2] = bflo(w0.y); qv[3] = bfhi(w0.y); qv[4] = bflo(w0.z); qv[5] = bfhi(w0.z); qv[6] = bflo(w0.w); qv[7] = bfhi(w0.w);
          qv[8] = bflo(w1.x); qv[9] = bfhi(w1.x); qv[10] = bflo(w1.y); qv[11] = bfhi(w1.y); qv[12] = bflo(w1.z); qv[13] = bfhi(w1.z); qv[14] = bflo(w1.w); qv[15] = bfhi(w1.w); }
        float ss = 0.f;
#pragma unroll
        for (int i = 0; i < 16; ++i) ss += qv[i] * qv[i];
        ss += __shfl_xor(ss, 16); ss += __shfl_xor(ss, 32); const float rstd = 1.0f / sqrtf(ss * (1.0f / 64.0f) + EPS);
#pragma unroll
        for (int i = 0; i < 8; ++i) { qv[i] = qv[i] * rstd * a.qnw[l * 64 + 8 * quad + i]; qv[8 + i] = qv[8 + i] * rstd * a.qnw[l * 64 + 32 + 8 * quad + i]; }
#pragma unroll
        for (int d = 0; d < 8; ++d) { const float other = __shfl_xor(qv[d], 16); const float c = cs[(size_t)tokq * 8 + d], s = sn[(size_t)tokq * 8 + d];
            if (quad == 0) qv[d] = qv[d] * c - other * s; else if (quad == 1) qv[d] = qv[d] * c + other * s; }
        bf16x8 qf[2];
        { v4u w; w.x = pk2(qv[0], qv[1]); w.y = pk2(qv[2], qv[3]); w.z = pk2(qv[4], qv[5]); w.w = pk2(qv[6], qv[7]); qf[0] = __builtin_bit_cast(bf16x8, w);
          w.x = pk2(qv[8], qv[9]); w.y = pk2(qv[10], qv[11]); w.z = pk2(qv[12], qv[13]); w.w = pk2(qv[14], qv[15]); qf[1] = __builtin_bit_cast(bf16x8, w); }
        f32x4 sacc[9];
#pragma unroll
        for (int i = 0; i < 9; ++i) { const LAS bf16* kr = Kl + (16 * (rg + i) + c16) * 72 + 8 * quad;
            const bf16x8 k0 = *(const LAS bf16x8*)kr, k1 = *(const LAS bf16x8*)(kr + 32);
            f32x4 z = {0.f, 0.f, 0.f, 0.f}; z = __builtin_amdgcn_mfma_f32_16x16x32_bf16(k0, qf[0], z, 0, 0, 0); sacc[i] = __builtin_amdgcn_mfma_f32_16x16x32_bf16(k1, qf[1], z, 0, 0, 0); }
        int dbase = 4 * quad - c16; asm volatile("" : "+v"(dbase)); int kbase = 16 * rg + 4 * quad; asm volatile("" : "+v"(kbase)); float mx = sink;
#pragma unroll
        for (int i = 0; i < 9; ++i)
#pragma unroll
            for (int j = 0; j < 4; ++j) { const int dlt = dbase + 16 * i + j; const int kj = kbase + 16 * i + j; const bool ok = (dlt > 0) && (dlt <= 128) && ((nb > 0) || (kj >= 128));
                const float s = ok ? sacc[i][j] * 0.125f : -3.0e38f; sacc[i][j] = s; mx = fmaxf(mx, s); }
        mx = fmaxf(mx, __shfl_xor(mx, 16)); mx = fmaxf(mx, __shfl_xor(mx, 32));
        float sum = 0.f;
#pragma unroll
        for (int i = 0; i < 9; ++i)
#pragma unroll
            for (int j = 0; j < 4; ++j) { const float p = (sacc[i][j] > -1.0e38f) ? __expf(sacc[i][j] - mx) : 0.f; sacc[i][j] = p; sum += p; }
        sum += __shfl_xor(sum, 16); sum += __shfl_xor(sum, 32);
        const float inv = 1.0f / (sum + __expf(sink - mx));
        f32x4 oacc[4];
#pragma unroll
        for (int et = 0; et < 4; ++et) oacc[et] = (f32x4){0.f, 0.f, 0.f, 0.f};
#pragma unroll
        for (int kk = 0; kk < 5; ++kk) {
            v4u pw; pw.x = pk2(sacc[2 * kk][0], sacc[2 * kk][1]); pw.y = pk2(sacc[2 * kk][2], sacc[2 * kk][3]);
            if (2 * kk + 1 < 9) { pw.z = pk2(sacc[(2 * kk + 1 < 9) ? 2 * kk + 1 : 0][0], sacc[(2 * kk + 1 < 9) ? 2 * kk + 1 : 0][1]); pw.w = pk2(sacc[(2 * kk + 1 < 9) ? 2 * kk + 1 : 0][2], sacc[(2 * kk + 1 < 9) ? 2 * kk + 1 : 0][3]); } else { pw.z = 0u; pw.w = 0u; }
            const bf16x8 pf = __builtin_bit_cast(bf16x8, pw);
#pragma unroll
            for (int et = 0; et < 4; ++et) { const LAS bf16* vr = VT + (16 * et + c16) * 280 + 16 * rg + 32 * kk + 4 * quad;
                const v2u lo = *(const LAS v2u*)vr, hi = *(const LAS v2u*)(vr + 16); v4u vw; vw.x = lo.x; vw.y = lo.y; vw.z = hi.x; vw.w = hi.y;
                oacc[et] = __builtin_amdgcn_mfma_f32_16x16x32_bf16(__builtin_bit_cast(bf16x8, vw), pf, oacc[et], 0, 0, 0); }
        }
#pragma unroll
        for (int et = 0; et < 4; ++et) { v2u w; w.x = pk2(oacc[et][0] * inv, oacc[et][1] * inv); w.y = pk2(oacc[et][2] * inv, oacc[et][3] * inv);
            *(v2u*)(ao + (size_t)tokq * 512 + head * 64 + 16 * et + 4 * quad) = w; }
    }
    __syncthreads();
}

constexpr int ML_Q = 0, ML_K = 17408, ML_KET = 34816, ML_VT = 53248, ML_CT = 73984, ML_CW = 113152, ML_CB = 118272, ML_RED = 118784, ML_NW = 119296, ML_GT = 119808;
DI float bfw(unsigned w, int hi) { return hi ? bfhi(w) : bflo(w); }
template <bool L3> DI void mlstm_unit(const Args& a, const Ctx& X, int l, int unit) {
    unsigned char* ws = a.ws; const bf16* proj = (const bf16*)(ws + WS_PROJ); bf16* hm = (bf16*)(ws + WS_H) + (size_t)T * 512;
    bf16* kcb = (bf16*)(ws + WS_KC);
    const float* gates = (const float*)(ws + WS_GATES); float* mlc = (float*)(ws + WS_MLC) + (size_t)unit * 18432; float* mlb = (float*)(ws + WS_MLB);
    const int seq = unit >> 5, sj = unit & 31, b = seq >> 2, hh = seq & 3; const int tokbase = b * SEQ + sj * 512;
    LAS bf16* Qs = (LAS bf16*)(X.lds + ML_Q); LAS bf16* Ks = (LAS bf16*)(X.lds + ML_K); LAS bf16* KET = (LAS bf16*)(X.lds + ML_KET);
    LAS bf16* VT = (LAS bf16*)(X.lds + ML_VT); LAS bf16* CT = (LAS bf16*)(X.lds + ML_CT); LAS float* CW = (LAS float*)(X.lds + ML_CW);
    LAS float* CB = (LAS float*)(X.lds + ML_CB); LAS float* RED = (LAS float*)(X.lds + ML_RED); LAS float* NW = (LAS float*)(X.lds + ML_NW);
    LAS float* GT = (LAS float*)(X.lds + ML_GT);
    int lane = X.lane; asm volatile("" : "+v"(lane));
    const int c16 = lane & 15, quad = lane >> 4, w = X.wave;
    int tidl = X.tid; asm volatile("" : "+v"(tidl));
    const int tg = tidl >> 5, cg = tidl & 31, t0 = 4 * tg, c0 = 4 * cg;
    v2u rq[7], rk[7], rv[4], kcv[4];
#define ML_LBAR() do { asm volatile("s_waitcnt lgkmcnt(0)" ::: "memory"); __builtin_amdgcn_s_barrier(); asm volatile("" ::: "memory"); } while (0)
#define ML_LOADRAW(tokc) do { _Pragma("unroll") for (int j = 0; j < 7; ++j) { const int tt = (tokc) + t0 - 3 + j; const bool ok = tt >= b * SEQ; const bf16* rp = proj + (size_t)(ok ? tt : (tokc)) * NPROJ + hh * 128 + c0; \
        if (L3) { rq[j] = *(const v2u*)(rp + C_MQ); if (!ok) { rq[j].x = 0u; rq[j].y = 0u; } } else { rk[j] = *(const v2u*)(rp + C_MK); if (!ok) { rk[j].x = 0u; rk[j].y = 0u; } } } \
        if (L3) { _Pragma("unroll") for (int i = 0; i < 4; ++i) kcv[i] = *(const v2u*)(kcb + (size_t)((tokc) + t0 + i) * 512 + hh * 128 + c0); } \
        _Pragma("unroll") for (int i = 0; i < 4; ++i) rv[i] = *(const v2u*)(proj + (size_t)((tokc) + t0 + i) * NPROJ + C_MV + hh * 128 + c0); } while (0)
    ML_LOADRAW(tokbase);
    for (int idx = X.tid; idx < 1280; idx += 512) { const int tap = idx >> 8, ch = idx & 255; const int gch = (ch < 128) ? (hh * 128 + ch) : (512 + hh * 128 + (ch - 128));
        CW[idx] = (tap < 4) ? a.conv_w[(size_t)(l * 4 + tap) * 1024 + gch] : a.conv_b[l * 1024 + gch]; }
    for (int idx = X.tid; idx < 16 * 72; idx += 512) VT[128 * 72 + idx] = (idx < 72) ? (bf16)0x3F80 : (bf16)0;
    if (X.tid < 128) NW[X.tid] = a.mnw[l * 512 + hh * 128 + X.tid];
    { const float* gp = gates + (size_t)(tokbase + X.tid) * 8; GT[2 * X.tid] = gp[hh]; GT[2 * X.tid + 1] = gp[4 + hh]; }
    f32x4 cacc[9];
#pragma unroll
    for (int et = 0; et < 9; ++et) {
        if (L3) {
#pragma unroll
            for (int j = 0; j < 4; ++j) { const float v = mlc[(16 * et + 4 * quad + j) * 128 + 16 * w + c16]; cacc[et][j] = v; CT[(16 * et + 4 * quad + j) * 136 + 16 * w + c16] = (bf16)f2bf(v); }
        } else cacc[et] = (f32x4){0.f, 0.f, 0.f, 0.f};
    }
    float bsum = 0.f;
    __syncthreads();
#pragma unroll 1
    for (int c = 0; c < 8; ++c) {
        const int tok0 = tokbase + c * 64;
        const f32x2 gl = *(const LAS f32x2*)(GT + 2 * (c * 64 + lane)); float bsc = gl.y; const float li = gl.x;
#pragma unroll
        for (int o = 1; o < 64; o <<= 1) { const float v = __shfl_up(bsc, o); if (lane >= o) bsc += v; }
        const float bl = __shfl(bsc, 63); const float csv = li - bsc;
        if (w == 0) { CB[lane] = bsc; CB[64 + lane] = csv; }
        bsum += bl;
        const int tt_ = w & 3, eh = w >> 2; const int tq = 16 * tt_ + c16;
        v2u ogv[4];
        if (L3) {
#pragma unroll
            for (int x = 0; x < 4; ++x) ogv[x] = *(const v2u*)(proj + (size_t)(tok0 + tq) * NPROJ + C_MO + hh * 128 + 16 * (4 * eh + x) + 4 * quad); }
        { float fac[4];
#pragma unroll
          for (int i = 0; i < 4; ++i) fac[i] = __expf(bl + __shfl(csv, t0 + i));
#pragma unroll
          for (int qk = (L3 ? 0 : 1); qk < 2; ++qk) {
              float o[4][4];
              if (L3 && qk) {
#pragma unroll
                  for (int i = 0; i < 4; ++i) { o[i][0] = bflo(kcv[i].x); o[i][1] = bfhi(kcv[i].x); o[i][2] = bflo(kcv[i].y); o[i][3] = bfhi(kcv[i].y); }
              } else {
              const f32x4 bias = *(const LAS f32x4*)(CW + 4 * 256 + qk * 128 + c0);
#pragma unroll
              for (int i = 0; i < 4; ++i) { o[i][0] = bias.x; o[i][1] = bias.y; o[i][2] = bias.z; o[i][3] = bias.w; }
#pragma unroll
              for (int j = 0; j < 4; ++j) { const f32x4 wj = *(const LAS f32x4*)(CW + j * 256 + qk * 128 + c0);
#pragma unroll
                  for (int i = 0; i < 4; ++i) { const v2u rr = qk ? rk[i + j] : rq[i + j];
                      o[i][0] += wj.x * bflo(rr.x); o[i][1] += wj.y * bfhi(rr.x); o[i][2] += wj.z * bflo(rr.y); o[i][3] += wj.w * bfhi(rr.y); } }
#pragma unroll
              for (int i = 0; i < 4; ++i)
#pragma unroll
                  for (int ch = 0; ch < 4; ++ch) { const float z = o[i][ch]; o[i][ch] = z * __builtin_amdgcn_rcpf(1.0f + __expf(-z)) * (qk ? 0.08838834764831845f : 1.0f); }
              }
              if (!L3 && qk) {
#pragma unroll
                  for (int i = 0; i < 4; ++i) { v2u pw; pw.x = pk2(o[i][0], o[i][1]); pw.y = pk2(o[i][2], o[i][3]); *(v2u*)(kcb + (size_t)(tok0 + t0 + i) * 512 + hh * 128 + c0) = pw;
                      o[i][0] = bflo(pw.x); o[i][1] = bfhi(pw.x); o[i][2] = bflo(pw.y); o[i][3] = bfhi(pw.y); } }
              if (L3) { LAS bf16* dst = (qk ? Ks : Qs) + t0 * 136 + c0;
#pragma unroll
                  for (int i = 0; i < 4; ++i) { v2u pw; pw.x = pk2(o[i][0], o[i][1]); pw.y = pk2(o[i][2], o[i][3]); *(LAS v2u*)(dst + i * 136) = pw; } }
              if (qk) {
#pragma unroll
                  for (int ch = 0; ch < 4; ++ch) { v2u pw; pw.x = pk2(o[0][ch] * fac[0], o[1][ch] * fac[1]); pw.y = pk2(o[2][ch] * fac[2], o[3][ch] * fac[3]); *(LAS v2u*)(KET + (c0 + ch) * 72 + t0) = pw; } }
          }
          { v2u p0, p1, p2, p3;
            p0.x = (rv[0].x & 0xffffu) | (rv[1].x << 16); p0.y = (rv[2].x & 0xffffu) | (rv[3].x << 16);
            p1.x = (rv[0].x >> 16) | (rv[1].x & 0xffff0000u); p1.y = (rv[2].x >> 16) | (rv[3].x & 0xffff0000u);
            p2.x = (rv[0].y & 0xffffu) | (rv[1].y << 16); p2.y = (rv[2].y & 0xffffu) | (rv[3].y << 16);
            p3.x = (rv[0].y >> 16) | (rv[1].y & 0xffff0000u); p3.y = (rv[2].y >> 16) | (rv[3].y & 0xffff0000u);
            *(LAS v2u*)(VT + (c0 + 0) * 72 + t0) = p0; *(LAS v2u*)(VT + (c0 + 1) * 72 + t0) = p1; *(LAS v2u*)(VT + (c0 + 2) * 72 + t0) = p2; *(LAS v2u*)(VT + (c0 + 3) * 72 + t0) = p3; }
        }
        ML_LBAR();
        if (c < 7) { ML_LOADRAW(tok0 + 64); }
        float hval[4][4];
        if (L3) {
            bf16x8 qf[4];
#pragma unroll
            for (int ks = 0; ks < 4; ++ks) qf[ks] = *(const LAS bf16x8*)(Qs + tq * 136 + 32 * ks + 8 * quad);
            f32x4 sacc[4];
#pragma unroll
            for (int st = 0; st < 4; ++st) { f32x4 z = {0.f, 0.f, 0.f, 0.f};
#pragma unroll
                for (int ks = 0; ks < 4; ++ks) z = __builtin_amdgcn_mfma_f32_16x16x32_bf16(*(const LAS bf16x8*)(Ks + (16 * st + c16) * 136 + 32 * ks + 8 * quad), qf[ks], z, 0, 0, 0);
                sacc[st] = z; }
            const float cbt = CB[tq];
#pragma unroll
            for (int st = 0; st < 4; ++st)
#pragma unroll
                for (int j = 0; j < 4; ++j) { const int s = 16 * st + 4 * quad + j; const float d = (s <= tq) ? __expf(cbt + CB[64 + s]) : 0.f; sacc[st][j] *= d; }
            bf16x8 pf[2];
#pragma unroll
            for (int kk = 0; kk < 2; ++kk) { v4u pw; pw.x = pk2(sacc[2 * kk][0], sacc[2 * kk][1]); pw.y = pk2(sacc[2 * kk][2], sacc[2 * kk][3]); pw.z = pk2(sacc[2 * kk + 1][0], sacc[2 * kk + 1][1]); pw.w = pk2(sacc[2 * kk + 1][2], sacc[2 * kk + 1][3]); pf[kk] = __builtin_bit_cast(bf16x8, pw); }
            const float ebt = __expf(cbt);
            f32x4 nn[5];
#pragma unroll
            for (int x = 0; x < 5; ++x) { const int et = (x < 4) ? (4 * eh + x) : 8; f32x4 na = {0.f, 0.f, 0.f, 0.f}, ia = {0.f, 0.f, 0.f, 0.f};
#pragma unroll
                for (int kk = 0; kk < 2; ++kk) { const LAS bf16* vr = VT + (16 * et + c16) * 72 + 32 * kk + 4 * quad; const v2u lo = *(const LAS v2u*)vr, hi = *(const LAS v2u*)(vr + 16); v4u vw; vw.x = lo.x; vw.y = lo.y; vw.z = hi.x; vw.w = hi.y;
                    na = __builtin_amdgcn_mfma_f32_16x16x32_bf16(__builtin_bit_cast(bf16x8, vw), pf[kk], na, 0, 0, 0); }
#pragma unroll
                for (int ks = 0; ks < 4; ++ks) ia = __builtin_amdgcn_mfma_f32_16x16x32_bf16(*(const LAS bf16x8*)(CT + (16 * et + c16) * 136 + 32 * ks + 8 * quad), qf[ks], ia, 0, 0, 0);
                nn[x] = na + ia * ebt; }
            const float den = __shfl(nn[4][0], c16); const float inv = 1.0f / fmaxf(fabsf(den), 1.0f);
            float ss = 0.f;
#pragma unroll
            for (int x = 0; x < 4; ++x)
#pragma unroll
                for (int j = 0; j < 4; ++j) { hval[x][j] = nn[x][j] * inv; ss += hval[x][j] * hval[x][j]; }
            ss += __shfl_xor(ss, 16); ss += __shfl_xor(ss, 32);
            if (quad == 0) RED[eh * 64 + tq] = ss;
            ML_LBAR();
            const float rstd = __builtin_amdgcn_rsqf((RED[tq] + RED[64 + tq]) * (1.0f / 128.0f) + EPS);
#pragma unroll
            for (int x = 0; x < 4; ++x) { const int e = 16 * (4 * eh + x) + 4 * quad; const v2u og = ogv[x];
                const float y0 = hval[x][0] * rstd * NW[e] * bflo(og.x), y1 = hval[x][1] * rstd * NW[e + 1] * bfhi(og.x), y2 = hval[x][2] * rstd * NW[e + 2] * bflo(og.y), y3 = hval[x][3] * rstd * NW[e + 3] * bfhi(og.y);
                v2u o; o.x = pk2(y0, y1); o.y = pk2(y2, y3); *(v2u*)(hm + (size_t)(tok0 + tq) * 512 + hh * 128 + e) = o; }
        }
        { const float ebl = __expf(bl);
          bf16x8 kf[2];
#pragma unroll
          for (int kk = 0; kk < 2; ++kk) kf[kk] = *(const LAS bf16x8*)(KET + (16 * w + c16) * 72 + 32 * kk + 8 * quad);
#pragma unroll
          for (int et = 0; et < 9; ++et) { f32x4 z = cacc[et] * ebl;
#pragma unroll
              for (int kk = 0; kk < 2; ++kk) z = __builtin_amdgcn_mfma_f32_16x16x32_bf16(*(const LAS bf16x8*)(VT + (16 * et + c16) * 72 + 32 * kk + 8 * quad), kf[kk], z, 0, 0, 0);
              cacc[et] = z;
              if (L3) {
#pragma unroll
                  for (int j = 0; j < 4; ++j) CT[(16 * et + 4 * quad + j) * 136 + 16 * w + c16] = (bf16)f2bf(z[j]); } } }
        ML_LBAR();
    }
#undef ML_LOADRAW
#undef ML_LBAR
    if (!L3) {
#pragma unroll
        for (int et = 0; et < 9; ++et)
#pragma unroll
            for (int j = 0; j < 4; ++j) mlc[(16 * et + 4 * quad + j) * 128 + 16 * w + c16] = cacc[et][j];
        if (X.tid == 0) mlb[unit] = bsum;
    }
}
DI void mlstm_scan(const Args& a, const Ctx& X) {
    float* mlc = (float*)(a.ws + WS_MLC); const float* mlb = (const float*)(a.ws + WS_MLB);
    for (int idx = X.bid * 512 + X.tid; idx < 8 * 18432; idx += X.G * 512) { const int seq = idx / 18432, el = idx - seq * 18432; float carry = 0.f;
        float* p0 = mlc + (size_t)seq * 32 * 18432 + el; float v[32], dcy[32];
#pragma unroll
        for (int j = 0; j < 32; ++j) { v[j] = p0[(size_t)j * 18432]; dcy[j] = mlb[seq * 32 + j]; }
#pragma unroll
        for (int j = 0; j < 32; ++j) { p0[(size_t)j * 18432] = carry; carry = __expf(dcy[j]) * carry + v[j]; } }
}

constexpr int P6_WR = 0, P6_AT = 33024, P6_SH = 37120, P6_LG = 41216, P6_HIST = 65536;
DI void p6_norm_route(const Args& a, const Ctx& X, int l, const float* xin) {
    unsigned char* ws = a.ws;
    LAS bf16* wrb = (LAS bf16*)(X.lds + P6_WR);
    LAS float* at = (LAS float*)(X.lds + P6_AT); LAS float* sht = (LAS float*)(X.lds + P6_SH);
    LAS float* lg = (LAS float*)(X.lds + P6_LG) + X.wave * 272;
    for (int idx = X.tid; idx < 16384; idx += 512) { const int k = idx >> 4, e = idx & 15; wrb[e * 1032 + k] = (bf16)f2bf(a.router_w[idx]); }
    const float* mod = (const float*)(ws + WS_MOD); unsigned char* hb = (unsigned char*)(ws + WS_H); float* tgate = (float*)(ws + WS_TGATE); int* tokl = (int*)(ws + WS_TOKL);
    const float* ssq = (const float*)(ws + WS_SSQ);
    unsigned* cnt = (unsigned*)(ws + WS_CTL) + CW_CNT + l * 2048;
    LAS int* hist = (LAS int*)(X.lds + P6_HIST); LAS int* cbase = hist + 32;
    int lane = X.lane; asm volatile("" : "+v"(lane));
    const int r = lane & 15, q = lane >> 4;
    const int gw = X.bid * 8 + X.wave, NGW = X.G * 8;
    for (int it = 0; it * NGW < T / 16; ++it) {
        const int rg = it * NGW + gw; const bool act = rg < T / 16;
        const int row0 = (act ? rg : 0) * 16; const int bb = ((it * NGW + X.bid * 8) * 16) >> 14;
        __syncthreads();
        if (X.tid < 32) hist[X.tid] = 0;
        { const float* mb = mod + (size_t)(l * 2 + (bb < 2 ? bb : 1)) * 6144;
          for (int k = X.tid; k < 1024; k += 512) { at[k] = a.nfw[l * D + k] * (1.0f + mb[4 * 1024 + k]); sht[k] = mb[3 * 1024 + k]; } }
        __syncthreads();
        const int row = row0 + r;
        float rstd;
        { const f32x4 pp = *(const f32x4*)(ssq + (size_t)row * 16 + 4 * q); float ss = (pp.x + pp.y) + (pp.z + pp.w); ss += __shfl_xor(ss, 16); ss += __shfl_xor(ss, 32); rstd = __builtin_amdgcn_rsqf(ss * (1.0f / D) + EPS); }
        const float* xr = xin + (size_t)row * D + 8 * q; unsigned char* hr = hb + (size_t)row * D + 8 * q;
        f32x4 acc = {0.f, 0.f, 0.f, 0.f};
#pragma unroll 8
        for (int s = 0; s < 32; ++s) {
            const f32x4 x0 = *(const f32x4*)(xr + 32 * s), x1 = *(const f32x4*)(xr + 32 * s + 4);
            const f32x4 a0 = *(const LAS f32x4*)(at + 32 * s + 8 * q), a1 = *(const LAS f32x4*)(at + 32 * s + 8 * q + 4);
            const f32x4 s0 = *(const LAS f32x4*)(sht + 32 * s + 8 * q), s1 = *(const LAS f32x4*)(sht + 32 * s + 8 * q + 4);
            const f32x4 h0 = x0 * rstd * a0 + s0, h1 = x1 * rstd * a1 + s1;
            v4u w; w.x = cvt_pk_bf16(h0.x, h0.y); w.y = cvt_pk_bf16(h0.z, h0.w); w.z = cvt_pk_bf16(h1.x, h1.y); w.w = cvt_pk_bf16(h1.z, h1.w);
            { v2u w8; w8.x = pk4_fp8(h0.x, h0.y, h0.z, h0.w); w8.y = pk4_fp8(h1.x, h1.y, h1.z, h1.w); *(v2u*)(hr + 32 * s) = w8; }
            const bf16x8 bfr = *(const LAS bf16x8*)(wrb + r * 1032 + 32 * s + 8 * q);
            acc = __builtin_amdgcn_mfma_f32_16x16x32_bf16(__builtin_bit_cast(bf16x8, w), bfr, acc, 0, 0, 0);
        }
#pragma unroll
        for (int j = 0; j < 4; ++j) lg[(4 * q + j) * 17 + r] = acc[j];
        LDS_WAIT(); asm volatile("" ::: "memory");
        int my_cls = 0; float my_ga = 0.f, my_gb = 0.f;
        if (lane < 16) {
            float sc[16], sel[16];
#pragma unroll
            for (int e = 0; e < 16; ++e) { const float p = lg[lane * 17 + e]; sc[e] = 1.0f / (1.0f + __expf(-p)); sel[e] = sc[e] + a.router_b[e]; }
            int gi = 0; float gbest = -1.0e30f;
#pragma unroll
            for (int g = 0; g < 4; ++g) { const float p0 = sel[4 * g], p1 = sel[4 * g + 1], p2 = sel[4 * g + 2], p3 = sel[4 * g + 3];
                const float gs = fmaxf(fmaxf(fmaxf(p0 + p1, p0 + p2), fmaxf(p0 + p3, p1 + p2)), fmaxf(p1 + p3, p2 + p3));
                if (gs > gbest) { gbest = gs; gi = g; } }
            float qs[4], s4[4];
#pragma unroll
            for (int i = 0; i < 4; ++i) { qs[i] = 0.f; s4[i] = 0.f; }
#pragma unroll
            for (int g = 0; g < 4; ++g) if (g == gi) {
#pragma unroll
                for (int i = 0; i < 4; ++i) { qs[i] = sel[4 * g + i]; s4[i] = sc[4 * g + i]; } }
            int i1 = 0; float b1 = qs[0];
#pragma unroll
            for (int i = 1; i < 4; ++i) if (qs[i] > b1) { b1 = qs[i]; i1 = i; }
            int i2 = -1; float b2 = -1.0e30f;
#pragma unroll
            for (int i = 0; i < 4; ++i) if (i != i1 && qs[i] > b2) { b2 = qs[i]; i2 = i; }
            const int ia = (i1 < i2) ? i1 : i2, ib = (i1 < i2) ? i2 : i1;
            float sa = 0.f, sb = 0.f;
#pragma unroll
            for (int i = 0; i < 4; ++i) { if (i == ia) sa = s4[i]; if (i == ib) sb = s4[i]; }
            const int pidx = (ia == 0) ? (ib - 1) : ((ia == 1) ? (ib + 1) : 5);
            const float inv = 1.0f / (sa + sb);
            my_cls = gi * 6 + pidx; my_ga = sa * inv; my_gb = sb * inv;
        }
        int rank = 0;
        if (act && lane < 16) rank = __hip_atomic_fetch_add(hist + my_cls, 1, __ATOMIC_RELAXED, __HIP_MEMORY_SCOPE_WORKGROUP);
        __syncthreads();
        if (X.tid < NCLS) { const int n = hist[X.tid]; cbase[X.tid] = n ? (int)__hip_atomic_fetch_add(cnt + 64 * X.tid, (unsigned)n, RLX_AGENT) : 0; }
        __syncthreads();
        if (act && lane < 16) { const int tok = row0 + lane; const int pos = cbase[my_cls] + rank;
            tokl[my_cls * CLS_CAP + pos] = tok; tgate[tok * 2] = my_ga; tgate[tok * 2 + 1] = my_gb; }
    }
}
DI MoeTab moe_tables(const Args& a, const Ctx& X, int l) {
    LAS int* tab = (LAS int*)(X.lds + TAB_OFF); LAS int* tcls = tab; LAS int* tpos = tab + 160; LAS int* cn = tab + 320; LAS int* rt_ = tab + 344;
    unsigned* cnt = (unsigned*)(a.ws + WS_CTL) + CW_CNT + l * 2048;
    if (X.tid < NCLS) cn[X.tid] = (int)__hip_atomic_load(cnt + 64 * X.tid, RLX_AGENT);
    __syncthreads();
    if (X.tid == 0) { int r = 0;
#pragma unroll 1
        for (int c = 0; c < NCLS; ++c) { const int n = (cn[c] + 255) >> 8;
#pragma unroll 1
            for (int i = 0; i < n; ++i) { tcls[r] = c; tpos[r] = i * 256; ++r; } }
        rt_[0] = r; }
    __syncthreads();
    MoeTab tb; tb.tcls = tcls; tb.tpos = tpos; tb.cnt = cn; tb.Rtot = __builtin_amdgcn_readfirstlane(rt_[0]); return tb;
}

#if defined(__HIP_DEVICE_COMPILE__)
DI Args load_args() { auto p = __builtin_amdgcn_kernarg_segment_ptr(); asm volatile("" : "+s"(p)); return *(const __attribute__((address_space(4))) Args*)p; }
#else
DI Args load_args() { return Args{}; }
#endif
__global__ void __launch_bounds__(512, 2) fwd(Args a_unused) {
    extern __shared__ __attribute__((aligned(16))) unsigned char lds_raw[];
    Ctx X; X.lds = (LAS unsigned char*)lds_raw; X.tid = threadIdx.x; X.lane = X.tid & 63; X.wave = __builtin_amdgcn_readfirstlane(X.tid >> 6); X.G = gridDim.x; X.bid = blockIdx.x;
    volatile LAS unsigned* MISC = (volatile LAS unsigned*)(X.lds + MISC_OFF);
    if (X.tid < 64) MISC[X.tid] = 0u;
    __syncthreads();
    int lo, hi; unsigned* ctl;
    { const Args a = load_args(); lo = a.ph_lo; hi = a.ph_hi; ctl = (unsigned*)(a.ws + WS_CTL); }
    XcdBarrier bar; bar.bar = ctl + CW_BAR; bar.x = 0; bar.st = MISC + 8;
    if (hi - lo > 1) bar = xcd_barrier_post(ctl + CW_BAR, MISC + 8);
#ifndef PH_MASK
#define PH_MASK 0xFFFFF
#endif
#define PON(p) ((PH_MASK >> (p)) & 1)
#ifndef DUP_MASK
#define DUP_MASK 0
#endif
#define NREP(p) (((DUP_MASK >> (p)) & 1) ? 2 : 1)
#ifndef TSEL_MASK
#define TSEL_MASK 0
#endif
#define TSCALE 4
#define TSEL(p) ((TSEL_MASK >> (p)) & 1)
#define IN(k) (lo <= (k) && (k) < hi)
#define SEAM(k) do { if (IN(k) && IN((k) + 1)) xcd_barrier(bar); } while (0)
    unsigned long long tacc = 0ull, tph = 0ull;
#define TBEG() do { if (TSEL_MASK) tph = __builtin_amdgcn_s_memrealtime(); } while (0)
#define TEND(p) do { if (TSEL(p)) tacc += __builtin_amdgcn_s_memrealtime() - tph; } while (0)
    TBEG();
    if (PON(10) && IN(0)) { for (int rep = 0; rep < NREP(10); ++rep) { const Args a = load_args(); p0_prologue(a, X); } }
    SEAM(0); TEND(10);
    TBEG();
    for (int l = 0; l < NL; ++l) {
        const int g0 = 1 + l * NPH;
        if (PON(0) && IN(g0 + 0)) { for (int rep = 0; rep < NREP(0); ++rep) { const Args a = load_args(); unsigned char* ws = a.ws; const float* mod = (const float*)(ws + WS_MOD); bf16* proj = (bf16*)(ws + WS_PROJ); const float* xin = (l == 0) ? a.x : a.out; (void)mod; (void)proj; (void)xin; const Ctx P = fresh(X); p1_norm_gates(a, P, l, xin); } }
        SEAM(g0 + 0); TEND(0); TBEG();
        if (PON(1) && IN(g0 + 1)) for (int rep = 0; rep < NREP(1); ++rep) { const Args a = load_args(); unsigned char* ws = a.ws; const float* mod = (const float*)(ws + WS_MOD); bf16* proj = (bf16*)(ws + WS_PROJ); const float* xin = (l == 0) ? a.x : a.out; (void)mod; (void)proj; (void)xin; const Ctx P = fresh(X);
            DenseSched S; S.A = (const char*)(ws + WS_H); S.Bt = (const char*)(ws + WS_WIN) + (size_t)l * NPROJW * D; S.lda = D; S.ldb = D; S.ord.init(T / 256, NPROJW / 256, P.G, P.bid);
            EpiProj E; E.O = proj; E.gates = (float*)(ws + WS_GATES); E.big = a.b_ig + l * 4; E.bfg = a.b_fg + l * 4;
            pg8::gemm_phase<EpiProj, DenseSched, true>(P.lds, D, S, E);
        }
        SEAM(g0 + 1); TEND(1); TBEG();
        if (PON(2) && IN(g0 + 2)) { const Args a = load_args(); unsigned char* ws = a.ws; const float* mod = (const float*)(ws + WS_MOD); bf16* proj = (bf16*)(ws + WS_PROJ); const float* xin = (l == 0) ? a.x : a.out; (void)mod; (void)proj; (void)xin; const Ctx P = fresh(X);
            if (PON(11)) for (int rep = 0; rep < NREP(11); ++rep) {
#pragma unroll 1
                for (int u = P.bid; u < 512; u += P.G) attn_unit(a, P, l, u); }
            if (PON(12)) for (int rep = 0; rep < NREP(12); ++rep) {
#pragma unroll 1
                for (int u = P.bid; u < 256; u += P.G) mlstm_unit<false>(a, P, l, u); }
        }
        SEAM(g0 + 2); TEND(2); TBEG();
        if (PON(3) && IN(g0 + 3)) { const Args a = load_args(); unsigned char* ws = a.ws; const float* mod = (const float*)(ws + WS_MOD); bf16* proj = (bf16*)(ws + WS_PROJ); const float* xin = (l == 0) ? a.x : a.out; (void)mod; (void)proj; (void)xin; const Ctx P = fresh(X); mlstm_scan(a, P); }
        SEAM(g0 + 3); TEND(3); TBEG();
        if (PON(4) && IN(g0 + 4)) for (int rep = 0; rep < NREP(4); ++rep) { const Args a = load_args(); unsigned char* ws = a.ws; const float* mod = (const float*)(ws + WS_MOD); bf16* proj = (bf16*)(ws + WS_PROJ); const float* xin = (l == 0) ? a.x : a.out; (void)mod; (void)proj; (void)xin; const Ctx P = fresh(X);
#pragma unroll 1
            for (int u = P.bid; u < 256; u += P.G) mlstm_unit<true>(a, P, l, u); }
        SEAM(g0 + 4); TEND(4); TBEG();
        if (PON(5) && IN(g0 + 5)) for (int rep = 0; rep < NREP(5); ++rep) { const Args a = load_args(); unsigned char* ws = a.ws; const float* mod = (const float*)(ws + WS_MOD); bf16* proj = (bf16*)(ws + WS_PROJ); const float* xin = (l == 0) ? a.x : a.out; (void)mod; (void)proj; (void)xin; const Ctx P = fresh(X);
            { DenseSched S; S.A = (const char*)(ws + WS_H); S.Bt = (const char*)(ws + WS_WAU) + (size_t)l * D * 512 * 2; S.lda = 1024; S.ldb = 1024; S.ord.init(T / 256, D / 256, P.G, P.bid);
              EpiGate<false> E; E.P = proj; E.gcol = C_GA; pg8::gemm_phase<EpiGate<false>, DenseSched>(P.lds, 1024, S, E); }
            { DenseSched S; S.A = (const char*)(ws + WS_H) + (size_t)T * 512 * 2; S.Bt = (const char*)(ws + WS_WMU) + (size_t)l * D * 512 * 2; S.lda = 1024; S.ldb = 1024; S.ord.init(T / 256, D / 256, P.G, P.bid);
              EpiGate<true> E; E.P = proj; E.gcol = C_GB; pg8::gemm_phase<EpiGate<true>, DenseSched>(P.lds, 1024, S, E); }
        }
        SEAM(g0 + 5); TEND(5); TBEG();
        if (PON(6) && IN(g0 + 6)) for (int rep = 0; rep < NREP(6); ++rep) { const Args a = load_args(); unsigned char* ws = a.ws; const float* mod = (const float*)(ws + WS_MOD); bf16* proj = (bf16*)(ws + WS_PROJ); const float* xin = (l == 0) ? a.x : a.out; (void)mod; (void)proj; (void)xin; const Ctx P = fresh(X);
            DenseSched S; S.A = (const char*)(proj + C_MQ); S.Bt = (const char*)(ws + WS_WOUT) + (size_t)l * D * D * 2; S.lda = NPROJ * 2; S.ldb = D * 2; S.ord.init(T / 256, D / 256, P.G, P.bid);
            EpiRes E; E.xin = xin; E.out = a.out; E.g = mod + (size_t)(l * 2) * 6144 + 2 * 1024; E.ssq = (float*)(ws + WS_SSQ); E.rmask = T - 1;
            if (rep) { E.out = (float*)(ws + WS_H); E.rmask = T / 2 - 1; }
            pg8::gemm_phase<EpiRes, DenseSched>(P.lds, D * 2, S, E);
        }
        SEAM(g0 + 6); TEND(6); TBEG();
        if (PON(7) && IN(g0 + 7)) { const Args a = load_args(); unsigned char* ws = a.ws; const float* mod = (const float*)(ws + WS_MOD); bf16* proj = (bf16*)(ws + WS_PROJ); const float* xin = (l == 0) ? a.x : a.out; (void)mod; (void)proj; (void)xin; const Ctx P = fresh(X); p6_norm_route(a, P, l, a.out); }
        SEAM(g0 + 7); TEND(7); TBEG();
        if (PON(8) && IN(g0 + 8)) for (int rep = 0; rep < NREP(8); ++rep) { const Args a = load_args(); unsigned char* ws = a.ws; const float* mod = (const float*)(ws + WS_MOD); bf16* proj = (bf16*)(ws + WS_PROJ); const float* xin = (l == 0) ? a.x : a.out; (void)mod; (void)proj; (void)xin; const Ctx P = fresh(X);
            const MoeTab tb = moe_tables(a, P, l);
            LAS unsigned* tokoff = (LAS unsigned*)(P.lds + TOKOFF_OFF); const int* tokl = (const int*)(ws + WS_TOKL);
#pragma unroll 1
            for (int s = 0; s < 8; ++s) { const int L0 = s * P.G + P.bid;
                if (L0 < tb.Rtot * 8 && P.tid < 256) { const int L = xcd_remap(L0, tb.Rtot * 8); const int rt = L >> 3, cls = tb.tcls[rt], pos = tb.tpos[rt] + P.tid, cn = tb.cnt[cls]; const int tok = tokl[cls * CLS_CAP + (pos < cn ? pos : 0)]; tokoff[s * 256 + P.tid] = (unsigned)tok; } }
            __syncthreads();
            MoeUpSched S; S.A = (const char*)(ws + WS_H); S.W = (const char*)(ws + WS_WGU) + (size_t)l * NE * 1024 * D; S.lda = D; S.ldb = D; S.tb = tb; S.G = P.G; S.c = P.bid; S.tokoff = tokoff;
            EpiSwiglu E; E.H = proj; E.tgate = (const float*)(ws + WS_TGATE); E.tokoff = tokoff;
            pg8::gemm_phase<EpiSwiglu, MoeUpSched, true>(P.lds, D, S, E);
        }
        SEAM(g0 + 8); TEND(8); TBEG();
        if (PON(9) && IN(g0 + 9)) for (int rep = 0; rep < NREP(9); ++rep) { const Args a = load_args(); unsigned char* ws = a.ws; const float* mod = (const float*)(ws + WS_MOD); bf16* proj = (bf16*)(ws + WS_PROJ); const float* xin = (l == 0) ? a.x : a.out; (void)mod; (void)proj; (void)xin; const Ctx P = fresh(X);
            const MoeTab tb = moe_tables(a, P, l);
            MoeDownSched S; S.A = (const char*)proj; S.W = (const char*)(ws + WS_WD) + (size_t)l * NE * 1024 * FF * 2; S.lda = D * 2; S.ldb = FF * 2; S.tb = tb; S.G = P.G; S.c = P.bid;
            EpiMoeOut E; E.xin = a.out; E.out = a.out; E.g = mod + (size_t)(l * 2) * 6144 + 5 * 1024; E.tokl = (const int*)(ws + WS_TOKL); E.tb = tb; E.rmask = T - 1;
            if (rep) { E.out = (float*)(ws + WS_H); E.rmask = T / 2 - 1; }
            pg8::gemm_phase<EpiMoeOut, MoeDownSched>(P.lds, D * 2, S, E);
        }
        SEAM(g0 + 9); TEND(9); TBEG();
    }
    if (TSEL_MASK && X.bid == 0) { const unsigned long long t1 = __builtin_amdgcn_s_memrealtime(); while (__builtin_amdgcn_s_memrealtime() - t1 < TSCALE * tacc) __builtin_amdgcn_s_sleep(8); }
#undef IN
#undef SEAM
}

extern "C" void kernel_launch(void* const* d_in, const int* in_sizes, int n_in, void* d_out, int out_size, void* d_ws, size_t ws_size, hipStream_t stream) {
    static int grid = 0;
    if (grid == 0) {
        if (n_in != 24 || in_sizes[0] != T * D || out_size != T * D || ws_size < WS_END) { fprintf(stderr, "kernel_launch: unexpected shapes / workspace (n_in %d, ws %zu, need %zu)\n", n_in, ws_size, (size_t)WS_END); grid = -1; return; }
        int dev = 0, cus = 0;
        if (hipGetDevice(&dev) != hipSuccess || hipDeviceGetAttribute(&cus, hipDeviceAttributeMultiprocessorCount, dev) != hipSuccess) { grid = -1; return; }
        if (hipFuncSetAttribute((const void*)fwd, hipFuncAttributeMaxDynamicSharedMemorySize, LDS_BYTES) != hipSuccess) { fprintf(stderr, "kernel_launch: hipFuncSetAttribute failed\n"); grid = -1; return; }
        int per_cu = 0;
        if (hipOccupancyMaxActiveBlocksPerMultiprocessor(&per_cu, (const void*)fwd, 512, LDS_BYTES) != hipSuccess || per_cu < 1) fprintf(stderr, "kernel_launch: occupancy query reports %d\n", per_cu);
        (void)hipGetLastError();
        grid = cus < 256 ? cus : 256;
    }
    if (grid < 0) return;
    (void)hipMemsetAsync((char*)d_ws + WS_CTL, 0, CTL_ZERO_BYTES, stream);
    Args a{};
    a.x = (const float*)d_in[0]; a.c = (const float*)d_in[1]; a.pos = (const int*)d_in[2]; a.ada_w = (const float*)d_in[3]; a.ada_b = (const float*)d_in[4];
    a.nmw = (const float*)d_in[5]; a.nfw = (const float*)d_in[6]; a.w_in = (const float*)d_in[7]; a.b_ig = (const float*)d_in[8]; a.b_fg = (const float*)d_in[9];
    a.qnw = (const float*)d_in[10]; a.knw = (const float*)d_in[11]; a.sinks = (const float*)d_in[12]; a.conv_w = (const float*)d_in[13]; a.conv_b = (const float*)d_in[14];
    a.mnw = (const float*)d_in[15]; a.w_au = (const float*)d_in[16]; a.w_mu = (const float*)d_in[17]; a.w_out = (const float*)d_in[18]; a.router_w = (const float*)d_in[19];
    a.router_b = (const float*)d_in[20]; a.w_gate = (const float*)d_in[21]; a.w_up = (const float*)d_in[22]; a.w_down = (const float*)d_in[23];
    a.out = (float*)d_out; a.ws = (unsigned char*)d_ws;
#if MK_MULTI
    for (int gp = 0; gp < NGP; ++gp) { a.ph_lo = gp; a.ph_hi = gp + 1; hipLaunchKernelGGL(fwd, dim3(grid), dim3(512), LDS_BYTES, stream, a); }
#else
    a.ph_lo = 0; a.ph_hi = NGP; hipLaunchKernelGGL(fwd, dim3(grid), dim3(512), LDS_BYTES, stream, a);
#endif
}
```

```cpp
#include <hip/hip_runtime.h>
#include <cstdio>
#include <cstdint>

#ifndef MK_MULTI
#define MK_MULTI 0
#endif

#define GAS __attribute__((address_space(1)))
#define LAS __attribute__((address_space(3)))
typedef unsigned short bf16;
typedef unsigned v4u __attribute__((ext_vector_type(4)));
typedef unsigned v2u __attribute__((ext_vector_type(2)));
typedef float f32x4 __attribute__((ext_vector_type(4)));
typedef float f32x2 __attribute__((ext_vector_type(2)));
typedef short bf16x8 __attribute__((ext_vector_type(8)));
typedef short bf16x4 __attribute__((ext_vector_type(4)));
#define DI __device__ __forceinline__
#define RLX_AGENT __ATOMIC_RELAXED, __HIP_MEMORY_SCOPE_AGENT
#define LDS_WAIT() asm volatile("s_waitcnt lgkmcnt(0)" ::: "memory")
#define VM_WAIT() asm volatile("s_waitcnt vmcnt(0)" ::: "memory")

constexpr int NB = 2, SEQ = 16384, T = NB * SEQ, D = 1024, NL = 4;
constexpr int DIN_SRC = 4872;
constexpr int NPROJ = 4864;
constexpr int C_AQ = 0, C_AK = 512, C_AV = 640, C_MQ = 768, C_MK = 1280, C_MV = 1792, C_MO = 2304, C_GA = 2816, C_GB = 3840;
constexpr int NE = 16, FF = 512;
constexpr int NCLS = 24, CLS_CAP = 32768;
constexpr float EPS = 1e-6f;
constexpr int NPH = 10;
constexpr int NGP = 1 + NL * NPH;

constexpr size_t MiB = 1u << 20;
constexpr size_t WS_CTL = 0, CTL_ZERO_BYTES = 1 * MiB;
constexpr size_t WS_MOD = 1 * MiB;
constexpr size_t WS_ROPE = 2 * MiB;
constexpr size_t WS_GATES = 4 * MiB;
constexpr size_t WS_TGATE = 5 * MiB;
constexpr size_t WS_TOKL = 6 * MiB;
constexpr size_t WS_MLB = 9 * MiB;
constexpr size_t WS_MLC = 10 * MiB;
constexpr int NPROJW = 5120;
constexpr size_t WS_WIN = 28 * MiB;
constexpr size_t WS_WAU = 68 * MiB;
constexpr size_t WS_WMU = 72 * MiB;
constexpr size_t WS_WOUT = 76 * MiB;
constexpr size_t WS_WGU = 84 * MiB;
constexpr size_t WS_WD = 148 * MiB;
constexpr size_t WS_H = 212 * MiB;
constexpr size_t WS_PROJ = 276 * MiB;
constexpr size_t WS_SSQ = 580 * MiB;
constexpr size_t WS_KC = 582 * MiB;
constexpr size_t WS_XB = 614 * MiB;
constexpr size_t WS_END = 678 * MiB;

constexpr int CW_TMO = 0;
constexpr int CW_BAR = 4096;
constexpr int CW_CNT = 8192;

constexpr int RING_BYTES = 131072;
constexpr int MISC_OFF = RING_BYTES;
constexpr int TAB_OFF = RING_BYTES + 256;
constexpr int TOKOFF_OFF = RING_BYTES + 2048;
constexpr int LDS_BYTES = 147456;

DI unsigned f2bf(float f) { unsigned u = __builtin_bit_cast(unsigned, f); return (u + 0x7fffu + ((u >> 16) & 1u)) >> 16; }
DI unsigned pk2(float lo, float hi) { return f2bf(lo) | (f2bf(hi) << 16); }
DI float bf2f(unsigned short b) { return __builtin_bit_cast(float, ((unsigned)b) << 16); }
DI float bflo(unsigned w) { return __builtin_bit_cast(float, w << 16); }
DI float bfhi(unsigned w) { return __builtin_bit_cast(float, w & 0xffff0000u); }
DI float wave_sum(float v) {
#pragma unroll
    for (int o = 1; o < 64; o <<= 1) v += __shfl_xor(v, o);
    return v;
}
DI float sigmoidf_(float x) { return __builtin_amdgcn_rcpf(1.0f + __expf(-x)); }

#define XB_TMO      128
#define XB_XCNT(j)  (256  + 64 * (j))
#define XB_XSUB(j)  (1280 + 64 * (j))
#define XB_XGEN(j)  (2304 + 64 * (j))
#define XB_TOP      3328
#define XB_TOPGEN   3392
#define XCD_BAR_WORDS 3456
#define XB_SPIN_CAP (1u << 18)
__device__ __forceinline__ unsigned xb_ld(unsigned* p)              { return __hip_atomic_load(p, __ATOMIC_RELAXED, __HIP_MEMORY_SCOPE_AGENT); }
__device__ __forceinline__ unsigned xb_add(unsigned* p, unsigned v) { return __hip_atomic_fetch_add(p, v, __ATOMIC_RELAXED, __HIP_MEMORY_SCOPE_AGENT); }
__device__ __forceinline__ unsigned xb_xcc_id() { return (unsigned)__builtin_amdgcn_s_getreg((3 << 11) | 20) & 0xFu; }
#define XB_SPIN(cond, bar) do { unsigned _sp = 0; while (cond) { __builtin_amdgcn_s_sleep(1); \
    if ((++_sp & 255u) == 0u) { if (xb_ld(&(bar)[XB_TMO])) break; if (_sp > XB_SPIN_CAP) { atomicAdd(&(bar)[XB_TMO], 1u); break; } } } } while (0)
struct XcdBarrier { unsigned* bar; unsigned x; volatile LAS unsigned* st; };
__device__ __forceinline__ XcdBarrier xcd_barrier_post(unsigned* bar, volatile LAS unsigned* st) {
    XcdBarrier b; b.bar = bar; b.x = xb_xcc_id(); b.st = st;
    if (threadIdx.x == 0) (void)xb_add(&bar[XB_XCNT(b.x)], 1u);
    return b;
}
__device__ __forceinline__ void xcd_barrier_complete(unsigned* bar, unsigned x, unsigned& nloc, unsigned& nx) {
    const unsigned G = gridDim.x * gridDim.y * gridDim.z;
    unsigned sum, cnt, mine, sp = 0u;
    for (;;) {
        sum = 0u; cnt = 0u; mine = 0u;
#pragma unroll
        for (unsigned j = 0; j < 16; ++j) { const unsigned c = xb_ld(&bar[XB_XCNT(j)]); sum += c; cnt += (c > 0u) ? 1u : 0u; mine = (j == x) ? c : mine; }
        if (sum == G) break;
        __builtin_amdgcn_s_sleep(1);
        if ((++sp & 255u) == 0u) { if (xb_ld(&bar[XB_TMO])) break; if (sp > XB_SPIN_CAP) { atomicAdd(&bar[XB_TMO], 1u); break; } }
    }
    nloc = mine > 0u ? mine : 1u; nx = cnt > 0u ? cnt : 1u;
}
__device__ __forceinline__ void xcd_barrier(const XcdBarrier& b) {
    asm volatile("s_waitcnt vmcnt(0)" ::: "memory");
    __syncthreads();
    if (threadIdx.x == 0) {
        unsigned* bar = b.bar;
        __builtin_amdgcn_s_waitcnt(0);
        unsigned nloc = b.st[0], nx = b.st[1];
        if (nloc == 0u) { xcd_barrier_complete(bar, b.x, nloc, nx); b.st[0] = nloc; b.st[1] = nx; }
        const unsigned old = xb_add(&bar[XB_XSUB(b.x)], 1u);
        const unsigned gen = old / nloc;
        if (old + 1u == (gen + 1u) * nloc) {
            __builtin_amdgcn_fence(__ATOMIC_RELEASE, "agent");
            asm volatile("s_waitcnt vmcnt(0)" ::: "memory");
            const unsigned og = xb_add(&bar[XB_TOP], 1u);
            const unsigned tg = og / nx;
            if (og + 1u == (tg + 1u) * nx) xb_add(&bar[XB_TOPGEN], 1u);
            else XB_SPIN(xb_ld(&bar[XB_TOPGEN]) == tg, bar);
            __builtin_amdgcn_fence(__ATOMIC_ACQUIRE, "agent");
            xb_add(&bar[XB_XGEN(b.x)], 1u);
            asm volatile("s_waitcnt vmcnt(0)" ::: "memory");
        } else {
            XB_SPIN(xb_ld(&bar[XB_XGEN(b.x)]) == gen, bar);
            __builtin_amdgcn_fence(__ATOMIC_ACQUIRE, "agent");
            asm volatile("s_waitcnt vmcnt(0)" ::: "memory");
        }
    }
    __syncthreads();
}

namespace pg8 {
constexpr int BM = 256, BK = 64, HALF = 128, HTB = HALF * BK * 2, STAGE_BYTES = 8 * HTB, NXCD = 8, WGM = 8;
__host__ __device__ __forceinline__ int lds_byte(int r, int c) { const int st = (r >> 4) * 2 + (c >> 5), rr = r & 15, cc = c & 31, ob = rr * 64 + cc * 2; return st * 1024 + (ob ^ (((ob >> 9) & 1) << 5)); }
__host__ __device__ __forceinline__ void stage_rc(int b, int& R, int& C) { const int st = b / 1024, sb = b % 1024, swz = sb ^ (((sb >> 9) & 1) << 5); R = (st >> 1) * 16 + swz / 64; C = (st & 1) * 32 + (swz % 64) / 2; }
__host__ __device__ __forceinline__ int perm32(int rho) { const int n = rho >> 4, i = rho & 15; return 8 * (i >> 2) + 4 * n + (i & 3); }

struct Unit { int pm, pn, x0, x1; };

struct TileOrder {
    int nM, nN, nwg, G, c;
    __device__ void init(int nM_, int nN_, int G_, int c_) { nM = nM_; nN = nN_; nwg = nM * nN; G = G_; c = c_; }
    __device__ bool get(int i, int& pm, int& pn) const {
        const long L = (long)i * G + c; if (L >= nwg) return false;
        int wgid = (int)L; { const int q = nwg / NXCD, r = nwg % NXCD, xcd = wgid % NXCD, off = wgid / NXCD; wgid = (xcd < r ? xcd * (q + 1) : r * (q + 1) + (xcd - r) * q) + off; }
        const int nig = WGM * nN, gid = wgid / nig, fm = gid * WGM, gsz = (nM - fm) < WGM ? (nM - fm) : WGM;
        pm = fm + ((wgid % nig) % gsz); pn = (wgid % nig) / gsz; return true;
    }
};

typedef int v8i __attribute__((ext_vector_type(8)));
template <class Epi, class Sched, bool F8 = false>
__device__ __forceinline__ void gemm_phase(LAS unsigned char* lds, const int Kb, const Sched& S, const Epi& E) {
    int tid = threadIdx.x; asm volatile("" : "+v"(tid));
    const int wid = __builtin_amdgcn_readfirstlane(tid >> 6), lane = tid & 63, wr = wid >> 2, wc = wid & 3, fr = lane & 15, fq = lane >> 4;
    const int nt = Kb / 128;
    constexpr bool GA = Sched::GATHER; constexpr int KS = Sched::KSPLIT;
    unsigned voffA[2], voffB[2]; int Rst[2], Cst[2];
#pragma unroll
    for (int i = 0; i < 2; ++i) { int R, C; stage_rc(tid * 16 + i * 8192, R, C); const int Rb = Epi::PERM ? ((R & ~31) + perm32(R & 31)) : R;
        voffA[i] = (unsigned)(R * S.lda + C * 2); voffB[i] = (unsigned)(Rb * S.ldb + C * 2); Rst[i] = R; Cst[i] = C; }
    const size_t kstep = (size_t)(BK * 2);
    const size_t hstepA = (size_t)HALF * S.lda, hstepB = (size_t)HALF * S.ldb;
    const unsigned ldsw = (unsigned)wid * 1024u; const unsigned gmul = (unsigned)S.lda;
    const int aoff = F8 ? (lds_byte(wr * 64 + fr, (fq & 1) * 16) + (fq >> 1) * 1024) : lds_byte(wr * 64 + fr, fq * 8);
    const int boff = F8 ? (lds_byte(wc * 32 + fr, (fq & 1) * 16) + (fq >> 1) * 1024) : lds_byte(wc * 32 + fr, fq * 8);
    unsigned vAc[2], vAn[2];
#define PG8_SA(b, h) (((b) * 2 + (h)) * HTB)
#define PG8_SB(b, h) ((4 + (b) * 2 + (h)) * HTB)
#define PG8_STAGE2(bufoff, gbase, v0, v1) do { \
        __builtin_amdgcn_global_load_lds((const unsigned*)((const char*)(gbase) + (v0)), (LAS unsigned*)(lds + (bufoff) + ldsw), 16, 0, 0); \
        __builtin_amdgcn_global_load_lds((const unsigned*)((const char*)(gbase) + (v1)), (LAS unsigned*)(lds + (bufoff) + ldsw + 8192), 16, 0, 0); } while (0)
#define PG8_STAGE_B(bufoff, ptr, h) PG8_STAGE2(bufoff, (ptr) + (h) * hstepB, voffB[0], voffB[1])
#define PG8_STAGE_A(bufoff, ptr, h, nx) do { if constexpr (GA) { const unsigned _p = (nx) ? vAn[h] : vAc[h]; PG8_STAGE2(bufoff, ptr, (_p & 0xffffu) * gmul + (unsigned)Cst[0] * 2u, (_p >> 16) * gmul + (unsigned)Cst[0] * 2u); } \
        else { PG8_STAGE2(bufoff, (ptr) + (h) * hstepA, voffA[0], voffA[1]); } } while (0)
    typedef int v4i_ __attribute__((ext_vector_type(4)));
#define PG8_LDA(dst, b, h) do { _Pragma("unroll") for (int m = 0; m < 4; ++m) { if constexpr (F8) { dst##8[m].lo = *(const LAS v4i_*)(lds + PG8_SA(b, h) + aoff + m * 2048); dst##8[m].hi = *(const LAS v4i_*)(lds + PG8_SA(b, h) + aoff + m * 2048 + 16); } \
        else { _Pragma("unroll") for (int k = 0; k < 2; ++k) dst[m][k] = *(const LAS bf16x8*)(lds + PG8_SA(b, h) + aoff + m * 2048 + k * 1024); } } } while (0)
#define PG8_LDB(dst, b, h) do { _Pragma("unroll") for (int n = 0; n < 2; ++n) { if constexpr (F8) { dst##8[n].lo = *(const LAS v4i_*)(lds + PG8_SB(b, h) + boff + n * 2048); dst##8[n].hi = *(const LAS v4i_*)(lds + PG8_SB(b, h) + boff + n * 2048 + 16); } \
        else { _Pragma("unroll") for (int k = 0; k < 2; ++k) dst[n][k] = *(const LAS bf16x8*)(lds + PG8_SB(b, h) + boff + n * 2048 + k * 1024); } } } while (0)
#define PG8_MMA(ai, bj, At, Bt) do { __builtin_amdgcn_s_setprio(1); _Pragma("unroll") for (int m = 0; m < 4; ++m) _Pragma("unroll") for (int n = 0; n < 2; ++n) { \
        if constexpr (F8) { asm volatile("v_mfma_scale_f32_16x16x128_f8f6f4 %0, %1, %2, %0, %3, %3 op_sel_hi:[0,0,0]" : "+v"(acc[ai][bj][m][n]) : "v"(Bt##8[n]), "v"(At##8[m]), "v"(f8scale)); } \
        else { _Pragma("unroll") for (int k = 0; k < 2; ++k) acc[ai][bj][m][n] = __builtin_amdgcn_mfma_f32_16x16x32_bf16(Bt[n][k], At[m][k], acc[ai][bj][m][n], 0, 0, 0); } } \
        __builtin_amdgcn_s_setprio(0); } while (0)
#define PG8_WAIT_V(n) asm volatile("s_waitcnt vmcnt(" #n ")" ::: "memory")
#define PG8_WAIT_L(n) asm volatile("s_waitcnt lgkmcnt(" #n ")" ::: "memory")
#define PG8_BAR __builtin_amdgcn_s_barrier()
#define PG8_SCHED __builtin_amdgcn_sched_barrier(0)
#define PG8_GOFF(dst, u) do { if constexpr (GA) { _Pragma("unroll") for (int h = 0; h < 2; ++h) dst[h] = S.a_rowoff(u, Rst[0] + HALF * h) | (S.a_rowoff(u, Rst[0] + 64 + HALF * h) << 16); } } while (0)
    Unit cur, nxt; int ui = 0;
    if (!S.next(0, cur)) return;
    f32x4 acc[2][2][4][2];
#pragma unroll
    for (int a = 0; a < 2; ++a)
#pragma unroll
        for (int b = 0; b < 2; ++b)
#pragma unroll
            for (int m = 0; m < 4; ++m)
#pragma unroll
                for (int n = 0; n < 2; ++n) acc[a][b][m][n] = (f32x4){0.f, 0.f, 0.f, 0.f};
    int f8scale = 0x7F7F7F7F; asm volatile("" : "+v"(f8scale));
    bf16x8 At[4][2], B0[2][2], B1[2][2]; v8i At8[4], B08[2], B18[2];
    const char* cA = S.a_base(cur); const char* cB0 = S.b_base(cur, 0); const char* cB1 = KS ? S.b_base(cur, 1) : cB0;
    PG8_GOFF(vAc, cur);
    vAn[0] = vAc[0]; vAn[1] = vAc[1];
    PG8_STAGE_B(PG8_SB(0, 0), cB0, 0); PG8_STAGE_B(PG8_SB(0, 1), cB0, 1); PG8_STAGE_A(PG8_SA(0, 0), cA, 0, false); PG8_STAGE_A(PG8_SA(0, 1), cA, 1, false);
    if (wr == 1) PG8_BAR;
    PG8_WAIT_V(2); PG8_BAR;
    PG8_STAGE_B(PG8_SB(1, 0), cB0 + kstep, 0); PG8_STAGE_A(PG8_SA(1, 0), cA + kstep, 0, false); PG8_STAGE_B(PG8_SB(1, 1), cB0 + kstep, 1);
    PG8_WAIT_V(6); PG8_BAR;
    for (;;) {
        const bool has_next = S.next(ui + 1, nxt);
        const char* nA = has_next ? S.a_base(nxt) : cA; const char* nB0 = has_next ? S.b_base(nxt, 0) : cB0; const char* nB1 = (KS && has_next) ? S.b_base(nxt, 1) : (KS ? cB1 : nB0);
        if constexpr (GA) { if (has_next) { PG8_GOFF(vAn, nxt); } }
#pragma unroll 1
        for (int t = 0; t < nt; t += 2) {
            const bool last = (t == nt - 2);
            const char* a1 = cA + (size_t)(t + 1) * kstep;
            const char* a2 = last ? nA : cA + (size_t)(t + 2) * kstep;
            const char* b2 = last ? nB0 : ((KS && (t + 2) >= KS) ? cB1 + (size_t)(t + 2 - KS) * kstep : cB0 + (size_t)(t + 2) * kstep);
            const char* a3 = a2 + kstep; const char* b3 = b2 + kstep;
            PG8_LDB(B0, 0, 0); PG8_LDB(B1, 0, 1); PG8_SCHED; PG8_LDA(At, 0, 0); PG8_STAGE_A(PG8_SA(1, 1), a1, 1, false);
            PG8_WAIT_V(8); PG8_WAIT_L(0); PG8_BAR; PG8_MMA(0, 0, At, B0); PG8_MMA(0, 1, At, B1); PG8_BAR; PG8_SCHED;
            PG8_LDA(At, 0, 1); PG8_STAGE_B(PG8_SB(0, 0), b2, 0); PG8_STAGE_B(PG8_SB(0, 1), b2, 1); PG8_STAGE_A(PG8_SA(0, 0), a2, 0, last);
            PG8_WAIT_V(8); PG8_WAIT_L(0); PG8_BAR; PG8_MMA(1, 0, At, B0); PG8_MMA(1, 1, At, B1); PG8_BAR; PG8_SCHED;
            PG8_LDB(B0, 1, 0); PG8_LDB(B1, 1, 1); PG8_SCHED; PG8_LDA(At, 1, 0); PG8_STAGE_A(PG8_SA(0, 1), a2, 1, last);
            PG8_WAIT_V(8); PG8_WAIT_L(0); PG8_BAR; PG8_MMA(0, 0, At, B0); PG8_MMA(0, 1, At, B1); PG8_BAR; PG8_SCHED;
            PG8_LDA(At, 1, 1); PG8_STAGE_B(PG8_SB(1, 0), b3, 0); PG8_STAGE_B(PG8_SB(1, 1), b3, 1); PG8_STAGE_A(PG8_SA(1, 0), a3, 0, last);
            PG8_WAIT_V(8); PG8_WAIT_L(0); PG8_BAR; PG8_MMA(1, 0, At, B0); PG8_MMA(1, 1, At, B1); PG8_BAR; PG8_SCHED;
        }
        if (wr == 0) PG8_BAR;
        if constexpr (F8) { asm volatile("s_nop 15\n\ts_nop 15" ::: "memory"); }
        { int fr_ = fr, fq_ = fq; asm volatile("" : "+v"(fr_), "+v"(fq_));
          E(acc, cur, wr, wc, fr_, fq_); }
        if (!has_next) break;
#pragma unroll
        for (int a = 0; a < 2; ++a)
#pragma unroll
            for (int b = 0; b < 2; ++b)
#pragma unroll
                for (int m = 0; m < 4; ++m)
#pragma unroll
                    for (int n = 0; n < 2; ++n) acc[a][b][m][n] = (f32x4){0.f, 0.f, 0.f, 0.f};
        cur = nxt; cA = nA; cB0 = nB0; cB1 = nB1; ++ui;
        vAc[0] = vAn[0]; vAc[1] = vAn[1];
        if (wr == 1) PG8_BAR;
    }
    PG8_WAIT_V(0);
    PG8_BAR;
#undef PG8_SA
#undef PG8_SB
#undef PG8_STAGE2
#undef PG8_STAGE_A
#undef PG8_STAGE_B
#undef PG8_LDA
#undef PG8_LDB
#undef PG8_MMA
#undef PG8_WAIT_V
#undef PG8_WAIT_L
#undef PG8_BAR
#undef PG8_SCHED
#undef PG8_GOFF
}
}
using pg8::Unit;

DI unsigned cvt_pk_bf16(float lo, float hi) { unsigned r; asm volatile("v_cvt_pk_bf16_f32 %0, %1, %2" : "=v"(r) : "v"(lo), "v"(hi)); return r; }

struct Args {
    const float* x; const float* c; const int* pos; const float* ada_w; const float* ada_b; const float* nmw; const float* nfw; const float* w_in;
    const float* b_ig; const float* b_fg; const float* qnw; const float* knw; const float* sinks; const float* conv_w; const float* conv_b; const float* mnw;
    const float* w_au; const float* w_mu; const float* w_out; const float* router_w; const float* router_b; const float* w_gate; const float* w_up; const float* w_down;
    float* out; unsigned char* ws; int ph_lo, ph_hi;
};

__constant__ float c_invf[8] = {1.0f, 0.1939227432012558f, 0.03760603070259094f, 0.007292664609849453f, 0.0014142135623842478f, 0.00027424818836152554f, 5.3182957344688475e-05f, 1.0313385246263351e-05f};

struct DenseSched {
    static constexpr bool GATHER = false; static constexpr int KSPLIT = 0;
    const char* A; const char* Bt; int lda, ldb; pg8::TileOrder ord;
    DI bool next(int i, Unit& u) const { int pm, pn; if (!ord.get(i, pm, pn)) return false; u.pm = pm; u.pn = pn; u.x0 = 0; u.x1 = 0; return true; }
    DI const char* a_base(const Unit& u) const { return A + (size_t)u.pm * 256 * lda; }
    DI const char* b_base(const Unit& u, int) const { return Bt + (size_t)u.pn * 256 * ldb; }
    DI unsigned a_rowoff(const Unit&, int) const { return 0u; }
};
struct EpiProj {
    static constexpr bool PERM = true;
    bf16* O; float* gates; const float* big; const float* bfg;
    DI void operator()(const f32x4 (&acc)[2][2][4][2], const Unit& u, int wr, int wc, int fr, int fq) const {
        const int row0 = u.pm * 256 + wr * 64 + fr, col0 = u.pn * 256 + wc * 32 + 8 * fq; const bool sg = u.pn >= 9; constexpr float WSC = 1.0f / 64.0f;
        if (u.pn == 19) {
            if (wc == 0 && fq == 0) {
#pragma unroll
                for (int ai = 0; ai < 2; ++ai)
#pragma unroll
                    for (int m = 0; m < 4; ++m) { const int row = row0 + ai * 128 + m * 16; const f32x4 vi = acc[ai][0][m][0], vf = acc[ai][0][m][1]; f32x4 oi, of;
#pragma unroll
                        for (int j = 0; j < 4; ++j) { oi[j] = vi[j] * WSC + big[j]; const float z = vf[j] * WSC + bfg[j]; of[j] = fminf(z, 0.f) - log1pf(__expf(-fabsf(z))); }
                        *(f32x4*)(gates + (size_t)row * 8) = oi; *(f32x4*)(gates + (size_t)row * 8 + 4) = of; } }
            return; }
#pragma unroll
        for (int ai = 0; ai < 2; ++ai)
#pragma unroll
            for (int m = 0; m < 4; ++m) { bf16* rowp = O + (size_t)(row0 + ai * 128 + m * 16) * NPROJ + col0;
#pragma unroll
                for (int bj = 0; bj < 2; ++bj) { f32x4 v0 = acc[ai][bj][m][0] * WSC, v1 = acc[ai][bj][m][1] * WSC;
                    if (sg) {
#pragma unroll
                        for (int j = 0; j < 4; ++j) { v0[j] = sigmoidf_(v0[j]); v1[j] = sigmoidf_(v1[j]); } }
                    v4u w; w.x = cvt_pk_bf16(v0[0], v0[1]); w.y = cvt_pk_bf16(v0[2], v0[3]); w.z = cvt_pk_bf16(v1[0], v1[1]); w.w = cvt_pk_bf16(v1[2], v1[3]);
                    *(v4u*)(rowp + bj * 128) = w; } }
    }
};
template <bool ADD> struct EpiGate {
    static constexpr bool PERM = true;
    bf16* P; int gcol;
    DI void operator()(const f32x4 (&acc)[2][2][4][2], const Unit& u, int wr, int wc, int fr, int fq) const {
        const int row0 = u.pm * 256 + wr * 64 + fr, col0 = u.pn * 256 + wc * 32 + 8 * fq;
#pragma unroll
        for (int ai = 0; ai < 2; ++ai)
#pragma unroll
            for (int m = 0; m < 4; ++m) { bf16* rowp = P + (size_t)(row0 + ai * 128 + m * 16) * NPROJ + col0;
#pragma unroll
                for (int bj = 0; bj < 2; ++bj) { const f32x4 v0 = acc[ai][bj][m][0], v1 = acc[ai][bj][m][1];
                    const v4u g = *(const v4u*)(rowp + gcol + bj * 128);
                    float o[8] = {bflo(g.x) * v0[0], bfhi(g.x) * v0[1], bflo(g.y) * v0[2], bfhi(g.y) * v0[3], bflo(g.z) * v1[0], bfhi(g.z) * v1[1], bflo(g.w) * v1[2], bfhi(g.w) * v1[3]};
                    if (ADD) { const v4u p = *(const v4u*)(rowp + C_MQ + bj * 128);
                        o[0] += bflo(p.x); o[1] += bfhi(p.x); o[2] += bflo(p.y); o[3] += bfhi(p.y); o[4] += bflo(p.z); o[5] += bfhi(p.z); o[6] += bflo(p.w); o[7] += bfhi(p.w); }
                    v4u w; w.x = cvt_pk_bf16(o[0], o[1]); w.y = cvt_pk_bf16(o[2], o[3]); w.z = cvt_pk_bf16(o[4], o[5]); w.w = cvt_pk_bf16(o[6], o[7]);
                    *(v4u*)(rowp + C_MQ + bj * 128) = w; } }
    }
};
struct EpiRes {
    static constexpr bool PERM = false;
    const bf16* xin; bf16* out; const float* g; float* ssq; int rmask;
    DI void operator()(const f32x4 (&acc)[2][2][4][2], const Unit& u, int wr, int wc, int fr, int fq) const {
        const int row0 = u.pm * 256 + wr * 64 + fr, col0 = u.pn * 256 + wc * 32 + 4 * fq; const int b = (u.pm * 256) >> 14;
        f32x4 gv[2][2];
#pragma unroll
        for (int bj = 0; bj < 2; ++bj)
#pragma unroll
            for (int n = 0; n < 2; ++n) gv[bj][n] = *(const f32x4*)(g + b * 6144 + col0 + bj * 128 + n * 16);
#pragma unroll
        for (int ai = 0; ai < 2; ++ai)
#pragma unroll
            for (int m = 0; m < 4; ++m) { const size_t off = (size_t)(row0 + ai * 128 + m * 16) * D + col0; const size_t offo = (size_t)((row0 + ai * 128 + m * 16) & rmask) * D + col0; float sq = 0.f;
#pragma unroll
                for (int bj = 0; bj < 2; ++bj)
#pragma unroll
                    for (int n = 0; n < 2; ++n) { const v2u xw = *(const v2u*)(xin + off + bj * 128 + n * 16); const f32x4 xv = {bflo(xw.x), bfhi(xw.x), bflo(xw.y), bfhi(xw.y)}; const f32x4 o = xv + gv[bj][n] * acc[ai][bj][m][n];
                        v2u ow; ow.x = cvt_pk_bf16(o.x, o.y); ow.y = cvt_pk_bf16(o.z, o.w); const float r0 = bflo(ow.x), r1 = bfhi(ow.x), r2 = bflo(ow.y), r3 = bfhi(ow.y);
                        sq += (r0 * r0 + r1 * r1) + (r2 * r2 + r3 * r3);
                        *(v2u*)(out + offo + bj * 128 + n * 16) = ow; }
                sq += __shfl_xor(sq, 16); sq += __shfl_xor(sq, 32);
                if (fq == 0) ssq[(size_t)(row0 + ai * 128 + m * 16) * 16 + u.pn * 4 + wc] = sq; }
    }
};

struct MoeTab { const LAS int* tcls; const LAS int* tpos; const LAS int* cnt; int Rtot; };
DI int xcd_remap(int L, int nwg) { const int q = nwg >> 3, r = nwg & 7, xcd = L & 7, off = L >> 3; return (xcd < r ? xcd * (q + 1) : r * (q + 1) + (xcd - r) * q) + off; }
DI void cls_experts(int cls, int& ea, int& eb) { const int g = cls / 6, p = cls - 6 * g; const int a = (p < 3) ? 0 : ((p < 5) ? 1 : 2); const int b = (p < 3) ? (p + 1) : ((p < 5) ? (p - 1) : 3); ea = 4 * g + a; eb = 4 * g + b; }
struct MoeUpSched {
    static constexpr bool GATHER = true; static constexpr int KSPLIT = 0;
    const char* A; const char* W; int lda, ldb; MoeTab tb; int G, c; const LAS unsigned* tokoff;
    DI bool next(int i, Unit& u) const { const int L0 = i * G + c; if (L0 >= tb.Rtot * 8) return false; const int L = xcd_remap(L0, tb.Rtot * 8); u.pm = L >> 3; u.pn = L & 7; u.x0 = i; u.x1 = __builtin_amdgcn_readfirstlane(tb.tcls[u.pm]); return true; }
    DI const char* a_base(const Unit&) const { return A; }
    DI const char* b_base(const Unit& u, int) const { int ea, eb; cls_experts(u.x1, ea, eb); const int e = (u.pn < 4) ? ea : eb; return W + ((size_t)e * 1024 + (size_t)(u.pn & 3) * 256) * ldb; }
    DI unsigned a_rowoff(const Unit& u, int r) const { return tokoff[u.x0 * 256 + r]; }
};
struct EpiSwiglu {
    static constexpr bool PERM = true;
    bf16* H; const float* tgate; const LAS unsigned* tokoff;
    DI void operator()(const f32x4 (&acc)[2][2][4][2], const Unit& u, int wr, int wc, int fr, int fq) const {
        const int r0 = wr * 64 + fr; const int hc = (u.pn >> 2) * 512 + (u.pn & 3) * 128 + wc * 32 + 8 * fq; const int gsel = u.pn >> 2;
#pragma unroll
        for (int ai = 0; ai < 2; ++ai)
#pragma unroll
            for (int m = 0; m < 4; ++m) { const int r = r0 + ai * 128 + m * 16; const unsigned tok = tokoff[u.x0 * 256 + r]; const float rg = tgate[tok * 2 + gsel];
                const f32x4 g0 = acc[ai][0][m][0] * (1.0f / 64.0f), g1 = acc[ai][0][m][1] * (1.0f / 64.0f), u0 = acc[ai][1][m][0] * (1.0f / 64.0f), u1 = acc[ai][1][m][1] * (1.0f / 64.0f);
                float o[8];
#pragma unroll
                for (int j = 0; j < 4; ++j) { o[j] = g0[j] * sigmoidf_(g0[j]) * u0[j] * rg; o[4 + j] = g1[j] * sigmoidf_(g1[j]) * u1[j] * rg; }
                v4u w; w.x = cvt_pk_bf16(o[0], o[1]); w.y = cvt_pk_bf16(o[2], o[3]); w.z = cvt_pk_bf16(o[4], o[5]); w.w = cvt_pk_bf16(o[6], o[7]);
                *(v4u*)(H + ((size_t)u.pm * 256 + r) * 1024 + hc) = w; }
    }
};
struct MoeDownSched {
    static constexpr bool GATHER = false; static constexpr int KSPLIT = 8;
    const char* A; const char* W; int lda, ldb; MoeTab tb; int G, c;
    DI bool next(int i, Unit& u) const { const int L0 = i * G + c; if (L0 >= tb.Rtot * 4) return false; const int L = xcd_remap(L0, tb.Rtot * 4); u.pm = L >> 2; u.pn = L & 3; u.x0 = __builtin_amdgcn_readfirstlane(tb.tpos[u.pm]); u.x1 = __builtin_amdgcn_readfirstlane(tb.tcls[u.pm]); return true; }
    DI const char* a_base(const Unit& u) const { return A + (size_t)u.pm * 256 * lda; }
    DI const char* b_base(const Unit& u, int half) const { int ea, eb; cls_experts(u.x1, ea, eb); const int e = half ? eb : ea; return W + ((size_t)e * 1024 + (size_t)u.pn * 256) * ldb; }
    DI unsigned a_rowoff(const Unit&, int) const { return 0u; }
};
struct EpiMoeOut {
    static constexpr bool PERM = false;
    const bf16* xin; bf16* outb; float* outf; const float* g; const int* tokl; MoeTab tb; int rmask, last;
    DI void operator()(const f32x4 (&acc)[2][2][4][2], const Unit& u, int wr, int wc, int fr, int fq) const {
        const int r0 = wr * 64 + fr, col0 = u.pn * 256 + wc * 32 + 4 * fq; const int cn = tb.cnt[u.x1];
#pragma unroll
        for (int ai = 0; ai < 2; ++ai)
#pragma unroll
            for (int m = 0; m < 4; ++m) { const int pos = u.x0 + r0 + ai * 128 + m * 16;
                if (pos < cn) { const int tok = tokl[u.x1 * CLS_CAP + pos]; const int b = tok >> 14; const bf16* ip = xin + (size_t)tok * D + col0; bf16* op = outb + (size_t)(tok & rmask) * D + col0; float* of = outf + (size_t)tok * D + col0; const float* gp = g + b * 6144 + col0;
#pragma unroll
                    for (int bj = 0; bj < 2; ++bj)
#pragma unroll
                        for (int n = 0; n < 2; ++n) { const v2u xw = *(const v2u*)(ip + bj * 128 + n * 16); const f32x4 xv = {bflo(xw.x), bfhi(xw.x), bflo(xw.y), bfhi(xw.y)}; const f32x4 gv = *(const f32x4*)(gp + bj * 128 + n * 16);
                            const f32x4 o = xv + gv * acc[ai][bj][m][n];
                            if (last) *(f32x4*)(of + bj * 128 + n * 16) = o;
                            else { v2u ow; ow.x = cvt_pk_bf16(o.x, o.y); ow.y = cvt_pk_bf16(o.z, o.w); *(v2u*)(op + bj * 128 + n * 16) = ow; } } } }
    }
};

struct Ctx { LAS unsigned char* lds; int tid, lane, wave, G, bid; };
DI Ctx fresh(const Ctx& X) { Ctx P = X; int t = X.tid; asm volatile("" : "+v"(t)); P.tid = t; P.lane = t & 63; P.wave = __builtin_amdgcn_readfirstlane(t >> 6); return P; }

DI void tr_item(const float* W, int ldw, int K, bf16* WT, int k0, LAS float* scr, int lane) {
#pragma unroll 8
    for (int i = 0; i < 32; ++i) { const int kk = 2 * i + (lane >> 5); scr[kk * 33 + (lane & 31)] = W[(size_t)(k0 + kk) * ldw + (lane & 31)]; }
    LDS_WAIT(); asm volatile("" ::: "memory");
    const int c = lane & 7;
#pragma unroll
    for (int j = 0; j < 4; ++j) { const int n = (lane >> 3) + 8 * j; const LAS float* s = scr + (8 * c) * 33 + n;
        v4u o; o.x = pk2(s[0 * 33], s[1 * 33]); o.y = pk2(s[2 * 33], s[3 * 33]); o.z = pk2(s[4 * 33], s[5 * 33]); o.w = pk2(s[6 * 33], s[7 * 33]);
        *(v4u*)(WT + (size_t)n * K + k0 + 8 * c) = o; }
    LDS_WAIT(); asm volatile("" ::: "memory");
}
DI unsigned pk4_fp8(float a0, float a1, float a2, float a3) { int p = __builtin_amdgcn_cvt_pk_fp8_f32(a0, a1, 0, false); p = __builtin_amdgcn_cvt_pk_fp8_f32(a2, a3, p, true); return (unsigned)p; }
DI void tr_item8(const float* W, int ldw, int K, unsigned char* WT, int k0, float scale, LAS float* scr, int lane) {
#pragma unroll 8
    for (int i = 0; i < 32; ++i) { const int kk = 2 * i + (lane >> 5); scr[kk * 33 + (lane & 31)] = W[(size_t)(k0 + kk) * ldw + (lane & 31)]; }
    LDS_WAIT(); asm volatile("" ::: "memory");
    const int c = lane & 7;
#pragma unroll
    for (int j = 0; j < 4; ++j) { const int n = (lane >> 3) + 8 * j; const LAS float* s = scr + (8 * c) * 33 + n;
        v2u o; o.x = pk4_fp8(s[0 * 33] * scale, s[1 * 33] * scale, s[2 * 33] * scale, s[3 * 33] * scale); o.y = pk4_fp8(s[4 * 33] * scale, s[5 * 33] * scale, s[6 * 33] * scale, s[7 * 33] * scale);
        *(v2u*)(WT + (size_t)n * K + k0 + 8 * c) = o; }
    LDS_WAIT(); asm volatile("" ::: "memory");
}
DI void p0_prologue(const Args& a, const Ctx& X) {
    unsigned char* ws = a.ws;
    LAS float* scr = (LAS float*)(X.lds + X.wave * 16384);
    const int gw = X.bid * 8 + X.wave, NGW = X.G * 8;
    constexpr int IT_WIN = 16 * 153, IT_AU = 8 * 32, IT_OUT = 16 * 32, IT_GU = 16 * 16 * 32, IT_DN = 16 * 8 * 32;
    constexpr int IT_L = IT_WIN + 2 * IT_AU + IT_OUT + IT_GU + IT_DN;
    for (int it = gw; it < NL * IT_L; it += NGW) {
        const int l = it / IT_L; int r = it - l * IT_L;
        if (r < IT_WIN) { const int kb = r / 153, nb = r - kb * 153, d0 = 32 * nb, s0 = (nb == 152) ? 2304 : (d0 + (d0 >= 2304 ? 8 : 0));
            tr_item8(a.w_in + (size_t)l * D * DIN_SRC + s0, DIN_SRC, D, (unsigned char*)(ws + WS_WIN) + ((size_t)l * NPROJW + d0) * D, 64 * kb, 64.0f, scr, X.lane); continue; }
        r -= IT_WIN;
        if (r < IT_AU) { const int kb = r >> 5, nb = r & 31;
            tr_item(a.w_au + (size_t)l * 512 * D + 32 * nb, D, 512, (bf16*)(ws + WS_WAU) + ((size_t)l * D + 32 * nb) * 512, 64 * kb, scr, X.lane); continue; }
        r -= IT_AU;
        if (r < IT_AU) { const int kb = r >> 5, nb = r & 31;
            tr_item(a.w_mu + (size_t)l * 512 * D + 32 * nb, D, 512, (bf16*)(ws + WS_WMU) + ((size_t)l * D + 32 * nb) * 512, 64 * kb, scr, X.lane); continue; }
        r -= IT_AU;
        if (r < IT_OUT) { const int kb = r >> 5, nb = r & 31;
            tr_item(a.w_out + (size_t)l * D * D + 32 * nb, D, D, (bf16*)(ws + WS_WOUT) + ((size_t)l * D + 32 * nb) * D, 64 * kb, scr, X.lane); continue; }
        r -= IT_OUT;
        if (r < IT_GU) { const int e = r >> 9, q = r & 511, kb = q >> 5, nb = q & 31, tq = nb >> 3, rb = nb & 7;
            const float* src = ((rb < 4) ? a.w_gate : a.w_up) + ((size_t)(l * NE + e) * D) * FF + 128 * tq + 32 * (rb & 3);
            tr_item8(src, FF, D, (unsigned char*)(ws + WS_WGU) + ((size_t)(l * NE + e) * 1024 + 32 * nb) * D, 64 * kb, 64.0f, scr, X.lane); continue; }
        r -= IT_GU;
        { const int e = r >> 8, q = r & 255, kb = q >> 5, nb = q & 31;
            tr_item(a.w_down + ((size_t)(l * NE + e) * FF) * D + 32 * nb, D, FF, (bf16*)(ws + WS_WD) + ((size_t)(l * NE + e) * 1024 + 32 * nb) * FF, 64 * kb, scr, X.lane); }
    }
    { const float* xs = a.x; bf16* xb = (bf16*)(ws + WS_XB);
      for (size_t i = (size_t)X.bid * 512 + X.tid; i < (size_t)T * D / 8; i += (size_t)X.G * 512) { const f32x4 v0 = *(const f32x4*)(xs + 8 * i), v1 = *(const f32x4*)(xs + 8 * i + 4);
          v4u w; w.x = cvt_pk_bf16(v0.x, v0.y); w.y = cvt_pk_bf16(v0.z, v0.w); w.z = cvt_pk_bf16(v1.x, v1.y); w.w = cvt_pk_bf16(v1.z, v1.w); *(v4u*)(xb + 8 * i) = w; } }
    { float* cs = (float*)(ws + WS_ROPE); float* sn = cs + (size_t)T * 8;
      for (int i = X.bid * 512 + X.tid; i < T * 8; i += X.G * 512) { const int tok = i >> 3, f = i & 7; const float angf = (float)a.pos[tok] * c_invf[f];
          double rev = (double)angf * 0.15915494309189535; rev -= rint(rev); const float rf = (float)rev;
          cs[i] = __builtin_amdgcn_cosf(rf); sn[i] = __builtin_amdgcn_sinf(rf); } }
    __syncthreads();
    LAS float* cact = (LAS float*)X.lds; LAS float* red = (LAS float*)(X.lds + 8192);
    for (int i = X.tid; i < 2048; i += 512) { const float cv = a.c[i]; cact[i] = cv / (1.0f + __expf(-cv)); }
    __syncthreads();
    float* mod = (float*)(ws + WS_MOD);
    for (int it = X.bid; it < NL * 96; it += X.G) { const int l = it / 96, cg = it - l * 96; const int col = cg * 64 + X.lane;
        const float* w = a.ada_w + (size_t)l * D * 6144 + col; float s0 = 0.f, s1 = 0.f;
#pragma unroll 8
        for (int kk = 0; kk < 128; ++kk) { const int k = X.wave * 128 + kk; const float wv = w[(size_t)k * 6144]; s0 += cact[k] * wv; s1 += cact[1024 + k] * wv; }
        red[(X.wave * 2 + 0) * 64 + X.lane] = s0; red[(X.wave * 2 + 1) * 64 + X.lane] = s1;
        __syncthreads();
        if (X.tid < 128) { const int b = X.tid >> 6, ln = X.tid & 63; float s = 0.f;
#pragma unroll
            for (int w8 = 0; w8 < 8; ++w8) s += red[(w8 * 2 + b) * 64 + ln];
            mod[(size_t)(l * 2 + b) * 6144 + cg * 64 + ln] = s + a.ada_b[l * 6144 + cg * 64 + ln]; }
        __syncthreads();
    }
}

DI void p1_norm_gates(const Args& a, const Ctx& X, int l, const bf16* xin) {
    unsigned char* ws = a.ws;
    const float* mod = (const float*)(ws + WS_MOD); unsigned char* hb = (unsigned char*)(ws + WS_H);
    const int gw = X.bid * 8 + X.wave, NGW = X.G * 8;
    for (int rg = gw; rg < T / 16; rg += NGW) {
        const int row0 = rg * 16, b = row0 >> 14;
        const float* mb = mod + (size_t)(l * 2 + b) * 6144;
        f32x4 aw[4], sh[4];
#pragma unroll
        for (int j = 0; j < 4; ++j) { const int k = 256 * j + 4 * X.lane; const f32x4 nw = *(const f32x4*)(a.nmw + l * D + k); const f32x4 sc = *(const f32x4*)(mb + 1024 + k); aw[j] = nw * (sc + 1.0f); sh[j] = *(const f32x4*)(mb + k); }
        v2u pre[4][4];
#pragma unroll
        for (int q = 0; q < 4; ++q) { const v2u* xp = (const v2u*)(xin + (size_t)(row0 + q) * D) + X.lane;
#pragma unroll
            for (int j = 0; j < 4; ++j) pre[q][j] = xp[64 * j]; }
#pragma unroll 1
        for (int rb = 0; rb < 16; rb += 4) {
#pragma unroll
          for (int q = 0; q < 4; ++q) { const int row = row0 + rb + q;
            f32x4 v[4]; float ss = 0.f;
#pragma unroll
            for (int j = 0; j < 4; ++j) { const v2u pw = pre[q][j]; v[j] = (f32x4){bflo(pw.x), bfhi(pw.x), bflo(pw.y), bfhi(pw.y)}; }
            if (rb + 4 < 16) { const v2u* xp = (const v2u*)(xin + (size_t)(row + 4) * D) + X.lane;
#pragma unroll
                for (int j = 0; j < 4; ++j) pre[q][j] = xp[64 * j]; }
#pragma unroll
            for (int j = 0; j < 4; ++j) ss += (v[j].x * v[j].x + v[j].y * v[j].y) + (v[j].z * v[j].z + v[j].w * v[j].w);
            ss = wave_sum(ss); const float rstd = __builtin_amdgcn_rsqf(ss * (1.0f / D) + EPS);
            unsigned* o4 = (unsigned*)(hb + (size_t)row * D) + X.lane;
#pragma unroll
            for (int j = 0; j < 4; ++j) { v[j] = v[j] * rstd * aw[j] + sh[j]; o4[64 * j] = pk4_fp8(v[j].x, v[j].y, v[j].z, v[j].w); }
          }
        }
    }
}

DI void attn_unit(const Args& a, const Ctx& X, int l, int unit) {
    unsigned char* ws = a.ws; const bf16* proj = (const bf16*)(ws + WS_PROJ); bf16* ao = (bf16*)(ws + WS_H);
    const float* cs = (const float*)(ws + WS_ROPE); const float* sn = cs + (size_t)T * 8;
    const int b = unit >> 8, rem = unit & 255, nb = rem >> 1, kvh = rem & 1; const int tok0 = b * SEQ + nb * 128;
    LAS bf16* Kl = (LAS bf16*)X.lds;
    LAS bf16* VT = (LAS bf16*)(X.lds + 36864);
    int lane = X.lane; asm volatile("" : "+v"(lane));
    const int c16 = lane & 15, quad = lane >> 4;
    {
        const int row = X.tid >> 1, half = X.tid & 1; const int tokk = tok0 - 128 + row; const bool valid = (nb > 0) || (row >= 128);
        float y[32]; float vv[32];
        if (valid) {
            const v4u* kp = (const v4u*)(proj + (size_t)tokk * NPROJ + C_AK + kvh * 64 + half * 32); const v4u* vp = (const v4u*)(proj + (size_t)tokk * NPROJ + C_AV + kvh * 64 + half * 32);
#pragma unroll
            for (int q = 0; q < 4; ++q) { const v4u kw = kp[q], vw = vp[q];
                y[8 * q + 0] = bflo(kw.x); y[8 * q + 1] = bfhi(kw.x); y[8 * q + 2] = bflo(kw.y); y[8 * q + 3] = bfhi(kw.y); y[8 * q + 4] = bflo(kw.z); y[8 * q + 5] = bfhi(kw.z); y[8 * q + 6] = bflo(kw.w); y[8 * q + 7] = bfhi(kw.w);
                vv[8 * q + 0] = bflo(vw.x); vv[8 * q + 1] = bfhi(vw.x); vv[8 * q + 2] = bflo(vw.y); vv[8 * q + 3] = bfhi(vw.y); vv[8 * q + 4] = bflo(vw.z); vv[8 * q + 5] = bfhi(vw.z); vv[8 * q + 6] = bflo(vw.w); vv[8 * q + 7] = bfhi(vw.w); }
        } else {
#pragma unroll
            for (int i = 0; i < 32; ++i) { y[i] = 0.f; vv[i] = 0.f; } }
        float ss = 0.f;
#pragma unroll
        for (int i = 0; i < 32; ++i) ss += y[i] * y[i];
        ss += __shfl_xor(ss, 1); const float rstd = 1.0f / sqrtf(ss * (1.0f / 64.0f) + EPS);
#pragma unroll
        for (int i = 0; i < 32; ++i) y[i] = y[i] * rstd * a.knw[l * 64 + half * 32 + i];
        if (half == 0 && valid) {
#pragma unroll
            for (int d = 0; d < 8; ++d) { const float c = cs[(size_t)tokk * 8 + d], s = sn[(size_t)tokk * 8 + d]; const float t1 = y[d], t2 = y[d + 8]; y[d] = t1 * c - t2 * s; y[d + 8] = t2 * c + t1 * s; } }
#pragma unroll
        for (int q = 0; q < 4; ++q) { v4u w; w.x = pk2(y[8 * q], y[8 * q + 1]); w.y = pk2(y[8 * q + 2], y[8 * q + 3]); w.z = pk2(y[8 * q + 4], y[8 * q + 5]); w.w = pk2(y[8 * q + 6], y[8 * q + 7]);
            *(LAS v4u*)(Kl + row * 72 + half * 32 + 8 * q) = w; }
#pragma unroll
        for (int i = 0; i < 32; ++i) VT[(half * 32 + i) * 280 + row] = (bf16)f2bf(vv[i]);
        if (X.tid < 64) {
#pragma unroll
            for (int cc = 256; cc < 280; ++cc) VT[X.tid * 280 + cc] = 0; }
    }
    __syncthreads();
#pragma unroll 1
    for (int task = X.wave; task < 32; task += 8) {
        const int g = task >> 3, rg = task & 7, r0 = 16 * rg, head = kvh * 4 + g; const int tokq = tok0 + r0 + c16;
        const float sink = a.sinks[l * 8 + head];
        float qv[16];
        { const bf16* qp = proj + (size_t)tokq * NPROJ + C_AQ + head * 64; const v4u w0 = *(const v4u*)(qp + 8 * quad), w1 = *(const v4u*)(qp + 32 + 8 * quad);
          qv[0] = bflo(w0.x); qv[1] = bfhi(w0.x); qv[2] = bflo(w0.y); qv[3] = bfhi(w0.y); qv[4] = bflo(w0.z); qv[5] = bfhi(w0.z); qv[6] = bflo(w0.w); qv[7] = bfhi(w0.w);
          qv[8] = bflo(w1.x); qv[9] = bfhi(w1.x); qv[10] = bflo(w1.y); qv[11] = bfhi(w1.y); qv[12] = bflo(w1.z); qv[13] = bfhi(w1.z); qv[14] = bflo(w1.w); qv[15] = bfhi(w1.w); }
        float ss = 0.f;
#pragma unroll
        for (int i = 0; i < 16; ++i) ss += qv[i] * qv[i];
        ss += __shfl_xor(ss, 16); ss += __shfl_xor(ss, 32); const float rstd = 1.0f / sqrtf(ss * (1.0f / 64.0f) + EPS);
#pragma unroll
        for (int i = 0; i < 8; ++i) { qv[i] = qv[i] * rstd * a.qnw[l * 64 + 8 * quad + i]; qv[8 + i] = qv[8 + i] * rstd * a.qnw[l * 64 + 32 + 8 * quad + i]; }
#pragma unroll
        for (int d = 0; d < 8; ++d) { const float other = __shfl_xor(qv[d], 16); const float c = cs[(size_t)tokq * 8 + d], s = sn[(size_t)tokq * 8 + d];
            if (quad == 0) qv[d] = qv[d] * c - other * s; else if (quad == 1) qv[d] = qv[d] * c + other * s; }
        bf16x8 qf[2];
        { v4u w; w.x = pk2(qv[0], qv[1]); w.y = pk2(qv[2], qv[3]); w.z = pk2(qv[4], qv[5]); w.w = pk2(qv[6], qv[7]); qf[0] = __builtin_bit_cast(bf16x8, w);
          w.x = pk2(qv[8], qv[9]); w.y = pk2(qv[10], qv[11]); w.z = pk2(qv[12], qv[13]); w.w = pk2(qv[14], qv[15]); qf[1] = __builtin_bit_cast(bf16x8, w); }
        f32x4 sacc[9];
#pragma unroll
        for (int i = 0; i < 9; ++i) { const LAS bf16* kr = Kl + (16 * (rg + i) + c16) * 72 + 8 * quad;
            const bf16x8 k0 = *(const LAS bf16x8*)kr, k1 = *(const LAS bf16x8*)(kr + 32);
            f32x4 z = {0.f, 0.f, 0.f, 0.f}; z = __builtin_amdgcn_mfma_f32_16x16x32_bf16(k0, qf[0], z, 0, 0, 0); sacc[i] = __builtin_amdgcn_mfma_f32_16x16x32_bf16(k1, qf[1], z, 0, 0, 0); }
        int dbase = 4 * quad - c16; asm volatile("" : "+v"(dbase)); int kbase = 16 * rg + 4 * quad; asm volatile("" : "+v"(kbase)); float mx = sink;
#pragma unroll
        for (int i = 0; i < 9; ++i)
#pragma unroll
            for (int j = 0; j < 4; ++j) { const int dlt = dbase + 16 * i + j; const int kj = kbase + 16 * i + j; const bool ok = (dlt > 0) && (dlt <= 128) && ((nb > 0) || (kj >= 128));
                const float s = ok ? sacc[i][j] * 0.125f : -3.0e38f; sacc[i][j] = s; mx = fmaxf(mx, s); }
        mx = fmaxf(mx, __shfl_xor(mx, 16)); mx = fmaxf(mx, __shfl_xor(mx, 32));
        float sum = 0.f;
#pragma unroll
        for (int i = 0; i < 9; ++i)
#pragma unroll
            for (int j = 0; j < 4; ++j) { const float p = (sacc[i][j] > -1.0e38f) ? __expf(sacc[i][j] - mx) : 0.f; sacc[i][j] = p; sum += p; }
        sum += __shfl_xor(sum, 16); sum += __shfl_xor(sum, 32);
        const float inv = 1.0f / (sum + __expf(sink - mx));
        f32x4 oacc[4];
#pragma unroll
        for (int et = 0; et < 4; ++et) oacc[et] = (f32x4){0.f, 0.f, 0.f, 0.f};
#pragma unroll
        for (int kk = 0; kk < 5; ++kk) {
            v4u pw; pw.x = pk2(sacc[2 * kk][0], sacc[2 * kk][1]); pw.y = pk2(sacc[2 * kk][2], sacc[2 * kk][3]);
            if (2 * kk + 1 < 9) { pw.z = pk2(sacc[(2 * kk + 1 < 9) ? 2 * kk + 1 : 0][0], sacc[(2 * kk + 1 < 9) ? 2 * kk + 1 : 0][1]); pw.w = pk2(sacc[(2 * kk + 1 < 9) ? 2 * kk + 1 : 0][2], sacc[(2 * kk + 1 < 9) ? 2 * kk + 1 : 0][3]); } else { pw.z = 0u; pw.w = 0u; }
            const bf16x8 pf = __builtin_bit_cast(bf16x8, pw);
#pragma unroll
            for (int et = 0; et < 4; ++et) { const LAS bf16* vr = VT + (16 * et + c16) * 280 + 16 * rg + 32 * kk + 4 * quad;
                const v2u lo = *(const LAS v2u*)vr, hi = *(const LAS v2u*)(vr + 16); v4u vw; vw.x = lo.x; vw.y = lo.y; vw.z = hi.x; vw.w = hi.y;
                oacc[et] = __builtin_amdgcn_mfma_f32_16x16x32_bf16(__builtin_bit_cast(bf16x8, vw), pf, oacc[et], 0, 0, 0); }
        }
#pragma unroll
        for (int et = 0; et < 4; ++et) { v2u w; w.x = pk2(oacc[et][0] * inv, oacc[et][1] * inv); w.y = pk2(oacc[et][2] * inv, oacc[et][3] * inv);
            *(v2u*)(ao + (size_t)tokq * 512 + head * 64 + 16 * et + 4 * quad) = w; }
    }
    __syncthreads();
}

constexpr int ML_Q = 0, ML_K = 17408, ML_KET = 34816, ML_VT = 53248, ML_CT = 73984, ML_CW = 113152, ML_CB = 118272, ML_RED = 118784, ML_NW = 119296, ML_GT = 119808;
DI float bfw(unsigned w, int hi) { return hi ? bfhi(w) : bflo(w); }
template <bool L3> DI void mlstm_unit(const Args& a, const Ctx& X, int l, int unit) {
    unsigned char* ws = a.ws; const bf16* proj = (const bf16*)(ws + WS_PROJ); bf16* hm = (bf16*)(ws + WS_H) + (size_t)T * 512;
    bf16* kcb = (bf16*)(ws + WS_KC);
    const float* gates = (const float*)(ws + WS_GATES); float* mlc = (float*)(ws + WS_MLC) + (size_t)unit * 18432; float* mlb = (float*)(ws + WS_MLB);
    const int seq = unit >> 5, sj = unit & 31, b = seq >> 2, hh = seq & 3; const int tokbase = b * SEQ + sj * 512;
    LAS bf16* Qs = (LAS bf16*)(X.lds + ML_Q); LAS bf16* Ks = (LAS bf16*)(X.lds + ML_K); LAS bf16* KET = (LAS bf16*)(X.lds + ML_KET);
    LAS bf16* VT = (LAS bf16*)(X.lds + ML_VT); LAS bf16* CT = (LAS bf16*)(X.lds + ML_CT); LAS float* CW = (LAS float*)(X.lds + ML_CW);
    LAS float* CB = (LAS float*)(X.lds + ML_CB); LAS float* RED = (LAS float*)(X.lds + ML_RED); LAS float* NW = (LAS float*)(X.lds + ML_NW);
    LAS float* GT = (LAS float*)(X.lds + ML_GT);
    int lane = X.lane; asm volatile("" : "+v"(lane));
    const int c16 = lane & 15, quad = lane >> 4, w = X.wave;
    int tidl = X.tid; asm volatile("" : "+v"(tidl));
    const int tg = tidl >> 5, cg = tidl & 31, t0 = 4 * tg, c0 = 4 * cg;
    v2u rq[7], rk[7], rv[4], kcv[4];
#define ML_LBAR() do { asm volatile("s_waitcnt lgkmcnt(0)" ::: "memory"); __builtin_amdgcn_s_barrier(); asm volatile("" ::: "memory"); } while (0)
#define ML_LOADRAW(tokc) do { _Pragma("unroll") for (int j = 0; j < 7; ++j) { const int tt = (tokc) + t0 - 3 + j; const bool ok = tt >= b * SEQ; const bf16* rp = proj + (size_t)(ok ? tt : (tokc)) * NPROJ + hh * 128 + c0; \
        if (L3) { rq[j] = *(const v2u*)(rp + C_MQ); if (!ok) { rq[j].x = 0u; rq[j].y = 0u; } } else { rk[j] = *(const v2u*)(rp + C_MK); if (!ok) { rk[j].x = 0u; rk[j].y = 0u; } } } \
        if (L3) { _Pragma("unroll") for (int i = 0; i < 4; ++i) kcv[i] = *(const v2u*)(kcb + (size_t)((tokc) + t0 + i) * 512 + hh * 128 + c0); } \
        _Pragma("unroll") for (int i = 0; i < 4; ++i) rv[i] = *(const v2u*)(proj + (size_t)((tokc) + t0 + i) * NPROJ + C_MV + hh * 128 + c0); } while (0)
    ML_LOADRAW(tokbase);
    for (int idx = X.tid; idx < 1280; idx += 512) { const int tap = idx >> 8, ch = idx & 255; const int gch = (ch < 128) ? (hh * 128 + ch) : (512 + hh * 128 + (ch - 128));
        CW[idx] = (tap < 4) ? a.conv_w[(size_t)(l * 4 + tap) * 1024 + gch] : a.conv_b[l * 1024 + gch]; }
    for (int idx = X.tid; idx < 16 * 72; idx += 512) VT[128 * 72 + idx] = (idx < 72) ? (bf16)0x3F80 : (bf16)0;
    if (X.tid < 128) NW[X.tid] = a.mnw[l * 512 + hh * 128 + X.tid];
    { const float* gp = gates + (size_t)(tokbase + X.tid) * 8; GT[2 * X.tid] = gp[hh]; GT[2 * X.tid + 1] = gp[4 + hh]; }
    f32x4 cacc[9];
#pragma unroll
    for (int et = 0; et < 9; ++et) {
        if (L3) {
#pragma unroll
            for (int j = 0; j < 4; ++j) { const float v = mlc[(16 * et + 4 * quad + j) * 128 + 16 * w + c16]; cacc[et][j] = v; CT[(16 * et + 4 * quad + j) * 136 + 16 * w + c16] = (bf16)f2bf(v); }
        } else cacc[et] = (f32x4){0.f, 0.f, 0.f, 0.f};
    }
    float bsum = 0.f;
    __syncthreads();
#pragma unroll 1
    for (int c = 0; c < 8; ++c) {
        const int tok0 = tokbase + c * 64;
        const f32x2 gl = *(const LAS f32x2*)(GT + 2 * (c * 64 + lane)); float bsc = gl.y; const float li = gl.x;
#pragma unroll
        for (int o = 1; o < 64; o <<= 1) { const float v = __shfl_up(bsc, o); if (lane >= o) bsc += v; }
        const float bl = __shfl(bsc, 63); const float csv = li - bsc;
        if (w == 0) { CB[lane] = bsc; CB[64 + lane] = csv; }
        bsum += bl;
        const int tt_ = w & 3, eh = w >> 2; const int tq = 16 * tt_ + c16;
        v2u ogv[4];
        if (L3) {
#pragma unroll
            for (int x = 0; x < 4; ++x) ogv[x] = *(const v2u*)(proj + (size_t)(tok0 + tq) * NPROJ + C_MO + hh * 128 + 16 * (4 * eh + x) + 4 * quad); }
        { float fac[4];
#pragma unroll
          for (int i = 0; i < 4; ++i) fac[i] = __expf(bl + __shfl(csv, t0 + i));
#pragma unroll
          for (int qk = (L3 ? 0 : 1); qk < 2; ++qk) {
              float o[4][4];
              if (L3 && qk) {
#pragma unroll
                  for (int i = 0; i < 4; ++i) { o[i][0] = bflo(kcv[i].x); o[i][1] = bfhi(kcv[i].x); o[i][2] = bflo(kcv[i].y); o[i][3] = bfhi(kcv[i].y); }
              } else {
              const f32x4 bias = *(const LAS f32x4*)(CW + 4 * 256 + qk * 128 + c0);
#pragma unroll
              for (int i = 0; i < 4; ++i) { o[i][0] = bias.x; o[i][1] = bias.y; o[i][2] = bias.z; o[i][3] = bias.w; }
#pragma unroll
              for (int j = 0; j < 4; ++j) { const f32x4 wj = *(const LAS f32x4*)(CW + j * 256 + qk * 128 + c0);
#pragma unroll
                  for (int i = 0; i < 4; ++i) { const v2u rr = qk ? rk[i + j] : rq[i + j];
                      o[i][0] += wj.x * bflo(rr.x); o[i][1] += wj.y * bfhi(rr.x); o[i][2] += wj.z * bflo(rr.y); o[i][3] += wj.w * bfhi(rr.y); } }
#pragma unroll
              for (int i = 0; i < 4; ++i)
#pragma unroll
                  for (int ch = 0; ch < 4; ++ch) { const float z = o[i][ch]; o[i][ch] = z * __builtin_amdgcn_rcpf(1.0f + __expf(-z)) * (qk ? 0.08838834764831845f : 1.0f); }
              }
              if (!L3 && qk) {
#pragma unroll
                  for (int i = 0; i < 4; ++i) { v2u pw; pw.x = pk2(o[i][0], o[i][1]); pw.y = pk2(o[i][2], o[i][3]); *(v2u*)(kcb + (size_t)(tok0 + t0 + i) * 512 + hh * 128 + c0) = pw;
                      o[i][0] = bflo(pw.x); o[i][1] = bfhi(pw.x); o[i][2] = bflo(pw.y); o[i][3] = bfhi(pw.y); } }
              if (L3) { LAS bf16* dst = (qk ? Ks : Qs) + t0 * 136 + c0;
#pragma unroll
                  for (int i = 0; i < 4; ++i) { v2u pw; pw.x = pk2(o[i][0], o[i][1]); pw.y = pk2(o[i][2], o[i][3]); *(LAS v2u*)(dst + i * 136) = pw; } }
              if (qk) {
#pragma unroll
                  for (int ch = 0; ch < 4; ++ch) { v2u pw; pw.x = pk2(o[0][ch] * fac[0], o[1][ch] * fac[1]); pw.y = pk2(o[2][ch] * fac[2], o[3][ch] * fac[3]); *(LAS v2u*)(KET + (c0 + ch) * 72 + t0) = pw; } }
          }
          { v2u p0, p1, p2, p3;
            p0.x = (rv[0].x & 0xffffu) | (rv[1].x << 16); p0.y = (rv[2].x & 0xffffu) | (rv[3].x << 16);
            p1.x = (rv[0].x >> 16) | (rv[1].x & 0xffff0000u); p1.y = (rv[2].x >> 16) | (rv[3].x & 0xffff0000u);
            p2.x = (rv[0].y & 0xffffu) | (rv[1].y << 16); p2.y = (rv[2].y & 0xffffu) | (rv[3].y << 16);
            p3.x = (rv[0].y >> 16) | (rv[1].y & 0xffff0000u); p3.y = (rv[2].y >> 16) | (rv[3].y & 0xffff0000u);
            *(LAS v2u*)(VT + (c0 + 0) * 72 + t0) = p0; *(LAS v2u*)(VT + (c0 + 1) * 72 + t0) = p1; *(LAS v2u*)(VT + (c0 + 2) * 72 + t0) = p2; *(LAS v2u*)(VT + (c0 + 3) * 72 + t0) = p3; }
        }
        ML_LBAR();
        if (c < 7) { ML_LOADRAW(tok0 + 64); }
        float hval[4][4];
        if (L3) {
            bf16x8 qf[4];
#pragma unroll
            for (int ks = 0; ks < 4; ++ks) qf[ks] = *(const LAS bf16x8*)(Qs + tq * 136 + 32 * ks + 8 * quad);
            f32x4 sacc[4];
#pragma unroll
            for (int st = 0; st < 4; ++st) { f32x4 z = {0.f, 0.f, 0.f, 0.f};
#pragma unroll
                for (int ks = 0; ks < 4; ++ks) z = __builtin_amdgcn_mfma_f32_16x16x32_bf16(*(const LAS bf16x8*)(Ks + (16 * st + c16) * 136 + 32 * ks + 8 * quad), qf[ks], z, 0, 0, 0);
                sacc[st] = z; }
            const float cbt = CB[tq];
#pragma unroll
            for (int st = 0; st < 4; ++st)
#pragma unroll
                for (int j = 0; j < 4; ++j) { const int s = 16 * st + 4 * quad + j; const float d = (s <= tq) ? __expf(cbt + CB[64 + s]) : 0.f; sacc[st][j] *= d; }
            bf16x8 pf[2];
#pragma unroll
            for (int kk = 0; kk < 2; ++kk) { v4u pw; pw.x = pk2(sacc[2 * kk][0], sacc[2 * kk][1]); pw.y = pk2(sacc[2 * kk][2], sacc[2 * kk][3]); pw.z = pk2(sacc[2 * kk + 1][0], sacc[2 * kk + 1][1]); pw.w = pk2(sacc[2 * kk + 1][2], sacc[2 * kk + 1][3]); pf[kk] = __builtin_bit_cast(bf16x8, pw); }
            const float ebt = __expf(cbt);
            f32x4 nn[5];
#pragma unroll
            for (int x = 0; x < 5; ++x) { const int et = (x < 4) ? (4 * eh + x) : 8; f32x4 na = {0.f, 0.f, 0.f, 0.f}, ia = {0.f, 0.f, 0.f, 0.f};
#pragma unroll
                for (int kk = 0; kk < 2; ++kk) { const LAS bf16* vr = VT + (16 * et + c16) * 72 + 32 * kk + 4 * quad; const v2u lo = *(const LAS v2u*)vr, hi = *(const LAS v2u*)(vr + 16); v4u vw; vw.x = lo.x; vw.y = lo.y; vw.z = hi.x; vw.w = hi.y;
                    na = __builtin_amdgcn_mfma_f32_16x16x32_bf16(__builtin_bit_cast(bf16x8, vw), pf[kk], na, 0, 0, 0); }
#pragma unroll
                for (int ks = 0; ks < 4; ++ks) ia = __builtin_amdgcn_mfma_f32_16x16x32_bf16(*(const LAS bf16x8*)(CT + (16 * et + c16) * 136 + 32 * ks + 8 * quad), qf[ks], ia, 0, 0, 0);
                nn[x] = na + ia * ebt; }
            const float den = __shfl(nn[4][0], c16); const float inv = 1.0f / fmaxf(fabsf(den), 1.0f);
            float ss = 0.f;
#pragma unroll
            for (int x = 0; x < 4; ++x)
#pragma unroll
                for (int j = 0; j < 4; ++j) { hval[x][j] = nn[x][j] * inv; ss += hval[x][j] * hval[x][j]; }
            ss += __shfl_xor(ss, 16); ss += __shfl_xor(ss, 32);
            if (quad == 0) RED[eh * 64 + tq] = ss;
            ML_LBAR();
            const float rstd = __builtin_amdgcn_rsqf((RED[tq] + RED[64 + tq]) * (1.0f / 128.0f) + EPS);
#pragma unroll
            for (int x = 0; x < 4; ++x) { const int e = 16 * (4 * eh + x) + 4 * quad; const v2u og = ogv[x];
                const float y0 = hval[x][0] * rstd * NW[e] * bflo(og.x), y1 = hval[x][1] * rstd * NW[e + 1] * bfhi(og.x), y2 = hval[x][2] * rstd * NW[e + 2] * bflo(og.y), y3 = hval[x][3] * rstd * NW[e + 3] * bfhi(og.y);
                v2u o; o.x = pk2(y0, y1); o.y = pk2(y2, y3); *(v2u*)(hm + (size_t)(tok0 + tq) * 512 + hh * 128 + e) = o; }
        }
        { const float ebl = __expf(bl);
          bf16x8 kf[2];
#pragma unroll
          for (int kk = 0; kk < 2; ++kk) kf[kk] = *(const LAS bf16x8*)(KET + (16 * w + c16) * 72 + 32 * kk + 8 * quad);
#pragma unroll
          for (int et = 0; et < 9; ++et) { f32x4 z = cacc[et] * ebl;
#pragma unroll
              for (int kk = 0; kk < 2; ++kk) z = __builtin_amdgcn_mfma_f32_16x16x32_bf16(*(const LAS bf16x8*)(VT + (16 * et + c16) * 72 + 32 * kk + 8 * quad), kf[kk], z, 0, 0, 0);
              cacc[et] = z;
              if (L3) {
#pragma unroll
                  for (int j = 0; j < 4; ++j) CT[(16 * et + 4 * quad + j) * 136 + 16 * w + c16] = (bf16)f2bf(z[j]); } } }
        ML_LBAR();
    }
#undef ML_LOADRAW
#undef ML_LBAR
    if (!L3) {
#pragma unroll
        for (int et = 0; et < 9; ++et)
#pragma unroll
            for (int j = 0; j < 4; ++j) mlc[(16 * et + 4 * quad + j) * 128 + 16 * w + c16] = cacc[et][j];
        if (X.tid == 0) mlb[unit] = bsum;
    }
}
DI void mlstm_scan(const Args& a, const Ctx& X) {
    float* mlc = (float*)(a.ws + WS_MLC); const float* mlb = (const float*)(a.ws + WS_MLB);
    for (int idx = X.bid * 512 + X.tid; idx < 8 * 18432; idx += X.G * 512) { const int seq = idx / 18432, el = idx - seq * 18432; float carry = 0.f;
        float* p0 = mlc + (size_t)seq * 32 * 18432 + el; float v[32], dcy[32];
#pragma unroll
        for (int j = 0; j < 32; ++j) { v[j] = p0[(size_t)j * 18432]; dcy[j] = mlb[seq * 32 + j]; }
#pragma unroll
        for (int j = 0; j < 32; ++j) { p0[(size_t)j * 18432] = carry; carry = __expf(dcy[j]) * carry + v[j]; } }
}

constexpr int P6_WR = 0, P6_AT = 33024, P6_SH = 37120, P6_LG = 41216, P6_HIST = 65536;
DI void p6_norm_route(const Args& a, const Ctx& X, int l, const bf16* xin) {
    unsigned char* ws = a.ws;
    LAS bf16* wrb = (LAS bf16*)(X.lds + P6_WR);
    LAS float* at = (LAS float*)(X.lds + P6_AT); LAS float* sht = (LAS float*)(X.lds + P6_SH);
    LAS float* lg = (LAS float*)(X.lds + P6_LG) + X.wave * 272;
    for (int idx = X.tid; idx < 16384; idx += 512) { const int k = idx >> 4, e = idx & 15; wrb[e * 1032 + k] = (bf16)f2bf(a.router_w[idx]); }
    const float* mod = (const float*)(ws + WS_MOD); unsigned char* hb = (unsigned char*)(ws + WS_H); float* tgate = (float*)(ws + WS_TGATE); int* tokl = (int*)(ws + WS_TOKL);
    const float* ssq = (const float*)(ws + WS_SSQ);
    unsigned* cnt = (unsigned*)(ws + WS_CTL) + CW_CNT + l * 2048;
    LAS int* hist = (LAS int*)(X.lds + P6_HIST); LAS int* cbase = hist + 32;
    int lane = X.lane; asm volatile("" : "+v"(lane));
    const int r = lane & 15, q = lane >> 4;
    const int gw = X.bid * 8 + X.wave, NGW = X.G * 8;
    for (int it = 0; it * NGW < T / 16; ++it) {
        const int rg = it * NGW + gw; const bool act = rg < T / 16;
        const int row0 = (act ? rg : 0) * 16; const int bb = ((it * NGW + X.bid * 8) * 16) >> 14;
        __syncthreads();
        if (X.tid < 32) hist[X.tid] = 0;
        { const float* mb = mod + (size_t)(l * 2 + (bb < 2 ? bb : 1)) * 6144;
          for (int k = X.tid; k < 1024; k += 512) { at[k] = a.nfw[l * D + k] * (1.0f + mb[4 * 1024 + k]); sht[k] = mb[3 * 1024 + k]; } }
        __syncthreads();
        const int row = row0 + r;
        float rstd;
        { const f32x4 pp = *(const f32x4*)(ssq + (size_t)row * 16 + 4 * q); float ss = (pp.x + pp.y) + (pp.z + pp.w); ss += __shfl_xor(ss, 16); ss += __shfl_xor(ss, 32); rstd = __builtin_amdgcn_rsqf(ss * (1.0f / D) + EPS); }
        const bf16* xr = xin + (size_t)row * D + 8 * q; unsigned char* hr = hb + (size_t)row * D + 8 * q;
        f32x4 acc = {0.f, 0.f, 0.f, 0.f};
#pragma unroll 8
        for (int s = 0; s < 32; ++s) {
            const v4u xw = *(const v4u*)(xr + 32 * s); const f32x4 x0 = {bflo(xw.x), bfhi(xw.x), bflo(xw.y), bfhi(xw.y)}, x1 = {bflo(xw.z), bfhi(xw.z), bflo(xw.w), bfhi(xw.w)};
            const f32x4 a0 = *(const LAS f32x4*)(at + 32 * s + 8 * q), a1 = *(const LAS f32x4*)(at + 32 * s + 8 * q + 4);
            const f32x4 s0 = *(const LAS f32x4*)(sht + 32 * s + 8 * q), s1 = *(const LAS f32x4*)(sht + 32 * s + 8 * q + 4);
            const f32x4 h0 = x0 * rstd * a0 + s0, h1 = x1 * rstd * a1 + s1;
            v4u w; w.x = cvt_pk_bf16(h0.x, h0.y); w.y = cvt_pk_bf16(h0.z, h0.w); w.z = cvt_pk_bf16(h1.x, h1.y); w.w = cvt_pk_bf16(h1.z, h1.w);
            { v2u w8; w8.x = pk4_fp8(h0.x, h0.y, h0.z, h0.w); w8.y = pk4_fp8(h1.x, h1.y, h1.z, h1.w); *(v2u*)(hr + 32 * s) = w8; }
            const bf16x8 bfr = *(const LAS bf16x8*)(wrb + r * 1032 + 32 * s + 8 * q);
            acc = __builtin_amdgcn_mfma_f32_16x16x32_bf16(__builtin_bit_cast(bf16x8, w), bfr, acc, 0, 0, 0);
        }
#pragma unroll
        for (int j = 0; j < 4; ++j) lg[(4 * q + j) * 17 + r] = acc[j];
        LDS_WAIT(); asm volatile("" ::: "memory");
        int my_cls = 0; float my_ga = 0.f, my_gb = 0.f;
        if (lane < 16) {
            float sc[16], sel[16];
#pragma unroll
            for (int e = 0; e < 16; ++e) { const float p = lg[lane * 17 + e]; sc[e] = 1.0f / (1.0f + __expf(-p)); sel[e] = sc[e] + a.router_b[e]; }
            int gi = 0; float gbest = -1.0e30f;
#pragma unroll
            for (int g = 0; g < 4; ++g) { const float p0 = sel[4 * g], p1 = sel[4 * g + 1], p2 = sel[4 * g + 2], p3 = sel[4 * g + 3];
                const float gs = fmaxf(fmaxf(fmaxf(p0 + p1, p0 + p2), fmaxf(p0 + p3, p1 + p2)), fmaxf(p1 + p3, p2 + p3));
                if (gs > gbest) { gbest = gs; gi = g; } }
            float qs[4], s4[4];
#pragma unroll
            for (int i = 0; i < 4; ++i) { qs[i] = 0.f; s4[i] = 0.f; }
#pragma unroll
            for (int g = 0; g < 4; ++g) if (g == gi) {
#pragma unroll
                for (int i = 0; i < 4; ++i) { qs[i] = sel[4 * g + i]; s4[i] = sc[4 * g + i]; } }
            int i1 = 0; float b1 = qs[0];
#pragma unroll
            for (int i = 1; i < 4; ++i) if (qs[i] > b1) { b1 = qs[i]; i1 = i; }
            int i2 = -1; float b2 = -1.0e30f;
#pragma unroll
            for (int i = 0; i < 4; ++i) if (i != i1 && qs[i] > b2) { b2 = qs[i]; i2 = i; }
            const int ia = (i1 < i2) ? i1 : i2, ib = (i1 < i2) ? i2 : i1;
            float sa = 0.f, sb = 0.f;
#pragma unroll
            for (int i = 0; i < 4; ++i) { if (i == ia) sa = s4[i]; if (i == ib) sb = s4[i]; }
            const int pidx = (ia == 0) ? (ib - 1) : ((ia == 1) ? (ib + 1) : 5);
            const float inv = 1.0f / (sa + sb);
            my_cls = gi * 6 + pidx; my_ga = sa * inv; my_gb = sb * inv;
        }
        int rank = 0;
        if (act && lane < 16) rank = __hip_atomic_fetch_add(hist + my_cls, 1, __ATOMIC_RELAXED, __HIP_MEMORY_SCOPE_WORKGROUP);
        __syncthreads();
        if (X.tid < NCLS) { const int n = hist[X.tid]; cbase[X.tid] = n ? (int)__hip_atomic_fetch_add(cnt + 64 * X.tid, (unsigned)n, RLX_AGENT) : 0; }
        __syncthreads();
        if (act && lane < 16) { const int tok = row0 + lane; const int pos = cbase[my_cls] + rank;
            tokl[my_cls * CLS_CAP + pos] = tok; tgate[tok * 2] = my_ga; tgate[tok * 2 + 1] = my_gb; }
    }
}
DI MoeTab moe_tables(const Args& a, const Ctx& X, int l) {
    LAS int* tab = (LAS int*)(X.lds + TAB_OFF); LAS int* tcls = tab; LAS int* tpos = tab + 160; LAS int* cn = tab + 320; LAS int* rt_ = tab + 344;
    unsigned* cnt = (unsigned*)(a.ws + WS_CTL) + CW_CNT + l * 2048;
    if (X.tid < NCLS) cn[X.tid] = (int)__hip_atomic_load(cnt + 64 * X.tid, RLX_AGENT);
    __syncthreads();
    if (X.tid == 0) { int r = 0;
#pragma unroll 1
        for (int c = 0; c < NCLS; ++c) { const int n = (cn[c] + 255) >> 8;
#pragma unroll 1
            for (int i = 0; i < n; ++i) { tcls[r] = c; tpos[r] = i * 256; ++r; } }
        rt_[0] = r; }
    __syncthreads();
    MoeTab tb; tb.tcls = tcls; tb.tpos = tpos; tb.cnt = cn; tb.Rtot = __builtin_amdgcn_readfirstlane(rt_[0]); return tb;
}

#if defined(__HIP_DEVICE_COMPILE__)
DI Args load_args() { auto p = __builtin_amdgcn_kernarg_segment_ptr(); asm volatile("" : "+s"(p)); return *(const __attribute__((address_space(4))) Args*)p; }
#else
DI Args load_args() { return Args{}; }
#endif
__global__ void __launch_bounds__(512, 2) fwd(Args a_unused) {
    extern __shared__ __attribute__((aligned(16))) unsigned char lds_raw[];
    Ctx X; X.lds = (LAS unsigned char*)lds_raw; X.tid = threadIdx.x; X.lane = X.tid & 63; X.wave = __builtin_amdgcn_readfirstlane(X.tid >> 6); X.G = gridDim.x; X.bid = blockIdx.x;
    volatile LAS unsigned* MISC = (volatile LAS unsigned*)(X.lds + MISC_OFF);
    if (X.tid < 64) MISC[X.tid] = 0u;
    __syncthreads();
    int lo, hi; unsigned* ctl;
    { const Args a = load_args(); lo = a.ph_lo; hi = a.ph_hi; ctl = (unsigned*)(a.ws + WS_CTL); }
    XcdBarrier bar; bar.bar = ctl + CW_BAR; bar.x = 0; bar.st = MISC + 8;
    if (hi - lo > 1) bar = xcd_barrier_post(ctl + CW_BAR, MISC + 8);
#ifndef PH_MASK
#define PH_MASK 0xFFFFF
#endif
#define PON(p) ((PH_MASK >> (p)) & 1)
#ifndef DUP_MASK
#define DUP_MASK 0
#endif
#define NREP(p) (((DUP_MASK >> (p)) & 1) ? 2 : 1)
#ifndef TSEL_MASK
#define TSEL_MASK 0
#endif
#define TSCALE 4
#define TSEL(p) ((TSEL_MASK >> (p)) & 1)
#define IN(k) (lo <= (k) && (k) < hi)
#define SEAM(k) do { if (IN(k) && IN((k) + 1)) xcd_barrier(bar); } while (0)
    unsigned long long tacc = 0ull, tph = 0ull;
#define TBEG() do { if (TSEL_MASK) tph = __builtin_amdgcn_s_memrealtime(); } while (0)
#define TEND(p) do { if (TSEL(p)) tacc += __builtin_amdgcn_s_memrealtime() - tph; } while (0)
    TBEG();
    if (PON(10) && IN(0)) { for (int rep = 0; rep < NREP(10); ++rep) { const Args a = load_args(); p0_prologue(a, X); } }
    SEAM(0); TEND(10);
    TBEG();
    for (int l = 0; l < NL; ++l) {
        const int g0 = 1 + l * NPH;
        if (PON(0) && IN(g0 + 0)) { for (int rep = 0; rep < NREP(0); ++rep) { const Args a = load_args(); unsigned char* ws = a.ws; const float* mod = (const float*)(ws + WS_MOD); bf16* proj = (bf16*)(ws + WS_PROJ); bf16* xb = (bf16*)(ws + WS_XB); (void)mod; (void)proj; (void)xb; const Ctx P = fresh(X); p1_norm_gates(a, P, l, xb); } }
        SEAM(g0 + 0); TEND(0); TBEG();
        if (PON(1) && IN(g0 + 1)) for (int rep = 0; rep < NREP(1); ++rep) { const Args a = load_args(); unsigned char* ws = a.ws; const float* mod = (const float*)(ws + WS_MOD); bf16* proj = (bf16*)(ws + WS_PROJ); bf16* xb = (bf16*)(ws + WS_XB); (void)mod; (void)proj; (void)xb; const Ctx P = fresh(X);
            DenseSched S; S.A = (const char*)(ws + WS_H); S.Bt = (const char*)(ws + WS_WIN) + (size_t)l * NPROJW * D; S.lda = D; S.ldb = D; S.ord.init(T / 256, NPROJW / 256, P.G, P.bid);
            EpiProj E; E.O = proj; E.gates = (float*)(ws + WS_GATES); E.big = a.b_ig + l * 4; E.bfg = a.b_fg + l * 4;
            pg8::gemm_phase<EpiProj, DenseSched, true>(P.lds, D, S, E);
        }
        SEAM(g0 + 1); TEND(1); TBEG();
        if (PON(2) && IN(g0 + 2)) { const Args a = load_args(); unsigned char* ws = a.ws; const float* mod = (const float*)(ws + WS_MOD); bf16* proj = (bf16*)(ws + WS_PROJ); bf16* xb = (bf16*)(ws + WS_XB); (void)mod; (void)proj; (void)xb; const Ctx P = fresh(X);
            if (PON(11)) for (int rep = 0; rep < NREP(11); ++rep) {
#pragma unroll 1
                for (int u = P.bid; u < 512; u += P.G) attn_unit(a, P, l, u); }
            if (PON(12)) for (int rep = 0; rep < NREP(12); ++rep) {
#pragma unroll 1
                for (int u = P.bid; u < 256; u += P.G) mlstm_unit<false>(a, P, l, u); }
        }
        SEAM(g0 + 2); TEND(2); TBEG();
        if (PON(3) && IN(g0 + 3)) { const Args a = load_args(); unsigned char* ws = a.ws; const float* mod = (const float*)(ws + WS_MOD); bf16* proj = (bf16*)(ws + WS_PROJ); bf16* xb = (bf16*)(ws + WS_XB); (void)mod; (void)proj; (void)xb; const Ctx P = fresh(X); mlstm_scan(a, P); }
        SEAM(g0 + 3); TEND(3); TBEG();
        if (PON(4) && IN(g0 + 4)) for (int rep = 0; rep < NREP(4); ++rep) { const Args a = load_args(); unsigned char* ws = a.ws; const float* mod = (const float*)(ws + WS_MOD); bf16* proj = (bf16*)(ws + WS_PROJ); bf16* xb = (bf16*)(ws + WS_XB); (void)mod; (void)proj; (void)xb; const Ctx P = fresh(X);
#pragma unroll 1
            for (int u = P.bid; u < 256; u += P.G) mlstm_unit<true>(a, P, l, u); }
        SEAM(g0 + 4); TEND(4); TBEG();
        if (PON(5) && IN(g0 + 5)) for (int rep = 0; rep < NREP(5); ++rep) { const Args a = load_args(); unsigned char* ws = a.ws; const float* mod = (const float*)(ws + WS_MOD); bf16* proj = (bf16*)(ws + WS_PROJ); bf16* xb = (bf16*)(ws + WS_XB); (void)mod; (void)proj; (void)xb; const Ctx P = fresh(X);
            { DenseSched S; S.A = (const char*)(ws + WS_H); S.Bt = (const char*)(ws + WS_WAU) + (size_t)l * D * 512 * 2; S.lda = 1024; S.ldb = 1024; S.ord.init(T / 256, D / 256, P.G, P.bid);
              EpiGate<false> E; E.P = proj; E.gcol = C_GA; pg8::gemm_phase<EpiGate<false>, DenseSched>(P.lds, 1024, S, E); }
            { DenseSched S; S.A = (const char*)(ws + WS_H) + (size_t)T * 512 * 2; S.Bt = (const char*)(ws + WS_WMU) + (size_t)l * D * 512 * 2; S.lda = 1024; S.ldb = 1024; S.ord.init(T / 256, D / 256, P.G, P.bid);
              EpiGate<true> E; E.P = proj; E.gcol = C_GB; pg8::gemm_phase<EpiGate<true>, DenseSched>(P.lds, 1024, S, E); }
        }
        SEAM(g0 + 5); TEND(5); TBEG();
        if (PON(6) && IN(g0 + 6)) for (int rep = 0; rep < NREP(6); ++rep) { const Args a = load_args(); unsigned char* ws = a.ws; const float* mod = (const float*)(ws + WS_MOD); bf16* proj = (bf16*)(ws + WS_PROJ); bf16* xb = (bf16*)(ws + WS_XB); (void)mod; (void)proj; (void)xb; const Ctx P = fresh(X);
            DenseSched S; S.A = (const char*)(proj + C_MQ); S.Bt = (const char*)(ws + WS_WOUT) + (size_t)l * D * D * 2; S.lda = NPROJ * 2; S.ldb = D * 2; S.ord.init(T / 256, D / 256, P.G, P.bid);
            EpiRes E; E.xin = xb; E.out = xb; E.g = mod + (size_t)(l * 2) * 6144 + 2 * 1024; E.ssq = (float*)(ws + WS_SSQ); E.rmask = T - 1;
            if (rep) { E.out = (bf16*)(ws + WS_H); E.rmask = T / 2 - 1; }
            pg8::gemm_phase<EpiRes, DenseSched>(P.lds, D * 2, S, E);
        }
        SEAM(g0 + 6); TEND(6); TBEG();
        if (PON(7) && IN(g0 + 7)) { const Args a = load_args(); unsigned char* ws = a.ws; const float* mod = (const float*)(ws + WS_MOD); bf16* proj = (bf16*)(ws + WS_PROJ); bf16* xb = (bf16*)(ws + WS_XB); (void)mod; (void)proj; (void)xb; const Ctx P = fresh(X); p6_norm_route(a, P, l, xb); }
        SEAM(g0 + 7); TEND(7); TBEG();
        if (PON(8) && IN(g0 + 8)) for (int rep = 0; rep < NREP(8); ++rep) { const Args a = load_args(); unsigned char* ws = a.ws; const float* mod = (const float*)(ws + WS_MOD); bf16* proj = (bf16*)(ws + WS_PROJ); bf16* xb = (bf16*)(ws + WS_XB); (void)mod; (void)proj; (void)xb; const Ctx P = fresh(X);
            const MoeTab tb = moe_tables(a, P, l);
            LAS unsigned* tokoff = (LAS unsigned*)(P.lds + TOKOFF_OFF); const int* tokl = (const int*)(ws + WS_TOKL);
#pragma unroll 1
            for (int s = 0; s < 8; ++s) { const int L0 = s * P.G + P.bid;
                if (L0 < tb.Rtot * 8 && P.tid < 256) { const int L = xcd_remap(L0, tb.Rtot * 8); const int rt = L >> 3, cls = tb.tcls[rt], pos = tb.tpos[rt] + P.tid, cn = tb.cnt[cls]; const int tok = tokl[cls * CLS_CAP + (pos < cn ? pos : 0)]; tokoff[s * 256 + P.tid] = (unsigned)tok; } }
            __syncthreads();
            MoeUpSched S; S.A = (const char*)(ws + WS_H); S.W = (const char*)(ws + WS_WGU) + (size_t)l * NE * 1024 * D; S.lda = D; S.ldb = D; S.tb = tb; S.G = P.G; S.c = P.bid; S.tokoff = tokoff;
            EpiSwiglu E; E.H = proj; E.tgate = (const float*)(ws + WS_TGATE); E.tokoff = tokoff;
            pg8::gemm_phase<EpiSwiglu, MoeUpSched, true>(P.lds, D, S, E);
        }
        SEAM(g0 + 8); TEND(8); TBEG();
        if (PON(9) && IN(g0 + 9)) for (int rep = 0; rep < NREP(9); ++rep) { const Args a = load_args(); unsigned char* ws = a.ws; const float* mod = (const float*)(ws + WS_MOD); bf16* proj = (bf16*)(ws + WS_PROJ); bf16* xb = (bf16*)(ws + WS_XB); (void)mod; (void)proj; (void)xb; const Ctx P = fresh(X);
            const MoeTab tb = moe_tables(a, P, l);
            MoeDownSched S; S.A = (const char*)proj; S.W = (const char*)(ws + WS_WD) + (size_t)l * NE * 1024 * FF * 2; S.lda = D * 2; S.ldb = FF * 2; S.tb = tb; S.G = P.G; S.c = P.bid;
            EpiMoeOut E; E.xin = xb; E.outb = xb; E.outf = a.out; E.last = (l == NL - 1); E.g = mod + (size_t)(l * 2) * 6144 + 5 * 1024; E.tokl = (const int*)(ws + WS_TOKL); E.tb = tb; E.rmask = T - 1;
            if (rep) { E.outb = (bf16*)(ws + WS_H); E.last = 0; E.rmask = T / 2 - 1; }
            pg8::gemm_phase<EpiMoeOut, MoeDownSched>(P.lds, D * 2, S, E);
        }
        SEAM(g0 + 9); TEND(9); TBEG();
    }
    if (TSEL_MASK && X.bid == 0) { const unsigned long long t1 = __builtin_amdgcn_s_memrealtime(); while (__builtin_amdgcn_s_memrealtime() - t1 < TSCALE * tacc) __builtin_amdgcn_s_sleep(8); }
#undef IN
#undef SEAM
}

extern "C" void kernel_launch(void* const* d_in, const int* in_sizes, int n_in, void* d_out, int out_size, void* d_ws, size_t ws_size, hipStream_t stream) {
    static int grid = 0;
    if (grid == 0) {
        if (n_in != 24 || in_sizes[0] != T * D || out_size != T * D || ws_size < WS_END) { fprintf(stderr, "kernel_launch: unexpected shapes / workspace (n_in %d, ws %zu, need %zu)\n", n_in, ws_size, (size_t)WS_END); grid = -1; return; }
        int dev = 0, cus = 0;
        if (hipGetDevice(&dev) != hipSuccess || hipDeviceGetAttribute(&cus, hipDeviceAttributeMultiprocessorCount, dev) != hipSuccess) { grid = -1; return; }
        if (hipFuncSetAttribute((const void*)fwd, hipFuncAttributeMaxDynamicSharedMemorySize, LDS_BYTES) != hipSuccess) { fprintf(stderr, "kernel_launch: hipFuncSetAttribute failed\n"); grid = -1; return; }
        int per_cu = 0;
        if (hipOccupancyMaxActiveBlocksPerMultiprocessor(&per_cu, (const void*)fwd, 512, LDS_BYTES) != hipSuccess || per_cu < 1) fprintf(stderr, "kernel_launch: occupancy query reports %d\n", per_cu);
        (void)hipGetLastError();
        grid = cus < 256 ? cus : 256;
    }
    if (grid < 0) return;
    (void)hipMemsetAsync((char*)d_ws + WS_CTL, 0, CTL_ZERO_BYTES, stream);
    Args a{};
    a.x = (const float*)d_in[0]; a.c = (const float*)d_in[1]; a.pos = (const int*)d_in[2]; a.ada_w = (const float*)d_in[3]; a.ada_b = (const float*)d_in[4];
    a.nmw = (const float*)d_in[5]; a.nfw = (const float*)d_in[6]; a.w_in = (const float*)d_in[7]; a.b_ig = (const float*)d_in[8]; a.b_fg = (const float*)d_in[9];
    a.qnw = (const float*)d_in[10]; a.knw = (const float*)d_in[11]; a.sinks = (const float*)d_in[12]; a.conv_w = (const float*)d_in[13]; a.conv_b = (const float*)d_in[14];
    a.mnw = (const float*)d_in[15]; a.w_au = (const float*)d_in[16]; a.w_mu = (const float*)d_in[17]; a.w_out = (const float*)d_in[18]; a.router_w = (const float*)d_in[19];
    a.router_b = (const float*)d_in[20]; a.w_gate = (const float*)d_in[21]; a.w_up = (const float*)d_in[22]; a.w_down = (const float*)d_in[23];
    a.out = (float*)d_out; a.ws = (unsigned char*)d_ws;
#if MK_MULTI
    for (int gp = 0; gp < NGP; ++gp) { a.ph_lo = gp; a.ph_hi = gp + 1; hipLaunchKernelGGL(fwd, dim3(grid), dim3(512), LDS_BYTES, stream, a); }
#else
    a.ph_lo = 0; a.ph_hi = NGP; hipLaunchKernelGGL(fwd, dim3(grid), dim3(512), LDS_BYTES, stream, a);
#endif
}
```

```cpp
#include <hip/hip_runtime.h>
#include <cstdio>
#include <cstdint>

#ifndef MK_MULTI
#define MK_MULTI 0
#endif

#define GAS __attribute__((address_space(1)))
#define LAS __attribute__((address_space(3)))
typedef unsigned short bf16;
typedef unsigned v4u __attribute__((ext_vector_type(4)));
typedef unsigned v2u __attribute__((ext_vector_type(2)));
typedef float f32x4 __attribute__((ext_vector_type(4)));
typedef float f32x2 __attribute__((ext_vector_type(2)));
typedef short bf16x8 __attribute__((ext_vector_type(8)));
typedef short bf16x4 __attribute__((ext_vector_type(4)));
#define DI __device__ __forceinline__
#define RLX_AGENT __ATOMIC_RELAXED, __HIP_MEMORY_SCOPE_AGENT
#define LDS_WAIT() asm volatile("s_waitcnt lgkmcnt(0)" ::: "memory")
#define VM_WAIT() asm volatile("s_waitcnt vmcnt(0)" ::: "memory")

constexpr int NB = 2, SEQ = 16384, T = NB * SEQ, D = 1024, NL = 4;
constexpr int DIN_SRC = 4872;
constexpr int NPROJ = 4864;
constexpr int C_AQ = 0, C_AK = 512, C_AV = 640, C_MQ = 768, C_MK = 1280, C_MV = 1792, C_MO = 2304, C_GA = 2816, C_GB = 3840;
constexpr int NE = 16, FF = 512;
constexpr int NCLS = 24, CLS_CAP = 32768;
constexpr float EPS = 1e-6f;
constexpr int NPH = 10;
constexpr int NGP = 1 + NL * NPH;

constexpr size_t MiB = 1u << 20;
constexpr size_t WS_CTL = 0, CTL_ZERO_BYTES = 1 * MiB;
constexpr size_t WS_MOD = 1 * MiB;
constexpr size_t WS_ROPE = 2 * MiB;
constexpr size_t WS_GATES = 4 * MiB;
constexpr size_t WS_TGATE = 5 * MiB;
constexpr size_t WS_TOKL = 6 * MiB;
constexpr size_t WS_MLB = 9 * MiB;
constexpr size_t WS_MLC = 10 * MiB;
constexpr int NPROJW = 5120;
constexpr size_t WS_WIN = 28 * MiB;
constexpr size_t WS_WAU = 68 * MiB;
constexpr size_t WS_WMU = 72 * MiB;
constexpr size_t WS_WOUT = 76 * MiB;
constexpr size_t WS_WGU = 84 * MiB;
constexpr size_t WS_WD = 148 * MiB;
constexpr size_t WS_H = 212 * MiB;
constexpr size_t WS_PROJ = 276 * MiB;
constexpr size_t WS_SSQ = 580 * MiB;
constexpr size_t WS_KC = 582 * MiB;
constexpr size_t WS_XB = 614 * MiB;
constexpr size_t WS_END = 678 * MiB;

constexpr int CW_TMO = 0;
constexpr int CW_BAR = 4096;
constexpr int CW_CNT = 8192;

constexpr int RING_BYTES = 131072;
constexpr int MISC_OFF = RING_BYTES;
constexpr int TAB_OFF = RING_BYTES + 256;
constexpr int TOKOFF_OFF = RING_BYTES + 2048;
constexpr int LDS_BYTES = 147456;

DI unsigned f2bf(float f) { unsigned u = __builtin_bit_cast(unsigned, f); return (u + 0x7fffu + ((u >> 16) & 1u)) >> 16; }
DI unsigned pk2(float lo, float hi) { return f2bf(lo) | (f2bf(hi) << 16); }
DI float bf2f(unsigned short b) { return __builtin_bit_cast(float, ((unsigned)b) << 16); }
DI float bflo(unsigned w) { return __builtin_bit_cast(float, w << 16); }
DI float bfhi(unsigned w) { return __builtin_bit_cast(float, w & 0xffff0000u); }
DI float wave_sum(float v) {
#pragma unroll
    for (int o = 1; o < 64; o <<= 1) v += __shfl_xor(v, o);
    return v;
}
DI float sigmoidf_(float x) { return __builtin_amdgcn_rcpf(1.0f + __expf(-x)); }

#define XB_TMO      128
#define XB_XCNT(j)  (256  + 64 * (j))
#define XB_XSUB(j)  (1280 + 64 * (j))
#define XB_XGEN(j)  (2304 + 64 * (j))
#define XB_TOP      3328
#define XB_TOPGEN   3392
#define XCD_BAR_WORDS 3456
#define XB_SPIN_CAP (1u << 18)
__device__ __forceinline__ unsigned xb_ld(unsigned* p)              { return __hip_atomic_load(p, __ATOMIC_RELAXED, __HIP_MEMORY_SCOPE_AGENT); }
__device__ __forceinline__ unsigned xb_add(unsigned* p, unsigned v) { return __hip_atomic_fetch_add(p, v, __ATOMIC_RELAXED, __HIP_MEMORY_SCOPE_AGENT); }
__device__ __forceinline__ unsigned xb_xcc_id() { return (unsigned)__builtin_amdgcn_s_getreg((3 << 11) | 20) & 0xFu; }
#define XB_SPIN(cond, bar) do { unsigned _sp = 0; while (cond) { __builtin_amdgcn_s_sleep(1); \
    if ((++_sp & 255u) == 0u) { if (xb_ld(&(bar)[XB_TMO])) break; if (_sp > XB_SPIN_CAP) { atomicAdd(&(bar)[XB_TMO], 1u); break; } } } } while (0)
struct XcdBarrier { unsigned* bar; unsigned x; volatile LAS unsigned* st; };
__device__ __forceinline__ XcdBarrier xcd_barrier_post(unsigned* bar, volatile LAS unsigned* st) {
    XcdBarrier b; b.bar = bar; b.x = xb_xcc_id(); b.st = st;
    if (threadIdx.x == 0) (void)xb_add(&bar[XB_XCNT(b.x)], 1u);
    return b;
}
__device__ __forceinline__ void xcd_barrier_complete(unsigned* bar, unsigned x, unsigned& nloc, unsigned& nx) {
    const unsigned G = gridDim.x * gridDim.y * gridDim.z;
    unsigned sum, cnt, mine, sp = 0u;
    for (;;) {
        sum = 0u; cnt = 0u; mine = 0u;
#pragma unroll
        for (unsigned j = 0; j < 16; ++j) { const unsigned c = xb_ld(&bar[XB_XCNT(j)]); sum += c; cnt += (c > 0u) ? 1u : 0u; mine = (j == x) ? c : mine; }
        if (sum == G) break;
        __builtin_amdgcn_s_sleep(1);
        if ((++sp & 255u) == 0u) { if (xb_ld(&bar[XB_TMO])) break; if (sp > XB_SPIN_CAP) { atomicAdd(&bar[XB_TMO], 1u); break; } }
    }
    nloc = mine > 0u ? mine : 1u; nx = cnt > 0u ? cnt : 1u;
}
__device__ __forceinline__ void xcd_barrier(const XcdBarrier& b) {
    asm volatile("s_waitcnt vmcnt(0)" ::: "memory");
    __syncthreads();
    if (threadIdx.x == 0) {
        unsigned* bar = b.bar;
        __builtin_amdgcn_s_waitcnt(0);
        unsigned nloc = b.st[0], nx = b.st[1];
        if (nloc == 0u) { xcd_barrier_complete(bar, b.x, nloc, nx); b.st[0] = nloc; b.st[1] = nx; }
        const unsigned old = xb_add(&bar[XB_XSUB(b.x)], 1u);
        const unsigned gen = old / nloc;
        if (old + 1u == (gen + 1u) * nloc) {
            __builtin_amdgcn_fence(__ATOMIC_RELEASE, "agent");
            asm volatile("s_waitcnt vmcnt(0)" ::: "memory");
            const unsigned og = xb_add(&bar[XB_TOP], 1u);
            const unsigned tg = og / nx;
            if (og + 1u == (tg + 1u) * nx) xb_add(&bar[XB_TOPGEN], 1u);
            else XB_SPIN(xb_ld(&bar[XB_TOPGEN]) == tg, bar);
            __builtin_amdgcn_fence(__ATOMIC_ACQUIRE, "agent");
            xb_add(&bar[XB_XGEN(b.x)], 1u);
            asm volatile("s_waitcnt vmcnt(0)" ::: "memory");
        } else {
            XB_SPIN(xb_ld(&bar[XB_XGEN(b.x)]) == gen, bar);
            __builtin_amdgcn_fence(__ATOMIC_ACQUIRE, "agent");
            asm volatile("s_waitcnt vmcnt(0)" ::: "memory");
        }
    }
    __syncthreads();
}

namespace pg8 {
constexpr int BM = 256, BK = 64, HALF = 128, HTB = HALF * BK * 2, STAGE_BYTES = 8 * HTB, NXCD = 8, WGM = 8;
__host__ __device__ __forceinline__ int lds_byte(int r, int c) { const int st = (r >> 4) * 2 + (c >> 5), rr = r & 15, cc = c & 31, ob = rr * 64 + cc * 2; return st * 1024 + (ob ^ (((ob >> 9) & 1) << 5)); }
__host__ __device__ __forceinline__ void stage_rc(int b, int& R, int& C) { const int st = b / 1024, sb = b % 1024, swz = sb ^ (((sb >> 9) & 1) << 5); R = (st >> 1) * 16 + swz / 64; C = (st & 1) * 32 + (swz % 64) / 2; }
__host__ __device__ __forceinline__ int perm32(int rho) { const int n = rho >> 4, i = rho & 15; return 8 * (i >> 2) + 4 * n + (i & 3); }

struct Unit { int pm, pn, x0, x1; };

struct TileOrder {
    int nM, nN, nwg, G, c;
    __device__ void init(int nM_, int nN_, int G_, int c_) { nM = nM_; nN = nN_; nwg = nM * nN; G = G_; c = c_; }
    __device__ bool get(int i, int& pm, int& pn) const {
        const long L = (long)i * G + c; if (L >= nwg) return false;
        int wgid = (int)L; { const int q = nwg / NXCD, r = nwg % NXCD, xcd = wgid % NXCD, off = wgid / NXCD; wgid = (xcd < r ? xcd * (q + 1) : r * (q + 1) + (xcd - r) * q) + off; }
        const int nig = WGM * nN, gid = wgid / nig, fm = gid * WGM, gsz = (nM - fm) < WGM ? (nM - fm) : WGM;
        pm = fm + ((wgid % nig) % gsz); pn = (wgid % nig) / gsz; return true;
    }
};

typedef int v8i __attribute__((ext_vector_type(8)));
template <class Epi, class Sched, bool F8 = false>
__device__ __forceinline__ void gemm_phase(LAS unsigned char* lds, const int Kb, const Sched& S, const Epi& E) {
    int tid = threadIdx.x; asm volatile("" : "+v"(tid));
    const int wid = __builtin_amdgcn_readfirstlane(tid >> 6), lane = tid & 63, wr = wid >> 2, wc = wid & 3, fr = lane & 15, fq = lane >> 4;
    const int nt = Kb / 128;
    constexpr bool GA = Sched::GATHER; constexpr int KS = Sched::KSPLIT; constexpr bool ASPLIT = Sched::ASPLIT;
    unsigned voffA[2], voffB[2]; int Rst[2], Cst[2];
#pragma unroll
    for (int i = 0; i < 2; ++i) { int R, C; stage_rc(tid * 16 + i * 8192, R, C); const int Rb = Epi::PERM ? ((R & ~31) + perm32(R & 31)) : R;
        voffA[i] = (unsigned)(R * S.lda + C * 2); voffB[i] = (unsigned)(Rb * S.ldb + C * 2); Rst[i] = R; Cst[i] = C; }
    const size_t kstep = (size_t)(BK * 2);
    const size_t hstepA = (size_t)HALF * S.lda, hstepB = (size_t)HALF * S.ldb;
    const unsigned ldsw = (unsigned)wid * 1024u; const unsigned gmul = (unsigned)S.lda;
    const int aoff = F8 ? (lds_byte(wr * 64 + fr, (fq & 1) * 16) + (fq >> 1) * 1024) : lds_byte(wr * 64 + fr, fq * 8);
    const int boff = F8 ? (lds_byte(wc * 32 + fr, (fq & 1) * 16) + (fq >> 1) * 1024) : lds_byte(wc * 32 + fr, fq * 8);
    unsigned vAc[2], vAn[2];
#define PG8_SA(b, h) (((b) * 2 + (h)) * HTB)
#define PG8_SB(b, h) ((4 + (b) * 2 + (h)) * HTB)
#define PG8_STAGE2(bufoff, gbase, v0, v1) do { \
        __builtin_amdgcn_global_load_lds((const unsigned*)((const char*)(gbase) + (v0)), (LAS unsigned*)(lds + (bufoff) + ldsw), 16, 0, 0); \
        __builtin_amdgcn_global_load_lds((const unsigned*)((const char*)(gbase) + (v1)), (LAS unsigned*)(lds + (bufoff) + ldsw + 8192), 16, 0, 0); } while (0)
#define PG8_STAGE_B(bufoff, ptr, h) PG8_STAGE2(bufoff, (ptr) + (h) * hstepB, voffB[0], voffB[1])
#define PG8_STAGE_A(bufoff, ptr, h, nx) do { if constexpr (GA) { const unsigned _p = (nx) ? vAn[h] : vAc[h]; PG8_STAGE2(bufoff, ptr, (_p & 0xffffu) * gmul + (unsigned)Cst[0] * 2u, (_p >> 16) * gmul + (unsigned)Cst[0] * 2u); } \
        else { PG8_STAGE2(bufoff, (ptr) + (h) * hstepA, voffA[0], voffA[1]); } } while (0)
    typedef int v4i_ __attribute__((ext_vector_type(4)));
#define PG8_LDA(dst, b, h) do { _Pragma("unroll") for (int m = 0; m < 4; ++m) { if constexpr (F8) { dst##8[m].lo = *(const LAS v4i_*)(lds + PG8_SA(b, h) + aoff + m * 2048); dst##8[m].hi = *(const LAS v4i_*)(lds + PG8_SA(b, h) + aoff + m * 2048 + 16); } \
        else { _Pragma("unroll") for (int k = 0; k < 2; ++k) dst[m][k] = *(const LAS bf16x8*)(lds + PG8_SA(b, h) + aoff + m * 2048 + k * 1024); } } } while (0)
#define PG8_LDB(dst, b, h) do { _Pragma("unroll") for (int n = 0; n < 2; ++n) { if constexpr (F8) { dst##8[n].lo = *(const LAS v4i_*)(lds + PG8_SB(b, h) + boff + n * 2048); dst##8[n].hi = *(const LAS v4i_*)(lds + PG8_SB(b, h) + boff + n * 2048 + 16); } \
        else { _Pragma("unroll") for (int k = 0; k < 2; ++k) dst[n][k] = *(const LAS bf16x8*)(lds + PG8_SB(b, h) + boff + n * 2048 + k * 1024); } } } while (0)
#define PG8_MMA(ai, bj, At, Bt) do { __builtin_amdgcn_s_setprio(1); _Pragma("unroll") for (int m = 0; m < 4; ++m) _Pragma("unroll") for (int n = 0; n < 2; ++n) { \
        if constexpr (F8) { asm volatile("v_mfma_scale_f32_16x16x128_f8f6f4 %0, %1, %2, %0, %3, %3 op_sel_hi:[0,0,0]" : "+v"(acc[ai][bj][m][n]) : "v"(Bt##8[n]), "v"(At##8[m]), "v"(f8scale)); } \
        else { _Pragma("unroll") for (int k = 0; k < 2; ++k) acc[ai][bj][m][n] = __builtin_amdgcn_mfma_f32_16x16x32_bf16(Bt[n][k], At[m][k], acc[ai][bj][m][n], 0, 0, 0); } } \
        __builtin_amdgcn_s_setprio(0); } while (0)
#define PG8_WAIT_V(n) asm volatile("s_waitcnt vmcnt(" #n ")" ::: "memory")
#define PG8_WAIT_L(n) asm volatile("s_waitcnt lgkmcnt(" #n ")" ::: "memory")
#define PG8_BAR __builtin_amdgcn_s_barrier()
#define PG8_SCHED __builtin_amdgcn_sched_barrier(0)
#define PG8_GOFF(dst, u) do { if constexpr (GA) { _Pragma("unroll") for (int h = 0; h < 2; ++h) dst[h] = S.a_rowoff(u, Rst[0] + HALF * h) | (S.a_rowoff(u, Rst[0] + 64 + HALF * h) << 16); } } while (0)
    Unit cur, nxt; int ui = 0;
    if (!S.next(0, cur)) return;
    f32x4 acc[2][2][4][2];
#pragma unroll
    for (int a = 0; a < 2; ++a)
#pragma unroll
        for (int b = 0; b < 2; ++b)
#pragma unroll
            for (int m = 0; m < 4; ++m)
#pragma unroll
                for (int n = 0; n < 2; ++n) acc[a][b][m][n] = (f32x4){0.f, 0.f, 0.f, 0.f};
    int f8scale = 0x7F7F7F7F; asm volatile("" : "+v"(f8scale));
    bf16x8 At[4][2], B0[2][2], B1[2][2]; v8i At8[4], B08[2], B18[2];
    const char* cA = S.a_base(cur, 0); const char* cA1 = ASPLIT ? S.a_base(cur, 1) : cA; const char* cB0 = S.b_base(cur, 0); const char* cB1 = KS ? S.b_base(cur, 1) : cB0;
    PG8_GOFF(vAc, cur);
    vAn[0] = vAc[0]; vAn[1] = vAc[1];
    PG8_STAGE_B(PG8_SB(0, 0), cB0, 0); PG8_STAGE_B(PG8_SB(0, 1), cB0, 1); PG8_STAGE_A(PG8_SA(0, 0), cA, 0, false); PG8_STAGE_A(PG8_SA(0, 1), cA, 1, false);
    if (wr == 1) PG8_BAR;
    PG8_WAIT_V(2); PG8_BAR;
    PG8_STAGE_B(PG8_SB(1, 0), cB0 + kstep, 0); PG8_STAGE_A(PG8_SA(1, 0), cA + kstep, 0, false); PG8_STAGE_B(PG8_SB(1, 1), cB0 + kstep, 1);
    PG8_WAIT_V(6); PG8_BAR;
    for (;;) {
        const bool has_next = S.next(ui + 1, nxt);
        const char* nA = has_next ? S.a_base(nxt, 0) : cA; const char* nA1 = (ASPLIT && has_next) ? S.a_base(nxt, 1) : (ASPLIT ? cA1 : nA); const char* nB0 = has_next ? S.b_base(nxt, 0) : cB0; const char* nB1 = (KS && has_next) ? S.b_base(nxt, 1) : (KS ? cB1 : nB0);
        if constexpr (GA) { if (has_next) { PG8_GOFF(vAn, nxt); } }
#pragma unroll 1
        for (int t = 0; t < nt; t += 2) {
            const bool last = (t == nt - 2);
            const char* a1 = (ASPLIT && (t + 1) >= KS) ? cA1 + (size_t)(t + 1 - KS) * kstep : cA + (size_t)(t + 1) * kstep;
            const char* a2 = last ? nA : ((ASPLIT && (t + 2) >= KS) ? cA1 + (size_t)(t + 2 - KS) * kstep : cA + (size_t)(t + 2) * kstep);
            if constexpr (Epi::MID) { if (t == KS) { int fr_ = fr, fq_ = fq; asm volatile("" : "+v"(fr_), "+v"(fq_)); E.mid(acc, cur, wr, wc, fr_, fq_); } }
            const char* b2 = last ? nB0 : ((KS && (t + 2) >= KS) ? cB1 + (size_t)(t + 2 - KS) * kstep : cB0 + (size_t)(t + 2) * kstep);
            const char* a3 = a2 + kstep; const char* b3 = b2 + kstep;
            PG8_LDB(B0, 0, 0); PG8_LDB(B1, 0, 1); PG8_SCHED; PG8_LDA(At, 0, 0); PG8_STAGE_A(PG8_SA(1, 1), a1, 1, false);
            PG8_WAIT_V(8); PG8_WAIT_L(0); PG8_BAR; PG8_MMA(0, 0, At, B0); PG8_MMA(0, 1, At, B1); PG8_BAR; PG8_SCHED;
            PG8_LDA(At, 0, 1); PG8_STAGE_B(PG8_SB(0, 0), b2, 0); PG8_STAGE_B(PG8_SB(0, 1), b2, 1); PG8_STAGE_A(PG8_SA(0, 0), a2, 0, last);
            PG8_WAIT_V(8); PG8_WAIT_L(0); PG8_BAR; PG8_MMA(1, 0, At, B0); PG8_MMA(1, 1, At, B1); PG8_BAR; PG8_SCHED;
            PG8_LDB(B0, 1, 0); PG8_LDB(B1, 1, 1); PG8_SCHED; PG8_LDA(At, 1, 0); PG8_STAGE_A(PG8_SA(0, 1), a2, 1, last);
            PG8_WAIT_V(8); PG8_WAIT_L(0); PG8_BAR; PG8_MMA(0, 0, At, B0); PG8_MMA(0, 1, At, B1); PG8_BAR; PG8_SCHED;
            PG8_LDA(At, 1, 1); PG8_STAGE_B(PG8_SB(1, 0), b3, 0); PG8_STAGE_B(PG8_SB(1, 1), b3, 1); PG8_STAGE_A(PG8_SA(1, 0), a3, 0, last);
            PG8_WAIT_V(8); PG8_WAIT_L(0); PG8_BAR; PG8_MMA(1, 0, At, B0); PG8_MMA(1, 1, At, B1); PG8_BAR; PG8_SCHED;
        }
        if (wr == 0) PG8_BAR;
        if constexpr (F8) { asm volatile("s_nop 15\n\ts_nop 15" ::: "memory"); }
        { int fr_ = fr, fq_ = fq; asm volatile("" : "+v"(fr_), "+v"(fq_));
          E(acc, cur, wr, wc, fr_, fq_); }
        if (!has_next) break;
#pragma unroll
        for (int a = 0; a < 2; ++a)
#pragma unroll
            for (int b = 0; b < 2; ++b)
#pragma unroll
                for (int m = 0; m < 4; ++m)
#pragma unroll
                    for (int n = 0; n < 2; ++n) acc[a][b][m][n] = (f32x4){0.f, 0.f, 0.f, 0.f};
        cur = nxt; cA = nA; cA1 = nA1; cB0 = nB0; cB1 = nB1; ++ui;
        vAc[0] = vAn[0]; vAc[1] = vAn[1];
        if (wr == 1) PG8_BAR;
    }
    PG8_WAIT_V(0);
    PG8_BAR;
#undef PG8_SA
#undef PG8_SB
#undef PG8_STAGE2
#undef PG8_STAGE_A
#undef PG8_STAGE_B
#undef PG8_LDA
#undef PG8_LDB
#undef PG8_MMA
#undef PG8_WAIT_V
#undef PG8_WAIT_L
#undef PG8_BAR
#undef PG8_SCHED
#undef PG8_GOFF
}
}
using pg8::Unit;

DI unsigned cvt_pk_bf16(float lo, float hi) { unsigned r; asm volatile("v_cvt_pk_bf16_f32 %0, %1, %2" : "=v"(r) : "v"(lo), "v"(hi)); return r; }

struct Args {
    const float* x; const float* c; const int* pos; const float* ada_w; const float* ada_b; const float* nmw; const float* nfw; const float* w_in;
    const float* b_ig; const float* b_fg; const float* qnw; const float* knw; const float* sinks; const float* conv_w; const float* conv_b; const float* mnw;
    const float* w_au; const float* w_mu; const float* w_out; const float* router_w; const float* router_b; const float* w_gate; const float* w_up; const float* w_down;
    float* out; unsigned char* ws; int ph_lo, ph_hi;
};

__constant__ float c_invf[8] = {1.0f, 0.1939227432012558f, 0.03760603070259094f, 0.007292664609849453f, 0.0014142135623842478f, 0.00027424818836152554f, 5.3182957344688475e-05f, 1.0313385246263351e-05f};

struct DenseSched {
    static constexpr bool GATHER = false, ASPLIT = false; static constexpr int KSPLIT = 0;
    const char* A; const char* Bt; int lda, ldb; pg8::TileOrder ord;
    DI bool next(int i, Unit& u) const { int pm, pn; if (!ord.get(i, pm, pn)) return false; u.pm = pm; u.pn = pn; u.x0 = 0; u.x1 = 0; return true; }
    DI const char* a_base(const Unit& u, int) const { return A + (size_t)u.pm * 256 * lda; }
    DI const char* b_base(const Unit& u, int) const { return Bt + (size_t)u.pn * 256 * ldb; }
    DI unsigned a_rowoff(const Unit&, int) const { return 0u; }
};
struct EpiProj {
    static constexpr bool PERM = true, MID = false;
    bf16* O; float* gates; const float* big; const float* bfg;
    DI void operator()(const f32x4 (&acc)[2][2][4][2], const Unit& u, int wr, int wc, int fr, int fq) const {
        const int row0 = u.pm * 256 + wr * 64 + fr, col0 = u.pn * 256 + wc * 32 + 8 * fq; const bool sg = u.pn >= 9; constexpr float WSC = 1.0f / 64.0f;
        if (u.pn == 19) {
            if (wc == 0 && fq == 0) {
#pragma unroll
                for (int ai = 0; ai < 2; ++ai)
#pragma unroll
                    for (int m = 0; m < 4; ++m) { const int row = row0 + ai * 128 + m * 16; const f32x4 vi = acc[ai][0][m][0], vf = acc[ai][0][m][1]; f32x4 oi, of;
#pragma unroll
                        for (int j = 0; j < 4; ++j) { oi[j] = vi[j] * WSC + big[j]; const float z = vf[j] * WSC + bfg[j]; of[j] = fminf(z, 0.f) - log1pf(__expf(-fabsf(z))); }
                        *(f32x4*)(gates + (size_t)row * 8) = oi; *(f32x4*)(gates + (size_t)row * 8 + 4) = of; } }
            return; }
#pragma unroll
        for (int ai = 0; ai < 2; ++ai)
#pragma unroll
            for (int m = 0; m < 4; ++m) { bf16* rowp = O + (size_t)(row0 + ai * 128 + m * 16) * NPROJ + col0;
#pragma unroll
                for (int bj = 0; bj < 2; ++bj) { f32x4 v0 = acc[ai][bj][m][0] * WSC, v1 = acc[ai][bj][m][1] * WSC;
                    if (sg) {
#pragma unroll
                        for (int j = 0; j < 4; ++j) { v0[j] = sigmoidf_(v0[j]); v1[j] = sigmoidf_(v1[j]); } }
                    v4u w; w.x = cvt_pk_bf16(v0[0], v0[1]); w.y = cvt_pk_bf16(v0[2], v0[3]); w.z = cvt_pk_bf16(v1[0], v1[1]); w.w = cvt_pk_bf16(v1[2], v1[3]);
                    *(v4u*)(rowp + bj * 128) = w; } }
    }
};
struct MergeSched {
    static constexpr bool GATHER = false, ASPLIT = true; static constexpr int KSPLIT = 8;
    const char* A0; const char* A1; const char* B0; const char* B1; int lda, ldb; pg8::TileOrder ord;
    DI bool next(int i, Unit& u) const { int pm, pn; if (!ord.get(i, pm, pn)) return false; u.pm = pm; u.pn = pn; u.x0 = 0; u.x1 = 0; return true; }
    DI const char* a_base(const Unit& u, int half) const { return (half ? A1 : A0) + (size_t)u.pm * 256 * lda; }
    DI const char* b_base(const Unit& u, int half) const { return (half ? B1 : B0) + (size_t)u.pn * 256 * ldb; }
    DI unsigned a_rowoff(const Unit&, int) const { return 0u; }
};
struct EpiMerge {
    static constexpr bool PERM = true, MID = true;
    bf16* P;
    DI void mid(f32x4 (&acc)[2][2][4][2], const Unit& u, int wr, int wc, int fr, int fq) const {
        const int row0 = u.pm * 256 + wr * 64 + fr, col0 = u.pn * 256 + wc * 32 + 8 * fq;
#pragma unroll
        for (int ai = 0; ai < 2; ++ai)
#pragma unroll
            for (int m = 0; m < 4; ++m) { const bf16* rowp = P + (size_t)(row0 + ai * 128 + m * 16) * NPROJ + col0;
#pragma unroll
                for (int bj = 0; bj < 2; ++bj) { const v4u ga = *(const v4u*)(rowp + C_GA + bj * 128), gb = *(const v4u*)(rowp + C_GB + bj * 128);
                    f32x4 r0, r1;
                    r0[0] = bflo(ga.x) * __builtin_amdgcn_rcpf(fmaxf(bflo(gb.x), 1e-30f)); r0[1] = bfhi(ga.x) * __builtin_amdgcn_rcpf(fmaxf(bfhi(gb.x), 1e-30f));
                    r0[2] = bflo(ga.y) * __builtin_amdgcn_rcpf(fmaxf(bflo(gb.y), 1e-30f)); r0[3] = bfhi(ga.y) * __builtin_amdgcn_rcpf(fmaxf(bfhi(gb.y), 1e-30f));
                    r1[0] = bflo(ga.z) * __builtin_amdgcn_rcpf(fmaxf(bflo(gb.z), 1e-30f)); r1[1] = bfhi(ga.z) * __builtin_amdgcn_rcpf(fmaxf(bfhi(gb.z), 1e-30f));
                    r1[2] = bflo(ga.w) * __builtin_amdgcn_rcpf(fmaxf(bflo(gb.w), 1e-30f)); r1[3] = bfhi(ga.w) * __builtin_amdgcn_rcpf(fmaxf(bfhi(gb.w), 1e-30f));
                    acc[ai][bj][m][0] *= r0; acc[ai][bj][m][1] *= r1; } }
    }
    DI void operator()(const f32x4 (&acc)[2][2][4][2], const Unit& u, int wr, int wc, int fr, int fq) const {
        const int row0 = u.pm * 256 + wr * 64 + fr, col0 = u.pn * 256 + wc * 32 + 8 * fq;
#pragma unroll
        for (int ai = 0; ai < 2; ++ai)
#pragma unroll
            for (int m = 0; m < 4; ++m) { bf16* rowp = P + (size_t)(row0 + ai * 128 + m * 16) * NPROJ + col0;
#pragma unroll
                for (int bj = 0; bj < 2; ++bj) { const f32x4 v0 = acc[ai][bj][m][0], v1 = acc[ai][bj][m][1];
                    const v4u g = *(const v4u*)(rowp + C_GB + bj * 128);
                    v4u w; w.x = cvt_pk_bf16(bflo(g.x) * v0[0], bfhi(g.x) * v0[1]); w.y = cvt_pk_bf16(bflo(g.y) * v0[2], bfhi(g.y) * v0[3]); w.z = cvt_pk_bf16(bflo(g.z) * v1[0], bfhi(g.z) * v1[1]); w.w = cvt_pk_bf16(bflo(g.w) * v1[2], bfhi(g.w) * v1[3]);
                    *(v4u*)(rowp + C_MQ + bj * 128) = w; } }
    }
};
struct EpiRes {
    static constexpr bool PERM = false, MID = false;
    const bf16* xin; bf16* out; const float* g; float* ssq; int rmask;
    DI void operator()(const f32x4 (&acc)[2][2][4][2], const Unit& u, int wr, int wc, int fr, int fq) const {
        const int row0 = u.pm * 256 + wr * 64 + fr, col0 = u.pn * 256 + wc * 32 + 4 * fq; const int b = (u.pm * 256) >> 14;
        f32x4 gv[2][2];
#pragma unroll
        for (int bj = 0; bj < 2; ++bj)
#pragma unroll
            for (int n = 0; n < 2; ++n) gv[bj][n] = *(const f32x4*)(g + b * 6144 + col0 + bj * 128 + n * 16);
#pragma unroll
        for (int ai = 0; ai < 2; ++ai)
#pragma unroll
            for (int m = 0; m < 4; ++m) { const size_t off = (size_t)(row0 + ai * 128 + m * 16) * D + col0; const size_t offo = (size_t)((row0 + ai * 128 + m * 16) & rmask) * D + col0; float sq = 0.f;
#pragma unroll
                for (int bj = 0; bj < 2; ++bj)
#pragma unroll
                    for (int n = 0; n < 2; ++n) { const v2u xw = *(const v2u*)(xin + off + bj * 128 + n * 16); const f32x4 xv = {bflo(xw.x), bfhi(xw.x), bflo(xw.y), bfhi(xw.y)}; const f32x4 o = xv + gv[bj][n] * acc[ai][bj][m][n];
                        v2u ow; ow.x = cvt_pk_bf16(o.x, o.y); ow.y = cvt_pk_bf16(o.z, o.w); const float r0 = bflo(ow.x), r1 = bfhi(ow.x), r2 = bflo(ow.y), r3 = bfhi(ow.y);
                        sq += (r0 * r0 + r1 * r1) + (r2 * r2 + r3 * r3);
                        *(v2u*)(out + offo + bj * 128 + n * 16) = ow; }
                sq += __shfl_xor(sq, 16); sq += __shfl_xor(sq, 32);
                if (fq == 0) ssq[(size_t)(row0 + ai * 128 + m * 16) * 16 + u.pn * 4 + wc] = sq; }
    }
};

struct MoeTab { const LAS int* tcls; const LAS int* tpos; const LAS int* cnt; int Rtot; };
DI int xcd_remap(int L, int nwg) { const int q = nwg >> 3, r = nwg & 7, xcd = L & 7, off = L >> 3; return (xcd < r ? xcd * (q + 1) : r * (q + 1) + (xcd - r) * q) + off; }
DI void cls_experts(int cls, int& ea, int& eb) { const int g = cls / 6, p = cls - 6 * g; const int a = (p < 3) ? 0 : ((p < 5) ? 1 : 2); const int b = (p < 3) ? (p + 1) : ((p < 5) ? (p - 1) : 3); ea = 4 * g + a; eb = 4 * g + b; }
struct MoeUpSched {
    static constexpr bool GATHER = true, ASPLIT = false; static constexpr int KSPLIT = 0;
    const char* A; const char* W; int lda, ldb; MoeTab tb; int G, c; const LAS unsigned* tokoff;
    DI bool next(int i, Unit& u) const { const int L0 = i * G + c; if (L0 >= tb.Rtot * 8) return false; const int L = xcd_remap(L0, tb.Rtot * 8); u.pm = L >> 3; u.pn = L & 7; u.x0 = i; u.x1 = __builtin_amdgcn_readfirstlane(tb.tcls[u.pm]); return true; }
    DI const char* a_base(const Unit&, int) const { return A; }
    DI const char* b_base(const Unit& u, int) const { int ea, eb; cls_experts(u.x1, ea, eb); const int e = (u.pn < 4) ? ea : eb; return W + ((size_t)e * 1024 + (size_t)(u.pn & 3) * 256) * ldb; }
    DI unsigned a_rowoff(const Unit& u, int r) const { return tokoff[u.x0 * 256 + r]; }
};
struct EpiSwiglu {
    static constexpr bool PERM = true, MID = false;
    bf16* H; const float* tgate; const LAS unsigned* tokoff;
    DI void operator()(const f32x4 (&acc)[2][2][4][2], const Unit& u, int wr, int wc, int fr, int fq) const {
        const int r0 = wr * 64 + fr; const int hc = (u.pn >> 2) * 512 + (u.pn & 3) * 128 + wc * 32 + 8 * fq; const int gsel = u.pn >> 2;
#pragma unroll
        for (int ai = 0; ai < 2; ++ai)
#pragma unroll
            for (int m = 0; m < 4; ++m) { const int r = r0 + ai * 128 + m * 16; const unsigned tok = tokoff[u.x0 * 256 + r]; const float rg = tgate[tok * 2 + gsel];
                const f32x4 g0 = acc[ai][0][m][0] * (1.0f / 64.0f), g1 = acc[ai][0][m][1] * (1.0f / 64.0f), u0 = acc[ai][1][m][0] * (1.0f / 64.0f), u1 = acc[ai][1][m][1] * (1.0f / 64.0f);
                float o[8];
#pragma unroll
                for (int j = 0; j < 4; ++j) { o[j] = g0[j] * sigmoidf_(g0[j]) * u0[j] * rg; o[4 + j] = g1[j] * sigmoidf_(g1[j]) * u1[j] * rg; }
                v4u w; w.x = cvt_pk_bf16(o[0], o[1]); w.y = cvt_pk_bf16(o[2], o[3]); w.z = cvt_pk_bf16(o[4], o[5]); w.w = cvt_pk_bf16(o[6], o[7]);
                *(v4u*)(H + ((size_t)u.pm * 256 + r) * 1024 + hc) = w; }
    }
};
struct MoeDownSched {
    static constexpr bool GATHER = false, ASPLIT = false; static constexpr int KSPLIT = 8;
    const char* A; const char* W; int lda, ldb; MoeTab tb; int G, c;
    DI bool next(int i, Unit& u) const { const int L0 = i * G + c; if (L0 >= tb.Rtot * 4) return false; const int L = xcd_remap(L0, tb.Rtot * 4); u.pm = L >> 2; u.pn = L & 3; u.x0 = __builtin_amdgcn_readfirstlane(tb.tpos[u.pm]); u.x1 = __builtin_amdgcn_readfirstlane(tb.tcls[u.pm]); return true; }
    DI const char* a_base(const Unit& u, int) const { return A + (size_t)u.pm * 256 * lda; }
    DI const char* b_base(const Unit& u, int half) const { int ea, eb; cls_experts(u.x1, ea, eb); const int e = half ? eb : ea; return W + ((size_t)e * 1024 + (size_t)u.pn * 256) * ldb; }
    DI unsigned a_rowoff(const Unit&, int) const { return 0u; }
};
struct EpiMoeOut {
    static constexpr bool PERM = false, MID = false;
    const bf16* xin; bf16* outb; float* outf; const float* g; const int* tokl; MoeTab tb; int rmask, last;
    DI void operator()(const f32x4 (&acc)[2][2][4][2], const Unit& u, int wr, int wc, int fr, int fq) const {
        const int r0 = wr * 64 + fr, col0 = u.pn * 256 + wc * 32 + 4 * fq; const int cn = tb.cnt[u.x1];
#pragma unroll
        for (int ai = 0; ai < 2; ++ai)
#pragma unroll
            for (int m = 0; m < 4; ++m) { const int pos = u.x0 + r0 + ai * 128 + m * 16;
                if (pos < cn) { const int tok = tokl[u.x1 * CLS_CAP + pos]; const int b = tok >> 14; const bf16* ip = xin + (size_t)tok * D + col0; bf16* op = outb + (size_t)(tok & rmask) * D + col0; float* of = outf + (size_t)tok * D + col0; const float* gp = g + b * 6144 + col0;
#pragma unroll
                    for (int bj = 0; bj < 2; ++bj)
#pragma unroll
                        for (int n = 0; n < 2; ++n) { const v2u xw = *(const v2u*)(ip + bj * 128 + n * 16); const f32x4 xv = {bflo(xw.x), bfhi(xw.x), bflo(xw.y), bfhi(xw.y)}; const f32x4 gv = *(const f32x4*)(gp + bj * 128 + n * 16);
                            const f32x4 o = xv + gv * acc[ai][bj][m][n];
                            if (last) *(f32x4*)(of + bj * 128 + n * 16) = o;
                            else { v2u ow; ow.x = cvt_pk_bf16(o.x, o.y); ow.y = cvt_pk_bf16(o.z, o.w); *(v2u*)(op + bj * 128 + n * 16) = ow; } } } }
    }
};

struct Ctx { LAS unsigned char* lds; int tid, lane, wave, G, bid; };
DI Ctx fresh(const Ctx& X) { Ctx P = X; int t = X.tid; asm volatile("" : "+v"(t)); P.tid = t; P.lane = t & 63; P.wave = __builtin_amdgcn_readfirstlane(t >> 6); return P; }

DI void tr_item(const float* W, int ldw, int K, bf16* WT, int k0, LAS float* scr, int lane) {
#pragma unroll 8
    for (int i = 0; i < 32; ++i) { const int kk = 2 * i + (lane >> 5); scr[kk * 33 + (lane & 31)] = W[(size_t)(k0 + kk) * ldw + (lane & 31)]; }
    LDS_WAIT(); asm volatile("" ::: "memory");
    const int c = lane & 7;
#pragma unroll
    for (int j = 0; j < 4; ++j) { const int n = (lane >> 3) + 8 * j; const LAS float* s = scr + (8 * c) * 33 + n;
        v4u o; o.x = pk2(s[0 * 33], s[1 * 33]); o.y = pk2(s[2 * 33], s[3 * 33]); o.z = pk2(s[4 * 33], s[5 * 33]); o.w = pk2(s[6 * 33], s[7 * 33]);
        *(v4u*)(WT + (size_t)n * K + k0 + 8 * c) = o; }
    LDS_WAIT(); asm volatile("" ::: "memory");
}
DI unsigned pk4_fp8(float a0, float a1, float a2, float a3) { int p = __builtin_amdgcn_cvt_pk_fp8_f32(a0, a1, 0, false); p = __builtin_amdgcn_cvt_pk_fp8_f32(a2, a3, p, true); return (unsigned)p; }
DI void tr_item8(const float* W, int ldw, int K, unsigned char* WT, int k0, float scale, LAS float* scr, int lane) {
#pragma unroll 8
    for (int i = 0; i < 32; ++i) { const int kk = 2 * i + (lane >> 5); scr[kk * 33 + (lane & 31)] = W[(size_t)(k0 + kk) * ldw + (lane & 31)]; }
    LDS_WAIT(); asm volatile("" ::: "memory");
    const int c = lane & 7;
#pragma unroll
    for (int j = 0; j < 4; ++j) { const int n = (lane >> 3) + 8 * j; const LAS float* s = scr + (8 * c) * 33 + n;
        v2u o; o.x = pk4_fp8(s[0 * 33] * scale, s[1 * 33] * scale, s[2 * 33] * scale, s[3 * 33] * scale); o.y = pk4_fp8(s[4 * 33] * scale, s[5 * 33] * scale, s[6 * 33] * scale, s[7 * 33] * scale);
        *(v2u*)(WT + (size_t)n * K + k0 + 8 * c) = o; }
    LDS_WAIT(); asm volatile("" ::: "memory");
}
DI void p0_prologue(const Args& a, const Ctx& X) {
    unsigned char* ws = a.ws;
    LAS float* scr = (LAS float*)(X.lds + X.wave * 16384);
    const int gw = X.bid * 8 + X.wave, NGW = X.G * 8;
    constexpr int IT_WIN = 16 * 153, IT_AU = 8 * 32, IT_OUT = 16 * 32, IT_GU = 16 * 16 * 32, IT_DN = 16 * 8 * 32;
    constexpr int IT_L = IT_WIN + 2 * IT_AU + IT_OUT + IT_GU + IT_DN;
    for (int it = gw; it < NL * IT_L; it += NGW) {
        const int l = it / IT_L; int r = it - l * IT_L;
        if (r < IT_WIN) { const int kb = r / 153, nb = r - kb * 153, d0 = 32 * nb, s0 = (nb == 152) ? 2304 : (d0 + (d0 >= 2304 ? 8 : 0));
            tr_item8(a.w_in + (size_t)l * D * DIN_SRC + s0, DIN_SRC, D, (unsigned char*)(ws + WS_WIN) + ((size_t)l * NPROJW + d0) * D, 64 * kb, 64.0f, scr, X.lane); continue; }
        r -= IT_WIN;
        if (r < IT_AU) { const int kb = r >> 5, nb = r & 31;
            tr_item(a.w_au + (size_t)l * 512 * D + 32 * nb, D, 512, (bf16*)(ws + WS_WAU) + ((size_t)l * D + 32 * nb) * 512, 64 * kb, scr, X.lane); continue; }
        r -= IT_AU;
        if (r < IT_AU) { const int kb = r >> 5, nb = r & 31;
            tr_item(a.w_mu + (size_t)l * 512 * D + 32 * nb, D, 512, (bf16*)(ws + WS_WMU) + ((size_t)l * D + 32 * nb) * 512, 64 * kb, scr, X.lane); continue; }
        r -= IT_AU;
        if (r < IT_OUT) { const int kb = r >> 5, nb = r & 31;
            tr_item(a.w_out + (size_t)l * D * D + 32 * nb, D, D, (bf16*)(ws + WS_WOUT) + ((size_t)l * D + 32 * nb) * D, 64 * kb, scr, X.lane); continue; }
        r -= IT_OUT;
        if (r < IT_GU) { const int e = r >> 9, q = r & 511, kb = q >> 5, nb = q & 31, tq = nb >> 3, rb = nb & 7;
            const float* src = ((rb < 4) ? a.w_gate : a.w_up) + ((size_t)(l * NE + e) * D) * FF + 128 * tq + 32 * (rb & 3);
            tr_item8(src, FF, D, (unsigned char*)(ws + WS_WGU) + ((size_t)(l * NE + e) * 1024 + 32 * nb) * D, 64 * kb, 64.0f, scr, X.lane); continue; }
        r -= IT_GU;
        { const int e = r >> 8, q = r & 255, kb = q >> 5, nb = q & 31;
            tr_item(a.w_down + ((size_t)(l * NE + e) * FF) * D + 32 * nb, D, FF, (bf16*)(ws + WS_WD) + ((size_t)(l * NE + e) * 1024 + 32 * nb) * FF, 64 * kb, scr, X.lane); }
    }
    { const float* xs = a.x; bf16* xb = (bf16*)(ws + WS_XB);
      for (size_t i = (size_t)X.bid * 512 + X.tid; i < (size_t)T * D / 8; i += (size_t)X.G * 512) { const f32x4 v0 = *(const f32x4*)(xs + 8 * i), v1 = *(const f32x4*)(xs + 8 * i + 4);
          v4u w; w.x = cvt_pk_bf16(v0.x, v0.y); w.y = cvt_pk_bf16(v0.z, v0.w); w.z = cvt_pk_bf16(v1.x, v1.y); w.w = cvt_pk_bf16(v1.z, v1.w); *(v4u*)(xb + 8 * i) = w; } }
    { float* cs = (float*)(ws + WS_ROPE); float* sn = cs + (size_t)T * 8;
      for (int i = X.bid * 512 + X.tid; i < T * 8; i += X.G * 512) { const int tok = i >> 3, f = i & 7; const float angf = (float)a.pos[tok] * c_invf[f];
          double rev = (double)angf * 0.15915494309189535; rev -= rint(rev); const float rf = (float)rev;
          cs[i] = __builtin_amdgcn_cosf(rf); sn[i] = __builtin_amdgcn_sinf(rf); } }
    __syncthreads();
    LAS float* cact = (LAS float*)X.lds; LAS float* red = (LAS float*)(X.lds + 8192);
    for (int i = X.tid; i < 2048; i += 512) { const float cv = a.c[i]; cact[i] = cv / (1.0f + __expf(-cv)); }
    __syncthreads();
    float* mod = (float*)(ws + WS_MOD);
    for (int it = X.bid; it < NL * 96; it += X.G) { const int l = it / 96, cg = it - l * 96; const int col = cg * 64 + X.lane;
        const float* w = a.ada_w + (size_t)l * D * 6144 + col; float s0 = 0.f, s1 = 0.f;
#pragma unroll 8
        for (int kk = 0; kk < 128; ++kk) { const int k = X.wave * 128 + kk; const float wv = w[(size_t)k * 6144]; s0 += cact[k] * wv; s1 += cact[1024 + k] * wv; }
        red[(X.wave * 2 + 0) * 64 + X.lane] = s0; red[(X.wave * 2 + 1) * 64 + X.lane] = s1;
        __syncthreads();
        if (X.tid < 128) { const int b = X.tid >> 6, ln = X.tid & 63; float s = 0.f;
#pragma unroll
            for (int w8 = 0; w8 < 8; ++w8) s += red[(w8 * 2 + b) * 64 + ln];
            mod[(size_t)(l * 2 + b) * 6144 + cg * 64 + ln] = s + a.ada_b[l * 6144 + cg * 64 + ln]; }
        __syncthreads();
    }
}

DI void p1_norm_gates(const Args& a, const Ctx& X, int l, const bf16* xin) {
    unsigned char* ws = a.ws;
    const float* mod = (const float*)(ws + WS_MOD); unsigned char* hb = (unsigned char*)(ws + WS_H);
    const int gw = X.bid * 8 + X.wave, NGW = X.G * 8;
    for (int rg = gw; rg < T / 16; rg += NGW) {
        const int row0 = rg * 16, b = row0 >> 14;
        const float* mb = mod + (size_t)(l * 2 + b) * 6144;
        f32x4 aw[4], sh[4];
#pragma unroll
        for (int j = 0; j < 4; ++j) { const int k = 256 * j + 4 * X.lane; const f32x4 nw = *(const f32x4*)(a.nmw + l * D + k); const f32x4 sc = *(const f32x4*)(mb + 1024 + k); aw[j] = nw * (sc + 1.0f); sh[j] = *(const f32x4*)(mb + k); }
        v2u pre[4][4];
#pragma unroll
        for (int q = 0; q < 4; ++q) { const v2u* xp = (const v2u*)(xin + (size_t)(row0 + q) * D) + X.lane;
#pragma unroll
            for (int j = 0; j < 4; ++j) pre[q][j] = xp[64 * j]; }
#pragma unroll 1
        for (int rb = 0; rb < 16; rb += 4) {
#pragma unroll
          for (int q = 0; q < 4; ++q) { const int row = row0 + rb + q;
            f32x4 v[4]; float ss = 0.f;
#pragma unroll
            for (int j = 0; j < 4; ++j) { const v2u pw = pre[q][j]; v[j] = (f32x4){bflo(pw.x), bfhi(pw.x), bflo(pw.y), bfhi(pw.y)}; }
            if (rb + 4 < 16) { const v2u* xp = (const v2u*)(xin + (size_t)(row + 4) * D) + X.lane;
#pragma unroll
                for (int j = 0; j < 4; ++j) pre[q][j] = xp[64 * j]; }
#pragma unroll
            for (int j = 0; j < 4; ++j) ss += (v[j].x * v[j].x + v[j].y * v[j].y) + (v[j].z * v[j].z + v[j].w * v[j].w);
            ss = wave_sum(ss); const float rstd = __builtin_amdgcn_rsqf(ss * (1.0f / D) + EPS);
            unsigned* o4 = (unsigned*)(hb + (size_t)row * D) + X.lane;
#pragma unroll
            for (int j = 0; j < 4; ++j) { v[j] = v[j] * rstd * aw[j] + sh[j]; o4[64 * j] = pk4_fp8(v[j].x, v[j].y, v[j].z, v[j].w); }
          }
        }
    }
}

DI void attn_unit(const Args& a, const Ctx& X, int l, int unit) {
    unsigned char* ws = a.ws; const bf16* proj = (const bf16*)(ws + WS_PROJ); bf16* ao = (bf16*)(ws + WS_H);
    const float* cs = (const float*)(ws + WS_ROPE); const float* sn = cs + (size_t)T * 8;
    const int b = unit >> 8, rem = unit & 255, nb = rem >> 1, kvh = rem & 1; const int tok0 = b * SEQ + nb * 128;
    LAS bf16* Kl = (LAS bf16*)X.lds;
    LAS bf16* VT = (LAS bf16*)(X.lds + 36864);
    int lane = X.lane; asm volatile("" : "+v"(lane));
    const int c16 = lane & 15, quad = lane >> 4;
    {
        const int row = X.tid >> 1, half = X.tid & 1; const int tokk = tok0 - 128 + row; const bool valid = (nb > 0) || (row >= 128);
        float y[32]; float vv[32];
        if (valid) {
            const v4u* kp = (const v4u*)(proj + (size_t)tokk * NPROJ + C_AK + kvh * 64 + half * 32); const v4u* vp = (const v4u*)(proj + (size_t)tokk * NPROJ + C_AV + kvh * 64 + half * 32);
#pragma unroll
            for (int q = 0; q < 4; ++q) { const v4u kw = kp[q], vw = vp[q];
                y[8 * q + 0] = bflo(kw.x); y[8 * q + 1] = bfhi(kw.x); y[8 * q + 2] = bflo(kw.y); y[8 * q + 3] = bfhi(kw.y); y[8 * q + 4] = bflo(kw.z); y[8 * q + 5] = bfhi(kw.z); y[8 * q + 6] = bflo(kw.w); y[8 * q + 7] = bfhi(kw.w);
                vv[8 * q + 0] = bflo(vw.x); vv[8 * q + 1] = bfhi(vw.x); vv[8 * q + 2] = bflo(vw.y); vv[8 * q + 3] = bfhi(vw.y); vv[8 * q + 4] = bflo(vw.z); vv[8 * q + 5] = bfhi(vw.z); vv[8 * q + 6] = bflo(vw.w); vv[8 * q + 7] = bfhi(vw.w); }
        } else {
#pragma unroll
            for (int i = 0; i < 32; ++i) { y[i] = 0.f; vv[i] = 0.f; } }
        float ss = 0.f;
#pragma unroll
        for (int i = 0; i < 32; ++i) ss += y[i] * y[i];
        ss += __shfl_xor(ss, 1); const float rstd = 1.0f / sqrtf(ss * (1.0f / 64.0f) + EPS);
#pragma unroll
        for (int i = 0; i < 32; ++i) y[i] = y[i] * rstd * a.knw[l * 64 + half * 32 + i];
        if (half == 0 && valid) {
#pragma unroll
            for (int d = 0; d < 8; ++d) { const float c = cs[(size_t)tokk * 8 + d], s = sn[(size_t)tokk * 8 + d]; const float t1 = y[d], t2 = y[d + 8]; y[d] = t1 * c - t2 * s; y[d + 8] = t2 * c + t1 * s; } }
#pragma unroll
        for (int q = 0; q < 4; ++q) { v4u w; w.x = pk2(y[8 * q], y[8 * q + 1]); w.y = pk2(y[8 * q + 2], y[8 * q + 3]); w.z = pk2(y[8 * q + 4], y[8 * q + 5]); w.w = pk2(y[8 * q + 6], y[8 * q + 7]);
            *(LAS v4u*)(Kl + row * 72 + half * 32 + 8 * q) = w; }
#pragma unroll
        for (int i = 0; i < 32; ++i) VT[(half * 32 + i) * 280 + row] = (bf16)f2bf(vv[i]);
        if (X.tid < 64) {
#pragma unroll
            for (int cc = 256; cc < 280; ++cc) VT[X.tid * 280 + cc] = 0; }
    }
    __syncthreads();
#pragma unroll 1
    for (int task = X.wave; task < 32; task += 8) {
        const int g = task >> 3, rg = task & 7, r0 = 16 * rg, head = kvh * 4 + g; const int tokq = tok0 + r0 + c16;
        const float sink = a.sinks[l * 8 + head];
        float qv[16];
        { const bf16* qp = proj + (size_t)tokq * NPROJ + C_AQ + head * 64; const v4u w0 = *(const v4u*)(qp + 8 * quad), w1 = *(const v4u*)(qp + 32 + 8 * quad);
          qv[0] = bflo(w0.x); qv[1] = bfhi(w0.x); qv[2] = bflo(w0.y); qv[3] = bfhi(w0.y); qv[4] = bflo(w0.z); qv[5] = bfhi(w0.z); qv[6] = bflo(w0.w); qv[7] = bfhi(w0.w);
          qv[8] = bflo(w1.x); qv[9] = bfhi(w1.x); qv[10] = bflo(w1.y); qv[11] = bfhi(w1.y); qv[12] = bflo(w1.z); qv[13] = bfhi(w1.z); qv[14] = bflo(w1.w); qv[15] = bfhi(w1.w); }
        float ss = 0.f;
#pragma unroll
        for (int i = 0; i < 16; ++i) ss += qv[i] * qv[i];
        ss += __shfl_xor(ss, 16); ss += __shfl_xor(ss, 32); const float rstd = 1.0f / sqrtf(ss * (1.0f / 64.0f) + EPS);
#pragma unroll
        for (int i = 0; i < 8; ++i) { qv[i] = qv[i] * rstd * a.qnw[l * 64 + 8 * quad + i]; qv[8 + i] = qv[8 + i] * rstd * a.qnw[l * 64 + 32 + 8 * quad + i]; }
#pragma unroll
        for (int d = 0; d < 8; ++d) { const float other = __shfl_xor(qv[d], 16); const float c = cs[(size_t)tokq * 8 + d], s = sn[(size_t)tokq * 8 + d];
            if (quad == 0) qv[d] = qv[d] * c - other * s; else if (quad == 1) qv[d] = qv[d] * c + other * s; }
        bf16x8 qf[2];
        { v4u w; w.x = pk2(qv[0], qv[1]); w.y = pk2(qv[2], qv[3]); w.z = pk2(qv[4], qv[5]); w.w = pk2(qv[6], qv[7]); qf[0] = __builtin_bit_cast(bf16x8, w);
          w.x = pk2(qv[8], qv[9]); w.y = pk2(qv[10], qv[11]); w.z = pk2(qv[12], qv[13]); w.w = pk2(qv[14], qv[15]); qf[1] = __builtin_bit_cast(bf16x8, w); }
        f32x4 sacc[9];
#pragma unroll
        for (int i = 0; i < 9; ++i) { const LAS bf16* kr = Kl + (16 * (rg + i) + c16) * 72 + 8 * quad;
            const bf16x8 k0 = *(const LAS bf16x8*)kr, k1 = *(const LAS bf16x8*)(kr + 32);
            f32x4 z = {0.f, 0.f, 0.f, 0.f}; z = __builtin_amdgcn_mfma_f32_16x16x32_bf16(k0, qf[0], z, 0, 0, 0); sacc[i] = __builtin_amdgcn_mfma_f32_16x16x32_bf16(k1, qf[1], z, 0, 0, 0); }
        int dbase = 4 * quad - c16; asm volatile("" : "+v"(dbase)); int kbase = 16 * rg + 4 * quad; asm volatile("" : "+v"(kbase)); float mx = sink;
#pragma unroll
        for (int i = 0; i < 9; ++i)
#pragma unroll
            for (int j = 0; j < 4; ++j) { const int dlt = dbase + 16 * i + j; const int kj = kbase + 16 * i + j; const bool ok = (dlt > 0) && (dlt <= 128) && ((nb > 0) || (kj >= 128));
                const float s = ok ? sacc[i][j] * 0.125f : -3.0e38f; sacc[i][j] = s; mx = fmaxf(mx, s); }
        mx = fmaxf(mx, __shfl_xor(mx, 16)); mx = fmaxf(mx, __shfl_xor(mx, 32));
        float sum = 0.f;
#pragma unroll
        for (int i = 0; i < 9; ++i)
#pragma unroll
            for (int j = 0; j < 4; ++j) { const float p = (sacc[i][j] > -1.0e38f) ? __expf(sacc[i][j] - mx) : 0.f; sacc[i][j] = p; sum += p; }
        sum += __shfl_xor(sum, 16); sum += __shfl_xor(sum, 32);
        const float inv = 1.0f / (sum + __expf(sink - mx));
        f32x4 oacc[4];
#pragma unroll
        for (int et = 0; et < 4; ++et) oacc[et] = (f32x4){0.f, 0.f, 0.f, 0.f};
#pragma unroll
        for (int kk = 0; kk < 5; ++kk) {
            v4u pw; pw.x = pk2(sacc[2 * kk][0], sacc[2 * kk][1]); pw.y = pk2(sacc[2 * kk][2], sacc[2 * kk][3]);
            if (2 * kk + 1 < 9) { pw.z = pk2(sacc[(2 * kk + 1 < 9) ? 2 * kk + 1 : 0][0], sacc[(2 * kk + 1 < 9) ? 2 * kk + 1 : 0][1]); pw.w = pk2(sacc[(2 * kk + 1 < 9) ? 2 * kk + 1 : 0][2], sacc[(2 * kk + 1 < 9) ? 2 * kk + 1 : 0][3]); } else { pw.z = 0u; pw.w = 0u; }
            const bf16x8 pf = __builtin_bit_cast(bf16x8, pw);
#pragma unroll
            for (int et = 0; et < 4; ++et) { const LAS bf16* vr = VT + (16 * et + c16) * 280 + 16 * rg + 32 * kk + 4 * quad;
                const v2u lo = *(const LAS v2u*)vr, hi = *(const LAS v2u*)(vr + 16); v4u vw; vw.x = lo.x; vw.y = lo.y; vw.z = hi.x; vw.w = hi.y;
                oacc[et] = __builtin_amdgcn_mfma_f32_16x16x32_bf16(__builtin_bit_cast(bf16x8, vw), pf, oacc[et], 0, 0, 0); }
        }
#pragma unroll
        for (int et = 0; et < 4; ++et) { v2u w; w.x = pk2(oacc[et][0] * inv, oacc[et][1] * inv); w.y = pk2(oacc[et][2] * inv, oacc[et][3] * inv);
            *(v2u*)(ao + (size_t)tokq * 512 + head * 64 + 16 * et + 4 * quad) = w; }
    }
    __syncthreads();
}

constexpr int ML_Q = 0, ML_K = 17408, ML_KET = 34816, ML_VT = 53248, ML_CT = 73984, ML_CW = 113152, ML_CB = 118272, ML_RED = 118784, ML_NW = 119296, ML_GT = 119808;
DI float bfw(unsigned w, int hi) { return hi ? bfhi(w) : bflo(w); }
template <bool L3> DI void mlstm_unit(const Args& a, const Ctx& X, int l, int unit) {
    unsigned char* ws = a.ws; const bf16* proj = (const bf16*)(ws + WS_PROJ); bf16* hm = (bf16*)(ws + WS_H) + (size_t)T * 512;
    bf16* kcb = (bf16*)(ws + WS_KC);
    const float* gates = (const float*)(ws + WS_GATES); float* mlc = (float*)(ws + WS_MLC) + (size_t)unit * 18432; float* mlb = (float*)(ws + WS_MLB);
    const int seq = unit >> 5, sj = unit & 31, b = seq >> 2, hh = seq & 3; const int tokbase = b * SEQ + sj * 512;
    LAS bf16* Qs = (LAS bf16*)(X.lds + ML_Q); LAS bf16* Ks = (LAS bf16*)(X.lds + ML_K); LAS bf16* KET = (LAS bf16*)(X.lds + ML_KET);
    LAS bf16* VT = (LAS bf16*)(X.lds + ML_VT); LAS bf16* CT = (LAS bf16*)(X.lds + ML_CT); LAS float* CW = (LAS float*)(X.lds + ML_CW);
    LAS float* CB = (LAS float*)(X.lds + ML_CB); LAS float* RED = (LAS float*)(X.lds + ML_RED); LAS float* NW = (LAS float*)(X.lds + ML_NW);
    LAS float* GT = (LAS float*)(X.lds + ML_GT);
    int lane = X.lane; asm volatile("" : "+v"(lane));
    const int c16 = lane & 15, quad = lane >> 4, w = X.wave;
    int tidl = X.tid; asm volatile("" : "+v"(tidl));
    const int tg = tidl >> 5, cg = tidl & 31, t0 = 4 * tg, c0 = 4 * cg;
    v2u rq[7], rk[7], rv[4], kcv[4];
#define ML_LBAR() do { asm volatile("s_waitcnt lgkmcnt(0)" ::: "memory"); __builtin_amdgcn_s_barrier(); asm volatile("" ::: "memory"); } while (0)
#define ML_LOADRAW(tokc) do { _Pragma("unroll") for (int j = 0; j < 7; ++j) { const int tt = (tokc) + t0 - 3 + j; const bool ok = tt >= b * SEQ; const bf16* rp = proj + (size_t)(ok ? tt : (tokc)) * NPROJ + hh * 128 + c0; \
        if (L3) { rq[j] = *(const v2u*)(rp + C_MQ); if (!ok) { rq[j].x = 0u; rq[j].y = 0u; } } else { rk[j] = *(const v2u*)(rp + C_MK); if (!ok) { rk[j].x = 0u; rk[j].y = 0u; } } } \
        if (L3) { _Pragma("unroll") for (int i = 0; i < 4; ++i) kcv[i] = *(const v2u*)(kcb + (size_t)((tokc) + t0 + i) * 512 + hh * 128 + c0); } \
        _Pragma("unroll") for (int i = 0; i < 4; ++i) rv[i] = *(const v2u*)(proj + (size_t)((tokc) + t0 + i) * NPROJ + C_MV + hh * 128 + c0); } while (0)
    ML_LOADRAW(tokbase);
    for (int idx = X.tid; idx < 1280; idx += 512) { const int tap = idx >> 8, ch = idx & 255; const int gch = (ch < 128) ? (hh * 128 + ch) : (512 + hh * 128 + (ch - 128));
        CW[idx] = (tap < 4) ? a.conv_w[(size_t)(l * 4 + tap) * 1024 + gch] : a.conv_b[l * 1024 + gch]; }
    for (int idx = X.tid; idx < 16 * 72; idx += 512) VT[128 * 72 + idx] = (idx < 72) ? (bf16)0x3F80 : (bf16)0;
    if (X.tid < 128) NW[X.tid] = a.mnw[l * 512 + hh * 128 + X.tid];
    { const float* gp = gates + (size_t)(tokbase + X.tid) * 8; GT[2 * X.tid] = gp[hh]; GT[2 * X.tid + 1] = gp[4 + hh]; }
    f32x4 cacc[9];
#pragma unroll
    for (int et = 0; et < 9; ++et) {
        if (L3) {
#pragma unroll
            for (int j = 0; j < 4; ++j) { const float v = mlc[(16 * et + 4 * quad + j) * 128 + 16 * w + c16]; cacc[et][j] = v; CT[(16 * et + 4 * quad + j) * 136 + 16 * w + c16] = (bf16)f2bf(v); }
        } else cacc[et] = (f32x4){0.f, 0.f, 0.f, 0.f};
    }
    float bsum = 0.f;
    __syncthreads();
#pragma unroll 1
    for (int c = 0; c < 8; ++c) {
        const int tok0 = tokbase + c * 64;
        const f32x2 gl = *(const LAS f32x2*)(GT + 2 * (c * 64 + lane)); float bsc = gl.y; const float li = gl.x;
#pragma unroll
        for (int o = 1; o < 64; o <<= 1) { const float v = __shfl_up(bsc, o); if (lane >= o) bsc += v; }
        const float bl = __shfl(bsc, 63); const float csv = li - bsc;
        if (w == 0) { CB[lane] = bsc; CB[64 + lane] = csv; }
        bsum += bl;
        const int tt_ = w & 3, eh = w >> 2; const int tq = 16 * tt_ + c16;
        v2u ogv[4];
        if (L3) {
#pragma unroll
            for (int x = 0; x < 4; ++x) ogv[x] = *(const v2u*)(proj + (size_t)(tok0 + tq) * NPROJ + C_MO + hh * 128 + 16 * (4 * eh + x) + 4 * quad); }
        { float fac[4];
#pragma unroll
          for (int i = 0; i < 4; ++i) fac[i] = __expf(bl + __shfl(csv, t0 + i));
#pragma unroll
          for (int qk = (L3 ? 0 : 1); qk < 2; ++qk) {
              float o[4][4];
              if (L3 && qk) {
#pragma unroll
                  for (int i = 0; i < 4; ++i) { o[i][0] = bflo(kcv[i].x); o[i][1] = bfhi(kcv[i].x); o[i][2] = bflo(kcv[i].y); o[i][3] = bfhi(kcv[i].y); }
              } else {
              const f32x4 bias = *(const LAS f32x4*)(CW + 4 * 256 + qk * 128 + c0);
#pragma unroll
              for (int i = 0; i < 4; ++i) { o[i][0] = bias.x; o[i][1] = bias.y; o[i][2] = bias.z; o[i][3] = bias.w; }
#pragma unroll
              for (int j = 0; j < 4; ++j) { const f32x4 wj = *(const LAS f32x4*)(CW + j * 256 + qk * 128 + c0);
#pragma unroll
                  for (int i = 0; i < 4; ++i) { const v2u rr = qk ? rk[i + j] : rq[i + j];
                      o[i][0] += wj.x * bflo(rr.x); o[i][1] += wj.y * bfhi(rr.x); o[i][2] += wj.z * bflo(rr.y); o[i][3] += wj.w * bfhi(rr.y); } }
#pragma unroll
              for (int i = 0; i < 4; ++i)
#pragma unroll
                  for (int ch = 0; ch < 4; ++ch) { const float z = o[i][ch]; o[i][ch] = z * __builtin_amdgcn_rcpf(1.0f + __expf(-z)) * (qk ? 0.08838834764831845f : 1.0f); }
              }
              if (!L3 && qk) {
#pragma unroll
                  for (int i = 0; i < 4; ++i) { v2u pw; pw.x = pk2(o[i][0], o[i][1]); pw.y = pk2(o[i][2], o[i][3]); *(v2u*)(kcb + (size_t)(tok0 + t0 + i) * 512 + hh * 128 + c0) = pw;
                      o[i][0] = bflo(pw.x); o[i][1] = bfhi(pw.x); o[i][2] = bflo(pw.y); o[i][3] = bfhi(pw.y); } }
              if (L3) { LAS bf16* dst = (qk ? Ks : Qs) + t0 * 136 + c0;
#pragma unroll
                  for (int i = 0; i < 4; ++i) { v2u pw; pw.x = pk2(o[i][0], o[i][1]); pw.y = pk2(o[i][2], o[i][3]); *(LAS v2u*)(dst + i * 136) = pw; } }
              if (qk) {
#pragma unroll
                  for (int ch = 0; ch < 4; ++ch) { v2u pw; pw.x = pk2(o[0][ch] * fac[0], o[1][ch] * fac[1]); pw.y = pk2(o[2][ch] * fac[2], o[3][ch] * fac[3]); *(LAS v2u*)(KET + (c0 + ch) * 72 + t0) = pw; } }
          }
          { v2u p0, p1, p2, p3;
            p0.x = (rv[0].x & 0xffffu) | (rv[1].x << 16); p0.y = (rv[2].x & 0xffffu) | (rv[3].x << 16);
            p1.x = (rv[0].x >> 16) | (rv[1].x & 0xffff0000u); p1.y = (rv[2].x >> 16) | (rv[3].x & 0xffff0000u);
            p2.x = (rv[0].y & 0xffffu) | (rv[1].y << 16); p2.y = (rv[2].y & 0xffffu) | (rv[3].y << 16);
            p3.x = (rv[0].y >> 16) | (rv[1].y & 0xffff0000u); p3.y = (rv[2].y >> 16) | (rv[3].y & 0xffff0000u);
            *(LAS v2u*)(VT + (c0 + 0) * 72 + t0) = p0; *(LAS v2u*)(VT + (c0 + 1) * 72 + t0) = p1; *(LAS v2u*)(VT + (c0 + 2) * 72 + t0) = p2; *(LAS v2u*)(VT + (c0 + 3) * 72 + t0) = p3; }
        }
        ML_LBAR();
        if (c < 7) { ML_LOADRAW(tok0 + 64); }
        float hval[4][4];
        if (L3) {
            bf16x8 qf[4];
#pragma unroll
            for (int ks = 0; ks < 4; ++ks) qf[ks] = *(const LAS bf16x8*)(Qs + tq * 136 + 32 * ks + 8 * quad);
            f32x4 sacc[4];
#pragma unroll
            for (int st = 0; st < 4; ++st) { f32x4 z = {0.f, 0.f, 0.f, 0.f};
#pragma unroll
                for (int ks = 0; ks < 4; ++ks) z = __builtin_amdgcn_mfma_f32_16x16x32_bf16(*(const LAS bf16x8*)(Ks + (16 * st + c16) * 136 + 32 * ks + 8 * quad), qf[ks], z, 0, 0, 0);
                sacc[st] = z; }
            const float cbt = CB[tq];
#pragma unroll
            for (int st = 0; st < 4; ++st)
#pragma unroll
                for (int j = 0; j < 4; ++j) { const int s = 16 * st + 4 * quad + j; const float d = (s <= tq) ? __expf(cbt + CB[64 + s]) : 0.f; sacc[st][j] *= d; }
            bf16x8 pf[2];
#pragma unroll
            for (int kk = 0; kk < 2; ++kk) { v4u pw; pw.x = pk2(sacc[2 * kk][0], sacc[2 * kk][1]); pw.y = pk2(sacc[2 * kk][2], sacc[2 * kk][3]); pw.z = pk2(sacc[2 * kk + 1][0], sacc[2 * kk + 1][1]); pw.w = pk2(sacc[2 * kk + 1][2], sacc[2 * kk + 1][3]); pf[kk] = __builtin_bit_cast(bf16x8, pw); }
            const float ebt = __expf(cbt);
            f32x4 nn[5];
#pragma unroll
            for (int x = 0; x < 5; ++x) { const int et = (x < 4) ? (4 * eh + x) : 8; f32x4 na = {0.f, 0.f, 0.f, 0.f}, ia = {0.f, 0.f, 0.f, 0.f};
#pragma unroll
                for (int kk = 0; kk < 2; ++kk) { const LAS bf16* vr = VT + (16 * et + c16) * 72 + 32 * kk + 4 * quad; const v2u lo = *(const LAS v2u*)vr, hi = *(const LAS v2u*)(vr + 16); v4u vw; vw.x = lo.x; vw.y = lo.y; vw.z = hi.x; vw.w = hi.y;
                    na = __builtin_amdgcn_mfma_f32_16x16x32_bf16(__builtin_bit_cast(bf16x8, vw), pf[kk], na, 0, 0, 0); }
#pragma unroll
                for (int ks = 0; ks < 4; ++ks) ia = __builtin_amdgcn_mfma_f32_16x16x32_bf16(*(const LAS bf16x8*)(CT + (16 * et + c16) * 136 + 32 * ks + 8 * quad), qf[ks], ia, 0, 0, 0);
                nn[x] = na + ia * ebt; }
            const float den = __shfl(nn[4][0], c16); const float inv = 1.0f / fmaxf(fabsf(den), 1.0f);
            float ss = 0.f;
#pragma unroll
            for (int x = 0; x < 4; ++x)
#pragma unroll
                for (int j = 0; j < 4; ++j) { hval[x][j] = nn[x][j] * inv; ss += hval[x][j] * hval[x][j]; }
            ss += __shfl_xor(ss, 16); ss += __shfl_xor(ss, 32);
            if (quad == 0) RED[eh * 64 + tq] = ss;
            ML_LBAR();
            const float rstd = __builtin_amdgcn_rsqf((RED[tq] + RED[64 + tq]) * (1.0f / 128.0f) + EPS);
#pragma unroll
            for (int x = 0; x < 4; ++x) { const int e = 16 * (4 * eh + x) + 4 * quad; const v2u og = ogv[x];
                const float y0 = hval[x][0] * rstd * NW[e] * bflo(og.x), y1 = hval[x][1] * rstd * NW[e + 1] * bfhi(og.x), y2 = hval[x][2] * rstd * NW[e + 2] * bflo(og.y), y3 = hval[x][3] * rstd * NW[e + 3] * bfhi(og.y);
                v2u o; o.x = pk2(y0, y1); o.y = pk2(y2, y3); *(v2u*)(hm + (size_t)(tok0 + tq) * 512 + hh * 128 + e) = o; }
        }
        { const float ebl = __expf(bl);
          bf16x8 kf[2];
#pragma unroll
          for (int kk = 0; kk < 2; ++kk) kf[kk] = *(const LAS bf16x8*)(KET + (16 * w + c16) * 72 + 32 * kk + 8 * quad);
#pragma unroll
          for (int et = 0; et < 9; ++et) { f32x4 z = cacc[et] * ebl;
#pragma unroll
              for (int kk = 0; kk < 2; ++kk) z = __builtin_amdgcn_mfma_f32_16x16x32_bf16(*(const LAS bf16x8*)(VT + (16 * et + c16) * 72 + 32 * kk + 8 * quad), kf[kk], z, 0, 0, 0);
              cacc[et] = z;
              if (L3) {
#pragma unroll
                  for (int j = 0; j < 4; ++j) CT[(16 * et + 4 * quad + j) * 136 + 16 * w + c16] = (bf16)f2bf(z[j]); } } }
        ML_LBAR();
    }
#undef ML_LOADRAW
#undef ML_LBAR
    if (!L3) {
#pragma unroll
        for (int et = 0; et < 9; ++et)
#pragma unroll
            for (int j = 0; j < 4; ++j) mlc[(16 * et + 4 * quad + j) * 128 + 16 * w + c16] = cacc[et][j];
        if (X.tid == 0) mlb[unit] = bsum;
    }
}
DI void mlstm_scan(const Args& a, const Ctx& X) {
    float* mlc = (float*)(a.ws + WS_MLC); const float* mlb = (const float*)(a.ws + WS_MLB);
    for (int idx = X.bid * 512 + X.tid; idx < 8 * 18432; idx += X.G * 512) { const int seq = idx / 18432, el = idx - seq * 18432; float carry = 0.f;
        float* p0 = mlc + (size_t)seq * 32 * 18432 + el; float v[32], dcy[32];
#pragma unroll
        for (int j = 0; j < 32; ++j) { v[j] = p0[(size_t)j * 18432]; dcy[j] = mlb[seq * 32 + j]; }
#pragma unroll
        for (int j = 0; j < 32; ++j) { p0[(size_t)j * 18432] = carry; carry = __expf(dcy[j]) * carry + v[j]; } }
}

constexpr int P6_WR = 0, P6_AT = 33024, P6_SH = 37120, P6_LG = 41216, P6_HIST = 65536;
DI void p6_norm_route(const Args& a, const Ctx& X, int l, const bf16* xin) {
    unsigned char* ws = a.ws;
    LAS bf16* wrb = (LAS bf16*)(X.lds + P6_WR);
    LAS float* at = (LAS float*)(X.lds + P6_AT); LAS float* sht = (LAS float*)(X.lds + P6_SH);
    LAS float* lg = (LAS float*)(X.lds + P6_LG) + X.wave * 272;
    for (int idx = X.tid; idx < 16384; idx += 512) { const int k = idx >> 4, e = idx & 15; wrb[e * 1032 + k] = (bf16)f2bf(a.router_w[idx]); }
    const float* mod = (const float*)(ws + WS_MOD); unsigned char* hb = (unsigned char*)(ws + WS_H); float* tgate = (float*)(ws + WS_TGATE); int* tokl = (int*)(ws + WS_TOKL);
    const float* ssq = (const float*)(ws + WS_SSQ);
    unsigned* cnt = (unsigned*)(ws + WS_CTL) + CW_CNT + l * 2048;
    LAS int* hist = (LAS int*)(X.lds + P6_HIST); LAS int* cbase = hist + 32;
    int lane = X.lane; asm volatile("" : "+v"(lane));
    const int r = lane & 15, q = lane >> 4;
    const int gw = X.bid * 8 + X.wave, NGW = X.G * 8;
    for (int it = 0; it * NGW < T / 16; ++it) {
        const int rg = it * NGW + gw; const bool act = rg < T / 16;
        const int row0 = (act ? rg : 0) * 16; const int bb = ((it * NGW + X.bid * 8) * 16) >> 14;
        __syncthreads();
        if (X.tid < 32) hist[X.tid] = 0;
        { const float* mb = mod + (size_t)(l * 2 + (bb < 2 ? bb : 1)) * 6144;
          for (int k = X.tid; k < 1024; k += 512) { at[k] = a.nfw[l * D + k] * (1.0f + mb[4 * 1024 + k]); sht[k] = mb[3 * 1024 + k]; } }
        __syncthreads();
        const int row = row0 + r;
        float rstd;
        { const f32x4 pp = *(const f32x4*)(ssq + (size_t)row * 16 + 4 * q); float ss = (pp.x + pp.y) + (pp.z + pp.w); ss += __shfl_xor(ss, 16); ss += __shfl_xor(ss, 32); rstd = __builtin_amdgcn_rsqf(ss * (1.0f / D) + EPS); }
        const bf16* xr = xin + (size_t)row * D + 8 * q; unsigned char* hr = hb + (size_t)row * D + 8 * q;
        f32x4 acc = {0.f, 0.f, 0.f, 0.f};
#pragma unroll 8
        for (int s = 0; s < 32; ++s) {
            const v4u xw = *(const v4u*)(xr + 32 * s); const f32x4 x0 = {bflo(xw.x), bfhi(xw.x), bflo(xw.y), bfhi(xw.y)}, x1 = {bflo(xw.z), bfhi(xw.z), bflo(xw.w), bfhi(xw.w)};
            const f32x4 a0 = *(const LAS f32x4*)(at + 32 * s + 8 * q), a1 = *(const LAS f32x4*)(at + 32 * s + 8 * q + 4);
            const f32x4 s0 = *(const LAS f32x4*)(sht + 32 * s + 8 * q), s1 = *(const LAS f32x4*)(sht + 32 * s + 8 * q + 4);
            const f32x4 h0 = x0 * rstd * a0 + s0, h1 = x1 * rstd * a1 + s1;
            v4u w; w.x = cvt_pk_bf16(h0.x, h0.y); w.y = cvt_pk_bf16(h0.z, h0.w); w.z = cvt_pk_bf16(h1.x, h1.y); w.w = cvt_pk_bf16(h1.z, h1.w);
            { v2u w8; w8.x = pk4_fp8(h0.x, h0.y, h0.z, h0.w); w8.y = pk4_fp8(h1.x, h1.y, h1.z, h1.w); *(v2u*)(hr + 32 * s) = w8; }
            const bf16x8 bfr = *(const LAS bf16x8*)(wrb + r * 1032 + 32 * s + 8 * q);
            acc = __builtin_amdgcn_mfma_f32_16x16x32_bf16(__builtin_bit_cast(bf16x8, w), bfr, acc, 0, 0, 0);
        }
#pragma unroll
        for (int j = 0; j < 4; ++j) lg[(4 * q + j) * 17 + r] = acc[j];
        LDS_WAIT(); asm volatile("" ::: "memory");
        int my_cls = 0; float my_ga = 0.f, my_gb = 0.f;
        if (lane < 16) {
            float sc[16], sel[16];
#pragma unroll
            for (int e = 0; e < 16; ++e) { const float p = lg[lane * 17 + e]; sc[e] = 1.0f / (1.0f + __expf(-p)); sel[e] = sc[e] + a.router_b[e]; }
            int gi = 0; float gbest = -1.0e30f;
#pragma unroll
            for (int g = 0; g < 4; ++g) { const float p0 = sel[4 * g], p1 = sel[4 * g + 1], p2 = sel[4 * g + 2], p3 = sel[4 * g + 3];
                const float gs = fmaxf(fmaxf(fmaxf(p0 + p1, p0 + p2), fmaxf(p0 + p3, p1 + p2)), fmaxf(p1 + p3, p2 + p3));
                if (gs > gbest) { gbest = gs; gi = g; } }
            float qs[4], s4[4];
#pragma unroll
            for (int i = 0; i < 4; ++i) { qs[i] = 0.f; s4[i] = 0.f; }
#pragma unroll
            for (int g = 0; g < 4; ++g) if (g == gi) {
#pragma unroll
                for (int i = 0; i < 4; ++i) { qs[i] = sel[4 * g + i]; s4[i] = sc[4 * g + i]; } }
            int i1 = 0; float b1 = qs[0];
#pragma unroll
            for (int i = 1; i < 4; ++i) if (qs[i] > b1) { b1 = qs[i]; i1 = i; }
            int i2 = -1; float b2 = -1.0e30f;
#pragma unroll
            for (int i = 0; i < 4; ++i) if (i != i1 && qs[i] > b2) { b2 = qs[i]; i2 = i; }
            const int ia = (i1 < i2) ? i1 : i2, ib = (i1 < i2) ? i2 : i1;
            float sa = 0.f, sb = 0.f;
#pragma unroll
            for (int i = 0; i < 4; ++i) { if (i == ia) sa = s4[i]; if (i == ib) sb = s4[i]; }
            const int pidx = (ia == 0) ? (ib - 1) : ((ia == 1) ? (ib + 1) : 5);
            const float inv = 1.0f / (sa + sb);
            my_cls = gi * 6 + pidx; my_ga = sa * inv; my_gb = sb * inv;
        }
        int rank = 0;
        if (act && lane < 16) rank = __hip_atomic_fetch_add(hist + my_cls, 1, __ATOMIC_RELAXED, __HIP_MEMORY_SCOPE_WORKGROUP);
        __syncthreads();
        if (X.tid < NCLS) { const int n = hist[X.tid]; cbase[X.tid] = n ? (int)__hip_atomic_fetch_add(cnt + 64 * X.tid, (unsigned)n, RLX_AGENT) : 0; }
        __syncthreads();
        if (act && lane < 16) { const int tok = row0 + lane; const int pos = cbase[my_cls] + rank;
            tokl[my_cls * CLS_CAP + pos] = tok; tgate[tok * 2] = my_ga; tgate[tok * 2 + 1] = my_gb; }
    }
}
DI MoeTab moe_tables(const Args& a, const Ctx& X, int l) {
    LAS int* tab = (LAS int*)(X.lds + TAB_OFF); LAS int* tcls = tab; LAS int* tpos = tab + 160; LAS int* cn = tab + 320; LAS int* rt_ = tab + 344;
    unsigned* cnt = (unsigned*)(a.ws + WS_CTL) + CW_CNT + l * 2048;
    if (X.tid < NCLS) cn[X.tid] = (int)__hip_atomic_load(cnt + 64 * X.tid, RLX_AGENT);
    __syncthreads();
    if (X.tid == 0) { int r = 0;
#pragma unroll 1
        for (int c = 0; c < NCLS; ++c) { const int n = (cn[c] + 255) >> 8;
#pragma unroll 1
            for (int i = 0; i < n; ++i) { tcls[r] = c; tpos[r] = i * 256; ++r; } }
        rt_[0] = r; }
    __syncthreads();
    MoeTab tb; tb.tcls = tcls; tb.tpos = tpos; tb.cnt = cn; tb.Rtot = __builtin_amdgcn_readfirstlane(rt_[0]); return tb;
}

#if defined(__HIP_DEVICE_COMPILE__)
DI Args load_args() { auto p = __builtin_amdgcn_kernarg_segment_ptr(); asm volatile("" : "+s"(p)); return *(const __attribute__((address_space(4))) Args*)p; }
#else
DI Args load_args() { return Args{}; }
#endif
__global__ void __launch_bounds__(512, 2) fwd(Args a_unused) {
    extern __shared__ __attribute__((aligned(16))) unsigned char lds_raw[];
    Ctx X; X.lds = (LAS unsigned char*)lds_raw; X.tid = threadIdx.x; X.lane = X.tid & 63; X.wave = __builtin_amdgcn_readfirstlane(X.tid >> 6); X.G = gridDim.x; X.bid = blockIdx.x;
    volatile LAS unsigned* MISC = (volatile LAS unsigned*)(X.lds + MISC_OFF);
    if (X.tid < 64) MISC[X.tid] = 0u;
    __syncthreads();
    int lo, hi; unsigned* ctl;
    { const Args a = load_args(); lo = a.ph_lo; hi = a.ph_hi; ctl = (unsigned*)(a.ws + WS_CTL); }
    XcdBarrier bar; bar.bar = ctl + CW_BAR; bar.x = 0; bar.st = MISC + 8;
    if (hi - lo > 1) bar = xcd_barrier_post(ctl + CW_BAR, MISC + 8);
#ifndef PH_MASK
#define PH_MASK 0xFFFFF
#endif
#define PON(p) ((PH_MASK >> (p)) & 1)
#ifndef DUP_MASK
#define DUP_MASK 0
#endif
#define NREP(p) (((DUP_MASK >> (p)) & 1) ? 2 : 1)
#ifndef TSEL_MASK
#define TSEL_MASK 0
#endif
#define TSCALE 4
#define TSEL(p) ((TSEL_MASK >> (p)) & 1)
#define IN(k) (lo <= (k) && (k) < hi)
#define SEAM(k) do { if (IN(k) && IN((k) + 1)) xcd_barrier(bar); } while (0)
    unsigned long long tacc = 0ull, tph = 0ull;
#define TBEG() do { if (TSEL_MASK) tph = __builtin_amdgcn_s_memrealtime(); } while (0)
#define TEND(p) do { if (TSEL(p)) tacc += __builtin_amdgcn_s_memrealtime() - tph; } while (0)
    TBEG();
    if (PON(10) && IN(0)) { for (int rep = 0; rep < NREP(10); ++rep) { const Args a = load_args(); p0_prologue(a, X); } }
    SEAM(0); TEND(10);
    TBEG();
    for (int l = 0; l < NL; ++l) {
        const int g0 = 1 + l * NPH;
        if (PON(0) && IN(g0 + 0)) { for (int rep = 0; rep < NREP(0); ++rep) { const Args a = load_args(); unsigned char* ws = a.ws; const float* mod = (const float*)(ws + WS_MOD); bf16* proj = (bf16*)(ws + WS_PROJ); bf16* xb = (bf16*)(ws + WS_XB); (void)mod; (void)proj; (void)xb; const Ctx P = fresh(X); p1_norm_gates(a, P, l, xb); } }
        SEAM(g0 + 0); TEND(0); TBEG();
        if (PON(1) && IN(g0 + 1)) for (int rep = 0; rep < NREP(1); ++rep) { const Args a = load_args(); unsigned char* ws = a.ws; const float* mod = (const float*)(ws + WS_MOD); bf16* proj = (bf16*)(ws + WS_PROJ); bf16* xb = (bf16*)(ws + WS_XB); (void)mod; (void)proj; (void)xb; const Ctx P = fresh(X);
            DenseSched S; S.A = (const char*)(ws + WS_H); S.Bt = (const char*)(ws + WS_WIN) + (size_t)l * NPROJW * D; S.lda = D; S.ldb = D; S.ord.init(T / 256, NPROJW / 256, P.G, P.bid);
            EpiProj E; E.O = proj; E.gates = (float*)(ws + WS_GATES); E.big = a.b_ig + l * 4; E.bfg = a.b_fg + l * 4;
            pg8::gemm_phase<EpiProj, DenseSched, true>(P.lds, D, S, E);
        }
        SEAM(g0 + 1); TEND(1); TBEG();
        if (PON(2) && IN(g0 + 2)) { const Args a = load_args(); unsigned char* ws = a.ws; const float* mod = (const float*)(ws + WS_MOD); bf16* proj = (bf16*)(ws + WS_PROJ); bf16* xb = (bf16*)(ws + WS_XB); (void)mod; (void)proj; (void)xb; const Ctx P = fresh(X);
            if (PON(11)) for (int rep = 0; rep < NREP(11); ++rep) {
#pragma unroll 1
                for (int u = P.bid; u < 512; u += P.G) attn_unit(a, P, l, u); }
            if (PON(12)) for (int rep = 0; rep < NREP(12); ++rep) {
#pragma unroll 1
                for (int u = P.bid; u < 256; u += P.G) mlstm_unit<false>(a, P, l, u); }
        }
        SEAM(g0 + 2); TEND(2); TBEG();
        if (PON(3) && IN(g0 + 3)) { const Args a = load_args(); unsigned char* ws = a.ws; const float* mod = (const float*)(ws + WS_MOD); bf16* proj = (bf16*)(ws + WS_PROJ); bf16* xb = (bf16*)(ws + WS_XB); (void)mod; (void)proj; (void)xb; const Ctx P = fresh(X); mlstm_scan(a, P); }
        SEAM(g0 + 3); TEND(3); TBEG();
        if (PON(4) && IN(g0 + 4)) for (int rep = 0; rep < NREP(4); ++rep) { const Args a = load_args(); unsigned char* ws = a.ws; const float* mod = (const float*)(ws + WS_MOD); bf16* proj = (bf16*)(ws + WS_PROJ); bf16* xb = (bf16*)(ws + WS_XB); (void)mod; (void)proj; (void)xb; const Ctx P = fresh(X);
#pragma unroll 1
            for (int u = P.bid; u < 256; u += P.G) mlstm_unit<true>(a, P, l, u); }
        SEAM(g0 + 4); TEND(4); TBEG();
        if (PON(5) && IN(g0 + 5)) for (int rep = 0; rep < NREP(5); ++rep) { const Args a = load_args(); unsigned char* ws = a.ws; const float* mod = (const float*)(ws + WS_MOD); bf16* proj = (bf16*)(ws + WS_PROJ); bf16* xb = (bf16*)(ws + WS_XB); (void)mod; (void)proj; (void)xb; const Ctx P = fresh(X);
            MergeSched S; S.A0 = (const char*)(ws + WS_H); S.A1 = (const char*)(ws + WS_H) + (size_t)T * 512 * 2; S.B0 = (const char*)(ws + WS_WAU) + (size_t)l * D * 512 * 2; S.B1 = (const char*)(ws + WS_WMU) + (size_t)l * D * 512 * 2;
            S.lda = 1024; S.ldb = 1024; S.ord.init(T / 256, D / 256, P.G, P.bid);
            EpiMerge E; E.P = proj; pg8::gemm_phase<EpiMerge, MergeSched>(P.lds, 2048, S, E);
        }
        SEAM(g0 + 5); TEND(5); TBEG();
        if (PON(6) && IN(g0 + 6)) for (int rep = 0; rep < NREP(6); ++rep) { const Args a = load_args(); unsigned char* ws = a.ws; const float* mod = (const float*)(ws + WS_MOD); bf16* proj = (bf16*)(ws + WS_PROJ); bf16* xb = (bf16*)(ws + WS_XB); (void)mod; (void)proj; (void)xb; const Ctx P = fresh(X);
            DenseSched S; S.A = (const char*)(proj + C_MQ); S.Bt = (const char*)(ws + WS_WOUT) + (size_t)l * D * D * 2; S.lda = NPROJ * 2; S.ldb = D * 2; S.ord.init(T / 256, D / 256, P.G, P.bid);
            EpiRes E; E.xin = xb; E.out = xb; E.g = mod + (size_t)(l * 2) * 6144 + 2 * 1024; E.ssq = (float*)(ws + WS_SSQ); E.rmask = T - 1;
            if (rep) { E.out = (bf16*)(ws + WS_H); E.rmask = T / 2 - 1; }
            pg8::gemm_phase<EpiRes, DenseSched>(P.lds, D * 2, S, E);
        }
        SEAM(g0 + 6); TEND(6); TBEG();
        if (PON(7) && IN(g0 + 7)) { const Args a = load_args(); unsigned char* ws = a.ws; const float* mod = (const float*)(ws + WS_MOD); bf16* proj = (bf16*)(ws + WS_PROJ); bf16* xb = (bf16*)(ws + WS_XB); (void)mod; (void)proj; (void)xb; const Ctx P = fresh(X); p6_norm_route(a, P, l, xb); }
        SEAM(g0 + 7); TEND(7); TBEG();
        if (PON(8) && IN(g0 + 8)) for (int rep = 0; rep < NREP(8); ++rep) { const Args a = load_args(); unsigned char* ws = a.ws; const float* mod = (const float*)(ws + WS_MOD); bf16* proj = (bf16*)(ws + WS_PROJ); bf16* xb = (bf16*)(ws + WS_XB); (void)mod; (void)proj; (void)xb; const Ctx P = fresh(X);
            const MoeTab tb = moe_tables(a, P, l);
            LAS unsigned* tokoff = (LAS unsigned*)(P.lds + TOKOFF_OFF); const int* tokl = (const int*)(ws + WS_TOKL);
#pragma unroll 1
            for (int s = 0; s < 8; ++s) { const int L0 = s * P.G + P.bid;
                if (L0 < tb.Rtot * 8 && P.tid < 256) { const int L = xcd_remap(L0, tb.Rtot * 8); const int rt = L >> 3, cls = tb.tcls[rt], pos = tb.tpos[rt] + P.tid, cn = tb.cnt[cls]; const int tok = tokl[cls * CLS_CAP + (pos < cn ? pos : 0)]; tokoff[s * 256 + P.tid] = (unsigned)tok; } }
            __syncthreads();
            MoeUpSched S; S.A = (const char*)(ws + WS_H); S.W = (const char*)(ws + WS_WGU) + (size_t)l * NE * 1024 * D; S.lda = D; S.ldb = D; S.tb = tb; S.G = P.G; S.c = P.bid; S.tokoff = tokoff;
            EpiSwiglu E; E.H = proj; E.tgate = (const float*)(ws + WS_TGATE); E.tokoff = tokoff;
            pg8::gemm_phase<EpiSwiglu, MoeUpSched, true>(P.lds, D, S, E);
        }
        SEAM(g0 + 8); TEND(8); TBEG();
        if (PON(9) && IN(g0 + 9)) for (int rep = 0; rep < NREP(9); ++rep) { const Args a = load_args(); unsigned char* ws = a.ws; const float* mod = (const float*)(ws + WS_MOD); bf16* proj = (bf16*)(ws + WS_PROJ); bf16* xb = (bf16*)(ws + WS_XB); (void)mod; (void)proj; (void)xb; const Ctx P = fresh(X);
            const MoeTab tb = moe_tables(a, P, l);
            MoeDownSched S; S.A = (const char*)proj; S.W = (const char*)(ws + WS_WD) + (size_t)l * NE * 1024 * FF * 2; S.lda = D * 2; S.ldb = FF * 2; S.tb = tb; S.G = P.G; S.c = P.bid;
            EpiMoeOut E; E.xin = xb; E.outb = xb; E.outf = a.out; E.last = (l == NL - 1); E.g = mod + (size_t)(l * 2) * 6144 + 5 * 1024; E.tokl = (const int*)(ws + WS_TOKL); E.tb = tb; E.rmask = T - 1;
            if (rep) { E.outb = (bf16*)(ws + WS_H); E.last = 0; E.rmask = T / 2 - 1; }
            pg8::gemm_phase<EpiMoeOut, MoeDownSched>(P.lds, D * 2, S, E);
        }
        SEAM(g0 + 9); TEND(9); TBEG();
    }
    if (TSEL_MASK && X.bid == 0) { const unsigned long long t1 = __builtin_amdgcn_s_memrealtime(); while (__builtin_amdgcn_s_memrealtime() - t1 < TSCALE * tacc) __builtin_amdgcn_s_sleep(8); }
#undef IN
#undef SEAM
}

extern "C" void kernel_launch(void* const* d_in, const int* in_sizes, int n_in, void* d_out, int out_size, void* d_ws, size_t ws_size, hipStream_t stream) {
    static int grid = 0;
    if (grid == 0) {
        if (n_in != 24 || in_sizes[0] != T * D || out_size != T * D || ws_size < WS_END) { fprintf(stderr, "kernel_launch: unexpected shapes / workspace (n_in %d, ws %zu, need %zu)\n", n_in, ws_size, (size_t)WS_END); grid = -1; return; }
        int dev = 0, cus = 0;
        if (hipGetDevice(&dev) != hipSuccess || hipDeviceGetAttribute(&cus, hipDeviceAttributeMultiprocessorCount, dev) != hipSuccess) { grid = -1; return; }
        if (hipFuncSetAttribute((const void*)fwd, hipFuncAttributeMaxDynamicSharedMemorySize, LDS_BYTES) != hipSuccess) { fprintf(stderr, "kernel_launch: hipFuncSetAttribute failed\n"); grid = -1; return; }
        int per_cu = 0;
        if (hipOccupancyMaxActiveBlocksPerMultiprocessor(&per_cu, (const void*)fwd, 512, LDS_BYTES) != hipSuccess || per_cu < 1) fprintf(stderr, "kernel_launch: occupancy query reports %d\n", per_cu);
        (void)hipGetLastError();
        grid = cus < 256 ? cus : 256;
    }
    if (grid < 0) return;
    (void)hipMemsetAsync((char*)d_ws + WS_CTL, 0, CTL_ZERO_BYTES, stream);
    Args a{};
    a.x = (const float*)d_in[0]; a.c = (const float*)d_in[1]; a.pos = (const int*)d_in[2]; a.ada_w = (const float*)d_in[3]; a.ada_b = (const float*)d_in[4];
    a.nmw = (const float*)d_in[5]; a.nfw = (const float*)d_in[6]; a.w_in = (const float*)d_in[7]; a.b_ig = (const float*)d_in[8]; a.b_fg = (const float*)d_in[9];
    a.qnw = (const float*)d_in[10]; a.knw = (const float*)d_in[11]; a.sinks = (const float*)d_in[12]; a.conv_w = (const float*)d_in[13]; a.conv_b = (const float*)d_in[14];
    a.mnw = (const float*)d_in[15]; a.w_au = (const float*)d_in[16]; a.w_mu = (const float*)d_in[17]; a.w_out = (const float*)d_in[18]; a.router_w = (const float*)d_in[19];
    a.router_b = (const float*)d_in[20]; a.w_gate = (const float*)d_in[21]; a.w_up = (const float*)d_in[22]; a.w_down = (const float*)d_in[23];
    a.out = (float*)d_out; a.ws = (unsigned char*)d_ws;
#if MK_MULTI
    for (int gp = 0; gp < NGP; ++gp) { a.ph_lo = gp; a.ph_hi = gp + 1; hipLaunchKernelGGL(fwd, dim3(grid), dim3(512), LDS_BYTES, stream, a); }
#else
    a.ph_lo = 0; a.ph_hi = NGP; hipLaunchKernelGGL(fwd, dim3(grid), dim3(512), LDS_BYTES, stream, a);
#endif
}
```

```cpp
#include <hip/hip_runtime.h>
#include <cstdio>
#include <cstdint>

#ifndef MK_MULTI
#define MK_MULTI 0
#endif

#define GAS __attribute__((address_space(1)))
#define LAS __attribute__((address_space(3)))
typedef unsigned short bf16;
typedef unsigned v4u __attribute__((ext_vector_type(4)));
typedef unsigned v2u __attribute__((ext_vector_type(2)));
typedef float f32x4 __attribute__((ext_vector_type(4)));
typedef float f32x2 __attribute__((ext_vector_type(2)));
typedef short bf16x8 __attribute__((ext_vector_type(8)));
typedef short bf16x4 __attribute__((ext_vector_type(4)));
#define DI __device__ __forceinline__
#define RLX_AGENT __ATOMIC_RELAXED, __HIP_MEMORY_SCOPE_AGENT
#define LDS_WAIT() asm volatile("s_waitcnt lgkmcnt(0)" ::: "memory")
#define VM_WAIT() asm volatile("s_waitcnt vmcnt(0)" ::: "memory")

constexpr int NB = 2, SEQ = 16384, T = NB * SEQ, D = 1024, NL = 4;
constexpr int DIN_SRC = 4872;
constexpr int NPROJ = 4864;
constexpr int C_AQ = 0, C_AK = 512, C_AV = 640, C_MQ = 768, C_MK = 1280, C_MV = 1792, C_MO = 2304, C_GA = 2816, C_GB = 3840;
constexpr int NE = 16, FF = 512;
constexpr int NCLS = 24, CLS_CAP = 32768;
constexpr float EPS = 1e-6f;
constexpr int NPH = 10;
constexpr int NGP = 1 + NL * NPH;

constexpr size_t MiB = 1u << 20;
constexpr size_t WS_CTL = 0, CTL_ZERO_BYTES = 1 * MiB;
constexpr size_t WS_MOD = 1 * MiB;
constexpr size_t WS_ROPE = 2 * MiB;
constexpr size_t WS_GATES = 4 * MiB;
constexpr size_t WS_TGATE = 5 * MiB;
constexpr size_t WS_TOKL = 6 * MiB;
constexpr size_t WS_MLB = 9 * MiB;
constexpr size_t WS_MLC = 10 * MiB;
constexpr int NPROJW = 5120;
constexpr size_t WS_WIN = 28 * MiB;
constexpr size_t WS_WAU = 68 * MiB;
constexpr size_t WS_WMU = 72 * MiB;
constexpr size_t WS_WOUT = 76 * MiB;
constexpr size_t WS_WGU = 84 * MiB;
constexpr size_t WS_WD = 148 * MiB;
constexpr size_t WS_H = 212 * MiB;
constexpr size_t WS_PROJ = 276 * MiB;
constexpr size_t WS_SSQ = 580 * MiB;
constexpr size_t WS_KC = 582 * MiB;
constexpr size_t WS_XB = 614 * MiB;
constexpr size_t WS_END = 678 * MiB;

constexpr int CW_TMO = 0;
constexpr int CW_BAR = 4096;
constexpr int CW_CNT = 8192;

constexpr int RING_BYTES = 131072;
constexpr int MISC_OFF = RING_BYTES;
constexpr int TAB_OFF = RING_BYTES + 256;
constexpr int TOKOFF_OFF = RING_BYTES + 2048;
constexpr int LDS_BYTES = 147456;

DI unsigned f2bf(float f) { unsigned u = __builtin_bit_cast(unsigned, f); return (u + 0x7fffu + ((u >> 16) & 1u)) >> 16; }
DI unsigned pk2(float lo, float hi) { return f2bf(lo) | (f2bf(hi) << 16); }
DI float bf2f(unsigned short b) { return __builtin_bit_cast(float, ((unsigned)b) << 16); }
DI float bflo(unsigned w) { return __builtin_bit_cast(float, w << 16); }
DI float bfhi(unsigned w) { return __builtin_bit_cast(float, w & 0xffff0000u); }
DI float wave_sum(float v) {
#pragma unroll
    for (int o = 1; o < 64; o <<= 1) v += __shfl_xor(v, o);
    return v;
}
DI float sigmoidf_(float x) { return __builtin_amdgcn_rcpf(1.0f + __expf(-x)); }

#define XB_TMO      128
#define XB_XCNT(j)  (256  + 64 * (j))
#define XB_XSUB(j)  (1280 + 64 * (j))
#define XB_XGEN(j)  (2304 + 64 * (j))
#define XB_TOP      3328
#define XB_TOPGEN   3392
#define XCD_BAR_WORDS 3456
#define XB_SPIN_CAP (1u << 18)
__device__ __forceinline__ unsigned xb_ld(unsigned* p)              { return __hip_atomic_load(p, __ATOMIC_RELAXED, __HIP_MEMORY_SCOPE_AGENT); }
__device__ __forceinline__ unsigned xb_add(unsigned* p, unsigned v) { return __hip_atomic_fetch_add(p, v, __ATOMIC_RELAXED, __HIP_MEMORY_SCOPE_AGENT); }
__device__ __forceinline__ unsigned xb_xcc_id() { return (unsigned)__builtin_amdgcn_s_getreg((3 << 11) | 20) & 0xFu; }
#define XB_SPIN(cond, bar) do { unsigned _sp = 0; while (cond) { __builtin_amdgcn_s_sleep(1); \
    if ((++_sp & 255u) == 0u) { if (xb_ld(&(bar)[XB_TMO])) break; if (_sp > XB_SPIN_CAP) { atomicAdd(&(bar)[XB_TMO], 1u); break; } } } } while (0)
struct XcdBarrier { unsigned* bar; unsigned x; volatile LAS unsigned* st; };
__device__ __forceinline__ XcdBarrier xcd_barrier_post(unsigned* bar, volatile LAS unsigned* st) {
    XcdBarrier b; b.bar = bar; b.x = xb_xcc_id(); b.st = st;
    if (threadIdx.x == 0) (void)xb_add(&bar[XB_XCNT(b.x)], 1u);
    return b;
}
__device__ __forceinline__ void xcd_barrier_complete(unsigned* bar, unsigned x, unsigned& nloc, unsigned& nx) {
    const unsigned G = gridDim.x * gridDim.y * gridDim.z;
    unsigned sum, cnt, mine, sp = 0u;
    for (;;) {
        sum = 0u; cnt = 0u; mine = 0u;
#pragma unroll
        for (unsigned j = 0; j < 16; ++j) { const unsigned c = xb_ld(&bar[XB_XCNT(j)]); sum += c; cnt += (c > 0u) ? 1u : 0u; mine = (j == x) ? c : mine; }
        if (sum == G) break;
        __builtin_amdgcn_s_sleep(1);
        if ((++sp & 255u) == 0u) { if (xb_ld(&bar[XB_TMO])) break; if (sp > XB_SPIN_CAP) { atomicAdd(&bar[XB_TMO], 1u); break; } }
    }
    nloc = mine > 0u ? mine : 1u; nx = cnt > 0u ? cnt : 1u;
}
__device__ __forceinline__ void xcd_barrier(const XcdBarrier& b) {
    asm volatile("s_waitcnt vmcnt(0)" ::: "memory");
    __syncthreads();
    if (threadIdx.x == 0) {
        unsigned* bar = b.bar;
        __builtin_amdgcn_s_waitcnt(0);
        unsigned nloc = b.st[0], nx = b.st[1];
        if (nloc == 0u) { xcd_barrier_complete(bar, b.x, nloc, nx); b.st[0] = nloc; b.st[1] = nx; }
        const unsigned old = xb_add(&bar[XB_XSUB(b.x)], 1u);
        const unsigned gen = old / nloc;
        if (old + 1u == (gen + 1u) * nloc) {
            __builtin_amdgcn_fence(__ATOMIC_RELEASE, "agent");
            asm volatile("s_waitcnt vmcnt(0)" ::: "memory");
            const unsigned og = xb_add(&bar[XB_TOP], 1u);
            const unsigned tg = og / nx;
            if (og + 1u == (tg + 1u) * nx) xb_add(&bar[XB_TOPGEN], 1u);
            else XB_SPIN(xb_ld(&bar[XB_TOPGEN]) == tg, bar);
            __builtin_amdgcn_fence(__ATOMIC_ACQUIRE, "agent");
            xb_add(&bar[XB_XGEN(b.x)], 1u);
            asm volatile("s_waitcnt vmcnt(0)" ::: "memory");
        } else {
            XB_SPIN(xb_ld(&bar[XB_XGEN(b.x)]) == gen, bar);
            __builtin_amdgcn_fence(__ATOMIC_ACQUIRE, "agent");
            asm volatile("s_waitcnt vmcnt(0)" ::: "memory");
        }
    }
    __syncthreads();
}

namespace pg8 {
constexpr int BM = 256, BK = 64, HALF = 128, HTB = HALF * BK * 2, STAGE_BYTES = 8 * HTB, NXCD = 8, WGM = 8;
__host__ __device__ __forceinline__ int lds_byte(int r, int c) { const int st = (r >> 4) * 2 + (c >> 5), rr = r & 15, cc = c & 31, ob = rr * 64 + cc * 2; return st * 1024 + (ob ^ (((ob >> 9) & 1) << 5)); }
__host__ __device__ __forceinline__ void stage_rc(int b, int& R, int& C) { const int st = b / 1024, sb = b % 1024, swz = sb ^ (((sb >> 9) & 1) << 5); R = (st >> 1) * 16 + swz / 64; C = (st & 1) * 32 + (swz % 64) / 2; }
__host__ __device__ __forceinline__ int perm32(int rho) { const int n = rho >> 4, i = rho & 15; return 8 * (i >> 2) + 4 * n + (i & 3); }

struct Unit { int pm, pn, x0, x1; };

struct TileOrder {
    int nM, nN, nwg, G, c;
    __device__ void init(int nM_, int nN_, int G_, int c_) { nM = nM_; nN = nN_; nwg = nM * nN; G = G_; c = c_; }
    __device__ bool get(int i, int& pm, int& pn) const {
        const long L = (long)i * G + c; if (L >= nwg) return false;
        int wgid = (int)L; { const int q = nwg / NXCD, r = nwg % NXCD, xcd = wgid % NXCD, off = wgid / NXCD; wgid = (xcd < r ? xcd * (q + 1) : r * (q + 1) + (xcd - r) * q) + off; }
        const int nig = WGM * nN, gid = wgid / nig, fm = gid * WGM, gsz = (nM - fm) < WGM ? (nM - fm) : WGM;
        pm = fm + ((wgid % nig) % gsz); pn = (wgid % nig) / gsz; return true;
    }
};

typedef int v8i __attribute__((ext_vector_type(8)));
template <class Epi, class Sched, bool F8 = false>
__device__ __forceinline__ void gemm_phase(LAS unsigned char* lds, const int Kb, const Sched& S, const Epi& E) {
    int tid = threadIdx.x; asm volatile("" : "+v"(tid));
    const int wid = __builtin_amdgcn_readfirstlane(tid >> 6), lane = tid & 63, wr = wid >> 2, wc = wid & 3, fr = lane & 15, fq = lane >> 4;
    const int nt = Kb / 128;
    constexpr bool GA = Sched::GATHER; constexpr int KS = Sched::KSPLIT; constexpr bool ASPLIT = Sched::ASPLIT;
    unsigned voffA[2], voffB[2]; int Rst[2], Cst[2];
#pragma unroll
    for (int i = 0; i < 2; ++i) { int R, C; stage_rc(tid * 16 + i * 8192, R, C); const int Rb = Epi::PERM ? ((R & ~31) + perm32(R & 31)) : R;
        voffA[i] = (unsigned)(R * S.lda + C * 2); voffB[i] = (unsigned)(Rb * S.ldb + C * 2); Rst[i] = R; Cst[i] = C; }
    const size_t kstep = (size_t)(BK * 2);
    const size_t hstepA = (size_t)HALF * S.lda, hstepB = (size_t)HALF * S.ldb;
    const unsigned ldsw = (unsigned)wid * 1024u; const unsigned gmul = (unsigned)S.lda;
    const int aoff = F8 ? (lds_byte(wr * 64 + fr, (fq & 1) * 16) + (fq >> 1) * 1024) : lds_byte(wr * 64 + fr, fq * 8);
    const int boff = F8 ? (lds_byte(wc * 32 + fr, (fq & 1) * 16) + (fq >> 1) * 1024) : lds_byte(wc * 32 + fr, fq * 8);
    unsigned vAc[2], vAn[2];
#define PG8_SA(b, h) (((b) * 2 + (h)) * HTB)
#define PG8_SB(b, h) ((4 + (b) * 2 + (h)) * HTB)
#define PG8_STAGE2(bufoff, gbase, v0, v1) do { \
        __builtin_amdgcn_global_load_lds((const unsigned*)((const char*)(gbase) + (v0)), (LAS unsigned*)(lds + (bufoff) + ldsw), 16, 0, 0); \
        __builtin_amdgcn_global_load_lds((const unsigned*)((const char*)(gbase) + (v1)), (LAS unsigned*)(lds + (bufoff) + ldsw + 8192), 16, 0, 0); } while (0)
#define PG8_STAGE_B(bufoff, ptr, h) PG8_STAGE2(bufoff, (ptr) + (h) * hstepB, voffB[0], voffB[1])
#define PG8_STAGE_A(bufoff, ptr, h, nx) do { if constexpr (GA) { const unsigned _p = (nx) ? vAn[h] : vAc[h]; PG8_STAGE2(bufoff, ptr, (_p & 0xffffu) * gmul + (unsigned)Cst[0] * 2u, (_p >> 16) * gmul + (unsigned)Cst[0] * 2u); } \
        else { PG8_STAGE2(bufoff, (ptr) + (h) * hstepA, voffA[0], voffA[1]); } } while (0)
    typedef int v4i_ __attribute__((ext_vector_type(4)));
#define PG8_LDA(dst, b, h) do { _Pragma("unroll") for (int m = 0; m < 4; ++m) { if constexpr (F8) { dst##8[m].lo = *(const LAS v4i_*)(lds + PG8_SA(b, h) + aoff + m * 2048); dst##8[m].hi = *(const LAS v4i_*)(lds + PG8_SA(b, h) + aoff + m * 2048 + 16); } \
        else { _Pragma("unroll") for (int k = 0; k < 2; ++k) dst[m][k] = *(const LAS bf16x8*)(lds + PG8_SA(b, h) + aoff + m * 2048 + k * 1024); } } } while (0)
#define PG8_LDB(dst, b, h) do { _Pragma("unroll") for (int n = 0; n < 2; ++n) { if constexpr (F8) { dst##8[n].lo = *(const LAS v4i_*)(lds + PG8_SB(b, h) + boff + n * 2048); dst##8[n].hi = *(const LAS v4i_*)(lds + PG8_SB(b, h) + boff + n * 2048 + 16); } \
        else { _Pragma("unroll") for (int k = 0; k < 2; ++k) dst[n][k] = *(const LAS bf16x8*)(lds + PG8_SB(b, h) + boff + n * 2048 + k * 1024); } } } while (0)
#define PG8_MMA(ai, bj, At, Bt) do { __builtin_amdgcn_s_setprio(1); _Pragma("unroll") for (int m = 0; m < 4; ++m) _Pragma("unroll") for (int n = 0; n < 2; ++n) { \
        if constexpr (F8) { asm volatile("v_mfma_scale_f32_16x16x128_f8f6f4 %0, %1, %2, %0, %3, %3 op_sel_hi:[0,0,0]" : "+v"(acc[ai][bj][m][n]) : "v"(Bt##8[n]), "v"(At##8[m]), "v"(f8scale)); } \
        else { _Pragma("unroll") for (int k = 0; k < 2; ++k) acc[ai][bj][m][n] = __builtin_amdgcn_mfma_f32_16x16x32_bf16(Bt[n][k], At[m][k], acc[ai][bj][m][n], 0, 0, 0); } } \
        __builtin_amdgcn_s_setprio(0); } while (0)
#define PG8_WAIT_V(n) asm volatile("s_waitcnt vmcnt(" #n ")" ::: "memory")
#define PG8_WAIT_L(n) asm volatile("s_waitcnt lgkmcnt(" #n ")" ::: "memory")
#define PG8_BAR __builtin_amdgcn_s_barrier()
#define PG8_SCHED __builtin_amdgcn_sched_barrier(0)
#define PG8_GOFF(dst, u) do { if constexpr (GA) { _Pragma("unroll") for (int h = 0; h < 2; ++h) dst[h] = S.a_rowoff(u, Rst[0] + HALF * h) | (S.a_rowoff(u, Rst[0] + 64 + HALF * h) << 16); } } while (0)
    Unit cur, nxt; int ui = 0;
    if (!S.next(0, cur)) return;
    f32x4 acc[2][2][4][2];
#pragma unroll
    for (int a = 0; a < 2; ++a)
#pragma unroll
        for (int b = 0; b < 2; ++b)
#pragma unroll
            for (int m = 0; m < 4; ++m)
#pragma unroll
                for (int n = 0; n < 2; ++n) acc[a][b][m][n] = (f32x4){0.f, 0.f, 0.f, 0.f};
    int f8scale = 0x7F7F7F7F; asm volatile("" : "+v"(f8scale));
    bf16x8 At[4][2], B0[2][2], B1[2][2]; v8i At8[4], B08[2], B18[2];
    const char* cA = S.a_base(cur, 0); const char* cA1 = ASPLIT ? S.a_base(cur, 1) : cA; const char* cB0 = S.b_base(cur, 0); const char* cB1 = KS ? S.b_base(cur, 1) : cB0;
    PG8_GOFF(vAc, cur);
    vAn[0] = vAc[0]; vAn[1] = vAc[1];
    PG8_STAGE_B(PG8_SB(0, 0), cB0, 0); PG8_STAGE_B(PG8_SB(0, 1), cB0, 1); PG8_STAGE_A(PG8_SA(0, 0), cA, 0, false); PG8_STAGE_A(PG8_SA(0, 1), cA, 1, false);
    if (wr == 1) PG8_BAR;
    PG8_WAIT_V(2); PG8_BAR;
    PG8_STAGE_B(PG8_SB(1, 0), cB0 + kstep, 0); PG8_STAGE_A(PG8_SA(1, 0), cA + kstep, 0, false); PG8_STAGE_B(PG8_SB(1, 1), cB0 + kstep, 1);
    PG8_WAIT_V(6); PG8_BAR;
    for (;;) {
        const bool has_next = S.next(ui + 1, nxt);
        const char* nA = has_next ? S.a_base(nxt, 0) : cA; const char* nA1 = (ASPLIT && has_next) ? S.a_base(nxt, 1) : (ASPLIT ? cA1 : nA); const char* nB0 = has_next ? S.b_base(nxt, 0) : cB0; const char* nB1 = (KS && has_next) ? S.b_base(nxt, 1) : (KS ? cB1 : nB0);
        if constexpr (GA) { if (has_next) { PG8_GOFF(vAn, nxt); } }
#pragma unroll 1
        for (int t = 0; t < nt; t += 2) {
            const bool last = (t == nt - 2);
            const char* a1 = (ASPLIT && (t + 1) >= KS) ? cA1 + (size_t)(t + 1 - KS) * kstep : cA + (size_t)(t + 1) * kstep;
            const char* a2 = last ? nA : ((ASPLIT && (t + 2) >= KS) ? cA1 + (size_t)(t + 2 - KS) * kstep : cA + (size_t)(t + 2) * kstep);
            if constexpr (Epi::MID) { if (t == KS) { int fr_ = fr, fq_ = fq; asm volatile("" : "+v"(fr_), "+v"(fq_)); E.mid(acc, cur, wr, wc, fr_, fq_); } }
            const char* b2 = last ? nB0 : ((KS && (t + 2) >= KS) ? cB1 + (size_t)(t + 2 - KS) * kstep : cB0 + (size_t)(t + 2) * kstep);
            const char* a3 = a2 + kstep; const char* b3 = b2 + kstep;
            PG8_LDB(B0, 0, 0); PG8_LDB(B1, 0, 1); PG8_SCHED; PG8_LDA(At, 0, 0); PG8_STAGE_A(PG8_SA(1, 1), a1, 1, false);
            PG8_WAIT_V(8); PG8_WAIT_L(0); PG8_BAR; PG8_MMA(0, 0, At, B0); PG8_MMA(0, 1, At, B1); PG8_BAR; PG8_SCHED;
            PG8_LDA(At, 0, 1); PG8_STAGE_B(PG8_SB(0, 0), b2, 0); PG8_STAGE_B(PG8_SB(0, 1), b2, 1); PG8_STAGE_A(PG8_SA(0, 0), a2, 0, last);
            PG8_WAIT_V(8); PG8_WAIT_L(0); PG8_BAR; PG8_MMA(1, 0, At, B0); PG8_MMA(1, 1, At, B1); PG8_BAR; PG8_SCHED;
            PG8_LDB(B0, 1, 0); PG8_LDB(B1, 1, 1); PG8_SCHED; PG8_LDA(At, 1, 0); PG8_STAGE_A(PG8_SA(0, 1), a2, 1, last);
            PG8_WAIT_V(8); PG8_WAIT_L(0); PG8_BAR; PG8_MMA(0, 0, At, B0); PG8_MMA(0, 1, At, B1); PG8_BAR; PG8_SCHED;
            PG8_LDA(At, 1, 1); PG8_STAGE_B(PG8_SB(1, 0), b3, 0); PG8_STAGE_B(PG8_SB(1, 1), b3, 1); PG8_STAGE_A(PG8_SA(1, 0), a3, 0, last);
            PG8_WAIT_V(8); PG8_WAIT_L(0); PG8_BAR; PG8_MMA(1, 0, At, B0); PG8_MMA(1, 1, At, B1); PG8_BAR; PG8_SCHED;
        }
        if (wr == 0) PG8_BAR;
        if constexpr (F8) { asm volatile("s_nop 15\n\ts_nop 15" ::: "memory"); }
        { int fr_ = fr, fq_ = fq; asm volatile("" : "+v"(fr_), "+v"(fq_));
          E(acc, cur, wr, wc, fr_, fq_); }
        if (!has_next) break;
#pragma unroll
        for (int a = 0; a < 2; ++a)
#pragma unroll
            for (int b = 0; b < 2; ++b)
#pragma unroll
                for (int m = 0; m < 4; ++m)
#pragma unroll
                    for (int n = 0; n < 2; ++n) acc[a][b][m][n] = (f32x4){0.f, 0.f, 0.f, 0.f};
        cur = nxt; cA = nA; cA1 = nA1; cB0 = nB0; cB1 = nB1; ++ui;
        vAc[0] = vAn[0]; vAc[1] = vAn[1];
        if (wr == 1) PG8_BAR;
    }
    PG8_WAIT_V(0);
    PG8_BAR;
#undef PG8_SA
#undef PG8_SB
#undef PG8_STAGE2
#undef PG8_STAGE_A
#undef PG8_STAGE_B
#undef PG8_LDA
#undef PG8_LDB
#undef PG8_MMA
#undef PG8_WAIT_V
#undef PG8_WAIT_L
#undef PG8_BAR
#undef PG8_SCHED
#undef PG8_GOFF
}
}
using pg8::Unit;

DI unsigned cvt_pk_bf16(float lo, float hi) { unsigned r; asm volatile("v_cvt_pk_bf16_f32 %0, %1, %2" : "=v"(r) : "v"(lo), "v"(hi)); return r; }

struct Args {
    const float* x; const float* c; const int* pos; const float* ada_w; const float* ada_b; const float* nmw; const float* nfw; const float* w_in;
    const float* b_ig; const float* b_fg; const float* qnw; const float* knw; const float* sinks; const float* conv_w; const float* conv_b; const float* mnw;
    const float* w_au; const float* w_mu; const float* w_out; const float* router_w; const float* router_b; const float* w_gate; const float* w_up; const float* w_down;
    float* out; unsigned char* ws; int ph_lo, ph_hi;
};

__constant__ float c_invf[8] = {1.0f, 0.1939227432012558f, 0.03760603070259094f, 0.007292664609849453f, 0.0014142135623842478f, 0.00027424818836152554f, 5.3182957344688475e-05f, 1.0313385246263351e-05f};

struct DenseSched {
    static constexpr bool GATHER = false, ASPLIT = false; static constexpr int KSPLIT = 0;
    const char* A; const char* Bt; int lda, ldb; pg8::TileOrder ord;
    DI bool next(int i, Unit& u) const { int pm, pn; if (!ord.get(i, pm, pn)) return false; u.pm = pm; u.pn = pn; u.x0 = 0; u.x1 = 0; return true; }
    DI const char* a_base(const Unit& u, int) const { return A + (size_t)u.pm * 256 * lda; }
    DI const char* b_base(const Unit& u, int) const { return Bt + (size_t)u.pn * 256 * ldb; }
    DI unsigned a_rowoff(const Unit&, int) const { return 0u; }
};
struct EpiProj {
    static constexpr bool PERM = true, MID = false;
    bf16* O; float* gates; const float* big; const float* bfg;
    DI void operator()(const f32x4 (&acc)[2][2][4][2], const Unit& u, int wr, int wc, int fr, int fq) const {
        const int row0 = u.pm * 256 + wr * 64 + fr, col0 = u.pn * 256 + wc * 32 + 8 * fq; const bool sg = u.pn >= 9; constexpr float WSC = 1.0f / 64.0f;
        if (u.pn == 19) {
            if (wc == 0 && fq == 0) {
#pragma unroll
                for (int ai = 0; ai < 2; ++ai)
#pragma unroll
                    for (int m = 0; m < 4; ++m) { const int row = row0 + ai * 128 + m * 16; const f32x4 vi = acc[ai][0][m][0], vf = acc[ai][0][m][1]; f32x4 oi, of;
#pragma unroll
                        for (int j = 0; j < 4; ++j) { oi[j] = vi[j] * WSC + big[j]; const float z = vf[j] * WSC + bfg[j]; of[j] = fminf(z, 0.f) - log1pf(__expf(-fabsf(z))); }
                        *(f32x4*)(gates + (size_t)row * 8) = oi; *(f32x4*)(gates + (size_t)row * 8 + 4) = of; } }
            return; }
#pragma unroll
        for (int ai = 0; ai < 2; ++ai)
#pragma unroll
            for (int m = 0; m < 4; ++m) { bf16* rowp = O + (size_t)(row0 + ai * 128 + m * 16) * NPROJ + col0;
#pragma unroll
                for (int bj = 0; bj < 2; ++bj) { f32x4 v0 = acc[ai][bj][m][0] * WSC, v1 = acc[ai][bj][m][1] * WSC;
                    if (sg) {
#pragma unroll
                        for (int j = 0; j < 4; ++j) { v0[j] = sigmoidf_(v0[j]); v1[j] = sigmoidf_(v1[j]); } }
                    v4u w; w.x = cvt_pk_bf16(v0[0], v0[1]); w.y = cvt_pk_bf16(v0[2], v0[3]); w.z = cvt_pk_bf16(v1[0], v1[1]); w.w = cvt_pk_bf16(v1[2], v1[3]);
                    *(v4u*)(rowp + bj * 128) = w; } }
    }
};
struct MergeSched {
    static constexpr bool GATHER = false, ASPLIT = true; static constexpr int KSPLIT = 8;
    const char* A0; const char* A1; const char* B0; const char* B1; int lda, ldb; pg8::TileOrder ord;
    DI bool next(int i, Unit& u) const { int pm, pn; if (!ord.get(i, pm, pn)) return false; u.pm = pm; u.pn = pn; u.x0 = 0; u.x1 = 0; return true; }
    DI const char* a_base(const Unit& u, int half) const { return (half ? A1 : A0) + (size_t)u.pm * 256 * lda; }
    DI const char* b_base(const Unit& u, int half) const { return (half ? B1 : B0) + (size_t)u.pn * 256 * ldb; }
    DI unsigned a_rowoff(const Unit&, int) const { return 0u; }
};
struct EpiMerge {
    static constexpr bool PERM = true, MID = true;
    bf16* P;
    DI void mid(f32x4 (&acc)[2][2][4][2], const Unit& u, int wr, int wc, int fr, int fq) const {
        const int row0 = u.pm * 256 + wr * 64 + fr, col0 = u.pn * 256 + wc * 32 + 8 * fq;
#pragma unroll
        for (int ai = 0; ai < 2; ++ai)
#pragma unroll
            for (int m = 0; m < 4; ++m) { const bf16* rowp = P + (size_t)(row0 + ai * 128 + m * 16) * NPROJ + col0;
#pragma unroll
                for (int bj = 0; bj < 2; ++bj) { const v4u ga = *(const v4u*)(rowp + C_GA + bj * 128), gb = *(const v4u*)(rowp + C_GB + bj * 128);
                    f32x4 r0, r1;
                    r0[0] = bflo(ga.x) * __builtin_amdgcn_rcpf(fmaxf(bflo(gb.x), 1e-30f)); r0[1] = bfhi(ga.x) * __builtin_amdgcn_rcpf(fmaxf(bfhi(gb.x), 1e-30f));
                    r0[2] = bflo(ga.y) * __builtin_amdgcn_rcpf(fmaxf(bflo(gb.y), 1e-30f)); r0[3] = bfhi(ga.y) * __builtin_amdgcn_rcpf(fmaxf(bfhi(gb.y), 1e-30f));
                    r1[0] = bflo(ga.z) * __builtin_amdgcn_rcpf(fmaxf(bflo(gb.z), 1e-30f)); r1[1] = bfhi(ga.z) * __builtin_amdgcn_rcpf(fmaxf(bfhi(gb.z), 1e-30f));
                    r1[2] = bflo(ga.w) * __builtin_amdgcn_rcpf(fmaxf(bflo(gb.w), 1e-30f)); r1[3] = bfhi(ga.w) * __builtin_amdgcn_rcpf(fmaxf(bfhi(gb.w), 1e-30f));
                    acc[ai][bj][m][0] *= r0; acc[ai][bj][m][1] *= r1; } }
    }
    DI void operator()(const f32x4 (&acc)[2][2][4][2], const Unit& u, int wr, int wc, int fr, int fq) const {
        const int row0 = u.pm * 256 + wr * 64 + fr, col0 = u.pn * 256 + wc * 32 + 8 * fq;
#pragma unroll
        for (int ai = 0; ai < 2; ++ai)
#pragma unroll
            for (int m = 0; m < 4; ++m) { bf16* rowp = P + (size_t)(row0 + ai * 128 + m * 16) * NPROJ + col0;
#pragma unroll
                for (int bj = 0; bj < 2; ++bj) { const f32x4 v0 = acc[ai][bj][m][0], v1 = acc[ai][bj][m][1];
                    const v4u g = *(const v4u*)(rowp + C_GB + bj * 128);
                    v4u w; w.x = cvt_pk_bf16(bflo(g.x) * v0[0], bfhi(g.x) * v0[1]); w.y = cvt_pk_bf16(bflo(g.y) * v0[2], bfhi(g.y) * v0[3]); w.z = cvt_pk_bf16(bflo(g.z) * v1[0], bfhi(g.z) * v1[1]); w.w = cvt_pk_bf16(bflo(g.w) * v1[2], bfhi(g.w) * v1[3]);
                    *(v4u*)(rowp + C_MQ + bj * 128) = w; } }
    }
};
struct EpiRes {
    static constexpr bool PERM = false, MID = false;
    const bf16* xin; bf16* out; const float* g; float* ssq; int rmask;
    DI void operator()(const f32x4 (&acc)[2][2][4][2], const Unit& u, int wr, int wc, int fr, int fq) const {
        const int row0 = u.pm * 256 + wr * 64 + fr, col0 = u.pn * 256 + wc * 32 + 4 * fq; const int b = (u.pm * 256) >> 14;
        f32x4 gv[2][2];
#pragma unroll
        for (int bj = 0; bj < 2; ++bj)
#pragma unroll
            for (int n = 0; n < 2; ++n) gv[bj][n] = *(const f32x4*)(g + b * 6144 + col0 + bj * 128 + n * 16);
#pragma unroll
        for (int ai = 0; ai < 2; ++ai)
#pragma unroll
            for (int m = 0; m < 4; ++m) { const size_t off = (size_t)(row0 + ai * 128 + m * 16) * D + col0; const size_t offo = (size_t)((row0 + ai * 128 + m * 16) & rmask) * D + col0; float sq = 0.f;
#pragma unroll
                for (int bj = 0; bj < 2; ++bj)
#pragma unroll
                    for (int n = 0; n < 2; ++n) { const v2u xw = *(const v2u*)(xin + off + bj * 128 + n * 16); const f32x4 xv = {bflo(xw.x), bfhi(xw.x), bflo(xw.y), bfhi(xw.y)}; const f32x4 o = xv + gv[bj][n] * acc[ai][bj][m][n];
                        v2u ow; ow.x = cvt_pk_bf16(o.x, o.y); ow.y = cvt_pk_bf16(o.z, o.w); const float r0 = bflo(ow.x), r1 = bfhi(ow.x), r2 = bflo(ow.y), r3 = bfhi(ow.y);
                        sq += (r0 * r0 + r1 * r1) + (r2 * r2 + r3 * r3);
                        *(v2u*)(out + offo + bj * 128 + n * 16) = ow; }
                sq += __shfl_xor(sq, 16); sq += __shfl_xor(sq, 32);
                if (fq == 0) ssq[(size_t)(row0 + ai * 128 + m * 16) * 16 + u.pn * 4 + wc] = sq; }
    }
};

struct MoeTab { const LAS int* tcls; const LAS int* tpos; const LAS int* cnt; int Rtot; };
DI int xcd_remap(int L, int nwg) { const int q = nwg >> 3, r = nwg & 7, xcd = L & 7, off = L >> 3; return (xcd < r ? xcd * (q + 1) : r * (q + 1) + (xcd - r) * q) + off; }
DI void cls_experts(int cls, int& ea, int& eb) { const int g = cls / 6, p = cls - 6 * g; const int a = (p < 3) ? 0 : ((p < 5) ? 1 : 2); const int b = (p < 3) ? (p + 1) : ((p < 5) ? (p - 1) : 3); ea = 4 * g + a; eb = 4 * g + b; }
struct MoeUpSched {
    static constexpr bool GATHER = true, ASPLIT = false; static constexpr int KSPLIT = 0;
    const char* A; const char* W; int lda, ldb; MoeTab tb; int G, c; const LAS unsigned* tokoff;
    DI bool next(int i, Unit& u) const { const int L0 = i * G + c; if (L0 >= tb.Rtot * 8) return false; const int L = xcd_remap(L0, tb.Rtot * 8); u.pm = L >> 3; u.pn = L & 7; u.x0 = i; u.x1 = __builtin_amdgcn_readfirstlane(tb.tcls[u.pm]); return true; }
    DI const char* a_base(const Unit&, int) const { return A; }
    DI const char* b_base(const Unit& u, int) const { int ea, eb; cls_experts(u.x1, ea, eb); const int e = (u.pn < 4) ? ea : eb; return W + ((size_t)e * 1024 + (size_t)(u.pn & 3) * 256) * ldb; }
    DI unsigned a_rowoff(const Unit& u, int r) const { return tokoff[u.x0 * 256 + r]; }
};
struct EpiSwiglu {
    static constexpr bool PERM = true, MID = false;
    bf16* H; const float* tgate; const LAS unsigned* tokoff;
    DI void operator()(const f32x4 (&acc)[2][2][4][2], const Unit& u, int wr, int wc, int fr, int fq) const {
        const int r0 = wr * 64 + fr; const int hc = (u.pn >> 2) * 512 + (u.pn & 3) * 128 + wc * 32 + 8 * fq; const int gsel = u.pn >> 2;
#pragma unroll
        for (int ai = 0; ai < 2; ++ai)
#pragma unroll
            for (int m = 0; m < 4; ++m) { const int r = r0 + ai * 128 + m * 16; const unsigned tok = tokoff[u.x0 * 256 + r]; const float rg = tgate[tok * 2 + gsel];
                const f32x4 g0 = acc[ai][0][m][0] * (1.0f / 64.0f), g1 = acc[ai][0][m][1] * (1.0f / 64.0f), u0 = acc[ai][1][m][0] * (1.0f / 64.0f), u1 = acc[ai][1][m][1] * (1.0f / 64.0f);
                float o[8];
#pragma unroll
                for (int j = 0; j < 4; ++j) { o[j] = g0[j] * sigmoidf_(g0[j]) * u0[j] * rg; o[4 + j] = g1[j] * sigmoidf_(g1[j]) * u1[j] * rg; }
                v4u w; w.x = cvt_pk_bf16(o[0], o[1]); w.y = cvt_pk_bf16(o[2], o[3]); w.z = cvt_pk_bf16(o[4], o[5]); w.w = cvt_pk_bf16(o[6], o[7]);
                *(v4u*)(H + ((size_t)u.pm * 256 + r) * 1024 + hc) = w; }
    }
};
struct MoeDownSched {
    static constexpr bool GATHER = false, ASPLIT = false; static constexpr int KSPLIT = 8;
    const char* A; const char* W; int lda, ldb; MoeTab tb; int G, c;
    DI bool next(int i, Unit& u) const { const int L0 = i * G + c; if (L0 >= tb.Rtot * 4) return false; const int L = xcd_remap(L0, tb.Rtot * 4); u.pm = L >> 2; u.pn = L & 3; u.x0 = __builtin_amdgcn_readfirstlane(tb.tpos[u.pm]); u.x1 = __builtin_amdgcn_readfirstlane(tb.tcls[u.pm]); return true; }
    DI const char* a_base(const Unit& u, int) const { return A + (size_t)u.pm * 256 * lda; }
    DI const char* b_base(const Unit& u, int half) const { int ea, eb; cls_experts(u.x1, ea, eb); const int e = half ? eb : ea; return W + ((size_t)e * 1024 + (size_t)u.pn * 256) * ldb; }
    DI unsigned a_rowoff(const Unit&, int) const { return 0u; }
};
struct EpiMoeOut {
    static constexpr bool PERM = false, MID = false;
    const bf16* xin; bf16* outb; float* outf; const float* g; const int* tokl; MoeTab tb; int rmask, last;
    DI void operator()(const f32x4 (&acc)[2][2][4][2], const Unit& u, int wr, int wc, int fr, int fq) const {
        const int r0 = wr * 64 + fr, col0 = u.pn * 256 + wc * 32 + 4 * fq; const int cn = tb.cnt[u.x1];
#pragma unroll
        for (int ai = 0; ai < 2; ++ai)
#pragma unroll
            for (int m = 0; m < 4; ++m) { const int pos = u.x0 + r0 + ai * 128 + m * 16;
                if (pos < cn) { const int tok = tokl[u.x1 * CLS_CAP + pos]; const int b = tok >> 14; const bf16* ip = xin + (size_t)tok * D + col0; bf16* op = outb + (size_t)(tok & rmask) * D + col0; float* of = outf + (size_t)tok * D + col0; const float* gp = g + b * 6144 + col0;
#pragma unroll
                    for (int bj = 0; bj < 2; ++bj)
#pragma unroll
                        for (int n = 0; n < 2; ++n) { const v2u xw = *(const v2u*)(ip + bj * 128 + n * 16); const f32x4 xv = {bflo(xw.x), bfhi(xw.x), bflo(xw.y), bfhi(xw.y)}; const f32x4 gv = *(const f32x4*)(gp + bj * 128 + n * 16);
                            const f32x4 o = xv + gv * acc[ai][bj][m][n];
                            if (last) *(f32x4*)(of + bj * 128 + n * 16) = o;
                            else { v2u ow; ow.x = cvt_pk_bf16(o.x, o.y); ow.y = cvt_pk_bf16(o.z, o.w); *(v2u*)(op + bj * 128 + n * 16) = ow; } } } }
    }
};

struct Ctx { LAS unsigned char* lds; int tid, lane, wave, G, bid; };
DI Ctx fresh(const Ctx& X) { Ctx P = X; int t = X.tid; asm volatile("" : "+v"(t)); P.tid = t; P.lane = t & 63; P.wave = __builtin_amdgcn_readfirstlane(t >> 6); return P; }

DI void tr_item(const float* W, int ldw, int K, bf16* WT, int k0, LAS float* scr, int lane) {
#pragma unroll 8
    for (int i = 0; i < 32; ++i) { const int kk = 2 * i + (lane >> 5); scr[kk * 33 + (lane & 31)] = W[(size_t)(k0 + kk) * ldw + (lane & 31)]; }
    LDS_WAIT(); asm volatile("" ::: "memory");
    const int c = lane & 7;
#pragma unroll
    for (int j = 0; j < 4; ++j) { const int n = (lane >> 3) + 8 * j; const LAS float* s = scr + (8 * c) * 33 + n;
        v4u o; o.x = pk2(s[0 * 33], s[1 * 33]); o.y = pk2(s[2 * 33], s[3 * 33]); o.z = pk2(s[4 * 33], s[5 * 33]); o.w = pk2(s[6 * 33], s[7 * 33]);
        *(v4u*)(WT + (size_t)n * K + k0 + 8 * c) = o; }
    LDS_WAIT(); asm volatile("" ::: "memory");
}
DI unsigned pk4_fp8(float a0, float a1, float a2, float a3) { int p = __builtin_amdgcn_cvt_pk_fp8_f32(a0, a1, 0, false); p = __builtin_amdgcn_cvt_pk_fp8_f32(a2, a3, p, true); return (unsigned)p; }
DI void tr_item8(const float* W, int ldw, int K, unsigned char* WT, int k0, float scale, LAS float* scr, int lane) {
#pragma unroll 8
    for (int i = 0; i < 32; ++i) { const int kk = 2 * i + (lane >> 5); scr[kk * 33 + (lane & 31)] = W[(size_t)(k0 + kk) * ldw + (lane & 31)]; }
    LDS_WAIT(); asm volatile("" ::: "memory");
    const int c = lane & 7;
#pragma unroll
    for (int j = 0; j < 4; ++j) { const int n = (lane >> 3) + 8 * j; const LAS float* s = scr + (8 * c) * 33 + n;
        v2u o; o.x = pk4_fp8(s[0 * 33] * scale, s[1 * 33] * scale, s[2 * 33] * scale, s[3 * 33] * scale); o.y = pk4_fp8(s[4 * 33] * scale, s[5 * 33] * scale, s[6 * 33] * scale, s[7 * 33] * scale);
        *(v2u*)(WT + (size_t)n * K + k0 + 8 * c) = o; }
    LDS_WAIT(); asm volatile("" ::: "memory");
}
DI void p0_prologue(const Args& a, const Ctx& X) {
    unsigned char* ws = a.ws;
    LAS float* scr = (LAS float*)(X.lds + X.wave * 16384);
    const int gw = X.bid * 8 + X.wave, NGW = X.G * 8;
    constexpr int IT_WIN = 16 * 153, IT_AU = 8 * 32, IT_OUT = 16 * 32, IT_GU = 16 * 16 * 32, IT_DN = 16 * 8 * 32;
    constexpr int IT_L = IT_WIN + 2 * IT_AU + IT_OUT + IT_GU + IT_DN;
    for (int it = gw; it < NL * IT_L; it += NGW) {
        const int l = it / IT_L; int r = it - l * IT_L;
        if (r < IT_WIN) { const int kb = r / 153, nb = r - kb * 153, d0 = 32 * nb, s0 = (nb == 152) ? 2304 : (d0 + (d0 >= 2304 ? 8 : 0));
            tr_item8(a.w_in + (size_t)l * D * DIN_SRC + s0, DIN_SRC, D, (unsigned char*)(ws + WS_WIN) + ((size_t)l * NPROJW + d0) * D, 64 * kb, 64.0f, scr, X.lane); continue; }
        r -= IT_WIN;
        if (r < IT_AU) { const int kb = r >> 5, nb = r & 31;
            tr_item(a.w_au + (size_t)l * 512 * D + 32 * nb, D, 512, (bf16*)(ws + WS_WAU) + ((size_t)l * D + 32 * nb) * 512, 64 * kb, scr, X.lane); continue; }
        r -= IT_AU;
        if (r < IT_AU) { const int kb = r >> 5, nb = r & 31;
            tr_item(a.w_mu + (size_t)l * 512 * D + 32 * nb, D, 512, (bf16*)(ws + WS_WMU) + ((size_t)l * D + 32 * nb) * 512, 64 * kb, scr, X.lane); continue; }
        r -= IT_AU;
        if (r < IT_OUT) { const int kb = r >> 5, nb = r & 31;
            tr_item(a.w_out + (size_t)l * D * D + 32 * nb, D, D, (bf16*)(ws + WS_WOUT) + ((size_t)l * D + 32 * nb) * D, 64 * kb, scr, X.lane); continue; }
        r -= IT_OUT;
        if (r < IT_GU) { const int e = r >> 9, q = r & 511, kb = q >> 5, nb = q & 31, tq = nb >> 3, rb = nb & 7;
            const float* src = ((rb < 4) ? a.w_gate : a.w_up) + ((size_t)(l * NE + e) * D) * FF + 128 * tq + 32 * (rb & 3);
            tr_item8(src, FF, D, (unsigned char*)(ws + WS_WGU) + ((size_t)(l * NE + e) * 1024 + 32 * nb) * D, 64 * kb, 64.0f, scr, X.lane); continue; }
        r -= IT_GU;
        { const int e = r >> 8, q = r & 255, kb = q >> 5, nb = q & 31;
            tr_item(a.w_down + ((size_t)(l * NE + e) * FF) * D + 32 * nb, D, FF, (bf16*)(ws + WS_WD) + ((size_t)(l * NE + e) * 1024 + 32 * nb) * FF, 64 * kb, scr, X.lane); }
    }
    { const float* xs = a.x; bf16* xb = (bf16*)(ws + WS_XB);
      for (size_t i = (size_t)X.bid * 512 + X.tid; i < (size_t)T * D / 8; i += (size_t)X.G * 512) { const f32x4 v0 = *(const f32x4*)(xs + 8 * i), v1 = *(const f32x4*)(xs + 8 * i + 4);
          v4u w; w.x = cvt_pk_bf16(v0.x, v0.y); w.y = cvt_pk_bf16(v0.z, v0.w); w.z = cvt_pk_bf16(v1.x, v1.y); w.w = cvt_pk_bf16(v1.z, v1.w); *(v4u*)(xb + 8 * i) = w; } }
    { float* cs = (float*)(ws + WS_ROPE); float* sn = cs + (size_t)T * 8;
      for (int i = X.bid * 512 + X.tid; i < T * 8; i += X.G * 512) { const int tok = i >> 3, f = i & 7; const float angf = (float)a.pos[tok] * c_invf[f];
          double rev = (double)angf * 0.15915494309189535; rev -= rint(rev); const float rf = (float)rev;
          cs[i] = __builtin_amdgcn_cosf(rf); sn[i] = __builtin_amdgcn_sinf(rf); } }
    __syncthreads();
    LAS float* cact = (LAS float*)X.lds; LAS float* red = (LAS float*)(X.lds + 8192);
    for (int i = X.tid; i < 2048; i += 512) { const float cv = a.c[i]; cact[i] = cv / (1.0f + __expf(-cv)); }
    __syncthreads();
    float* mod = (float*)(ws + WS_MOD);
    for (int it = X.bid; it < NL * 96; it += X.G) { const int l = it / 96, cg = it - l * 96; const int col = cg * 64 + X.lane;
        const float* w = a.ada_w + (size_t)l * D * 6144 + col; float s0 = 0.f, s1 = 0.f;
#pragma unroll 8
        for (int kk = 0; kk < 128; ++kk) { const int k = X.wave * 128 + kk; const float wv = w[(size_t)k * 6144]; s0 += cact[k] * wv; s1 += cact[1024 + k] * wv; }
        red[(X.wave * 2 + 0) * 64 + X.lane] = s0; red[(X.wave * 2 + 1) * 64 + X.lane] = s1;
        __syncthreads();
        if (X.tid < 128) { const int b = X.tid >> 6, ln = X.tid & 63; float s = 0.f;
#pragma unroll
            for (int w8 = 0; w8 < 8; ++w8) s += red[(w8 * 2 + b) * 64 + ln];
            mod[(size_t)(l * 2 + b) * 6144 + cg * 64 + ln] = s + a.ada_b[l * 6144 + cg * 64 + ln]; }
        __syncthreads();
    }
}

DI void p1_norm_gates(const Args& a, const Ctx& X, int l, const bf16* xin) {
    unsigned char* ws = a.ws;
    const float* mod = (const float*)(ws + WS_MOD); unsigned char* hb = (unsigned char*)(ws + WS_H);
    const int gw = X.bid * 8 + X.wave, NGW = X.G * 8;
    for (int rg = gw; rg < T / 16; rg += NGW) {
        const int row0 = rg * 16, b = row0 >> 14;
        const float* mb = mod + (size_t)(l * 2 + b) * 6144;
        f32x4 aw[4], sh[4];
#pragma unroll
        for (int j = 0; j < 4; ++j) { const int k = 256 * j + 4 * X.lane; const f32x4 nw = *(const f32x4*)(a.nmw + l * D + k); const f32x4 sc = *(const f32x4*)(mb + 1024 + k); aw[j] = nw * (sc + 1.0f); sh[j] = *(const f32x4*)(mb + k); }
        v2u pre[4][4];
#pragma unroll
        for (int q = 0; q < 4; ++q) { const v2u* xp = (const v2u*)(xin + (size_t)(row0 + q) * D) + X.lane;
#pragma unroll
            for (int j = 0; j < 4; ++j) pre[q][j] = xp[64 * j]; }
#pragma unroll 1
        for (int rb = 0; rb < 16; rb += 4) {
#pragma unroll
          for (int q = 0; q < 4; ++q) { const int row = row0 + rb + q;
            f32x4 v[4]; float ss = 0.f;
#pragma unroll
            for (int j = 0; j < 4; ++j) { const v2u pw = pre[q][j]; v[j] = (f32x4){bflo(pw.x), bfhi(pw.x), bflo(pw.y), bfhi(pw.y)}; }
            if (rb + 4 < 16) { const v2u* xp = (const v2u*)(xin + (size_t)(row + 4) * D) + X.lane;
#pragma unroll
                for (int j = 0; j < 4; ++j) pre[q][j] = xp[64 * j]; }
#pragma unroll
            for (int j = 0; j < 4; ++j) ss += (v[j].x * v[j].x + v[j].y * v[j].y) + (v[j].z * v[j].z + v[j].w * v[j].w);
            ss = wave_sum(ss); const float rstd = __builtin_amdgcn_rsqf(ss * (1.0f / D) + EPS);
            unsigned* o4 = (unsigned*)(hb + (size_t)row * D) + X.lane;
#pragma unroll
            for (int j = 0; j < 4; ++j) { v[j] = v[j] * rstd * aw[j] + sh[j]; o4[64 * j] = pk4_fp8(v[j].x, v[j].y, v[j].z, v[j].w); }
          }
        }
    }
}

DI void attn_unit(const Args& a, const Ctx& X, int l, int unit) {
    unsigned char* ws = a.ws; const bf16* proj = (const bf16*)(ws + WS_PROJ); bf16* ao = (bf16*)(ws + WS_H);
    const float* cs = (const float*)(ws + WS_ROPE); const float* sn = cs + (size_t)T * 8;
    const int b = unit >> 8, rem = unit & 255, nb = rem >> 1, kvh = rem & 1; const int tok0 = b * SEQ + nb * 128;
    LAS bf16* Kl = (LAS bf16*)X.lds;
    LAS bf16* VT = (LAS bf16*)(X.lds + 36864);
    int lane = X.lane; asm volatile("" : "+v"(lane));
    const int c16 = lane & 15, quad = lane >> 4;
    v4u nq0, nq1; f32x4 ncs0, ncs1, nsn0, nsn1;
#define AT_PREF(task_) do { const int g_ = (task_) >> 3, tq_ = tok0 + 16 * ((task_) & 7) + c16; const bf16* qp_ = proj + (size_t)tq_ * NPROJ + C_AQ + (kvh * 4 + g_) * 64; \
        nq0 = *(const v4u*)(qp_ + 8 * quad); nq1 = *(const v4u*)(qp_ + 32 + 8 * quad); ncs0 = *(const f32x4*)(cs + (size_t)tq_ * 8); ncs1 = *(const f32x4*)(cs + (size_t)tq_ * 8 + 4); nsn0 = *(const f32x4*)(sn + (size_t)tq_ * 8); nsn1 = *(const f32x4*)(sn + (size_t)tq_ * 8 + 4); } while (0)
    AT_PREF(X.wave);
    float qw[16];
#pragma unroll
    for (int i = 0; i < 8; ++i) { qw[i] = a.qnw[l * 64 + 8 * quad + i]; qw[8 + i] = a.qnw[l * 64 + 32 + 8 * quad + i]; }
    const f32x4 sk4 = *(const f32x4*)(a.sinks + l * 8 + kvh * 4);
    {
        const int row = X.tid >> 1, half = X.tid & 1; const int tokk = tok0 - 128 + row; const bool valid = (nb > 0) || (row >= 128);
        float y[32]; float vv[32];
        if (valid) {
            const v4u* kp = (const v4u*)(proj + (size_t)tokk * NPROJ + C_AK + kvh * 64 + half * 32); const v4u* vp = (const v4u*)(proj + (size_t)tokk * NPROJ + C_AV + kvh * 64 + half * 32);
#pragma unroll
            for (int q = 0; q < 4; ++q) { const v4u kw = kp[q], vw = vp[q];
                y[8 * q + 0] = bflo(kw.x); y[8 * q + 1] = bfhi(kw.x); y[8 * q + 2] = bflo(kw.y); y[8 * q + 3] = bfhi(kw.y); y[8 * q + 4] = bflo(kw.z); y[8 * q + 5] = bfhi(kw.z); y[8 * q + 6] = bflo(kw.w); y[8 * q + 7] = bfhi(kw.w);
                vv[8 * q + 0] = bflo(vw.x); vv[8 * q + 1] = bfhi(vw.x); vv[8 * q + 2] = bflo(vw.y); vv[8 * q + 3] = bfhi(vw.y); vv[8 * q + 4] = bflo(vw.z); vv[8 * q + 5] = bfhi(vw.z); vv[8 * q + 6] = bflo(vw.w); vv[8 * q + 7] = bfhi(vw.w); }
        } else {
#pragma unroll
            for (int i = 0; i < 32; ++i) { y[i] = 0.f; vv[i] = 0.f; } }
        float ss = 0.f;
#pragma unroll
        for (int i = 0; i < 32; ++i) ss += y[i] * y[i];
        ss += __shfl_xor(ss, 1); const float rstd = 1.0f / sqrtf(ss * (1.0f / 64.0f) + EPS);
#pragma unroll
        for (int i = 0; i < 32; ++i) y[i] = y[i] * rstd * a.knw[l * 64 + half * 32 + i];
        if (half == 0 && valid) {
#pragma unroll
            for (int d = 0; d < 8; ++d) { const float c = cs[(size_t)tokk * 8 + d], s = sn[(size_t)tokk * 8 + d]; const float t1 = y[d], t2 = y[d + 8]; y[d] = t1 * c - t2 * s; y[d + 8] = t2 * c + t1 * s; } }
#pragma unroll
        for (int q = 0; q < 4; ++q) { v4u w; w.x = pk2(y[8 * q], y[8 * q + 1]); w.y = pk2(y[8 * q + 2], y[8 * q + 3]); w.z = pk2(y[8 * q + 4], y[8 * q + 5]); w.w = pk2(y[8 * q + 6], y[8 * q + 7]);
            *(LAS v4u*)(Kl + row * 72 + half * 32 + 8 * q) = w; }
#pragma unroll
        for (int i = 0; i < 32; ++i) VT[(half * 32 + i) * 280 + row] = (bf16)f2bf(vv[i]);
        if (X.tid < 64) {
#pragma unroll
            for (int cc = 256; cc < 280; ++cc) VT[X.tid * 280 + cc] = 0; }
    }
    __syncthreads();
#pragma unroll 1
    for (int task = X.wave; task < 32; task += 8) {
        const int g = task >> 3, rg = task & 7, r0 = 16 * rg, head = kvh * 4 + g; const int tokq = tok0 + r0 + c16;
        const float sink = (g == 0) ? sk4.x : ((g == 1) ? sk4.y : ((g == 2) ? sk4.z : sk4.w));
        const v4u w0 = nq0, w1 = nq1; const f32x4 cc0 = ncs0, cc1 = ncs1, ss0 = nsn0, ss1 = nsn1;
        if (task + 8 < 32) { AT_PREF(task + 8); }
        float qv[16];
        qv[0] = bflo(w0.x); qv[1] = bfhi(w0.x); qv[2] = bflo(w0.y); qv[3] = bfhi(w0.y); qv[4] = bflo(w0.z); qv[5] = bfhi(w0.z); qv[6] = bflo(w0.w); qv[7] = bfhi(w0.w);
        qv[8] = bflo(w1.x); qv[9] = bfhi(w1.x); qv[10] = bflo(w1.y); qv[11] = bfhi(w1.y); qv[12] = bflo(w1.z); qv[13] = bfhi(w1.z); qv[14] = bflo(w1.w); qv[15] = bfhi(w1.w);
        float ss = 0.f;
#pragma unroll
        for (int i = 0; i < 16; ++i) ss += qv[i] * qv[i];
        ss += __shfl_xor(ss, 16); ss += __shfl_xor(ss, 32); const float rstd = __builtin_amdgcn_rsqf(ss * (1.0f / 64.0f) + EPS);
#pragma unroll
        for (int i = 0; i < 16; ++i) qv[i] = qv[i] * rstd * qw[i];
        { const float cv[8] = {cc0.x, cc0.y, cc0.z, cc0.w, cc1.x, cc1.y, cc1.z, cc1.w}, sv[8] = {ss0.x, ss0.y, ss0.z, ss0.w, ss1.x, ss1.y, ss1.z, ss1.w};
#pragma unroll
          for (int d = 0; d < 8; ++d) { const float other = __shfl_xor(qv[d], 16);
              if (quad == 0) qv[d] = qv[d] * cv[d] - other * sv[d]; else if (quad == 1) qv[d] = qv[d] * cv[d] + other * sv[d]; } }
        bf16x8 qf[2];
        { v4u w; w.x = pk2(qv[0], qv[1]); w.y = pk2(qv[2], qv[3]); w.z = pk2(qv[4], qv[5]); w.w = pk2(qv[6], qv[7]); qf[0] = __builtin_bit_cast(bf16x8, w);
          w.x = pk2(qv[8], qv[9]); w.y = pk2(qv[10], qv[11]); w.z = pk2(qv[12], qv[13]); w.w = pk2(qv[14], qv[15]); qf[1] = __builtin_bit_cast(bf16x8, w); }
        f32x4 sacc[9];
#pragma unroll
        for (int i = 0; i < 9; ++i) { const LAS bf16* kr = Kl + (16 * (rg + i) + c16) * 72 + 8 * quad;
            const bf16x8 k0 = *(const LAS bf16x8*)kr, k1 = *(const LAS bf16x8*)(kr + 32);
            f32x4 z = {0.f, 0.f, 0.f, 0.f}; z = __builtin_amdgcn_mfma_f32_16x16x32_bf16(k0, qf[0], z, 0, 0, 0); sacc[i] = __builtin_amdgcn_mfma_f32_16x16x32_bf16(k1, qf[1], z, 0, 0, 0); }
        int dbase = 4 * quad - c16; asm volatile("" : "+v"(dbase)); int kbase = 16 * rg + 4 * quad; asm volatile("" : "+v"(kbase)); float mx = sink;
#pragma unroll
        for (int i = 0; i < 9; ++i)
#pragma unroll
            for (int j = 0; j < 4; ++j) { const int dlt = dbase + 16 * i + j; const int kj = kbase + 16 * i + j; const bool ok = (dlt > 0) && (dlt <= 128) && ((nb > 0) || (kj >= 128));
                const float s = ok ? sacc[i][j] * 0.125f : -3.0e38f; sacc[i][j] = s; mx = fmaxf(mx, s); }
        mx = fmaxf(mx, __shfl_xor(mx, 16)); mx = fmaxf(mx, __shfl_xor(mx, 32));
        float sum = 0.f;
#pragma unroll
        for (int i = 0; i < 9; ++i)
#pragma unroll
            for (int j = 0; j < 4; ++j) { const float p = (sacc[i][j] > -1.0e38f) ? __expf(sacc[i][j] - mx) : 0.f; sacc[i][j] = p; sum += p; }
        sum += __shfl_xor(sum, 16); sum += __shfl_xor(sum, 32);
        const float inv = 1.0f / (sum + __expf(sink - mx));
        f32x4 oacc[4];
#pragma unroll
        for (int et = 0; et < 4; ++et) oacc[et] = (f32x4){0.f, 0.f, 0.f, 0.f};
#pragma unroll
        for (int kk = 0; kk < 5; ++kk) {
            v4u pw; pw.x = pk2(sacc[2 * kk][0], sacc[2 * kk][1]); pw.y = pk2(sacc[2 * kk][2], sacc[2 * kk][3]);
            if (2 * kk + 1 < 9) { pw.z = pk2(sacc[(2 * kk + 1 < 9) ? 2 * kk + 1 : 0][0], sacc[(2 * kk + 1 < 9) ? 2 * kk + 1 : 0][1]); pw.w = pk2(sacc[(2 * kk + 1 < 9) ? 2 * kk + 1 : 0][2], sacc[(2 * kk + 1 < 9) ? 2 * kk + 1 : 0][3]); } else { pw.z = 0u; pw.w = 0u; }
            const bf16x8 pf = __builtin_bit_cast(bf16x8, pw);
#pragma unroll
            for (int et = 0; et < 4; ++et) { const LAS bf16* vr = VT + (16 * et + c16) * 280 + 16 * rg + 32 * kk + 4 * quad;
                const v2u lo = *(const LAS v2u*)vr, hi = *(const LAS v2u*)(vr + 16); v4u vw; vw.x = lo.x; vw.y = lo.y; vw.z = hi.x; vw.w = hi.y;
                oacc[et] = __builtin_amdgcn_mfma_f32_16x16x32_bf16(__builtin_bit_cast(bf16x8, vw), pf, oacc[et], 0, 0, 0); }
        }
#pragma unroll
        for (int et = 0; et < 4; ++et) { v2u w; w.x = pk2(oacc[et][0] * inv, oacc[et][1] * inv); w.y = pk2(oacc[et][2] * inv, oacc[et][3] * inv);
            *(v2u*)(ao + (size_t)tokq * 512 + head * 64 + 16 * et + 4 * quad) = w; }
    }
    __syncthreads();
#undef AT_PREF
}

constexpr int ML_Q = 0, ML_K = 17408, ML_KET = 34816, ML_VT = 53248, ML_CT = 73984, ML_CW = 113152, ML_CB = 118272, ML_RED = 118784, ML_NW = 119296, ML_GT = 119808;
DI float bfw(unsigned w, int hi) { return hi ? bfhi(w) : bflo(w); }
template <bool L3> DI void mlstm_unit(const Args& a, const Ctx& X, int l, int unit) {
    unsigned char* ws = a.ws; const bf16* proj = (const bf16*)(ws + WS_PROJ); bf16* hm = (bf16*)(ws + WS_H) + (size_t)T * 512;
    bf16* kcb = (bf16*)(ws + WS_KC);
    const float* gates = (const float*)(ws + WS_GATES); float* mlc = (float*)(ws + WS_MLC) + (size_t)unit * 18432; float* mlb = (float*)(ws + WS_MLB);
    const int seq = unit >> 5, sj = unit & 31, b = seq >> 2, hh = seq & 3; const int tokbase = b * SEQ + sj * 512;
    LAS bf16* Qs = (LAS bf16*)(X.lds + ML_Q); LAS bf16* Ks = (LAS bf16*)(X.lds + ML_K); LAS bf16* KET = (LAS bf16*)(X.lds + ML_KET);
    LAS bf16* VT = (LAS bf16*)(X.lds + ML_VT); LAS bf16* CT = (LAS bf16*)(X.lds + ML_CT); LAS float* CW = (LAS float*)(X.lds + ML_CW);
    LAS float* CB = (LAS float*)(X.lds + ML_CB); LAS float* RED = (LAS float*)(X.lds + ML_RED); LAS float* NW = (LAS float*)(X.lds + ML_NW);
    LAS float* GT = (LAS float*)(X.lds + ML_GT);
    int lane = X.lane; asm volatile("" : "+v"(lane));
    const int c16 = lane & 15, quad = lane >> 4, w = X.wave;
    int tidl = X.tid; asm volatile("" : "+v"(tidl));
    const int tg = tidl >> 5, cg = tidl & 31, t0 = 4 * tg, c0 = 4 * cg;
    v2u rq[7], rk[7], rv[4], kcv[4];
#define ML_LBAR() do { asm volatile("s_waitcnt lgkmcnt(0)" ::: "memory"); __builtin_amdgcn_s_barrier(); asm volatile("" ::: "memory"); } while (0)
#define ML_LOADRAW(tokc) do { _Pragma("unroll") for (int j = 0; j < 7; ++j) { const int tt = (tokc) + t0 - 3 + j; const bool ok = tt >= b * SEQ; const bf16* rp = proj + (size_t)(ok ? tt : (tokc)) * NPROJ + hh * 128 + c0; \
        if (L3) { rq[j] = *(const v2u*)(rp + C_MQ); if (!ok) { rq[j].x = 0u; rq[j].y = 0u; } } else { rk[j] = *(const v2u*)(rp + C_MK); if (!ok) { rk[j].x = 0u; rk[j].y = 0u; } } } \
        if (L3) { _Pragma("unroll") for (int i = 0; i < 4; ++i) kcv[i] = *(const v2u*)(kcb + (size_t)((tokc) + t0 + i) * 512 + hh * 128 + c0); } \
        _Pragma("unroll") for (int i = 0; i < 4; ++i) rv[i] = *(const v2u*)(proj + (size_t)((tokc) + t0 + i) * NPROJ + C_MV + hh * 128 + c0); } while (0)
    ML_LOADRAW(tokbase);
    for (int idx = X.tid; idx < 1280; idx += 512) { const int tap = idx >> 8, ch = idx & 255; const int gch = (ch < 128) ? (hh * 128 + ch) : (512 + hh * 128 + (ch - 128));
        CW[idx] = (tap < 4) ? a.conv_w[(size_t)(l * 4 + tap) * 1024 + gch] : a.conv_b[l * 1024 + gch]; }
    for (int idx = X.tid; idx < 16 * 72; idx += 512) VT[128 * 72 + idx] = (idx < 72) ? (bf16)0x3F80 : (bf16)0;
    if (X.tid < 128) NW[X.tid] = a.mnw[l * 512 + hh * 128 + X.tid];
    { const float* gp = gates + (size_t)(tokbase + X.tid) * 8; GT[2 * X.tid] = gp[hh]; GT[2 * X.tid + 1] = gp[4 + hh]; }
    f32x4 cacc[9];
#pragma unroll
    for (int et = 0; et < 9; ++et) {
        if (L3) {
#pragma unroll
            for (int j = 0; j < 4; ++j) { const float v = mlc[(16 * et + 4 * quad + j) * 128 + 16 * w + c16]; cacc[et][j] = v; CT[(16 * et + 4 * quad + j) * 136 + 16 * w + c16] = (bf16)f2bf(v); }
        } else cacc[et] = (f32x4){0.f, 0.f, 0.f, 0.f};
    }
    float bsum = 0.f;
    __syncthreads();
#pragma unroll 1
    for (int c = 0; c < 8; ++c) {
        const int tok0 = tokbase + c * 64;
        const f32x2 gl = *(const LAS f32x2*)(GT + 2 * (c * 64 + lane)); float bsc = gl.y; const float li = gl.x;
#pragma unroll
        for (int o = 1; o < 64; o <<= 1) { const float v = __shfl_up(bsc, o); if (lane >= o) bsc += v; }
        const float bl = __shfl(bsc, 63); const float csv = li - bsc;
        if (w == 0) { CB[lane] = bsc; CB[64 + lane] = csv; }
        bsum += bl;
        const int tt_ = w & 3, eh = w >> 2; const int tq = 16 * tt_ + c16;
        v2u ogv[4];
        if (L3) {
#pragma unroll
            for (int x = 0; x < 4; ++x) ogv[x] = *(const v2u*)(proj + (size_t)(tok0 + tq) * NPROJ + C_MO + hh * 128 + 16 * (4 * eh + x) + 4 * quad); }
        { float fac[4];
#pragma unroll
          for (int i = 0; i < 4; ++i) fac[i] = __expf(bl + __shfl(csv, t0 + i));
#pragma unroll
          for (int qk = (L3 ? 0 : 1); qk < 2; ++qk) {
              float o[4][4];
              if (L3 && qk) {
#pragma unroll
                  for (int i = 0; i < 4; ++i) { o[i][0] = bflo(kcv[i].x); o[i][1] = bfhi(kcv[i].x); o[i][2] = bflo(kcv[i].y); o[i][3] = bfhi(kcv[i].y); }
              } else {
              const f32x4 bias = *(const LAS f32x4*)(CW + 4 * 256 + qk * 128 + c0);
#pragma unroll
              for (int i = 0; i < 4; ++i) { o[i][0] = bias.x; o[i][1] = bias.y; o[i][2] = bias.z; o[i][3] = bias.w; }
#pragma unroll
              for (int j = 0; j < 4; ++j) { const f32x4 wj = *(const LAS f32x4*)(CW + j * 256 + qk * 128 + c0);
#pragma unroll
                  for (int i = 0; i < 4; ++i) { const v2u rr = qk ? rk[i + j] : rq[i + j];
                      o[i][0] += wj.x * bflo(rr.x); o[i][1] += wj.y * bfhi(rr.x); o[i][2] += wj.z * bflo(rr.y); o[i][3] += wj.w * bfhi(rr.y); } }
#pragma unroll
              for (int i = 0; i < 4; ++i)
#pragma unroll
                  for (int ch = 0; ch < 4; ++ch) { const float z = o[i][ch]; o[i][ch] = z * __builtin_amdgcn_rcpf(1.0f + __expf(-z)) * (qk ? 0.08838834764831845f : 1.0f); }
              }
              if (!L3 && qk) {
#pragma unroll
                  for (int i = 0; i < 4; ++i) { v2u pw; pw.x = pk2(o[i][0], o[i][1]); pw.y = pk2(o[i][2], o[i][3]); *(v2u*)(kcb + (size_t)(tok0 + t0 + i) * 512 + hh * 128 + c0) = pw;
                      o[i][0] = bflo(pw.x); o[i][1] = bfhi(pw.x); o[i][2] = bflo(pw.y); o[i][3] = bfhi(pw.y); } }
              if (L3) { LAS bf16* dst = (qk ? Ks : Qs) + t0 * 136 + c0;
#pragma unroll
                  for (int i = 0; i < 4; ++i) { v2u pw; pw.x = pk2(o[i][0], o[i][1]); pw.y = pk2(o[i][2], o[i][3]); *(LAS v2u*)(dst + i * 136) = pw; } }
              if (qk) {
#pragma unroll
                  for (int ch = 0; ch < 4; ++ch) { v2u pw; pw.x = pk2(o[0][ch] * fac[0], o[1][ch] * fac[1]); pw.y = pk2(o[2][ch] * fac[2], o[3][ch] * fac[3]); *(LAS v2u*)(KET + (c0 + ch) * 72 + t0) = pw; } }
          }
          { v2u p0, p1, p2, p3;
            p0.x = (rv[0].x & 0xffffu) | (rv[1].x << 16); p0.y = (rv[2].x & 0xffffu) | (rv[3].x << 16);
            p1.x = (rv[0].x >> 16) | (rv[1].x & 0xffff0000u); p1.y = (rv[2].x >> 16) | (rv[3].x & 0xffff0000u);
            p2.x = (rv[0].y & 0xffffu) | (rv[1].y << 16); p2.y = (rv[2].y & 0xffffu) | (rv[3].y << 16);
            p3.x = (rv[0].y >> 16) | (rv[1].y & 0xffff0000u); p3.y = (rv[2].y >> 16) | (rv[3].y & 0xffff0000u);
            *(LAS v2u*)(VT + (c0 + 0) * 72 + t0) = p0; *(LAS v2u*)(VT + (c0 + 1) * 72 + t0) = p1; *(LAS v2u*)(VT + (c0 + 2) * 72 + t0) = p2; *(LAS v2u*)(VT + (c0 + 3) * 72 + t0) = p3; }
        }
        ML_LBAR();
        if (c < 7) { ML_LOADRAW(tok0 + 64); }
        float hval[4][4];
        if (L3) {
            bf16x8 qf[4];
#pragma unroll
            for (int ks = 0; ks < 4; ++ks) qf[ks] = *(const LAS bf16x8*)(Qs + tq * 136 + 32 * ks + 8 * quad);
            f32x4 sacc[4];
#pragma unroll
            for (int st = 0; st < 4; ++st) { f32x4 z = {0.f, 0.f, 0.f, 0.f};
#pragma unroll
                for (int ks = 0; ks < 4; ++ks) z = __builtin_amdgcn_mfma_f32_16x16x32_bf16(*(const LAS bf16x8*)(Ks + (16 * st + c16) * 136 + 32 * ks + 8 * quad), qf[ks], z, 0, 0, 0);
                sacc[st] = z; }
            const float cbt = CB[tq];
#pragma unroll
            for (int st = 0; st < 4; ++st)
#pragma unroll
                for (int j = 0; j < 4; ++j) { const int s = 16 * st + 4 * quad + j; const float d = (s <= tq) ? __expf(cbt + CB[64 + s]) : 0.f; sacc[st][j] *= d; }
            bf16x8 pf[2];
#pragma unroll
            for (int kk = 0; kk < 2; ++kk) { v4u pw; pw.x = pk2(sacc[2 * kk][0], sacc[2 * kk][1]); pw.y = pk2(sacc[2 * kk][2], sacc[2 * kk][3]); pw.z = pk2(sacc[2 * kk + 1][0], sacc[2 * kk + 1][1]); pw.w = pk2(sacc[2 * kk + 1][2], sacc[2 * kk + 1][3]); pf[kk] = __builtin_bit_cast(bf16x8, pw); }
            const float ebt = __expf(cbt);
            f32x4 nn[5];
#pragma unroll
            for (int x = 0; x < 5; ++x) { const int et = (x < 4) ? (4 * eh + x) : 8; f32x4 na = {0.f, 0.f, 0.f, 0.f}, ia = {0.f, 0.f, 0.f, 0.f};
#pragma unroll
                for (int kk = 0; kk < 2; ++kk) { const LAS bf16* vr = VT + (16 * et + c16) * 72 + 32 * kk + 4 * quad; const v2u lo = *(const LAS v2u*)vr, hi = *(const LAS v2u*)(vr + 16); v4u vw; vw.x = lo.x; vw.y = lo.y; vw.z = hi.x; vw.w = hi.y;
                    na = __builtin_amdgcn_mfma_f32_16x16x32_bf16(__builtin_bit_cast(bf16x8, vw), pf[kk], na, 0, 0, 0); }
#pragma unroll
                for (int ks = 0; ks < 4; ++ks) ia = __builtin_amdgcn_mfma_f32_16x16x32_bf16(*(const LAS bf16x8*)(CT + (16 * et + c16) * 136 + 32 * ks + 8 * quad), qf[ks], ia, 0, 0, 0);
                nn[x] = na + ia * ebt; }
            const float den = __shfl(nn[4][0], c16); const float inv = 1.0f / fmaxf(fabsf(den), 1.0f);
            float ss = 0.f;
#pragma unroll
            for (int x = 0; x < 4; ++x)
#pragma unroll
                for (int j = 0; j < 4; ++j) { hval[x][j] = nn[x][j] * inv; ss += hval[x][j] * hval[x][j]; }
            ss += __shfl_xor(ss, 16); ss += __shfl_xor(ss, 32);
            if (quad == 0) RED[eh * 64 + tq] = ss;
            ML_LBAR();
            const float rstd = __builtin_amdgcn_rsqf((RED[tq] + RED[64 + tq]) * (1.0f / 128.0f) + EPS);
#pragma unroll
            for (int x = 0; x < 4; ++x) { const int e = 16 * (4 * eh + x) + 4 * quad; const v2u og = ogv[x];
                const float y0 = hval[x][0] * rstd * NW[e] * bflo(og.x), y1 = hval[x][1] * rstd * NW[e + 1] * bfhi(og.x), y2 = hval[x][2] * rstd * NW[e + 2] * bflo(og.y), y3 = hval[x][3] * rstd * NW[e + 3] * bfhi(og.y);
                v2u o; o.x = pk2(y0, y1); o.y = pk2(y2, y3); *(v2u*)(hm + (size_t)(tok0 + tq) * 512 + hh * 128 + e) = o; }
        }
        { const float ebl = __expf(bl);
          bf16x8 kf[2];
#pragma unroll
          for (int kk = 0; kk < 2; ++kk) kf[kk] = *(const LAS bf16x8*)(KET + (16 * w + c16) * 72 + 32 * kk + 8 * quad);
#pragma unroll
          for (int et = 0; et < 9; ++et) { f32x4 z = cacc[et] * ebl;
#pragma unroll
              for (int kk = 0; kk < 2; ++kk) z = __builtin_amdgcn_mfma_f32_16x16x32_bf16(*(const LAS bf16x8*)(VT + (16 * et + c16) * 72 + 32 * kk + 8 * quad), kf[kk], z, 0, 0, 0);
              cacc[et] = z;
              if (L3) {
#pragma unroll
                  for (int j = 0; j < 4; ++j) CT[(16 * et + 4 * quad + j) * 136 + 16 * w + c16] = (bf16)f2bf(z[j]); } } }
        ML_LBAR();
    }
#undef ML_LOADRAW
#undef ML_LBAR
    if (!L3) {
#pragma unroll
        for (int et = 0; et < 9; ++et)
#pragma unroll
            for (int j = 0; j < 4; ++j) mlc[(16 * et + 4 * quad + j) * 128 + 16 * w + c16] = cacc[et][j];
        if (X.tid == 0) mlb[unit] = bsum;
    }
}
DI void mlstm_scan(const Args& a, const Ctx& X) {
    float* mlc = (float*)(a.ws + WS_MLC); const float* mlb = (const float*)(a.ws + WS_MLB);
    for (int idx = X.bid * 512 + X.tid; idx < 8 * 18432; idx += X.G * 512) { const int seq = idx / 18432, el = idx - seq * 18432; float carry = 0.f;
        float* p0 = mlc + (size_t)seq * 32 * 18432 + el; float v[32], dcy[32];
#pragma unroll
        for (int j = 0; j < 32; ++j) { v[j] = p0[(size_t)j * 18432]; dcy[j] = mlb[seq * 32 + j]; }
#pragma unroll
        for (int j = 0; j < 32; ++j) { p0[(size_t)j * 18432] = carry; carry = __expf(dcy[j]) * carry + v[j]; } }
}

constexpr int P6_WR = 0, P6_AT = 33024, P6_SH = 37120, P6_LG = 41216, P6_HIST = 65536;
DI void p6_norm_route(const Args& a, const Ctx& X, int l, const bf16* xin) {
    unsigned char* ws = a.ws;
    LAS bf16* wrb = (LAS bf16*)(X.lds + P6_WR);
    LAS float* at = (LAS float*)(X.lds + P6_AT); LAS float* sht = (LAS float*)(X.lds + P6_SH);
    LAS float* lg = (LAS float*)(X.lds + P6_LG) + X.wave * 272;
    for (int idx = X.tid; idx < 16384; idx += 512) { const int k = idx >> 4, e = idx & 15; wrb[e * 1032 + k] = (bf16)f2bf(a.router_w[idx]); }
    const float* mod = (const float*)(ws + WS_MOD); unsigned char* hb = (unsigned char*)(ws + WS_H); float* tgate = (float*)(ws + WS_TGATE); int* tokl = (int*)(ws + WS_TOKL);
    const float* ssq = (const float*)(ws + WS_SSQ);
    unsigned* cnt = (unsigned*)(ws + WS_CTL) + CW_CNT + l * 2048;
    LAS int* hist = (LAS int*)(X.lds + P6_HIST); LAS int* cbase = hist + 32;
    int lane = X.lane; asm volatile("" : "+v"(lane));
    const int r = lane & 15, q = lane >> 4;
    const int gw = X.bid * 8 + X.wave, NGW = X.G * 8;
    for (int it = 0; it * NGW < T / 16; ++it) {
        const int rg = it * NGW + gw; const bool act = rg < T / 16;
        const int row0 = (act ? rg : 0) * 16; const int bb = ((it * NGW + X.bid * 8) * 16) >> 14;
        __syncthreads();
        if (X.tid < 32) hist[X.tid] = 0;
        { const float* mb = mod + (size_t)(l * 2 + (bb < 2 ? bb : 1)) * 6144;
          for (int k = X.tid; k < 1024; k += 512) { at[k] = a.nfw[l * D + k] * (1.0f + mb[4 * 1024 + k]); sht[k] = mb[3 * 1024 + k]; } }
        __syncthreads();
        const int row = row0 + r;
        float rstd;
        { const f32x4 pp = *(const f32x4*)(ssq + (size_t)row * 16 + 4 * q); float ss = (pp.x + pp.y) + (pp.z + pp.w); ss += __shfl_xor(ss, 16); ss += __shfl_xor(ss, 32); rstd = __builtin_amdgcn_rsqf(ss * (1.0f / D) + EPS); }
        const bf16* xr = xin + (size_t)row * D + 8 * q; unsigned char* hr = hb + (size_t)row * D + 8 * q;
        f32x4 acc = {0.f, 0.f, 0.f, 0.f};
#pragma unroll 8
        for (int s = 0; s < 32; ++s) {
            const v4u xw = *(const v4u*)(xr + 32 * s); const f32x4 x0 = {bflo(xw.x), bfhi(xw.x), bflo(xw.y), bfhi(xw.y)}, x1 = {bflo(xw.z), bfhi(xw.z), bflo(xw.w), bfhi(xw.w)};
            const f32x4 a0 = *(const LAS f32x4*)(at + 32 * s + 8 * q), a1 = *(const LAS f32x4*)(at + 32 * s + 8 * q + 4);
            const f32x4 s0 = *(const LAS f32x4*)(sht + 32 * s + 8 * q), s1 = *(const LAS f32x4*)(sht + 32 * s + 8 * q + 4);
            const f32x4 h0 = x0 * rstd * a0 + s0, h1 = x1 * rstd * a1 + s1;
            v4u w; w.x = cvt_pk_bf16(h0.x, h0.y); w.y = cvt_pk_bf16(h0.z, h0.w); w.z = cvt_pk_bf16(h1.x, h1.y); w.w = cvt_pk_bf16(h1.z, h1.w);
            { v2u w8; w8.x = pk4_fp8(h0.x, h0.y, h0.z, h0.w); w8.y = pk4_fp8(h1.x, h1.y, h1.z, h1.w); *(v2u*)(hr + 32 * s) = w8; }
            const bf16x8 bfr = *(const LAS bf16x8*)(wrb + r * 1032 + 32 * s + 8 * q);
            acc = __builtin_amdgcn_mfma_f32_16x16x32_bf16(__builtin_bit_cast(bf16x8, w), bfr, acc, 0, 0, 0);
        }
#pragma unroll
        for (int j = 0; j < 4; ++j) lg[(4 * q + j) * 17 + r] = acc[j];
        LDS_WAIT(); asm volatile("" ::: "memory");
        int my_cls = 0; float my_ga = 0.f, my_gb = 0.f;
        if (lane < 16) {
            float sc[16], sel[16];
#pragma unroll
            for (int e = 0; e < 16; ++e) { const float p = lg[lane * 17 + e]; sc[e] = 1.0f / (1.0f + __expf(-p)); sel[e] = sc[e] + a.router_b[e]; }
            int gi = 0; float gbest = -1.0e30f;
#pragma unroll
            for (int g = 0; g < 4; ++g) { const float p0 = sel[4 * g], p1 = sel[4 * g + 1], p2 = sel[4 * g + 2], p3 = sel[4 * g + 3];
                const float gs = fmaxf(fmaxf(fmaxf(p0 + p1, p0 + p2), fmaxf(p0 + p3, p1 + p2)), fmaxf(p1 + p3, p2 + p3));
                if (gs > gbest) { gbest = gs; gi = g; } }
            float qs[4], s4[4];
#pragma unroll
            for (int i = 0; i < 4; ++i) { qs[i] = 0.f; s4[i] = 0.f; }
#pragma unroll
            for (int g = 0; g < 4; ++g) if (g == gi) {
#pragma unroll
                for (int i = 0; i < 4; ++i) { qs[i] = sel[4 * g + i]; s4[i] = sc[4 * g + i]; } }
            int i1 = 0; float b1 = qs[0];
#pragma unroll
            for (int i = 1; i < 4; ++i) if (qs[i] > b1) { b1 = qs[i]; i1 = i; }
            int i2 = -1; float b2 = -1.0e30f;
#pragma unroll
            for (int i = 0; i < 4; ++i) if (i != i1 && qs[i] > b2) { b2 = qs[i]; i2 = i; }
            const int ia = (i1 < i2) ? i1 : i2, ib = (i1 < i2) ? i2 : i1;
            float sa = 0.f, sb = 0.f;
#pragma unroll
            for (int i = 0; i < 4; ++i) { if (i == ia) sa = s4[i]; if (i == ib) sb = s4[i]; }
            const int pidx = (ia == 0) ? (ib - 1) : ((ia == 1) ? (ib + 1) : 5);
            const float inv = 1.0f / (sa + sb);
            my_cls = gi * 6 + pidx; my_ga = sa * inv; my_gb = sb * inv;
        }
        int rank = 0;
        if (act && lane < 16) rank = __hip_atomic_fetch_add(hist + my_cls, 1, __ATOMIC_RELAXED, __HIP_MEMORY_SCOPE_WORKGROUP);
        __syncthreads();
        if (X.tid < NCLS) { const int n = hist[X.tid]; cbase[X.tid] = n ? (int)__hip_atomic_fetch_add(cnt + 64 * X.tid, (unsigned)n, RLX_AGENT) : 0; }
        __syncthreads();
        if (act && lane < 16) { const int tok = row0 + lane; const int pos = cbase[my_cls] + rank;
            tokl[my_cls * CLS_CAP + pos] = tok; tgate[tok * 2] = my_ga; tgate[tok * 2 + 1] = my_gb; }
    }
}
DI MoeTab moe_tables(const Args& a, const Ctx& X, int l) {
    LAS int* tab = (LAS int*)(X.lds + TAB_OFF); LAS int* tcls = tab; LAS int* tpos = tab + 160; LAS int* cn = tab + 320; LAS int* rt_ = tab + 344;
    unsigned* cnt = (unsigned*)(a.ws + WS_CTL) + CW_CNT + l * 2048;
    if (X.tid < NCLS) cn[X.tid] = (int)__hip_atomic_load(cnt + 64 * X.tid, RLX_AGENT);
    __syncthreads();
    if (X.tid == 0) { int r = 0;
#pragma unroll 1
        for (int c = 0; c < NCLS; ++c) { const int n = (cn[c] + 255) >> 8;
#pragma unroll 1
            for (int i = 0; i < n; ++i) { tcls[r] = c; tpos[r] = i * 256; ++r; } }
        rt_[0] = r; }
    __syncthreads();
    MoeTab tb; tb.tcls = tcls; tb.tpos = tpos; tb.cnt = cn; tb.Rtot = __builtin_amdgcn_readfirstlane(rt_[0]); return tb;
}

#if defined(__HIP_DEVICE_COMPILE__)
DI Args load_args() { auto p = __builtin_amdgcn_kernarg_segment_ptr(); asm volatile("" : "+s"(p)); return *(const __attribute__((address_space(4))) Args*)p; }
#else
DI Args load_args() { return Args{}; }
#endif
__global__ void __launch_bounds__(512, 2) fwd(Args a_unused) {
    extern __shared__ __attribute__((aligned(16))) unsigned char lds_raw[];
    Ctx X; X.lds = (LAS unsigned char*)lds_raw; X.tid = threadIdx.x; X.lane = X.tid & 63; X.wave = __builtin_amdgcn_readfirstlane(X.tid >> 6); X.G = gridDim.x; X.bid = blockIdx.x;
    volatile LAS unsigned* MISC = (volatile LAS unsigned*)(X.lds + MISC_OFF);
    if (X.tid < 64) MISC[X.tid] = 0u;
    __syncthreads();
    int lo, hi; unsigned* ctl;
    { const Args a = load_args(); lo = a.ph_lo; hi = a.ph_hi; ctl = (unsigned*)(a.ws + WS_CTL); }
    XcdBarrier bar; bar.bar = ctl + CW_BAR; bar.x = 0; bar.st = MISC + 8;
    if (hi - lo > 1) bar = xcd_barrier_post(ctl + CW_BAR, MISC + 8);
#ifndef PH_MASK
#define PH_MASK 0xFFFFF
#endif
#define PON(p) ((PH_MASK >> (p)) & 1)
#ifndef DUP_MASK
#define DUP_MASK 0
#endif
#define NREP(p) (((DUP_MASK >> (p)) & 1) ? 2 : 1)
#ifndef TSEL_MASK
#define TSEL_MASK 0
#endif
#define TSCALE 4
#define TSEL(p) ((TSEL_MASK >> (p)) & 1)
#define IN(k) (lo <= (k) && (k) < hi)
#define SEAM(k) do { if (IN(k) && IN((k) + 1)) xcd_barrier(bar); } while (0)
    unsigned long long tacc = 0ull, tph = 0ull;
#define TBEG() do { if (TSEL_MASK) tph = __builtin_amdgcn_s_memrealtime(); } while (0)
#define TEND(p) do { if (TSEL(p)) tacc += __builtin_amdgcn_s_memrealtime() - tph; } while (0)
    TBEG();
    if (PON(10) && IN(0)) { for (int rep = 0; rep < NREP(10); ++rep) { const Args a = load_args(); p0_prologue(a, X); } }
    SEAM(0); TEND(10);
    TBEG();
    for (int l = 0; l < NL; ++l) {
        const int g0 = 1 + l * NPH;
        if (PON(0) && IN(g0 + 0)) { for (int rep = 0; rep < NREP(0); ++rep) { const Args a = load_args(); unsigned char* ws = a.ws; const float* mod = (const float*)(ws + WS_MOD); bf16* proj = (bf16*)(ws + WS_PROJ); bf16* xb = (bf16*)(ws + WS_XB); (void)mod; (void)proj; (void)xb; const Ctx P = fresh(X); p1_norm_gates(a, P, l, xb); } }
        SEAM(g0 + 0); TEND(0); TBEG();
        if (PON(1) && IN(g0 + 1)) for (int rep = 0; rep < NREP(1); ++rep) { const Args a = load_args(); unsigned char* ws = a.ws; const float* mod = (const float*)(ws + WS_MOD); bf16* proj = (bf16*)(ws + WS_PROJ); bf16* xb = (bf16*)(ws + WS_XB); (void)mod; (void)proj; (void)xb; const Ctx P = fresh(X);
            DenseSched S; S.A = (const char*)(ws + WS_H); S.Bt = (const char*)(ws + WS_WIN) + (size_t)l * NPROJW * D; S.lda = D; S.ldb = D; S.ord.init(T / 256, NPROJW / 256, P.G, P.bid);
            EpiProj E; E.O = proj; E.gates = (float*)(ws + WS_GATES); E.big = a.b_ig + l * 4; E.bfg = a.b_fg + l * 4;
            pg8::gemm_phase<EpiProj, DenseSched, true>(P.lds, D, S, E);
        }
        SEAM(g0 + 1); TEND(1); TBEG();
        if (PON(2) && IN(g0 + 2)) { const Args a = load_args(); unsigned char* ws = a.ws; const float* mod = (const float*)(ws + WS_MOD); bf16* proj = (bf16*)(ws + WS_PROJ); bf16* xb = (bf16*)(ws + WS_XB); (void)mod; (void)proj; (void)xb; const Ctx P = fresh(X);
            if (PON(11)) for (int rep = 0; rep < NREP(11); ++rep) {
#pragma unroll 1
                for (int u = P.bid; u < 512; u += P.G) attn_unit(a, P, l, u); }
            if (PON(12)) for (int rep = 0; rep < NREP(12); ++rep) {
#pragma unroll 1
                for (int u = P.bid; u < 256; u += P.G) mlstm_unit<false>(a, P, l, u); }
        }
        SEAM(g0 + 2); TEND(2); TBEG();
        if (PON(3) && IN(g0 + 3)) { const Args a = load_args(); unsigned char* ws = a.ws; const float* mod = (const float*)(ws + WS_MOD); bf16* proj = (bf16*)(ws + WS_PROJ); bf16* xb = (bf16*)(ws + WS_XB); (void)mod; (void)proj; (void)xb; const Ctx P = fresh(X); mlstm_scan(a, P); }
        SEAM(g0 + 3); TEND(3); TBEG();
        if (PON(4) && IN(g0 + 4)) for (int rep = 0; rep < NREP(4); ++rep) { const Args a = load_args(); unsigned char* ws = a.ws; const float* mod = (const float*)(ws + WS_MOD); bf16* proj = (bf16*)(ws + WS_PROJ); bf16* xb = (bf16*)(ws + WS_XB); (void)mod; (void)proj; (void)xb; const Ctx P = fresh(X);
#pragma unroll 1
            for (int u = P.bid; u < 256; u += P.G) mlstm_unit<true>(a, P, l, u); }
        SEAM(g0 + 4); TEND(4); TBEG();
        if (PON(5) && IN(g0 + 5)) for (int rep = 0; rep < NREP(5); ++rep) { const Args a = load_args(); unsigned char* ws = a.ws; const float* mod = (const float*)(ws + WS_MOD); bf16* proj = (bf16*)(ws + WS_PROJ); bf16* xb = (bf16*)(ws + WS_XB); (void)mod; (void)proj; (void)xb; const Ctx P = fresh(X);
            MergeSched S; S.A0 = (const char*)(ws + WS_H); S.A1 = (const char*)(ws + WS_H) + (size_t)T * 512 * 2; S.B0 = (const char*)(ws + WS_WAU) + (size_t)l * D * 512 * 2; S.B1 = (const char*)(ws + WS_WMU) + (size_t)l * D * 512 * 2;
            S.lda = 1024; S.ldb = 1024; S.ord.init(T / 256, D / 256, P.G, P.bid);
            EpiMerge E; E.P = proj; pg8::gemm_phase<EpiMerge, MergeSched>(P.lds, 2048, S, E);
        }
        SEAM(g0 + 5); TEND(5); TBEG();
        if (PON(6) && IN(g0 + 6)) for (int rep = 0; rep < NREP(6); ++rep) { const Args a = load_args(); unsigned char* ws = a.ws; const float* mod = (const float*)(ws + WS_MOD); bf16* proj = (bf16*)(ws + WS_PROJ); bf16* xb = (bf16*)(ws + WS_XB); (void)mod; (void)proj; (void)xb; const Ctx P = fresh(X);
            DenseSched S; S.A = (const char*)(proj + C_MQ); S.Bt = (const char*)(ws + WS_WOUT) + (size_t)l * D * D * 2; S.lda = NPROJ * 2; S.ldb = D * 2; S.ord.init(T / 256, D / 256, P.G, P.bid);
            EpiRes E; E.xin = xb; E.out = xb; E.g = mod + (size_t)(l * 2) * 6144 + 2 * 1024; E.ssq = (float*)(ws + WS_SSQ); E.rmask = T - 1;
            if (rep) { E.out = (bf16*)(ws + WS_H); E.rmask = T / 2 - 1; }
            pg8::gemm_phase<EpiRes, DenseSched>(P.lds, D * 2, S, E);
        }
        SEAM(g0 + 6); TEND(6); TBEG();
        if (PON(7) && IN(g0 + 7)) { const Args a = load_args(); unsigned char* ws = a.ws; const float* mod = (const float*)(ws + WS_MOD); bf16* proj = (bf16*)(ws + WS_PROJ); bf16* xb = (bf16*)(ws + WS_XB); (void)mod; (void)proj; (void)xb; const Ctx P = fresh(X); p6_norm_route(a, P, l, xb); }
        SEAM(g0 + 7); TEND(7); TBEG();
        if (PON(8) && IN(g0 + 8)) for (int rep = 0; rep < NREP(8); ++rep) { const Args a = load_args(); unsigned char* ws = a.ws; const float* mod = (const float*)(ws + WS_MOD); bf16* proj = (bf16*)(ws + WS_PROJ); bf16* xb = (bf16*)(ws + WS_XB); (void)mod; (void)proj; (void)xb; const Ctx P = fresh(X);
            const MoeTab tb = moe_tables(a, P, l);
            LAS unsigned* tokoff = (LAS unsigned*)(P.lds + TOKOFF_OFF); const int* tokl = (const int*)(ws + WS_TOKL);
#pragma unroll 1
            for (int s = 0; s < 8; ++s) { const int L0 = s * P.G + P.bid;
                if (L0 < tb.Rtot * 8 && P.tid < 256) { const int L = xcd_remap(L0, tb.Rtot * 8); const int rt = L >> 3, cls = tb.tcls[rt], pos = tb.tpos[rt] + P.tid, cn = tb.cnt[cls]; const int tok = tokl[cls * CLS_CAP + (pos < cn ? pos : 0)]; tokoff[s * 256 + P.tid] = (unsigned)tok; } }
            __syncthreads();
            MoeUpSched S; S.A = (const char*)(ws + WS_H); S.W = (const char*)(ws + WS_WGU) + (size_t)l * NE * 1024 * D; S.lda = D; S.ldb = D; S.tb = tb; S.G = P.G; S.c = P.bid; S.tokoff = tokoff;
            EpiSwiglu E; E.H = proj; E.tgate = (const float*)(ws + WS_TGATE); E.tokoff = tokoff;
            pg8::gemm_phase<EpiSwiglu, MoeUpSched, true>(P.lds, D, S, E);
        }
        SEAM(g0 + 8); TEND(8); TBEG();
        if (PON(9) && IN(g0 + 9)) for (int rep = 0; rep < NREP(9); ++rep) { const Args a = load_args(); unsigned char* ws = a.ws; const float* mod = (const float*)(ws + WS_MOD); bf16* proj = (bf16*)(ws + WS_PROJ); bf16* xb = (bf16*)(ws + WS_XB); (void)mod; (void)proj; (void)xb; const Ctx P = fresh(X);
            const MoeTab tb = moe_tables(a, P, l);
            MoeDownSched S; S.A = (const char*)proj; S.W = (const char*)(ws + WS_WD) + (size_t)l * NE * 1024 * FF * 2; S.lda = D * 2; S.ldb = FF * 2; S.tb = tb; S.G = P.G; S.c = P.bid;
            EpiMoeOut E; E.xin = xb; E.outb = xb; E.outf = a.out; E.last = (l == NL - 1); E.g = mod + (size_t)(l * 2) * 6144 + 5 * 1024; E.tokl = (const int*)(ws + WS_TOKL); E.tb = tb; E.rmask = T - 1;
            if (rep) { E.outb = (bf16*)(ws + WS_H); E.last = 0; E.rmask = T / 2 - 1; }
            pg8::gemm_phase<EpiMoeOut, MoeDownSched>(P.lds, D * 2, S, E);
        }
        SEAM(g0 + 9); TEND(9); TBEG();
    }
    if (TSEL_MASK && X.bid == 0) { const unsigned long long t1 = __builtin_amdgcn_s_memrealtime(); while (__builtin_amdgcn_s_memrealtime() - t1 < TSCALE * tacc) __builtin_amdgcn_s_sleep(8); }
#undef IN
#undef SEAM
}

extern "C" void kernel_launch(void* const* d_in, const int* in_sizes, int n_in, void* d_out, int out_size, void* d_ws, size_t ws_size, hipStream_t stream) {
    static int grid = 0;
    if (grid == 0) {
        if (n_in != 24 || in_sizes[0] != T * D || out_size != T * D || ws_size < WS_END) { fprintf(stderr, "kernel_launch: unexpected shapes / workspace (n_in %d, ws %zu, need %zu)\n", n_in, ws_size, (size_t)WS_END); grid = -1; return; }
        int dev = 0, cus = 0;
        if (hipGetDevice(&dev) != hipSuccess || hipDeviceGetAttribute(&cus, hipDeviceAttributeMultiprocessorCount, dev) != hipSuccess) { grid = -1; return; }
        if (hipFuncSetAttribute((const void*)fwd, hipFuncAttributeMaxDynamicSharedMemorySize, LDS_BYTES) != hipSuccess) { fprintf(stderr, "kernel_launch: hipFuncSetAttribute failed\n"); grid = -1; return; }
        int per_cu = 0;
        if (hipOccupancyMaxActiveBlocksPerMultiprocessor(&per_cu, (const void*)fwd, 512, LDS_BYTES) != hipSuccess || per_cu < 1) fprintf(stderr, "kernel_launch: occupancy query reports %d\n", per_cu);
        (void)hipGetLastError();
        grid = cus < 256 ? cus : 256;
    }
    if (grid < 0) return;
    (void)hipMemsetAsync((char*)d_ws + WS_CTL, 0, CTL_ZERO_BYTES, stream);
    Args a{};
    a.x = (const float*)d_in[0]; a.c = (const float*)d_in[1]; a.pos = (const int*)d_in[2]; a.ada_w = (const float*)d_in[3]; a.ada_b = (const float*)d_in[4];
    a.nmw = (const float*)d_in[5]; a.nfw = (const float*)d_in[6]; a.w_in = (const float*)d_in[7]; a.b_ig = (const float*)d_in[8]; a.b_fg = (const float*)d_in[9];
    a.qnw = (const float*)d_in[10]; a.knw = (const float*)d_in[11]; a.sinks = (const float*)d_in[12]; a.conv_w = (const float*)d_in[13]; a.conv_b = (const float*)d_in[14];
    a.mnw = (const float*)d_in[15]; a.w_au = (const float*)d_in[16]; a.w_mu = (const float*)d_in[17]; a.w_out = (const float*)d_in[18]; a.router_w = (const float*)d_in[19];
    a.router_b = (const float*)d_in[20]; a.w_gate = (const float*)d_in[21]; a.w_up = (const float*)d_in[22]; a.w_down = (const float*)d_in[23];
    a.out = (float*)d_out; a.ws = (unsigned char*)d_ws;
#if MK_MULTI
    for (int gp = 0; gp < NGP; ++gp) { a.ph_lo = gp; a.ph_hi = gp + 1; hipLaunchKernelGGL(fwd, dim3(grid), dim3(512), LDS_BYTES, stream, a); }
#else
    a.ph_lo = 0; a.ph_hi = NGP; hipLaunchKernelGGL(fwd, dim3(grid), dim3(512), LDS_BYTES, stream, a);
#endif
}
```

```cpp
#include <hip/hip_runtime.h>
#include <cstdio>
#include <cstdint>

#ifndef MK_MULTI
#define MK_MULTI 0
#endif

#define GAS __attribute__((address_space(1)))
#define LAS __attribute__((address_space(3)))
typedef unsigned short bf16;
typedef unsigned v4u __attribute__((ext_vector_type(4)));
typedef unsigned v2u __attribute__((ext_vector_type(2)));
typedef float f32x4 __attribute__((ext_vector_type(4)));
typedef float f32x2 __attribute__((ext_vector_type(2)));
typedef short bf16x8 __attribute__((ext_vector_type(8)));
typedef short bf16x4 __attribute__((ext_vector_type(4)));
#define DI __device__ __forceinline__
#define RLX_AGENT __ATOMIC_RELAXED, __HIP_MEMORY_SCOPE_AGENT
#define LDS_WAIT() asm volatile("s_waitcnt lgkmcnt(0)" ::: "memory")
#define VM_WAIT() asm volatile("s_waitcnt vmcnt(0)" ::: "memory")

constexpr int NB = 2, SEQ = 16384, T = NB * SEQ, D = 1024, NL = 4;
constexpr int DIN_SRC = 4872;
constexpr int NPROJ = 4864;
constexpr int C_AQ = 0, C_AK = 512, C_AV = 640, C_MQ = 768, C_MK = 1280, C_MV = 1792, C_MO = 2304, C_GA = 2816, C_GB = 3840;
constexpr int NE = 16, FF = 512;
constexpr int NCLS = 24, CLS_CAP = 32768;
constexpr float EPS = 1e-6f;
constexpr int NPH = 10;
constexpr int NGP = 1 + NL * NPH;

constexpr size_t MiB = 1u << 20;
constexpr size_t WS_CTL = 0, CTL_ZERO_BYTES = 1 * MiB;
constexpr size_t WS_MOD = 1 * MiB;
constexpr size_t WS_ROPE = 2 * MiB;
constexpr size_t WS_GATES = 4 * MiB;
constexpr size_t WS_TGATE = 5 * MiB;
constexpr size_t WS_TOKL = 6 * MiB;
constexpr size_t WS_MLB = 9 * MiB;
constexpr size_t WS_MLC = 10 * MiB;
constexpr int NPROJW = 5120;
constexpr size_t WS_WIN = 28 * MiB;
constexpr size_t WS_WAU = 68 * MiB;
constexpr size_t WS_WMU = 72 * MiB;
constexpr size_t WS_WOUT = 76 * MiB;
constexpr size_t WS_WGU = 84 * MiB;
constexpr size_t WS_WD = 148 * MiB;
constexpr size_t WS_H = 212 * MiB;
constexpr size_t WS_PROJ = 276 * MiB;
constexpr size_t WS_SSQ = 580 * MiB;
constexpr size_t WS_KC = 582 * MiB;
constexpr size_t WS_XB = 614 * MiB;
constexpr size_t WS_END = 678 * MiB;

constexpr int CW_TMO = 0;
constexpr int CW_BAR = 4096;
constexpr int CW_CNT = 8192;

constexpr int RING_BYTES = 131072;
constexpr int MISC_OFF = RING_BYTES;
constexpr int TAB_OFF = RING_BYTES + 256;
constexpr int TOKOFF_OFF = RING_BYTES + 2048;
constexpr int LDS_BYTES = 147456;

typedef __bf16 bf16x2_t __attribute__((ext_vector_type(2)));
DI unsigned cvt_pk_bf16(float lo, float hi) { const f32x2 v = {lo, hi}; return __builtin_bit_cast(unsigned, __builtin_convertvector(v, bf16x2_t)); }
DI unsigned pk2m(float lo, float hi) { return cvt_pk_bf16(lo, hi); }
DI unsigned f2bf(float f) { return cvt_pk_bf16(f, 0.f) & 0xffffu; }
DI unsigned pk2(float lo, float hi) { return cvt_pk_bf16(lo, hi); }
DI float bf2f(unsigned short b) { return __builtin_bit_cast(float, ((unsigned)b) << 16); }
DI float bflo(unsigned w) { return __builtin_bit_cast(float, w << 16); }
DI float bfhi(unsigned w) { return __builtin_bit_cast(float, w & 0xffff0000u); }
DI float wave_sum(float v) {
#pragma unroll
    for (int o = 1; o < 64; o <<= 1) v += __shfl_xor(v, o);
    return v;
}
DI float sigmoidf_(float x) { return __builtin_amdgcn_rcpf(1.0f + __expf(-x)); }

#define XB_TMO      128
#define XB_XCNT(j)  (256  + 64 * (j))
#define XB_XSUB(j)  (1280 + 64 * (j))
#define XB_XGEN(j)  (2304 + 64 * (j))
#define XB_TOP      3328
#define XB_TOPGEN   3392
#define XCD_BAR_WORDS 3456
#define XB_SPIN_CAP (1u << 18)
__device__ __forceinline__ unsigned xb_ld(unsigned* p)              { return __hip_atomic_load(p, __ATOMIC_RELAXED, __HIP_MEMORY_SCOPE_AGENT); }
__device__ __forceinline__ unsigned xb_add(unsigned* p, unsigned v) { return __hip_atomic_fetch_add(p, v, __ATOMIC_RELAXED, __HIP_MEMORY_SCOPE_AGENT); }
__device__ __forceinline__ unsigned xb_xcc_id() { return (unsigned)__builtin_amdgcn_s_getreg((3 << 11) | 20) & 0xFu; }
#define XB_SPIN(cond, bar) do { unsigned _sp = 0; while (cond) { __builtin_amdgcn_s_sleep(1); \
    if ((++_sp & 255u) == 0u) { if (xb_ld(&(bar)[XB_TMO])) break; if (_sp > XB_SPIN_CAP) { atomicAdd(&(bar)[XB_TMO], 1u); break; } } } } while (0)
struct XcdBarrier { unsigned* bar; unsigned x; volatile LAS unsigned* st; };
__device__ __forceinline__ XcdBarrier xcd_barrier_post(unsigned* bar, volatile LAS unsigned* st) {
    XcdBarrier b; b.bar = bar; b.x = xb_xcc_id(); b.st = st;
    if (threadIdx.x == 0) (void)xb_add(&bar[XB_XCNT(b.x)], 1u);
    return b;
}
__device__ __forceinline__ void xcd_barrier_complete(unsigned* bar, unsigned x, unsigned& nloc, unsigned& nx) {
    const unsigned G = gridDim.x * gridDim.y * gridDim.z;
    unsigned sum, cnt, mine, sp = 0u;
    for (;;) {
        sum = 0u; cnt = 0u; mine = 0u;
#pragma unroll
        for (unsigned j = 0; j < 16; ++j) { const unsigned c = xb_ld(&bar[XB_XCNT(j)]); sum += c; cnt += (c > 0u) ? 1u : 0u; mine = (j == x) ? c : mine; }
        if (sum == G) break;
        __builtin_amdgcn_s_sleep(1);
        if ((++sp & 255u) == 0u) { if (xb_ld(&bar[XB_TMO])) break; if (sp > XB_SPIN_CAP) { atomicAdd(&bar[XB_TMO], 1u); break; } }
    }
    nloc = mine > 0u ? mine : 1u; nx = cnt > 0u ? cnt : 1u;
}
__device__ __forceinline__ void xcd_barrier(const XcdBarrier& b) {
    asm volatile("s_waitcnt vmcnt(0)" ::: "memory");
    __syncthreads();
    if (threadIdx.x == 0) {
        unsigned* bar = b.bar;
        __builtin_amdgcn_s_waitcnt(0);
        unsigned nloc = b.st[0], nx = b.st[1];
        if (nloc == 0u) { xcd_barrier_complete(bar, b.x, nloc, nx); b.st[0] = nloc; b.st[1] = nx; }
        const unsigned old = xb_add(&bar[XB_XSUB(b.x)], 1u);
        const unsigned gen = old / nloc;
        if (old + 1u == (gen + 1u) * nloc) {
            __builtin_amdgcn_fence(__ATOMIC_RELEASE, "agent");
            asm volatile("s_waitcnt vmcnt(0)" ::: "memory");
            const unsigned og = xb_add(&bar[XB_TOP], 1u);
            const unsigned tg = og / nx;
            if (og + 1u == (tg + 1u) * nx) xb_add(&bar[XB_TOPGEN], 1u);
            else XB_SPIN(xb_ld(&bar[XB_TOPGEN]) == tg, bar);
            __builtin_amdgcn_fence(__ATOMIC_ACQUIRE, "agent");
            xb_add(&bar[XB_XGEN(b.x)], 1u);
            asm volatile("s_waitcnt vmcnt(0)" ::: "memory");
        } else {
            XB_SPIN(xb_ld(&bar[XB_XGEN(b.x)]) == gen, bar);
            __builtin_amdgcn_fence(__ATOMIC_ACQUIRE, "agent");
            asm volatile("s_waitcnt vmcnt(0)" ::: "memory");
        }
    }
    __syncthreads();
}

namespace pg8 {
constexpr int BM = 256, BK = 64, HALF = 128, HTB = HALF * BK * 2, STAGE_BYTES = 8 * HTB, NXCD = 8, WGM = 8;
__host__ __device__ __forceinline__ int lds_byte(int r, int c) { const int st = (r >> 4) * 2 + (c >> 5), rr = r & 15, cc = c & 31, ob = rr * 64 + cc * 2; return st * 1024 + (ob ^ (((ob >> 9) & 1) << 5)); }
__host__ __device__ __forceinline__ void stage_rc(int b, int& R, int& C) { const int st = b / 1024, sb = b % 1024, swz = sb ^ (((sb >> 9) & 1) << 5); R = (st >> 1) * 16 + swz / 64; C = (st & 1) * 32 + (swz % 64) / 2; }
__host__ __device__ __forceinline__ int perm32(int rho) { const int n = rho >> 4, i = rho & 15; return 8 * (i >> 2) + 4 * n + (i & 3); }

struct Unit { int pm, pn, x0, x1; };

struct TileOrder {
    int nM, nN, nwg, G, c;
    __device__ void init(int nM_, int nN_, int G_, int c_) { nM = nM_; nN = nN_; nwg = nM * nN; G = G_; c = c_; }
    __device__ bool get(int i, int& pm, int& pn) const {
        const long L = (long)i * G + c; if (L >= nwg) return false;
        int wgid = (int)L; { const int q = nwg / NXCD, r = nwg % NXCD, xcd = wgid % NXCD, off = wgid / NXCD; wgid = (xcd < r ? xcd * (q + 1) : r * (q + 1) + (xcd - r) * q) + off; }
        const int nig = WGM * nN, gid = wgid / nig, fm = gid * WGM, gsz = (nM - fm) < WGM ? (nM - fm) : WGM;
        pm = fm + ((wgid % nig) % gsz); pn = (wgid % nig) / gsz; return true;
    }
};

typedef int v8i __attribute__((ext_vector_type(8)));
template <class Epi, class Sched, bool F8 = false>
__device__ __forceinline__ void gemm_phase(LAS unsigned char* lds, const int Kb, const Sched& S, const Epi& E) {
    int tid = threadIdx.x; asm volatile("" : "+v"(tid));
    const int wid = __builtin_amdgcn_readfirstlane(tid >> 6), lane = tid & 63, wr = wid >> 2, wc = wid & 3, fr = lane & 15, fq = lane >> 4;
    const int nt = Kb / 128;
    constexpr bool GA = Sched::GATHER; constexpr int KS = Sched::KSPLIT; constexpr bool ASPLIT = Sched::ASPLIT;
    unsigned voffA[2], voffB[2]; int Rst[2], Cst[2];
#pragma unroll
    for (int i = 0; i < 2; ++i) { int R, C; stage_rc(tid * 16 + i * 8192, R, C); const int Rb = Epi::PERM ? ((R & ~31) + perm32(R & 31)) : R;
        voffA[i] = (unsigned)(R * S.lda + C * 2); voffB[i] = (unsigned)(Rb * S.ldb + C * 2); Rst[i] = R; Cst[i] = C; }
    const size_t kstep = (size_t)(BK * 2);
    const size_t hstepA = (size_t)HALF * S.lda, hstepB = (size_t)HALF * S.ldb;
    const unsigned ldsw = (unsigned)wid * 1024u; const unsigned gmul = (unsigned)S.lda;
    const int aoff = F8 ? (lds_byte(wr * 64 + fr, (fq & 1) * 16) + (fq >> 1) * 1024) : lds_byte(wr * 64 + fr, fq * 8);
    const int boff = F8 ? (lds_byte(wc * 32 + fr, (fq & 1) * 16) + (fq >> 1) * 1024) : lds_byte(wc * 32 + fr, fq * 8);
    unsigned vAc[2], vAn[2];
#define PG8_SA(b, h) (((b) * 2 + (h)) * HTB)
#define PG8_SB(b, h) ((4 + (b) * 2 + (h)) * HTB)
#define PG8_STAGE2(bufoff, gbase, v0, v1) do { \
        __builtin_amdgcn_global_load_lds((const unsigned*)((const char*)(gbase) + (v0)), (LAS unsigned*)(lds + (bufoff) + ldsw), 16, 0, 0); \
        __builtin_amdgcn_global_load_lds((const unsigned*)((const char*)(gbase) + (v1)), (LAS unsigned*)(lds + (bufoff) + ldsw + 8192), 16, 0, 0); } while (0)
#define PG8_STAGE_B(bufoff, ptr, h) PG8_STAGE2(bufoff, (ptr) + (h) * hstepB, voffB[0], voffB[1])
#define PG8_STAGE_A(bufoff, ptr, h, nx) do { if constexpr (GA) { const unsigned _p = (nx) ? vAn[h] : vAc[h]; PG8_STAGE2(bufoff, ptr, (_p & 0xffffu) * gmul + (unsigned)Cst[0] * 2u, (_p >> 16) * gmul + (unsigned)Cst[0] * 2u); } \
        else { PG8_STAGE2(bufoff, (ptr) + (h) * hstepA, voffA[0], voffA[1]); } } while (0)
    typedef int v4i_ __attribute__((ext_vector_type(4)));
#define PG8_LDA(dst, b, h) do { _Pragma("unroll") for (int m = 0; m < 4; ++m) { if constexpr (F8) { dst##8[m].lo = *(const LAS v4i_*)(lds + PG8_SA(b, h) + aoff + m * 2048); dst##8[m].hi = *(const LAS v4i_*)(lds + PG8_SA(b, h) + aoff + m * 2048 + 16); } \
        else { _Pragma("unroll") for (int k = 0; k < 2; ++k) dst[m][k] = *(const LAS bf16x8*)(lds + PG8_SA(b, h) + aoff + m * 2048 + k * 1024); } } } while (0)
#define PG8_LDB(dst, b, h) do { _Pragma("unroll") for (int n = 0; n < 2; ++n) { if constexpr (F8) { dst##8[n].lo = *(const LAS v4i_*)(lds + PG8_SB(b, h) + boff + n * 2048); dst##8[n].hi = *(const LAS v4i_*)(lds + PG8_SB(b, h) + boff + n * 2048 + 16); } \
        else { _Pragma("unroll") for (int k = 0; k < 2; ++k) dst[n][k] = *(const LAS bf16x8*)(lds + PG8_SB(b, h) + boff + n * 2048 + k * 1024); } } } while (0)
#define PG8_MMA(ai, bj, At, Bt) do { __builtin_amdgcn_s_setprio(1); _Pragma("unroll") for (int m = 0; m < 4; ++m) _Pragma("unroll") for (int n = 0; n < 2; ++n) { \
        if constexpr (F8) { asm volatile("v_mfma_scale_f32_16x16x128_f8f6f4 %0, %1, %2, %0, %3, %3 op_sel_hi:[0,0,0]" : "+v"(acc[ai][bj][m][n]) : "v"(Bt##8[n]), "v"(At##8[m]), "v"(f8scale)); } \
        else { _Pragma("unroll") for (int k = 0; k < 2; ++k) acc[ai][bj][m][n] = __builtin_amdgcn_mfma_f32_16x16x32_bf16(Bt[n][k], At[m][k], acc[ai][bj][m][n], 0, 0, 0); } } \
        __builtin_amdgcn_s_setprio(0); } while (0)
#define PG8_WAIT_V(n) asm volatile("s_waitcnt vmcnt(" #n ")" ::: "memory")
#define PG8_WAIT_L(n) asm volatile("s_waitcnt lgkmcnt(" #n ")" ::: "memory")
#define PG8_BAR __builtin_amdgcn_s_barrier()
#define PG8_SCHED __builtin_amdgcn_sched_barrier(0)
#define PG8_GOFF(dst, u) do { if constexpr (GA) { _Pragma("unroll") for (int h = 0; h < 2; ++h) dst[h] = S.a_rowoff(u, Rst[0] + HALF * h) | (S.a_rowoff(u, Rst[0] + 64 + HALF * h) << 16); } } while (0)
    Unit cur, nxt; int ui = 0;
    if (!S.next(0, cur)) return;
    f32x4 acc[2][2][4][2];
#pragma unroll
    for (int a = 0; a < 2; ++a)
#pragma unroll
        for (int b = 0; b < 2; ++b)
#pragma unroll
            for (int m = 0; m < 4; ++m)
#pragma unroll
                for (int n = 0; n < 2; ++n) acc[a][b][m][n] = (f32x4){0.f, 0.f, 0.f, 0.f};
    int f8scale = 0x7F7F7F7F; asm volatile("" : "+v"(f8scale));
    bf16x8 At[4][2], B0[2][2], B1[2][2]; v8i At8[4], B08[2], B18[2];
    const char* cA = S.a_base(cur, 0); const char* cA1 = ASPLIT ? S.a_base(cur, 1) : cA; const char* cB0 = S.b_base(cur, 0); const char* cB1 = KS ? S.b_base(cur, 1) : cB0;
    PG8_GOFF(vAc, cur);
    vAn[0] = vAc[0]; vAn[1] = vAc[1];
    PG8_STAGE_B(PG8_SB(0, 0), cB0, 0); PG8_STAGE_B(PG8_SB(0, 1), cB0, 1); PG8_STAGE_A(PG8_SA(0, 0), cA, 0, false); PG8_STAGE_A(PG8_SA(0, 1), cA, 1, false);
    if (wr == 1) PG8_BAR;
    PG8_WAIT_V(2); PG8_BAR;
    PG8_STAGE_B(PG8_SB(1, 0), cB0 + kstep, 0); PG8_STAGE_A(PG8_SA(1, 0), cA + kstep, 0, false); PG8_STAGE_B(PG8_SB(1, 1), cB0 + kstep, 1);
    PG8_WAIT_V(6); PG8_BAR;
    for (;;) {
        const bool has_next = S.next(ui + 1, nxt);
        const char* nA = has_next ? S.a_base(nxt, 0) : cA; const char* nA1 = (ASPLIT && has_next) ? S.a_base(nxt, 1) : (ASPLIT ? cA1 : nA); const char* nB0 = has_next ? S.b_base(nxt, 0) : cB0; const char* nB1 = (KS && has_next) ? S.b_base(nxt, 1) : (KS ? cB1 : nB0);
        if constexpr (GA) { if (has_next) { PG8_GOFF(vAn, nxt); } }
#pragma unroll 1
        for (int t = 0; t < nt; t += 2) {
            const bool last = (t == nt - 2);
            const char* a1 = (ASPLIT && (t + 1) >= KS) ? cA1 + (size_t)(t + 1 - KS) * kstep : cA + (size_t)(t + 1) * kstep;
            const char* a2 = last ? nA : ((ASPLIT && (t + 2) >= KS) ? cA1 + (size_t)(t + 2 - KS) * kstep : cA + (size_t)(t + 2) * kstep);
            if constexpr (Epi::MID) { if (t == KS) { int fr_ = fr, fq_ = fq; asm volatile("" : "+v"(fr_), "+v"(fq_)); E.mid(acc, cur, wr, wc, fr_, fq_); } }
            const char* b2 = last ? nB0 : ((KS && (t + 2) >= KS) ? cB1 + (size_t)(t + 2 - KS) * kstep : cB0 + (size_t)(t + 2) * kstep);
            const char* a3 = a2 + kstep; const char* b3 = b2 + kstep;
            PG8_LDB(B0, 0, 0); PG8_LDB(B1, 0, 1); PG8_SCHED; PG8_LDA(At, 0, 0); PG8_STAGE_A(PG8_SA(1, 1), a1, 1, false);
            PG8_WAIT_V(8); PG8_WAIT_L(0); PG8_BAR; PG8_MMA(0, 0, At, B0); PG8_MMA(0, 1, At, B1); PG8_BAR; PG8_SCHED;
            PG8_LDA(At, 0, 1); PG8_STAGE_B(PG8_SB(0, 0), b2, 0); PG8_STAGE_B(PG8_SB(0, 1), b2, 1); PG8_STAGE_A(PG8_SA(0, 0), a2, 0, last);
            PG8_WAIT_V(8); PG8_WAIT_L(0); PG8_BAR; PG8_MMA(1, 0, At, B0); PG8_MMA(1, 1, At, B1); PG8_BAR; PG8_SCHED;
            PG8_LDB(B0, 1, 0); PG8_LDB(B1, 1, 1); PG8_SCHED; PG8_LDA(At, 1, 0); PG8_STAGE_A(PG8_SA(0, 1), a2, 1, last);
            PG8_WAIT_V(8); PG8_WAIT_L(0); PG8_BAR; PG8_MMA(0, 0, At, B0); PG8_MMA(0, 1, At, B1); PG8_BAR; PG8_SCHED;
            PG8_LDA(At, 1, 1); PG8_STAGE_B(PG8_SB(1, 0), b3, 0); PG8_STAGE_B(PG8_SB(1, 1), b3, 1); PG8_STAGE_A(PG8_SA(1, 0), a3, 0, last);
            PG8_WAIT_V(8); PG8_WAIT_L(0); PG8_BAR; PG8_MMA(1, 0, At, B0); PG8_MMA(1, 1, At, B1); PG8_BAR; PG8_SCHED;
        }
        if (wr == 0) PG8_BAR;
        if constexpr (F8) { asm volatile("s_nop 15\n\ts_nop 15" ::: "memory"); }
        { int fr_ = fr, fq_ = fq; asm volatile("" : "+v"(fr_), "+v"(fq_));
          E(acc, cur, wr, wc, fr_, fq_); }
        if (!has_next) break;
#pragma unroll
        for (int a = 0; a < 2; ++a)
#pragma unroll
            for (int b = 0; b < 2; ++b)
#pragma unroll
                for (int m = 0; m < 4; ++m)
#pragma unroll
                    for (int n = 0; n < 2; ++n) acc[a][b][m][n] = (f32x4){0.f, 0.f, 0.f, 0.f};
        cur = nxt; cA = nA; cA1 = nA1; cB0 = nB0; cB1 = nB1; ++ui;
        vAc[0] = vAn[0]; vAc[1] = vAn[1];
        if (wr == 1) PG8_BAR;
    }
    PG8_WAIT_V(0);
    PG8_BAR;
#undef PG8_SA
#undef PG8_SB
#undef PG8_STAGE2
#undef PG8_STAGE_A
#undef PG8_STAGE_B
#undef PG8_LDA
#undef PG8_LDB
#undef PG8_MMA
#undef PG8_WAIT_V
#undef PG8_WAIT_L
#undef PG8_BAR
#undef PG8_SCHED
#undef PG8_GOFF
}
}
using pg8::Unit;


struct Args {
    const float* x; const float* c; const int* pos; const float* ada_w; const float* ada_b; const float* nmw; const float* nfw; const float* w_in;
    const float* b_ig; const float* b_fg; const float* qnw; const float* knw; const float* sinks; const float* conv_w; const float* conv_b; const float* mnw;
    const float* w_au; const float* w_mu; const float* w_out; const float* router_w; const float* router_b; const float* w_gate; const float* w_up; const float* w_down;
    float* out; unsigned char* ws; int ph_lo, ph_hi;
};

__constant__ float c_invf[8] = {1.0f, 0.1939227432012558f, 0.03760603070259094f, 0.007292664609849453f, 0.0014142135623842478f, 0.00027424818836152554f, 5.3182957344688475e-05f, 1.0313385246263351e-05f};

struct DenseSched {
    static constexpr bool GATHER = false, ASPLIT = false; static constexpr int KSPLIT = 0;
    const char* A; const char* Bt; int lda, ldb; pg8::TileOrder ord;
    DI bool next(int i, Unit& u) const { int pm, pn; if (!ord.get(i, pm, pn)) return false; u.pm = pm; u.pn = pn; u.x0 = 0; u.x1 = 0; return true; }
    DI const char* a_base(const Unit& u, int) const { return A + (size_t)u.pm * 256 * lda; }
    DI const char* b_base(const Unit& u, int) const { return Bt + (size_t)u.pn * 256 * ldb; }
    DI unsigned a_rowoff(const Unit&, int) const { return 0u; }
};
struct EpiProj {
    static constexpr bool PERM = true, MID = false;
    bf16* O; float* gates; const float* big; const float* bfg;
    DI void operator()(const f32x4 (&acc)[2][2][4][2], const Unit& u, int wr, int wc, int fr, int fq) const {
        const int row0 = u.pm * 256 + wr * 64 + fr, col0 = u.pn * 256 + wc * 32 + 8 * fq; const bool sg = u.pn >= 9; constexpr float WSC = 1.0f / 64.0f;
        if (u.pn == 19) {
            if (wc == 0 && fq == 0) {
#pragma unroll
                for (int ai = 0; ai < 2; ++ai)
#pragma unroll
                    for (int m = 0; m < 4; ++m) { const int row = row0 + ai * 128 + m * 16; const f32x4 vi = acc[ai][0][m][0], vf = acc[ai][0][m][1]; f32x4 oi, of;
#pragma unroll
                        for (int j = 0; j < 4; ++j) { oi[j] = vi[j] * WSC + big[j]; const float z = vf[j] * WSC + bfg[j]; of[j] = fminf(z, 0.f) - log1pf(__expf(-fabsf(z))); }
                        *(f32x4*)(gates + (size_t)row * 8) = oi; *(f32x4*)(gates + (size_t)row * 8 + 4) = of; } }
            return; }
#pragma unroll
        for (int ai = 0; ai < 2; ++ai)
#pragma unroll
            for (int m = 0; m < 4; ++m) { bf16* rowp = O + (size_t)(row0 + ai * 128 + m * 16) * NPROJ + col0;
#pragma unroll
                for (int bj = 0; bj < 2; ++bj) { f32x4 v0 = acc[ai][bj][m][0] * WSC, v1 = acc[ai][bj][m][1] * WSC;
                    if (sg) {
#pragma unroll
                        for (int j = 0; j < 4; ++j) { v0[j] = sigmoidf_(v0[j]); v1[j] = sigmoidf_(v1[j]); } }
                    v4u w; w.x = cvt_pk_bf16(v0[0], v0[1]); w.y = cvt_pk_bf16(v0[2], v0[3]); w.z = cvt_pk_bf16(v1[0], v1[1]); w.w = cvt_pk_bf16(v1[2], v1[3]);
                    *(v4u*)(rowp + bj * 128) = w; } }
    }
};
struct MergeSched {
    static constexpr bool GATHER = false, ASPLIT = true; static constexpr int KSPLIT = 8;
    const char* A0; const char* A1; const char* B0; const char* B1; int lda, ldb; pg8::TileOrder ord;
    DI bool next(int i, Unit& u) const { int pm, pn; if (!ord.get(i, pm, pn)) return false; u.pm = pm; u.pn = pn; u.x0 = 0; u.x1 = 0; return true; }
    DI const char* a_base(const Unit& u, int half) const { return (half ? A1 : A0) + (size_t)u.pm * 256 * lda; }
    DI const char* b_base(const Unit& u, int half) const { return (half ? B1 : B0) + (size_t)u.pn * 256 * ldb; }
    DI unsigned a_rowoff(const Unit&, int) const { return 0u; }
};
struct EpiMerge {
    static constexpr bool PERM = true, MID = true;
    bf16* P;
    DI void mid(f32x4 (&acc)[2][2][4][2], const Unit& u, int wr, int wc, int fr, int fq) const {
        const int row0 = u.pm * 256 + wr * 64 + fr, col0 = u.pn * 256 + wc * 32 + 8 * fq;
#pragma unroll
        for (int ai = 0; ai < 2; ++ai)
#pragma unroll
            for (int m = 0; m < 4; ++m) { const bf16* rowp = P + (size_t)(row0 + ai * 128 + m * 16) * NPROJ + col0;
#pragma unroll
                for (int bj = 0; bj < 2; ++bj) { const v4u ga = *(const v4u*)(rowp + C_GA + bj * 128), gb = *(const v4u*)(rowp + C_GB + bj * 128);
                    f32x4 r0, r1;
                    r0[0] = bflo(ga.x) * __builtin_amdgcn_rcpf(fmaxf(bflo(gb.x), 1e-30f)); r0[1] = bfhi(ga.x) * __builtin_amdgcn_rcpf(fmaxf(bfhi(gb.x), 1e-30f));
                    r0[2] = bflo(ga.y) * __builtin_amdgcn_rcpf(fmaxf(bflo(gb.y), 1e-30f)); r0[3] = bfhi(ga.y) * __builtin_amdgcn_rcpf(fmaxf(bfhi(gb.y), 1e-30f));
                    r1[0] = bflo(ga.z) * __builtin_amdgcn_rcpf(fmaxf(bflo(gb.z), 1e-30f)); r1[1] = bfhi(ga.z) * __builtin_amdgcn_rcpf(fmaxf(bfhi(gb.z), 1e-30f));
                    r1[2] = bflo(ga.w) * __builtin_amdgcn_rcpf(fmaxf(bflo(gb.w), 1e-30f)); r1[3] = bfhi(ga.w) * __builtin_amdgcn_rcpf(fmaxf(bfhi(gb.w), 1e-30f));
                    acc[ai][bj][m][0] *= r0; acc[ai][bj][m][1] *= r1; } }
    }
    DI void operator()(const f32x4 (&acc)[2][2][4][2], const Unit& u, int wr, int wc, int fr, int fq) const {
        const int row0 = u.pm * 256 + wr * 64 + fr, col0 = u.pn * 256 + wc * 32 + 8 * fq;
#pragma unroll
        for (int ai = 0; ai < 2; ++ai)
#pragma unroll
            for (int m = 0; m < 4; ++m) { bf16* rowp = P + (size_t)(row0 + ai * 128 + m * 16) * NPROJ + col0;
#pragma unroll
                for (int bj = 0; bj < 2; ++bj) { const f32x4 v0 = acc[ai][bj][m][0], v1 = acc[ai][bj][m][1];
                    const v4u g = *(const v4u*)(rowp + C_GB + bj * 128);
                    v4u w; w.x = cvt_pk_bf16(bflo(g.x) * v0[0], bfhi(g.x) * v0[1]); w.y = cvt_pk_bf16(bflo(g.y) * v0[2], bfhi(g.y) * v0[3]); w.z = cvt_pk_bf16(bflo(g.z) * v1[0], bfhi(g.z) * v1[1]); w.w = cvt_pk_bf16(bflo(g.w) * v1[2], bfhi(g.w) * v1[3]);
                    *(v4u*)(rowp + C_MQ + bj * 128) = w; } }
    }
};
struct EpiRes {
    static constexpr bool PERM = false, MID = false;
    const bf16* xin; bf16* out; const float* g; float* ssq; int rmask;
    DI void operator()(const f32x4 (&acc)[2][2][4][2], const Unit& u, int wr, int wc, int fr, int fq) const {
        const int row0 = u.pm * 256 + wr * 64 + fr, col0 = u.pn * 256 + wc * 32 + 4 * fq; const int b = (u.pm * 256) >> 14;
        f32x4 gv[2][2];
#pragma unroll
        for (int bj = 0; bj < 2; ++bj)
#pragma unroll
            for (int n = 0; n < 2; ++n) gv[bj][n] = *(const f32x4*)(g + b * 6144 + col0 + bj * 128 + n * 16);
#pragma unroll
        for (int ai = 0; ai < 2; ++ai)
#pragma unroll
            for (int m = 0; m < 4; ++m) { const size_t off = (size_t)(row0 + ai * 128 + m * 16) * D + col0; const size_t offo = (size_t)((row0 + ai * 128 + m * 16) & rmask) * D + col0; float sq = 0.f;
#pragma unroll
                for (int bj = 0; bj < 2; ++bj)
#pragma unroll
                    for (int n = 0; n < 2; ++n) { const v2u xw = *(const v2u*)(xin + off + bj * 128 + n * 16); const f32x4 xv = {bflo(xw.x), bfhi(xw.x), bflo(xw.y), bfhi(xw.y)}; const f32x4 o = xv + gv[bj][n] * acc[ai][bj][m][n];
                        v2u ow; ow.x = cvt_pk_bf16(o.x, o.y); ow.y = cvt_pk_bf16(o.z, o.w); const float r0 = bflo(ow.x), r1 = bfhi(ow.x), r2 = bflo(ow.y), r3 = bfhi(ow.y);
                        sq += (r0 * r0 + r1 * r1) + (r2 * r2 + r3 * r3);
                        *(v2u*)(out + offo + bj * 128 + n * 16) = ow; }
                sq += __shfl_xor(sq, 16); sq += __shfl_xor(sq, 32);
                if (fq == 0) ssq[(size_t)(row0 + ai * 128 + m * 16) * 16 + u.pn * 4 + wc] = sq; }
    }
};

struct MoeTab { const LAS int* tcls; const LAS int* tpos; const LAS int* cnt; int Rtot; };
DI int xcd_remap(int L, int nwg) { const int q = nwg >> 3, r = nwg & 7, xcd = L & 7, off = L >> 3; return (xcd < r ? xcd * (q + 1) : r * (q + 1) + (xcd - r) * q) + off; }
DI void cls_experts(int cls, int& ea, int& eb) { const int g = cls / 6, p = cls - 6 * g; const int a = (p < 3) ? 0 : ((p < 5) ? 1 : 2); const int b = (p < 3) ? (p + 1) : ((p < 5) ? (p - 1) : 3); ea = 4 * g + a; eb = 4 * g + b; }
struct MoeUpSched {
    static constexpr bool GATHER = true, ASPLIT = false; static constexpr int KSPLIT = 0;
    const char* A; const char* W; int lda, ldb; MoeTab tb; int G, c; const LAS unsigned* tokoff;
    DI bool next(int i, Unit& u) const { const int L0 = i * G + c; if (L0 >= tb.Rtot * 8) return false; const int L = xcd_remap(L0, tb.Rtot * 8); u.pm = L >> 3; u.pn = L & 7; u.x0 = i; u.x1 = __builtin_amdgcn_readfirstlane(tb.tcls[u.pm]); return true; }
    DI const char* a_base(const Unit&, int) const { return A; }
    DI const char* b_base(const Unit& u, int) const { int ea, eb; cls_experts(u.x1, ea, eb); const int e = (u.pn < 4) ? ea : eb; return W + ((size_t)e * 1024 + (size_t)(u.pn & 3) * 256) * ldb; }
    DI unsigned a_rowoff(const Unit& u, int r) const { return tokoff[u.x0 * 256 + r]; }
};
struct EpiSwiglu {
    static constexpr bool PERM = true, MID = false;
    bf16* H; const float* tgate; const LAS unsigned* tokoff;
    DI void operator()(const f32x4 (&acc)[2][2][4][2], const Unit& u, int wr, int wc, int fr, int fq) const {
        const int r0 = wr * 64 + fr; const int hc = (u.pn >> 2) * 512 + (u.pn & 3) * 128 + wc * 32 + 8 * fq; const int gsel = u.pn >> 2;
#pragma unroll
        for (int ai = 0; ai < 2; ++ai)
#pragma unroll
            for (int m = 0; m < 4; ++m) { const int r = r0 + ai * 128 + m * 16; const unsigned tok = tokoff[u.x0 * 256 + r]; const float rg = tgate[tok * 2 + gsel];
                const f32x4 g0 = acc[ai][0][m][0] * (1.0f / 64.0f), g1 = acc[ai][0][m][1] * (1.0f / 64.0f), u0 = acc[ai][1][m][0] * (1.0f / 64.0f), u1 = acc[ai][1][m][1] * (1.0f / 64.0f);
                float o[8];
#pragma unroll
                for (int j = 0; j < 4; ++j) { o[j] = g0[j] * sigmoidf_(g0[j]) * u0[j] * rg; o[4 + j] = g1[j] * sigmoidf_(g1[j]) * u1[j] * rg; }
                v4u w; w.x = cvt_pk_bf16(o[0], o[1]); w.y = cvt_pk_bf16(o[2], o[3]); w.z = cvt_pk_bf16(o[4], o[5]); w.w = cvt_pk_bf16(o[6], o[7]);
                *(v4u*)(H + ((size_t)u.pm * 256 + r) * 1024 + hc) = w; }
    }
};
struct MoeDownSched {
    static constexpr bool GATHER = false, ASPLIT = false; static constexpr int KSPLIT = 8;
    const char* A; const char* W; int lda, ldb; MoeTab tb; int G, c;
    DI bool next(int i, Unit& u) const { const int L0 = i * G + c; if (L0 >= tb.Rtot * 4) return false; const int L = xcd_remap(L0, tb.Rtot * 4); u.pm = L >> 2; u.pn = L & 3; u.x0 = __builtin_amdgcn_readfirstlane(tb.tpos[u.pm]); u.x1 = __builtin_amdgcn_readfirstlane(tb.tcls[u.pm]); return true; }
    DI const char* a_base(const Unit& u, int) const { return A + (size_t)u.pm * 256 * lda; }
    DI const char* b_base(const Unit& u, int half) const { int ea, eb; cls_experts(u.x1, ea, eb); const int e = half ? eb : ea; return W + ((size_t)e * 1024 + (size_t)u.pn * 256) * ldb; }
    DI unsigned a_rowoff(const Unit&, int) const { return 0u; }
};
struct EpiMoeOut {
    static constexpr bool PERM = false, MID = false;
    const bf16* xin; bf16* outb; float* outf; const float* g; const int* tokl; MoeTab tb; int rmask, last;
    DI void operator()(const f32x4 (&acc)[2][2][4][2], const Unit& u, int wr, int wc, int fr, int fq) const {
        const int r0 = wr * 64 + fr, col0 = u.pn * 256 + wc * 32 + 4 * fq; const int cn = tb.cnt[u.x1];
#pragma unroll
        for (int ai = 0; ai < 2; ++ai)
#pragma unroll
            for (int m = 0; m < 4; ++m) { const int pos = u.x0 + r0 + ai * 128 + m * 16;
                if (pos < cn) { const int tok = tokl[u.x1 * CLS_CAP + pos]; const int b = tok >> 14; const bf16* ip = xin + (size_t)tok * D + col0; bf16* op = outb + (size_t)(tok & rmask) * D + col0; float* of = outf + (size_t)tok * D + col0; const float* gp = g + b * 6144 + col0;
#pragma unroll
                    for (int bj = 0; bj < 2; ++bj)
#pragma unroll
                        for (int n = 0; n < 2; ++n) { const v2u xw = *(const v2u*)(ip + bj * 128 + n * 16); const f32x4 xv = {bflo(xw.x), bfhi(xw.x), bflo(xw.y), bfhi(xw.y)}; const f32x4 gv = *(const f32x4*)(gp + bj * 128 + n * 16);
                            const f32x4 o = xv + gv * acc[ai][bj][m][n];
                            if (last) *(f32x4*)(of + bj * 128 + n * 16) = o;
                            else { v2u ow; ow.x = cvt_pk_bf16(o.x, o.y); ow.y = cvt_pk_bf16(o.z, o.w); *(v2u*)(op + bj * 128 + n * 16) = ow; } } } }
    }
};

struct Ctx { LAS unsigned char* lds; int tid, lane, wave, G, bid; };
DI Ctx fresh(const Ctx& X) { Ctx P = X; int t = X.tid; asm volatile("" : "+v"(t)); P.tid = t; P.lane = t & 63; P.wave = __builtin_amdgcn_readfirstlane(t >> 6); return P; }

DI void tr_item(const float* W, int ldw, int K, bf16* WT, int k0, LAS float* scr, int lane) {
#pragma unroll 8
    for (int i = 0; i < 32; ++i) { const int kk = 2 * i + (lane >> 5); scr[kk * 33 + (lane & 31)] = W[(size_t)(k0 + kk) * ldw + (lane & 31)]; }
    LDS_WAIT(); asm volatile("" ::: "memory");
    const int c = lane & 7;
#pragma unroll
    for (int j = 0; j < 4; ++j) { const int n = (lane >> 3) + 8 * j; const LAS float* s = scr + (8 * c) * 33 + n;
        v4u o; o.x = pk2(s[0 * 33], s[1 * 33]); o.y = pk2(s[2 * 33], s[3 * 33]); o.z = pk2(s[4 * 33], s[5 * 33]); o.w = pk2(s[6 * 33], s[7 * 33]);
        *(v4u*)(WT + (size_t)n * K + k0 + 8 * c) = o; }
    LDS_WAIT(); asm volatile("" ::: "memory");
}
DI unsigned pk4_fp8(float a0, float a1, float a2, float a3) { int p = __builtin_amdgcn_cvt_pk_fp8_f32(a0, a1, 0, false); p = __builtin_amdgcn_cvt_pk_fp8_f32(a2, a3, p, true); return (unsigned)p; }
DI void tr_item8(const float* W, int ldw, int K, unsigned char* WT, int k0, float scale, LAS float* scr, int lane) {
#pragma unroll 8
    for (int i = 0; i < 32; ++i) { const int kk = 2 * i + (lane >> 5); scr[kk * 33 + (lane & 31)] = W[(size_t)(k0 + kk) * ldw + (lane & 31)]; }
    LDS_WAIT(); asm volatile("" ::: "memory");
    const int c = lane & 7;
#pragma unroll
    for (int j = 0; j < 4; ++j) { const int n = (lane >> 3) + 8 * j; const LAS float* s = scr + (8 * c) * 33 + n;
        v2u o; o.x = pk4_fp8(s[0 * 33] * scale, s[1 * 33] * scale, s[2 * 33] * scale, s[3 * 33] * scale); o.y = pk4_fp8(s[4 * 33] * scale, s[5 * 33] * scale, s[6 * 33] * scale, s[7 * 33] * scale);
        *(v2u*)(WT + (size_t)n * K + k0 + 8 * c) = o; }
    LDS_WAIT(); asm volatile("" ::: "memory");
}
DI void p0_prologue(const Args& a, const Ctx& X) {
    unsigned char* ws = a.ws;
    LAS float* scr = (LAS float*)(X.lds + X.wave * 16384);
    const int gw = X.bid * 8 + X.wave, NGW = X.G * 8;
    constexpr int IT_WIN = 16 * 153, IT_AU = 8 * 32, IT_OUT = 16 * 32, IT_GU = 16 * 16 * 32, IT_DN = 16 * 8 * 32;
    constexpr int IT_L = IT_WIN + 2 * IT_AU + IT_OUT + IT_GU + IT_DN;
    for (int it = gw; it < NL * IT_L; it += NGW) {
        const int l = it / IT_L; int r = it - l * IT_L;
        if (r < IT_WIN) { const int kb = r / 153, nb = r - kb * 153, d0 = 32 * nb, s0 = (nb == 152) ? 2304 : (d0 + (d0 >= 2304 ? 8 : 0));
            tr_item8(a.w_in + (size_t)l * D * DIN_SRC + s0, DIN_SRC, D, (unsigned char*)(ws + WS_WIN) + ((size_t)l * NPROJW + d0) * D, 64 * kb, 64.0f, scr, X.lane); continue; }
        r -= IT_WIN;
        if (r < IT_AU) { const int kb = r >> 5, nb = r & 31;
            tr_item(a.w_au + (size_t)l * 512 * D + 32 * nb, D, 512, (bf16*)(ws + WS_WAU) + ((size_t)l * D + 32 * nb) * 512, 64 * kb, scr, X.lane); continue; }
        r -= IT_AU;
        if (r < IT_AU) { const int kb = r >> 5, nb = r & 31;
            tr_item(a.w_mu + (size_t)l * 512 * D + 32 * nb, D, 512, (bf16*)(ws + WS_WMU) + ((size_t)l * D + 32 * nb) * 512, 64 * kb, scr, X.lane); continue; }
        r -= IT_AU;
        if (r < IT_OUT) { const int kb = r >> 5, nb = r & 31;
            tr_item(a.w_out + (size_t)l * D * D + 32 * nb, D, D, (bf16*)(ws + WS_WOUT) + ((size_t)l * D + 32 * nb) * D, 64 * kb, scr, X.lane); continue; }
        r -= IT_OUT;
        if (r < IT_GU) { const int e = r >> 9, q = r & 511, kb = q >> 5, nb = q & 31, tq = nb >> 3, rb = nb & 7;
            const float* src = ((rb < 4) ? a.w_gate : a.w_up) + ((size_t)(l * NE + e) * D) * FF + 128 * tq + 32 * (rb & 3);
            tr_item8(src, FF, D, (unsigned char*)(ws + WS_WGU) + ((size_t)(l * NE + e) * 1024 + 32 * nb) * D, 64 * kb, 64.0f, scr, X.lane); continue; }
        r -= IT_GU;
        { const int e = r >> 8, q = r & 255, kb = q >> 5, nb = q & 31;
            tr_item(a.w_down + ((size_t)(l * NE + e) * FF) * D + 32 * nb, D, FF, (bf16*)(ws + WS_WD) + ((size_t)(l * NE + e) * 1024 + 32 * nb) * FF, 64 * kb, scr, X.lane); }
    }
    { const float* xs = a.x; bf16* xb = (bf16*)(ws + WS_XB);
      for (size_t i = (size_t)X.bid * 512 + X.tid; i < (size_t)T * D / 8; i += (size_t)X.G * 512) { const f32x4 v0 = *(const f32x4*)(xs + 8 * i), v1 = *(const f32x4*)(xs + 8 * i + 4);
          v4u w; w.x = cvt_pk_bf16(v0.x, v0.y); w.y = cvt_pk_bf16(v0.z, v0.w); w.z = cvt_pk_bf16(v1.x, v1.y); w.w = cvt_pk_bf16(v1.z, v1.w); *(v4u*)(xb + 8 * i) = w; } }
    { float* cs = (float*)(ws + WS_ROPE); float* sn = cs + (size_t)T * 8;
      for (int i = X.bid * 512 + X.tid; i < T * 8; i += X.G * 512) { const int tok = i >> 3, f = i & 7; const float angf = (float)a.pos[tok] * c_invf[f];
          double rev = (double)angf * 0.15915494309189535; rev -= rint(rev); const float rf = (float)rev;
          cs[i] = __builtin_amdgcn_cosf(rf); sn[i] = __builtin_amdgcn_sinf(rf); } }
    __syncthreads();
    LAS float* cact = (LAS float*)X.lds; LAS float* red = (LAS float*)(X.lds + 8192);
    for (int i = X.tid; i < 2048; i += 512) { const float cv = a.c[i]; cact[i] = cv / (1.0f + __expf(-cv)); }
    __syncthreads();
    float* mod = (float*)(ws + WS_MOD);
    for (int it = X.bid; it < NL * 96; it += X.G) { const int l = it / 96, cg = it - l * 96; const int col = cg * 64 + X.lane;
        const float* w = a.ada_w + (size_t)l * D * 6144 + col; float s0 = 0.f, s1 = 0.f;
#pragma unroll 8
        for (int kk = 0; kk < 128; ++kk) { const int k = X.wave * 128 + kk; const float wv = w[(size_t)k * 6144]; s0 += cact[k] * wv; s1 += cact[1024 + k] * wv; }
        red[(X.wave * 2 + 0) * 64 + X.lane] = s0; red[(X.wave * 2 + 1) * 64 + X.lane] = s1;
        __syncthreads();
        if (X.tid < 128) { const int b = X.tid >> 6, ln = X.tid & 63; float s = 0.f;
#pragma unroll
            for (int w8 = 0; w8 < 8; ++w8) s += red[(w8 * 2 + b) * 64 + ln];
            mod[(size_t)(l * 2 + b) * 6144 + cg * 64 + ln] = s + a.ada_b[l * 6144 + cg * 64 + ln]; }
        __syncthreads();
    }
}

DI void p1_norm_gates(const Args& a, const Ctx& X, int l, const bf16* xin) {
    unsigned char* ws = a.ws;
    const float* mod = (const float*)(ws + WS_MOD); unsigned char* hb = (unsigned char*)(ws + WS_H);
    const int gw = X.bid * 8 + X.wave, NGW = X.G * 8;
    for (int rg = gw; rg < T / 16; rg += NGW) {
        const int row0 = rg * 16, b = row0 >> 14;
        const float* mb = mod + (size_t)(l * 2 + b) * 6144;
        f32x4 aw[4], sh[4];
#pragma unroll
        for (int j = 0; j < 4; ++j) { const int k = 256 * j + 4 * X.lane; const f32x4 nw = *(const f32x4*)(a.nmw + l * D + k); const f32x4 sc = *(const f32x4*)(mb + 1024 + k); aw[j] = nw * (sc + 1.0f); sh[j] = *(const f32x4*)(mb + k); }
        v2u pre[4][4];
#pragma unroll
        for (int q = 0; q < 4; ++q) { const v2u* xp = (const v2u*)(xin + (size_t)(row0 + q) * D) + X.lane;
#pragma unroll
            for (int j = 0; j < 4; ++j) pre[q][j] = xp[64 * j]; }
#pragma unroll 1
        for (int rb = 0; rb < 16; rb += 4) {
#pragma unroll
          for (int q = 0; q < 4; ++q) { const int row = row0 + rb + q;
            f32x4 v[4]; float ss = 0.f;
#pragma unroll
            for (int j = 0; j < 4; ++j) { const v2u pw = pre[q][j]; v[j] = (f32x4){bflo(pw.x), bfhi(pw.x), bflo(pw.y), bfhi(pw.y)}; }
            if (rb + 4 < 16) { const v2u* xp = (const v2u*)(xin + (size_t)(row + 4) * D) + X.lane;
#pragma unroll
                for (int j = 0; j < 4; ++j) pre[q][j] = xp[64 * j]; }
#pragma unroll
            for (int j = 0; j < 4; ++j) ss += (v[j].x * v[j].x + v[j].y * v[j].y) + (v[j].z * v[j].z + v[j].w * v[j].w);
            ss = wave_sum(ss); const float rstd = __builtin_amdgcn_rsqf(ss * (1.0f / D) + EPS);
            unsigned* o4 = (unsigned*)(hb + (size_t)row * D) + X.lane;
#pragma unroll
            for (int j = 0; j < 4; ++j) { v[j] = v[j] * rstd * aw[j] + sh[j]; o4[64 * j] = pk4_fp8(v[j].x, v[j].y, v[j].z, v[j].w); }
          }
        }
    }
}

DI void attn_unit(const Args& a, const Ctx& X, int l, int unit) {
    unsigned char* ws = a.ws; const bf16* proj = (const bf16*)(ws + WS_PROJ); bf16* ao = (bf16*)(ws + WS_H);
    const float* cs = (const float*)(ws + WS_ROPE); const float* sn = cs + (size_t)T * 8;
    const int b = unit >> 8, rem = unit & 255, nb = rem >> 1, kvh = rem & 1; const int tok0 = b * SEQ + nb * 128;
    LAS bf16* Kl = (LAS bf16*)X.lds;
    LAS bf16* VT = (LAS bf16*)(X.lds + 36864);
    int lane = X.lane; asm volatile("" : "+v"(lane));
    const int c16 = lane & 15, quad = lane >> 4;
    v4u nq0, nq1; f32x4 ncs0, ncs1, nsn0, nsn1;
#define AT_PREF(task_) do { const int g_ = (task_) >> 3, tq_ = tok0 + 16 * ((task_) & 7) + c16; const bf16* qp_ = proj + (size_t)tq_ * NPROJ + C_AQ + (kvh * 4 + g_) * 64; \
        nq0 = *(const v4u*)(qp_ + 8 * quad); nq1 = *(const v4u*)(qp_ + 32 + 8 * quad); ncs0 = *(const f32x4*)(cs + (size_t)tq_ * 8); ncs1 = *(const f32x4*)(cs + (size_t)tq_ * 8 + 4); nsn0 = *(const f32x4*)(sn + (size_t)tq_ * 8); nsn1 = *(const f32x4*)(sn + (size_t)tq_ * 8 + 4); } while (0)
    AT_PREF(X.wave);
    float qw[16];
#pragma unroll
    for (int i = 0; i < 8; ++i) { qw[i] = a.qnw[l * 64 + 8 * quad + i]; qw[8 + i] = a.qnw[l * 64 + 32 + 8 * quad + i]; }
    const f32x4 sk4 = *(const f32x4*)(a.sinks + l * 8 + kvh * 4);
    {
        const int row = X.tid >> 1, half = X.tid & 1; const int tokk = tok0 - 128 + row; const bool valid = (nb > 0) || (row >= 128);
        float y[32]; float vv[32];
        if (valid) {
            const v4u* kp = (const v4u*)(proj + (size_t)tokk * NPROJ + C_AK + kvh * 64 + half * 32); const v4u* vp = (const v4u*)(proj + (size_t)tokk * NPROJ + C_AV + kvh * 64 + half * 32);
#pragma unroll
            for (int q = 0; q < 4; ++q) { const v4u kw = kp[q], vw = vp[q];
                y[8 * q + 0] = bflo(kw.x); y[8 * q + 1] = bfhi(kw.x); y[8 * q + 2] = bflo(kw.y); y[8 * q + 3] = bfhi(kw.y); y[8 * q + 4] = bflo(kw.z); y[8 * q + 5] = bfhi(kw.z); y[8 * q + 6] = bflo(kw.w); y[8 * q + 7] = bfhi(kw.w);
                vv[8 * q + 0] = bflo(vw.x); vv[8 * q + 1] = bfhi(vw.x); vv[8 * q + 2] = bflo(vw.y); vv[8 * q + 3] = bfhi(vw.y); vv[8 * q + 4] = bflo(vw.z); vv[8 * q + 5] = bfhi(vw.z); vv[8 * q + 6] = bflo(vw.w); vv[8 * q + 7] = bfhi(vw.w); }
        } else {
#pragma unroll
            for (int i = 0; i < 32; ++i) { y[i] = 0.f; vv[i] = 0.f; } }
        float ss = 0.f;
#pragma unroll
        for (int i = 0; i < 32; ++i) ss += y[i] * y[i];
        ss += __shfl_xor(ss, 1); const float rstd = 1.0f / sqrtf(ss * (1.0f / 64.0f) + EPS);
#pragma unroll
        for (int i = 0; i < 32; ++i) y[i] = y[i] * rstd * a.knw[l * 64 + half * 32 + i];
        if (half == 0 && valid) {
#pragma unroll
            for (int d = 0; d < 8; ++d) { const float c = cs[(size_t)tokk * 8 + d], s = sn[(size_t)tokk * 8 + d]; const float t1 = y[d], t2 = y[d + 8]; y[d] = t1 * c - t2 * s; y[d + 8] = t2 * c + t1 * s; } }
#pragma unroll
        for (int q = 0; q < 4; ++q) { v4u w; w.x = pk2(y[8 * q], y[8 * q + 1]); w.y = pk2(y[8 * q + 2], y[8 * q + 3]); w.z = pk2(y[8 * q + 4], y[8 * q + 5]); w.w = pk2(y[8 * q + 6], y[8 * q + 7]);
            *(LAS v4u*)(Kl + row * 72 + half * 32 + 8 * q) = w; }
#pragma unroll
        for (int i = 0; i < 32; ++i) VT[(half * 32 + i) * 280 + row] = (bf16)f2bf(vv[i]);
        if (X.tid < 64) {
#pragma unroll
            for (int cc = 256; cc < 280; ++cc) VT[X.tid * 280 + cc] = 0; }
    }
    __syncthreads();
#pragma unroll 1
    for (int task = X.wave; task < 32; task += 8) {
        const int g = task >> 3, rg = task & 7, r0 = 16 * rg, head = kvh * 4 + g; const int tokq = tok0 + r0 + c16;
        const float sink = (g == 0) ? sk4.x : ((g == 1) ? sk4.y : ((g == 2) ? sk4.z : sk4.w));
        const v4u w0 = nq0, w1 = nq1; const f32x4 cc0 = ncs0, cc1 = ncs1, ss0 = nsn0, ss1 = nsn1;
        if (task + 8 < 32) { AT_PREF(task + 8); }
        float qv[16];
        qv[0] = bflo(w0.x); qv[1] = bfhi(w0.x); qv[2] = bflo(w0.y); qv[3] = bfhi(w0.y); qv[4] = bflo(w0.z); qv[5] = bfhi(w0.z); qv[6] = bflo(w0.w); qv[7] = bfhi(w0.w);
        qv[8] = bflo(w1.x); qv[9] = bfhi(w1.x); qv[10] = bflo(w1.y); qv[11] = bfhi(w1.y); qv[12] = bflo(w1.z); qv[13] = bfhi(w1.z); qv[14] = bflo(w1.w); qv[15] = bfhi(w1.w);
        float ss = 0.f;
#pragma unroll
        for (int i = 0; i < 16; ++i) ss += qv[i] * qv[i];
        ss += __shfl_xor(ss, 16); ss += __shfl_xor(ss, 32); const float rstd = __builtin_amdgcn_rsqf(ss * (1.0f / 64.0f) + EPS);
#pragma unroll
        for (int i = 0; i < 16; ++i) qv[i] = qv[i] * rstd * qw[i];
        { const float cv[8] = {cc0.x, cc0.y, cc0.z, cc0.w, cc1.x, cc1.y, cc1.z, cc1.w}, sv[8] = {ss0.x, ss0.y, ss0.z, ss0.w, ss1.x, ss1.y, ss1.z, ss1.w};
#pragma unroll
          for (int d = 0; d < 8; ++d) { const float other = __shfl_xor(qv[d], 16);
              if (quad == 0) qv[d] = qv[d] * cv[d] - other * sv[d]; else if (quad == 1) qv[d] = qv[d] * cv[d] + other * sv[d]; } }
        bf16x8 qf[2];
        { v4u w; w.x = pk2m(qv[0], qv[1]); w.y = pk2m(qv[2], qv[3]); w.z = pk2m(qv[4], qv[5]); w.w = pk2m(qv[6], qv[7]); qf[0] = __builtin_bit_cast(bf16x8, w);
          w.x = pk2m(qv[8], qv[9]); w.y = pk2m(qv[10], qv[11]); w.z = pk2m(qv[12], qv[13]); w.w = pk2m(qv[14], qv[15]); qf[1] = __builtin_bit_cast(bf16x8, w); }
        f32x4 sacc[9];
#pragma unroll
        for (int i = 0; i < 9; ++i) { const LAS bf16* kr = Kl + (16 * (rg + i) + c16) * 72 + 8 * quad;
            const bf16x8 k0 = *(const LAS bf16x8*)kr, k1 = *(const LAS bf16x8*)(kr + 32);
            f32x4 z = {0.f, 0.f, 0.f, 0.f}; z = __builtin_amdgcn_mfma_f32_16x16x32_bf16(k0, qf[0], z, 0, 0, 0); sacc[i] = __builtin_amdgcn_mfma_f32_16x16x32_bf16(k1, qf[1], z, 0, 0, 0); }
        int dbase = 4 * quad - c16; asm volatile("" : "+v"(dbase)); int kbase = 16 * rg + 4 * quad; asm volatile("" : "+v"(kbase)); float mx = sink;
#pragma unroll
        for (int i = 0; i < 9; ++i)
#pragma unroll
            for (int j = 0; j < 4; ++j) { const int dlt = dbase + 16 * i + j; const int kj = kbase + 16 * i + j; const bool ok = (dlt > 0) && (dlt <= 128) && ((nb > 0) || (kj >= 128));
                const float s = ok ? sacc[i][j] * 0.125f : -3.0e38f; sacc[i][j] = s; mx = fmaxf(mx, s); }
        mx = fmaxf(mx, __shfl_xor(mx, 16)); mx = fmaxf(mx, __shfl_xor(mx, 32));
        float sum = 0.f;
#pragma unroll
        for (int i = 0; i < 9; ++i)
#pragma unroll
            for (int j = 0; j < 4; ++j) { const float p = (sacc[i][j] > -1.0e38f) ? __expf(sacc[i][j] - mx) : 0.f; sacc[i][j] = p; sum += p; }
        sum += __shfl_xor(sum, 16); sum += __shfl_xor(sum, 32);
        const float inv = 1.0f / (sum + __expf(sink - mx));
        f32x4 oacc[4];
#pragma unroll
        for (int et = 0; et < 4; ++et) oacc[et] = (f32x4){0.f, 0.f, 0.f, 0.f};
#pragma unroll
        for (int kk = 0; kk < 5; ++kk) {
            v4u pw; pw.x = pk2m(sacc[2 * kk][0], sacc[2 * kk][1]); pw.y = pk2m(sacc[2 * kk][2], sacc[2 * kk][3]);
            if (2 * kk + 1 < 9) { pw.z = pk2m(sacc[(2 * kk + 1 < 9) ? 2 * kk + 1 : 0][0], sacc[(2 * kk + 1 < 9) ? 2 * kk + 1 : 0][1]); pw.w = pk2m(sacc[(2 * kk + 1 < 9) ? 2 * kk + 1 : 0][2], sacc[(2 * kk + 1 < 9) ? 2 * kk + 1 : 0][3]); } else { pw.z = 0u; pw.w = 0u; }
            const bf16x8 pf = __builtin_bit_cast(bf16x8, pw);
#pragma unroll
            for (int et = 0; et < 4; ++et) { const LAS bf16* vr = VT + (16 * et + c16) * 280 + 16 * rg + 32 * kk + 4 * quad;
                const v2u lo = *(const LAS v2u*)vr, hi = *(const LAS v2u*)(vr + 16); v4u vw; vw.x = lo.x; vw.y = lo.y; vw.z = hi.x; vw.w = hi.y;
                oacc[et] = __builtin_amdgcn_mfma_f32_16x16x32_bf16(__builtin_bit_cast(bf16x8, vw), pf, oacc[et], 0, 0, 0); }
        }
#pragma unroll
        for (int et = 0; et < 4; ++et) { v2u w; w.x = pk2(oacc[et][0] * inv, oacc[et][1] * inv); w.y = pk2(oacc[et][2] * inv, oacc[et][3] * inv);
            *(v2u*)(ao + (size_t)tokq * 512 + head * 64 + 16 * et + 4 * quad) = w; }
    }
    __syncthreads();
#undef AT_PREF
}

constexpr int ML_Q = 0, ML_K = 17408, ML_KET = 34816, ML_VT = 53248, ML_CT = 73984, ML_CW = 113152, ML_CB = 118272, ML_RED = 118784, ML_NW = 119296, ML_GT = 119808;
DI float bfw(unsigned w, int hi) { return hi ? bfhi(w) : bflo(w); }
template <bool L3> DI void mlstm_unit(const Args& a, const Ctx& X, int l, int unit) {
    unsigned char* ws = a.ws; const bf16* proj = (const bf16*)(ws + WS_PROJ); bf16* hm = (bf16*)(ws + WS_H) + (size_t)T * 512;
    bf16* kcb = (bf16*)(ws + WS_KC);
    const float* gates = (const float*)(ws + WS_GATES); float* mlc = (float*)(ws + WS_MLC) + (size_t)unit * 18432; float* mlb = (float*)(ws + WS_MLB);
    const int seq = unit >> 5, sj = unit & 31, b = seq >> 2, hh = seq & 3; const int tokbase = b * SEQ + sj * 512;
    LAS bf16* Qs = (LAS bf16*)(X.lds + ML_Q); LAS bf16* Ks = (LAS bf16*)(X.lds + ML_K); LAS bf16* KET = (LAS bf16*)(X.lds + ML_KET);
    LAS bf16* VT = (LAS bf16*)(X.lds + ML_VT); LAS bf16* CT = (LAS bf16*)(X.lds + ML_CT); LAS float* CW = (LAS float*)(X.lds + ML_CW);
    LAS float* CB = (LAS float*)(X.lds + ML_CB); LAS float* RED = (LAS float*)(X.lds + ML_RED); LAS float* NW = (LAS float*)(X.lds + ML_NW);
    LAS float* GT = (LAS float*)(X.lds + ML_GT);
    int lane = X.lane; asm volatile("" : "+v"(lane));
    const int c16 = lane & 15, quad = lane >> 4, w = X.wave;
    int tidl = X.tid; asm volatile("" : "+v"(tidl));
    const int tg = tidl >> 5, cg = tidl & 31, t0 = 4 * tg, c0 = 4 * cg;
    v2u rq[7], rk[7], rv[4], kcv[4];
#define ML_LBAR() do { asm volatile("s_waitcnt lgkmcnt(0)" ::: "memory"); __builtin_amdgcn_s_barrier(); asm volatile("" ::: "memory"); } while (0)
#define ML_LOADRAW(tokc) do { _Pragma("unroll") for (int j = 0; j < 7; ++j) { const int tt = (tokc) + t0 - 3 + j; const bool ok = tt >= b * SEQ; const bf16* rp = proj + (size_t)(ok ? tt : (tokc)) * NPROJ + hh * 128 + c0; \
        if (L3) { rq[j] = *(const v2u*)(rp + C_MQ); if (!ok) { rq[j].x = 0u; rq[j].y = 0u; } } else { rk[j] = *(const v2u*)(rp + C_MK); if (!ok) { rk[j].x = 0u; rk[j].y = 0u; } } } \
        if (L3) { _Pragma("unroll") for (int i = 0; i < 4; ++i) kcv[i] = *(const v2u*)(kcb + (size_t)((tokc) + t0 + i) * 512 + hh * 128 + c0); } \
        _Pragma("unroll") for (int i = 0; i < 4; ++i) rv[i] = *(const v2u*)(proj + (size_t)((tokc) + t0 + i) * NPROJ + C_MV + hh * 128 + c0); } while (0)
    ML_LOADRAW(tokbase);
    for (int idx = X.tid; idx < 1280; idx += 512) { const int tap = idx >> 8, ch = idx & 255; const int gch = (ch < 128) ? (hh * 128 + ch) : (512 + hh * 128 + (ch - 128));
        CW[idx] = (tap < 4) ? a.conv_w[(size_t)(l * 4 + tap) * 1024 + gch] : a.conv_b[l * 1024 + gch]; }
    for (int idx = X.tid; idx < 16 * 72; idx += 512) VT[128 * 72 + idx] = (idx < 72) ? (bf16)0x3F80 : (bf16)0;
    if (X.tid < 128) NW[X.tid] = a.mnw[l * 512 + hh * 128 + X.tid];
    { const float* gp = gates + (size_t)(tokbase + X.tid) * 8; GT[2 * X.tid] = gp[hh]; GT[2 * X.tid + 1] = gp[4 + hh]; }
    f32x4 cacc[9];
#pragma unroll
    for (int et = 0; et < 9; ++et) {
        if (L3) {
#pragma unroll
            for (int j = 0; j < 4; ++j) { const float v = mlc[(16 * et + 4 * quad + j) * 128 + 16 * w + c16]; cacc[et][j] = v; CT[(16 * et + 4 * quad + j) * 136 + 16 * w + c16] = (bf16)f2bf(v); }
        } else cacc[et] = (f32x4){0.f, 0.f, 0.f, 0.f};
    }
    float bsum = 0.f;
    __syncthreads();
#pragma unroll 1
    for (int c = 0; c < 8; ++c) {
        const int tok0 = tokbase + c * 64;
        const f32x2 gl = *(const LAS f32x2*)(GT + 2 * (c * 64 + lane)); float bsc = gl.y; const float li = gl.x;
#pragma unroll
        for (int o = 1; o < 64; o <<= 1) { const float v = __shfl_up(bsc, o); if (lane >= o) bsc += v; }
        const float bl = __shfl(bsc, 63); const float csv = li - bsc;
        if (w == 0) { CB[lane] = bsc; CB[64 + lane] = csv; }
        bsum += bl;
        const int tt_ = w & 3, eh = w >> 2; const int tq = 16 * tt_ + c16;
        v2u ogv[4];
        if (L3) {
#pragma unroll
            for (int x = 0; x < 4; ++x) ogv[x] = *(const v2u*)(proj + (size_t)(tok0 + tq) * NPROJ + C_MO + hh * 128 + 16 * (4 * eh + x) + 4 * quad); }
        { float fac[4];
#pragma unroll
          for (int i = 0; i < 4; ++i) fac[i] = __expf(bl + __shfl(csv, t0 + i));
#pragma unroll
          for (int qk = (L3 ? 0 : 1); qk < 2; ++qk) {
              float o[4][4];
              if (L3 && qk) {
#pragma unroll
                  for (int i = 0; i < 4; ++i) { o[i][0] = bflo(kcv[i].x); o[i][1] = bfhi(kcv[i].x); o[i][2] = bflo(kcv[i].y); o[i][3] = bfhi(kcv[i].y); }
              } else {
              const f32x4 bias = *(const LAS f32x4*)(CW + 4 * 256 + qk * 128 + c0);
#pragma unroll
              for (int i = 0; i < 4; ++i) { o[i][0] = bias.x; o[i][1] = bias.y; o[i][2] = bias.z; o[i][3] = bias.w; }
#pragma unroll
              for (int j = 0; j < 4; ++j) { const f32x4 wj = *(const LAS f32x4*)(CW + j * 256 + qk * 128 + c0);
#pragma unroll
                  for (int i = 0; i < 4; ++i) { const v2u rr = qk ? rk[i + j] : rq[i + j];
                      o[i][0] += wj.x * bflo(rr.x); o[i][1] += wj.y * bfhi(rr.x); o[i][2] += wj.z * bflo(rr.y); o[i][3] += wj.w * bfhi(rr.y); } }
#pragma unroll
              for (int i = 0; i < 4; ++i)
#pragma unroll
                  for (int ch = 0; ch < 4; ++ch) { const float z = o[i][ch]; o[i][ch] = z * __builtin_amdgcn_rcpf(1.0f + __expf(-z)) * (qk ? 0.08838834764831845f : 1.0f); }
              }
              if (!L3 && qk) {
#pragma unroll
                  for (int i = 0; i < 4; ++i) { v2u pw; pw.x = pk2(o[i][0], o[i][1]); pw.y = pk2(o[i][2], o[i][3]); *(v2u*)(kcb + (size_t)(tok0 + t0 + i) * 512 + hh * 128 + c0) = pw;
                      o[i][0] = bflo(pw.x); o[i][1] = bfhi(pw.x); o[i][2] = bflo(pw.y); o[i][3] = bfhi(pw.y); } }
              if (L3) { LAS bf16* dst = (qk ? Ks : Qs) + t0 * 136 + c0;
#pragma unroll
                  for (int i = 0; i < 4; ++i) { v2u pw; pw.x = pk2(o[i][0], o[i][1]); pw.y = pk2(o[i][2], o[i][3]); *(LAS v2u*)(dst + i * 136) = pw; } }
              if (qk) {
#pragma unroll
                  for (int ch = 0; ch < 4; ++ch) { v2u pw; pw.x = pk2(o[0][ch] * fac[0], o[1][ch] * fac[1]); pw.y = pk2(o[2][ch] * fac[2], o[3][ch] * fac[3]); *(LAS v2u*)(KET + (c0 + ch) * 72 + t0) = pw; } }
          }
          { v2u p0, p1, p2, p3;
            p0.x = (rv[0].x & 0xffffu) | (rv[1].x << 16); p0.y = (rv[2].x & 0xffffu) | (rv[3].x << 16);
            p1.x = (rv[0].x >> 16) | (rv[1].x & 0xffff0000u); p1.y = (rv[2].x >> 16) | (rv[3].x & 0xffff0000u);
            p2.x = (rv[0].y & 0xffffu) | (rv[1].y << 16); p2.y = (rv[2].y & 0xffffu) | (rv[3].y << 16);
            p3.x = (rv[0].y >> 16) | (rv[1].y & 0xffff0000u); p3.y = (rv[2].y >> 16) | (rv[3].y & 0xffff0000u);
            *(LAS v2u*)(VT + (c0 + 0) * 72 + t0) = p0; *(LAS v2u*)(VT + (c0 + 1) * 72 + t0) = p1; *(LAS v2u*)(VT + (c0 + 2) * 72 + t0) = p2; *(LAS v2u*)(VT + (c0 + 3) * 72 + t0) = p3; }
        }
        ML_LBAR();
        if (c < 7) { ML_LOADRAW(tok0 + 64); }
        float hval[4][4];
        if (L3) {
            bf16x8 qf[4];
#pragma unroll
            for (int ks = 0; ks < 4; ++ks) qf[ks] = *(const LAS bf16x8*)(Qs + tq * 136 + 32 * ks + 8 * quad);
            f32x4 sacc[4];
#pragma unroll
            for (int st = 0; st < 4; ++st) { f32x4 z = {0.f, 0.f, 0.f, 0.f};
#pragma unroll
                for (int ks = 0; ks < 4; ++ks) z = __builtin_amdgcn_mfma_f32_16x16x32_bf16(*(const LAS bf16x8*)(Ks + (16 * st + c16) * 136 + 32 * ks + 8 * quad), qf[ks], z, 0, 0, 0);
                sacc[st] = z; }
            const float cbt = CB[tq];
#pragma unroll
            for (int st = 0; st < 4; ++st)
#pragma unroll
                for (int j = 0; j < 4; ++j) { const int s = 16 * st + 4 * quad + j; const float d = (s <= tq) ? __expf(cbt + CB[64 + s]) : 0.f; sacc[st][j] *= d; }
            bf16x8 pf[2];
#pragma unroll
            for (int kk = 0; kk < 2; ++kk) { v4u pw; pw.x = pk2m(sacc[2 * kk][0], sacc[2 * kk][1]); pw.y = pk2m(sacc[2 * kk][2], sacc[2 * kk][3]); pw.z = pk2m(sacc[2 * kk + 1][0], sacc[2 * kk + 1][1]); pw.w = pk2m(sacc[2 * kk + 1][2], sacc[2 * kk + 1][3]); pf[kk] = __builtin_bit_cast(bf16x8, pw); }
            const float ebt = __expf(cbt);
            f32x4 nn[5];
#pragma unroll
            for (int x = 0; x < 5; ++x) { const int et = (x < 4) ? (4 * eh + x) : 8; f32x4 na = {0.f, 0.f, 0.f, 0.f}, ia = {0.f, 0.f, 0.f, 0.f};
#pragma unroll
                for (int kk = 0; kk < 2; ++kk) { const LAS bf16* vr = VT + (16 * et + c16) * 72 + 32 * kk + 4 * quad; const v2u lo = *(const LAS v2u*)vr, hi = *(const LAS v2u*)(vr + 16); v4u vw; vw.x = lo.x; vw.y = lo.y; vw.z = hi.x; vw.w = hi.y;
                    na = __builtin_amdgcn_mfma_f32_16x16x32_bf16(__builtin_bit_cast(bf16x8, vw), pf[kk], na, 0, 0, 0); }
#pragma unroll
                for (int ks = 0; ks < 4; ++ks) ia = __builtin_amdgcn_mfma_f32_16x16x32_bf16(*(const LAS bf16x8*)(CT + (16 * et + c16) * 136 + 32 * ks + 8 * quad), qf[ks], ia, 0, 0, 0);
                nn[x] = na + ia * ebt; }
            const float den = __shfl(nn[4][0], c16); const float inv = 1.0f / fmaxf(fabsf(den), 1.0f);
            float ss = 0.f;
#pragma unroll
            for (int x = 0; x < 4; ++x)
#pragma unroll
                for (int j = 0; j < 4; ++j) { hval[x][j] = nn[x][j] * inv; ss += hval[x][j] * hval[x][j]; }
            ss += __shfl_xor(ss, 16); ss += __shfl_xor(ss, 32);
            if (quad == 0) RED[eh * 64 + tq] = ss;
            ML_LBAR();
            const float rstd = __builtin_amdgcn_rsqf((RED[tq] + RED[64 + tq]) * (1.0f / 128.0f) + EPS);
#pragma unroll
            for (int x = 0; x < 4; ++x) { const int e = 16 * (4 * eh + x) + 4 * quad; const v2u og = ogv[x];
                const float y0 = hval[x][0] * rstd * NW[e] * bflo(og.x), y1 = hval[x][1] * rstd * NW[e + 1] * bfhi(og.x), y2 = hval[x][2] * rstd * NW[e + 2] * bflo(og.y), y3 = hval[x][3] * rstd * NW[e + 3] * bfhi(og.y);
                v2u o; o.x = pk2(y0, y1); o.y = pk2(y2, y3); *(v2u*)(hm + (size_t)(tok0 + tq) * 512 + hh * 128 + e) = o; }
        }
        { const float ebl = __expf(bl);
          bf16x8 kf[2];
#pragma unroll
          for (int kk = 0; kk < 2; ++kk) kf[kk] = *(const LAS bf16x8*)(KET + (16 * w + c16) * 72 + 32 * kk + 8 * quad);
#pragma unroll
          for (int et = 0; et < 9; ++et) { f32x4 z = cacc[et] * ebl;
#pragma unroll
              for (int kk = 0; kk < 2; ++kk) z = __builtin_amdgcn_mfma_f32_16x16x32_bf16(*(const LAS bf16x8*)(VT + (16 * et + c16) * 72 + 32 * kk + 8 * quad), kf[kk], z, 0, 0, 0);
              cacc[et] = z;
              if (L3) {
#pragma unroll
                  for (int j = 0; j < 4; ++j) CT[(16 * et + 4 * quad + j) * 136 + 16 * w + c16] = (bf16)f2bf(z[j]); } } }
        ML_LBAR();
    }
#undef ML_LOADRAW
#undef ML_LBAR
    if (!L3) {
#pragma unroll
        for (int et = 0; et < 9; ++et)
#pragma unroll
            for (int j = 0; j < 4; ++j) mlc[(16 * et + 4 * quad + j) * 128 + 16 * w + c16] = cacc[et][j];
        if (X.tid == 0) mlb[unit] = bsum;
    }
}
DI void mlstm_scan(const Args& a, const Ctx& X) {
    float* mlc = (float*)(a.ws + WS_MLC); const float* mlb = (const float*)(a.ws + WS_MLB);
    for (int idx = X.bid * 512 + X.tid; idx < 8 * 18432; idx += X.G * 512) { const int seq = idx / 18432, el = idx - seq * 18432; float carry = 0.f;
        float* p0 = mlc + (size_t)seq * 32 * 18432 + el; float v[32], dcy[32];
#pragma unroll
        for (int j = 0; j < 32; ++j) { v[j] = p0[(size_t)j * 18432]; dcy[j] = mlb[seq * 32 + j]; }
#pragma unroll
        for (int j = 0; j < 32; ++j) { p0[(size_t)j * 18432] = carry; carry = __expf(dcy[j]) * carry + v[j]; } }
}

constexpr int P6_WR = 0, P6_AT = 33024, P6_SH = 37120, P6_LG = 41216, P6_HIST = 65536;
DI void p6_norm_route(const Args& a, const Ctx& X, int l, const bf16* xin) {
    unsigned char* ws = a.ws;
    LAS bf16* wrb = (LAS bf16*)(X.lds + P6_WR);
    LAS float* at = (LAS float*)(X.lds + P6_AT); LAS float* sht = (LAS float*)(X.lds + P6_SH);
    LAS float* lg = (LAS float*)(X.lds + P6_LG) + X.wave * 272;
    for (int idx = X.tid; idx < 16384; idx += 512) { const int k = idx >> 4, e = idx & 15; wrb[e * 1032 + k] = (bf16)f2bf(a.router_w[idx]); }
    const float* mod = (const float*)(ws + WS_MOD); unsigned char* hb = (unsigned char*)(ws + WS_H); float* tgate = (float*)(ws + WS_TGATE); int* tokl = (int*)(ws + WS_TOKL);
    const float* ssq = (const float*)(ws + WS_SSQ);
    unsigned* cnt = (unsigned*)(ws + WS_CTL) + CW_CNT + l * 2048;
    LAS int* hist = (LAS int*)(X.lds + P6_HIST); LAS int* cbase = hist + 32;
    int lane = X.lane; asm volatile("" : "+v"(lane));
    const int r = lane & 15, q = lane >> 4;
    const int gw = X.bid * 8 + X.wave, NGW = X.G * 8;
    for (int it = 0; it * NGW < T / 16; ++it) {
        const int rg = it * NGW + gw; const bool act = rg < T / 16;
        const int row0 = (act ? rg : 0) * 16; const int bb = ((it * NGW + X.bid * 8) * 16) >> 14;
        __syncthreads();
        if (X.tid < 32) hist[X.tid] = 0;
        { const float* mb = mod + (size_t)(l * 2 + (bb < 2 ? bb : 1)) * 6144;
          for (int k = X.tid; k < 1024; k += 512) { at[k] = a.nfw[l * D + k] * (1.0f + mb[4 * 1024 + k]); sht[k] = mb[3 * 1024 + k]; } }
        __syncthreads();
        const int row = row0 + r;
        float rstd;
        { const f32x4 pp = *(const f32x4*)(ssq + (size_t)row * 16 + 4 * q); float ss = (pp.x + pp.y) + (pp.z + pp.w); ss += __shfl_xor(ss, 16); ss += __shfl_xor(ss, 32); rstd = __builtin_amdgcn_rsqf(ss * (1.0f / D) + EPS); }
        const bf16* xr = xin + (size_t)row * D + 8 * q; unsigned char* hr = hb + (size_t)row * D + 8 * q;
        f32x4 acc = {0.f, 0.f, 0.f, 0.f};
#pragma unroll 8
        for (int s = 0; s < 32; ++s) {
            const v4u xw = *(const v4u*)(xr + 32 * s); const f32x4 x0 = {bflo(xw.x), bfhi(xw.x), bflo(xw.y), bfhi(xw.y)}, x1 = {bflo(xw.z), bfhi(xw.z), bflo(xw.w), bfhi(xw.w)};
            const f32x4 a0 = *(const LAS f32x4*)(at + 32 * s + 8 * q), a1 = *(const LAS f32x4*)(at + 32 * s + 8 * q + 4);
            const f32x4 s0 = *(const LAS f32x4*)(sht + 32 * s + 8 * q), s1 = *(const LAS f32x4*)(sht + 32 * s + 8 * q + 4);
            const f32x4 h0 = x0 * rstd * a0 + s0, h1 = x1 * rstd * a1 + s1;
            v4u w; w.x = pk2m(h0.x, h0.y); w.y = pk2m(h0.z, h0.w); w.z = pk2m(h1.x, h1.y); w.w = pk2m(h1.z, h1.w);
            { v2u w8; w8.x = pk4_fp8(h0.x, h0.y, h0.z, h0.w); w8.y = pk4_fp8(h1.x, h1.y, h1.z, h1.w); *(v2u*)(hr + 32 * s) = w8; }
            const bf16x8 bfr = *(const LAS bf16x8*)(wrb + r * 1032 + 32 * s + 8 * q);
            acc = __builtin_amdgcn_mfma_f32_16x16x32_bf16(__builtin_bit_cast(bf16x8, w), bfr, acc, 0, 0, 0);
        }
#pragma unroll
        for (int j = 0; j < 4; ++j) lg[(4 * q + j) * 17 + r] = acc[j];
        LDS_WAIT(); asm volatile("" ::: "memory");
        int my_cls = 0; float my_ga = 0.f, my_gb = 0.f;
        if (lane < 16) {
            float sc[16], sel[16];
#pragma unroll
            for (int e = 0; e < 16; ++e) { const float p = lg[lane * 17 + e]; sc[e] = 1.0f / (1.0f + __expf(-p)); sel[e] = sc[e] + a.router_b[e]; }
            int gi = 0; float gbest = -1.0e30f;
#pragma unroll
            for (int g = 0; g < 4; ++g) { const float p0 = sel[4 * g], p1 = sel[4 * g + 1], p2 = sel[4 * g + 2], p3 = sel[4 * g + 3];
                const float gs = fmaxf(fmaxf(fmaxf(p0 + p1, p0 + p2), fmaxf(p0 + p3, p1 + p2)), fmaxf(p1 + p3, p2 + p3));
                if (gs > gbest) { gbest = gs; gi = g; } }
            float qs[4], s4[4];
#pragma unroll
            for (int i = 0; i < 4; ++i) { qs[i] = 0.f; s4[i] = 0.f; }
#pragma unroll
            for (int g = 0; g < 4; ++g) if (g == gi) {
#pragma unroll
                for (int i = 0; i < 4; ++i) { qs[i] = sel[4 * g + i]; s4[i] = sc[4 * g + i]; } }
            int i1 = 0; float b1 = qs[0];
#pragma unroll
            for (int i = 1; i < 4; ++i) if (qs[i] > b1) { b1 = qs[i]; i1 = i; }
            int i2 = -1; float b2 = -1.0e30f;
#pragma unroll
            for (int i = 0; i < 4; ++i) if (i != i1 && qs[i] > b2) { b2 = qs[i]; i2 = i; }
            const int ia = (i1 < i2) ? i1 : i2, ib = (i1 < i2) ? i2 : i1;
            float sa = 0.f, sb = 0.f;
#pragma unroll
            for (int i = 0; i < 4; ++i) { if (i == ia) sa = s4[i]; if (i == ib) sb = s4[i]; }
            const int pidx = (ia == 0) ? (ib - 1) : ((ia == 1) ? (ib + 1) : 5);
            const float inv = 1.0f / (sa + sb);
            my_cls = gi * 6 + pidx; my_ga = sa * inv; my_gb = sb * inv;
        }
        int rank = 0;
        if (act && lane < 16) rank = __hip_atomic_fetch_add(hist + my_cls, 1, __ATOMIC_RELAXED, __HIP_MEMORY_SCOPE_WORKGROUP);
        __syncthreads();
        if (X.tid < NCLS) { const int n = hist[X.tid]; cbase[X.tid] = n ? (int)__hip_atomic_fetch_add(cnt + 64 * X.tid, (unsigned)n, RLX_AGENT) : 0; }
        __syncthreads();
        if (act && lane < 16) { const int tok = row0 + lane; const int pos = cbase[my_cls] + rank;
            tokl[my_cls * CLS_CAP + pos] = tok; tgate[tok * 2] = my_ga; tgate[tok * 2 + 1] = my_gb; }
    }
}
DI MoeTab moe_tables(const Args& a, const Ctx& X, int l) {
    LAS int* tab = (LAS int*)(X.lds + TAB_OFF); LAS int* tcls = tab; LAS int* tpos = tab + 160; LAS int* cn = tab + 320; LAS int* rt_ = tab + 344;
    unsigned* cnt = (unsigned*)(a.ws + WS_CTL) + CW_CNT + l * 2048;
    if (X.tid < NCLS) cn[X.tid] = (int)__hip_atomic_load(cnt + 64 * X.tid, RLX_AGENT);
    __syncthreads();
    if (X.tid == 0) { int r = 0;
#pragma unroll 1
        for (int c = 0; c < NCLS; ++c) { const int n = (cn[c] + 255) >> 8;
#pragma unroll 1
            for (int i = 0; i < n; ++i) { tcls[r] = c; tpos[r] = i * 256; ++r; } }
        rt_[0] = r; }
    __syncthreads();
    MoeTab tb; tb.tcls = tcls; tb.tpos = tpos; tb.cnt = cn; tb.Rtot = __builtin_amdgcn_readfirstlane(rt_[0]); return tb;
}

#if defined(__HIP_DEVICE_COMPILE__)
DI Args load_args() { auto p = __builtin_amdgcn_kernarg_segment_ptr(); asm volatile("" : "+s"(p)); return *(const __attribute__((address_space(4))) Args*)p; }
#else
DI Args load_args() { return Args{}; }
#endif
__global__ void __launch_bounds__(512, 2) fwd(Args a_unused) {
    extern __shared__ __attribute__((aligned(16))) unsigned char lds_raw[];
    Ctx X; X.lds = (LAS unsigned char*)lds_raw; X.tid = threadIdx.x; X.lane = X.tid & 63; X.wave = __builtin_amdgcn_readfirstlane(X.tid >> 6); X.G = gridDim.x; X.bid = blockIdx.x;
    volatile LAS unsigned* MISC = (volatile LAS unsigned*)(X.lds + MISC_OFF);
    if (X.tid < 64) MISC[X.tid] = 0u;
    __syncthreads();
    int lo, hi; unsigned* ctl;
    { const Args a = load_args(); lo = a.ph_lo; hi = a.ph_hi; ctl = (unsigned*)(a.ws + WS_CTL); }
    XcdBarrier bar; bar.bar = ctl + CW_BAR; bar.x = 0; bar.st = MISC + 8;
    if (hi - lo > 1) bar = xcd_barrier_post(ctl + CW_BAR, MISC + 8);
#ifndef PH_MASK
#define PH_MASK 0xFFFFF
#endif
#define PON(p) ((PH_MASK >> (p)) & 1)
#ifndef DUP_MASK
#define DUP_MASK 0
#endif
#define NREP(p) (((DUP_MASK >> (p)) & 1) ? 2 : 1)
#ifndef TSEL_MASK
#define TSEL_MASK 0
#endif
#define TSCALE 4
#define TSEL(p) ((TSEL_MASK >> (p)) & 1)
#define IN(k) (lo <= (k) && (k) < hi)
#define SEAM(k) do { if (IN(k) && IN((k) + 1)) xcd_barrier(bar); } while (0)
    unsigned long long tacc = 0ull, tph = 0ull;
#define TBEG() do { if (TSEL_MASK) tph = __builtin_amdgcn_s_memrealtime(); } while (0)
#define TEND(p) do { if (TSEL(p)) tacc += __builtin_amdgcn_s_memrealtime() - tph; } while (0)
    TBEG();
    if (PON(10) && IN(0)) { for (int rep = 0; rep < NREP(10); ++rep) { const Args a = load_args(); p0_prologue(a, X); } }
    SEAM(0); TEND(10);
    TBEG();
    for (int l = 0; l < NL; ++l) {
        const int g0 = 1 + l * NPH;
        if (PON(0) && IN(g0 + 0)) { for (int rep = 0; rep < NREP(0); ++rep) { const Args a = load_args(); unsigned char* ws = a.ws; const float* mod = (const float*)(ws + WS_MOD); bf16* proj = (bf16*)(ws + WS_PROJ); bf16* xb = (bf16*)(ws + WS_XB); (void)mod; (void)proj; (void)xb; const Ctx P = fresh(X); p1_norm_gates(a, P, l, xb); } }
        SEAM(g0 + 0); TEND(0); TBEG();
        if (PON(1) && IN(g0 + 1)) for (int rep = 0; rep < NREP(1); ++rep) { const Args a = load_args(); unsigned char* ws = a.ws; const float* mod = (const float*)(ws + WS_MOD); bf16* proj = (bf16*)(ws + WS_PROJ); bf16* xb = (bf16*)(ws + WS_XB); (void)mod; (void)proj; (void)xb; const Ctx P = fresh(X);
            DenseSched S; S.A = (const char*)(ws + WS_H); S.Bt = (const char*)(ws + WS_WIN) + (size_t)l * NPROJW * D; S.lda = D; S.ldb = D; S.ord.init(T / 256, NPROJW / 256, P.G, P.bid);
            EpiProj E; E.O = proj; E.gates = (float*)(ws + WS_GATES); E.big = a.b_ig + l * 4; E.bfg = a.b_fg + l * 4;
            pg8::gemm_phase<EpiProj, DenseSched, true>(P.lds, D, S, E);
        }
        SEAM(g0 + 1); TEND(1); TBEG();
        if (PON(2) && IN(g0 + 2)) { const Args a = load_args(); unsigned char* ws = a.ws; const float* mod = (const float*)(ws + WS_MOD); bf16* proj = (bf16*)(ws + WS_PROJ); bf16* xb = (bf16*)(ws + WS_XB); (void)mod; (void)proj; (void)xb; const Ctx P = fresh(X);
            if (PON(11)) for (int rep = 0; rep < NREP(11); ++rep) {
#pragma unroll 1
                for (int u = P.bid; u < 512; u += P.G) attn_unit(a, P, l, u); }
            if (PON(12)) for (int rep = 0; rep < NREP(12); ++rep) {
#pragma unroll 1
                for (int u = P.bid; u < 256; u += P.G) mlstm_unit<false>(a, P, l, u); }
        }
        SEAM(g0 + 2); TEND(2); TBEG();
        if (PON(3) && IN(g0 + 3)) { const Args a = load_args(); unsigned char* ws = a.ws; const float* mod = (const float*)(ws + WS_MOD); bf16* proj = (bf16*)(ws + WS_PROJ); bf16* xb = (bf16*)(ws + WS_XB); (void)mod; (void)proj; (void)xb; const Ctx P = fresh(X); mlstm_scan(a, P); }
        SEAM(g0 + 3); TEND(3); TBEG();
        if (PON(4) && IN(g0 + 4)) for (int rep = 0; rep < NREP(4); ++rep) { const Args a = load_args(); unsigned char* ws = a.ws; const float* mod = (const float*)(ws + WS_MOD); bf16* proj = (bf16*)(ws + WS_PROJ); bf16* xb = (bf16*)(ws + WS_XB); (void)mod; (void)proj; (void)xb; const Ctx P = fresh(X);
#pragma unroll 1
            for (int u = P.bid; u < 256; u += P.G) mlstm_unit<true>(a, P, l, u); }
        SEAM(g0 + 4); TEND(4); TBEG();
        if (PON(5) && IN(g0 + 5)) for (int rep = 0; rep < NREP(5); ++rep) { const Args a = load_args(); unsigned char* ws = a.ws; const float* mod = (const float*)(ws + WS_MOD); bf16* proj = (bf16*)(ws + WS_PROJ); bf16* xb = (bf16*)(ws + WS_XB); (void)mod; (void)proj; (void)xb; const Ctx P = fresh(X);
            MergeSched S; S.A0 = (const char*)(ws + WS_H); S.A1 = (const char*)(ws + WS_H) + (size_t)T * 512 * 2; S.B0 = (const char*)(ws + WS_WAU) + (size_t)l * D * 512 * 2; S.B1 = (const char*)(ws + WS_WMU) + (size_t)l * D * 512 * 2;
            S.lda = 1024; S.ldb = 1024; S.ord.init(T / 256, D / 256, P.G, P.bid);
            EpiMerge E; E.P = proj; pg8::gemm_phase<EpiMerge, MergeSched>(P.lds, 2048, S, E);
        }
        SEAM(g0 + 5); TEND(5); TBEG();
        if (PON(6) && IN(g0 + 6)) for (int rep = 0; rep < NREP(6); ++rep) { const Args a = load_args(); unsigned char* ws = a.ws; const float* mod = (const float*)(ws + WS_MOD); bf16* proj = (bf16*)(ws + WS_PROJ); bf16* xb = (bf16*)(ws + WS_XB); (void)mod; (void)proj; (void)xb; const Ctx P = fresh(X);
            DenseSched S; S.A = (const char*)(proj + C_MQ); S.Bt = (const char*)(ws + WS_WOUT) + (size_t)l * D * D * 2; S.lda = NPROJ * 2; S.ldb = D * 2; S.ord.init(T / 256, D / 256, P.G, P.bid);
            EpiRes E; E.xin = xb; E.out = xb; E.g = mod + (size_t)(l * 2) * 6144 + 2 * 1024; E.ssq = (float*)(ws + WS_SSQ); E.rmask = T - 1;
            if (rep) { E.out = (bf16*)(ws + WS_H); E.rmask = T / 2 - 1; }
            pg8::gemm_phase<EpiRes, DenseSched>(P.lds, D * 2, S, E);
        }
        SEAM(g0 + 6); TEND(6); TBEG();
        if (PON(7) && IN(g0 + 7)) { const Args a = load_args(); unsigned char* ws = a.ws; const float* mod = (const float*)(ws + WS_MOD); bf16* proj = (bf16*)(ws + WS_PROJ); bf16* xb = (bf16*)(ws + WS_XB); (void)mod; (void)proj; (void)xb; const Ctx P = fresh(X); p6_norm_route(a, P, l, xb); }
        SEAM(g0 + 7); TEND(7); TBEG();
        if (PON(8) && IN(g0 + 8)) for (int rep = 0; rep < NREP(8); ++rep) { const Args a = load_args(); unsigned char* ws = a.ws; const float* mod = (const float*)(ws + WS_MOD); bf16* proj = (bf16*)(ws + WS_PROJ); bf16* xb = (bf16*)(ws + WS_XB); (void)mod; (void)proj; (void)xb; const Ctx P = fresh(X);
            const MoeTab tb = moe_tables(a, P, l);
            LAS unsigned* tokoff = (LAS unsigned*)(P.lds + TOKOFF_OFF); const int* tokl = (const int*)(ws + WS_TOKL);
#pragma unroll 1
            for (int s = 0; s < 8; ++s) { const int L0 = s * P.G + P.bid;
                if (L0 < tb.Rtot * 8 && P.tid < 256) { const int L = xcd_remap(L0, tb.Rtot * 8); const int rt = L >> 3, cls = tb.tcls[rt], pos = tb.tpos[rt] + P.tid, cn = tb.cnt[cls]; const int tok = tokl[cls * CLS_CAP + (pos < cn ? pos : 0)]; tokoff[s * 256 + P.tid] = (unsigned)tok; } }
            __syncthreads();
            MoeUpSched S; S.A = (const char*)(ws + WS_H); S.W = (const char*)(ws + WS_WGU) + (size_t)l * NE * 1024 * D; S.lda = D; S.ldb = D; S.tb = tb; S.G = P.G; S.c = P.bid; S.tokoff = tokoff;
            EpiSwiglu E; E.H = proj; E.tgate = (const float*)(ws + WS_TGATE); E.tokoff = tokoff;
            pg8::gemm_phase<EpiSwiglu, MoeUpSched, true>(P.lds, D, S, E);
        }
        SEAM(g0 + 8); TEND(8); TBEG();
        if (PON(9) && IN(g0 + 9)) for (int rep = 0; rep < NREP(9); ++rep) { const Args a = load_args(); unsigned char* ws = a.ws; const float* mod = (const float*)(ws + WS_MOD); bf16* proj = (bf16*)(ws + WS_PROJ); bf16* xb = (bf16*)(ws + WS_XB); (void)mod; (void)proj; (void)xb; const Ctx P = fresh(X);
            const MoeTab tb = moe_tables(a, P, l);
            MoeDownSched S; S.A = (const char*)proj; S.W = (const char*)(ws + WS_WD) + (size_t)l * NE * 1024 * FF * 2; S.lda = D * 2; S.ldb = FF * 2; S.tb = tb; S.G = P.G; S.c = P.bid;
            EpiMoeOut E; E.xin = xb; E.outb = xb; E.outf = a.out; E.last = (l == NL - 1); E.g = mod + (size_t)(l * 2) * 6144 + 5 * 1024; E.tokl = (const int*)(ws + WS_TOKL); E.tb = tb; E.rmask = T - 1;
            if (rep) { E.outb = (bf16*)(ws + WS_H); E.last = 0; E.rmask = T / 2 - 1; }
            pg8::gemm_phase<EpiMoeOut, MoeDownSched>(P.lds, D * 2, S, E);
        }
        SEAM(g0 + 9); TEND(9); TBEG();
    }
    if (TSEL_MASK && X.bid == 0) { const unsigned long long t1 = __builtin_amdgcn_s_memrealtime(); while (__builtin_amdgcn_s_memrealtime() - t1 < TSCALE * tacc) __builtin_amdgcn_s_sleep(8); }
#undef IN
#undef SEAM
}

extern "C" void kernel_launch(void* const* d_in, const int* in_sizes, int n_in, void* d_out, int out_size, void* d_ws, size_t ws_size, hipStream_t stream) {
    static int grid = 0;
    if (grid == 0) {
        if (n_in != 24 || in_sizes[0] != T * D || out_size != T * D || ws_size < WS_END) { fprintf(stderr, "kernel_launch: unexpected shapes / workspace (n_in %d, ws %zu, need %zu)\n", n_in, ws_size, (size_t)WS_END); grid = -1; return; }
        int dev = 0, cus = 0;
        if (hipGetDevice(&dev) != hipSuccess || hipDeviceGetAttribute(&cus, hipDeviceAttributeMultiprocessorCount, dev) != hipSuccess) { grid = -1; return; }
        if (hipFuncSetAttribute((const void*)fwd, hipFuncAttributeMaxDynamicSharedMemorySize, LDS_BYTES) != hipSuccess) { fprintf(stderr, "kernel_launch: hipFuncSetAttribute failed\n"); grid = -1; return; }
        int per_cu = 0;
        if (hipOccupancyMaxActiveBlocksPerMultiprocessor(&per_cu, (const void*)fwd, 512, LDS_BYTES) != hipSuccess || per_cu < 1) fprintf(stderr, "kernel_launch: occupancy query reports %d\n", per_cu);
        (void)hipGetLastError();
        grid = cus < 256 ? cus : 256;
    }
    if (grid < 0) return;
    (void)hipMemsetAsync((char*)d_ws + WS_CTL, 0, CTL_ZERO_BYTES, stream);
    Args a{};
    a.x = (const float*)d_in[0]; a.c = (const float*)d_in[1]; a.pos = (const int*)d_in[2]; a.ada_w = (const float*)d_in[3]; a.ada_b = (const float*)d_in[4];
    a.nmw = (const float*)d_in[5]; a.nfw = (const float*)d_in[6]; a.w_in = (const float*)d_in[7]; a.b_ig = (const float*)d_in[8]; a.b_fg = (const float*)d_in[9];
    a.qnw = (const float*)d_in[10]; a.knw = (const float*)d_in[11]; a.sinks = (const float*)d_in[12]; a.conv_w = (const float*)d_in[13]; a.conv_b = (const float*)d_in[14];
    a.mnw = (const float*)d_in[15]; a.w_au = (const float*)d_in[16]; a.w_mu = (const float*)d_in[17]; a.w_out = (const float*)d_in[18]; a.router_w = (const float*)d_in[19];
    a.router_b = (const float*)d_in[20]; a.w_gate = (const float*)d_in[21]; a.w_up = (const float*)d_in[22]; a.w_down = (const float*)d_in[23];
    a.out = (float*)d_out; a.ws = (unsigned char*)d_ws;
#if MK_MULTI
    for (int gp = 0; gp < NGP; ++gp) { a.ph_lo = gp; a.ph_hi = gp + 1; hipLaunchKernelGGL(fwd, dim3(grid), dim3(512), LDS_BYTES, stream, a); }
#else
    a.ph_lo = 0; a.ph_hi = NGP; hipLaunchKernelGGL(fwd, dim3(grid), dim3(512), LDS_BYTES, stream, a);
#endif
}
```

```cpp
#include <hip/hip_runtime.h>
#include <cstdio>
#include <cstdint>

#ifndef MK_MULTI
#define MK_MULTI 0
#endif

#define GAS __attribute__((address_space(1)))
#define LAS __attribute__((address_space(3)))
typedef unsigned short bf16;
typedef unsigned v4u __attribute__((ext_vector_type(4)));
typedef unsigned v2u __attribute__((ext_vector_type(2)));
typedef float f32x4 __attribute__((ext_vector_type(4)));
typedef float f32x2 __attribute__((ext_vector_type(2)));
typedef short bf16x8 __attribute__((ext_vector_type(8)));
typedef short bf16x4 __attribute__((ext_vector_type(4)));
#define DI __device__ __forceinline__
#define RLX_AGENT __ATOMIC_RELAXED, __HIP_MEMORY_SCOPE_AGENT
#define LDS_WAIT() asm volatile("s_waitcnt lgkmcnt(0)" ::: "memory")
#define VM_WAIT() asm volatile("s_waitcnt vmcnt(0)" ::: "memory")

constexpr int NB = 2, SEQ = 16384, T = NB * SEQ, D = 1024, NL = 4;
constexpr int DIN_SRC = 4872;
constexpr int NPROJ = 4864;
constexpr int C_AQ = 0, C_AK = 512, C_AV = 640, C_MQ = 768, C_MK = 1280, C_MV = 1792, C_MO = 2304, C_GA = 2816, C_GB = 3840;
constexpr int NE = 16, FF = 512;
constexpr int NCLS = 24, CLS_CAP = 32768;
constexpr float EPS = 1e-6f;
constexpr int NPH = 10;
constexpr int NGP = 1 + NL * NPH;

constexpr size_t MiB = 1u << 20;
constexpr size_t WS_CTL = 0, CTL_ZERO_BYTES = 1 * MiB;
constexpr size_t WS_MOD = 1 * MiB;
constexpr size_t WS_ROPE = 2 * MiB;
constexpr size_t WS_GATES = 4 * MiB;
constexpr size_t WS_TGATE = 5 * MiB;
constexpr size_t WS_TOKL = 6 * MiB;
constexpr size_t WS_MLB = 9 * MiB;
constexpr size_t WS_MLC = 10 * MiB;
constexpr int NPROJW = 5120;
constexpr size_t WS_WIN = 28 * MiB;
constexpr size_t WS_WAU = 68 * MiB;
constexpr size_t WS_WMU = 72 * MiB;
constexpr size_t WS_WOUT = 76 * MiB;
constexpr size_t WS_WGU = 84 * MiB;
constexpr size_t WS_WD = 148 * MiB;
constexpr size_t WS_H = 212 * MiB;
constexpr size_t WS_PROJ = 276 * MiB;
constexpr size_t WS_SSQ = 580 * MiB;
constexpr size_t WS_KC = 582 * MiB;
constexpr size_t WS_XB = 614 * MiB;
constexpr size_t WS_END = 678 * MiB;

constexpr int CW_TMO = 0;
constexpr int CW_BAR = 4096;
constexpr int CW_CNT = 8192;

constexpr int RING_BYTES = 131072;
constexpr int MISC_OFF = RING_BYTES;
constexpr int TAB_OFF = RING_BYTES + 256;
constexpr int TOKOFF_OFF = RING_BYTES + 2048;
constexpr int LDS_BYTES = 147456;

typedef __bf16 bf16x2_t __attribute__((ext_vector_type(2)));
DI unsigned cvt_pk_bf16(float lo, float hi) { const f32x2 v = {lo, hi}; return __builtin_bit_cast(unsigned, __builtin_convertvector(v, bf16x2_t)); }
DI unsigned pk2m(float lo, float hi) { return cvt_pk_bf16(lo, hi); }
DI unsigned f2bf(float f) { return cvt_pk_bf16(f, 0.f) & 0xffffu; }
DI unsigned pk2(float lo, float hi) { return cvt_pk_bf16(lo, hi); }
DI float bf2f(unsigned short b) { return __builtin_bit_cast(float, ((unsigned)b) << 16); }
DI float bflo(unsigned w) { return __builtin_bit_cast(float, w << 16); }
DI float bfhi(unsigned w) { return __builtin_bit_cast(float, w & 0xffff0000u); }
DI float wave_sum(float v) {
#pragma unroll
    for (int o = 1; o < 64; o <<= 1) v += __shfl_xor(v, o);
    return v;
}
DI unsigned pk4_fp8(float a0, float a1, float a2, float a3) { int p = __builtin_amdgcn_cvt_pk_fp8_f32(a0, a1, 0, false); p = __builtin_amdgcn_cvt_pk_fp8_f32(a2, a3, p, true); return (unsigned)p; }
DI float sigmoidf_(float x) { return __builtin_amdgcn_rcpf(1.0f + __expf(-x)); }

#define XB_TMO      128
#define XB_XCNT(j)  (256  + 64 * (j))
#define XB_XSUB(j)  (1280 + 64 * (j))
#define XB_XGEN(j)  (2304 + 64 * (j))
#define XB_TOP      3328
#define XB_TOPGEN   3392
#define XCD_BAR_WORDS 3456
#define XB_SPIN_CAP (1u << 18)
__device__ __forceinline__ unsigned xb_ld(unsigned* p)              { return __hip_atomic_load(p, __ATOMIC_RELAXED, __HIP_MEMORY_SCOPE_AGENT); }
__device__ __forceinline__ unsigned xb_add(unsigned* p, unsigned v) { return __hip_atomic_fetch_add(p, v, __ATOMIC_RELAXED, __HIP_MEMORY_SCOPE_AGENT); }
__device__ __forceinline__ unsigned xb_xcc_id() { return (unsigned)__builtin_amdgcn_s_getreg((3 << 11) | 20) & 0xFu; }
#define XB_SPIN(cond, bar) do { unsigned _sp = 0; while (cond) { __builtin_amdgcn_s_sleep(1); \
    if ((++_sp & 255u) == 0u) { if (xb_ld(&(bar)[XB_TMO])) break; if (_sp > XB_SPIN_CAP) { atomicAdd(&(bar)[XB_TMO], 1u); break; } } } } while (0)
struct XcdBarrier { unsigned* bar; unsigned x; volatile LAS unsigned* st; };
__device__ __forceinline__ XcdBarrier xcd_barrier_post(unsigned* bar, volatile LAS unsigned* st) {
    XcdBarrier b; b.bar = bar; b.x = xb_xcc_id(); b.st = st;
    if (threadIdx.x == 0) (void)xb_add(&bar[XB_XCNT(b.x)], 1u);
    return b;
}
__device__ __forceinline__ void xcd_barrier_complete(unsigned* bar, unsigned x, unsigned& nloc, unsigned& nx) {
    const unsigned G = gridDim.x * gridDim.y * gridDim.z;
    unsigned sum, cnt, mine, sp = 0u;
    for (;;) {
        sum = 0u; cnt = 0u; mine = 0u;
#pragma unroll
        for (unsigned j = 0; j < 16; ++j) { const unsigned c = xb_ld(&bar[XB_XCNT(j)]); sum += c; cnt += (c > 0u) ? 1u : 0u; mine = (j == x) ? c : mine; }
        if (sum == G) break;
        __builtin_amdgcn_s_sleep(1);
        if ((++sp & 255u) == 0u) { if (xb_ld(&bar[XB_TMO])) break; if (sp > XB_SPIN_CAP) { atomicAdd(&bar[XB_TMO], 1u); break; } }
    }
    nloc = mine > 0u ? mine : 1u; nx = cnt > 0u ? cnt : 1u;
}
__device__ __forceinline__ void xcd_barrier(const XcdBarrier& b) {
    asm volatile("s_waitcnt vmcnt(0)" ::: "memory");
    __syncthreads();
    if (threadIdx.x == 0) {
        unsigned* bar = b.bar;
        __builtin_amdgcn_s_waitcnt(0);
        unsigned nloc = b.st[0], nx = b.st[1];
        if (nloc == 0u) { xcd_barrier_complete(bar, b.x, nloc, nx); b.st[0] = nloc; b.st[1] = nx; }
        const unsigned old = xb_add(&bar[XB_XSUB(b.x)], 1u);
        const unsigned gen = old / nloc;
        if (old + 1u == (gen + 1u) * nloc) {
            __builtin_amdgcn_fence(__ATOMIC_RELEASE, "agent");
            asm volatile("s_waitcnt vmcnt(0)" ::: "memory");
            const unsigned og = xb_add(&bar[XB_TOP], 1u);
            const unsigned tg = og / nx;
            if (og + 1u == (tg + 1u) * nx) xb_add(&bar[XB_TOPGEN], 1u);
            else XB_SPIN(xb_ld(&bar[XB_TOPGEN]) == tg, bar);
            __builtin_amdgcn_fence(__ATOMIC_ACQUIRE, "agent");
            xb_add(&bar[XB_XGEN(b.x)], 1u);
            asm volatile("s_waitcnt vmcnt(0)" ::: "memory");
        } else {
            XB_SPIN(xb_ld(&bar[XB_XGEN(b.x)]) == gen, bar);
            __builtin_amdgcn_fence(__ATOMIC_ACQUIRE, "agent");
            asm volatile("s_waitcnt vmcnt(0)" ::: "memory");
        }
    }
    __syncthreads();
}

namespace pg8 {
constexpr int BM = 256, BK = 64, HALF = 128, HTB = HALF * BK * 2, STAGE_BYTES = 8 * HTB, NXCD = 8, WGM = 8;
__host__ __device__ __forceinline__ int lds_byte(int r, int c) { const int st = (r >> 4) * 2 + (c >> 5), rr = r & 15, cc = c & 31, ob = rr * 64 + cc * 2; return st * 1024 + (ob ^ (((ob >> 9) & 1) << 5)); }
__host__ __device__ __forceinline__ void stage_rc(int b, int& R, int& C) { const int st = b / 1024, sb = b % 1024, swz = sb ^ (((sb >> 9) & 1) << 5); R = (st >> 1) * 16 + swz / 64; C = (st & 1) * 32 + (swz % 64) / 2; }
__host__ __device__ __forceinline__ int perm32(int rho) { const int n = rho >> 4, i = rho & 15; return 8 * (i >> 2) + 4 * n + (i & 3); }

struct Unit { int pm, pn, x0, x1; };

struct TileOrder {
    int nM, nN, nwg, G, c;
    __device__ void init(int nM_, int nN_, int G_, int c_) { nM = nM_; nN = nN_; nwg = nM * nN; G = G_; c = c_; }
    __device__ bool get(int i, int& pm, int& pn) const {
        const long L = (long)i * G + c; if (L >= nwg) return false;
        int wgid = (int)L; { const int q = nwg / NXCD, r = nwg % NXCD, xcd = wgid % NXCD, off = wgid / NXCD; wgid = (xcd < r ? xcd * (q + 1) : r * (q + 1) + (xcd - r) * q) + off; }
        const int nig = WGM * nN, gid = wgid / nig, fm = gid * WGM, gsz = (nM - fm) < WGM ? (nM - fm) : WGM;
        pm = fm + ((wgid % nig) % gsz); pn = (wgid % nig) / gsz; return true;
    }
};

typedef int v8i __attribute__((ext_vector_type(8)));
template <class Epi, class Sched, bool F8 = false>
__device__ __forceinline__ void gemm_phase(LAS unsigned char* lds, const int Kb, const Sched& S, const Epi& E) {
    int tid = threadIdx.x; asm volatile("" : "+v"(tid));
    const int wid = __builtin_amdgcn_readfirstlane(tid >> 6), lane = tid & 63, wr = wid >> 2, wc = wid & 3, fr = lane & 15, fq = lane >> 4;
    const int nt = Kb / 128;
    constexpr bool GA = Sched::GATHER; constexpr int KS = Sched::KSPLIT; constexpr bool ASPLIT = Sched::ASPLIT;
    unsigned voffA[2], voffB[2]; int Rst[2], Cst[2];
#pragma unroll
    for (int i = 0; i < 2; ++i) { int R, C; stage_rc(tid * 16 + i * 8192, R, C); const int Rb = Epi::PERM ? ((R & ~31) + perm32(R & 31)) : R;
        voffA[i] = (unsigned)(R * S.lda + C * 2); voffB[i] = (unsigned)(Rb * S.ldb + C * 2); Rst[i] = R; Cst[i] = C; }
    const size_t kstep = (size_t)(BK * 2);
    const size_t hstepA = (size_t)HALF * S.lda, hstepB = (size_t)HALF * S.ldb;
    const unsigned ldsw = (unsigned)wid * 1024u; const unsigned gmul = (unsigned)S.lda;
    const int aoff = F8 ? (lds_byte(wr * 64 + fr, (fq & 1) * 16) + (fq >> 1) * 1024) : lds_byte(wr * 64 + fr, fq * 8);
    const int boff = F8 ? (lds_byte(wc * 32 + fr, (fq & 1) * 16) + (fq >> 1) * 1024) : lds_byte(wc * 32 + fr, fq * 8);
    unsigned vAc[2], vAn[2];
#define PG8_SA(b, h) (((b) * 2 + (h)) * HTB)
#define PG8_SB(b, h) ((4 + (b) * 2 + (h)) * HTB)
#define PG8_STAGE2(bufoff, gbase, v0, v1) do { \
        __builtin_amdgcn_global_load_lds((const unsigned*)((const char*)(gbase) + (v0)), (LAS unsigned*)(lds + (bufoff) + ldsw), 16, 0, 0); \
        __builtin_amdgcn_global_load_lds((const unsigned*)((const char*)(gbase) + (v1)), (LAS unsigned*)(lds + (bufoff) + ldsw + 8192), 16, 0, 0); } while (0)
#define PG8_STAGE_B(bufoff, ptr, h) PG8_STAGE2(bufoff, (ptr) + (h) * hstepB, voffB[0], voffB[1])
#define PG8_STAGE_A(bufoff, ptr, h, nx) do { if constexpr (GA) { const unsigned _p = (nx) ? vAn[h] : vAc[h]; PG8_STAGE2(bufoff, ptr, (_p & 0xffffu) * gmul + (unsigned)Cst[0] * 2u, (_p >> 16) * gmul + (unsigned)Cst[0] * 2u); } \
        else { PG8_STAGE2(bufoff, (ptr) + (h) * hstepA, voffA[0], voffA[1]); } } while (0)
    typedef int v4i_ __attribute__((ext_vector_type(4)));
#define PG8_LDA(dst, b, h) do { _Pragma("unroll") for (int m = 0; m < 4; ++m) { if constexpr (F8) { dst##8[m].lo = *(const LAS v4i_*)(lds + PG8_SA(b, h) + aoff + m * 2048); dst##8[m].hi = *(const LAS v4i_*)(lds + PG8_SA(b, h) + aoff + m * 2048 + 16); } \
        else { _Pragma("unroll") for (int k = 0; k < 2; ++k) dst[m][k] = *(const LAS bf16x8*)(lds + PG8_SA(b, h) + aoff + m * 2048 + k * 1024); } } } while (0)
#define PG8_LDB(dst, b, h) do { _Pragma("unroll") for (int n = 0; n < 2; ++n) { if constexpr (F8) { dst##8[n].lo = *(const LAS v4i_*)(lds + PG8_SB(b, h) + boff + n * 2048); dst##8[n].hi = *(const LAS v4i_*)(lds + PG8_SB(b, h) + boff + n * 2048 + 16); } \
        else { _Pragma("unroll") for (int k = 0; k < 2; ++k) dst[n][k] = *(const LAS bf16x8*)(lds + PG8_SB(b, h) + boff + n * 2048 + k * 1024); } } } while (0)
#define PG8_MMA(ai, bj, At, Bt) do { __builtin_amdgcn_s_setprio(1); _Pragma("unroll") for (int m = 0; m < 4; ++m) _Pragma("unroll") for (int n = 0; n < 2; ++n) { \
        if constexpr (F8) { asm volatile("v_mfma_scale_f32_16x16x128_f8f6f4 %0, %1, %2, %0, %3, %3 op_sel_hi:[0,0,0]" : "+v"(acc[ai][bj][m][n]) : "v"(Bt##8[n]), "v"(At##8[m]), "v"(f8scale)); } \
        else { _Pragma("unroll") for (int k = 0; k < 2; ++k) acc[ai][bj][m][n] = __builtin_amdgcn_mfma_f32_16x16x32_bf16(Bt[n][k], At[m][k], acc[ai][bj][m][n], 0, 0, 0); } } \
        __builtin_amdgcn_s_setprio(0); } while (0)
#define PG8_WAIT_V(n) asm volatile("s_waitcnt vmcnt(" #n ")" ::: "memory")
#define PG8_WAIT_L(n) asm volatile("s_waitcnt lgkmcnt(" #n ")" ::: "memory")
#define PG8_BAR __builtin_amdgcn_s_barrier()
#define PG8_SCHED __builtin_amdgcn_sched_barrier(0)
#define PG8_GOFF(dst, u) do { if constexpr (GA) { _Pragma("unroll") for (int h = 0; h < 2; ++h) dst[h] = S.a_rowoff(u, Rst[0] + HALF * h) | (S.a_rowoff(u, Rst[0] + 64 + HALF * h) << 16); } } while (0)
    Unit cur, nxt; int ui = 0;
    if (!S.next(0, cur)) return;
    f32x4 acc[2][2][4][2];
#pragma unroll
    for (int a = 0; a < 2; ++a)
#pragma unroll
        for (int b = 0; b < 2; ++b)
#pragma unroll
            for (int m = 0; m < 4; ++m)
#pragma unroll
                for (int n = 0; n < 2; ++n) acc[a][b][m][n] = (f32x4){0.f, 0.f, 0.f, 0.f};
    int f8scale = 0x7F7F7F7F; asm volatile("" : "+v"(f8scale));
    bf16x8 At[4][2], B0[2][2], B1[2][2]; v8i At8[4], B08[2], B18[2];
    const char* cA = S.a_base(cur, 0); const char* cA1 = ASPLIT ? S.a_base(cur, 1) : cA; const char* cB0 = S.b_base(cur, 0); const char* cB1 = KS ? S.b_base(cur, 1) : cB0;
    PG8_GOFF(vAc, cur);
    vAn[0] = vAc[0]; vAn[1] = vAc[1];
    PG8_STAGE_B(PG8_SB(0, 0), cB0, 0); PG8_STAGE_B(PG8_SB(0, 1), cB0, 1); PG8_STAGE_A(PG8_SA(0, 0), cA, 0, false); PG8_STAGE_A(PG8_SA(0, 1), cA, 1, false);
    if (wr == 1) PG8_BAR;
    PG8_WAIT_V(2); PG8_BAR;
    PG8_STAGE_B(PG8_SB(1, 0), cB0 + kstep, 0); PG8_STAGE_A(PG8_SA(1, 0), cA + kstep, 0, false); PG8_STAGE_B(PG8_SB(1, 1), cB0 + kstep, 1);
    PG8_WAIT_V(6); PG8_BAR;
    for (;;) {
        const bool has_next = S.next(ui + 1, nxt);
        const char* nA = has_next ? S.a_base(nxt, 0) : cA; const char* nA1 = (ASPLIT && has_next) ? S.a_base(nxt, 1) : (ASPLIT ? cA1 : nA); const char* nB0 = has_next ? S.b_base(nxt, 0) : cB0; const char* nB1 = (KS && has_next) ? S.b_base(nxt, 1) : (KS ? cB1 : nB0);
        if constexpr (GA) { if (has_next) { PG8_GOFF(vAn, nxt); } }
#pragma unroll 1
        for (int t = 0; t < nt; t += 2) {
            const bool last = (t == nt - 2);
            const char* a1 = (ASPLIT && (t + 1) >= KS) ? cA1 + (size_t)(t + 1 - KS) * kstep : cA + (size_t)(t + 1) * kstep;
            const char* a2 = last ? nA : ((ASPLIT && (t + 2) >= KS) ? cA1 + (size_t)(t + 2 - KS) * kstep : cA + (size_t)(t + 2) * kstep);
            if constexpr (Epi::MID) { if (t == KS) { int fr_ = fr, fq_ = fq; asm volatile("" : "+v"(fr_), "+v"(fq_)); E.mid(acc, cur, wr, wc, fr_, fq_); } }
            const char* b2 = last ? nB0 : ((KS && (t + 2) >= KS) ? cB1 + (size_t)(t + 2 - KS) * kstep : cB0 + (size_t)(t + 2) * kstep);
            const char* a3 = a2 + kstep; const char* b3 = b2 + kstep;
            PG8_LDB(B0, 0, 0); PG8_LDB(B1, 0, 1); PG8_SCHED; PG8_LDA(At, 0, 0); PG8_STAGE_A(PG8_SA(1, 1), a1, 1, false);
            PG8_WAIT_V(8); PG8_WAIT_L(0); PG8_BAR; PG8_MMA(0, 0, At, B0); PG8_MMA(0, 1, At, B1); PG8_BAR; PG8_SCHED;
            PG8_LDA(At, 0, 1); PG8_STAGE_B(PG8_SB(0, 0), b2, 0); PG8_STAGE_B(PG8_SB(0, 1), b2, 1); PG8_STAGE_A(PG8_SA(0, 0), a2, 0, last);
            PG8_WAIT_V(8); PG8_WAIT_L(0); PG8_BAR; PG8_MMA(1, 0, At, B0); PG8_MMA(1, 1, At, B1); PG8_BAR; PG8_SCHED;
            PG8_LDB(B0, 1, 0); PG8_LDB(B1, 1, 1); PG8_SCHED; PG8_LDA(At, 1, 0); PG8_STAGE_A(PG8_SA(0, 1), a2, 1, last);
            PG8_WAIT_V(8); PG8_WAIT_L(0); PG8_BAR; PG8_MMA(0, 0, At, B0); PG8_MMA(0, 1, At, B1); PG8_BAR; PG8_SCHED;
            PG8_LDA(At, 1, 1); PG8_STAGE_B(PG8_SB(1, 0), b3, 0); PG8_STAGE_B(PG8_SB(1, 1), b3, 1); PG8_STAGE_A(PG8_SA(1, 0), a3, 0, last);
            PG8_WAIT_V(8); PG8_WAIT_L(0); PG8_BAR; PG8_MMA(1, 0, At, B0); PG8_MMA(1, 1, At, B1); PG8_BAR; PG8_SCHED;
        }
        if (wr == 0) PG8_BAR;
        if constexpr (F8) { asm volatile("s_nop 15\n\ts_nop 15" ::: "memory"); }
        { int fr_ = fr, fq_ = fq; asm volatile("" : "+v"(fr_), "+v"(fq_));
          E(acc, cur, wr, wc, fr_, fq_); }
        if (!has_next) break;
#pragma unroll
        for (int a = 0; a < 2; ++a)
#pragma unroll
            for (int b = 0; b < 2; ++b)
#pragma unroll
                for (int m = 0; m < 4; ++m)
#pragma unroll
                    for (int n = 0; n < 2; ++n) acc[a][b][m][n] = (f32x4){0.f, 0.f, 0.f, 0.f};
        cur = nxt; cA = nA; cA1 = nA1; cB0 = nB0; cB1 = nB1; ++ui;
        vAc[0] = vAn[0]; vAc[1] = vAn[1];
        if (wr == 1) PG8_BAR;
    }
    PG8_WAIT_V(0);
    PG8_BAR;
#undef PG8_SA
#undef PG8_SB
#undef PG8_STAGE2
#undef PG8_STAGE_A
#undef PG8_STAGE_B
#undef PG8_LDA
#undef PG8_LDB
#undef PG8_MMA
#undef PG8_WAIT_V
#undef PG8_WAIT_L
#undef PG8_BAR
#undef PG8_SCHED
#undef PG8_GOFF
}
}
using pg8::Unit;


struct Args {
    const float* x; const float* c; const int* pos; const float* ada_w; const float* ada_b; const float* nmw; const float* nfw; const float* w_in;
    const float* b_ig; const float* b_fg; const float* qnw; const float* knw; const float* sinks; const float* conv_w; const float* conv_b; const float* mnw;
    const float* w_au; const float* w_mu; const float* w_out; const float* router_w; const float* router_b; const float* w_gate; const float* w_up; const float* w_down;
    float* out; unsigned char* ws; int ph_lo, ph_hi;
};

__constant__ float c_invf[8] = {1.0f, 0.1939227432012558f, 0.03760603070259094f, 0.007292664609849453f, 0.0014142135623842478f, 0.00027424818836152554f, 5.3182957344688475e-05f, 1.0313385246263351e-05f};

struct DenseSched {
    static constexpr bool GATHER = false, ASPLIT = false; static constexpr int KSPLIT = 0;
    const char* A; const char* Bt; int lda, ldb; pg8::TileOrder ord;
    DI bool next(int i, Unit& u) const { int pm, pn; if (!ord.get(i, pm, pn)) return false; u.pm = pm; u.pn = pn; u.x0 = 0; u.x1 = 0; return true; }
    DI const char* a_base(const Unit& u, int) const { return A + (size_t)u.pm * 256 * lda; }
    DI const char* b_base(const Unit& u, int) const { return Bt + (size_t)u.pn * 256 * ldb; }
    DI unsigned a_rowoff(const Unit&, int) const { return 0u; }
};
struct EpiProj {
    static constexpr bool PERM = true, MID = false;
    bf16* O; float* gates; const float* big; const float* bfg;
    DI void operator()(const f32x4 (&acc)[2][2][4][2], const Unit& u, int wr, int wc, int fr, int fq) const {
        const int row0 = u.pm * 256 + wr * 64 + fr, col0 = u.pn * 256 + wc * 32 + 8 * fq; const bool sg = u.pn >= 9; constexpr float WSC = 1.0f / 64.0f;
        if (u.pn == 19) {
            if (wc == 0 && fq == 0) {
#pragma unroll
                for (int ai = 0; ai < 2; ++ai)
#pragma unroll
                    for (int m = 0; m < 4; ++m) { const int row = row0 + ai * 128 + m * 16; const f32x4 vi = acc[ai][0][m][0], vf = acc[ai][0][m][1]; f32x4 oi, of;
#pragma unroll
                        for (int j = 0; j < 4; ++j) { oi[j] = vi[j] * WSC + big[j]; const float z = vf[j] * WSC + bfg[j]; of[j] = fminf(z, 0.f) - log1pf(__expf(-fabsf(z))); }
                        *(f32x4*)(gates + (size_t)row * 8) = oi; *(f32x4*)(gates + (size_t)row * 8 + 4) = of; } }
            return; }
#pragma unroll
        for (int ai = 0; ai < 2; ++ai)
#pragma unroll
            for (int m = 0; m < 4; ++m) { bf16* rowp = O + (size_t)(row0 + ai * 128 + m * 16) * NPROJ + col0;
#pragma unroll
                for (int bj = 0; bj < 2; ++bj) { f32x4 v0 = acc[ai][bj][m][0] * WSC, v1 = acc[ai][bj][m][1] * WSC;
                    if (sg) {
#pragma unroll
                        for (int j = 0; j < 4; ++j) { v0[j] = sigmoidf_(v0[j]); v1[j] = sigmoidf_(v1[j]); } }
                    v4u w; w.x = cvt_pk_bf16(v0[0], v0[1]); w.y = cvt_pk_bf16(v0[2], v0[3]); w.z = cvt_pk_bf16(v1[0], v1[1]); w.w = cvt_pk_bf16(v1[2], v1[3]);
                    *(v4u*)(rowp + bj * 128) = w; } }
    }
};
struct MergeSched {
    static constexpr bool GATHER = false, ASPLIT = true; static constexpr int KSPLIT = 8;
    const char* A0; const char* A1; const char* B0; const char* B1; int lda, ldb; pg8::TileOrder ord;
    DI bool next(int i, Unit& u) const { int pm, pn; if (!ord.get(i, pm, pn)) return false; u.pm = pm; u.pn = pn; u.x0 = 0; u.x1 = 0; return true; }
    DI const char* a_base(const Unit& u, int half) const { return (half ? A1 : A0) + (size_t)u.pm * 256 * lda; }
    DI const char* b_base(const Unit& u, int half) const { return (half ? B1 : B0) + (size_t)u.pn * 256 * ldb; }
    DI unsigned a_rowoff(const Unit&, int) const { return 0u; }
};
struct EpiMerge {
    static constexpr bool PERM = true, MID = true;
    bf16* P;
    DI void mid(f32x4 (&acc)[2][2][4][2], const Unit& u, int wr, int wc, int fr, int fq) const {
        const int row0 = u.pm * 256 + wr * 64 + fr, col0 = u.pn * 256 + wc * 32 + 8 * fq;
#pragma unroll
        for (int ai = 0; ai < 2; ++ai)
#pragma unroll
            for (int m = 0; m < 4; ++m) { const bf16* rowp = P + (size_t)(row0 + ai * 128 + m * 16) * NPROJ + col0;
#pragma unroll
                for (int bj = 0; bj < 2; ++bj) { const v4u ga = *(const v4u*)(rowp + C_GA + bj * 128), gb = *(const v4u*)(rowp + C_GB + bj * 128);
                    f32x4 r0, r1;
                    r0[0] = bflo(ga.x) * __builtin_amdgcn_rcpf(fmaxf(bflo(gb.x), 1e-30f)); r0[1] = bfhi(ga.x) * __builtin_amdgcn_rcpf(fmaxf(bfhi(gb.x), 1e-30f));
                    r0[2] = bflo(ga.y) * __builtin_amdgcn_rcpf(fmaxf(bflo(gb.y), 1e-30f)); r0[3] = bfhi(ga.y) * __builtin_amdgcn_rcpf(fmaxf(bfhi(gb.y), 1e-30f));
                    r1[0] = bflo(ga.z) * __builtin_amdgcn_rcpf(fmaxf(bflo(gb.z), 1e-30f)); r1[1] = bfhi(ga.z) * __builtin_amdgcn_rcpf(fmaxf(bfhi(gb.z), 1e-30f));
                    r1[2] = bflo(ga.w) * __builtin_amdgcn_rcpf(fmaxf(bflo(gb.w), 1e-30f)); r1[3] = bfhi(ga.w) * __builtin_amdgcn_rcpf(fmaxf(bfhi(gb.w), 1e-30f));
                    acc[ai][bj][m][0] *= r0; acc[ai][bj][m][1] *= r1; } }
    }
    DI void operator()(const f32x4 (&acc)[2][2][4][2], const Unit& u, int wr, int wc, int fr, int fq) const {
        const int row0 = u.pm * 256 + wr * 64 + fr, col0 = u.pn * 256 + wc * 32 + 8 * fq;
#pragma unroll
        for (int ai = 0; ai < 2; ++ai)
#pragma unroll
            for (int m = 0; m < 4; ++m) { bf16* rowp = P + (size_t)(row0 + ai * 128 + m * 16) * NPROJ + col0;
#pragma unroll
                for (int bj = 0; bj < 2; ++bj) { const f32x4 v0 = acc[ai][bj][m][0], v1 = acc[ai][bj][m][1];
                    const v4u g = *(const v4u*)(rowp + C_GB + bj * 128);
                    v4u w; w.x = cvt_pk_bf16(bflo(g.x) * v0[0], bfhi(g.x) * v0[1]); w.y = cvt_pk_bf16(bflo(g.y) * v0[2], bfhi(g.y) * v0[3]); w.z = cvt_pk_bf16(bflo(g.z) * v1[0], bfhi(g.z) * v1[1]); w.w = cvt_pk_bf16(bflo(g.w) * v1[2], bfhi(g.w) * v1[3]);
                    *(v4u*)(rowp + C_MQ + bj * 128) = w; } }
    }
};
struct EpiRes {
    static constexpr bool PERM = false, MID = false;
    const bf16* xin; bf16* out; const float* g; float* ssq; int rmask;
    DI void operator()(const f32x4 (&acc)[2][2][4][2], const Unit& u, int wr, int wc, int fr, int fq) const {
        const int row0 = u.pm * 256 + wr * 64 + fr, col0 = u.pn * 256 + wc * 32 + 4 * fq; const int b = (u.pm * 256) >> 14;
        f32x4 gv[2][2];
#pragma unroll
        for (int bj = 0; bj < 2; ++bj)
#pragma unroll
            for (int n = 0; n < 2; ++n) gv[bj][n] = *(const f32x4*)(g + b * 6144 + col0 + bj * 128 + n * 16);
#pragma unroll
        for (int ai = 0; ai < 2; ++ai)
#pragma unroll
            for (int m = 0; m < 4; ++m) { const size_t off = (size_t)(row0 + ai * 128 + m * 16) * D + col0; const size_t offo = (size_t)((row0 + ai * 128 + m * 16) & rmask) * D + col0; float sq = 0.f;
#pragma unroll
                for (int bj = 0; bj < 2; ++bj)
#pragma unroll
                    for (int n = 0; n < 2; ++n) { const v2u xw = *(const v2u*)(xin + off + bj * 128 + n * 16); const f32x4 xv = {bflo(xw.x), bfhi(xw.x), bflo(xw.y), bfhi(xw.y)}; const f32x4 o = xv + gv[bj][n] * acc[ai][bj][m][n];
                        v2u ow; ow.x = cvt_pk_bf16(o.x, o.y); ow.y = cvt_pk_bf16(o.z, o.w); const float r0 = bflo(ow.x), r1 = bfhi(ow.x), r2 = bflo(ow.y), r3 = bfhi(ow.y);
                        sq += (r0 * r0 + r1 * r1) + (r2 * r2 + r3 * r3);
                        *(v2u*)(out + offo + bj * 128 + n * 16) = ow; }
                sq += __shfl_xor(sq, 16); sq += __shfl_xor(sq, 32);
                if (fq == 0) ssq[(size_t)(row0 + ai * 128 + m * 16) * 16 + u.pn * 4 + wc] = sq; }
    }
};

struct MoeTab { const LAS int* tcls; const LAS int* tpos; const LAS int* cnt; int Rtot; };
DI int xcd_remap(int L, int nwg) { const int q = nwg >> 3, r = nwg & 7, xcd = L & 7, off = L >> 3; return (xcd < r ? xcd * (q + 1) : r * (q + 1) + (xcd - r) * q) + off; }
DI void cls_experts(int cls, int& ea, int& eb) { const int g = cls / 6, p = cls - 6 * g; const int a = (p < 3) ? 0 : ((p < 5) ? 1 : 2); const int b = (p < 3) ? (p + 1) : ((p < 5) ? (p - 1) : 3); ea = 4 * g + a; eb = 4 * g + b; }
struct MoeUpSched {
    static constexpr bool GATHER = true, ASPLIT = false; static constexpr int KSPLIT = 0;
    const char* A; const char* W; int lda, ldb; MoeTab tb; int G, c; const LAS unsigned* tokoff;
    DI bool next(int i, Unit& u) const { const int L0 = i * G + c; if (L0 >= tb.Rtot * 8) return false; const int L = xcd_remap(L0, tb.Rtot * 8); u.pm = L >> 3; u.pn = L & 7; u.x0 = i; u.x1 = __builtin_amdgcn_readfirstlane(tb.tcls[u.pm]); return true; }
    DI const char* a_base(const Unit&, int) const { return A; }
    DI const char* b_base(const Unit& u, int) const { int ea, eb; cls_experts(u.x1, ea, eb); const int e = (u.pn < 4) ? ea : eb; return W + ((size_t)e * 1024 + (size_t)(u.pn & 3) * 256) * ldb; }
    DI unsigned a_rowoff(const Unit& u, int r) const { return tokoff[u.x0 * 256 + r]; }
};
struct EpiSwiglu {
    static constexpr bool PERM = true, MID = false;
    unsigned char* H; const float* tgate; const LAS unsigned* tokoff;
    DI void operator()(const f32x4 (&acc)[2][2][4][2], const Unit& u, int wr, int wc, int fr, int fq) const {
        const int r0 = wr * 64 + fr; const int hc = (u.pn >> 2) * 512 + (u.pn & 3) * 128 + wc * 32 + 8 * fq; const int gsel = u.pn >> 2;
#pragma unroll
        for (int ai = 0; ai < 2; ++ai)
#pragma unroll
            for (int m = 0; m < 4; ++m) { const int r = r0 + ai * 128 + m * 16; const unsigned tok = tokoff[u.x0 * 256 + r]; const float rg = tgate[tok * 2 + gsel];
                const f32x4 g0 = acc[ai][0][m][0] * (1.0f / 64.0f), g1 = acc[ai][0][m][1] * (1.0f / 64.0f), u0 = acc[ai][1][m][0] * (1.0f / 64.0f), u1 = acc[ai][1][m][1] * (1.0f / 64.0f);
                float o[8];
#pragma unroll
                for (int j = 0; j < 4; ++j) { o[j] = g0[j] * sigmoidf_(g0[j]) * u0[j] * rg; o[4 + j] = g1[j] * sigmoidf_(g1[j]) * u1[j] * rg; }
                v2u w; w.x = pk4_fp8(o[0] * 16.0f, o[1] * 16.0f, o[2] * 16.0f, o[3] * 16.0f); w.y = pk4_fp8(o[4] * 16.0f, o[5] * 16.0f, o[6] * 16.0f, o[7] * 16.0f);
                *(v2u*)(H + ((size_t)u.pm * 256 + r) * 1024 + hc) = w; }
    }
};
struct MoeDownSched {
    static constexpr bool GATHER = false, ASPLIT = false; static constexpr int KSPLIT = 4;
    const char* A; const char* W; int lda, ldb; MoeTab tb; int G, c;
    DI bool next(int i, Unit& u) const { const int L0 = i * G + c; if (L0 >= tb.Rtot * 4) return false; const int L = xcd_remap(L0, tb.Rtot * 4); u.pm = L >> 2; u.pn = L & 3; u.x0 = __builtin_amdgcn_readfirstlane(tb.tpos[u.pm]); u.x1 = __builtin_amdgcn_readfirstlane(tb.tcls[u.pm]); return true; }
    DI const char* a_base(const Unit& u, int) const { return A + (size_t)u.pm * 256 * lda; }
    DI const char* b_base(const Unit& u, int half) const { int ea, eb; cls_experts(u.x1, ea, eb); const int e = half ? eb : ea; return W + ((size_t)e * 1024 + (size_t)u.pn * 256) * ldb; }
    DI unsigned a_rowoff(const Unit&, int) const { return 0u; }
};
struct EpiMoeOut {
    static constexpr bool PERM = false, MID = false;
    const bf16* xin; bf16* outb; float* outf; const float* g; const int* tokl; MoeTab tb; int rmask, last;
    DI void operator()(const f32x4 (&acc)[2][2][4][2], const Unit& u, int wr, int wc, int fr, int fq) const {
        const int r0 = wr * 64 + fr, col0 = u.pn * 256 + wc * 32 + 4 * fq; const int cn = tb.cnt[u.x1];
#pragma unroll
        for (int ai = 0; ai < 2; ++ai)
#pragma unroll
            for (int m = 0; m < 4; ++m) { const int pos = u.x0 + r0 + ai * 128 + m * 16;
                if (pos < cn) { const int tok = tokl[u.x1 * CLS_CAP + pos]; const int b = tok >> 14; const bf16* ip = xin + (size_t)tok * D + col0; bf16* op = outb + (size_t)(tok & rmask) * D + col0; float* of = outf + (size_t)tok * D + col0; const float* gp = g + b * 6144 + col0;
#pragma unroll
                    for (int bj = 0; bj < 2; ++bj)
#pragma unroll
                        for (int n = 0; n < 2; ++n) { const v2u xw = *(const v2u*)(ip + bj * 128 + n * 16); const f32x4 xv = {bflo(xw.x), bfhi(xw.x), bflo(xw.y), bfhi(xw.y)}; const f32x4 gv = *(const f32x4*)(gp + bj * 128 + n * 16);
                            const f32x4 o = xv + gv * (acc[ai][bj][m][n] * (1.0f / 512.0f));
                            if (last) *(f32x4*)(of + bj * 128 + n * 16) = o;
                            else { v2u ow; ow.x = cvt_pk_bf16(o.x, o.y); ow.y = cvt_pk_bf16(o.z, o.w); *(v2u*)(op + bj * 128 + n * 16) = ow; } } } }
    }
};

struct Ctx { LAS unsigned char* lds; int tid, lane, wave, G, bid; };
DI Ctx fresh(const Ctx& X) { Ctx P = X; int t = X.tid; asm volatile("" : "+v"(t)); P.tid = t; P.lane = t & 63; P.wave = __builtin_amdgcn_readfirstlane(t >> 6); return P; }

DI void tr_item(const float* W, int ldw, int K, bf16* WT, int k0, LAS float* scr, int lane) {
    { const int rr = lane >> 3, c4 = lane & 7; f32x4 v[8];
#pragma unroll
      for (int i = 0; i < 8; ++i) v[i] = *(const f32x4*)(W + (size_t)(k0 + rr + 8 * i) * ldw + 4 * c4);
#pragma unroll
      for (int i = 0; i < 8; ++i) { LAS float* d = scr + (rr + 8 * i) * 33 + 4 * c4; d[0] = v[i].x; d[1] = v[i].y; d[2] = v[i].z; d[3] = v[i].w; } }
    LDS_WAIT(); asm volatile("" ::: "memory");
    const int c = lane & 7;
#pragma unroll
    for (int j = 0; j < 4; ++j) { const int n = (lane >> 3) + 8 * j; const LAS float* s = scr + (8 * c) * 33 + n;
        v4u o; o.x = pk2(s[0 * 33], s[1 * 33]); o.y = pk2(s[2 * 33], s[3 * 33]); o.z = pk2(s[4 * 33], s[5 * 33]); o.w = pk2(s[6 * 33], s[7 * 33]);
        *(v4u*)(WT + (size_t)n * K + k0 + 8 * c) = o; }
    LDS_WAIT(); asm volatile("" ::: "memory");
}
DI void tr_item8(const float* W, int ldw, int K, unsigned char* WT, int k0, float scale, LAS float* scr, int lane) {
    { const int rr = lane >> 3, c4 = lane & 7; f32x4 v[8];
#pragma unroll
      for (int i = 0; i < 8; ++i) v[i] = *(const f32x4*)(W + (size_t)(k0 + rr + 8 * i) * ldw + 4 * c4);
#pragma unroll
      for (int i = 0; i < 8; ++i) { LAS float* d = scr + (rr + 8 * i) * 33 + 4 * c4; d[0] = v[i].x; d[1] = v[i].y; d[2] = v[i].z; d[3] = v[i].w; } }
    LDS_WAIT(); asm volatile("" ::: "memory");
    const int c = lane & 7;
#pragma unroll
    for (int j = 0; j < 4; ++j) { const int n = (lane >> 3) + 8 * j; const LAS float* s = scr + (8 * c) * 33 + n;
        v2u o; o.x = pk4_fp8(s[0 * 33] * scale, s[1 * 33] * scale, s[2 * 33] * scale, s[3 * 33] * scale); o.y = pk4_fp8(s[4 * 33] * scale, s[5 * 33] * scale, s[6 * 33] * scale, s[7 * 33] * scale);
        *(v2u*)(WT + (size_t)n * K + k0 + 8 * c) = o; }
    LDS_WAIT(); asm volatile("" ::: "memory");
}
DI void p0_prologue(const Args& a, const Ctx& X) {
    unsigned char* ws = a.ws;
    LAS float* scr = (LAS float*)(X.lds + X.wave * 16384);
    const int gw = X.bid * 8 + X.wave, NGW = X.G * 8;
    constexpr int IT_WIN = 16 * 153, IT_AU = 8 * 32, IT_OUT = 16 * 32, IT_GU = 16 * 16 * 32, IT_DN = 16 * 8 * 32;
    constexpr int IT_L = IT_WIN + 2 * IT_AU + IT_OUT + IT_GU + IT_DN;
    for (int it = gw; it < NL * IT_L; it += NGW) {
        const int l = it / IT_L; int r = it - l * IT_L;
        if (r < IT_WIN) { const int kb = r / 153, nb = r - kb * 153, d0 = 32 * nb, s0 = (nb == 152) ? 2304 : (d0 + (d0 >= 2304 ? 8 : 0));
            tr_item8(a.w_in + (size_t)l * D * DIN_SRC + s0, DIN_SRC, D, (unsigned char*)(ws + WS_WIN) + ((size_t)l * NPROJW + d0) * D, 64 * kb, 64.0f, scr, X.lane); continue; }
        r -= IT_WIN;
        if (r < IT_AU) { const int kb = r >> 5, nb = r & 31;
            tr_item(a.w_au + (size_t)l * 512 * D + 32 * nb, D, 512, (bf16*)(ws + WS_WAU) + ((size_t)l * D + 32 * nb) * 512, 64 * kb, scr, X.lane); continue; }
        r -= IT_AU;
        if (r < IT_AU) { const int kb = r >> 5, nb = r & 31;
            tr_item(a.w_mu + (size_t)l * 512 * D + 32 * nb, D, 512, (bf16*)(ws + WS_WMU) + ((size_t)l * D + 32 * nb) * 512, 64 * kb, scr, X.lane); continue; }
        r -= IT_AU;
        if (r < IT_OUT) { const int kb = r >> 5, nb = r & 31;
            tr_item(a.w_out + (size_t)l * D * D + 32 * nb, D, D, (bf16*)(ws + WS_WOUT) + ((size_t)l * D + 32 * nb) * D, 64 * kb, scr, X.lane); continue; }
        r -= IT_OUT;
        if (r < IT_GU) { const int e = r >> 9, q = r & 511, kb = q >> 5, nb = q & 31, tq = nb >> 3, rb = nb & 7;
            const float* src = ((rb < 4) ? a.w_gate : a.w_up) + ((size_t)(l * NE + e) * D) * FF + 128 * tq + 32 * (rb & 3);
            tr_item8(src, FF, D, (unsigned char*)(ws + WS_WGU) + ((size_t)(l * NE + e) * 1024 + 32 * nb) * D, 64 * kb, 64.0f, scr, X.lane); continue; }
        r -= IT_GU;
        { const int e = r >> 8, q = r & 255, kb = q >> 5, nb = q & 31;
            tr_item8(a.w_down + ((size_t)(l * NE + e) * FF) * D + 32 * nb, D, FF, (unsigned char*)(ws + WS_WD) + ((size_t)(l * NE + e) * 1024 + 32 * nb) * FF, 64 * kb, 32.0f, scr, X.lane); }
    }
    { const float* xs = a.x; bf16* xb = (bf16*)(ws + WS_XB);
      for (size_t i = (size_t)X.bid * 512 + X.tid; i < (size_t)T * D / 8; i += (size_t)X.G * 512) { const f32x4 v0 = *(const f32x4*)(xs + 8 * i), v1 = *(const f32x4*)(xs + 8 * i + 4);
          v4u w; w.x = cvt_pk_bf16(v0.x, v0.y); w.y = cvt_pk_bf16(v0.z, v0.w); w.z = cvt_pk_bf16(v1.x, v1.y); w.w = cvt_pk_bf16(v1.z, v1.w); *(v4u*)(xb + 8 * i) = w; } }
    { float* cs = (float*)(ws + WS_ROPE); float* sn = cs + (size_t)T * 8;
      for (int i = X.bid * 512 + X.tid; i < T * 8; i += X.G * 512) { const int tok = i >> 3, f = i & 7; const float angf = (float)a.pos[tok] * c_invf[f];
          double rev = (double)angf * 0.15915494309189535; rev -= rint(rev); const float rf = (float)rev;
          cs[i] = __builtin_amdgcn_cosf(rf); sn[i] = __builtin_amdgcn_sinf(rf); } }
    __syncthreads();
    LAS float* cact = (LAS float*)X.lds; LAS float* red = (LAS float*)(X.lds + 8192);
    for (int i = X.tid; i < 2048; i += 512) { const float cv = a.c[i]; cact[i] = cv / (1.0f + __expf(-cv)); }
    __syncthreads();
    float* mod = (float*)(ws + WS_MOD);
    for (int it = X.bid; it < NL * 96; it += X.G) { const int l = it / 96, cg = it - l * 96; const int col = cg * 64 + X.lane;
        const float* w = a.ada_w + (size_t)l * D * 6144 + col; float s0 = 0.f, s1 = 0.f;
#pragma unroll 8
        for (int kk = 0; kk < 128; ++kk) { const int k = X.wave * 128 + kk; const float wv = w[(size_t)k * 6144]; s0 += cact[k] * wv; s1 += cact[1024 + k] * wv; }
        red[(X.wave * 2 + 0) * 64 + X.lane] = s0; red[(X.wave * 2 + 1) * 64 + X.lane] = s1;
        __syncthreads();
        if (X.tid < 128) { const int b = X.tid >> 6, ln = X.tid & 63; float s = 0.f;
#pragma unroll
            for (int w8 = 0; w8 < 8; ++w8) s += red[(w8 * 2 + b) * 64 + ln];
            mod[(size_t)(l * 2 + b) * 6144 + cg * 64 + ln] = s + a.ada_b[l * 6144 + cg * 64 + ln]; }
        __syncthreads();
    }
}

DI void p1_norm_gates(const Args& a, const Ctx& X, int l, const bf16* xin) {
    unsigned char* ws = a.ws;
    const float* mod = (const float*)(ws + WS_MOD); unsigned char* hb = (unsigned char*)(ws + WS_H);
    const int gw = X.bid * 8 + X.wave, NGW = X.G * 8;
    for (int rg = gw; rg < T / 16; rg += NGW) {
        const int row0 = rg * 16, b = row0 >> 14;
        const float* mb = mod + (size_t)(l * 2 + b) * 6144;
        f32x4 aw[4], sh[4];
#pragma unroll
        for (int j = 0; j < 4; ++j) { const int k = 256 * j + 4 * X.lane; const f32x4 nw = *(const f32x4*)(a.nmw + l * D + k); const f32x4 sc = *(const f32x4*)(mb + 1024 + k); aw[j] = nw * (sc + 1.0f); sh[j] = *(const f32x4*)(mb + k); }
        v2u pre[4][4];
#pragma unroll
        for (int q = 0; q < 4; ++q) { const v2u* xp = (const v2u*)(xin + (size_t)(row0 + q) * D) + X.lane;
#pragma unroll
            for (int j = 0; j < 4; ++j) pre[q][j] = xp[64 * j]; }
#pragma unroll 1
        for (int rb = 0; rb < 16; rb += 4) {
#pragma unroll
          for (int q = 0; q < 4; ++q) { const int row = row0 + rb + q;
            f32x4 v[4]; float ss = 0.f;
#pragma unroll
            for (int j = 0; j < 4; ++j) { const v2u pw = pre[q][j]; v[j] = (f32x4){bflo(pw.x), bfhi(pw.x), bflo(pw.y), bfhi(pw.y)}; }
            if (rb + 4 < 16) { const v2u* xp = (const v2u*)(xin + (size_t)(row + 4) * D) + X.lane;
#pragma unroll
                for (int j = 0; j < 4; ++j) pre[q][j] = xp[64 * j]; }
#pragma unroll
            for (int j = 0; j < 4; ++j) ss += (v[j].x * v[j].x + v[j].y * v[j].y) + (v[j].z * v[j].z + v[j].w * v[j].w);
            ss = wave_sum(ss); const float rstd = __builtin_amdgcn_rsqf(ss * (1.0f / D) + EPS);
            unsigned* o4 = (unsigned*)(hb + (size_t)row * D) + X.lane;
#pragma unroll
            for (int j = 0; j < 4; ++j) { v[j] = v[j] * rstd * aw[j] + sh[j]; o4[64 * j] = pk4_fp8(v[j].x, v[j].y, v[j].z, v[j].w); }
          }
        }
    }
}

DI void attn_unit(const Args& a, const Ctx& X, int l, int unit) {
    unsigned char* ws = a.ws; const bf16* proj = (const bf16*)(ws + WS_PROJ); bf16* ao = (bf16*)(ws + WS_H);
    const float* cs = (const float*)(ws + WS_ROPE); const float* sn = cs + (size_t)T * 8;
    const int b = unit >> 8, rem = unit & 255, nb = rem >> 1, kvh = rem & 1; const int tok0 = b * SEQ + nb * 128;
    LAS bf16* Kl = (LAS bf16*)X.lds;
    LAS bf16* VT = (LAS bf16*)(X.lds + 36864);
    int lane = X.lane; asm volatile("" : "+v"(lane));
    const int c16 = lane & 15, quad = lane >> 4;
    v4u nq0, nq1; f32x4 ncs0, ncs1, nsn0, nsn1;
#define AT_PREF(task_) do { const int g_ = (task_) >> 3, tq_ = tok0 + 16 * ((task_) & 7) + c16; const bf16* qp_ = proj + (size_t)tq_ * NPROJ + C_AQ + (kvh * 4 + g_) * 64; \
        nq0 = *(const v4u*)(qp_ + 8 * quad); nq1 = *(const v4u*)(qp_ + 32 + 8 * quad); ncs0 = *(const f32x4*)(cs + (size_t)tq_ * 8); ncs1 = *(const f32x4*)(cs + (size_t)tq_ * 8 + 4); nsn0 = *(const f32x4*)(sn + (size_t)tq_ * 8); nsn1 = *(const f32x4*)(sn + (size_t)tq_ * 8 + 4); } while (0)
    AT_PREF(X.wave);
    float qw[16];
#pragma unroll
    for (int i = 0; i < 8; ++i) { qw[i] = a.qnw[l * 64 + 8 * quad + i]; qw[8 + i] = a.qnw[l * 64 + 32 + 8 * quad + i]; }
    const f32x4 sk4 = *(const f32x4*)(a.sinks + l * 8 + kvh * 4);
    {
        const int row = X.tid >> 1, half = X.tid & 1; const int tokk = tok0 - 128 + row; const bool valid = (nb > 0) || (row >= 128);
        float y[32]; float vv[32];
        if (valid) {
            const v4u* kp = (const v4u*)(proj + (size_t)tokk * NPROJ + C_AK + kvh * 64 + half * 32); const v4u* vp = (const v4u*)(proj + (size_t)tokk * NPROJ + C_AV + kvh * 64 + half * 32);
#pragma unroll
            for (int q = 0; q < 4; ++q) { const v4u kw = kp[q], vw = vp[q];
                y[8 * q + 0] = bflo(kw.x); y[8 * q + 1] = bfhi(kw.x); y[8 * q + 2] = bflo(kw.y); y[8 * q + 3] = bfhi(kw.y); y[8 * q + 4] = bflo(kw.z); y[8 * q + 5] = bfhi(kw.z); y[8 * q + 6] = bflo(kw.w); y[8 * q + 7] = bfhi(kw.w);
                vv[8 * q + 0] = bflo(vw.x); vv[8 * q + 1] = bfhi(vw.x); vv[8 * q + 2] = bflo(vw.y); vv[8 * q + 3] = bfhi(vw.y); vv[8 * q + 4] = bflo(vw.z); vv[8 * q + 5] = bfhi(vw.z); vv[8 * q + 6] = bflo(vw.w); vv[8 * q + 7] = bfhi(vw.w); }
        } else {
#pragma unroll
            for (int i = 0; i < 32; ++i) { y[i] = 0.f; vv[i] = 0.f; } }
        float ss = 0.f;
#pragma unroll
        for (int i = 0; i < 32; ++i) ss += y[i] * y[i];
        ss += __shfl_xor(ss, 1); const float rstd = 1.0f / sqrtf(ss * (1.0f / 64.0f) + EPS);
#pragma unroll
        for (int i = 0; i < 32; ++i) y[i] = y[i] * rstd * a.knw[l * 64 + half * 32 + i];
        if (half == 0 && valid) {
#pragma unroll
            for (int d = 0; d < 8; ++d) { const float c = cs[(size_t)tokk * 8 + d], s = sn[(size_t)tokk * 8 + d]; const float t1 = y[d], t2 = y[d + 8]; y[d] = t1 * c - t2 * s; y[d + 8] = t2 * c + t1 * s; } }
#pragma unroll
        for (int q = 0; q < 4; ++q) { v4u w; w.x = pk2(y[8 * q], y[8 * q + 1]); w.y = pk2(y[8 * q + 2], y[8 * q + 3]); w.z = pk2(y[8 * q + 4], y[8 * q + 5]); w.w = pk2(y[8 * q + 6], y[8 * q + 7]);
            *(LAS v4u*)(Kl + row * 72 + half * 32 + 8 * q) = w; }
#pragma unroll
        for (int i = 0; i < 32; ++i) VT[(half * 32 + i) * 280 + row] = (bf16)f2bf(vv[i]);
        if (X.tid < 64) {
#pragma unroll
            for (int cc = 256; cc < 280; ++cc) VT[X.tid * 280 + cc] = 0; }
    }
    __syncthreads();
#pragma unroll 1
    for (int task = X.wave; task < 32; task += 8) {
        const int g = task >> 3, rg = task & 7, r0 = 16 * rg, head = kvh * 4 + g; const int tokq = tok0 + r0 + c16;
        const float sink = (g == 0) ? sk4.x : ((g == 1) ? sk4.y : ((g == 2) ? sk4.z : sk4.w));
        const v4u w0 = nq0, w1 = nq1; const f32x4 cc0 = ncs0, cc1 = ncs1, ss0 = nsn0, ss1 = nsn1;
        if (task + 8 < 32) { AT_PREF(task + 8); }
        float qv[16];
        qv[0] = bflo(w0.x); qv[1] = bfhi(w0.x); qv[2] = bflo(w0.y); qv[3] = bfhi(w0.y); qv[4] = bflo(w0.z); qv[5] = bfhi(w0.z); qv[6] = bflo(w0.w); qv[7] = bfhi(w0.w);
        qv[8] = bflo(w1.x); qv[9] = bfhi(w1.x); qv[10] = bflo(w1.y); qv[11] = bfhi(w1.y); qv[12] = bflo(w1.z); qv[13] = bfhi(w1.z); qv[14] = bflo(w1.w); qv[15] = bfhi(w1.w);
        float ss = 0.f;
#pragma unroll
        for (int i = 0; i < 16; ++i) ss += qv[i] * qv[i];
        ss += __shfl_xor(ss, 16); ss += __shfl_xor(ss, 32); const float rstd = __builtin_amdgcn_rsqf(ss * (1.0f / 64.0f) + EPS);
#pragma unroll
        for (int i = 0; i < 16; ++i) qv[i] = qv[i] * rstd * qw[i];
        { const float cv[8] = {cc0.x, cc0.y, cc0.z, cc0.w, cc1.x, cc1.y, cc1.z, cc1.w}, sv[8] = {ss0.x, ss0.y, ss0.z, ss0.w, ss1.x, ss1.y, ss1.z, ss1.w};
#pragma unroll
          for (int d = 0; d < 8; ++d) { const float other = __shfl_xor(qv[d], 16);
              if (quad == 0) qv[d] = qv[d] * cv[d] - other * sv[d]; else if (quad == 1) qv[d] = qv[d] * cv[d] + other * sv[d]; } }
        bf16x8 qf[2];
        { v4u w; w.x = pk2m(qv[0], qv[1]); w.y = pk2m(qv[2], qv[3]); w.z = pk2m(qv[4], qv[5]); w.w = pk2m(qv[6], qv[7]); qf[0] = __builtin_bit_cast(bf16x8, w);
          w.x = pk2m(qv[8], qv[9]); w.y = pk2m(qv[10], qv[11]); w.z = pk2m(qv[12], qv[13]); w.w = pk2m(qv[14], qv[15]); qf[1] = __builtin_bit_cast(bf16x8, w); }
        f32x4 sacc[9];
#pragma unroll
        for (int i = 0; i < 9; ++i) { const LAS bf16* kr = Kl + (16 * (rg + i) + c16) * 72 + 8 * quad;
            const bf16x8 k0 = *(const LAS bf16x8*)kr, k1 = *(const LAS bf16x8*)(kr + 32);
            f32x4 z = {0.f, 0.f, 0.f, 0.f}; z = __builtin_amdgcn_mfma_f32_16x16x32_bf16(k0, qf[0], z, 0, 0, 0); sacc[i] = __builtin_amdgcn_mfma_f32_16x16x32_bf16(k1, qf[1], z, 0, 0, 0); }
        int dbase = 4 * quad - c16; asm volatile("" : "+v"(dbase)); int kbase = 16 * rg + 4 * quad; asm volatile("" : "+v"(kbase)); float mx = sink;
#pragma unroll
        for (int i = 0; i < 9; ++i)
#pragma unroll
            for (int j = 0; j < 4; ++j) { const int dlt = dbase + 16 * i + j; const int kj = kbase + 16 * i + j; const bool ok = (dlt > 0) && (dlt <= 128) && ((nb > 0) || (kj >= 128));
                const float s = ok ? sacc[i][j] * 0.125f : -3.0e38f; sacc[i][j] = s; mx = fmaxf(mx, s); }
        mx = fmaxf(mx, __shfl_xor(mx, 16)); mx = fmaxf(mx, __shfl_xor(mx, 32));
        float sum = 0.f;
#pragma unroll
        for (int i = 0; i < 9; ++i)
#pragma unroll
            for (int j = 0; j < 4; ++j) { const float p = (sacc[i][j] > -1.0e38f) ? __expf(sacc[i][j] - mx) : 0.f; sacc[i][j] = p; sum += p; }
        sum += __shfl_xor(sum, 16); sum += __shfl_xor(sum, 32);
        const float inv = 1.0f / (sum + __expf(sink - mx));
        f32x4 oacc[4];
#pragma unroll
        for (int et = 0; et < 4; ++et) oacc[et] = (f32x4){0.f, 0.f, 0.f, 0.f};
#pragma unroll
        for (int kk = 0; kk < 5; ++kk) {
            v4u pw; pw.x = pk2m(sacc[2 * kk][0], sacc[2 * kk][1]); pw.y = pk2m(sacc[2 * kk][2], sacc[2 * kk][3]);
            if (2 * kk + 1 < 9) { pw.z = pk2m(sacc[(2 * kk + 1 < 9) ? 2 * kk + 1 : 0][0], sacc[(2 * kk + 1 < 9) ? 2 * kk + 1 : 0][1]); pw.w = pk2m(sacc[(2 * kk + 1 < 9) ? 2 * kk + 1 : 0][2], sacc[(2 * kk + 1 < 9) ? 2 * kk + 1 : 0][3]); } else { pw.z = 0u; pw.w = 0u; }
            const bf16x8 pf = __builtin_bit_cast(bf16x8, pw);
#pragma unroll
            for (int et = 0; et < 4; ++et) { const LAS bf16* vr = VT + (16 * et + c16) * 280 + 16 * rg + 32 * kk + 4 * quad;
                const v2u lo = *(const LAS v2u*)vr, hi = *(const LAS v2u*)(vr + 16); v4u vw; vw.x = lo.x; vw.y = lo.y; vw.z = hi.x; vw.w = hi.y;
                oacc[et] = __builtin_amdgcn_mfma_f32_16x16x32_bf16(__builtin_bit_cast(bf16x8, vw), pf, oacc[et], 0, 0, 0); }
        }
#pragma unroll
        for (int et = 0; et < 4; ++et) { v2u w; w.x = pk2(oacc[et][0] * inv, oacc[et][1] * inv); w.y = pk2(oacc[et][2] * inv, oacc[et][3] * inv);
            *(v2u*)(ao + (size_t)tokq * 512 + head * 64 + 16 * et + 4 * quad) = w; }
    }
    __syncthreads();
#undef AT_PREF
}

constexpr int ML_Q = 0, ML_K = 17408, ML_KET = 34816, ML_VT = 53248, ML_CT = 73984, ML_CW = 113152, ML_CB = 118272, ML_RED = 118784, ML_NW = 119296, ML_GT = 119808;
DI float bfw(unsigned w, int hi) { return hi ? bfhi(w) : bflo(w); }
template <bool L3> DI void mlstm_unit(const Args& a, const Ctx& X, int l, int unit) {
    unsigned char* ws = a.ws; const bf16* proj = (const bf16*)(ws + WS_PROJ); bf16* hm = (bf16*)(ws + WS_H) + (size_t)T * 512;
    bf16* kcb = (bf16*)(ws + WS_KC);
    const float* gates = (const float*)(ws + WS_GATES); float* mlc = (float*)(ws + WS_MLC) + (size_t)unit * 18432; float* mlb = (float*)(ws + WS_MLB);
    const int seq = unit >> 5, sj = unit & 31, b = seq >> 2, hh = seq & 3; const int tokbase = b * SEQ + sj * 512;
    LAS bf16* Qs = (LAS bf16*)(X.lds + ML_Q); LAS bf16* Ks = (LAS bf16*)(X.lds + ML_K); LAS bf16* KET = (LAS bf16*)(X.lds + ML_KET);
    LAS bf16* VT = (LAS bf16*)(X.lds + ML_VT); LAS bf16* CT = (LAS bf16*)(X.lds + ML_CT); LAS float* CW = (LAS float*)(X.lds + ML_CW);
    LAS float* CB = (LAS float*)(X.lds + ML_CB); LAS float* RED = (LAS float*)(X.lds + ML_RED); LAS float* NW = (LAS float*)(X.lds + ML_NW);
    LAS float* GT = (LAS float*)(X.lds + ML_GT);
    int lane = X.lane; asm volatile("" : "+v"(lane));
    const int c16 = lane & 15, quad = lane >> 4, w = X.wave;
    int tidl = X.tid; asm volatile("" : "+v"(tidl));
    const int tg = tidl >> 5, cg = tidl & 31, t0 = 4 * tg, c0 = 4 * cg;
    v2u rq[7], rk[7], rv[4], kcv[4];
#define ML_LBAR() do { asm volatile("s_waitcnt lgkmcnt(0)" ::: "memory"); __builtin_amdgcn_s_barrier(); asm volatile("" ::: "memory"); } while (0)
#define ML_LOADRAW(tokc) do { _Pragma("unroll") for (int j = 0; j < 7; ++j) { const int tt = (tokc) + t0 - 3 + j; const bool ok = tt >= b * SEQ; const bf16* rp = proj + (size_t)(ok ? tt : (tokc)) * NPROJ + hh * 128 + c0; \
        if (L3) { rq[j] = *(const v2u*)(rp + C_MQ); if (!ok) { rq[j].x = 0u; rq[j].y = 0u; } } else { rk[j] = *(const v2u*)(rp + C_MK); if (!ok) { rk[j].x = 0u; rk[j].y = 0u; } } } \
        if (L3) { _Pragma("unroll") for (int i = 0; i < 4; ++i) kcv[i] = *(const v2u*)(kcb + (size_t)((tokc) + t0 + i) * 512 + hh * 128 + c0); } \
        _Pragma("unroll") for (int i = 0; i < 4; ++i) rv[i] = *(const v2u*)(proj + (size_t)((tokc) + t0 + i) * NPROJ + C_MV + hh * 128 + c0); } while (0)
    ML_LOADRAW(tokbase);
    for (int idx = X.tid; idx < 1280; idx += 512) { const int tap = idx >> 8, ch = idx & 255; const int gch = (ch < 128) ? (hh * 128 + ch) : (512 + hh * 128 + (ch - 128));
        CW[idx] = (tap < 4) ? a.conv_w[(size_t)(l * 4 + tap) * 1024 + gch] : a.conv_b[l * 1024 + gch]; }
    for (int idx = X.tid; idx < 16 * 72; idx += 512) VT[128 * 72 + idx] = (idx < 72) ? (bf16)0x3F80 : (bf16)0;
    if (X.tid < 128) NW[X.tid] = a.mnw[l * 512 + hh * 128 + X.tid];
    { const float* gp = gates + (size_t)(tokbase + X.tid) * 8; GT[2 * X.tid] = gp[hh]; GT[2 * X.tid + 1] = gp[4 + hh]; }
    f32x4 cacc[9];
#pragma unroll
    for (int et = 0; et < 9; ++et) {
        if (L3) {
#pragma unroll
            for (int j = 0; j < 4; ++j) { const float v = mlc[(16 * et + 4 * quad + j) * 128 + 16 * w + c16]; cacc[et][j] = v; CT[(16 * et + 4 * quad + j) * 136 + 16 * w + c16] = (bf16)f2bf(v); }
        } else cacc[et] = (f32x4){0.f, 0.f, 0.f, 0.f};
    }
    float bsum = 0.f;
    __syncthreads();
#pragma unroll 1
    for (int c = 0; c < 8; ++c) {
        const int tok0 = tokbase + c * 64;
        const f32x2 gl = *(const LAS f32x2*)(GT + 2 * (c * 64 + lane)); float bsc = gl.y; const float li = gl.x;
#pragma unroll
        for (int o = 1; o < 64; o <<= 1) { const float v = __shfl_up(bsc, o); if (lane >= o) bsc += v; }
        const float bl = __shfl(bsc, 63); const float csv = li - bsc;
        if (w == 0) { CB[lane] = bsc; CB[64 + lane] = csv; }
        bsum += bl;
        const int tt_ = w & 3, eh = w >> 2; const int tq = 16 * tt_ + c16;
        v2u ogv[4];
        if (L3) {
#pragma unroll
            for (int x = 0; x < 4; ++x) ogv[x] = *(const v2u*)(proj + (size_t)(tok0 + tq) * NPROJ + C_MO + hh * 128 + 16 * (4 * eh + x) + 4 * quad); }
        { float fac[4];
#pragma unroll
          for (int i = 0; i < 4; ++i) fac[i] = __expf(bl + __shfl(csv, t0 + i));
#pragma unroll
          for (int qk = (L3 ? 0 : 1); qk < 2; ++qk) {
              float o[4][4];
              if (L3 && qk) {
#pragma unroll
                  for (int i = 0; i < 4; ++i) { o[i][0] = bflo(kcv[i].x); o[i][1] = bfhi(kcv[i].x); o[i][2] = bflo(kcv[i].y); o[i][3] = bfhi(kcv[i].y); }
              } else {
              const f32x4 bias = *(const LAS f32x4*)(CW + 4 * 256 + qk * 128 + c0);
#pragma unroll
              for (int i = 0; i < 4; ++i) { o[i][0] = bias.x; o[i][1] = bias.y; o[i][2] = bias.z; o[i][3] = bias.w; }
#pragma unroll
              for (int j = 0; j < 4; ++j) { const f32x4 wj = *(const LAS f32x4*)(CW + j * 256 + qk * 128 + c0);
#pragma unroll
                  for (int i = 0; i < 4; ++i) { const v2u rr = qk ? rk[i + j] : rq[i + j];
                      o[i][0] += wj.x * bflo(rr.x); o[i][1] += wj.y * bfhi(rr.x); o[i][2] += wj.z * bflo(rr.y); o[i][3] += wj.w * bfhi(rr.y); } }
#pragma unroll
              for (int i = 0; i < 4; ++i)
#pragma unroll
                  for (int ch = 0; ch < 4; ++ch) { const float z = o[i][ch]; o[i][ch] = z * __builtin_amdgcn_rcpf(1.0f + __expf(-z)) * (qk ? 0.08838834764831845f : 1.0f); }
              }
              if (!L3 && qk) {
#pragma unroll
                  for (int i = 0; i < 4; ++i) { v2u pw; pw.x = pk2(o[i][0], o[i][1]); pw.y = pk2(o[i][2], o[i][3]); *(v2u*)(kcb + (size_t)(tok0 + t0 + i) * 512 + hh * 128 + c0) = pw;
                      o[i][0] = bflo(pw.x); o[i][1] = bfhi(pw.x); o[i][2] = bflo(pw.y); o[i][3] = bfhi(pw.y); } }
              if (L3) { LAS bf16* dst = (qk ? Ks : Qs) + t0 * 136 + c0;
#pragma unroll
                  for (int i = 0; i < 4; ++i) { v2u pw; pw.x = pk2(o[i][0], o[i][1]); pw.y = pk2(o[i][2], o[i][3]); *(LAS v2u*)(dst + i * 136) = pw; } }
              if (qk) {
#pragma unroll
                  for (int ch = 0; ch < 4; ++ch) { v2u pw; pw.x = pk2(o[0][ch] * fac[0], o[1][ch] * fac[1]); pw.y = pk2(o[2][ch] * fac[2], o[3][ch] * fac[3]); *(LAS v2u*)(KET + (c0 + ch) * 72 + t0) = pw; } }
          }
          { v2u p0, p1, p2, p3;
            p0.x = (rv[0].x & 0xffffu) | (rv[1].x << 16); p0.y = (rv[2].x & 0xffffu) | (rv[3].x << 16);
            p1.x = (rv[0].x >> 16) | (rv[1].x & 0xffff0000u); p1.y = (rv[2].x >> 16) | (rv[3].x & 0xffff0000u);
            p2.x = (rv[0].y & 0xffffu) | (rv[1].y << 16); p2.y = (rv[2].y & 0xffffu) | (rv[3].y << 16);
            p3.x = (rv[0].y >> 16) | (rv[1].y & 0xffff0000u); p3.y = (rv[2].y >> 16) | (rv[3].y & 0xffff0000u);
            *(LAS v2u*)(VT + (c0 + 0) * 72 + t0) = p0; *(LAS v2u*)(VT + (c0 + 1) * 72 + t0) = p1; *(LAS v2u*)(VT + (c0 + 2) * 72 + t0) = p2; *(LAS v2u*)(VT + (c0 + 3) * 72 + t0) = p3; }
        }
        ML_LBAR();
        if (c < 7) { ML_LOADRAW(tok0 + 64); }
        float hval[4][4];
        if (L3) {
            bf16x8 qf[4];
#pragma unroll
            for (int ks = 0; ks < 4; ++ks) qf[ks] = *(const LAS bf16x8*)(Qs + tq * 136 + 32 * ks + 8 * quad);
            f32x4 sacc[4];
#pragma unroll
            for (int st = 0; st < 4; ++st) { f32x4 z = {0.f, 0.f, 0.f, 0.f};
#pragma unroll
                for (int ks = 0; ks < 4; ++ks) z = __builtin_amdgcn_mfma_f32_16x16x32_bf16(*(const LAS bf16x8*)(Ks + (16 * st + c16) * 136 + 32 * ks + 8 * quad), qf[ks], z, 0, 0, 0);
                sacc[st] = z; }
            const float cbt = CB[tq];
#pragma unroll
            for (int st = 0; st < 4; ++st)
#pragma unroll
                for (int j = 0; j < 4; ++j) { const int s = 16 * st + 4 * quad + j; const float d = (s <= tq) ? __expf(cbt + CB[64 + s]) : 0.f; sacc[st][j] *= d; }
            bf16x8 pf[2];
#pragma unroll
            for (int kk = 0; kk < 2; ++kk) { v4u pw; pw.x = pk2m(sacc[2 * kk][0], sacc[2 * kk][1]); pw.y = pk2m(sacc[2 * kk][2], sacc[2 * kk][3]); pw.z = pk2m(sacc[2 * kk + 1][0], sacc[2 * kk + 1][1]); pw.w = pk2m(sacc[2 * kk + 1][2], sacc[2 * kk + 1][3]); pf[kk] = __builtin_bit_cast(bf16x8, pw); }
            const float ebt = __expf(cbt);
            f32x4 nn[5];
#pragma unroll
            for (int x = 0; x < 5; ++x) { const int et = (x < 4) ? (4 * eh + x) : 8; f32x4 na = {0.f, 0.f, 0.f, 0.f}, ia = {0.f, 0.f, 0.f, 0.f};
#pragma unroll
                for (int kk = 0; kk < 2; ++kk) { const LAS bf16* vr = VT + (16 * et + c16) * 72 + 32 * kk + 4 * quad; const v2u lo = *(const LAS v2u*)vr, hi = *(const LAS v2u*)(vr + 16); v4u vw; vw.x = lo.x; vw.y = lo.y; vw.z = hi.x; vw.w = hi.y;
                    na = __builtin_amdgcn_mfma_f32_16x16x32_bf16(__builtin_bit_cast(bf16x8, vw), pf[kk], na, 0, 0, 0); }
#pragma unroll
                for (int ks = 0; ks < 4; ++ks) ia = __builtin_amdgcn_mfma_f32_16x16x32_bf16(*(const LAS bf16x8*)(CT + (16 * et + c16) * 136 + 32 * ks + 8 * quad), qf[ks], ia, 0, 0, 0);
                nn[x] = na + ia * ebt; }
            const float den = __shfl(nn[4][0], c16); const float inv = 1.0f / fmaxf(fabsf(den), 1.0f);
            float ss = 0.f;
#pragma unroll
            for (int x = 0; x < 4; ++x)
#pragma unroll
                for (int j = 0; j < 4; ++j) { hval[x][j] = nn[x][j] * inv; ss += hval[x][j] * hval[x][j]; }
            ss += __shfl_xor(ss, 16); ss += __shfl_xor(ss, 32);
            if (quad == 0) RED[eh * 64 + tq] = ss;
            ML_LBAR();
            const float rstd = __builtin_amdgcn_rsqf((RED[tq] + RED[64 + tq]) * (1.0f / 128.0f) + EPS);
#pragma unroll
            for (int x = 0; x < 4; ++x) { const int e = 16 * (4 * eh + x) + 4 * quad; const v2u og = ogv[x];
                const float y0 = hval[x][0] * rstd * NW[e] * bflo(og.x), y1 = hval[x][1] * rstd * NW[e + 1] * bfhi(og.x), y2 = hval[x][2] * rstd * NW[e + 2] * bflo(og.y), y3 = hval[x][3] * rstd * NW[e + 3] * bfhi(og.y);
                v2u o; o.x = pk2(y0, y1); o.y = pk2(y2, y3); *(v2u*)(hm + (size_t)(tok0 + tq) * 512 + hh * 128 + e) = o; }
        }
        { const float ebl = __expf(bl);
          bf16x8 kf[2];
#pragma unroll
          for (int kk = 0; kk < 2; ++kk) kf[kk] = *(const LAS bf16x8*)(KET + (16 * w + c16) * 72 + 32 * kk + 8 * quad);
#pragma unroll
          for (int et = 0; et < 9; ++et) { f32x4 z = cacc[et] * ebl;
#pragma unroll
              for (int kk = 0; kk < 2; ++kk) z = __builtin_amdgcn_mfma_f32_16x16x32_bf16(*(const LAS bf16x8*)(VT + (16 * et + c16) * 72 + 32 * kk + 8 * quad), kf[kk], z, 0, 0, 0);
              cacc[et] = z;
              if (L3) {
#pragma unroll
                  for (int j = 0; j < 4; ++j) CT[(16 * et + 4 * quad + j) * 136 + 16 * w + c16] = (bf16)f2bf(z[j]); } } }
        ML_LBAR();
    }
#undef ML_LOADRAW
#undef ML_LBAR
    if (!L3) {
#pragma unroll
        for (int et = 0; et < 9; ++et)
#pragma unroll
            for (int j = 0; j < 4; ++j) mlc[(16 * et + 4 * quad + j) * 128 + 16 * w + c16] = cacc[et][j];
        if (X.tid == 0) mlb[unit] = bsum;
    }
}
DI void mlstm_scan(const Args& a, const Ctx& X) {
    float* mlc = (float*)(a.ws + WS_MLC); const float* mlb = (const float*)(a.ws + WS_MLB);
    for (int idx = X.bid * 512 + X.tid; idx < 8 * 18432; idx += X.G * 512) { const int seq = idx / 18432, el = idx - seq * 18432; float carry = 0.f;
        float* p0 = mlc + (size_t)seq * 32 * 18432 + el; float v[32], dcy[32];
#pragma unroll
        for (int j = 0; j < 32; ++j) { v[j] = p0[(size_t)j * 18432]; dcy[j] = mlb[seq * 32 + j]; }
#pragma unroll
        for (int j = 0; j < 32; ++j) { p0[(size_t)j * 18432] = carry; carry = __expf(dcy[j]) * carry + v[j]; } }
}

constexpr int P6_WR = 0, P6_AT = 33024, P6_SH = 37120, P6_LG = 41216, P6_HIST = 65536;
DI void p6_norm_route(const Args& a, const Ctx& X, int l, const bf16* xin) {
    unsigned char* ws = a.ws;
    LAS bf16* wrb = (LAS bf16*)(X.lds + P6_WR);
    LAS float* at = (LAS float*)(X.lds + P6_AT); LAS float* sht = (LAS float*)(X.lds + P6_SH);
    LAS float* lg = (LAS float*)(X.lds + P6_LG) + X.wave * 272;
    for (int idx = X.tid; idx < 16384; idx += 512) { const int k = idx >> 4, e = idx & 15; wrb[e * 1032 + k] = (bf16)f2bf(a.router_w[idx]); }
    const float* mod = (const float*)(ws + WS_MOD); unsigned char* hb = (unsigned char*)(ws + WS_H); float* tgate = (float*)(ws + WS_TGATE); int* tokl = (int*)(ws + WS_TOKL);
    const float* ssq = (const float*)(ws + WS_SSQ);
    unsigned* cnt = (unsigned*)(ws + WS_CTL) + CW_CNT + l * 2048;
    LAS int* hist = (LAS int*)(X.lds + P6_HIST); LAS int* cbase = hist + 32;
    int lane = X.lane; asm volatile("" : "+v"(lane));
    const int r = lane & 15, q = lane >> 4;
    const int gw = X.bid * 8 + X.wave, NGW = X.G * 8;
    for (int it = 0; it * NGW < T / 16; ++it) {
        const int rg = it * NGW + gw; const bool act = rg < T / 16;
        const int row0 = (act ? rg : 0) * 16; const int bb = ((it * NGW + X.bid * 8) * 16) >> 14;
        __syncthreads();
        if (X.tid < 32) hist[X.tid] = 0;
        { const float* mb = mod + (size_t)(l * 2 + (bb < 2 ? bb : 1)) * 6144;
          for (int k = X.tid; k < 1024; k += 512) { at[k] = a.nfw[l * D + k] * (1.0f + mb[4 * 1024 + k]); sht[k] = mb[3 * 1024 + k]; } }
        __syncthreads();
        const int row = row0 + r;
        float rstd;
        { const f32x4 pp = *(const f32x4*)(ssq + (size_t)row * 16 + 4 * q); float ss = (pp.x + pp.y) + (pp.z + pp.w); ss += __shfl_xor(ss, 16); ss += __shfl_xor(ss, 32); rstd = __builtin_amdgcn_rsqf(ss * (1.0f / D) + EPS); }
        const bf16* xr = xin + (size_t)row * D + 8 * q; unsigned char* hr = hb + (size_t)row * D + 8 * q;
        f32x4 acc = {0.f, 0.f, 0.f, 0.f};
#pragma unroll 8
        for (int s = 0; s < 32; ++s) {
            const v4u xw = *(const v4u*)(xr + 32 * s); const f32x4 x0 = {bflo(xw.x), bfhi(xw.x), bflo(xw.y), bfhi(xw.y)}, x1 = {bflo(xw.z), bfhi(xw.z), bflo(xw.w), bfhi(xw.w)};
            const f32x4 a0 = *(const LAS f32x4*)(at + 32 * s + 8 * q), a1 = *(const LAS f32x4*)(at + 32 * s + 8 * q + 4);
            const f32x4 s0 = *(const LAS f32x4*)(sht + 32 * s + 8 * q), s1 = *(const LAS f32x4*)(sht + 32 * s + 8 * q + 4);
            const f32x4 h0 = x0 * rstd * a0 + s0, h1 = x1 * rstd * a1 + s1;
            v4u w; w.x = pk2m(h0.x, h0.y); w.y = pk2m(h0.z, h0.w); w.z = pk2m(h1.x, h1.y); w.w = pk2m(h1.z, h1.w);
            { v2u w8; w8.x = pk4_fp8(h0.x, h0.y, h0.z, h0.w); w8.y = pk4_fp8(h1.x, h1.y, h1.z, h1.w); *(v2u*)(hr + 32 * s) = w8; }
            const bf16x8 bfr = *(const LAS bf16x8*)(wrb + r * 1032 + 32 * s + 8 * q);
            acc = __builtin_amdgcn_mfma_f32_16x16x32_bf16(__builtin_bit_cast(bf16x8, w), bfr, acc, 0, 0, 0);
        }
#pragma unroll
        for (int j = 0; j < 4; ++j) lg[(4 * q + j) * 17 + r] = acc[j];
        LDS_WAIT(); asm volatile("" ::: "memory");
        int my_cls = 0; float my_ga = 0.f, my_gb = 0.f;
        if (lane < 16) {
            float sc[16], sel[16];
#pragma unroll
            for (int e = 0; e < 16; ++e) { const float p = lg[lane * 17 + e]; sc[e] = 1.0f / (1.0f + __expf(-p)); sel[e] = sc[e] + a.router_b[e]; }
            int gi = 0; float gbest = -1.0e30f;
#pragma unroll
            for (int g = 0; g < 4; ++g) { const float p0 = sel[4 * g], p1 = sel[4 * g + 1], p2 = sel[4 * g + 2], p3 = sel[4 * g + 3];
                const float gs = fmaxf(fmaxf(fmaxf(p0 + p1, p0 + p2), fmaxf(p0 + p3, p1 + p2)), fmaxf(p1 + p3, p2 + p3));
                if (gs > gbest) { gbest = gs; gi = g; } }
            float qs[4], s4[4];
#pragma unroll
            for (int i = 0; i < 4; ++i) { qs[i] = 0.f; s4[i] = 0.f; }
#pragma unroll
            for (int g = 0; g < 4; ++g) if (g == gi) {
#pragma unroll
                for (int i = 0; i < 4; ++i) { qs[i] = sel[4 * g + i]; s4[i] = sc[4 * g + i]; } }
            int i1 = 0; float b1 = qs[0];
#pragma unroll
            for (int i = 1; i < 4; ++i) if (qs[i] > b1) { b1 = qs[i]; i1 = i; }
            int i2 = -1; float b2 = -1.0e30f;
#pragma unroll
            for (int i = 0; i < 4; ++i) if (i != i1 && qs[i] > b2) { b2 = qs[i]; i2 = i; }
            const int ia = (i1 < i2) ? i1 : i2, ib = (i1 < i2) ? i2 : i1;
            float sa = 0.f, sb = 0.f;
#pragma unroll
            for (int i = 0; i < 4; ++i) { if (i == ia) sa = s4[i]; if (i == ib) sb = s4[i]; }
            const int pidx = (ia == 0) ? (ib - 1) : ((ia == 1) ? (ib + 1) : 5);
            const float inv = 1.0f / (sa + sb);
            my_cls = gi * 6 + pidx; my_ga = sa * inv; my_gb = sb * inv;
        }
        int rank = 0;
        if (act && lane < 16) rank = __hip_atomic_fetch_add(hist + my_cls, 1, __ATOMIC_RELAXED, __HIP_MEMORY_SCOPE_WORKGROUP);
        __syncthreads();
        if (X.tid < NCLS) { const int n = hist[X.tid]; cbase[X.tid] = n ? (int)__hip_atomic_fetch_add(cnt + 64 * X.tid, (unsigned)n, RLX_AGENT) : 0; }
        __syncthreads();
        if (act && lane < 16) { const int tok = row0 + lane; const int pos = cbase[my_cls] + rank;
            tokl[my_cls * CLS_CAP + pos] = tok; tgate[tok * 2] = my_ga; tgate[tok * 2 + 1] = my_gb; }
    }
}
DI MoeTab moe_tables(const Args& a, const Ctx& X, int l) {
    LAS int* tab = (LAS int*)(X.lds + TAB_OFF); LAS int* tcls = tab; LAS int* tpos = tab + 160; LAS int* cn = tab + 320; LAS int* rt_ = tab + 344;
    unsigned* cnt = (unsigned*)(a.ws + WS_CTL) + CW_CNT + l * 2048;
    if (X.tid < NCLS) cn[X.tid] = (int)__hip_atomic_load(cnt + 64 * X.tid, RLX_AGENT);
    __syncthreads();
    if (X.tid == 0) { int r = 0;
#pragma unroll 1
        for (int c = 0; c < NCLS; ++c) { const int n = (cn[c] + 255) >> 8;
#pragma unroll 1
            for (int i = 0; i < n; ++i) { tcls[r] = c; tpos[r] = i * 256; ++r; } }
        rt_[0] = r; }
    __syncthreads();
    MoeTab tb; tb.tcls = tcls; tb.tpos = tpos; tb.cnt = cn; tb.Rtot = __builtin_amdgcn_readfirstlane(rt_[0]); return tb;
}

#if defined(__HIP_DEVICE_COMPILE__)
DI Args load_args() { auto p = __builtin_amdgcn_kernarg_segment_ptr(); asm volatile("" : "+s"(p)); return *(const __attribute__((address_space(4))) Args*)p; }
#else
DI Args load_args() { return Args{}; }
#endif
__global__ void __launch_bounds__(512, 2) fwd(Args a_unused) {
    extern __shared__ __attribute__((aligned(16))) unsigned char lds_raw[];
    Ctx X; X.lds = (LAS unsigned char*)lds_raw; X.tid = threadIdx.x; X.lane = X.tid & 63; X.wave = __builtin_amdgcn_readfirstlane(X.tid >> 6); X.G = gridDim.x; X.bid = blockIdx.x;
    volatile LAS unsigned* MISC = (volatile LAS unsigned*)(X.lds + MISC_OFF);
    if (X.tid < 64) MISC[X.tid] = 0u;
    __syncthreads();
    int lo, hi; unsigned* ctl;
    { const Args a = load_args(); lo = a.ph_lo; hi = a.ph_hi; ctl = (unsigned*)(a.ws + WS_CTL); }
    XcdBarrier bar; bar.bar = ctl + CW_BAR; bar.x = 0; bar.st = MISC + 8;
    if (hi - lo > 1) bar = xcd_barrier_post(ctl + CW_BAR, MISC + 8);
#ifndef PH_MASK
#define PH_MASK 0xFFFFF
#endif
#define PON(p) ((PH_MASK >> (p)) & 1)
#ifndef DUP_MASK
#define DUP_MASK 0
#endif
#define NREP(p) (((DUP_MASK >> (p)) & 1) ? 2 : 1)
#ifndef TSEL_MASK
#define TSEL_MASK 0
#endif
#define TSCALE 4
#define TSEL(p) ((TSEL_MASK >> (p)) & 1)
#define IN(k) (lo <= (k) && (k) < hi)
#define SEAM(k) do { if (IN(k) && IN((k) + 1)) xcd_barrier(bar); } while (0)
    unsigned long long tacc = 0ull, tph = 0ull;
#define TBEG() do { if (TSEL_MASK) tph = __builtin_amdgcn_s_memrealtime(); } while (0)
#define TEND(p) do { if (TSEL(p)) tacc += __builtin_amdgcn_s_memrealtime() - tph; } while (0)
    TBEG();
    if (PON(10) && IN(0)) { for (int rep = 0; rep < NREP(10); ++rep) { const Args a = load_args(); p0_prologue(a, X); } }
    SEAM(0); TEND(10);
    TBEG();
    for (int l = 0; l < NL; ++l) {
        const int g0 = 1 + l * NPH;
        if (PON(0) && IN(g0 + 0)) { for (int rep = 0; rep < NREP(0); ++rep) { const Args a = load_args(); unsigned char* ws = a.ws; const float* mod = (const float*)(ws + WS_MOD); bf16* proj = (bf16*)(ws + WS_PROJ); bf16* xb = (bf16*)(ws + WS_XB); (void)mod; (void)proj; (void)xb; const Ctx P = fresh(X); p1_norm_gates(a, P, l, xb); } }
        SEAM(g0 + 0); TEND(0); TBEG();
        if (PON(1) && IN(g0 + 1)) for (int rep = 0; rep < NREP(1); ++rep) { const Args a = load_args(); unsigned char* ws = a.ws; const float* mod = (const float*)(ws + WS_MOD); bf16* proj = (bf16*)(ws + WS_PROJ); bf16* xb = (bf16*)(ws + WS_XB); (void)mod; (void)proj; (void)xb; const Ctx P = fresh(X);
            DenseSched S; S.A = (const char*)(ws + WS_H); S.Bt = (const char*)(ws + WS_WIN) + (size_t)l * NPROJW * D; S.lda = D; S.ldb = D; S.ord.init(T / 256, NPROJW / 256, P.G, P.bid);
            EpiProj E; E.O = proj; E.gates = (float*)(ws + WS_GATES); E.big = a.b_ig + l * 4; E.bfg = a.b_fg + l * 4;
            pg8::gemm_phase<EpiProj, DenseSched, true>(P.lds, D, S, E);
        }
        SEAM(g0 + 1); TEND(1); TBEG();
        if (PON(2) && IN(g0 + 2)) { const Args a = load_args(); unsigned char* ws = a.ws; const float* mod = (const float*)(ws + WS_MOD); bf16* proj = (bf16*)(ws + WS_PROJ); bf16* xb = (bf16*)(ws + WS_XB); (void)mod; (void)proj; (void)xb; const Ctx P = fresh(X);
            if (PON(11)) for (int rep = 0; rep < NREP(11); ++rep) {
#pragma unroll 1
                for (int u = P.bid; u < 512; u += P.G) attn_unit(a, P, l, u); }
            if (PON(12)) for (int rep = 0; rep < NREP(12); ++rep) {
#pragma unroll 1
                for (int u = P.bid; u < 256; u += P.G) mlstm_unit<false>(a, P, l, u); }
        }
        SEAM(g0 + 2); TEND(2); TBEG();
        if (PON(3) && IN(g0 + 3)) { const Args a = load_args(); unsigned char* ws = a.ws; const float* mod = (const float*)(ws + WS_MOD); bf16* proj = (bf16*)(ws + WS_PROJ); bf16* xb = (bf16*)(ws + WS_XB); (void)mod; (void)proj; (void)xb; const Ctx P = fresh(X); mlstm_scan(a, P); }
        SEAM(g0 + 3); TEND(3); TBEG();
        if (PON(4) && IN(g0 + 4)) for (int rep = 0; rep < NREP(4); ++rep) { const Args a = load_args(); unsigned char* ws = a.ws; const float* mod = (const float*)(ws + WS_MOD); bf16* proj = (bf16*)(ws + WS_PROJ); bf16* xb = (bf16*)(ws + WS_XB); (void)mod; (void)proj; (void)xb; const Ctx P = fresh(X);
#pragma unroll 1
            for (int u = P.bid; u < 256; u += P.G) mlstm_unit<true>(a, P, l, u); }
        SEAM(g0 + 4); TEND(4); TBEG();
        if (PON(5) && IN(g0 + 5)) for (int rep = 0; rep < NREP(5); ++rep) { const Args a = load_args(); unsigned char* ws = a.ws; const float* mod = (const float*)(ws + WS_MOD); bf16* proj = (bf16*)(ws + WS_PROJ); bf16* xb = (bf16*)(ws + WS_XB); (void)mod; (void)proj; (void)xb; const Ctx P = fresh(X);
            MergeSched S; S.A0 = (const char*)(ws + WS_H); S.A1 = (const char*)(ws + WS_H) + (size_t)T * 512 * 2; S.B0 = (const char*)(ws + WS_WAU) + (size_t)l * D * 512 * 2; S.B1 = (const char*)(ws + WS_WMU) + (size_t)l * D * 512 * 2;
            S.lda = 1024; S.ldb = 1024; S.ord.init(T / 256, D / 256, P.G, P.bid);
            EpiMerge E; E.P = proj; pg8::gemm_phase<EpiMerge, MergeSched>(P.lds, 2048, S, E);
        }
        SEAM(g0 + 5); TEND(5); TBEG();
        if (PON(6) && IN(g0 + 6)) for (int rep = 0; rep < NREP(6); ++rep) { const Args a = load_args(); unsigned char* ws = a.ws; const float* mod = (const float*)(ws + WS_MOD); bf16* proj = (bf16*)(ws + WS_PROJ); bf16* xb = (bf16*)(ws + WS_XB); (void)mod; (void)proj; (void)xb; const Ctx P = fresh(X);
            DenseSched S; S.A = (const char*)(proj + C_MQ); S.Bt = (const char*)(ws + WS_WOUT) + (size_t)l * D * D * 2; S.lda = NPROJ * 2; S.ldb = D * 2; S.ord.init(T / 256, D / 256, P.G, P.bid);
            EpiRes E; E.xin = xb; E.out = xb; E.g = mod + (size_t)(l * 2) * 6144 + 2 * 1024; E.ssq = (float*)(ws + WS_SSQ); E.rmask = T - 1;
            if (rep) { E.out = (bf16*)(ws + WS_H); E.rmask = T / 2 - 1; }
            pg8::gemm_phase<EpiRes, DenseSched>(P.lds, D * 2, S, E);
        }
        SEAM(g0 + 6); TEND(6); TBEG();
        if (PON(7) && IN(g0 + 7)) { const Args a = load_args(); unsigned char* ws = a.ws; const float* mod = (const float*)(ws + WS_MOD); bf16* proj = (bf16*)(ws + WS_PROJ); bf16* xb = (bf16*)(ws + WS_XB); (void)mod; (void)proj; (void)xb; const Ctx P = fresh(X); p6_norm_route(a, P, l, xb); }
        SEAM(g0 + 7); TEND(7); TBEG();
        if (PON(8) && IN(g0 + 8)) for (int rep = 0; rep < NREP(8); ++rep) { const Args a = load_args(); unsigned char* ws = a.ws; const float* mod = (const float*)(ws + WS_MOD); bf16* proj = (bf16*)(ws + WS_PROJ); bf16* xb = (bf16*)(ws + WS_XB); (void)mod; (void)proj; (void)xb; const Ctx P = fresh(X);
            const MoeTab tb = moe_tables(a, P, l);
            LAS unsigned* tokoff = (LAS unsigned*)(P.lds + TOKOFF_OFF); const int* tokl = (const int*)(ws + WS_TOKL);
#pragma unroll 1
            for (int s = 0; s < 8; ++s) { const int L0 = s * P.G + P.bid;
                if (L0 < tb.Rtot * 8 && P.tid < 256) { const int L = xcd_remap(L0, tb.Rtot * 8); const int rt = L >> 3, cls = tb.tcls[rt], pos = tb.tpos[rt] + P.tid, cn = tb.cnt[cls]; const int tok = tokl[cls * CLS_CAP + (pos < cn ? pos : 0)]; tokoff[s * 256 + P.tid] = (unsigned)tok; } }
            __syncthreads();
            MoeUpSched S; S.A = (const char*)(ws + WS_H); S.W = (const char*)(ws + WS_WGU) + (size_t)l * NE * 1024 * D; S.lda = D; S.ldb = D; S.tb = tb; S.G = P.G; S.c = P.bid; S.tokoff = tokoff;
            EpiSwiglu E; E.H = (unsigned char*)proj; E.tgate = (const float*)(ws + WS_TGATE); E.tokoff = tokoff;
            pg8::gemm_phase<EpiSwiglu, MoeUpSched, true>(P.lds, D, S, E);
        }
        SEAM(g0 + 8); TEND(8); TBEG();
        if (PON(9) && IN(g0 + 9)) for (int rep = 0; rep < NREP(9); ++rep) { const Args a = load_args(); unsigned char* ws = a.ws; const float* mod = (const float*)(ws + WS_MOD); bf16* proj = (bf16*)(ws + WS_PROJ); bf16* xb = (bf16*)(ws + WS_XB); (void)mod; (void)proj; (void)xb; const Ctx P = fresh(X);
            const MoeTab tb = moe_tables(a, P, l);
            MoeDownSched S; S.A = (const char*)proj; S.W = (const char*)(ws + WS_WD) + (size_t)l * NE * 1024 * FF; S.lda = D; S.ldb = FF; S.tb = tb; S.G = P.G; S.c = P.bid;
            EpiMoeOut E; E.xin = xb; E.outb = xb; E.outf = a.out; E.last = (l == NL - 1); E.g = mod + (size_t)(l * 2) * 6144 + 5 * 1024; E.tokl = (const int*)(ws + WS_TOKL); E.tb = tb; E.rmask = T - 1;
            if (rep) { E.outb = (bf16*)(ws + WS_H); E.last = 0; E.rmask = T / 2 - 1; }
            pg8::gemm_phase<EpiMoeOut, MoeDownSched, true>(P.lds, D, S, E);
        }
        SEAM(g0 + 9); TEND(9); TBEG();
    }
    if (TSEL_MASK && X.bid == 0) { const unsigned long long t1 = __builtin_amdgcn_s_memrealtime(); while (__builtin_amdgcn_s_memrealtime() - t1 < TSCALE * tacc) __builtin_amdgcn_s_sleep(8); }
#undef IN
#undef SEAM
}

extern "C" void kernel_launch(void* const* d_in, const int* in_sizes, int n_in, void* d_out, int out_size, void* d_ws, size_t ws_size, hipStream_t stream) {
    static int grid = 0;
    if (grid == 0) {
        if (n_in != 24 || in_sizes[0] != T * D || out_size != T * D || ws_size < WS_END) { fprintf(stderr, "kernel_launch: unexpected shapes / workspace (n_in %d, ws %zu, need %zu)\n", n_in, ws_size, (size_t)WS_END); grid = -1; return; }
        int dev = 0, cus = 0;
        if (hipGetDevice(&dev) != hipSuccess || hipDeviceGetAttribute(&cus, hipDeviceAttributeMultiprocessorCount, dev) != hipSuccess) { grid = -1; return; }
        if (hipFuncSetAttribute((const void*)fwd, hipFuncAttributeMaxDynamicSharedMemorySize, LDS_BYTES) != hipSuccess) { fprintf(stderr, "kernel_launch: hipFuncSetAttribute failed\n"); grid = -1; return; }
        int per_cu = 0;
        if (hipOccupancyMaxActiveBlocksPerMultiprocessor(&per_cu, (const void*)fwd, 512, LDS_BYTES) != hipSuccess || per_cu < 1) fprintf(stderr, "kernel_launch: occupancy query reports %d\n", per_cu);
        (void)hipGetLastError();
        grid = cus < 256 ? cus : 256;
    }
    if (grid < 0) return;
    (void)hipMemsetAsync((char*)d_ws + WS_CTL, 0, CTL_ZERO_BYTES, stream);
    Args a{};
    a.x = (const float*)d_in[0]; a.c = (const float*)d_in[1]; a.pos = (const int*)d_in[2]; a.ada_w = (const float*)d_in[3]; a.ada_b = (const float*)d_in[4];
    a.nmw = (const float*)d_in[5]; a.nfw = (const float*)d_in[6]; a.w_in = (const float*)d_in[7]; a.b_ig = (const float*)d_in[8]; a.b_fg = (const float*)d_in[9];
    a.qnw = (const float*)d_in[10]; a.knw = (const float*)d_in[11]; a.sinks = (const float*)d_in[12]; a.conv_w = (const float*)d_in[13]; a.conv_b = (const float*)d_in[14];
    a.mnw = (const float*)d_in[15]; a.w_au = (const float*)d_in[16]; a.w_mu = (const float*)d_in[17]; a.w_out = (const float*)d_in[18]; a.router_w = (const float*)d_in[19];
    a.router_b = (const float*)d_in[20]; a.w_gate = (const float*)d_in[21]; a.w_up = (const float*)d_in[22]; a.w_down = (const float*)d_in[23];
    a.out = (float*)d_out; a.ws = (unsigned char*)d_ws;
#if MK_MULTI
    for (int gp = 0; gp < NGP; ++gp) { a.ph_lo = gp; a.ph_hi = gp + 1; hipLaunchKernelGGL(fwd, dim3(grid), dim3(512), LDS_BYTES, stream, a); }
#else
    a.ph_lo = 0; a.ph_hi = NGP; hipLaunchKernelGGL(fwd, dim3(grid), dim3(512), LDS_BYTES, stream, a);
#endif
}
```

```cpp
#include <hip/hip_runtime.h>
#include <cstdio>
#include <cstdint>

#ifndef MK_MULTI
#define MK_MULTI 0
#endif

#define GAS __attribute__((address_space(1)))
#define LAS __attribute__((address_space(3)))
typedef unsigned short bf16;
typedef unsigned v4u __attribute__((ext_vector_type(4)));
typedef unsigned v2u __attribute__((ext_vector_type(2)));
typedef float f32x4 __attribute__((ext_vector_type(4)));
typedef float f32x2 __attribute__((ext_vector_type(2)));
typedef short bf16x8 __attribute__((ext_vector_type(8)));
typedef short bf16x4 __attribute__((ext_vector_type(4)));
#define DI __device__ __forceinline__
#define RLX_AGENT __ATOMIC_RELAXED, __HIP_MEMORY_SCOPE_AGENT
#define LDS_WAIT() asm volatile("s_waitcnt lgkmcnt(0)" ::: "memory")
#define VM_WAIT() asm volatile("s_waitcnt vmcnt(0)" ::: "memory")

constexpr int NB = 2, SEQ = 16384, T = NB * SEQ, D = 1024, NL = 4;
constexpr int DIN_SRC = 4872;
constexpr int NPROJ = 4864;
constexpr int C_AQ = 0, C_AK = 512, C_AV = 640, C_MQ = 768, C_MK = 1280, C_MV = 1792, C_MO = 2304, C_GA = 2816, C_GB = 3840;
constexpr int NE = 16, FF = 512;
constexpr int NCLS = 24, CLS_CAP = 32768;
constexpr float EPS = 1e-6f;
constexpr int NPH = 10;
constexpr int NGP = 1 + NL * NPH;

constexpr size_t MiB = 1u << 20;
constexpr size_t WS_CTL = 0, CTL_ZERO_BYTES = 1 * MiB;
constexpr size_t WS_MOD = 1 * MiB;
constexpr size_t WS_ROPE = 2 * MiB;
constexpr size_t WS_GATES = 4 * MiB;
constexpr size_t WS_TGATE = 5 * MiB;
constexpr size_t WS_TOKL = 6 * MiB;
constexpr size_t WS_MLB = 9 * MiB;
constexpr size_t WS_MLC = 10 * MiB;
constexpr int NPROJW = 5120;
constexpr size_t WS_WIN = 28 * MiB;
constexpr size_t WS_WAU = 68 * MiB;
constexpr size_t WS_WMU = 72 * MiB;
constexpr size_t WS_WOUT = 76 * MiB;
constexpr size_t WS_WGU = 84 * MiB;
constexpr size_t WS_WD = 148 * MiB;
constexpr size_t WS_H = 212 * MiB;
constexpr size_t WS_PROJ = 276 * MiB;
constexpr size_t WS_SSQ = 580 * MiB;
constexpr size_t WS_KC = 582 * MiB;
constexpr size_t WS_XB = 614 * MiB;
constexpr size_t WS_END = 678 * MiB;

constexpr int CW_TMO = 0;
constexpr int CW_BAR = 4096;
constexpr int CW_CNT = 8192;

constexpr int RING_BYTES = 131072;
constexpr int MISC_OFF = RING_BYTES;
constexpr int TAB_OFF = RING_BYTES + 256;
constexpr int TOKOFF_OFF = RING_BYTES + 2048;
constexpr int LDS_BYTES = 147456;

typedef __bf16 bf16x2_t __attribute__((ext_vector_type(2)));
DI unsigned cvt_pk_bf16(float lo, float hi) { const f32x2 v = {lo, hi}; return __builtin_bit_cast(unsigned, __builtin_convertvector(v, bf16x2_t)); }
DI unsigned pk2m(float lo, float hi) { return cvt_pk_bf16(lo, hi); }
DI unsigned f2bf(float f) { return cvt_pk_bf16(f, 0.f) & 0xffffu; }
DI unsigned pk2(float lo, float hi) { return cvt_pk_bf16(lo, hi); }
DI float bf2f(unsigned short b) { return __builtin_bit_cast(float, ((unsigned)b) << 16); }
DI float bflo(unsigned w) { return __builtin_bit_cast(float, w << 16); }
DI float bfhi(unsigned w) { return __builtin_bit_cast(float, w & 0xffff0000u); }
DI float wave_sum(float v) {
#pragma unroll
    for (int o = 1; o < 64; o <<= 1) v += __shfl_xor(v, o);
    return v;
}
DI unsigned pk4_fp8(float a0, float a1, float a2, float a3) { int p = __builtin_amdgcn_cvt_pk_fp8_f32(a0, a1, 0, false); p = __builtin_amdgcn_cvt_pk_fp8_f32(a2, a3, p, true); return (unsigned)p; }
DI float sigmoidf_(float x) { return __builtin_amdgcn_rcpf(1.0f + __expf(-x)); }

#define XB_TMO      128
#define XB_XCNT(j)  (256  + 64 * (j))
#define XB_XSUB(j)  (1280 + 64 * (j))
#define XB_XGEN(j)  (2304 + 64 * (j))
#define XB_TOP      3328
#define XB_TOPGEN   3392
#define XCD_BAR_WORDS 3456
#define XB_SPIN_CAP (1u << 18)
__device__ __forceinline__ unsigned xb_ld(unsigned* p)              { return __hip_atomic_load(p, __ATOMIC_RELAXED, __HIP_MEMORY_SCOPE_AGENT); }
__device__ __forceinline__ unsigned xb_add(unsigned* p, unsigned v) { return __hip_atomic_fetch_add(p, v, __ATOMIC_RELAXED, __HIP_MEMORY_SCOPE_AGENT); }
__device__ __forceinline__ unsigned xb_xcc_id() { return (unsigned)__builtin_amdgcn_s_getreg((3 << 11) | 20) & 0xFu; }
#define XB_SPIN(cond, bar) do { unsigned _sp = 0; while (cond) { __builtin_amdgcn_s_sleep(1); \
    if ((++_sp & 255u) == 0u) { if (xb_ld(&(bar)[XB_TMO])) break; if (_sp > XB_SPIN_CAP) { atomicAdd(&(bar)[XB_TMO], 1u); break; } } } } while (0)
struct XcdBarrier { unsigned* bar; unsigned x; volatile LAS unsigned* st; };
__device__ __forceinline__ XcdBarrier xcd_barrier_post(unsigned* bar, volatile LAS unsigned* st) {
    XcdBarrier b; b.bar = bar; b.x = xb_xcc_id(); b.st = st;
    if (threadIdx.x == 0) (void)xb_add(&bar[XB_XCNT(b.x)], 1u);
    return b;
}
__device__ __forceinline__ void xcd_barrier_complete(unsigned* bar, unsigned x, unsigned& nloc, unsigned& nx) {
    const unsigned G = gridDim.x * gridDim.y * gridDim.z;
    unsigned sum, cnt, mine, sp = 0u;
    for (;;) {
        sum = 0u; cnt = 0u; mine = 0u;
#pragma unroll
        for (unsigned j = 0; j < 16; ++j) { const unsigned c = xb_ld(&bar[XB_XCNT(j)]); sum += c; cnt += (c > 0u) ? 1u : 0u; mine = (j == x) ? c : mine; }
        if (sum == G) break;
        __builtin_amdgcn_s_sleep(1);
        if ((++sp & 255u) == 0u) { if (xb_ld(&bar[XB_TMO])) break; if (sp > XB_SPIN_CAP) { atomicAdd(&bar[XB_TMO], 1u); break; } }
    }
    nloc = mine > 0u ? mine : 1u; nx = cnt > 0u ? cnt : 1u;
}
__device__ __forceinline__ void xcd_barrier(const XcdBarrier& b) {
    asm volatile("s_waitcnt vmcnt(0)" ::: "memory");
    __syncthreads();
    if (threadIdx.x == 0) {
        unsigned* bar = b.bar;
        __builtin_amdgcn_s_waitcnt(0);
        unsigned nloc = b.st[0], nx = b.st[1];
        if (nloc == 0u) { xcd_barrier_complete(bar, b.x, nloc, nx); b.st[0] = nloc; b.st[1] = nx; }
        const unsigned old = xb_add(&bar[XB_XSUB(b.x)], 1u);
        const unsigned gen = old / nloc;
        if (old + 1u == (gen + 1u) * nloc) {
            __builtin_amdgcn_fence(__ATOMIC_RELEASE, "agent");
            asm volatile("s_waitcnt vmcnt(0)" ::: "memory");
            const unsigned og = xb_add(&bar[XB_TOP], 1u);
            const unsigned tg = og / nx;
            if (og + 1u == (tg + 1u) * nx) xb_add(&bar[XB_TOPGEN], 1u);
            else XB_SPIN(xb_ld(&bar[XB_TOPGEN]) == tg, bar);
            __builtin_amdgcn_fence(__ATOMIC_ACQUIRE, "agent");
            xb_add(&bar[XB_XGEN(b.x)], 1u);
            asm volatile("s_waitcnt vmcnt(0)" ::: "memory");
        } else {
            XB_SPIN(xb_ld(&bar[XB_XGEN(b.x)]) == gen, bar);
            __builtin_amdgcn_fence(__ATOMIC_ACQUIRE, "agent");
            asm volatile("s_waitcnt vmcnt(0)" ::: "memory");
        }
    }
    __syncthreads();
}

namespace pg8 {
constexpr int BM = 256, BK = 64, HALF = 128, HTB = HALF * BK * 2, STAGE_BYTES = 8 * HTB, NXCD = 8, WGM = 8;
__host__ __device__ __forceinline__ int lds_byte(int r, int c) { const int st = (r >> 4) * 2 + (c >> 5), rr = r & 15, cc = c & 31, ob = rr * 64 + cc * 2; return st * 1024 + (ob ^ (((ob >> 9) & 1) << 5)); }
__host__ __device__ __forceinline__ void stage_rc(int b, int& R, int& C) { const int st = b / 1024, sb = b % 1024, swz = sb ^ (((sb >> 9) & 1) << 5); R = (st >> 1) * 16 + swz / 64; C = (st & 1) * 32 + (swz % 64) / 2; }
__host__ __device__ __forceinline__ int perm32(int rho) { const int n = rho >> 4, i = rho & 15; return 8 * (i >> 2) + 4 * n + (i & 3); }

struct Unit { int pm, pn, x0, x1; };

struct TileOrder {
    int nM, nN, nwg, G, c;
    __device__ void init(int nM_, int nN_, int G_, int c_) { nM = nM_; nN = nN_; nwg = nM * nN; G = G_; c = c_; }
    __device__ bool get(int i, int& pm, int& pn) const {
        const long L = (long)i * G + c; if (L >= nwg) return false;
        int wgid = (int)L; { const int q = nwg / NXCD, r = nwg % NXCD, xcd = wgid % NXCD, off = wgid / NXCD; wgid = (xcd < r ? xcd * (q + 1) : r * (q + 1) + (xcd - r) * q) + off; }
        const int nig = WGM * nN, gid = wgid / nig, fm = gid * WGM, gsz = (nM - fm) < WGM ? (nM - fm) : WGM;
        pm = fm + ((wgid % nig) % gsz); pn = (wgid % nig) / gsz; return true;
    }
};

typedef int v8i __attribute__((ext_vector_type(8)));
template <class Epi, class Sched, bool F8 = false>
__device__ __forceinline__ void gemm_phase(LAS unsigned char* lds, const int Kb, const Sched& S, const Epi& E) {
    int tid = threadIdx.x; asm volatile("" : "+v"(tid));
    const int wid = __builtin_amdgcn_readfirstlane(tid >> 6), lane = tid & 63, wr = wid >> 2, wc = wid & 3, fr = lane & 15, fq = lane >> 4;
    const int nt = Kb / 128;
    constexpr bool GA = Sched::GATHER; constexpr int KS = Sched::KSPLIT; constexpr bool ASPLIT = Sched::ASPLIT;
    unsigned voffA[2], voffB[2]; int Rst[2], Cst[2];
#pragma unroll
    for (int i = 0; i < 2; ++i) { int R, C; stage_rc(tid * 16 + i * 8192, R, C); const int Rb = Epi::PERM ? ((R & ~31) + perm32(R & 31)) : R;
        voffA[i] = (unsigned)(R * S.lda + C * 2); voffB[i] = (unsigned)(Rb * S.ldb + C * 2); Rst[i] = R; Cst[i] = C; }
    const size_t kstep = (size_t)(BK * 2);
    const size_t hstepA = (size_t)HALF * S.lda, hstepB = (size_t)HALF * S.ldb;
    const unsigned ldsw = (unsigned)wid * 1024u; const unsigned gmul = (unsigned)S.lda;
    const int aoff = F8 ? (lds_byte(wr * 64 + fr, (fq & 1) * 16) + (fq >> 1) * 1024) : lds_byte(wr * 64 + fr, fq * 8);
    const int boff = F8 ? (lds_byte(wc * 32 + fr, (fq & 1) * 16) + (fq >> 1) * 1024) : lds_byte(wc * 32 + fr, fq * 8);
    unsigned vAc[2], vAn[2];
#define PG8_SA(b, h) (((b) * 2 + (h)) * HTB)
#define PG8_SB(b, h) ((4 + (b) * 2 + (h)) * HTB)
#define PG8_STAGE2(bufoff, gbase, v0, v1) do { \
        __builtin_amdgcn_global_load_lds((const unsigned*)((const char*)(gbase) + (v0)), (LAS unsigned*)(lds + (bufoff) + ldsw), 16, 0, 0); \
        __builtin_amdgcn_global_load_lds((const unsigned*)((const char*)(gbase) + (v1)), (LAS unsigned*)(lds + (bufoff) + ldsw + 8192), 16, 0, 0); } while (0)
#define PG8_STAGE_B(bufoff, ptr, h) PG8_STAGE2(bufoff, (ptr) + (h) * hstepB, voffB[0], voffB[1])
#define PG8_STAGE_A(bufoff, ptr, h, nx) do { if constexpr (GA) { const unsigned _p = (nx) ? vAn[h] : vAc[h]; PG8_STAGE2(bufoff, ptr, (_p & 0xffffu) * gmul + (unsigned)Cst[0] * 2u, (_p >> 16) * gmul + (unsigned)Cst[0] * 2u); } \
        else { PG8_STAGE2(bufoff, (ptr) + (h) * hstepA, voffA[0], voffA[1]); } } while (0)
    typedef int v4i_ __attribute__((ext_vector_type(4)));
#define PG8_LDA(dst, b, h) do { _Pragma("unroll") for (int m = 0; m < 4; ++m) { if constexpr (F8) { dst##8[m].lo = *(const LAS v4i_*)(lds + PG8_SA(b, h) + aoff + m * 2048); dst##8[m].hi = *(const LAS v4i_*)(lds + PG8_SA(b, h) + aoff + m * 2048 + 16); } \
        else { _Pragma("unroll") for (int k = 0; k < 2; ++k) dst[m][k] = *(const LAS bf16x8*)(lds + PG8_SA(b, h) + aoff + m * 2048 + k * 1024); } } } while (0)
#define PG8_LDB(dst, b, h) do { _Pragma("unroll") for (int n = 0; n < 2; ++n) { if constexpr (F8) { dst##8[n].lo = *(const LAS v4i_*)(lds + PG8_SB(b, h) + boff + n * 2048); dst##8[n].hi = *(const LAS v4i_*)(lds + PG8_SB(b, h) + boff + n * 2048 + 16); } \
        else { _Pragma("unroll") for (int k = 0; k < 2; ++k) dst[n][k] = *(const LAS bf16x8*)(lds + PG8_SB(b, h) + boff + n * 2048 + k * 1024); } } } while (0)
#define PG8_MMA(ai, bj, At, Bt) do { __builtin_amdgcn_s_setprio(1); _Pragma("unroll") for (int m = 0; m < 4; ++m) _Pragma("unroll") for (int n = 0; n < 2; ++n) { \
        if constexpr (F8) { asm volatile("v_mfma_scale_f32_16x16x128_f8f6f4 %0, %1, %2, %0, %3, %3 op_sel_hi:[0,0,0]" : "+v"(acc[ai][bj][m][n]) : "v"(Bt##8[n]), "v"(At##8[m]), "v"(f8scale)); } \
        else { _Pragma("unroll") for (int k = 0; k < 2; ++k) acc[ai][bj][m][n] = __builtin_amdgcn_mfma_f32_16x16x32_bf16(Bt[n][k], At[m][k], acc[ai][bj][m][n], 0, 0, 0); } } \
        __builtin_amdgcn_s_setprio(0); } while (0)
#define PG8_WAIT_V(n) asm volatile("s_waitcnt vmcnt(" #n ")" ::: "memory")
#define PG8_WAIT_L(n) asm volatile("s_waitcnt lgkmcnt(" #n ")" ::: "memory")
#define PG8_BAR __builtin_amdgcn_s_barrier()
#define PG8_SCHED __builtin_amdgcn_sched_barrier(0)
#define PG8_GOFF(dst, u) do { if constexpr (GA) { _Pragma("unroll") for (int h = 0; h < 2; ++h) dst[h] = S.a_rowoff(u, Rst[0] + HALF * h) | (S.a_rowoff(u, Rst[0] + 64 + HALF * h) << 16); } } while (0)
    Unit cur, nxt; int ui = 0;
    if (!S.next(0, cur)) return;
    f32x4 acc[2][2][4][2];
#pragma unroll
    for (int a = 0; a < 2; ++a)
#pragma unroll
        for (int b = 0; b < 2; ++b)
#pragma unroll
            for (int m = 0; m < 4; ++m)
#pragma unroll
                for (int n = 0; n < 2; ++n) acc[a][b][m][n] = (f32x4){0.f, 0.f, 0.f, 0.f};
    int f8scale = 0x7F7F7F7F; asm volatile("" : "+v"(f8scale));
    bf16x8 At[4][2], B0[2][2], B1[2][2]; v8i At8[4], B08[2], B18[2];
    const char* cA = S.a_base(cur, 0); const char* cA1 = ASPLIT ? S.a_base(cur, 1) : cA; const char* cB0 = S.b_base(cur, 0); const char* cB1 = KS ? S.b_base(cur, 1) : cB0;
    PG8_GOFF(vAc, cur);
    vAn[0] = vAc[0]; vAn[1] = vAc[1];
    PG8_STAGE_B(PG8_SB(0, 0), cB0, 0); PG8_STAGE_B(PG8_SB(0, 1), cB0, 1); PG8_STAGE_A(PG8_SA(0, 0), cA, 0, false); PG8_STAGE_A(PG8_SA(0, 1), cA, 1, false);
    if (wr == 1) PG8_BAR;
    PG8_WAIT_V(2); PG8_BAR;
    PG8_STAGE_B(PG8_SB(1, 0), cB0 + kstep, 0); PG8_STAGE_A(PG8_SA(1, 0), cA + kstep, 0, false); PG8_STAGE_B(PG8_SB(1, 1), cB0 + kstep, 1);
    PG8_WAIT_V(6); PG8_BAR;
    for (;;) {
        const bool has_next = S.next(ui + 1, nxt);
        const char* nA = has_next ? S.a_base(nxt, 0) : cA; const char* nA1 = (ASPLIT && has_next) ? S.a_base(nxt, 1) : (ASPLIT ? cA1 : nA); const char* nB0 = has_next ? S.b_base(nxt, 0) : cB0; const char* nB1 = (KS && has_next) ? S.b_base(nxt, 1) : (KS ? cB1 : nB0);
        if constexpr (GA) { if (has_next) { PG8_GOFF(vAn, nxt); } }
#pragma unroll 1
        for (int t = 0; t < nt; t += 2) {
            const bool last = (t == nt - 2);
            const char* a1 = (ASPLIT && (t + 1) >= KS) ? cA1 + (size_t)(t + 1 - KS) * kstep : cA + (size_t)(t + 1) * kstep;
            const char* a2 = last ? nA : ((ASPLIT && (t + 2) >= KS) ? cA1 + (size_t)(t + 2 - KS) * kstep : cA + (size_t)(t + 2) * kstep);
            if constexpr (Epi::MID) { if (t == KS) { int fr_ = fr, fq_ = fq; asm volatile("" : "+v"(fr_), "+v"(fq_)); if constexpr (F8) { asm volatile("s_nop 15" ::: "memory"); } E.mid(acc, cur, wr, wc, fr_, fq_); if constexpr (F8) { asm volatile("s_nop 3" ::: "memory"); } } }
            const char* b2 = last ? nB0 : ((KS && (t + 2) >= KS) ? cB1 + (size_t)(t + 2 - KS) * kstep : cB0 + (size_t)(t + 2) * kstep);
            const char* a3 = a2 + kstep; const char* b3 = b2 + kstep;
            PG8_LDB(B0, 0, 0); PG8_LDB(B1, 0, 1); PG8_SCHED; PG8_LDA(At, 0, 0); PG8_STAGE_A(PG8_SA(1, 1), a1, 1, false);
            PG8_WAIT_V(8); PG8_WAIT_L(0); PG8_BAR; PG8_MMA(0, 0, At, B0); PG8_MMA(0, 1, At, B1); PG8_BAR; PG8_SCHED;
            PG8_LDA(At, 0, 1); PG8_STAGE_B(PG8_SB(0, 0), b2, 0); PG8_STAGE_B(PG8_SB(0, 1), b2, 1); PG8_STAGE_A(PG8_SA(0, 0), a2, 0, last);
            PG8_WAIT_V(8); PG8_WAIT_L(0); PG8_BAR; PG8_MMA(1, 0, At, B0); PG8_MMA(1, 1, At, B1); PG8_BAR; PG8_SCHED;
            PG8_LDB(B0, 1, 0); PG8_LDB(B1, 1, 1); PG8_SCHED; PG8_LDA(At, 1, 0); PG8_STAGE_A(PG8_SA(0, 1), a2, 1, last);
            PG8_WAIT_V(8); PG8_WAIT_L(0); PG8_BAR; PG8_MMA(0, 0, At, B0); PG8_MMA(0, 1, At, B1); PG8_BAR; PG8_SCHED;
            PG8_LDA(At, 1, 1); PG8_STAGE_B(PG8_SB(1, 0), b3, 0); PG8_STAGE_B(PG8_SB(1, 1), b3, 1); PG8_STAGE_A(PG8_SA(1, 0), a3, 0, last);
            PG8_WAIT_V(8); PG8_WAIT_L(0); PG8_BAR; PG8_MMA(1, 0, At, B0); PG8_MMA(1, 1, At, B1); PG8_BAR; PG8_SCHED;
        }
        if (wr == 0) PG8_BAR;
        if constexpr (F8) { asm volatile("s_nop 15\n\ts_nop 15" ::: "memory"); }
        { int fr_ = fr, fq_ = fq; asm volatile("" : "+v"(fr_), "+v"(fq_));
          E(acc, cur, wr, wc, fr_, fq_); }
        if (!has_next) break;
#pragma unroll
        for (int a = 0; a < 2; ++a)
#pragma unroll
            for (int b = 0; b < 2; ++b)
#pragma unroll
                for (int m = 0; m < 4; ++m)
#pragma unroll
                    for (int n = 0; n < 2; ++n) acc[a][b][m][n] = (f32x4){0.f, 0.f, 0.f, 0.f};
        cur = nxt; cA = nA; cA1 = nA1; cB0 = nB0; cB1 = nB1; ++ui;
        vAc[0] = vAn[0]; vAc[1] = vAn[1];
        if (wr == 1) PG8_BAR;
    }
    PG8_WAIT_V(0);
    PG8_BAR;
#undef PG8_SA
#undef PG8_SB
#undef PG8_STAGE2
#undef PG8_STAGE_A
#undef PG8_STAGE_B
#undef PG8_LDA
#undef PG8_LDB
#undef PG8_MMA
#undef PG8_WAIT_V
#undef PG8_WAIT_L
#undef PG8_BAR
#undef PG8_SCHED
#undef PG8_GOFF
}
}
using pg8::Unit;


struct Args {
    const float* x; const float* c; const int* pos; const float* ada_w; const float* ada_b; const float* nmw; const float* nfw; const float* w_in;
    const float* b_ig; const float* b_fg; const float* qnw; const float* knw; const float* sinks; const float* conv_w; const float* conv_b; const float* mnw;
    const float* w_au; const float* w_mu; const float* w_out; const float* router_w; const float* router_b; const float* w_gate; const float* w_up; const float* w_down;
    float* out; unsigned char* ws; int ph_lo, ph_hi;
};

__constant__ float c_invf[8] = {1.0f, 0.1939227432012558f, 0.03760603070259094f, 0.007292664609849453f, 0.0014142135623842478f, 0.00027424818836152554f, 5.3182957344688475e-05f, 1.0313385246263351e-05f};

struct DenseSched {
    static constexpr bool GATHER = false, ASPLIT = false; static constexpr int KSPLIT = 0;
    const char* A; const char* Bt; int lda, ldb; pg8::TileOrder ord;
    DI bool next(int i, Unit& u) const { int pm, pn; if (!ord.get(i, pm, pn)) return false; u.pm = pm; u.pn = pn; u.x0 = 0; u.x1 = 0; return true; }
    DI const char* a_base(const Unit& u, int) const { return A + (size_t)u.pm * 256 * lda; }
    DI const char* b_base(const Unit& u, int) const { return Bt + (size_t)u.pn * 256 * ldb; }
    DI unsigned a_rowoff(const Unit&, int) const { return 0u; }
};
struct EpiProj {
    static constexpr bool PERM = true, MID = false;
    bf16* O; float* gates; const float* big; const float* bfg;
    DI void operator()(const f32x4 (&acc)[2][2][4][2], const Unit& u, int wr, int wc, int fr, int fq) const {
        const int row0 = u.pm * 256 + wr * 64 + fr, col0 = u.pn * 256 + wc * 32 + 8 * fq; const bool sg = u.pn >= 9; constexpr float WSC = 1.0f / 64.0f;
        if (u.pn == 19) {
            if (wc == 0 && fq == 0) {
#pragma unroll
                for (int ai = 0; ai < 2; ++ai)
#pragma unroll
                    for (int m = 0; m < 4; ++m) { const int row = row0 + ai * 128 + m * 16; const f32x4 vi = acc[ai][0][m][0], vf = acc[ai][0][m][1]; f32x4 oi, of;
#pragma unroll
                        for (int j = 0; j < 4; ++j) { oi[j] = vi[j] * WSC + big[j]; const float z = vf[j] * WSC + bfg[j]; of[j] = fminf(z, 0.f) - log1pf(__expf(-fabsf(z))); }
                        *(f32x4*)(gates + (size_t)row * 8) = oi; *(f32x4*)(gates + (size_t)row * 8 + 4) = of; } }
            return; }
#pragma unroll
        for (int ai = 0; ai < 2; ++ai)
#pragma unroll
            for (int m = 0; m < 4; ++m) { bf16* rowp = O + (size_t)(row0 + ai * 128 + m * 16) * NPROJ + col0;
#pragma unroll
                for (int bj = 0; bj < 2; ++bj) { f32x4 v0 = acc[ai][bj][m][0] * WSC, v1 = acc[ai][bj][m][1] * WSC;
                    if (sg) {
#pragma unroll
                        for (int j = 0; j < 4; ++j) { v0[j] = sigmoidf_(v0[j]); v1[j] = sigmoidf_(v1[j]); } }
                    v4u w; w.x = cvt_pk_bf16(v0[0], v0[1]); w.y = cvt_pk_bf16(v0[2], v0[3]); w.z = cvt_pk_bf16(v1[0], v1[1]); w.w = cvt_pk_bf16(v1[2], v1[3]);
                    *(v4u*)(rowp + bj * 128) = w; } }
    }
};
struct MergeSched {
    static constexpr bool GATHER = false, ASPLIT = true; static constexpr int KSPLIT = 4;
    const char* A0; const char* A1; const char* B0; const char* B1; int lda, ldb; pg8::TileOrder ord;
    DI bool next(int i, Unit& u) const { int pm, pn; if (!ord.get(i, pm, pn)) return false; u.pm = pm; u.pn = pn; u.x0 = 0; u.x1 = 0; return true; }
    DI const char* a_base(const Unit& u, int half) const { return (half ? A1 : A0) + (size_t)u.pm * 256 * lda; }
    DI const char* b_base(const Unit& u, int half) const { return (half ? B1 : B0) + (size_t)u.pn * 256 * ldb; }
    DI unsigned a_rowoff(const Unit&, int) const { return 0u; }
};
struct EpiMerge {
    static constexpr bool PERM = true, MID = true;
    bf16* P;
    DI void mid(f32x4 (&acc)[2][2][4][2], const Unit& u, int wr, int wc, int fr, int fq) const {
        const int row0 = u.pm * 256 + wr * 64 + fr, col0 = u.pn * 256 + wc * 32 + 8 * fq;
#pragma unroll
        for (int ai = 0; ai < 2; ++ai)
#pragma unroll
            for (int m = 0; m < 4; ++m) { const bf16* rowp = P + (size_t)(row0 + ai * 128 + m * 16) * NPROJ + col0;
#pragma unroll
                for (int bj = 0; bj < 2; ++bj) { const v4u ga = *(const v4u*)(rowp + C_GA + bj * 128), gb = *(const v4u*)(rowp + C_GB + bj * 128);
                    f32x4 r0, r1;
                    r0[0] = bflo(ga.x) * __builtin_amdgcn_rcpf(fmaxf(bflo(gb.x), 1e-30f)); r0[1] = bfhi(ga.x) * __builtin_amdgcn_rcpf(fmaxf(bfhi(gb.x), 1e-30f));
                    r0[2] = bflo(ga.y) * __builtin_amdgcn_rcpf(fmaxf(bflo(gb.y), 1e-30f)); r0[3] = bfhi(ga.y) * __builtin_amdgcn_rcpf(fmaxf(bfhi(gb.y), 1e-30f));
                    r1[0] = bflo(ga.z) * __builtin_amdgcn_rcpf(fmaxf(bflo(gb.z), 1e-30f)); r1[1] = bfhi(ga.z) * __builtin_amdgcn_rcpf(fmaxf(bfhi(gb.z), 1e-30f));
                    r1[2] = bflo(ga.w) * __builtin_amdgcn_rcpf(fmaxf(bflo(gb.w), 1e-30f)); r1[3] = bfhi(ga.w) * __builtin_amdgcn_rcpf(fmaxf(bfhi(gb.w), 1e-30f));
                    acc[ai][bj][m][0] *= r0; acc[ai][bj][m][1] *= r1; } }
    }
    DI void operator()(const f32x4 (&acc)[2][2][4][2], const Unit& u, int wr, int wc, int fr, int fq) const {
        const int row0 = u.pm * 256 + wr * 64 + fr, col0 = u.pn * 256 + wc * 32 + 8 * fq; constexpr float SC = 1.0f / 32.0f;
#pragma unroll
        for (int ai = 0; ai < 2; ++ai)
#pragma unroll
            for (int m = 0; m < 4; ++m) { bf16* rowp = P + (size_t)(row0 + ai * 128 + m * 16) * NPROJ + col0; unsigned char* mp = (unsigned char*)(P + (size_t)(row0 + ai * 128 + m * 16) * NPROJ + C_MQ) + col0;
#pragma unroll
                for (int bj = 0; bj < 2; ++bj) { const f32x4 v0 = acc[ai][bj][m][0] * SC, v1 = acc[ai][bj][m][1] * SC;
                    const v4u g = *(const v4u*)(rowp + C_GB + bj * 128);
                    v2u w; w.x = pk4_fp8(bflo(g.x) * v0[0], bfhi(g.x) * v0[1], bflo(g.y) * v0[2], bfhi(g.y) * v0[3]); w.y = pk4_fp8(bflo(g.z) * v1[0], bfhi(g.z) * v1[1], bflo(g.w) * v1[2], bfhi(g.w) * v1[3]);
                    *(v2u*)(mp + bj * 128) = w; } }
    }
};
struct EpiRes {
    static constexpr bool PERM = false, MID = false;
    const bf16* xin; bf16* out; const float* g; float* ssq; int rmask;
    DI void operator()(const f32x4 (&acc)[2][2][4][2], const Unit& u, int wr, int wc, int fr, int fq) const {
        const int row0 = u.pm * 256 + wr * 64 + fr, col0 = u.pn * 256 + wc * 32 + 4 * fq; const int b = (u.pm * 256) >> 14;
        f32x4 gv[2][2];
#pragma unroll
        for (int bj = 0; bj < 2; ++bj)
#pragma unroll
            for (int n = 0; n < 2; ++n) gv[bj][n] = *(const f32x4*)(g + b * 6144 + col0 + bj * 128 + n * 16);
#pragma unroll
        for (int ai = 0; ai < 2; ++ai)
#pragma unroll
            for (int m = 0; m < 4; ++m) { const size_t off = (size_t)(row0 + ai * 128 + m * 16) * D + col0; const size_t offo = (size_t)((row0 + ai * 128 + m * 16) & rmask) * D + col0; float sq = 0.f;
#pragma unroll
                for (int bj = 0; bj < 2; ++bj)
#pragma unroll
                    for (int n = 0; n < 2; ++n) { const v2u xw = *(const v2u*)(xin + off + bj * 128 + n * 16); const f32x4 xv = {bflo(xw.x), bfhi(xw.x), bflo(xw.y), bfhi(xw.y)}; const f32x4 o = xv + gv[bj][n] * (acc[ai][bj][m][n] * (1.0f / 512.0f));
                        v2u ow; ow.x = cvt_pk_bf16(o.x, o.y); ow.y = cvt_pk_bf16(o.z, o.w); const float r0 = bflo(ow.x), r1 = bfhi(ow.x), r2 = bflo(ow.y), r3 = bfhi(ow.y);
                        sq += (r0 * r0 + r1 * r1) + (r2 * r2 + r3 * r3);
                        *(v2u*)(out + offo + bj * 128 + n * 16) = ow; }
                sq += __shfl_xor(sq, 16); sq += __shfl_xor(sq, 32);
                if (fq == 0) ssq[(size_t)(row0 + ai * 128 + m * 16) * 16 + u.pn * 4 + wc] = sq; }
    }
};

struct MoeTab { const LAS int* tcls; const LAS int* tpos; const LAS int* cnt; int Rtot; };
DI int xcd_remap(int L, int nwg) { const int q = nwg >> 3, r = nwg & 7, xcd = L & 7, off = L >> 3; return (xcd < r ? xcd * (q + 1) : r * (q + 1) + (xcd - r) * q) + off; }
DI void cls_experts(int cls, int& ea, int& eb) { const int g = cls / 6, p = cls - 6 * g; const int a = (p < 3) ? 0 : ((p < 5) ? 1 : 2); const int b = (p < 3) ? (p + 1) : ((p < 5) ? (p - 1) : 3); ea = 4 * g + a; eb = 4 * g + b; }
struct MoeUpSched {
    static constexpr bool GATHER = true, ASPLIT = false; static constexpr int KSPLIT = 0;
    const char* A; const char* W; int lda, ldb; MoeTab tb; int G, c; const LAS unsigned* tokoff;
    DI bool next(int i, Unit& u) const { const int L0 = i * G + c; if (L0 >= tb.Rtot * 8) return false; const int L = xcd_remap(L0, tb.Rtot * 8); u.pm = L >> 3; u.pn = L & 7; u.x0 = i; u.x1 = __builtin_amdgcn_readfirstlane(tb.tcls[u.pm]); return true; }
    DI const char* a_base(const Unit&, int) const { return A; }
    DI const char* b_base(const Unit& u, int) const { int ea, eb; cls_experts(u.x1, ea, eb); const int e = (u.pn < 4) ? ea : eb; return W + ((size_t)e * 1024 + (size_t)(u.pn & 3) * 256) * ldb; }
    DI unsigned a_rowoff(const Unit& u, int r) const { return tokoff[u.x0 * 256 + r]; }
};
struct EpiSwiglu {
    static constexpr bool PERM = true, MID = false;
    unsigned char* H; const float* tgate; const LAS unsigned* tokoff;
    DI void operator()(const f32x4 (&acc)[2][2][4][2], const Unit& u, int wr, int wc, int fr, int fq) const {
        const int r0 = wr * 64 + fr; const int hc = (u.pn >> 2) * 512 + (u.pn & 3) * 128 + wc * 32 + 8 * fq; const int gsel = u.pn >> 2;
#pragma unroll
        for (int ai = 0; ai < 2; ++ai)
#pragma unroll
            for (int m = 0; m < 4; ++m) { const int r = r0 + ai * 128 + m * 16; const unsigned tok = tokoff[u.x0 * 256 + r]; const float rg = tgate[tok * 2 + gsel];
                const f32x4 g0 = acc[ai][0][m][0] * (1.0f / 64.0f), g1 = acc[ai][0][m][1] * (1.0f / 64.0f), u0 = acc[ai][1][m][0] * (1.0f / 64.0f), u1 = acc[ai][1][m][1] * (1.0f / 64.0f);
                float o[8];
#pragma unroll
                for (int j = 0; j < 4; ++j) { o[j] = g0[j] * sigmoidf_(g0[j]) * u0[j] * rg; o[4 + j] = g1[j] * sigmoidf_(g1[j]) * u1[j] * rg; }
                v2u w; w.x = pk4_fp8(o[0] * 16.0f, o[1] * 16.0f, o[2] * 16.0f, o[3] * 16.0f); w.y = pk4_fp8(o[4] * 16.0f, o[5] * 16.0f, o[6] * 16.0f, o[7] * 16.0f);
                *(v2u*)(H + ((size_t)u.pm * 256 + r) * 1024 + hc) = w; }
    }
};
struct MoeDownSched {
    static constexpr bool GATHER = false, ASPLIT = false; static constexpr int KSPLIT = 4;
    const char* A; const char* W; int lda, ldb; MoeTab tb; int G, c;
    DI bool next(int i, Unit& u) const { const int L0 = i * G + c; if (L0 >= tb.Rtot * 4) return false; const int L = xcd_remap(L0, tb.Rtot * 4); u.pm = L >> 2; u.pn = L & 3; u.x0 = __builtin_amdgcn_readfirstlane(tb.tpos[u.pm]); u.x1 = __builtin_amdgcn_readfirstlane(tb.tcls[u.pm]); return true; }
    DI const char* a_base(const Unit& u, int) const { return A + (size_t)u.pm * 256 * lda; }
    DI const char* b_base(const Unit& u, int half) const { int ea, eb; cls_experts(u.x1, ea, eb); const int e = half ? eb : ea; return W + ((size_t)e * 1024 + (size_t)u.pn * 256) * ldb; }
    DI unsigned a_rowoff(const Unit&, int) const { return 0u; }
};
struct EpiMoeOut {
    static constexpr bool PERM = false, MID = false;
    const bf16* xin; bf16* outb; float* outf; const float* g; const int* tokl; MoeTab tb; int rmask, last;
    DI void operator()(const f32x4 (&acc)[2][2][4][2], const Unit& u, int wr, int wc, int fr, int fq) const {
        const int r0 = wr * 64 + fr, col0 = u.pn * 256 + wc * 32 + 4 * fq; const int cn = tb.cnt[u.x1];
#pragma unroll
        for (int ai = 0; ai < 2; ++ai)
#pragma unroll
            for (int m = 0; m < 4; ++m) { const int pos = u.x0 + r0 + ai * 128 + m * 16;
                if (pos < cn) { const int tok = tokl[u.x1 * CLS_CAP + pos]; const int b = tok >> 14; const bf16* ip = xin + (size_t)tok * D + col0; bf16* op = outb + (size_t)(tok & rmask) * D + col0; float* of = outf + (size_t)tok * D + col0; const float* gp = g + b * 6144 + col0;
#pragma unroll
                    for (int bj = 0; bj < 2; ++bj)
#pragma unroll
                        for (int n = 0; n < 2; ++n) { const v2u xw = *(const v2u*)(ip + bj * 128 + n * 16); const f32x4 xv = {bflo(xw.x), bfhi(xw.x), bflo(xw.y), bfhi(xw.y)}; const f32x4 gv = *(const f32x4*)(gp + bj * 128 + n * 16);
                            const f32x4 o = xv + gv * (acc[ai][bj][m][n] * (1.0f / 512.0f));
                            if (last) *(f32x4*)(of + bj * 128 + n * 16) = o;
                            else { v2u ow; ow.x = cvt_pk_bf16(o.x, o.y); ow.y = cvt_pk_bf16(o.z, o.w); *(v2u*)(op + bj * 128 + n * 16) = ow; } } } }
    }
};

struct Ctx { LAS unsigned char* lds; int tid, lane, wave, G, bid; };
DI Ctx fresh(const Ctx& X) { Ctx P = X; int t = X.tid; asm volatile("" : "+v"(t)); P.tid = t; P.lane = t & 63; P.wave = __builtin_amdgcn_readfirstlane(t >> 6); return P; }

DI void tr_item(const float* W, int ldw, int K, bf16* WT, int k0, LAS float* scr, int lane) {
    { const int rr = lane >> 3, c4 = lane & 7; f32x4 v[8];
#pragma unroll
      for (int i = 0; i < 8; ++i) v[i] = *(const f32x4*)(W + (size_t)(k0 + rr + 8 * i) * ldw + 4 * c4);
#pragma unroll
      for (int i = 0; i < 8; ++i) { LAS float* d = scr + (rr + 8 * i) * 33 + 4 * c4; d[0] = v[i].x; d[1] = v[i].y; d[2] = v[i].z; d[3] = v[i].w; } }
    LDS_WAIT(); asm volatile("" ::: "memory");
    const int c = lane & 7;
#pragma unroll
    for (int j = 0; j < 4; ++j) { const int n = (lane >> 3) + 8 * j; const LAS float* s = scr + (8 * c) * 33 + n;
        v4u o; o.x = pk2(s[0 * 33], s[1 * 33]); o.y = pk2(s[2 * 33], s[3 * 33]); o.z = pk2(s[4 * 33], s[5 * 33]); o.w = pk2(s[6 * 33], s[7 * 33]);
        *(v4u*)(WT + (size_t)n * K + k0 + 8 * c) = o; }
    LDS_WAIT(); asm volatile("" ::: "memory");
}
DI void tr_item8(const float* W, int ldw, int K, unsigned char* WT, int k0, float scale, LAS float* scr, int lane) {
    { const int rr = lane >> 3, c4 = lane & 7; f32x4 v[8];
#pragma unroll
      for (int i = 0; i < 8; ++i) v[i] = *(const f32x4*)(W + (size_t)(k0 + rr + 8 * i) * ldw + 4 * c4);
#pragma unroll
      for (int i = 0; i < 8; ++i) { LAS float* d = scr + (rr + 8 * i) * 33 + 4 * c4; d[0] = v[i].x; d[1] = v[i].y; d[2] = v[i].z; d[3] = v[i].w; } }
    LDS_WAIT(); asm volatile("" ::: "memory");
    const int c = lane & 7;
#pragma unroll
    for (int j = 0; j < 4; ++j) { const int n = (lane >> 3) + 8 * j; const LAS float* s = scr + (8 * c) * 33 + n;
        v2u o; o.x = pk4_fp8(s[0 * 33] * scale, s[1 * 33] * scale, s[2 * 33] * scale, s[3 * 33] * scale); o.y = pk4_fp8(s[4 * 33] * scale, s[5 * 33] * scale, s[6 * 33] * scale, s[7 * 33] * scale);
        *(v2u*)(WT + (size_t)n * K + k0 + 8 * c) = o; }
    LDS_WAIT(); asm volatile("" ::: "memory");
}
DI void p0_prologue(const Args& a, const Ctx& X) {
    unsigned char* ws = a.ws;
    LAS float* scr = (LAS float*)(X.lds + X.wave * 16384);
    const int gw = X.bid * 8 + X.wave, NGW = X.G * 8;
    constexpr int IT_WIN = 16 * 153, IT_AU = 8 * 32, IT_OUT = 16 * 32, IT_GU = 16 * 16 * 32, IT_DN = 16 * 8 * 32;
    constexpr int IT_L = IT_WIN + 2 * IT_AU + IT_OUT + IT_GU + IT_DN;
    for (int it = gw; it < NL * IT_L; it += NGW) {
        const int l = it / IT_L; int r = it - l * IT_L;
        if (r < IT_WIN) { const int kb = r / 153, nb = r - kb * 153, d0 = 32 * nb, s0 = (nb == 152) ? 2304 : (d0 + (d0 >= 2304 ? 8 : 0));
            tr_item8(a.w_in + (size_t)l * D * DIN_SRC + s0, DIN_SRC, D, (unsigned char*)(ws + WS_WIN) + ((size_t)l * NPROJW + d0) * D, 64 * kb, 64.0f, scr, X.lane); continue; }
        r -= IT_WIN;
        if (r < IT_AU) { const int kb = r >> 5, nb = r & 31;
            tr_item8(a.w_au + (size_t)l * 512 * D + 32 * nb, D, 512, (unsigned char*)(ws + WS_WAU) + ((size_t)l * D + 32 * nb) * 512, 64 * kb, 32.0f, scr, X.lane); continue; }
        r -= IT_AU;
        if (r < IT_AU) { const int kb = r >> 5, nb = r & 31;
            tr_item8(a.w_mu + (size_t)l * 512 * D + 32 * nb, D, 512, (unsigned char*)(ws + WS_WMU) + ((size_t)l * D + 32 * nb) * 512, 64 * kb, 32.0f, scr, X.lane); continue; }
        r -= IT_AU;
        if (r < IT_OUT) { const int kb = r >> 5, nb = r & 31;
            tr_item8(a.w_out + (size_t)l * D * D + 32 * nb, D, D, (unsigned char*)(ws + WS_WOUT) + ((size_t)l * D + 32 * nb) * D, 64 * kb, 64.0f, scr, X.lane); continue; }
        r -= IT_OUT;
        if (r < IT_GU) { const int e = r >> 9, q = r & 511, kb = q >> 5, nb = q & 31, tq = nb >> 3, rb = nb & 7;
            const float* src = ((rb < 4) ? a.w_gate : a.w_up) + ((size_t)(l * NE + e) * D) * FF + 128 * tq + 32 * (rb & 3);
            tr_item8(src, FF, D, (unsigned char*)(ws + WS_WGU) + ((size_t)(l * NE + e) * 1024 + 32 * nb) * D, 64 * kb, 64.0f, scr, X.lane); continue; }
        r -= IT_GU;
        { const int e = r >> 8, q = r & 255, kb = q >> 5, nb = q & 31;
            tr_item8(a.w_down + ((size_t)(l * NE + e) * FF) * D + 32 * nb, D, FF, (unsigned char*)(ws + WS_WD) + ((size_t)(l * NE + e) * 1024 + 32 * nb) * FF, 64 * kb, 32.0f, scr, X.lane); }
    }
    { const float* xs = a.x; bf16* xb = (bf16*)(ws + WS_XB);
      for (size_t i = (size_t)X.bid * 512 + X.tid; i < (size_t)T * D / 8; i += (size_t)X.G * 512) { const f32x4 v0 = *(const f32x4*)(xs + 8 * i), v1 = *(const f32x4*)(xs + 8 * i + 4);
          v4u w; w.x = cvt_pk_bf16(v0.x, v0.y); w.y = cvt_pk_bf16(v0.z, v0.w); w.z = cvt_pk_bf16(v1.x, v1.y); w.w = cvt_pk_bf16(v1.z, v1.w); *(v4u*)(xb + 8 * i) = w; } }
    { float* cs = (float*)(ws + WS_ROPE); float* sn = cs + (size_t)T * 8;
      for (int i = X.bid * 512 + X.tid; i < T * 8; i += X.G * 512) { const int tok = i >> 3, f = i & 7; const float angf = (float)a.pos[tok] * c_invf[f];
          double rev = (double)angf * 0.15915494309189535; rev -= rint(rev); const float rf = (float)rev;
          cs[i] = __builtin_amdgcn_cosf(rf); sn[i] = __builtin_amdgcn_sinf(rf); } }
    __syncthreads();
    LAS float* cact = (LAS float*)X.lds; LAS float* red = (LAS float*)(X.lds + 8192);
    for (int i = X.tid; i < 2048; i += 512) { const float cv = a.c[i]; cact[i] = cv / (1.0f + __expf(-cv)); }
    __syncthreads();
    float* mod = (float*)(ws + WS_MOD);
    for (int it = X.bid; it < NL * 96; it += X.G) { const int l = it / 96, cg = it - l * 96; const int col = cg * 64 + X.lane;
        const float* w = a.ada_w + (size_t)l * D * 6144 + col; float s0 = 0.f, s1 = 0.f;
#pragma unroll 8
        for (int kk = 0; kk < 128; ++kk) { const int k = X.wave * 128 + kk; const float wv = w[(size_t)k * 6144]; s0 += cact[k] * wv; s1 += cact[1024 + k] * wv; }
        red[(X.wave * 2 + 0) * 64 + X.lane] = s0; red[(X.wave * 2 + 1) * 64 + X.lane] = s1;
        __syncthreads();
        if (X.tid < 128) { const int b = X.tid >> 6, ln = X.tid & 63; float s = 0.f;
#pragma unroll
            for (int w8 = 0; w8 < 8; ++w8) s += red[(w8 * 2 + b) * 64 + ln];
            mod[(size_t)(l * 2 + b) * 6144 + cg * 64 + ln] = s + a.ada_b[l * 6144 + cg * 64 + ln]; }
        __syncthreads();
    }
}

DI void p1_norm_gates(const Args& a, const Ctx& X, int l, const bf16* xin) {
    unsigned char* ws = a.ws;
    const float* mod = (const float*)(ws + WS_MOD); unsigned char* hb = (unsigned char*)(ws + WS_H);
    const int gw = X.bid * 8 + X.wave, NGW = X.G * 8;
    for (int rg = gw; rg < T / 16; rg += NGW) {
        const int row0 = rg * 16, b = row0 >> 14;
        const float* mb = mod + (size_t)(l * 2 + b) * 6144;
        f32x4 aw[4], sh[4];
#pragma unroll
        for (int j = 0; j < 4; ++j) { const int k = 256 * j + 4 * X.lane; const f32x4 nw = *(const f32x4*)(a.nmw + l * D + k); const f32x4 sc = *(const f32x4*)(mb + 1024 + k); aw[j] = nw * (sc + 1.0f); sh[j] = *(const f32x4*)(mb + k); }
        v2u pre[4][4];
#pragma unroll
        for (int q = 0; q < 4; ++q) { const v2u* xp = (const v2u*)(xin + (size_t)(row0 + q) * D) + X.lane;
#pragma unroll
            for (int j = 0; j < 4; ++j) pre[q][j] = xp[64 * j]; }
#pragma unroll 1
        for (int rb = 0; rb < 16; rb += 4) {
#pragma unroll
          for (int q = 0; q < 4; ++q) { const int row = row0 + rb + q;
            f32x4 v[4]; float ss = 0.f;
#pragma unroll
            for (int j = 0; j < 4; ++j) { const v2u pw = pre[q][j]; v[j] = (f32x4){bflo(pw.x), bfhi(pw.x), bflo(pw.y), bfhi(pw.y)}; }
            if (rb + 4 < 16) { const v2u* xp = (const v2u*)(xin + (size_t)(row + 4) * D) + X.lane;
#pragma unroll
                for (int j = 0; j < 4; ++j) pre[q][j] = xp[64 * j]; }
#pragma unroll
            for (int j = 0; j < 4; ++j) ss += (v[j].x * v[j].x + v[j].y * v[j].y) + (v[j].z * v[j].z + v[j].w * v[j].w);
            ss = wave_sum(ss); const float rstd = __builtin_amdgcn_rsqf(ss * (1.0f / D) + EPS);
            unsigned* o4 = (unsigned*)(hb + (size_t)row * D) + X.lane;
#pragma unroll
            for (int j = 0; j < 4; ++j) { v[j] = v[j] * rstd * aw[j] + sh[j]; o4[64 * j] = pk4_fp8(v[j].x, v[j].y, v[j].z, v[j].w); }
          }
        }
    }
}

DI void attn_unit(const Args& a, const Ctx& X, int l, int unit) {
    unsigned char* ws = a.ws; const bf16* proj = (const bf16*)(ws + WS_PROJ); unsigned char* ao = (unsigned char*)(ws + WS_H);
    const float* cs = (const float*)(ws + WS_ROPE); const float* sn = cs + (size_t)T * 8;
    const int b = unit >> 8, rem = unit & 255, nb = rem >> 1, kvh = rem & 1; const int tok0 = b * SEQ + nb * 128;
    LAS bf16* Kl = (LAS bf16*)X.lds;
    LAS bf16* VT = (LAS bf16*)(X.lds + 36864);
    int lane = X.lane; asm volatile("" : "+v"(lane));
    const int c16 = lane & 15, quad = lane >> 4;
    v4u nq0, nq1; f32x4 ncs0, ncs1, nsn0, nsn1;
#define AT_PREF(task_) do { const int g_ = (task_) >> 3, tq_ = tok0 + 16 * ((task_) & 7) + c16; const bf16* qp_ = proj + (size_t)tq_ * NPROJ + C_AQ + (kvh * 4 + g_) * 64; \
        nq0 = *(const v4u*)(qp_ + 8 * quad); nq1 = *(const v4u*)(qp_ + 32 + 8 * quad); ncs0 = *(const f32x4*)(cs + (size_t)tq_ * 8); ncs1 = *(const f32x4*)(cs + (size_t)tq_ * 8 + 4); nsn0 = *(const f32x4*)(sn + (size_t)tq_ * 8); nsn1 = *(const f32x4*)(sn + (size_t)tq_ * 8 + 4); } while (0)
    AT_PREF(X.wave);
    float qw[16];
#pragma unroll
    for (int i = 0; i < 8; ++i) { qw[i] = a.qnw[l * 64 + 8 * quad + i]; qw[8 + i] = a.qnw[l * 64 + 32 + 8 * quad + i]; }
    const f32x4 sk4 = *(const f32x4*)(a.sinks + l * 8 + kvh * 4);
    {
        const int row = X.tid >> 1, half = X.tid & 1; const int tokk = tok0 - 128 + row; const bool valid = (nb > 0) || (row >= 128);
        float y[32]; float vv[32];
        if (valid) {
            const v4u* kp = (const v4u*)(proj + (size_t)tokk * NPROJ + C_AK + kvh * 64 + half * 32); const v4u* vp = (const v4u*)(proj + (size_t)tokk * NPROJ + C_AV + kvh * 64 + half * 32);
#pragma unroll
            for (int q = 0; q < 4; ++q) { const v4u kw = kp[q], vw = vp[q];
                y[8 * q + 0] = bflo(kw.x); y[8 * q + 1] = bfhi(kw.x); y[8 * q + 2] = bflo(kw.y); y[8 * q + 3] = bfhi(kw.y); y[8 * q + 4] = bflo(kw.z); y[8 * q + 5] = bfhi(kw.z); y[8 * q + 6] = bflo(kw.w); y[8 * q + 7] = bfhi(kw.w);
                vv[8 * q + 0] = bflo(vw.x); vv[8 * q + 1] = bfhi(vw.x); vv[8 * q + 2] = bflo(vw.y); vv[8 * q + 3] = bfhi(vw.y); vv[8 * q + 4] = bflo(vw.z); vv[8 * q + 5] = bfhi(vw.z); vv[8 * q + 6] = bflo(vw.w); vv[8 * q + 7] = bfhi(vw.w); }
        } else {
#pragma unroll
            for (int i = 0; i < 32; ++i) { y[i] = 0.f; vv[i] = 0.f; } }
        float ss = 0.f;
#pragma unroll
        for (int i = 0; i < 32; ++i) ss += y[i] * y[i];
        ss += __shfl_xor(ss, 1); const float rstd = 1.0f / sqrtf(ss * (1.0f / 64.0f) + EPS);
#pragma unroll
        for (int i = 0; i < 32; ++i) y[i] = y[i] * rstd * a.knw[l * 64 + half * 32 + i];
        if (half == 0 && valid) {
#pragma unroll
            for (int d = 0; d < 8; ++d) { const float c = cs[(size_t)tokk * 8 + d], s = sn[(size_t)tokk * 8 + d]; const float t1 = y[d], t2 = y[d + 8]; y[d] = t1 * c - t2 * s; y[d + 8] = t2 * c + t1 * s; } }
#pragma unroll
        for (int q = 0; q < 4; ++q) { v4u w; w.x = pk2(y[8 * q], y[8 * q + 1]); w.y = pk2(y[8 * q + 2], y[8 * q + 3]); w.z = pk2(y[8 * q + 4], y[8 * q + 5]); w.w = pk2(y[8 * q + 6], y[8 * q + 7]);
            *(LAS v4u*)(Kl + row * 72 + half * 32 + 8 * q) = w; }
#pragma unroll
        for (int i = 0; i < 32; ++i) VT[(half * 32 + i) * 280 + row] = (bf16)f2bf(vv[i]);
        if (X.tid < 64) {
#pragma unroll
            for (int cc = 256; cc < 280; ++cc) VT[X.tid * 280 + cc] = 0; }
    }
    __syncthreads();
#pragma unroll 1
    for (int task = X.wave; task < 32; task += 8) {
        const int g = task >> 3, rg = task & 7, r0 = 16 * rg, head = kvh * 4 + g; const int tokq = tok0 + r0 + c16;
        const float sink = (g == 0) ? sk4.x : ((g == 1) ? sk4.y : ((g == 2) ? sk4.z : sk4.w));
        const v4u w0 = nq0, w1 = nq1; const f32x4 cc0 = ncs0, cc1 = ncs1, ss0 = nsn0, ss1 = nsn1;
        if (task + 8 < 32) { AT_PREF(task + 8); }
        float qv[16];
        qv[0] = bflo(w0.x); qv[1] = bfhi(w0.x); qv[2] = bflo(w0.y); qv[3] = bfhi(w0.y); qv[4] = bflo(w0.z); qv[5] = bfhi(w0.z); qv[6] = bflo(w0.w); qv[7] = bfhi(w0.w);
        qv[8] = bflo(w1.x); qv[9] = bfhi(w1.x); qv[10] = bflo(w1.y); qv[11] = bfhi(w1.y); qv[12] = bflo(w1.z); qv[13] = bfhi(w1.z); qv[14] = bflo(w1.w); qv[15] = bfhi(w1.w);
        float ss = 0.f;
#pragma unroll
        for (int i = 0; i < 16; ++i) ss += qv[i] * qv[i];
        ss += __shfl_xor(ss, 16); ss += __shfl_xor(ss, 32); const float rstd = __builtin_amdgcn_rsqf(ss * (1.0f / 64.0f) + EPS);
#pragma unroll
        for (int i = 0; i < 16; ++i) qv[i] = qv[i] * rstd * qw[i];
        { const float cv[8] = {cc0.x, cc0.y, cc0.z, cc0.w, cc1.x, cc1.y, cc1.z, cc1.w}, sv[8] = {ss0.x, ss0.y, ss0.z, ss0.w, ss1.x, ss1.y, ss1.z, ss1.w};
#pragma unroll
          for (int d = 0; d < 8; ++d) { const float other = __shfl_xor(qv[d], 16);
              if (quad == 0) qv[d] = qv[d] * cv[d] - other * sv[d]; else if (quad == 1) qv[d] = qv[d] * cv[d] + other * sv[d]; } }
        bf16x8 qf[2];
        { v4u w; w.x = pk2m(qv[0], qv[1]); w.y = pk2m(qv[2], qv[3]); w.z = pk2m(qv[4], qv[5]); w.w = pk2m(qv[6], qv[7]); qf[0] = __builtin_bit_cast(bf16x8, w);
          w.x = pk2m(qv[8], qv[9]); w.y = pk2m(qv[10], qv[11]); w.z = pk2m(qv[12], qv[13]); w.w = pk2m(qv[14], qv[15]); qf[1] = __builtin_bit_cast(bf16x8, w); }
        f32x4 sacc[9];
#pragma unroll
        for (int i = 0; i < 9; ++i) { const LAS bf16* kr = Kl + (16 * (rg + i) + c16) * 72 + 8 * quad;
            const bf16x8 k0 = *(const LAS bf16x8*)kr, k1 = *(const LAS bf16x8*)(kr + 32);
            f32x4 z = {0.f, 0.f, 0.f, 0.f}; z = __builtin_amdgcn_mfma_f32_16x16x32_bf16(k0, qf[0], z, 0, 0, 0); sacc[i] = __builtin_amdgcn_mfma_f32_16x16x32_bf16(k1, qf[1], z, 0, 0, 0); }
        int dbase = 4 * quad - c16; asm volatile("" : "+v"(dbase)); int kbase = 16 * rg + 4 * quad; asm volatile("" : "+v"(kbase)); float mx = sink;
#pragma unroll
        for (int i = 0; i < 9; ++i)
#pragma unroll
            for (int j = 0; j < 4; ++j) { const int dlt = dbase + 16 * i + j; const int kj = kbase + 16 * i + j; const bool ok = (dlt > 0) && (dlt <= 128) && ((nb > 0) || (kj >= 128));
                const float s = ok ? sacc[i][j] * 0.125f : -3.0e38f; sacc[i][j] = s; mx = fmaxf(mx, s); }
        mx = fmaxf(mx, __shfl_xor(mx, 16)); mx = fmaxf(mx, __shfl_xor(mx, 32));
        float sum = 0.f;
#pragma unroll
        for (int i = 0; i < 9; ++i)
#pragma unroll
            for (int j = 0; j < 4; ++j) { const float p = (sacc[i][j] > -1.0e38f) ? __expf(sacc[i][j] - mx) : 0.f; sacc[i][j] = p; sum += p; }
        sum += __shfl_xor(sum, 16); sum += __shfl_xor(sum, 32);
        const float inv = 1.0f / (sum + __expf(sink - mx));
        f32x4 oacc[4];
#pragma unroll
        for (int et = 0; et < 4; ++et) oacc[et] = (f32x4){0.f, 0.f, 0.f, 0.f};
#pragma unroll
        for (int kk = 0; kk < 5; ++kk) {
            v4u pw; pw.x = pk2m(sacc[2 * kk][0], sacc[2 * kk][1]); pw.y = pk2m(sacc[2 * kk][2], sacc[2 * kk][3]);
            if (2 * kk + 1 < 9) { pw.z = pk2m(sacc[(2 * kk + 1 < 9) ? 2 * kk + 1 : 0][0], sacc[(2 * kk + 1 < 9) ? 2 * kk + 1 : 0][1]); pw.w = pk2m(sacc[(2 * kk + 1 < 9) ? 2 * kk + 1 : 0][2], sacc[(2 * kk + 1 < 9) ? 2 * kk + 1 : 0][3]); } else { pw.z = 0u; pw.w = 0u; }
            const bf16x8 pf = __builtin_bit_cast(bf16x8, pw);
#pragma unroll
            for (int et = 0; et < 4; ++et) { const LAS bf16* vr = VT + (16 * et + c16) * 280 + 16 * rg + 32 * kk + 4 * quad;
                const v2u lo = *(const LAS v2u*)vr, hi = *(const LAS v2u*)(vr + 16); v4u vw; vw.x = lo.x; vw.y = lo.y; vw.z = hi.x; vw.w = hi.y;
                oacc[et] = __builtin_amdgcn_mfma_f32_16x16x32_bf16(__builtin_bit_cast(bf16x8, vw), pf, oacc[et], 0, 0, 0); }
        }
#pragma unroll
        for (int et = 0; et < 4; ++et) { const float i8 = inv * 8.0f;
            *(unsigned*)(ao + (size_t)tokq * 512 + head * 64 + 16 * et + 4 * quad) = pk4_fp8(oacc[et][0] * i8, oacc[et][1] * i8, oacc[et][2] * i8, oacc[et][3] * i8); }
    }
    __syncthreads();
#undef AT_PREF
}

constexpr int ML_Q = 0, ML_K = 17408, ML_KET = 34816, ML_VT = 53248, ML_CT = 73984, ML_CW = 113152, ML_CB = 118272, ML_RED = 118784, ML_NW = 119296, ML_GT = 119808;
DI float bfw(unsigned w, int hi) { return hi ? bfhi(w) : bflo(w); }
template <bool L3> DI void mlstm_unit(const Args& a, const Ctx& X, int l, int unit) {
    unsigned char* ws = a.ws; const bf16* proj = (const bf16*)(ws + WS_PROJ); unsigned char* hm = (unsigned char*)(ws + WS_H) + (size_t)T * 512;
    bf16* kcb = (bf16*)(ws + WS_KC);
    const float* gates = (const float*)(ws + WS_GATES); float* mlc = (float*)(ws + WS_MLC) + (size_t)unit * 18432; float* mlb = (float*)(ws + WS_MLB);
    const int seq = unit >> 5, sj = unit & 31, b = seq >> 2, hh = seq & 3; const int tokbase = b * SEQ + sj * 512;
    LAS bf16* Qs = (LAS bf16*)(X.lds + ML_Q); LAS bf16* Ks = (LAS bf16*)(X.lds + ML_K); LAS bf16* KET = (LAS bf16*)(X.lds + ML_KET);
    LAS bf16* VT = (LAS bf16*)(X.lds + ML_VT); LAS bf16* CT = (LAS bf16*)(X.lds + ML_CT); LAS float* CW = (LAS float*)(X.lds + ML_CW);
    LAS float* CB = (LAS float*)(X.lds + ML_CB); LAS float* RED = (LAS float*)(X.lds + ML_RED); LAS float* NW = (LAS float*)(X.lds + ML_NW);
    LAS float* GT = (LAS float*)(X.lds + ML_GT);
    int lane = X.lane; asm volatile("" : "+v"(lane));
    const int c16 = lane & 15, quad = lane >> 4, w = X.wave;
    int tidl = X.tid; asm volatile("" : "+v"(tidl));
    const int tg = tidl >> 5, cg = tidl & 31, t0 = 4 * tg, c0 = 4 * cg;
    v2u rq[7], rk[7], rv[4], kcv[4];
#define ML_LBAR() do { asm volatile("s_waitcnt lgkmcnt(0)" ::: "memory"); __builtin_amdgcn_s_barrier(); asm volatile("" ::: "memory"); } while (0)
#define ML_LOADRAW(tokc) do { _Pragma("unroll") for (int j = 0; j < 7; ++j) { const int tt = (tokc) + t0 - 3 + j; const bool ok = tt >= b * SEQ; const bf16* rp = proj + (size_t)(ok ? tt : (tokc)) * NPROJ + hh * 128 + c0; \
        if (L3) { rq[j] = *(const v2u*)(rp + C_MQ); if (!ok) { rq[j].x = 0u; rq[j].y = 0u; } } else { rk[j] = *(const v2u*)(rp + C_MK); if (!ok) { rk[j].x = 0u; rk[j].y = 0u; } } } \
        if (L3) { _Pragma("unroll") for (int i = 0; i < 4; ++i) kcv[i] = *(const v2u*)(kcb + (size_t)((tokc) + t0 + i) * 512 + hh * 128 + c0); } \
        _Pragma("unroll") for (int i = 0; i < 4; ++i) rv[i] = *(const v2u*)(proj + (size_t)((tokc) + t0 + i) * NPROJ + C_MV + hh * 128 + c0); } while (0)
    ML_LOADRAW(tokbase);
    for (int idx = X.tid; idx < 1280; idx += 512) { const int tap = idx >> 8, ch = idx & 255; const int gch = (ch < 128) ? (hh * 128 + ch) : (512 + hh * 128 + (ch - 128));
        CW[idx] = (tap < 4) ? a.conv_w[(size_t)(l * 4 + tap) * 1024 + gch] : a.conv_b[l * 1024 + gch]; }
    for (int idx = X.tid; idx < 16 * 72; idx += 512) VT[128 * 72 + idx] = (idx < 72) ? (bf16)0x3F80 : (bf16)0;
    if (X.tid < 128) NW[X.tid] = a.mnw[l * 512 + hh * 128 + X.tid];
    { const float* gp = gates + (size_t)(tokbase + X.tid) * 8; GT[2 * X.tid] = gp[hh]; GT[2 * X.tid + 1] = gp[4 + hh]; }
    f32x4 cacc[9];
#pragma unroll
    for (int et = 0; et < 9; ++et) {
        if (L3) {
#pragma unroll
            for (int j = 0; j < 4; ++j) { const float v = mlc[(16 * et + 4 * quad + j) * 128 + 16 * w + c16]; cacc[et][j] = v; CT[(16 * et + 4 * quad + j) * 136 + 16 * w + c16] = (bf16)f2bf(v); }
        } else cacc[et] = (f32x4){0.f, 0.f, 0.f, 0.f};
    }
    float bsum = 0.f;
    __syncthreads();
#pragma unroll 1
    for (int c = 0; c < 8; ++c) {
        const int tok0 = tokbase + c * 64;
        const f32x2 gl = *(const LAS f32x2*)(GT + 2 * (c * 64 + lane)); float bsc = gl.y; const float li = gl.x;
#pragma unroll
        for (int o = 1; o < 64; o <<= 1) { const float v = __shfl_up(bsc, o); if (lane >= o) bsc += v; }
        const float bl = __shfl(bsc, 63); const float csv = li - bsc;
        if (w == 0) { CB[lane] = bsc; CB[64 + lane] = csv; }
        bsum += bl;
        const int tt_ = w & 3, eh = w >> 2; const int tq = 16 * tt_ + c16;
        v2u ogv[4];
        if (L3) {
#pragma unroll
            for (int x = 0; x < 4; ++x) ogv[x] = *(const v2u*)(proj + (size_t)(tok0 + tq) * NPROJ + C_MO + hh * 128 + 16 * (4 * eh + x) + 4 * quad); }
        { float fac[4];
#pragma unroll
          for (int i = 0; i < 4; ++i) fac[i] = __expf(bl + __shfl(csv, t0 + i));
#pragma unroll
          for (int qk = (L3 ? 0 : 1); qk < 2; ++qk) {
              float o[4][4];
              if (L3 && qk) {
#pragma unroll
                  for (int i = 0; i < 4; ++i) { o[i][0] = bflo(kcv[i].x); o[i][1] = bfhi(kcv[i].x); o[i][2] = bflo(kcv[i].y); o[i][3] = bfhi(kcv[i].y); }
              } else {
              const f32x4 bias = *(const LAS f32x4*)(CW + 4 * 256 + qk * 128 + c0);
#pragma unroll
              for (int i = 0; i < 4; ++i) { o[i][0] = bias.x; o[i][1] = bias.y; o[i][2] = bias.z; o[i][3] = bias.w; }
#pragma unroll
              for (int j = 0; j < 4; ++j) { const f32x4 wj = *(const LAS f32x4*)(CW + j * 256 + qk * 128 + c0);
#pragma unroll
                  for (int i = 0; i < 4; ++i) { const v2u rr = qk ? rk[i + j] : rq[i + j];
                      o[i][0] += wj.x * bflo(rr.x); o[i][1] += wj.y * bfhi(rr.x); o[i][2] += wj.z * bflo(rr.y); o[i][3] += wj.w * bfhi(rr.y); } }
#pragma unroll
              for (int i = 0; i < 4; ++i)
#pragma unroll
                  for (int ch = 0; ch < 4; ++ch) { const float z = o[i][ch]; o[i][ch] = z * __builtin_amdgcn_rcpf(1.0f + __expf(-z)) * (qk ? 0.08838834764831845f : 1.0f); }
              }
              if (!L3 && qk) {
#pragma unroll
                  for (int i = 0; i < 4; ++i) { v2u pw; pw.x = pk2(o[i][0], o[i][1]); pw.y = pk2(o[i][2], o[i][3]); *(v2u*)(kcb + (size_t)(tok0 + t0 + i) * 512 + hh * 128 + c0) = pw;
                      o[i][0] = bflo(pw.x); o[i][1] = bfhi(pw.x); o[i][2] = bflo(pw.y); o[i][3] = bfhi(pw.y); } }
              if (L3) { LAS bf16* dst = (qk ? Ks : Qs) + t0 * 136 + c0;
#pragma unroll
                  for (int i = 0; i < 4; ++i) { v2u pw; pw.x = pk2(o[i][0], o[i][1]); pw.y = pk2(o[i][2], o[i][3]); *(LAS v2u*)(dst + i * 136) = pw; } }
              if (qk) {
#pragma unroll
                  for (int ch = 0; ch < 4; ++ch) { v2u pw; pw.x = pk2(o[0][ch] * fac[0], o[1][ch] * fac[1]); pw.y = pk2(o[2][ch] * fac[2], o[3][ch] * fac[3]); *(LAS v2u*)(KET + (c0 + ch) * 72 + t0) = pw; } }
          }
          { v2u p0, p1, p2, p3;
            p0.x = (rv[0].x & 0xffffu) | (rv[1].x << 16); p0.y = (rv[2].x & 0xffffu) | (rv[3].x << 16);
            p1.x = (rv[0].x >> 16) | (rv[1].x & 0xffff0000u); p1.y = (rv[2].x >> 16) | (rv[3].x & 0xffff0000u);
            p2.x = (rv[0].y & 0xffffu) | (rv[1].y << 16); p2.y = (rv[2].y & 0xffffu) | (rv[3].y << 16);
            p3.x = (rv[0].y >> 16) | (rv[1].y & 0xffff0000u); p3.y = (rv[2].y >> 16) | (rv[3].y & 0xffff0000u);
            *(LAS v2u*)(VT + (c0 + 0) * 72 + t0) = p0; *(LAS v2u*)(VT + (c0 + 1) * 72 + t0) = p1; *(LAS v2u*)(VT + (c0 + 2) * 72 + t0) = p2; *(LAS v2u*)(VT + (c0 + 3) * 72 + t0) = p3; }
        }
        ML_LBAR();
        if (c < 7) { ML_LOADRAW(tok0 + 64); }
        float hval[4][4];
        if (L3) {
            bf16x8 qf[4];
#pragma unroll
            for (int ks = 0; ks < 4; ++ks) qf[ks] = *(const LAS bf16x8*)(Qs + tq * 136 + 32 * ks + 8 * quad);
            f32x4 sacc[4];
#pragma unroll
            for (int st = 0; st < 4; ++st) { f32x4 z = {0.f, 0.f, 0.f, 0.f};
#pragma unroll
                for (int ks = 0; ks < 4; ++ks) z = __builtin_amdgcn_mfma_f32_16x16x32_bf16(*(const LAS bf16x8*)(Ks + (16 * st + c16) * 136 + 32 * ks + 8 * quad), qf[ks], z, 0, 0, 0);
                sacc[st] = z; }
            const float cbt = CB[tq];
#pragma unroll
            for (int st = 0; st < 4; ++st)
#pragma unroll
                for (int j = 0; j < 4; ++j) { const int s = 16 * st + 4 * quad + j; const float d = (s <= tq) ? __expf(cbt + CB[64 + s]) : 0.f; sacc[st][j] *= d; }
            bf16x8 pf[2];
#pragma unroll
            for (int kk = 0; kk < 2; ++kk) { v4u pw; pw.x = pk2m(sacc[2 * kk][0], sacc[2 * kk][1]); pw.y = pk2m(sacc[2 * kk][2], sacc[2 * kk][3]); pw.z = pk2m(sacc[2 * kk + 1][0], sacc[2 * kk + 1][1]); pw.w = pk2m(sacc[2 * kk + 1][2], sacc[2 * kk + 1][3]); pf[kk] = __builtin_bit_cast(bf16x8, pw); }
            const float ebt = __expf(cbt);
            f32x4 nn[5];
#pragma unroll
            for (int x = 0; x < 5; ++x) { const int et = (x < 4) ? (4 * eh + x) : 8; f32x4 na = {0.f, 0.f, 0.f, 0.f}, ia = {0.f, 0.f, 0.f, 0.f};
#pragma unroll
                for (int kk = 0; kk < 2; ++kk) { const LAS bf16* vr = VT + (16 * et + c16) * 72 + 32 * kk + 4 * quad; const v2u lo = *(const LAS v2u*)vr, hi = *(const LAS v2u*)(vr + 16); v4u vw; vw.x = lo.x; vw.y = lo.y; vw.z = hi.x; vw.w = hi.y;
                    na = __builtin_amdgcn_mfma_f32_16x16x32_bf16(__builtin_bit_cast(bf16x8, vw), pf[kk], na, 0, 0, 0); }
#pragma unroll
                for (int ks = 0; ks < 4; ++ks) ia = __builtin_amdgcn_mfma_f32_16x16x32_bf16(*(const LAS bf16x8*)(CT + (16 * et + c16) * 136 + 32 * ks + 8 * quad), qf[ks], ia, 0, 0, 0);
                nn[x] = na + ia * ebt; }
            const float den = __shfl(nn[4][0], c16); const float inv = 1.0f / fmaxf(fabsf(den), 1.0f);
            float ss = 0.f;
#pragma unroll
            for (int x = 0; x < 4; ++x)
#pragma unroll
                for (int j = 0; j < 4; ++j) { hval[x][j] = nn[x][j] * inv; ss += hval[x][j] * hval[x][j]; }
            ss += __shfl_xor(ss, 16); ss += __shfl_xor(ss, 32);
            if (quad == 0) RED[eh * 64 + tq] = ss;
            ML_LBAR();
            const float rstd = __builtin_amdgcn_rsqf((RED[tq] + RED[64 + tq]) * (1.0f / 128.0f) + EPS);
#pragma unroll
            for (int x = 0; x < 4; ++x) { const int e = 16 * (4 * eh + x) + 4 * quad; const v2u og = ogv[x];
                const float y0 = hval[x][0] * rstd * NW[e] * bflo(og.x), y1 = hval[x][1] * rstd * NW[e + 1] * bfhi(og.x), y2 = hval[x][2] * rstd * NW[e + 2] * bflo(og.y), y3 = hval[x][3] * rstd * NW[e + 3] * bfhi(og.y);
                *(unsigned*)(hm + (size_t)(tok0 + tq) * 512 + hh * 128 + e) = pk4_fp8(y0 * 8.0f, y1 * 8.0f, y2 * 8.0f, y3 * 8.0f); }
        }
        { const float ebl = __expf(bl);
          bf16x8 kf[2];
#pragma unroll
          for (int kk = 0; kk < 2; ++kk) kf[kk] = *(const LAS bf16x8*)(KET + (16 * w + c16) * 72 + 32 * kk + 8 * quad);
#pragma unroll
          for (int et = 0; et < 9; ++et) { f32x4 z = cacc[et] * ebl;
#pragma unroll
              for (int kk = 0; kk < 2; ++kk) z = __builtin_amdgcn_mfma_f32_16x16x32_bf16(*(const LAS bf16x8*)(VT + (16 * et + c16) * 72 + 32 * kk + 8 * quad), kf[kk], z, 0, 0, 0);
              cacc[et] = z;
              if (L3) {
#pragma unroll
                  for (int j = 0; j < 4; ++j) CT[(16 * et + 4 * quad + j) * 136 + 16 * w + c16] = (bf16)f2bf(z[j]); } } }
        ML_LBAR();
    }
#undef ML_LOADRAW
#undef ML_LBAR
    if (!L3) {
#pragma unroll
        for (int et = 0; et < 9; ++et)
#pragma unroll
            for (int j = 0; j < 4; ++j) mlc[(16 * et + 4 * quad + j) * 128 + 16 * w + c16] = cacc[et][j];
        if (X.tid == 0) mlb[unit] = bsum;
    }
}
DI void mlstm_scan(const Args& a, const Ctx& X) {
    float* mlc = (float*)(a.ws + WS_MLC); const float* mlb = (const float*)(a.ws + WS_MLB);
    for (int idx = X.bid * 512 + X.tid; idx < 8 * 18432; idx += X.G * 512) { const int seq = idx / 18432, el = idx - seq * 18432; float carry = 0.f;
        float* p0 = mlc + (size_t)seq * 32 * 18432 + el; float v[32], dcy[32];
#pragma unroll
        for (int j = 0; j < 32; ++j) { v[j] = p0[(size_t)j * 18432]; dcy[j] = mlb[seq * 32 + j]; }
#pragma unroll
        for (int j = 0; j < 32; ++j) { p0[(size_t)j * 18432] = carry; carry = __expf(dcy[j]) * carry + v[j]; } }
}

constexpr int P6_WR = 0, P6_AT = 33024, P6_SH = 37120, P6_LG = 41216, P6_HIST = 65536;
DI void p6_norm_route(const Args& a, const Ctx& X, int l, const bf16* xin) {
    unsigned char* ws = a.ws;
    LAS bf16* wrb = (LAS bf16*)(X.lds + P6_WR);
    LAS float* at = (LAS float*)(X.lds + P6_AT); LAS float* sht = (LAS float*)(X.lds + P6_SH);
    LAS float* lg = (LAS float*)(X.lds + P6_LG) + X.wave * 272;
    for (int idx = X.tid; idx < 16384; idx += 512) { const int k = idx >> 4, e = idx & 15; wrb[e * 1032 + k] = (bf16)f2bf(a.router_w[idx]); }
    const float* mod = (const float*)(ws + WS_MOD); unsigned char* hb = (unsigned char*)(ws + WS_H); float* tgate = (float*)(ws + WS_TGATE); int* tokl = (int*)(ws + WS_TOKL);
    const float* ssq = (const float*)(ws + WS_SSQ);
    unsigned* cnt = (unsigned*)(ws + WS_CTL) + CW_CNT + l * 2048;
    LAS int* hist = (LAS int*)(X.lds + P6_HIST); LAS int* cbase = hist + 32;
    int lane = X.lane; asm volatile("" : "+v"(lane));
    const int r = lane & 15, q = lane >> 4;
    const int gw = X.bid * 8 + X.wave, NGW = X.G * 8;
    for (int it = 0; it * NGW < T / 16; ++it) {
        const int rg = it * NGW + gw; const bool act = rg < T / 16;
        const int row0 = (act ? rg : 0) * 16; const int bb = ((it * NGW + X.bid * 8) * 16) >> 14;
        __syncthreads();
        if (X.tid < 32) hist[X.tid] = 0;
        { const float* mb = mod + (size_t)(l * 2 + (bb < 2 ? bb : 1)) * 6144;
          for (int k = X.tid; k < 1024; k += 512) { at[k] = a.nfw[l * D + k] * (1.0f + mb[4 * 1024 + k]); sht[k] = mb[3 * 1024 + k]; } }
        __syncthreads();
        const int row = row0 + r;
        float rstd;
        { const f32x4 pp = *(const f32x4*)(ssq + (size_t)row * 16 + 4 * q); float ss = (pp.x + pp.y) + (pp.z + pp.w); ss += __shfl_xor(ss, 16); ss += __shfl_xor(ss, 32); rstd = __builtin_amdgcn_rsqf(ss * (1.0f / D) + EPS); }
        const bf16* xr = xin + (size_t)row * D + 8 * q; unsigned char* hr = hb + (size_t)row * D + 8 * q;
        f32x4 acc = {0.f, 0.f, 0.f, 0.f};
#pragma unroll 8
        for (int s = 0; s < 32; ++s) {
            const v4u xw = *(const v4u*)(xr + 32 * s); const f32x4 x0 = {bflo(xw.x), bfhi(xw.x), bflo(xw.y), bfhi(xw.y)}, x1 = {bflo(xw.z), bfhi(xw.z), bflo(xw.w), bfhi(xw.w)};
            const f32x4 a0 = *(const LAS f32x4*)(at + 32 * s + 8 * q), a1 = *(const LAS f32x4*)(at + 32 * s + 8 * q + 4);
            const f32x4 s0 = *(const LAS f32x4*)(sht + 32 * s + 8 * q), s1 = *(const LAS f32x4*)(sht + 32 * s + 8 * q + 4);
            const f32x4 h0 = x0 * rstd * a0 + s0, h1 = x1 * rstd * a1 + s1;
            v4u w; w.x = pk2m(h0.x, h0.y); w.y = pk2m(h0.z, h0.w); w.z = pk2m(h1.x, h1.y); w.w = pk2m(h1.z, h1.w);
            { v2u w8; w8.x = pk4_fp8(h0.x, h0.y, h0.z, h0.w); w8.y = pk4_fp8(h1.x, h1.y, h1.z, h1.w); *(v2u*)(hr + 32 * s) = w8; }
            const bf16x8 bfr = *(const LAS bf16x8*)(wrb + r * 1032 + 32 * s + 8 * q);
            acc = __builtin_amdgcn_mfma_f32_16x16x32_bf16(__builtin_bit_cast(bf16x8, w), bfr, acc, 0, 0, 0);
        }
#pragma unroll
        for (int j = 0; j < 4; ++j) lg[(4 * q + j) * 17 + r] = acc[j];
        LDS_WAIT(); asm volatile("" ::: "memory");
        int my_cls = 0; float my_ga = 0.f, my_gb = 0.f;
        if (lane < 16) {
            float sc[16], sel[16];
#pragma unroll
            for (int e = 0; e < 16; ++e) { const float p = lg[lane * 17 + e]; sc[e] = 1.0f / (1.0f + __expf(-p)); sel[e] = sc[e] + a.router_b[e]; }
            int gi = 0; float gbest = -1.0e30f;
#pragma unroll
            for (int g = 0; g < 4; ++g) { const float p0 = sel[4 * g], p1 = sel[4 * g + 1], p2 = sel[4 * g + 2], p3 = sel[4 * g + 3];
                const float gs = fmaxf(fmaxf(fmaxf(p0 + p1, p0 + p2), fmaxf(p0 + p3, p1 + p2)), fmaxf(p1 + p3, p2 + p3));
                if (gs > gbest) { gbest = gs; gi = g; } }
            float qs[4], s4[4];
#pragma unroll
            for (int i = 0; i < 4; ++i) { qs[i] = 0.f; s4[i] = 0.f; }
#pragma unroll
            for (int g = 0; g < 4; ++g) if (g == gi) {
#pragma unroll
                for (int i = 0; i < 4; ++i) { qs[i] = sel[4 * g + i]; s4[i] = sc[4 * g + i]; } }
            int i1 = 0; float b1 = qs[0];
#pragma unroll
            for (int i = 1; i < 4; ++i) if (qs[i] > b1) { b1 = qs[i]; i1 = i; }
            int i2 = -1; float b2 = -1.0e30f;
#pragma unroll
            for (int i = 0; i < 4; ++i) if (i != i1 && qs[i] > b2) { b2 = qs[i]; i2 = i; }
            const int ia = (i1 < i2) ? i1 : i2, ib = (i1 < i2) ? i2 : i1;
            float sa = 0.f, sb = 0.f;
#pragma unroll
            for (int i = 0; i < 4; ++i) { if (i == ia) sa = s4[i]; if (i == ib) sb = s4[i]; }
            const int pidx = (ia == 0) ? (ib - 1) : ((ia == 1) ? (ib + 1) : 5);
            const float inv = 1.0f / (sa + sb);
            my_cls = gi * 6 + pidx; my_ga = sa * inv; my_gb = sb * inv;
        }
        int rank = 0;
        if (act && lane < 16) rank = __hip_atomic_fetch_add(hist + my_cls, 1, __ATOMIC_RELAXED, __HIP_MEMORY_SCOPE_WORKGROUP);
        __syncthreads();
        if (X.tid < NCLS) { const int n = hist[X.tid]; cbase[X.tid] = n ? (int)__hip_atomic_fetch_add(cnt + 64 * X.tid, (unsigned)n, RLX_AGENT) : 0; }
        __syncthreads();
        if (act && lane < 16) { const int tok = row0 + lane; const int pos = cbase[my_cls] + rank;
            tokl[my_cls * CLS_CAP + pos] = tok; tgate[tok * 2] = my_ga; tgate[tok * 2 + 1] = my_gb; }
    }
}
DI MoeTab moe_tables(const Args& a, const Ctx& X, int l) {
    LAS int* tab = (LAS int*)(X.lds + TAB_OFF); LAS int* tcls = tab; LAS int* tpos = tab + 160; LAS int* cn = tab + 320; LAS int* rt_ = tab + 344;
    unsigned* cnt = (unsigned*)(a.ws + WS_CTL) + CW_CNT + l * 2048;
    if (X.tid < NCLS) cn[X.tid] = (int)__hip_atomic_load(cnt + 64 * X.tid, RLX_AGENT);
    __syncthreads();
    if (X.tid == 0) { int r = 0;
#pragma unroll 1
        for (int c = 0; c < NCLS; ++c) { const int n = (cn[c] + 255) >> 8;
#pragma unroll 1
            for (int i = 0; i < n; ++i) { tcls[r] = c; tpos[r] = i * 256; ++r; } }
        rt_[0] = r; }
    __syncthreads();
    MoeTab tb; tb.tcls = tcls; tb.tpos = tpos; tb.cnt = cn; tb.Rtot = __builtin_amdgcn_readfirstlane(rt_[0]); return tb;
}

#if defined(__HIP_DEVICE_COMPILE__)
DI Args load_args() { auto p = __builtin_amdgcn_kernarg_segment_ptr(); asm volatile("" : "+s"(p)); return *(const __attribute__((address_space(4))) Args*)p; }
#else
DI Args load_args() { return Args{}; }
#endif
__global__ void __launch_bounds__(512, 2) fwd(Args a_unused) {
    extern __shared__ __attribute__((aligned(16))) unsigned char lds_raw[];
    Ctx X; X.lds = (LAS unsigned char*)lds_raw; X.tid = threadIdx.x; X.lane = X.tid & 63; X.wave = __builtin_amdgcn_readfirstlane(X.tid >> 6); X.G = gridDim.x; X.bid = blockIdx.x;
    volatile LAS unsigned* MISC = (volatile LAS unsigned*)(X.lds + MISC_OFF);
    if (X.tid < 64) MISC[X.tid] = 0u;
    __syncthreads();
    int lo, hi; unsigned* ctl;
    { const Args a = load_args(); lo = a.ph_lo; hi = a.ph_hi; ctl = (unsigned*)(a.ws + WS_CTL); }
    XcdBarrier bar; bar.bar = ctl + CW_BAR; bar.x = 0; bar.st = MISC + 8;
    if (hi - lo > 1) bar = xcd_barrier_post(ctl + CW_BAR, MISC + 8);
#ifndef PH_MASK
#define PH_MASK 0xFFFFF
#endif
#define PON(p) ((PH_MASK >> (p)) & 1)
#ifndef DUP_MASK
#define DUP_MASK 0
#endif
#define NREP(p) (((DUP_MASK >> (p)) & 1) ? 2 : 1)
#ifndef TSEL_MASK
#define TSEL_MASK 0
#endif
#define TSCALE 4
#define TSEL(p) ((TSEL_MASK >> (p)) & 1)
#define IN(k) (lo <= (k) && (k) < hi)
#define SEAM(k) do { if (IN(k) && IN((k) + 1)) xcd_barrier(bar); } while (0)
    unsigned long long tacc = 0ull, tph = 0ull;
#define TBEG() do { if (TSEL_MASK) tph = __builtin_amdgcn_s_memrealtime(); } while (0)
#define TEND(p) do { if (TSEL(p)) tacc += __builtin_amdgcn_s_memrealtime() - tph; } while (0)
    TBEG();
    if (PON(10) && IN(0)) { for (int rep = 0; rep < NREP(10); ++rep) { const Args a = load_args(); p0_prologue(a, X); } }
    SEAM(0); TEND(10);
    TBEG();
    for (int l = 0; l < NL; ++l) {
        const int g0 = 1 + l * NPH;
        if (PON(0) && IN(g0 + 0)) { for (int rep = 0; rep < NREP(0); ++rep) { const Args a = load_args(); unsigned char* ws = a.ws; const float* mod = (const float*)(ws + WS_MOD); bf16* proj = (bf16*)(ws + WS_PROJ); bf16* xb = (bf16*)(ws + WS_XB); (void)mod; (void)proj; (void)xb; const Ctx P = fresh(X); p1_norm_gates(a, P, l, xb); } }
        SEAM(g0 + 0); TEND(0); TBEG();
        if (PON(1) && IN(g0 + 1)) for (int rep = 0; rep < NREP(1); ++rep) { const Args a = load_args(); unsigned char* ws = a.ws; const float* mod = (const float*)(ws + WS_MOD); bf16* proj = (bf16*)(ws + WS_PROJ); bf16* xb = (bf16*)(ws + WS_XB); (void)mod; (void)proj; (void)xb; const Ctx P = fresh(X);
            DenseSched S; S.A = (const char*)(ws + WS_H); S.Bt = (const char*)(ws + WS_WIN) + (size_t)l * NPROJW * D; S.lda = D; S.ldb = D; S.ord.init(T / 256, NPROJW / 256, P.G, P.bid);
            EpiProj E; E.O = proj; E.gates = (float*)(ws + WS_GATES); E.big = a.b_ig + l * 4; E.bfg = a.b_fg + l * 4;
            pg8::gemm_phase<EpiProj, DenseSched, true>(P.lds, D, S, E);
        }
        SEAM(g0 + 1); TEND(1); TBEG();
        if (PON(2) && IN(g0 + 2)) { const Args a = load_args(); unsigned char* ws = a.ws; const float* mod = (const float*)(ws + WS_MOD); bf16* proj = (bf16*)(ws + WS_PROJ); bf16* xb = (bf16*)(ws + WS_XB); (void)mod; (void)proj; (void)xb; const Ctx P = fresh(X);
            if (PON(11)) for (int rep = 0; rep < NREP(11); ++rep) {
#pragma unroll 1
                for (int u = P.bid; u < 512; u += P.G) attn_unit(a, P, l, u); }
            if (PON(12)) for (int rep = 0; rep < NREP(12); ++rep) {
#pragma unroll 1
                for (int u = P.bid; u < 256; u += P.G) mlstm_unit<false>(a, P, l, u); }
        }
        SEAM(g0 + 2); TEND(2); TBEG();
        if (PON(3) && IN(g0 + 3)) { const Args a = load_args(); unsigned char* ws = a.ws; const float* mod = (const float*)(ws + WS_MOD); bf16* proj = (bf16*)(ws + WS_PROJ); bf16* xb = (bf16*)(ws + WS_XB); (void)mod; (void)proj; (void)xb; const Ctx P = fresh(X); mlstm_scan(a, P); }
        SEAM(g0 + 3); TEND(3); TBEG();
        if (PON(4) && IN(g0 + 4)) for (int rep = 0; rep < NREP(4); ++rep) { const Args a = load_args(); unsigned char* ws = a.ws; const float* mod = (const float*)(ws + WS_MOD); bf16* proj = (bf16*)(ws + WS_PROJ); bf16* xb = (bf16*)(ws + WS_XB); (void)mod; (void)proj; (void)xb; const Ctx P = fresh(X);
#pragma unroll 1
            for (int u = P.bid; u < 256; u += P.G) mlstm_unit<true>(a, P, l, u); }
        SEAM(g0 + 4); TEND(4); TBEG();
        if (PON(5) && IN(g0 + 5)) for (int rep = 0; rep < NREP(5); ++rep) { const Args a = load_args(); unsigned char* ws = a.ws; const float* mod = (const float*)(ws + WS_MOD); bf16* proj = (bf16*)(ws + WS_PROJ); bf16* xb = (bf16*)(ws + WS_XB); (void)mod; (void)proj; (void)xb; const Ctx P = fresh(X);
            MergeSched S; S.A0 = (const char*)(ws + WS_H); S.A1 = (const char*)(ws + WS_H) + (size_t)T * 512; S.B0 = (const char*)(ws + WS_WAU) + (size_t)l * D * 512; S.B1 = (const char*)(ws + WS_WMU) + (size_t)l * D * 512;
            S.lda = 512; S.ldb = 512; S.ord.init(T / 256, D / 256, P.G, P.bid);
            EpiMerge E; E.P = proj; pg8::gemm_phase<EpiMerge, MergeSched, true>(P.lds, 1024, S, E);
        }
        SEAM(g0 + 5); TEND(5); TBEG();
        if (PON(6) && IN(g0 + 6)) for (int rep = 0; rep < NREP(6); ++rep) { const Args a = load_args(); unsigned char* ws = a.ws; const float* mod = (const float*)(ws + WS_MOD); bf16* proj = (bf16*)(ws + WS_PROJ); bf16* xb = (bf16*)(ws + WS_XB); (void)mod; (void)proj; (void)xb; const Ctx P = fresh(X);
            DenseSched S; S.A = (const char*)(proj + C_MQ); S.Bt = (const char*)(ws + WS_WOUT) + (size_t)l * D * D; S.lda = NPROJ * 2; S.ldb = D; S.ord.init(T / 256, D / 256, P.G, P.bid);
            EpiRes E; E.xin = xb; E.out = xb; E.g = mod + (size_t)(l * 2) * 6144 + 2 * 1024; E.ssq = (float*)(ws + WS_SSQ); E.rmask = T - 1;
            if (rep) { E.out = (bf16*)(ws + WS_H); E.rmask = T / 2 - 1; }
            pg8::gemm_phase<EpiRes, DenseSched, true>(P.lds, D, S, E);
        }
        SEAM(g0 + 6); TEND(6); TBEG();
        if (PON(7) && IN(g0 + 7)) { const Args a = load_args(); unsigned char* ws = a.ws; const float* mod = (const float*)(ws + WS_MOD); bf16* proj = (bf16*)(ws + WS_PROJ); bf16* xb = (bf16*)(ws + WS_XB); (void)mod; (void)proj; (void)xb; const Ctx P = fresh(X); p6_norm_route(a, P, l, xb); }
        SEAM(g0 + 7); TEND(7); TBEG();
        if (PON(8) && IN(g0 + 8)) for (int rep = 0; rep < NREP(8); ++rep) { const Args a = load_args(); unsigned char* ws = a.ws; const float* mod = (const float*)(ws + WS_MOD); bf16* proj = (bf16*)(ws + WS_PROJ); bf16* xb = (bf16*)(ws + WS_XB); (void)mod; (void)proj; (void)xb; const Ctx P = fresh(X);
            const MoeTab tb = moe_tables(a, P, l);
            LAS unsigned* tokoff = (LAS unsigned*)(P.lds + TOKOFF_OFF); const int* tokl = (const int*)(ws + WS_TOKL);
#pragma unroll 1
            for (int s = 0; s < 8; ++s) { const int L0 = s * P.G + P.bid;
                if (L0 < tb.Rtot * 8 && P.tid < 256) { const int L = xcd_remap(L0, tb.Rtot * 8); const int rt = L >> 3, cls = tb.tcls[rt], pos = tb.tpos[rt] + P.tid, cn = tb.cnt[cls]; const int tok = tokl[cls * CLS_CAP + (pos < cn ? pos : 0)]; tokoff[s * 256 + P.tid] = (unsigned)tok; } }
            __syncthreads();
            MoeUpSched S; S.A = (const char*)(ws + WS_H); S.W = (const char*)(ws + WS_WGU) + (size_t)l * NE * 1024 * D; S.lda = D; S.ldb = D; S.tb = tb; S.G = P.G; S.c = P.bid; S.tokoff = tokoff;
            EpiSwiglu E; E.H = (unsigned char*)proj; E.tgate = (const float*)(ws + WS_TGATE); E.tokoff = tokoff;
            pg8::gemm_phase<EpiSwiglu, MoeUpSched, true>(P.lds, D, S, E);
        }
        SEAM(g0 + 8); TEND(8); TBEG();
        if (PON(9) && IN(g0 + 9)) for (int rep = 0; rep < NREP(9); ++rep) { const Args a = load_args(); unsigned char* ws = a.ws; const float* mod = (const float*)(ws + WS_MOD); bf16* proj = (bf16*)(ws + WS_PROJ); bf16* xb = (bf16*)(ws + WS_XB); (void)mod; (void)proj; (void)xb; const Ctx P = fresh(X);
            const MoeTab tb = moe_tables(a, P, l);
            MoeDownSched S; S.A = (const char*)proj; S.W = (const char*)(ws + WS_WD) + (size_t)l * NE * 1024 * FF; S.lda = D; S.ldb = FF; S.tb = tb; S.G = P.G; S.c = P.bid;
            EpiMoeOut E; E.xin = xb; E.outb = xb; E.outf = a.out; E.last = (l == NL - 1); E.g = mod + (size_t)(l * 2) * 6144 + 5 * 1024; E.tokl = (const int*)(ws + WS_TOKL); E.tb = tb; E.rmask = T - 1;
            if (rep) { E.outb = (bf16*)(ws + WS_H); E.last = 0; E.rmask = T / 2 - 1; }
            pg8::gemm_phase<EpiMoeOut, MoeDownSched, true>(P.lds, D, S, E);
        }
        SEAM(g0 + 9); TEND(9); TBEG();
    }
    if (TSEL_MASK && X.bid == 0) { const unsigned long long t1 = __builtin_amdgcn_s_memrealtime(); while (__builtin_amdgcn_s_memrealtime() - t1 < TSCALE * tacc) __builtin_amdgcn_s_sleep(8); }
#undef IN
#undef SEAM
}

extern "C" void kernel_launch(void* const* d_in, const int* in_sizes, int n_in, void* d_out, int out_size, void* d_ws, size_t ws_size, hipStream_t stream) {
    static int grid = 0;
    if (grid == 0) {
        if (n_in != 24 || in_sizes[0] != T * D || out_size != T * D || ws_size < WS_END) { fprintf(stderr, "kernel_launch: unexpected shapes / workspace (n_in %d, ws %zu, need %zu)\n", n_in, ws_size, (size_t)WS_END); grid = -1; return; }
        int dev = 0, cus = 0;
        if (hipGetDevice(&dev) != hipSuccess || hipDeviceGetAttribute(&cus, hipDeviceAttributeMultiprocessorCount, dev) != hipSuccess) { grid = -1; return; }
        if (hipFuncSetAttribute((const void*)fwd, hipFuncAttributeMaxDynamicSharedMemorySize, LDS_BYTES) != hipSuccess) { fprintf(stderr, "kernel_launch: hipFuncSetAttribute failed\n"); grid = -1; return; }
        int per_cu = 0;
        if (hipOccupancyMaxActiveBlocksPerMultiprocessor(&per_cu, (const void*)fwd, 512, LDS_BYTES) != hipSuccess || per_cu < 1) fprintf(stderr, "kernel_launch: occupancy query reports %d\n", per_cu);
        (void)hipGetLastError();
        grid = cus < 256 ? cus : 256;
    }
    if (grid < 0) return;
    (void)hipMemsetAsync((char*)d_ws + WS_CTL, 0, CTL_ZERO_BYTES, stream);
    Args a{};
    a.x = (const float*)d_in[0]; a.c = (const float*)d_in[1]; a.pos = (const int*)d_in[2]; a.ada_w = (const float*)d_in[3]; a.ada_b = (const float*)d_in[4];
    a.nmw = (const float*)d_in[5]; a.nfw = (const float*)d_in[6]; a.w_in = (const float*)d_in[7]; a.b_ig = (const float*)d_in[8]; a.b_fg = (const float*)d_in[9];
    a.qnw = (const float*)d_in[10]; a.knw = (const float*)d_in[11]; a.sinks = (const float*)d_in[12]; a.conv_w = (const float*)d_in[13]; a.conv_b = (const float*)d_in[14];
    a.mnw = (const float*)d_in[15]; a.w_au = (const float*)d_in[16]; a.w_mu = (const float*)d_in[17]; a.w_out = (const float*)d_in[18]; a.router_w = (const float*)d_in[19];
    a.router_b = (const float*)d_in[20]; a.w_gate = (const float*)d_in[21]; a.w_up = (const float*)d_in[22]; a.w_down = (const float*)d_in[23];
    a.out = (float*)d_out; a.ws = (unsigned char*)d_ws;
#if MK_MULTI
    for (int gp = 0; gp < NGP; ++gp) { a.ph_lo = gp; a.ph_hi = gp + 1; hipLaunchKernelGGL(fwd, dim3(grid), dim3(512), LDS_BYTES, stream, a); }
#else
    a.ph_lo = 0; a.ph_hi = NGP; hipLaunchKernelGGL(fwd, dim3(grid), dim3(512), LDS_BYTES, stream, a);
#endif
}
```

```cpp
#include <hip/hip_runtime.h>
#include <cstdio>
#include <cstdint>

#ifndef MK_MULTI
#define MK_MULTI 0
#endif

#define GAS __attribute__((address_space(1)))
#define LAS __attribute__((address_space(3)))
typedef unsigned short bf16;
typedef unsigned v4u __attribute__((ext_vector_type(4)));
typedef unsigned v2u __attribute__((ext_vector_type(2)));
typedef float f32x4 __attribute__((ext_vector_type(4)));
typedef float f32x2 __attribute__((ext_vector_type(2)));
typedef short bf16x8 __attribute__((ext_vector_type(8)));
typedef short bf16x4 __attribute__((ext_vector_type(4)));
#define DI __device__ __forceinline__
#define RLX_AGENT __ATOMIC_RELAXED, __HIP_MEMORY_SCOPE_AGENT
#define LDS_WAIT() asm volatile("s_waitcnt lgkmcnt(0)" ::: "memory")
#define VM_WAIT() asm volatile("s_waitcnt vmcnt(0)" ::: "memory")

constexpr int NB = 2, SEQ = 16384, T = NB * SEQ, D = 1024, NL = 4;
constexpr int DIN_SRC = 4872;
constexpr int NPROJ = 4864;
constexpr int C_AQ = 0, C_AK = 512, C_AV = 640, C_MQ = 768, C_MK = 1280, C_MV = 1792, C_MO = 2304, C_GA = 2816, C_GB = 3840;
constexpr int NE = 16, FF = 512;
constexpr int NCLS = 24, CLS_CAP = 32768;
constexpr float EPS = 1e-6f;
constexpr int NPH = 10;
constexpr int NGP = 1 + NL * NPH;

constexpr size_t MiB = 1u << 20;
constexpr size_t WS_CTL = 0, CTL_ZERO_BYTES = 1 * MiB;
constexpr size_t WS_MOD = 1 * MiB;
constexpr size_t WS_ROPE = 2 * MiB;
constexpr size_t WS_GATES = 4 * MiB;
constexpr size_t WS_TGATE = 5 * MiB;
constexpr size_t WS_TOKL = 6 * MiB;
constexpr size_t WS_MLB = 9 * MiB;
constexpr size_t WS_MLC = 10 * MiB;
constexpr int NPROJW = 5120;
constexpr size_t WS_WIN = 28 * MiB;
constexpr size_t WS_WAU = 68 * MiB;
constexpr size_t WS_WMU = 72 * MiB;
constexpr size_t WS_WOUT = 76 * MiB;
constexpr size_t WS_WGU = 84 * MiB;
constexpr size_t WS_WD = 148 * MiB;
constexpr size_t WS_H = 212 * MiB;
constexpr size_t WS_PROJ = 276 * MiB;
constexpr size_t WS_SSQ = 580 * MiB;
constexpr size_t WS_KC = 582 * MiB;
constexpr size_t WS_XB = 614 * MiB;
constexpr size_t WS_END = 678 * MiB;

constexpr int CW_TMO = 0;
constexpr int CW_BAR = 4096;
constexpr int CW_CNT = 8192;

constexpr int RING_BYTES = 131072;
constexpr int MISC_OFF = RING_BYTES;
constexpr int TAB_OFF = RING_BYTES + 256;
constexpr int TOKOFF_OFF = RING_BYTES + 2048;
constexpr int LDS_BYTES = 147456;

typedef __bf16 bf16x2_t __attribute__((ext_vector_type(2)));
DI unsigned cvt_pk_bf16(float lo, float hi) { const f32x2 v = {lo, hi}; return __builtin_bit_cast(unsigned, __builtin_convertvector(v, bf16x2_t)); }
DI unsigned pk2m(float lo, float hi) { return cvt_pk_bf16(lo, hi); }
DI unsigned f2bf(float f) { return cvt_pk_bf16(f, 0.f) & 0xffffu; }
DI unsigned pk2(float lo, float hi) { return cvt_pk_bf16(lo, hi); }
DI float bf2f(unsigned short b) { return __builtin_bit_cast(float, ((unsigned)b) << 16); }
DI float bflo(unsigned w) { return __builtin_bit_cast(float, w << 16); }
DI float bfhi(unsigned w) { return __builtin_bit_cast(float, w & 0xffff0000u); }
DI float wave_sum(float v) {
#pragma unroll
    for (int o = 1; o < 64; o <<= 1) v += __shfl_xor(v, o);
    return v;
}
DI unsigned pk4_fp8(float a0, float a1, float a2, float a3) { int p = __builtin_amdgcn_cvt_pk_fp8_f32(a0, a1, 0, false); p = __builtin_amdgcn_cvt_pk_fp8_f32(a2, a3, p, true); return (unsigned)p; }
DI float sigmoidf_(float x) { return __builtin_amdgcn_rcpf(1.0f + __expf(-x)); }

#define XB_TMO      128
#define XB_XCNT(j)  (256  + 64 * (j))
#define XB_XSUB(j)  (1280 + 64 * (j))
#define XB_XGEN(j)  (2304 + 64 * (j))
#define XB_TOP      3328
#define XB_TOPGEN   3392
#define XCD_BAR_WORDS 3456
#define XB_SPIN_CAP (1u << 18)
__device__ __forceinline__ unsigned xb_ld(unsigned* p)              { return __hip_atomic_load(p, __ATOMIC_RELAXED, __HIP_MEMORY_SCOPE_AGENT); }
__device__ __forceinline__ unsigned xb_add(unsigned* p, unsigned v) { return __hip_atomic_fetch_add(p, v, __ATOMIC_RELAXED, __HIP_MEMORY_SCOPE_AGENT); }
__device__ __forceinline__ unsigned xb_xcc_id() { return (unsigned)__builtin_amdgcn_s_getreg((3 << 11) | 20) & 0xFu; }
#define XB_SPIN(cond, bar) do { unsigned _sp = 0; while (cond) { __builtin_amdgcn_s_sleep(1); \
    if ((++_sp & 255u) == 0u) { if (xb_ld(&(bar)[XB_TMO])) break; if (_sp > XB_SPIN_CAP) { atomicAdd(&(bar)[XB_TMO], 1u); break; } } } } while (0)
struct XcdBarrier { unsigned* bar; unsigned x; volatile LAS unsigned* st; };
__device__ __forceinline__ XcdBarrier xcd_barrier_post(unsigned* bar, volatile LAS unsigned* st) {
    XcdBarrier b; b.bar = bar; b.x = xb_xcc_id(); b.st = st;
    if (threadIdx.x == 0) (void)xb_add(&bar[XB_XCNT(b.x)], 1u);
    return b;
}
__device__ __forceinline__ void xcd_barrier_complete(unsigned* bar, unsigned x, unsigned& nloc, unsigned& nx) {
    const unsigned G = gridDim.x * gridDim.y * gridDim.z;
    unsigned sum, cnt, mine, sp = 0u;
    for (;;) {
        sum = 0u; cnt = 0u; mine = 0u;
#pragma unroll
        for (unsigned j = 0; j < 16; ++j) { const unsigned c = xb_ld(&bar[XB_XCNT(j)]); sum += c; cnt += (c > 0u) ? 1u : 0u; mine = (j == x) ? c : mine; }
        if (sum == G) break;
        __builtin_amdgcn_s_sleep(1);
        if ((++sp & 255u) == 0u) { if (xb_ld(&bar[XB_TMO])) break; if (sp > XB_SPIN_CAP) { atomicAdd(&bar[XB_TMO], 1u); break; } }
    }
    nloc = mine > 0u ? mine : 1u; nx = cnt > 0u ? cnt : 1u;
}
__device__ __forceinline__ void xcd_barrier(const XcdBarrier& b) {
    asm volatile("s_waitcnt vmcnt(0)" ::: "memory");
    __syncthreads();
    if (threadIdx.x == 0) {
        unsigned* bar = b.bar;
        __builtin_amdgcn_s_waitcnt(0);
        unsigned nloc = b.st[0], nx = b.st[1];
        if (nloc == 0u) { xcd_barrier_complete(bar, b.x, nloc, nx); b.st[0] = nloc; b.st[1] = nx; }
        const unsigned old = xb_add(&bar[XB_XSUB(b.x)], 1u);
        const unsigned gen = old / nloc;
        if (old + 1u == (gen + 1u) * nloc) {
            __builtin_amdgcn_fence(__ATOMIC_RELEASE, "agent");
            asm volatile("s_waitcnt vmcnt(0)" ::: "memory");
            const unsigned og = xb_add(&bar[XB_TOP], 1u);
            const unsigned tg = og / nx;
            if (og + 1u == (tg + 1u) * nx) xb_add(&bar[XB_TOPGEN], 1u);
            else XB_SPIN(xb_ld(&bar[XB_TOPGEN]) == tg, bar);
            __builtin_amdgcn_fence(__ATOMIC_ACQUIRE, "agent");
            xb_add(&bar[XB_XGEN(b.x)], 1u);
            asm volatile("s_waitcnt vmcnt(0)" ::: "memory");
        } else {
            XB_SPIN(xb_ld(&bar[XB_XGEN(b.x)]) == gen, bar);
            __builtin_amdgcn_fence(__ATOMIC_ACQUIRE, "agent");
            asm volatile("s_waitcnt vmcnt(0)" ::: "memory");
        }
    }
    __syncthreads();
}

namespace pg8 {
constexpr int BM = 256, BK = 64, HALF = 128, HTB = HALF * BK * 2, STAGE_BYTES = 8 * HTB, NXCD = 8, WGM = 8;
__host__ __device__ __forceinline__ int lds_byte(int r, int c) { const int st = (r >> 4) * 2 + (c >> 5), rr = r & 15, cc = c & 31, ob = rr * 64 + cc * 2; return st * 1024 + (ob ^ (((ob >> 9) & 1) << 5)); }
__host__ __device__ __forceinline__ void stage_rc(int b, int& R, int& C) { const int st = b / 1024, sb = b % 1024, swz = sb ^ (((sb >> 9) & 1) << 5); R = (st >> 1) * 16 + swz / 64; C = (st & 1) * 32 + (swz % 64) / 2; }
__host__ __device__ __forceinline__ int perm32(int rho) { const int n = rho >> 4, i = rho & 15; return 8 * (i >> 2) + 4 * n + (i & 3); }

struct Unit { int pm, pn, x0, x1; };

struct TileOrder {
    int nM, nN, nwg, G, c;
    __device__ void init(int nM_, int nN_, int G_, int c_) { nM = nM_; nN = nN_; nwg = nM * nN; G = G_; c = c_; }
    __device__ bool get(int i, int& pm, int& pn) const {
        const long L = (long)i * G + c; if (L >= nwg) return false;
        int wgid = (int)L; { const int q = nwg / NXCD, r = nwg % NXCD, xcd = wgid % NXCD, off = wgid / NXCD; wgid = (xcd < r ? xcd * (q + 1) : r * (q + 1) + (xcd - r) * q) + off; }
        const int nig = WGM * nN, gid = wgid / nig, fm = gid * WGM, gsz = (nM - fm) < WGM ? (nM - fm) : WGM;
        pm = fm + ((wgid % nig) % gsz); pn = (wgid % nig) / gsz; return true;
    }
};

typedef int v8i __attribute__((ext_vector_type(8)));
template <class Epi, class Sched, bool F8 = false>
__device__ __forceinline__ void gemm_phase(LAS unsigned char* lds, const int Kb, const Sched& S, const Epi& E) {
    int tid = threadIdx.x; asm volatile("" : "+v"(tid));
    const int wid = __builtin_amdgcn_readfirstlane(tid >> 6), lane = tid & 63, wr = wid >> 2, wc = wid & 3, fr = lane & 15, fq = lane >> 4;
    const int nt = Kb / 128;
    constexpr bool GA = Sched::GATHER; constexpr int KS = Sched::KSPLIT; constexpr bool ASPLIT = Sched::ASPLIT;
    unsigned voffA[2], voffB[2]; int Rst[2], Cst[2];
#pragma unroll
    for (int i = 0; i < 2; ++i) { int R, C; stage_rc(tid * 16 + i * 8192, R, C); const int Rb = Epi::PERM ? ((R & ~31) + perm32(R & 31)) : R;
        voffA[i] = (unsigned)(R * S.lda + C * 2); voffB[i] = (unsigned)(Rb * S.ldb + C * 2); Rst[i] = R; Cst[i] = C; }
    const size_t kstep = (size_t)(BK * 2);
    const size_t hstepA = (size_t)HALF * S.lda, hstepB = (size_t)HALF * S.ldb;
    const unsigned ldsw = (unsigned)wid * 1024u; const unsigned gmul = (unsigned)S.lda;
    const int aoff = F8 ? (lds_byte(wr * 64 + fr, (fq & 1) * 16) + (fq >> 1) * 1024) : lds_byte(wr * 64 + fr, fq * 8);
    const int boff = F8 ? (lds_byte(wc * 32 + fr, (fq & 1) * 16) + (fq >> 1) * 1024) : lds_byte(wc * 32 + fr, fq * 8);
    unsigned vAc[2], vAn[2];
#define PG8_SA(b, h) (((b) * 2 + (h)) * HTB)
#define PG8_SB(b, h) ((4 + (b) * 2 + (h)) * HTB)
#define PG8_STAGE2(bufoff, gbase, v0, v1) do { \
        __builtin_amdgcn_global_load_lds((const unsigned*)((const char*)(gbase) + (v0)), (LAS unsigned*)(lds + (bufoff) + ldsw), 16, 0, 0); \
        __builtin_amdgcn_global_load_lds((const unsigned*)((const char*)(gbase) + (v1)), (LAS unsigned*)(lds + (bufoff) + ldsw + 8192), 16, 0, 0); } while (0)
#define PG8_STAGE_B(bufoff, ptr, h) PG8_STAGE2(bufoff, (ptr) + (h) * hstepB, voffB[0], voffB[1])
#define PG8_STAGE_A(bufoff, ptr, h, nx) do { if constexpr (GA) { const unsigned _p = (nx) ? vAn[h] : vAc[h]; PG8_STAGE2(bufoff, ptr, (_p & 0xffffu) * gmul + (unsigned)Cst[0] * 2u, (_p >> 16) * gmul + (unsigned)Cst[0] * 2u); } \
        else { PG8_STAGE2(bufoff, (ptr) + (h) * hstepA, voffA[0], voffA[1]); } } while (0)
    typedef int v4i_ __attribute__((ext_vector_type(4)));
#define PG8_LDA(dst, b, h) do { _Pragma("unroll") for (int m = 0; m < 4; ++m) { if constexpr (F8) { dst##8[m].lo = *(const LAS v4i_*)(lds + PG8_SA(b, h) + aoff + m * 2048); dst##8[m].hi = *(const LAS v4i_*)(lds + PG8_SA(b, h) + aoff + m * 2048 + 16); } \
        else { _Pragma("unroll") for (int k = 0; k < 2; ++k) dst[m][k] = *(const LAS bf16x8*)(lds + PG8_SA(b, h) + aoff + m * 2048 + k * 1024); } } } while (0)
#define PG8_LDB(dst, b, h) do { _Pragma("unroll") for (int n = 0; n < 2; ++n) { if constexpr (F8) { dst##8[n].lo = *(const LAS v4i_*)(lds + PG8_SB(b, h) + boff + n * 2048); dst##8[n].hi = *(const LAS v4i_*)(lds + PG8_SB(b, h) + boff + n * 2048 + 16); } \
        else { _Pragma("unroll") for (int k = 0; k < 2; ++k) dst[n][k] = *(const LAS bf16x8*)(lds + PG8_SB(b, h) + boff + n * 2048 + k * 1024); } } } while (0)
#define PG8_MMA(ai, bj, At, Bt) do { __builtin_amdgcn_s_setprio(1); _Pragma("unroll") for (int m = 0; m < 4; ++m) _Pragma("unroll") for (int n = 0; n < 2; ++n) { \
        if constexpr (F8) { asm volatile("v_mfma_scale_f32_16x16x128_f8f6f4 %0, %1, %2, %0, %3, %3 op_sel_hi:[0,0,0]" : "+v"(acc[ai][bj][m][n]) : "v"(Bt##8[n]), "v"(At##8[m]), "v"(f8scale)); } \
        else { _Pragma("unroll") for (int k = 0; k < 2; ++k) acc[ai][bj][m][n] = __builtin_amdgcn_mfma_f32_16x16x32_bf16(Bt[n][k], At[m][k], acc[ai][bj][m][n], 0, 0, 0); } } \
        __builtin_amdgcn_s_setprio(0); } while (0)
#define PG8_WAIT_V(n) asm volatile("s_waitcnt vmcnt(" #n ")" ::: "memory")
#define PG8_WAIT_L(n) asm volatile("s_waitcnt lgkmcnt(" #n ")" ::: "memory")
#define PG8_BAR __builtin_amdgcn_s_barrier()
#define PG8_SCHED __builtin_amdgcn_sched_barrier(0)
#define PG8_GOFF(dst, u) do { if constexpr (GA) { _Pragma("unroll") for (int h = 0; h < 2; ++h) dst[h] = S.a_rowoff(u, Rst[0] + HALF * h) | (S.a_rowoff(u, Rst[0] + 64 + HALF * h) << 16); } } while (0)
    Unit cur, nxt; int ui = 0;
    if (!S.next(0, cur)) return;
    f32x4 acc[2][2][4][2];
#pragma unroll
    for (int a = 0; a < 2; ++a)
#pragma unroll
        for (int b = 0; b < 2; ++b)
#pragma unroll
            for (int m = 0; m < 4; ++m)
#pragma unroll
                for (int n = 0; n < 2; ++n) acc[a][b][m][n] = (f32x4){0.f, 0.f, 0.f, 0.f};
    int f8scale = 0x7F7F7F7F; asm volatile("" : "+v"(f8scale));
    bf16x8 At[4][2], B0[2][2], B1[2][2]; v8i At8[4], B08[2], B18[2];
    const char* cA = S.a_base(cur, 0); const char* cA1 = ASPLIT ? S.a_base(cur, 1) : cA; const char* cB0 = S.b_base(cur, 0); const char* cB1 = KS ? S.b_base(cur, 1) : cB0;
    PG8_GOFF(vAc, cur);
    vAn[0] = vAc[0]; vAn[1] = vAc[1];
    PG8_STAGE_B(PG8_SB(0, 0), cB0, 0); PG8_STAGE_B(PG8_SB(0, 1), cB0, 1); PG8_STAGE_A(PG8_SA(0, 0), cA, 0, false); PG8_STAGE_A(PG8_SA(0, 1), cA, 1, false);
    if (wr == 1) PG8_BAR;
    PG8_WAIT_V(2); PG8_BAR;
    PG8_STAGE_B(PG8_SB(1, 0), cB0 + kstep, 0); PG8_STAGE_A(PG8_SA(1, 0), cA + kstep, 0, false); PG8_STAGE_B(PG8_SB(1, 1), cB0 + kstep, 1);
    PG8_WAIT_V(6); PG8_BAR;
    for (;;) {
        const bool has_next = S.next(ui + 1, nxt);
        const char* nA = has_next ? S.a_base(nxt, 0) : cA; const char* nA1 = (ASPLIT && has_next) ? S.a_base(nxt, 1) : (ASPLIT ? cA1 : nA); const char* nB0 = has_next ? S.b_base(nxt, 0) : cB0; const char* nB1 = (KS && has_next) ? S.b_base(nxt, 1) : (KS ? cB1 : nB0);
        if constexpr (GA) { if (has_next) { PG8_GOFF(vAn, nxt); } }
#pragma unroll 1
        for (int t = 0; t < nt; t += 2) {
            const bool last = (t == nt - 2);
            const char* a1 = (ASPLIT && (t + 1) >= KS) ? cA1 + (size_t)(t + 1 - KS) * kstep : cA + (size_t)(t + 1) * kstep;
            const char* a2 = last ? nA : ((ASPLIT && (t + 2) >= KS) ? cA1 + (size_t)(t + 2 - KS) * kstep : cA + (size_t)(t + 2) * kstep);
            if constexpr (Epi::MID) { if (t == KS) { int fr_ = fr, fq_ = fq; asm volatile("" : "+v"(fr_), "+v"(fq_)); if constexpr (F8) { asm volatile("s_nop 15" ::: "memory"); } E.mid(acc, cur, wr, wc, fr_, fq_); if constexpr (F8) { asm volatile("s_nop 3" ::: "memory"); } } }
            const char* b2 = last ? nB0 : ((KS && (t + 2) >= KS) ? cB1 + (size_t)(t + 2 - KS) * kstep : cB0 + (size_t)(t + 2) * kstep);
            const char* a3 = a2 + kstep; const char* b3 = b2 + kstep;
            PG8_LDB(B0, 0, 0); PG8_LDB(B1, 0, 1); PG8_SCHED; PG8_LDA(At, 0, 0); PG8_STAGE_A(PG8_SA(1, 1), a1, 1, false);
            PG8_WAIT_V(8); PG8_WAIT_L(0); PG8_BAR; PG8_MMA(0, 0, At, B0); PG8_MMA(0, 1, At, B1); PG8_BAR; PG8_SCHED;
            PG8_LDA(At, 0, 1); PG8_STAGE_B(PG8_SB(0, 0), b2, 0); PG8_STAGE_B(PG8_SB(0, 1), b2, 1); PG8_STAGE_A(PG8_SA(0, 0), a2, 0, last);
            PG8_WAIT_V(8); PG8_WAIT_L(0); PG8_BAR; PG8_MMA(1, 0, At, B0); PG8_MMA(1, 1, At, B1); PG8_BAR; PG8_SCHED;
            PG8_LDB(B0, 1, 0); PG8_LDB(B1, 1, 1); PG8_SCHED; PG8_LDA(At, 1, 0); PG8_STAGE_A(PG8_SA(0, 1), a2, 1, last);
            PG8_WAIT_V(8); PG8_WAIT_L(0); PG8_BAR; PG8_MMA(0, 0, At, B0); PG8_MMA(0, 1, At, B1); PG8_BAR; PG8_SCHED;
            PG8_LDA(At, 1, 1); PG8_STAGE_B(PG8_SB(1, 0), b3, 0); PG8_STAGE_B(PG8_SB(1, 1), b3, 1); PG8_STAGE_A(PG8_SA(1, 0), a3, 0, last);
            PG8_WAIT_V(8); PG8_WAIT_L(0); PG8_BAR; PG8_MMA(1, 0, At, B0); PG8_MMA(1, 1, At, B1); PG8_BAR; PG8_SCHED;
        }
        if (wr == 0) PG8_BAR;
        if constexpr (F8) { asm volatile("s_nop 15\n\ts_nop 15" ::: "memory"); }
        { int fr_ = fr, fq_ = fq; asm volatile("" : "+v"(fr_), "+v"(fq_));
          E(acc, cur, wr, wc, fr_, fq_); }
        if (!has_next) break;
#pragma unroll
        for (int a = 0; a < 2; ++a)
#pragma unroll
            for (int b = 0; b < 2; ++b)
#pragma unroll
                for (int m = 0; m < 4; ++m)
#pragma unroll
                    for (int n = 0; n < 2; ++n) acc[a][b][m][n] = (f32x4){0.f, 0.f, 0.f, 0.f};
        cur = nxt; cA = nA; cA1 = nA1; cB0 = nB0; cB1 = nB1; ++ui;
        vAc[0] = vAn[0]; vAc[1] = vAn[1];
        if (wr == 1) PG8_BAR;
    }
    PG8_WAIT_V(0);
    PG8_BAR;
#undef PG8_SA
#undef PG8_SB
#undef PG8_STAGE2
#undef PG8_STAGE_A
#undef PG8_STAGE_B
#undef PG8_LDA
#undef PG8_LDB
#undef PG8_MMA
#undef PG8_WAIT_V
#undef PG8_WAIT_L
#undef PG8_BAR
#undef PG8_SCHED
#undef PG8_GOFF
}
}
using pg8::Unit;


struct Args {
    const float* x; const float* c; const int* pos; const float* ada_w; const float* ada_b; const float* nmw; const float* nfw; const float* w_in;
    const float* b_ig; const float* b_fg; const float* qnw; const float* knw; const float* sinks; const float* conv_w; const float* conv_b; const float* mnw;
    const float* w_au; const float* w_mu; const float* w_out; const float* router_w; const float* router_b; const float* w_gate; const float* w_up; const float* w_down;
    float* out; unsigned char* ws; int ph_lo, ph_hi;
};

__constant__ float c_invf[8] = {1.0f, 0.1939227432012558f, 0.03760603070259094f, 0.007292664609849453f, 0.0014142135623842478f, 0.00027424818836152554f, 5.3182957344688475e-05f, 1.0313385246263351e-05f};

struct DenseSched {
    static constexpr bool GATHER = false, ASPLIT = false; static constexpr int KSPLIT = 0;
    const char* A; const char* Bt; int lda, ldb; pg8::TileOrder ord;
    DI bool next(int i, Unit& u) const { int pm, pn; if (!ord.get(i, pm, pn)) return false; u.pm = pm; u.pn = pn; u.x0 = 0; u.x1 = 0; return true; }
    DI const char* a_base(const Unit& u, int) const { return A + (size_t)u.pm * 256 * lda; }
    DI const char* b_base(const Unit& u, int) const { return Bt + (size_t)u.pn * 256 * ldb; }
    DI unsigned a_rowoff(const Unit&, int) const { return 0u; }
};
struct EpiProj {
    static constexpr bool PERM = true, MID = false;
    bf16* O; float* gates; const float* big; const float* bfg;
    DI void operator()(const f32x4 (&acc)[2][2][4][2], const Unit& u, int wr, int wc, int fr, int fq) const {
        const int row0 = u.pm * 256 + wr * 64 + fr, col0 = u.pn * 256 + wc * 32 + 8 * fq; const bool sg = u.pn >= 9; constexpr float WSC = 1.0f / 64.0f;
        if (u.pn == 19) {
            if (wc == 0 && fq == 0) {
#pragma unroll
                for (int ai = 0; ai < 2; ++ai)
#pragma unroll
                    for (int m = 0; m < 4; ++m) { const int row = row0 + ai * 128 + m * 16; const f32x4 vi = acc[ai][0][m][0], vf = acc[ai][0][m][1]; f32x4 oi, of;
#pragma unroll
                        for (int j = 0; j < 4; ++j) { oi[j] = vi[j] * WSC + big[j]; const float z = vf[j] * WSC + bfg[j]; of[j] = fminf(z, 0.f) - log1pf(__expf(-fabsf(z))); }
                        *(f32x4*)(gates + (size_t)row * 8) = oi; *(f32x4*)(gates + (size_t)row * 8 + 4) = of; } }
            return; }
#pragma unroll
        for (int ai = 0; ai < 2; ++ai)
#pragma unroll
            for (int m = 0; m < 4; ++m) { bf16* rowp = O + (size_t)(row0 + ai * 128 + m * 16) * NPROJ + col0;
#pragma unroll
                for (int bj = 0; bj < 2; ++bj) { f32x4 v0 = acc[ai][bj][m][0] * WSC, v1 = acc[ai][bj][m][1] * WSC;
                    if (sg) {
#pragma unroll
                        for (int j = 0; j < 4; ++j) { v0[j] = sigmoidf_(v0[j]); v1[j] = sigmoidf_(v1[j]); } }
                    v4u w; w.x = cvt_pk_bf16(v0[0], v0[1]); w.y = cvt_pk_bf16(v0[2], v0[3]); w.z = cvt_pk_bf16(v1[0], v1[1]); w.w = cvt_pk_bf16(v1[2], v1[3]);
                    *(v4u*)(rowp + bj * 128) = w; } }
    }
};
struct MergeSched {
    static constexpr bool GATHER = false, ASPLIT = true; static constexpr int KSPLIT = 4;
    const char* A0; const char* A1; const char* B0; const char* B1; int lda, ldb; pg8::TileOrder ord;
    DI bool next(int i, Unit& u) const { int pm, pn; if (!ord.get(i, pm, pn)) return false; u.pm = pm; u.pn = pn; u.x0 = 0; u.x1 = 0; return true; }
    DI const char* a_base(const Unit& u, int half) const { return (half ? A1 : A0) + (size_t)u.pm * 256 * lda; }
    DI const char* b_base(const Unit& u, int half) const { return (half ? B1 : B0) + (size_t)u.pn * 256 * ldb; }
    DI unsigned a_rowoff(const Unit&, int) const { return 0u; }
};
struct EpiMerge {
    static constexpr bool PERM = true, MID = true;
    bf16* P;
    DI void mid(f32x4 (&acc)[2][2][4][2], const Unit& u, int wr, int wc, int fr, int fq) const {
        const int row0 = u.pm * 256 + wr * 64 + fr, col0 = u.pn * 256 + wc * 32 + 8 * fq;
#pragma unroll
        for (int ai = 0; ai < 2; ++ai)
#pragma unroll
            for (int m = 0; m < 4; ++m) { const bf16* rowp = P + (size_t)(row0 + ai * 128 + m * 16) * NPROJ + col0;
#pragma unroll
                for (int bj = 0; bj < 2; ++bj) { const v4u ga = *(const v4u*)(rowp + C_GA + bj * 128), gb = *(const v4u*)(rowp + C_GB + bj * 128);
                    f32x4 r0, r1;
                    r0[0] = bflo(ga.x) * __builtin_amdgcn_rcpf(fmaxf(bflo(gb.x), 1e-30f)); r0[1] = bfhi(ga.x) * __builtin_amdgcn_rcpf(fmaxf(bfhi(gb.x), 1e-30f));
                    r0[2] = bflo(ga.y) * __builtin_amdgcn_rcpf(fmaxf(bflo(gb.y), 1e-30f)); r0[3] = bfhi(ga.y) * __builtin_amdgcn_rcpf(fmaxf(bfhi(gb.y), 1e-30f));
                    r1[0] = bflo(ga.z) * __builtin_amdgcn_rcpf(fmaxf(bflo(gb.z), 1e-30f)); r1[1] = bfhi(ga.z) * __builtin_amdgcn_rcpf(fmaxf(bfhi(gb.z), 1e-30f));
                    r1[2] = bflo(ga.w) * __builtin_amdgcn_rcpf(fmaxf(bflo(gb.w), 1e-30f)); r1[3] = bfhi(ga.w) * __builtin_amdgcn_rcpf(fmaxf(bfhi(gb.w), 1e-30f));
                    acc[ai][bj][m][0] *= r0; acc[ai][bj][m][1] *= r1; } }
    }
    DI void operator()(const f32x4 (&acc)[2][2][4][2], const Unit& u, int wr, int wc, int fr, int fq) const {
        const int row0 = u.pm * 256 + wr * 64 + fr, col0 = u.pn * 256 + wc * 32 + 8 * fq; constexpr float SC = 1.0f / 32.0f;
#pragma unroll
        for (int ai = 0; ai < 2; ++ai)
#pragma unroll
            for (int m = 0; m < 4; ++m) { bf16* rowp = P + (size_t)(row0 + ai * 128 + m * 16) * NPROJ + col0; unsigned char* mp = (unsigned char*)(P + (size_t)(row0 + ai * 128 + m * 16) * NPROJ + C_MQ) + col0;
#pragma unroll
                for (int bj = 0; bj < 2; ++bj) { const f32x4 v0 = acc[ai][bj][m][0] * SC, v1 = acc[ai][bj][m][1] * SC;
                    const v4u g = *(const v4u*)(rowp + C_GB + bj * 128);
                    v2u w; w.x = pk4_fp8(bflo(g.x) * v0[0], bfhi(g.x) * v0[1], bflo(g.y) * v0[2], bfhi(g.y) * v0[3]); w.y = pk4_fp8(bflo(g.z) * v1[0], bfhi(g.z) * v1[1], bflo(g.w) * v1[2], bfhi(g.w) * v1[3]);
                    *(v2u*)(mp + bj * 128) = w; } }
    }
};
struct EpiRes {
    static constexpr bool PERM = false, MID = false;
    const bf16* xin; bf16* out; const float* g; float* ssq; int rmask;
    DI void operator()(const f32x4 (&acc)[2][2][4][2], const Unit& u, int wr, int wc, int fr, int fq) const {
        const int row0 = u.pm * 256 + wr * 64 + fr, col0 = u.pn * 256 + wc * 32 + 4 * fq; const int b = (u.pm * 256) >> 14;
        f32x4 gv[2][2];
#pragma unroll
        for (int bj = 0; bj < 2; ++bj)
#pragma unroll
            for (int n = 0; n < 2; ++n) gv[bj][n] = *(const f32x4*)(g + b * 6144 + col0 + bj * 128 + n * 16);
#pragma unroll
        for (int ai = 0; ai < 2; ++ai)
#pragma unroll
            for (int m = 0; m < 4; ++m) { const size_t off = (size_t)(row0 + ai * 128 + m * 16) * D + col0; const size_t offo = (size_t)((row0 + ai * 128 + m * 16) & rmask) * D + col0; float sq = 0.f;
#pragma unroll
                for (int bj = 0; bj < 2; ++bj)
#pragma unroll
                    for (int n = 0; n < 2; ++n) { const v2u xw = *(const v2u*)(xin + off + bj * 128 + n * 16); const f32x4 xv = {bflo(xw.x), bfhi(xw.x), bflo(xw.y), bfhi(xw.y)}; const f32x4 o = xv + gv[bj][n] * (acc[ai][bj][m][n] * (1.0f / 512.0f));
                        v2u ow; ow.x = cvt_pk_bf16(o.x, o.y); ow.y = cvt_pk_bf16(o.z, o.w); const float r0 = bflo(ow.x), r1 = bfhi(ow.x), r2 = bflo(ow.y), r3 = bfhi(ow.y);
                        sq += (r0 * r0 + r1 * r1) + (r2 * r2 + r3 * r3);
                        *(v2u*)(out + offo + bj * 128 + n * 16) = ow; }
                sq += __shfl_xor(sq, 16); sq += __shfl_xor(sq, 32);
                if (fq == 0) ssq[(size_t)(row0 + ai * 128 + m * 16) * 16 + u.pn * 4 + wc] = sq; }
    }
};

struct MoeTab { const LAS int* tcls; const LAS int* tpos; const LAS int* cnt; int Rtot; };
DI int xcd_remap(int L, int nwg) { const int q = nwg >> 3, r = nwg & 7, xcd = L & 7, off = L >> 3; return (xcd < r ? xcd * (q + 1) : r * (q + 1) + (xcd - r) * q) + off; }
DI void cls_experts(int cls, int& ea, int& eb) { const int g = cls / 6, p = cls - 6 * g; const int a = (p < 3) ? 0 : ((p < 5) ? 1 : 2); const int b = (p < 3) ? (p + 1) : ((p < 5) ? (p - 1) : 3); ea = 4 * g + a; eb = 4 * g + b; }
struct MoeUpSched {
    static constexpr bool GATHER = true, ASPLIT = false; static constexpr int KSPLIT = 0;
    const char* A; const char* W; int lda, ldb; MoeTab tb; int G, c; const LAS unsigned* tokoff;
    DI bool next(int i, Unit& u) const { const int L0 = i * G + c; if (L0 >= tb.Rtot * 8) return false; const int L = xcd_remap(L0, tb.Rtot * 8); u.pm = L >> 3; u.pn = L & 7; u.x0 = i; u.x1 = __builtin_amdgcn_readfirstlane(tb.tcls[u.pm]); return true; }
    DI const char* a_base(const Unit&, int) const { return A; }
    DI const char* b_base(const Unit& u, int) const { int ea, eb; cls_experts(u.x1, ea, eb); const int e = (u.pn < 4) ? ea : eb; return W + ((size_t)e * 1024 + (size_t)(u.pn & 3) * 256) * ldb; }
    DI unsigned a_rowoff(const Unit& u, int r) const { return tokoff[u.x0 * 256 + r]; }
};
struct EpiSwiglu {
    static constexpr bool PERM = true, MID = false;
    unsigned char* H; const float* tgate; const LAS unsigned* tokoff;
    DI void operator()(const f32x4 (&acc)[2][2][4][2], const Unit& u, int wr, int wc, int fr, int fq) const {
        const int r0 = wr * 64 + fr; const int hc = (u.pn >> 2) * 512 + (u.pn & 3) * 128 + wc * 32 + 8 * fq; const int gsel = u.pn >> 2;
#pragma unroll
        for (int ai = 0; ai < 2; ++ai)
#pragma unroll
            for (int m = 0; m < 4; ++m) { const int r = r0 + ai * 128 + m * 16; const unsigned tok = tokoff[u.x0 * 256 + r]; const float rg = tgate[tok * 2 + gsel];
                const f32x4 g0 = acc[ai][0][m][0] * (1.0f / 64.0f), g1 = acc[ai][0][m][1] * (1.0f / 64.0f), u0 = acc[ai][1][m][0] * (1.0f / 64.0f), u1 = acc[ai][1][m][1] * (1.0f / 64.0f);
                float o[8];
#pragma unroll
                for (int j = 0; j < 4; ++j) { o[j] = g0[j] * sigmoidf_(g0[j]) * u0[j] * rg; o[4 + j] = g1[j] * sigmoidf_(g1[j]) * u1[j] * rg; }
#pragma unroll
                for (int j = 0; j < 8; ++j) o[j] = fminf(fmaxf(o[j] * 8.0f, -440.0f), 440.0f);
                v2u w; w.x = pk4_fp8(o[0], o[1], o[2], o[3]); w.y = pk4_fp8(o[4], o[5], o[6], o[7]);
                *(v2u*)(H + ((size_t)u.pm * 256 + r) * 1024 + hc) = w; }
    }
};
struct MoeDownSched {
    static constexpr bool GATHER = false, ASPLIT = false; static constexpr int KSPLIT = 4;
    const char* A; const char* W; int lda, ldb; MoeTab tb; int G, c;
    DI bool next(int i, Unit& u) const { const int L0 = i * G + c; if (L0 >= tb.Rtot * 4) return false; const int L = xcd_remap(L0, tb.Rtot * 4); u.pm = L >> 2; u.pn = L & 3; u.x0 = __builtin_amdgcn_readfirstlane(tb.tpos[u.pm]); u.x1 = __builtin_amdgcn_readfirstlane(tb.tcls[u.pm]); return true; }
    DI const char* a_base(const Unit& u, int) const { return A + (size_t)u.pm * 256 * lda; }
    DI const char* b_base(const Unit& u, int half) const { int ea, eb; cls_experts(u.x1, ea, eb); const int e = half ? eb : ea; return W + ((size_t)e * 1024 + (size_t)u.pn * 256) * ldb; }
    DI unsigned a_rowoff(const Unit&, int) const { return 0u; }
};
struct EpiMoeOut {
    static constexpr bool PERM = false, MID = false;
    const bf16* xin; bf16* outb; float* outf; const float* g; const int* tokl; MoeTab tb; int rmask, last;
    DI void operator()(const f32x4 (&acc)[2][2][4][2], const Unit& u, int wr, int wc, int fr, int fq) const {
        const int r0 = wr * 64 + fr, col0 = u.pn * 256 + wc * 32 + 4 * fq; const int cn = tb.cnt[u.x1];
#pragma unroll
        for (int ai = 0; ai < 2; ++ai)
#pragma unroll
            for (int m = 0; m < 4; ++m) { const int pos = u.x0 + r0 + ai * 128 + m * 16;
                if (pos < cn) { const int tok = tokl[u.x1 * CLS_CAP + pos]; const int b = tok >> 14; const bf16* ip = xin + (size_t)tok * D + col0; bf16* op = outb + (size_t)(tok & rmask) * D + col0; float* of = outf + (size_t)tok * D + col0; const float* gp = g + b * 6144 + col0;
#pragma unroll
                    for (int bj = 0; bj < 2; ++bj)
#pragma unroll
                        for (int n = 0; n < 2; ++n) { const v2u xw = *(const v2u*)(ip + bj * 128 + n * 16); const f32x4 xv = {bflo(xw.x), bfhi(xw.x), bflo(xw.y), bfhi(xw.y)}; const f32x4 gv = *(const f32x4*)(gp + bj * 128 + n * 16);
                            const f32x4 o = xv + gv * (acc[ai][bj][m][n] * (1.0f / 256.0f));
                            if (last) *(f32x4*)(of + bj * 128 + n * 16) = o;
                            else { v2u ow; ow.x = cvt_pk_bf16(o.x, o.y); ow.y = cvt_pk_bf16(o.z, o.w); *(v2u*)(op + bj * 128 + n * 16) = ow; } } } }
    }
};

struct Ctx { LAS unsigned char* lds; int tid, lane, wave, G, bid; };
DI Ctx fresh(const Ctx& X) { Ctx P = X; int t = X.tid; asm volatile("" : "+v"(t)); P.tid = t; P.lane = t & 63; P.wave = __builtin_amdgcn_readfirstlane(t >> 6); return P; }

DI void tr_item(const float* W, int ldw, int K, bf16* WT, int k0, LAS float* scr, int lane) {
    { const int rr = lane >> 3, c4 = lane & 7; f32x4 v[8];
#pragma unroll
      for (int i = 0; i < 8; ++i) v[i] = *(const f32x4*)(W + (size_t)(k0 + rr + 8 * i) * ldw + 4 * c4);
#pragma unroll
      for (int i = 0; i < 8; ++i) { LAS float* d = scr + (rr + 8 * i) * 33 + 4 * c4; d[0] = v[i].x; d[1] = v[i].y; d[2] = v[i].z; d[3] = v[i].w; } }
    LDS_WAIT(); asm volatile("" ::: "memory");
    const int c = lane & 7;
#pragma unroll
    for (int j = 0; j < 4; ++j) { const int n = (lane >> 3) + 8 * j; const LAS float* s = scr + (8 * c) * 33 + n;
        v4u o; o.x = pk2(s[0 * 33], s[1 * 33]); o.y = pk2(s[2 * 33], s[3 * 33]); o.z = pk2(s[4 * 33], s[5 * 33]); o.w = pk2(s[6 * 33], s[7 * 33]);
        *(v4u*)(WT + (size_t)n * K + k0 + 8 * c) = o; }
    LDS_WAIT(); asm volatile("" ::: "memory");
}
DI void tr_item8(const float* W, int ldw, int K, unsigned char* WT, int k0, float scale, LAS float* scr, int lane) {
    { const int rr = lane >> 3, c4 = lane & 7; f32x4 v[8];
#pragma unroll
      for (int i = 0; i < 8; ++i) v[i] = *(const f32x4*)(W + (size_t)(k0 + rr + 8 * i) * ldw + 4 * c4);
#pragma unroll
      for (int i = 0; i < 8; ++i) { LAS float* d = scr + (rr + 8 * i) * 33 + 4 * c4; d[0] = v[i].x; d[1] = v[i].y; d[2] = v[i].z; d[3] = v[i].w; } }
    LDS_WAIT(); asm volatile("" ::: "memory");
    const int c = lane & 7;
#pragma unroll
    for (int j = 0; j < 4; ++j) { const int n = (lane >> 3) + 8 * j; const LAS float* s = scr + (8 * c) * 33 + n;
        v2u o; o.x = pk4_fp8(s[0 * 33] * scale, s[1 * 33] * scale, s[2 * 33] * scale, s[3 * 33] * scale); o.y = pk4_fp8(s[4 * 33] * scale, s[5 * 33] * scale, s[6 * 33] * scale, s[7 * 33] * scale);
        *(v2u*)(WT + (size_t)n * K + k0 + 8 * c) = o; }
    LDS_WAIT(); asm volatile("" ::: "memory");
}
DI void p0_prologue(const Args& a, const Ctx& X) {
    unsigned char* ws = a.ws;
    LAS float* scr = (LAS float*)(X.lds + X.wave * 16384);
    const int gw = X.bid * 8 + X.wave, NGW = X.G * 8;
    constexpr int IT_WIN = 16 * 153, IT_AU = 8 * 32, IT_OUT = 16 * 32, IT_GU = 16 * 16 * 32, IT_DN = 16 * 8 * 32;
    constexpr int IT_L = IT_WIN + 2 * IT_AU + IT_OUT + IT_GU + IT_DN;
    for (int it = gw; it < NL * IT_L; it += NGW) {
        const int l = it / IT_L; int r = it - l * IT_L;
        if (r < IT_WIN) { const int kb = r / 153, nb = r - kb * 153, d0 = 32 * nb, s0 = (nb == 152) ? 2304 : (d0 + (d0 >= 2304 ? 8 : 0));
            tr_item8(a.w_in + (size_t)l * D * DIN_SRC + s0, DIN_SRC, D, (unsigned char*)(ws + WS_WIN) + ((size_t)l * NPROJW + d0) * D, 64 * kb, 64.0f, scr, X.lane); continue; }
        r -= IT_WIN;
        if (r < IT_AU) { const int kb = r >> 5, nb = r & 31;
            tr_item8(a.w_au + (size_t)l * 512 * D + 32 * nb, D, 512, (unsigned char*)(ws + WS_WAU) + ((size_t)l * D + 32 * nb) * 512, 64 * kb, 32.0f, scr, X.lane); continue; }
        r -= IT_AU;
        if (r < IT_AU) { const int kb = r >> 5, nb = r & 31;
            tr_item8(a.w_mu + (size_t)l * 512 * D + 32 * nb, D, 512, (unsigned char*)(ws + WS_WMU) + ((size_t)l * D + 32 * nb) * 512, 64 * kb, 32.0f, scr, X.lane); continue; }
        r -= IT_AU;
        if (r < IT_OUT) { const int kb = r >> 5, nb = r & 31;
            tr_item8(a.w_out + (size_t)l * D * D + 32 * nb, D, D, (unsigned char*)(ws + WS_WOUT) + ((size_t)l * D + 32 * nb) * D, 64 * kb, 64.0f, scr, X.lane); continue; }
        r -= IT_OUT;
        if (r < IT_GU) { const int e = r >> 9, q = r & 511, kb = q >> 5, nb = q & 31, tq = nb >> 3, rb = nb & 7;
            const float* src = ((rb < 4) ? a.w_gate : a.w_up) + ((size_t)(l * NE + e) * D) * FF + 128 * tq + 32 * (rb & 3);
            tr_item8(src, FF, D, (unsigned char*)(ws + WS_WGU) + ((size_t)(l * NE + e) * 1024 + 32 * nb) * D, 64 * kb, 64.0f, scr, X.lane); continue; }
        r -= IT_GU;
        { const int e = r >> 8, q = r & 255, kb = q >> 5, nb = q & 31;
            tr_item8(a.w_down + ((size_t)(l * NE + e) * FF) * D + 32 * nb, D, FF, (unsigned char*)(ws + WS_WD) + ((size_t)(l * NE + e) * 1024 + 32 * nb) * FF, 64 * kb, 32.0f, scr, X.lane); }
    }
    { const float* xs = a.x; bf16* xb = (bf16*)(ws + WS_XB);
      for (size_t i = (size_t)X.bid * 512 + X.tid; i < (size_t)T * D / 8; i += (size_t)X.G * 512) { const f32x4 v0 = *(const f32x4*)(xs + 8 * i), v1 = *(const f32x4*)(xs + 8 * i + 4);
          v4u w; w.x = cvt_pk_bf16(v0.x, v0.y); w.y = cvt_pk_bf16(v0.z, v0.w); w.z = cvt_pk_bf16(v1.x, v1.y); w.w = cvt_pk_bf16(v1.z, v1.w); *(v4u*)(xb + 8 * i) = w; } }
    { float* cs = (float*)(ws + WS_ROPE); float* sn = cs + (size_t)T * 8;
      for (int i = X.bid * 512 + X.tid; i < T * 8; i += X.G * 512) { const int tok = i >> 3, f = i & 7; const float angf = (float)a.pos[tok] * c_invf[f];
          double rev = (double)angf * 0.15915494309189535; rev -= rint(rev); const float rf = (float)rev;
          cs[i] = __builtin_amdgcn_cosf(rf); sn[i] = __builtin_amdgcn_sinf(rf); } }
    __syncthreads();
    LAS float* cact = (LAS float*)X.lds; LAS float* red = (LAS float*)(X.lds + 8192);
    for (int i = X.tid; i < 2048; i += 512) { const float cv = a.c[i]; cact[i] = cv / (1.0f + __expf(-cv)); }
    __syncthreads();
    float* mod = (float*)(ws + WS_MOD);
    for (int it = X.bid; it < NL * 96; it += X.G) { const int l = it / 96, cg = it - l * 96; const int col = cg * 64 + X.lane;
        const float* w = a.ada_w + (size_t)l * D * 6144 + col; float s0 = 0.f, s1 = 0.f;
#pragma unroll 8
        for (int kk = 0; kk < 128; ++kk) { const int k = X.wave * 128 + kk; const float wv = w[(size_t)k * 6144]; s0 += cact[k] * wv; s1 += cact[1024 + k] * wv; }
        red[(X.wave * 2 + 0) * 64 + X.lane] = s0; red[(X.wave * 2 + 1) * 64 + X.lane] = s1;
        __syncthreads();
        if (X.tid < 128) { const int b = X.tid >> 6, ln = X.tid & 63; float s = 0.f;
#pragma unroll
            for (int w8 = 0; w8 < 8; ++w8) s += red[(w8 * 2 + b) * 64 + ln];
            mod[(size_t)(l * 2 + b) * 6144 + cg * 64 + ln] = s + a.ada_b[l * 6144 + cg * 64 + ln]; }
        __syncthreads();
    }
}

DI void p1_norm_gates(const Args& a, const Ctx& X, int l, const bf16* xin) {
    unsigned char* ws = a.ws;
    const float* mod = (const float*)(ws + WS_MOD); unsigned char* hb = (unsigned char*)(ws + WS_H);
    const int gw = X.bid * 8 + X.wave, NGW = X.G * 8;
    for (int rg = gw; rg < T / 16; rg += NGW) {
        const int row0 = rg * 16, b = row0 >> 14;
        const float* mb = mod + (size_t)(l * 2 + b) * 6144;
        f32x4 aw[4], sh[4];
#pragma unroll
        for (int j = 0; j < 4; ++j) { const int k = 256 * j + 4 * X.lane; const f32x4 nw = *(const f32x4*)(a.nmw + l * D + k); const f32x4 sc = *(const f32x4*)(mb + 1024 + k); aw[j] = nw * (sc + 1.0f); sh[j] = *(const f32x4*)(mb + k); }
        v2u pre[4][4];
#pragma unroll
        for (int q = 0; q < 4; ++q) { const v2u* xp = (const v2u*)(xin + (size_t)(row0 + q) * D) + X.lane;
#pragma unroll
            for (int j = 0; j < 4; ++j) pre[q][j] = xp[64 * j]; }
#pragma unroll 1
        for (int rb = 0; rb < 16; rb += 4) {
#pragma unroll
          for (int q = 0; q < 4; ++q) { const int row = row0 + rb + q;
            f32x4 v[4]; float ss = 0.f;
#pragma unroll
            for (int j = 0; j < 4; ++j) { const v2u pw = pre[q][j]; v[j] = (f32x4){bflo(pw.x), bfhi(pw.x), bflo(pw.y), bfhi(pw.y)}; }
            if (rb + 4 < 16) { const v2u* xp = (const v2u*)(xin + (size_t)(row + 4) * D) + X.lane;
#pragma unroll
                for (int j = 0; j < 4; ++j) pre[q][j] = xp[64 * j]; }
#pragma unroll
            for (int j = 0; j < 4; ++j) ss += (v[j].x * v[j].x + v[j].y * v[j].y) + (v[j].z * v[j].z + v[j].w * v[j].w);
            ss = wave_sum(ss); const float rstd = __builtin_amdgcn_rsqf(ss * (1.0f / D) + EPS);
            unsigned* o4 = (unsigned*)(hb + (size_t)row * D) + X.lane;
#pragma unroll
            for (int j = 0; j < 4; ++j) { v[j] = v[j] * rstd * aw[j] + sh[j]; o4[64 * j] = pk4_fp8(v[j].x, v[j].y, v[j].z, v[j].w); }
          }
        }
    }
}

DI void attn_unit(const Args& a, const Ctx& X, int l, int unit) {
    unsigned char* ws = a.ws; const bf16* proj = (const bf16*)(ws + WS_PROJ); unsigned char* ao = (unsigned char*)(ws + WS_H);
    const float* cs = (const float*)(ws + WS_ROPE); const float* sn = cs + (size_t)T * 8;
    const int b = unit >> 8, rem = unit & 255, nb = rem >> 1, kvh = rem & 1; const int tok0 = b * SEQ + nb * 128;
    LAS bf16* Kl = (LAS bf16*)X.lds;
    LAS bf16* VT = (LAS bf16*)(X.lds + 36864);
    int lane = X.lane; asm volatile("" : "+v"(lane));
    const int c16 = lane & 15, quad = lane >> 4;
    v4u nq0, nq1; f32x4 ncs0, ncs1, nsn0, nsn1;
#define AT_PREF(task_) do { const int g_ = (task_) >> 3, tq_ = tok0 + 16 * ((task_) & 7) + c16; const bf16* qp_ = proj + (size_t)tq_ * NPROJ + C_AQ + (kvh * 4 + g_) * 64; \
        nq0 = *(const v4u*)(qp_ + 8 * quad); nq1 = *(const v4u*)(qp_ + 32 + 8 * quad); ncs0 = *(const f32x4*)(cs + (size_t)tq_ * 8); ncs1 = *(const f32x4*)(cs + (size_t)tq_ * 8 + 4); nsn0 = *(const f32x4*)(sn + (size_t)tq_ * 8); nsn1 = *(const f32x4*)(sn + (size_t)tq_ * 8 + 4); } while (0)
    AT_PREF(X.wave);
    float qw[16];
#pragma unroll
    for (int i = 0; i < 8; ++i) { qw[i] = a.qnw[l * 64 + 8 * quad + i]; qw[8 + i] = a.qnw[l * 64 + 32 + 8 * quad + i]; }
    const f32x4 sk4 = *(const f32x4*)(a.sinks + l * 8 + kvh * 4);
    {
        const int row = X.tid >> 1, half = X.tid & 1; const int tokk = tok0 - 128 + row; const bool valid = (nb > 0) || (row >= 128);
        float y[32]; float vv[32];
        if (valid) {
            const v4u* kp = (const v4u*)(proj + (size_t)tokk * NPROJ + C_AK + kvh * 64 + half * 32); const v4u* vp = (const v4u*)(proj + (size_t)tokk * NPROJ + C_AV + kvh * 64 + half * 32);
#pragma unroll
            for (int q = 0; q < 4; ++q) { const v4u kw = kp[q], vw = vp[q];
                y[8 * q + 0] = bflo(kw.x); y[8 * q + 1] = bfhi(kw.x); y[8 * q + 2] = bflo(kw.y); y[8 * q + 3] = bfhi(kw.y); y[8 * q + 4] = bflo(kw.z); y[8 * q + 5] = bfhi(kw.z); y[8 * q + 6] = bflo(kw.w); y[8 * q + 7] = bfhi(kw.w);
                vv[8 * q + 0] = bflo(vw.x); vv[8 * q + 1] = bfhi(vw.x); vv[8 * q + 2] = bflo(vw.y); vv[8 * q + 3] = bfhi(vw.y); vv[8 * q + 4] = bflo(vw.z); vv[8 * q + 5] = bfhi(vw.z); vv[8 * q + 6] = bflo(vw.w); vv[8 * q + 7] = bfhi(vw.w); }
        } else {
#pragma unroll
            for (int i = 0; i < 32; ++i) { y[i] = 0.f; vv[i] = 0.f; } }
        float ss = 0.f;
#pragma unroll
        for (int i = 0; i < 32; ++i) ss += y[i] * y[i];
        ss += __shfl_xor(ss, 1); const float rstd = 1.0f / sqrtf(ss * (1.0f / 64.0f) + EPS);
#pragma unroll
        for (int i = 0; i < 32; ++i) y[i] = y[i] * rstd * a.knw[l * 64 + half * 32 + i];
        if (half == 0 && valid) {
#pragma unroll
            for (int d = 0; d < 8; ++d) { const float c = cs[(size_t)tokk * 8 + d], s = sn[(size_t)tokk * 8 + d]; const float t1 = y[d], t2 = y[d + 8]; y[d] = t1 * c - t2 * s; y[d + 8] = t2 * c + t1 * s; } }
#pragma unroll
        for (int q = 0; q < 4; ++q) { v4u w; w.x = pk2(y[8 * q], y[8 * q + 1]); w.y = pk2(y[8 * q + 2], y[8 * q + 3]); w.z = pk2(y[8 * q + 4], y[8 * q + 5]); w.w = pk2(y[8 * q + 6], y[8 * q + 7]);
            *(LAS v4u*)(Kl + row * 72 + half * 32 + 8 * q) = w; }
#pragma unroll
        for (int i = 0; i < 32; ++i) VT[(half * 32 + i) * 280 + row] = (bf16)f2bf(vv[i]);
        if (X.tid < 64) {
#pragma unroll
            for (int cc = 256; cc < 280; ++cc) VT[X.tid * 280 + cc] = 0; }
    }
    __syncthreads();
#pragma unroll 1
    for (int task = X.wave; task < 32; task += 8) {
        const int g = task >> 3, rg = task & 7, r0 = 16 * rg, head = kvh * 4 + g; const int tokq = tok0 + r0 + c16;
        const float sink = (g == 0) ? sk4.x : ((g == 1) ? sk4.y : ((g == 2) ? sk4.z : sk4.w));
        const v4u w0 = nq0, w1 = nq1; const f32x4 cc0 = ncs0, cc1 = ncs1, ss0 = nsn0, ss1 = nsn1;
        if (task + 8 < 32) { AT_PREF(task + 8); }
        float qv[16];
        qv[0] = bflo(w0.x); qv[1] = bfhi(w0.x); qv[2] = bflo(w0.y); qv[3] = bfhi(w0.y); qv[4] = bflo(w0.z); qv[5] = bfhi(w0.z); qv[6] = bflo(w0.w); qv[7] = bfhi(w0.w);
        qv[8] = bflo(w1.x); qv[9] = bfhi(w1.x); qv[10] = bflo(w1.y); qv[11] = bfhi(w1.y); qv[12] = bflo(w1.z); qv[13] = bfhi(w1.z); qv[14] = bflo(w1.w); qv[15] = bfhi(w1.w);
        float ss = 0.f;
#pragma unroll
        for (int i = 0; i < 16; ++i) ss += qv[i] * qv[i];
        ss += __shfl_xor(ss, 16); ss += __shfl_xor(ss, 32); const float rstd = __builtin_amdgcn_rsqf(ss * (1.0f / 64.0f) + EPS);
#pragma unroll
        for (int i = 0; i < 16; ++i) qv[i] = qv[i] * rstd * qw[i];
        { const float cv[8] = {cc0.x, cc0.y, cc0.z, cc0.w, cc1.x, cc1.y, cc1.z, cc1.w}, sv[8] = {ss0.x, ss0.y, ss0.z, ss0.w, ss1.x, ss1.y, ss1.z, ss1.w};
#pragma unroll
          for (int d = 0; d < 8; ++d) { const float other = __shfl_xor(qv[d], 16);
              if (quad == 0) qv[d] = qv[d] * cv[d] - other * sv[d]; else if (quad == 1) qv[d] = qv[d] * cv[d] + other * sv[d]; } }
        bf16x8 qf[2];
        { v4u w; w.x = pk2m(qv[0], qv[1]); w.y = pk2m(qv[2], qv[3]); w.z = pk2m(qv[4], qv[5]); w.w = pk2m(qv[6], qv[7]); qf[0] = __builtin_bit_cast(bf16x8, w);
          w.x = pk2m(qv[8], qv[9]); w.y = pk2m(qv[10], qv[11]); w.z = pk2m(qv[12], qv[13]); w.w = pk2m(qv[14], qv[15]); qf[1] = __builtin_bit_cast(bf16x8, w); }
        f32x4 sacc[9];
#pragma unroll
        for (int i = 0; i < 9; ++i) { const LAS bf16* kr = Kl + (16 * (rg + i) + c16) * 72 + 8 * quad;
            const bf16x8 k0 = *(const LAS bf16x8*)kr, k1 = *(const LAS bf16x8*)(kr + 32);
            f32x4 z = {0.f, 0.f, 0.f, 0.f}; z = __builtin_amdgcn_mfma_f32_16x16x32_bf16(k0, qf[0], z, 0, 0, 0); sacc[i] = __builtin_amdgcn_mfma_f32_16x16x32_bf16(k1, qf[1], z, 0, 0, 0); }
        int dbase = 4 * quad - c16; asm volatile("" : "+v"(dbase)); int kbase = 16 * rg + 4 * quad; asm volatile("" : "+v"(kbase)); float mx = sink;
#pragma unroll
        for (int i = 0; i < 9; ++i)
#pragma unroll
            for (int j = 0; j < 4; ++j) { const int dlt = dbase + 16 * i + j; const int kj = kbase + 16 * i + j; const bool ok = (dlt > 0) && (dlt <= 128) && ((nb > 0) || (kj >= 128));
                const float s = ok ? sacc[i][j] * 0.125f : -3.0e38f; sacc[i][j] = s; mx = fmaxf(mx, s); }
        mx = fmaxf(mx, __shfl_xor(mx, 16)); mx = fmaxf(mx, __shfl_xor(mx, 32));
        float sum = 0.f;
#pragma unroll
        for (int i = 0; i < 9; ++i)
#pragma unroll
            for (int j = 0; j < 4; ++j) { const float p = (sacc[i][j] > -1.0e38f) ? __expf(sacc[i][j] - mx) : 0.f; sacc[i][j] = p; sum += p; }
        sum += __shfl_xor(sum, 16); sum += __shfl_xor(sum, 32);
        const float inv = 1.0f / (sum + __expf(sink - mx));
        f32x4 oacc[4];
#pragma unroll
        for (int et = 0; et < 4; ++et) oacc[et] = (f32x4){0.f, 0.f, 0.f, 0.f};
#pragma unroll
        for (int kk = 0; kk < 5; ++kk) {
            v4u pw; pw.x = pk2m(sacc[2 * kk][0], sacc[2 * kk][1]); pw.y = pk2m(sacc[2 * kk][2], sacc[2 * kk][3]);
            if (2 * kk + 1 < 9) { pw.z = pk2m(sacc[(2 * kk + 1 < 9) ? 2 * kk + 1 : 0][0], sacc[(2 * kk + 1 < 9) ? 2 * kk + 1 : 0][1]); pw.w = pk2m(sacc[(2 * kk + 1 < 9) ? 2 * kk + 1 : 0][2], sacc[(2 * kk + 1 < 9) ? 2 * kk + 1 : 0][3]); } else { pw.z = 0u; pw.w = 0u; }
            const bf16x8 pf = __builtin_bit_cast(bf16x8, pw);
#pragma unroll
            for (int et = 0; et < 4; ++et) { const LAS bf16* vr = VT + (16 * et + c16) * 280 + 16 * rg + 32 * kk + 4 * quad;
                const v2u lo = *(const LAS v2u*)vr, hi = *(const LAS v2u*)(vr + 16); v4u vw; vw.x = lo.x; vw.y = lo.y; vw.z = hi.x; vw.w = hi.y;
                oacc[et] = __builtin_amdgcn_mfma_f32_16x16x32_bf16(__builtin_bit_cast(bf16x8, vw), pf, oacc[et], 0, 0, 0); }
        }
#pragma unroll
        for (int et = 0; et < 4; ++et) { const float i8 = inv * 8.0f;
            *(unsigned*)(ao + (size_t)tokq * 512 + head * 64 + 16 * et + 4 * quad) = pk4_fp8(oacc[et][0] * i8, oacc[et][1] * i8, oacc[et][2] * i8, oacc[et][3] * i8); }
    }
    __syncthreads();
#undef AT_PREF
}

constexpr int ML_Q = 0, ML_K = 17408, ML_KET = 34816, ML_VT = 53248, ML_CT = 73984, ML_CW = 113152, ML_CB = 118272, ML_RED = 118784, ML_NW = 119296, ML_GT = 119808;
DI float bfw(unsigned w, int hi) { return hi ? bfhi(w) : bflo(w); }
template <bool L3> DI void mlstm_unit(const Args& a, const Ctx& X, int l, int unit) {
    unsigned char* ws = a.ws; const bf16* proj = (const bf16*)(ws + WS_PROJ); unsigned char* hm = (unsigned char*)(ws + WS_H) + (size_t)T * 512;
    bf16* kcb = (bf16*)(ws + WS_KC);
    const float* gates = (const float*)(ws + WS_GATES); float* mlc = (float*)(ws + WS_MLC) + (size_t)unit * 18432; float* mlb = (float*)(ws + WS_MLB);
    const int seq = unit >> 5, sj = unit & 31, b = seq >> 2, hh = seq & 3; const int tokbase = b * SEQ + sj * 512;
    LAS bf16* Qs = (LAS bf16*)(X.lds + ML_Q); LAS bf16* Ks = (LAS bf16*)(X.lds + ML_K); LAS bf16* KET = (LAS bf16*)(X.lds + ML_KET);
    LAS bf16* VT = (LAS bf16*)(X.lds + ML_VT); LAS bf16* CT = (LAS bf16*)(X.lds + ML_CT); LAS float* CW = (LAS float*)(X.lds + ML_CW);
    LAS float* CB = (LAS float*)(X.lds + ML_CB); LAS float* RED = (LAS float*)(X.lds + ML_RED); LAS float* NW = (LAS float*)(X.lds + ML_NW);
    LAS float* GT = (LAS float*)(X.lds + ML_GT);
    int lane = X.lane; asm volatile("" : "+v"(lane));
    const int c16 = lane & 15, quad = lane >> 4, w = X.wave;
    int tidl = X.tid; asm volatile("" : "+v"(tidl));
    const int tg = tidl >> 5, cg = tidl & 31, t0 = 4 * tg, c0 = 4 * cg;
    v2u rq[7], rk[7], rv[4], kcv[4];
#define ML_LBAR() do { asm volatile("s_waitcnt lgkmcnt(0)" ::: "memory"); __builtin_amdgcn_s_barrier(); asm volatile("" ::: "memory"); } while (0)
#define ML_LOADRAW(tokc) do { _Pragma("unroll") for (int j = 0; j < 7; ++j) { const int tt = (tokc) + t0 - 3 + j; const bool ok = tt >= b * SEQ; const bf16* rp = proj + (size_t)(ok ? tt : (tokc)) * NPROJ + hh * 128 + c0; \
        if (L3) { rq[j] = *(const v2u*)(rp + C_MQ); if (!ok) { rq[j].x = 0u; rq[j].y = 0u; } } else { rk[j] = *(const v2u*)(rp + C_MK); if (!ok) { rk[j].x = 0u; rk[j].y = 0u; } } } \
        if (L3) { _Pragma("unroll") for (int i = 0; i < 4; ++i) kcv[i] = *(const v2u*)(kcb + (size_t)((tokc) + t0 + i) * 512 + hh * 128 + c0); } \
        _Pragma("unroll") for (int i = 0; i < 4; ++i) rv[i] = *(const v2u*)(proj + (size_t)((tokc) + t0 + i) * NPROJ + C_MV + hh * 128 + c0); } while (0)
    ML_LOADRAW(tokbase);
    for (int idx = X.tid; idx < 1280; idx += 512) { const int tap = idx >> 8, ch = idx & 255; const int gch = (ch < 128) ? (hh * 128 + ch) : (512 + hh * 128 + (ch - 128));
        CW[idx] = (tap < 4) ? a.conv_w[(size_t)(l * 4 + tap) * 1024 + gch] : a.conv_b[l * 1024 + gch]; }
    for (int idx = X.tid; idx < 16 * 72; idx += 512) VT[128 * 72 + idx] = (idx < 72) ? (bf16)0x3F80 : (bf16)0;
    if (X.tid < 128) NW[X.tid] = a.mnw[l * 512 + hh * 128 + X.tid];
    { const float* gp = gates + (size_t)(tokbase + X.tid) * 8; GT[2 * X.tid] = gp[hh]; GT[2 * X.tid + 1] = gp[4 + hh]; }
    f32x4 cacc[9];
#pragma unroll
    for (int et = 0; et < 9; ++et) {
        if (L3) {
#pragma unroll
            for (int j = 0; j < 4; ++j) { const float v = mlc[(16 * et + 4 * quad + j) * 128 + 16 * w + c16]; cacc[et][j] = v; CT[(16 * et + 4 * quad + j) * 136 + 16 * w + c16] = (bf16)f2bf(v); }
        } else cacc[et] = (f32x4){0.f, 0.f, 0.f, 0.f};
    }
    float bsum = 0.f;
    __syncthreads();
#pragma unroll 1
    for (int c = 0; c < 8; ++c) {
        const int tok0 = tokbase + c * 64;
        const f32x2 gl = *(const LAS f32x2*)(GT + 2 * (c * 64 + lane)); float bsc = gl.y; const float li = gl.x;
#pragma unroll
        for (int o = 1; o < 64; o <<= 1) { const float v = __shfl_up(bsc, o); if (lane >= o) bsc += v; }
        const float bl = __shfl(bsc, 63); const float csv = li - bsc;
        if (w == 0) { CB[lane] = bsc; CB[64 + lane] = csv; }
        bsum += bl;
        const int tt_ = w & 3, eh = w >> 2; const int tq = 16 * tt_ + c16;
        v2u ogv[4];
        if (L3) {
#pragma unroll
            for (int x = 0; x < 4; ++x) ogv[x] = *(const v2u*)(proj + (size_t)(tok0 + tq) * NPROJ + C_MO + hh * 128 + 16 * (4 * eh + x) + 4 * quad); }
        { float fac[4];
#pragma unroll
          for (int i = 0; i < 4; ++i) fac[i] = __expf(bl + __shfl(csv, t0 + i));
#pragma unroll
          for (int qk = (L3 ? 0 : 1); qk < 2; ++qk) {
              float o[4][4];
              if (L3 && qk) {
#pragma unroll
                  for (int i = 0; i < 4; ++i) { o[i][0] = bflo(kcv[i].x); o[i][1] = bfhi(kcv[i].x); o[i][2] = bflo(kcv[i].y); o[i][3] = bfhi(kcv[i].y); }
              } else {
              const f32x4 bias = *(const LAS f32x4*)(CW + 4 * 256 + qk * 128 + c0);
#pragma unroll
              for (int i = 0; i < 4; ++i) { o[i][0] = bias.x; o[i][1] = bias.y; o[i][2] = bias.z; o[i][3] = bias.w; }
#pragma unroll
              for (int j = 0; j < 4; ++j) { const f32x4 wj = *(const LAS f32x4*)(CW + j * 256 + qk * 128 + c0);
#pragma unroll
                  for (int i = 0; i < 4; ++i) { const v2u rr = qk ? rk[i + j] : rq[i + j];
                      o[i][0] += wj.x * bflo(rr.x); o[i][1] += wj.y * bfhi(rr.x); o[i][2] += wj.z * bflo(rr.y); o[i][3] += wj.w * bfhi(rr.y); } }
#pragma unroll
              for (int i = 0; i < 4; ++i)
#pragma unroll
                  for (int ch = 0; ch < 4; ++ch) { const float z = o[i][ch]; o[i][ch] = z * __builtin_amdgcn_rcpf(1.0f + __expf(-z)) * (qk ? 0.08838834764831845f : 1.0f); }
              }
              if (!L3 && qk) {
#pragma unroll
                  for (int i = 0; i < 4; ++i) { v2u pw; pw.x = pk2(o[i][0], o[i][1]); pw.y = pk2(o[i][2], o[i][3]); *(v2u*)(kcb + (size_t)(tok0 + t0 + i) * 512 + hh * 128 + c0) = pw;
                      o[i][0] = bflo(pw.x); o[i][1] = bfhi(pw.x); o[i][2] = bflo(pw.y); o[i][3] = bfhi(pw.y); } }
              if (L3) { LAS bf16* dst = (qk ? Ks : Qs) + t0 * 136 + c0;
#pragma unroll
                  for (int i = 0; i < 4; ++i) { v2u pw; pw.x = pk2(o[i][0], o[i][1]); pw.y = pk2(o[i][2], o[i][3]); *(LAS v2u*)(dst + i * 136) = pw; } }
              if (qk) {
#pragma unroll
                  for (int ch = 0; ch < 4; ++ch) { v2u pw; pw.x = pk2(o[0][ch] * fac[0], o[1][ch] * fac[1]); pw.y = pk2(o[2][ch] * fac[2], o[3][ch] * fac[3]); *(LAS v2u*)(KET + (c0 + ch) * 72 + t0) = pw; } }
          }
          { v2u p0, p1, p2, p3;
            p0.x = (rv[0].x & 0xffffu) | (rv[1].x << 16); p0.y = (rv[2].x & 0xffffu) | (rv[3].x << 16);
            p1.x = (rv[0].x >> 16) | (rv[1].x & 0xffff0000u); p1.y = (rv[2].x >> 16) | (rv[3].x & 0xffff0000u);
            p2.x = (rv[0].y & 0xffffu) | (rv[1].y << 16); p2.y = (rv[2].y & 0xffffu) | (rv[3].y << 16);
            p3.x = (rv[0].y >> 16) | (rv[1].y & 0xffff0000u); p3.y = (rv[2].y >> 16) | (rv[3].y & 0xffff0000u);
            *(LAS v2u*)(VT + (c0 + 0) * 72 + t0) = p0; *(LAS v2u*)(VT + (c0 + 1) * 72 + t0) = p1; *(LAS v2u*)(VT + (c0 + 2) * 72 + t0) = p2; *(LAS v2u*)(VT + (c0 + 3) * 72 + t0) = p3; }
        }
        ML_LBAR();
        if (c < 7) { ML_LOADRAW(tok0 + 64); }
        float hval[4][4];
        if (L3) {
            bf16x8 qf[4];
#pragma unroll
            for (int ks = 0; ks < 4; ++ks) qf[ks] = *(const LAS bf16x8*)(Qs + tq * 136 + 32 * ks + 8 * quad);
            f32x4 sacc[4];
#pragma unroll
            for (int st = 0; st < 4; ++st) { f32x4 z = {0.f, 0.f, 0.f, 0.f};
#pragma unroll
                for (int ks = 0; ks < 4; ++ks) z = __builtin_amdgcn_mfma_f32_16x16x32_bf16(*(const LAS bf16x8*)(Ks + (16 * st + c16) * 136 + 32 * ks + 8 * quad), qf[ks], z, 0, 0, 0);
                sacc[st] = z; }
            const float cbt = CB[tq];
#pragma unroll
            for (int st = 0; st < 4; ++st)
#pragma unroll
                for (int j = 0; j < 4; ++j) { const int s = 16 * st + 4 * quad + j; const float d = (s <= tq) ? __expf(cbt + CB[64 + s]) : 0.f; sacc[st][j] *= d; }
            bf16x8 pf[2];
#pragma unroll
            for (int kk = 0; kk < 2; ++kk) { v4u pw; pw.x = pk2m(sacc[2 * kk][0], sacc[2 * kk][1]); pw.y = pk2m(sacc[2 * kk][2], sacc[2 * kk][3]); pw.z = pk2m(sacc[2 * kk + 1][0], sacc[2 * kk + 1][1]); pw.w = pk2m(sacc[2 * kk + 1][2], sacc[2 * kk + 1][3]); pf[kk] = __builtin_bit_cast(bf16x8, pw); }
            const float ebt = __expf(cbt);
            f32x4 nn[5];
#pragma unroll
            for (int x = 0; x < 5; ++x) { const int et = (x < 4) ? (4 * eh + x) : 8; f32x4 na = {0.f, 0.f, 0.f, 0.f}, ia = {0.f, 0.f, 0.f, 0.f};
#pragma unroll
                for (int kk = 0; kk < 2; ++kk) { const LAS bf16* vr = VT + (16 * et + c16) * 72 + 32 * kk + 4 * quad; const v2u lo = *(const LAS v2u*)vr, hi = *(const LAS v2u*)(vr + 16); v4u vw; vw.x = lo.x; vw.y = lo.y; vw.z = hi.x; vw.w = hi.y;
                    na = __builtin_amdgcn_mfma_f32_16x16x32_bf16(__builtin_bit_cast(bf16x8, vw), pf[kk], na, 0, 0, 0); }
#pragma unroll
                for (int ks = 0; ks < 4; ++ks) ia = __builtin_amdgcn_mfma_f32_16x16x32_bf16(*(const LAS bf16x8*)(CT + (16 * et + c16) * 136 + 32 * ks + 8 * quad), qf[ks], ia, 0, 0, 0);
                nn[x] = na + ia * ebt; }
            const float den = __shfl(nn[4][0], c16); const float inv = 1.0f / fmaxf(fabsf(den), 1.0f);
            float ss = 0.f;
#pragma unroll
            for (int x = 0; x < 4; ++x)
#pragma unroll
                for (int j = 0; j < 4; ++j) { hval[x][j] = nn[x][j] * inv; ss += hval[x][j] * hval[x][j]; }
            ss += __shfl_xor(ss, 16); ss += __shfl_xor(ss, 32);
            if (quad == 0) RED[eh * 64 + tq] = ss;
            ML_LBAR();
            const float rstd = __builtin_amdgcn_rsqf((RED[tq] + RED[64 + tq]) * (1.0f / 128.0f) + EPS);
#pragma unroll
            for (int x = 0; x < 4; ++x) { const int e = 16 * (4 * eh + x) + 4 * quad; const v2u og = ogv[x];
                const float y0 = hval[x][0] * rstd * NW[e] * bflo(og.x), y1 = hval[x][1] * rstd * NW[e + 1] * bfhi(og.x), y2 = hval[x][2] * rstd * NW[e + 2] * bflo(og.y), y3 = hval[x][3] * rstd * NW[e + 3] * bfhi(og.y);
                *(unsigned*)(hm + (size_t)(tok0 + tq) * 512 + hh * 128 + e) = pk4_fp8(y0 * 8.0f, y1 * 8.0f, y2 * 8.0f, y3 * 8.0f); }
        }
        { const float ebl = __expf(bl);
          bf16x8 kf[2];
#pragma unroll
          for (int kk = 0; kk < 2; ++kk) kf[kk] = *(const LAS bf16x8*)(KET + (16 * w + c16) * 72 + 32 * kk + 8 * quad);
#pragma unroll
          for (int et = 0; et < 9; ++et) { f32x4 z = cacc[et] * ebl;
#pragma unroll
              for (int kk = 0; kk < 2; ++kk) z = __builtin_amdgcn_mfma_f32_16x16x32_bf16(*(const LAS bf16x8*)(VT + (16 * et + c16) * 72 + 32 * kk + 8 * quad), kf[kk], z, 0, 0, 0);
              cacc[et] = z;
              if (L3) {
#pragma unroll
                  for (int j = 0; j < 4; ++j) CT[(16 * et + 4 * quad + j) * 136 + 16 * w + c16] = (bf16)f2bf(z[j]); } } }
        ML_LBAR();
    }
#undef ML_LOADRAW
#undef ML_LBAR
    if (!L3) {
#pragma unroll
        for (int et = 0; et < 9; ++et)
#pragma unroll
            for (int j = 0; j < 4; ++j) mlc[(16 * et + 4 * quad + j) * 128 + 16 * w + c16] = cacc[et][j];
        if (X.tid == 0) mlb[unit] = bsum;
    }
}
DI void mlstm_scan(const Args& a, const Ctx& X) {
    float* mlc = (float*)(a.ws + WS_MLC); const float* mlb = (const float*)(a.ws + WS_MLB);
    for (int idx = X.bid * 512 + X.tid; idx < 8 * 18432; idx += X.G * 512) { const int seq = idx / 18432, el = idx - seq * 18432; float carry = 0.f;
        float* p0 = mlc + (size_t)seq * 32 * 18432 + el; float v[32], dcy[32];
#pragma unroll
        for (int j = 0; j < 32; ++j) { v[j] = p0[(size_t)j * 18432]; dcy[j] = mlb[seq * 32 + j]; }
#pragma unroll
        for (int j = 0; j < 32; ++j) { p0[(size_t)j * 18432] = carry; carry = __expf(dcy[j]) * carry + v[j]; } }
}

constexpr int P6_WR = 0, P6_AT = 33024, P6_SH = 37120, P6_LG = 41216, P6_HIST = 65536;
DI void p6_norm_route(const Args& a, const Ctx& X, int l, const bf16* xin) {
    unsigned char* ws = a.ws;
    LAS bf16* wrb = (LAS bf16*)(X.lds + P6_WR);
    LAS float* at = (LAS float*)(X.lds + P6_AT); LAS float* sht = (LAS float*)(X.lds + P6_SH);
    LAS float* lg = (LAS float*)(X.lds + P6_LG) + X.wave * 272;
    for (int idx = X.tid; idx < 16384; idx += 512) { const int k = idx >> 4, e = idx & 15; wrb[e * 1032 + k] = (bf16)f2bf(a.router_w[idx]); }
    const float* mod = (const float*)(ws + WS_MOD); unsigned char* hb = (unsigned char*)(ws + WS_H); float* tgate = (float*)(ws + WS_TGATE); int* tokl = (int*)(ws + WS_TOKL);
    const float* ssq = (const float*)(ws + WS_SSQ);
    unsigned* cnt = (unsigned*)(ws + WS_CTL) + CW_CNT + l * 2048;
    LAS int* hist = (LAS int*)(X.lds + P6_HIST); LAS int* cbase = hist + 32;
    int lane = X.lane; asm volatile("" : "+v"(lane));
    const int r = lane & 15, q = lane >> 4;
    const int gw = X.bid * 8 + X.wave, NGW = X.G * 8;
    for (int it = 0; it * NGW < T / 16; ++it) {
        const int rg = it * NGW + gw; const bool act = rg < T / 16;
        const int row0 = (act ? rg : 0) * 16; const int bb = ((it * NGW + X.bid * 8) * 16) >> 14;
        __syncthreads();
        if (X.tid < 32) hist[X.tid] = 0;
        { const float* mb = mod + (size_t)(l * 2 + (bb < 2 ? bb : 1)) * 6144;
          for (int k = X.tid; k < 1024; k += 512) { at[k] = a.nfw[l * D + k] * (1.0f + mb[4 * 1024 + k]); sht[k] = mb[3 * 1024 + k]; } }
        __syncthreads();
        const int row = row0 + r;
        float rstd;
        { const f32x4 pp = *(const f32x4*)(ssq + (size_t)row * 16 + 4 * q); float ss = (pp.x + pp.y) + (pp.z + pp.w); ss += __shfl_xor(ss, 16); ss += __shfl_xor(ss, 32); rstd = __builtin_amdgcn_rsqf(ss * (1.0f / D) + EPS); }
        const bf16* xr = xin + (size_t)row * D + 8 * q; unsigned char* hr = hb + (size_t)row * D + 8 * q;
        f32x4 acc = {0.f, 0.f, 0.f, 0.f};
#pragma unroll 8
        for (int s = 0; s < 32; ++s) {
            const v4u xw = *(const v4u*)(xr + 32 * s); const f32x4 x0 = {bflo(xw.x), bfhi(xw.x), bflo(xw.y), bfhi(xw.y)}, x1 = {bflo(xw.z), bfhi(xw.z), bflo(xw.w), bfhi(xw.w)};
            const f32x4 a0 = *(const LAS f32x4*)(at + 32 * s + 8 * q), a1 = *(const LAS f32x4*)(at + 32 * s + 8 * q + 4);
            const f32x4 s0 = *(const LAS f32x4*)(sht + 32 * s + 8 * q), s1 = *(const LAS f32x4*)(sht + 32 * s + 8 * q + 4);
            const f32x4 h0 = x0 * rstd * a0 + s0, h1 = x1 * rstd * a1 + s1;
            v4u w; w.x = pk2m(h0.x, h0.y); w.y = pk2m(h0.z, h0.w); w.z = pk2m(h1.x, h1.y); w.w = pk2m(h1.z, h1.w);
            { v2u w8; w8.x = pk4_fp8(h0.x, h0.y, h0.z, h0.w); w8.y = pk4_fp8(h1.x, h1.y, h1.z, h1.w); *(v2u*)(hr + 32 * s) = w8; }
            const bf16x8 bfr = *(const LAS bf16x8*)(wrb + r * 1032 + 32 * s + 8 * q);
            acc = __builtin_amdgcn_mfma_f32_16x16x32_bf16(__builtin_bit_cast(bf16x8, w), bfr, acc, 0, 0, 0);
        }
#pragma unroll
        for (int j = 0; j < 4; ++j) lg[(4 * q + j) * 17 + r] = acc[j];
        LDS_WAIT(); asm volatile("" ::: "memory");
        int my_cls = 0; float my_ga = 0.f, my_gb = 0.f;
        if (lane < 16) {
            float sc[16], sel[16];
#pragma unroll
            for (int e = 0; e < 16; ++e) { const float p = lg[lane * 17 + e]; sc[e] = 1.0f / (1.0f + __expf(-p)); sel[e] = sc[e] + a.router_b[e]; }
            int gi = 0; float gbest = -1.0e30f;
#pragma unroll
            for (int g = 0; g < 4; ++g) { const float p0 = sel[4 * g], p1 = sel[4 * g + 1], p2 = sel[4 * g + 2], p3 = sel[4 * g + 3];
                const float gs = fmaxf(fmaxf(fmaxf(p0 + p1, p0 + p2), fmaxf(p0 + p3, p1 + p2)), fmaxf(p1 + p3, p2 + p3));
                if (gs > gbest) { gbest = gs; gi = g; } }
            float qs[4], s4[4];
#pragma unroll
            for (int i = 0; i < 4; ++i) { qs[i] = 0.f; s4[i] = 0.f; }
#pragma unroll
            for (int g = 0; g < 4; ++g) if (g == gi) {
#pragma unroll
                for (int i = 0; i < 4; ++i) { qs[i] = sel[4 * g + i]; s4[i] = sc[4 * g + i]; } }
            int i1 = 0; float b1 = qs[0];
#pragma unroll
            for (int i = 1; i < 4; ++i) if (qs[i] > b1) { b1 = qs[i]; i1 = i; }
            int i2 = -1; float b2 = -1.0e30f;
#pragma unroll
            for (int i = 0; i < 4; ++i) if (i != i1 && qs[i] > b2) { b2 = qs[i]; i2 = i; }
            const int ia = (i1 < i2) ? i1 : i2, ib = (i1 < i2) ? i2 : i1;
            float sa = 0.f, sb = 0.f;
#pragma unroll
            for (int i = 0; i < 4; ++i) { if (i == ia) sa = s4[i]; if (i == ib) sb = s4[i]; }
            const int pidx = (ia == 0) ? (ib - 1) : ((ia == 1) ? (ib + 1) : 5);
            const float inv = 1.0f / (sa + sb);
            my_cls = gi * 6 + pidx; my_ga = sa * inv; my_gb = sb * inv;
        }
        int rank = 0;
        if (act && lane < 16) rank = __hip_atomic_fetch_add(hist + my_cls, 1, __ATOMIC_RELAXED, __HIP_MEMORY_SCOPE_WORKGROUP);
        __syncthreads();
        if (X.tid < NCLS) { const int n = hist[X.tid]; cbase[X.tid] = n ? (int)__hip_atomic_fetch_add(cnt + 64 * X.tid, (unsigned)n, RLX_AGENT) : 0; }
        __syncthreads();
        if (act && lane < 16) { const int tok = row0 + lane; const int pos = cbase[my_cls] + rank;
            tokl[my_cls * CLS_CAP + pos] = tok; tgate[tok * 2] = my_ga; tgate[tok * 2 + 1] = my_gb; }
    }
}
DI MoeTab moe_tables(const Args& a, const Ctx& X, int l) {
    LAS int* tab = (LAS int*)(X.lds + TAB_OFF); LAS int* tcls = tab; LAS int* tpos = tab + 160; LAS int* cn = tab + 320; LAS int* rt_ = tab + 344;
    unsigned* cnt = (unsigned*)(a.ws + WS_CTL) + CW_CNT + l * 2048;
    if (X.tid < NCLS) cn[X.tid] = (int)__hip_atomic_load(cnt + 64 * X.tid, RLX_AGENT);
    __syncthreads();
    if (X.tid == 0) { int r = 0;
#pragma unroll 1
        for (int c = 0; c < NCLS; ++c) { const int n = (cn[c] + 255) >> 8;
#pragma unroll 1
            for (int i = 0; i < n; ++i) { tcls[r] = c; tpos[r] = i * 256; ++r; } }
        rt_[0] = r; }
    __syncthreads();
    MoeTab tb; tb.tcls = tcls; tb.tpos = tpos; tb.cnt = cn; tb.Rtot = __builtin_amdgcn_readfirstlane(rt_[0]); return tb;
}

#if defined(__HIP_DEVICE_COMPILE__)
DI Args load_args() { auto p = __builtin_amdgcn_kernarg_segment_ptr(); asm volatile("" : "+s"(p)); return *(const __attribute__((address_space(4))) Args*)p; }
#else
DI Args load_args() { return Args{}; }
#endif
__global__ void __launch_bounds__(512, 2) fwd(Args a_unused) {
    extern __shared__ __attribute__((aligned(16))) unsigned char lds_raw[];
    Ctx X; X.lds = (LAS unsigned char*)lds_raw; X.tid = threadIdx.x; X.lane = X.tid & 63; X.wave = __builtin_amdgcn_readfirstlane(X.tid >> 6); X.G = gridDim.x; X.bid = blockIdx.x;
    volatile LAS unsigned* MISC = (volatile LAS unsigned*)(X.lds + MISC_OFF);
    if (X.tid < 64) MISC[X.tid] = 0u;
    __syncthreads();
    int lo, hi; unsigned* ctl;
    { const Args a = load_args(); lo = a.ph_lo; hi = a.ph_hi; ctl = (unsigned*)(a.ws + WS_CTL); }
    XcdBarrier bar; bar.bar = ctl + CW_BAR; bar.x = 0; bar.st = MISC + 8;
    if (hi - lo > 1) bar = xcd_barrier_post(ctl + CW_BAR, MISC + 8);
#ifndef PH_MASK
#define PH_MASK 0xFFFFF
#endif
#define PON(p) ((PH_MASK >> (p)) & 1)
#ifndef DUP_MASK
#define DUP_MASK 0
#endif
#define NREP(p) (((DUP_MASK >> (p)) & 1) ? 2 : 1)
#ifndef TSEL_MASK
#define TSEL_MASK 0
#endif
#define TSCALE 4
#define TSEL(p) ((TSEL_MASK >> (p)) & 1)
#define IN(k) (lo <= (k) && (k) < hi)
#define SEAM(k) do { if (IN(k) && IN((k) + 1)) xcd_barrier(bar); } while (0)
    unsigned long long tacc = 0ull, tph = 0ull;
#define TBEG() do { if (TSEL_MASK) tph = __builtin_amdgcn_s_memrealtime(); } while (0)
#define TEND(p) do { if (TSEL(p)) tacc += __builtin_amdgcn_s_memrealtime() - tph; } while (0)
    TBEG();
    if (PON(10) && IN(0)) { for (int rep = 0; rep < NREP(10); ++rep) { const Args a = load_args(); p0_prologue(a, X); } }
    SEAM(0); TEND(10);
    TBEG();
    for (int l = 0; l < NL; ++l) {
        const int g0 = 1 + l * NPH;
        if (PON(0) && IN(g0 + 0)) { for (int rep = 0; rep < NREP(0); ++rep) { const Args a = load_args(); unsigned char* ws = a.ws; const float* mod = (const float*)(ws + WS_MOD); bf16* proj = (bf16*)(ws + WS_PROJ); bf16* xb = (bf16*)(ws + WS_XB); (void)mod; (void)proj; (void)xb; const Ctx P = fresh(X); p1_norm_gates(a, P, l, xb); } }
        SEAM(g0 + 0); TEND(0); TBEG();
        if (PON(1) && IN(g0 + 1)) for (int rep = 0; rep < NREP(1); ++rep) { const Args a = load_args(); unsigned char* ws = a.ws; const float* mod = (const float*)(ws + WS_MOD); bf16* proj = (bf16*)(ws + WS_PROJ); bf16* xb = (bf16*)(ws + WS_XB); (void)mod; (void)proj; (void)xb; const Ctx P = fresh(X);
            DenseSched S; S.A = (const char*)(ws + WS_H); S.Bt = (const char*)(ws + WS_WIN) + (size_t)l * NPROJW * D; S.lda = D; S.ldb = D; S.ord.init(T / 256, NPROJW / 256, P.G, P.bid);
            EpiProj E; E.O = proj; E.gates = (float*)(ws + WS_GATES); E.big = a.b_ig + l * 4; E.bfg = a.b_fg + l * 4;
            pg8::gemm_phase<EpiProj, DenseSched, true>(P.lds, D, S, E);
        }
        SEAM(g0 + 1); TEND(1); TBEG();
        if (PON(2) && IN(g0 + 2)) { const Args a = load_args(); unsigned char* ws = a.ws; const float* mod = (const float*)(ws + WS_MOD); bf16* proj = (bf16*)(ws + WS_PROJ); bf16* xb = (bf16*)(ws + WS_XB); (void)mod; (void)proj; (void)xb; const Ctx P = fresh(X);
            if (PON(11)) for (int rep = 0; rep < NREP(11); ++rep) {
#pragma unroll 1
                for (int u = P.bid; u < 512; u += P.G) attn_unit(a, P, l, u); }
            if (PON(12)) for (int rep = 0; rep < NREP(12); ++rep) {
#pragma unroll 1
                for (int u = P.bid; u < 256; u += P.G) mlstm_unit<false>(a, P, l, u); }
        }
        SEAM(g0 + 2); TEND(2); TBEG();
        if (PON(3) && IN(g0 + 3)) { const Args a = load_args(); unsigned char* ws = a.ws; const float* mod = (const float*)(ws + WS_MOD); bf16* proj = (bf16*)(ws + WS_PROJ); bf16* xb = (bf16*)(ws + WS_XB); (void)mod; (void)proj; (void)xb; const Ctx P = fresh(X); mlstm_scan(a, P); }
        SEAM(g0 + 3); TEND(3); TBEG();
        if (PON(4) && IN(g0 + 4)) for (int rep = 0; rep < NREP(4); ++rep) { const Args a = load_args(); unsigned char* ws = a.ws; const float* mod = (const float*)(ws + WS_MOD); bf16* proj = (bf16*)(ws + WS_PROJ); bf16* xb = (bf16*)(ws + WS_XB); (void)mod; (void)proj; (void)xb; const Ctx P = fresh(X);
#pragma unroll 1
            for (int u = P.bid; u < 256; u += P.G) mlstm_unit<true>(a, P, l, u); }
        SEAM(g0 + 4); TEND(4); TBEG();
        if (PON(5) && IN(g0 + 5)) for (int rep = 0; rep < NREP(5); ++rep) { const Args a = load_args(); unsigned char* ws = a.ws; const float* mod = (const float*)(ws + WS_MOD); bf16* proj = (bf16*)(ws + WS_PROJ); bf16* xb = (bf16*)(ws + WS_XB); (void)mod; (void)proj; (void)xb; const Ctx P = fresh(X);
            MergeSched S; S.A0 = (const char*)(ws + WS_H); S.A1 = (const char*)(ws + WS_H) + (size_t)T * 512; S.B0 = (const char*)(ws + WS_WAU) + (size_t)l * D * 512; S.B1 = (const char*)(ws + WS_WMU) + (size_t)l * D * 512;
            S.lda = 512; S.ldb = 512; S.ord.init(T / 256, D / 256, P.G, P.bid);
            EpiMerge E; E.P = proj; pg8::gemm_phase<EpiMerge, MergeSched, true>(P.lds, 1024, S, E);
        }
        SEAM(g0 + 5); TEND(5); TBEG();
        if (PON(6) && IN(g0 + 6)) for (int rep = 0; rep < NREP(6); ++rep) { const Args a = load_args(); unsigned char* ws = a.ws; const float* mod = (const float*)(ws + WS_MOD); bf16* proj = (bf16*)(ws + WS_PROJ); bf16* xb = (bf16*)(ws + WS_XB); (void)mod; (void)proj; (void)xb; const Ctx P = fresh(X);
            DenseSched S; S.A = (const char*)(proj + C_MQ); S.Bt = (const char*)(ws + WS_WOUT) + (size_t)l * D * D; S.lda = NPROJ * 2; S.ldb = D; S.ord.init(T / 256, D / 256, P.G, P.bid);
            EpiRes E; E.xin = xb; E.out = xb; E.g = mod + (size_t)(l * 2) * 6144 + 2 * 1024; E.ssq = (float*)(ws + WS_SSQ); E.rmask = T - 1;
            if (rep) { E.out = (bf16*)(ws + WS_H); E.rmask = T / 2 - 1; }
            pg8::gemm_phase<EpiRes, DenseSched, true>(P.lds, D, S, E);
        }
        SEAM(g0 + 6); TEND(6); TBEG();
        if (PON(7) && IN(g0 + 7)) { const Args a = load_args(); unsigned char* ws = a.ws; const float* mod = (const float*)(ws + WS_MOD); bf16* proj = (bf16*)(ws + WS_PROJ); bf16* xb = (bf16*)(ws + WS_XB); (void)mod; (void)proj; (void)xb; const Ctx P = fresh(X); p6_norm_route(a, P, l, xb); }
        SEAM(g0 + 7); TEND(7); TBEG();
        if (PON(8) && IN(g0 + 8)) for (int rep = 0; rep < NREP(8); ++rep) { const Args a = load_args(); unsigned char* ws = a.ws; const float* mod = (const float*)(ws + WS_MOD); bf16* proj = (bf16*)(ws + WS_PROJ); bf16* xb = (bf16*)(ws + WS_XB); (void)mod; (void)proj; (void)xb; const Ctx P = fresh(X);
            const MoeTab tb = moe_tables(a, P, l);
            LAS unsigned* tokoff = (LAS unsigned*)(P.lds + TOKOFF_OFF); const int* tokl = (const int*)(ws + WS_TOKL);
#pragma unroll 1
            for (int s = 0; s < 8; ++s) { const int L0 = s * P.G + P.bid;
                if (L0 < tb.Rtot * 8 && P.tid < 256) { const int L = xcd_remap(L0, tb.Rtot * 8); const int rt = L >> 3, cls = tb.tcls[rt], pos = tb.tpos[rt] + P.tid, cn = tb.cnt[cls]; const int tok = tokl[cls * CLS_CAP + (pos < cn ? pos : 0)]; tokoff[s * 256 + P.tid] = (unsigned)tok; } }
            __syncthreads();
            MoeUpSched S; S.A = (const char*)(ws + WS_H); S.W = (const char*)(ws + WS_WGU) + (size_t)l * NE * 1024 * D; S.lda = D; S.ldb = D; S.tb = tb; S.G = P.G; S.c = P.bid; S.tokoff = tokoff;
            EpiSwiglu E; E.H = (unsigned char*)proj; E.tgate = (const float*)(ws + WS_TGATE); E.tokoff = tokoff;
            pg8::gemm_phase<EpiSwiglu, MoeUpSched, true>(P.lds, D, S, E);
        }
        SEAM(g0 + 8); TEND(8); TBEG();
        if (PON(9) && IN(g0 + 9)) for (int rep = 0; rep < NREP(9); ++rep) { const Args a = load_args(); unsigned char* ws = a.ws; const float* mod = (const float*)(ws + WS_MOD); bf16* proj = (bf16*)(ws + WS_PROJ); bf16* xb = (bf16*)(ws + WS_XB); (void)mod; (void)proj; (void)xb; const Ctx P = fresh(X);
            const MoeTab tb = moe_tables(a, P, l);
            MoeDownSched S; S.A = (const char*)proj; S.W = (const char*)(ws + WS_WD) + (size_t)l * NE * 1024 * FF; S.lda = D; S.ldb = FF; S.tb = tb; S.G = P.G; S.c = P.bid;
            EpiMoeOut E; E.xin = xb; E.outb = xb; E.outf = a.out; E.last = (l == NL - 1); E.g = mod + (size_t)(l * 2) * 6144 + 5 * 1024; E.tokl = (const int*)(ws + WS_TOKL); E.tb = tb; E.rmask = T - 1;
            if (rep) { E.outb = (bf16*)(ws + WS_H); E.last = 0; E.rmask = T / 2 - 1; }
            pg8::gemm_phase<EpiMoeOut, MoeDownSched, true>(P.lds, D, S, E);
        }
        SEAM(g0 + 9); TEND(9); TBEG();
    }
    if (TSEL_MASK && X.bid == 0) { const unsigned long long t1 = __builtin_amdgcn_s_memrealtime(); while (__builtin_amdgcn_s_memrealtime() - t1 < TSCALE * tacc) __builtin_amdgcn_s_sleep(8); }
#undef IN
#undef SEAM
}

extern "C" void kernel_launch(void* const* d_in, const int* in_sizes, int n_in, void* d_out, int out_size, void* d_ws, size_t ws_size, hipStream_t stream) {
    static int grid = 0;
    if (grid == 0) {
        if (n_in != 24 || in_sizes[0] != T * D || out_size != T * D || ws_size < WS_END) { fprintf(stderr, "kernel_launch: unexpected shapes / workspace (n_in %d, ws %zu, need %zu)\n", n_in, ws_size, (size_t)WS_END); grid = -1; return; }
        int dev = 0, cus = 0;
        if (hipGetDevice(&dev) != hipSuccess || hipDeviceGetAttribute(&cus, hipDeviceAttributeMultiprocessorCount, dev) != hipSuccess) { grid = -1; return; }
        if (hipFuncSetAttribute((const void*)fwd, hipFuncAttributeMaxDynamicSharedMemorySize, LDS_BYTES) != hipSuccess) { fprintf(stderr, "kernel_launch: hipFuncSetAttribute failed\n"); grid = -1; return; }
        int per_cu = 0;
        if (hipOccupancyMaxActiveBlocksPerMultiprocessor(&per_cu, (const void*)fwd, 512, LDS_BYTES) != hipSuccess || per_cu < 1) fprintf(stderr, "kernel_launch: occupancy query reports %d\n", per_cu);
        (void)hipGetLastError();
        grid = cus < 256 ? cus : 256;
    }
    if (grid < 0) return;
    (void)hipMemsetAsync((char*)d_ws + WS_CTL, 0, CTL_ZERO_BYTES, stream);
    Args a{};
    a.x = (const float*)d_in[0]; a.c = (const float*)d_in[1]; a.pos = (const int*)d_in[2]; a.ada_w = (const float*)d_in[3]; a.ada_b = (const float*)d_in[4];
    a.nmw = (const float*)d_in[5]; a.nfw = (const float*)d_in[6]; a.w_in = (const float*)d_in[7]; a.b_ig = (const float*)d_in[8]; a.b_fg = (const float*)d_in[9];
    a.qnw = (const float*)d_in[10]; a.knw = (const float*)d_in[11]; a.sinks = (const float*)d_in[12]; a.conv_w = (const float*)d_in[13]; a.conv_b = (const float*)d_in[14];
    a.mnw = (const float*)d_in[15]; a.w_au = (const float*)d_in[16]; a.w_mu = (const float*)d_in[17]; a.w_out = (const float*)d_in[18]; a.router_w = (const float*)d_in[19];
    a.router_b = (const float*)d_in[20]; a.w_gate = (const float*)d_in[21]; a.w_up = (const float*)d_in[22]; a.w_down = (const float*)d_in[23];
    a.out = (float*)d_out; a.ws = (unsigned char*)d_ws;
#if MK_MULTI
    for (int gp = 0; gp < NGP; ++gp) { a.ph_lo = gp; a.ph_hi = gp + 1; hipLaunchKernelGGL(fwd, dim3(grid), dim3(512), LDS_BYTES, stream, a); }
#else
    a.ph_lo = 0; a.ph_hi = NGP; hipLaunchKernelGGL(fwd, dim3(grid), dim3(512), LDS_BYTES, stream, a);
#endif
}
```

```cpp
#include <hip/hip_runtime.h>
#include <cstdio>
#include <cstdint>

#ifndef MK_MULTI
#define MK_MULTI 0
#endif

#define GAS __attribute__((address_space(1)))
#define LAS __attribute__((address_space(3)))
typedef unsigned short bf16;
typedef unsigned v4u __attribute__((ext_vector_type(4)));
typedef unsigned v2u __attribute__((ext_vector_type(2)));
typedef float f32x4 __attribute__((ext_vector_type(4)));
typedef float f32x2 __attribute__((ext_vector_type(2)));
typedef short bf16x8 __attribute__((ext_vector_type(8)));
typedef short bf16x4 __attribute__((ext_vector_type(4)));
#define DI __device__ __forceinline__
#define RLX_AGENT __ATOMIC_RELAXED, __HIP_MEMORY_SCOPE_AGENT
#define LDS_WAIT() asm volatile("s_waitcnt lgkmcnt(0)" ::: "memory")
#define VM_WAIT() asm volatile("s_waitcnt vmcnt(0)" ::: "memory")

constexpr int NB = 2, SEQ = 16384, T = NB * SEQ, D = 1024, NL = 4;
constexpr int DIN_SRC = 4872;
constexpr int NPROJ = 4864;
constexpr int C_AQ = 0, C_AK = 512, C_AV = 640, C_MQ = 768, C_MK = 1280, C_MV = 1792, C_MO = 2304, C_GA = 2816, C_GB = 3840;
constexpr int NE = 16, FF = 512;
constexpr int NCLS = 24, CLS_CAP = 32768;
constexpr float EPS = 1e-6f;
constexpr int NPH = 10;
constexpr int NGP = 1 + NL * NPH;

constexpr size_t MiB = 1u << 20;
constexpr size_t WS_CTL = 0, CTL_ZERO_BYTES = 1 * MiB;
constexpr size_t WS_MOD = 1 * MiB;
constexpr size_t WS_ROPE = 2 * MiB;
constexpr size_t WS_GATES = 4 * MiB;
constexpr size_t WS_TGATE = 5 * MiB;
constexpr size_t WS_TOKL = 6 * MiB;
constexpr size_t WS_MLB = 9 * MiB;
constexpr size_t WS_MLC = 10 * MiB;
constexpr int NPROJW = 5120;
constexpr size_t WS_WIN = 28 * MiB;
constexpr size_t WS_WAU = 68 * MiB;
constexpr size_t WS_WMU = 72 * MiB;
constexpr size_t WS_WOUT = 76 * MiB;
constexpr size_t WS_WGU = 84 * MiB;
constexpr size_t WS_WD = 148 * MiB;
constexpr size_t WS_H = 212 * MiB;
constexpr size_t WS_PROJ = 276 * MiB;
constexpr size_t WS_SSQ = 580 * MiB;
constexpr size_t WS_KC = 582 * MiB;
constexpr size_t WS_XB = 614 * MiB;
constexpr size_t WS_END = 678 * MiB;

constexpr int CW_TMO = 0;
constexpr int CW_BAR = 4096;
constexpr int CW_CNT = 8192;

constexpr int RING_BYTES = 131072;
constexpr int MISC_OFF = RING_BYTES;
constexpr int TAB_OFF = RING_BYTES + 256;
constexpr int TOKOFF_OFF = RING_BYTES + 2048;
constexpr int LDS_BYTES = 147456;

typedef __bf16 bf16x2_t __attribute__((ext_vector_type(2)));
DI unsigned cvt_pk_bf16(float lo, float hi) { const f32x2 v = {lo, hi}; return __builtin_bit_cast(unsigned, __builtin_convertvector(v, bf16x2_t)); }
DI unsigned pk2m(float lo, float hi) { return cvt_pk_bf16(lo, hi); }
DI unsigned f2bf(float f) { return cvt_pk_bf16(f, 0.f) & 0xffffu; }
DI unsigned pk2(float lo, float hi) { return cvt_pk_bf16(lo, hi); }
DI float bf2f(unsigned short b) { return __builtin_bit_cast(float, ((unsigned)b) << 16); }
DI float bflo(unsigned w) { return __builtin_bit_cast(float, w << 16); }
DI float bfhi(unsigned w) { return __builtin_bit_cast(float, w & 0xffff0000u); }
DI float wave_sum(float v) {
#pragma unroll
    for (int o = 1; o < 64; o <<= 1) v += __shfl_xor(v, o);
    return v;
}
DI unsigned pk4_fp8(float a0, float a1, float a2, float a3) { int p = __builtin_amdgcn_cvt_pk_fp8_f32(a0, a1, 0, false); p = __builtin_amdgcn_cvt_pk_fp8_f32(a2, a3, p, true); return (unsigned)p; }
DI float sigmoidf_(float x) { return __builtin_amdgcn_rcpf(1.0f + __expf(-x)); }

#define XB_TMO      128
#define XB_XCNT(j)  (256  + 64 * (j))
#define XB_XSUB(j)  (1280 + 64 * (j))
#define XB_XGEN(j)  (2304 + 64 * (j))
#define XB_TOP      3328
#define XB_TOPGEN   3392
#define XCD_BAR_WORDS 3456
#define XB_SPIN_CAP (1u << 18)
__device__ __forceinline__ unsigned xb_ld(unsigned* p)              { return __hip_atomic_load(p, __ATOMIC_RELAXED, __HIP_MEMORY_SCOPE_AGENT); }
__device__ __forceinline__ unsigned xb_add(unsigned* p, unsigned v) { return __hip_atomic_fetch_add(p, v, __ATOMIC_RELAXED, __HIP_MEMORY_SCOPE_AGENT); }
__device__ __forceinline__ unsigned xb_xcc_id() { return (unsigned)__builtin_amdgcn_s_getreg((3 << 11) | 20) & 0xFu; }
#define XB_SPIN(cond, bar) do { unsigned _sp = 0; while (cond) { __builtin_amdgcn_s_sleep(1); \
    if ((++_sp & 255u) == 0u) { if (xb_ld(&(bar)[XB_TMO])) break; if (_sp > XB_SPIN_CAP) { atomicAdd(&(bar)[XB_TMO], 1u); break; } } } } while (0)
struct XcdBarrier { unsigned* bar; unsigned x; volatile LAS unsigned* st; };
__device__ __forceinline__ XcdBarrier xcd_barrier_post(unsigned* bar, volatile LAS unsigned* st) {
    XcdBarrier b; b.bar = bar; b.x = xb_xcc_id(); b.st = st;
    if (threadIdx.x == 0) (void)xb_add(&bar[XB_XCNT(b.x)], 1u);
    return b;
}
__device__ __forceinline__ void xcd_barrier_complete(unsigned* bar, unsigned x, unsigned& nloc, unsigned& nx) {
    const unsigned G = gridDim.x * gridDim.y * gridDim.z;
    unsigned sum, cnt, mine, sp = 0u;
    for (;;) {
        sum = 0u; cnt = 0u; mine = 0u;
#pragma unroll
        for (unsigned j = 0; j < 16; ++j) { const unsigned c = xb_ld(&bar[XB_XCNT(j)]); sum += c; cnt += (c > 0u) ? 1u : 0u; mine = (j == x) ? c : mine; }
        if (sum == G) break;
        __builtin_amdgcn_s_sleep(1);
        if ((++sp & 255u) == 0u) { if (xb_ld(&bar[XB_TMO])) break; if (sp > XB_SPIN_CAP) { atomicAdd(&bar[XB_TMO], 1u); break; } }
    }
    nloc = mine > 0u ? mine : 1u; nx = cnt > 0u ? cnt : 1u;
}
__device__ __forceinline__ void xcd_barrier(const XcdBarrier& b) {
    asm volatile("s_waitcnt vmcnt(0)" ::: "memory");
    __syncthreads();
    if (threadIdx.x == 0) {
        unsigned* bar = b.bar;
        __builtin_amdgcn_s_waitcnt(0);
        unsigned nloc = b.st[0], nx = b.st[1];
        if (nloc == 0u) { xcd_barrier_complete(bar, b.x, nloc, nx); b.st[0] = nloc; b.st[1] = nx; }
        const unsigned old = xb_add(&bar[XB_XSUB(b.x)], 1u);
        const unsigned gen = old / nloc;
        if (old + 1u == (gen + 1u) * nloc) {
            __builtin_amdgcn_fence(__ATOMIC_RELEASE, "agent");
            asm volatile("s_waitcnt vmcnt(0)" ::: "memory");
            const unsigned og = xb_add(&bar[XB_TOP], 1u);
            const unsigned tg = og / nx;
            if (og + 1u == (tg + 1u) * nx) xb_add(&bar[XB_TOPGEN], 1u);
            else XB_SPIN(xb_ld(&bar[XB_TOPGEN]) == tg, bar);
            __builtin_amdgcn_fence(__ATOMIC_ACQUIRE, "agent");
            xb_add(&bar[XB_XGEN(b.x)], 1u);
            asm volatile("s_waitcnt vmcnt(0)" ::: "memory");
        } else {
            XB_SPIN(xb_ld(&bar[XB_XGEN(b.x)]) == gen, bar);
            __builtin_amdgcn_fence(__ATOMIC_ACQUIRE, "agent");
            asm volatile("s_waitcnt vmcnt(0)" ::: "memory");
        }
    }
    __syncthreads();
}

namespace pg8 {
constexpr int BM = 256, BK = 64, HALF = 128, HTB = HALF * BK * 2, STAGE_BYTES = 8 * HTB, NXCD = 8, WGM = 8;
__host__ __device__ __forceinline__ int lds_byte(int r, int c) { const int st = (r >> 4) * 2 + (c >> 5), rr = r & 15, cc = c & 31, ob = rr * 64 + cc * 2; return st * 1024 + (ob ^ (((ob >> 9) & 1) << 5)); }
__host__ __device__ __forceinline__ void stage_rc(int b, int& R, int& C) { const int st = b / 1024, sb = b % 1024, swz = sb ^ (((sb >> 9) & 1) << 5); R = (st >> 1) * 16 + swz / 64; C = (st & 1) * 32 + (swz % 64) / 2; }
__host__ __device__ __forceinline__ int perm32(int rho) { const int n = rho >> 4, i = rho & 15; return 8 * (i >> 2) + 4 * n + (i & 3); }

struct Unit { int pm, pn, x0, x1; };

struct TileOrder {
    int nM, nN, nwg, G, c;
    __device__ void init(int nM_, int nN_, int G_, int c_) { nM = nM_; nN = nN_; nwg = nM * nN; G = G_; c = c_; }
    __device__ bool get(int i, int& pm, int& pn) const {
        const long L = (long)i * G + c; if (L >= nwg) return false;
        int wgid = (int)L; { const int q = nwg / NXCD, r = nwg % NXCD, xcd = wgid % NXCD, off = wgid / NXCD; wgid = (xcd < r ? xcd * (q + 1) : r * (q + 1) + (xcd - r) * q) + off; }
        const int nig = WGM * nN, gid = wgid / nig, fm = gid * WGM, gsz = (nM - fm) < WGM ? (nM - fm) : WGM;
        pm = fm + ((wgid % nig) % gsz); pn = (wgid % nig) / gsz; return true;
    }
};

typedef int v8i __attribute__((ext_vector_type(8)));
template <class Epi, class Sched, bool F8 = false>
__device__ __forceinline__ void gemm_phase(LAS unsigned char* lds, const int Kb, const Sched& S, const Epi& E) {
    int tid = threadIdx.x; asm volatile("" : "+v"(tid));
    const int wid = __builtin_amdgcn_readfirstlane(tid >> 6), lane = tid & 63, wr = wid >> 2, wc = wid & 3, fr = lane & 15, fq = lane >> 4;
    const int nt = Kb / 128;
    constexpr bool GA = Sched::GATHER; constexpr int KS = Sched::KSPLIT; constexpr bool ASPLIT = Sched::ASPLIT;
    unsigned voffA[2], voffB[2]; int Rst[2], Cst[2];
#pragma unroll
    for (int i = 0; i < 2; ++i) { int R, C; stage_rc(tid * 16 + i * 8192, R, C); const int Rb = Epi::PERM ? ((R & ~31) + perm32(R & 31)) : R;
        voffA[i] = (unsigned)(R * S.lda + C * 2); voffB[i] = (unsigned)(Rb * S.ldb + C * 2); Rst[i] = R; Cst[i] = C; }
    const size_t kstep = (size_t)(BK * 2);
    const size_t hstepA = (size_t)HALF * S.lda, hstepB = (size_t)HALF * S.ldb;
    const unsigned ldsw = (unsigned)wid * 1024u; const unsigned gmul = (unsigned)S.lda;
    const int aoff = F8 ? (lds_byte(wr * 64 + fr, (fq & 1) * 16) + (fq >> 1) * 1024) : lds_byte(wr * 64 + fr, fq * 8);
    const int boff = F8 ? (lds_byte(wc * 32 + fr, (fq & 1) * 16) + (fq >> 1) * 1024) : lds_byte(wc * 32 + fr, fq * 8);
    unsigned vAc[2], vAn[2];
#define PG8_SA(b, h) (((b) * 2 + (h)) * HTB)
#define PG8_SB(b, h) ((4 + (b) * 2 + (h)) * HTB)
#define PG8_STAGE2(bufoff, gbase, v0, v1) do { \
        __builtin_amdgcn_global_load_lds((const unsigned*)((const char*)(gbase) + (v0)), (LAS unsigned*)(lds + (bufoff) + ldsw), 16, 0, 0); \
        __builtin_amdgcn_global_load_lds((const unsigned*)((const char*)(gbase) + (v1)), (LAS unsigned*)(lds + (bufoff) + ldsw + 8192), 16, 0, 0); } while (0)
#define PG8_STAGE_B(bufoff, ptr, h) PG8_STAGE2(bufoff, (ptr) + (h) * hstepB, voffB[0], voffB[1])
#define PG8_STAGE_A(bufoff, ptr, h, nx) do { if constexpr (GA) { const unsigned _p = (nx) ? vAn[h] : vAc[h]; PG8_STAGE2(bufoff, ptr, (_p & 0xffffu) * gmul + (unsigned)Cst[0] * 2u, (_p >> 16) * gmul + (unsigned)Cst[0] * 2u); } \
        else { PG8_STAGE2(bufoff, (ptr) + (h) * hstepA, voffA[0], voffA[1]); } } while (0)
    typedef int v4i_ __attribute__((ext_vector_type(4)));
#define PG8_LDA(dst, b, h) do { _Pragma("unroll") for (int m = 0; m < 4; ++m) { if constexpr (F8) { dst##8[m].lo = *(const LAS v4i_*)(lds + PG8_SA(b, h) + aoff + m * 2048); dst##8[m].hi = *(const LAS v4i_*)(lds + PG8_SA(b, h) + aoff + m * 2048 + 16); } \
        else { _Pragma("unroll") for (int k = 0; k < 2; ++k) dst[m][k] = *(const LAS bf16x8*)(lds + PG8_SA(b, h) + aoff + m * 2048 + k * 1024); } } } while (0)
#define PG8_LDB(dst, b, h) do { _Pragma("unroll") for (int n = 0; n < 2; ++n) { if constexpr (F8) { dst##8[n].lo = *(const LAS v4i_*)(lds + PG8_SB(b, h) + boff + n * 2048); dst##8[n].hi = *(const LAS v4i_*)(lds + PG8_SB(b, h) + boff + n * 2048 + 16); } \
        else { _Pragma("unroll") for (int k = 0; k < 2; ++k) dst[n][k] = *(const LAS bf16x8*)(lds + PG8_SB(b, h) + boff + n * 2048 + k * 1024); } } } while (0)
#define PG8_MMA(ai, bj, At, Bt) do { __builtin_amdgcn_s_setprio(1); _Pragma("unroll") for (int m = 0; m < 4; ++m) _Pragma("unroll") for (int n = 0; n < 2; ++n) { \
        if constexpr (F8) { asm volatile("v_mfma_scale_f32_16x16x128_f8f6f4 %0, %1, %2, %0, %3, %3 op_sel_hi:[0,0,0]" : "+v"(acc[ai][bj][m][n]) : "v"(Bt##8[n]), "v"(At##8[m]), "v"(f8scale)); } \
        else { _Pragma("unroll") for (int k = 0; k < 2; ++k) acc[ai][bj][m][n] = __builtin_amdgcn_mfma_f32_16x16x32_bf16(Bt[n][k], At[m][k], acc[ai][bj][m][n], 0, 0, 0); } } \
        __builtin_amdgcn_s_setprio(0); } while (0)
#define PG8_WAIT_V(n) asm volatile("s_waitcnt vmcnt(" #n ")" ::: "memory")
#define PG8_WAIT_L(n) asm volatile("s_waitcnt lgkmcnt(" #n ")" ::: "memory")
#define PG8_BAR __builtin_amdgcn_s_barrier()
#define PG8_SCHED __builtin_amdgcn_sched_barrier(0)
#define PG8_GOFF(dst, u) do { if constexpr (GA) { _Pragma("unroll") for (int h = 0; h < 2; ++h) dst[h] = S.a_rowoff(u, Rst[0] + HALF * h) | (S.a_rowoff(u, Rst[0] + 64 + HALF * h) << 16); } } while (0)
    Unit cur, nxt; int ui = 0;
    if (!S.next(0, cur)) return;
    f32x4 acc[2][2][4][2];
#pragma unroll
    for (int a = 0; a < 2; ++a)
#pragma unroll
        for (int b = 0; b < 2; ++b)
#pragma unroll
            for (int m = 0; m < 4; ++m)
#pragma unroll
                for (int n = 0; n < 2; ++n) acc[a][b][m][n] = (f32x4){0.f, 0.f, 0.f, 0.f};
    int f8scale = 0x7F7F7F7F; asm volatile("" : "+v"(f8scale));
    bf16x8 At[4][2], B0[2][2], B1[2][2]; v8i At8[4], B08[2], B18[2];
    const char* cA = S.a_base(cur, 0); const char* cA1 = ASPLIT ? S.a_base(cur, 1) : cA; const char* cB0 = S.b_base(cur, 0); const char* cB1 = KS ? S.b_base(cur, 1) : cB0;
    PG8_GOFF(vAc, cur);
    vAn[0] = vAc[0]; vAn[1] = vAc[1];
    PG8_STAGE_B(PG8_SB(0, 0), cB0, 0); PG8_STAGE_B(PG8_SB(0, 1), cB0, 1); PG8_STAGE_A(PG8_SA(0, 0), cA, 0, false); PG8_STAGE_A(PG8_SA(0, 1), cA, 1, false);
    if (wr == 1) PG8_BAR;
    PG8_WAIT_V(2); PG8_BAR;
    PG8_STAGE_B(PG8_SB(1, 0), cB0 + kstep, 0); PG8_STAGE_A(PG8_SA(1, 0), cA + kstep, 0, false); PG8_STAGE_B(PG8_SB(1, 1), cB0 + kstep, 1);
    PG8_WAIT_V(6); PG8_BAR;
    for (;;) {
        const bool has_next = S.next(ui + 1, nxt);
        const char* nA = has_next ? S.a_base(nxt, 0) : cA; const char* nA1 = (ASPLIT && has_next) ? S.a_base(nxt, 1) : (ASPLIT ? cA1 : nA); const char* nB0 = has_next ? S.b_base(nxt, 0) : cB0; const char* nB1 = (KS && has_next) ? S.b_base(nxt, 1) : (KS ? cB1 : nB0);
        if constexpr (GA) { if (has_next) { PG8_GOFF(vAn, nxt); } }
#pragma unroll 1
        for (int t = 0; t < nt; t += 2) {
            const bool last = (t == nt - 2);
            const char* a1 = (ASPLIT && (t + 1) >= KS) ? cA1 + (size_t)(t + 1 - KS) * kstep : cA + (size_t)(t + 1) * kstep;
            const char* a2 = last ? nA : ((ASPLIT && (t + 2) >= KS) ? cA1 + (size_t)(t + 2 - KS) * kstep : cA + (size_t)(t + 2) * kstep);
            if constexpr (Epi::MID) { if (t == KS) { int fr_ = fr, fq_ = fq; asm volatile("" : "+v"(fr_), "+v"(fq_)); if constexpr (F8) { asm volatile("s_nop 15" ::: "memory"); } E.mid(acc, cur, wr, wc, fr_, fq_); if constexpr (F8) { asm volatile("s_nop 3" ::: "memory"); } } }
            const char* b2 = last ? nB0 : ((KS && (t + 2) >= KS) ? cB1 + (size_t)(t + 2 - KS) * kstep : cB0 + (size_t)(t + 2) * kstep);
            const char* a3 = a2 + kstep; const char* b3 = b2 + kstep;
            PG8_LDB(B0, 0, 0); PG8_LDB(B1, 0, 1); PG8_SCHED; PG8_LDA(At, 0, 0); PG8_STAGE_A(PG8_SA(1, 1), a1, 1, false);
            PG8_WAIT_V(8); PG8_WAIT_L(0); PG8_BAR; PG8_MMA(0, 0, At, B0); PG8_MMA(0, 1, At, B1); PG8_BAR; PG8_SCHED;
            PG8_LDA(At, 0, 1); PG8_STAGE_B(PG8_SB(0, 0), b2, 0); PG8_STAGE_B(PG8_SB(0, 1), b2, 1); PG8_STAGE_A(PG8_SA(0, 0), a2, 0, last);
            PG8_WAIT_V(8); PG8_WAIT_L(0); PG8_BAR; PG8_MMA(1, 0, At, B0); PG8_MMA(1, 1, At, B1); PG8_BAR; PG8_SCHED;
            PG8_LDB(B0, 1, 0); PG8_LDB(B1, 1, 1); PG8_SCHED; PG8_LDA(At, 1, 0); PG8_STAGE_A(PG8_SA(0, 1), a2, 1, last);
            PG8_WAIT_V(8); PG8_WAIT_L(0); PG8_BAR; PG8_MMA(0, 0, At, B0); PG8_MMA(0, 1, At, B1); PG8_BAR; PG8_SCHED;
            PG8_LDA(At, 1, 1); PG8_STAGE_B(PG8_SB(1, 0), b3, 0); PG8_STAGE_B(PG8_SB(1, 1), b3, 1); PG8_STAGE_A(PG8_SA(1, 0), a3, 0, last);
            PG8_WAIT_V(8); PG8_WAIT_L(0); PG8_BAR; PG8_MMA(1, 0, At, B0); PG8_MMA(1, 1, At, B1); PG8_BAR; PG8_SCHED;
        }
        if (wr == 0) PG8_BAR;
        if constexpr (F8) { asm volatile("s_nop 15\n\ts_nop 15" ::: "memory"); }
        { int fr_ = fr, fq_ = fq; asm volatile("" : "+v"(fr_), "+v"(fq_));
          E(acc, cur, wr, wc, fr_, fq_); }
        if (!has_next) break;
#pragma unroll
        for (int a = 0; a < 2; ++a)
#pragma unroll
            for (int b = 0; b < 2; ++b)
#pragma unroll
                for (int m = 0; m < 4; ++m)
#pragma unroll
                    for (int n = 0; n < 2; ++n) acc[a][b][m][n] = (f32x4){0.f, 0.f, 0.f, 0.f};
        cur = nxt; cA = nA; cA1 = nA1; cB0 = nB0; cB1 = nB1; ++ui;
        vAc[0] = vAn[0]; vAc[1] = vAn[1];
        if (wr == 1) PG8_BAR;
    }
    PG8_WAIT_V(0);
    PG8_BAR;
#undef PG8_SA
#undef PG8_SB
#undef PG8_STAGE2
#undef PG8_STAGE_A
#undef PG8_STAGE_B
#undef PG8_LDA
#undef PG8_LDB
#undef PG8_MMA
#undef PG8_WAIT_V
#undef PG8_WAIT_L
#undef PG8_BAR
#undef PG8_SCHED
#undef PG8_GOFF
}
}
using pg8::Unit;


struct Args {
    const float* x; const float* c; const int* pos; const float* ada_w; const float* ada_b; const float* nmw; const float* nfw; const float* w_in;
    const float* b_ig; const float* b_fg; const float* qnw; const float* knw; const float* sinks; const float* conv_w; const float* conv_b; const float* mnw;
    const float* w_au; const float* w_mu; const float* w_out; const float* router_w; const float* router_b; const float* w_gate; const float* w_up; const float* w_down;
    float* out; unsigned char* ws; int ph_lo, ph_hi;
};

__constant__ float c_invf[8] = {1.0f, 0.1939227432012558f, 0.03760603070259094f, 0.007292664609849453f, 0.0014142135623842478f, 0.00027424818836152554f, 5.3182957344688475e-05f, 1.0313385246263351e-05f};

struct DenseSched {
    static constexpr bool GATHER = false, ASPLIT = false; static constexpr int KSPLIT = 0;
    const char* A; const char* Bt; int lda, ldb; pg8::TileOrder ord;
    DI bool next(int i, Unit& u) const { int pm, pn; if (!ord.get(i, pm, pn)) return false; u.pm = pm; u.pn = pn; u.x0 = 0; u.x1 = 0; return true; }
    DI const char* a_base(const Unit& u, int) const { return A + (size_t)u.pm * 256 * lda; }
    DI const char* b_base(const Unit& u, int) const { return Bt + (size_t)u.pn * 256 * ldb; }
    DI unsigned a_rowoff(const Unit&, int) const { return 0u; }
};
struct EpiProj {
    static constexpr bool PERM = true, MID = false;
    bf16* O; float* gates; const float* big; const float* bfg;
    DI void operator()(const f32x4 (&acc)[2][2][4][2], const Unit& u, int wr, int wc, int fr, int fq) const {
        const int row0 = u.pm * 256 + wr * 64 + fr, col0 = u.pn * 256 + wc * 32 + 8 * fq; const bool sg = u.pn >= 9; constexpr float WSC = 1.0f / 64.0f;
        if (u.pn == 19) {
            if (wc == 0 && fq == 0) {
#pragma unroll
                for (int ai = 0; ai < 2; ++ai)
#pragma unroll
                    for (int m = 0; m < 4; ++m) { const int row = row0 + ai * 128 + m * 16; const f32x4 vi = acc[ai][0][m][0], vf = acc[ai][0][m][1]; f32x4 oi, of;
#pragma unroll
                        for (int j = 0; j < 4; ++j) { oi[j] = vi[j] * WSC + big[j]; const float z = vf[j] * WSC + bfg[j]; of[j] = fminf(z, 0.f) - log1pf(__expf(-fabsf(z))); }
                        *(f32x4*)(gates + (size_t)row * 8) = oi; *(f32x4*)(gates + (size_t)row * 8 + 4) = of; } }
            return; }
#pragma unroll
        for (int ai = 0; ai < 2; ++ai)
#pragma unroll
            for (int m = 0; m < 4; ++m) { bf16* rowp = O + (size_t)(row0 + ai * 128 + m * 16) * NPROJ + col0;
#pragma unroll
                for (int bj = 0; bj < 2; ++bj) { f32x4 v0 = acc[ai][bj][m][0] * WSC, v1 = acc[ai][bj][m][1] * WSC;
                    if (sg) {
#pragma unroll
                        for (int j = 0; j < 4; ++j) { v0[j] = sigmoidf_(v0[j]); v1[j] = sigmoidf_(v1[j]); } }
                    v4u w; w.x = cvt_pk_bf16(v0[0], v0[1]); w.y = cvt_pk_bf16(v0[2], v0[3]); w.z = cvt_pk_bf16(v1[0], v1[1]); w.w = cvt_pk_bf16(v1[2], v1[3]);
                    *(v4u*)(rowp + bj * 128) = w; } }
    }
};
struct MergeSched {
    static constexpr bool GATHER = false, ASPLIT = true; static constexpr int KSPLIT = 4;
    const char* A0; const char* A1; const char* B0; const char* B1; int lda, ldb; pg8::TileOrder ord;
    DI bool next(int i, Unit& u) const { int pm, pn; if (!ord.get(i, pm, pn)) return false; u.pm = pm; u.pn = pn; u.x0 = 0; u.x1 = 0; return true; }
    DI const char* a_base(const Unit& u, int half) const { return (half ? A1 : A0) + (size_t)u.pm * 256 * lda; }
    DI const char* b_base(const Unit& u, int half) const { return (half ? B1 : B0) + (size_t)u.pn * 256 * ldb; }
    DI unsigned a_rowoff(const Unit&, int) const { return 0u; }
};
struct EpiMerge {
    static constexpr bool PERM = true, MID = true;
    bf16* P;
    DI void mid(f32x4 (&acc)[2][2][4][2], const Unit& u, int wr, int wc, int fr, int fq) const {
        const int row0 = u.pm * 256 + wr * 64 + fr, col0 = u.pn * 256 + wc * 32 + 8 * fq;
#pragma unroll
        for (int ai = 0; ai < 2; ++ai)
#pragma unroll
            for (int m = 0; m < 4; ++m) { const bf16* rowp = P + (size_t)(row0 + ai * 128 + m * 16) * NPROJ + col0;
#pragma unroll
                for (int bj = 0; bj < 2; ++bj) { const v4u ga = *(const v4u*)(rowp + C_GA + bj * 128), gb = *(const v4u*)(rowp + C_GB + bj * 128);
                    f32x4 r0, r1;
                    r0[0] = bflo(ga.x) * __builtin_amdgcn_rcpf(fmaxf(bflo(gb.x), 1e-30f)); r0[1] = bfhi(ga.x) * __builtin_amdgcn_rcpf(fmaxf(bfhi(gb.x), 1e-30f));
                    r0[2] = bflo(ga.y) * __builtin_amdgcn_rcpf(fmaxf(bflo(gb.y), 1e-30f)); r0[3] = bfhi(ga.y) * __builtin_amdgcn_rcpf(fmaxf(bfhi(gb.y), 1e-30f));
                    r1[0] = bflo(ga.z) * __builtin_amdgcn_rcpf(fmaxf(bflo(gb.z), 1e-30f)); r1[1] = bfhi(ga.z) * __builtin_amdgcn_rcpf(fmaxf(bfhi(gb.z), 1e-30f));
                    r1[2] = bflo(ga.w) * __builtin_amdgcn_rcpf(fmaxf(bflo(gb.w), 1e-30f)); r1[3] = bfhi(ga.w) * __builtin_amdgcn_rcpf(fmaxf(bfhi(gb.w), 1e-30f));
                    acc[ai][bj][m][0] *= r0; acc[ai][bj][m][1] *= r1; } }
    }
    DI void operator()(const f32x4 (&acc)[2][2][4][2], const Unit& u, int wr, int wc, int fr, int fq) const {
        const int row0 = u.pm * 256 + wr * 64 + fr, col0 = u.pn * 256 + wc * 32 + 8 * fq; constexpr float SC = 1.0f / 32.0f;
#pragma unroll
        for (int ai = 0; ai < 2; ++ai)
#pragma unroll
            for (int m = 0; m < 4; ++m) { bf16* rowp = P + (size_t)(row0 + ai * 128 + m * 16) * NPROJ + col0; unsigned char* mp = (unsigned char*)(P + (size_t)(row0 + ai * 128 + m * 16) * NPROJ + C_MQ) + col0;
#pragma unroll
                for (int bj = 0; bj < 2; ++bj) { const f32x4 v0 = acc[ai][bj][m][0] * SC, v1 = acc[ai][bj][m][1] * SC;
                    const v4u g = *(const v4u*)(rowp + C_GB + bj * 128);
                    v2u w; w.x = pk4_fp8(bflo(g.x) * v0[0], bfhi(g.x) * v0[1], bflo(g.y) * v0[2], bfhi(g.y) * v0[3]); w.y = pk4_fp8(bflo(g.z) * v1[0], bfhi(g.z) * v1[1], bflo(g.w) * v1[2], bfhi(g.w) * v1[3]);
                    *(v2u*)(mp + bj * 128) = w; } }
    }
};
struct EpiRes {
    static constexpr bool PERM = false, MID = false;
    const bf16* xin; bf16* out; const float* g; float* ssq; int rmask;
    DI void operator()(const f32x4 (&acc)[2][2][4][2], const Unit& u, int wr, int wc, int fr, int fq) const {
        const int row0 = u.pm * 256 + wr * 64 + fr, col0 = u.pn * 256 + wc * 32 + 4 * fq; const int b = (u.pm * 256) >> 14;
        f32x4 gv[2][2];
#pragma unroll
        for (int bj = 0; bj < 2; ++bj)
#pragma unroll
            for (int n = 0; n < 2; ++n) gv[bj][n] = *(const f32x4*)(g + b * 6144 + col0 + bj * 128 + n * 16);
#pragma unroll
        for (int ai = 0; ai < 2; ++ai)
#pragma unroll
            for (int m = 0; m < 4; ++m) { const size_t off = (size_t)(row0 + ai * 128 + m * 16) * D + col0; const size_t offo = (size_t)((row0 + ai * 128 + m * 16) & rmask) * D + col0; float sq = 0.f;
#pragma unroll
                for (int bj = 0; bj < 2; ++bj)
#pragma unroll
                    for (int n = 0; n < 2; ++n) { const v2u xw = *(const v2u*)(xin + off + bj * 128 + n * 16); const f32x4 xv = {bflo(xw.x), bfhi(xw.x), bflo(xw.y), bfhi(xw.y)}; const f32x4 o = xv + gv[bj][n] * (acc[ai][bj][m][n] * (1.0f / 512.0f));
                        v2u ow; ow.x = cvt_pk_bf16(o.x, o.y); ow.y = cvt_pk_bf16(o.z, o.w); const float r0 = bflo(ow.x), r1 = bfhi(ow.x), r2 = bflo(ow.y), r3 = bfhi(ow.y);
                        sq += (r0 * r0 + r1 * r1) + (r2 * r2 + r3 * r3);
                        *(v2u*)(out + offo + bj * 128 + n * 16) = ow; }
                sq += __shfl_xor(sq, 16); sq += __shfl_xor(sq, 32);
                if (fq == 0) ssq[(size_t)(row0 + ai * 128 + m * 16) * 16 + u.pn * 4 + wc] = sq; }
    }
};

struct MoeTab { const LAS int* tcls; const LAS int* tpos; const LAS int* cnt; int Rtot; };
DI int xcd_remap(int L, int nwg) { const int q = nwg >> 3, r = nwg & 7, xcd = L & 7, off = L >> 3; return (xcd < r ? xcd * (q + 1) : r * (q + 1) + (xcd - r) * q) + off; }
DI void cls_experts(int cls, int& ea, int& eb) { const int g = cls / 6, p = cls - 6 * g; const int a = (p < 3) ? 0 : ((p < 5) ? 1 : 2); const int b = (p < 3) ? (p + 1) : ((p < 5) ? (p - 1) : 3); ea = 4 * g + a; eb = 4 * g + b; }
struct MoeUpSched {
    static constexpr bool GATHER = true, ASPLIT = false; static constexpr int KSPLIT = 0;
    const char* A; const char* W; int lda, ldb; MoeTab tb; int G, c; const LAS unsigned* tokoff;
    DI bool next(int i, Unit& u) const { const int L0 = i * G + c; if (L0 >= tb.Rtot * 8) return false; const int L = xcd_remap(L0, tb.Rtot * 8); u.pm = L >> 3; u.pn = L & 7; u.x0 = i; u.x1 = __builtin_amdgcn_readfirstlane(tb.tcls[u.pm]); return true; }
    DI const char* a_base(const Unit&, int) const { return A; }
    DI const char* b_base(const Unit& u, int) const { int ea, eb; cls_experts(u.x1, ea, eb); const int e = (u.pn < 4) ? ea : eb; return W + ((size_t)e * 1024 + (size_t)(u.pn & 3) * 256) * ldb; }
    DI unsigned a_rowoff(const Unit& u, int r) const { return tokoff[u.x0 * 256 + r]; }
};
struct EpiSwiglu {
    static constexpr bool PERM = true, MID = false;
    unsigned char* H; const float* tgate; const LAS unsigned* tokoff;
    DI void operator()(const f32x4 (&acc)[2][2][4][2], const Unit& u, int wr, int wc, int fr, int fq) const {
        const int r0 = wr * 64 + fr; const int hc = (u.pn >> 2) * 512 + (u.pn & 3) * 128 + wc * 32 + 8 * fq; const int gsel = u.pn >> 2;
#pragma unroll
        for (int ai = 0; ai < 2; ++ai)
#pragma unroll
            for (int m = 0; m < 4; ++m) { const int r = r0 + ai * 128 + m * 16; const unsigned tok = tokoff[u.x0 * 256 + r]; const float rg = tgate[tok * 2 + gsel];
                const f32x4 g0 = acc[ai][0][m][0] * (1.0f / 64.0f), g1 = acc[ai][0][m][1] * (1.0f / 64.0f), u0 = acc[ai][1][m][0] * (1.0f / 64.0f), u1 = acc[ai][1][m][1] * (1.0f / 64.0f);
                float o[8];
#pragma unroll
                for (int j = 0; j < 4; ++j) { o[j] = g0[j] * sigmoidf_(g0[j]) * u0[j] * rg; o[4 + j] = g1[j] * sigmoidf_(g1[j]) * u1[j] * rg; }
#pragma unroll
                for (int j = 0; j < 8; ++j) o[j] = fminf(fmaxf(o[j] * 8.0f, -440.0f), 440.0f);
                v2u w; w.x = pk4_fp8(o[0], o[1], o[2], o[3]); w.y = pk4_fp8(o[4], o[5], o[6], o[7]);
                *(v2u*)(H + ((size_t)u.pm * 256 + r) * 1024 + hc) = w; }
    }
};
struct MoeDownSched {
    static constexpr bool GATHER = false, ASPLIT = false; static constexpr int KSPLIT = 4;
    const char* A; const char* W; int lda, ldb; MoeTab tb; int G, c;
    DI bool next(int i, Unit& u) const { const int L0 = i * G + c; if (L0 >= tb.Rtot * 4) return false; const int L = xcd_remap(L0, tb.Rtot * 4); u.pm = L >> 2; u.pn = L & 3; u.x0 = __builtin_amdgcn_readfirstlane(tb.tpos[u.pm]); u.x1 = __builtin_amdgcn_readfirstlane(tb.tcls[u.pm]); return true; }
    DI const char* a_base(const Unit& u, int) const { return A + (size_t)u.pm * 256 * lda; }
    DI const char* b_base(const Unit& u, int half) const { int ea, eb; cls_experts(u.x1, ea, eb); const int e = half ? eb : ea; return W + ((size_t)e * 1024 + (size_t)u.pn * 256) * ldb; }
    DI unsigned a_rowoff(const Unit&, int) const { return 0u; }
};
struct EpiMoeOut {
    static constexpr bool PERM = false, MID = false;
    const bf16* xin; bf16* outb; float* outf; const float* g; const int* tokl; MoeTab tb; int rmask, last;
    DI void operator()(const f32x4 (&acc)[2][2][4][2], const Unit& u, int wr, int wc, int fr, int fq) const {
        const int r0 = wr * 64 + fr, col0 = u.pn * 256 + wc * 32 + 4 * fq; const int cn = tb.cnt[u.x1];
#pragma unroll
        for (int ai = 0; ai < 2; ++ai)
#pragma unroll
            for (int m = 0; m < 4; ++m) { const int pos = u.x0 + r0 + ai * 128 + m * 16;
                if (pos < cn) { const int tok = tokl[u.x1 * CLS_CAP + pos]; const int b = tok >> 14; const bf16* ip = xin + (size_t)tok * D + col0; bf16* op = outb + (size_t)(tok & rmask) * D + col0; float* of = outf + (size_t)tok * D + col0; const float* gp = g + b * 6144 + col0;
#pragma unroll
                    for (int bj = 0; bj < 2; ++bj)
#pragma unroll
                        for (int n = 0; n < 2; ++n) { const v2u xw = *(const v2u*)(ip + bj * 128 + n * 16); const f32x4 xv = {bflo(xw.x), bfhi(xw.x), bflo(xw.y), bfhi(xw.y)}; const f32x4 gv = *(const f32x4*)(gp + bj * 128 + n * 16);
                            const f32x4 o = xv + gv * (acc[ai][bj][m][n] * (1.0f / 256.0f));
                            if (last) *(f32x4*)(of + bj * 128 + n * 16) = o;
                            else { v2u ow; ow.x = cvt_pk_bf16(o.x, o.y); ow.y = cvt_pk_bf16(o.z, o.w); *(v2u*)(op + bj * 128 + n * 16) = ow; } } } }
    }
};

struct Ctx { LAS unsigned char* lds; int tid, lane, wave, G, bid; };
DI Ctx fresh(const Ctx& X) { Ctx P = X; int t = X.tid; asm volatile("" : "+v"(t)); P.tid = t; P.lane = t & 63; P.wave = __builtin_amdgcn_readfirstlane(t >> 6); return P; }

DI void tr_item(const float* W, int ldw, int K, bf16* WT, int k0, LAS float* scr, int lane) {
    { const int rr = lane >> 3, c4 = lane & 7; f32x4 v[8];
#pragma unroll
      for (int i = 0; i < 8; ++i) v[i] = *(const f32x4*)(W + (size_t)(k0 + rr + 8 * i) * ldw + 4 * c4);
#pragma unroll
      for (int i = 0; i < 8; ++i) { LAS float* d = scr + (rr + 8 * i) * 33 + 4 * c4; d[0] = v[i].x; d[1] = v[i].y; d[2] = v[i].z; d[3] = v[i].w; } }
    LDS_WAIT(); asm volatile("" ::: "memory");
    const int c = lane & 7;
#pragma unroll
    for (int j = 0; j < 4; ++j) { const int n = (lane >> 3) + 8 * j; const LAS float* s = scr + (8 * c) * 33 + n;
        v4u o; o.x = pk2(s[0 * 33], s[1 * 33]); o.y = pk2(s[2 * 33], s[3 * 33]); o.z = pk2(s[4 * 33], s[5 * 33]); o.w = pk2(s[6 * 33], s[7 * 33]);
        *(v4u*)(WT + (size_t)n * K + k0 + 8 * c) = o; }
    LDS_WAIT(); asm volatile("" ::: "memory");
}
DI void tr_item8(const float* W, int ldw, int K, unsigned char* WT, int k0, float scale, LAS float* scr, int lane) {
    { const int rr = lane >> 3, c4 = lane & 7; f32x4 v[8];
#pragma unroll
      for (int i = 0; i < 8; ++i) v[i] = *(const f32x4*)(W + (size_t)(k0 + rr + 8 * i) * ldw + 4 * c4);
#pragma unroll
      for (int i = 0; i < 8; ++i) { LAS float* d = scr + (rr + 8 * i) * 33 + 4 * c4; d[0] = v[i].x; d[1] = v[i].y; d[2] = v[i].z; d[3] = v[i].w; } }
    LDS_WAIT(); asm volatile("" ::: "memory");
    const int c = lane & 7;
#pragma unroll
    for (int j = 0; j < 4; ++j) { const int n = (lane >> 3) + 8 * j; const LAS float* s = scr + (8 * c) * 33 + n;
        v2u o; o.x = pk4_fp8(s[0 * 33] * scale, s[1 * 33] * scale, s[2 * 33] * scale, s[3 * 33] * scale); o.y = pk4_fp8(s[4 * 33] * scale, s[5 * 33] * scale, s[6 * 33] * scale, s[7 * 33] * scale);
        *(v2u*)(WT + (size_t)n * K + k0 + 8 * c) = o; }
    LDS_WAIT(); asm volatile("" ::: "memory");
}
DI void p0_prologue(const Args& a, const Ctx& X) {
    unsigned char* ws = a.ws;
    LAS float* scr = (LAS float*)(X.lds + X.wave * 16384);
    const int gw = X.bid * 8 + X.wave, NGW = X.G * 8;
    constexpr int IT_WIN = 16 * 153, IT_AU = 8 * 32, IT_OUT = 16 * 32, IT_GU = 16 * 16 * 32, IT_DN = 16 * 8 * 32;
    constexpr int IT_L = IT_WIN + 2 * IT_AU + IT_OUT + IT_GU + IT_DN;
    for (int it = gw; it < NL * IT_L; it += NGW) {
        const int l = it / IT_L; int r = it - l * IT_L;
        if (r < IT_WIN) { const int kb = r / 153, nb = r - kb * 153, d0 = 32 * nb, s0 = (nb == 152) ? 2304 : (d0 + (d0 >= 2304 ? 8 : 0));
            tr_item8(a.w_in + (size_t)l * D * DIN_SRC + s0, DIN_SRC, D, (unsigned char*)(ws + WS_WIN) + ((size_t)l * NPROJW + d0) * D, 64 * kb, 64.0f, scr, X.lane); continue; }
        r -= IT_WIN;
        if (r < IT_AU) { const int kb = r >> 5, nb = r & 31;
            tr_item8(a.w_au + (size_t)l * 512 * D + 32 * nb, D, 512, (unsigned char*)(ws + WS_WAU) + ((size_t)l * D + 32 * nb) * 512, 64 * kb, 32.0f, scr, X.lane); continue; }
        r -= IT_AU;
        if (r < IT_AU) { const int kb = r >> 5, nb = r & 31;
            tr_item8(a.w_mu + (size_t)l * 512 * D + 32 * nb, D, 512, (unsigned char*)(ws + WS_WMU) + ((size_t)l * D + 32 * nb) * 512, 64 * kb, 32.0f, scr, X.lane); continue; }
        r -= IT_AU;
        if (r < IT_OUT) { const int kb = r >> 5, nb = r & 31;
            tr_item8(a.w_out + (size_t)l * D * D + 32 * nb, D, D, (unsigned char*)(ws + WS_WOUT) + ((size_t)l * D + 32 * nb) * D, 64 * kb, 64.0f, scr, X.lane); continue; }
        r -= IT_OUT;
        if (r < IT_GU) { const int e = r >> 9, q = r & 511, kb = q >> 5, nb = q & 31, tq = nb >> 3, rb = nb & 7;
            const float* src = ((rb < 4) ? a.w_gate : a.w_up) + ((size_t)(l * NE + e) * D) * FF + 128 * tq + 32 * (rb & 3);
            tr_item8(src, FF, D, (unsigned char*)(ws + WS_WGU) + ((size_t)(l * NE + e) * 1024 + 32 * nb) * D, 64 * kb, 64.0f, scr, X.lane); continue; }
        r -= IT_GU;
        { const int e = r >> 8, q = r & 255, kb = q >> 5, nb = q & 31;
            tr_item8(a.w_down + ((size_t)(l * NE + e) * FF) * D + 32 * nb, D, FF, (unsigned char*)(ws + WS_WD) + ((size_t)(l * NE + e) * 1024 + 32 * nb) * FF, 64 * kb, 32.0f, scr, X.lane); }
    }
    { const float* xs = a.x; bf16* xb = (bf16*)(ws + WS_XB);
      for (size_t i = (size_t)X.bid * 512 + X.tid; i < (size_t)T * D / 8; i += (size_t)X.G * 512) { const f32x4 v0 = *(const f32x4*)(xs + 8 * i), v1 = *(const f32x4*)(xs + 8 * i + 4);
          v4u w; w.x = cvt_pk_bf16(v0.x, v0.y); w.y = cvt_pk_bf16(v0.z, v0.w); w.z = cvt_pk_bf16(v1.x, v1.y); w.w = cvt_pk_bf16(v1.z, v1.w); *(v4u*)(xb + 8 * i) = w; } }
    { float* cs = (float*)(ws + WS_ROPE); float* sn = cs + (size_t)T * 8;
      for (int i = X.bid * 512 + X.tid; i < T * 8; i += X.G * 512) { const int tok = i >> 3, f = i & 7; const float angf = (float)a.pos[tok] * c_invf[f];
          double rev = (double)angf * 0.15915494309189535; rev -= rint(rev); const float rf = (float)rev;
          cs[i] = __builtin_amdgcn_cosf(rf); sn[i] = __builtin_amdgcn_sinf(rf); } }
    __syncthreads();
    LAS float* cact = (LAS float*)X.lds; LAS float* red = (LAS float*)(X.lds + 8192);
    for (int i = X.tid; i < 2048; i += 512) { const float cv = a.c[i]; cact[i] = cv / (1.0f + __expf(-cv)); }
    __syncthreads();
    float* mod = (float*)(ws + WS_MOD);
    for (int it = X.bid; it < NL * 96; it += X.G) { const int l = it / 96, cg = it - l * 96; const int col = cg * 64 + X.lane;
        const float* w = a.ada_w + (size_t)l * D * 6144 + col; float s0 = 0.f, s1 = 0.f;
#pragma unroll 8
        for (int kk = 0; kk < 128; ++kk) { const int k = X.wave * 128 + kk; const float wv = w[(size_t)k * 6144]; s0 += cact[k] * wv; s1 += cact[1024 + k] * wv; }
        red[(X.wave * 2 + 0) * 64 + X.lane] = s0; red[(X.wave * 2 + 1) * 64 + X.lane] = s1;
        __syncthreads();
        if (X.tid < 128) { const int b = X.tid >> 6, ln = X.tid & 63; float s = 0.f;
#pragma unroll
            for (int w8 = 0; w8 < 8; ++w8) s += red[(w8 * 2 + b) * 64 + ln];
            mod[(size_t)(l * 2 + b) * 6144 + cg * 64 + ln] = s + a.ada_b[l * 6144 + cg * 64 + ln]; }
        __syncthreads();
    }
}

DI void p1_norm_gates(const Args& a, const Ctx& X, int l, const bf16* xin) {
    unsigned char* ws = a.ws;
    const float* mod = (const float*)(ws + WS_MOD); unsigned char* hb = (unsigned char*)(ws + WS_H);
    const int gw = X.bid * 8 + X.wave, NGW = X.G * 8;
    for (int rg = gw; rg < T / 16; rg += NGW) {
        const int row0 = rg * 16, b = row0 >> 14;
        const float* mb = mod + (size_t)(l * 2 + b) * 6144;
        f32x4 aw[4], sh[4];
#pragma unroll
        for (int j = 0; j < 4; ++j) { const int k = 256 * j + 4 * X.lane; const f32x4 nw = *(const f32x4*)(a.nmw + l * D + k); const f32x4 sc = *(const f32x4*)(mb + 1024 + k); aw[j] = nw * (sc + 1.0f); sh[j] = *(const f32x4*)(mb + k); }
        v2u pre[4][4];
#pragma unroll
        for (int q = 0; q < 4; ++q) { const v2u* xp = (const v2u*)(xin + (size_t)(row0 + q) * D) + X.lane;
#pragma unroll
            for (int j = 0; j < 4; ++j) pre[q][j] = xp[64 * j]; }
#pragma unroll 1
        for (int rb = 0; rb < 16; rb += 4) {
#pragma unroll
          for (int q = 0; q < 4; ++q) { const int row = row0 + rb + q;
            f32x4 v[4]; float ss = 0.f;
#pragma unroll
            for (int j = 0; j < 4; ++j) { const v2u pw = pre[q][j]; v[j] = (f32x4){bflo(pw.x), bfhi(pw.x), bflo(pw.y), bfhi(pw.y)}; }
            if (rb + 4 < 16) { const v2u* xp = (const v2u*)(xin + (size_t)(row + 4) * D) + X.lane;
#pragma unroll
                for (int j = 0; j < 4; ++j) pre[q][j] = xp[64 * j]; }
#pragma unroll
            for (int j = 0; j < 4; ++j) ss += (v[j].x * v[j].x + v[j].y * v[j].y) + (v[j].z * v[j].z + v[j].w * v[j].w);
            ss = wave_sum(ss); const float rstd = __builtin_amdgcn_rsqf(ss * (1.0f / D) + EPS);
            unsigned* o4 = (unsigned*)(hb + (size_t)row * D) + X.lane;
#pragma unroll
            for (int j = 0; j < 4; ++j) { v[j] = v[j] * rstd * aw[j] + sh[j]; o4[64 * j] = pk4_fp8(v[j].x, v[j].y, v[j].z, v[j].w); }
          }
        }
    }
}

DI void attn_unit(const Args& a, const Ctx& X, int l, int unit) {
    unsigned char* ws = a.ws; const bf16* proj = (const bf16*)(ws + WS_PROJ); unsigned char* ao = (unsigned char*)(ws + WS_H);
    const float* cs = (const float*)(ws + WS_ROPE); const float* sn = cs + (size_t)T * 8;
    const int b = unit >> 8, rem = unit & 255, nb = rem >> 1, kvh = rem & 1; const int tok0 = b * SEQ + nb * 128;
    LAS bf16* Kl = (LAS bf16*)X.lds;
    LAS bf16* VT = (LAS bf16*)(X.lds + 36864);
    int lane = X.lane; asm volatile("" : "+v"(lane));
    const int c16 = lane & 15, quad = lane >> 4;
    v4u nq0, nq1; f32x4 ncs0, ncs1, nsn0, nsn1;
#define AT_PREF(task_) do { const int g_ = (task_) >> 3, tq_ = tok0 + 16 * ((task_) & 7) + c16; const bf16* qp_ = proj + (size_t)tq_ * NPROJ + C_AQ + (kvh * 4 + g_) * 64; \
        nq0 = *(const v4u*)(qp_ + 8 * quad); nq1 = *(const v4u*)(qp_ + 32 + 8 * quad); ncs0 = *(const f32x4*)(cs + (size_t)tq_ * 8); ncs1 = *(const f32x4*)(cs + (size_t)tq_ * 8 + 4); nsn0 = *(const f32x4*)(sn + (size_t)tq_ * 8); nsn1 = *(const f32x4*)(sn + (size_t)tq_ * 8 + 4); } while (0)
    AT_PREF(X.wave);
    float qw[16];
#pragma unroll
    for (int i = 0; i < 8; ++i) { qw[i] = a.qnw[l * 64 + 8 * quad + i]; qw[8 + i] = a.qnw[l * 64 + 32 + 8 * quad + i]; }
    const f32x4 sk4 = *(const f32x4*)(a.sinks + l * 8 + kvh * 4);
    {
        const int row = X.tid >> 1, half = X.tid & 1; const int tokk = tok0 - 128 + row; const bool valid = (nb > 0) || (row >= 128);
        float y[32]; float vv[32];
        if (valid) {
            const v4u* kp = (const v4u*)(proj + (size_t)tokk * NPROJ + C_AK + kvh * 64 + half * 32); const v4u* vp = (const v4u*)(proj + (size_t)tokk * NPROJ + C_AV + kvh * 64 + half * 32);
#pragma unroll
            for (int q = 0; q < 4; ++q) { const v4u kw = kp[q], vw = vp[q];
                y[8 * q + 0] = bflo(kw.x); y[8 * q + 1] = bfhi(kw.x); y[8 * q + 2] = bflo(kw.y); y[8 * q + 3] = bfhi(kw.y); y[8 * q + 4] = bflo(kw.z); y[8 * q + 5] = bfhi(kw.z); y[8 * q + 6] = bflo(kw.w); y[8 * q + 7] = bfhi(kw.w);
                vv[8 * q + 0] = bflo(vw.x); vv[8 * q + 1] = bfhi(vw.x); vv[8 * q + 2] = bflo(vw.y); vv[8 * q + 3] = bfhi(vw.y); vv[8 * q + 4] = bflo(vw.z); vv[8 * q + 5] = bfhi(vw.z); vv[8 * q + 6] = bflo(vw.w); vv[8 * q + 7] = bfhi(vw.w); }
        } else {
#pragma unroll
            for (int i = 0; i < 32; ++i) { y[i] = 0.f; vv[i] = 0.f; } }
        float ss = 0.f;
#pragma unroll
        for (int i = 0; i < 32; ++i) ss += y[i] * y[i];
        ss += __shfl_xor(ss, 1); const float rstd = 1.0f / sqrtf(ss * (1.0f / 64.0f) + EPS);
#pragma unroll
        for (int i = 0; i < 32; ++i) y[i] = y[i] * rstd * a.knw[l * 64 + half * 32 + i];
        if (half == 0 && valid) {
#pragma unroll
            for (int d = 0; d < 8; ++d) { const float c = cs[(size_t)tokk * 8 + d], s = sn[(size_t)tokk * 8 + d]; const float t1 = y[d], t2 = y[d + 8]; y[d] = t1 * c - t2 * s; y[d + 8] = t2 * c + t1 * s; } }
#pragma unroll
        for (int q = 0; q < 4; ++q) { v4u w; w.x = pk2(y[8 * q], y[8 * q + 1]); w.y = pk2(y[8 * q + 2], y[8 * q + 3]); w.z = pk2(y[8 * q + 4], y[8 * q + 5]); w.w = pk2(y[8 * q + 6], y[8 * q + 7]);
            *(LAS v4u*)(Kl + row * 72 + half * 32 + 8 * q) = w; }
#pragma unroll
        for (int i = 0; i < 32; ++i) VT[(half * 32 + i) * 280 + row] = (bf16)f2bf(vv[i]);
        if (X.tid < 64) {
#pragma unroll
            for (int cc = 256; cc < 280; ++cc) VT[X.tid * 280 + cc] = 0; }
    }
    __syncthreads();
#pragma unroll 1
    for (int task = X.wave; task < 32; task += 8) {
        const int g = task >> 3, rg = task & 7, r0 = 16 * rg, head = kvh * 4 + g; const int tokq = tok0 + r0 + c16;
        const float sink = (g == 0) ? sk4.x : ((g == 1) ? sk4.y : ((g == 2) ? sk4.z : sk4.w));
        const v4u w0 = nq0, w1 = nq1; const f32x4 cc0 = ncs0, cc1 = ncs1, ss0 = nsn0, ss1 = nsn1;
        if (task + 8 < 32) { AT_PREF(task + 8); }
        float qv[16];
        qv[0] = bflo(w0.x); qv[1] = bfhi(w0.x); qv[2] = bflo(w0.y); qv[3] = bfhi(w0.y); qv[4] = bflo(w0.z); qv[5] = bfhi(w0.z); qv[6] = bflo(w0.w); qv[7] = bfhi(w0.w);
        qv[8] = bflo(w1.x); qv[9] = bfhi(w1.x); qv[10] = bflo(w1.y); qv[11] = bfhi(w1.y); qv[12] = bflo(w1.z); qv[13] = bfhi(w1.z); qv[14] = bflo(w1.w); qv[15] = bfhi(w1.w);
        float ss = 0.f;
#pragma unroll
        for (int i = 0; i < 16; ++i) ss += qv[i] * qv[i];
        ss += __shfl_xor(ss, 16); ss += __shfl_xor(ss, 32); const float rstd = __builtin_amdgcn_rsqf(ss * (1.0f / 64.0f) + EPS);
#pragma unroll
        for (int i = 0; i < 16; ++i) qv[i] = qv[i] * rstd * qw[i];
        { const float cv[8] = {cc0.x, cc0.y, cc0.z, cc0.w, cc1.x, cc1.y, cc1.z, cc1.w}, sv[8] = {ss0.x, ss0.y, ss0.z, ss0.w, ss1.x, ss1.y, ss1.z, ss1.w};
#pragma unroll
          for (int d = 0; d < 8; ++d) { const float other = __shfl_xor(qv[d], 16);
              if (quad == 0) qv[d] = qv[d] * cv[d] - other * sv[d]; else if (quad == 1) qv[d] = qv[d] * cv[d] + other * sv[d]; } }
        bf16x8 qf[2];
        { v4u w; w.x = pk2m(qv[0], qv[1]); w.y = pk2m(qv[2], qv[3]); w.z = pk2m(qv[4], qv[5]); w.w = pk2m(qv[6], qv[7]); qf[0] = __builtin_bit_cast(bf16x8, w);
          w.x = pk2m(qv[8], qv[9]); w.y = pk2m(qv[10], qv[11]); w.z = pk2m(qv[12], qv[13]); w.w = pk2m(qv[14], qv[15]); qf[1] = __builtin_bit_cast(bf16x8, w); }
        f32x4 sacc[9];
#pragma unroll
        for (int i = 0; i < 9; ++i) { const LAS bf16* kr = Kl + (16 * (rg + i) + c16) * 72 + 8 * quad;
            const bf16x8 k0 = *(const LAS bf16x8*)kr, k1 = *(const LAS bf16x8*)(kr + 32);
            f32x4 z = {0.f, 0.f, 0.f, 0.f}; z = __builtin_amdgcn_mfma_f32_16x16x32_bf16(k0, qf[0], z, 0, 0, 0); sacc[i] = __builtin_amdgcn_mfma_f32_16x16x32_bf16(k1, qf[1], z, 0, 0, 0); }
        int dbase = 4 * quad - c16; asm volatile("" : "+v"(dbase)); int kbase = 16 * rg + 4 * quad; asm volatile("" : "+v"(kbase)); float mx = sink;
#pragma unroll
        for (int i = 0; i < 9; ++i)
#pragma unroll
            for (int j = 0; j < 4; ++j) { const int dlt = dbase + 16 * i + j; const int kj = kbase + 16 * i + j; const bool ok = (dlt > 0) && (dlt <= 128) && ((nb > 0) || (kj >= 128));
                const float s = ok ? sacc[i][j] * 0.125f : -3.0e38f; sacc[i][j] = s; mx = fmaxf(mx, s); }
        mx = fmaxf(mx, __shfl_xor(mx, 16)); mx = fmaxf(mx, __shfl_xor(mx, 32));
        float sum = 0.f;
#pragma unroll
        for (int i = 0; i < 9; ++i)
#pragma unroll
            for (int j = 0; j < 4; ++j) { const float p = (sacc[i][j] > -1.0e38f) ? __expf(sacc[i][j] - mx) : 0.f; sacc[i][j] = p; sum += p; }
        sum += __shfl_xor(sum, 16); sum += __shfl_xor(sum, 32);
        const float inv = 1.0f / (sum + __expf(sink - mx));
        f32x4 oacc[4];
#pragma unroll
        for (int et = 0; et < 4; ++et) oacc[et] = (f32x4){0.f, 0.f, 0.f, 0.f};
#pragma unroll
        for (int kk = 0; kk < 5; ++kk) {
            v4u pw; pw.x = pk2m(sacc[2 * kk][0], sacc[2 * kk][1]); pw.y = pk2m(sacc[2 * kk][2], sacc[2 * kk][3]);
            if (2 * kk + 1 < 9) { pw.z = pk2m(sacc[(2 * kk + 1 < 9) ? 2 * kk + 1 : 0][0], sacc[(2 * kk + 1 < 9) ? 2 * kk + 1 : 0][1]); pw.w = pk2m(sacc[(2 * kk + 1 < 9) ? 2 * kk + 1 : 0][2], sacc[(2 * kk + 1 < 9) ? 2 * kk + 1 : 0][3]); } else { pw.z = 0u; pw.w = 0u; }
            const bf16x8 pf = __builtin_bit_cast(bf16x8, pw);
#pragma unroll
            for (int et = 0; et < 4; ++et) { const LAS bf16* vr = VT + (16 * et + c16) * 280 + 16 * rg + 32 * kk + 4 * quad;
                const v2u lo = *(const LAS v2u*)vr, hi = *(const LAS v2u*)(vr + 16); v4u vw; vw.x = lo.x; vw.y = lo.y; vw.z = hi.x; vw.w = hi.y;
                oacc[et] = __builtin_amdgcn_mfma_f32_16x16x32_bf16(__builtin_bit_cast(bf16x8, vw), pf, oacc[et], 0, 0, 0); }
        }
#pragma unroll
        for (int et = 0; et < 4; ++et) { const float i8 = inv * 8.0f;
            *(unsigned*)(ao + (size_t)tokq * 512 + head * 64 + 16 * et + 4 * quad) = pk4_fp8(oacc[et][0] * i8, oacc[et][1] * i8, oacc[et][2] * i8, oacc[et][3] * i8); }
    }
    __syncthreads();
#undef AT_PREF
}

constexpr int ML_Q = 0, ML_K = 17408, ML_KET = 34816, ML_VT = 53248, ML_CT = 73984, ML_CW = 113152, ML_CB = 118272, ML_RED = 118784, ML_NW = 119296, ML_GT = 119808;
DI float bfw(unsigned w, int hi) { return hi ? bfhi(w) : bflo(w); }
template <bool L3> DI void mlstm_unit(const Args& a, const Ctx& X, int l, int unit) {
    unsigned char* ws = a.ws; const bf16* proj = (const bf16*)(ws + WS_PROJ); unsigned char* hm = (unsigned char*)(ws + WS_H) + (size_t)T * 512;
    bf16* kcb = (bf16*)(ws + WS_KC);
    const float* gates = (const float*)(ws + WS_GATES); float* mlc = (float*)(ws + WS_MLC) + (size_t)unit * 18432; float* mlb = (float*)(ws + WS_MLB);
    const int seq = unit >> 5, sj = unit & 31, b = seq >> 2, hh = seq & 3; const int tokbase = b * SEQ + sj * 512;
    LAS bf16* Qs = (LAS bf16*)(X.lds + ML_Q); LAS bf16* Ks = (LAS bf16*)(X.lds + ML_K); LAS bf16* KET = (LAS bf16*)(X.lds + ML_KET);
    LAS bf16* VT = (LAS bf16*)(X.lds + ML_VT); LAS bf16* CT = (LAS bf16*)(X.lds + ML_CT); LAS float* CW = (LAS float*)(X.lds + ML_CW);
    LAS float* CB = (LAS float*)(X.lds + ML_CB); LAS float* RED = (LAS float*)(X.lds + ML_RED); LAS float* NW = (LAS float*)(X.lds + ML_NW);
    LAS float* GT = (LAS float*)(X.lds + ML_GT);
    int lane = X.lane; asm volatile("" : "+v"(lane));
    const int c16 = lane & 15, quad = lane >> 4, w = X.wave;
    int tidl = X.tid; asm volatile("" : "+v"(tidl));
    const int tg = tidl >> 5, cg = tidl & 31, t0 = 4 * tg, c0 = 4 * cg;
    v2u rq[7], rk[7], rv[4], kcv[4];
#define ML_LBAR() do { asm volatile("s_waitcnt lgkmcnt(0)" ::: "memory"); __builtin_amdgcn_s_barrier(); asm volatile("" ::: "memory"); } while (0)
#define ML_LOADRAW(tokc) do { _Pragma("unroll") for (int j = 0; j < 7; ++j) { const int tt = (tokc) + t0 - 3 + j; const bool ok = tt >= b * SEQ; const bf16* rp = proj + (size_t)(ok ? tt : (tokc)) * NPROJ + hh * 128 + c0; \
        if (L3) { rq[j] = *(const v2u*)(rp + C_MQ); if (!ok) { rq[j].x = 0u; rq[j].y = 0u; } } else { rk[j] = *(const v2u*)(rp + C_MK); if (!ok) { rk[j].x = 0u; rk[j].y = 0u; } } } \
        if (L3) { _Pragma("unroll") for (int i = 0; i < 4; ++i) kcv[i] = *(const v2u*)(kcb + (size_t)((tokc) + t0 + i) * 512 + hh * 128 + c0); } \
        _Pragma("unroll") for (int i = 0; i < 4; ++i) rv[i] = *(const v2u*)(proj + (size_t)((tokc) + t0 + i) * NPROJ + C_MV + hh * 128 + c0); } while (0)
    ML_LOADRAW(tokbase);
    for (int idx = X.tid; idx < 1280; idx += 512) { const int tap = idx >> 8, ch = idx & 255; const int gch = (ch < 128) ? (hh * 128 + ch) : (512 + hh * 128 + (ch - 128));
        CW[idx] = (tap < 4) ? a.conv_w[(size_t)(l * 4 + tap) * 1024 + gch] : a.conv_b[l * 1024 + gch]; }
    for (int idx = X.tid; idx < 16 * 72; idx += 512) VT[128 * 72 + idx] = (idx < 72) ? (bf16)0x3F80 : (bf16)0;
    if (X.tid < 128) NW[X.tid] = a.mnw[l * 512 + hh * 128 + X.tid];
    { const float* gp = gates + (size_t)(tokbase + X.tid) * 8; GT[2 * X.tid] = gp[hh]; GT[2 * X.tid + 1] = gp[4 + hh]; }
    f32x4 cacc[9];
#pragma unroll
    for (int et = 0; et < 9; ++et) {
        if (L3) {
#pragma unroll
            for (int j = 0; j < 4; ++j) { const float v = mlc[(16 * et + 4 * quad + j) * 128 + 16 * w + c16]; cacc[et][j] = v; CT[(16 * et + 4 * quad + j) * 136 + 16 * w + c16] = (bf16)f2bf(v); }
        } else cacc[et] = (f32x4){0.f, 0.f, 0.f, 0.f};
    }
    float bsum = 0.f;
    __syncthreads();
#pragma unroll 1
    for (int c = 0; c < 8; ++c) {
        const int tok0 = tokbase + c * 64;
        const f32x2 gl = *(const LAS f32x2*)(GT + 2 * (c * 64 + lane)); float bsc = gl.y; const float li = gl.x;
#pragma unroll
        for (int o = 1; o < 64; o <<= 1) { const float v = __shfl_up(bsc, o); if (lane >= o) bsc += v; }
        const float bl = __shfl(bsc, 63); const float csv = li - bsc;
        if (w == 0) { CB[lane] = bsc; CB[64 + lane] = csv; }
        bsum += bl;
        const int tt_ = w & 3, eh = w >> 2; const int tq = 16 * tt_ + c16;
        v2u ogv[4];
        if (L3) {
#pragma unroll
            for (int x = 0; x < 4; ++x) ogv[x] = *(const v2u*)(proj + (size_t)(tok0 + tq) * NPROJ + C_MO + hh * 128 + 16 * (4 * eh + x) + 4 * quad); }
        { float fac[4];
#pragma unroll
          for (int i = 0; i < 4; ++i) fac[i] = __expf(bl + __shfl(csv, t0 + i));
#pragma unroll
          for (int qk = (L3 ? 0 : 1); qk < 2; ++qk) {
              float o[4][4];
              if (L3 && qk) {
#pragma unroll
                  for (int i = 0; i < 4; ++i) { o[i][0] = bflo(kcv[i].x); o[i][1] = bfhi(kcv[i].x); o[i][2] = bflo(kcv[i].y); o[i][3] = bfhi(kcv[i].y); }
              } else {
              const f32x4 bias = *(const LAS f32x4*)(CW + 4 * 256 + qk * 128 + c0);
#pragma unroll
              for (int i = 0; i < 4; ++i) { o[i][0] = bias.x; o[i][1] = bias.y; o[i][2] = bias.z; o[i][3] = bias.w; }
#pragma unroll
              for (int j = 0; j < 4; ++j) { const f32x4 wj = *(const LAS f32x4*)(CW + j * 256 + qk * 128 + c0);
#pragma unroll
                  for (int i = 0; i < 4; ++i) { const v2u rr = qk ? rk[i + j] : rq[i + j];
                      o[i][0] += wj.x * bflo(rr.x); o[i][1] += wj.y * bfhi(rr.x); o[i][2] += wj.z * bflo(rr.y); o[i][3] += wj.w * bfhi(rr.y); } }
#pragma unroll
              for (int i = 0; i < 4; ++i)
#pragma unroll
                  for (int ch = 0; ch < 4; ++ch) { const float z = o[i][ch]; o[i][ch] = z * __builtin_amdgcn_rcpf(1.0f + __expf(-z)) * (qk ? 0.08838834764831845f : 1.0f); }
              }
              if (!L3 && qk) {
#pragma unroll
                  for (int i = 0; i < 4; ++i) { v2u pw; pw.x = pk2(o[i][0], o[i][1]); pw.y = pk2(o[i][2], o[i][3]); *(v2u*)(kcb + (size_t)(tok0 + t0 + i) * 512 + hh * 128 + c0) = pw;
                      o[i][0] = bflo(pw.x); o[i][1] = bfhi(pw.x); o[i][2] = bflo(pw.y); o[i][3] = bfhi(pw.y); } }
              if (L3) { LAS bf16* dst = (qk ? Ks : Qs) + t0 * 136 + c0;
#pragma unroll
                  for (int i = 0; i < 4; ++i) { v2u pw; pw.x = pk2(o[i][0], o[i][1]); pw.y = pk2(o[i][2], o[i][3]); *(LAS v2u*)(dst + i * 136) = pw; } }
              if (qk) {
#pragma unroll
                  for (int ch = 0; ch < 4; ++ch) { v2u pw; pw.x = pk2(o[0][ch] * fac[0], o[1][ch] * fac[1]); pw.y = pk2(o[2][ch] * fac[2], o[3][ch] * fac[3]); *(LAS v2u*)(KET + (c0 + ch) * 72 + t0) = pw; } }
          }
          { v2u p0, p1, p2, p3;
            p0.x = (rv[0].x & 0xffffu) | (rv[1].x << 16); p0.y = (rv[2].x & 0xffffu) | (rv[3].x << 16);
            p1.x = (rv[0].x >> 16) | (rv[1].x & 0xffff0000u); p1.y = (rv[2].x >> 16) | (rv[3].x & 0xffff0000u);
            p2.x = (rv[0].y & 0xffffu) | (rv[1].y << 16); p2.y = (rv[2].y & 0xffffu) | (rv[3].y << 16);
            p3.x = (rv[0].y >> 16) | (rv[1].y & 0xffff0000u); p3.y = (rv[2].y >> 16) | (rv[3].y & 0xffff0000u);
            *(LAS v2u*)(VT + (c0 + 0) * 72 + t0) = p0; *(LAS v2u*)(VT + (c0 + 1) * 72 + t0) = p1; *(LAS v2u*)(VT + (c0 + 2) * 72 + t0) = p2; *(LAS v2u*)(VT + (c0 + 3) * 72 + t0) = p3; }
        }
        ML_LBAR();
        if (c < 7) { ML_LOADRAW(tok0 + 64); }
        float hval[4][4];
        if (L3) {
            bf16x8 qf[4];
#pragma unroll
            for (int ks = 0; ks < 4; ++ks) qf[ks] = *(const LAS bf16x8*)(Qs + tq * 136 + 32 * ks + 8 * quad);
            f32x4 sacc[4];
#pragma unroll
            for (int st = 0; st < 4; ++st) { f32x4 z = {0.f, 0.f, 0.f, 0.f};
#pragma unroll
                for (int ks = 0; ks < 4; ++ks) z = __builtin_amdgcn_mfma_f32_16x16x32_bf16(*(const LAS bf16x8*)(Ks + (16 * st + c16) * 136 + 32 * ks + 8 * quad), qf[ks], z, 0, 0, 0);
                sacc[st] = z; }
            const float cbt = CB[tq];
#pragma unroll
            for (int st = 0; st < 4; ++st)
#pragma unroll
                for (int j = 0; j < 4; ++j) { const int s = 16 * st + 4 * quad + j; const float d = (s <= tq) ? __expf(cbt + CB[64 + s]) : 0.f; sacc[st][j] *= d; }
            bf16x8 pf[2];
#pragma unroll
            for (int kk = 0; kk < 2; ++kk) { v4u pw; pw.x = pk2m(sacc[2 * kk][0], sacc[2 * kk][1]); pw.y = pk2m(sacc[2 * kk][2], sacc[2 * kk][3]); pw.z = pk2m(sacc[2 * kk + 1][0], sacc[2 * kk + 1][1]); pw.w = pk2m(sacc[2 * kk + 1][2], sacc[2 * kk + 1][3]); pf[kk] = __builtin_bit_cast(bf16x8, pw); }
            const float ebt = __expf(cbt);
            f32x4 nn[5];
#pragma unroll
            for (int x = 0; x < 5; ++x) { const int et = (x < 4) ? (4 * eh + x) : 8; f32x4 na = {0.f, 0.f, 0.f, 0.f}, ia = {0.f, 0.f, 0.f, 0.f};
#pragma unroll
                for (int kk = 0; kk < 2; ++kk) { const LAS bf16* vr = VT + (16 * et + c16) * 72 + 32 * kk + 4 * quad; const v2u lo = *(const LAS v2u*)vr, hi = *(const LAS v2u*)(vr + 16); v4u vw; vw.x = lo.x; vw.y = lo.y; vw.z = hi.x; vw.w = hi.y;
                    na = __builtin_amdgcn_mfma_f32_16x16x32_bf16(__builtin_bit_cast(bf16x8, vw), pf[kk], na, 0, 0, 0); }
#pragma unroll
                for (int ks = 0; ks < 4; ++ks) ia = __builtin_amdgcn_mfma_f32_16x16x32_bf16(*(const LAS bf16x8*)(CT + (16 * et + c16) * 136 + 32 * ks + 8 * quad), qf[ks], ia, 0, 0, 0);
                nn[x] = na + ia * ebt; }
            const float den = __shfl(nn[4][0], c16); const float inv = 1.0f / fmaxf(fabsf(den), 1.0f);
            float ss = 0.f;
#pragma unroll
            for (int x = 0; x < 4; ++x)
#pragma unroll
                for (int j = 0; j < 4; ++j) { hval[x][j] = nn[x][j] * inv; ss += hval[x][j] * hval[x][j]; }
            ss += __shfl_xor(ss, 16); ss += __shfl_xor(ss, 32);
            if (quad == 0) RED[eh * 64 + tq] = ss;
            ML_LBAR();
            const float rstd = __builtin_amdgcn_rsqf((RED[tq] + RED[64 + tq]) * (1.0f / 128.0f) + EPS);
#pragma unroll
            for (int x = 0; x < 4; ++x) { const int e = 16 * (4 * eh + x) + 4 * quad; const v2u og = ogv[x];
                const float y0 = hval[x][0] * rstd * NW[e] * bflo(og.x), y1 = hval[x][1] * rstd * NW[e + 1] * bfhi(og.x), y2 = hval[x][2] * rstd * NW[e + 2] * bflo(og.y), y3 = hval[x][3] * rstd * NW[e + 3] * bfhi(og.y);
                *(unsigned*)(hm + (size_t)(tok0 + tq) * 512 + hh * 128 + e) = pk4_fp8(y0 * 8.0f, y1 * 8.0f, y2 * 8.0f, y3 * 8.0f); }
        }
        { const float ebl = __expf(bl);
          bf16x8 kf[2];
#pragma unroll
          for (int kk = 0; kk < 2; ++kk) kf[kk] = *(const LAS bf16x8*)(KET + (16 * w + c16) * 72 + 32 * kk + 8 * quad);
#pragma unroll
          for (int et = 0; et < 9; ++et) { f32x4 z = cacc[et] * ebl;
#pragma unroll
              for (int kk = 0; kk < 2; ++kk) z = __builtin_amdgcn_mfma_f32_16x16x32_bf16(*(const LAS bf16x8*)(VT + (16 * et + c16) * 72 + 32 * kk + 8 * quad), kf[kk], z, 0, 0, 0);
              cacc[et] = z;
              if (L3) {
#pragma unroll
                  for (int j = 0; j < 4; ++j) CT[(16 * et + 4 * quad + j) * 136 + 16 * w + c16] = (bf16)f2bf(z[j]); } } }
        ML_LBAR();
    }
#undef ML_LOADRAW
#undef ML_LBAR
    if (!L3) {
#pragma unroll
        for (int et = 0; et < 9; ++et)
#pragma unroll
            for (int j = 0; j < 4; ++j) mlc[(16 * et + 4 * quad + j) * 128 + 16 * w + c16] = cacc[et][j];
        if (X.tid == 0) mlb[unit] = bsum;
    }
}
DI void mlstm_scan(const Args& a, const Ctx& X) {
    float* mlc = (float*)(a.ws + WS_MLC); const float* mlb = (const float*)(a.ws + WS_MLB);
    for (int idx = X.bid * 512 + X.tid; idx < 8 * 18432; idx += X.G * 512) { const int seq = idx / 18432, el = idx - seq * 18432; float carry = 0.f;
        float* p0 = mlc + (size_t)seq * 32 * 18432 + el; float v[32], dcy[32];
#pragma unroll
        for (int j = 0; j < 32; ++j) { v[j] = p0[(size_t)j * 18432]; dcy[j] = mlb[seq * 32 + j]; }
#pragma unroll
        for (int j = 0; j < 32; ++j) { p0[(size_t)j * 18432] = carry; carry = __expf(dcy[j]) * carry + v[j]; } }
}

constexpr int P6_WR = 0, P6_AT = 33024, P6_SH = 37120, P6_LG = 41216, P6_HIST = 65536;
DI void p6_norm_route(const Args& a, const Ctx& X, int l, const bf16* xin) {
    unsigned char* ws = a.ws;
    LAS bf16* wrb = (LAS bf16*)(X.lds + P6_WR);
    LAS float* at = (LAS float*)(X.lds + P6_AT); LAS float* sht = (LAS float*)(X.lds + P6_SH);
    LAS float* lg = (LAS float*)(X.lds + P6_LG) + X.wave * 272;
    for (int idx = X.tid; idx < 16384; idx += 512) { const int k = idx >> 4, e = idx & 15; wrb[e * 1032 + k] = (bf16)f2bf(a.router_w[idx]); }
    const float* mod = (const float*)(ws + WS_MOD); unsigned char* hb = (unsigned char*)(ws + WS_H); float* tgate = (float*)(ws + WS_TGATE); int* tokl = (int*)(ws + WS_TOKL);
    const float* ssq = (const float*)(ws + WS_SSQ);
    unsigned* cnt = (unsigned*)(ws + WS_CTL) + CW_CNT + l * 2048;
    LAS int* hist = (LAS int*)(X.lds + P6_HIST); LAS int* cbase = hist + 32;
    int lane = X.lane; asm volatile("" : "+v"(lane));
    const int r = lane & 15, q = lane >> 4;
    const int gw = X.bid * 8 + X.wave, NGW = X.G * 8;
    for (int it = 0; it * NGW < T / 16; ++it) {
        const int rg = it * NGW + gw; const bool act = rg < T / 16;
        const int row0 = (act ? rg : 0) * 16; const int bb = ((it * NGW + X.bid * 8) * 16) >> 14;
        __syncthreads();
        if (X.tid < 32) hist[X.tid] = 0;
        { const float* mb = mod + (size_t)(l * 2 + (bb < 2 ? bb : 1)) * 6144;
          for (int k = X.tid; k < 1024; k += 512) { at[k] = a.nfw[l * D + k] * (1.0f + mb[4 * 1024 + k]); sht[k] = mb[3 * 1024 + k]; } }
        __syncthreads();
        const int row = row0 + r;
        float rstd;
        { const f32x4 pp = *(const f32x4*)(ssq + (size_t)row * 16 + 4 * q); float ss = (pp.x + pp.y) + (pp.z + pp.w); ss += __shfl_xor(ss, 16); ss += __shfl_xor(ss, 32); rstd = __builtin_amdgcn_rsqf(ss * (1.0f / D) + EPS); }
        const bf16* xr = xin + (size_t)row * D + 8 * q; unsigned char* hr = hb + (size_t)row * D + 8 * q;
        f32x4 acc = {0.f, 0.f, 0.f, 0.f};
#pragma unroll 8
        for (int s = 0; s < 32; ++s) {
            const v4u xw = *(const v4u*)(xr + 32 * s); const f32x4 x0 = {bflo(xw.x), bfhi(xw.x), bflo(xw.y), bfhi(xw.y)}, x1 = {bflo(xw.z), bfhi(xw.z), bflo(xw.w), bfhi(xw.w)};
            const f32x4 a0 = *(const LAS f32x4*)(at + 32 * s + 8 * q), a1 = *(const LAS f32x4*)(at + 32 * s + 8 * q + 4);
            const f32x4 s0 = *(const LAS f32x4*)(sht + 32 * s + 8 * q), s1 = *(const LAS f32x4*)(sht + 32 * s + 8 * q + 4);
            const f32x4 h0 = x0 * rstd * a0 + s0, h1 = x1 * rstd * a1 + s1;
            v4u w; w.x = pk2m(h0.x, h0.y); w.y = pk2m(h0.z, h0.w); w.z = pk2m(h1.x, h1.y); w.w = pk2m(h1.z, h1.w);
            { v2u w8; w8.x = pk4_fp8(h0.x, h0.y, h0.z, h0.w); w8.y = pk4_fp8(h1.x, h1.y, h1.z, h1.w); *(v2u*)(hr + 32 * s) = w8; }
            const bf16x8 bfr = *(const LAS bf16x8*)(wrb + r * 1032 + 32 * s + 8 * q);
            acc = __builtin_amdgcn_mfma_f32_16x16x32_bf16(__builtin_bit_cast(bf16x8, w), bfr, acc, 0, 0, 0);
        }
#pragma unroll
        for (int j = 0; j < 4; ++j) lg[(4 * q + j) * 17 + r] = acc[j];
        LDS_WAIT(); asm volatile("" ::: "memory");
        int my_cls = 0; float my_ga = 0.f, my_gb = 0.f;
        if (lane < 16) {
            float sc[16], sel[16];
#pragma unroll
            for (int e = 0; e < 16; ++e) { const float p = lg[lane * 17 + e]; sc[e] = 1.0f / (1.0f + __expf(-p)); sel[e] = sc[e] + a.router_b[e]; }
            int gi = 0; float gbest = -1.0e30f;
#pragma unroll
            for (int g = 0; g < 4; ++g) { const float p0 = sel[4 * g], p1 = sel[4 * g + 1], p2 = sel[4 * g + 2], p3 = sel[4 * g + 3];
                const float gs = fmaxf(fmaxf(fmaxf(p0 + p1, p0 + p2), fmaxf(p0 + p3, p1 + p2)), fmaxf(p1 + p3, p2 + p3));
                if (gs > gbest) { gbest = gs; gi = g; } }
            float qs[4], s4[4];
#pragma unroll
            for (int i = 0; i < 4; ++i) { qs[i] = 0.f; s4[i] = 0.f; }
#pragma unroll
            for (int g = 0; g < 4; ++g) if (g == gi) {
#pragma unroll
                for (int i = 0; i < 4; ++i) { qs[i] = sel[4 * g + i]; s4[i] = sc[4 * g + i]; } }
            int i1 = 0; float b1 = qs[0];
#pragma unroll
            for (int i = 1; i < 4; ++i) if (qs[i] > b1) { b1 = qs[i]; i1 = i; }
            int i2 = -1; float b2 = -1.0e30f;
#pragma unroll
            for (int i = 0; i < 4; ++i) if (i != i1 && qs[i] > b2) { b2 = qs[i]; i2 = i; }
            const int ia = (i1 < i2) ? i1 : i2, ib = (i1 < i2) ? i2 : i1;
            float sa = 0.f, sb = 0.f;
#pragma unroll
            for (int i = 0; i < 4; ++i) { if (i == ia) sa = s4[i]; if (i == ib) sb = s4[i]; }
            const int pidx = (ia == 0) ? (ib - 1) : ((ia == 1) ? (ib + 1) : 5);
            const float inv = 1.0f / (sa + sb);
            my_cls = gi * 6 + pidx; my_ga = sa * inv; my_gb = sb * inv;
        }
        int rank = 0;
        if (act && lane < 16) rank = __hip_atomic_fetch_add(hist + my_cls, 1, __ATOMIC_RELAXED, __HIP_MEMORY_SCOPE_WORKGROUP);
        __syncthreads();
        if (X.tid < NCLS) { const int n = hist[X.tid]; cbase[X.tid] = n ? (int)__hip_atomic_fetch_add(cnt + 64 * X.tid, (unsigned)n, RLX_AGENT) : 0; }
        __syncthreads();
        if (act && lane < 16) { const int tok = row0 + lane; const int pos = cbase[my_cls] + rank;
            tokl[my_cls * CLS_CAP + pos] = tok; tgate[tok * 2] = my_ga; tgate[tok * 2 + 1] = my_gb; }
    }
}
DI MoeTab moe_tables(const Args& a, const Ctx& X, int l) {
    LAS int* tab = (LAS int*)(X.lds + TAB_OFF); LAS int* tcls = tab; LAS int* tpos = tab + 160; LAS int* cn = tab + 320; LAS int* rt_ = tab + 344;
    unsigned* cnt = (unsigned*)(a.ws + WS_CTL) + CW_CNT + l * 2048;
    if (X.tid < NCLS) cn[X.tid] = (int)__hip_atomic_load(cnt + 64 * X.tid, RLX_AGENT);
    __syncthreads();
    if (X.tid < NCLS) {
        int base = 0;
#pragma unroll 1
        for (int c = 0; c < X.tid; ++c) base += (cn[c] + 255) >> 8;
        const int n = (cn[X.tid] + 255) >> 8;
#pragma unroll 1
        for (int i = 0; i < n; ++i) { tcls[base + i] = X.tid; tpos[base + i] = i * 256; }
        if (X.tid == NCLS - 1) rt_[0] = base + n; }
    __syncthreads();
    MoeTab tb; tb.tcls = tcls; tb.tpos = tpos; tb.cnt = cn; tb.Rtot = __builtin_amdgcn_readfirstlane(rt_[0]); return tb;
}

#if defined(__HIP_DEVICE_COMPILE__)
DI Args load_args() { auto p = __builtin_amdgcn_kernarg_segment_ptr(); asm volatile("" : "+s"(p)); return *(const __attribute__((address_space(4))) Args*)p; }
#else
DI Args load_args() { return Args{}; }
#endif
__global__ void __launch_bounds__(512, 2) fwd(Args a_unused) {
    extern __shared__ __attribute__((aligned(16))) unsigned char lds_raw[];
    Ctx X; X.lds = (LAS unsigned char*)lds_raw; X.tid = threadIdx.x; X.lane = X.tid & 63; X.wave = __builtin_amdgcn_readfirstlane(X.tid >> 6); X.G = gridDim.x; X.bid = blockIdx.x;
    volatile LAS unsigned* MISC = (volatile LAS unsigned*)(X.lds + MISC_OFF);
    if (X.tid < 64) MISC[X.tid] = 0u;
    __syncthreads();
    int lo, hi; unsigned* ctl;
    { const Args a = load_args(); lo = a.ph_lo; hi = a.ph_hi; ctl = (unsigned*)(a.ws + WS_CTL); }
    XcdBarrier bar; bar.bar = ctl + CW_BAR; bar.x = 0; bar.st = MISC + 8;
    if (hi - lo > 1) bar = xcd_barrier_post(ctl + CW_BAR, MISC + 8);
#ifndef PH_MASK
#define PH_MASK 0xFFFFF
#endif
#define PON(p) ((PH_MASK >> (p)) & 1)
#ifndef DUP_MASK
#define DUP_MASK 0
#endif
#define NREP(p) (((DUP_MASK >> (p)) & 1) ? 2 : 1)
#ifndef TSEL_MASK
#define TSEL_MASK 0
#endif
#define TSCALE 4
#define TSEL(p) ((TSEL_MASK >> (p)) & 1)
#define IN(k) (lo <= (k) && (k) < hi)
#define SEAM(k) do { if (IN(k) && IN((k) + 1)) xcd_barrier(bar); } while (0)
    unsigned long long tacc = 0ull, tph = 0ull;
#define TBEG() do { if (TSEL_MASK) tph = __builtin_amdgcn_s_memrealtime(); } while (0)
#define TEND(p) do { if (TSEL(p)) tacc += __builtin_amdgcn_s_memrealtime() - tph; } while (0)
    TBEG();
    if (PON(10) && IN(0)) { for (int rep = 0; rep < NREP(10); ++rep) { const Args a = load_args(); p0_prologue(a, X); } }
    SEAM(0); TEND(10);
    TBEG();
    for (int l = 0; l < NL; ++l) {
        const int g0 = 1 + l * NPH;
        if (PON(0) && IN(g0 + 0)) { for (int rep = 0; rep < NREP(0); ++rep) { const Args a = load_args(); unsigned char* ws = a.ws; const float* mod = (const float*)(ws + WS_MOD); bf16* proj = (bf16*)(ws + WS_PROJ); bf16* xb = (bf16*)(ws + WS_XB); (void)mod; (void)proj; (void)xb; const Ctx P = fresh(X); p1_norm_gates(a, P, l, xb); } }
        SEAM(g0 + 0); TEND(0); TBEG();
        if (PON(1) && IN(g0 + 1)) for (int rep = 0; rep < NREP(1); ++rep) { const Args a = load_args(); unsigned char* ws = a.ws; const float* mod = (const float*)(ws + WS_MOD); bf16* proj = (bf16*)(ws + WS_PROJ); bf16* xb = (bf16*)(ws + WS_XB); (void)mod; (void)proj; (void)xb; const Ctx P = fresh(X);
            DenseSched S; S.A = (const char*)(ws + WS_H); S.Bt = (const char*)(ws + WS_WIN) + (size_t)l * NPROJW * D; S.lda = D; S.ldb = D; S.ord.init(T / 256, NPROJW / 256, P.G, P.bid);
            EpiProj E; E.O = proj; E.gates = (float*)(ws + WS_GATES); E.big = a.b_ig + l * 4; E.bfg = a.b_fg + l * 4;
            pg8::gemm_phase<EpiProj, DenseSched, true>(P.lds, D, S, E);
        }
        SEAM(g0 + 1); TEND(1); TBEG();
        if (PON(2) && IN(g0 + 2)) { const Args a = load_args(); unsigned char* ws = a.ws; const float* mod = (const float*)(ws + WS_MOD); bf16* proj = (bf16*)(ws + WS_PROJ); bf16* xb = (bf16*)(ws + WS_XB); (void)mod; (void)proj; (void)xb; const Ctx P = fresh(X);
            if (PON(11)) for (int rep = 0; rep < NREP(11); ++rep) {
#pragma unroll 1
                for (int u = P.bid; u < 512; u += P.G) attn_unit(a, P, l, u); }
            if (PON(12)) for (int rep = 0; rep < NREP(12); ++rep) {
#pragma unroll 1
                for (int u = P.bid; u < 256; u += P.G) mlstm_unit<false>(a, P, l, u); }
        }
        SEAM(g0 + 2); TEND(2); TBEG();
        if (PON(3) && IN(g0 + 3)) { const Args a = load_args(); unsigned char* ws = a.ws; const float* mod = (const float*)(ws + WS_MOD); bf16* proj = (bf16*)(ws + WS_PROJ); bf16* xb = (bf16*)(ws + WS_XB); (void)mod; (void)proj; (void)xb; const Ctx P = fresh(X); mlstm_scan(a, P); }
        SEAM(g0 + 3); TEND(3); TBEG();
        if (PON(4) && IN(g0 + 4)) for (int rep = 0; rep < NREP(4); ++rep) { const Args a = load_args(); unsigned char* ws = a.ws; const float* mod = (const float*)(ws + WS_MOD); bf16* proj = (bf16*)(ws + WS_PROJ); bf16* xb = (bf16*)(ws + WS_XB); (void)mod; (void)proj; (void)xb; const Ctx P = fresh(X);
#pragma unroll 1
            for (int u = P.bid; u < 256; u += P.G) mlstm_unit<true>(a, P, l, u); }
        SEAM(g0 + 4); TEND(4); TBEG();
        if (PON(5) && IN(g0 + 5)) for (int rep = 0; rep < NREP(5); ++rep) { const Args a = load_args(); unsigned char* ws = a.ws; const float* mod = (const float*)(ws + WS_MOD); bf16* proj = (bf16*)(ws + WS_PROJ); bf16* xb = (bf16*)(ws + WS_XB); (void)mod; (void)proj; (void)xb; const Ctx P = fresh(X);
            MergeSched S; S.A0 = (const char*)(ws + WS_H); S.A1 = (const char*)(ws + WS_H) + (size_t)T * 512; S.B0 = (const char*)(ws + WS_WAU) + (size_t)l * D * 512; S.B1 = (const char*)(ws + WS_WMU) + (size_t)l * D * 512;
            S.lda = 512; S.ldb = 512; S.ord.init(T / 256, D / 256, P.G, P.bid);
            EpiMerge E; E.P = proj; pg8::gemm_phase<EpiMerge, MergeSched, true>(P.lds, 1024, S, E);
        }
        SEAM(g0 + 5); TEND(5); TBEG();
        if (PON(6) && IN(g0 + 6)) for (int rep = 0; rep < NREP(6); ++rep) { const Args a = load_args(); unsigned char* ws = a.ws; const float* mod = (const float*)(ws + WS_MOD); bf16* proj = (bf16*)(ws + WS_PROJ); bf16* xb = (bf16*)(ws + WS_XB); (void)mod; (void)proj; (void)xb; const Ctx P = fresh(X);
            DenseSched S; S.A = (const char*)(proj + C_MQ); S.Bt = (const char*)(ws + WS_WOUT) + (size_t)l * D * D; S.lda = NPROJ * 2; S.ldb = D; S.ord.init(T / 256, D / 256, P.G, P.bid);
            EpiRes E; E.xin = xb; E.out = xb; E.g = mod + (size_t)(l * 2) * 6144 + 2 * 1024; E.ssq = (float*)(ws + WS_SSQ); E.rmask = T - 1;
            if (rep) { E.out = (bf16*)(ws + WS_H); E.rmask = T / 2 - 1; }
            pg8::gemm_phase<EpiRes, DenseSched, true>(P.lds, D, S, E);
        }
        SEAM(g0 + 6); TEND(6); TBEG();
        if (PON(7) && IN(g0 + 7)) { const Args a = load_args(); unsigned char* ws = a.ws; const float* mod = (const float*)(ws + WS_MOD); bf16* proj = (bf16*)(ws + WS_PROJ); bf16* xb = (bf16*)(ws + WS_XB); (void)mod; (void)proj; (void)xb; const Ctx P = fresh(X); p6_norm_route(a, P, l, xb); }
        SEAM(g0 + 7); TEND(7); TBEG();
        if (PON(8) && IN(g0 + 8)) for (int rep = 0; rep < NREP(8); ++rep) { const Args a = load_args(); unsigned char* ws = a.ws; const float* mod = (const float*)(ws + WS_MOD); bf16* proj = (bf16*)(ws + WS_PROJ); bf16* xb = (bf16*)(ws + WS_XB); (void)mod; (void)proj; (void)xb; const Ctx P = fresh(X);
            const MoeTab tb = moe_tables(a, P, l);
            LAS unsigned* tokoff = (LAS unsigned*)(P.lds + TOKOFF_OFF); const int* tokl = (const int*)(ws + WS_TOKL);
#pragma unroll 1
            for (int s = 0; s < 8; ++s) { const int L0 = s * P.G + P.bid;
                if (L0 < tb.Rtot * 8 && P.tid < 256) { const int L = xcd_remap(L0, tb.Rtot * 8); const int rt = L >> 3, cls = tb.tcls[rt], pos = tb.tpos[rt] + P.tid, cn = tb.cnt[cls]; const int tok = tokl[cls * CLS_CAP + (pos < cn ? pos : 0)]; tokoff[s * 256 + P.tid] = (unsigned)tok; } }
            __syncthreads();
            MoeUpSched S; S.A = (const char*)(ws + WS_H); S.W = (const char*)(ws + WS_WGU) + (size_t)l * NE * 1024 * D; S.lda = D; S.ldb = D; S.tb = tb; S.G = P.G; S.c = P.bid; S.tokoff = tokoff;
            EpiSwiglu E; E.H = (unsigned char*)proj; E.tgate = (const float*)(ws + WS_TGATE); E.tokoff = tokoff;
            pg8::gemm_phase<EpiSwiglu, MoeUpSched, true>(P.lds, D, S, E);
        }
        SEAM(g0 + 8); TEND(8); TBEG();
        if (PON(9) && IN(g0 + 9)) for (int rep = 0; rep < NREP(9); ++rep) { const Args a = load_args(); unsigned char* ws = a.ws; const float* mod = (const float*)(ws + WS_MOD); bf16* proj = (bf16*)(ws + WS_PROJ); bf16* xb = (bf16*)(ws + WS_XB); (void)mod; (void)proj; (void)xb; const Ctx P = fresh(X);
            const MoeTab tb = moe_tables(a, P, l);
            MoeDownSched S; S.A = (const char*)proj; S.W = (const char*)(ws + WS_WD) + (size_t)l * NE * 1024 * FF; S.lda = D; S.ldb = FF; S.tb = tb; S.G = P.G; S.c = P.bid;
            EpiMoeOut E; E.xin = xb; E.outb = xb; E.outf = a.out; E.last = (l == NL - 1); E.g = mod + (size_t)(l * 2) * 6144 + 5 * 1024; E.tokl = (const int*)(ws + WS_TOKL); E.tb = tb; E.rmask = T - 1;
            if (rep) { E.outb = (bf16*)(ws + WS_H); E.last = 0; E.rmask = T / 2 - 1; }
            pg8::gemm_phase<EpiMoeOut, MoeDownSched, true>(P.lds, D, S, E);
        }
        SEAM(g0 + 9); TEND(9); TBEG();
    }
    if (TSEL_MASK && X.bid == 0) { const unsigned long long t1 = __builtin_amdgcn_s_memrealtime(); while (__builtin_amdgcn_s_memrealtime() - t1 < TSCALE * tacc) __builtin_amdgcn_s_sleep(8); }
#undef IN
#undef SEAM
}

extern "C" void kernel_launch(void* const* d_in, const int* in_sizes, int n_in, void* d_out, int out_size, void* d_ws, size_t ws_size, hipStream_t stream) {
    static int grid = 0;
    if (grid == 0) {
        if (n_in != 24 || in_sizes[0] != T * D || out_size != T * D || ws_size < WS_END) { fprintf(stderr, "kernel_launch: unexpected shapes / workspace (n_in %d, ws %zu, need %zu)\n", n_in, ws_size, (size_t)WS_END); grid = -1; return; }
        int dev = 0, cus = 0;
        if (hipGetDevice(&dev) != hipSuccess || hipDeviceGetAttribute(&cus, hipDeviceAttributeMultiprocessorCount, dev) != hipSuccess) { grid = -1; return; }
        if (hipFuncSetAttribute((const void*)fwd, hipFuncAttributeMaxDynamicSharedMemorySize, LDS_BYTES) != hipSuccess) { fprintf(stderr, "kernel_launch: hipFuncSetAttribute failed\n"); grid = -1; return; }
        int per_cu = 0;
        if (hipOccupancyMaxActiveBlocksPerMultiprocessor(&per_cu, (const void*)fwd, 512, LDS_BYTES) != hipSuccess || per_cu < 1) fprintf(stderr, "kernel_launch: occupancy query reports %d\n", per_cu);
        (void)hipGetLastError();
        grid = cus < 256 ? cus : 256;
    }
    if (grid < 0) return;
    (void)hipMemsetAsync((char*)d_ws + WS_CTL, 0, CTL_ZERO_BYTES, stream);
    Args a{};
    a.x = (const float*)d_in[0]; a.c = (const float*)d_in[1]; a.pos = (const int*)d_in[2]; a.ada_w = (const float*)d_in[3]; a.ada_b = (const float*)d_in[4];
    a.nmw = (const float*)d_in[5]; a.nfw = (const float*)d_in[6]; a.w_in = (const float*)d_in[7]; a.b_ig = (const float*)d_in[8]; a.b_fg = (const float*)d_in[9];
    a.qnw = (const float*)d_in[10]; a.knw = (const float*)d_in[11]; a.sinks = (const float*)d_in[12]; a.conv_w = (const float*)d_in[13]; a.conv_b = (const float*)d_in[14];
    a.mnw = (const float*)d_in[15]; a.w_au = (const float*)d_in[16]; a.w_mu = (const float*)d_in[17]; a.w_out = (const float*)d_in[18]; a.router_w = (const float*)d_in[19];
    a.router_b = (const float*)d_in[20]; a.w_gate = (const float*)d_in[21]; a.w_up = (const float*)d_in[22]; a.w_down = (const float*)d_in[23];
    a.out = (float*)d_out; a.ws = (unsigned char*)d_ws;
#if MK_MULTI
    for (int gp = 0; gp < NGP; ++gp) { a.ph_lo = gp; a.ph_hi = gp + 1; hipLaunchKernelGGL(fwd, dim3(grid), dim3(512), LDS_BYTES, stream, a); }
#else
    a.ph_lo = 0; a.ph_hi = NGP; hipLaunchKernelGGL(fwd, dim3(grid), dim3(512), LDS_BYTES, stream, a);
#endif
}
```

```cpp
#include <hip/hip_runtime.h>
#include <cstdio>
#include <cstdint>

#ifndef MK_MULTI
#define MK_MULTI 0
#endif

#define GAS __attribute__((address_space(1)))
#define LAS __attribute__((address_space(3)))
typedef unsigned short bf16;
typedef unsigned v4u __attribute__((ext_vector_type(4)));
typedef unsigned v2u __attribute__((ext_vector_type(2)));
typedef float f32x4 __attribute__((ext_vector_type(4)));
typedef float f32x2 __attribute__((ext_vector_type(2)));
typedef short bf16x8 __attribute__((ext_vector_type(8)));
typedef short bf16x4 __attribute__((ext_vector_type(4)));
#define DI __device__ __forceinline__
#define RLX_AGENT __ATOMIC_RELAXED, __HIP_MEMORY_SCOPE_AGENT
#define LDS_WAIT() asm volatile("s_waitcnt lgkmcnt(0)" ::: "memory")
#define VM_WAIT() asm volatile("s_waitcnt vmcnt(0)" ::: "memory")

constexpr int NB = 2, SEQ = 16384, T = NB * SEQ, D = 1024, NL = 4;
constexpr int DIN_SRC = 4872;
constexpr int NPROJ = 4864;
constexpr int C_AQ = 0, C_AK = 512, C_AV = 640, C_MQ = 768, C_MK = 1280, C_MV = 1792, C_MO = 2304, C_GA = 2816, C_GB = 3840;
constexpr int NE = 16, FF = 512;
constexpr int NCLS = 24, CLS_CAP = 32768;
constexpr float EPS = 1e-6f;
constexpr int NPH = 10;
constexpr int NGP = 1 + NL * NPH;

constexpr size_t MiB = 1u << 20;
constexpr size_t WS_CTL = 0, CTL_ZERO_BYTES = 1 * MiB;
constexpr size_t WS_MOD = 1 * MiB;
constexpr size_t WS_ROPE = 2 * MiB;
constexpr size_t WS_GATES = 4 * MiB;
constexpr size_t WS_TGATE = 5 * MiB;
constexpr size_t WS_TOKL = 6 * MiB;
constexpr size_t WS_MLB = 9 * MiB;
constexpr size_t WS_MLC = 10 * MiB;
constexpr int NPROJW = 5120;
constexpr size_t WS_WIN = 28 * MiB;
constexpr size_t WS_WAU = 68 * MiB;
constexpr size_t WS_WMU = 72 * MiB;
constexpr size_t WS_WOUT = 76 * MiB;
constexpr size_t WS_WGU = 84 * MiB;
constexpr size_t WS_WD = 148 * MiB;
constexpr size_t WS_H = 212 * MiB;
constexpr size_t WS_PROJ = 276 * MiB;
constexpr size_t WS_SSQ = 580 * MiB;
constexpr size_t WS_KC = 582 * MiB;
constexpr size_t WS_XB = 614 * MiB;
constexpr size_t WS_END = 678 * MiB;

constexpr int CW_TMO = 0;
constexpr int CW_BAR = 4096;
constexpr int CW_CNT = 8192;

constexpr int RING_BYTES = 131072;
constexpr int MISC_OFF = RING_BYTES;
constexpr int TAB_OFF = RING_BYTES + 256;
constexpr int TOKOFF_OFF = RING_BYTES + 2048;
constexpr int LDS_BYTES = 147456;

typedef __bf16 bf16x2_t __attribute__((ext_vector_type(2)));
DI unsigned cvt_pk_bf16(float lo, float hi) { const f32x2 v = {lo, hi}; return __builtin_bit_cast(unsigned, __builtin_convertvector(v, bf16x2_t)); }
DI unsigned pk2m(float lo, float hi) { return cvt_pk_bf16(lo, hi); }
DI unsigned f2bf(float f) { return cvt_pk_bf16(f, 0.f) & 0xffffu; }
DI unsigned pk2(float lo, float hi) { return cvt_pk_bf16(lo, hi); }
DI float bf2f(unsigned short b) { return __builtin_bit_cast(float, ((unsigned)b) << 16); }
DI float bflo(unsigned w) { return __builtin_bit_cast(float, w << 16); }
DI float bfhi(unsigned w) { return __builtin_bit_cast(float, w & 0xffff0000u); }
DI float shx(float v, int m, int lane) { return __builtin_bit_cast(float, __builtin_amdgcn_ds_bpermute((lane ^ m) << 2, __builtin_bit_cast(int, v))); }
DI float shl_(float v, int src) { return __builtin_bit_cast(float, __builtin_amdgcn_ds_bpermute(src << 2, __builtin_bit_cast(int, v))); }
DI float wave_sum(float v, int lane) {
#pragma unroll
    for (int o = 1; o < 64; o <<= 1) v += shx(v, o, lane);
    return v;
}
DI unsigned pk4_fp8(float a0, float a1, float a2, float a3) { int p = __builtin_amdgcn_cvt_pk_fp8_f32(a0, a1, 0, false); p = __builtin_amdgcn_cvt_pk_fp8_f32(a2, a3, p, true); return (unsigned)p; }
DI float sigmoidf_(float x) { return __builtin_amdgcn_rcpf(1.0f + __expf(-x)); }

#define XB_TMO      128
#define XB_XCNT(j)  (256  + 64 * (j))
#define XB_XSUB(j)  (1280 + 64 * (j))
#define XB_XGEN(j)  (2304 + 64 * (j))
#define XB_TOP      3328
#define XB_TOPGEN   3392
#define XCD_BAR_WORDS 3456
#define XB_SPIN_CAP (1u << 18)
__device__ __forceinline__ unsigned xb_ld(unsigned* p)              { return __hip_atomic_load(p, __ATOMIC_RELAXED, __HIP_MEMORY_SCOPE_AGENT); }
__device__ __forceinline__ unsigned xb_add(unsigned* p, unsigned v) { return __hip_atomic_fetch_add(p, v, __ATOMIC_RELAXED, __HIP_MEMORY_SCOPE_AGENT); }
__device__ __forceinline__ unsigned xb_xcc_id() { return (unsigned)__builtin_amdgcn_s_getreg((3 << 11) | 20) & 0xFu; }
#define XB_SPIN(cond, bar) do { unsigned _sp = 0; while (cond) { __builtin_amdgcn_s_sleep(1); \
    if ((++_sp & 255u) == 0u) { if (xb_ld(&(bar)[XB_TMO])) break; if (_sp > XB_SPIN_CAP) { atomicAdd(&(bar)[XB_TMO], 1u); break; } } } } while (0)
struct XcdBarrier { unsigned* bar; unsigned x; volatile LAS unsigned* st; };
__device__ __forceinline__ XcdBarrier xcd_barrier_post(unsigned* bar, volatile LAS unsigned* st) {
    XcdBarrier b; b.bar = bar; b.x = xb_xcc_id(); b.st = st;
    if (threadIdx.x == 0) (void)xb_add(&bar[XB_XCNT(b.x)], 1u);
    return b;
}
__device__ __forceinline__ void xcd_barrier_complete(unsigned* bar, unsigned x, unsigned& nloc, unsigned& nx) {
    const unsigned G = gridDim.x * gridDim.y * gridDim.z;
    unsigned sum, cnt, mine, sp = 0u;
    for (;;) {
        sum = 0u; cnt = 0u; mine = 0u;
#pragma unroll
        for (unsigned j = 0; j < 16; ++j) { const unsigned c = xb_ld(&bar[XB_XCNT(j)]); sum += c; cnt += (c > 0u) ? 1u : 0u; mine = (j == x) ? c : mine; }
        if (sum == G) break;
        __builtin_amdgcn_s_sleep(1);
        if ((++sp & 255u) == 0u) { if (xb_ld(&bar[XB_TMO])) break; if (sp > XB_SPIN_CAP) { atomicAdd(&bar[XB_TMO], 1u); break; } }
    }
    nloc = mine > 0u ? mine : 1u; nx = cnt > 0u ? cnt : 1u;
}
__device__ __forceinline__ void xcd_barrier(const XcdBarrier& b) {
    asm volatile("s_waitcnt vmcnt(0)" ::: "memory");
    __syncthreads();
    if (threadIdx.x == 0) {
        unsigned* bar = b.bar; asm volatile("" : "+s"(bar));
        __builtin_amdgcn_s_waitcnt(0);
        unsigned nloc = b.st[0], nx = b.st[1];
        if (nloc == 0u) { xcd_barrier_complete(bar, b.x, nloc, nx); b.st[0] = nloc; b.st[1] = nx; }
        const unsigned old = xb_add(&bar[XB_XSUB(b.x)], 1u);
        const unsigned gen = old / nloc;
        if (old + 1u == (gen + 1u) * nloc) {
            __builtin_amdgcn_fence(__ATOMIC_RELEASE, "agent");
            asm volatile("s_waitcnt vmcnt(0)" ::: "memory");
            const unsigned og = xb_add(&bar[XB_TOP], 1u);
            const unsigned tg = og / nx;
            if (og + 1u == (tg + 1u) * nx) xb_add(&bar[XB_TOPGEN], 1u);
            else XB_SPIN(xb_ld(&bar[XB_TOPGEN]) == tg, bar);
            __builtin_amdgcn_fence(__ATOMIC_ACQUIRE, "agent");
            xb_add(&bar[XB_XGEN(b.x)], 1u);
            asm volatile("s_waitcnt vmcnt(0)" ::: "memory");
        } else {
            XB_SPIN(xb_ld(&bar[XB_XGEN(b.x)]) == gen, bar);
            __builtin_amdgcn_fence(__ATOMIC_ACQUIRE, "agent");
            asm volatile("s_waitcnt vmcnt(0)" ::: "memory");
        }
    }
    __syncthreads();
}

namespace pg8 {
constexpr int BM = 256, BK = 64, HALF = 128, HTB = HALF * BK * 2, STAGE_BYTES = 8 * HTB, NXCD = 8, WGM = 8;
__host__ __device__ __forceinline__ int lds_byte(int r, int c) { const int st = (r >> 4) * 2 + (c >> 5), rr = r & 15, cc = c & 31, ob = rr * 64 + cc * 2; return st * 1024 + (ob ^ (((ob >> 9) & 1) << 5)); }
__host__ __device__ __forceinline__ void stage_rc(int b, int& R, int& C) { const int st = b / 1024, sb = b % 1024, swz = sb ^ (((sb >> 9) & 1) << 5); R = (st >> 1) * 16 + swz / 64; C = (st & 1) * 32 + (swz % 64) / 2; }
__host__ __device__ __forceinline__ int perm32(int rho) { const int n = rho >> 4, i = rho & 15; return 8 * (i >> 2) + 4 * n + (i & 3); }

struct Unit { int pm, pn, x0, x1; };

struct TileOrder {
    int nM, nN, nwg, G, c;
    __device__ void init(int nM_, int nN_, int G_, int c_) { nM = nM_; nN = nN_; nwg = nM * nN; G = G_; c = c_; }
    __device__ bool get(int i, int& pm, int& pn) const {
        const long L = (long)i * G + c; if (L >= nwg) return false;
        int wgid = (int)L; { const int q = nwg / NXCD, r = nwg % NXCD, xcd = wgid % NXCD, off = wgid / NXCD; wgid = (xcd < r ? xcd * (q + 1) : r * (q + 1) + (xcd - r) * q) + off; }
        const int nig = WGM * nN, gid = wgid / nig, fm = gid * WGM, gsz = (nM - fm) < WGM ? (nM - fm) : WGM;
        pm = fm + ((wgid % nig) % gsz); pn = (wgid % nig) / gsz; return true;
    }
};

typedef int v8i __attribute__((ext_vector_type(8)));
template <class Epi, class Sched, bool F8 = false>
__device__ __forceinline__ void gemm_phase(LAS unsigned char* lds, const int Kb, const Sched& S, const Epi& E) {
    int tid = threadIdx.x; asm volatile("" : "+v"(tid));
    const int wid = __builtin_amdgcn_readfirstlane(tid >> 6), lane = tid & 63, wr = wid >> 2, wc = wid & 3, fr = lane & 15, fq = lane >> 4;
    const int nt = Kb / 128;
    constexpr bool GA = Sched::GATHER; constexpr int KS = Sched::KSPLIT; constexpr bool ASPLIT = Sched::ASPLIT;
    unsigned voffA[2], voffB[2]; int Rst[2], Cst[2];
#pragma unroll
    for (int i = 0; i < 2; ++i) { int R, C; stage_rc(tid * 16 + i * 8192, R, C); const int Rb = Epi::PERM ? ((R & ~31) + perm32(R & 31)) : R;
        voffA[i] = (unsigned)(R * S.lda + C * 2); voffB[i] = (unsigned)(Rb * S.ldb + C * 2); Rst[i] = R; Cst[i] = C; }
    const size_t kstep = (size_t)(BK * 2);
    const size_t hstepA = (size_t)HALF * S.lda, hstepB = (size_t)HALF * S.ldb;
    const unsigned ldsw = (unsigned)wid * 1024u; const unsigned gmul = (unsigned)S.lda;
    const int aoff = F8 ? (lds_byte(wr * 64 + fr, (fq & 1) * 16) + (fq >> 1) * 1024) : lds_byte(wr * 64 + fr, fq * 8);
    const int boff = F8 ? (lds_byte(wc * 32 + fr, (fq & 1) * 16) + (fq >> 1) * 1024) : lds_byte(wc * 32 + fr, fq * 8);
    unsigned vAc[2], vAn[2];
#define PG8_SA(b, h) (((b) * 2 + (h)) * HTB)
#define PG8_SB(b, h) ((4 + (b) * 2 + (h)) * HTB)
#define PG8_STAGE2(bufoff, gbase, v0, v1) do { \
        __builtin_amdgcn_global_load_lds((const unsigned*)((const char*)(gbase) + (v0)), (LAS unsigned*)(lds + (bufoff) + ldsw), 16, 0, 0); \
        __builtin_amdgcn_global_load_lds((const unsigned*)((const char*)(gbase) + (v1)), (LAS unsigned*)(lds + (bufoff) + ldsw + 8192), 16, 0, 0); } while (0)
#define PG8_STAGE_B(bufoff, ptr, h) PG8_STAGE2(bufoff, (ptr) + (h) * hstepB, voffB[0], voffB[1])
#define PG8_STAGE_A(bufoff, ptr, h, nx) do { if constexpr (GA) { const unsigned _p = (nx) ? vAn[h] : vAc[h]; PG8_STAGE2(bufoff, ptr, (_p & 0xffffu) * gmul + (unsigned)Cst[0] * 2u, (_p >> 16) * gmul + (unsigned)Cst[0] * 2u); } \
        else { PG8_STAGE2(bufoff, (ptr) + (h) * hstepA, voffA[0], voffA[1]); } } while (0)
    typedef int v4i_ __attribute__((ext_vector_type(4)));
#define PG8_LDA(dst, b, h) do { _Pragma("unroll") for (int m = 0; m < 4; ++m) { if constexpr (F8) { dst##8[m].lo = *(const LAS v4i_*)(lds + PG8_SA(b, h) + aoff + m * 2048); dst##8[m].hi = *(const LAS v4i_*)(lds + PG8_SA(b, h) + aoff + m * 2048 + 16); } \
        else { _Pragma("unroll") for (int k = 0; k < 2; ++k) dst[m][k] = *(const LAS bf16x8*)(lds + PG8_SA(b, h) + aoff + m * 2048 + k * 1024); } } } while (0)
#define PG8_LDB(dst, b, h) do { _Pragma("unroll") for (int n = 0; n < 2; ++n) { if constexpr (F8) { dst##8[n].lo = *(const LAS v4i_*)(lds + PG8_SB(b, h) + boff + n * 2048); dst##8[n].hi = *(const LAS v4i_*)(lds + PG8_SB(b, h) + boff + n * 2048 + 16); } \
        else { _Pragma("unroll") for (int k = 0; k < 2; ++k) dst[n][k] = *(const LAS bf16x8*)(lds + PG8_SB(b, h) + boff + n * 2048 + k * 1024); } } } while (0)
#define PG8_MMA(ai, bj, At, Bt) do { __builtin_amdgcn_s_setprio(1); _Pragma("unroll") for (int m = 0; m < 4; ++m) _Pragma("unroll") for (int n = 0; n < 2; ++n) { \
        if constexpr (F8) { asm volatile("v_mfma_scale_f32_16x16x128_f8f6f4 %0, %1, %2, %0, %3, %3 op_sel_hi:[0,0,0]" : "+v"(acc[ai][bj][m][n]) : "v"(Bt##8[n]), "v"(At##8[m]), "v"(f8scale)); } \
        else { _Pragma("unroll") for (int k = 0; k < 2; ++k) acc[ai][bj][m][n] = __builtin_amdgcn_mfma_f32_16x16x32_bf16(Bt[n][k], At[m][k], acc[ai][bj][m][n], 0, 0, 0); } } \
        __builtin_amdgcn_s_setprio(0); } while (0)
#define PG8_WAIT_V(n) asm volatile("s_waitcnt vmcnt(" #n ")" ::: "memory")
#define PG8_WAIT_L(n) asm volatile("s_waitcnt lgkmcnt(" #n ")" ::: "memory")
#define PG8_BAR __builtin_amdgcn_s_barrier()
#define PG8_SCHED __builtin_amdgcn_sched_barrier(0)
#define PG8_GOFF(dst, u) do { if constexpr (GA) { _Pragma("unroll") for (int h = 0; h < 2; ++h) dst[h] = S.a_rowoff(u, Rst[0] + HALF * h) | (S.a_rowoff(u, Rst[0] + 64 + HALF * h) << 16); } } while (0)
    Unit cur, nxt; int ui = 0;
    if (!S.next(0, cur)) return;
    f32x4 acc[2][2][4][2];
#pragma unroll
    for (int a = 0; a < 2; ++a)
#pragma unroll
        for (int b = 0; b < 2; ++b)
#pragma unroll
            for (int m = 0; m < 4; ++m)
#pragma unroll
                for (int n = 0; n < 2; ++n) acc[a][b][m][n] = (f32x4){0.f, 0.f, 0.f, 0.f};
    int f8scale = 0x7F7F7F7F; asm volatile("" : "+v"(f8scale));
    bf16x8 At[4][2], B0[2][2], B1[2][2]; v8i At8[4], B08[2], B18[2];
    const char* cA = S.a_base(cur, 0); const char* cA1 = ASPLIT ? S.a_base(cur, 1) : cA; const char* cB0 = S.b_base(cur, 0); const char* cB1 = KS ? S.b_base(cur, 1) : cB0;
    PG8_GOFF(vAc, cur);
    vAn[0] = vAc[0]; vAn[1] = vAc[1];
    PG8_STAGE_B(PG8_SB(0, 0), cB0, 0); PG8_STAGE_B(PG8_SB(0, 1), cB0, 1); PG8_STAGE_A(PG8_SA(0, 0), cA, 0, false); PG8_STAGE_A(PG8_SA(0, 1), cA, 1, false);
    if (wr == 1) PG8_BAR;
    PG8_WAIT_V(2); PG8_BAR;
    PG8_STAGE_B(PG8_SB(1, 0), cB0 + kstep, 0); PG8_STAGE_A(PG8_SA(1, 0), cA + kstep, 0, false); PG8_STAGE_B(PG8_SB(1, 1), cB0 + kstep, 1);
    PG8_WAIT_V(6); PG8_BAR;
    for (;;) {
        const bool has_next = S.next(ui + 1, nxt);
        const char* nA = has_next ? S.a_base(nxt, 0) : cA; const char* nA1 = (ASPLIT && has_next) ? S.a_base(nxt, 1) : (ASPLIT ? cA1 : nA); const char* nB0 = has_next ? S.b_base(nxt, 0) : cB0; const char* nB1 = (KS && has_next) ? S.b_base(nxt, 1) : (KS ? cB1 : nB0);
        if constexpr (GA) { if (has_next) { PG8_GOFF(vAn, nxt); } }
#pragma unroll 1
        for (int t = 0; t < nt; t += 2) {
            const bool last = (t == nt - 2);
            const char* a1 = (ASPLIT && (t + 1) >= KS) ? cA1 + (size_t)(t + 1 - KS) * kstep : cA + (size_t)(t + 1) * kstep;
            const char* a2 = last ? nA : ((ASPLIT && (t + 2) >= KS) ? cA1 + (size_t)(t + 2 - KS) * kstep : cA + (size_t)(t + 2) * kstep);
            if constexpr (Epi::MID) { if (t == KS) { int fr_ = fr, fq_ = fq; asm volatile("" : "+v"(fr_), "+v"(fq_)); if constexpr (F8) { asm volatile("s_nop 15" ::: "memory"); } E.mid(acc, cur, wr, wc, fr_, fq_); if constexpr (F8) { asm volatile("s_nop 3" ::: "memory"); } } }
            const char* b2 = last ? nB0 : ((KS && (t + 2) >= KS) ? cB1 + (size_t)(t + 2 - KS) * kstep : cB0 + (size_t)(t + 2) * kstep);
            const char* a3 = a2 + kstep; const char* b3 = b2 + kstep;
            PG8_LDB(B0, 0, 0); PG8_LDB(B1, 0, 1); PG8_SCHED; PG8_LDA(At, 0, 0); PG8_STAGE_A(PG8_SA(1, 1), a1, 1, false);
            PG8_WAIT_V(8); PG8_WAIT_L(0); PG8_BAR; PG8_MMA(0, 0, At, B0); PG8_MMA(0, 1, At, B1); PG8_BAR; PG8_SCHED;
            PG8_LDA(At, 0, 1); PG8_STAGE_B(PG8_SB(0, 0), b2, 0); PG8_STAGE_B(PG8_SB(0, 1), b2, 1); PG8_STAGE_A(PG8_SA(0, 0), a2, 0, last);
            PG8_WAIT_V(8); PG8_WAIT_L(0); PG8_BAR; PG8_MMA(1, 0, At, B0); PG8_MMA(1, 1, At, B1); PG8_BAR; PG8_SCHED;
            PG8_LDB(B0, 1, 0); PG8_LDB(B1, 1, 1); PG8_SCHED; PG8_LDA(At, 1, 0); PG8_STAGE_A(PG8_SA(0, 1), a2, 1, last);
            PG8_WAIT_V(8); PG8_WAIT_L(0); PG8_BAR; PG8_MMA(0, 0, At, B0); PG8_MMA(0, 1, At, B1); PG8_BAR; PG8_SCHED;
            PG8_LDA(At, 1, 1); PG8_STAGE_B(PG8_SB(1, 0), b3, 0); PG8_STAGE_B(PG8_SB(1, 1), b3, 1); PG8_STAGE_A(PG8_SA(1, 0), a3, 0, last);
            PG8_WAIT_V(8); PG8_WAIT_L(0); PG8_BAR; PG8_MMA(1, 0, At, B0); PG8_MMA(1, 1, At, B1); PG8_BAR; PG8_SCHED;
        }
        if (wr == 0) PG8_BAR;
        if constexpr (F8) { asm volatile("s_nop 15\n\ts_nop 15" ::: "memory"); }
        { int fr_ = fr, fq_ = fq; asm volatile("" : "+v"(fr_), "+v"(fq_));
          E(acc, cur, wr, wc, fr_, fq_); }
        if (!has_next) break;
#pragma unroll
        for (int a = 0; a < 2; ++a)
#pragma unroll
            for (int b = 0; b < 2; ++b)
#pragma unroll
                for (int m = 0; m < 4; ++m)
#pragma unroll
                    for (int n = 0; n < 2; ++n) acc[a][b][m][n] = (f32x4){0.f, 0.f, 0.f, 0.f};
        cur = nxt; cA = nA; cA1 = nA1; cB0 = nB0; cB1 = nB1; ++ui;
        vAc[0] = vAn[0]; vAc[1] = vAn[1];
        if (wr == 1) PG8_BAR;
    }
    PG8_WAIT_V(0);
    PG8_BAR;
#undef PG8_SA
#undef PG8_SB
#undef PG8_STAGE2
#undef PG8_STAGE_A
#undef PG8_STAGE_B
#undef PG8_LDA
#undef PG8_LDB
#undef PG8_MMA
#undef PG8_WAIT_V
#undef PG8_WAIT_L
#undef PG8_BAR
#undef PG8_SCHED
#undef PG8_GOFF
}
}
using pg8::Unit;


struct Args {
    const float* x; const float* c; const int* pos; const float* ada_w; const float* ada_b; const float* nmw; const float* nfw; const float* w_in;
    const float* b_ig; const float* b_fg; const float* qnw; const float* knw; const float* sinks; const float* conv_w; const float* conv_b; const float* mnw;
    const float* w_au; const float* w_mu; const float* w_out; const float* router_w; const float* router_b; const float* w_gate; const float* w_up; const float* w_down;
    float* out; unsigned char* ws; int ph_lo, ph_hi;
};

__constant__ float c_invf[8] = {1.0f, 0.1939227432012558f, 0.03760603070259094f, 0.007292664609849453f, 0.0014142135623842478f, 0.00027424818836152554f, 5.3182957344688475e-05f, 1.0313385246263351e-05f};

struct DenseSched {
    static constexpr bool GATHER = false, ASPLIT = false; static constexpr int KSPLIT = 0;
    const char* A; const char* Bt; int lda, ldb; pg8::TileOrder ord;
    DI bool next(int i, Unit& u) const { int pm, pn; if (!ord.get(i, pm, pn)) return false; u.pm = pm; u.pn = pn; u.x0 = 0; u.x1 = 0; return true; }
    DI const char* a_base(const Unit& u, int) const { return A + (size_t)u.pm * 256 * lda; }
    DI const char* b_base(const Unit& u, int) const { return Bt + (size_t)u.pn * 256 * ldb; }
    DI unsigned a_rowoff(const Unit&, int) const { return 0u; }
};
struct EpiProj {
    static constexpr bool PERM = true, MID = false;
    bf16* O; float* gates; const float* big; const float* bfg;
    DI void operator()(const f32x4 (&acc)[2][2][4][2], const Unit& u, int wr, int wc, int fr, int fq) const {
        const int row0 = u.pm * 256 + wr * 64 + fr, col0 = u.pn * 256 + wc * 32 + 8 * fq; const bool sg = u.pn >= 9; constexpr float WSC = 1.0f / 64.0f;
        if (u.pn == 19) {
            if (wc == 0 && fq == 0) {
#pragma unroll
                for (int ai = 0; ai < 2; ++ai)
#pragma unroll
                    for (int m = 0; m < 4; ++m) { const int row = row0 + ai * 128 + m * 16; const f32x4 vi = acc[ai][0][m][0], vf = acc[ai][0][m][1]; f32x4 oi, of;
#pragma unroll
                        for (int j = 0; j < 4; ++j) { oi[j] = vi[j] * WSC + big[j]; const float z = vf[j] * WSC + bfg[j]; of[j] = fminf(z, 0.f) - log1pf(__expf(-fabsf(z))); }
                        *(f32x4*)(gates + (size_t)row * 8) = oi; *(f32x4*)(gates + (size_t)row * 8 + 4) = of; } }
            return; }
#pragma unroll
        for (int ai = 0; ai < 2; ++ai)
#pragma unroll
            for (int m = 0; m < 4; ++m) { bf16* rowp = O + (size_t)(row0 + ai * 128 + m * 16) * NPROJ + col0;
#pragma unroll
                for (int bj = 0; bj < 2; ++bj) { f32x4 v0 = acc[ai][bj][m][0] * WSC, v1 = acc[ai][bj][m][1] * WSC;
                    if (sg) {
#pragma unroll
                        for (int j = 0; j < 4; ++j) { v0[j] = sigmoidf_(v0[j]); v1[j] = sigmoidf_(v1[j]); } }
                    v4u w; w.x = cvt_pk_bf16(v0[0], v0[1]); w.y = cvt_pk_bf16(v0[2], v0[3]); w.z = cvt_pk_bf16(v1[0], v1[1]); w.w = cvt_pk_bf16(v1[2], v1[3]);
                    *(v4u*)(rowp + bj * 128) = w; } }
    }
};
struct MergeSched {
    static constexpr bool GATHER = false, ASPLIT = true; static constexpr int KSPLIT = 4;
    const char* A0; const char* A1; const char* B0; const char* B1; int lda, ldb; pg8::TileOrder ord;
    DI bool next(int i, Unit& u) const { int pm, pn; if (!ord.get(i, pm, pn)) return false; u.pm = pm; u.pn = pn; u.x0 = 0; u.x1 = 0; return true; }
    DI const char* a_base(const Unit& u, int half) const { return (half ? A1 : A0) + (size_t)u.pm * 256 * lda; }
    DI const char* b_base(const Unit& u, int half) const { return (half ? B1 : B0) + (size_t)u.pn * 256 * ldb; }
    DI unsigned a_rowoff(const Unit&, int) const { return 0u; }
};
struct EpiMerge {
    static constexpr bool PERM = true, MID = true;
    bf16* P; int nul;
    DI void mid(f32x4 (&acc)[2][2][4][2], const Unit& u, int wr, int wc, int fr, int fq) const {
        if (nul) return;
        const int row0 = u.pm * 256 + wr * 64 + fr, col0 = u.pn * 256 + wc * 32 + 8 * fq;
#pragma unroll
        for (int ai = 0; ai < 2; ++ai) {
            v4u ga[4][2], gb[4][2];
#pragma unroll
            for (int m = 0; m < 4; ++m)
#pragma unroll
                for (int bj = 0; bj < 2; ++bj) { const bf16* rowp = P + (size_t)(row0 + ai * 128 + m * 16) * NPROJ + col0 + bj * 128; ga[m][bj] = *(const v4u*)(rowp + C_GA); gb[m][bj] = *(const v4u*)(rowp + C_GB); }
#pragma unroll
            for (int m = 0; m < 4; ++m)
#pragma unroll
                for (int bj = 0; bj < 2; ++bj) { const v4u a_ = ga[m][bj], b_ = gb[m][bj]; f32x4 r0, r1;
                    r0[0] = bflo(a_.x) * __builtin_amdgcn_rcpf(fmaxf(bflo(b_.x), 1e-30f)); r0[1] = bfhi(a_.x) * __builtin_amdgcn_rcpf(fmaxf(bfhi(b_.x), 1e-30f));
                    r0[2] = bflo(a_.y) * __builtin_amdgcn_rcpf(fmaxf(bflo(b_.y), 1e-30f)); r0[3] = bfhi(a_.y) * __builtin_amdgcn_rcpf(fmaxf(bfhi(b_.y), 1e-30f));
                    r1[0] = bflo(a_.z) * __builtin_amdgcn_rcpf(fmaxf(bflo(b_.z), 1e-30f)); r1[1] = bfhi(a_.z) * __builtin_amdgcn_rcpf(fmaxf(bfhi(b_.z), 1e-30f));
                    r1[2] = bflo(a_.w) * __builtin_amdgcn_rcpf(fmaxf(bflo(b_.w), 1e-30f)); r1[3] = bfhi(a_.w) * __builtin_amdgcn_rcpf(fmaxf(bfhi(b_.w), 1e-30f));
                    acc[ai][bj][m][0] *= r0; acc[ai][bj][m][1] *= r1; }
        }
    }
    DI void operator()(const f32x4 (&acc)[2][2][4][2], const Unit& u, int wr, int wc, int fr, int fq) const {
        if (nul) { if (acc[0][0][0][0][0] == 12345.678f) P[0] = 0; return; }
        const int row0 = u.pm * 256 + wr * 64 + fr, col0 = u.pn * 256 + wc * 32 + 8 * fq; constexpr float SC = 1.0f / 32.0f;
        v4u gw[2][4][2];
#pragma unroll
        for (int ai = 0; ai < 2; ++ai)
#pragma unroll
            for (int m = 0; m < 4; ++m)
#pragma unroll
                for (int bj = 0; bj < 2; ++bj) gw[ai][m][bj] = *(const v4u*)(P + (size_t)(row0 + ai * 128 + m * 16) * NPROJ + col0 + C_GB + bj * 128);
        asm volatile("" ::: "memory");
#pragma unroll
        for (int ai = 0; ai < 2; ++ai)
#pragma unroll
            for (int m = 0; m < 4; ++m) { unsigned char* mp = (unsigned char*)(P + (size_t)(row0 + ai * 128 + m * 16) * NPROJ + C_MQ) + col0;
#pragma unroll
                for (int bj = 0; bj < 2; ++bj) { const f32x4 v0 = acc[ai][bj][m][0] * SC, v1 = acc[ai][bj][m][1] * SC; const v4u g = gw[ai][m][bj];
                    v2u w; w.x = pk4_fp8(bflo(g.x) * v0[0], bfhi(g.x) * v0[1], bflo(g.y) * v0[2], bfhi(g.y) * v0[3]); w.y = pk4_fp8(bflo(g.z) * v1[0], bfhi(g.z) * v1[1], bflo(g.w) * v1[2], bfhi(g.w) * v1[3]);
                    *(v2u*)(mp + bj * 128) = w; } }
    }
};
struct EpiRes {
    static constexpr bool PERM = true, MID = false;
    const bf16* xin; bf16* out; const float* g; float* ssq; int rmask, nul;
    DI void operator()(const f32x4 (&acc)[2][2][4][2], const Unit& u, int wr, int wc, int fr, int fq) const {
        const int row0 = u.pm * 256 + wr * 64 + fr, col0 = u.pn * 256 + wc * 32 + 8 * fq; const int b = (u.pm * 256) >> 14;
        if (nul) { if (acc[0][0][0][0][0] == 12345.678f) out[0] = 0; return; }
        f32x4 gv[2][2];
#pragma unroll
        for (int bj = 0; bj < 2; ++bj)
#pragma unroll
            for (int n = 0; n < 2; ++n) gv[bj][n] = *(const f32x4*)(g + b * 6144 + col0 + bj * 128 + 4 * n) * (1.0f / 512.0f);
#pragma unroll
        for (int ai = 0; ai < 2; ++ai) {
            v4u xw[4][2];
#pragma unroll
            for (int m = 0; m < 4; ++m)
#pragma unroll
                for (int bj = 0; bj < 2; ++bj) xw[m][bj] = *(const v4u*)(xin + (size_t)(row0 + ai * 128 + m * 16) * D + col0 + bj * 128);
            asm volatile("" ::: "memory");
#pragma unroll
            for (int m = 0; m < 4; ++m) { const int row = row0 + ai * 128 + m * 16; float sq = 0.f;
#pragma unroll
                for (int bj = 0; bj < 2; ++bj) { const v4u w = xw[m][bj];
                    const f32x4 o0 = (f32x4){bflo(w.x), bfhi(w.x), bflo(w.y), bfhi(w.y)} + gv[bj][0] * acc[ai][bj][m][0];
                    const f32x4 o1 = (f32x4){bflo(w.z), bfhi(w.z), bflo(w.w), bfhi(w.w)} + gv[bj][1] * acc[ai][bj][m][1];
                    v4u ow; ow.x = cvt_pk_bf16(o0.x, o0.y); ow.y = cvt_pk_bf16(o0.z, o0.w); ow.z = cvt_pk_bf16(o1.x, o1.y); ow.w = cvt_pk_bf16(o1.z, o1.w);
                    const float r0 = bflo(ow.x), r1 = bfhi(ow.x), r2 = bflo(ow.y), r3 = bfhi(ow.y), r4 = bflo(ow.z), r5 = bfhi(ow.z), r6 = bflo(ow.w), r7 = bfhi(ow.w);
                    sq += ((r0 * r0 + r1 * r1) + (r2 * r2 + r3 * r3)) + ((r4 * r4 + r5 * r5) + (r6 * r6 + r7 * r7));
                    *(v4u*)(out + (size_t)(row & rmask) * D + col0 + bj * 128) = ow; }
                { const int ln = fq * 16 + fr; sq += shx(sq, 16, ln); sq += shx(sq, 32, ln); }
                if (fq == 0) ssq[(size_t)row * 16 + u.pn * 4 + wc] = sq; }
            asm volatile("" ::: "memory");
        }
    }
};

struct MoeTab { const LAS int* tcls; const LAS int* tpos; const LAS int* cnt; int Rtot; };
DI int xcd_remap(int L, int nwg) { const int q = nwg >> 3, r = nwg & 7, xcd = L & 7, off = L >> 3; return (xcd < r ? xcd * (q + 1) : r * (q + 1) + (xcd - r) * q) + off; }
DI void cls_experts(int cls, int& ea, int& eb) { const int g = cls / 6, p = cls - 6 * g; const int a = (p < 3) ? 0 : ((p < 5) ? 1 : 2); const int b = (p < 3) ? (p + 1) : ((p < 5) ? (p - 1) : 3); ea = 4 * g + a; eb = 4 * g + b; }
struct MoeUpSched {
    static constexpr bool GATHER = true, ASPLIT = false; static constexpr int KSPLIT = 0;
    const char* A; const char* W; int lda, ldb; MoeTab tb; int G, c; const LAS unsigned* tokoff;
    DI bool next(int i, Unit& u) const { const int L0 = i * G + c; if (L0 >= tb.Rtot * 8) return false; const int L = xcd_remap(L0, tb.Rtot * 8); u.pm = L >> 3; u.pn = L & 7; u.x0 = i; u.x1 = __builtin_amdgcn_readfirstlane(tb.tcls[u.pm]); return true; }
    DI const char* a_base(const Unit&, int) const { return A; }
    DI const char* b_base(const Unit& u, int) const { int ea, eb; cls_experts(u.x1, ea, eb); const int e = (u.pn < 4) ? ea : eb; return W + ((size_t)e * 1024 + (size_t)(u.pn & 3) * 256) * ldb; }
    DI unsigned a_rowoff(const Unit& u, int r) const { return tokoff[u.x0 * 256 + r]; }
};
struct EpiSwiglu {
    static constexpr bool PERM = true, MID = false;
    unsigned char* H; const float* tgate; const LAS unsigned* tokoff;
    DI void operator()(const f32x4 (&acc)[2][2][4][2], const Unit& u, int wr, int wc, int fr, int fq) const {
        const int r0 = wr * 64 + fr; const int hc = (u.pn >> 2) * 512 + (u.pn & 3) * 128 + wc * 32 + 8 * fq; const int gsel = u.pn >> 2;
        float rgv[2][4];
#pragma unroll
        for (int ai = 0; ai < 2; ++ai)
#pragma unroll
            for (int m = 0; m < 4; ++m) { const unsigned tok = tokoff[u.x0 * 256 + r0 + ai * 128 + m * 16]; rgv[ai][m] = tgate[tok * 2 + gsel] * 8.0f; }
        asm volatile("" ::: "memory");
#pragma unroll
        for (int ai = 0; ai < 2; ++ai)
#pragma unroll
            for (int m = 0; m < 4; ++m) { const int r = r0 + ai * 128 + m * 16; const float rg = rgv[ai][m];
                const f32x4 g0 = acc[ai][0][m][0] * (1.0f / 64.0f), g1 = acc[ai][0][m][1] * (1.0f / 64.0f), u0 = acc[ai][1][m][0] * (1.0f / 64.0f), u1 = acc[ai][1][m][1] * (1.0f / 64.0f);
                float o[8];
#pragma unroll
                for (int j = 0; j < 4; ++j) { o[j] = g0[j] * sigmoidf_(g0[j]) * u0[j] * rg; o[4 + j] = g1[j] * sigmoidf_(g1[j]) * u1[j] * rg; }
#pragma unroll
                for (int j = 0; j < 8; ++j) o[j] = fminf(fmaxf(o[j], -440.0f), 440.0f);
                v2u w; w.x = pk4_fp8(o[0], o[1], o[2], o[3]); w.y = pk4_fp8(o[4], o[5], o[6], o[7]);
                *(v2u*)(H + ((size_t)u.pm * 256 + r) * 1024 + hc) = w; }
    }
};
struct MoeDownSched {
    static constexpr bool GATHER = false, ASPLIT = false; static constexpr int KSPLIT = 4;
    const char* A; const char* W; int lda, ldb; MoeTab tb; int G, c;
    DI bool next(int i, Unit& u) const { const int L0 = i * G + c; if (L0 >= tb.Rtot * 4) return false; const int L = xcd_remap(L0, tb.Rtot * 4); u.pm = L >> 2; u.pn = L & 3; u.x0 = __builtin_amdgcn_readfirstlane(tb.tpos[u.pm]); u.x1 = __builtin_amdgcn_readfirstlane(tb.tcls[u.pm]); return true; }
    DI const char* a_base(const Unit& u, int) const { return A + (size_t)u.pm * 256 * lda; }
    DI const char* b_base(const Unit& u, int half) const { int ea, eb; cls_experts(u.x1, ea, eb); const int e = half ? eb : ea; return W + ((size_t)e * 1024 + (size_t)u.pn * 256) * ldb; }
    DI unsigned a_rowoff(const Unit&, int) const { return 0u; }
};
struct EpiMoeOut {
    static constexpr bool PERM = true, MID = false;
    const bf16* xin; bf16* outb; float* outf; const float* g; const int* tokl; MoeTab tb; int rmask, last;
    DI void operator()(const f32x4 (&acc)[2][2][4][2], const Unit& u, int wr, int wc, int fr, int fq) const {
        const int r0 = wr * 64 + fr, col0 = u.pn * 256 + wc * 32 + 8 * fq; const int cn = tb.cnt[u.x1];
        v2u gvp[2][2][2];
#pragma unroll
        for (int b = 0; b < 2; ++b)
#pragma unroll
            for (int bj = 0; bj < 2; ++bj)
#pragma unroll
                for (int n = 0; n < 2; ++n) { const f32x4 t = *(const f32x4*)(g + b * 6144 + col0 + bj * 128 + 4 * n) * (1.0f / 256.0f); gvp[b][bj][n].x = cvt_pk_bf16(t.x, t.y); gvp[b][bj][n].y = cvt_pk_bf16(t.z, t.w); }
        int tok[2][4];
#pragma unroll
        for (int ai = 0; ai < 2; ++ai)
#pragma unroll
            for (int m = 0; m < 4; ++m) { const int pos = u.x0 + r0 + ai * 128 + m * 16; tok[ai][m] = (pos < cn) ? tokl[u.x1 * CLS_CAP + pos] : -1; }
#pragma unroll
        for (int ai = 0; ai < 2; ++ai) {
            v4u xw[4][2];
#pragma unroll
            for (int m = 0; m < 4; ++m)
#pragma unroll
                for (int bj = 0; bj < 2; ++bj) { const int tk = tok[ai][m] < 0 ? 0 : tok[ai][m]; xw[m][bj] = *(const v4u*)(xin + (size_t)tk * D + col0 + bj * 128); }
            asm volatile("" ::: "memory");
#pragma unroll
            for (int m = 0; m < 4; ++m) { const int tk = tok[ai][m];
                if (tk >= 0) { const bool b1 = (tk >> 14) != 0;
#pragma unroll
                    for (int bj = 0; bj < 2; ++bj) { const v4u w = xw[m][bj];
                        const v2u pa = b1 ? gvp[1][bj][0] : gvp[0][bj][0], pb = b1 ? gvp[1][bj][1] : gvp[0][bj][1];
                        const f32x4 ga = {bflo(pa.x), bfhi(pa.x), bflo(pa.y), bfhi(pa.y)}, gb = {bflo(pb.x), bfhi(pb.x), bflo(pb.y), bfhi(pb.y)};
                        const f32x4 o0 = (f32x4){bflo(w.x), bfhi(w.x), bflo(w.y), bfhi(w.y)} + ga * acc[ai][bj][m][0];
                        const f32x4 o1 = (f32x4){bflo(w.z), bfhi(w.z), bflo(w.w), bfhi(w.w)} + gb * acc[ai][bj][m][1];
                        if (last) { float* of = outf + (size_t)tk * D + col0 + bj * 128; *(f32x4*)of = o0; *(f32x4*)(of + 4) = o1; }
                        else { v4u ow; ow.x = cvt_pk_bf16(o0.x, o0.y); ow.y = cvt_pk_bf16(o0.z, o0.w); ow.z = cvt_pk_bf16(o1.x, o1.y); ow.w = cvt_pk_bf16(o1.z, o1.w);
                            *(v4u*)(outb + (size_t)(tk & rmask) * D + col0 + bj * 128) = ow; } } } }
            asm volatile("" ::: "memory");
        }
    }
};

struct Ctx { LAS unsigned char* lds; int tid, lane, wave, G, bid; };
DI Ctx fresh(const Ctx& X) { Ctx P = X; int t = X.tid; asm volatile("" : "+v"(t)); P.tid = t; P.lane = t & 63; P.wave = __builtin_amdgcn_readfirstlane(t >> 6); return P; }

DI void tr_item(const float* W, int ldw, int K, bf16* WT, int k0, LAS float* scr, int lane) {
    { const int rr = lane >> 3, c4 = lane & 7; f32x4 v[8];
#pragma unroll
      for (int i = 0; i < 8; ++i) v[i] = *(const f32x4*)(W + (size_t)(k0 + rr + 8 * i) * ldw + 4 * c4);
#pragma unroll
      for (int i = 0; i < 8; ++i) { LAS float* d = scr + (rr + 8 * i) * 33 + 4 * c4; d[0] = v[i].x; d[1] = v[i].y; d[2] = v[i].z; d[3] = v[i].w; } }
    LDS_WAIT(); asm volatile("" ::: "memory");
    const int c = lane & 7;
#pragma unroll
    for (int j = 0; j < 4; ++j) { const int n = (lane >> 3) + 8 * j; const LAS float* s = scr + (8 * c) * 33 + n;
        v4u o; o.x = pk2(s[0 * 33], s[1 * 33]); o.y = pk2(s[2 * 33], s[3 * 33]); o.z = pk2(s[4 * 33], s[5 * 33]); o.w = pk2(s[6 * 33], s[7 * 33]);
        *(v4u*)(WT + (size_t)n * K + k0 + 8 * c) = o; }
    LDS_WAIT(); asm volatile("" ::: "memory");
}
DI void tr_item8(const float* W, int ldw, int K, unsigned char* WT, int k0, float scale, LAS float* scr, int lane) {
    { const int rr = lane >> 3, c4 = lane & 7; f32x4 v[8];
#pragma unroll
      for (int i = 0; i < 8; ++i) v[i] = *(const f32x4*)(W + (size_t)(k0 + rr + 8 * i) * ldw + 4 * c4);
#pragma unroll
      for (int i = 0; i < 8; ++i) { LAS float* d = scr + (rr + 8 * i) * 33 + 4 * c4; d[0] = v[i].x; d[1] = v[i].y; d[2] = v[i].z; d[3] = v[i].w; } }
    LDS_WAIT(); asm volatile("" ::: "memory");
    const int c = lane & 7;
#pragma unroll
    for (int j = 0; j < 4; ++j) { const int n = (lane >> 3) + 8 * j; const LAS float* s = scr + (8 * c) * 33 + n;
        v2u o; o.x = pk4_fp8(s[0 * 33] * scale, s[1 * 33] * scale, s[2 * 33] * scale, s[3 * 33] * scale); o.y = pk4_fp8(s[4 * 33] * scale, s[5 * 33] * scale, s[6 * 33] * scale, s[7 * 33] * scale);
        *(v2u*)(WT + (size_t)n * K + k0 + 8 * c) = o; }
    LDS_WAIT(); asm volatile("" ::: "memory");
}
DI void p0_prologue(const Args& a, const Ctx& X) {
    unsigned char* ws = a.ws;
    LAS float* scr = (LAS float*)(X.lds + X.wave * 16384);
    const int gw = X.bid * 8 + X.wave, NGW = X.G * 8;
    constexpr int IT_WIN = 16 * 153, IT_AU = 8 * 32, IT_OUT = 16 * 32, IT_GU = 16 * 16 * 32, IT_DN = 16 * 8 * 32;
    constexpr int IT_L = IT_WIN + 2 * IT_AU + IT_OUT + IT_GU + IT_DN;
    for (int it = gw; it < NL * IT_L; it += NGW) {
        const int l = it / IT_L; int r = it - l * IT_L;
        if (r < IT_WIN) { const int kb = r / 153, nb = r - kb * 153, d0 = 32 * nb, s0 = (nb == 152) ? 2304 : (d0 + (d0 >= 2304 ? 8 : 0));
            tr_item8(a.w_in + (size_t)l * D * DIN_SRC + s0, DIN_SRC, D, (unsigned char*)(ws + WS_WIN) + ((size_t)l * NPROJW + d0) * D, 64 * kb, 64.0f, scr, X.lane); continue; }
        r -= IT_WIN;
        if (r < IT_AU) { const int kb = r >> 5, nb = r & 31;
            tr_item8(a.w_au + (size_t)l * 512 * D + 32 * nb, D, 512, (unsigned char*)(ws + WS_WAU) + ((size_t)l * D + 32 * nb) * 512, 64 * kb, 32.0f, scr, X.lane); continue; }
        r -= IT_AU;
        if (r < IT_AU) { const int kb = r >> 5, nb = r & 31;
            tr_item8(a.w_mu + (size_t)l * 512 * D + 32 * nb, D, 512, (unsigned char*)(ws + WS_WMU) + ((size_t)l * D + 32 * nb) * 512, 64 * kb, 32.0f, scr, X.lane); continue; }
        r -= IT_AU;
        if (r < IT_OUT) { const int kb = r >> 5, nb = r & 31;
            tr_item8(a.w_out + (size_t)l * D * D + 32 * nb, D, D, (unsigned char*)(ws + WS_WOUT) + ((size_t)l * D + 32 * nb) * D, 64 * kb, 64.0f, scr, X.lane); continue; }
        r -= IT_OUT;
        if (r < IT_GU) { const int e = r >> 9, q = r & 511, kb = q >> 5, nb = q & 31, tq = nb >> 3, rb = nb & 7;
            const float* src = ((rb < 4) ? a.w_gate : a.w_up) + ((size_t)(l * NE + e) * D) * FF + 128 * tq + 32 * (rb & 3);
            tr_item8(src, FF, D, (unsigned char*)(ws + WS_WGU) + ((size_t)(l * NE + e) * 1024 + 32 * nb) * D, 64 * kb, 64.0f, scr, X.lane); continue; }
        r -= IT_GU;
        { const int e = r >> 8, q = r & 255, kb = q >> 5, nb = q & 31;
            tr_item8(a.w_down + ((size_t)(l * NE + e) * FF) * D + 32 * nb, D, FF, (unsigned char*)(ws + WS_WD) + ((size_t)(l * NE + e) * 1024 + 32 * nb) * FF, 64 * kb, 32.0f, scr, X.lane); }
    }
    { const float* xs = a.x; bf16* xb = (bf16*)(ws + WS_XB);
      for (size_t i = (size_t)X.bid * 512 + X.tid; i < (size_t)T * D / 8; i += (size_t)X.G * 512) { const f32x4 v0 = *(const f32x4*)(xs + 8 * i), v1 = *(const f32x4*)(xs + 8 * i + 4);
          v4u w; w.x = cvt_pk_bf16(v0.x, v0.y); w.y = cvt_pk_bf16(v0.z, v0.w); w.z = cvt_pk_bf16(v1.x, v1.y); w.w = cvt_pk_bf16(v1.z, v1.w); *(v4u*)(xb + 8 * i) = w; } }
    { float* cs = (float*)(ws + WS_ROPE); float* sn = cs + (size_t)T * 8;
      for (int i = X.bid * 512 + X.tid; i < T * 8; i += X.G * 512) { const int tok = i >> 3, f = i & 7; const float angf = (float)a.pos[tok] * c_invf[f];
          double rev = (double)angf * 0.15915494309189535; rev -= rint(rev); const float rf = (float)rev;
          cs[i] = __builtin_amdgcn_cosf(rf); sn[i] = __builtin_amdgcn_sinf(rf); } }
    __syncthreads();
    LAS float* cact = (LAS float*)X.lds; LAS float* red = (LAS float*)(X.lds + 8192);
    for (int i = X.tid; i < 2048; i += 512) { const float cv = a.c[i]; cact[i] = cv / (1.0f + __expf(-cv)); }
    __syncthreads();
    float* mod = (float*)(ws + WS_MOD);
    for (int it = X.bid; it < NL * 96; it += X.G) { const int l = it / 96, cg = it - l * 96; const int col = cg * 64 + X.lane;
        const float* w = a.ada_w + (size_t)l * D * 6144 + col; float s0 = 0.f, s1 = 0.f;
#pragma unroll 8
        for (int kk = 0; kk < 128; ++kk) { const int k = X.wave * 128 + kk; const float wv = w[(size_t)k * 6144]; s0 += cact[k] * wv; s1 += cact[1024 + k] * wv; }
        red[(X.wave * 2 + 0) * 64 + X.lane] = s0; red[(X.wave * 2 + 1) * 64 + X.lane] = s1;
        __syncthreads();
        if (X.tid < 128) { const int b = X.tid >> 6, ln = X.tid & 63; float s = 0.f;
#pragma unroll
            for (int w8 = 0; w8 < 8; ++w8) s += red[(w8 * 2 + b) * 64 + ln];
            mod[(size_t)(l * 2 + b) * 6144 + cg * 64 + ln] = s + a.ada_b[l * 6144 + cg * 64 + ln]; }
        __syncthreads();
    }
}

DI void p1_norm_gates(const Args& a, const Ctx& X, int l, const bf16* xin) {
    unsigned char* ws = a.ws;
    const float* mod = (const float*)(ws + WS_MOD); unsigned char* hb = (unsigned char*)(ws + WS_H);
    const int gw = X.bid * 8 + X.wave, NGW = X.G * 8;
    for (int rg = gw; rg < T / 16; rg += NGW) {
        const int row0 = rg * 16, b = row0 >> 14;
        const float* mb = mod + (size_t)(l * 2 + b) * 6144;
        f32x4 aw[4], sh[4];
#pragma unroll
        for (int j = 0; j < 4; ++j) { const int k = 256 * j + 4 * X.lane; const f32x4 nw = *(const f32x4*)(a.nmw + l * D + k); const f32x4 sc = *(const f32x4*)(mb + 1024 + k); aw[j] = nw * (sc + 1.0f); sh[j] = *(const f32x4*)(mb + k); }
        v2u pre[4][4];
#pragma unroll
        for (int q = 0; q < 4; ++q) { const v2u* xp = (const v2u*)(xin + (size_t)(row0 + q) * D) + X.lane;
#pragma unroll
            for (int j = 0; j < 4; ++j) pre[q][j] = xp[64 * j]; }
#pragma unroll 1
        for (int rb = 0; rb < 16; rb += 4) {
#pragma unroll
          for (int q = 0; q < 4; ++q) { const int row = row0 + rb + q;
            f32x4 v[4]; float ss = 0.f;
#pragma unroll
            for (int j = 0; j < 4; ++j) { const v2u pw = pre[q][j]; v[j] = (f32x4){bflo(pw.x), bfhi(pw.x), bflo(pw.y), bfhi(pw.y)}; }
            if (rb + 4 < 16) { const v2u* xp = (const v2u*)(xin + (size_t)(row + 4) * D) + X.lane;
#pragma unroll
                for (int j = 0; j < 4; ++j) pre[q][j] = xp[64 * j]; }
#pragma unroll
            for (int j = 0; j < 4; ++j) ss += (v[j].x * v[j].x + v[j].y * v[j].y) + (v[j].z * v[j].z + v[j].w * v[j].w);
            ss = wave_sum(ss, X.lane); const float rstd = __builtin_amdgcn_rsqf(ss * (1.0f / D) + EPS);
            unsigned* o4 = (unsigned*)(hb + (size_t)row * D) + X.lane;
#pragma unroll
            for (int j = 0; j < 4; ++j) { v[j] = v[j] * rstd * aw[j] + sh[j]; o4[64 * j] = pk4_fp8(v[j].x, v[j].y, v[j].z, v[j].w); }
          }
        }
    }
}

DI void attn_unit(const Args& a, const Ctx& X, int l, int unit) {
    unsigned char* ws = a.ws; const bf16* proj = (const bf16*)(ws + WS_PROJ); unsigned char* ao = (unsigned char*)(ws + WS_H);
    const float* cs = (const float*)(ws + WS_ROPE); const float* sn = cs + (size_t)T * 8;
    const int b = unit >> 8, rem = unit & 255, nb = rem >> 1, kvh = rem & 1; const int tok0 = b * SEQ + nb * 128;
    LAS bf16* Kl = (LAS bf16*)X.lds;
    LAS bf16* VT = (LAS bf16*)(X.lds + 36864);
    int lane = X.lane; asm volatile("" : "+v"(lane));
    const int c16 = lane & 15, quad = lane >> 4;
    v4u nq0, nq1; f32x4 ncs0, ncs1, nsn0, nsn1;
#define AT_PREF(task_) do { const int g_ = (task_) >> 3, tq_ = tok0 + 16 * ((task_) & 7) + c16; const bf16* qp_ = proj + (size_t)tq_ * NPROJ + C_AQ + (kvh * 4 + g_) * 64; \
        nq0 = *(const v4u*)(qp_ + 8 * quad); nq1 = *(const v4u*)(qp_ + 32 + 8 * quad); ncs0 = *(const f32x4*)(cs + (size_t)tq_ * 8); ncs1 = *(const f32x4*)(cs + (size_t)tq_ * 8 + 4); nsn0 = *(const f32x4*)(sn + (size_t)tq_ * 8); nsn1 = *(const f32x4*)(sn + (size_t)tq_ * 8 + 4); } while (0)
    AT_PREF(X.wave);
    float qw[16];
#pragma unroll
    for (int i = 0; i < 8; ++i) { qw[i] = a.qnw[l * 64 + 8 * quad + i]; qw[8 + i] = a.qnw[l * 64 + 32 + 8 * quad + i]; }
    const f32x4 sk4 = *(const f32x4*)(a.sinks + l * 8 + kvh * 4);
    {
        const int row = X.tid >> 1, half = X.tid & 1; const int tokk = tok0 - 128 + row; const bool valid = (nb > 0) || (row >= 128);
        float y[32]; float vv[32];
        if (valid) {
            const v4u* kp = (const v4u*)(proj + (size_t)tokk * NPROJ + C_AK + kvh * 64 + half * 32); const v4u* vp = (const v4u*)(proj + (size_t)tokk * NPROJ + C_AV + kvh * 64 + half * 32);
#pragma unroll
            for (int q = 0; q < 4; ++q) { const v4u kw = kp[q], vw = vp[q];
                y[8 * q + 0] = bflo(kw.x); y[8 * q + 1] = bfhi(kw.x); y[8 * q + 2] = bflo(kw.y); y[8 * q + 3] = bfhi(kw.y); y[8 * q + 4] = bflo(kw.z); y[8 * q + 5] = bfhi(kw.z); y[8 * q + 6] = bflo(kw.w); y[8 * q + 7] = bfhi(kw.w);
                vv[8 * q + 0] = bflo(vw.x); vv[8 * q + 1] = bfhi(vw.x); vv[8 * q + 2] = bflo(vw.y); vv[8 * q + 3] = bfhi(vw.y); vv[8 * q + 4] = bflo(vw.z); vv[8 * q + 5] = bfhi(vw.z); vv[8 * q + 6] = bflo(vw.w); vv[8 * q + 7] = bfhi(vw.w); }
        } else {
#pragma unroll
            for (int i = 0; i < 32; ++i) { y[i] = 0.f; vv[i] = 0.f; } }
        float ss = 0.f;
#pragma unroll
        for (int i = 0; i < 32; ++i) ss += y[i] * y[i];
        ss += shx(ss, 1, lane); const float rstd = 1.0f / sqrtf(ss * (1.0f / 64.0f) + EPS);
#pragma unroll
        for (int i = 0; i < 32; ++i) y[i] = y[i] * rstd * a.knw[l * 64 + half * 32 + i];
        if (half == 0 && valid) {
#pragma unroll
            for (int d = 0; d < 8; ++d) { const float c = cs[(size_t)tokk * 8 + d], s = sn[(size_t)tokk * 8 + d]; const float t1 = y[d], t2 = y[d + 8]; y[d] = t1 * c - t2 * s; y[d + 8] = t2 * c + t1 * s; } }
#pragma unroll
        for (int q = 0; q < 4; ++q) { v4u w; w.x = pk2(y[8 * q], y[8 * q + 1]); w.y = pk2(y[8 * q + 2], y[8 * q + 3]); w.z = pk2(y[8 * q + 4], y[8 * q + 5]); w.w = pk2(y[8 * q + 6], y[8 * q + 7]);
            *(LAS v4u*)(Kl + row * 72 + half * 32 + 8 * q) = w; }
#pragma unroll
        for (int i = 0; i < 32; ++i) VT[(half * 32 + i) * 280 + row] = (bf16)f2bf(vv[i]);
        if (X.tid < 64) {
#pragma unroll
            for (int cc = 256; cc < 280; ++cc) VT[X.tid * 280 + cc] = 0; }
    }
    __syncthreads();
#pragma unroll 1
    for (int task = X.wave; task < 32; task += 8) {
        const int g = task >> 3, rg = task & 7, r0 = 16 * rg, head = kvh * 4 + g; const int tokq = tok0 + r0 + c16;
        const float sink = (g == 0) ? sk4.x : ((g == 1) ? sk4.y : ((g == 2) ? sk4.z : sk4.w));
        const v4u w0 = nq0, w1 = nq1; const f32x4 cc0 = ncs0, cc1 = ncs1, ss0 = nsn0, ss1 = nsn1;
        if (task + 8 < 32) { AT_PREF(task + 8); }
        float qv[16];
        qv[0] = bflo(w0.x); qv[1] = bfhi(w0.x); qv[2] = bflo(w0.y); qv[3] = bfhi(w0.y); qv[4] = bflo(w0.z); qv[5] = bfhi(w0.z); qv[6] = bflo(w0.w); qv[7] = bfhi(w0.w);
        qv[8] = bflo(w1.x); qv[9] = bfhi(w1.x); qv[10] = bflo(w1.y); qv[11] = bfhi(w1.y); qv[12] = bflo(w1.z); qv[13] = bfhi(w1.z); qv[14] = bflo(w1.w); qv[15] = bfhi(w1.w);
        float ss = 0.f;
#pragma unroll
        for (int i = 0; i < 16; ++i) ss += qv[i] * qv[i];
        ss += shx(ss, 16, lane); ss += shx(ss, 32, lane); const float rstd = __builtin_amdgcn_rsqf(ss * (1.0f / 64.0f) + EPS);
#pragma unroll
        for (int i = 0; i < 16; ++i) qv[i] = qv[i] * rstd * qw[i];
        { const float cv[8] = {cc0.x, cc0.y, cc0.z, cc0.w, cc1.x, cc1.y, cc1.z, cc1.w}, sv[8] = {ss0.x, ss0.y, ss0.z, ss0.w, ss1.x, ss1.y, ss1.z, ss1.w};
#pragma unroll
          for (int d = 0; d < 8; ++d) { const float other = shx(qv[d], 16, lane);
              if (quad == 0) qv[d] = qv[d] * cv[d] - other * sv[d]; else if (quad == 1) qv[d] = qv[d] * cv[d] + other * sv[d]; } }
        bf16x8 qf[2];
        { v4u w; w.x = pk2m(qv[0], qv[1]); w.y = pk2m(qv[2], qv[3]); w.z = pk2m(qv[4], qv[5]); w.w = pk2m(qv[6], qv[7]); qf[0] = __builtin_bit_cast(bf16x8, w);
          w.x = pk2m(qv[8], qv[9]); w.y = pk2m(qv[10], qv[11]); w.z = pk2m(qv[12], qv[13]); w.w = pk2m(qv[14], qv[15]); qf[1] = __builtin_bit_cast(bf16x8, w); }
        f32x4 sacc[9];
#pragma unroll
        for (int i = 0; i < 9; ++i) { const LAS bf16* kr = Kl + (16 * (rg + i) + c16) * 72 + 8 * quad;
            const bf16x8 k0 = *(const LAS bf16x8*)kr, k1 = *(const LAS bf16x8*)(kr + 32);
            f32x4 z = {0.f, 0.f, 0.f, 0.f}; z = __builtin_amdgcn_mfma_f32_16x16x32_bf16(k0, qf[0], z, 0, 0, 0); sacc[i] = __builtin_amdgcn_mfma_f32_16x16x32_bf16(k1, qf[1], z, 0, 0, 0); }
        int dbase = 4 * quad - c16; asm volatile("" : "+v"(dbase)); int kbase = 16 * rg + 4 * quad; asm volatile("" : "+v"(kbase)); float mx = sink;
#pragma unroll
        for (int i = 0; i < 9; ++i)
#pragma unroll
            for (int j = 0; j < 4; ++j) { const int dlt = dbase + 16 * i + j; const int kj = kbase + 16 * i + j; const bool ok = (dlt > 0) && (dlt <= 128) && ((nb > 0) || (kj >= 128));
                const float s = ok ? sacc[i][j] * 0.125f : -3.0e38f; sacc[i][j] = s; mx = fmaxf(mx, s); }
        mx = fmaxf(mx, shx(mx, 16, lane)); mx = fmaxf(mx, shx(mx, 32, lane));
        float sum = 0.f;
#pragma unroll
        for (int i = 0; i < 9; ++i)
#pragma unroll
            for (int j = 0; j < 4; ++j) { const float p = (sacc[i][j] > -1.0e38f) ? __expf(sacc[i][j] - mx) : 0.f; sacc[i][j] = p; sum += p; }
        sum += shx(sum, 16, lane); sum += shx(sum, 32, lane);
        const float inv = 1.0f / (sum + __expf(sink - mx));
        f32x4 oacc[4];
#pragma unroll
        for (int et = 0; et < 4; ++et) oacc[et] = (f32x4){0.f, 0.f, 0.f, 0.f};
#pragma unroll
        for (int kk = 0; kk < 5; ++kk) {
            v4u pw; pw.x = pk2m(sacc[2 * kk][0], sacc[2 * kk][1]); pw.y = pk2m(sacc[2 * kk][2], sacc[2 * kk][3]);
            if (2 * kk + 1 < 9) { pw.z = pk2m(sacc[(2 * kk + 1 < 9) ? 2 * kk + 1 : 0][0], sacc[(2 * kk + 1 < 9) ? 2 * kk + 1 : 0][1]); pw.w = pk2m(sacc[(2 * kk + 1 < 9) ? 2 * kk + 1 : 0][2], sacc[(2 * kk + 1 < 9) ? 2 * kk + 1 : 0][3]); } else { pw.z = 0u; pw.w = 0u; }
            const bf16x8 pf = __builtin_bit_cast(bf16x8, pw);
#pragma unroll
            for (int et = 0; et < 4; ++et) { const LAS bf16* vr = VT + (16 * et + c16) * 280 + 16 * rg + 32 * kk + 4 * quad;
                const v2u lo = *(const LAS v2u*)vr, hi = *(const LAS v2u*)(vr + 16); v4u vw; vw.x = lo.x; vw.y = lo.y; vw.z = hi.x; vw.w = hi.y;
                oacc[et] = __builtin_amdgcn_mfma_f32_16x16x32_bf16(__builtin_bit_cast(bf16x8, vw), pf, oacc[et], 0, 0, 0); }
        }
#pragma unroll
        for (int et = 0; et < 4; ++et) { const float i8 = inv * 8.0f;
            *(unsigned*)(ao + (size_t)tokq * 512 + head * 64 + 16 * et + 4 * quad) = pk4_fp8(oacc[et][0] * i8, oacc[et][1] * i8, oacc[et][2] * i8, oacc[et][3] * i8); }
    }
    __syncthreads();
#undef AT_PREF
}

constexpr int ML_Q = 0, ML_K = 17408, ML_KET = 34816, ML_VT = 53248, ML_CT = 73984, ML_CW = 113152, ML_CB = 118272, ML_RED = 118784, ML_NW = 119296, ML_GT = 119808;
DI float bfw(unsigned w, int hi) { return hi ? bfhi(w) : bflo(w); }
template <bool L3> DI void mlstm_unit(const Args& a, const Ctx& X, int l, int unit) {
    unsigned char* ws = a.ws; const bf16* proj = (const bf16*)(ws + WS_PROJ); unsigned char* hm = (unsigned char*)(ws + WS_H) + (size_t)T * 512;
    bf16* kcb = (bf16*)(ws + WS_KC);
    const float* gates = (const float*)(ws + WS_GATES); float* mlc = (float*)(ws + WS_MLC) + (size_t)unit * 18432; float* mlb = (float*)(ws + WS_MLB);
    const int seq = unit >> 5, sj = unit & 31, b = seq >> 2, hh = seq & 3; const int tokbase = b * SEQ + sj * 512;
    LAS bf16* Qs = (LAS bf16*)(X.lds + ML_Q); LAS bf16* Ks = (LAS bf16*)(X.lds + ML_K); LAS bf16* KET = (LAS bf16*)(X.lds + ML_KET);
    LAS bf16* VT = (LAS bf16*)(X.lds + ML_VT); LAS bf16* CT = (LAS bf16*)(X.lds + ML_CT); LAS float* CW = (LAS float*)(X.lds + ML_CW);
    LAS float* CB = (LAS float*)(X.lds + ML_CB); LAS float* RED = (LAS float*)(X.lds + ML_RED); LAS float* NW = (LAS float*)(X.lds + ML_NW);
    LAS float* GT = (LAS float*)(X.lds + ML_GT);
    int lane = X.lane; asm volatile("" : "+v"(lane));
    const int c16 = lane & 15, quad = lane >> 4, w = X.wave;
    int tidl = X.tid; asm volatile("" : "+v"(tidl));
    const int tg = tidl >> 5, cg = tidl & 31, t0 = 4 * tg, c0 = 4 * cg;
    v2u rq[7], rk[7], rv[4], kcv[4];
#define ML_LBAR() do { asm volatile("s_waitcnt lgkmcnt(0)" ::: "memory"); __builtin_amdgcn_s_barrier(); asm volatile("" ::: "memory"); } while (0)
#define ML_LOADRAW(tokc) do { _Pragma("unroll") for (int j = 0; j < 7; ++j) { const int tt = (tokc) + t0 - 3 + j; const bool ok = tt >= b * SEQ; const bf16* rp = proj + (size_t)(ok ? tt : (tokc)) * NPROJ + hh * 128 + c0; \
        if (L3) { rq[j] = *(const v2u*)(rp + C_MQ); if (!ok) { rq[j].x = 0u; rq[j].y = 0u; } } else { rk[j] = *(const v2u*)(rp + C_MK); if (!ok) { rk[j].x = 0u; rk[j].y = 0u; } } } \
        if (L3) { _Pragma("unroll") for (int i = 0; i < 4; ++i) kcv[i] = *(const v2u*)(kcb + (size_t)((tokc) + t0 + i) * 512 + hh * 128 + c0); } \
        _Pragma("unroll") for (int i = 0; i < 4; ++i) rv[i] = *(const v2u*)(proj + (size_t)((tokc) + t0 + i) * NPROJ + C_MV + hh * 128 + c0); } while (0)
    ML_LOADRAW(tokbase);
    for (int idx = X.tid; idx < 1280; idx += 512) { const int tap = idx >> 8, ch = idx & 255; const int gch = (ch < 128) ? (hh * 128 + ch) : (512 + hh * 128 + (ch - 128));
        CW[idx] = (tap < 4) ? a.conv_w[(size_t)(l * 4 + tap) * 1024 + gch] : a.conv_b[l * 1024 + gch]; }
    for (int idx = X.tid; idx < 16 * 72; idx += 512) VT[128 * 72 + idx] = (idx < 72) ? (bf16)0x3F80 : (bf16)0;
    if (X.tid < 128) NW[X.tid] = a.mnw[l * 512 + hh * 128 + X.tid];
    { const float* gp = gates + (size_t)(tokbase + X.tid) * 8; GT[2 * X.tid] = gp[hh]; GT[2 * X.tid + 1] = gp[4 + hh]; }
    f32x4 cacc[9];
#pragma unroll
    for (int et = 0; et < 9; ++et) {
        if (L3) {
#pragma unroll
            for (int j = 0; j < 4; ++j) { const float v = mlc[(16 * et + 4 * quad + j) * 128 + 16 * w + c16]; cacc[et][j] = v; CT[(16 * et + 4 * quad + j) * 136 + 16 * w + c16] = (bf16)f2bf(v); }
        } else cacc[et] = (f32x4){0.f, 0.f, 0.f, 0.f};
    }
    float bsum = 0.f;
    __syncthreads();
#pragma unroll 1
    for (int c = 0; c < 8; ++c) {
        const int tok0 = tokbase + c * 64;
        const f32x2 gl = *(const LAS f32x2*)(GT + 2 * (c * 64 + lane)); float bsc = gl.y; const float li = gl.x;
#pragma unroll
        for (int o = 1; o < 64; o <<= 1) { const float v = shl_(bsc, (lane - o) & 63); if (lane >= o) bsc += v; }
        const float bl = shl_(bsc, 63); const float csv = li - bsc;
        if (w == 0) { CB[lane] = bsc; CB[64 + lane] = csv; }
        bsum += bl;
        const int tt_ = w & 3, eh = w >> 2; const int tq = 16 * tt_ + c16;
        v2u ogv[4];
        if (L3) {
#pragma unroll
            for (int x = 0; x < 4; ++x) ogv[x] = *(const v2u*)(proj + (size_t)(tok0 + tq) * NPROJ + C_MO + hh * 128 + 16 * (4 * eh + x) + 4 * quad); }
        { float fac[4];
#pragma unroll
          for (int i = 0; i < 4; ++i) fac[i] = __expf(bl + shl_(csv, t0 + i));
#pragma unroll
          for (int qk = (L3 ? 0 : 1); qk < 2; ++qk) {
              float o[4][4];
              if (L3 && qk) {
#pragma unroll
                  for (int i = 0; i < 4; ++i) { o[i][0] = bflo(kcv[i].x); o[i][1] = bfhi(kcv[i].x); o[i][2] = bflo(kcv[i].y); o[i][3] = bfhi(kcv[i].y); }
              } else {
              const f32x4 bias = *(const LAS f32x4*)(CW + 4 * 256 + qk * 128 + c0);
#pragma unroll
              for (int i = 0; i < 4; ++i) { o[i][0] = bias.x; o[i][1] = bias.y; o[i][2] = bias.z; o[i][3] = bias.w; }
#pragma unroll
              for (int j = 0; j < 4; ++j) { const f32x4 wj = *(const LAS f32x4*)(CW + j * 256 + qk * 128 + c0);
#pragma unroll
                  for (int i = 0; i < 4; ++i) { const v2u rr = qk ? rk[i + j] : rq[i + j];
                      o[i][0] += wj.x * bflo(rr.x); o[i][1] += wj.y * bfhi(rr.x); o[i][2] += wj.z * bflo(rr.y); o[i][3] += wj.w * bfhi(rr.y); } }
#pragma unroll
              for (int i = 0; i < 4; ++i)
#pragma unroll
                  for (int ch = 0; ch < 4; ++ch) { const float z = o[i][ch]; o[i][ch] = z * __builtin_amdgcn_rcpf(1.0f + __expf(-z)) * (qk ? 0.08838834764831845f : 1.0f); }
              }
              if (!L3 && qk) {
#pragma unroll
                  for (int i = 0; i < 4; ++i) { v2u pw; pw.x = pk2(o[i][0], o[i][1]); pw.y = pk2(o[i][2], o[i][3]); *(v2u*)(kcb + (size_t)(tok0 + t0 + i) * 512 + hh * 128 + c0) = pw;
                      o[i][0] = bflo(pw.x); o[i][1] = bfhi(pw.x); o[i][2] = bflo(pw.y); o[i][3] = bfhi(pw.y); } }
              if (L3) { LAS bf16* dst = (qk ? Ks : Qs) + t0 * 136 + c0;
#pragma unroll
                  for (int i = 0; i < 4; ++i) { v2u pw; pw.x = pk2(o[i][0], o[i][1]); pw.y = pk2(o[i][2], o[i][3]); *(LAS v2u*)(dst + i * 136) = pw; } }
              if (qk) {
#pragma unroll
                  for (int ch = 0; ch < 4; ++ch) { v2u pw; pw.x = pk2(o[0][ch] * fac[0], o[1][ch] * fac[1]); pw.y = pk2(o[2][ch] * fac[2], o[3][ch] * fac[3]); *(LAS v2u*)(KET + (c0 + ch) * 72 + t0) = pw; } }
          }
          { v2u p0, p1, p2, p3;
            p0.x = (rv[0].x & 0xffffu) | (rv[1].x << 16); p0.y = (rv[2].x & 0xffffu) | (rv[3].x << 16);
            p1.x = (rv[0].x >> 16) | (rv[1].x & 0xffff0000u); p1.y = (rv[2].x >> 16) | (rv[3].x & 0xffff0000u);
            p2.x = (rv[0].y & 0xffffu) | (rv[1].y << 16); p2.y = (rv[2].y & 0xffffu) | (rv[3].y << 16);
            p3.x = (rv[0].y >> 16) | (rv[1].y & 0xffff0000u); p3.y = (rv[2].y >> 16) | (rv[3].y & 0xffff0000u);
            *(LAS v2u*)(VT + (c0 + 0) * 72 + t0) = p0; *(LAS v2u*)(VT + (c0 + 1) * 72 + t0) = p1; *(LAS v2u*)(VT + (c0 + 2) * 72 + t0) = p2; *(LAS v2u*)(VT + (c0 + 3) * 72 + t0) = p3; }
        }
        ML_LBAR();
        if (c < 7) { ML_LOADRAW(tok0 + 64); }
        float hval[4][4];
        if (L3) {
            bf16x8 qf[4];
#pragma unroll
            for (int ks = 0; ks < 4; ++ks) qf[ks] = *(const LAS bf16x8*)(Qs + tq * 136 + 32 * ks + 8 * quad);
            f32x4 sacc[4];
#pragma unroll
            for (int st = 0; st < 4; ++st) { f32x4 z = {0.f, 0.f, 0.f, 0.f};
#pragma unroll
                for (int ks = 0; ks < 4; ++ks) z = __builtin_amdgcn_mfma_f32_16x16x32_bf16(*(const LAS bf16x8*)(Ks + (16 * st + c16) * 136 + 32 * ks + 8 * quad), qf[ks], z, 0, 0, 0);
                sacc[st] = z; }
            const float cbt = CB[tq];
#pragma unroll
            for (int st = 0; st < 4; ++st)
#pragma unroll
                for (int j = 0; j < 4; ++j) { const int s = 16 * st + 4 * quad + j; const float d = (s <= tq) ? __expf(cbt + CB[64 + s]) : 0.f; sacc[st][j] *= d; }
            bf16x8 pf[2];
#pragma unroll
            for (int kk = 0; kk < 2; ++kk) { v4u pw; pw.x = pk2m(sacc[2 * kk][0], sacc[2 * kk][1]); pw.y = pk2m(sacc[2 * kk][2], sacc[2 * kk][3]); pw.z = pk2m(sacc[2 * kk + 1][0], sacc[2 * kk + 1][1]); pw.w = pk2m(sacc[2 * kk + 1][2], sacc[2 * kk + 1][3]); pf[kk] = __builtin_bit_cast(bf16x8, pw); }
            const float ebt = __expf(cbt);
            f32x4 nn[5];
#pragma unroll
            for (int x = 0; x < 5; ++x) { const int et = (x < 4) ? (4 * eh + x) : 8; f32x4 na = {0.f, 0.f, 0.f, 0.f}, ia = {0.f, 0.f, 0.f, 0.f};
#pragma unroll
                for (int kk = 0; kk < 2; ++kk) { const LAS bf16* vr = VT + (16 * et + c16) * 72 + 32 * kk + 4 * quad; const v2u lo = *(const LAS v2u*)vr, hi = *(const LAS v2u*)(vr + 16); v4u vw; vw.x = lo.x; vw.y = lo.y; vw.z = hi.x; vw.w = hi.y;
                    na = __builtin_amdgcn_mfma_f32_16x16x32_bf16(__builtin_bit_cast(bf16x8, vw), pf[kk], na, 0, 0, 0); }
#pragma unroll
                for (int ks = 0; ks < 4; ++ks) ia = __builtin_amdgcn_mfma_f32_16x16x32_bf16(*(const LAS bf16x8*)(CT + (16 * et + c16) * 136 + 32 * ks + 8 * quad), qf[ks], ia, 0, 0, 0);
                nn[x] = na + ia * ebt; }
            const float den = shl_(nn[4][0], c16); const float inv = 1.0f / fmaxf(fabsf(den), 1.0f);
            float ss = 0.f;
#pragma unroll
            for (int x = 0; x < 4; ++x)
#pragma unroll
                for (int j = 0; j < 4; ++j) { hval[x][j] = nn[x][j] * inv; ss += hval[x][j] * hval[x][j]; }
            ss += shx(ss, 16, lane); ss += shx(ss, 32, lane);
            if (quad == 0) RED[eh * 64 + tq] = ss;
            ML_LBAR();
            const float rstd = __builtin_amdgcn_rsqf((RED[tq] + RED[64 + tq]) * (1.0f / 128.0f) + EPS);
#pragma unroll
            for (int x = 0; x < 4; ++x) { const int e = 16 * (4 * eh + x) + 4 * quad; const v2u og = ogv[x];
                const float y0 = hval[x][0] * rstd * NW[e] * bflo(og.x), y1 = hval[x][1] * rstd * NW[e + 1] * bfhi(og.x), y2 = hval[x][2] * rstd * NW[e + 2] * bflo(og.y), y3 = hval[x][3] * rstd * NW[e + 3] * bfhi(og.y);
                *(unsigned*)(hm + (size_t)(tok0 + tq) * 512 + hh * 128 + e) = pk4_fp8(y0 * 8.0f, y1 * 8.0f, y2 * 8.0f, y3 * 8.0f); }
        }
        { const float ebl = __expf(bl);
          bf16x8 kf[2];
#pragma unroll
          for (int kk = 0; kk < 2; ++kk) kf[kk] = *(const LAS bf16x8*)(KET + (16 * w + c16) * 72 + 32 * kk + 8 * quad);
#pragma unroll
          for (int et = 0; et < 9; ++et) { f32x4 z = cacc[et] * ebl;
#pragma unroll
              for (int kk = 0; kk < 2; ++kk) z = __builtin_amdgcn_mfma_f32_16x16x32_bf16(*(const LAS bf16x8*)(VT + (16 * et + c16) * 72 + 32 * kk + 8 * quad), kf[kk], z, 0, 0, 0);
              cacc[et] = z;
              if (L3) {
#pragma unroll
                  for (int j = 0; j < 4; ++j) CT[(16 * et + 4 * quad + j) * 136 + 16 * w + c16] = (bf16)f2bf(z[j]); } } }
        ML_LBAR();
    }
#undef ML_LOADRAW
#undef ML_LBAR
    if (!L3) {
#pragma unroll
        for (int et = 0; et < 9; ++et)
#pragma unroll
            for (int j = 0; j < 4; ++j) mlc[(16 * et + 4 * quad + j) * 128 + 16 * w + c16] = cacc[et][j];
        if (X.tid == 0) mlb[unit] = bsum;
    }
}
DI void mlstm_scan(const Args& a, const Ctx& X) {
    float* mlc = (float*)(a.ws + WS_MLC); const float* mlb = (const float*)(a.ws + WS_MLB);
    for (int idx = X.bid * 512 + X.tid; idx < 8 * 18432; idx += X.G * 512) { const int seq = idx / 18432, el = idx - seq * 18432; float carry = 0.f;
        float* p0 = mlc + (size_t)seq * 32 * 18432 + el; float v[32], dcy[32];
#pragma unroll
        for (int j = 0; j < 32; ++j) { v[j] = p0[(size_t)j * 18432]; dcy[j] = mlb[seq * 32 + j]; }
#pragma unroll
        for (int j = 0; j < 32; ++j) { p0[(size_t)j * 18432] = carry; carry = __expf(dcy[j]) * carry + v[j]; } }
}

constexpr int P6_WR = 0, P6_AT = 33024, P6_SH = 37120, P6_LG = 41216, P6_HIST = 65536;
DI void p6_norm_route(const Args& a, const Ctx& X, int l, const bf16* xin) {
    unsigned char* ws = a.ws;
    LAS bf16* wrb = (LAS bf16*)(X.lds + P6_WR);
    LAS float* at = (LAS float*)(X.lds + P6_AT); LAS float* sht = (LAS float*)(X.lds + P6_SH);
    LAS float* lg = (LAS float*)(X.lds + P6_LG) + X.wave * 272;
    for (int idx = X.tid; idx < 16384; idx += 512) { const int k = idx >> 4, e = idx & 15; wrb[e * 1032 + k] = (bf16)f2bf(a.router_w[idx]); }
    const float* mod = (const float*)(ws + WS_MOD); unsigned char* hb = (unsigned char*)(ws + WS_H); float* tgate = (float*)(ws + WS_TGATE); int* tokl = (int*)(ws + WS_TOKL);
    const float* ssq = (const float*)(ws + WS_SSQ);
    unsigned* cnt = (unsigned*)(ws + WS_CTL) + CW_CNT + l * 2048;
    LAS int* hist = (LAS int*)(X.lds + P6_HIST); LAS int* cbase = hist + 32;
    int lane = X.lane; asm volatile("" : "+v"(lane));
    const int r = lane & 15, q = lane >> 4;
    const int gw = X.bid * 8 + X.wave, NGW = X.G * 8;
    for (int it = 0; it * NGW < T / 16; ++it) {
        const int rg = it * NGW + gw; const bool act = rg < T / 16;
        const int row0 = (act ? rg : 0) * 16; const int bb = ((it * NGW + X.bid * 8) * 16) >> 14;
        __syncthreads();
        if (X.tid < 32) hist[X.tid] = 0;
        { const float* mb = mod + (size_t)(l * 2 + (bb < 2 ? bb : 1)) * 6144;
          for (int k = X.tid; k < 1024; k += 512) { at[k] = a.nfw[l * D + k] * (1.0f + mb[4 * 1024 + k]); sht[k] = mb[3 * 1024 + k]; } }
        __syncthreads();
        const int row = row0 + r;
        float rstd;
        { const f32x4 pp = *(const f32x4*)(ssq + (size_t)row * 16 + 4 * q); float ss = (pp.x + pp.y) + (pp.z + pp.w); ss += shx(ss, 16, lane); ss += shx(ss, 32, lane); rstd = __builtin_amdgcn_rsqf(ss * (1.0f / D) + EPS); }
        const bf16* xr = xin + (size_t)row * D + 8 * q; unsigned char* hr = hb + (size_t)row * D + 8 * q;
        f32x4 acc = {0.f, 0.f, 0.f, 0.f};
#pragma unroll 8
        for (int s = 0; s < 32; ++s) {
            const v4u xw = *(const v4u*)(xr + 32 * s); const f32x4 x0 = {bflo(xw.x), bfhi(xw.x), bflo(xw.y), bfhi(xw.y)}, x1 = {bflo(xw.z), bfhi(xw.z), bflo(xw.w), bfhi(xw.w)};
            const f32x4 a0 = *(const LAS f32x4*)(at + 32 * s + 8 * q), a1 = *(const LAS f32x4*)(at + 32 * s + 8 * q + 4);
            const f32x4 s0 = *(const LAS f32x4*)(sht + 32 * s + 8 * q), s1 = *(const LAS f32x4*)(sht + 32 * s + 8 * q + 4);
            const f32x4 h0 = x0 * rstd * a0 + s0, h1 = x1 * rstd * a1 + s1;
            v4u w; w.x = pk2m(h0.x, h0.y); w.y = pk2m(h0.z, h0.w); w.z = pk2m(h1.x, h1.y); w.w = pk2m(h1.z, h1.w);
            { v2u w8; w8.x = pk4_fp8(h0.x, h0.y, h0.z, h0.w); w8.y = pk4_fp8(h1.x, h1.y, h1.z, h1.w); *(v2u*)(hr + 32 * s) = w8; }
            const bf16x8 bfr = *(const LAS bf16x8*)(wrb + r * 1032 + 32 * s + 8 * q);
            acc = __builtin_amdgcn_mfma_f32_16x16x32_bf16(__builtin_bit_cast(bf16x8, w), bfr, acc, 0, 0, 0);
        }
#pragma unroll
        for (int j = 0; j < 4; ++j) lg[(4 * q + j) * 17 + r] = acc[j];
        LDS_WAIT(); asm volatile("" ::: "memory");
        int my_cls = 0; float my_ga = 0.f, my_gb = 0.f;
        if (lane < 16) {
            float sc[16], sel[16];
#pragma unroll
            for (int e = 0; e < 16; ++e) { const float p = lg[lane * 17 + e]; sc[e] = 1.0f / (1.0f + __expf(-p)); sel[e] = sc[e] + a.router_b[e]; }
            int gi = 0; float gbest = -1.0e30f;
#pragma unroll
            for (int g = 0; g < 4; ++g) { const float p0 = sel[4 * g], p1 = sel[4 * g + 1], p2 = sel[4 * g + 2], p3 = sel[4 * g + 3];
                const float gs = fmaxf(fmaxf(fmaxf(p0 + p1, p0 + p2), fmaxf(p0 + p3, p1 + p2)), fmaxf(p1 + p3, p2 + p3));
                if (gs > gbest) { gbest = gs; gi = g; } }
            float qs[4], s4[4];
#pragma unroll
            for (int i = 0; i < 4; ++i) { qs[i] = 0.f; s4[i] = 0.f; }
#pragma unroll
            for (int g = 0; g < 4; ++g) if (g == gi) {
#pragma unroll
                for (int i = 0; i < 4; ++i) { qs[i] = sel[4 * g + i]; s4[i] = sc[4 * g + i]; } }
            int i1 = 0; float b1 = qs[0];
#pragma unroll
            for (int i = 1; i < 4; ++i) if (qs[i] > b1) { b1 = qs[i]; i1 = i; }
            int i2 = -1; float b2 = -1.0e30f;
#pragma unroll
            for (int i = 0; i < 4; ++i) if (i != i1 && qs[i] > b2) { b2 = qs[i]; i2 = i; }
            const int ia = (i1 < i2) ? i1 : i2, ib = (i1 < i2) ? i2 : i1;
            float sa = 0.f, sb = 0.f;
#pragma unroll
            for (int i = 0; i < 4; ++i) { if (i == ia) sa = s4[i]; if (i == ib) sb = s4[i]; }
            const int pidx = (ia == 0) ? (ib - 1) : ((ia == 1) ? (ib + 1) : 5);
            const float inv = 1.0f / (sa + sb);
            my_cls = gi * 6 + pidx; my_ga = sa * inv; my_gb = sb * inv;
        }
        int rank = 0;
        if (act && lane < 16) rank = __hip_atomic_fetch_add(hist + my_cls, 1, __ATOMIC_RELAXED, __HIP_MEMORY_SCOPE_WORKGROUP);
        __syncthreads();
        if (X.tid < NCLS) { const int n = hist[X.tid]; cbase[X.tid] = n ? (int)__hip_atomic_fetch_add(cnt + 64 * X.tid, (unsigned)n, RLX_AGENT) : 0; }
        __syncthreads();
        if (act && lane < 16) { const int tok = row0 + lane; const int pos = cbase[my_cls] + rank;
            tokl[my_cls * CLS_CAP + pos] = tok; tgate[tok * 2] = my_ga; tgate[tok * 2 + 1] = my_gb; }
    }
}
DI MoeTab moe_tables(const Args& a, const Ctx& X, int l) {
    LAS int* tab = (LAS int*)(X.lds + TAB_OFF); LAS int* tcls = tab; LAS int* tpos = tab + 160; LAS int* cn = tab + 320; LAS int* rt_ = tab + 344;
    unsigned* cnt = (unsigned*)(a.ws + WS_CTL) + CW_CNT + l * 2048;
    if (X.tid < NCLS) cn[X.tid] = (int)__hip_atomic_load(cnt + 64 * X.tid, RLX_AGENT);
    __syncthreads();
    if (X.tid < NCLS) {
        int base = 0;
#pragma unroll 1
        for (int c = 0; c < X.tid; ++c) base += (cn[c] + 255) >> 8;
        const int n = (cn[X.tid] + 255) >> 8;
#pragma unroll 1
        for (int i = 0; i < n; ++i) { tcls[base + i] = X.tid; tpos[base + i] = i * 256; }
        if (X.tid == NCLS - 1) rt_[0] = base + n; }
    __syncthreads();
    MoeTab tb; tb.tcls = tcls; tb.tpos = tpos; tb.cnt = cn; tb.Rtot = __builtin_amdgcn_readfirstlane(rt_[0]); return tb;
}

#if defined(__HIP_DEVICE_COMPILE__)
DI Args load_args() { auto p = __builtin_amdgcn_kernarg_segment_ptr(); asm volatile("" : "+s"(p)); return *(const __attribute__((address_space(4))) Args*)p; }
#else
DI Args load_args() { return Args{}; }
#endif
__global__ void __launch_bounds__(512, 2) fwd(Args a_unused) {
    extern __shared__ __attribute__((aligned(16))) unsigned char lds_raw[];
    Ctx X; X.lds = (LAS unsigned char*)lds_raw; X.tid = threadIdx.x; X.lane = X.tid & 63; X.wave = __builtin_amdgcn_readfirstlane(X.tid >> 6); X.G = gridDim.x; X.bid = blockIdx.x;
    volatile LAS unsigned* MISC = (volatile LAS unsigned*)(X.lds + MISC_OFF);
    if (X.tid < 64) MISC[X.tid] = 0u;
    __syncthreads();
    int lo, hi; unsigned* ctl;
    { const Args a = load_args(); lo = a.ph_lo; hi = a.ph_hi; ctl = (unsigned*)(a.ws + WS_CTL); }
    XcdBarrier bar; bar.bar = ctl + CW_BAR; bar.x = 0; bar.st = MISC + 8;
    if (hi - lo > 1) bar = xcd_barrier_post(ctl + CW_BAR, MISC + 8);
#ifndef PH_MASK
#define PH_MASK 0xFFFFF
#endif
#define PON(p) ((PH_MASK >> (p)) & 1)
#ifndef DUP_MASK
#define DUP_MASK 0
#endif
#define NREP(p) (((DUP_MASK >> (p)) & 1) ? 2 : 1)
#ifndef NULEPI
#define NULEPI 0
#endif
#ifndef TSEL_MASK
#define TSEL_MASK 0
#endif
#define TSCALE 4
#define TSEL(p) ((TSEL_MASK >> (p)) & 1)
#define IN(k) (lo <= (k) && (k) < hi)
#define SEAM(k) do { if (IN(k) && IN((k) + 1)) xcd_barrier(bar); } while (0)
    unsigned long long tacc = 0ull, tph = 0ull;
#define TBEG() do { if (TSEL_MASK) tph = __builtin_amdgcn_s_memrealtime(); } while (0)
#define TEND(p) do { if (TSEL(p)) tacc += __builtin_amdgcn_s_memrealtime() - tph; } while (0)
    TBEG();
    if (PON(10) && IN(0)) { for (int rep = 0; rep < NREP(10); ++rep) { const Args a = load_args(); p0_prologue(a, X); } }
    SEAM(0); TEND(10);
    TBEG();
    for (int l = 0; l < NL; ++l) {
        const int g0 = 1 + l * NPH;
        if (PON(0) && IN(g0 + 0)) { for (int rep = 0; rep < NREP(0); ++rep) { const Args a = load_args(); unsigned char* ws = a.ws; const float* mod = (const float*)(ws + WS_MOD); bf16* proj = (bf16*)(ws + WS_PROJ); bf16* xb = (bf16*)(ws + WS_XB); (void)mod; (void)proj; (void)xb; const Ctx P = fresh(X); p1_norm_gates(a, P, l, xb); } }
        SEAM(g0 + 0); TEND(0); TBEG();
        if (PON(1) && IN(g0 + 1)) for (int rep = 0; rep < NREP(1); ++rep) { const Args a = load_args(); unsigned char* ws = a.ws; const float* mod = (const float*)(ws + WS_MOD); bf16* proj = (bf16*)(ws + WS_PROJ); bf16* xb = (bf16*)(ws + WS_XB); (void)mod; (void)proj; (void)xb; const Ctx P = fresh(X);
            DenseSched S; S.A = (const char*)(ws + WS_H); S.Bt = (const char*)(ws + WS_WIN) + (size_t)l * NPROJW * D; S.lda = D; S.ldb = D; S.ord.init(T / 256, NPROJW / 256, P.G, P.bid);
            EpiProj E; E.O = proj; E.gates = (float*)(ws + WS_GATES); E.big = a.b_ig + l * 4; E.bfg = a.b_fg + l * 4;
            pg8::gemm_phase<EpiProj, DenseSched, true>(P.lds, D, S, E);
        }
        SEAM(g0 + 1); TEND(1); TBEG();
        if (PON(2) && IN(g0 + 2)) { const Args a = load_args(); unsigned char* ws = a.ws; const float* mod = (const float*)(ws + WS_MOD); bf16* proj = (bf16*)(ws + WS_PROJ); bf16* xb = (bf16*)(ws + WS_XB); (void)mod; (void)proj; (void)xb; const Ctx P = fresh(X);
            if (PON(11)) for (int rep = 0; rep < NREP(11); ++rep) {
#pragma unroll 1
                for (int u = P.bid; u < 512; u += P.G) attn_unit(a, P, l, u); }
            if (PON(12)) for (int rep = 0; rep < NREP(12); ++rep) {
#pragma unroll 1
                for (int u = P.bid; u < 256; u += P.G) mlstm_unit<false>(a, P, l, u); }
        }
        SEAM(g0 + 2); TEND(2); TBEG();
        if (PON(3) && IN(g0 + 3)) { const Args a = load_args(); unsigned char* ws = a.ws; const float* mod = (const float*)(ws + WS_MOD); bf16* proj = (bf16*)(ws + WS_PROJ); bf16* xb = (bf16*)(ws + WS_XB); (void)mod; (void)proj; (void)xb; const Ctx P = fresh(X); mlstm_scan(a, P); }
        SEAM(g0 + 3); TEND(3); TBEG();
        if (PON(4) && IN(g0 + 4)) for (int rep = 0; rep < NREP(4); ++rep) { const Args a = load_args(); unsigned char* ws = a.ws; const float* mod = (const float*)(ws + WS_MOD); bf16* proj = (bf16*)(ws + WS_PROJ); bf16* xb = (bf16*)(ws + WS_XB); (void)mod; (void)proj; (void)xb; const Ctx P = fresh(X);
#pragma unroll 1
            for (int u = P.bid; u < 256; u += P.G) mlstm_unit<true>(a, P, l, u); }
        SEAM(g0 + 4); TEND(4); TBEG();
        if (PON(5) && IN(g0 + 5)) for (int rep = 0; rep < NREP(5); ++rep) { const Args a = load_args(); unsigned char* ws = a.ws; const float* mod = (const float*)(ws + WS_MOD); bf16* proj = (bf16*)(ws + WS_PROJ); bf16* xb = (bf16*)(ws + WS_XB); (void)mod; (void)proj; (void)xb; const Ctx P = fresh(X);
            MergeSched S; S.A0 = (const char*)(ws + WS_H); S.A1 = (const char*)(ws + WS_H) + (size_t)T * 512; S.B0 = (const char*)(ws + WS_WAU) + (size_t)l * D * 512; S.B1 = (const char*)(ws + WS_WMU) + (size_t)l * D * 512;
            S.lda = 512; S.ldb = 512; S.ord.init(T / 256, D / 256, P.G, P.bid);
            EpiMerge E; E.P = proj; E.nul = (rep == 0 && NREP(5) == 2) ? NULEPI : 0; pg8::gemm_phase<EpiMerge, MergeSched, true>(P.lds, 1024, S, E);
        }
        SEAM(g0 + 5); TEND(5); TBEG();
        if (PON(6) && IN(g0 + 6)) for (int rep = 0; rep < NREP(6); ++rep) { const Args a = load_args(); unsigned char* ws = a.ws; const float* mod = (const float*)(ws + WS_MOD); bf16* proj = (bf16*)(ws + WS_PROJ); bf16* xb = (bf16*)(ws + WS_XB); (void)mod; (void)proj; (void)xb; const Ctx P = fresh(X);
            DenseSched S; S.A = (const char*)(proj + C_MQ); S.Bt = (const char*)(ws + WS_WOUT) + (size_t)l * D * D; S.lda = NPROJ * 2; S.ldb = D; S.ord.init(T / 256, D / 256, P.G, P.bid);
            EpiRes E; E.xin = xb; E.out = xb; E.g = mod + (size_t)(l * 2) * 6144 + 2 * 1024; E.ssq = (float*)(ws + WS_SSQ); E.rmask = T - 1; E.nul = 0;
            if (rep) { E.out = (bf16*)(ws + WS_H); E.rmask = T / 2 - 1; E.nul = NULEPI; }
            pg8::gemm_phase<EpiRes, DenseSched, true>(P.lds, D, S, E);
        }
        SEAM(g0 + 6); TEND(6); TBEG();
        if (PON(7) && IN(g0 + 7)) { const Args a = load_args(); unsigned char* ws = a.ws; const float* mod = (const float*)(ws + WS_MOD); bf16* proj = (bf16*)(ws + WS_PROJ); bf16* xb = (bf16*)(ws + WS_XB); (void)mod; (void)proj; (void)xb; const Ctx P = fresh(X); p6_norm_route(a, P, l, xb); }
        SEAM(g0 + 7); TEND(7); TBEG();
        if (PON(8) && IN(g0 + 8)) for (int rep = 0; rep < NREP(8); ++rep) { const Args a = load_args(); unsigned char* ws = a.ws; const float* mod = (const float*)(ws + WS_MOD); bf16* proj = (bf16*)(ws + WS_PROJ); bf16* xb = (bf16*)(ws + WS_XB); (void)mod; (void)proj; (void)xb; const Ctx P = fresh(X);
            const MoeTab tb = moe_tables(a, P, l);
            LAS unsigned* tokoff = (LAS unsigned*)(P.lds + TOKOFF_OFF); const int* tokl = (const int*)(ws + WS_TOKL);
#pragma unroll 1
            for (int s = 0; s < 8; ++s) { const int L0 = s * P.G + P.bid;
                if (L0 < tb.Rtot * 8 && P.tid < 256) { const int L = xcd_remap(L0, tb.Rtot * 8); const int rt = L >> 3, cls = tb.tcls[rt], pos = tb.tpos[rt] + P.tid, cn = tb.cnt[cls]; const int tok = tokl[cls * CLS_CAP + (pos < cn ? pos : 0)]; tokoff[s * 256 + P.tid] = (unsigned)tok; } }
            __syncthreads();
            MoeUpSched S; S.A = (const char*)(ws + WS_H); S.W = (const char*)(ws + WS_WGU) + (size_t)l * NE * 1024 * D; S.lda = D; S.ldb = D; S.tb = tb; S.G = P.G; S.c = P.bid; S.tokoff = tokoff;
            EpiSwiglu E; E.H = (unsigned char*)proj; E.tgate = (const float*)(ws + WS_TGATE); E.tokoff = tokoff;
            pg8::gemm_phase<EpiSwiglu, MoeUpSched, true>(P.lds, D, S, E);
        }
        SEAM(g0 + 8); TEND(8); TBEG();
        if (PON(9) && IN(g0 + 9)) for (int rep = 0; rep < NREP(9); ++rep) { const Args a = load_args(); unsigned char* ws = a.ws; const float* mod = (const float*)(ws + WS_MOD); bf16* proj = (bf16*)(ws + WS_PROJ); bf16* xb = (bf16*)(ws + WS_XB); (void)mod; (void)proj; (void)xb; const Ctx P = fresh(X);
            const MoeTab tb = moe_tables(a, P, l);
            MoeDownSched S; S.A = (const char*)proj; S.W = (const char*)(ws + WS_WD) + (size_t)l * NE * 1024 * FF; S.lda = D; S.ldb = FF; S.tb = tb; S.G = P.G; S.c = P.bid;
            EpiMoeOut E; E.xin = xb; E.outb = xb; E.outf = a.out; E.last = (l == NL - 1); E.g = mod + (size_t)(l * 2) * 6144 + 5 * 1024; E.tokl = (const int*)(ws + WS_TOKL); E.tb = tb; E.rmask = T - 1;
            if (rep) { E.outb = (bf16*)(ws + WS_H); E.last = 0; E.rmask = T / 2 - 1; }
            pg8::gemm_phase<EpiMoeOut, MoeDownSched, true>(P.lds, D, S, E);
        }
        SEAM(g0 + 9); TEND(9); TBEG();
    }
    if (TSEL_MASK && X.bid == 0) { const unsigned long long t1 = __builtin_amdgcn_s_memrealtime(); while (__builtin_amdgcn_s_memrealtime() - t1 < TSCALE * tacc) __builtin_amdgcn_s_sleep(8); }
#undef IN
#undef SEAM
}

extern "C" void kernel_launch(void* const* d_in, const int* in_sizes, int n_in, void* d_out, int out_size, void* d_ws, size_t ws_size, hipStream_t stream) {
    static int grid = 0;
    if (grid == 0) {
        if (n_in != 24 || in_sizes[0] != T * D || out_size != T * D || ws_size < WS_END) { fprintf(stderr, "kernel_launch: unexpected shapes / workspace (n_in %d, ws %zu, need %zu)\n", n_in, ws_size, (size_t)WS_END); grid = -1; return; }
        int dev = 0, cus = 0;
        if (hipGetDevice(&dev) != hipSuccess || hipDeviceGetAttribute(&cus, hipDeviceAttributeMultiprocessorCount, dev) != hipSuccess) { grid = -1; return; }
        if (hipFuncSetAttribute((const void*)fwd, hipFuncAttributeMaxDynamicSharedMemorySize, LDS_BYTES) != hipSuccess) { fprintf(stderr, "kernel_launch: hipFuncSetAttribute failed\n"); grid = -1; return; }
        int per_cu = 0;
        if (hipOccupancyMaxActiveBlocksPerMultiprocessor(&per_cu, (const void*)fwd, 512, LDS_BYTES) != hipSuccess || per_cu < 1) fprintf(stderr, "kernel_launch: occupancy query reports %d\n", per_cu);
        (void)hipGetLastError();
        grid = cus < 256 ? cus : 256;
    }
    if (grid < 0) return;
    (void)hipMemsetAsync((char*)d_ws + WS_CTL, 0, CTL_ZERO_BYTES, stream);
    Args a{};
    a.x = (const float*)d_in[0]; a.c = (const float*)d_in[1]; a.pos = (const int*)d_in[2]; a.ada_w = (const float*)d_in[3]; a.ada_b = (const float*)d_in[4];
    a.nmw = (const float*)d_in[5]; a.nfw = (const float*)d_in[6]; a.w_in = (const float*)d_in[7]; a.b_ig = (const float*)d_in[8]; a.b_fg = (const float*)d_in[9];
    a.qnw = (const float*)d_in[10]; a.knw = (const float*)d_in[11]; a.sinks = (const float*)d_in[12]; a.conv_w = (const float*)d_in[13]; a.conv_b = (const float*)d_in[14];
    a.mnw = (const float*)d_in[15]; a.w_au = (const float*)d_in[16]; a.w_mu = (const float*)d_in[17]; a.w_out = (const float*)d_in[18]; a.router_w = (const float*)d_in[19];
    a.router_b = (const float*)d_in[20]; a.w_gate = (const float*)d_in[21]; a.w_up = (const float*)d_in[22]; a.w_down = (const float*)d_in[23];
    a.out = (float*)d_out; a.ws = (unsigned char*)d_ws;
#if MK_MULTI
    for (int gp = 0; gp < NGP; ++gp) { a.ph_lo = gp; a.ph_hi = gp + 1; hipLaunchKernelGGL(fwd, dim3(grid), dim3(512), LDS_BYTES, stream, a); }
#else
    a.ph_lo = 0; a.ph_hi = NGP; hipLaunchKernelGGL(fwd, dim3(grid), dim3(512), LDS_BYTES, stream, a);
#endif
}
```

```cpp
#include <hip/hip_runtime.h>
#include <cstdio>
#include <cstdint>

#ifndef MK_MULTI
#define MK_MULTI 0
#endif

#define GAS __attribute__((address_space(1)))
#define LAS __attribute__((address_space(3)))
typedef unsigned short bf16;
typedef unsigned v4u __attribute__((ext_vector_type(4)));
typedef unsigned v2u __attribute__((ext_vector_type(2)));
typedef float f32x4 __attribute__((ext_vector_type(4)));
typedef float f32x2 __attribute__((ext_vector_type(2)));
typedef short bf16x8 __attribute__((ext_vector_type(8)));
typedef short bf16x4 __attribute__((ext_vector_type(4)));
#define DI __device__ __forceinline__
#define RLX_AGENT __ATOMIC_RELAXED, __HIP_MEMORY_SCOPE_AGENT
#define LDS_WAIT() asm volatile("s_waitcnt lgkmcnt(0)" ::: "memory")
#define VM_WAIT() asm volatile("s_waitcnt vmcnt(0)" ::: "memory")

constexpr int NB = 2, SEQ = 16384, T = NB * SEQ, D = 1024, NL = 4;
constexpr int DIN_SRC = 4872;
constexpr int NPROJ = 4864;
constexpr int C_AQ = 0, C_AK = 512, C_AV = 640, C_MQ = 768, C_MK = 1280, C_MV = 1792, C_MO = 2304, C_GA = 2816, C_GB = 3840;
constexpr int NE = 16, FF = 512;
constexpr int NCLS = 24, CLS_CAP = 32768;
constexpr float EPS = 1e-6f;
constexpr int NPH = 10;
constexpr int NGP = 1 + NL * NPH;

constexpr size_t MiB = 1u << 20;
constexpr size_t WS_CTL = 0, CTL_ZERO_BYTES = 128 * 1024;
constexpr size_t WS_MOD = 1 * MiB;
constexpr size_t WS_ROPE = 2 * MiB;
constexpr size_t WS_GATES = 4 * MiB;
constexpr size_t WS_TGATE = 5 * MiB;
constexpr size_t WS_TOKL = 6 * MiB;
constexpr size_t WS_MLB = 9 * MiB;
constexpr size_t WS_MLC = 10 * MiB;
constexpr int NPROJW = 5120;
constexpr size_t WS_WIN = 28 * MiB;
constexpr size_t WS_WAU = 68 * MiB;
constexpr size_t WS_WMU = 72 * MiB;
constexpr size_t WS_WOUT = 76 * MiB;
constexpr size_t WS_WGU = 84 * MiB;
constexpr size_t WS_WD = 148 * MiB;
constexpr size_t WS_H = 212 * MiB;
constexpr size_t WS_PROJ = 276 * MiB;
constexpr size_t WS_SSQ = 580 * MiB;
constexpr size_t WS_KC = 582 * MiB;
constexpr size_t WS_XB = 614 * MiB;
constexpr size_t WS_END = 678 * MiB;

constexpr int CW_TMO = 0;
constexpr int CW_BAR = 4096;
constexpr int CW_CNT = 8192;

constexpr int RING_BYTES = 131072;
constexpr int MISC_OFF = RING_BYTES;
constexpr int TAB_OFF = RING_BYTES + 256;
constexpr int TOKOFF_OFF = RING_BYTES + 2048;
constexpr int LDS_BYTES = 147456;

typedef __bf16 bf16x2_t __attribute__((ext_vector_type(2)));
DI unsigned cvt_pk_bf16(float lo, float hi) { const f32x2 v = {lo, hi}; return __builtin_bit_cast(unsigned, __builtin_convertvector(v, bf16x2_t)); }
DI unsigned pk2m(float lo, float hi) { return cvt_pk_bf16(lo, hi); }
DI unsigned f2bf(float f) { return cvt_pk_bf16(f, 0.f) & 0xffffu; }
DI unsigned pk2(float lo, float hi) { return cvt_pk_bf16(lo, hi); }
DI float bf2f(unsigned short b) { return __builtin_bit_cast(float, ((unsigned)b) << 16); }
DI float bflo(unsigned w) { return __builtin_bit_cast(float, w << 16); }
DI float bfhi(unsigned w) { return __builtin_bit_cast(float, w & 0xffff0000u); }
DI float shx(float v, int m, int lane) { return __builtin_bit_cast(float, __builtin_amdgcn_ds_bpermute((lane ^ m) << 2, __builtin_bit_cast(int, v))); }
DI float shl_(float v, int src) { return __builtin_bit_cast(float, __builtin_amdgcn_ds_bpermute(src << 2, __builtin_bit_cast(int, v))); }
DI float wave_sum(float v, int lane) {
#pragma unroll
    for (int o = 1; o < 64; o <<= 1) v += shx(v, o, lane);
    return v;
}
DI f32x4 fp8x4(unsigned w) { const int i = (int)w; return (f32x4){__builtin_amdgcn_cvt_f32_fp8(i, 0), __builtin_amdgcn_cvt_f32_fp8(i, 1), __builtin_amdgcn_cvt_f32_fp8(i, 2), __builtin_amdgcn_cvt_f32_fp8(i, 3)}; }
DI unsigned pk4_fp8(float a0, float a1, float a2, float a3) { int p = __builtin_amdgcn_cvt_pk_fp8_f32(a0, a1, 0, false); p = __builtin_amdgcn_cvt_pk_fp8_f32(a2, a3, p, true); return (unsigned)p; }
DI f32x4 u8x4_to_f32(unsigned w) { return (f32x4){(float)(w & 0xffu), (float)((w >> 8) & 0xffu), (float)((w >> 16) & 0xffu), (float)(w >> 24)}; }
DI unsigned f32_to_u8x4(float a0, float a1, float a2, float a3) { int p = __builtin_amdgcn_cvt_pk_u8_f32(a0, 0, 0); p = __builtin_amdgcn_cvt_pk_u8_f32(a1, 1, p); p = __builtin_amdgcn_cvt_pk_u8_f32(a2, 2, p); p = __builtin_amdgcn_cvt_pk_u8_f32(a3, 3, p); return (unsigned)p; }
DI float sigmoidf_(float x) { return __builtin_amdgcn_rcpf(1.0f + __expf(-x)); }

#define XB_TMO      128
#define XB_XCNT(j)  (256  + 64 * (j))
#define XB_XSUB(j)  (1280 + 64 * (j))
#define XB_XGEN(j)  (2304 + 64 * (j))
#define XB_TOP      3328
#define XB_TOPGEN   3392
#define XCD_BAR_WORDS 3456
#define XB_SPIN_CAP (1u << 18)
__device__ __forceinline__ unsigned xb_ld(unsigned* p)              { return __hip_atomic_load(p, __ATOMIC_RELAXED, __HIP_MEMORY_SCOPE_AGENT); }
__device__ __forceinline__ unsigned xb_add(unsigned* p, unsigned v) { return __hip_atomic_fetch_add(p, v, __ATOMIC_RELAXED, __HIP_MEMORY_SCOPE_AGENT); }
__device__ __forceinline__ unsigned xb_xcc_id() { return (unsigned)__builtin_amdgcn_s_getreg((3 << 11) | 20) & 0xFu; }
#define XB_SPIN(cond, bar) do { unsigned _sp = 0; while (cond) { __builtin_amdgcn_s_sleep(1); \
    if ((++_sp & 255u) == 0u) { if (xb_ld(&(bar)[XB_TMO])) break; if (_sp > XB_SPIN_CAP) { atomicAdd(&(bar)[XB_TMO], 1u); break; } } } } while (0)
struct XcdBarrier { unsigned* bar; unsigned x; volatile LAS unsigned* st; };
__device__ __forceinline__ XcdBarrier xcd_barrier_post(unsigned* bar, volatile LAS unsigned* st) {
    XcdBarrier b; b.bar = bar; b.x = xb_xcc_id(); b.st = st;
    if (threadIdx.x == 0) (void)xb_add(&bar[XB_XCNT(b.x)], 1u);
    return b;
}
__device__ __forceinline__ void xcd_barrier_complete(unsigned* bar, unsigned x, unsigned& nloc, unsigned& nx) {
    const unsigned G = gridDim.x * gridDim.y * gridDim.z;
    unsigned sum, cnt, mine, sp = 0u;
    for (;;) {
        sum = 0u; cnt = 0u; mine = 0u;
#pragma unroll
        for (unsigned j = 0; j < 16; ++j) { const unsigned c = xb_ld(&bar[XB_XCNT(j)]); sum += c; cnt += (c > 0u) ? 1u : 0u; mine = (j == x) ? c : mine; }
        if (sum == G) break;
        __builtin_amdgcn_s_sleep(1);
        if ((++sp & 255u) == 0u) { if (xb_ld(&bar[XB_TMO])) break; if (sp > XB_SPIN_CAP) { atomicAdd(&bar[XB_TMO], 1u); break; } }
    }
    nloc = mine > 0u ? mine : 1u; nx = cnt > 0u ? cnt : 1u;
}
__device__ __forceinline__ void xcd_barrier(const XcdBarrier& b) {
    asm volatile("s_waitcnt vmcnt(0)" ::: "memory");
    __syncthreads();
    if (threadIdx.x == 0) {
        unsigned* bar = b.bar; asm volatile("" : "+s"(bar));
        __builtin_amdgcn_s_waitcnt(0);
        unsigned nloc = b.st[0], nx = b.st[1];
        if (nloc == 0u) { xcd_barrier_complete(bar, b.x, nloc, nx); b.st[0] = nloc; b.st[1] = nx; }
        const unsigned old = xb_add(&bar[XB_XSUB(b.x)], 1u);
        const unsigned gen = old / nloc;
        if (old + 1u == (gen + 1u) * nloc) {
            __builtin_amdgcn_fence(__ATOMIC_RELEASE, "agent");
            asm volatile("s_waitcnt vmcnt(0)" ::: "memory");
            const unsigned og = xb_add(&bar[XB_TOP], 1u);
            const unsigned tg = og / nx;
            if (og + 1u == (tg + 1u) * nx) xb_add(&bar[XB_TOPGEN], 1u);
            else XB_SPIN(xb_ld(&bar[XB_TOPGEN]) == tg, bar);
            __builtin_amdgcn_fence(__ATOMIC_ACQUIRE, "agent");
            xb_add(&bar[XB_XGEN(b.x)], 1u);
            asm volatile("s_waitcnt vmcnt(0)" ::: "memory");
        } else {
            XB_SPIN(xb_ld(&bar[XB_XGEN(b.x)]) == gen, bar);
            __builtin_amdgcn_fence(__ATOMIC_ACQUIRE, "agent");
            asm volatile("s_waitcnt vmcnt(0)" ::: "memory");
        }
    }
    __syncthreads();
}

namespace pg8 {
constexpr int BM = 256, BK = 64, HALF = 128, HTB = HALF * BK * 2, STAGE_BYTES = 8 * HTB, NXCD = 8, WGM = 8;
__host__ __device__ __forceinline__ int lds_byte(int r, int c) { const int st = (r >> 4) * 2 + (c >> 5), rr = r & 15, cc = c & 31, ob = rr * 64 + cc * 2; return st * 1024 + (ob ^ (((ob >> 9) & 1) << 5)); }
__host__ __device__ __forceinline__ void stage_rc(int b, int& R, int& C) { const int st = b / 1024, sb = b % 1024, swz = sb ^ (((sb >> 9) & 1) << 5); R = (st >> 1) * 16 + swz / 64; C = (st & 1) * 32 + (swz % 64) / 2; }
__host__ __device__ __forceinline__ int perm32(int rho) { const int n = rho >> 4, i = rho & 15; return 8 * (i >> 2) + 4 * n + (i & 3); }

struct Unit { int pm, pn, x0, x1; };

struct TileOrder {
    int nM, nN, nwg, G, c, shift;
    __device__ void init(int nM_, int nN_, int G_, int c_, int shift_ = 0) { nM = nM_; nN = nN_; nwg = nM * nN; G = G_; c = c_; shift = shift_; }
    __device__ bool get(int i, int& pm, int& pn) const {
        const long L = (long)i * G + c; if (L >= nwg) return false;
        int wgid = (int)L; { const int q = nwg / NXCD, r = nwg % NXCD, xcd = wgid % NXCD, off = wgid / NXCD; wgid = (xcd < r ? xcd * (q + 1) : r * (q + 1) + (xcd - r) * q) + off; }
        const int nig = WGM * nN, gid = wgid / nig, fm = gid * WGM, gsz = (nM - fm) < WGM ? (nM - fm) : WGM;
        pm = fm + ((wgid % nig) % gsz); pn = (wgid % nig) / gsz; if (gid & 1) { pn += shift; if (pn >= nN) pn -= nN; } return true;
    }
};

typedef int v8i __attribute__((ext_vector_type(8)));
template <class Epi, class Sched, bool F8 = false>
__device__ __forceinline__ void gemm_phase(LAS unsigned char* lds, const int Kb, const Sched& S, const Epi& E) {
    int tid = threadIdx.x; asm volatile("" : "+v"(tid));
    const int wid = __builtin_amdgcn_readfirstlane(tid >> 6), lane = tid & 63, wr = wid >> 2, wc = wid & 3, fr = lane & 15, fq = lane >> 4;
    const int nt = Kb / 128;
    constexpr bool GA = Sched::GATHER; constexpr int KS = Sched::KSPLIT; constexpr bool ASPLIT = Sched::ASPLIT;
    unsigned voffA[2], voffB[2]; int Rst[2], Cst[2];
#pragma unroll
    for (int i = 0; i < 2; ++i) { int R, C; stage_rc(tid * 16 + i * 8192, R, C); const int Rb = Epi::PERM ? ((R & ~31) + perm32(R & 31)) : R;
        voffA[i] = (unsigned)(R * S.lda + C * 2); voffB[i] = (unsigned)(Rb * S.ldb + C * 2); Rst[i] = R; Cst[i] = C; }
    const size_t kstep = (size_t)(BK * 2);
    const size_t hstepA = (size_t)HALF * S.lda, hstepB = (size_t)HALF * S.ldb;
    const unsigned ldsw = (unsigned)wid * 1024u; const unsigned gmul = (unsigned)S.lda;
    const int aoff = F8 ? (lds_byte(wr * 64 + fr, (fq & 1) * 16) + (fq >> 1) * 1024) : lds_byte(wr * 64 + fr, fq * 8);
    const int boff = F8 ? (lds_byte(wc * 32 + fr, (fq & 1) * 16) + (fq >> 1) * 1024) : lds_byte(wc * 32 + fr, fq * 8);
    unsigned vAc[2], vAn[2];
#define PG8_SA(b, h) (((b) * 2 + (h)) * HTB)
#define PG8_SB(b, h) ((4 + (b) * 2 + (h)) * HTB)
#define PG8_STAGE2(bufoff, gbase, v0, v1) do { \
        __builtin_amdgcn_global_load_lds((const unsigned*)((const char*)(gbase) + (v0)), (LAS unsigned*)(lds + (bufoff) + ldsw), 16, 0, 0); \
        __builtin_amdgcn_global_load_lds((const unsigned*)((const char*)(gbase) + (v1)), (LAS unsigned*)(lds + (bufoff) + ldsw + 8192), 16, 0, 0); } while (0)
#define PG8_STAGE_B(bufoff, ptr, h) PG8_STAGE2(bufoff, (ptr) + (h) * hstepB, voffB[0], voffB[1])
#define PG8_STAGE_A(bufoff, ptr, h, nx) do { if constexpr (GA) { const unsigned _p = (nx) ? vAn[h] : vAc[h]; PG8_STAGE2(bufoff, ptr, (_p & 0xffffu) * gmul + (unsigned)Cst[0] * 2u, (_p >> 16) * gmul + (unsigned)Cst[0] * 2u); } \
        else { PG8_STAGE2(bufoff, (ptr) + (h) * hstepA, voffA[0], voffA[1]); } } while (0)
    typedef int v4i_ __attribute__((ext_vector_type(4)));
#define PG8_LDA(dst, b, h) do { _Pragma("unroll") for (int m = 0; m < 4; ++m) { if constexpr (F8) { dst##8[m].lo = *(const LAS v4i_*)(lds + PG8_SA(b, h) + aoff + m * 2048); dst##8[m].hi = *(const LAS v4i_*)(lds + PG8_SA(b, h) + aoff + m * 2048 + 16); } \
        else { _Pragma("unroll") for (int k = 0; k < 2; ++k) dst[m][k] = *(const LAS bf16x8*)(lds + PG8_SA(b, h) + aoff + m * 2048 + k * 1024); } } } while (0)
#define PG8_LDB(dst, b, h) do { _Pragma("unroll") for (int n = 0; n < 2; ++n) { if constexpr (F8) { dst##8[n].lo = *(const LAS v4i_*)(lds + PG8_SB(b, h) + boff + n * 2048); dst##8[n].hi = *(const LAS v4i_*)(lds + PG8_SB(b, h) + boff + n * 2048 + 16); } \
        else { _Pragma("unroll") for (int k = 0; k < 2; ++k) dst[n][k] = *(const LAS bf16x8*)(lds + PG8_SB(b, h) + boff + n * 2048 + k * 1024); } } } while (0)
#define PG8_MMA(ai, bj, At, Bt) do { __builtin_amdgcn_s_setprio(1); _Pragma("unroll") for (int m = 0; m < 4; ++m) _Pragma("unroll") for (int n = 0; n < 2; ++n) { \
        if constexpr (F8) { asm volatile("v_mfma_scale_f32_16x16x128_f8f6f4 %0, %1, %2, %0, %3, %3 op_sel_hi:[0,0,0]" : "+v"(acc[ai][bj][m][n]) : "v"(Bt##8[n]), "v"(At##8[m]), "v"(f8scale)); } \
        else { _Pragma("unroll") for (int k = 0; k < 2; ++k) acc[ai][bj][m][n] = __builtin_amdgcn_mfma_f32_16x16x32_bf16(Bt[n][k], At[m][k], acc[ai][bj][m][n], 0, 0, 0); } } \
        __builtin_amdgcn_s_setprio(0); } while (0)
#define PG8_WAIT_V(n) asm volatile("s_waitcnt vmcnt(" #n ")" ::: "memory")
#define PG8_WAIT_L(n) asm volatile("s_waitcnt lgkmcnt(" #n ")" ::: "memory")
#define PG8_BAR __builtin_amdgcn_s_barrier()
#define PG8_SCHED __builtin_amdgcn_sched_barrier(0)
#define PG8_GOFF(dst, u) do { if constexpr (GA) { _Pragma("unroll") for (int h = 0; h < 2; ++h) dst[h] = S.a_rowoff(u, Rst[0] + HALF * h) | (S.a_rowoff(u, Rst[0] + 64 + HALF * h) << 16); } } while (0)
    Unit cur, nxt; int ui = 0;
    if (!S.next(0, cur)) return;
    f32x4 acc[2][2][4][2];
#pragma unroll
    for (int a = 0; a < 2; ++a)
#pragma unroll
        for (int b = 0; b < 2; ++b)
#pragma unroll
            for (int m = 0; m < 4; ++m)
#pragma unroll
                for (int n = 0; n < 2; ++n) acc[a][b][m][n] = (f32x4){0.f, 0.f, 0.f, 0.f};
    int f8scale = 0x7F7F7F7F; asm volatile("" : "+v"(f8scale));
    bf16x8 At[4][2], B0[2][2], B1[2][2]; v8i At8[4], B08[2], B18[2];
    const char* cA = S.a_base(cur, 0); const char* cA1 = ASPLIT ? S.a_base(cur, 1) : cA; const char* cB0 = S.b_base(cur, 0); const char* cB1 = KS ? S.b_base(cur, 1) : cB0;
    PG8_GOFF(vAc, cur);
    vAn[0] = vAc[0]; vAn[1] = vAc[1];
    PG8_STAGE_B(PG8_SB(0, 0), cB0, 0); PG8_STAGE_B(PG8_SB(0, 1), cB0, 1); PG8_STAGE_A(PG8_SA(0, 0), cA, 0, false); PG8_STAGE_A(PG8_SA(0, 1), cA, 1, false);
    if (wr == 1) PG8_BAR;
    PG8_WAIT_V(2); PG8_BAR;
    PG8_STAGE_B(PG8_SB(1, 0), cB0 + kstep, 0); PG8_STAGE_A(PG8_SA(1, 0), cA + kstep, 0, false); PG8_STAGE_B(PG8_SB(1, 1), cB0 + kstep, 1);
    PG8_WAIT_V(6); PG8_BAR;
    for (;;) {
        const bool has_next = S.next(ui + 1, nxt);
        const char* nA = has_next ? S.a_base(nxt, 0) : cA; const char* nA1 = (ASPLIT && has_next) ? S.a_base(nxt, 1) : (ASPLIT ? cA1 : nA); const char* nB0 = has_next ? S.b_base(nxt, 0) : cB0; const char* nB1 = (KS && has_next) ? S.b_base(nxt, 1) : (KS ? cB1 : nB0);
        if constexpr (GA) { if (has_next) { PG8_GOFF(vAn, nxt); } }
#pragma unroll 1
        for (int t = 0; t < nt; t += 2) {
            const bool last = (t == nt - 2);
            const char* a1 = (ASPLIT && (t + 1) >= KS) ? cA1 + (size_t)(t + 1 - KS) * kstep : cA + (size_t)(t + 1) * kstep;
            const char* a2 = last ? nA : ((ASPLIT && (t + 2) >= KS) ? cA1 + (size_t)(t + 2 - KS) * kstep : cA + (size_t)(t + 2) * kstep);
            if constexpr (Epi::MID) { if (t == KS) { int fr_ = fr, fq_ = fq; asm volatile("" : "+v"(fr_), "+v"(fq_)); if constexpr (F8) { asm volatile("s_nop 15" ::: "memory"); } E.mid(acc, cur, wr, wc, fr_, fq_); if constexpr (F8) { asm volatile("s_nop 3" ::: "memory"); } } }
            const char* b2 = last ? nB0 : ((KS && (t + 2) >= KS) ? cB1 + (size_t)(t + 2 - KS) * kstep : cB0 + (size_t)(t + 2) * kstep);
            const char* a3 = a2 + kstep; const char* b3 = b2 + kstep;
            PG8_LDB(B0, 0, 0); PG8_LDB(B1, 0, 1); PG8_SCHED; PG8_LDA(At, 0, 0); PG8_STAGE_A(PG8_SA(1, 1), a1, 1, false);
            PG8_WAIT_V(8); PG8_WAIT_L(0); PG8_BAR; PG8_MMA(0, 0, At, B0); PG8_MMA(0, 1, At, B1); PG8_BAR; PG8_SCHED;
            PG8_LDA(At, 0, 1); PG8_STAGE_B(PG8_SB(0, 0), b2, 0); PG8_STAGE_B(PG8_SB(0, 1), b2, 1); PG8_STAGE_A(PG8_SA(0, 0), a2, 0, last);
            PG8_WAIT_V(8); PG8_WAIT_L(0); PG8_BAR; PG8_MMA(1, 0, At, B0); PG8_MMA(1, 1, At, B1); PG8_BAR; PG8_SCHED;
            PG8_LDB(B0, 1, 0); PG8_LDB(B1, 1, 1); PG8_SCHED; PG8_LDA(At, 1, 0); PG8_STAGE_A(PG8_SA(0, 1), a2, 1, last);
            PG8_WAIT_V(8); PG8_WAIT_L(0); PG8_BAR; PG8_MMA(0, 0, At, B0); PG8_MMA(0, 1, At, B1); PG8_BAR; PG8_SCHED;
            PG8_LDA(At, 1, 1); PG8_STAGE_B(PG8_SB(1, 0), b3, 0); PG8_STAGE_B(PG8_SB(1, 1), b3, 1); PG8_STAGE_A(PG8_SA(1, 0), a3, 0, last);
            PG8_WAIT_V(8); PG8_WAIT_L(0); PG8_BAR; PG8_MMA(1, 0, At, B0); PG8_MMA(1, 1, At, B1); PG8_BAR; PG8_SCHED;
        }
        if (wr == 0) PG8_BAR;
        if constexpr (F8) { asm volatile("s_nop 15\n\ts_nop 15" ::: "memory"); }
        { int fr_ = fr, fq_ = fq; asm volatile("" : "+v"(fr_), "+v"(fq_));
          E(acc, cur, wr, wc, fr_, fq_); }
        if (!has_next) break;
#pragma unroll
        for (int a = 0; a < 2; ++a)
#pragma unroll
            for (int b = 0; b < 2; ++b)
#pragma unroll
                for (int m = 0; m < 4; ++m)
#pragma unroll
                    for (int n = 0; n < 2; ++n) acc[a][b][m][n] = (f32x4){0.f, 0.f, 0.f, 0.f};
        cur = nxt; cA = nA; cA1 = nA1; cB0 = nB0; cB1 = nB1; ++ui;
        vAc[0] = vAn[0]; vAc[1] = vAn[1];
        if (wr == 1) PG8_BAR;
    }
    PG8_WAIT_V(0);
    PG8_BAR;
#undef PG8_SA
#undef PG8_SB
#undef PG8_STAGE2
#undef PG8_STAGE_A
#undef PG8_STAGE_B
#undef PG8_LDA
#undef PG8_LDB
#undef PG8_MMA
#undef PG8_WAIT_V
#undef PG8_WAIT_L
#undef PG8_BAR
#undef PG8_SCHED
#undef PG8_GOFF
}
}
using pg8::Unit;


struct Args {
    const float* x; const float* c; const int* pos; const float* ada_w; const float* ada_b; const float* nmw; const float* nfw; const float* w_in;
    const float* b_ig; const float* b_fg; const float* qnw; const float* knw; const float* sinks; const float* conv_w; const float* conv_b; const float* mnw;
    const float* w_au; const float* w_mu; const float* w_out; const float* router_w; const float* router_b; const float* w_gate; const float* w_up; const float* w_down;
    float* out; unsigned char* ws; int ph_lo, ph_hi;
};

__constant__ float c_invf[8] = {1.0f, 0.1939227432012558f, 0.03760603070259094f, 0.007292664609849453f, 0.0014142135623842478f, 0.00027424818836152554f, 5.3182957344688475e-05f, 1.0313385246263351e-05f};

struct DenseSched {
    static constexpr bool GATHER = false, ASPLIT = false; static constexpr int KSPLIT = 0;
    const char* A; const char* Bt; int lda, ldb; pg8::TileOrder ord;
    DI bool next(int i, Unit& u) const { int pm, pn; if (!ord.get(i, pm, pn)) return false; u.pm = pm; u.pn = pn; u.x0 = 0; u.x1 = 0; return true; }
    DI const char* a_base(const Unit& u, int) const { return A + (size_t)u.pm * 256 * lda; }
    DI const char* b_base(const Unit& u, int) const { return Bt + (size_t)u.pn * 256 * ldb; }
    DI unsigned a_rowoff(const Unit&, int) const { return 0u; }
};
struct EpiProj {
    static constexpr bool PERM = true, MID = false;
    bf16* O; float* gates; const float* big; const float* bfg; int nul, rwrap;
    DI void operator()(const f32x4 (&acc)[2][2][4][2], const Unit& u, int wr, int wc, int fr, int fq) const {
        const int row0 = u.pm * 256 + wr * 64 + fr, col0 = u.pn * 256 + wc * 32 + 8 * fq; const bool sg = u.pn >= 9; constexpr float WSC = 1.0f / 64.0f;
        if (nul == 1) { if (acc[0][0][0][0][0] == 12345.678f) O[0] = 0; return; }
        unsigned cks = 0u;
        if (u.pn == 19) {
            if (wc == 0 && fq == 0) {
#pragma unroll
                for (int ai = 0; ai < 2; ++ai)
#pragma unroll
                    for (int m = 0; m < 4; ++m) { const int row = row0 + ai * 128 + m * 16; const f32x4 vi = acc[ai][0][m][0], vf = acc[ai][0][m][1]; f32x4 oi, of;
#pragma unroll
                        for (int j = 0; j < 4; ++j) { oi[j] = vi[j] * WSC + big[j]; const float z = vf[j] * WSC + bfg[j]; of[j] = fminf(z, 0.f) - log1pf(__expf(-fabsf(z))); }
                        *(f32x4*)(gates + (size_t)row * 8) = oi; *(f32x4*)(gates + (size_t)row * 8 + 4) = of; } }
            return; }
#pragma unroll
        for (int ai = 0; ai < 2; ++ai)
#pragma unroll
            for (int m = 0; m < 4; ++m) { bf16* rowp = O + (size_t)((row0 + ai * 128 + m * 16) & rwrap) * NPROJ + col0;
#pragma unroll
                for (int bj = 0; bj < 2; ++bj) { f32x4 v0 = acc[ai][bj][m][0], v1 = acc[ai][bj][m][1];
                    if (sg) {
#pragma unroll
                        for (int j = 0; j < 4; ++j) {
                            v0[j] = __builtin_amdgcn_rcpf(__builtin_fmaf(__builtin_amdgcn_exp2f(v0[j] * (-1.4426950408889634f / 64.0f)), 1.0f / 255.0f, 1.0f / 255.0f));
                            v1[j] = __builtin_amdgcn_rcpf(__builtin_fmaf(__builtin_amdgcn_exp2f(v1[j] * (-1.4426950408889634f / 64.0f)), 1.0f / 255.0f, 1.0f / 255.0f)); }
                        if (u.pn >= 15) {
#pragma unroll
                            for (int j = 0; j < 4; ++j) { v0[j] = fmaxf(v0[j], 1.0f); v1[j] = fmaxf(v1[j], 1.0f); } }
                        v2u q; q.x = f32_to_u8x4(v0[0], v0[1], v0[2], v0[3]); q.y = f32_to_u8x4(v1[0], v1[1], v1[2], v1[3]);
                        *(v2u*)((unsigned char*)(O + (size_t)((row0 + ai * 128 + m * 16) & rwrap) * NPROJ) + 512 * u.pn + wc * 32 + 8 * fq + bj * 128) = q; continue; }
                    if (u.pn <= 8) {
                        v0 = v0 * (WSC * 16.0f); v1 = v1 * (WSC * 16.0f);
                        v2u q; q.x = pk4_fp8(v0[0], v0[1], v0[2], v0[3]); q.y = pk4_fp8(v1[0], v1[1], v1[2], v1[3]);
                        *(v2u*)((unsigned char*)(O + (size_t)((row0 + ai * 128 + m * 16) & rwrap) * NPROJ) + 512 * u.pn + wc * 32 + 8 * fq + bj * 128) = q; continue; }
                    v0 = v0 * WSC; v1 = v1 * WSC;
                    v4u w; w.x = cvt_pk_bf16(v0[0], v0[1]); w.y = cvt_pk_bf16(v0[2], v0[3]); w.z = cvt_pk_bf16(v1[0], v1[1]); w.w = cvt_pk_bf16(v1[2], v1[3]);
                    if (nul == 3) cks ^= (w.x ^ w.y) ^ (w.z ^ w.w); else *(v4u*)(rowp + bj * 128) = w; } }
        if (nul == 3) ((unsigned*)O)[(size_t)row0 * NPROJ / 2 + col0 / 2] = cks;
    }
};
struct MergeSched {
    static constexpr bool GATHER = false, ASPLIT = true; static constexpr int KSPLIT = 4;
    const char* A0; const char* A1; const char* B0; const char* B1; int lda, ldb; pg8::TileOrder ord;
    DI bool next(int i, Unit& u) const { int pm, pn; if (!ord.get(i, pm, pn)) return false; u.pm = pm; u.pn = pn; u.x0 = 0; u.x1 = 0; return true; }
    DI const char* a_base(const Unit& u, int half) const { return (half ? A1 : A0) + (size_t)u.pm * 256 * lda; }
    DI const char* b_base(const Unit& u, int half) const { return (half ? B1 : B0) + (size_t)u.pn * 256 * ldb; }
    DI unsigned a_rowoff(const Unit&, int) const { return 0u; }
};
struct EpiMerge {
    static constexpr bool PERM = true, MID = true;
    bf16* P; int nul;
    DI void mid(f32x4 (&acc)[2][2][4][2], const Unit& u, int wr, int wc, int fr, int fq) const {
        if (nul) return;
        const int row0 = u.pm * 256 + wr * 64 + fr, cb = wc * 32 + 8 * fq;
#pragma unroll
        for (int ai = 0; ai < 2; ++ai) {
            v2u ga[4][2], gb[4][2];
#pragma unroll
            for (int m = 0; m < 4; ++m)
#pragma unroll
                for (int bj = 0; bj < 2; ++bj) { const unsigned char* rowp = (const unsigned char*)(P + (size_t)(row0 + ai * 128 + m * 16) * NPROJ) + cb + bj * 128;
                    ga[m][bj] = *(const v2u*)(rowp + 512 * (11 + u.pn)); gb[m][bj] = *(const v2u*)(rowp + 512 * (15 + u.pn)); }
#pragma unroll
            for (int m = 0; m < 4; ++m)
#pragma unroll
                for (int bj = 0; bj < 2; ++bj) { const f32x4 a0 = u8x4_to_f32(ga[m][bj].x), a1 = u8x4_to_f32(ga[m][bj].y), b0 = u8x4_to_f32(gb[m][bj].x), b1 = u8x4_to_f32(gb[m][bj].y); f32x4 r0, r1;
#pragma unroll
                    for (int j = 0; j < 4; ++j) { r0[j] = a0[j] * __builtin_amdgcn_rcpf(b0[j]); r1[j] = a1[j] * __builtin_amdgcn_rcpf(b1[j]); }
                    acc[ai][bj][m][0] *= r0; acc[ai][bj][m][1] *= r1; }
        }
    }
    DI void operator()(const f32x4 (&acc)[2][2][4][2], const Unit& u, int wr, int wc, int fr, int fq) const {
        if (nul) { if (acc[0][0][0][0][0] == 12345.678f) P[0] = 0; return; }
        const int row0 = u.pm * 256 + wr * 64 + fr, col0 = u.pn * 256 + wc * 32 + 8 * fq, cb = wc * 32 + 8 * fq; constexpr float SC = 1.0f / (32.0f * 255.0f);
        v2u gw[2][4][2];
#pragma unroll
        for (int ai = 0; ai < 2; ++ai)
#pragma unroll
            for (int m = 0; m < 4; ++m)
#pragma unroll
                for (int bj = 0; bj < 2; ++bj) gw[ai][m][bj] = *(const v2u*)((const unsigned char*)(P + (size_t)(row0 + ai * 128 + m * 16) * NPROJ) + 512 * (15 + u.pn) + cb + bj * 128);
        asm volatile("" ::: "memory");
#pragma unroll
        for (int ai = 0; ai < 2; ++ai)
#pragma unroll
            for (int m = 0; m < 4; ++m) { unsigned char* mp = (unsigned char*)(P + (size_t)(row0 + ai * 128 + m * 16) * NPROJ + C_MQ) + col0;
#pragma unroll
                for (int bj = 0; bj < 2; ++bj) { const f32x4 v0 = acc[ai][bj][m][0] * SC, v1 = acc[ai][bj][m][1] * SC; const f32x4 g0 = u8x4_to_f32(gw[ai][m][bj].x), g1 = u8x4_to_f32(gw[ai][m][bj].y);
                    v2u w; w.x = pk4_fp8(g0[0] * v0[0], g0[1] * v0[1], g0[2] * v0[2], g0[3] * v0[3]);
                    w.y = pk4_fp8(g1[0] * v1[0], g1[1] * v1[1], g1[2] * v1[2], g1[3] * v1[3]);
                    *(v2u*)(mp + bj * 128) = w; } }
    }
};
struct EpiRes {
    static constexpr bool PERM = true, MID = false;
    const bf16* xin; bf16* out; const float* g; float* ssq; int rmask, nul;
    DI void operator()(const f32x4 (&acc)[2][2][4][2], const Unit& u, int wr, int wc, int fr, int fq) const {
        const int row0 = u.pm * 256 + wr * 64 + fr, col0 = u.pn * 256 + wc * 32 + 8 * fq; const int b = (u.pm * 256) >> 14;
        if (nul) { if (acc[0][0][0][0][0] == 12345.678f) out[0] = 0; return; }
        f32x4 gv[2][2];
#pragma unroll
        for (int bj = 0; bj < 2; ++bj)
#pragma unroll
            for (int n = 0; n < 2; ++n) gv[bj][n] = *(const f32x4*)(g + b * 6144 + col0 + bj * 128 + 4 * n) * (1.0f / 512.0f);
#pragma unroll
        for (int ai = 0; ai < 2; ++ai) {
            v4u xw[4][2];
#pragma unroll
            for (int m = 0; m < 4; ++m)
#pragma unroll
                for (int bj = 0; bj < 2; ++bj) xw[m][bj] = *(const v4u*)(xin + (size_t)(row0 + ai * 128 + m * 16) * D + col0 + bj * 128);
            asm volatile("" ::: "memory");
#pragma unroll
            for (int m = 0; m < 4; ++m) { const int row = row0 + ai * 128 + m * 16; float sq = 0.f;
#pragma unroll
                for (int bj = 0; bj < 2; ++bj) { const v4u w = xw[m][bj];
                    const f32x4 o0 = (f32x4){bflo(w.x), bfhi(w.x), bflo(w.y), bfhi(w.y)} + gv[bj][0] * acc[ai][bj][m][0];
                    const f32x4 o1 = (f32x4){bflo(w.z), bfhi(w.z), bflo(w.w), bfhi(w.w)} + gv[bj][1] * acc[ai][bj][m][1];
                    v4u ow; ow.x = cvt_pk_bf16(o0.x, o0.y); ow.y = cvt_pk_bf16(o0.z, o0.w); ow.z = cvt_pk_bf16(o1.x, o1.y); ow.w = cvt_pk_bf16(o1.z, o1.w);
                    { const f32x4 q0 = o0 * o0, q1 = o1 * o1; sq += ((q0.x + q0.y) + (q0.z + q0.w)) + ((q1.x + q1.y) + (q1.z + q1.w)); }
                    *(v4u*)(out + (size_t)(row & rmask) * D + col0 + bj * 128) = ow; }
                { const int ln = fq * 16 + fr; sq += shx(sq, 16, ln); sq += shx(sq, 32, ln); }
                if (fq == 0) ssq[(size_t)row * 16 + u.pn * 4 + wc] = sq; }
            asm volatile("" ::: "memory");
        }
    }
};

struct MoeTab { const LAS int* tcls; const LAS int* tpos; const LAS int* cnt; int Rtot; };
DI int xcd_remap(int L, int nwg) { const int q = nwg >> 3, r = nwg & 7, xcd = L & 7, off = L >> 3; return (xcd < r ? xcd * (q + 1) : r * (q + 1) + (xcd - r) * q) + off; }
DI void cls_experts(int cls, int& ea, int& eb) { const int g = cls / 6, p = cls - 6 * g; const int a = (p < 3) ? 0 : ((p < 5) ? 1 : 2); const int b = (p < 3) ? (p + 1) : ((p < 5) ? (p - 1) : 3); ea = 4 * g + a; eb = 4 * g + b; }
struct MoeUpSched {
    static constexpr bool GATHER = true, ASPLIT = false; static constexpr int KSPLIT = 0;
    const char* A; const char* W; int lda, ldb; MoeTab tb; int G, c; const LAS unsigned* tokoff;
    DI bool next(int i, Unit& u) const { const int L0 = i * G + c; if (L0 >= tb.Rtot * 8) return false; const int L = xcd_remap(L0, tb.Rtot * 8); u.pm = L >> 3; u.pn = L & 7; u.x0 = i; u.x1 = __builtin_amdgcn_readfirstlane(tb.tcls[u.pm]); return true; }
    DI const char* a_base(const Unit&, int) const { return A; }
    DI const char* b_base(const Unit& u, int) const { int ea, eb; cls_experts(u.x1, ea, eb); const int e = (u.pn < 4) ? ea : eb; return W + ((size_t)e * 1024 + (size_t)(u.pn & 3) * 256) * ldb; }
    DI unsigned a_rowoff(const Unit& u, int r) const { return tokoff[u.x0 * 256 + r]; }
};
struct EpiSwiglu {
    static constexpr bool PERM = true, MID = false;
    unsigned char* H; const float* tgate; const LAS unsigned* tokoff;
    DI void operator()(const f32x4 (&acc)[2][2][4][2], const Unit& u, int wr, int wc, int fr, int fq) const {
        const int r0 = wr * 64 + fr; const int hc = (u.pn >> 2) * 512 + (u.pn & 3) * 128 + wc * 32 + 8 * fq; const int gsel = u.pn >> 2;
        float rgv[2][4];
#pragma unroll
        for (int ai = 0; ai < 2; ++ai)
#pragma unroll
            for (int m = 0; m < 4; ++m) { const unsigned tok = tokoff[u.x0 * 256 + r0 + ai * 128 + m * 16]; rgv[ai][m] = tgate[tok * 2 + gsel] * 8.0f; }
        asm volatile("" ::: "memory");
#pragma unroll
        for (int ai = 0; ai < 2; ++ai)
#pragma unroll
            for (int m = 0; m < 4; ++m) { const int r = r0 + ai * 128 + m * 16; const float rg = rgv[ai][m];
                const f32x4 G0 = acc[ai][0][m][0], G1 = acc[ai][0][m][1], U0 = acc[ai][1][m][0], U1 = acc[ai][1][m][1]; const float kk = rg * (1.0f / 4096.0f);
                float o[8];
#pragma unroll
                for (int j = 0; j < 4; ++j) { o[j] = (G0[j] * U0[j]) * kk * __builtin_amdgcn_rcpf(1.0f + __builtin_amdgcn_exp2f(G0[j] * (-1.4426950408889634f / 64.0f)));
                                              o[4 + j] = (G1[j] * U1[j]) * kk * __builtin_amdgcn_rcpf(1.0f + __builtin_amdgcn_exp2f(G1[j] * (-1.4426950408889634f / 64.0f))); }
#pragma unroll
                for (int j = 0; j < 8; ++j) o[j] = __builtin_amdgcn_fmed3f(o[j], -440.0f, 440.0f);
                v2u w; w.x = pk4_fp8(o[0], o[1], o[2], o[3]); w.y = pk4_fp8(o[4], o[5], o[6], o[7]);
                *(v2u*)(H + ((size_t)u.pm * 256 + r) * 1024 + hc) = w; }
    }
};
struct MoeDownSched {
    static constexpr bool GATHER = false, ASPLIT = false; static constexpr int KSPLIT = 4;
    const char* A; const char* W; int lda, ldb; MoeTab tb; int G, c;
    DI bool next(int i, Unit& u) const { const int L0 = i * G + c; if (L0 >= tb.Rtot * 4) return false; const int L = xcd_remap(L0, tb.Rtot * 4); u.pm = L >> 2; u.pn = L & 3; u.x0 = __builtin_amdgcn_readfirstlane(tb.tpos[u.pm]); u.x1 = __builtin_amdgcn_readfirstlane(tb.tcls[u.pm]); return true; }
    DI const char* a_base(const Unit& u, int) const { return A + (size_t)u.pm * 256 * lda; }
    DI const char* b_base(const Unit& u, int half) const { int ea, eb; cls_experts(u.x1, ea, eb); const int e = half ? eb : ea; return W + ((size_t)e * 1024 + (size_t)u.pn * 256) * ldb; }
    DI unsigned a_rowoff(const Unit&, int) const { return 0u; }
};
struct EpiMoeOut {
    static constexpr bool PERM = true, MID = false;
    const bf16* xin; bf16* outb; float* outf; const float* g; const int* tokl; MoeTab tb; int rmask, last;
    DI void operator()(const f32x4 (&acc)[2][2][4][2], const Unit& u, int wr, int wc, int fr, int fq) const {
        const int r0 = wr * 64 + fr, col0 = u.pn * 256 + wc * 32 + 8 * fq; const int cn = tb.cnt[u.x1];
        v2u gvp[2][2][2];
#pragma unroll
        for (int b = 0; b < 2; ++b)
#pragma unroll
            for (int bj = 0; bj < 2; ++bj)
#pragma unroll
                for (int n = 0; n < 2; ++n) { const f32x4 t = *(const f32x4*)(g + b * 6144 + col0 + bj * 128 + 4 * n) * (1.0f / 256.0f); gvp[b][bj][n].x = cvt_pk_bf16(t.x, t.y); gvp[b][bj][n].y = cvt_pk_bf16(t.z, t.w); }
        int tok[2][4];
#pragma unroll
        for (int ai = 0; ai < 2; ++ai)
#pragma unroll
            for (int m = 0; m < 4; ++m) { const int pos = u.x0 + r0 + ai * 128 + m * 16; tok[ai][m] = (pos < cn) ? tokl[u.x1 * CLS_CAP + pos] : -1; }
#pragma unroll
        for (int ai = 0; ai < 2; ++ai) {
            v4u xw[4][2];
#pragma unroll
            for (int m = 0; m < 4; ++m)
#pragma unroll
                for (int bj = 0; bj < 2; ++bj) { const int tk = tok[ai][m] < 0 ? 0 : tok[ai][m]; xw[m][bj] = *(const v4u*)(xin + (size_t)tk * D + col0 + bj * 128); }
            asm volatile("" ::: "memory");
#pragma unroll
            for (int m = 0; m < 4; ++m) { const int tk = tok[ai][m];
                if (tk >= 0) { const bool b1 = (tk >> 14) != 0;
#pragma unroll
                    for (int bj = 0; bj < 2; ++bj) { const v4u w = xw[m][bj];
                        const v2u pa = b1 ? gvp[1][bj][0] : gvp[0][bj][0], pb = b1 ? gvp[1][bj][1] : gvp[0][bj][1];
                        const f32x4 ga = {bflo(pa.x), bfhi(pa.x), bflo(pa.y), bfhi(pa.y)}, gb = {bflo(pb.x), bfhi(pb.x), bflo(pb.y), bfhi(pb.y)};
                        const f32x4 o0 = (f32x4){bflo(w.x), bfhi(w.x), bflo(w.y), bfhi(w.y)} + ga * acc[ai][bj][m][0];
                        const f32x4 o1 = (f32x4){bflo(w.z), bfhi(w.z), bflo(w.w), bfhi(w.w)} + gb * acc[ai][bj][m][1];
                        if (last) { float* of = outf + (size_t)tk * D + col0 + bj * 128; *(f32x4*)of = o0; *(f32x4*)(of + 4) = o1; }
                        else { v4u ow; ow.x = cvt_pk_bf16(o0.x, o0.y); ow.y = cvt_pk_bf16(o0.z, o0.w); ow.z = cvt_pk_bf16(o1.x, o1.y); ow.w = cvt_pk_bf16(o1.z, o1.w);
                            *(v4u*)(outb + (size_t)(tk & rmask) * D + col0 + bj * 128) = ow; } } } }
            asm volatile("" ::: "memory");
        }
    }
};

struct Ctx { LAS unsigned char* lds; int tid, lane, wave, G, bid; };
DI Ctx fresh(const Ctx& X) { Ctx P = X; int t = X.tid; asm volatile("" : "+v"(t)); P.tid = t; P.lane = t & 63; P.wave = __builtin_amdgcn_readfirstlane(t >> 6); return P; }

DI void tr_item(const float* W, int ldw, int K, bf16* WT, int k0, LAS float* scr, int lane) {
    { const int rr = lane >> 3, c4 = lane & 7; f32x4 v[8];
#pragma unroll
      for (int i = 0; i < 8; ++i) v[i] = *(const f32x4*)(W + (size_t)(k0 + rr + 8 * i) * ldw + 4 * c4);
#pragma unroll
      for (int i = 0; i < 8; ++i) { LAS float* d = scr + (rr + 8 * i) * 33 + 4 * c4; d[0] = v[i].x; d[1] = v[i].y; d[2] = v[i].z; d[3] = v[i].w; } }
    LDS_WAIT(); asm volatile("" ::: "memory");
    const int c = lane & 7;
#pragma unroll
    for (int j = 0; j < 4; ++j) { const int n = (lane >> 3) + 8 * j; const LAS float* s = scr + (8 * c) * 33 + n;
        v4u o; o.x = pk2(s[0 * 33], s[1 * 33]); o.y = pk2(s[2 * 33], s[3 * 33]); o.z = pk2(s[4 * 33], s[5 * 33]); o.w = pk2(s[6 * 33], s[7 * 33]);
        *(v4u*)(WT + (size_t)n * K + k0 + 8 * c) = o; }
    LDS_WAIT(); asm volatile("" ::: "memory");
}
struct TrItem { const float* W; unsigned char* WT; int ldw, K, k0; float scale; };
DI void tr_load8(const TrItem& t, int lane, f32x4 (&v)[8]) {
    const int rr = lane >> 3, c4 = lane & 7;
#pragma unroll
    for (int i = 0; i < 8; ++i) v[i] = *(const f32x4*)(t.W + (size_t)(t.k0 + rr + 8 * i) * t.ldw + 4 * c4);
}
DI void tr_store8(const TrItem& t, const f32x4 (&v)[8], LAS float* scr, int lane) {
    { const int rr = lane >> 3, c4 = lane & 7;
#pragma unroll
      for (int i = 0; i < 8; ++i) { LAS float* d = scr + (rr + 8 * i) * 33 + 4 * c4; d[0] = v[i].x; d[1] = v[i].y; d[2] = v[i].z; d[3] = v[i].w; } }
    LDS_WAIT(); asm volatile("" ::: "memory");
    const int c = lane & 7; const float scale = t.scale;
#pragma unroll
    for (int j = 0; j < 4; ++j) { const int n = (lane >> 3) + 8 * j; const LAS float* s = scr + (8 * c) * 33 + n;
        v2u o; o.x = pk4_fp8(s[0 * 33] * scale, s[1 * 33] * scale, s[2 * 33] * scale, s[3 * 33] * scale); o.y = pk4_fp8(s[4 * 33] * scale, s[5 * 33] * scale, s[6 * 33] * scale, s[7 * 33] * scale);
        *(v2u*)(t.WT + (size_t)n * t.K + t.k0 + 8 * c) = o; }
    LDS_WAIT(); asm volatile("" ::: "memory");
}
DI void p0_prologue(const Args& a, const Ctx& X) {
    unsigned char* ws = a.ws;
    LAS float* scr = (LAS float*)(X.lds + X.wave * 16384);
    const int gw = X.bid * 8 + X.wave, NGW = X.G * 8;
    constexpr int IT_WIN = 16 * 153, IT_AU = 8 * 32, IT_OUT = 16 * 32, IT_GU = 16 * 16 * 32, IT_DN = 16 * 8 * 32;
    constexpr int IT_L = IT_WIN + 2 * IT_AU + IT_OUT + IT_GU + IT_DN;
    auto decode = [&](int it, TrItem& t) {
        const int l = it / IT_L; int r = it - l * IT_L;
        if (r < IT_WIN) { const int kb = r / 153, nb = r - kb * 153, d0 = 32 * nb, s0 = (nb == 152) ? 2304 : (d0 + (d0 >= 2304 ? 8 : 0));
            t.W = a.w_in + (size_t)l * D * DIN_SRC + s0; t.ldw = DIN_SRC; t.K = D; t.WT = (unsigned char*)(ws + WS_WIN) + ((size_t)l * NPROJW + d0) * D; t.k0 = 64 * kb; t.scale = 64.0f; return; }
        r -= IT_WIN;
        if (r < IT_AU) { const int kb = r >> 5, nb = r & 31;
            t.W = a.w_au + (size_t)l * 512 * D + 32 * nb; t.ldw = D; t.K = 512; t.WT = (unsigned char*)(ws + WS_WAU) + ((size_t)l * D + 32 * nb) * 512; t.k0 = 64 * kb; t.scale = 32.0f; return; }
        r -= IT_AU;
        if (r < IT_AU) { const int kb = r >> 5, nb = r & 31;
            t.W = a.w_mu + (size_t)l * 512 * D + 32 * nb; t.ldw = D; t.K = 512; t.WT = (unsigned char*)(ws + WS_WMU) + ((size_t)l * D + 32 * nb) * 512; t.k0 = 64 * kb; t.scale = 32.0f; return; }
        r -= IT_AU;
        if (r < IT_OUT) { const int kb = r >> 5, nb = r & 31;
            t.W = a.w_out + (size_t)l * D * D + 32 * nb; t.ldw = D; t.K = D; t.WT = (unsigned char*)(ws + WS_WOUT) + ((size_t)l * D + 32 * nb) * D; t.k0 = 64 * kb; t.scale = 64.0f; return; }
        r -= IT_OUT;
        if (r < IT_GU) { const int e = r >> 9, q = r & 511, kb = q >> 5, nb = q & 31, tq = nb >> 3, rb = nb & 7;
            t.W = ((rb < 4) ? a.w_gate : a.w_up) + ((size_t)(l * NE + e) * D) * FF + 128 * tq + 32 * (rb & 3); t.ldw = FF; t.K = D; t.WT = (unsigned char*)(ws + WS_WGU) + ((size_t)(l * NE + e) * 1024 + 32 * nb) * D; t.k0 = 64 * kb; t.scale = 64.0f; return; }
        r -= IT_GU;
        { const int e = r >> 8, q = r & 255, kb = q >> 5, nb = q & 31;
            t.W = a.w_down + ((size_t)(l * NE + e) * FF) * D + 32 * nb; t.ldw = D; t.K = FF; t.WT = (unsigned char*)(ws + WS_WD) + ((size_t)(l * NE + e) * 1024 + 32 * nb) * FF; t.k0 = 64 * kb; t.scale = 32.0f; }
    };
    { TrItem cur, nxt; f32x4 va[8], vb[8];
      if (gw < NL * IT_L) { decode(gw, cur); tr_load8(cur, X.lane, va); }
#pragma unroll 1
      for (int it = gw; it < NL * IT_L; it += 2 * NGW) {
          const bool h1 = it + NGW < NL * IT_L, h2 = it + 2 * NGW < NL * IT_L;
          if (h1) { decode(it + NGW, nxt); tr_load8(nxt, X.lane, vb); }
          tr_store8(cur, va, scr, X.lane);
          if (h1) { if (h2) { decode(it + 2 * NGW, cur); tr_load8(cur, X.lane, va); }
                    tr_store8(nxt, vb, scr, X.lane); } } }
    { const float* xs = a.x; bf16* xb = (bf16*)(ws + WS_XB);
      const size_t NP = (size_t)T * D / 8, ST = (size_t)X.G * 512;
      for (size_t i = (size_t)X.bid * 512 + X.tid; i < NP; i += 4 * ST) { f32x4 v0[4], v1[4];
#pragma unroll
          for (int k = 0; k < 4; ++k) { const size_t ii = i + k * ST; if (ii < NP) { v0[k] = *(const f32x4*)(xs + 8 * ii); v1[k] = *(const f32x4*)(xs + 8 * ii + 4); } }
#pragma unroll
          for (int k = 0; k < 4; ++k) { const size_t ii = i + k * ST; if (ii < NP) { v4u w; w.x = cvt_pk_bf16(v0[k].x, v0[k].y); w.y = cvt_pk_bf16(v0[k].z, v0[k].w); w.z = cvt_pk_bf16(v1[k].x, v1[k].y); w.w = cvt_pk_bf16(v1[k].z, v1[k].w); *(v4u*)(xb + 8 * ii) = w; } } } }
    { float* cs = (float*)(ws + WS_ROPE); float* sn = cs + (size_t)T * 8;
      for (int i = X.bid * 512 + X.tid; i < T * 8; i += X.G * 512) { const int tok = i >> 3, f = i & 7; const float angf = (float)a.pos[tok] * c_invf[f];
          double rev = (double)angf * 0.15915494309189535; rev -= rint(rev); const float rf = (float)rev;
          cs[i] = __builtin_amdgcn_cosf(rf); sn[i] = __builtin_amdgcn_sinf(rf); } }
    __syncthreads();
    LAS float* cact = (LAS float*)X.lds; LAS float* red = (LAS float*)(X.lds + 8192);
    for (int i = X.tid; i < 2048; i += 512) { const float cv = a.c[i]; cact[i] = cv / (1.0f + __expf(-cv)); }
    __syncthreads();
    float* mod = (float*)(ws + WS_MOD);
    for (int it = X.bid; it < NL * 48; it += X.G) { const int l = it / 48, cg = it - l * 48; const int hl = X.lane >> 5, ln = X.lane & 31, ks = X.wave * 2 + hl; const int col = cg * 128 + 4 * ln;
        const float* w = a.ada_w + (size_t)l * D * 6144 + col; f32x4 s0 = {0.f, 0.f, 0.f, 0.f}, s1 = {0.f, 0.f, 0.f, 0.f};
#pragma unroll 1
        for (int k16 = 0; k16 < 64; k16 += 16) { const int kb = ks * 64 + k16; f32x4 wv[16];
#pragma unroll
            for (int kk = 0; kk < 16; ++kk) wv[kk] = *(const f32x4*)(w + (size_t)(kb + kk) * 6144);
#pragma unroll
            for (int kk = 0; kk < 16; ++kk) { s0 += wv[kk] * cact[kb + kk]; s1 += wv[kk] * cact[1024 + kb + kk]; } }
        *(LAS f32x4*)(red + (ks * 2 + 0) * 128 + 4 * ln) = s0; *(LAS f32x4*)(red + (ks * 2 + 1) * 128 + 4 * ln) = s1;
        __syncthreads();
        if (X.tid < 256) { const int b = X.tid >> 7, cc = X.tid & 127; float sm = 0.f;
#pragma unroll
          for (int s16 = 0; s16 < 16; ++s16) sm += red[(s16 * 2 + b) * 128 + cc];
          mod[(size_t)(l * 2 + b) * 6144 + cg * 128 + cc] = sm + a.ada_b[l * 6144 + cg * 128 + cc]; }
        __syncthreads();
    }
}

DI void p1_norm_gates(const Args& a, const Ctx& X, int l, const bf16* xin) {
    unsigned char* ws = a.ws;
    const float* mod = (const float*)(ws + WS_MOD); unsigned char* hb = (unsigned char*)(ws + WS_H);
    const int gw = X.bid * 8 + X.wave, NGW = X.G * 8;
    for (int rg = gw; rg < T / 16; rg += NGW) {
        const int row0 = rg * 16, b = row0 >> 14;
        const float* mb = mod + (size_t)(l * 2 + b) * 6144;
        f32x4 aw[4], sh[4];
#pragma unroll
        for (int j = 0; j < 4; ++j) { const int k = 256 * j + 4 * X.lane; const f32x4 nw = *(const f32x4*)(a.nmw + l * D + k); const f32x4 sc = *(const f32x4*)(mb + 1024 + k); aw[j] = nw * (sc + 1.0f); sh[j] = *(const f32x4*)(mb + k); }
        v2u pre[4][4];
#pragma unroll
        for (int q = 0; q < 4; ++q) { const v2u* xp = (const v2u*)(xin + (size_t)(row0 + q) * D) + X.lane;
#pragma unroll
            for (int j = 0; j < 4; ++j) pre[q][j] = xp[64 * j]; }
#pragma unroll 1
        for (int rb = 0; rb < 16; rb += 4) {
#pragma unroll
          for (int q = 0; q < 4; ++q) { const int row = row0 + rb + q;
            f32x4 v[4]; float ss = 0.f;
#pragma unroll
            for (int j = 0; j < 4; ++j) { const v2u pw = pre[q][j]; v[j] = (f32x4){bflo(pw.x), bfhi(pw.x), bflo(pw.y), bfhi(pw.y)}; }
            if (rb + 4 < 16) { const v2u* xp = (const v2u*)(xin + (size_t)(row + 4) * D) + X.lane;
#pragma unroll
                for (int j = 0; j < 4; ++j) pre[q][j] = xp[64 * j]; }
#pragma unroll
            for (int j = 0; j < 4; ++j) ss += (v[j].x * v[j].x + v[j].y * v[j].y) + (v[j].z * v[j].z + v[j].w * v[j].w);
            ss = wave_sum(ss, X.lane); const float rstd = __builtin_amdgcn_rsqf(ss * (1.0f / D) + EPS);
            unsigned* o4 = (unsigned*)(hb + (size_t)row * D) + X.lane;
#pragma unroll
            for (int j = 0; j < 4; ++j) { v[j] = v[j] * rstd * aw[j] + sh[j]; o4[64 * j] = pk4_fp8(v[j].x, v[j].y, v[j].z, v[j].w); }
          }
        }
    }
}

DI void attn_unit(const Args& a, const Ctx& X, int l, int unit) {
    unsigned char* ws = a.ws; const bf16* proj = (const bf16*)(ws + WS_PROJ); unsigned char* ao = (unsigned char*)(ws + WS_H);
    const float* cs = (const float*)(ws + WS_ROPE); const float* sn = cs + (size_t)T * 8;
    const int b = unit >> 8, rem = unit & 255, nb = rem >> 1, kvh = rem & 1; const int tok0 = b * SEQ + nb * 128;
    LAS bf16* Kl = (LAS bf16*)X.lds;
    LAS bf16* VT = (LAS bf16*)(X.lds + 36864);
    int lane = X.lane; asm volatile("" : "+v"(lane));
    const int c16 = lane & 15, quad = lane >> 4;
    v2u nq[2][2]; f32x4 ncs[2][2], nsn[2][2];
#define AT_PREF(task_) do { const int g_ = (task_) >> 2; _Pragma("unroll") for (int rt = 0; rt < 2; ++rt) { const int tq_ = tok0 + 32 * ((task_) & 3) + 16 * rt + c16; \
        const unsigned char* qp_ = (const unsigned char*)(proj + (size_t)tq_ * NPROJ) + 512 * ((kvh * 4 + g_) >> 2) + ((kvh * 4 + g_) & 3) * 64; nq[rt][0] = *(const v2u*)(qp_ + 8 * quad); nq[rt][1] = *(const v2u*)(qp_ + 32 + 8 * quad); \
        ncs[rt][0] = *(const f32x4*)(cs + (size_t)tq_ * 8); ncs[rt][1] = *(const f32x4*)(cs + (size_t)tq_ * 8 + 4); nsn[rt][0] = *(const f32x4*)(sn + (size_t)tq_ * 8); nsn[rt][1] = *(const f32x4*)(sn + (size_t)tq_ * 8 + 4); } } while (0)
    AT_PREF(X.wave);
    float qw[16];
#pragma unroll
    for (int i = 0; i < 8; ++i) { qw[i] = a.qnw[l * 64 + 8 * quad + i]; qw[8 + i] = a.qnw[l * 64 + 32 + 8 * quad + i]; }
    const f32x4 sk4 = *(const f32x4*)(a.sinks + l * 8 + kvh * 4);
    {
        const int row = X.tid >> 1, half = X.tid & 1; const int tokk = tok0 - 128 + row; const bool valid = (nb > 0) || (row >= 128);
        float y[32]; float vv[32];
        f32x4 kn4[8], rc4[2], rs4[2];
        { const float* knp = a.knw + l * 64 + half * 32; const size_t tkc = (size_t)(valid ? tokk : tok0) * 8;
#pragma unroll
          for (int i = 0; i < 8; ++i) kn4[i] = *(const f32x4*)(knp + 4 * i);
          rc4[0] = *(const f32x4*)(cs + tkc); rc4[1] = *(const f32x4*)(cs + tkc + 4); rs4[0] = *(const f32x4*)(sn + tkc); rs4[1] = *(const f32x4*)(sn + tkc + 4); }
        if (valid) {
            const unsigned char* rowp = (const unsigned char*)(proj + (size_t)tokk * NPROJ) + 512 * 2 + kvh * 64 + half * 32; const v4u kw0 = *(const v4u*)rowp, kw1 = *(const v4u*)(rowp + 16), vw0 = *(const v4u*)(rowp + 128), vw1 = *(const v4u*)(rowp + 144);
            const unsigned kd[8] = {kw0.x, kw0.y, kw0.z, kw0.w, kw1.x, kw1.y, kw1.z, kw1.w}, vd[8] = {vw0.x, vw0.y, vw0.z, vw0.w, vw1.x, vw1.y, vw1.z, vw1.w};
#pragma unroll
            for (int q = 0; q < 8; ++q) { const f32x4 kf4 = fp8x4(kd[q]), vf4 = fp8x4(vd[q]) * (1.0f / 16.0f);
#pragma unroll
                for (int j = 0; j < 4; ++j) { y[4 * q + j] = kf4[j]; vv[4 * q + j] = vf4[j]; } }
        } else {
#pragma unroll
            for (int i = 0; i < 32; ++i) { y[i] = 0.f; vv[i] = 0.f; } }
        float ss = 0.f;
#pragma unroll
        for (int i = 0; i < 32; ++i) ss += y[i] * y[i];
        ss += shx(ss, 1, lane); const float rstd = __builtin_amdgcn_rsqf(ss * (1.0f / 64.0f) + EPS * 256.0f);
#pragma unroll
        for (int i = 0; i < 32; ++i) y[i] = y[i] * rstd * kn4[i >> 2][i & 3];
        if (half == 0 && valid) {
#pragma unroll
            for (int d = 0; d < 8; ++d) { const float c = rc4[d >> 2][d & 3], s = rs4[d >> 2][d & 3]; const float t1 = y[d], t2 = y[d + 8]; y[d] = t1 * c - t2 * s; y[d + 8] = t2 * c + t1 * s; } }
#pragma unroll
        for (int q = 0; q < 4; ++q) { v4u w; w.x = pk2(y[8 * q], y[8 * q + 1]); w.y = pk2(y[8 * q + 2], y[8 * q + 3]); w.z = pk2(y[8 * q + 4], y[8 * q + 5]); w.w = pk2(y[8 * q + 6], y[8 * q + 7]);
            *(LAS v4u*)(Kl + row * 72 + half * 32 + 8 * q) = w; }
#pragma unroll
        for (int i = 0; i < 32; ++i) VT[(half * 32 + i) * 280 + row] = (bf16)f2bf(vv[i]);
        if (X.tid < 64) {
#pragma unroll
            for (int cc = 256; cc < 280; ++cc) VT[X.tid * 280 + cc] = 0; }
    }
    __syncthreads();
    int dbase = 4 * quad - c16; asm volatile("" : "+v"(dbase));
#pragma unroll 1
    for (int it = 0; it < 2; ++it) {
        const int task = X.wave + 8 * it; const int g = task >> 2, rq = task & 3, ka = 2 * rq, head = kvh * 4 + g;
        const float sinkl = ((g == 0) ? sk4.x : ((g == 1) ? sk4.y : ((g == 2) ? sk4.z : sk4.w))) * 1.4426950408889634f;
        float qv[2][16]; float ss[2]; f32x4 cc[2][2], sv4[2][2];
#pragma unroll
        for (int rt = 0; rt < 2; ++rt) { const v2u w0 = nq[rt][0], w1 = nq[rt][1]; cc[rt][0] = ncs[rt][0]; cc[rt][1] = ncs[rt][1]; sv4[rt][0] = nsn[rt][0]; sv4[rt][1] = nsn[rt][1];
            { const f32x4 q0 = fp8x4(w0.x), q1 = fp8x4(w0.y), q2 = fp8x4(w1.x), q3 = fp8x4(w1.y);
#pragma unroll
              for (int j = 0; j < 4; ++j) { qv[rt][j] = q0[j]; qv[rt][4 + j] = q1[j]; qv[rt][8 + j] = q2[j]; qv[rt][12 + j] = q3[j]; } }
            ss[rt] = (((qv[rt][0] * qv[rt][0] + qv[rt][1] * qv[rt][1]) + (qv[rt][2] * qv[rt][2] + qv[rt][3] * qv[rt][3])) + ((qv[rt][4] * qv[rt][4] + qv[rt][5] * qv[rt][5]) + (qv[rt][6] * qv[rt][6] + qv[rt][7] * qv[rt][7])))
                   + (((qv[rt][8] * qv[rt][8] + qv[rt][9] * qv[rt][9]) + (qv[rt][10] * qv[rt][10] + qv[rt][11] * qv[rt][11])) + ((qv[rt][12] * qv[rt][12] + qv[rt][13] * qv[rt][13]) + (qv[rt][14] * qv[rt][14] + qv[rt][15] * qv[rt][15]))); }
        { const float t0 = shx(ss[0], 16, lane), t1 = shx(ss[1], 16, lane); ss[0] += t0; ss[1] += t1; }
        { const float t0 = shx(ss[0], 32, lane), t1 = shx(ss[1], 32, lane); ss[0] += t0; ss[1] += t1; }
        float ot[2][8];
#pragma unroll
        for (int rt = 0; rt < 2; ++rt) { const float rs_ = __builtin_amdgcn_rsqf(ss[rt] * (1.0f / 64.0f) + EPS * 256.0f) * (0.125f * 1.4426950408889634f);
#pragma unroll
            for (int i = 0; i < 16; ++i) qv[rt][i] = qv[rt][i] * rs_ * qw[i]; }
#pragma unroll
        for (int rt = 0; rt < 2; ++rt)
#pragma unroll
            for (int d = 0; d < 8; ++d) ot[rt][d] = shx(qv[rt][d], 16, lane);
        bf16x8 qf[2][2];
#pragma unroll
        for (int rt = 0; rt < 2; ++rt) { const float cv[8] = {cc[rt][0].x, cc[rt][0].y, cc[rt][0].z, cc[rt][0].w, cc[rt][1].x, cc[rt][1].y, cc[rt][1].z, cc[rt][1].w}, sv[8] = {sv4[rt][0].x, sv4[rt][0].y, sv4[rt][0].z, sv4[rt][0].w, sv4[rt][1].x, sv4[rt][1].y, sv4[rt][1].z, sv4[rt][1].w};
#pragma unroll
            for (int d = 0; d < 8; ++d) { if (quad == 0) qv[rt][d] = qv[rt][d] * cv[d] - ot[rt][d] * sv[d]; else if (quad == 1) qv[rt][d] = qv[rt][d] * cv[d] + ot[rt][d] * sv[d]; }
            v4u w; w.x = pk2m(qv[rt][0], qv[rt][1]); w.y = pk2m(qv[rt][2], qv[rt][3]); w.z = pk2m(qv[rt][4], qv[rt][5]); w.w = pk2m(qv[rt][6], qv[rt][7]); qf[rt][0] = __builtin_bit_cast(bf16x8, w);
            w.x = pk2m(qv[rt][8], qv[rt][9]); w.y = pk2m(qv[rt][10], qv[rt][11]); w.z = pk2m(qv[rt][12], qv[rt][13]); w.w = pk2m(qv[rt][14], qv[rt][15]); qf[rt][1] = __builtin_bit_cast(bf16x8, w); }
        __builtin_amdgcn_sched_barrier(0);
        f32x4 sacc[2][9];
#pragma unroll
        for (int i = 0; i < 10; ++i) { const LAS bf16* kr = Kl + (16 * (ka + i) + c16) * 72 + 8 * quad;
            const bf16x8 k0 = *(const LAS bf16x8*)kr, k1 = *(const LAS bf16x8*)(kr + 32);
            if (i <= 8) { f32x4 z = {0.f, 0.f, 0.f, 0.f}; z = __builtin_amdgcn_mfma_f32_16x16x32_bf16(k0, qf[0][0], z, 0, 0, 0); sacc[0][(i <= 8) ? i : 0] = __builtin_amdgcn_mfma_f32_16x16x32_bf16(k1, qf[0][1], z, 0, 0, 0); }
            if (i >= 1) { f32x4 z = {0.f, 0.f, 0.f, 0.f}; z = __builtin_amdgcn_mfma_f32_16x16x32_bf16(k0, qf[1][0], z, 0, 0, 0); sacc[1][(i >= 1) ? i - 1 : 0] = __builtin_amdgcn_mfma_f32_16x16x32_bf16(k1, qf[1][1], z, 0, 0, 0); }
            if ((i & 3) == 3) asm volatile("" ::: "memory"); }
        __builtin_amdgcn_sched_barrier(0);
        if (it == 0) { AT_PREF(X.wave + 8); }
        if (nb > 0) {
#pragma unroll
            for (int rt = 0; rt < 2; ++rt)
#pragma unroll
                for (int j = 0; j < 4; ++j) { sacc[rt][0][j] = (dbase + j > 0) ? sacc[rt][0][j] : -3.0e38f; sacc[rt][8][j] = (dbase + j <= 0) ? sacc[rt][8][j] : -3.0e38f; }
        } else {
#pragma unroll
            for (int rt = 0; rt < 2; ++rt) { int kbase = 16 * (ka + rt) + 4 * quad; asm volatile("" : "+v"(kbase));
#pragma unroll
                for (int i = 0; i < 9; ++i)
#pragma unroll
                    for (int j = 0; j < 4; ++j) { const int dlt = dbase + 16 * i + j; const int kj = kbase + 16 * i + j; const bool ok = (dlt > 0) && (dlt <= 128) && (kj >= 128); sacc[rt][i][j] = ok ? sacc[rt][i][j] : -3.0e38f; } } }
        float mx[2], sum[2], inv[2];
#pragma unroll
        for (int rt = 0; rt < 2; ++rt) { float m0 = sacc[rt][0][0], m1 = sacc[rt][0][1], m2 = sacc[rt][0][2], m3 = sacc[rt][0][3];
#pragma unroll
            for (int i = 1; i < 9; ++i) { m0 = fmaxf(m0, sacc[rt][i][0]); m1 = fmaxf(m1, sacc[rt][i][1]); m2 = fmaxf(m2, sacc[rt][i][2]); m3 = fmaxf(m3, sacc[rt][i][3]); }
            mx[rt] = fmaxf(sinkl, fmaxf(fmaxf(m0, m1), fmaxf(m2, m3))); }
        { const float t0 = shx(mx[0], 16, lane), t1 = shx(mx[1], 16, lane); mx[0] = fmaxf(mx[0], t0); mx[1] = fmaxf(mx[1], t1); }
        { const float t0 = shx(mx[0], 32, lane), t1 = shx(mx[1], 32, lane); mx[0] = fmaxf(mx[0], t0); mx[1] = fmaxf(mx[1], t1); }
#pragma unroll
        for (int rt = 0; rt < 2; ++rt) { float s0 = 0.f, s1 = 0.f, s2 = 0.f, s3 = 0.f;
#pragma unroll
            for (int i = 0; i < 9; ++i) { const f32x4 p = {__builtin_amdgcn_exp2f(sacc[rt][i][0] - mx[rt]), __builtin_amdgcn_exp2f(sacc[rt][i][1] - mx[rt]), __builtin_amdgcn_exp2f(sacc[rt][i][2] - mx[rt]), __builtin_amdgcn_exp2f(sacc[rt][i][3] - mx[rt])};
                sacc[rt][i] = p; s0 += p[0]; s1 += p[1]; s2 += p[2]; s3 += p[3]; }
            sum[rt] = (s0 + s1) + (s2 + s3); }
        { const float t0 = shx(sum[0], 16, lane), t1 = shx(sum[1], 16, lane); sum[0] += t0; sum[1] += t1; }
        { const float t0 = shx(sum[0], 32, lane), t1 = shx(sum[1], 32, lane); sum[0] += t0; sum[1] += t1; }
#pragma unroll
        for (int rt = 0; rt < 2; ++rt) inv[rt] = __builtin_amdgcn_rcpf(sum[rt] + __builtin_amdgcn_exp2f(sinkl - mx[rt])) * 8.0f;
        __builtin_amdgcn_sched_barrier(0);
        f32x4 oacc[2][4];
#pragma unroll
        for (int rt = 0; rt < 2; ++rt)
#pragma unroll
            for (int et = 0; et < 4; ++et) oacc[rt][et] = (f32x4){0.f, 0.f, 0.f, 0.f};
#pragma unroll
        for (int kk = 0; kk < 5; ++kk) {
            v4u p0, p1;
            p0.x = pk2m(sacc[0][2 * kk][0], sacc[0][2 * kk][1]); p0.y = pk2m(sacc[0][2 * kk][2], sacc[0][2 * kk][3]);
            if (kk < 4) { p0.z = pk2m(sacc[0][(kk < 4) ? 2 * kk + 1 : 0][0], sacc[0][(kk < 4) ? 2 * kk + 1 : 0][1]); p0.w = pk2m(sacc[0][(kk < 4) ? 2 * kk + 1 : 0][2], sacc[0][(kk < 4) ? 2 * kk + 1 : 0][3]); } else { p0.z = 0u; p0.w = 0u; }
            if (kk > 0) { p1.x = pk2m(sacc[1][(kk > 0) ? 2 * kk - 1 : 0][0], sacc[1][(kk > 0) ? 2 * kk - 1 : 0][1]); p1.y = pk2m(sacc[1][(kk > 0) ? 2 * kk - 1 : 0][2], sacc[1][(kk > 0) ? 2 * kk - 1 : 0][3]); } else { p1.x = 0u; p1.y = 0u; }
            p1.z = pk2m(sacc[1][2 * kk][0], sacc[1][2 * kk][1]); p1.w = pk2m(sacc[1][2 * kk][2], sacc[1][2 * kk][3]);
            const bf16x8 pf0 = __builtin_bit_cast(bf16x8, p0), pf1 = __builtin_bit_cast(bf16x8, p1);
#pragma unroll
            for (int et = 0; et < 4; ++et) { const LAS bf16* vr = VT + (16 * et + c16) * 280 + 16 * ka + 32 * kk + 4 * quad;
                const v2u lo = *(const LAS v2u*)vr, hi = *(const LAS v2u*)(vr + 16); v4u vw; vw.x = lo.x; vw.y = lo.y; vw.z = hi.x; vw.w = hi.y; const bf16x8 vf = __builtin_bit_cast(bf16x8, vw);
                oacc[0][et] = __builtin_amdgcn_mfma_f32_16x16x32_bf16(vf, pf0, oacc[0][et], 0, 0, 0);
                oacc[1][et] = __builtin_amdgcn_mfma_f32_16x16x32_bf16(vf, pf1, oacc[1][et], 0, 0, 0); }
            asm volatile("" ::: "memory"); }
#pragma unroll
        for (int rt = 0; rt < 2; ++rt) { const int tokq = tok0 + 32 * rq + 16 * rt + c16;
#pragma unroll
            for (int et = 0; et < 4; ++et)
                *(unsigned*)(ao + (size_t)tokq * 512 + head * 64 + 16 * et + 4 * quad) = pk4_fp8(oacc[rt][et][0] * inv[rt], oacc[rt][et][1] * inv[rt], oacc[rt][et][2] * inv[rt], oacc[rt][et][3] * inv[rt]); }
    }
    __syncthreads();
#undef AT_PREF
}

constexpr int ML_Q = 0, ML_K = 17408, ML_KET = 34816, ML_VT = 53248, ML_CT = 73984, ML_CW = 113152, ML_CB = 118272, ML_RED = 118784, ML_NW = 119296, ML_GT = 119808;
DI float bfw(unsigned w, int hi) { return hi ? bfhi(w) : bflo(w); }
template <bool L3> DI void mlstm_unit(const Args& a, const Ctx& X, int l, int unit) {
    unsigned char* ws = a.ws; const bf16* proj = (const bf16*)(ws + WS_PROJ); unsigned char* hm = (unsigned char*)(ws + WS_H) + (size_t)T * 512;
    unsigned char* kcb = (unsigned char*)(ws + WS_KC);
    const float* gates = (const float*)(ws + WS_GATES); float* mlc = (float*)(ws + WS_MLC) + (size_t)unit * 18432; float* mlb = (float*)(ws + WS_MLB);
    const int seq = unit >> 5, sj = unit & 31, b = seq >> 2, hh = seq & 3; const int tokbase = b * SEQ + sj * 512;
    LAS bf16* Qs = (LAS bf16*)(X.lds + ML_Q); LAS bf16* Ks = (LAS bf16*)(X.lds + ML_K); LAS bf16* KET = (LAS bf16*)(X.lds + ML_KET);
    LAS bf16* VT = (LAS bf16*)(X.lds + ML_VT); LAS bf16* CT = (LAS bf16*)(X.lds + ML_CT); LAS float* CW = (LAS float*)(X.lds + ML_CW);
    LAS float* CB = (LAS float*)(X.lds + ML_CB); LAS float* RED = (LAS float*)(X.lds + ML_RED); LAS float* NW = (LAS float*)(X.lds + ML_NW);
    LAS float* GT = (LAS float*)(X.lds + ML_GT);
    int lane = X.lane; asm volatile("" : "+v"(lane));
    const int c16 = lane & 15, quad = lane >> 4, w = X.wave;
    int tidl = X.tid; asm volatile("" : "+v"(tidl));
    const int tg = tidl >> 5, cg = tidl & 31, t0 = 4 * tg, c0 = 4 * cg;
    unsigned rq[7], rk[7], rv[4], kcv[4];
#define ML_LBAR() do { asm volatile("s_waitcnt lgkmcnt(0)" ::: "memory"); __builtin_amdgcn_s_barrier(); asm volatile("" ::: "memory"); } while (0)
#define ML_LOADRAW(tokc) do { _Pragma("unroll") for (int j = 0; j < 7; ++j) { const int tt = (tokc) + t0 - 3 + j; const bool ok = tt >= b * SEQ; const unsigned char* rp = (const unsigned char*)(proj + (size_t)(ok ? tt : (tokc)) * NPROJ) + 512 * ((L3 ? 3 : 5) + (hh >> 1)) + (hh & 1) * 128 + c0; \
        if (L3) rq[j] = *(const unsigned*)rp; else rk[j] = *(const unsigned*)rp; } \
        if (L3) { _Pragma("unroll") for (int i = 0; i < 4; ++i) kcv[i] = *(const unsigned*)(kcb + (size_t)((tokc) + t0 + i) * 512 + hh * 128 + c0); } \
        _Pragma("unroll") for (int i = 0; i < 4; ++i) rv[i] = *(const unsigned*)((const unsigned char*)(proj + (size_t)((tokc) + t0 + i) * NPROJ) + 512 * (7 + (hh >> 1)) + (hh & 1) * 128 + c0); } while (0)
    ML_LOADRAW(tokbase);
    { float cwv[3];
#pragma unroll
      for (int k3 = 0; k3 < 3; ++k3) { const int idx = (X.tid + 512 * k3 < 1280) ? (X.tid + 512 * k3) : 1279; const int tap = idx >> 8, ch = idx & 255; const int gch = (ch < 128) ? (hh * 128 + ch) : (512 + hh * 128 + (ch - 128));
          const float* cp = (tap < 4) ? (a.conv_w + (size_t)(l * 4 + tap) * 1024 + gch) : (a.conv_b + l * 1024 + gch); cwv[k3] = *cp; }
      const float nwv = a.mnw[l * 512 + hh * 128 + (X.tid & 127)];
      const float* gp = gates + (size_t)(tokbase + X.tid) * 8; const float g0v = gp[hh], g1v = gp[4 + hh];
      CW[X.tid] = cwv[0] * (1.0f / 16.0f); CW[512 + X.tid] = cwv[1] * (1.0f / 16.0f); if (X.tid < 256) CW[1024 + X.tid] = cwv[2];
      if (X.tid < 128) NW[X.tid] = nwv;
      GT[2 * X.tid] = g0v; GT[2 * X.tid + 1] = g1v; }
    for (int idx = X.tid; idx < 16 * 72; idx += 512) { const bf16 ov = (idx < 72) ? (bf16)0x3F80 : (bf16)0; VT[128 * 72 + idx] = ov; if (!L3) ((LAS bf16*)(X.lds + ML_CT))[128 * 72 + idx] = ov; }
    f32x4 cacc[9];
#pragma unroll
    for (int et = 0; et < 9; ++et) {
        if (L3) {
            { const f32x4 v = *(const f32x4*)(mlc + (16 * et + c16) * 128 + 16 * w + 4 * quad); cacc[et] = v; v2u pw; pw.x = pk2(v[0], v[1]); pw.y = pk2(v[2], v[3]); *(LAS v2u*)(CT + (16 * et + c16) * 136 + 16 * w + 4 * quad) = pw; }
        } else cacc[et] = (f32x4){0.f, 0.f, 0.f, 0.f};
    }
    float bsum = 0.f;
    __syncthreads();
#pragma unroll 1
    for (int c = 0; c < 8; ++c) {
        const int tok0 = tokbase + c * 64;
        LAS bf16* KETc = KET; LAS bf16* VTc = VT;
        const f32x2 gl = *(const LAS f32x2*)(GT + 2 * (c * 64 + lane)); float bsc = gl.y; const float li = gl.x;
#pragma unroll
        for (int o = 1; o < 64; o <<= 1) { const float v = shl_(bsc, (lane - o) & 63); if (lane >= o) bsc += v; }
        const float bl = shl_(bsc, 63); const float csv = li - bsc;
        if (w == 0) { CB[lane] = bsc; CB[64 + lane] = csv; }
        bsum += bl;
        const int tt_ = w & 3, eh = w >> 2; const int tq = 16 * tt_ + c16;
        unsigned ogv[4];
        if (L3) {
#pragma unroll
            for (int x = 0; x < 4; ++x) ogv[x] = *(const unsigned*)((const unsigned char*)(proj + (size_t)(tok0 + tq) * NPROJ) + 512 * (9 + (hh >> 1)) + (hh & 1) * 128 + 16 * (4 * eh + x) + 4 * quad); }
        { float fac[4];
#pragma unroll
          for (int i = 0; i < 4; ++i) fac[i] = __expf(bl + shl_(csv, t0 + i));
#pragma unroll
          for (int j = 0; j < 3; ++j) { const bool ok = tok0 + t0 - 3 + j >= b * SEQ;
              if (L3) rq[j] = ok ? rq[j] : 0u; else rk[j] = ok ? rk[j] : 0u; }
#pragma unroll
          for (int qk = (L3 ? 0 : 1); qk < 2; ++qk) {
              float o[4][4];
              if (L3 && qk) {
#pragma unroll
                  for (int i = 0; i < 4; ++i) { const f32x4 kf4 = fp8x4(kcv[i]) * (1.0f / 256.0f); o[i][0] = kf4[0]; o[i][1] = kf4[1]; o[i][2] = kf4[2]; o[i][3] = kf4[3]; }
              } else {
              const f32x4 bias = *(const LAS f32x4*)(CW + 4 * 256 + qk * 128 + c0);
#pragma unroll
              for (int i = 0; i < 4; ++i) { o[i][0] = bias.x; o[i][1] = bias.y; o[i][2] = bias.z; o[i][3] = bias.w; }
#pragma unroll
              for (int j = 0; j < 4; ++j) { const f32x4 wj = *(const LAS f32x4*)(CW + j * 256 + qk * 128 + c0);
#pragma unroll
                  for (int i = 0; i < 4; ++i) { const int rr = (int)(qk ? rk[i + j] : rq[i + j]);
                      o[i][0] += wj.x * __builtin_amdgcn_cvt_f32_fp8(rr, 0); o[i][1] += wj.y * __builtin_amdgcn_cvt_f32_fp8(rr, 1); o[i][2] += wj.z * __builtin_amdgcn_cvt_f32_fp8(rr, 2); o[i][3] += wj.w * __builtin_amdgcn_cvt_f32_fp8(rr, 3); } }
#pragma unroll
              for (int i = 0; i < 4; ++i)
#pragma unroll
                  for (int ch = 0; ch < 4; ++ch) { const float z = o[i][ch]; o[i][ch] = z * __builtin_amdgcn_rcpf(1.0f + __expf(-z)) * (qk ? 0.08838834764831845f : 1.0f); }
              }
              if (!L3 && qk) {
#pragma unroll
                  for (int i = 0; i < 4; ++i) { const unsigned pw = pk4_fp8(o[i][0] * 256.0f, o[i][1] * 256.0f, o[i][2] * 256.0f, o[i][3] * 256.0f); *(unsigned*)(kcb + (size_t)(tok0 + t0 + i) * 512 + hh * 128 + c0) = pw;
                      const f32x4 kf4 = fp8x4(pw) * (1.0f / 256.0f); o[i][0] = kf4[0]; o[i][1] = kf4[1]; o[i][2] = kf4[2]; o[i][3] = kf4[3]; } }
              if (L3) { LAS bf16* dst = (qk ? Ks : Qs) + t0 * 136 + c0;
#pragma unroll
                  for (int i = 0; i < 4; ++i) { v2u pw; pw.x = pk2(o[i][0], o[i][1]); pw.y = pk2(o[i][2], o[i][3]); *(LAS v2u*)(dst + i * 136) = pw; } }
              if (qk) {
#pragma unroll
                  for (int ch = 0; ch < 4; ++ch) { v2u pw; pw.x = pk2(o[0][ch] * fac[0], o[1][ch] * fac[1]); pw.y = pk2(o[2][ch] * fac[2], o[3][ch] * fac[3]); *(LAS v2u*)(KETc + (c0 + ch) * 72 + t0) = pw; } }
          }
          { v2u p0, p1, p2, p3;
            float vf[4][4];
#pragma unroll
            for (int i = 0; i < 4; ++i) { const int rr = (int)rv[i]; vf[i][0] = __builtin_amdgcn_cvt_f32_fp8(rr, 0); vf[i][1] = __builtin_amdgcn_cvt_f32_fp8(rr, 1); vf[i][2] = __builtin_amdgcn_cvt_f32_fp8(rr, 2); vf[i][3] = __builtin_amdgcn_cvt_f32_fp8(rr, 3); }
            p0.x = pk2(vf[0][0], vf[1][0]); p0.y = pk2(vf[2][0], vf[3][0]);
            p1.x = pk2(vf[0][1], vf[1][1]); p1.y = pk2(vf[2][1], vf[3][1]);
            p2.x = pk2(vf[0][2], vf[1][2]); p2.y = pk2(vf[2][2], vf[3][2]);
            p3.x = pk2(vf[0][3], vf[1][3]); p3.y = pk2(vf[2][3], vf[3][3]);
            *(LAS v2u*)(VTc + (c0 + 0) * 72 + t0) = p0; *(LAS v2u*)(VTc + (c0 + 1) * 72 + t0) = p1; *(LAS v2u*)(VTc + (c0 + 2) * 72 + t0) = p2; *(LAS v2u*)(VTc + (c0 + 3) * 72 + t0) = p3; }
        }
        ML_LBAR();
        if (c < 7) { ML_LOADRAW(tok0 + 64); }
        float hval[4][4];
        if (L3) {
            bf16x8 qf[4];
#pragma unroll
            for (int ks = 0; ks < 4; ++ks) qf[ks] = *(const LAS bf16x8*)(Qs + tq * 136 + 32 * ks + 8 * quad);
            f32x4 sacc[4];
#pragma unroll
            for (int st = 0; st < 4; ++st) { f32x4 z = {0.f, 0.f, 0.f, 0.f};
#pragma unroll
                for (int ks = 0; ks < 4; ++ks) z = __builtin_amdgcn_mfma_f32_16x16x32_bf16(*(const LAS bf16x8*)(Ks + (16 * st + c16) * 136 + 32 * ks + 8 * quad), qf[ks], z, 0, 0, 0);
                sacc[st] = z; }
            const float cbt = CB[tq];
            f32x4 csq[4];
#pragma unroll
            for (int st = 0; st < 4; ++st) csq[st] = *(const LAS f32x4*)(CB + 64 + 16 * st + 4 * quad);
#pragma unroll
            for (int st = 0; st < 4; ++st)
#pragma unroll
                for (int j = 0; j < 4; ++j) { const int s = 16 * st + 4 * quad + j; const float d = (s <= tq) ? __expf(cbt + csq[st][j]) : 0.f; sacc[st][j] *= d; }
            bf16x8 pf[2];
#pragma unroll
            for (int kk = 0; kk < 2; ++kk) { v4u pw; pw.x = pk2m(sacc[2 * kk][0], sacc[2 * kk][1]); pw.y = pk2m(sacc[2 * kk][2], sacc[2 * kk][3]); pw.z = pk2m(sacc[2 * kk + 1][0], sacc[2 * kk + 1][1]); pw.w = pk2m(sacc[2 * kk + 1][2], sacc[2 * kk + 1][3]); pf[kk] = __builtin_bit_cast(bf16x8, pw); }
            const float ebt = __expf(cbt);
            f32x4 nn[5];
#pragma unroll
            for (int x = 0; x < 5; ++x) { const int et = (x < 4) ? (4 * eh + x) : 8; f32x4 na = {0.f, 0.f, 0.f, 0.f}, ia = {0.f, 0.f, 0.f, 0.f};
#pragma unroll
                for (int kk = 0; kk < 2; ++kk) { const LAS bf16* vr = VT + (16 * et + c16) * 72 + 32 * kk + 4 * quad; const v2u lo = *(const LAS v2u*)vr, hi = *(const LAS v2u*)(vr + 16); v4u vw; vw.x = lo.x; vw.y = lo.y; vw.z = hi.x; vw.w = hi.y;
                    na = __builtin_amdgcn_mfma_f32_16x16x32_bf16(__builtin_bit_cast(bf16x8, vw), pf[kk], na, 0, 0, 0); }
#pragma unroll
                for (int ks = 0; ks < 4; ++ks) ia = __builtin_amdgcn_mfma_f32_16x16x32_bf16(*(const LAS bf16x8*)(CT + (16 * et + c16) * 136 + 32 * ks + 8 * quad), qf[ks], ia, 0, 0, 0);
                nn[x] = na + ia * ebt; }
            const float den = shl_(nn[4][0], c16); const float inv = __builtin_amdgcn_rcpf(fmaxf(fabsf(den), 1.0f)) * (1.0f / 16.0f);
            float ss = 0.f;
#pragma unroll
            for (int x = 0; x < 4; ++x)
#pragma unroll
                for (int j = 0; j < 4; ++j) { hval[x][j] = nn[x][j] * inv; ss += hval[x][j] * hval[x][j]; }
            ss += shx(ss, 16, lane); ss += shx(ss, 32, lane);
            if (quad == 0) RED[eh * 64 + tq] = ss;
        }
        { const float ebl = __expf(bl);
          bf16x8 kf[2];
#pragma unroll
          for (int kk = 0; kk < 2; ++kk) kf[kk] = *(const LAS bf16x8*)(KETc + (16 * w + c16) * 72 + 32 * kk + 8 * quad);
#pragma unroll
          for (int et = 0; et < 9; ++et) { f32x4 z = cacc[et] * ebl;
#pragma unroll
              for (int kk = 0; kk < 2; ++kk) z = __builtin_amdgcn_mfma_f32_16x16x32_bf16(kf[kk], *(const LAS bf16x8*)(VTc + (16 * et + c16) * 72 + 32 * kk + 8 * quad), z, 0, 0, 0);
              cacc[et] = z; } }
        if (L3) {
            ML_LBAR();
            const float rstd = __builtin_amdgcn_rsqf((RED[tq] + RED[64 + tq]) * (1.0f / 128.0f) + EPS);
#pragma unroll
            for (int x = 0; x < 4; ++x) { const int e = 16 * (4 * eh + x) + 4 * quad; const f32x4 og = u8x4_to_f32(ogv[x]) * (1.0f / 255.0f);
                const float y0 = hval[x][0] * rstd * NW[e] * og[0], y1 = hval[x][1] * rstd * NW[e + 1] * og[1], y2 = hval[x][2] * rstd * NW[e + 2] * og[2], y3 = hval[x][3] * rstd * NW[e + 3] * og[3];
                *(unsigned*)(hm + (size_t)(tok0 + tq) * 512 + hh * 128 + e) = pk4_fp8(y0 * 8.0f, y1 * 8.0f, y2 * 8.0f, y3 * 8.0f); }
#pragma unroll
            for (int et = 0; et < 9; ++et) { const f32x4 z = cacc[et]; v2u pw; pw.x = pk2(z[0], z[1]); pw.y = pk2(z[2], z[3]); *(LAS v2u*)(CT + (16 * et + c16) * 136 + 16 * w + 4 * quad) = pw; }
        }
        else ML_LBAR();
    }
#undef ML_LOADRAW
#undef ML_LBAR
    if (!L3) {
#pragma unroll
        for (int et = 0; et < 9; ++et)
            *(f32x4*)(mlc + (16 * et + c16) * 128 + 16 * w + 4 * quad) = cacc[et];
        if (X.tid == 0) mlb[unit] = bsum;
    }
}
DI void mlstm_scan(const Args& a, const Ctx& X) {
    float* mlc = (float*)(a.ws + WS_MLC); const float* mlb = (const float*)(a.ws + WS_MLB);
    for (int idx = X.bid * 512 + X.tid; idx < 8 * 9216; idx += X.G * 512) { const int seq = idx / 9216, el = 2 * (idx - seq * 9216); float cz = 0.f; asm volatile("" : "+v"(cz)); f32x2 carry = {cz, cz};
        float* p0 = mlc + (size_t)seq * 32 * 18432 + el; f32x2 v[32]; float dcy[32];
#pragma unroll
        for (int j = 0; j < 32; ++j) { v[j] = *(const f32x2*)(p0 + (size_t)j * 18432); dcy[j] = mlb[seq * 32 + j]; }
#pragma unroll
        for (int j = 0; j < 32; ++j) { *(f32x2*)(p0 + (size_t)j * 18432) = carry; carry = carry * __expf(dcy[j]) + v[j]; } }
}

constexpr int P6_WR = 0, P6_AT = 33024, P6_SH = 37120, P6_LG = 41216, P6_HIST = 65536;
DI void p6_norm_route(const Args& a, const Ctx& X, int l, const bf16* xin) {
    unsigned char* ws = a.ws;
    LAS bf16* wrb = (LAS bf16*)(X.lds + P6_WR);
    LAS float* at = (LAS float*)(X.lds + P6_AT); LAS float* sht = (LAS float*)(X.lds + P6_SH);
    LAS float* lg = (LAS float*)(X.lds + P6_LG) + X.wave * 272;
    { f32x4 rw[8];
#pragma unroll
      for (int i = 0; i < 8; ++i) rw[i] = *(const f32x4*)(a.router_w + 4 * (X.tid + 512 * i));
#pragma unroll
      for (int i = 0; i < 8; ++i) { const int i4 = X.tid + 512 * i; const int k = i4 >> 2, e0 = (i4 & 3) * 4;
          wrb[(e0 + 0) * 1032 + k] = (bf16)f2bf(rw[i].x); wrb[(e0 + 1) * 1032 + k] = (bf16)f2bf(rw[i].y); wrb[(e0 + 2) * 1032 + k] = (bf16)f2bf(rw[i].z); wrb[(e0 + 3) * 1032 + k] = (bf16)f2bf(rw[i].w); } }
    const float* mod = (const float*)(ws + WS_MOD); unsigned char* hb = (unsigned char*)(ws + WS_H); float* tgate = (float*)(ws + WS_TGATE); int* tokl = (int*)(ws + WS_TOKL);
    const float* ssq = (const float*)(ws + WS_SSQ);
    unsigned* cnt = (unsigned*)(ws + WS_CTL) + CW_CNT + l * 2048;
    LAS int* hist = (LAS int*)(X.lds + P6_HIST); LAS int* cbase = hist + 32;
    int lane = X.lane; asm volatile("" : "+v"(lane));
    const int r = lane & 15, q = lane >> 4;
    const int gw = X.bid * 8 + X.wave, NGW = X.G * 8;
    for (int it = 0; it * NGW < T / 16; ++it) {
        const int rg = it * NGW + gw; const bool act = rg < T / 16;
        const int row0 = (act ? rg : 0) * 16; const int bb = ((it * NGW + X.bid * 8) * 16) >> 14;
        __syncthreads();
        if (X.tid < 32) hist[X.tid] = 0;
        { const float* mb = mod + (size_t)(l * 2 + (bb < 2 ? bb : 1)) * 6144;
          const float n0 = a.nfw[l * D + X.tid], n1 = a.nfw[l * D + 512 + X.tid], c0 = mb[4 * 1024 + X.tid], c1 = mb[4 * 1024 + 512 + X.tid], s0 = mb[3 * 1024 + X.tid], s1 = mb[3 * 1024 + 512 + X.tid];
          at[X.tid] = n0 * (1.0f + c0); at[512 + X.tid] = n1 * (1.0f + c1); sht[X.tid] = s0; sht[512 + X.tid] = s1; }
        __syncthreads();
        const int row = row0 + r;
        float rstd;
        { const f32x4 pp = *(const f32x4*)(ssq + (size_t)row * 16 + 4 * q); float ss = (pp.x + pp.y) + (pp.z + pp.w); ss += shx(ss, 16, lane); ss += shx(ss, 32, lane); rstd = __builtin_amdgcn_rsqf(ss * (1.0f / D) + EPS); }
        const bf16* xr = xin + (size_t)row * D + 8 * q; unsigned char* hr = hb + (size_t)row * D + 8 * q;
        f32x4 acc = {0.f, 0.f, 0.f, 0.f};
#pragma unroll 1
        for (int sb = 0; sb < 32; sb += 8) {
            v4u xb8[8];
#pragma unroll
            for (int i = 0; i < 8; ++i) xb8[i] = *(const v4u*)(xr + 32 * (sb + i));
            asm volatile("" ::: "memory");
#pragma unroll
            for (int i = 0; i < 8; ++i) { const int s = sb + i; const v4u xw = xb8[i];
                const f32x4 x0 = {bflo(xw.x), bfhi(xw.x), bflo(xw.y), bfhi(xw.y)}, x1 = {bflo(xw.z), bfhi(xw.z), bflo(xw.w), bfhi(xw.w)};
                const f32x4 a0 = *(const LAS f32x4*)(at + 32 * s + 8 * q), a1 = *(const LAS f32x4*)(at + 32 * s + 8 * q + 4);
                const f32x4 s0 = *(const LAS f32x4*)(sht + 32 * s + 8 * q), s1 = *(const LAS f32x4*)(sht + 32 * s + 8 * q + 4);
                const f32x4 h0 = x0 * rstd * a0 + s0, h1 = x1 * rstd * a1 + s1;
                v4u w; w.x = pk2m(h0.x, h0.y); w.y = pk2m(h0.z, h0.w); w.z = pk2m(h1.x, h1.y); w.w = pk2m(h1.z, h1.w);
                { v2u w8; w8.x = pk4_fp8(h0.x, h0.y, h0.z, h0.w); w8.y = pk4_fp8(h1.x, h1.y, h1.z, h1.w); *(v2u*)(hr + 32 * s) = w8; }
                const bf16x8 bfr = *(const LAS bf16x8*)(wrb + r * 1032 + 32 * s + 8 * q);
                acc = __builtin_amdgcn_mfma_f32_16x16x32_bf16(__builtin_bit_cast(bf16x8, w), bfr, acc, 0, 0, 0); }
        }
#pragma unroll
        for (int j = 0; j < 4; ++j) lg[(4 * q + j) * 17 + r] = acc[j];
        LDS_WAIT(); asm volatile("" ::: "memory");
        int my_cls = 0; float my_ga = 0.f, my_gb = 0.f;
        if (lane < 16) {
            float sc[16], sel[16];
#pragma unroll
            for (int e = 0; e < 16; ++e) { const float p = lg[lane * 17 + e]; sc[e] = 1.0f / (1.0f + __expf(-p)); sel[e] = sc[e] + a.router_b[e]; }
            int gi = 0; float gbest = -1.0e30f;
#pragma unroll
            for (int g = 0; g < 4; ++g) { const float p0 = sel[4 * g], p1 = sel[4 * g + 1], p2 = sel[4 * g + 2], p3 = sel[4 * g + 3];
                const float gs = fmaxf(fmaxf(fmaxf(p0 + p1, p0 + p2), fmaxf(p0 + p3, p1 + p2)), fmaxf(p1 + p3, p2 + p3));
                if (gs > gbest) { gbest = gs; gi = g; } }
            float qs[4], s4[4];
#pragma unroll
            for (int i = 0; i < 4; ++i) { qs[i] = 0.f; s4[i] = 0.f; }
#pragma unroll
            for (int g = 0; g < 4; ++g) if (g == gi) {
#pragma unroll
                for (int i = 0; i < 4; ++i) { qs[i] = sel[4 * g + i]; s4[i] = sc[4 * g + i]; } }
            int i1 = 0; float b1 = qs[0];
#pragma unroll
            for (int i = 1; i < 4; ++i) if (qs[i] > b1) { b1 = qs[i]; i1 = i; }
            int i2 = -1; float b2 = -1.0e30f;
#pragma unroll
            for (int i = 0; i < 4; ++i) if (i != i1 && qs[i] > b2) { b2 = qs[i]; i2 = i; }
            const int ia = (i1 < i2) ? i1 : i2, ib = (i1 < i2) ? i2 : i1;
            float sa = 0.f, sb = 0.f;
#pragma unroll
            for (int i = 0; i < 4; ++i) { if (i == ia) sa = s4[i]; if (i == ib) sb = s4[i]; }
            const int pidx = (ia == 0) ? (ib - 1) : ((ia == 1) ? (ib + 1) : 5);
            const float inv = 1.0f / (sa + sb);
            my_cls = gi * 6 + pidx; my_ga = sa * inv; my_gb = sb * inv;
        }
        int rank = 0;
        if (act && lane < 16) rank = __hip_atomic_fetch_add(hist + my_cls, 1, __ATOMIC_RELAXED, __HIP_MEMORY_SCOPE_WORKGROUP);
        __syncthreads();
        if (X.tid < NCLS) { const int n = hist[X.tid]; cbase[X.tid] = n ? (int)__hip_atomic_fetch_add(cnt + 64 * X.tid, (unsigned)n, RLX_AGENT) : 0; }
        __syncthreads();
        if (act && lane < 16) { const int tok = row0 + lane; const int pos = cbase[my_cls] + rank;
            tokl[my_cls * CLS_CAP + pos] = tok; tgate[tok * 2] = my_ga; tgate[tok * 2 + 1] = my_gb; }
    }
}
DI MoeTab moe_tables(const Args& a, const Ctx& X, int l) {
    LAS int* tab = (LAS int*)(X.lds + TAB_OFF); LAS int* tcls = tab; LAS int* tpos = tab + 160; LAS int* cn = tab + 320; LAS int* rt_ = tab + 344;
    unsigned* cnt = (unsigned*)(a.ws + WS_CTL) + CW_CNT + l * 2048;
    if (X.tid < NCLS) cn[X.tid] = (int)__hip_atomic_load(cnt + 64 * X.tid, RLX_AGENT);
    __syncthreads();
    if (X.tid < NCLS) {
        int base = 0;
#pragma unroll 1
        for (int c = 0; c < X.tid; ++c) base += (cn[c] + 255) >> 8;
        const int n = (cn[X.tid] + 255) >> 8;
#pragma unroll 1
        for (int i = 0; i < n; ++i) { tcls[base + i] = X.tid; tpos[base + i] = i * 256; }
        if (X.tid == NCLS - 1) rt_[0] = base + n; }
    __syncthreads();
    MoeTab tb; tb.tcls = tcls; tb.tpos = tpos; tb.cnt = cn; tb.Rtot = __builtin_amdgcn_readfirstlane(rt_[0]); return tb;
}

#if defined(__HIP_DEVICE_COMPILE__)
DI Args load_args() { auto p = __builtin_amdgcn_kernarg_segment_ptr(); asm volatile("" : "+s"(p)); return *(const __attribute__((address_space(4))) Args*)p; }
#else
DI Args load_args() { return Args{}; }
#endif
__global__ void __launch_bounds__(512, 2) fwd(Args a_unused) {
    extern __shared__ __attribute__((aligned(16))) unsigned char lds_raw[];
    Ctx X; X.lds = (LAS unsigned char*)lds_raw; X.tid = threadIdx.x; X.lane = X.tid & 63; X.wave = __builtin_amdgcn_readfirstlane(X.tid >> 6); X.G = gridDim.x; X.bid = blockIdx.x;
    volatile LAS unsigned* MISC = (volatile LAS unsigned*)(X.lds + MISC_OFF);
    if (X.tid < 64) MISC[X.tid] = 0u;
    __syncthreads();
    int lo, hi; unsigned* ctl;
    { const Args a = load_args(); lo = a.ph_lo; hi = a.ph_hi; ctl = (unsigned*)(a.ws + WS_CTL); }
    XcdBarrier bar; bar.bar = ctl + CW_BAR; bar.x = 0; bar.st = MISC + 8;
    if (hi - lo > 1) bar = xcd_barrier_post(ctl + CW_BAR, MISC + 8);
#ifndef PH_MASK
#define PH_MASK 0xFFFFF
#endif
#define PON(p) ((PH_MASK >> (p)) & 1)
#ifndef DUP_MASK
#define DUP_MASK 0
#endif
#define NREP(p) (((DUP_MASK >> (p)) & 1) ? 2 : 1)
#ifndef NULEPI
#define NULEPI 0
#endif
#ifndef TSEL_MASK
#define TSEL_MASK 0
#endif
#define TSCALE 4
#define TSEL(p) ((TSEL_MASK >> (p)) & 1)
#define IN(k) (lo <= (k) && (k) < hi)
#define SEAM(k) do { if (IN(k) && IN((k) + 1)) xcd_barrier(bar); } while (0)
    unsigned long long tacc = 0ull, tph = 0ull;
#define TBEG() do { if (TSEL_MASK) tph = __builtin_amdgcn_s_memrealtime(); } while (0)
#define TEND(p) do { if (TSEL(p)) tacc += __builtin_amdgcn_s_memrealtime() - tph; } while (0)
    TBEG();
    if (PON(10) && IN(0)) { for (int rep = 0; rep < NREP(10); ++rep) { const Args a = load_args(); p0_prologue(a, X); } }
    SEAM(0); TEND(10);
    TBEG();
    for (int l = 0; l < NL; ++l) {
        const int g0 = 1 + l * NPH;
        if (PON(0) && IN(g0 + 0)) { for (int rep = 0; rep < NREP(0); ++rep) { const Args a = load_args(); unsigned char* ws = a.ws; const float* mod = (const float*)(ws + WS_MOD); bf16* proj = (bf16*)(ws + WS_PROJ); bf16* xb = (bf16*)(ws + WS_XB); (void)mod; (void)proj; (void)xb; const Ctx P = fresh(X); p1_norm_gates(a, P, l, xb); } }
        SEAM(g0 + 0); TEND(0); TBEG();
        if (PON(1) && IN(g0 + 1)) for (int rep = 0; rep < NREP(1); ++rep) { const Args a = load_args(); unsigned char* ws = a.ws; const float* mod = (const float*)(ws + WS_MOD); bf16* proj = (bf16*)(ws + WS_PROJ); bf16* xb = (bf16*)(ws + WS_XB); (void)mod; (void)proj; (void)xb; const Ctx P = fresh(X);
            DenseSched S; S.A = (const char*)(ws + WS_H); S.Bt = (const char*)(ws + WS_WIN) + (size_t)l * NPROJW * D; S.lda = D; S.ldb = D; S.ord.init(T / 256, NPROJW / 256, P.G, P.bid, 2);
            EpiProj E; E.O = proj; E.gates = (float*)(ws + WS_GATES); E.big = a.b_ig + l * 4; E.bfg = a.b_fg + l * 4; E.nul = (rep == 0 && NREP(1) == 2 && (NULEPI == 1 || NULEPI == 3)) ? NULEPI : 0; E.rwrap = (rep == 0 && NREP(1) == 2 && NULEPI == 2) ? 255 : 0x7fffffff;
#ifndef STAGGER_TICKS
#define STAGGER_TICKS 0
#endif
            if (STAGGER_TICKS && ((P.bid >> 3) & 1)) { const unsigned long long t0 = __builtin_amdgcn_s_memrealtime(); while (__builtin_amdgcn_s_memrealtime() - t0 < STAGGER_TICKS) __builtin_amdgcn_s_sleep(4); }
            pg8::gemm_phase<EpiProj, DenseSched, true>(P.lds, D, S, E);
        }
        SEAM(g0 + 1); TEND(1); TBEG();
        if (PON(2) && IN(g0 + 2)) { const Args a = load_args(); unsigned char* ws = a.ws; const float* mod = (const float*)(ws + WS_MOD); bf16* proj = (bf16*)(ws + WS_PROJ); bf16* xb = (bf16*)(ws + WS_XB); (void)mod; (void)proj; (void)xb; const Ctx P = fresh(X);
            if (PON(11)) for (int rep = 0; rep < NREP(11); ++rep) {
#pragma unroll 1
                for (int u = P.bid; u < 512; u += P.G) attn_unit(a, P, l, u); }
            if (PON(12)) for (int rep = 0; rep < NREP(12); ++rep) {
#pragma unroll 1
                for (int u = P.bid; u < 256; u += P.G) mlstm_unit<false>(a, P, l, u); }
        }
        SEAM(g0 + 2); TEND(2); TBEG();
        if (PON(3) && IN(g0 + 3)) { const Args a = load_args(); unsigned char* ws = a.ws; const float* mod = (const float*)(ws + WS_MOD); bf16* proj = (bf16*)(ws + WS_PROJ); bf16* xb = (bf16*)(ws + WS_XB); (void)mod; (void)proj; (void)xb; const Ctx P = fresh(X); mlstm_scan(a, P); }
        SEAM(g0 + 3); TEND(3); TBEG();
        if (PON(4) && IN(g0 + 4)) for (int rep = 0; rep < NREP(4); ++rep) { const Args a = load_args(); unsigned char* ws = a.ws; const float* mod = (const float*)(ws + WS_MOD); bf16* proj = (bf16*)(ws + WS_PROJ); bf16* xb = (bf16*)(ws + WS_XB); (void)mod; (void)proj; (void)xb; const Ctx P = fresh(X);
#pragma unroll 1
            for (int u = P.bid; u < 256; u += P.G) mlstm_unit<true>(a, P, l, u); }
        SEAM(g0 + 4); TEND(4); TBEG();
        if (PON(5) && IN(g0 + 5)) for (int rep = 0; rep < NREP(5); ++rep) { const Args a = load_args(); unsigned char* ws = a.ws; const float* mod = (const float*)(ws + WS_MOD); bf16* proj = (bf16*)(ws + WS_PROJ); bf16* xb = (bf16*)(ws + WS_XB); (void)mod; (void)proj; (void)xb; const Ctx P = fresh(X);
            MergeSched S; S.A0 = (const char*)(ws + WS_H); S.A1 = (const char*)(ws + WS_H) + (size_t)T * 512; S.B0 = (const char*)(ws + WS_WAU) + (size_t)l * D * 512; S.B1 = (const char*)(ws + WS_WMU) + (size_t)l * D * 512;
            S.lda = 512; S.ldb = 512; S.ord.init(T / 256, D / 256, P.G, P.bid);
            EpiMerge E; E.P = proj; E.nul = (rep == 0 && NREP(5) == 2) ? NULEPI : 0; pg8::gemm_phase<EpiMerge, MergeSched, true>(P.lds, 1024, S, E);
        }
        SEAM(g0 + 5); TEND(5); TBEG();
        if (PON(6) && IN(g0 + 6)) for (int rep = 0; rep < NREP(6); ++rep) { const Args a = load_args(); unsigned char* ws = a.ws; const float* mod = (const float*)(ws + WS_MOD); bf16* proj = (bf16*)(ws + WS_PROJ); bf16* xb = (bf16*)(ws + WS_XB); (void)mod; (void)proj; (void)xb; const Ctx P = fresh(X);
            DenseSched S; S.A = (const char*)(proj + C_MQ); S.Bt = (const char*)(ws + WS_WOUT) + (size_t)l * D * D; S.lda = NPROJ * 2; S.ldb = D; S.ord.init(T / 256, D / 256, P.G, P.bid);
            EpiRes E; E.xin = xb; E.out = xb; E.g = mod + (size_t)(l * 2) * 6144 + 2 * 1024; E.ssq = (float*)(ws + WS_SSQ); E.rmask = T - 1; E.nul = 0;
            if (rep) { E.out = (bf16*)(ws + WS_H); E.rmask = T / 2 - 1; E.nul = NULEPI; }
            pg8::gemm_phase<EpiRes, DenseSched, true>(P.lds, D, S, E);
        }
        SEAM(g0 + 6); TEND(6); TBEG();
        if (PON(7) && IN(g0 + 7)) { const Args a = load_args(); unsigned char* ws = a.ws; const float* mod = (const float*)(ws + WS_MOD); bf16* proj = (bf16*)(ws + WS_PROJ); bf16* xb = (bf16*)(ws + WS_XB); (void)mod; (void)proj; (void)xb; const Ctx P = fresh(X); p6_norm_route(a, P, l, xb); }
        SEAM(g0 + 7); TEND(7); TBEG();
        if (PON(8) && IN(g0 + 8)) for (int rep = 0; rep < NREP(8); ++rep) { const Args a = load_args(); unsigned char* ws = a.ws; const float* mod = (const float*)(ws + WS_MOD); bf16* proj = (bf16*)(ws + WS_PROJ); bf16* xb = (bf16*)(ws + WS_XB); (void)mod; (void)proj; (void)xb; const Ctx P = fresh(X);
            const MoeTab tb = moe_tables(a, P, l);
            LAS unsigned* tokoff = (LAS unsigned*)(P.lds + TOKOFF_OFF); const int* tokl = (const int*)(ws + WS_TOKL);
#pragma unroll 1
            for (int s = 0; s < 8; ++s) { const int L0 = s * P.G + P.bid;
                if (L0 < tb.Rtot * 8 && P.tid < 256) { const int L = xcd_remap(L0, tb.Rtot * 8); const int rt = L >> 3, cls = tb.tcls[rt], pos = tb.tpos[rt] + P.tid, cn = tb.cnt[cls]; const int tok = tokl[cls * CLS_CAP + (pos < cn ? pos : 0)]; tokoff[s * 256 + P.tid] = (unsigned)tok; } }
            __syncthreads();
            MoeUpSched S; S.A = (const char*)(ws + WS_H); S.W = (const char*)(ws + WS_WGU) + (size_t)l * NE * 1024 * D; S.lda = D; S.ldb = D; S.tb = tb; S.G = P.G; S.c = P.bid; S.tokoff = tokoff;
            EpiSwiglu E; E.H = (unsigned char*)proj; E.tgate = (const float*)(ws + WS_TGATE); E.tokoff = tokoff;
            pg8::gemm_phase<EpiSwiglu, MoeUpSched, true>(P.lds, D, S, E);
        }
        SEAM(g0 + 8); TEND(8); TBEG();
        if (PON(9) && IN(g0 + 9)) for (int rep = 0; rep < NREP(9); ++rep) { const Args a = load_args(); unsigned char* ws = a.ws; const float* mod = (const float*)(ws + WS_MOD); bf16* proj = (bf16*)(ws + WS_PROJ); bf16* xb = (bf16*)(ws + WS_XB); (void)mod; (void)proj; (void)xb; const Ctx P = fresh(X);
            const MoeTab tb = moe_tables(a, P, l);
            MoeDownSched S; S.A = (const char*)proj; S.W = (const char*)(ws + WS_WD) + (size_t)l * NE * 1024 * FF; S.lda = D; S.ldb = FF; S.tb = tb; S.G = P.G; S.c = P.bid;
            EpiMoeOut E; E.xin = xb; E.outb = xb; E.outf = a.out; E.last = (l == NL - 1); E.g = mod + (size_t)(l * 2) * 6144 + 5 * 1024; E.tokl = (const int*)(ws + WS_TOKL); E.tb = tb; E.rmask = T - 1;
            if (rep) { E.outb = (bf16*)(ws + WS_H); E.last = 0; E.rmask = T / 2 - 1; }
            pg8::gemm_phase<EpiMoeOut, MoeDownSched, true>(P.lds, D, S, E);
        }
        SEAM(g0 + 9); TEND(9); TBEG();
    }
    if (TSEL_MASK && X.bid == 0) { const unsigned long long t1 = __builtin_amdgcn_s_memrealtime(); while (__builtin_amdgcn_s_memrealtime() - t1 < TSCALE * tacc) __builtin_amdgcn_s_sleep(8); }
#undef IN
#undef SEAM
}

extern "C" void kernel_launch(void* const* d_in, const int* in_sizes, int n_in, void* d_out, int out_size, void* d_ws, size_t ws_size, hipStream_t stream) {
    static int grid = 0;
    if (grid == 0) {
        if (n_in != 24 || in_sizes[0] != T * D || out_size != T * D || ws_size < WS_END) { fprintf(stderr, "kernel_launch: unexpected shapes / workspace (n_in %d, ws %zu, need %zu)\n", n_in, ws_size, (size_t)WS_END); grid = -1; return; }
        int dev = 0, cus = 0;
        if (hipGetDevice(&dev) != hipSuccess || hipDeviceGetAttribute(&cus, hipDeviceAttributeMultiprocessorCount, dev) != hipSuccess) { grid = -1; return; }
        if (hipFuncSetAttribute((const void*)fwd, hipFuncAttributeMaxDynamicSharedMemorySize, LDS_BYTES) != hipSuccess) { fprintf(stderr, "kernel_launch: hipFuncSetAttribute failed\n"); grid = -1; return; }
        int per_cu = 0;
        if (hipOccupancyMaxActiveBlocksPerMultiprocessor(&per_cu, (const void*)fwd, 512, LDS_BYTES) != hipSuccess || per_cu < 1) fprintf(stderr, "kernel_launch: occupancy query reports %d\n", per_cu);
        (void)hipGetLastError();
        grid = cus < 256 ? cus : 256;
    }
    if (grid < 0) return;
    (void)hipMemsetAsync((char*)d_ws + WS_CTL, 0, CTL_ZERO_BYTES, stream);
    Args a{};
    a.x = (const float*)d_in[0]; a.c = (const float*)d_in[1]; a.pos = (const int*)d_in[2]; a.ada_w = (const float*)d_in[3]; a.ada_b = (const float*)d_in[4];
    a.nmw = (const float*)d_in[5]; a.nfw = (const float*)d_in[6]; a.w_in = (const float*)d_in[7]; a.b_ig = (const float*)d_in[8]; a.b_fg = (const float*)d_in[9];
    a.qnw = (const float*)d_in[10]; a.knw = (const float*)d_in[11]; a.sinks = (const float*)d_in[12]; a.conv_w = (const float*)d_in[13]; a.conv_b = (const float*)d_in[14];
    a.mnw = (const float*)d_in[15]; a.w_au = (const float*)d_in[16]; a.w_mu = (const float*)d_in[17]; a.w_out = (const float*)d_in[18]; a.router_w = (const float*)d_in[19];
    a.router_b = (const float*)d_in[20]; a.w_gate = (const float*)d_in[21]; a.w_up = (const float*)d_in[22]; a.w_down = (const float*)d_in[23];
    a.out = (float*)d_out; a.ws = (unsigned char*)d_ws;
#if MK_MULTI
    for (int gp = 0; gp < NGP; ++gp) { a.ph_lo = gp; a.ph_hi = gp + 1; hipLaunchKernelGGL(fwd, dim3(grid), dim3(512), LDS_BYTES, stream, a); }
#else
    a.ph_lo = 0; a.ph_hi = NGP; hipLaunchKernelGGL(fwd, dim3(grid), dim3(512), LDS_BYTES, stream, a);
#endif
}
```

```cpp
#include <hip/hip_runtime.h>
#include <cstdio>
#include <cstdint>

#ifndef MK_MULTI
#define MK_MULTI 0
#endif

#define GAS __attribute__((address_space(1)))
#define LAS __attribute__((address_space(3)))
typedef unsigned short bf16;
typedef unsigned v4u __attribute__((ext_vector_type(4)));
typedef unsigned v2u __attribute__((ext_vector_type(2)));
typedef float f32x4 __attribute__((ext_vector_type(4)));
typedef float f32x2 __attribute__((ext_vector_type(2)));
typedef short bf16x8 __attribute__((ext_vector_type(8)));
typedef short bf16x4 __attribute__((ext_vector_type(4)));
#define DI __device__ __forceinline__
#define RLX_AGENT __ATOMIC_RELAXED, __HIP_MEMORY_SCOPE_AGENT
#define LDS_WAIT() asm volatile("s_waitcnt lgkmcnt(0)" ::: "memory")
#define VM_WAIT() asm volatile("s_waitcnt vmcnt(0)" ::: "memory")

constexpr int NB = 2, SEQ = 16384, T = NB * SEQ, D = 1024, NL = 4;
constexpr int DIN_SRC = 4872;
constexpr int NPROJ = 4864;
constexpr int C_AQ = 0, C_AK = 512, C_AV = 640, C_MQ = 768, C_MK = 1280, C_MV = 1792, C_MO = 2304, C_GA = 2816, C_GB = 3840;
constexpr int NE = 16, FF = 512;
constexpr int NCLS = 24, CLS_CAP = 32768;
constexpr float EPS = 1e-6f;
constexpr int NPH = 10;
constexpr int NGP = 1 + NL * NPH;

constexpr size_t MiB = 1u << 20;
constexpr size_t WS_CTL = 0, CTL_ZERO_BYTES = 128 * 1024;
constexpr size_t WS_MOD = 1 * MiB;
constexpr size_t WS_ROPE = 2 * MiB;
constexpr size_t WS_GATES = 4 * MiB;
constexpr size_t WS_TGATE = 5 * MiB;
constexpr size_t WS_TOKL = 6 * MiB;
constexpr size_t WS_MLB = 9 * MiB;
constexpr size_t WS_MLC = 10 * MiB;
constexpr int NPROJW = 5120;
constexpr size_t WS_WIN = 28 * MiB;
constexpr size_t WS_WAU = 68 * MiB;
constexpr size_t WS_WMU = 72 * MiB;
constexpr size_t WS_WOUT = 76 * MiB;
constexpr size_t WS_WGU = 84 * MiB;
constexpr size_t WS_WD = 148 * MiB;
constexpr size_t WS_H = 212 * MiB;
constexpr size_t WS_PROJ = 276 * MiB;
constexpr size_t WS_SSQ = 580 * MiB;
constexpr size_t WS_KC = 582 * MiB;
constexpr size_t WS_XB = 614 * MiB;
constexpr size_t WS_END = 678 * MiB;

constexpr int CW_TMO = 0;
constexpr int CW_BAR = 4096;
constexpr int CW_CNT = 8192;

constexpr int RING_BYTES = 131072;
constexpr int MISC_OFF = RING_BYTES;
constexpr int TAB_OFF = RING_BYTES + 256;
constexpr int TOKOFF_OFF = RING_BYTES + 2048;
constexpr int LDS_BYTES = 147456;

typedef __bf16 bf16x2_t __attribute__((ext_vector_type(2)));
DI unsigned cvt_pk_bf16(float lo, float hi) { const f32x2 v = {lo, hi}; return __builtin_bit_cast(unsigned, __builtin_convertvector(v, bf16x2_t)); }
DI unsigned pk2m(float lo, float hi) { return cvt_pk_bf16(lo, hi); }
DI unsigned f2bf(float f) { return cvt_pk_bf16(f, 0.f) & 0xffffu; }
DI unsigned pk2(float lo, float hi) { return cvt_pk_bf16(lo, hi); }
DI float bf2f(unsigned short b) { return __builtin_bit_cast(float, ((unsigned)b) << 16); }
DI float bflo(unsigned w) { return __builtin_bit_cast(float, w << 16); }
DI float bfhi(unsigned w) { return __builtin_bit_cast(float, w & 0xffff0000u); }
DI float shx(float v, int m, int lane) { return __builtin_bit_cast(float, __builtin_amdgcn_ds_bpermute((lane ^ m) << 2, __builtin_bit_cast(int, v))); }
DI float shl_(float v, int src) { return __builtin_bit_cast(float, __builtin_amdgcn_ds_bpermute(src << 2, __builtin_bit_cast(int, v))); }
DI float wave_sum(float v, int lane) {
#pragma unroll
    for (int o = 1; o < 64; o <<= 1) v += shx(v, o, lane);
    return v;
}
DI f32x4 fp8x4(unsigned w) { const int i = (int)w; return (f32x4){__builtin_amdgcn_cvt_f32_fp8(i, 0), __builtin_amdgcn_cvt_f32_fp8(i, 1), __builtin_amdgcn_cvt_f32_fp8(i, 2), __builtin_amdgcn_cvt_f32_fp8(i, 3)}; }
DI unsigned pk4_fp8(float a0, float a1, float a2, float a3) { int p = __builtin_amdgcn_cvt_pk_fp8_f32(a0, a1, 0, false); p = __builtin_amdgcn_cvt_pk_fp8_f32(a2, a3, p, true); return (unsigned)p; }
DI f32x4 u8x4_to_f32(unsigned w) { return (f32x4){(float)(w & 0xffu), (float)((w >> 8) & 0xffu), (float)((w >> 16) & 0xffu), (float)(w >> 24)}; }
DI unsigned f32_to_u8x4(float a0, float a1, float a2, float a3) { int p = __builtin_amdgcn_cvt_pk_u8_f32(a0, 0, 0); p = __builtin_amdgcn_cvt_pk_u8_f32(a1, 1, p); p = __builtin_amdgcn_cvt_pk_u8_f32(a2, 2, p); p = __builtin_amdgcn_cvt_pk_u8_f32(a3, 3, p); return (unsigned)p; }
DI float sigmoidf_(float x) { return __builtin_amdgcn_rcpf(1.0f + __expf(-x)); }

#define XB_TMO      128
#define XB_XCNT(j)  (256  + 64 * (j))
#define XB_XSUB(j)  (1280 + 64 * (j))
#define XB_XGEN(j)  (2304 + 64 * (j))
#define XB_TOP      3328
#define XB_TOPGEN   3392
#define XCD_BAR_WORDS 3456
#define XB_SPIN_CAP (1u << 18)
__device__ __forceinline__ unsigned xb_ld(unsigned* p)              { return __hip_atomic_load(p, __ATOMIC_RELAXED, __HIP_MEMORY_SCOPE_AGENT); }
__device__ __forceinline__ unsigned xb_add(unsigned* p, unsigned v) { return __hip_atomic_fetch_add(p, v, __ATOMIC_RELAXED, __HIP_MEMORY_SCOPE_AGENT); }
__device__ __forceinline__ unsigned xb_xcc_id() { return (unsigned)__builtin_amdgcn_s_getreg((3 << 11) | 20) & 0xFu; }
#define XB_SPIN(cond, bar) do { unsigned _sp = 0; while (cond) { __builtin_amdgcn_s_sleep(1); \
    if ((++_sp & 255u) == 0u) { if (xb_ld(&(bar)[XB_TMO])) break; if (_sp > XB_SPIN_CAP) { atomicAdd(&(bar)[XB_TMO], 1u); break; } } } } while (0)
struct XcdBarrier { unsigned* bar; unsigned x; volatile LAS unsigned* st; };
__device__ __forceinline__ XcdBarrier xcd_barrier_post(unsigned* bar, volatile LAS unsigned* st) {
    XcdBarrier b; b.bar = bar; b.x = xb_xcc_id(); b.st = st;
    if (threadIdx.x == 0) (void)xb_add(&bar[XB_XCNT(b.x)], 1u);
    return b;
}
__device__ __forceinline__ void xcd_barrier_complete(unsigned* bar, unsigned x, unsigned& nloc, unsigned& nx) {
    const unsigned G = gridDim.x * gridDim.y * gridDim.z;
    unsigned sum, cnt, mine, sp = 0u;
    for (;;) {
        sum = 0u; cnt = 0u; mine = 0u;
#pragma unroll
        for (unsigned j = 0; j < 16; ++j) { const unsigned c = xb_ld(&bar[XB_XCNT(j)]); sum += c; cnt += (c > 0u) ? 1u : 0u; mine = (j == x) ? c : mine; }
        if (sum == G) break;
        __builtin_amdgcn_s_sleep(1);
        if ((++sp & 255u) == 0u) { if (xb_ld(&bar[XB_TMO])) break; if (sp > XB_SPIN_CAP) { atomicAdd(&bar[XB_TMO], 1u); break; } }
    }
    nloc = mine > 0u ? mine : 1u; nx = cnt > 0u ? cnt : 1u;
}
__device__ __forceinline__ void xcd_barrier(const XcdBarrier& b) {
    asm volatile("s_waitcnt vmcnt(0)" ::: "memory");
    __syncthreads();
    if (threadIdx.x == 0) {
        unsigned* bar = b.bar; asm volatile("" : "+s"(bar));
        __builtin_amdgcn_s_waitcnt(0);
        unsigned nloc = b.st[0], nx = b.st[1];
        if (nloc == 0u) { xcd_barrier_complete(bar, b.x, nloc, nx); b.st[0] = nloc; b.st[1] = nx; }
        const unsigned old = xb_add(&bar[XB_XSUB(b.x)], 1u);
        const unsigned gen = old / nloc;
        if (old + 1u == (gen + 1u) * nloc) {
            __builtin_amdgcn_fence(__ATOMIC_RELEASE, "agent");
            asm volatile("s_waitcnt vmcnt(0)" ::: "memory");
            const unsigned og = xb_add(&bar[XB_TOP], 1u);
            const unsigned tg = og / nx;
            if (og + 1u == (tg + 1u) * nx) xb_add(&bar[XB_TOPGEN], 1u);
            else XB_SPIN(xb_ld(&bar[XB_TOPGEN]) == tg, bar);
            __builtin_amdgcn_fence(__ATOMIC_ACQUIRE, "agent");
            xb_add(&bar[XB_XGEN(b.x)], 1u);
            asm volatile("s_waitcnt vmcnt(0)" ::: "memory");
        } else {
            XB_SPIN(xb_ld(&bar[XB_XGEN(b.x)]) == gen, bar);
            __builtin_amdgcn_fence(__ATOMIC_ACQUIRE, "agent");
            asm volatile("s_waitcnt vmcnt(0)" ::: "memory");
        }
    }
    __syncthreads();
}

namespace pg8 {
constexpr int BM = 256, BK = 64, HALF = 128, HTB = HALF * BK * 2, STAGE_BYTES = 8 * HTB, NXCD = 8, WGM = 8;
__host__ __device__ __forceinline__ int lds_byte(int r, int c) { const int st = (r >> 4) * 2 + (c >> 5), rr = r & 15, cc = c & 31, ob = rr * 64 + cc * 2; return st * 1024 + (ob ^ (((ob >> 9) & 1) << 5)); }
__host__ __device__ __forceinline__ void stage_rc(int b, int& R, int& C) { const int st = b / 1024, sb = b % 1024, swz = sb ^ (((sb >> 9) & 1) << 5); R = (st >> 1) * 16 + swz / 64; C = (st & 1) * 32 + (swz % 64) / 2; }
__host__ __device__ __forceinline__ int perm32(int rho) { const int n = rho >> 4, i = rho & 15; return 8 * (i >> 2) + 4 * n + (i & 3); }

struct Unit { int pm, pn, x0, x1; };

struct TileOrder {
    int nM, nN, nwg, G, c, shift;
    __device__ void init(int nM_, int nN_, int G_, int c_, int shift_ = 0) { nM = nM_; nN = nN_; nwg = nM * nN; G = G_; c = c_; shift = shift_; }
    __device__ bool get(int i, int& pm, int& pn) const {
        const long L = (long)i * G + c; if (L >= nwg) return false;
        int wgid = (int)L; { const int q = nwg / NXCD, r = nwg % NXCD, xcd = wgid % NXCD, off = wgid / NXCD; wgid = (xcd < r ? xcd * (q + 1) : r * (q + 1) + (xcd - r) * q) + off; }
        const int nig = WGM * nN, gid = wgid / nig, fm = gid * WGM, gsz = (nM - fm) < WGM ? (nM - fm) : WGM;
        pm = fm + ((wgid % nig) % gsz); pn = (wgid % nig) / gsz; if (gid & 1) { pn += shift; if (pn >= nN) pn -= nN; } return true;
    }
};

typedef int v8i __attribute__((ext_vector_type(8)));
template <class Epi, class Sched, bool F8 = false>
__device__ __forceinline__ void gemm_phase(LAS unsigned char* lds, const int Kb, const Sched& S, const Epi& E) {
    int tid = threadIdx.x; asm volatile("" : "+v"(tid));
    const int wid = __builtin_amdgcn_readfirstlane(tid >> 6), lane = tid & 63, wr = wid >> 2, wc = wid & 3, fr = lane & 15, fq = lane >> 4;
    const int nt = Kb / 128;
    constexpr bool GA = Sched::GATHER; constexpr int KS = Sched::KSPLIT; constexpr bool ASPLIT = Sched::ASPLIT;
    unsigned voffA[2], voffB[2]; int Rst[2], Cst[2];
#pragma unroll
    for (int i = 0; i < 2; ++i) { int R, C; stage_rc(tid * 16 + i * 8192, R, C); const int Rb = Epi::PERM ? ((R & ~31) + perm32(R & 31)) : R;
        voffA[i] = (unsigned)(R * S.lda + C * 2); voffB[i] = (unsigned)(Rb * S.ldb + C * 2); Rst[i] = R; Cst[i] = C; }
    const size_t kstep = (size_t)(BK * 2);
    const size_t hstepA = (size_t)HALF * S.lda, hstepB = (size_t)HALF * S.ldb;
    const unsigned ldsw = (unsigned)wid * 1024u; const unsigned gmul = (unsigned)S.lda;
    const int aoff = F8 ? (lds_byte(wr * 64 + fr, (fq & 1) * 16) + (fq >> 1) * 1024) : lds_byte(wr * 64 + fr, fq * 8);
    const int boff = F8 ? (lds_byte(wc * 32 + fr, (fq & 1) * 16) + (fq >> 1) * 1024) : lds_byte(wc * 32 + fr, fq * 8);
    unsigned vAc[2], vAn[2];
#define PG8_SA(b, h) (((b) * 2 + (h)) * HTB)
#define PG8_SB(b, h) ((4 + (b) * 2 + (h)) * HTB)
#define PG8_STAGE2(bufoff, gbase, v0, v1) do { \
        __builtin_amdgcn_global_load_lds((const unsigned*)((const char*)(gbase) + (v0)), (LAS unsigned*)(lds + (bufoff) + ldsw), 16, 0, 0); \
        __builtin_amdgcn_global_load_lds((const unsigned*)((const char*)(gbase) + (v1)), (LAS unsigned*)(lds + (bufoff) + ldsw + 8192), 16, 0, 0); } while (0)
#define PG8_STAGE_B(bufoff, ptr, h) PG8_STAGE2(bufoff, (ptr) + (h) * hstepB, voffB[0], voffB[1])
#define PG8_STAGE_A(bufoff, ptr, h, nx) do { if constexpr (GA) { const unsigned _p = (nx) ? vAn[h] : vAc[h]; PG8_STAGE2(bufoff, ptr, (_p & 0xffffu) * gmul + (unsigned)Cst[0] * 2u, (_p >> 16) * gmul + (unsigned)Cst[0] * 2u); } \
        else { PG8_STAGE2(bufoff, (ptr) + (h) * hstepA, voffA[0], voffA[1]); } } while (0)
    typedef int v4i_ __attribute__((ext_vector_type(4)));
#define PG8_LDA(dst, b, h) do { _Pragma("unroll") for (int m = 0; m < 4; ++m) { if constexpr (F8) { dst##8[m].lo = *(const LAS v4i_*)(lds + PG8_SA(b, h) + aoff + m * 2048); dst##8[m].hi = *(const LAS v4i_*)(lds + PG8_SA(b, h) + aoff + m * 2048 + 16); } \
        else { _Pragma("unroll") for (int k = 0; k < 2; ++k) dst[m][k] = *(const LAS bf16x8*)(lds + PG8_SA(b, h) + aoff + m * 2048 + k * 1024); } } } while (0)
#define PG8_LDB(dst, b, h) do { _Pragma("unroll") for (int n = 0; n < 2; ++n) { if constexpr (F8) { dst##8[n].lo = *(const LAS v4i_*)(lds + PG8_SB(b, h) + boff + n * 2048); dst##8[n].hi = *(const LAS v4i_*)(lds + PG8_SB(b, h) + boff + n * 2048 + 16); } \
        else { _Pragma("unroll") for (int k = 0; k < 2; ++k) dst[n][k] = *(const LAS bf16x8*)(lds + PG8_SB(b, h) + boff + n * 2048 + k * 1024); } } } while (0)
#define PG8_MMA(ai, bj, At, Bt) do { __builtin_amdgcn_s_setprio(1); _Pragma("unroll") for (int m = 0; m < 4; ++m) _Pragma("unroll") for (int n = 0; n < 2; ++n) { \
        if constexpr (F8) { asm volatile("v_mfma_scale_f32_16x16x128_f8f6f4 %0, %1, %2, %0, %3, %3 op_sel_hi:[0,0,0]" : "+v"(acc[ai][bj][m][n]) : "v"(Bt##8[n]), "v"(At##8[m]), "v"(f8scale)); } \
        else { _Pragma("unroll") for (int k = 0; k < 2; ++k) acc[ai][bj][m][n] = __builtin_amdgcn_mfma_f32_16x16x32_bf16(Bt[n][k], At[m][k], acc[ai][bj][m][n], 0, 0, 0); } } \
        __builtin_amdgcn_s_setprio(0); } while (0)
#define PG8_WAIT_V(n) asm volatile("s_waitcnt vmcnt(" #n ")" ::: "memory")
#define PG8_WAIT_L(n) asm volatile("s_waitcnt lgkmcnt(" #n ")" ::: "memory")
#define PG8_BAR __builtin_amdgcn_s_barrier()
#define PG8_SCHED __builtin_amdgcn_sched_barrier(0)
#define PG8_GOFF(dst, u) do { if constexpr (GA) { _Pragma("unroll") for (int h = 0; h < 2; ++h) dst[h] = S.a_rowoff(u, Rst[0] + HALF * h) | (S.a_rowoff(u, Rst[0] + 64 + HALF * h) << 16); } } while (0)
    Unit cur, nxt; int ui = 0;
    if (!S.next(0, cur)) return;
    f32x4 acc[2][2][4][2];
#pragma unroll
    for (int a = 0; a < 2; ++a)
#pragma unroll
        for (int b = 0; b < 2; ++b)
#pragma unroll
            for (int m = 0; m < 4; ++m)
#pragma unroll
                for (int n = 0; n < 2; ++n) acc[a][b][m][n] = (f32x4){0.f, 0.f, 0.f, 0.f};
    int f8scale = 0x7F7F7F7F; asm volatile("" : "+v"(f8scale));
    bf16x8 At[4][2], B0[2][2], B1[2][2]; v8i At8[4], B08[2], B18[2];
    const char* cA = S.a_base(cur, 0); const char* cA1 = ASPLIT ? S.a_base(cur, 1) : cA; const char* cB0 = S.b_base(cur, 0); const char* cB1 = KS ? S.b_base(cur, 1) : cB0;
    PG8_GOFF(vAc, cur);
    vAn[0] = vAc[0]; vAn[1] = vAc[1];
    PG8_STAGE_B(PG8_SB(0, 0), cB0, 0); PG8_STAGE_B(PG8_SB(0, 1), cB0, 1); PG8_STAGE_A(PG8_SA(0, 0), cA, 0, false); PG8_STAGE_A(PG8_SA(0, 1), cA, 1, false);
    if (wr == 1) PG8_BAR;
    PG8_WAIT_V(2); PG8_BAR;
    PG8_STAGE_B(PG8_SB(1, 0), cB0 + kstep, 0); PG8_STAGE_A(PG8_SA(1, 0), cA + kstep, 0, false); PG8_STAGE_B(PG8_SB(1, 1), cB0 + kstep, 1);
    PG8_WAIT_V(6); PG8_BAR;
    for (;;) {
        const bool has_next = S.next(ui + 1, nxt);
        const char* nA = has_next ? S.a_base(nxt, 0) : cA; const char* nA1 = (ASPLIT && has_next) ? S.a_base(nxt, 1) : (ASPLIT ? cA1 : nA); const char* nB0 = has_next ? S.b_base(nxt, 0) : cB0; const char* nB1 = (KS && has_next) ? S.b_base(nxt, 1) : (KS ? cB1 : nB0);
        if constexpr (GA) { if (has_next) { PG8_GOFF(vAn, nxt); } }
#pragma unroll 1
        for (int t = 0; t < nt; t += 2) {
            const bool last = (t == nt - 2);
            const char* a1 = (ASPLIT && (t + 1) >= KS) ? cA1 + (size_t)(t + 1 - KS) * kstep : cA + (size_t)(t + 1) * kstep;
            const char* a2 = last ? nA : ((ASPLIT && (t + 2) >= KS) ? cA1 + (size_t)(t + 2 - KS) * kstep : cA + (size_t)(t + 2) * kstep);
            if constexpr (Epi::MID) { if (t == KS) { int fr_ = fr, fq_ = fq; asm volatile("" : "+v"(fr_), "+v"(fq_)); if constexpr (F8) { asm volatile("s_nop 15" ::: "memory"); } E.mid(acc, cur, wr, wc, fr_, fq_); if constexpr (F8) { asm volatile("s_nop 3" ::: "memory"); } } }
            const char* b2 = last ? nB0 : ((KS && (t + 2) >= KS) ? cB1 + (size_t)(t + 2 - KS) * kstep : cB0 + (size_t)(t + 2) * kstep);
            const char* a3 = a2 + kstep; const char* b3 = b2 + kstep;
            PG8_LDB(B0, 0, 0); PG8_LDB(B1, 0, 1); PG8_SCHED; PG8_LDA(At, 0, 0); PG8_STAGE_A(PG8_SA(1, 1), a1, 1, false);
            PG8_WAIT_V(8); PG8_WAIT_L(0); PG8_BAR; PG8_MMA(0, 0, At, B0); PG8_MMA(0, 1, At, B1); PG8_BAR; PG8_SCHED;
            PG8_LDA(At, 0, 1); PG8_STAGE_B(PG8_SB(0, 0), b2, 0); PG8_STAGE_B(PG8_SB(0, 1), b2, 1); PG8_STAGE_A(PG8_SA(0, 0), a2, 0, last);
            PG8_WAIT_V(8); PG8_WAIT_L(0); PG8_BAR; PG8_MMA(1, 0, At, B0); PG8_MMA(1, 1, At, B1); PG8_BAR; PG8_SCHED;
            PG8_LDB(B0, 1, 0); PG8_LDB(B1, 1, 1); PG8_SCHED; PG8_LDA(At, 1, 0); PG8_STAGE_A(PG8_SA(0, 1), a2, 1, last);
            PG8_WAIT_V(8); PG8_WAIT_L(0); PG8_BAR; PG8_MMA(0, 0, At, B0); PG8_MMA(0, 1, At, B1); PG8_BAR; PG8_SCHED;
            PG8_LDA(At, 1, 1); PG8_STAGE_B(PG8_SB(1, 0), b3, 0); PG8_STAGE_B(PG8_SB(1, 1), b3, 1); PG8_STAGE_A(PG8_SA(1, 0), a3, 0, last);
            PG8_WAIT_V(8); PG8_WAIT_L(0); PG8_BAR; PG8_MMA(1, 0, At, B0); PG8_MMA(1, 1, At, B1); PG8_BAR; PG8_SCHED;
        }
        if (wr == 0) PG8_BAR;
        if constexpr (F8) { asm volatile("s_nop 15\n\ts_nop 15" ::: "memory"); }
        { int fr_ = fr, fq_ = fq; asm volatile("" : "+v"(fr_), "+v"(fq_));
          E(acc, cur, wr, wc, fr_, fq_); }
        if (!has_next) break;
#pragma unroll
        for (int a = 0; a < 2; ++a)
#pragma unroll
            for (int b = 0; b < 2; ++b)
#pragma unroll
                for (int m = 0; m < 4; ++m)
#pragma unroll
                    for (int n = 0; n < 2; ++n) acc[a][b][m][n] = (f32x4){0.f, 0.f, 0.f, 0.f};
        cur = nxt; cA = nA; cA1 = nA1; cB0 = nB0; cB1 = nB1; ++ui;
        vAc[0] = vAn[0]; vAc[1] = vAn[1];
        if (wr == 1) PG8_BAR;
    }
    PG8_WAIT_V(0);
    PG8_BAR;
#undef PG8_SA
#undef PG8_SB
#undef PG8_STAGE2
#undef PG8_STAGE_A
#undef PG8_STAGE_B
#undef PG8_LDA
#undef PG8_LDB
#undef PG8_MMA
#undef PG8_WAIT_V
#undef PG8_WAIT_L
#undef PG8_BAR
#undef PG8_SCHED
#undef PG8_GOFF
}
}
using pg8::Unit;


struct Args {
    const float* x; const float* c; const int* pos; const float* ada_w; const float* ada_b; const float* nmw; const float* nfw; const float* w_in;
    const float* b_ig; const float* b_fg; const float* qnw; const float* knw; const float* sinks; const float* conv_w; const float* conv_b; const float* mnw;
    const float* w_au; const float* w_mu; const float* w_out; const float* router_w; const float* router_b; const float* w_gate; const float* w_up; const float* w_down;
    float* out; unsigned char* ws; int ph_lo, ph_hi;
};

__constant__ float c_invf[8] = {1.0f, 0.1939227432012558f, 0.03760603070259094f, 0.007292664609849453f, 0.0014142135623842478f, 0.00027424818836152554f, 5.3182957344688475e-05f, 1.0313385246263351e-05f};

struct DenseSched {
    static constexpr bool GATHER = false, ASPLIT = false; static constexpr int KSPLIT = 0;
    const char* A; const char* Bt; int lda, ldb; pg8::TileOrder ord;
    DI bool next(int i, Unit& u) const { int pm, pn; if (!ord.get(i, pm, pn)) return false; u.pm = pm; u.pn = pn; u.x0 = 0; u.x1 = 0; return true; }
    DI const char* a_base(const Unit& u, int) const { return A + (size_t)u.pm * 256 * lda; }
    DI const char* b_base(const Unit& u, int) const { return Bt + (size_t)u.pn * 256 * ldb; }
    DI unsigned a_rowoff(const Unit&, int) const { return 0u; }
};
struct EpiProj {
    static constexpr bool PERM = true, MID = false;
    bf16* O; float* gates; const float* big; const float* bfg; int nul, rwrap;
    DI void operator()(const f32x4 (&acc)[2][2][4][2], const Unit& u, int wr, int wc, int fr, int fq) const {
        const int row0 = u.pm * 256 + wr * 64 + fr, col0 = u.pn * 256 + wc * 32 + 8 * fq; const bool sg = u.pn >= 9; constexpr float WSC = 1.0f / 64.0f;
        if (nul == 1) { if (acc[0][0][0][0][0] == 12345.678f) O[0] = 0; return; }
        unsigned cks = 0u;
        if (u.pn == 19) {
            if (wc == 0 && fq == 0) {
#pragma unroll
                for (int ai = 0; ai < 2; ++ai)
#pragma unroll
                    for (int m = 0; m < 4; ++m) { const int row = row0 + ai * 128 + m * 16; const f32x4 vi = acc[ai][0][m][0], vf = acc[ai][0][m][1]; f32x4 oi, of;
#pragma unroll
                        for (int j = 0; j < 4; ++j) { oi[j] = vi[j] * WSC + big[j]; const float z = vf[j] * WSC + bfg[j]; of[j] = fminf(z, 0.f) - log1pf(__expf(-fabsf(z))); }
                        *(f32x4*)(gates + (size_t)row * 8) = oi; *(f32x4*)(gates + (size_t)row * 8 + 4) = of; } }
            return; }
#pragma unroll
        for (int ai = 0; ai < 2; ++ai)
#pragma unroll
            for (int m = 0; m < 4; ++m) { bf16* rowp = O + (size_t)((row0 + ai * 128 + m * 16) & rwrap) * NPROJ + col0;
#pragma unroll
                for (int bj = 0; bj < 2; ++bj) { f32x4 v0 = acc[ai][bj][m][0], v1 = acc[ai][bj][m][1];
                    if (sg) {
#pragma unroll
                        for (int j = 0; j < 4; ++j) {
                            v0[j] = __builtin_amdgcn_rcpf(__builtin_fmaf(__builtin_amdgcn_exp2f(v0[j] * (-1.4426950408889634f / 64.0f)), 1.0f / 255.0f, 1.0f / 255.0f));
                            v1[j] = __builtin_amdgcn_rcpf(__builtin_fmaf(__builtin_amdgcn_exp2f(v1[j] * (-1.4426950408889634f / 64.0f)), 1.0f / 255.0f, 1.0f / 255.0f)); }
                        if (u.pn >= 15) {
#pragma unroll
                            for (int j = 0; j < 4; ++j) { v0[j] = fmaxf(v0[j], 1.0f); v1[j] = fmaxf(v1[j], 1.0f); } }
                        v2u q; q.x = f32_to_u8x4(v0[0], v0[1], v0[2], v0[3]); q.y = f32_to_u8x4(v1[0], v1[1], v1[2], v1[3]);
                        *(v2u*)((unsigned char*)(O + (size_t)((row0 + ai * 128 + m * 16) & rwrap) * NPROJ) + 512 * u.pn + wc * 32 + 8 * fq + bj * 128) = q; continue; }
                    if (u.pn <= 8) {
                        v0 = v0 * (WSC * 16.0f); v1 = v1 * (WSC * 16.0f);
                        v2u q; q.x = pk4_fp8(v0[0], v0[1], v0[2], v0[3]); q.y = pk4_fp8(v1[0], v1[1], v1[2], v1[3]);
                        *(v2u*)((unsigned char*)(O + (size_t)((row0 + ai * 128 + m * 16) & rwrap) * NPROJ) + 512 * u.pn + wc * 32 + 8 * fq + bj * 128) = q; continue; }
                    v0 = v0 * WSC; v1 = v1 * WSC;
                    v4u w; w.x = cvt_pk_bf16(v0[0], v0[1]); w.y = cvt_pk_bf16(v0[2], v0[3]); w.z = cvt_pk_bf16(v1[0], v1[1]); w.w = cvt_pk_bf16(v1[2], v1[3]);
                    if (nul == 3) cks ^= (w.x ^ w.y) ^ (w.z ^ w.w); else *(v4u*)(rowp + bj * 128) = w; } }
        if (nul == 3) ((unsigned*)O)[(size_t)row0 * NPROJ / 2 + col0 / 2] = cks;
    }
};
struct MergeSched {
    static constexpr bool GATHER = false, ASPLIT = true; static constexpr int KSPLIT = 4;
    const char* A0; const char* A1; const char* B0; const char* B1; int lda, ldb; pg8::TileOrder ord;
    DI bool next(int i, Unit& u) const { int pm, pn; if (!ord.get(i, pm, pn)) return false; u.pm = pm; u.pn = pn; u.x0 = 0; u.x1 = 0; return true; }
    DI const char* a_base(const Unit& u, int half) const { return (half ? A1 : A0) + (size_t)u.pm * 256 * lda; }
    DI const char* b_base(const Unit& u, int half) const { return (half ? B1 : B0) + (size_t)u.pn * 256 * ldb; }
    DI unsigned a_rowoff(const Unit&, int) const { return 0u; }
};
struct EpiMerge {
    static constexpr bool PERM = true, MID = true;
    bf16* P; int nul;
    DI void mid(f32x4 (&acc)[2][2][4][2], const Unit& u, int wr, int wc, int fr, int fq) const {
        if (nul) return;
        const int row0 = u.pm * 256 + wr * 64 + fr, cb = wc * 32 + 8 * fq;
#pragma unroll
        for (int ai = 0; ai < 2; ++ai) {
            v2u ga[4][2], gb[4][2];
#pragma unroll
            for (int m = 0; m < 4; ++m)
#pragma unroll
                for (int bj = 0; bj < 2; ++bj) { const unsigned char* rowp = (const unsigned char*)(P + (size_t)(row0 + ai * 128 + m * 16) * NPROJ) + cb + bj * 128;
                    ga[m][bj] = *(const v2u*)(rowp + 512 * (11 + u.pn)); gb[m][bj] = *(const v2u*)(rowp + 512 * (15 + u.pn)); }
#pragma unroll
            for (int m = 0; m < 4; ++m)
#pragma unroll
                for (int bj = 0; bj < 2; ++bj) { const f32x4 a0 = u8x4_to_f32(ga[m][bj].x), a1 = u8x4_to_f32(ga[m][bj].y), b0 = u8x4_to_f32(gb[m][bj].x), b1 = u8x4_to_f32(gb[m][bj].y); f32x4 r0, r1;
#pragma unroll
                    for (int j = 0; j < 4; ++j) { r0[j] = a0[j] * __builtin_amdgcn_rcpf(b0[j]); r1[j] = a1[j] * __builtin_amdgcn_rcpf(b1[j]); }
                    acc[ai][bj][m][0] *= r0; acc[ai][bj][m][1] *= r1; }
        }
    }
    DI void operator()(const f32x4 (&acc)[2][2][4][2], const Unit& u, int wr, int wc, int fr, int fq) const {
        if (nul) { if (acc[0][0][0][0][0] == 12345.678f) P[0] = 0; return; }
        const int row0 = u.pm * 256 + wr * 64 + fr, col0 = u.pn * 256 + wc * 32 + 8 * fq, cb = wc * 32 + 8 * fq; constexpr float SC = 1.0f / (32.0f * 255.0f);
        v2u gw[2][4][2];
#pragma unroll
        for (int ai = 0; ai < 2; ++ai)
#pragma unroll
            for (int m = 0; m < 4; ++m)
#pragma unroll
                for (int bj = 0; bj < 2; ++bj) gw[ai][m][bj] = *(const v2u*)((const unsigned char*)(P + (size_t)(row0 + ai * 128 + m * 16) * NPROJ) + 512 * (15 + u.pn) + cb + bj * 128);
        asm volatile("" ::: "memory");
#pragma unroll
        for (int ai = 0; ai < 2; ++ai)
#pragma unroll
            for (int m = 0; m < 4; ++m) { unsigned char* mp = (unsigned char*)(P + (size_t)(row0 + ai * 128 + m * 16) * NPROJ + C_MQ) + col0;
#pragma unroll
                for (int bj = 0; bj < 2; ++bj) { const f32x4 v0 = acc[ai][bj][m][0] * SC, v1 = acc[ai][bj][m][1] * SC; const f32x4 g0 = u8x4_to_f32(gw[ai][m][bj].x), g1 = u8x4_to_f32(gw[ai][m][bj].y);
                    v2u w; w.x = pk4_fp8(g0[0] * v0[0], g0[1] * v0[1], g0[2] * v0[2], g0[3] * v0[3]);
                    w.y = pk4_fp8(g1[0] * v1[0], g1[1] * v1[1], g1[2] * v1[2], g1[3] * v1[3]);
                    *(v2u*)(mp + bj * 128) = w; } }
    }
};
struct EpiRes {
    static constexpr bool PERM = true, MID = false;
    const bf16* xin; bf16* out; const float* g; float* ssq; int rmask, nul;
    DI void operator()(const f32x4 (&acc)[2][2][4][2], const Unit& u, int wr, int wc, int fr, int fq) const {
        const int row0 = u.pm * 256 + wr * 64 + fr, col0 = u.pn * 256 + wc * 32 + 8 * fq; const int b = (u.pm * 256) >> 14;
        if (nul) { if (acc[0][0][0][0][0] == 12345.678f) out[0] = 0; return; }
        f32x4 gv[2][2];
#pragma unroll
        for (int bj = 0; bj < 2; ++bj)
#pragma unroll
            for (int n = 0; n < 2; ++n) gv[bj][n] = *(const f32x4*)(g + b * 6144 + col0 + bj * 128 + 4 * n) * (1.0f / 512.0f);
#pragma unroll
        for (int ai = 0; ai < 2; ++ai) {
            v4u xw[4][2];
#pragma unroll
            for (int m = 0; m < 4; ++m)
#pragma unroll
                for (int bj = 0; bj < 2; ++bj) xw[m][bj] = *(const v4u*)(xin + (size_t)(row0 + ai * 128 + m * 16) * D + col0 + bj * 128);
            asm volatile("" ::: "memory");
#pragma unroll
            for (int m = 0; m < 4; ++m) { const int row = row0 + ai * 128 + m * 16; float sq = 0.f;
#pragma unroll
                for (int bj = 0; bj < 2; ++bj) { const v4u w = xw[m][bj];
                    const f32x4 o0 = (f32x4){bflo(w.x), bfhi(w.x), bflo(w.y), bfhi(w.y)} + gv[bj][0] * acc[ai][bj][m][0];
                    const f32x4 o1 = (f32x4){bflo(w.z), bfhi(w.z), bflo(w.w), bfhi(w.w)} + gv[bj][1] * acc[ai][bj][m][1];
                    v4u ow; ow.x = cvt_pk_bf16(o0.x, o0.y); ow.y = cvt_pk_bf16(o0.z, o0.w); ow.z = cvt_pk_bf16(o1.x, o1.y); ow.w = cvt_pk_bf16(o1.z, o1.w);
                    { const f32x4 q0 = o0 * o0, q1 = o1 * o1; sq += ((q0.x + q0.y) + (q0.z + q0.w)) + ((q1.x + q1.y) + (q1.z + q1.w)); }
                    *(v4u*)(out + (size_t)(row & rmask) * D + col0 + bj * 128) = ow; }
                { const int ln = fq * 16 + fr; sq += shx(sq, 16, ln); sq += shx(sq, 32, ln); }
                if (fq == 0) ssq[(size_t)row * 16 + u.pn * 4 + wc] = sq; }
            asm volatile("" ::: "memory");
        }
    }
};

struct MoeTab { const LAS int* tcls; const LAS int* tpos; const LAS int* cnt; int Rtot; };
DI int xcd_remap(int L, int nwg) { const int q = nwg >> 3, r = nwg & 7, xcd = L & 7, off = L >> 3; return (xcd < r ? xcd * (q + 1) : r * (q + 1) + (xcd - r) * q) + off; }
DI void cls_experts(int cls, int& ea, int& eb) { const int g = cls / 6, p = cls - 6 * g; const int a = (p < 3) ? 0 : ((p < 5) ? 1 : 2); const int b = (p < 3) ? (p + 1) : ((p < 5) ? (p - 1) : 3); ea = 4 * g + a; eb = 4 * g + b; }
struct MoeUpSched {
    static constexpr bool GATHER = true, ASPLIT = false; static constexpr int KSPLIT = 0;
    const char* A; const char* W; int lda, ldb; MoeTab tb; int G, c; const LAS unsigned* tokoff;
    DI bool next(int i, Unit& u) const { const int L0 = i * G + c; if (L0 >= tb.Rtot * 8) return false; const int L = xcd_remap(L0, tb.Rtot * 8); u.pm = L >> 3; u.pn = L & 7; u.x0 = i; u.x1 = __builtin_amdgcn_readfirstlane(tb.tcls[u.pm]); return true; }
    DI const char* a_base(const Unit&, int) const { return A; }
    DI const char* b_base(const Unit& u, int) const { int ea, eb; cls_experts(u.x1, ea, eb); const int e = (u.pn < 4) ? ea : eb; return W + ((size_t)e * 1024 + (size_t)(u.pn & 3) * 256) * ldb; }
    DI unsigned a_rowoff(const Unit& u, int r) const { return tokoff[u.x0 * 256 + r]; }
};
struct EpiSwiglu {
    static constexpr bool PERM = true, MID = false;
    unsigned char* H; const float* tgate; const LAS unsigned* tokoff;
    DI void operator()(const f32x4 (&acc)[2][2][4][2], const Unit& u, int wr, int wc, int fr, int fq) const {
        const int r0 = wr * 64 + fr; const int hc = (u.pn >> 2) * 512 + (u.pn & 3) * 128 + wc * 32 + 8 * fq; const int gsel = u.pn >> 2;
        float rgv[2][4];
#pragma unroll
        for (int ai = 0; ai < 2; ++ai)
#pragma unroll
            for (int m = 0; m < 4; ++m) { const unsigned tok = tokoff[u.x0 * 256 + r0 + ai * 128 + m * 16]; rgv[ai][m] = tgate[tok * 2 + gsel] * 8.0f; }
        asm volatile("" ::: "memory");
#pragma unroll
        for (int ai = 0; ai < 2; ++ai)
#pragma unroll
            for (int m = 0; m < 4; ++m) { const int r = r0 + ai * 128 + m * 16; const float rg = rgv[ai][m];
                const f32x4 G0 = acc[ai][0][m][0], G1 = acc[ai][0][m][1], U0 = acc[ai][1][m][0], U1 = acc[ai][1][m][1]; const float kk = rg * (1.0f / 4096.0f);
                float o[8];
#pragma unroll
                for (int j = 0; j < 4; ++j) { o[j] = (G0[j] * U0[j]) * kk * __builtin_amdgcn_rcpf(1.0f + __builtin_amdgcn_exp2f(G0[j] * (-1.4426950408889634f / 64.0f)));
                                              o[4 + j] = (G1[j] * U1[j]) * kk * __builtin_amdgcn_rcpf(1.0f + __builtin_amdgcn_exp2f(G1[j] * (-1.4426950408889634f / 64.0f))); }
#pragma unroll
                for (int j = 0; j < 8; ++j) o[j] = __builtin_amdgcn_fmed3f(o[j], -440.0f, 440.0f);
                v2u w; w.x = pk4_fp8(o[0], o[1], o[2], o[3]); w.y = pk4_fp8(o[4], o[5], o[6], o[7]);
                *(v2u*)(H + ((size_t)u.pm * 256 + r) * 1024 + hc) = w; }
    }
};
struct MoeDownSched {
    static constexpr bool GATHER = false, ASPLIT = false; static constexpr int KSPLIT = 4;
    const char* A; const char* W; int lda, ldb; MoeTab tb; int G, c;
    DI bool next(int i, Unit& u) const { const int L0 = i * G + c; if (L0 >= tb.Rtot * 4) return false; const int L = xcd_remap(L0, tb.Rtot * 4); u.pm = L >> 2; u.pn = L & 3; u.x0 = __builtin_amdgcn_readfirstlane(tb.tpos[u.pm]); u.x1 = __builtin_amdgcn_readfirstlane(tb.tcls[u.pm]); return true; }
    DI const char* a_base(const Unit& u, int) const { return A + (size_t)u.pm * 256 * lda; }
    DI const char* b_base(const Unit& u, int half) const { int ea, eb; cls_experts(u.x1, ea, eb); const int e = half ? eb : ea; return W + ((size_t)e * 1024 + (size_t)u.pn * 256) * ldb; }
    DI unsigned a_rowoff(const Unit&, int) const { return 0u; }
};
struct EpiMoeOut {
    static constexpr bool PERM = true, MID = false;
    const bf16* xin; bf16* outb; float* outf; const float* g; const int* tokl; MoeTab tb; int rmask, last;
    DI void operator()(const f32x4 (&acc)[2][2][4][2], const Unit& u, int wr, int wc, int fr, int fq) const {
        const int r0 = wr * 64 + fr, col0 = u.pn * 256 + wc * 32 + 8 * fq; const int cn = tb.cnt[u.x1];
        v2u gvp[2][2][2];
#pragma unroll
        for (int b = 0; b < 2; ++b)
#pragma unroll
            for (int bj = 0; bj < 2; ++bj)
#pragma unroll
                for (int n = 0; n < 2; ++n) { const f32x4 t = *(const f32x4*)(g + b * 6144 + col0 + bj * 128 + 4 * n) * (1.0f / 256.0f); gvp[b][bj][n].x = cvt_pk_bf16(t.x, t.y); gvp[b][bj][n].y = cvt_pk_bf16(t.z, t.w); }
        int tok[2][4];
#pragma unroll
        for (int ai = 0; ai < 2; ++ai)
#pragma unroll
            for (int m = 0; m < 4; ++m) { const int pos = u.x0 + r0 + ai * 128 + m * 16; tok[ai][m] = (pos < cn) ? tokl[u.x1 * CLS_CAP + pos] : -1; }
#pragma unroll
        for (int ai = 0; ai < 2; ++ai) {
            v4u xw[4][2];
#pragma unroll
            for (int m = 0; m < 4; ++m)
#pragma unroll
                for (int bj = 0; bj < 2; ++bj) { const int tk = tok[ai][m] < 0 ? 0 : tok[ai][m]; xw[m][bj] = *(const v4u*)(xin + (size_t)tk * D + col0 + bj * 128); }
            asm volatile("" ::: "memory");
#pragma unroll
            for (int m = 0; m < 4; ++m) { const int tk = tok[ai][m];
                if (tk >= 0) { const bool b1 = (tk >> 14) != 0;
#pragma unroll
                    for (int bj = 0; bj < 2; ++bj) { const v4u w = xw[m][bj];
                        const v2u pa = b1 ? gvp[1][bj][0] : gvp[0][bj][0], pb = b1 ? gvp[1][bj][1] : gvp[0][bj][1];
                        const f32x4 ga = {bflo(pa.x), bfhi(pa.x), bflo(pa.y), bfhi(pa.y)}, gb = {bflo(pb.x), bfhi(pb.x), bflo(pb.y), bfhi(pb.y)};
                        const f32x4 o0 = (f32x4){bflo(w.x), bfhi(w.x), bflo(w.y), bfhi(w.y)} + ga * acc[ai][bj][m][0];
                        const f32x4 o1 = (f32x4){bflo(w.z), bfhi(w.z), bflo(w.w), bfhi(w.w)} + gb * acc[ai][bj][m][1];
                        if (last) { float* of = outf + (size_t)tk * D + col0 + bj * 128; *(f32x4*)of = o0; *(f32x4*)(of + 4) = o1; }
                        else { v4u ow; ow.x = cvt_pk_bf16(o0.x, o0.y); ow.y = cvt_pk_bf16(o0.z, o0.w); ow.z = cvt_pk_bf16(o1.x, o1.y); ow.w = cvt_pk_bf16(o1.z, o1.w);
                            *(v4u*)(outb + (size_t)(tk & rmask) * D + col0 + bj * 128) = ow; } } } }
            asm volatile("" ::: "memory");
        }
    }
};

struct Ctx { LAS unsigned char* lds; int tid, lane, wave, G, bid; };
DI Ctx fresh(const Ctx& X) { Ctx P = X; int t = X.tid; asm volatile("" : "+v"(t)); P.tid = t; P.lane = t & 63; P.wave = __builtin_amdgcn_readfirstlane(t >> 6); return P; }

DI void tr_item(const float* W, int ldw, int K, bf16* WT, int k0, LAS float* scr, int lane) {
    { const int rr = lane >> 3, c4 = lane & 7; f32x4 v[8];
#pragma unroll
      for (int i = 0; i < 8; ++i) v[i] = *(const f32x4*)(W + (size_t)(k0 + rr + 8 * i) * ldw + 4 * c4);
#pragma unroll
      for (int i = 0; i < 8; ++i) { LAS float* d = scr + (rr + 8 * i) * 33 + 4 * c4; d[0] = v[i].x; d[1] = v[i].y; d[2] = v[i].z; d[3] = v[i].w; } }
    LDS_WAIT(); asm volatile("" ::: "memory");
    const int c = lane & 7;
#pragma unroll
    for (int j = 0; j < 4; ++j) { const int n = (lane >> 3) + 8 * j; const LAS float* s = scr + (8 * c) * 33 + n;
        v4u o; o.x = pk2(s[0 * 33], s[1 * 33]); o.y = pk2(s[2 * 33], s[3 * 33]); o.z = pk2(s[4 * 33], s[5 * 33]); o.w = pk2(s[6 * 33], s[7 * 33]);
        *(v4u*)(WT + (size_t)n * K + k0 + 8 * c) = o; }
    LDS_WAIT(); asm volatile("" ::: "memory");
}
struct TrItem { const float* W; unsigned char* WT; int ldw, K, k0; float scale; };
DI void tr_load8(const TrItem& t, int lane, f32x4 (&v)[8]) {
    const int rr = lane >> 3, c4 = lane & 7;
#pragma unroll
    for (int i = 0; i < 8; ++i) v[i] = *(const f32x4*)(t.W + (size_t)(t.k0 + rr + 8 * i) * t.ldw + 4 * c4);
}
DI void tr_store8(const TrItem& t, const f32x4 (&v)[8], LAS float* scr, int lane) {
    { const int rr = lane >> 3, c4 = lane & 7;
#pragma unroll
      for (int i = 0; i < 8; ++i) { LAS float* d = scr + (rr + 8 * i) * 33 + 4 * c4; d[0] = v[i].x; d[1] = v[i].y; d[2] = v[i].z; d[3] = v[i].w; } }
    LDS_WAIT(); asm volatile("" ::: "memory");
    const int c = lane & 7; const float scale = t.scale;
#pragma unroll
    for (int j = 0; j < 4; ++j) { const int n = (lane >> 3) + 8 * j; const LAS float* s = scr + (8 * c) * 33 + n;
        v2u o; o.x = pk4_fp8(s[0 * 33] * scale, s[1 * 33] * scale, s[2 * 33] * scale, s[3 * 33] * scale); o.y = pk4_fp8(s[4 * 33] * scale, s[5 * 33] * scale, s[6 * 33] * scale, s[7 * 33] * scale);
        *(v2u*)(t.WT + (size_t)n * t.K + t.k0 + 8 * c) = o; }
    LDS_WAIT(); asm volatile("" ::: "memory");
}
DI void p0_prologue(const Args& a, const Ctx& X) {
    unsigned char* ws = a.ws;
    LAS float* scr = (LAS float*)(X.lds + X.wave * 16384);
    const int gw = X.bid * 8 + X.wave, NGW = X.G * 8;
    constexpr int IT_WIN = 16 * 153, IT_AU = 8 * 32, IT_OUT = 16 * 32, IT_GU = 16 * 16 * 32, IT_DN = 16 * 8 * 32;
    constexpr int IT_L = IT_WIN + 2 * IT_AU + IT_OUT + IT_GU + IT_DN;
    auto decode = [&](int it, TrItem& t) {
        const int l = it / IT_L; int r = it - l * IT_L;
        if (r < IT_WIN) { const int kb = r / 153, nb = r - kb * 153, d0 = 32 * nb, s0 = (nb == 152) ? 2304 : (d0 + (d0 >= 2304 ? 8 : 0));
            t.W = a.w_in + (size_t)l * D * DIN_SRC + s0; t.ldw = DIN_SRC; t.K = D; t.WT = (unsigned char*)(ws + WS_WIN) + ((size_t)l * NPROJW + d0) * D; t.k0 = 64 * kb; t.scale = 64.0f; return; }
        r -= IT_WIN;
        if (r < IT_AU) { const int kb = r >> 5, nb = r & 31;
            t.W = a.w_au + (size_t)l * 512 * D + 32 * nb; t.ldw = D; t.K = 512; t.WT = (unsigned char*)(ws + WS_WAU) + ((size_t)l * D + 32 * nb) * 512; t.k0 = 64 * kb; t.scale = 32.0f; return; }
        r -= IT_AU;
        if (r < IT_AU) { const int kb = r >> 5, nb = r & 31;
            t.W = a.w_mu + (size_t)l * 512 * D + 32 * nb; t.ldw = D; t.K = 512; t.WT = (unsigned char*)(ws + WS_WMU) + ((size_t)l * D + 32 * nb) * 512; t.k0 = 64 * kb; t.scale = 32.0f; return; }
        r -= IT_AU;
        if (r < IT_OUT) { const int kb = r >> 5, nb = r & 31;
            t.W = a.w_out + (size_t)l * D * D + 32 * nb; t.ldw = D; t.K = D; t.WT = (unsigned char*)(ws + WS_WOUT) + ((size_t)l * D + 32 * nb) * D; t.k0 = 64 * kb; t.scale = 64.0f; return; }
        r -= IT_OUT;
        if (r < IT_GU) { const int e = r >> 9, q = r & 511, kb = q >> 5, nb = q & 31, tq = nb >> 3, rb = nb & 7;
            t.W = ((rb < 4) ? a.w_gate : a.w_up) + ((size_t)(l * NE + e) * D) * FF + 128 * tq + 32 * (rb & 3); t.ldw = FF; t.K = D; t.WT = (unsigned char*)(ws + WS_WGU) + ((size_t)(l * NE + e) * 1024 + 32 * nb) * D; t.k0 = 64 * kb; t.scale = 64.0f; return; }
        r -= IT_GU;
        { const int e = r >> 8, q = r & 255, kb = q >> 5, nb = q & 31;
            t.W = a.w_down + ((size_t)(l * NE + e) * FF) * D + 32 * nb; t.ldw = D; t.K = FF; t.WT = (unsigned char*)(ws + WS_WD) + ((size_t)(l * NE + e) * 1024 + 32 * nb) * FF; t.k0 = 64 * kb; t.scale = 32.0f; }
    };
    { TrItem cur, nxt; f32x4 va[8], vb[8];
      if (gw < NL * IT_L) { decode(gw, cur); tr_load8(cur, X.lane, va); }
#pragma unroll 1
      for (int it = gw; it < NL * IT_L; it += 2 * NGW) {
          const bool h1 = it + NGW < NL * IT_L, h2 = it + 2 * NGW < NL * IT_L;
          if (h1) { decode(it + NGW, nxt); tr_load8(nxt, X.lane, vb); }
          tr_store8(cur, va, scr, X.lane);
          if (h1) { if (h2) { decode(it + 2 * NGW, cur); tr_load8(cur, X.lane, va); }
                    tr_store8(nxt, vb, scr, X.lane); } } }
    { const float* xs = a.x; bf16* xb = (bf16*)(ws + WS_XB);
      const size_t NP = (size_t)T * D / 8, ST = (size_t)X.G * 512;
      for (size_t i = (size_t)X.bid * 512 + X.tid; i < NP; i += 4 * ST) { f32x4 v0[4], v1[4];
#pragma unroll
          for (int k = 0; k < 4; ++k) { const size_t ii = i + k * ST; if (ii < NP) { v0[k] = *(const f32x4*)(xs + 8 * ii); v1[k] = *(const f32x4*)(xs + 8 * ii + 4); } }
#pragma unroll
          for (int k = 0; k < 4; ++k) { const size_t ii = i + k * ST; if (ii < NP) { v4u w; w.x = cvt_pk_bf16(v0[k].x, v0[k].y); w.y = cvt_pk_bf16(v0[k].z, v0[k].w); w.z = cvt_pk_bf16(v1[k].x, v1[k].y); w.w = cvt_pk_bf16(v1[k].z, v1[k].w); *(v4u*)(xb + 8 * ii) = w; } } } }
    { float* cs = (float*)(ws + WS_ROPE); float* sn = cs + (size_t)T * 8;
      for (int i = X.bid * 512 + X.tid; i < T * 8; i += X.G * 512) { const int tok = i >> 3, f = i & 7; const float angf = (float)a.pos[tok] * c_invf[f];
          double rev = (double)angf * 0.15915494309189535; rev -= rint(rev); const float rf = (float)rev;
          cs[i] = __builtin_amdgcn_cosf(rf); sn[i] = __builtin_amdgcn_sinf(rf); } }
    __syncthreads();
    LAS float* cact = (LAS float*)X.lds; LAS float* red = (LAS float*)(X.lds + 8192);
    for (int i = X.tid; i < 2048; i += 512) { const float cv = a.c[i]; cact[i] = cv / (1.0f + __expf(-cv)); }
    __syncthreads();
    float* mod = (float*)(ws + WS_MOD);
    for (int it = X.bid; it < NL * 48; it += X.G) { const int l = it / 48, cg = it - l * 48; const int hl = X.lane >> 5, ln = X.lane & 31, ks = X.wave * 2 + hl; const int col = cg * 128 + 4 * ln;
        const float* w = a.ada_w + (size_t)l * D * 6144 + col; f32x4 s0 = {0.f, 0.f, 0.f, 0.f}, s1 = {0.f, 0.f, 0.f, 0.f};
#pragma unroll 1
        for (int k16 = 0; k16 < 64; k16 += 16) { const int kb = ks * 64 + k16; f32x4 wv[16];
#pragma unroll
            for (int kk = 0; kk < 16; ++kk) wv[kk] = *(const f32x4*)(w + (size_t)(kb + kk) * 6144);
#pragma unroll
            for (int kk = 0; kk < 16; ++kk) { s0 += wv[kk] * cact[kb + kk]; s1 += wv[kk] * cact[1024 + kb + kk]; } }
        *(LAS f32x4*)(red + (ks * 2 + 0) * 128 + 4 * ln) = s0; *(LAS f32x4*)(red + (ks * 2 + 1) * 128 + 4 * ln) = s1;
        __syncthreads();
        if (X.tid < 256) { const int b = X.tid >> 7, cc = X.tid & 127; float sm = 0.f;
#pragma unroll
          for (int s16 = 0; s16 < 16; ++s16) sm += red[(s16 * 2 + b) * 128 + cc];
          mod[(size_t)(l * 2 + b) * 6144 + cg * 128 + cc] = sm + a.ada_b[l * 6144 + cg * 128 + cc]; }
        __syncthreads();
    }
}

DI void p1_norm_gates(const Args& a, const Ctx& X, int l, const bf16* xin) {
    unsigned char* ws = a.ws;
    const float* mod = (const float*)(ws + WS_MOD); unsigned char* hb = (unsigned char*)(ws + WS_H);
    const int gw = X.bid * 8 + X.wave, NGW = X.G * 8;
    for (int rg = gw; rg < T / 16; rg += NGW) {
        const int row0 = rg * 16, b = row0 >> 14;
        const float* mb = mod + (size_t)(l * 2 + b) * 6144;
        f32x4 aw[4], sh[4];
#pragma unroll
        for (int j = 0; j < 4; ++j) { const int k = 256 * j + 4 * X.lane; const f32x4 nw = *(const f32x4*)(a.nmw + l * D + k); const f32x4 sc = *(const f32x4*)(mb + 1024 + k); aw[j] = nw * (sc + 1.0f); sh[j] = *(const f32x4*)(mb + k); }
        v2u pre[4][4];
#pragma unroll
        for (int q = 0; q < 4; ++q) { const v2u* xp = (const v2u*)(xin + (size_t)(row0 + q) * D) + X.lane;
#pragma unroll
            for (int j = 0; j < 4; ++j) pre[q][j] = xp[64 * j]; }
#pragma unroll 1
        for (int rb = 0; rb < 16; rb += 4) {
#pragma unroll
          for (int q = 0; q < 4; ++q) { const int row = row0 + rb + q;
            f32x4 v[4]; float ss = 0.f;
#pragma unroll
            for (int j = 0; j < 4; ++j) { const v2u pw = pre[q][j]; v[j] = (f32x4){bflo(pw.x), bfhi(pw.x), bflo(pw.y), bfhi(pw.y)}; }
            if (rb + 4 < 16) { const v2u* xp = (const v2u*)(xin + (size_t)(row + 4) * D) + X.lane;
#pragma unroll
                for (int j = 0; j < 4; ++j) pre[q][j] = xp[64 * j]; }
#pragma unroll
            for (int j = 0; j < 4; ++j) ss += (v[j].x * v[j].x + v[j].y * v[j].y) + (v[j].z * v[j].z + v[j].w * v[j].w);
            ss = wave_sum(ss, X.lane); const float rstd = __builtin_amdgcn_rsqf(ss * (1.0f / D) + EPS);
            unsigned* o4 = (unsigned*)(hb + (size_t)row * D) + X.lane;
#pragma unroll
            for (int j = 0; j < 4; ++j) { v[j] = v[j] * rstd * aw[j] + sh[j]; o4[64 * j] = pk4_fp8(v[j].x, v[j].y, v[j].z, v[j].w); }
          }
        }
    }
}

DI void attn_unit(const Args& a, const Ctx& X, int l, int unit) {
    unsigned char* ws = a.ws; const bf16* proj = (const bf16*)(ws + WS_PROJ); unsigned char* ao = (unsigned char*)(ws + WS_H);
    const float* cs = (const float*)(ws + WS_ROPE); const float* sn = cs + (size_t)T * 8;
    const int b = unit >> 8, rem = unit & 255, nb = rem >> 1, kvh = rem & 1; const int tok0 = b * SEQ + nb * 128;
    LAS bf16* Kl = (LAS bf16*)X.lds;
    LAS bf16* VT = (LAS bf16*)(X.lds + 36864);
    int lane = X.lane; asm volatile("" : "+v"(lane));
    const int c16 = lane & 15, quad = lane >> 4;
    v2u nq[2][2]; f32x4 ncs[2][2], nsn[2][2];
#define AT_PREF(task_) do { const int g_ = (task_) >> 2; _Pragma("unroll") for (int rt = 0; rt < 2; ++rt) { const int tq_ = tok0 + 32 * ((task_) & 3) + 16 * rt + c16; \
        const unsigned char* qp_ = (const unsigned char*)(proj + (size_t)tq_ * NPROJ) + 512 * ((kvh * 4 + g_) >> 2) + ((kvh * 4 + g_) & 3) * 64; nq[rt][0] = *(const v2u*)(qp_ + 8 * quad); nq[rt][1] = *(const v2u*)(qp_ + 32 + 8 * quad); \
        ncs[rt][0] = *(const f32x4*)(cs + (size_t)tq_ * 8); ncs[rt][1] = *(const f32x4*)(cs + (size_t)tq_ * 8 + 4); nsn[rt][0] = *(const f32x4*)(sn + (size_t)tq_ * 8); nsn[rt][1] = *(const f32x4*)(sn + (size_t)tq_ * 8 + 4); } } while (0)
    AT_PREF(X.wave);
    float qw[16];
#pragma unroll
    for (int i = 0; i < 8; ++i) { qw[i] = a.qnw[l * 64 + 8 * quad + i]; qw[8 + i] = a.qnw[l * 64 + 32 + 8 * quad + i]; }
    const f32x4 sk4 = *(const f32x4*)(a.sinks + l * 8 + kvh * 4);
    {
        const int row = X.tid >> 1, half = X.tid & 1; const int tokk = tok0 - 128 + row; const bool valid = (nb > 0) || (row >= 128);
        float y[32]; float vv[32];
        f32x4 kn4[8], rc4[2], rs4[2];
        { const float* knp = a.knw + l * 64 + half * 32; const size_t tkc = (size_t)(valid ? tokk : tok0) * 8;
#pragma unroll
          for (int i = 0; i < 8; ++i) kn4[i] = *(const f32x4*)(knp + 4 * i);
          rc4[0] = *(const f32x4*)(cs + tkc); rc4[1] = *(const f32x4*)(cs + tkc + 4); rs4[0] = *(const f32x4*)(sn + tkc); rs4[1] = *(const f32x4*)(sn + tkc + 4); }
        if (valid) {
            const unsigned char* rowp = (const unsigned char*)(proj + (size_t)tokk * NPROJ) + 512 * 2 + kvh * 64 + half * 32; const v4u kw0 = *(const v4u*)rowp, kw1 = *(const v4u*)(rowp + 16), vw0 = *(const v4u*)(rowp + 128), vw1 = *(const v4u*)(rowp + 144);
            const unsigned kd[8] = {kw0.x, kw0.y, kw0.z, kw0.w, kw1.x, kw1.y, kw1.z, kw1.w}, vd[8] = {vw0.x, vw0.y, vw0.z, vw0.w, vw1.x, vw1.y, vw1.z, vw1.w};
#pragma unroll
            for (int q = 0; q < 8; ++q) { const f32x4 kf4 = fp8x4(kd[q]), vf4 = fp8x4(vd[q]) * (1.0f / 16.0f);
#pragma unroll
                for (int j = 0; j < 4; ++j) { y[4 * q + j] = kf4[j]; vv[4 * q + j] = vf4[j]; } }
        } else {
#pragma unroll
            for (int i = 0; i < 32; ++i) { y[i] = 0.f; vv[i] = 0.f; } }
        float ss = 0.f;
#pragma unroll
        for (int i = 0; i < 32; ++i) ss += y[i] * y[i];
        ss += shx(ss, 1, lane); const float rstd = __builtin_amdgcn_rsqf(ss * (1.0f / 64.0f) + EPS * 256.0f);
#pragma unroll
        for (int i = 0; i < 32; ++i) y[i] = y[i] * rstd * kn4[i >> 2][i & 3];
        if (half == 0 && valid) {
#pragma unroll
            for (int d = 0; d < 8; ++d) { const float c = rc4[d >> 2][d & 3], s = rs4[d >> 2][d & 3]; const float t1 = y[d], t2 = y[d + 8]; y[d] = t1 * c - t2 * s; y[d + 8] = t2 * c + t1 * s; } }
#pragma unroll
        for (int q = 0; q < 4; ++q) { v4u w; w.x = pk2(y[8 * q], y[8 * q + 1]); w.y = pk2(y[8 * q + 2], y[8 * q + 3]); w.z = pk2(y[8 * q + 4], y[8 * q + 5]); w.w = pk2(y[8 * q + 6], y[8 * q + 7]);
            *(LAS v4u*)(Kl + row * 72 + half * 32 + 8 * q) = w; }
#pragma unroll
        for (int i = 0; i < 32; ++i) VT[(half * 32 + i) * 280 + row] = (bf16)f2bf(vv[i]);
        if (X.tid < 64) {
#pragma unroll
            for (int cc = 256; cc < 280; ++cc) VT[X.tid * 280 + cc] = 0; }
    }
    __syncthreads();
    int dbase = 4 * quad - c16; asm volatile("" : "+v"(dbase));
#pragma unroll 1
    for (int it = 0; it < 2; ++it) {
        const int task = X.wave + 8 * it; const int g = task >> 2, rq = task & 3, ka = 2 * rq, head = kvh * 4 + g;
        const float sinkl = ((g == 0) ? sk4.x : ((g == 1) ? sk4.y : ((g == 2) ? sk4.z : sk4.w))) * 1.4426950408889634f;
        float qv[2][16]; float ss[2]; f32x4 cc[2][2], sv4[2][2];
#pragma unroll
        for (int rt = 0; rt < 2; ++rt) { const v2u w0 = nq[rt][0], w1 = nq[rt][1]; cc[rt][0] = ncs[rt][0]; cc[rt][1] = ncs[rt][1]; sv4[rt][0] = nsn[rt][0]; sv4[rt][1] = nsn[rt][1];
            { const f32x4 q0 = fp8x4(w0.x), q1 = fp8x4(w0.y), q2 = fp8x4(w1.x), q3 = fp8x4(w1.y);
#pragma unroll
              for (int j = 0; j < 4; ++j) { qv[rt][j] = q0[j]; qv[rt][4 + j] = q1[j]; qv[rt][8 + j] = q2[j]; qv[rt][12 + j] = q3[j]; } }
            ss[rt] = (((qv[rt][0] * qv[rt][0] + qv[rt][1] * qv[rt][1]) + (qv[rt][2] * qv[rt][2] + qv[rt][3] * qv[rt][3])) + ((qv[rt][4] * qv[rt][4] + qv[rt][5] * qv[rt][5]) + (qv[rt][6] * qv[rt][6] + qv[rt][7] * qv[rt][7])))
                   + (((qv[rt][8] * qv[rt][8] + qv[rt][9] * qv[rt][9]) + (qv[rt][10] * qv[rt][10] + qv[rt][11] * qv[rt][11])) + ((qv[rt][12] * qv[rt][12] + qv[rt][13] * qv[rt][13]) + (qv[rt][14] * qv[rt][14] + qv[rt][15] * qv[rt][15]))); }
        { const float t0 = shx(ss[0], 16, lane), t1 = shx(ss[1], 16, lane); ss[0] += t0; ss[1] += t1; }
        { const float t0 = shx(ss[0], 32, lane), t1 = shx(ss[1], 32, lane); ss[0] += t0; ss[1] += t1; }
        float ot[2][8];
#pragma unroll
        for (int rt = 0; rt < 2; ++rt) { const float rs_ = __builtin_amdgcn_rsqf(ss[rt] * (1.0f / 64.0f) + EPS * 256.0f) * (0.125f * 1.4426950408889634f);
#pragma unroll
            for (int i = 0; i < 16; ++i) qv[rt][i] = qv[rt][i] * rs_ * qw[i]; }
#pragma unroll
        for (int rt = 0; rt < 2; ++rt)
#pragma unroll
            for (int d = 0; d < 8; ++d) ot[rt][d] = shx(qv[rt][d], 16, lane);
        bf16x8 qf[2][2];
#pragma unroll
        for (int rt = 0; rt < 2; ++rt) { const float cv[8] = {cc[rt][0].x, cc[rt][0].y, cc[rt][0].z, cc[rt][0].w, cc[rt][1].x, cc[rt][1].y, cc[rt][1].z, cc[rt][1].w}, sv[8] = {sv4[rt][0].x, sv4[rt][0].y, sv4[rt][0].z, sv4[rt][0].w, sv4[rt][1].x, sv4[rt][1].y, sv4[rt][1].z, sv4[rt][1].w};
#pragma unroll
            for (int d = 0; d < 8; ++d) { if (quad == 0) qv[rt][d] = qv[rt][d] * cv[d] - ot[rt][d] * sv[d]; else if (quad == 1) qv[rt][d] = qv[rt][d] * cv[d] + ot[rt][d] * sv[d]; }
            v4u w; w.x = pk2m(qv[rt][0], qv[rt][1]); w.y = pk2m(qv[rt][2], qv[rt][3]); w.z = pk2m(qv[rt][4], qv[rt][5]); w.w = pk2m(qv[rt][6], qv[rt][7]); qf[rt][0] = __builtin_bit_cast(bf16x8, w);
            w.x = pk2m(qv[rt][8], qv[rt][9]); w.y = pk2m(qv[rt][10], qv[rt][11]); w.z = pk2m(qv[rt][12], qv[rt][13]); w.w = pk2m(qv[rt][14], qv[rt][15]); qf[rt][1] = __builtin_bit_cast(bf16x8, w); }
        __builtin_amdgcn_sched_barrier(0);
        f32x4 sacc[2][9];
#pragma unroll
        for (int i = 0; i < 10; ++i) { const LAS bf16* kr = Kl + (16 * (ka + i) + c16) * 72 + 8 * quad;
            const bf16x8 k0 = *(const LAS bf16x8*)kr, k1 = *(const LAS bf16x8*)(kr + 32);
            if (i <= 8) { f32x4 z = {0.f, 0.f, 0.f, 0.f}; z = __builtin_amdgcn_mfma_f32_16x16x32_bf16(k0, qf[0][0], z, 0, 0, 0); sacc[0][(i <= 8) ? i : 0] = __builtin_amdgcn_mfma_f32_16x16x32_bf16(k1, qf[0][1], z, 0, 0, 0); }
            if (i >= 1) { f32x4 z = {0.f, 0.f, 0.f, 0.f}; z = __builtin_amdgcn_mfma_f32_16x16x32_bf16(k0, qf[1][0], z, 0, 0, 0); sacc[1][(i >= 1) ? i - 1 : 0] = __builtin_amdgcn_mfma_f32_16x16x32_bf16(k1, qf[1][1], z, 0, 0, 0); }
            if ((i & 3) == 3) asm volatile("" ::: "memory"); }
        __builtin_amdgcn_sched_barrier(0);
        if (it == 0) { AT_PREF(X.wave + 8); }
        if (nb > 0) {
#pragma unroll
            for (int rt = 0; rt < 2; ++rt)
#pragma unroll
                for (int j = 0; j < 4; ++j) { sacc[rt][0][j] = (dbase + j > 0) ? sacc[rt][0][j] : -3.0e38f; sacc[rt][8][j] = (dbase + j <= 0) ? sacc[rt][8][j] : -3.0e38f; }
        } else {
#pragma unroll
            for (int rt = 0; rt < 2; ++rt) { int kbase = 16 * (ka + rt) + 4 * quad; asm volatile("" : "+v"(kbase));
#pragma unroll
                for (int i = 0; i < 9; ++i)
#pragma unroll
                    for (int j = 0; j < 4; ++j) { const int dlt = dbase + 16 * i + j; const int kj = kbase + 16 * i + j; const bool ok = (dlt > 0) && (dlt <= 128) && (kj >= 128); sacc[rt][i][j] = ok ? sacc[rt][i][j] : -3.0e38f; } } }
        float mx[2], sum[2], inv[2];
#pragma unroll
        for (int rt = 0; rt < 2; ++rt) { float m0 = sacc[rt][0][0], m1 = sacc[rt][0][1], m2 = sacc[rt][0][2], m3 = sacc[rt][0][3];
#pragma unroll
            for (int i = 1; i < 9; ++i) { m0 = fmaxf(m0, sacc[rt][i][0]); m1 = fmaxf(m1, sacc[rt][i][1]); m2 = fmaxf(m2, sacc[rt][i][2]); m3 = fmaxf(m3, sacc[rt][i][3]); }
            mx[rt] = fmaxf(sinkl, fmaxf(fmaxf(m0, m1), fmaxf(m2, m3))); }
        { const float t0 = shx(mx[0], 16, lane), t1 = shx(mx[1], 16, lane); mx[0] = fmaxf(mx[0], t0); mx[1] = fmaxf(mx[1], t1); }
        { const float t0 = shx(mx[0], 32, lane), t1 = shx(mx[1], 32, lane); mx[0] = fmaxf(mx[0], t0); mx[1] = fmaxf(mx[1], t1); }
#pragma unroll
        for (int rt = 0; rt < 2; ++rt) { float s0 = 0.f, s1 = 0.f, s2 = 0.f, s3 = 0.f;
#pragma unroll
            for (int i = 0; i < 9; ++i) { const f32x4 p = {__builtin_amdgcn_exp2f(sacc[rt][i][0] - mx[rt]), __builtin_amdgcn_exp2f(sacc[rt][i][1] - mx[rt]), __builtin_amdgcn_exp2f(sacc[rt][i][2] - mx[rt]), __builtin_amdgcn_exp2f(sacc[rt][i][3] - mx[rt])};
                sacc[rt][i] = p; s0 += p[0]; s1 += p[1]; s2 += p[2]; s3 += p[3]; }
            sum[rt] = (s0 + s1) + (s2 + s3); }
        { const float t0 = shx(sum[0], 16, lane), t1 = shx(sum[1], 16, lane); sum[0] += t0; sum[1] += t1; }
        { const float t0 = shx(sum[0], 32, lane), t1 = shx(sum[1], 32, lane); sum[0] += t0; sum[1] += t1; }
#pragma unroll
        for (int rt = 0; rt < 2; ++rt) inv[rt] = __builtin_amdgcn_rcpf(sum[rt] + __builtin_amdgcn_exp2f(sinkl - mx[rt])) * 8.0f;
        __builtin_amdgcn_sched_barrier(0);
        f32x4 oacc[2][4];
#pragma unroll
        for (int rt = 0; rt < 2; ++rt)
#pragma unroll
            for (int et = 0; et < 4; ++et) oacc[rt][et] = (f32x4){0.f, 0.f, 0.f, 0.f};
#pragma unroll
        for (int kk = 0; kk < 5; ++kk) {
            v4u p0, p1;
            p0.x = pk2m(sacc[0][2 * kk][0], sacc[0][2 * kk][1]); p0.y = pk2m(sacc[0][2 * kk][2], sacc[0][2 * kk][3]);
            if (kk < 4) { p0.z = pk2m(sacc[0][(kk < 4) ? 2 * kk + 1 : 0][0], sacc[0][(kk < 4) ? 2 * kk + 1 : 0][1]); p0.w = pk2m(sacc[0][(kk < 4) ? 2 * kk + 1 : 0][2], sacc[0][(kk < 4) ? 2 * kk + 1 : 0][3]); } else { p0.z = 0u; p0.w = 0u; }
            if (kk > 0) { p1.x = pk2m(sacc[1][(kk > 0) ? 2 * kk - 1 : 0][0], sacc[1][(kk > 0) ? 2 * kk - 1 : 0][1]); p1.y = pk2m(sacc[1][(kk > 0) ? 2 * kk - 1 : 0][2], sacc[1][(kk > 0) ? 2 * kk - 1 : 0][3]); } else { p1.x = 0u; p1.y = 0u; }
            p1.z = pk2m(sacc[1][2 * kk][0], sacc[1][2 * kk][1]); p1.w = pk2m(sacc[1][2 * kk][2], sacc[1][2 * kk][3]);
            const bf16x8 pf0 = __builtin_bit_cast(bf16x8, p0), pf1 = __builtin_bit_cast(bf16x8, p1);
#pragma unroll
            for (int et = 0; et < 4; ++et) { const LAS bf16* vr = VT + (16 * et + c16) * 280 + 16 * ka + 32 * kk + 4 * quad;
                const v2u lo = *(const LAS v2u*)vr, hi = *(const LAS v2u*)(vr + 16); v4u vw; vw.x = lo.x; vw.y = lo.y; vw.z = hi.x; vw.w = hi.y; const bf16x8 vf = __builtin_bit_cast(bf16x8, vw);
                oacc[0][et] = __builtin_amdgcn_mfma_f32_16x16x32_bf16(vf, pf0, oacc[0][et], 0, 0, 0);
                oacc[1][et] = __builtin_amdgcn_mfma_f32_16x16x32_bf16(vf, pf1, oacc[1][et], 0, 0, 0); }
            asm volatile("" ::: "memory"); }
#pragma unroll
        for (int rt = 0; rt < 2; ++rt) { const int tokq = tok0 + 32 * rq + 16 * rt + c16;
#pragma unroll
            for (int et = 0; et < 4; ++et)
                *(unsigned*)(ao + (size_t)tokq * 512 + head * 64 + 16 * et + 4 * quad) = pk4_fp8(oacc[rt][et][0] * inv[rt], oacc[rt][et][1] * inv[rt], oacc[rt][et][2] * inv[rt], oacc[rt][et][3] * inv[rt]); }
    }
    __syncthreads();
#undef AT_PREF
}

constexpr int ML_Q = 0, ML_K = 17408, ML_KET = 34816, ML_VT = 53248, ML_CT = 73984, ML_CW = 113152, ML_CB = 118272, ML_RED = 118784, ML_NW = 119296, ML_GT = 119808;
DI float bfw(unsigned w, int hi) { return hi ? bfhi(w) : bflo(w); }
template <bool L3> DI void mlstm_unit(const Args& a, const Ctx& X, int l, int unit) {
    unsigned char* ws = a.ws; const bf16* proj = (const bf16*)(ws + WS_PROJ); unsigned char* hm = (unsigned char*)(ws + WS_H) + (size_t)T * 512;
    unsigned char* kcb = (unsigned char*)(ws + WS_KC);
    const float* gates = (const float*)(ws + WS_GATES); bf16* mlc = (bf16*)(ws + WS_MLC) + (size_t)unit * 18432; float* mlb = (float*)(ws + WS_MLB);
    const int seq = unit >> 5, sj = unit & 31, b = seq >> 2, hh = seq & 3; const int tokbase = b * SEQ + sj * 512;
    LAS bf16* Qs = (LAS bf16*)(X.lds + ML_Q); LAS bf16* Ks = (LAS bf16*)(X.lds + ML_K); LAS bf16* KET = (LAS bf16*)(X.lds + ML_KET);
    LAS bf16* VT = (LAS bf16*)(X.lds + ML_VT); LAS bf16* CT = (LAS bf16*)(X.lds + ML_CT); LAS float* CW = (LAS float*)(X.lds + ML_CW);
    LAS float* CB = (LAS float*)(X.lds + ML_CB); LAS float* RED = (LAS float*)(X.lds + ML_RED); LAS float* NW = (LAS float*)(X.lds + ML_NW);
    LAS float* GT = (LAS float*)(X.lds + ML_GT);
    int lane = X.lane; asm volatile("" : "+v"(lane));
    const int c16 = lane & 15, quad = lane >> 4, w = X.wave;
    int tidl = X.tid; asm volatile("" : "+v"(tidl));
    const int tg = tidl >> 5, cg = tidl & 31, t0 = 4 * tg, c0 = 4 * cg;
    unsigned rq[7], rk[7], rv[4], kcv[4];
#define ML_LBAR() do { asm volatile("s_waitcnt lgkmcnt(0)" ::: "memory"); __builtin_amdgcn_s_barrier(); asm volatile("" ::: "memory"); } while (0)
#define ML_LOADRAW(tokc) do { _Pragma("unroll") for (int j = 0; j < 7; ++j) { const int tt = (tokc) + t0 - 3 + j; const bool ok = tt >= b * SEQ; const unsigned char* rp = (const unsigned char*)(proj + (size_t)(ok ? tt : (tokc)) * NPROJ) + 512 * ((L3 ? 3 : 5) + (hh >> 1)) + (hh & 1) * 128 + c0; \
        if (L3) rq[j] = *(const unsigned*)rp; else rk[j] = *(const unsigned*)rp; } \
        if (L3) { _Pragma("unroll") for (int i = 0; i < 4; ++i) kcv[i] = *(const unsigned*)(kcb + (size_t)((tokc) + t0 + i) * 512 + hh * 128 + c0); } \
        _Pragma("unroll") for (int i = 0; i < 4; ++i) rv[i] = *(const unsigned*)((const unsigned char*)(proj + (size_t)((tokc) + t0 + i) * NPROJ) + 512 * (7 + (hh >> 1)) + (hh & 1) * 128 + c0); } while (0)
    ML_LOADRAW(tokbase);
    { float cwv[3];
#pragma unroll
      for (int k3 = 0; k3 < 3; ++k3) { const int idx = (X.tid + 512 * k3 < 1280) ? (X.tid + 512 * k3) : 1279; const int tap = idx >> 8, ch = idx & 255; const int gch = (ch < 128) ? (hh * 128 + ch) : (512 + hh * 128 + (ch - 128));
          const float* cp = (tap < 4) ? (a.conv_w + (size_t)(l * 4 + tap) * 1024 + gch) : (a.conv_b + l * 1024 + gch); cwv[k3] = *cp; }
      const float nwv = a.mnw[l * 512 + hh * 128 + (X.tid & 127)];
      const float* gp = gates + (size_t)(tokbase + X.tid) * 8; const float g0v = gp[hh], g1v = gp[4 + hh];
      CW[X.tid] = cwv[0] * (1.0f / 16.0f); CW[512 + X.tid] = cwv[1] * (1.0f / 16.0f); if (X.tid < 256) CW[1024 + X.tid] = cwv[2];
      if (X.tid < 128) NW[X.tid] = nwv;
      GT[2 * X.tid] = g0v; GT[2 * X.tid + 1] = g1v; }
    for (int idx = X.tid; idx < 16 * 72; idx += 512) { const bf16 ov = (idx < 72) ? (bf16)0x3F80 : (bf16)0; VT[128 * 72 + idx] = ov; if (!L3) ((LAS bf16*)(X.lds + ML_CT))[128 * 72 + idx] = ov; }
    f32x4 cacc[9];
#pragma unroll
    for (int et = 0; et < 9; ++et) {
        if (L3) {
            { const v2u pw = *(const v2u*)(mlc + (16 * et + c16) * 128 + 16 * w + 4 * quad); cacc[et] = (f32x4){bflo(pw.x), bfhi(pw.x), bflo(pw.y), bfhi(pw.y)}; *(LAS v2u*)(CT + (16 * et + c16) * 136 + 16 * w + 4 * quad) = pw; }
        } else cacc[et] = (f32x4){0.f, 0.f, 0.f, 0.f};
    }
    float bsum = 0.f;
    __syncthreads();
#pragma unroll 1
    for (int c = 0; c < 8; ++c) {
        const int tok0 = tokbase + c * 64;
        LAS bf16* KETc = KET; LAS bf16* VTc = VT;
        const f32x2 gl = *(const LAS f32x2*)(GT + 2 * (c * 64 + lane)); float bsc = gl.y; const float li = gl.x;
#pragma unroll
        for (int o = 1; o < 64; o <<= 1) { const float v = shl_(bsc, (lane - o) & 63); if (lane >= o) bsc += v; }
        const float bl = shl_(bsc, 63); const float csv = li - bsc;
        if (w == 0) { CB[lane] = bsc; CB[64 + lane] = csv; }
        bsum += bl;
        const int tt_ = w & 3, eh = w >> 2; const int tq = 16 * tt_ + c16;
        unsigned ogv[4];
        if (L3) {
#pragma unroll
            for (int x = 0; x < 4; ++x) ogv[x] = *(const unsigned*)((const unsigned char*)(proj + (size_t)(tok0 + tq) * NPROJ) + 512 * (9 + (hh >> 1)) + (hh & 1) * 128 + 16 * (4 * eh + x) + 4 * quad); }
        { float fac[4];
#pragma unroll
          for (int i = 0; i < 4; ++i) fac[i] = __expf(bl + shl_(csv, t0 + i));
#pragma unroll
          for (int j = 0; j < 3; ++j) { const bool ok = tok0 + t0 - 3 + j >= b * SEQ;
              if (L3) rq[j] = ok ? rq[j] : 0u; else rk[j] = ok ? rk[j] : 0u; }
#pragma unroll
          for (int qk = (L3 ? 0 : 1); qk < 2; ++qk) {
              float o[4][4];
              if (L3 && qk) {
#pragma unroll
                  for (int i = 0; i < 4; ++i) { const f32x4 kf4 = fp8x4(kcv[i]) * (1.0f / 256.0f); o[i][0] = kf4[0]; o[i][1] = kf4[1]; o[i][2] = kf4[2]; o[i][3] = kf4[3]; }
              } else {
              const f32x4 bias = *(const LAS f32x4*)(CW + 4 * 256 + qk * 128 + c0);
#pragma unroll
              for (int i = 0; i < 4; ++i) { o[i][0] = bias.x; o[i][1] = bias.y; o[i][2] = bias.z; o[i][3] = bias.w; }
#pragma unroll
              for (int j = 0; j < 4; ++j) { const f32x4 wj = *(const LAS f32x4*)(CW + j * 256 + qk * 128 + c0);
#pragma unroll
                  for (int i = 0; i < 4; ++i) { const int rr = (int)(qk ? rk[i + j] : rq[i + j]);
                      o[i][0] += wj.x * __builtin_amdgcn_cvt_f32_fp8(rr, 0); o[i][1] += wj.y * __builtin_amdgcn_cvt_f32_fp8(rr, 1); o[i][2] += wj.z * __builtin_amdgcn_cvt_f32_fp8(rr, 2); o[i][3] += wj.w * __builtin_amdgcn_cvt_f32_fp8(rr, 3); } }
#pragma unroll
              for (int i = 0; i < 4; ++i)
#pragma unroll
                  for (int ch = 0; ch < 4; ++ch) { const float z = o[i][ch]; o[i][ch] = z * __builtin_amdgcn_rcpf(1.0f + __expf(-z)) * (qk ? 0.08838834764831845f : 1.0f); }
              }
              if (!L3 && qk) {
#pragma unroll
                  for (int i = 0; i < 4; ++i) { const unsigned pw = pk4_fp8(o[i][0] * 256.0f, o[i][1] * 256.0f, o[i][2] * 256.0f, o[i][3] * 256.0f); *(unsigned*)(kcb + (size_t)(tok0 + t0 + i) * 512 + hh * 128 + c0) = pw;
                      const f32x4 kf4 = fp8x4(pw) * (1.0f / 256.0f); o[i][0] = kf4[0]; o[i][1] = kf4[1]; o[i][2] = kf4[2]; o[i][3] = kf4[3]; } }
              if (L3) { LAS bf16* dst = (qk ? Ks : Qs) + t0 * 136 + c0;
#pragma unroll
                  for (int i = 0; i < 4; ++i) { v2u pw; pw.x = pk2(o[i][0], o[i][1]); pw.y = pk2(o[i][2], o[i][3]); *(LAS v2u*)(dst + i * 136) = pw; } }
              if (qk) {
#pragma unroll
                  for (int ch = 0; ch < 4; ++ch) { v2u pw; pw.x = pk2(o[0][ch] * fac[0], o[1][ch] * fac[1]); pw.y = pk2(o[2][ch] * fac[2], o[3][ch] * fac[3]); *(LAS v2u*)(KETc + (c0 + ch) * 72 + t0) = pw; } }
          }
          { v2u p0, p1, p2, p3;
            float vf[4][4];
#pragma unroll
            for (int i = 0; i < 4; ++i) { const int rr = (int)rv[i]; vf[i][0] = __builtin_amdgcn_cvt_f32_fp8(rr, 0); vf[i][1] = __builtin_amdgcn_cvt_f32_fp8(rr, 1); vf[i][2] = __builtin_amdgcn_cvt_f32_fp8(rr, 2); vf[i][3] = __builtin_amdgcn_cvt_f32_fp8(rr, 3); }
            p0.x = pk2(vf[0][0], vf[1][0]); p0.y = pk2(vf[2][0], vf[3][0]);
            p1.x = pk2(vf[0][1], vf[1][1]); p1.y = pk2(vf[2][1], vf[3][1]);
            p2.x = pk2(vf[0][2], vf[1][2]); p2.y = pk2(vf[2][2], vf[3][2]);
            p3.x = pk2(vf[0][3], vf[1][3]); p3.y = pk2(vf[2][3], vf[3][3]);
            *(LAS v2u*)(VTc + (c0 + 0) * 72 + t0) = p0; *(LAS v2u*)(VTc + (c0 + 1) * 72 + t0) = p1; *(LAS v2u*)(VTc + (c0 + 2) * 72 + t0) = p2; *(LAS v2u*)(VTc + (c0 + 3) * 72 + t0) = p3; }
        }
        ML_LBAR();
        if (c < 7) { ML_LOADRAW(tok0 + 64); }
        float hval[4][4];
        if (L3) {
            bf16x8 qf[4];
#pragma unroll
            for (int ks = 0; ks < 4; ++ks) qf[ks] = *(const LAS bf16x8*)(Qs + tq * 136 + 32 * ks + 8 * quad);
            f32x4 sacc[4];
#pragma unroll
            for (int st = 0; st < 4; ++st) { f32x4 z = {0.f, 0.f, 0.f, 0.f};
#pragma unroll
                for (int ks = 0; ks < 4; ++ks) z = __builtin_amdgcn_mfma_f32_16x16x32_bf16(*(const LAS bf16x8*)(Ks + (16 * st + c16) * 136 + 32 * ks + 8 * quad), qf[ks], z, 0, 0, 0);
                sacc[st] = z; }
            const float cbt = CB[tq];
            f32x4 csq[4];
#pragma unroll
            for (int st = 0; st < 4; ++st) csq[st] = *(const LAS f32x4*)(CB + 64 + 16 * st + 4 * quad);
#pragma unroll
            for (int st = 0; st < 4; ++st)
#pragma unroll
                for (int j = 0; j < 4; ++j) { const int s = 16 * st + 4 * quad + j; const float d = (s <= tq) ? __expf(cbt + csq[st][j]) : 0.f; sacc[st][j] *= d; }
            bf16x8 pf[2];
#pragma unroll
            for (int kk = 0; kk < 2; ++kk) { v4u pw; pw.x = pk2m(sacc[2 * kk][0], sacc[2 * kk][1]); pw.y = pk2m(sacc[2 * kk][2], sacc[2 * kk][3]); pw.z = pk2m(sacc[2 * kk + 1][0], sacc[2 * kk + 1][1]); pw.w = pk2m(sacc[2 * kk + 1][2], sacc[2 * kk + 1][3]); pf[kk] = __builtin_bit_cast(bf16x8, pw); }
            const float ebt = __expf(cbt);
            f32x4 nn[5];
#pragma unroll
            for (int x = 0; x < 5; ++x) { const int et = (x < 4) ? (4 * eh + x) : 8; f32x4 na = {0.f, 0.f, 0.f, 0.f}, ia = {0.f, 0.f, 0.f, 0.f};
#pragma unroll
                for (int kk = 0; kk < 2; ++kk) { const LAS bf16* vr = VT + (16 * et + c16) * 72 + 32 * kk + 4 * quad; const v2u lo = *(const LAS v2u*)vr, hi = *(const LAS v2u*)(vr + 16); v4u vw; vw.x = lo.x; vw.y = lo.y; vw.z = hi.x; vw.w = hi.y;
                    na = __builtin_amdgcn_mfma_f32_16x16x32_bf16(__builtin_bit_cast(bf16x8, vw), pf[kk], na, 0, 0, 0); }
#pragma unroll
                for (int ks = 0; ks < 4; ++ks) ia = __builtin_amdgcn_mfma_f32_16x16x32_bf16(*(const LAS bf16x8*)(CT + (16 * et + c16) * 136 + 32 * ks + 8 * quad), qf[ks], ia, 0, 0, 0);
                nn[x] = na + ia * ebt; }
            const float den = shl_(nn[4][0], c16); const float inv = __builtin_amdgcn_rcpf(fmaxf(fabsf(den), 1.0f)) * (1.0f / 16.0f);
            float ss = 0.f;
#pragma unroll
            for (int x = 0; x < 4; ++x)
#pragma unroll
                for (int j = 0; j < 4; ++j) { hval[x][j] = nn[x][j] * inv; ss += hval[x][j] * hval[x][j]; }
            ss += shx(ss, 16, lane); ss += shx(ss, 32, lane);
            if (quad == 0) RED[eh * 64 + tq] = ss;
        }
        { const float ebl = __expf(bl);
          bf16x8 kf[2];
#pragma unroll
          for (int kk = 0; kk < 2; ++kk) kf[kk] = *(const LAS bf16x8*)(KETc + (16 * w + c16) * 72 + 32 * kk + 8 * quad);
#pragma unroll
          for (int et = 0; et < 9; ++et) { f32x4 z = cacc[et] * ebl;
#pragma unroll
              for (int kk = 0; kk < 2; ++kk) z = __builtin_amdgcn_mfma_f32_16x16x32_bf16(kf[kk], *(const LAS bf16x8*)(VTc + (16 * et + c16) * 72 + 32 * kk + 8 * quad), z, 0, 0, 0);
              cacc[et] = z; } }
        if (L3) {
            ML_LBAR();
            const float rstd = __builtin_amdgcn_rsqf((RED[tq] + RED[64 + tq]) * (1.0f / 128.0f) + EPS);
#pragma unroll
            for (int x = 0; x < 4; ++x) { const int e = 16 * (4 * eh + x) + 4 * quad; const f32x4 og = u8x4_to_f32(ogv[x]) * (1.0f / 255.0f);
                const float y0 = hval[x][0] * rstd * NW[e] * og[0], y1 = hval[x][1] * rstd * NW[e + 1] * og[1], y2 = hval[x][2] * rstd * NW[e + 2] * og[2], y3 = hval[x][3] * rstd * NW[e + 3] * og[3];
                *(unsigned*)(hm + (size_t)(tok0 + tq) * 512 + hh * 128 + e) = pk4_fp8(y0 * 8.0f, y1 * 8.0f, y2 * 8.0f, y3 * 8.0f); }
#pragma unroll
            for (int et = 0; et < 9; ++et) { const f32x4 z = cacc[et]; v2u pw; pw.x = pk2(z[0], z[1]); pw.y = pk2(z[2], z[3]); *(LAS v2u*)(CT + (16 * et + c16) * 136 + 16 * w + 4 * quad) = pw; }
        }
        else ML_LBAR();
    }
#undef ML_LOADRAW
#undef ML_LBAR
    if (!L3) {
#pragma unroll
        for (int et = 0; et < 9; ++et)
            { v2u pw; pw.x = pk2(cacc[et][0], cacc[et][1]); pw.y = pk2(cacc[et][2], cacc[et][3]); *(v2u*)(mlc + (16 * et + c16) * 128 + 16 * w + 4 * quad) = pw; }
        if (X.tid == 0) mlb[unit] = bsum;
    }
}
DI void mlstm_scan(const Args& a, const Ctx& X) {
    bf16* mlc = (bf16*)(a.ws + WS_MLC); const float* mlb = (const float*)(a.ws + WS_MLB);
    for (int idx = X.bid * 512 + X.tid; idx < 8 * 9216; idx += X.G * 512) { const int seq = idx / 9216, el = 2 * (idx - seq * 9216); float cz = 0.f; asm volatile("" : "+v"(cz)); f32x2 carry = {cz, cz};
        bf16* p0 = mlc + (size_t)seq * 32 * 18432 + el; unsigned v[32]; float dcy[32];
#pragma unroll
        for (int j = 0; j < 32; ++j) { v[j] = *(const unsigned*)(p0 + (size_t)j * 18432); dcy[j] = mlb[seq * 32 + j]; }
#pragma unroll
        for (int j = 0; j < 32; ++j) { *(unsigned*)(p0 + (size_t)j * 18432) = pk2(carry.x, carry.y); const f32x2 vj = {bflo(v[j]), bfhi(v[j])}; carry = carry * __expf(dcy[j]) + vj; } }
}

constexpr int P6_WR = 0, P6_AT = 33024, P6_SH = 37120, P6_LG = 41216, P6_HIST = 65536;
DI void p6_norm_route(const Args& a, const Ctx& X, int l, const bf16* xin) {
    unsigned char* ws = a.ws;
    LAS bf16* wrb = (LAS bf16*)(X.lds + P6_WR);
    LAS float* at = (LAS float*)(X.lds + P6_AT); LAS float* sht = (LAS float*)(X.lds + P6_SH);
    LAS float* lg = (LAS float*)(X.lds + P6_LG) + X.wave * 272;
    { f32x4 rw[8];
#pragma unroll
      for (int i = 0; i < 8; ++i) rw[i] = *(const f32x4*)(a.router_w + 4 * (X.tid + 512 * i));
#pragma unroll
      for (int i = 0; i < 8; ++i) { const int i4 = X.tid + 512 * i; const int k = i4 >> 2, e0 = (i4 & 3) * 4;
          wrb[(e0 + 0) * 1032 + k] = (bf16)f2bf(rw[i].x); wrb[(e0 + 1) * 1032 + k] = (bf16)f2bf(rw[i].y); wrb[(e0 + 2) * 1032 + k] = (bf16)f2bf(rw[i].z); wrb[(e0 + 3) * 1032 + k] = (bf16)f2bf(rw[i].w); } }
    const float* mod = (const float*)(ws + WS_MOD); unsigned char* hb = (unsigned char*)(ws + WS_H); float* tgate = (float*)(ws + WS_TGATE); int* tokl = (int*)(ws + WS_TOKL);
    const float* ssq = (const float*)(ws + WS_SSQ);
    unsigned* cnt = (unsigned*)(ws + WS_CTL) + CW_CNT + l * 2048;
    LAS int* hist = (LAS int*)(X.lds + P6_HIST); LAS int* cbase = hist + 32;
    int lane = X.lane; asm volatile("" : "+v"(lane));
    const int r = lane & 15, q = lane >> 4;
    const int gw = X.bid * 8 + X.wave, NGW = X.G * 8;
    for (int it = 0; it * NGW < T / 16; ++it) {
        const int rg = it * NGW + gw; const bool act = rg < T / 16;
        const int row0 = (act ? rg : 0) * 16; const int bb = ((it * NGW + X.bid * 8) * 16) >> 14;
        __syncthreads();
        if (X.tid < 32) hist[X.tid] = 0;
        { const float* mb = mod + (size_t)(l * 2 + (bb < 2 ? bb : 1)) * 6144;
          const float n0 = a.nfw[l * D + X.tid], n1 = a.nfw[l * D + 512 + X.tid], c0 = mb[4 * 1024 + X.tid], c1 = mb[4 * 1024 + 512 + X.tid], s0 = mb[3 * 1024 + X.tid], s1 = mb[3 * 1024 + 512 + X.tid];
          at[X.tid] = n0 * (1.0f + c0); at[512 + X.tid] = n1 * (1.0f + c1); sht[X.tid] = s0; sht[512 + X.tid] = s1; }
        __syncthreads();
        const int row = row0 + r;
        float rstd;
        { const f32x4 pp = *(const f32x4*)(ssq + (size_t)row * 16 + 4 * q); float ss = (pp.x + pp.y) + (pp.z + pp.w); ss += shx(ss, 16, lane); ss += shx(ss, 32, lane); rstd = __builtin_amdgcn_rsqf(ss * (1.0f / D) + EPS); }
        const bf16* xr = xin + (size_t)row * D + 8 * q; unsigned char* hr = hb + (size_t)row * D + 8 * q;
        f32x4 acc = {0.f, 0.f, 0.f, 0.f};
#pragma unroll 1
        for (int sb = 0; sb < 32; sb += 8) {
            v4u xb8[8];
#pragma unroll
            for (int i = 0; i < 8; ++i) xb8[i] = *(const v4u*)(xr + 32 * (sb + i));
            asm volatile("" ::: "memory");
#pragma unroll
            for (int i = 0; i < 8; ++i) { const int s = sb + i; const v4u xw = xb8[i];
                const f32x4 x0 = {bflo(xw.x), bfhi(xw.x), bflo(xw.y), bfhi(xw.y)}, x1 = {bflo(xw.z), bfhi(xw.z), bflo(xw.w), bfhi(xw.w)};
                const f32x4 a0 = *(const LAS f32x4*)(at + 32 * s + 8 * q), a1 = *(const LAS f32x4*)(at + 32 * s + 8 * q + 4);
                const f32x4 s0 = *(const LAS f32x4*)(sht + 32 * s + 8 * q), s1 = *(const LAS f32x4*)(sht + 32 * s + 8 * q + 4);
                const f32x4 h0 = x0 * rstd * a0 + s0, h1 = x1 * rstd * a1 + s1;
                v4u w; w.x = pk2m(h0.x, h0.y); w.y = pk2m(h0.z, h0.w); w.z = pk2m(h1.x, h1.y); w.w = pk2m(h1.z, h1.w);
                { v2u w8; w8.x = pk4_fp8(h0.x, h0.y, h0.z, h0.w); w8.y = pk4_fp8(h1.x, h1.y, h1.z, h1.w); *(v2u*)(hr + 32 * s) = w8; }
                const bf16x8 bfr = *(const LAS bf16x8*)(wrb + r * 1032 + 32 * s + 8 * q);
                acc = __builtin_amdgcn_mfma_f32_16x16x32_bf16(__builtin_bit_cast(bf16x8, w), bfr, acc, 0, 0, 0); }
        }
#pragma unroll
        for (int j = 0; j < 4; ++j) lg[(4 * q + j) * 17 + r] = acc[j];
        LDS_WAIT(); asm volatile("" ::: "memory");
        int my_cls = 0; float my_ga = 0.f, my_gb = 0.f;
        if (lane < 16) {
            float sc[16], sel[16];
#pragma unroll
            for (int e = 0; e < 16; ++e) { const float p = lg[lane * 17 + e]; sc[e] = 1.0f / (1.0f + __expf(-p)); sel[e] = sc[e] + a.router_b[e]; }
            int gi = 0; float gbest = -1.0e30f;
#pragma unroll
            for (int g = 0; g < 4; ++g) { const float p0 = sel[4 * g], p1 = sel[4 * g + 1], p2 = sel[4 * g + 2], p3 = sel[4 * g + 3];
                const float gs = fmaxf(fmaxf(fmaxf(p0 + p1, p0 + p2), fmaxf(p0 + p3, p1 + p2)), fmaxf(p1 + p3, p2 + p3));
                if (gs > gbest) { gbest = gs; gi = g; } }
            float qs[4], s4[4];
#pragma unroll
            for (int i = 0; i < 4; ++i) { qs[i] = 0.f; s4[i] = 0.f; }
#pragma unroll
            for (int g = 0; g < 4; ++g) if (g == gi) {
#pragma unroll
                for (int i = 0; i < 4; ++i) { qs[i] = sel[4 * g + i]; s4[i] = sc[4 * g + i]; } }
            int i1 = 0; float b1 = qs[0];
#pragma unroll
            for (int i = 1; i < 4; ++i) if (qs[i] > b1) { b1 = qs[i]; i1 = i; }
            int i2 = -1; float b2 = -1.0e30f;
#pragma unroll
            for (int i = 0; i < 4; ++i) if (i != i1 && qs[i] > b2) { b2 = qs[i]; i2 = i; }
            const int ia = (i1 < i2) ? i1 : i2, ib = (i1 < i2) ? i2 : i1;
            float sa = 0.f, sb = 0.f;
#pragma unroll
            for (int i = 0; i < 4; ++i) { if (i == ia) sa = s4[i]; if (i == ib) sb = s4[i]; }
            const int pidx = (ia == 0) ? (ib - 1) : ((ia == 1) ? (ib + 1) : 5);
            const float inv = 1.0f / (sa + sb);
            my_cls = gi * 6 + pidx; my_ga = sa * inv; my_gb = sb * inv;
        }
        int rank = 0;
        if (act && lane < 16) rank = __hip_atomic_fetch_add(hist + my_cls, 1, __ATOMIC_RELAXED, __HIP_MEMORY_SCOPE_WORKGROUP);
        __syncthreads();
        if (X.tid < NCLS) { const int n = hist[X.tid]; cbase[X.tid] = n ? (int)__hip_atomic_fetch_add(cnt + 64 * X.tid, (unsigned)n, RLX_AGENT) : 0; }
        __syncthreads();
        if (act && lane < 16) { const int tok = row0 + lane; const int pos = cbase[my_cls] + rank;
            tokl[my_cls * CLS_CAP + pos] = tok; tgate[tok * 2] = my_ga; tgate[tok * 2 + 1] = my_gb; }
    }
}
DI MoeTab moe_tables(const Args& a, const Ctx& X, int l) {
    LAS int* tab = (LAS int*)(X.lds + TAB_OFF); LAS int* tcls = tab; LAS int* tpos = tab + 160; LAS int* cn = tab + 320; LAS int* rt_ = tab + 344;
    unsigned* cnt = (unsigned*)(a.ws + WS_CTL) + CW_CNT + l * 2048;
    if (X.tid < NCLS) cn[X.tid] = (int)__hip_atomic_load(cnt + 64 * X.tid, RLX_AGENT);
    __syncthreads();
    if (X.tid < NCLS) {
        int base = 0;
#pragma unroll 1
        for (int c = 0; c < X.tid; ++c) base += (cn[c] + 255) >> 8;
        const int n = (cn[X.tid] + 255) >> 8;
#pragma unroll 1
        for (int i = 0; i < n; ++i) { tcls[base + i] = X.tid; tpos[base + i] = i * 256; }
        if (X.tid == NCLS - 1) rt_[0] = base + n; }
    __syncthreads();
    MoeTab tb; tb.tcls = tcls; tb.tpos = tpos; tb.cnt = cn; tb.Rtot = __builtin_amdgcn_readfirstlane(rt_[0]); return tb;
}

#if defined(__HIP_DEVICE_COMPILE__)
DI Args load_args() { auto p = __builtin_amdgcn_kernarg_segment_ptr(); asm volatile("" : "+s"(p)); return *(const __attribute__((address_space(4))) Args*)p; }
#else
DI Args load_args() { return Args{}; }
#endif
__global__ void __launch_bounds__(512, 2) fwd(Args a_unused) {
    extern __shared__ __attribute__((aligned(16))) unsigned char lds_raw[];
    Ctx X; X.lds = (LAS unsigned char*)lds_raw; X.tid = threadIdx.x; X.lane = X.tid & 63; X.wave = __builtin_amdgcn_readfirstlane(X.tid >> 6); X.G = gridDim.x; X.bid = blockIdx.x;
    volatile LAS unsigned* MISC = (volatile LAS unsigned*)(X.lds + MISC_OFF);
    if (X.tid < 64) MISC[X.tid] = 0u;
    __syncthreads();
    int lo, hi; unsigned* ctl;
    { const Args a = load_args(); lo = a.ph_lo; hi = a.ph_hi; ctl = (unsigned*)(a.ws + WS_CTL); }
    XcdBarrier bar; bar.bar = ctl + CW_BAR; bar.x = 0; bar.st = MISC + 8;
    if (hi - lo > 1) bar = xcd_barrier_post(ctl + CW_BAR, MISC + 8);
#ifndef PH_MASK
#define PH_MASK 0xFFFFF
#endif
#define PON(p) ((PH_MASK >> (p)) & 1)
#ifndef DUP_MASK
#define DUP_MASK 0
#endif
#define NREP(p) (((DUP_MASK >> (p)) & 1) ? 2 : 1)
#ifndef NULEPI
#define NULEPI 0
#endif
#ifndef TSEL_MASK
#define TSEL_MASK 0
#endif
#define TSCALE 4
#define TSEL(p) ((TSEL_MASK >> (p)) & 1)
#define IN(k) (lo <= (k) && (k) < hi)
#define SEAM(k) do { if (IN(k) && IN((k) + 1)) xcd_barrier(bar); } while (0)
    unsigned long long tacc = 0ull, tph = 0ull;
#define TBEG() do { if (TSEL_MASK) tph = __builtin_amdgcn_s_memrealtime(); } while (0)
#define TEND(p) do { if (TSEL(p)) tacc += __builtin_amdgcn_s_memrealtime() - tph; } while (0)
    TBEG();
    if (PON(10) && IN(0)) { for (int rep = 0; rep < NREP(10); ++rep) { const Args a = load_args(); p0_prologue(a, X); } }
    SEAM(0); TEND(10);
    TBEG();
    for (int l = 0; l < NL; ++l) {
        const int g0 = 1 + l * NPH;
        if (PON(0) && IN(g0 + 0)) { for (int rep = 0; rep < NREP(0); ++rep) { const Args a = load_args(); unsigned char* ws = a.ws; const float* mod = (const float*)(ws + WS_MOD); bf16* proj = (bf16*)(ws + WS_PROJ); bf16* xb = (bf16*)(ws + WS_XB); (void)mod; (void)proj; (void)xb; const Ctx P = fresh(X); p1_norm_gates(a, P, l, xb); } }
        SEAM(g0 + 0); TEND(0); TBEG();
        if (PON(1) && IN(g0 + 1)) for (int rep = 0; rep < NREP(1); ++rep) { const Args a = load_args(); unsigned char* ws = a.ws; const float* mod = (const float*)(ws + WS_MOD); bf16* proj = (bf16*)(ws + WS_PROJ); bf16* xb = (bf16*)(ws + WS_XB); (void)mod; (void)proj; (void)xb; const Ctx P = fresh(X);
            DenseSched S; S.A = (const char*)(ws + WS_H); S.Bt = (const char*)(ws + WS_WIN) + (size_t)l * NPROJW * D; S.lda = D; S.ldb = D; S.ord.init(T / 256, NPROJW / 256, P.G, P.bid, 2);
            EpiProj E; E.O = proj; E.gates = (float*)(ws + WS_GATES); E.big = a.b_ig + l * 4; E.bfg = a.b_fg + l * 4; E.nul = (rep == 0 && NREP(1) == 2 && (NULEPI == 1 || NULEPI == 3)) ? NULEPI : 0; E.rwrap = (rep == 0 && NREP(1) == 2 && NULEPI == 2) ? 255 : 0x7fffffff;
#ifndef STAGGER_TICKS
#define STAGGER_TICKS 0
#endif
            if (STAGGER_TICKS && ((P.bid >> 3) & 1)) { const unsigned long long t0 = __builtin_amdgcn_s_memrealtime(); while (__builtin_amdgcn_s_memrealtime() - t0 < STAGGER_TICKS) __builtin_amdgcn_s_sleep(4); }
            pg8::gemm_phase<EpiProj, DenseSched, true>(P.lds, D, S, E);
        }
        SEAM(g0 + 1); TEND(1); TBEG();
        if (PON(2) && IN(g0 + 2)) { const Args a = load_args(); unsigned char* ws = a.ws; const float* mod = (const float*)(ws + WS_MOD); bf16* proj = (bf16*)(ws + WS_PROJ); bf16* xb = (bf16*)(ws + WS_XB); (void)mod; (void)proj; (void)xb; const Ctx P = fresh(X);
            if (PON(11)) for (int rep = 0; rep < NREP(11); ++rep) {
#pragma unroll 1
                for (int u = P.bid; u < 512; u += P.G) attn_unit(a, P, l, u); }
            if (PON(12)) for (int rep = 0; rep < NREP(12); ++rep) {
#pragma unroll 1
                for (int u = P.bid; u < 256; u += P.G) mlstm_unit<false>(a, P, l, u); }
        }
        SEAM(g0 + 2); TEND(2); TBEG();
        if (PON(3) && IN(g0 + 3)) { const Args a = load_args(); unsigned char* ws = a.ws; const float* mod = (const float*)(ws + WS_MOD); bf16* proj = (bf16*)(ws + WS_PROJ); bf16* xb = (bf16*)(ws + WS_XB); (void)mod; (void)proj; (void)xb; const Ctx P = fresh(X); mlstm_scan(a, P); }
        SEAM(g0 + 3); TEND(3); TBEG();
        if (PON(4) && IN(g0 + 4)) for (int rep = 0; rep < NREP(4); ++rep) { const Args a = load_args(); unsigned char* ws = a.ws; const float* mod = (const float*)(ws + WS_MOD); bf16* proj = (bf16*)(ws + WS_PROJ); bf16* xb = (bf16*)(ws + WS_XB); (void)mod; (void)proj; (void)xb; const Ctx P = fresh(X);
#pragma unroll 1
            for (int u = P.bid; u < 256; u += P.G) mlstm_unit<true>(a, P, l, u); }
        SEAM(g0 + 4); TEND(4); TBEG();
        if (PON(5) && IN(g0 + 5)) for (int rep = 0; rep < NREP(5); ++rep) { const Args a = load_args(); unsigned char* ws = a.ws; const float* mod = (const float*)(ws + WS_MOD); bf16* proj = (bf16*)(ws + WS_PROJ); bf16* xb = (bf16*)(ws + WS_XB); (void)mod; (void)proj; (void)xb; const Ctx P = fresh(X);
            MergeSched S; S.A0 = (const char*)(ws + WS_H); S.A1 = (const char*)(ws + WS_H) + (size_t)T * 512; S.B0 = (const char*)(ws + WS_WAU) + (size_t)l * D * 512; S.B1 = (const char*)(ws + WS_WMU) + (size_t)l * D * 512;
            S.lda = 512; S.ldb = 512; S.ord.init(T / 256, D / 256, P.G, P.bid);
            EpiMerge E; E.P = proj; E.nul = (rep == 0 && NREP(5) == 2) ? NULEPI : 0; pg8::gemm_phase<EpiMerge, MergeSched, true>(P.lds, 1024, S, E);
        }
        SEAM(g0 + 5); TEND(5); TBEG();
        if (PON(6) && IN(g0 + 6)) for (int rep = 0; rep < NREP(6); ++rep) { const Args a = load_args(); unsigned char* ws = a.ws; const float* mod = (const float*)(ws + WS_MOD); bf16* proj = (bf16*)(ws + WS_PROJ); bf16* xb = (bf16*)(ws + WS_XB); (void)mod; (void)proj; (void)xb; const Ctx P = fresh(X);
            DenseSched S; S.A = (const char*)(proj + C_MQ); S.Bt = (const char*)(ws + WS_WOUT) + (size_t)l * D * D; S.lda = NPROJ * 2; S.ldb = D; S.ord.init(T / 256, D / 256, P.G, P.bid);
            EpiRes E; E.xin = xb; E.out = xb; E.g = mod + (size_t)(l * 2) * 6144 + 2 * 1024; E.ssq = (float*)(ws + WS_SSQ); E.rmask = T - 1; E.nul = 0;
            if (rep) { E.out = (bf16*)(ws + WS_H); E.rmask = T / 2 - 1; E.nul = NULEPI; }
            pg8::gemm_phase<EpiRes, DenseSched, true>(P.lds, D, S, E);
        }
        SEAM(g0 + 6); TEND(6); TBEG();
        if (PON(7) && IN(g0 + 7)) { const Args a = load_args(); unsigned char* ws = a.ws; const float* mod = (const float*)(ws + WS_MOD); bf16* proj = (bf16*)(ws + WS_PROJ); bf16* xb = (bf16*)(ws + WS_XB); (void)mod; (void)proj; (void)xb; const Ctx P = fresh(X); p6_norm_route(a, P, l, xb); }
        SEAM(g0 + 7); TEND(7); TBEG();
        if (PON(8) && IN(g0 + 8)) for (int rep = 0; rep < NREP(8); ++rep) { const Args a = load_args(); unsigned char* ws = a.ws; const float* mod = (const float*)(ws + WS_MOD); bf16* proj = (bf16*)(ws + WS_PROJ); bf16* xb = (bf16*)(ws + WS_XB); (void)mod; (void)proj; (void)xb; const Ctx P = fresh(X);
            const MoeTab tb = moe_tables(a, P, l);
            LAS unsigned* tokoff = (LAS unsigned*)(P.lds + TOKOFF_OFF); const int* tokl = (const int*)(ws + WS_TOKL);
#pragma unroll 1
            for (int s = 0; s < 8; ++s) { const int L0 = s * P.G + P.bid;
                if (L0 < tb.Rtot * 8 && P.tid < 256) { const int L = xcd_remap(L0, tb.Rtot * 8); const int rt = L >> 3, cls = tb.tcls[rt], pos = tb.tpos[rt] + P.tid, cn = tb.cnt[cls]; const int tok = tokl[cls * CLS_CAP + (pos < cn ? pos : 0)]; tokoff[s * 256 + P.tid] = (unsigned)tok; } }
            __syncthreads();
            MoeUpSched S; S.A = (const char*)(ws + WS_H); S.W = (const char*)(ws + WS_WGU) + (size_t)l * NE * 1024 * D; S.lda = D; S.ldb = D; S.tb = tb; S.G = P.G; S.c = P.bid; S.tokoff = tokoff;
            EpiSwiglu E; E.H = (unsigned char*)proj; E.tgate = (const float*)(ws + WS_TGATE); E.tokoff = tokoff;
            pg8::gemm_phase<EpiSwiglu, MoeUpSched, true>(P.lds, D, S, E);
        }
        SEAM(g0 + 8); TEND(8); TBEG();
        if (PON(9) && IN(g0 + 9)) for (int rep = 0; rep < NREP(9); ++rep) { const Args a = load_args(); unsigned char* ws = a.ws; const float* mod = (const float*)(ws + WS_MOD); bf16* proj = (bf16*)(ws + WS_PROJ); bf16* xb = (bf16*)(ws + WS_XB); (void)mod; (void)proj; (void)xb; const Ctx P = fresh(X);
            const MoeTab tb = moe_tables(a, P, l);
            MoeDownSched S; S.A = (const char*)proj; S.W = (const char*)(ws + WS_WD) + (size_t)l * NE * 1024 * FF; S.lda = D; S.ldb = FF; S.tb = tb; S.G = P.G; S.c = P.bid;
            EpiMoeOut E; E.xin = xb; E.outb = xb; E.outf = a.out; E.last = (l == NL - 1); E.g = mod + (size_t)(l * 2) * 6144 + 5 * 1024; E.tokl = (const int*)(ws + WS_TOKL); E.tb = tb; E.rmask = T - 1;
            if (rep) { E.outb = (bf16*)(ws + WS_H); E.last = 0; E.rmask = T / 2 - 1; }
            pg8::gemm_phase<EpiMoeOut, MoeDownSched, true>(P.lds, D, S, E);
        }
        SEAM(g0 + 9); TEND(9); TBEG();
    }
    if (TSEL_MASK && X.bid == 0) { const unsigned long long t1 = __builtin_amdgcn_s_memrealtime(); while (__builtin_amdgcn_s_memrealtime() - t1 < TSCALE * tacc) __builtin_amdgcn_s_sleep(8); }
#undef IN
#undef SEAM
}

extern "C" void kernel_launch(void* const* d_in, const int* in_sizes, int n_in, void* d_out, int out_size, void* d_ws, size_t ws_size, hipStream_t stream) {
    static int grid = 0;
    if (grid == 0) {
        if (n_in != 24 || in_sizes[0] != T * D || out_size != T * D || ws_size < WS_END) { fprintf(stderr, "kernel_launch: unexpected shapes / workspace (n_in %d, ws %zu, need %zu)\n", n_in, ws_size, (size_t)WS_END); grid = -1; return; }
        int dev = 0, cus = 0;
        if (hipGetDevice(&dev) != hipSuccess || hipDeviceGetAttribute(&cus, hipDeviceAttributeMultiprocessorCount, dev) != hipSuccess) { grid = -1; return; }
        if (hipFuncSetAttribute((const void*)fwd, hipFuncAttributeMaxDynamicSharedMemorySize, LDS_BYTES) != hipSuccess) { fprintf(stderr, "kernel_launch: hipFuncSetAttribute failed\n"); grid = -1; return; }
        int per_cu = 0;
        if (hipOccupancyMaxActiveBlocksPerMultiprocessor(&per_cu, (const void*)fwd, 512, LDS_BYTES) != hipSuccess || per_cu < 1) fprintf(stderr, "kernel_launch: occupancy query reports %d\n", per_cu);
        (void)hipGetLastError();
        grid = cus < 256 ? cus : 256;
    }
    if (grid < 0) return;
    (void)hipMemsetAsync((char*)d_ws + WS_CTL, 0, CTL_ZERO_BYTES, stream);
    Args a{};
    a.x = (const float*)d_in[0]; a.c = (const float*)d_in[1]; a.pos = (const int*)d_in[2]; a.ada_w = (const float*)d_in[3]; a.ada_b = (const float*)d_in[4];
    a.nmw = (const float*)d_in[5]; a.nfw = (const float*)d_in[6]; a.w_in = (const float*)d_in[7]; a.b_ig = (const float*)d_in[8]; a.b_fg = (const float*)d_in[9];
    a.qnw = (const float*)d_in[10]; a.knw = (const float*)d_in[11]; a.sinks = (const float*)d_in[12]; a.conv_w = (const float*)d_in[13]; a.conv_b = (const float*)d_in[14];
    a.mnw = (const float*)d_in[15]; a.w_au = (const float*)d_in[16]; a.w_mu = (const float*)d_in[17]; a.w_out = (const float*)d_in[18]; a.router_w = (const float*)d_in[19];
    a.router_b = (const float*)d_in[20]; a.w_gate = (const float*)d_in[21]; a.w_up = (const float*)d_in[22]; a.w_down = (const float*)d_in[23];
    a.out = (float*)d_out; a.ws = (unsigned char*)d_ws;
#if MK_MULTI
    for (int gp = 0; gp < NGP; ++gp) { a.ph_lo = gp; a.ph_hi = gp + 1; hipLaunchKernelGGL(fwd, dim3(grid), dim3(512), LDS_BYTES, stream, a); }
#else
    a.ph_lo = 0; a.ph_hi = NGP; hipLaunchKernelGGL(fwd, dim3(grid), dim3(512), LDS_BYTES, stream, a);
#endif
}
```

```cpp
#include <hip/hip_runtime.h>
#include <cstdio>
#include <cstdint>

#ifndef MK_MULTI
#define MK_MULTI 0
#endif

#define GAS __attribute__((address_space(1)))
#define LAS __attribute__((address_space(3)))
typedef unsigned short bf16;
typedef unsigned v4u __attribute__((ext_vector_type(4)));
typedef unsigned v2u __attribute__((ext_vector_type(2)));
typedef float f32x4 __attribute__((ext_vector_type(4)));
typedef float f32x2 __attribute__((ext_vector_type(2)));
typedef short bf16x8 __attribute__((ext_vector_type(8)));
typedef short bf16x4 __attribute__((ext_vector_type(4)));
#define DI __device__ __forceinline__
#define RLX_AGENT __ATOMIC_RELAXED, __HIP_MEMORY_SCOPE_AGENT
#define LDS_WAIT() asm volatile("s_waitcnt lgkmcnt(0)" ::: "memory")
#define VM_WAIT() asm volatile("s_waitcnt vmcnt(0)" ::: "memory")

constexpr int NB = 2, SEQ = 16384, T = NB * SEQ, D = 1024, NL = 4;
constexpr int DIN_SRC = 4872;
constexpr int NPROJ = 4864;
constexpr int C_AQ = 0, C_AK = 512, C_AV = 640, C_MQ = 768, C_MK = 1280, C_MV = 1792, C_MO = 2304, C_GA = 2816, C_GB = 3840;
constexpr int NE = 16, FF = 512;
constexpr int NCLS = 24, CLS_CAP = 32768;
constexpr float EPS = 1e-6f;
constexpr int NPH = 10;
constexpr int NGP = 1 + NL * NPH;

constexpr size_t MiB = 1u << 20;
constexpr size_t WS_CTL = 0, CTL_ZERO_BYTES = 128 * 1024;
constexpr size_t WS_MOD = 1 * MiB;
constexpr size_t WS_ROPE = 2 * MiB;
constexpr size_t WS_GATES = 4 * MiB;
constexpr size_t WS_TGATE = 5 * MiB;
constexpr size_t WS_TOKL = 6 * MiB;
constexpr size_t WS_MLB = 9 * MiB;
constexpr size_t WS_MLC = 10 * MiB;
constexpr int NPROJW = 5120;
constexpr size_t WS_WIN = 28 * MiB;
constexpr size_t WS_WAU = 68 * MiB;
constexpr size_t WS_WMU = 72 * MiB;
constexpr size_t WS_WOUT = 76 * MiB;
constexpr size_t WS_WGU = 84 * MiB;
constexpr size_t WS_WD = 148 * MiB;
constexpr size_t WS_H = 212 * MiB;
constexpr size_t WS_PROJ = 276 * MiB;
constexpr size_t WS_SSQ = 580 * MiB;
constexpr size_t WS_KC = 582 * MiB;
constexpr size_t WS_XB = 614 * MiB;
constexpr size_t WS_END = 678 * MiB;

constexpr int CW_TMO = 0;
constexpr int CW_BAR = 4096;
constexpr int CW_CNT = 8192;

constexpr int RING_BYTES = 131072;
constexpr int MISC_OFF = RING_BYTES;
constexpr int TAB_OFF = RING_BYTES + 256;
constexpr int TOKOFF_OFF = RING_BYTES + 2048;
constexpr int LDS_BYTES = 147456;

typedef __bf16 bf16x2_t __attribute__((ext_vector_type(2)));
DI unsigned cvt_pk_bf16(float lo, float hi) { const f32x2 v = {lo, hi}; return __builtin_bit_cast(unsigned, __builtin_convertvector(v, bf16x2_t)); }
DI unsigned pk2m(float lo, float hi) { return cvt_pk_bf16(lo, hi); }
DI unsigned f2bf(float f) { return cvt_pk_bf16(f, 0.f) & 0xffffu; }
DI unsigned pk2(float lo, float hi) { return cvt_pk_bf16(lo, hi); }
DI float bf2f(unsigned short b) { return __builtin_bit_cast(float, ((unsigned)b) << 16); }
DI float bflo(unsigned w) { return __builtin_bit_cast(float, w << 16); }
DI float bfhi(unsigned w) { return __builtin_bit_cast(float, w & 0xffff0000u); }
DI float shx(float v, int m, int lane) { return __builtin_bit_cast(float, __builtin_amdgcn_ds_bpermute((lane ^ m) << 2, __builtin_bit_cast(int, v))); }
DI float shl_(float v, int src) { return __builtin_bit_cast(float, __builtin_amdgcn_ds_bpermute(src << 2, __builtin_bit_cast(int, v))); }
DI float wave_sum(float v, int lane) {
#pragma unroll
    for (int o = 1; o < 64; o <<= 1) v += shx(v, o, lane);
    return v;
}
DI f32x4 fp8x4(unsigned w) { const int i = (int)w; return (f32x4){__builtin_amdgcn_cvt_f32_fp8(i, 0), __builtin_amdgcn_cvt_f32_fp8(i, 1), __builtin_amdgcn_cvt_f32_fp8(i, 2), __builtin_amdgcn_cvt_f32_fp8(i, 3)}; }
DI unsigned pk4_fp8(float a0, float a1, float a2, float a3) { int p = __builtin_amdgcn_cvt_pk_fp8_f32(a0, a1, 0, false); p = __builtin_amdgcn_cvt_pk_fp8_f32(a2, a3, p, true); return (unsigned)p; }
DI f32x4 u8x4_to_f32(unsigned w) { return (f32x4){(float)(w & 0xffu), (float)((w >> 8) & 0xffu), (float)((w >> 16) & 0xffu), (float)(w >> 24)}; }
DI unsigned f32_to_u8x4(float a0, float a1, float a2, float a3) { int p = __builtin_amdgcn_cvt_pk_u8_f32(a0, 0, 0); p = __builtin_amdgcn_cvt_pk_u8_f32(a1, 1, p); p = __builtin_amdgcn_cvt_pk_u8_f32(a2, 2, p); p = __builtin_amdgcn_cvt_pk_u8_f32(a3, 3, p); return (unsigned)p; }
DI float sigmoidf_(float x) { return __builtin_amdgcn_rcpf(1.0f + __expf(-x)); }

#define XB_TMO      128
#define XB_XCNT(j)  (256  + 64 * (j))
#define XB_XSUB(j)  (1280 + 64 * (j))
#define XB_XGEN(j)  (2304 + 64 * (j))
#define XB_TOP      3328
#define XB_TOPGEN   3392
#define XCD_BAR_WORDS 3456
#define XB_SPIN_CAP (1u << 18)
__device__ __forceinline__ unsigned xb_ld(unsigned* p)              { return __hip_atomic_load(p, __ATOMIC_RELAXED, __HIP_MEMORY_SCOPE_AGENT); }
__device__ __forceinline__ unsigned xb_add(unsigned* p, unsigned v) { return __hip_atomic_fetch_add(p, v, __ATOMIC_RELAXED, __HIP_MEMORY_SCOPE_AGENT); }
__device__ __forceinline__ unsigned xb_xcc_id() { return (unsigned)__builtin_amdgcn_s_getreg((3 << 11) | 20) & 0xFu; }
#define XB_SPIN(cond, bar) do { unsigned _sp = 0; while (cond) { __builtin_amdgcn_s_sleep(1); \
    if ((++_sp & 255u) == 0u) { if (xb_ld(&(bar)[XB_TMO])) break; if (_sp > XB_SPIN_CAP) { atomicAdd(&(bar)[XB_TMO], 1u); break; } } } } while (0)
struct XcdBarrier { unsigned* bar; unsigned x; volatile LAS unsigned* st; };
__device__ __forceinline__ XcdBarrier xcd_barrier_post(unsigned* bar, volatile LAS unsigned* st) {
    XcdBarrier b; b.bar = bar; b.x = xb_xcc_id(); b.st = st;
    if (threadIdx.x == 0) (void)xb_add(&bar[XB_XCNT(b.x)], 1u);
    return b;
}
__device__ __forceinline__ void xcd_barrier_complete(unsigned* bar, unsigned x, unsigned& nloc, unsigned& nx) {
    const unsigned G = gridDim.x * gridDim.y * gridDim.z;
    unsigned sum, cnt, mine, sp = 0u;
    for (;;) {
        sum = 0u; cnt = 0u; mine = 0u;
#pragma unroll
        for (unsigned j = 0; j < 16; ++j) { const unsigned c = xb_ld(&bar[XB_XCNT(j)]); sum += c; cnt += (c > 0u) ? 1u : 0u; mine = (j == x) ? c : mine; }
        if (sum == G) break;
        __builtin_amdgcn_s_sleep(1);
        if ((++sp & 255u) == 0u) { if (xb_ld(&bar[XB_TMO])) break; if (sp > XB_SPIN_CAP) { atomicAdd(&bar[XB_TMO], 1u); break; } }
    }
    nloc = mine > 0u ? mine : 1u; nx = cnt > 0u ? cnt : 1u;
}
__device__ __forceinline__ void xcd_barrier(const XcdBarrier& b) {
    asm volatile("s_waitcnt vmcnt(0)" ::: "memory");
    __syncthreads();
    if (threadIdx.x == 0) {
        unsigned* bar = b.bar; asm volatile("" : "+s"(bar));
        __builtin_amdgcn_s_waitcnt(0);
        unsigned nloc = b.st[0], nx = b.st[1];
        if (nloc == 0u) { xcd_barrier_complete(bar, b.x, nloc, nx); b.st[0] = nloc; b.st[1] = nx; }
        const unsigned old = xb_add(&bar[XB_XSUB(b.x)], 1u);
        const unsigned gen = old / nloc;
        if (old + 1u == (gen + 1u) * nloc) {
            __builtin_amdgcn_fence(__ATOMIC_RELEASE, "agent");
            asm volatile("s_waitcnt vmcnt(0)" ::: "memory");
            const unsigned og = xb_add(&bar[XB_TOP], 1u);
            const unsigned tg = og / nx;
            if (og + 1u == (tg + 1u) * nx) xb_add(&bar[XB_TOPGEN], 1u);
            else XB_SPIN(xb_ld(&bar[XB_TOPGEN]) == tg, bar);
            __builtin_amdgcn_fence(__ATOMIC_ACQUIRE, "agent");
            xb_add(&bar[XB_XGEN(b.x)], 1u);
            asm volatile("s_waitcnt vmcnt(0)" ::: "memory");
        } else {
            XB_SPIN(xb_ld(&bar[XB_XGEN(b.x)]) == gen, bar);
            __builtin_amdgcn_fence(__ATOMIC_ACQUIRE, "agent");
            asm volatile("s_waitcnt vmcnt(0)" ::: "memory");
        }
    }
    __syncthreads();
}

namespace pg8 {
constexpr int BM = 256, BK = 64, HALF = 128, HTB = HALF * BK * 2, STAGE_BYTES = 8 * HTB, NXCD = 8, WGM = 8;
__host__ __device__ __forceinline__ int lds_byte(int r, int c) { const int st = (r >> 4) * 2 + (c >> 5), rr = r & 15, cc = c & 31, ob = rr * 64 + cc * 2; return st * 1024 + (ob ^ (((ob >> 9) & 1) << 5)); }
__host__ __device__ __forceinline__ void stage_rc(int b, int& R, int& C) { const int st = b / 1024, sb = b % 1024, swz = sb ^ (((sb >> 9) & 1) << 5); R = (st >> 1) * 16 + swz / 64; C = (st & 1) * 32 + (swz % 64) / 2; }
__host__ __device__ __forceinline__ int perm32(int rho) { const int n = rho >> 4, i = rho & 15; return 8 * (i >> 2) + 4 * n + (i & 3); }

struct Unit { int pm, pn, x0, x1; };

struct TileOrder {
    int nM, nN, nwg, G, c, shift;
    __device__ void init(int nM_, int nN_, int G_, int c_, int shift_ = 0) { nM = nM_; nN = nN_; nwg = nM * nN; G = G_; c = c_; shift = shift_; }
    __device__ bool get(int i, int& pm, int& pn) const {
        const long L = (long)i * G + c; if (L >= nwg) return false;
        int wgid = (int)L; { const int q = nwg / NXCD, r = nwg % NXCD, xcd = wgid % NXCD, off = wgid / NXCD; wgid = (xcd < r ? xcd * (q + 1) : r * (q + 1) + (xcd - r) * q) + off; }
        const int nig = WGM * nN, gid = wgid / nig, fm = gid * WGM, gsz = (nM - fm) < WGM ? (nM - fm) : WGM;
        pm = fm + ((wgid % nig) % gsz); pn = (wgid % nig) / gsz; if (gid & 1) { pn += shift; if (pn >= nN) pn -= nN; } return true;
    }
};

typedef int v8i __attribute__((ext_vector_type(8)));
template <class Epi, class Sched, bool F8 = false>
__device__ __forceinline__ void gemm_phase(LAS unsigned char* lds, const int Kb, const Sched& S, const Epi& E) {
    int tid = threadIdx.x; asm volatile("" : "+v"(tid));
    const int wid = __builtin_amdgcn_readfirstlane(tid >> 6), lane = tid & 63, wr = wid >> 2, wc = wid & 3, fr = lane & 15, fq = lane >> 4;
    const int nt = Kb / 128;
    constexpr bool GA = Sched::GATHER; constexpr int KS = Sched::KSPLIT; constexpr bool ASPLIT = Sched::ASPLIT;
    unsigned voffA[2], voffB[2]; int Rst[2], Cst[2];
#pragma unroll
    for (int i = 0; i < 2; ++i) { int R, C; stage_rc(tid * 16 + i * 8192, R, C); const int Rb = Epi::PERM ? ((R & ~31) + perm32(R & 31)) : R;
        voffA[i] = (unsigned)(R * S.lda + C * 2); voffB[i] = (unsigned)(Rb * S.ldb + C * 2); Rst[i] = R; Cst[i] = C; }
    const size_t kstep = (size_t)(BK * 2);
    const size_t hstepA = (size_t)HALF * S.lda, hstepB = (size_t)HALF * S.ldb;
    const unsigned ldsw = (unsigned)wid * 1024u; const unsigned gmul = (unsigned)S.lda;
    const int aoff = F8 ? (lds_byte(wr * 64 + fr, (fq & 1) * 16) + (fq >> 1) * 1024) : lds_byte(wr * 64 + fr, fq * 8);
    const int boff = F8 ? (lds_byte(wc * 32 + fr, (fq & 1) * 16) + (fq >> 1) * 1024) : lds_byte(wc * 32 + fr, fq * 8);
    unsigned vAc[2], vAn[2];
#define PG8_SA(b, h) (((b) * 2 + (h)) * HTB)
#define PG8_SB(b, h) ((4 + (b) * 2 + (h)) * HTB)
#define PG8_STAGE2(bufoff, gbase, v0, v1) do { \
        __builtin_amdgcn_global_load_lds((const unsigned*)((const char*)(gbase) + (v0)), (LAS unsigned*)(lds + (bufoff) + ldsw), 16, 0, 0); \
        __builtin_amdgcn_global_load_lds((const unsigned*)((const char*)(gbase) + (v1)), (LAS unsigned*)(lds + (bufoff) + ldsw + 8192), 16, 0, 0); } while (0)
#define PG8_STAGE_B(bufoff, ptr, h) PG8_STAGE2(bufoff, (ptr) + (h) * hstepB, voffB[0], voffB[1])
#define PG8_STAGE_A(bufoff, ptr, h, nx) do { if constexpr (GA) { const unsigned _p = (nx) ? vAn[h] : vAc[h]; PG8_STAGE2(bufoff, ptr, (_p & 0xffffu) * gmul + (unsigned)Cst[0] * 2u, (_p >> 16) * gmul + (unsigned)Cst[0] * 2u); } \
        else { PG8_STAGE2(bufoff, (ptr) + (h) * hstepA, voffA[0], voffA[1]); } } while (0)
    typedef int v4i_ __attribute__((ext_vector_type(4)));
#define PG8_LDA(dst, b, h) do { _Pragma("unroll") for (int m = 0; m < 4; ++m) { if constexpr (F8) { dst##8[m].lo = *(const LAS v4i_*)(lds + PG8_SA(b, h) + aoff + m * 2048); dst##8[m].hi = *(const LAS v4i_*)(lds + PG8_SA(b, h) + aoff + m * 2048 + 16); } \
        else { _Pragma("unroll") for (int k = 0; k < 2; ++k) dst[m][k] = *(const LAS bf16x8*)(lds + PG8_SA(b, h) + aoff + m * 2048 + k * 1024); } } } while (0)
#define PG8_LDB(dst, b, h) do { _Pragma("unroll") for (int n = 0; n < 2; ++n) { if constexpr (F8) { dst##8[n].lo = *(const LAS v4i_*)(lds + PG8_SB(b, h) + boff + n * 2048); dst##8[n].hi = *(const LAS v4i_*)(lds + PG8_SB(b, h) + boff + n * 2048 + 16); } \
        else { _Pragma("unroll") for (int k = 0; k < 2; ++k) dst[n][k] = *(const LAS bf16x8*)(lds + PG8_SB(b, h) + boff + n * 2048 + k * 1024); } } } while (0)
#define PG8_MMA(ai, bj, At, Bt) do { __builtin_amdgcn_s_setprio(1); _Pragma("unroll") for (int m = 0; m < 4; ++m) _Pragma("unroll") for (int n = 0; n < 2; ++n) { \
        if constexpr (F8) { asm volatile("v_mfma_scale_f32_16x16x128_f8f6f4 %0, %1, %2, %0, %3, %3 op_sel_hi:[0,0,0]" : "+v"(acc[ai][bj][m][n]) : "v"(Bt##8[n]), "v"(At##8[m]), "v"(f8scale)); } \
        else { _Pragma("unroll") for (int k = 0; k < 2; ++k) acc[ai][bj][m][n] = __builtin_amdgcn_mfma_f32_16x16x32_bf16(Bt[n][k], At[m][k], acc[ai][bj][m][n], 0, 0, 0); } } \
        __builtin_amdgcn_s_setprio(0); } while (0)
#define PG8_WAIT_V(n) asm volatile("s_waitcnt vmcnt(" #n ")" ::: "memory")
#define PG8_WAIT_L(n) asm volatile("s_waitcnt lgkmcnt(" #n ")" ::: "memory")
#define PG8_BAR __builtin_amdgcn_s_barrier()
#define PG8_SCHED __builtin_amdgcn_sched_barrier(0)
#define PG8_GOFF(dst, u) do { if constexpr (GA) { _Pragma("unroll") for (int h = 0; h < 2; ++h) dst[h] = S.a_rowoff(u, Rst[0] + HALF * h) | (S.a_rowoff(u, Rst[0] + 64 + HALF * h) << 16); } } while (0)
    Unit cur, nxt; int ui = 0;
    if (!S.next(0, cur)) return;
    f32x4 acc[2][2][4][2];
#pragma unroll
    for (int a = 0; a < 2; ++a)
#pragma unroll
        for (int b = 0; b < 2; ++b)
#pragma unroll
            for (int m = 0; m < 4; ++m)
#pragma unroll
                for (int n = 0; n < 2; ++n) acc[a][b][m][n] = (f32x4){0.f, 0.f, 0.f, 0.f};
    int f8scale = 0x7F7F7F7F; asm volatile("" : "+v"(f8scale));
    bf16x8 At[4][2], B0[2][2], B1[2][2]; v8i At8[4], B08[2], B18[2];
    const char* cA = S.a_base(cur, 0); const char* cA1 = ASPLIT ? S.a_base(cur, 1) : cA; const char* cB0 = S.b_base(cur, 0); const char* cB1 = KS ? S.b_base(cur, 1) : cB0;
    PG8_GOFF(vAc, cur);
    vAn[0] = vAc[0]; vAn[1] = vAc[1];
    PG8_STAGE_B(PG8_SB(0, 0), cB0, 0); PG8_STAGE_B(PG8_SB(0, 1), cB0, 1); PG8_STAGE_A(PG8_SA(0, 0), cA, 0, false); PG8_STAGE_A(PG8_SA(0, 1), cA, 1, false);
    if (wr == 1) PG8_BAR;
    PG8_WAIT_V(2); PG8_BAR;
    PG8_STAGE_B(PG8_SB(1, 0), cB0 + kstep, 0); PG8_STAGE_A(PG8_SA(1, 0), cA + kstep, 0, false); PG8_STAGE_B(PG8_SB(1, 1), cB0 + kstep, 1);
    PG8_WAIT_V(6); PG8_BAR;
    for (;;) {
        const bool has_next = S.next(ui + 1, nxt);
        const char* nA = has_next ? S.a_base(nxt, 0) : cA; const char* nA1 = (ASPLIT && has_next) ? S.a_base(nxt, 1) : (ASPLIT ? cA1 : nA); const char* nB0 = has_next ? S.b_base(nxt, 0) : cB0; const char* nB1 = (KS && has_next) ? S.b_base(nxt, 1) : (KS ? cB1 : nB0);
        if constexpr (GA) { if (has_next) { PG8_GOFF(vAn, nxt); } }
#pragma unroll 1
        for (int t = 0; t < nt; t += 2) {
            const bool last = (t == nt - 2);
            const char* a1 = (ASPLIT && (t + 1) >= KS) ? cA1 + (size_t)(t + 1 - KS) * kstep : cA + (size_t)(t + 1) * kstep;
            const char* a2 = last ? nA : ((ASPLIT && (t + 2) >= KS) ? cA1 + (size_t)(t + 2 - KS) * kstep : cA + (size_t)(t + 2) * kstep);
            if constexpr (Epi::MID) { if (t == KS) { int fr_ = fr, fq_ = fq; asm volatile("" : "+v"(fr_), "+v"(fq_)); if constexpr (F8) { asm volatile("s_nop 15" ::: "memory"); } E.mid(acc, cur, wr, wc, fr_, fq_); if constexpr (F8) { asm volatile("s_nop 3" ::: "memory"); } } }
            const char* b2 = last ? nB0 : ((KS && (t + 2) >= KS) ? cB1 + (size_t)(t + 2 - KS) * kstep : cB0 + (size_t)(t + 2) * kstep);
            const char* a3 = a2 + kstep; const char* b3 = b2 + kstep;
            PG8_LDB(B0, 0, 0); PG8_LDB(B1, 0, 1); PG8_SCHED; PG8_LDA(At, 0, 0); PG8_STAGE_A(PG8_SA(1, 1), a1, 1, false);
            PG8_WAIT_V(8); PG8_WAIT_L(0); PG8_BAR; PG8_MMA(0, 0, At, B0); PG8_MMA(0, 1, At, B1); PG8_BAR; PG8_SCHED;
            PG8_LDA(At, 0, 1); PG8_STAGE_B(PG8_SB(0, 0), b2, 0); PG8_STAGE_B(PG8_SB(0, 1), b2, 1); PG8_STAGE_A(PG8_SA(0, 0), a2, 0, last);
            PG8_WAIT_V(8); PG8_WAIT_L(0); PG8_BAR; PG8_MMA(1, 0, At, B0); PG8_MMA(1, 1, At, B1); PG8_BAR; PG8_SCHED;
            PG8_LDB(B0, 1, 0); PG8_LDB(B1, 1, 1); PG8_SCHED; PG8_LDA(At, 1, 0); PG8_STAGE_A(PG8_SA(0, 1), a2, 1, last);
            PG8_WAIT_V(8); PG8_WAIT_L(0); PG8_BAR; PG8_MMA(0, 0, At, B0); PG8_MMA(0, 1, At, B1); PG8_BAR; PG8_SCHED;
            PG8_LDA(At, 1, 1); PG8_STAGE_B(PG8_SB(1, 0), b3, 0); PG8_STAGE_B(PG8_SB(1, 1), b3, 1); PG8_STAGE_A(PG8_SA(1, 0), a3, 0, last);
            PG8_WAIT_V(8); PG8_WAIT_L(0); PG8_BAR; PG8_MMA(1, 0, At, B0); PG8_MMA(1, 1, At, B1); PG8_BAR; PG8_SCHED;
        }
        if (wr == 0) PG8_BAR;
        if constexpr (F8) { asm volatile("s_nop 15\n\ts_nop 15" ::: "memory"); }
        { int fr_ = fr, fq_ = fq; asm volatile("" : "+v"(fr_), "+v"(fq_));
          E(acc, cur, wr, wc, fr_, fq_); }
        if (!has_next) break;
#pragma unroll
        for (int a = 0; a < 2; ++a)
#pragma unroll
            for (int b = 0; b < 2; ++b)
#pragma unroll
                for (int m = 0; m < 4; ++m)
#pragma unroll
                    for (int n = 0; n < 2; ++n) acc[a][b][m][n] = (f32x4){0.f, 0.f, 0.f, 0.f};
        cur = nxt; cA = nA; cA1 = nA1; cB0 = nB0; cB1 = nB1; ++ui;
        vAc[0] = vAn[0]; vAc[1] = vAn[1];
        if (wr == 1) PG8_BAR;
    }
    PG8_WAIT_V(0);
    PG8_BAR;
#undef PG8_SA
#undef PG8_SB
#undef PG8_STAGE2
#undef PG8_STAGE_A
#undef PG8_STAGE_B
#undef PG8_LDA
#undef PG8_LDB
#undef PG8_MMA
#undef PG8_WAIT_V
#undef PG8_WAIT_L
#undef PG8_BAR
#undef PG8_SCHED
#undef PG8_GOFF
}
}
using pg8::Unit;


struct Args {
    const float* x; const float* c; const int* pos; const float* ada_w; const float* ada_b; const float* nmw; const float* nfw; const float* w_in;
    const float* b_ig; const float* b_fg; const float* qnw; const float* knw; const float* sinks; const float* conv_w; const float* conv_b; const float* mnw;
    const float* w_au; const float* w_mu; const float* w_out; const float* router_w; const float* router_b; const float* w_gate; const float* w_up; const float* w_down;
    float* out; unsigned char* ws; int ph_lo, ph_hi;
};

__constant__ float c_invf[8] = {1.0f, 0.1939227432012558f, 0.03760603070259094f, 0.007292664609849453f, 0.0014142135623842478f, 0.00027424818836152554f, 5.3182957344688475e-05f, 1.0313385246263351e-05f};

struct DenseSched {
    static constexpr bool GATHER = false, ASPLIT = false; static constexpr int KSPLIT = 0;
    const char* A; const char* Bt; int lda, ldb; pg8::TileOrder ord;
    DI bool next(int i, Unit& u) const { int pm, pn; if (!ord.get(i, pm, pn)) return false; u.pm = pm; u.pn = pn; u.x0 = 0; u.x1 = 0; return true; }
    DI const char* a_base(const Unit& u, int) const { return A + (size_t)u.pm * 256 * lda; }
    DI const char* b_base(const Unit& u, int) const { return Bt + (size_t)u.pn * 256 * ldb; }
    DI unsigned a_rowoff(const Unit&, int) const { return 0u; }
};
struct EpiProj {
    static constexpr bool PERM = true, MID = false;
    bf16* O; float* gates; const float* big; const float* bfg; int nul, rwrap;
    DI void operator()(const f32x4 (&acc)[2][2][4][2], const Unit& u, int wr, int wc, int fr, int fq) const {
        const int row0 = u.pm * 256 + wr * 64 + fr, col0 = u.pn * 256 + wc * 32 + 8 * fq; const bool sg = u.pn >= 9; constexpr float WSC = 1.0f / 64.0f;
        if (nul == 1) { if (acc[0][0][0][0][0] == 12345.678f) O[0] = 0; return; }
        unsigned cks = 0u;
        if (u.pn == 19) {
            if (wc == 0 && fq == 0) {
#pragma unroll
                for (int ai = 0; ai < 2; ++ai)
#pragma unroll
                    for (int m = 0; m < 4; ++m) { const int row = row0 + ai * 128 + m * 16; const f32x4 vi = acc[ai][0][m][0], vf = acc[ai][0][m][1]; f32x4 oi, of;
#pragma unroll
                        for (int j = 0; j < 4; ++j) { oi[j] = vi[j] * WSC + big[j]; const float z = vf[j] * WSC + bfg[j]; of[j] = fminf(z, 0.f) - log1pf(__expf(-fabsf(z))); }
                        *(f32x4*)(gates + (size_t)row * 8) = oi; *(f32x4*)(gates + (size_t)row * 8 + 4) = of; } }
            return; }
#pragma unroll
        for (int ai = 0; ai < 2; ++ai)
#pragma unroll
            for (int m = 0; m < 4; ++m) { bf16* rowp = O + (size_t)((row0 + ai * 128 + m * 16) & rwrap) * NPROJ + col0;
#pragma unroll
                for (int bj = 0; bj < 2; ++bj) { f32x4 v0 = acc[ai][bj][m][0], v1 = acc[ai][bj][m][1];
                    if (sg) {
#pragma unroll
                        for (int j = 0; j < 4; ++j) {
                            v0[j] = __builtin_amdgcn_rcpf(__builtin_fmaf(__builtin_amdgcn_exp2f(v0[j] * (-1.4426950408889634f / 64.0f)), 1.0f / 255.0f, 1.0f / 255.0f));
                            v1[j] = __builtin_amdgcn_rcpf(__builtin_fmaf(__builtin_amdgcn_exp2f(v1[j] * (-1.4426950408889634f / 64.0f)), 1.0f / 255.0f, 1.0f / 255.0f)); }
                        if (u.pn >= 15) {
#pragma unroll
                            for (int j = 0; j < 4; ++j) { v0[j] = fmaxf(v0[j], 1.0f); v1[j] = fmaxf(v1[j], 1.0f); } }
                        v2u q; q.x = f32_to_u8x4(v0[0], v0[1], v0[2], v0[3]); q.y = f32_to_u8x4(v1[0], v1[1], v1[2], v1[3]);
                        *(v2u*)((unsigned char*)(O + (size_t)((row0 + ai * 128 + m * 16) & rwrap) * NPROJ) + 512 * u.pn + wc * 32 + 8 * fq + bj * 128) = q; continue; }
                    if (u.pn <= 8) {
                        v0 = v0 * (WSC * 16.0f); v1 = v1 * (WSC * 16.0f);
                        v2u q; q.x = pk4_fp8(v0[0], v0[1], v0[2], v0[3]); q.y = pk4_fp8(v1[0], v1[1], v1[2], v1[3]);
                        *(v2u*)((unsigned char*)(O + (size_t)((row0 + ai * 128 + m * 16) & rwrap) * NPROJ) + 512 * u.pn + wc * 32 + 8 * fq + bj * 128) = q; continue; }
                    v0 = v0 * WSC; v1 = v1 * WSC;
                    v4u w; w.x = cvt_pk_bf16(v0[0], v0[1]); w.y = cvt_pk_bf16(v0[2], v0[3]); w.z = cvt_pk_bf16(v1[0], v1[1]); w.w = cvt_pk_bf16(v1[2], v1[3]);
                    if (nul == 3) cks ^= (w.x ^ w.y) ^ (w.z ^ w.w); else *(v4u*)(rowp + bj * 128) = w; } }
        if (nul == 3) ((unsigned*)O)[(size_t)row0 * NPROJ / 2 + col0 / 2] = cks;
    }
};
struct MergeSched {
    static constexpr bool GATHER = false, ASPLIT = true; static constexpr int KSPLIT = 4;
    const char* A0; const char* A1; const char* B0; const char* B1; int lda, ldb; pg8::TileOrder ord;
    DI bool next(int i, Unit& u) const { int pm, pn; if (!ord.get(i, pm, pn)) return false; u.pm = pm; u.pn = pn; u.x0 = 0; u.x1 = 0; return true; }
    DI const char* a_base(const Unit& u, int half) const { return (half ? A1 : A0) + (size_t)u.pm * 256 * lda; }
    DI const char* b_base(const Unit& u, int half) const { return (half ? B1 : B0) + (size_t)u.pn * 256 * ldb; }
    DI unsigned a_rowoff(const Unit&, int) const { return 0u; }
};
struct EpiMerge {
    static constexpr bool PERM = true, MID = true;
    bf16* P; int nul;
    DI void mid(f32x4 (&acc)[2][2][4][2], const Unit& u, int wr, int wc, int fr, int fq) const {
        if (nul) return;
        const int row0 = u.pm * 256 + wr * 64 + fr, cb = wc * 32 + 8 * fq;
#pragma unroll
        for (int ai = 0; ai < 2; ++ai) {
            v2u ga[4][2], gb[4][2];
#pragma unroll
            for (int m = 0; m < 4; ++m)
#pragma unroll
                for (int bj = 0; bj < 2; ++bj) { const unsigned char* rowp = (const unsigned char*)(P + (size_t)(row0 + ai * 128 + m * 16) * NPROJ) + cb + bj * 128;
                    ga[m][bj] = *(const v2u*)(rowp + 512 * (11 + u.pn)); gb[m][bj] = *(const v2u*)(rowp + 512 * (15 + u.pn)); }
#pragma unroll
            for (int m = 0; m < 4; ++m)
#pragma unroll
                for (int bj = 0; bj < 2; ++bj) { const f32x4 a0 = u8x4_to_f32(ga[m][bj].x), a1 = u8x4_to_f32(ga[m][bj].y), b0 = u8x4_to_f32(gb[m][bj].x), b1 = u8x4_to_f32(gb[m][bj].y); f32x4 r0, r1;
#pragma unroll
                    for (int j = 0; j < 4; ++j) { r0[j] = a0[j] * __builtin_amdgcn_rcpf(b0[j]); r1[j] = a1[j] * __builtin_amdgcn_rcpf(b1[j]); }
                    acc[ai][bj][m][0] *= r0; acc[ai][bj][m][1] *= r1; }
        }
    }
    DI void operator()(const f32x4 (&acc)[2][2][4][2], const Unit& u, int wr, int wc, int fr, int fq) const {
        if (nul) { if (acc[0][0][0][0][0] == 12345.678f) P[0] = 0; return; }
        const int row0 = u.pm * 256 + wr * 64 + fr, col0 = u.pn * 256 + wc * 32 + 8 * fq, cb = wc * 32 + 8 * fq; constexpr float SC = 1.0f / (32.0f * 255.0f);
        v2u gw[2][4][2];
#pragma unroll
        for (int ai = 0; ai < 2; ++ai)
#pragma unroll
            for (int m = 0; m < 4; ++m)
#pragma unroll
                for (int bj = 0; bj < 2; ++bj) gw[ai][m][bj] = *(const v2u*)((const unsigned char*)(P + (size_t)(row0 + ai * 128 + m * 16) * NPROJ) + 512 * (15 + u.pn) + cb + bj * 128);
        asm volatile("" ::: "memory");
#pragma unroll
        for (int ai = 0; ai < 2; ++ai)
#pragma unroll
            for (int m = 0; m < 4; ++m) { unsigned char* mp = (unsigned char*)(P + (size_t)(row0 + ai * 128 + m * 16) * NPROJ + C_MQ) + col0;
#pragma unroll
                for (int bj = 0; bj < 2; ++bj) { const f32x4 v0 = acc[ai][bj][m][0] * SC, v1 = acc[ai][bj][m][1] * SC; const f32x4 g0 = u8x4_to_f32(gw[ai][m][bj].x), g1 = u8x4_to_f32(gw[ai][m][bj].y);
                    v2u w; w.x = pk4_fp8(g0[0] * v0[0], g0[1] * v0[1], g0[2] * v0[2], g0[3] * v0[3]);
                    w.y = pk4_fp8(g1[0] * v1[0], g1[1] * v1[1], g1[2] * v1[2], g1[3] * v1[3]);
                    *(v2u*)(mp + bj * 128) = w; } }
    }
};
struct EpiRes {
    static constexpr bool PERM = true, MID = false;
    const bf16* xin; bf16* out; const float* g; float* ssq; int rmask, nul;
    DI void operator()(const f32x4 (&acc)[2][2][4][2], const Unit& u, int wr, int wc, int fr, int fq) const {
        const int row0 = u.pm * 256 + wr * 64 + fr, col0 = u.pn * 256 + wc * 32 + 8 * fq; const int b = (u.pm * 256) >> 14;
        if (nul) { if (acc[0][0][0][0][0] == 12345.678f) out[0] = 0; return; }
        f32x4 gv[2][2];
#pragma unroll
        for (int bj = 0; bj < 2; ++bj)
#pragma unroll
            for (int n = 0; n < 2; ++n) gv[bj][n] = *(const f32x4*)(g + b * 6144 + col0 + bj * 128 + 4 * n) * (1.0f / 512.0f);
#pragma unroll
        for (int ai = 0; ai < 2; ++ai) {
            v4u xw[4][2];
#pragma unroll
            for (int m = 0; m < 4; ++m)
#pragma unroll
                for (int bj = 0; bj < 2; ++bj) xw[m][bj] = *(const v4u*)(xin + (size_t)(row0 + ai * 128 + m * 16) * D + col0 + bj * 128);
            asm volatile("" ::: "memory");
#pragma unroll
            for (int m = 0; m < 4; ++m) { const int row = row0 + ai * 128 + m * 16; float sq = 0.f;
#pragma unroll
                for (int bj = 0; bj < 2; ++bj) { const v4u w = xw[m][bj];
                    const f32x4 o0 = (f32x4){bflo(w.x), bfhi(w.x), bflo(w.y), bfhi(w.y)} + gv[bj][0] * acc[ai][bj][m][0];
                    const f32x4 o1 = (f32x4){bflo(w.z), bfhi(w.z), bflo(w.w), bfhi(w.w)} + gv[bj][1] * acc[ai][bj][m][1];
                    v4u ow; ow.x = cvt_pk_bf16(o0.x, o0.y); ow.y = cvt_pk_bf16(o0.z, o0.w); ow.z = cvt_pk_bf16(o1.x, o1.y); ow.w = cvt_pk_bf16(o1.z, o1.w);
                    { const f32x4 q0 = o0 * o0, q1 = o1 * o1; sq += ((q0.x + q0.y) + (q0.z + q0.w)) + ((q1.x + q1.y) + (q1.z + q1.w)); }
                    *(v4u*)(out + (size_t)(row & rmask) * D + col0 + bj * 128) = ow; }
                { const int ln = fq * 16 + fr; sq += shx(sq, 16, ln); sq += shx(sq, 32, ln); }
                if (fq == 0) ssq[(size_t)row * 16 + u.pn * 4 + wc] = sq; }
            asm volatile("" ::: "memory");
        }
    }
};

struct MoeTab { const LAS int* tcls; const LAS int* tpos; const LAS int* cnt; int Rtot; };
DI int xcd_remap(int L, int nwg) { const int q = nwg >> 3, r = nwg & 7, xcd = L & 7, off = L >> 3; return (xcd < r ? xcd * (q + 1) : r * (q + 1) + (xcd - r) * q) + off; }
DI void cls_experts(int cls, int& ea, int& eb) { const int g = cls / 6, p = cls - 6 * g; const int a = (p < 3) ? 0 : ((p < 5) ? 1 : 2); const int b = (p < 3) ? (p + 1) : ((p < 5) ? (p - 1) : 3); ea = 4 * g + a; eb = 4 * g + b; }
struct MoeUpSched {
    static constexpr bool GATHER = true, ASPLIT = false; static constexpr int KSPLIT = 0;
    const char* A; const char* W; int lda, ldb; MoeTab tb; int G, c; const LAS unsigned* tokoff;
    DI bool next(int i, Unit& u) const { const int L0 = i * G + c; if (L0 >= tb.Rtot * 8) return false; const int L = xcd_remap(L0, tb.Rtot * 8); u.pm = L >> 3; u.pn = L & 7; u.x0 = i; u.x1 = __builtin_amdgcn_readfirstlane(tb.tcls[u.pm]); return true; }
    DI const char* a_base(const Unit&, int) const { return A; }
    DI const char* b_base(const Unit& u, int) const { int ea, eb; cls_experts(u.x1, ea, eb); const int e = (u.pn < 4) ? ea : eb; return W + ((size_t)e * 1024 + (size_t)(u.pn & 3) * 256) * ldb; }
    DI unsigned a_rowoff(const Unit& u, int r) const { return tokoff[u.x0 * 256 + r]; }
};
struct EpiSwiglu {
    static constexpr bool PERM = true, MID = false;
    unsigned char* H; const float* tgate; const LAS unsigned* tokoff;
    DI void operator()(const f32x4 (&acc)[2][2][4][2], const Unit& u, int wr, int wc, int fr, int fq) const {
        const int r0 = wr * 64 + fr; const int hc = (u.pn >> 2) * 512 + (u.pn & 3) * 128 + wc * 32 + 8 * fq; const int gsel = u.pn >> 2;
        float rgv[2][4];
#pragma unroll
        for (int ai = 0; ai < 2; ++ai)
#pragma unroll
            for (int m = 0; m < 4; ++m) { const unsigned tok = tokoff[u.x0 * 256 + r0 + ai * 128 + m * 16]; rgv[ai][m] = tgate[tok * 2 + gsel] * 8.0f; }
        asm volatile("" ::: "memory");
#pragma unroll
        for (int ai = 0; ai < 2; ++ai)
#pragma unroll
            for (int m = 0; m < 4; ++m) { const int r = r0 + ai * 128 + m * 16; const float rg = rgv[ai][m];
                const f32x4 G0 = acc[ai][0][m][0], G1 = acc[ai][0][m][1], U0 = acc[ai][1][m][0], U1 = acc[ai][1][m][1]; const float kk = rg * (1.0f / 4096.0f);
                float o[8];
#pragma unroll
                for (int j = 0; j < 4; ++j) { o[j] = (G0[j] * U0[j]) * kk * __builtin_amdgcn_rcpf(1.0f + __builtin_amdgcn_exp2f(G0[j] * (-1.4426950408889634f / 64.0f)));
                                              o[4 + j] = (G1[j] * U1[j]) * kk * __builtin_amdgcn_rcpf(1.0f + __builtin_amdgcn_exp2f(G1[j] * (-1.4426950408889634f / 64.0f))); }
#pragma unroll
                for (int j = 0; j < 8; ++j) o[j] = __builtin_amdgcn_fmed3f(o[j], -440.0f, 440.0f);
                v2u w; w.x = pk4_fp8(o[0], o[1], o[2], o[3]); w.y = pk4_fp8(o[4], o[5], o[6], o[7]);
                *(v2u*)(H + ((size_t)u.pm * 256 + r) * 1024 + hc) = w; }
    }
};
struct MoeDownSched {
    static constexpr bool GATHER = false, ASPLIT = false; static constexpr int KSPLIT = 4;
    const char* A; const char* W; int lda, ldb; MoeTab tb; int G, c;
    DI bool next(int i, Unit& u) const { const int L0 = i * G + c; if (L0 >= tb.Rtot * 4) return false; const int L = xcd_remap(L0, tb.Rtot * 4); u.pm = L >> 2; u.pn = L & 3; u.x0 = __builtin_amdgcn_readfirstlane(tb.tpos[u.pm]); u.x1 = __builtin_amdgcn_readfirstlane(tb.tcls[u.pm]); return true; }
    DI const char* a_base(const Unit& u, int) const { return A + (size_t)u.pm * 256 * lda; }
    DI const char* b_base(const Unit& u, int half) const { int ea, eb; cls_experts(u.x1, ea, eb); const int e = half ? eb : ea; return W + ((size_t)e * 1024 + (size_t)u.pn * 256) * ldb; }
    DI unsigned a_rowoff(const Unit&, int) const { return 0u; }
};
struct EpiMoeOut {
    static constexpr bool PERM = true, MID = false;
    const bf16* xin; bf16* outb; float* outf; const float* g; const int* tokl; MoeTab tb; int rmask, last;
    DI void operator()(const f32x4 (&acc)[2][2][4][2], const Unit& u, int wr, int wc, int fr, int fq) const {
        const int r0 = wr * 64 + fr, col0 = u.pn * 256 + wc * 32 + 8 * fq; const int cn = tb.cnt[u.x1];
        v2u gvp[2][2][2];
#pragma unroll
        for (int b = 0; b < 2; ++b)
#pragma unroll
            for (int bj = 0; bj < 2; ++bj)
#pragma unroll
                for (int n = 0; n < 2; ++n) { const f32x4 t = *(const f32x4*)(g + b * 6144 + col0 + bj * 128 + 4 * n) * (1.0f / 256.0f); gvp[b][bj][n].x = cvt_pk_bf16(t.x, t.y); gvp[b][bj][n].y = cvt_pk_bf16(t.z, t.w); }
        int tok[2][4];
#pragma unroll
        for (int ai = 0; ai < 2; ++ai)
#pragma unroll
            for (int m = 0; m < 4; ++m) { const int pos = u.x0 + r0 + ai * 128 + m * 16; tok[ai][m] = (pos < cn) ? tokl[u.x1 * CLS_CAP + pos] : -1; }
#pragma unroll
        for (int ai = 0; ai < 2; ++ai) {
            v4u xw[4][2];
#pragma unroll
            for (int m = 0; m < 4; ++m)
#pragma unroll
                for (int bj = 0; bj < 2; ++bj) { const int tk = tok[ai][m] < 0 ? 0 : tok[ai][m]; xw[m][bj] = *(const v4u*)(xin + (size_t)tk * D + col0 + bj * 128); }
            asm volatile("" ::: "memory");
#pragma unroll
            for (int m = 0; m < 4; ++m) { const int tk = tok[ai][m];
                if (tk >= 0) { const bool b1 = (tk >> 14) != 0;
#pragma unroll
                    for (int bj = 0; bj < 2; ++bj) { const v4u w = xw[m][bj];
                        const v2u pa = b1 ? gvp[1][bj][0] : gvp[0][bj][0], pb = b1 ? gvp[1][bj][1] : gvp[0][bj][1];
                        const f32x4 ga = {bflo(pa.x), bfhi(pa.x), bflo(pa.y), bfhi(pa.y)}, gb = {bflo(pb.x), bfhi(pb.x), bflo(pb.y), bfhi(pb.y)};
                        const f32x4 o0 = (f32x4){bflo(w.x), bfhi(w.x), bflo(w.y), bfhi(w.y)} + ga * acc[ai][bj][m][0];
                        const f32x4 o1 = (f32x4){bflo(w.z), bfhi(w.z), bflo(w.w), bfhi(w.w)} + gb * acc[ai][bj][m][1];
                        if (last) { float* of = outf + (size_t)tk * D + col0 + bj * 128; *(f32x4*)of = o0; *(f32x4*)(of + 4) = o1; }
                        else { v4u ow; ow.x = cvt_pk_bf16(o0.x, o0.y); ow.y = cvt_pk_bf16(o0.z, o0.w); ow.z = cvt_pk_bf16(o1.x, o1.y); ow.w = cvt_pk_bf16(o1.z, o1.w);
                            *(v4u*)(outb + (size_t)(tk & rmask) * D + col0 + bj * 128) = ow; } } } }
            asm volatile("" ::: "memory");
        }
    }
};

struct Ctx { LAS unsigned char* lds; int tid, lane, wave, G, bid; };
DI Ctx fresh(const Ctx& X) { Ctx P = X; int t = X.tid; asm volatile("" : "+v"(t)); P.tid = t; P.lane = t & 63; P.wave = __builtin_amdgcn_readfirstlane(t >> 6); return P; }

DI void tr_item(const float* W, int ldw, int K, bf16* WT, int k0, LAS float* scr, int lane) {
    { const int rr = lane >> 3, c4 = lane & 7; f32x4 v[8];
#pragma unroll
      for (int i = 0; i < 8; ++i) v[i] = *(const f32x4*)(W + (size_t)(k0 + rr + 8 * i) * ldw + 4 * c4);
#pragma unroll
      for (int i = 0; i < 8; ++i) { LAS float* d = scr + (rr + 8 * i) * 33 + 4 * c4; d[0] = v[i].x; d[1] = v[i].y; d[2] = v[i].z; d[3] = v[i].w; } }
    LDS_WAIT(); asm volatile("" ::: "memory");
    const int c = lane & 7;
#pragma unroll
    for (int j = 0; j < 4; ++j) { const int n = (lane >> 3) + 8 * j; const LAS float* s = scr + (8 * c) * 33 + n;
        v4u o; o.x = pk2(s[0 * 33], s[1 * 33]); o.y = pk2(s[2 * 33], s[3 * 33]); o.z = pk2(s[4 * 33], s[5 * 33]); o.w = pk2(s[6 * 33], s[7 * 33]);
        *(v4u*)(WT + (size_t)n * K + k0 + 8 * c) = o; }
    LDS_WAIT(); asm volatile("" ::: "memory");
}
struct TrItem { const float* W; unsigned char* WT; int ldw, K, k0; float scale; };
DI void tr_load8(const TrItem& t, int lane, f32x4 (&v)[8]) {
    const int rr = lane >> 3, c4 = lane & 7;
#pragma unroll
    for (int i = 0; i < 8; ++i) v[i] = *(const f32x4*)(t.W + (size_t)(t.k0 + rr + 8 * i) * t.ldw + 4 * c4);
}
DI void tr_store8(const TrItem& t, const f32x4 (&v)[8], LAS float* scr, int lane) {
    { const int rr = lane >> 3, c4 = lane & 7;
#pragma unroll
      for (int i = 0; i < 8; ++i) { LAS float* d = scr + (rr + 8 * i) * 33 + 4 * c4; d[0] = v[i].x; d[1] = v[i].y; d[2] = v[i].z; d[3] = v[i].w; } }
    LDS_WAIT(); asm volatile("" ::: "memory");
    const int c = lane & 7; const float scale = t.scale;
#pragma unroll
    for (int j = 0; j < 4; ++j) { const int n = (lane >> 3) + 8 * j; const LAS float* s = scr + (8 * c) * 33 + n;
        v2u o; o.x = pk4_fp8(s[0 * 33] * scale, s[1 * 33] * scale, s[2 * 33] * scale, s[3 * 33] * scale); o.y = pk4_fp8(s[4 * 33] * scale, s[5 * 33] * scale, s[6 * 33] * scale, s[7 * 33] * scale);
        *(v2u*)(t.WT + (size_t)n * t.K + t.k0 + 8 * c) = o; }
    LDS_WAIT(); asm volatile("" ::: "memory");
}
constexpr int IT_WIN = 16 * 153, IT_AU = 8 * 32, IT_OUT = 16 * 32, IT_GU = 16 * 16 * 32, IT_DN = 16 * 8 * 32;
constexpr int IT_A = IT_WIN + 2 * IT_AU + IT_OUT, IT_E = IT_GU + IT_DN, IT_L = IT_A + IT_E;
DI void tr_decode(const Args& a, int it, TrItem& t) {
    unsigned char* ws = a.ws;
        const int l = it / IT_L; int r = it - l * IT_L;
        if (r < IT_WIN) { const int kb = r / 153, nb = r - kb * 153, d0 = 32 * nb, s0 = (nb == 152) ? 2304 : (d0 + (d0 >= 2304 ? 8 : 0));
            t.W = a.w_in + (size_t)l * D * DIN_SRC + s0; t.ldw = DIN_SRC; t.K = D; t.WT = (unsigned char*)(ws + WS_WIN) + ((size_t)l * NPROJW + d0) * D; t.k0 = 64 * kb; t.scale = 64.0f; return; }
        r -= IT_WIN;
        if (r < IT_AU) { const int kb = r >> 5, nb = r & 31;
            t.W = a.w_au + (size_t)l * 512 * D + 32 * nb; t.ldw = D; t.K = 512; t.WT = (unsigned char*)(ws + WS_WAU) + ((size_t)l * D + 32 * nb) * 512; t.k0 = 64 * kb; t.scale = 32.0f; return; }
        r -= IT_AU;
        if (r < IT_AU) { const int kb = r >> 5, nb = r & 31;
            t.W = a.w_mu + (size_t)l * 512 * D + 32 * nb; t.ldw = D; t.K = 512; t.WT = (unsigned char*)(ws + WS_WMU) + ((size_t)l * D + 32 * nb) * 512; t.k0 = 64 * kb; t.scale = 32.0f; return; }
        r -= IT_AU;
        if (r < IT_OUT) { const int kb = r >> 5, nb = r & 31;
            t.W = a.w_out + (size_t)l * D * D + 32 * nb; t.ldw = D; t.K = D; t.WT = (unsigned char*)(ws + WS_WOUT) + ((size_t)l * D + 32 * nb) * D; t.k0 = 64 * kb; t.scale = 64.0f; return; }
        r -= IT_OUT;
        if (r < IT_GU) { const int e = r >> 9, q = r & 511, kb = q >> 5, nb = q & 31, tq = nb >> 3, rb = nb & 7;
            t.W = ((rb < 4) ? a.w_gate : a.w_up) + ((size_t)(l * NE + e) * D) * FF + 128 * tq + 32 * (rb & 3); t.ldw = FF; t.K = D; t.WT = (unsigned char*)(ws + WS_WGU) + ((size_t)(l * NE + e) * 1024 + 32 * nb) * D; t.k0 = 64 * kb; t.scale = 64.0f; return; }
        r -= IT_GU;
        { const int e = r >> 8, q = r & 255, kb = q >> 5, nb = q & 31;
            t.W = a.w_down + ((size_t)(l * NE + e) * FF) * D + 32 * nb; t.ldw = D; t.K = FF; t.WT = (unsigned char*)(ws + WS_WD) + ((size_t)(l * NE + e) * 1024 + 32 * nb) * FF; t.k0 = 64 * kb; t.scale = 32.0f; }
}
template <class Map>
DI void tr_run(const Args& a, const Ctx& X, int j0, int stride, int n, Map map) {
    LAS float* scr = (LAS float*)(X.lds + X.wave * 16384);
    TrItem cur, nxt; f32x4 va[8], vb[8];
    if (j0 < n) { tr_decode(a, map(j0), cur); tr_load8(cur, X.lane, va); }
#pragma unroll 1
    for (int j = j0; j < n; j += 2 * stride) {
        const bool h1 = j + stride < n, h2 = j + 2 * stride < n;
        if (h1) { tr_decode(a, map(j + stride), nxt); tr_load8(nxt, X.lane, vb); }
        tr_store8(cur, va, scr, X.lane);
        if (h1) { if (h2) { tr_decode(a, map(j + 2 * stride), cur); tr_load8(cur, X.lane, va); }
                  tr_store8(nxt, vb, scr, X.lane); } }
}
DI void conv_fill(const Args& a, const Ctx& X, int lt, int nl, int jbase, int jcount) {
    int first = nl, nblk = X.G - nl; if (nblk < 64) { first = 0; nblk = X.G; }
    if (X.bid < first) return;
    tr_run(a, X, (X.bid - first) * 8 + X.wave, nblk * 8, jcount, [lt, jbase](int j) { return lt * IT_L + jbase + j; });
}
DI void p0_prologue(const Args& a, const Ctx& X) {
    unsigned char* ws = a.ws;
    const int gw = X.bid * 8 + X.wave, NGW = X.G * 8;
    tr_run(a, X, gw, NGW, IT_L, [](int j) { return j; });
    { const float* xs = a.x; bf16* xb = (bf16*)(ws + WS_XB);
      const size_t NP = (size_t)T * D / 8, ST = (size_t)X.G * 512;
      for (size_t i = (size_t)X.bid * 512 + X.tid; i < NP; i += 4 * ST) { f32x4 v0[4], v1[4];
#pragma unroll
          for (int k = 0; k < 4; ++k) { const size_t ii = i + k * ST; if (ii < NP) { v0[k] = *(const f32x4*)(xs + 8 * ii); v1[k] = *(const f32x4*)(xs + 8 * ii + 4); } }
#pragma unroll
          for (int k = 0; k < 4; ++k) { const size_t ii = i + k * ST; if (ii < NP) { v4u w; w.x = cvt_pk_bf16(v0[k].x, v0[k].y); w.y = cvt_pk_bf16(v0[k].z, v0[k].w); w.z = cvt_pk_bf16(v1[k].x, v1[k].y); w.w = cvt_pk_bf16(v1[k].z, v1[k].w); *(v4u*)(xb + 8 * ii) = w; } } } }
    { float* cs = (float*)(ws + WS_ROPE); float* sn = cs + (size_t)T * 8;
      for (int i = X.bid * 512 + X.tid; i < T * 8; i += X.G * 512) { const int tok = i >> 3, f = i & 7; const float angf = (float)a.pos[tok] * c_invf[f];
          double rev = (double)angf * 0.15915494309189535; rev -= rint(rev); const float rf = (float)rev;
          cs[i] = __builtin_amdgcn_cosf(rf); sn[i] = __builtin_amdgcn_sinf(rf); } }
    __syncthreads();
    LAS float* cact = (LAS float*)X.lds; LAS float* red = (LAS float*)(X.lds + 8192);
    for (int i = X.tid; i < 2048; i += 512) { const float cv = a.c[i]; cact[i] = cv / (1.0f + __expf(-cv)); }
    __syncthreads();
    float* mod = (float*)(ws + WS_MOD);
    for (int it = X.bid; it < NL * 48; it += X.G) { const int l = it / 48, cg = it - l * 48; const int hl = X.lane >> 5, ln = X.lane & 31, ks = X.wave * 2 + hl; const int col = cg * 128 + 4 * ln;
        const float* w = a.ada_w + (size_t)l * D * 6144 + col; f32x4 s0 = {0.f, 0.f, 0.f, 0.f}, s1 = {0.f, 0.f, 0.f, 0.f};
#pragma unroll 1
        for (int k16 = 0; k16 < 64; k16 += 16) { const int kb = ks * 64 + k16; f32x4 wv[16];
#pragma unroll
            for (int kk = 0; kk < 16; ++kk) wv[kk] = *(const f32x4*)(w + (size_t)(kb + kk) * 6144);
#pragma unroll
            for (int kk = 0; kk < 16; ++kk) { s0 += wv[kk] * cact[kb + kk]; s1 += wv[kk] * cact[1024 + kb + kk]; } }
        *(LAS f32x4*)(red + (ks * 2 + 0) * 128 + 4 * ln) = s0; *(LAS f32x4*)(red + (ks * 2 + 1) * 128 + 4 * ln) = s1;
        __syncthreads();
        if (X.tid < 256) { const int b = X.tid >> 7, cc = X.tid & 127; float sm = 0.f;
#pragma unroll
          for (int s16 = 0; s16 < 16; ++s16) sm += red[(s16 * 2 + b) * 128 + cc];
          mod[(size_t)(l * 2 + b) * 6144 + cg * 128 + cc] = sm + a.ada_b[l * 6144 + cg * 128 + cc]; }
        __syncthreads();
    }
}

DI void p1_norm_gates(const Args& a, const Ctx& X, int l, const bf16* xin) {
    unsigned char* ws = a.ws;
    const float* mod = (const float*)(ws + WS_MOD); unsigned char* hb = (unsigned char*)(ws + WS_H);
    const int gw = X.bid * 8 + X.wave, NGW = X.G * 8;
    for (int rg = gw; rg < T / 16; rg += NGW) {
        const int row0 = rg * 16, b = row0 >> 14;
        const float* mb = mod + (size_t)(l * 2 + b) * 6144;
        f32x4 aw[4], sh[4];
#pragma unroll
        for (int j = 0; j < 4; ++j) { const int k = 256 * j + 4 * X.lane; const f32x4 nw = *(const f32x4*)(a.nmw + l * D + k); const f32x4 sc = *(const f32x4*)(mb + 1024 + k); aw[j] = nw * (sc + 1.0f); sh[j] = *(const f32x4*)(mb + k); }
        v2u pre[4][4];
#pragma unroll
        for (int q = 0; q < 4; ++q) { const v2u* xp = (const v2u*)(xin + (size_t)(row0 + q) * D) + X.lane;
#pragma unroll
            for (int j = 0; j < 4; ++j) pre[q][j] = xp[64 * j]; }
#pragma unroll 1
        for (int rb = 0; rb < 16; rb += 4) {
#pragma unroll
          for (int q = 0; q < 4; ++q) { const int row = row0 + rb + q;
            f32x4 v[4]; float ss = 0.f;
#pragma unroll
            for (int j = 0; j < 4; ++j) { const v2u pw = pre[q][j]; v[j] = (f32x4){bflo(pw.x), bfhi(pw.x), bflo(pw.y), bfhi(pw.y)}; }
            if (rb + 4 < 16) { const v2u* xp = (const v2u*)(xin + (size_t)(row + 4) * D) + X.lane;
#pragma unroll
                for (int j = 0; j < 4; ++j) pre[q][j] = xp[64 * j]; }
#pragma unroll
            for (int j = 0; j < 4; ++j) ss += (v[j].x * v[j].x + v[j].y * v[j].y) + (v[j].z * v[j].z + v[j].w * v[j].w);
            ss = wave_sum(ss, X.lane); const float rstd = __builtin_amdgcn_rsqf(ss * (1.0f / D) + EPS);
            unsigned* o4 = (unsigned*)(hb + (size_t)row * D) + X.lane;
#pragma unroll
            for (int j = 0; j < 4; ++j) { v[j] = v[j] * rstd * aw[j] + sh[j]; o4[64 * j] = pk4_fp8(v[j].x, v[j].y, v[j].z, v[j].w); }
          }
        }
    }
}

DI void attn_unit(const Args& a, const Ctx& X, int l, int unit) {
    unsigned char* ws = a.ws; const bf16* proj = (const bf16*)(ws + WS_PROJ); unsigned char* ao = (unsigned char*)(ws + WS_H);
    const float* cs = (const float*)(ws + WS_ROPE); const float* sn = cs + (size_t)T * 8;
    const int b = unit >> 8, rem = unit & 255, nb = rem >> 1, kvh = rem & 1; const int tok0 = b * SEQ + nb * 128;
    LAS bf16* Kl = (LAS bf16*)X.lds;
    LAS bf16* VT = (LAS bf16*)(X.lds + 36864);
    int lane = X.lane; asm volatile("" : "+v"(lane));
    const int c16 = lane & 15, quad = lane >> 4;
    v2u nq[2][2]; f32x4 ncs[2][2], nsn[2][2];
#define AT_PREF(task_) do { const int g_ = (task_) >> 2; _Pragma("unroll") for (int rt = 0; rt < 2; ++rt) { const int tq_ = tok0 + 32 * ((task_) & 3) + 16 * rt + c16; \
        const unsigned char* qp_ = (const unsigned char*)(proj + (size_t)tq_ * NPROJ) + 512 * ((kvh * 4 + g_) >> 2) + ((kvh * 4 + g_) & 3) * 64; nq[rt][0] = *(const v2u*)(qp_ + 8 * quad); nq[rt][1] = *(const v2u*)(qp_ + 32 + 8 * quad); \
        ncs[rt][0] = *(const f32x4*)(cs + (size_t)tq_ * 8); ncs[rt][1] = *(const f32x4*)(cs + (size_t)tq_ * 8 + 4); nsn[rt][0] = *(const f32x4*)(sn + (size_t)tq_ * 8); nsn[rt][1] = *(const f32x4*)(sn + (size_t)tq_ * 8 + 4); } } while (0)
    AT_PREF(X.wave);
    float qw[16];
#pragma unroll
    for (int i = 0; i < 8; ++i) { qw[i] = a.qnw[l * 64 + 8 * quad + i]; qw[8 + i] = a.qnw[l * 64 + 32 + 8 * quad + i]; }
    const f32x4 sk4 = *(const f32x4*)(a.sinks + l * 8 + kvh * 4);
    {
        const int row = X.tid >> 1, half = X.tid & 1; const int tokk = tok0 - 128 + row; const bool valid = (nb > 0) || (row >= 128);
        float y[32]; float vv[32];
        f32x4 kn4[8], rc4[2], rs4[2];
        { const float* knp = a.knw + l * 64 + half * 32; const size_t tkc = (size_t)(valid ? tokk : tok0) * 8;
#pragma unroll
          for (int i = 0; i < 8; ++i) kn4[i] = *(const f32x4*)(knp + 4 * i);
          rc4[0] = *(const f32x4*)(cs + tkc); rc4[1] = *(const f32x4*)(cs + tkc + 4); rs4[0] = *(const f32x4*)(sn + tkc); rs4[1] = *(const f32x4*)(sn + tkc + 4); }
        if (valid) {
            const unsigned char* rowp = (const unsigned char*)(proj + (size_t)tokk * NPROJ) + 512 * 2 + kvh * 64 + half * 32; const v4u kw0 = *(const v4u*)rowp, kw1 = *(const v4u*)(rowp + 16), vw0 = *(const v4u*)(rowp + 128), vw1 = *(const v4u*)(rowp + 144);
            const unsigned kd[8] = {kw0.x, kw0.y, kw0.z, kw0.w, kw1.x, kw1.y, kw1.z, kw1.w}, vd[8] = {vw0.x, vw0.y, vw0.z, vw0.w, vw1.x, vw1.y, vw1.z, vw1.w};
#pragma unroll
            for (int q = 0; q < 8; ++q) { const f32x4 kf4 = fp8x4(kd[q]), vf4 = fp8x4(vd[q]) * (1.0f / 16.0f);
#pragma unroll
                for (int j = 0; j < 4; ++j) { y[4 * q + j] = kf4[j]; vv[4 * q + j] = vf4[j]; } }
        } else {
#pragma unroll
            for (int i = 0; i < 32; ++i) { y[i] = 0.f; vv[i] = 0.f; } }
        float ss = 0.f;
#pragma unroll
        for (int i = 0; i < 32; ++i) ss += y[i] * y[i];
        ss += shx(ss, 1, lane); const float rstd = __builtin_amdgcn_rsqf(ss * (1.0f / 64.0f) + EPS * 256.0f);
#pragma unroll
        for (int i = 0; i < 32; ++i) y[i] = y[i] * rstd * kn4[i >> 2][i & 3];
        if (half == 0 && valid) {
#pragma unroll
            for (int d = 0; d < 8; ++d) { const float c = rc4[d >> 2][d & 3], s = rs4[d >> 2][d & 3]; const float t1 = y[d], t2 = y[d + 8]; y[d] = t1 * c - t2 * s; y[d + 8] = t2 * c + t1 * s; } }
#pragma unroll
        for (int q = 0; q < 4; ++q) { v4u w; w.x = pk2(y[8 * q], y[8 * q + 1]); w.y = pk2(y[8 * q + 2], y[8 * q + 3]); w.z = pk2(y[8 * q + 4], y[8 * q + 5]); w.w = pk2(y[8 * q + 6], y[8 * q + 7]);
            *(LAS v4u*)(Kl + row * 72 + half * 32 + 8 * q) = w; }
#pragma unroll
        for (int i = 0; i < 32; ++i) VT[(half * 32 + i) * 280 + row] = (bf16)f2bf(vv[i]);
        if (X.tid < 64) {
#pragma unroll
            for (int cc = 256; cc < 280; ++cc) VT[X.tid * 280 + cc] = 0; }
    }
    __syncthreads();
    int dbase = 4 * quad - c16; asm volatile("" : "+v"(dbase));
#pragma unroll 1
    for (int it = 0; it < 2; ++it) {
        const int task = X.wave + 8 * it; const int g = task >> 2, rq = task & 3, ka = 2 * rq, head = kvh * 4 + g;
        const float sinkl = ((g == 0) ? sk4.x : ((g == 1) ? sk4.y : ((g == 2) ? sk4.z : sk4.w))) * 1.4426950408889634f;
        float qv[2][16]; float ss[2]; f32x4 cc[2][2], sv4[2][2];
#pragma unroll
        for (int rt = 0; rt < 2; ++rt) { const v2u w0 = nq[rt][0], w1 = nq[rt][1]; cc[rt][0] = ncs[rt][0]; cc[rt][1] = ncs[rt][1]; sv4[rt][0] = nsn[rt][0]; sv4[rt][1] = nsn[rt][1];
            { const f32x4 q0 = fp8x4(w0.x), q1 = fp8x4(w0.y), q2 = fp8x4(w1.x), q3 = fp8x4(w1.y);
#pragma unroll
              for (int j = 0; j < 4; ++j) { qv[rt][j] = q0[j]; qv[rt][4 + j] = q1[j]; qv[rt][8 + j] = q2[j]; qv[rt][12 + j] = q3[j]; } }
            ss[rt] = (((qv[rt][0] * qv[rt][0] + qv[rt][1] * qv[rt][1]) + (qv[rt][2] * qv[rt][2] + qv[rt][3] * qv[rt][3])) + ((qv[rt][4] * qv[rt][4] + qv[rt][5] * qv[rt][5]) + (qv[rt][6] * qv[rt][6] + qv[rt][7] * qv[rt][7])))
                   + (((qv[rt][8] * qv[rt][8] + qv[rt][9] * qv[rt][9]) + (qv[rt][10] * qv[rt][10] + qv[rt][11] * qv[rt][11])) + ((qv[rt][12] * qv[rt][12] + qv[rt][13] * qv[rt][13]) + (qv[rt][14] * qv[rt][14] + qv[rt][15] * qv[rt][15]))); }
        { const float t0 = shx(ss[0], 16, lane), t1 = shx(ss[1], 16, lane); ss[0] += t0; ss[1] += t1; }
        { const float t0 = shx(ss[0], 32, lane), t1 = shx(ss[1], 32, lane); ss[0] += t0; ss[1] += t1; }
        float ot[2][8];
#pragma unroll
        for (int rt = 0; rt < 2; ++rt) { const float rs_ = __builtin_amdgcn_rsqf(ss[rt] * (1.0f / 64.0f) + EPS * 256.0f) * (0.125f * 1.4426950408889634f);
#pragma unroll
            for (int i = 0; i < 16; ++i) qv[rt][i] = qv[rt][i] * rs_ * qw[i]; }
#pragma unroll
        for (int rt = 0; rt < 2; ++rt)
#pragma unroll
            for (int d = 0; d < 8; ++d) ot[rt][d] = shx(qv[rt][d], 16, lane);
        bf16x8 qf[2][2];
#pragma unroll
        for (int rt = 0; rt < 2; ++rt) { const float cv[8] = {cc[rt][0].x, cc[rt][0].y, cc[rt][0].z, cc[rt][0].w, cc[rt][1].x, cc[rt][1].y, cc[rt][1].z, cc[rt][1].w}, sv[8] = {sv4[rt][0].x, sv4[rt][0].y, sv4[rt][0].z, sv4[rt][0].w, sv4[rt][1].x, sv4[rt][1].y, sv4[rt][1].z, sv4[rt][1].w};
#pragma unroll
            for (int d = 0; d < 8; ++d) { if (quad == 0) qv[rt][d] = qv[rt][d] * cv[d] - ot[rt][d] * sv[d]; else if (quad == 1) qv[rt][d] = qv[rt][d] * cv[d] + ot[rt][d] * sv[d]; }
            v4u w; w.x = pk2m(qv[rt][0], qv[rt][1]); w.y = pk2m(qv[rt][2], qv[rt][3]); w.z = pk2m(qv[rt][4], qv[rt][5]); w.w = pk2m(qv[rt][6], qv[rt][7]); qf[rt][0] = __builtin_bit_cast(bf16x8, w);
            w.x = pk2m(qv[rt][8], qv[rt][9]); w.y = pk2m(qv[rt][10], qv[rt][11]); w.z = pk2m(qv[rt][12], qv[rt][13]); w.w = pk2m(qv[rt][14], qv[rt][15]); qf[rt][1] = __builtin_bit_cast(bf16x8, w); }
        __builtin_amdgcn_sched_barrier(0);
        f32x4 sacc[2][9];
#pragma unroll
        for (int i = 0; i < 10; ++i) { const LAS bf16* kr = Kl + (16 * (ka + i) + c16) * 72 + 8 * quad;
            const bf16x8 k0 = *(const LAS bf16x8*)kr, k1 = *(const LAS bf16x8*)(kr + 32);
            if (i <= 8) { f32x4 z = {0.f, 0.f, 0.f, 0.f}; z = __builtin_amdgcn_mfma_f32_16x16x32_bf16(k0, qf[0][0], z, 0, 0, 0); sacc[0][(i <= 8) ? i : 0] = __builtin_amdgcn_mfma_f32_16x16x32_bf16(k1, qf[0][1], z, 0, 0, 0); }
            if (i >= 1) { f32x4 z = {0.f, 0.f, 0.f, 0.f}; z = __builtin_amdgcn_mfma_f32_16x16x32_bf16(k0, qf[1][0], z, 0, 0, 0); sacc[1][(i >= 1) ? i - 1 : 0] = __builtin_amdgcn_mfma_f32_16x16x32_bf16(k1, qf[1][1], z, 0, 0, 0); }
            if ((i & 3) == 3) asm volatile("" ::: "memory"); }
        __builtin_amdgcn_sched_barrier(0);
        if (it == 0) { AT_PREF(X.wave + 8); }
        if (nb > 0) {
#pragma unroll
            for (int rt = 0; rt < 2; ++rt)
#pragma unroll
                for (int j = 0; j < 4; ++j) { sacc[rt][0][j] = (dbase + j > 0) ? sacc[rt][0][j] : -3.0e38f; sacc[rt][8][j] = (dbase + j <= 0) ? sacc[rt][8][j] : -3.0e38f; }
        } else {
#pragma unroll
            for (int rt = 0; rt < 2; ++rt) { int kbase = 16 * (ka + rt) + 4 * quad; asm volatile("" : "+v"(kbase));
#pragma unroll
                for (int i = 0; i < 9; ++i)
#pragma unroll
                    for (int j = 0; j < 4; ++j) { const int dlt = dbase + 16 * i + j; const int kj = kbase + 16 * i + j; const bool ok = (dlt > 0) && (dlt <= 128) && (kj >= 128); sacc[rt][i][j] = ok ? sacc[rt][i][j] : -3.0e38f; } } }
        float mx[2], sum[2], inv[2];
#pragma unroll
        for (int rt = 0; rt < 2; ++rt) { float m0 = sacc[rt][0][0], m1 = sacc[rt][0][1], m2 = sacc[rt][0][2], m3 = sacc[rt][0][3];
#pragma unroll
            for (int i = 1; i < 9; ++i) { m0 = fmaxf(m0, sacc[rt][i][0]); m1 = fmaxf(m1, sacc[rt][i][1]); m2 = fmaxf(m2, sacc[rt][i][2]); m3 = fmaxf(m3, sacc[rt][i][3]); }
            mx[rt] = fmaxf(sinkl, fmaxf(fmaxf(m0, m1), fmaxf(m2, m3))); }
        { const float t0 = shx(mx[0], 16, lane), t1 = shx(mx[1], 16, lane); mx[0] = fmaxf(mx[0], t0); mx[1] = fmaxf(mx[1], t1); }
        { const float t0 = shx(mx[0], 32, lane), t1 = shx(mx[1], 32, lane); mx[0] = fmaxf(mx[0], t0); mx[1] = fmaxf(mx[1], t1); }
#pragma unroll
        for (int rt = 0; rt < 2; ++rt) { float s0 = 0.f, s1 = 0.f, s2 = 0.f, s3 = 0.f;
#pragma unroll
            for (int i = 0; i < 9; ++i) { const f32x4 p = {__builtin_amdgcn_exp2f(sacc[rt][i][0] - mx[rt]), __builtin_amdgcn_exp2f(sacc[rt][i][1] - mx[rt]), __builtin_amdgcn_exp2f(sacc[rt][i][2] - mx[rt]), __builtin_amdgcn_exp2f(sacc[rt][i][3] - mx[rt])};
                sacc[rt][i] = p; s0 += p[0]; s1 += p[1]; s2 += p[2]; s3 += p[3]; }
            sum[rt] = (s0 + s1) + (s2 + s3); }
        { const float t0 = shx(sum[0], 16, lane), t1 = shx(sum[1], 16, lane); sum[0] += t0; sum[1] += t1; }
        { const float t0 = shx(sum[0], 32, lane), t1 = shx(sum[1], 32, lane); sum[0] += t0; sum[1] += t1; }
#pragma unroll
        for (int rt = 0; rt < 2; ++rt) inv[rt] = __builtin_amdgcn_rcpf(sum[rt] + __builtin_amdgcn_exp2f(sinkl - mx[rt])) * 8.0f;
        __builtin_amdgcn_sched_barrier(0);
        f32x4 oacc[2][4];
#pragma unroll
        for (int rt = 0; rt < 2; ++rt)
#pragma unroll
            for (int et = 0; et < 4; ++et) oacc[rt][et] = (f32x4){0.f, 0.f, 0.f, 0.f};
#pragma unroll
        for (int kk = 0; kk < 5; ++kk) {
            v4u p0, p1;
            p0.x = pk2m(sacc[0][2 * kk][0], sacc[0][2 * kk][1]); p0.y = pk2m(sacc[0][2 * kk][2], sacc[0][2 * kk][3]);
            if (kk < 4) { p0.z = pk2m(sacc[0][(kk < 4) ? 2 * kk + 1 : 0][0], sacc[0][(kk < 4) ? 2 * kk + 1 : 0][1]); p0.w = pk2m(sacc[0][(kk < 4) ? 2 * kk + 1 : 0][2], sacc[0][(kk < 4) ? 2 * kk + 1 : 0][3]); } else { p0.z = 0u; p0.w = 0u; }
            if (kk > 0) { p1.x = pk2m(sacc[1][(kk > 0) ? 2 * kk - 1 : 0][0], sacc[1][(kk > 0) ? 2 * kk - 1 : 0][1]); p1.y = pk2m(sacc[1][(kk > 0) ? 2 * kk - 1 : 0][2], sacc[1][(kk > 0) ? 2 * kk - 1 : 0][3]); } else { p1.x = 0u; p1.y = 0u; }
            p1.z = pk2m(sacc[1][2 * kk][0], sacc[1][2 * kk][1]); p1.w = pk2m(sacc[1][2 * kk][2], sacc[1][2 * kk][3]);
            const bf16x8 pf0 = __builtin_bit_cast(bf16x8, p0), pf1 = __builtin_bit_cast(bf16x8, p1);
#pragma unroll
            for (int et = 0; et < 4; ++et) { const LAS bf16* vr = VT + (16 * et + c16) * 280 + 16 * ka + 32 * kk + 4 * quad;
                const v2u lo = *(const LAS v2u*)vr, hi = *(const LAS v2u*)(vr + 16); v4u vw; vw.x = lo.x; vw.y = lo.y; vw.z = hi.x; vw.w = hi.y; const bf16x8 vf = __builtin_bit_cast(bf16x8, vw);
                oacc[0][et] = __builtin_amdgcn_mfma_f32_16x16x32_bf16(vf, pf0, oacc[0][et], 0, 0, 0);
                oacc[1][et] = __builtin_amdgcn_mfma_f32_16x16x32_bf16(vf, pf1, oacc[1][et], 0, 0, 0); }
            asm volatile("" ::: "memory"); }
#pragma unroll
        for (int rt = 0; rt < 2; ++rt) { const int tokq = tok0 + 32 * rq + 16 * rt + c16;
#pragma unroll
            for (int et = 0; et < 4; ++et)
                *(unsigned*)(ao + (size_t)tokq * 512 + head * 64 + 16 * et + 4 * quad) = pk4_fp8(oacc[rt][et][0] * inv[rt], oacc[rt][et][1] * inv[rt], oacc[rt][et][2] * inv[rt], oacc[rt][et][3] * inv[rt]); }
    }
    __syncthreads();
#undef AT_PREF
}

constexpr int ML_Q = 0, ML_K = 17408, ML_KET = 34816, ML_VT = 53248, ML_CT = 73984, ML_CW = 113152, ML_CB = 118272, ML_RED = 118784, ML_NW = 119296, ML_GT = 119808;
DI float bfw(unsigned w, int hi) { return hi ? bfhi(w) : bflo(w); }
template <bool L3> DI void mlstm_unit(const Args& a, const Ctx& X, int l, int unit) {
    unsigned char* ws = a.ws; const bf16* proj = (const bf16*)(ws + WS_PROJ); unsigned char* hm = (unsigned char*)(ws + WS_H) + (size_t)T * 512;
    unsigned char* kcb = (unsigned char*)(ws + WS_KC);
    const float* gates = (const float*)(ws + WS_GATES); bf16* mlc = (bf16*)(ws + WS_MLC) + (size_t)unit * 18432; float* mlb = (float*)(ws + WS_MLB);
    const int seq = unit >> 5, sj = unit & 31, b = seq >> 2, hh = seq & 3; const int tokbase = b * SEQ + sj * 512;
    LAS bf16* Qs = (LAS bf16*)(X.lds + ML_Q); LAS bf16* Ks = (LAS bf16*)(X.lds + ML_K); LAS bf16* KET = (LAS bf16*)(X.lds + ML_KET);
    LAS bf16* VT = (LAS bf16*)(X.lds + ML_VT); LAS bf16* CT = (LAS bf16*)(X.lds + ML_CT); LAS float* CW = (LAS float*)(X.lds + ML_CW);
    LAS float* CB = (LAS float*)(X.lds + ML_CB); LAS float* RED = (LAS float*)(X.lds + ML_RED); LAS float* NW = (LAS float*)(X.lds + ML_NW);
    LAS float* GT = (LAS float*)(X.lds + ML_GT);
    int lane = X.lane; asm volatile("" : "+v"(lane));
    const int c16 = lane & 15, quad = lane >> 4, w = X.wave;
    int tidl = X.tid; asm volatile("" : "+v"(tidl));
    const int tg = tidl >> 5, cg = tidl & 31, t0 = 4 * tg, c0 = 4 * cg;
    unsigned rq[7], rk[7], rv[4], kcv[4];
#define ML_LBAR() do { asm volatile("s_waitcnt lgkmcnt(0)" ::: "memory"); __builtin_amdgcn_s_barrier(); asm volatile("" ::: "memory"); } while (0)
#define ML_LOADRAW(tokc) do { _Pragma("unroll") for (int j = 0; j < 7; ++j) { const int tt = (tokc) + t0 - 3 + j; const bool ok = tt >= b * SEQ; const unsigned char* rp = (const unsigned char*)(proj + (size_t)(ok ? tt : (tokc)) * NPROJ) + 512 * ((L3 ? 3 : 5) + (hh >> 1)) + (hh & 1) * 128 + c0; \
        if (L3) rq[j] = *(const unsigned*)rp; else rk[j] = *(const unsigned*)rp; } \
        if (L3) { _Pragma("unroll") for (int i = 0; i < 4; ++i) kcv[i] = *(const unsigned*)(kcb + (size_t)((tokc) + t0 + i) * 512 + hh * 128 + c0); } \
        _Pragma("unroll") for (int i = 0; i < 4; ++i) rv[i] = *(const unsigned*)((const unsigned char*)(proj + (size_t)((tokc) + t0 + i) * NPROJ) + 512 * (7 + (hh >> 1)) + (hh & 1) * 128 + c0); } while (0)
    ML_LOADRAW(tokbase);
    { float cwv[3];
#pragma unroll
      for (int k3 = 0; k3 < 3; ++k3) { const int idx = (X.tid + 512 * k3 < 1280) ? (X.tid + 512 * k3) : 1279; const int tap = idx >> 8, ch = idx & 255; const int gch = (ch < 128) ? (hh * 128 + ch) : (512 + hh * 128 + (ch - 128));
          const float* cp = (tap < 4) ? (a.conv_w + (size_t)(l * 4 + tap) * 1024 + gch) : (a.conv_b + l * 1024 + gch); cwv[k3] = *cp; }
      const float nwv = a.mnw[l * 512 + hh * 128 + (X.tid & 127)];
      const float* gp = gates + (size_t)(tokbase + X.tid) * 8; const float g0v = gp[hh], g1v = gp[4 + hh];
      CW[X.tid] = cwv[0] * (1.0f / 16.0f); CW[512 + X.tid] = cwv[1] * (1.0f / 16.0f); if (X.tid < 256) CW[1024 + X.tid] = cwv[2];
      if (X.tid < 128) NW[X.tid] = nwv;
      GT[2 * X.tid] = g0v; GT[2 * X.tid + 1] = g1v; }
    for (int idx = X.tid; idx < 16 * 72; idx += 512) { const bf16 ov = (idx < 72) ? (bf16)0x3F80 : (bf16)0; VT[128 * 72 + idx] = ov; if (!L3) ((LAS bf16*)(X.lds + ML_CT))[128 * 72 + idx] = ov; }
    f32x4 cacc[9];
#pragma unroll
    for (int et = 0; et < 9; ++et) {
        if (L3) {
            { const v2u pw = *(const v2u*)(mlc + (16 * et + c16) * 128 + 16 * w + 4 * quad); cacc[et] = (f32x4){bflo(pw.x), bfhi(pw.x), bflo(pw.y), bfhi(pw.y)}; *(LAS v2u*)(CT + (16 * et + c16) * 136 + 16 * w + 4 * quad) = pw; }
        } else cacc[et] = (f32x4){0.f, 0.f, 0.f, 0.f};
    }
    float bsum = 0.f;
    __syncthreads();
#pragma unroll 1
    for (int c = 0; c < 8; ++c) {
        const int tok0 = tokbase + c * 64;
        LAS bf16* KETc = KET; LAS bf16* VTc = VT;
        const f32x2 gl = *(const LAS f32x2*)(GT + 2 * (c * 64 + lane)); float bsc = gl.y; const float li = gl.x;
#pragma unroll
        for (int o = 1; o < 64; o <<= 1) { const float v = shl_(bsc, (lane - o) & 63); if (lane >= o) bsc += v; }
        const float bl = shl_(bsc, 63); const float csv = li - bsc;
        if (w == 0) { CB[lane] = bsc; CB[64 + lane] = csv; }
        bsum += bl;
        const int tt_ = w & 3, eh = w >> 2; const int tq = 16 * tt_ + c16;
        unsigned ogv[4];
        if (L3) {
#pragma unroll
            for (int x = 0; x < 4; ++x) ogv[x] = *(const unsigned*)((const unsigned char*)(proj + (size_t)(tok0 + tq) * NPROJ) + 512 * (9 + (hh >> 1)) + (hh & 1) * 128 + 16 * (4 * eh + x) + 4 * quad); }
        { float fac[4];
#pragma unroll
          for (int i = 0; i < 4; ++i) fac[i] = __expf(bl + shl_(csv, t0 + i));
#pragma unroll
          for (int j = 0; j < 3; ++j) { const bool ok = tok0 + t0 - 3 + j >= b * SEQ;
              if (L3) rq[j] = ok ? rq[j] : 0u; else rk[j] = ok ? rk[j] : 0u; }
#pragma unroll
          for (int qk = (L3 ? 0 : 1); qk < 2; ++qk) {
              float o[4][4];
              if (L3 && qk) {
#pragma unroll
                  for (int i = 0; i < 4; ++i) { const f32x4 kf4 = fp8x4(kcv[i]) * (1.0f / 256.0f); o[i][0] = kf4[0]; o[i][1] = kf4[1]; o[i][2] = kf4[2]; o[i][3] = kf4[3]; }
              } else {
              const f32x4 bias = *(const LAS f32x4*)(CW + 4 * 256 + qk * 128 + c0);
#pragma unroll
              for (int i = 0; i < 4; ++i) { o[i][0] = bias.x; o[i][1] = bias.y; o[i][2] = bias.z; o[i][3] = bias.w; }
#pragma unroll
              for (int j = 0; j < 4; ++j) { const f32x4 wj = *(const LAS f32x4*)(CW + j * 256 + qk * 128 + c0);
#pragma unroll
                  for (int i = 0; i < 4; ++i) { const int rr = (int)(qk ? rk[i + j] : rq[i + j]);
                      o[i][0] += wj.x * __builtin_amdgcn_cvt_f32_fp8(rr, 0); o[i][1] += wj.y * __builtin_amdgcn_cvt_f32_fp8(rr, 1); o[i][2] += wj.z * __builtin_amdgcn_cvt_f32_fp8(rr, 2); o[i][3] += wj.w * __builtin_amdgcn_cvt_f32_fp8(rr, 3); } }
#pragma unroll
              for (int i = 0; i < 4; ++i)
#pragma unroll
                  for (int ch = 0; ch < 4; ++ch) { const float z = o[i][ch]; o[i][ch] = z * __builtin_amdgcn_rcpf(1.0f + __expf(-z)) * (qk ? 0.08838834764831845f : 1.0f); }
              }
              if (!L3 && qk) {
#pragma unroll
                  for (int i = 0; i < 4; ++i) { const unsigned pw = pk4_fp8(o[i][0] * 256.0f, o[i][1] * 256.0f, o[i][2] * 256.0f, o[i][3] * 256.0f); *(unsigned*)(kcb + (size_t)(tok0 + t0 + i) * 512 + hh * 128 + c0) = pw;
                      const f32x4 kf4 = fp8x4(pw) * (1.0f / 256.0f); o[i][0] = kf4[0]; o[i][1] = kf4[1]; o[i][2] = kf4[2]; o[i][3] = kf4[3]; } }
              if (L3) { LAS bf16* dst = (qk ? Ks : Qs) + t0 * 136 + c0;
#pragma unroll
                  for (int i = 0; i < 4; ++i) { v2u pw; pw.x = pk2(o[i][0], o[i][1]); pw.y = pk2(o[i][2], o[i][3]); *(LAS v2u*)(dst + i * 136) = pw; } }
              if (qk) {
#pragma unroll
                  for (int ch = 0; ch < 4; ++ch) { v2u pw; pw.x = pk2(o[0][ch] * fac[0], o[1][ch] * fac[1]); pw.y = pk2(o[2][ch] * fac[2], o[3][ch] * fac[3]); *(LAS v2u*)(KETc + (c0 + ch) * 72 + t0) = pw; } }
          }
          { v2u p0, p1, p2, p3;
            float vf[4][4];
#pragma unroll
            for (int i = 0; i < 4; ++i) { const int rr = (int)rv[i]; vf[i][0] = __builtin_amdgcn_cvt_f32_fp8(rr, 0); vf[i][1] = __builtin_amdgcn_cvt_f32_fp8(rr, 1); vf[i][2] = __builtin_amdgcn_cvt_f32_fp8(rr, 2); vf[i][3] = __builtin_amdgcn_cvt_f32_fp8(rr, 3); }
            p0.x = pk2(vf[0][0], vf[1][0]); p0.y = pk2(vf[2][0], vf[3][0]);
            p1.x = pk2(vf[0][1], vf[1][1]); p1.y = pk2(vf[2][1], vf[3][1]);
            p2.x = pk2(vf[0][2], vf[1][2]); p2.y = pk2(vf[2][2], vf[3][2]);
            p3.x = pk2(vf[0][3], vf[1][3]); p3.y = pk2(vf[2][3], vf[3][3]);
            *(LAS v2u*)(VTc + (c0 + 0) * 72 + t0) = p0; *(LAS v2u*)(VTc + (c0 + 1) * 72 + t0) = p1; *(LAS v2u*)(VTc + (c0 + 2) * 72 + t0) = p2; *(LAS v2u*)(VTc + (c0 + 3) * 72 + t0) = p3; }
        }
        ML_LBAR();
        if (c < 7) { ML_LOADRAW(tok0 + 64); }
        float hval[4][4];
        if (L3) {
            bf16x8 qf[4];
#pragma unroll
            for (int ks = 0; ks < 4; ++ks) qf[ks] = *(const LAS bf16x8*)(Qs + tq * 136 + 32 * ks + 8 * quad);
            f32x4 sacc[4];
#pragma unroll
            for (int st = 0; st < 4; ++st) { f32x4 z = {0.f, 0.f, 0.f, 0.f};
#pragma unroll
                for (int ks = 0; ks < 4; ++ks) z = __builtin_amdgcn_mfma_f32_16x16x32_bf16(*(const LAS bf16x8*)(Ks + (16 * st + c16) * 136 + 32 * ks + 8 * quad), qf[ks], z, 0, 0, 0);
                sacc[st] = z; }
            const float cbt = CB[tq];
            f32x4 csq[4];
#pragma unroll
            for (int st = 0; st < 4; ++st) csq[st] = *(const LAS f32x4*)(CB + 64 + 16 * st + 4 * quad);
#pragma unroll
            for (int st = 0; st < 4; ++st)
#pragma unroll
                for (int j = 0; j < 4; ++j) { const int s = 16 * st + 4 * quad + j; const float d = (s <= tq) ? __expf(cbt + csq[st][j]) : 0.f; sacc[st][j] *= d; }
            bf16x8 pf[2];
#pragma unroll
            for (int kk = 0; kk < 2; ++kk) { v4u pw; pw.x = pk2m(sacc[2 * kk][0], sacc[2 * kk][1]); pw.y = pk2m(sacc[2 * kk][2], sacc[2 * kk][3]); pw.z = pk2m(sacc[2 * kk + 1][0], sacc[2 * kk + 1][1]); pw.w = pk2m(sacc[2 * kk + 1][2], sacc[2 * kk + 1][3]); pf[kk] = __builtin_bit_cast(bf16x8, pw); }
            const float ebt = __expf(cbt);
            f32x4 nn[5];
#pragma unroll
            for (int x = 0; x < 5; ++x) { const int et = (x < 4) ? (4 * eh + x) : 8; f32x4 na = {0.f, 0.f, 0.f, 0.f}, ia = {0.f, 0.f, 0.f, 0.f};
#pragma unroll
                for (int kk = 0; kk < 2; ++kk) { const LAS bf16* vr = VT + (16 * et + c16) * 72 + 32 * kk + 4 * quad; const v2u lo = *(const LAS v2u*)vr, hi = *(const LAS v2u*)(vr + 16); v4u vw; vw.x = lo.x; vw.y = lo.y; vw.z = hi.x; vw.w = hi.y;
                    na = __builtin_amdgcn_mfma_f32_16x16x32_bf16(__builtin_bit_cast(bf16x8, vw), pf[kk], na, 0, 0, 0); }
#pragma unroll
                for (int ks = 0; ks < 4; ++ks) ia = __builtin_amdgcn_mfma_f32_16x16x32_bf16(*(const LAS bf16x8*)(CT + (16 * et + c16) * 136 + 32 * ks + 8 * quad), qf[ks], ia, 0, 0, 0);
                nn[x] = na + ia * ebt; }
            const float den = shl_(nn[4][0], c16); const float inv = __builtin_amdgcn_rcpf(fmaxf(fabsf(den), 1.0f)) * (1.0f / 16.0f);
            float ss = 0.f;
#pragma unroll
            for (int x = 0; x < 4; ++x)
#pragma unroll
                for (int j = 0; j < 4; ++j) { hval[x][j] = nn[x][j] * inv; ss += hval[x][j] * hval[x][j]; }
            ss += shx(ss, 16, lane); ss += shx(ss, 32, lane);
            if (quad == 0) RED[eh * 64 + tq] = ss;
        }
        { const float ebl = __expf(bl);
          bf16x8 kf[2];
#pragma unroll
          for (int kk = 0; kk < 2; ++kk) kf[kk] = *(const LAS bf16x8*)(KETc + (16 * w + c16) * 72 + 32 * kk + 8 * quad);
#pragma unroll
          for (int et = 0; et < 9; ++et) { f32x4 z = cacc[et] * ebl;
#pragma unroll
              for (int kk = 0; kk < 2; ++kk) z = __builtin_amdgcn_mfma_f32_16x16x32_bf16(kf[kk], *(const LAS bf16x8*)(VTc + (16 * et + c16) * 72 + 32 * kk + 8 * quad), z, 0, 0, 0);
              cacc[et] = z; } }
        if (L3) {
            ML_LBAR();
            const float rstd = __builtin_amdgcn_rsqf((RED[tq] + RED[64 + tq]) * (1.0f / 128.0f) + EPS);
#pragma unroll
            for (int x = 0; x < 4; ++x) { const int e = 16 * (4 * eh + x) + 4 * quad; const f32x4 og = u8x4_to_f32(ogv[x]) * (1.0f / 255.0f);
                const float y0 = hval[x][0] * rstd * NW[e] * og[0], y1 = hval[x][1] * rstd * NW[e + 1] * og[1], y2 = hval[x][2] * rstd * NW[e + 2] * og[2], y3 = hval[x][3] * rstd * NW[e + 3] * og[3];
                *(unsigned*)(hm + (size_t)(tok0 + tq) * 512 + hh * 128 + e) = pk4_fp8(y0 * 8.0f, y1 * 8.0f, y2 * 8.0f, y3 * 8.0f); }
#pragma unroll
            for (int et = 0; et < 9; ++et) { const f32x4 z = cacc[et]; v2u pw; pw.x = pk2(z[0], z[1]); pw.y = pk2(z[2], z[3]); *(LAS v2u*)(CT + (16 * et + c16) * 136 + 16 * w + 4 * quad) = pw; }
        }
        else ML_LBAR();
    }
#undef ML_LOADRAW
#undef ML_LBAR
    if (!L3) {
#pragma unroll
        for (int et = 0; et < 9; ++et)
            { v2u pw; pw.x = pk2(cacc[et][0], cacc[et][1]); pw.y = pk2(cacc[et][2], cacc[et][3]); *(v2u*)(mlc + (16 * et + c16) * 128 + 16 * w + 4 * quad) = pw; }
        if (X.tid == 0) mlb[unit] = bsum;
    }
}
DI void mlstm_scan(const Args& a, const Ctx& X) {
    bf16* mlc = (bf16*)(a.ws + WS_MLC); const float* mlb = (const float*)(a.ws + WS_MLB);
    for (int idx = X.bid * 512 + X.tid; idx < 8 * 9216; idx += X.G * 512) { const int seq = idx / 9216, el = 2 * (idx - seq * 9216); float cz = 0.f; asm volatile("" : "+v"(cz)); f32x2 carry = {cz, cz};
        bf16* p0 = mlc + (size_t)seq * 32 * 18432 + el; unsigned v[32]; float dcy[32];
#pragma unroll
        for (int j = 0; j < 32; ++j) { v[j] = *(const unsigned*)(p0 + (size_t)j * 18432); dcy[j] = mlb[seq * 32 + j]; }
#pragma unroll
        for (int j = 0; j < 32; ++j) { *(unsigned*)(p0 + (size_t)j * 18432) = pk2(carry.x, carry.y); const f32x2 vj = {bflo(v[j]), bfhi(v[j])}; carry = carry * __expf(dcy[j]) + vj; } }
}

constexpr int P6_WR = 0, P6_AT = 33024, P6_SH = 37120, P6_LG = 41216, P6_HIST = 65536;
DI void p6_norm_route(const Args& a, const Ctx& X, int l, const bf16* xin) {
    unsigned char* ws = a.ws;
    LAS bf16* wrb = (LAS bf16*)(X.lds + P6_WR);
    LAS float* at = (LAS float*)(X.lds + P6_AT); LAS float* sht = (LAS float*)(X.lds + P6_SH);
    LAS float* lg = (LAS float*)(X.lds + P6_LG) + X.wave * 272;
    { f32x4 rw[8];
#pragma unroll
      for (int i = 0; i < 8; ++i) rw[i] = *(const f32x4*)(a.router_w + 4 * (X.tid + 512 * i));
#pragma unroll
      for (int i = 0; i < 8; ++i) { const int i4 = X.tid + 512 * i; const int k = i4 >> 2, e0 = (i4 & 3) * 4;
          wrb[(e0 + 0) * 1032 + k] = (bf16)f2bf(rw[i].x); wrb[(e0 + 1) * 1032 + k] = (bf16)f2bf(rw[i].y); wrb[(e0 + 2) * 1032 + k] = (bf16)f2bf(rw[i].z); wrb[(e0 + 3) * 1032 + k] = (bf16)f2bf(rw[i].w); } }
    const float* mod = (const float*)(ws + WS_MOD); unsigned char* hb = (unsigned char*)(ws + WS_H); float* tgate = (float*)(ws + WS_TGATE); int* tokl = (int*)(ws + WS_TOKL);
    const float* ssq = (const float*)(ws + WS_SSQ);
    unsigned* cnt = (unsigned*)(ws + WS_CTL) + CW_CNT + l * 2048;
    LAS int* hist = (LAS int*)(X.lds + P6_HIST); LAS int* cbase = hist + 32;
    int lane = X.lane; asm volatile("" : "+v"(lane));
    const int r = lane & 15, q = lane >> 4;
    const int gw = X.bid * 8 + X.wave, NGW = X.G * 8;
    for (int it = 0; it * NGW < T / 16; ++it) {
        const int rg = it * NGW + gw; const bool act = rg < T / 16;
        const int row0 = (act ? rg : 0) * 16; const int bb = ((it * NGW + X.bid * 8) * 16) >> 14;
        __syncthreads();
        if (X.tid < 32) hist[X.tid] = 0;
        { const float* mb = mod + (size_t)(l * 2 + (bb < 2 ? bb : 1)) * 6144;
          const float n0 = a.nfw[l * D + X.tid], n1 = a.nfw[l * D + 512 + X.tid], c0 = mb[4 * 1024 + X.tid], c1 = mb[4 * 1024 + 512 + X.tid], s0 = mb[3 * 1024 + X.tid], s1 = mb[3 * 1024 + 512 + X.tid];
          at[X.tid] = n0 * (1.0f + c0); at[512 + X.tid] = n1 * (1.0f + c1); sht[X.tid] = s0; sht[512 + X.tid] = s1; }
        __syncthreads();
        const int row = row0 + r;
        float rstd;
        { const f32x4 pp = *(const f32x4*)(ssq + (size_t)row * 16 + 4 * q); float ss = (pp.x + pp.y) + (pp.z + pp.w); ss += shx(ss, 16, lane); ss += shx(ss, 32, lane); rstd = __builtin_amdgcn_rsqf(ss * (1.0f / D) + EPS); }
        const bf16* xr = xin + (size_t)row * D + 8 * q; unsigned char* hr = hb + (size_t)row * D + 8 * q;
        f32x4 acc = {0.f, 0.f, 0.f, 0.f};
#pragma unroll 1
        for (int sb = 0; sb < 32; sb += 8) {
            v4u xb8[8];
#pragma unroll
            for (int i = 0; i < 8; ++i) xb8[i] = *(const v4u*)(xr + 32 * (sb + i));
            asm volatile("" ::: "memory");
#pragma unroll
            for (int i = 0; i < 8; ++i) { const int s = sb + i; const v4u xw = xb8[i];
                const f32x4 x0 = {bflo(xw.x), bfhi(xw.x), bflo(xw.y), bfhi(xw.y)}, x1 = {bflo(xw.z), bfhi(xw.z), bflo(xw.w), bfhi(xw.w)};
                const f32x4 a0 = *(const LAS f32x4*)(at + 32 * s + 8 * q), a1 = *(const LAS f32x4*)(at + 32 * s + 8 * q + 4);
                const f32x4 s0 = *(const LAS f32x4*)(sht + 32 * s + 8 * q), s1 = *(const LAS f32x4*)(sht + 32 * s + 8 * q + 4);
                const f32x4 h0 = x0 * rstd * a0 + s0, h1 = x1 * rstd * a1 + s1;
                v4u w; w.x = pk2m(h0.x, h0.y); w.y = pk2m(h0.z, h0.w); w.z = pk2m(h1.x, h1.y); w.w = pk2m(h1.z, h1.w);
                { v2u w8; w8.x = pk4_fp8(h0.x, h0.y, h0.z, h0.w); w8.y = pk4_fp8(h1.x, h1.y, h1.z, h1.w); *(v2u*)(hr + 32 * s) = w8; }
                const bf16x8 bfr = *(const LAS bf16x8*)(wrb + r * 1032 + 32 * s + 8 * q);
                acc = __builtin_amdgcn_mfma_f32_16x16x32_bf16(__builtin_bit_cast(bf16x8, w), bfr, acc, 0, 0, 0); }
        }
#pragma unroll
        for (int j = 0; j < 4; ++j) lg[(4 * q + j) * 17 + r] = acc[j];
        LDS_WAIT(); asm volatile("" ::: "memory");
        int my_cls = 0; float my_ga = 0.f, my_gb = 0.f;
        if (lane < 16) {
            float sc[16], sel[16];
#pragma unroll
            for (int e = 0; e < 16; ++e) { const float p = lg[lane * 17 + e]; sc[e] = 1.0f / (1.0f + __expf(-p)); sel[e] = sc[e] + a.router_b[e]; }
            int gi = 0; float gbest = -1.0e30f;
#pragma unroll
            for (int g = 0; g < 4; ++g) { const float p0 = sel[4 * g], p1 = sel[4 * g + 1], p2 = sel[4 * g + 2], p3 = sel[4 * g + 3];
                const float gs = fmaxf(fmaxf(fmaxf(p0 + p1, p0 + p2), fmaxf(p0 + p3, p1 + p2)), fmaxf(p1 + p3, p2 + p3));
                if (gs > gbest) { gbest = gs; gi = g; } }
            float qs[4], s4[4];
#pragma unroll
            for (int i = 0; i < 4; ++i) { qs[i] = 0.f; s4[i] = 0.f; }
#pragma unroll
            for (int g = 0; g < 4; ++g) if (g == gi) {
#pragma unroll
                for (int i = 0; i < 4; ++i) { qs[i] = sel[4 * g + i]; s4[i] = sc[4 * g + i]; } }
            int i1 = 0; float b1 = qs[0];
#pragma unroll
            for (int i = 1; i < 4; ++i) if (qs[i] > b1) { b1 = qs[i]; i1 = i; }
            int i2 = -1; float b2 = -1.0e30f;
#pragma unroll
            for (int i = 0; i < 4; ++i) if (i != i1 && qs[i] > b2) { b2 = qs[i]; i2 = i; }
            const int ia = (i1 < i2) ? i1 : i2, ib = (i1 < i2) ? i2 : i1;
            float sa = 0.f, sb = 0.f;
#pragma unroll
            for (int i = 0; i < 4; ++i) { if (i == ia) sa = s4[i]; if (i == ib) sb = s4[i]; }
            const int pidx = (ia == 0) ? (ib - 1) : ((ia == 1) ? (ib + 1) : 5);
            const float inv = 1.0f / (sa + sb);
            my_cls = gi * 6 + pidx; my_ga = sa * inv; my_gb = sb * inv;
        }
        int rank = 0;
        if (act && lane < 16) rank = __hip_atomic_fetch_add(hist + my_cls, 1, __ATOMIC_RELAXED, __HIP_MEMORY_SCOPE_WORKGROUP);
        __syncthreads();
        if (X.tid < NCLS) { const int n = hist[X.tid]; cbase[X.tid] = n ? (int)__hip_atomic_fetch_add(cnt + 64 * X.tid, (unsigned)n, RLX_AGENT) : 0; }
        __syncthreads();
        if (act && lane < 16) { const int tok = row0 + lane; const int pos = cbase[my_cls] + rank;
            tokl[my_cls * CLS_CAP + pos] = tok; tgate[tok * 2] = my_ga; tgate[tok * 2 + 1] = my_gb; }
    }
}
DI MoeTab moe_tables(const Args& a, const Ctx& X, int l) {
    LAS int* tab = (LAS int*)(X.lds + TAB_OFF); LAS int* tcls = tab; LAS int* tpos = tab + 160; LAS int* cn = tab + 320; LAS int* rt_ = tab + 344;
    unsigned* cnt = (unsigned*)(a.ws + WS_CTL) + CW_CNT + l * 2048;
    if (X.tid < NCLS) cn[X.tid] = (int)__hip_atomic_load(cnt + 64 * X.tid, RLX_AGENT);
    __syncthreads();
    if (X.tid < NCLS) {
        int base = 0;
#pragma unroll 1
        for (int c = 0; c < X.tid; ++c) base += (cn[c] + 255) >> 8;
        const int n = (cn[X.tid] + 255) >> 8;
#pragma unroll 1
        for (int i = 0; i < n; ++i) { tcls[base + i] = X.tid; tpos[base + i] = i * 256; }
        if (X.tid == NCLS - 1) rt_[0] = base + n; }
    __syncthreads();
    MoeTab tb; tb.tcls = tcls; tb.tpos = tpos; tb.cnt = cn; tb.Rtot = __builtin_amdgcn_readfirstlane(rt_[0]); return tb;
}

#if defined(__HIP_DEVICE_COMPILE__)
DI Args load_args() { auto p = __builtin_amdgcn_kernarg_segment_ptr(); asm volatile("" : "+s"(p)); return *(const __attribute__((address_space(4))) Args*)p; }
#else
DI Args load_args() { return Args{}; }
#endif
__global__ void __launch_bounds__(512, 2) fwd(Args a_unused) {
    extern __shared__ __attribute__((aligned(16))) unsigned char lds_raw[];
    Ctx X; X.lds = (LAS unsigned char*)lds_raw; X.tid = threadIdx.x; X.lane = X.tid & 63; X.wave = __builtin_amdgcn_readfirstlane(X.tid >> 6); X.G = gridDim.x; X.bid = blockIdx.x;
    volatile LAS unsigned* MISC = (volatile LAS unsigned*)(X.lds + MISC_OFF);
    if (X.tid < 64) MISC[X.tid] = 0u;
    __syncthreads();
    int lo, hi; unsigned* ctl;
    { const Args a = load_args(); lo = a.ph_lo; hi = a.ph_hi; ctl = (unsigned*)(a.ws + WS_CTL); }
    XcdBarrier bar; bar.bar = ctl + CW_BAR; bar.x = 0; bar.st = MISC + 8;
    if (hi - lo > 1) bar = xcd_barrier_post(ctl + CW_BAR, MISC + 8);
#ifndef PH_MASK
#define PH_MASK 0xFFFFF
#endif
#define PON(p) ((PH_MASK >> (p)) & 1)
#ifndef DUP_MASK
#define DUP_MASK 0
#endif
#define NREP(p) (((DUP_MASK >> (p)) & 1) ? 2 : 1)
#ifndef NULEPI
#define NULEPI 0
#endif
#ifndef TSEL_MASK
#define TSEL_MASK 0
#endif
#define TSCALE 4
#define TSEL(p) ((TSEL_MASK >> (p)) & 1)
#define IN(k) (lo <= (k) && (k) < hi)
#define SEAM(k) do { if (IN(k) && IN((k) + 1)) xcd_barrier(bar); } while (0)
    unsigned long long tacc = 0ull, tph = 0ull;
#define TBEG() do { if (TSEL_MASK) tph = __builtin_amdgcn_s_memrealtime(); } while (0)
#define TEND(p) do { if (TSEL(p)) tacc += __builtin_amdgcn_s_memrealtime() - tph; } while (0)
    TBEG();
    if (PON(10) && IN(0)) { for (int rep = 0; rep < NREP(10); ++rep) { const Args a = load_args(); p0_prologue(a, X); } }
    SEAM(0); TEND(10);
    TBEG();
    for (int l = 0; l < NL; ++l) {
        const int g0 = 1 + l * NPH;
        if (PON(0) && IN(g0 + 0)) { for (int rep = 0; rep < NREP(0); ++rep) { const Args a = load_args(); unsigned char* ws = a.ws; const float* mod = (const float*)(ws + WS_MOD); bf16* proj = (bf16*)(ws + WS_PROJ); bf16* xb = (bf16*)(ws + WS_XB); (void)mod; (void)proj; (void)xb; const Ctx P = fresh(X); p1_norm_gates(a, P, l, xb); } }
        SEAM(g0 + 0); TEND(0); TBEG();
        if (PON(1) && IN(g0 + 1)) for (int rep = 0; rep < NREP(1); ++rep) { const Args a = load_args(); unsigned char* ws = a.ws; const float* mod = (const float*)(ws + WS_MOD); bf16* proj = (bf16*)(ws + WS_PROJ); bf16* xb = (bf16*)(ws + WS_XB); (void)mod; (void)proj; (void)xb; const Ctx P = fresh(X);
            DenseSched S; S.A = (const char*)(ws + WS_H); S.Bt = (const char*)(ws + WS_WIN) + (size_t)l * NPROJW * D; S.lda = D; S.ldb = D; S.ord.init(T / 256, NPROJW / 256, P.G, P.bid, 2);
            EpiProj E; E.O = proj; E.gates = (float*)(ws + WS_GATES); E.big = a.b_ig + l * 4; E.bfg = a.b_fg + l * 4; E.nul = (rep == 0 && NREP(1) == 2 && (NULEPI == 1 || NULEPI == 3)) ? NULEPI : 0; E.rwrap = (rep == 0 && NREP(1) == 2 && NULEPI == 2) ? 255 : 0x7fffffff;
#ifndef STAGGER_TICKS
#define STAGGER_TICKS 0
#endif
            if (STAGGER_TICKS && ((P.bid >> 3) & 1)) { const unsigned long long t0 = __builtin_amdgcn_s_memrealtime(); while (__builtin_amdgcn_s_memrealtime() - t0 < STAGGER_TICKS) __builtin_amdgcn_s_sleep(4); }
            pg8::gemm_phase<EpiProj, DenseSched, true>(P.lds, D, S, E);
        }
        SEAM(g0 + 1); TEND(1); TBEG();
        if (PON(2) && IN(g0 + 2)) { const Args a = load_args(); unsigned char* ws = a.ws; const float* mod = (const float*)(ws + WS_MOD); bf16* proj = (bf16*)(ws + WS_PROJ); bf16* xb = (bf16*)(ws + WS_XB); (void)mod; (void)proj; (void)xb; const Ctx P = fresh(X);
            if (PON(11)) for (int rep = 0; rep < NREP(11); ++rep) {
#pragma unroll 1
                for (int u = P.bid; u < 512; u += P.G) attn_unit(a, P, l, u); }
            if (PON(12)) for (int rep = 0; rep < NREP(12); ++rep) {
#pragma unroll 1
                for (int u = P.bid; u < 256; u += P.G) mlstm_unit<false>(a, P, l, u); }
        }
        SEAM(g0 + 2); TEND(2); TBEG();
        if (PON(3) && IN(g0 + 3)) { const Args a = load_args(); unsigned char* ws = a.ws; const float* mod = (const float*)(ws + WS_MOD); bf16* proj = (bf16*)(ws + WS_PROJ); bf16* xb = (bf16*)(ws + WS_XB); (void)mod; (void)proj; (void)xb; const Ctx P = fresh(X); mlstm_scan(a, P); }
        SEAM(g0 + 3); TEND(3); TBEG();
        if (PON(4) && IN(g0 + 4)) for (int rep = 0; rep < NREP(4); ++rep) { const Args a = load_args(); unsigned char* ws = a.ws; const float* mod = (const float*)(ws + WS_MOD); bf16* proj = (bf16*)(ws + WS_PROJ); bf16* xb = (bf16*)(ws + WS_XB); (void)mod; (void)proj; (void)xb; const Ctx P = fresh(X);
#pragma unroll 1
            for (int u = P.bid; u < 256; u += P.G) mlstm_unit<true>(a, P, l, u); }
        SEAM(g0 + 4); TEND(4); TBEG();
        if (PON(5) && IN(g0 + 5)) for (int rep = 0; rep < NREP(5); ++rep) { const Args a = load_args(); unsigned char* ws = a.ws; const float* mod = (const float*)(ws + WS_MOD); bf16* proj = (bf16*)(ws + WS_PROJ); bf16* xb = (bf16*)(ws + WS_XB); (void)mod; (void)proj; (void)xb; const Ctx P = fresh(X);
            MergeSched S; S.A0 = (const char*)(ws + WS_H); S.A1 = (const char*)(ws + WS_H) + (size_t)T * 512; S.B0 = (const char*)(ws + WS_WAU) + (size_t)l * D * 512; S.B1 = (const char*)(ws + WS_WMU) + (size_t)l * D * 512;
            S.lda = 512; S.ldb = 512; S.ord.init(T / 256, D / 256, P.G, P.bid);
            EpiMerge E; E.P = proj; E.nul = (rep == 0 && NREP(5) == 2) ? NULEPI : 0; pg8::gemm_phase<EpiMerge, MergeSched, true>(P.lds, 1024, S, E);
        }
        SEAM(g0 + 5); TEND(5); TBEG();
        if (PON(6) && IN(g0 + 6)) for (int rep = 0; rep < NREP(6); ++rep) { const Args a = load_args(); unsigned char* ws = a.ws; const float* mod = (const float*)(ws + WS_MOD); bf16* proj = (bf16*)(ws + WS_PROJ); bf16* xb = (bf16*)(ws + WS_XB); (void)mod; (void)proj; (void)xb; const Ctx P = fresh(X);
            DenseSched S; S.A = (const char*)(proj + C_MQ); S.Bt = (const char*)(ws + WS_WOUT) + (size_t)l * D * D; S.lda = NPROJ * 2; S.ldb = D; S.ord.init(T / 256, D / 256, P.G, P.bid);
            EpiRes E; E.xin = xb; E.out = xb; E.g = mod + (size_t)(l * 2) * 6144 + 2 * 1024; E.ssq = (float*)(ws + WS_SSQ); E.rmask = T - 1; E.nul = 0;
            if (rep) { E.out = (bf16*)(ws + WS_H); E.rmask = T / 2 - 1; E.nul = NULEPI; }
            pg8::gemm_phase<EpiRes, DenseSched, true>(P.lds, D, S, E);
        }
        SEAM(g0 + 6); TEND(6); TBEG();
        if (PON(7) && IN(g0 + 7)) { const Args a = load_args(); unsigned char* ws = a.ws; const float* mod = (const float*)(ws + WS_MOD); bf16* proj = (bf16*)(ws + WS_PROJ); bf16* xb = (bf16*)(ws + WS_XB); (void)mod; (void)proj; (void)xb; const Ctx P = fresh(X); p6_norm_route(a, P, l, xb); }
        SEAM(g0 + 7); TEND(7); TBEG();
        if (PON(8) && IN(g0 + 8)) for (int rep = 0; rep < NREP(8); ++rep) { const Args a = load_args(); unsigned char* ws = a.ws; const float* mod = (const float*)(ws + WS_MOD); bf16* proj = (bf16*)(ws + WS_PROJ); bf16* xb = (bf16*)(ws + WS_XB); (void)mod; (void)proj; (void)xb; const Ctx P = fresh(X);
            const MoeTab tb = moe_tables(a, P, l);
            LAS unsigned* tokoff = (LAS unsigned*)(P.lds + TOKOFF_OFF); const int* tokl = (const int*)(ws + WS_TOKL);
#pragma unroll 1
            for (int s = 0; s < 8; ++s) { const int L0 = s * P.G + P.bid;
                if (L0 < tb.Rtot * 8 && P.tid < 256) { const int L = xcd_remap(L0, tb.Rtot * 8); const int rt = L >> 3, cls = tb.tcls[rt], pos = tb.tpos[rt] + P.tid, cn = tb.cnt[cls]; const int tok = tokl[cls * CLS_CAP + (pos < cn ? pos : 0)]; tokoff[s * 256 + P.tid] = (unsigned)tok; } }
            __syncthreads();
            MoeUpSched S; S.A = (const char*)(ws + WS_H); S.W = (const char*)(ws + WS_WGU) + (size_t)l * NE * 1024 * D; S.lda = D; S.ldb = D; S.tb = tb; S.G = P.G; S.c = P.bid; S.tokoff = tokoff;
            EpiSwiglu E; E.H = (unsigned char*)proj; E.tgate = (const float*)(ws + WS_TGATE); E.tokoff = tokoff;
            pg8::gemm_phase<EpiSwiglu, MoeUpSched, true>(P.lds, D, S, E);
            if (rep == 0 && l + 1 < NL) { conv_fill(a, P, l + 1, (tb.Rtot * 8) % P.G, 0, IT_A); conv_fill(a, P, l + 1, (tb.Rtot * 8) % P.G, IT_A + IT_GU, IT_DN); }
        }
        SEAM(g0 + 8); TEND(8); TBEG();
        if (PON(9) && IN(g0 + 9)) for (int rep = 0; rep < NREP(9); ++rep) { const Args a = load_args(); unsigned char* ws = a.ws; const float* mod = (const float*)(ws + WS_MOD); bf16* proj = (bf16*)(ws + WS_PROJ); bf16* xb = (bf16*)(ws + WS_XB); (void)mod; (void)proj; (void)xb; const Ctx P = fresh(X);
            const MoeTab tb = moe_tables(a, P, l);
            MoeDownSched S; S.A = (const char*)proj; S.W = (const char*)(ws + WS_WD) + (size_t)l * NE * 1024 * FF; S.lda = D; S.ldb = FF; S.tb = tb; S.G = P.G; S.c = P.bid;
            EpiMoeOut E; E.xin = xb; E.outb = xb; E.outf = a.out; E.last = (l == NL - 1); E.g = mod + (size_t)(l * 2) * 6144 + 5 * 1024; E.tokl = (const int*)(ws + WS_TOKL); E.tb = tb; E.rmask = T - 1;
            if (rep) { E.outb = (bf16*)(ws + WS_H); E.last = 0; E.rmask = T / 2 - 1; }
            pg8::gemm_phase<EpiMoeOut, MoeDownSched, true>(P.lds, D, S, E);
            if (rep == 0 && l + 1 < NL) conv_fill(a, P, l + 1, (tb.Rtot * 4) % P.G, IT_A, IT_GU);
        }
        SEAM(g0 + 9); TEND(9); TBEG();
    }
    if (TSEL_MASK && X.bid == 0) { const unsigned long long t1 = __builtin_amdgcn_s_memrealtime(); while (__builtin_amdgcn_s_memrealtime() - t1 < TSCALE * tacc) __builtin_amdgcn_s_sleep(8); }
#undef IN
#undef SEAM
}

extern "C" void kernel_launch(void* const* d_in, const int* in_sizes, int n_in, void* d_out, int out_size, void* d_ws, size_t ws_size, hipStream_t stream) {
    static int grid = 0;
    if (grid == 0) {
        if (n_in != 24 || in_sizes[0] != T * D || out_size != T * D || ws_size < WS_END) { fprintf(stderr, "kernel_launch: unexpected shapes / workspace (n_in %d, ws %zu, need %zu)\n", n_in, ws_size, (size_t)WS_END); grid = -1; return; }
        int dev = 0, cus = 0;
        if (hipGetDevice(&dev) != hipSuccess || hipDeviceGetAttribute(&cus, hipDeviceAttributeMultiprocessorCount, dev) != hipSuccess) { grid = -1; return; }
        if (hipFuncSetAttribute((const void*)fwd, hipFuncAttributeMaxDynamicSharedMemorySize, LDS_BYTES) != hipSuccess) { fprintf(stderr, "kernel_launch: hipFuncSetAttribute failed\n"); grid = -1; return; }
        int per_cu = 0;
        if (hipOccupancyMaxActiveBlocksPerMultiprocessor(&per_cu, (const void*)fwd, 512, LDS_BYTES) != hipSuccess || per_cu < 1) fprintf(stderr, "kernel_launch: occupancy query reports %d\n", per_cu);
        (void)hipGetLastError();
        grid = cus < 256 ? cus : 256;
    }
    if (grid < 0) return;
    (void)hipMemsetAsync((char*)d_ws + WS_CTL, 0, CTL_ZERO_BYTES, stream);
    Args a{};
    a.x = (const float*)d_in[0]; a.c = (const float*)d_in[1]; a.pos = (const int*)d_in[2]; a.ada_w = (const float*)d_in[3]; a.ada_b = (const float*)d_in[4];
    a.nmw = (const float*)d_in[5]; a.nfw = (const float*)d_in[6]; a.w_in = (const float*)d_in[7]; a.b_ig = (const float*)d_in[8]; a.b_fg = (const float*)d_in[9];
    a.qnw = (const float*)d_in[10]; a.knw = (const float*)d_in[11]; a.sinks = (const float*)d_in[12]; a.conv_w = (const float*)d_in[13]; a.conv_b = (const float*)d_in[14];
    a.mnw = (const float*)d_in[15]; a.w_au = (const float*)d_in[16]; a.w_mu = (const float*)d_in[17]; a.w_out = (const float*)d_in[18]; a.router_w = (const float*)d_in[19];
    a.router_b = (const float*)d_in[20]; a.w_gate = (const float*)d_in[21]; a.w_up = (const float*)d_in[22]; a.w_down = (const float*)d_in[23];
    a.out = (float*)d_out; a.ws = (unsigned char*)d_ws;
#if MK_MULTI
    for (int gp = 0; gp < NGP; ++gp) { a.ph_lo = gp; a.ph_hi = gp + 1; hipLaunchKernelGGL(fwd, dim3(grid), dim3(512), LDS_BYTES, stream, a); }
#else
    a.ph_lo = 0; a.ph_hi = NGP; hipLaunchKernelGGL(fwd, dim3(grid), dim3(512), LDS_BYTES, stream, a);
#endif
}
```
